# Optimizing an MI355X kernel written in HIP

```python
import math
import jax, jax.numpy as jnp
from jax import lax
import numpy as np

D_MODEL = 1024
BATCH = 8
SEQ = 4096
DEPTH = 2

CTX_LEN = 256
GRID_W = 64
Q_BLOCK = 128
ROPE_BASE = 10000.0
EPS = 1e-6

GQA_HEADS = 8
GQA_KV_HEADS = 2
GQA_HEAD_DIM = 64
MLA_HEADS = 8
MLA_Q_RANK = 256
MLA_KV_RANK = 128
MLA_NOPE_DIM = 64
MLA_ROPE_DIM = 32
MLA_V_DIM = 64
ATTN_WIDTH = GQA_HEADS * GQA_HEAD_DIM + MLA_HEADS * MLA_V_DIM
ATTN_SPLITS = (GQA_HEADS * GQA_HEAD_DIM, GQA_KV_HEADS * GQA_HEAD_DIM, GQA_KV_HEADS * GQA_HEAD_DIM,
               MLA_Q_RANK, MLA_KV_RANK, MLA_ROPE_DIM, ATTN_WIDTH)
ATTN_IN = (GQA_HEADS + 2 * GQA_KV_HEADS) * GQA_HEAD_DIM + MLA_Q_RANK + MLA_KV_RANK + MLA_ROPE_DIM + ATTN_WIDTH
HY_WIDTH = D_MODEL
HY_ORDER = 2
HY_SHORT = 3
HY_BANDS = 16
HY_EMB = 1 + 2 * HY_BANDS
HY_FFN = 64
HY_FAST_DECAY = 0.3
HY_SLOW_DECAY = 1.5
HY_DECAY_TARGET = 1e-2

kernel_name = "hybrid_gqa_mla_hyena_prefix_dit"


def _f32(a):
    return a.astype(jnp.float32)


def split_cols(p, sizes):
    out, start = [], 0
    for n in sizes:
        out.append(p[..., start:start + n])
        start += n
    return out


def rms_norm(x, w):
    xf = _f32(x)
    y = xf * lax.rsqrt(jnp.mean(xf * xf, axis=-1, keepdims=True) + EPS)
    return (y * _f32(w)).astype(x.dtype)


def modulate(x, norm_w, shift, scale):
    return rms_norm(x, norm_w) * (1 + scale) + shift


def axial_rope_tables(n_tokens, rot_dim):
    n_rows = n_tokens // GRID_W
    rows = jnp.repeat(jnp.arange(n_rows, dtype=jnp.int32), GRID_W)
    cols = jnp.tile(jnp.arange(GRID_W, dtype=jnp.int32), n_rows)
    quarter = rot_dim // 4
    inv_freq = ROPE_BASE ** (-jnp.arange(quarter, dtype=jnp.float32) / quarter)
    ang_r = _f32(rows)[:, None] * inv_freq
    ang_c = _f32(cols)[:, None] * inv_freq
    return (jnp.cos(ang_r), jnp.sin(ang_r), jnp.cos(ang_c), jnp.sin(ang_c))


def rotate_pairs(x, cos, sin):
    a, b = jnp.split(x, 2, axis=-1)
    return jnp.concatenate([a * cos - b * sin, b * cos + a * sin], axis=-1)


def apply_axial_rope(x, tables):
    cr, sr, cc, sc = (t[:, None, :].astype(x.dtype) for t in tables)
    xr, xc = jnp.split(x, 2, axis=-1)
    return jnp.concatenate([rotate_pairs(xr, cr, sr), rotate_pairs(xc, cc, sc)], axis=-1)


def block_attention(q, k, v, scale):
    B, Lq, Hkv, G, d = q.shape
    nb = Lq // Q_BLOCK
    kf, vf = _f32(k), _f32(v)
    qb = jnp.moveaxis(q.reshape(B, nb, Q_BLOCK, Hkv, G, d), 1, 0)

    def one_block(qi):
        s = jnp.einsum("bqhgd,bkhd->bhgqk", _f32(qi), kf) * scale
        p = jax.nn.softmax(s, axis=-1)
        return jnp.einsum("bhgqk,bkhe->bqhge", p, vf)

    o = lax.map(one_block, qb)
    return jnp.moveaxis(o, 0, 1).reshape(B, Lq, Hkv * G, v.shape[-1]).astype(v.dtype)


def attn_project(h, w_in, q_norm_w, k_norm_w, cq_norm_w, ckv_norm_w, w_uq, w_ukv, rope_a, rope_m):
    B, L, _ = h.shape
    q_a, k_a, v_a, c_q, c_kv, k_pe, gate = split_cols(h @ w_in, ATTN_SPLITS)
    q_a = rms_norm(q_a.reshape(B, L, GQA_HEADS, GQA_HEAD_DIM), q_norm_w)
    k_a = rms_norm(k_a.reshape(B, L, GQA_KV_HEADS, GQA_HEAD_DIM), k_norm_w)
    v_a = v_a.reshape(B, L, GQA_KV_HEADS, GQA_HEAD_DIM)
    q_m = (rms_norm(c_q, cq_norm_w) @ w_uq).reshape(B, L, MLA_HEADS, MLA_NOPE_DIM + MLA_ROPE_DIM)
    kv_m = (rms_norm(c_kv, ckv_norm_w) @ w_ukv).reshape(B, L, MLA_HEADS, MLA_NOPE_DIM + MLA_V_DIM)
    q_nope, q_pe = q_m[..., :MLA_NOPE_DIM], q_m[..., MLA_NOPE_DIM:]
    k_nope, v_m = kv_m[..., :MLA_NOPE_DIM], kv_m[..., MLA_NOPE_DIM:]
    k_pe = k_pe.reshape(B, L, 1, MLA_ROPE_DIM)
    if rope_a is not None:
        q_a = apply_axial_rope(q_a, rope_a)
        k_a = apply_axial_rope(k_a, rope_a)
        q_pe = apply_axial_rope(q_pe, rope_m)
        k_pe = apply_axial_rope(k_pe, rope_m)
    q_m = jnp.concatenate([q_nope, q_pe], axis=-1)
    k_m = jnp.concatenate([k_nope, jnp.broadcast_to(k_pe, (B, L, MLA_HEADS, MLA_ROPE_DIM))], axis=-1)
    return q_a, k_a, v_a, q_m, k_m, v_m, gate


def attn_mixer(h_lat, h_ctx, w_in, q_norm_w, k_norm_w, cq_norm_w, ckv_norm_w, w_uq, w_ukv, w_out, with_ctx_out):
    L = h_lat.shape[1]
    rope_a = axial_rope_tables(L, GQA_HEAD_DIM)
    rope_m = axial_rope_tables(L, MLA_ROPE_DIM)
    lq_a, lk_a, lv_a, lq_m, lk_m, lv_m, l_gate = attn_project(
        h_lat, w_in, q_norm_w, k_norm_w, cq_norm_w, ckv_norm_w, w_uq, w_ukv, rope_a, rope_m)
    cq_a, ck_a, cv_a, cq_m, ck_m, cv_m, c_gate = attn_project(
        h_ctx, w_in, q_norm_w, k_norm_w, cq_norm_w, ckv_norm_w, w_uq, w_ukv, None, None)

    def mix(q_a, q_m, gate, k_a, v_a, k_m, v_m):
        B, Lq = q_a.shape[:2]
        o_a = block_attention(q_a.reshape(B, Lq, GQA_KV_HEADS, GQA_HEADS // GQA_KV_HEADS, GQA_HEAD_DIM),
                              k_a, v_a, GQA_HEAD_DIM ** -0.5)
        o_m = block_attention(q_m[:, :, :, None, :], k_m, v_m, (MLA_NOPE_DIM + MLA_ROPE_DIM) ** -0.5)
        o = jnp.concatenate([o_a.reshape(B, Lq, -1), o_m.reshape(B, Lq, -1)], axis=-1)
        return (o * jax.nn.silu(gate)) @ w_out

    y_lat = mix(lq_a, lq_m, l_gate,
                jnp.concatenate([ck_a, lk_a], axis=1), jnp.concatenate([cv_a, lv_a], axis=1),
                jnp.concatenate([ck_m, lk_m], axis=1), jnp.concatenate([cv_m, lv_m], axis=1))
    y_ctx = mix(cq_a, cq_m, c_gate, ck_a, cv_a, ck_m, cv_m) if with_ctx_out else None
    return y_lat, y_ctx


def hyena_filters(L, w1, b1, w2, b2, w3, b3, freq):
    t = jnp.linspace(0.0, 1.0, L, dtype=jnp.float32)[:, None]
    w = (2.0 * math.pi / L) * jnp.arange(L, dtype=jnp.float32)[:, None]
    bands = jnp.linspace(1e-4, HY_BANDS - 1, HY_BANDS, dtype=jnp.float32)
    emb = jnp.concatenate([t, jnp.cos(w * bands), -jnp.sin(w * bands)], axis=-1)
    hid = jnp.sin(_f32(freq) * (emb @ _f32(w1) + _f32(b1)))
    hid = jnp.sin(_f32(freq) * (hid @ _f32(w2) + _f32(b2)))
    h = (hid @ _f32(w3) + _f32(b3)).reshape(L, HY_ORDER, 2, HY_WIDTH)
    max_decay = math.log(HY_DECAY_TARGET) / HY_FAST_DECAY
    min_decay = math.log(HY_DECAY_TARGET) / HY_SLOW_DECAY
    deltas = jnp.linspace(min_decay, max_decay, HY_WIDTH, dtype=jnp.float32)
    h = h * jnp.exp(-t * jnp.abs(deltas))[:, None, None, :]
    fwd, bwd = h[:, :, 0], h[:, :, 1]
    kern = jnp.concatenate([fwd, jnp.zeros((1, HY_ORDER, HY_WIDTH), jnp.float32), bwd[:0:-1]], axis=0)
    kern = kern / jnp.sum(jnp.abs(kern), axis=0, keepdims=True)
    return jnp.fft.rfft(kern, axis=0)


def long_conv(u, k_f, skip):
    L = u.shape[1]
    uf = _f32(u)
    y = jnp.fft.irfft(jnp.fft.rfft(uf, n=2 * L, axis=1) * k_f, n=2 * L, axis=1)[:, :L]
    return (y + uf * _f32(skip)).astype(u.dtype)


def short_conv(u, w, b):
    L = u.shape[1]
    pad = HY_SHORT // 2
    up = jnp.pad(u, ((0, 0), (pad, pad), (0, 0)))
    return sum(up[:, j:j + L] * w[j] for j in range(HY_SHORT)) + b


def hyena_mixer(h, w_in, conv_w, conv_b, f_w1, f_b1, f_w2, f_b2, f_w3, f_b3, freq, skip, w_out):
    L = h.shape[1]
    p = h @ w_in
    u = short_conv(p[..., :(HY_ORDER + 1) * HY_WIDTH], conv_w, conv_b)
    gate = p[..., (HY_ORDER + 1) * HY_WIDTH:]
    parts = jnp.split(u, HY_ORDER + 1, axis=-1)
    k_f = hyena_filters(L, f_w1, f_b1, f_w2, f_b2, f_w3, f_b3, freq)
    z = parts[0]
    for o in range(HY_ORDER):
        z = parts[o + 1] * long_conv(z, k_f[:, o], skip[o])
    return (z * jax.nn.silu(gate)) @ w_out


def setup_inputs(seed: int = 0) -> dict:
    key = jax.random.key(seed)
    ks = jax.random.split(key, 32)
    n_attn = (DEPTH + 1) // 2
    n_hy = DEPTH // 2
    f32 = jnp.float32

    def nrm(k, shape, fan_in):
        return jax.random.normal(k, shape, f32) * fan_in ** -0.5

    def gain(k, shape):
        return 1.0 + 0.05 * jax.random.normal(k, shape, f32)

    def small(k, shape, s=0.02):
        return s * jax.random.normal(k, shape, f32)

    return {
        "x": jax.random.normal(ks[0], (BATCH, SEQ, D_MODEL), f32),
        "c": jax.random.normal(ks[1], (BATCH, D_MODEL), f32),
        "ctx": jax.random.normal(ks[2], (BATCH, CTX_LEN, D_MODEL), f32),
        "c_ctx": jax.random.normal(ks[3], (D_MODEL,), f32),
        "ada_w": nrm(ks[4], (DEPTH, D_MODEL, 3 * D_MODEL), D_MODEL),
        "ada_b": small(ks[5], (DEPTH, 3 * D_MODEL)),
        "norm_w": gain(ks[6], (DEPTH, D_MODEL)),
        "attn_w_in": nrm(ks[7], (n_attn, D_MODEL, ATTN_IN), D_MODEL),
        "attn_q_norm": gain(ks[8], (n_attn, GQA_HEAD_DIM)),
        "attn_k_norm": gain(ks[9], (n_attn, GQA_HEAD_DIM)),
        "mla_q_norm": gain(ks[10], (n_attn, MLA_Q_RANK)),
        "mla_kv_norm": gain(ks[11], (n_attn, MLA_KV_RANK)),
        "mla_w_uq": nrm(ks[12], (n_attn, MLA_Q_RANK, MLA_HEADS * (MLA_NOPE_DIM + MLA_ROPE_DIM)), MLA_Q_RANK),
        "mla_w_ukv": nrm(ks[13], (n_attn, MLA_KV_RANK, MLA_HEADS * (MLA_NOPE_DIM + MLA_V_DIM)), MLA_KV_RANK),
        "attn_w_out": nrm(ks[14], (n_attn, ATTN_WIDTH, D_MODEL), ATTN_WIDTH),
        "hy_w_in": nrm(ks[15], (n_hy, D_MODEL, (HY_ORDER + 2) * HY_WIDTH), D_MODEL),
        "hy_conv_w": nrm(ks[16], (n_hy, HY_SHORT, (HY_ORDER + 1) * HY_WIDTH), HY_SHORT),
        "hy_conv_b": small(ks[17], (n_hy, (HY_ORDER + 1) * HY_WIDTH)),
        "hy_ffn_w1": nrm(ks[18], (n_hy, HY_EMB, HY_FFN), HY_EMB),
        "hy_ffn_b1": small(ks[19], (n_hy, HY_FFN), 0.1),
        "hy_ffn_w2": nrm(ks[20], (n_hy, HY_FFN, HY_FFN), HY_FFN),
        "hy_ffn_b2": small(ks[21], (n_hy, HY_FFN), 0.1),
        "hy_ffn_w3": nrm(ks[22], (n_hy, HY_FFN, HY_ORDER * 2 * HY_WIDTH), HY_FFN),
        "hy_ffn_b3": small(ks[23], (n_hy, HY_ORDER * 2 * HY_WIDTH), 0.1),
        "hy_freq": gain(ks[24], (n_hy, HY_FFN)),
        "hy_skip": small(ks[25], (n_hy, HY_ORDER, HY_WIDTH), 0.1),
        "hy_w_out": nrm(ks[26], (n_hy, HY_WIDTH, D_MODEL), HY_WIDTH),
        "final_norm_w": gain(ks[27], (D_MODEL,)),
    }


def reference(x, c, ctx, c_ctx, ada_w, ada_b, norm_w, attn_w_in, attn_q_norm, attn_k_norm,
              mla_q_norm, mla_kv_norm, mla_w_uq, mla_w_ukv, attn_w_out, hy_w_in, hy_conv_w, hy_conv_b,
              hy_ffn_w1, hy_ffn_b1, hy_ffn_w2, hy_ffn_b2, hy_ffn_w3, hy_ffn_b3, hy_freq, hy_skip,
              hy_w_out, final_norm_w):
    last_attn = (DEPTH - 1) - ((DEPTH - 1) % 2)
    s_lat = jax.nn.silu(c)
    s_ctx = jax.nn.silu(c_ctx)
    x_lat, x_ctx = x, ctx
    for i in range(DEPTH):
        j = i // 2
        ctx_update = i < last_attn
        shift, scale, gate = jnp.split(s_lat @ ada_w[i] + ada_b[i], 3, axis=-1)
        h_lat = modulate(x_lat, norm_w[i], shift[:, None], scale[:, None])
        need_ctx = (i % 2 == 0) or ctx_update
        if need_ctx:
            shift_c, scale_c, gate_c = jnp.split(s_ctx @ ada_w[i] + ada_b[i], 3, axis=-1)
            h_ctx = modulate(x_ctx, norm_w[i], shift_c, scale_c)
        if i % 2 == 0:
            y_lat, y_ctx = attn_mixer(h_lat, h_ctx, attn_w_in[j], attn_q_norm[j], attn_k_norm[j],
                                      mla_q_norm[j], mla_kv_norm[j], mla_w_uq[j], mla_w_ukv[j],
                                      attn_w_out[j], ctx_update)
        else:
            hy_args = (hy_w_in[j], hy_conv_w[j], hy_conv_b[j], hy_ffn_w1[j], hy_ffn_b1[j], hy_ffn_w2[j],
                       hy_ffn_b2[j], hy_ffn_w3[j], hy_ffn_b3[j], hy_freq[j], hy_skip[j], hy_w_out[j])
            y_lat = hyena_mixer(h_lat, *hy_args)
            y_ctx = hyena_mixer(h_ctx, *hy_args) if ctx_update else None
        x_lat = x_lat + gate[:, None] * y_lat
        if ctx_update:
            x_ctx = x_ctx + gate_c * y_ctx
    return rms_norm(x_lat, final_norm_w)
```

```cpp
#include <hip/hip_runtime.h>
#include <hip/hip_cooperative_groups.h>
#include <cstdio>
#include <cstdint>
namespace cg = cooperative_groups;

#ifndef MK_LAUNCHES
#define MK_LAUNCHES 12
#endif

#define DEV __device__ __forceinline__
typedef unsigned short bf16_t;
typedef short bf16x8 __attribute__((ext_vector_type(8)));
typedef short s16x4 __attribute__((ext_vector_type(4)));
typedef float f32x16 __attribute__((ext_vector_type(16)));
typedef float f32x4 __attribute__((ext_vector_type(4)));
typedef float f32x2 __attribute__((ext_vector_type(2)));
typedef unsigned u32x4 __attribute__((ext_vector_type(4)));
typedef unsigned u32x2 __attribute__((ext_vector_type(2)));
typedef __bf16 bf16x2_t __attribute__((ext_vector_type(2)));
#define LAS __attribute__((address_space(3)))

constexpr int NB = 8, SEQ = 4096, DM = 1024, CTXL = 256, LK = SEQ + CTXL;
constexpr int NTOK = NB * SEQ, NCTX = NB * CTXL, NALL = NTOK + NCTX;
constexpr int AIN = 2208, AINP = 2304;
constexpr float EPS = 1e-6f;
constexpr float LOG2E = 1.4426950408889634f;
constexpr float QSC_A = 0.125f * LOG2E;
constexpr float QSC_M = 0.10206207261596575f * LOG2E;

constexpr size_t MiB = 1ull << 20;
constexpr size_t WS_WIN = 0;
constexpr size_t WS_WUQ = 5 * MiB;
constexpr size_t WS_WUKV = 6 * MiB;
constexpr size_t WS_WOUT = 7 * MiB;
constexpr size_t WS_HWIN = 9 * MiB;
constexpr size_t WS_HWOUT = 17 * MiB;
constexpr size_t WS_W3 = 19 * MiB;
constexpr size_t WS_HID2 = 20 * MiB;
constexpr size_t WS_MOD0 = 21 * MiB;
constexpr size_t WS_MOD1 = WS_MOD0 + 9 * 3072 * 4;
constexpr size_t WS_SSUM = WS_MOD1 + 8 * 3072 * 4;
constexpr size_t WS_ROPE = WS_SSUM + 2048 * 4;
constexpr size_t WS_GR = 22 * MiB;
constexpr size_t WS_H0 = 64 * MiB;
constexpr size_t WS_PRAW = 136 * MiB;
constexpr size_t WS_QA = 297 * MiB;
constexpr size_t WS_KA = 329 * MiB;
constexpr size_t WS_VA = 338 * MiB;
constexpr size_t WS_CQN = 347 * MiB;
constexpr size_t WS_CKVN = 363 * MiB;
constexpr size_t WS_G = 372 * MiB;
constexpr size_t WS_QM = 64 * MiB;
constexpr size_t WS_KM = 136 * MiB;
constexpr size_t WS_VM = 190 * MiB;
constexpr size_t WS_OG = 226 * MiB;
constexpr size_t WS_H1 = 436 * MiB;
constexpr size_t WS_PT = 64 * MiB;
constexpr size_t WS_OG2 = 320 * MiB;
constexpr size_t WS_END = 500 * MiB;
constexpr size_t WS2_KM = 436 * MiB;
constexpr size_t WS2_VM = 190 * MiB;
constexpr size_t WS2_OG = 226 * MiB;

constexpr int LDS_BYTES = 150 * 1024;

DEV float bf2f(bf16_t v) { return __uint_as_float(((unsigned)v) << 16); }
DEV unsigned pk2(float lo, float hi) { f32x2 v = {lo, hi}; bf16x2_t b = __builtin_convertvector(v, bf16x2_t); return __builtin_bit_cast(unsigned, b); }
DEV bf16_t f2bf(float f) { return (bf16_t)(pk2(f, 0.f) & 0xffffu); }
DEV float lo_bf(unsigned w) { return __uint_as_float(w << 16); }
DEV float hi_bf(unsigned w) { return __uint_as_float(w & 0xffff0000u); }
DEV int crow(int r, int hi) { return (r & 3) + 8 * (r >> 2) + 4 * hi; }
DEV float silu(float v) { return v / (1.f + __expf(-v)); }
DEV void unpack8(const u32x4 w, float* v) { v[0] = lo_bf(w.x); v[1] = hi_bf(w.x); v[2] = lo_bf(w.y); v[3] = hi_bf(w.y); v[4] = lo_bf(w.z); v[5] = hi_bf(w.z); v[6] = lo_bf(w.w); v[7] = hi_bf(w.w); }
DEV u32x4 pack8(const float* v) { u32x4 w; w.x = pk2(v[0], v[1]); w.y = pk2(v[2], v[3]); w.z = pk2(v[4], v[5]); w.w = pk2(v[6], v[7]); return w; }

struct Params {
    const float *x, *c, *ctx, *c_ctx, *ada_w, *ada_b, *norm_w, *w_in, *q_norm, *k_norm, *cq_norm, *ckv_norm, *w_uq, *w_ukv, *w_out,
        *hy_w_in, *conv_w, *conv_b, *f_w1, *f_b1, *f_w2, *f_b2, *f_w3, *f_b3, *freq, *skip, *hy_w_out, *final_w;
    float* out; char* ws; int ph_lo, ph_hi;
};

constexpr int G_RS = 144;
constexpr int G_RB = 256 * G_RS, G_CB = 128 * G_RS, G_STAGE = G_RB + G_CB;
constexpr int T_RS = 576;

template <bool TR, class Epi>
DEV void gemm_tile(char* lds, const bf16_t* __restrict__ R, size_t ldr, const bf16_t* __restrict__ C, size_t ldc, int K, const Epi& epi, int ti0, int tj0) {
    const int tid = threadIdx.x, lane = tid & 63, wid = tid >> 6;
    const int wi = wid >> 1, wj = wid & 1, l31 = lane & 31, hi = lane >> 5;
    f32x16 acc[2][2];
#pragma unroll
    for (int a = 0; a < 2; ++a)
#pragma unroll
        for (int b = 0; b < 2; ++b)
#pragma unroll
            for (int r = 0; r < 16; ++r) acc[a][b][r] = 0.f;
    u32x4 rr[4], rc[2];
    const bf16_t* Rp; const bf16_t* Cp; int rl_off, cl_off;
    if (TR) { const int c = tid & 31, kr = tid >> 5; Rp = R + (size_t)kr * ldr + c * 8; rl_off = kr * T_RS + c * 16; }
    else { const int lr = tid >> 3, lc = tid & 7; Rp = R + (size_t)lr * ldr + lc * 8; rl_off = lr * G_RS + lc * 16; }
    { const int lr = tid >> 3, lc = tid & 7; Cp = C + (size_t)lr * ldc + lc * 8; cl_off = lr * G_RS + lc * 16; }
    const int nk = K / 64;
    int ra_off[2], cb_off[2];
#pragma unroll
    for (int t = 0; t < 2; ++t) {
        if (TR) { const int g1 = (lane >> 4) & 1, q = (lane & 15) >> 2, p = lane & 3; ra_off[t] = (8 * hi + q) * T_RS + (wi * 64 + t * 32 + 16 * g1 + 4 * p) * 2; }
        else ra_off[t] = (wi * 64 + t * 32 + l31) * G_RS + hi * 16;
        cb_off[t] = G_RB + (wj * 64 + t * 32 + l31) * G_RS + hi * 16;
    }
#define G_LOAD(kt) do { \
        if (TR) { _Pragma("unroll") for (int p = 0; p < 4; ++p) rr[p] = *(const u32x4*)(Rp + ((size_t)(kt) * 64 + 16 * p) * ldr); } \
        else { _Pragma("unroll") for (int p = 0; p < 4; ++p) rr[p] = *(const u32x4*)(Rp + (size_t)(64 * p) * ldr + (kt) * 64); } \
        _Pragma("unroll") for (int p = 0; p < 2; ++p) rc[p] = *(const u32x4*)(Cp + (size_t)(64 * p) * ldc + (kt) * 64); } while (0)
#define G_STORE(buf) do { char* b_ = lds + (buf) * G_STAGE; \
        if (TR) { _Pragma("unroll") for (int p = 0; p < 4; ++p) *(u32x4*)(b_ + rl_off + 16 * p * T_RS) = rr[p]; } \
        else { _Pragma("unroll") for (int p = 0; p < 4; ++p) *(u32x4*)(b_ + rl_off + 64 * p * G_RS) = rr[p]; } \
        _Pragma("unroll") for (int p = 0; p < 2; ++p) *(u32x4*)(b_ + G_RB + cl_off + 64 * p * G_RS) = rc[p]; } while (0)
    G_LOAD(0); G_STORE(0);
    __syncthreads();
    for (int kt = 0; kt < nk; ++kt) {
        const bool more = (kt + 1 < nk);
        if (more) G_LOAD(kt + 1);
        const char* b_ = lds + (kt & 1) * G_STAGE;
#pragma unroll
        for (int ks = 0; ks < 4; ++ks) {
            bf16x8 fa[2], fb[2];
#pragma unroll
            for (int t = 0; t < 2; ++t) {
                if (TR) {
                    const s16x4 lo = __builtin_bit_cast(s16x4, __builtin_amdgcn_ds_read_tr16_b64_v4i16((LAS s16x4*)(b_ + ra_off[t] + ks * 16 * T_RS)));
                    const s16x4 hh = __builtin_bit_cast(s16x4, __builtin_amdgcn_ds_read_tr16_b64_v4i16((LAS s16x4*)(b_ + ra_off[t] + (ks * 16 + 4) * T_RS)));
                    fa[t] = (bf16x8){lo[0], lo[1], lo[2], lo[3], hh[0], hh[1], hh[2], hh[3]};
                } else fa[t] = *(const bf16x8*)(b_ + ra_off[t] + ks * 32);
                fb[t] = *(const bf16x8*)(b_ + cb_off[t] + ks * 32);
            }
#pragma unroll
            for (int a = 0; a < 2; ++a)
#pragma unroll
                for (int b = 0; b < 2; ++b) acc[a][b] = __builtin_amdgcn_mfma_f32_32x32x16_bf16(fa[a], fb[b], acc[a][b], 0, 0, 0);
        }
        if (more) G_STORE((kt + 1) & 1);
        __syncthreads();
    }
#undef G_LOAD
#undef G_STORE
#pragma unroll
    for (int a = 0; a < 2; ++a)
#pragma unroll
        for (int b = 0; b < 2; ++b) epi(ti0 + wi * 64 + a * 32, tj0 + wj * 64 + b * 32, acc[a][b], l31, hi);
}

template <bool TR, class Epi>
DEV void gemm_phase(char* lds, const bf16_t* R, size_t ldr, const bf16_t* C, size_t ldc, int nI, int nJ, int K, const Epi& epi) {
    const int tI = nI / 256, tJ = nJ / 128, nt = tI * tJ;
    for (int t = blockIdx.x; t < nt; t += gridDim.x) {
        const int ti = t / tJ, tj = t % tJ;
        gemm_tile<TR, Epi>(lds, R + (size_t)ti * 256 * ldr, ldr, C + (size_t)tj * 128 * ldc, ldc, K, epi, ti * 256, tj * 128);
    }
}

struct EpiRaw {
    bf16_t* O; size_t ld;
    DEV void operator()(int i0, int j0, const f32x16& a, int l31, int hi) const {
#pragma unroll
        for (int r = 0; r < 16; ++r) O[(size_t)(i0 + crow(r, hi)) * ld + j0 + l31] = f2bf(a[r]);
    }
};
struct EpiUq {
    bf16_t* QM; const float* cos32; const float* sin32;
    DEV void operator()(int i0, int j0, const f32x16& a, int l31, int hi) const {
        const bool pe = (j0 % 96) == 64;
        const int fi = l31 & 7; const bool colang = (l31 & 16) != 0; const bool bpart = (l31 & 8) != 0;
#pragma unroll
        for (int r = 0; r < 16; ++r) {
            const int tok = i0 + crow(r, hi); float v = a[r];
            const float o = __shfl_xor(v, 8);
            if (pe) { const int l = tok & (SEQ - 1); const int pos = colang ? (l & 63) : (l >> 6);
                const float cs = cos32[pos * 8 + fi], sn = sin32[pos * 8 + fi];
                v = bpart ? (v * cs + o * sn) : (v * cs - o * sn); }
            QM[(size_t)tok * 768 + j0 + l31] = f2bf(v * QSC_M);
        }
    }
};
struct EpiUkv {
    bf16_t* KM; bf16_t* VM;
    DEV void operator()(int i0, int j0, const f32x16& a, int l31, int hi) const {
        const int h = j0 >> 7, e = (j0 & 127) + l31;
#pragma unroll
        for (int r = 0; r < 16; ++r) { const size_t row = (size_t)(i0 + crow(r, hi));
            if (e < 64) KM[row * 768 + h * 96 + e] = f2bf(a[r]); else VM[row * 512 + h * 64 + (e - 64)] = f2bf(a[r]); }
    }
};
struct EpiRes {
    const float* base; float* out; const float* mod;
    DEV void operator()(int i0, int j0, const f32x16& a, int l31, int hi) const {
        const int b = i0 >> 12; const float g = mod[b * 3072 + 2048 + j0 + l31];
#pragma unroll
        for (int r = 0; r < 16; ++r) { const size_t o = (size_t)(i0 + crow(r, hi)) * DM + j0 + l31; out[o] = base[o] + g * a[r]; }
    }
};
struct EpiPT {
    bf16_t* PT;
    DEV void operator()(int i0, int j0, const f32x16& a, int l31, int hi) const {
        const int b = j0 >> 12, l = (j0 & 4095) + l31;
#pragma unroll
        for (int r = 0; r < 16; ++r) PT[((size_t)(b * 4096 + i0 + crow(r, hi))) * 4096 + l] = f2bf(a[r]);
    }
};
struct EpiFilt {
    bf16_t* GR; float* ssum; const float* b3;
    DEV void operator()(int i0, int j0, const f32x16& a, int l31, int hi) const {
        const int t = j0 + l31; const float tn = (float)t * (1.0f / 4095.0f);
        const float dmin = -3.0701134573253945f, dmax = -15.350567286626973f;
#pragma unroll
        for (int r = 0; r < 16; ++r) {
            const int n = i0 + crow(r, hi); const int c = n & 1023, od = n >> 10, o = od >> 1, dir = od & 1;
            const float delta = fabsf(dmin + (float)c * ((dmax - dmin) / 1023.0f));
            float v = (a[r] + b3[n]) * __expf(-tn * delta);
            bf16_t* g = GR + ((size_t)(o * 1024 + c)) * 8192;
            if (dir == 0) g[4096 - t] = f2bf(v);
            else { if (t == 0) { g[0] = 0; v = 0.f; } else g[4096 + t] = f2bf(v); }
            float s = fabsf(v);
            s += __shfl_xor(s, 16); s += __shfl_xor(s, 8); s += __shfl_xor(s, 4); s += __shfl_xor(s, 2); s += __shfl_xor(s, 1);
            if (l31 == 0) atomicAdd(ssum + o * 1024 + c, s);
        }
    }
};

DEV void transpose_item(char* lds, const float* W, int K, int N, int Npad, bf16_t* WT, int item) {
    float* tile = (float*)lds;
    const int nb = Npad / 64, kb = item / nb, nbi = item % nb, k0 = kb * 64, n0 = nbi * 64;
    const int tid = threadIdx.x;
    { const int kk = tid >> 4, n4 = (tid & 15) * 4;
#pragma unroll
        for (int p = 0; p < 2; ++p) { f32x4 v = {0.f, 0.f, 0.f, 0.f}; if (n0 + n4 < N) v = *(const f32x4*)(W + (size_t)(k0 + kk + 32 * p) * N + n0 + n4);
            float* d = tile + (kk + 32 * p) * 65 + n4; d[0] = v.x; d[1] = v.y; d[2] = v.z; d[3] = v.w; } }
    __syncthreads();
    { const int n = tid >> 3, kc = tid & 7; float v[8];
#pragma unroll
        for (int j = 0; j < 8; ++j) v[j] = tile[(kc * 8 + j) * 65 + n];
        *(u32x4*)(WT + (size_t)(n0 + n) * K + k0 + kc * 8) = pack8(v); }
    __syncthreads();
}

DEV void mod_item(char* lds, const Params& p, int item) {
    const int layer = item / 96, n0 = (item % 96) * 32, tid = threadIdx.x;
    float* s = (float*)lds;
    float* red = s + 9 * 1024;
    for (int i = tid; i < 9 * 1024; i += 512) { const int v = i >> 10, k = i & 1023; const float cv = (v < 8) ? p.c[v * 1024 + k] : p.c_ctx[k]; s[i] = silu(cv); }
    __syncthreads();
    const int kc = tid >> 5, n = tid & 31; const float* W = p.ada_w + (size_t)layer * DM * 3072 + n0 + n;
    float acc[9];
#pragma unroll
    for (int v = 0; v < 9; ++v) acc[v] = 0.f;
#pragma unroll 8
    for (int kk = 0; kk < 64; ++kk) { const int k = kc * 64 + kk; const float w = W[(size_t)k * 3072];
#pragma unroll
        for (int v = 0; v < 9; ++v) acc[v] += s[v * 1024 + k] * w; }
#pragma unroll
    for (int v = 0; v < 9; ++v) red[(kc * 9 + v) * 32 + n] = acc[v];
    __syncthreads();
    if (tid < 9 * 32) { const int v = tid >> 5, nn = tid & 31; float t = 0.f;
#pragma unroll
        for (int k2 = 0; k2 < 16; ++k2) t += red[(k2 * 9 + v) * 32 + nn];
        t += p.ada_b[layer * 3072 + n0 + nn];
        if (layer == 0) ((float*)(p.ws + WS_MOD0))[v * 3072 + n0 + nn] = t;
        else if (v < 8) ((float*)(p.ws + WS_MOD1))[v * 3072 + n0 + nn] = t; }
    __syncthreads();
}

DEV void hid2_row(char* lds, const Params& p, int t, int wid, int lane) {
    float* sc = (float*)lds + wid * 128;
    const float tn = (float)t * (1.0f / 4095.0f);
    const float w = (float)(2.0 * 3.14159265358979323846 / 4096.0) * (float)t;
    float e = 0.f;
    if (lane == 0) e = tn;
    else if (lane <= 32) { const int k = (lane - 1) & 15; const float band = 1e-4f + (float)k * ((15.0f - 1e-4f) / 15.0f); const float ang = w * band; e = (lane <= 16) ? cosf(ang) : -sinf(ang); }
    sc[lane] = e;
    asm volatile("s_waitcnt lgkmcnt(0)" ::: "memory");
    float a = p.f_b1[lane];
    for (int i = 0; i < 33; ++i) a += sc[i] * p.f_w1[i * 64 + lane];
    const float fr = p.freq[lane];
    const float h1 = sinf(fr * a);
    sc[64 + lane] = h1;
    asm volatile("s_waitcnt lgkmcnt(0)" ::: "memory");
    float a2 = p.f_b2[lane];
    for (int i = 0; i < 64; ++i) a2 += sc[64 + i] * p.f_w2[i * 64 + lane];
    const float h2 = sinf(fr * a2);
    ((bf16_t*)(p.ws + WS_HID2))[t * 64 + lane] = f2bf(h2);
    asm volatile("s_waitcnt lgkmcnt(0)" ::: "memory");
}

DEV void phase_prep(char* lds, const Params& p) {
    const int tid = threadIdx.x, wid = tid >> 6, lane = tid & 63;
    { const int gt = blockIdx.x * 512 + tid;
        if (gt < 2048) ((float*)(p.ws + WS_SSUM))[gt] = 0.f;
        float* rp = (float*)(p.ws + WS_ROPE);
        if (gt < 1024) { const int pos = gt >> 4, i = gt & 15; const float inv = exp2f(-(float)i * (13.287712379549449f / 16.0f)); const float ang = (float)pos * inv; rp[gt] = cosf(ang); rp[1024 + gt] = sinf(ang); }
        if (gt < 512) { const int pos = gt >> 3, i = gt & 7; const float inv = exp2f(-(float)i * (13.287712379549449f / 8.0f)); const float ang = (float)pos * inv; rp[2048 + gt] = cosf(ang); rp[2560 + gt] = sinf(ang); } }
    for (int it = blockIdx.x; it < 192; it += gridDim.x) mod_item(lds, p, it);
    for (int t = blockIdx.x * 8 + wid; t < 4096; t += gridDim.x * 8) hid2_row(lds, p, t, wid, lane);
    __syncthreads();
    constexpr int I_WIN = 16 * 36, I_UQ = 4 * 12, I_UKV = 2 * 16, I_WO = 256, I_HIN = 16 * 64, I_HO = 256, I_W3 = 64;
    constexpr int NIT = I_WIN + I_UQ + I_UKV + I_WO + I_HIN + I_HO + I_W3;
    for (int it = blockIdx.x; it < NIT; it += gridDim.x) {
        int r = it;
        if (r < I_WIN) { transpose_item(lds, p.w_in, 1024, AIN, AINP, (bf16_t*)(p.ws + WS_WIN), r); continue; } r -= I_WIN;
        if (r < I_UQ) { transpose_item(lds, p.w_uq, 256, 768, 768, (bf16_t*)(p.ws + WS_WUQ), r); continue; } r -= I_UQ;
        if (r < I_UKV) { transpose_item(lds, p.w_ukv, 128, 1024, 1024, (bf16_t*)(p.ws + WS_WUKV), r); continue; } r -= I_UKV;
        if (r < I_WO) { transpose_item(lds, p.w_out, 1024, 1024, 1024, (bf16_t*)(p.ws + WS_WOUT), r); continue; } r -= I_WO;
        if (r < I_HIN) { transpose_item(lds, p.hy_w_in, 1024, 4096, 4096, (bf16_t*)(p.ws + WS_HWIN), r); continue; } r -= I_HIN;
        if (r < I_HO) { transpose_item(lds, p.hy_w_out, 1024, 1024, 1024, (bf16_t*)(p.ws + WS_HWOUT), r); continue; } r -= I_HO;
        transpose_item(lds, p.f_w3, 64, 4096, 4096, (bf16_t*)(p.ws + WS_W3), r);
    }
}

DEV float wave_sum(float v) {
#pragma unroll
    for (int o = 1; o < 64; o <<= 1) v += __shfl_xor(v, o);
    return v;
}
DEV void modnorm_row(const float* xr, const float* nw, const float* shift, const float* scale, bf16_t* orow, int lane) {
    f32x4 v[4]; float s = 0.f;
#pragma unroll
    for (int j = 0; j < 4; ++j) { v[j] = *(const f32x4*)(xr + lane * 4 + 256 * j); s += v[j].x * v[j].x + v[j].y * v[j].y + v[j].z * v[j].z + v[j].w * v[j].w; }
    const float r = rsqrtf(wave_sum(s) * (1.0f / DM) + EPS);
#pragma unroll
    for (int j = 0; j < 4; ++j) { const int c0 = lane * 4 + 256 * j;
        const f32x4 w = *(const f32x4*)(nw + c0), sh = *(const f32x4*)(shift + c0), sc = *(const f32x4*)(scale + c0);
        const float o0 = v[j].x * r * w.x * (1.f + sc.x) + sh.x, o1 = v[j].y * r * w.y * (1.f + sc.y) + sh.y, o2 = v[j].z * r * w.z * (1.f + sc.z) + sh.z, o3 = v[j].w * r * w.w * (1.f + sc.w) + sh.w;
        u32x2 pk; pk.x = pk2(o0, o1); pk.y = pk2(o2, o3); *(u32x2*)(orow + c0) = pk; }
}

DEV void phase_norm0(const Params& p) {
    const int wid = threadIdx.x >> 6, lane = threadIdx.x & 63; const float* mod0 = (const float*)(p.ws + WS_MOD0); bf16_t* H0 = (bf16_t*)(p.ws + WS_H0);
    for (int row = blockIdx.x * 8 + wid; row < NALL; row += gridDim.x * 8) {
        const float* xr; int v;
        if (row < NTOK) { xr = p.x + (size_t)row * DM; v = row >> 12; } else { xr = p.ctx + (size_t)(row - NTOK) * DM; v = 8; }
        modnorm_row(xr, p.norm_w, mod0 + v * 3072, mod0 + v * 3072 + 1024, H0 + (size_t)row * DM, lane);
    }
}
DEV void phase_norm1(const Params& p) {
    const int wid = threadIdx.x >> 6, lane = threadIdx.x & 63; const float* mod1 = (const float*)(p.ws + WS_MOD1); bf16_t* H1 = (bf16_t*)(p.ws + WS_H1);
    for (int row = blockIdx.x * 8 + wid; row < NTOK; row += gridDim.x * 8) { const int v = row >> 12;
        modnorm_row(p.out + (size_t)row * DM, p.norm_w + DM, mod1 + v * 3072, mod1 + v * 3072 + 1024, H1 + (size_t)row * DM, lane); }
}
DEV void phase_final(const Params& p) {
    const int wid = threadIdx.x >> 6, lane = threadIdx.x & 63;
    for (int row = blockIdx.x * 8 + wid; row < NTOK; row += gridDim.x * 8) {
        float* xr = p.out + (size_t)row * DM; f32x4 v[4]; float s = 0.f;
#pragma unroll
        for (int j = 0; j < 4; ++j) { v[j] = *(const f32x4*)(xr + lane * 4 + 256 * j); s += v[j].x * v[j].x + v[j].y * v[j].y + v[j].z * v[j].z + v[j].w * v[j].w; }
        const float r = rsqrtf(wave_sum(s) * (1.0f / DM) + EPS);
#pragma unroll
        for (int j = 0; j < 4; ++j) { const int c0 = lane * 4 + 256 * j; const f32x4 w = *(const f32x4*)(p.final_w + c0);
            f32x4 o; o.x = v[j].x * r * w.x; o.y = v[j].y * r * w.y; o.z = v[j].z * r * w.z; o.w = v[j].w * r * w.w; *(f32x4*)(xr + c0) = o; }
    }
}

DEV void phase_post(const Params& p) {
    const int wid = threadIdx.x >> 6, lane = threadIdx.x & 63;
    const bf16_t* PRAW = (const bf16_t*)(p.ws + WS_PRAW);
    bf16_t* QA = (bf16_t*)(p.ws + WS_QA); bf16_t* KA = (bf16_t*)(p.ws + WS_KA); bf16_t* VA = (bf16_t*)(p.ws + WS_VA);
    bf16_t* CQN = (bf16_t*)(p.ws + WS_CQN); bf16_t* CKVN = (bf16_t*)(p.ws + WS_CKVN); bf16_t* G = (bf16_t*)(p.ws + WS_G); bf16_t* KM = (bf16_t*)(p.ws + WS2_KM);
    const float* rp = (const float*)(p.ws + WS_ROPE); const float *cos64 = rp, *sin64 = rp + 1024, *cos32 = rp + 2048, *sin32 = rp + 2560;
    for (int tok = blockIdx.x * 8 + wid; tok < NALL; tok += gridDim.x * 8) {
        const bool lat = tok < NTOK; int b, pos, prow = 0, pcol = 0;
        if (lat) { b = tok >> 12; const int l = tok & 4095; pos = CTXL + l; prow = l >> 6; pcol = l & 63; } else { const int j = tok - NTOK; b = j >> 8; pos = j & 255; }
        const bf16_t* pr = PRAW + (size_t)tok * AINP; const size_t kvrow = (size_t)b * LK + pos;
        float v[8], o[8];
        if (lat) {
            unpack8(*(const u32x4*)(pr + lane * 8), v);
            float ss = 0.f;
#pragma unroll
            for (int j = 0; j < 8; ++j) ss += v[j] * v[j];
            ss += __shfl_xor(ss, 1); ss += __shfl_xor(ss, 2); ss += __shfl_xor(ss, 4);
            const float r = rsqrtf(ss * (1.0f / 64.0f) + EPS); const int k = lane & 7;
#pragma unroll
            for (int j = 0; j < 8; ++j) v[j] = v[j] * r * p.q_norm[k * 8 + j];
            const int posv = (k < 4) ? prow : pcol; const int fb = posv * 16 + (k & 1) * 8;
#pragma unroll
            for (int j = 0; j < 8; ++j) { const float ot = __shfl_xor(v[j], 2); const float cs = cos64[fb + j], sn = sin64[fb + j];
                o[j] = ((k & 2) ? (v[j] * cs + ot * sn) : (v[j] * cs - ot * sn)) * QSC_A; }
            *(u32x4*)(QA + (size_t)tok * 512 + lane * 8) = pack8(o);
        }
        {
            const u32x4 raw = *(const u32x4*)(pr + 512 + lane * 8); unpack8(raw, v);
            float ss = 0.f;
#pragma unroll
            for (int j = 0; j < 8; ++j) ss += v[j] * v[j];
            ss += __shfl_xor(ss, 1); ss += __shfl_xor(ss, 2); ss += __shfl_xor(ss, 4);
            const float s8 = ss;
            ss += __shfl_xor(ss, 8); ss += __shfl_xor(ss, 16);
            const float s32 = ss;
            float vn[8]; const int k = lane & 7;
            { const float r = rsqrtf(s8 * (1.0f / 64.0f) + EPS);
#pragma unroll
                for (int j = 0; j < 8; ++j) vn[j] = v[j] * r * p.k_norm[k * 8 + j]; }
            const int posv = (k < 4) ? prow : pcol; const int fb = posv * 16 + (k & 1) * 8;
#pragma unroll
            for (int j = 0; j < 8; ++j) { const float ot = __shfl_xor(vn[j], 2); const float cs = cos64[fb + j], sn = sin64[fb + j];
                o[j] = lat ? ((k & 2) ? (vn[j] * cs + ot * sn) : (vn[j] * cs - ot * sn)) : vn[j]; }
            if (lane < 16) *(u32x4*)(KA + kvrow * 128 + lane * 8) = pack8(o);
            else if (lane < 32) *(u32x4*)(VA + kvrow * 128 + (lane - 16) * 8) = raw;
            else if (lat) { const float r = rsqrtf(s32 * (1.0f / 256.0f) + EPS); const int cb = (lane - 32) * 8;
#pragma unroll
                for (int j = 0; j < 8; ++j) o[j] = v[j] * r * p.cq_norm[cb + j];
                *(u32x4*)(CQN + (size_t)tok * 256 + cb) = pack8(o); }
        }
        {
            unpack8(*(const u32x4*)(pr + 1024 + lane * 8), v);
            float ss = 0.f;
#pragma unroll
            for (int j = 0; j < 8; ++j) ss += v[j] * v[j];
            ss += __shfl_xor(ss, 1); ss += __shfl_xor(ss, 2); ss += __shfl_xor(ss, 4); ss += __shfl_xor(ss, 8);
            const int k = lane & 3; const int posv = (k < 2) ? prow : pcol;
            float oth[8];
#pragma unroll
            for (int j = 0; j < 8; ++j) oth[j] = __shfl_xor(v[j], 1);
            if (lane < 16) { const float r = rsqrtf(ss * (1.0f / 128.0f) + EPS);
#pragma unroll
                for (int j = 0; j < 8; ++j) o[j] = v[j] * r * p.ckv_norm[lane * 8 + j];
                *(u32x4*)(CKVN + kvrow * 128 + lane * 8) = pack8(o); }
            else if (lane < 20) {
#pragma unroll
                for (int j = 0; j < 8; ++j) { const float cs = cos32[posv * 8 + j], sn = sin32[posv * 8 + j];
                    o[j] = lat ? ((k & 1) ? (v[j] * cs + oth[j] * sn) : (v[j] * cs - oth[j] * sn)) : v[j]; }
                const u32x4 w = pack8(o);
#pragma unroll
                for (int h = 0; h < 8; ++h) *(u32x4*)(KM + kvrow * 768 + h * 96 + 64 + k * 8) = w; }
            else if (lat) {
#pragma unroll
                for (int j = 0; j < 8; ++j) o[j] = silu(v[j]);
                *(u32x4*)(G + (size_t)tok * 1024 + (lane - 20) * 8) = pack8(o); }
        }
        if (lat) {
            unpack8(*(const u32x4*)(pr + 1536 + lane * 8), v);
#pragma unroll
            for (int j = 0; j < 8; ++j) o[j] = silu(v[j]);
            *(u32x4*)(G + (size_t)tok * 1024 + 352 + lane * 8) = pack8(o);
            if (lane < 20) { unpack8(*(const u32x4*)(pr + 2048 + lane * 8), v);
#pragma unroll
                for (int j = 0; j < 8; ++j) o[j] = silu(v[j]);
                *(u32x4*)(G + (size_t)tok * 1024 + 864 + lane * 8) = pack8(o); }
        }
    }
}

template <int DQK>
DEV void attn_unit(char* lds, const bf16_t* __restrict__ Q, int ldq, int qcol, const bf16_t* __restrict__ Kp, int ldk, int kcol, const bf16_t* __restrict__ Vp, int ldv, int vcol,
                   const bf16_t* __restrict__ Gt, bf16_t* OG, int ocol, int b, int q0) {
    constexpr int KRS = (DQK + 8) * 2, KB = 64 * KRS, VRS = 192, VB = 64 * VRS, STG = KB + VB, NKS = DQK / 16, KCH = DQK / 8;
    const int tid = threadIdx.x, lane = tid & 63, wid = tid >> 6, l31 = lane & 31, hi = lane >> 5;
    bf16x8 qf[NKS];
    { const bf16_t* qp = Q + (size_t)(b * SEQ + q0 + wid * 32 + l31) * ldq + qcol + hi * 8;
#pragma unroll
        for (int ks = 0; ks < NKS; ++ks) qf[ks] = *(const bf16x8*)(qp + ks * 16); }
    const bf16_t* kbase = Kp + (size_t)b * LK * ldk + kcol; const bf16_t* vbase = Vp + (size_t)b * LK * ldv + vcol;
    const int kr0 = tid / KCH, kc0 = tid % KCH;
    const int kr1 = (tid + 512) / KCH, kc1 = (tid + 512) % KCH;
    const bool k2 = (KCH * 64 > 512) && (tid + 512 < KCH * 64);
    const int vr = tid >> 3, vc = tid & 7;
    u32x4 sk0, sk1, sv;
#define A_LOAD(t) do { const size_t kp_ = (size_t)(t) * 64; sk0 = *(const u32x4*)(kbase + (kp_ + kr0) * ldk + kc0 * 8); \
        if (k2) sk1 = *(const u32x4*)(kbase + (kp_ + kr1) * ldk + kc1 * 8); sv = *(const u32x4*)(vbase + (kp_ + vr) * ldv + vc * 8); } while (0)
#define A_STORE(buf) do { char* b_ = lds + (buf) * STG; *(u32x4*)(b_ + kr0 * KRS + kc0 * 16) = sk0; if (k2) *(u32x4*)(b_ + kr1 * KRS + kc1 * 16) = sk1; \
        *(u32x4*)(b_ + KB + vr * VRS + vc * 16) = sv; } while (0)
    f32x16 o0, o1;
#pragma unroll
    for (int r = 0; r < 16; ++r) { o0[r] = 0.f; o1[r] = 0.f; }
    float m_run = -1e30f, l_run = 0.f;
    const int g1 = (lane >> 4) & 1, tq = (lane & 15) >> 2, tp = lane & 3;
    const int vt_off = KB + (4 * hi + tq) * VRS + (16 * g1 + 4 * tp) * 2;
    const int kf_off = l31 * KRS + hi * 16;
    constexpr int NT = LK / 64;
    A_LOAD(0); A_STORE(0);
    __syncthreads();
    for (int t = 0; t < NT; ++t) {
        const bool more = (t + 1 < NT);
        if (more) A_LOAD(t + 1);
        const char* b_ = lds + (t & 1) * STG;
        f32x16 p0, p1;
#pragma unroll
        for (int r = 0; r < 16; ++r) { p0[r] = 0.f; p1[r] = 0.f; }
#pragma unroll
        for (int ks = 0; ks < NKS; ++ks) {
            const bf16x8 ka = *(const bf16x8*)(b_ + kf_off + ks * 32);
            const bf16x8 kb = *(const bf16x8*)(b_ + kf_off + 32 * KRS + ks * 32);
            p0 = __builtin_amdgcn_mfma_f32_32x32x16_bf16(ka, qf[ks], p0, 0, 0, 0);
            p1 = __builtin_amdgcn_mfma_f32_32x32x16_bf16(kb, qf[ks], p1, 0, 0, 0);
        }
        float mx = p0[0];
#pragma unroll
        for (int r = 1; r < 16; ++r) mx = fmaxf(mx, p0[r]);
#pragma unroll
        for (int r = 0; r < 16; ++r) mx = fmaxf(mx, p1[r]);
        mx = fmaxf(mx, __shfl_xor(mx, 32));
        const float m_new = fmaxf(m_run, mx);
        const float alpha = __builtin_amdgcn_exp2f(m_run - m_new);
        m_run = m_new;
        float ls = 0.f;
#pragma unroll
        for (int r = 0; r < 16; ++r) { p0[r] = __builtin_amdgcn_exp2f(p0[r] - m_new); p1[r] = __builtin_amdgcn_exp2f(p1[r] - m_new); ls += p0[r] + p1[r]; }
        l_run = l_run * alpha + ls;
#pragma unroll
        for (int r = 0; r < 16; ++r) { o0[r] *= alpha; o1[r] *= alpha; }
        u32x4 pw[4];
        pw[0] = (u32x4){pk2(p0[0], p0[1]), pk2(p0[2], p0[3]), pk2(p0[4], p0[5]), pk2(p0[6], p0[7])};
        pw[1] = (u32x4){pk2(p0[8], p0[9]), pk2(p0[10], p0[11]), pk2(p0[12], p0[13]), pk2(p0[14], p0[15])};
        pw[2] = (u32x4){pk2(p1[0], p1[1]), pk2(p1[2], p1[3]), pk2(p1[4], p1[5]), pk2(p1[6], p1[7])};
        pw[3] = (u32x4){pk2(p1[8], p1[9]), pk2(p1[10], p1[11]), pk2(p1[12], p1[13]), pk2(p1[14], p1[15])};
#pragma unroll
        for (int s = 0; s < 4; ++s) {
            const bf16x8 pb = __builtin_bit_cast(bf16x8, pw[s]);
#pragma unroll
            for (int dt = 0; dt < 2; ++dt) {
                const char* vp = b_ + vt_off + s * 16 * VRS + dt * 64;
                const s16x4 lo = __builtin_bit_cast(s16x4, __builtin_amdgcn_ds_read_tr16_b64_v4i16((LAS s16x4*)vp));
                const s16x4 hh = __builtin_bit_cast(s16x4, __builtin_amdgcn_ds_read_tr16_b64_v4i16((LAS s16x4*)(vp + 8 * VRS)));
                const bf16x8 vf = (bf16x8){lo[0], lo[1], lo[2], lo[3], hh[0], hh[1], hh[2], hh[3]};
                if (dt == 0) o0 = __builtin_amdgcn_mfma_f32_32x32x16_bf16(vf, pb, o0, 0, 0, 0);
                else o1 = __builtin_amdgcn_mfma_f32_32x32x16_bf16(vf, pb, o1, 0, 0, 0);
            }
        }
        if (more) A_STORE((t + 1) & 1);
        __syncthreads();
    }
#undef A_LOAD
#undef A_STORE
    const float lt = l_run + __shfl_xor(l_run, 32); const float inv = 1.0f / lt;
    const size_t tok = (size_t)(b * SEQ + q0 + wid * 32 + l31);
#pragma unroll
    for (int dt = 0; dt < 2; ++dt)
#pragma unroll
        for (int g = 0; g < 4; ++g) { const int d = 32 * dt + 8 * g + 4 * hi; const size_t off = tok * 1024 + ocol + d;
            const u32x2 gw = *(const u32x2*)(Gt + off);
            const f32x16& oo = dt ? o1 : o0;
            u32x2 w; w.x = pk2(oo[4 * g] * inv * lo_bf(gw.x), oo[4 * g + 1] * inv * hi_bf(gw.x)); w.y = pk2(oo[4 * g + 2] * inv * lo_bf(gw.y), oo[4 * g + 3] * inv * hi_bf(gw.y));
            *(u32x2*)(OG + off) = w; }
}

DEV void phase_attn(char* lds, const Params& p) {
    const bf16_t* QA = (const bf16_t*)(p.ws + WS_QA); const bf16_t* KA = (const bf16_t*)(p.ws + WS_KA); const bf16_t* VA = (const bf16_t*)(p.ws + WS_VA);
    const bf16_t* QM = (const bf16_t*)(p.ws + WS_QM); const bf16_t* KM = (const bf16_t*)(p.ws + WS2_KM); const bf16_t* VM = (const bf16_t*)(p.ws + WS2_VM);
    const bf16_t* G = (const bf16_t*)(p.ws + WS_G); bf16_t* OG = (bf16_t*)(p.ws + WS2_OG);
    for (int u = blockIdx.x; u < 2048; u += gridDim.x) {
        const int type = u >> 10, rem = u & 1023, b = rem >> 7, h = (rem >> 4) & 7, qb = rem & 15;
        if (type == 0) attn_unit<64>(lds, QA, 512, h * 64, KA, 128, (h >> 2) * 64, VA, 128, (h >> 2) * 64, G, OG, h * 64, b, qb * 256);
        else attn_unit<96>(lds, QM, 768, h * 96, KM, 768, h * 96, VM, 512, h * 64, G, OG, 512 + h * 64, b, qb * 256);
    }
}

constexpr int CV_PADL = 192, CV_ROW = 4488, CV_RS = CV_ROW * 2;
constexpr int CV_UB = 8 * CV_RS;
constexpr int CV_FS = 16448;
DEV void conv_load_filter(char* lds, const bf16_t* gr) {
    const int tid = threadIdx.x;
#pragma unroll
    for (int rnd = 0; rnd < 2; ++rnd) {
        const int ch = tid + rnd * 512;
        const u32x4 a = *(const u32x4*)(gr + ch * 8);
        u32x4 bq = {0u, 0u, 0u, 0u}; if (ch + 1 < 1024) bq = *(const u32x4*)(gr + ch * 8 + 8);
        const unsigned w[8] = {a.x, a.y, a.z, a.w, bq.x, bq.y, bq.z, bq.w};
        char* f = lds + CV_UB + ch * 16;
        *(u32x4*)(f) = a;
        u32x4 c1, c2, c3;
        c1.x = __builtin_amdgcn_alignbit(w[1], w[0], 16); c1.y = __builtin_amdgcn_alignbit(w[2], w[1], 16); c1.z = __builtin_amdgcn_alignbit(w[3], w[2], 16); c1.w = __builtin_amdgcn_alignbit(w[4], w[3], 16);
        c2 = (u32x4){w[1], w[2], w[3], w[4]};
        c3.x = __builtin_amdgcn_alignbit(w[2], w[1], 16); c3.y = __builtin_amdgcn_alignbit(w[3], w[2], 16); c3.z = __builtin_amdgcn_alignbit(w[4], w[3], 16); c3.w = __builtin_amdgcn_alignbit(w[5], w[4], 16);
        *(u32x4*)(f + CV_FS) = c1; *(u32x4*)(f + 2 * CV_FS) = c2; *(u32x4*)(f + 3 * CV_FS) = c3;
    }
}
DEV void sconv4(const bf16_t* px, int t, float w0, float w1, float w2, float bias, float* u) {
    const u32x2 mid = *(const u32x2*)(px + t);
    const float pm = (t > 0) ? bf2f(px[t - 1]) : 0.f, pp = (t + 4 < SEQ) ? bf2f(px[t + 4]) : 0.f;
    const float q0 = lo_bf(mid.x), q1 = hi_bf(mid.x), q2 = lo_bf(mid.y), q3 = hi_bf(mid.y);
    u[0] = w0 * pm + w1 * q0 + w2 * q1 + bias; u[1] = w0 * q0 + w1 * q1 + w2 * q2 + bias; u[2] = w0 * q1 + w1 * q2 + w2 * q3 + bias; u[3] = w0 * q2 + w1 * q3 + w2 * pp + bias;
}
DEV void conv_mfma_loop(const char* lds, f32x16 (&acc)[2][2], int wid, int lane) {
    const int l31 = lane & 31, hi = lane >> 5;
#pragma unroll
    for (int a = 0; a < 2; ++a)
#pragma unroll
        for (int b = 0; b < 2; ++b)
#pragma unroll
            for (int r = 0; r < 16; ++r) acc[a][b][r] = 0.f;
    int a_off[2];
#pragma unroll
    for (int mt = 0; mt < 2; ++mt) { const int r = l31 + 32 * mt, q = (4 - (r & 3)) & 3; a_off[mt] = CV_UB + q * CV_FS + (4096 - r - q + 8 * hi) * 2; }
    int b_off[2];
#pragma unroll
    for (int n = 0; n < 2; ++n) { const int nt = 2 * wid + n; b_off[n] = (l31 & 7) * CV_RS + (CV_PADL + 64 * (4 * nt + (l31 >> 3)) + 8 * hi) * 2; }
    const int dlo = 8 * wid - 63, dhi = 8 * wid + 7;
    for (int d = dlo; d <= dhi; ++d) {
        bf16x8 fa[2][4];
#pragma unroll
        for (int mt = 0; mt < 2; ++mt)
#pragma unroll
            for (int ks = 0; ks < 4; ++ks) { const char* ap = lds + a_off[mt] - 128 * d + ks * 32;
                const u32x2 lo = *(const u32x2*)ap, hh = *(const u32x2*)(ap + 8);
                fa[mt][ks] = __builtin_bit_cast(bf16x8, (u32x4){lo.x, lo.y, hh.x, hh.y}); }
#pragma unroll
        for (int n = 0; n < 2; ++n) {
            const int nt = 2 * wid + n;
            if (d >= 4 * nt - 63 && d <= 4 * nt + 3) {
#pragma unroll
                for (int ks = 0; ks < 4; ++ks) { const bf16x8 fb = *(const bf16x8*)(lds + b_off[n] - 128 * d + ks * 32);
#pragma unroll
                    for (int mt = 0; mt < 2; ++mt) acc[n][mt] = __builtin_amdgcn_mfma_f32_32x32x16_bf16(fa[mt][ks], fb, acc[n][mt], 0, 0, 0); }
            }
        }
    }
}
DEV void conv_unit(char* lds, const Params& p, int c) {
    const int tid = threadIdx.x, lane = tid & 63, wid = tid >> 6, l31 = lane & 31, hi = lane >> 5;
    const bf16_t* PT = (const bf16_t*)(p.ws + WS_PT); const bf16_t* GR = (const bf16_t*)(p.ws + WS_GR); const float* ssum = (const float*)(p.ws + WS_SSUM);
    bf16_t* OG2 = (bf16_t*)(p.ws + WS_OG2);
    for (int i = tid; i < 8 * 98; i += 512) { const int b = i / 98, j = i % 98;
        const int e = (j < 48) ? j * 4 : (CV_PADL + SEQ + (j - 48) * 4); *(u32x2*)(lds + b * CV_RS + e * 2) = (u32x2){0u, 0u}; }
    { const float w0 = p.conv_w[c], w1 = p.conv_w[3072 + c], w2 = p.conv_w[6144 + c], bias = p.conv_b[c];
        for (int i = tid; i < 8 * 1024; i += 512) { const int b = i >> 10, t = (i & 1023) * 4; float u[4];
            sconv4(PT + ((size_t)(b * 4096 + c)) * 4096, t, w0, w1, w2, bias, u);
            u32x2 w; w.x = pk2(u[0], u[1]); w.y = pk2(u[2], u[3]); *(u32x2*)(lds + b * CV_RS + (CV_PADL + t) * 2) = w; } }
    conv_load_filter(lds, GR + (size_t)c * 8192);
    __syncthreads();
    f32x16 acc[2][2];
    conv_mfma_loop(lds, acc, wid, lane);
    __syncthreads();
    { const float invs = 1.0f / ssum[c], sk = p.skip[c];
        const float w0 = p.conv_w[1024 + c], w1 = p.conv_w[3072 + 1024 + c], w2 = p.conv_w[6144 + 1024 + c], bias = p.conv_b[1024 + c];
        const int b = l31 & 7;
#pragma unroll
        for (int n = 0; n < 2; ++n) { const int i = 4 * (2 * wid + n) + (l31 >> 3);
#pragma unroll
            for (int mt = 0; mt < 2; ++mt)
#pragma unroll
                for (int g = 0; g < 4; ++g) { const int t = 64 * i + 32 * mt + 8 * g + 4 * hi; float x1[4];
                    sconv4(PT + ((size_t)(b * 4096 + 1024 + c)) * 4096, t, w0, w1, w2, bias, x1);
                    char* up = lds + b * CV_RS + (CV_PADL + t) * 2; const u32x2 vw = *(const u32x2*)up;
                    const float z0 = x1[0] * (acc[n][mt][4 * g] * invs + sk * lo_bf(vw.x)), z1 = x1[1] * (acc[n][mt][4 * g + 1] * invs + sk * hi_bf(vw.x));
                    const float z2 = x1[2] * (acc[n][mt][4 * g + 2] * invs + sk * lo_bf(vw.y)), z3 = x1[3] * (acc[n][mt][4 * g + 3] * invs + sk * hi_bf(vw.y));
                    u32x2 w; w.x = pk2(z0, z1); w.y = pk2(z2, z3); *(u32x2*)up = w; } } }
    conv_load_filter(lds, GR + (size_t)(1024 + c) * 8192);
    __syncthreads();
    conv_mfma_loop(lds, acc, wid, lane);
    { const float invs = 1.0f / ssum[1024 + c], sk = p.skip[1024 + c];
        const float w0 = p.conv_w[2048 + c], w1 = p.conv_w[3072 + 2048 + c], w2 = p.conv_w[6144 + 2048 + c], bias = p.conv_b[2048 + c];
        const int b = l31 & 7;
#pragma unroll
        for (int n = 0; n < 2; ++n) { const int i = 4 * (2 * wid + n) + (l31 >> 3);
#pragma unroll
            for (int mt = 0; mt < 2; ++mt)
#pragma unroll
                for (int g = 0; g < 4; ++g) { const int t = 64 * i + 32 * mt + 8 * g + 4 * hi; float x2[4];
                    sconv4(PT + ((size_t)(b * 4096 + 2048 + c)) * 4096, t, w0, w1, w2, bias, x2);
                    const u32x2 zw = *(const u32x2*)(lds + b * CV_RS + (CV_PADL + t) * 2);
                    const u32x2 gw = *(const u32x2*)(PT + ((size_t)(b * 4096 + 3072 + c)) * 4096 + t);
                    const float y0 = x2[0] * (acc[n][mt][4 * g] * invs + sk * lo_bf(zw.x)) * silu(lo_bf(gw.x)), y1 = x2[1] * (acc[n][mt][4 * g + 1] * invs + sk * hi_bf(zw.x)) * silu(hi_bf(gw.x));
                    const float y2 = x2[2] * (acc[n][mt][4 * g + 2] * invs + sk * lo_bf(zw.y)) * silu(lo_bf(gw.y)), y3 = x2[3] * (acc[n][mt][4 * g + 3] * invs + sk * hi_bf(zw.y)) * silu(hi_bf(gw.y));
                    u32x2 w; w.x = pk2(y0, y1); w.y = pk2(y2, y3); *(u32x2*)(OG2 + ((size_t)(b * 1024 + c)) * 4096 + t) = w; } } }
    __syncthreads();
}

constexpr int NPHASE = 12;
__global__ void __launch_bounds__(512) fwd_kernel(Params p) {
    extern __shared__ __attribute__((aligned(16))) char lds[];
    char* ws = p.ws;
#define SEAM(k) do { if (MK_LAUNCHES == 1 && (k) + 1 < p.ph_hi) { cg::this_grid().sync(); } } while (0)
#define IN(k) (p.ph_lo <= (k) && (k) < p.ph_hi)
    if (IN(0)) { phase_prep(lds, p); SEAM(0); }
    if (IN(1)) {
        EpiFilt ef{(bf16_t*)(ws + WS_GR), (float*)(ws + WS_SSUM), p.f_b3};
        gemm_phase<false, EpiFilt>(lds, (const bf16_t*)(ws + WS_W3), 64, (const bf16_t*)(ws + WS_HID2), 64, 4096, 4096, 64, ef);
        phase_norm0(p); SEAM(1); }
    if (IN(2)) {
        EpiRaw e{(bf16_t*)(ws + WS_PRAW), (size_t)AINP};
        gemm_phase<false, EpiRaw>(lds, (const bf16_t*)(ws + WS_H0), DM, (const bf16_t*)(ws + WS_WIN), DM, NALL, AINP, DM, e); SEAM(2); }
    if (IN(3)) { phase_post(p); SEAM(3); }
    if (IN(4)) {
        const float* rp = (const float*)(ws + WS_ROPE);
        EpiUq eq{(bf16_t*)(ws + WS_QM), rp + 2048, rp + 2560};
        gemm_phase<false, EpiUq>(lds, (const bf16_t*)(ws + WS_CQN), 256, (const bf16_t*)(ws + WS_WUQ), 256, NTOK, 768, 256, eq);
        EpiUkv ek{(bf16_t*)(ws + WS2_KM), (bf16_t*)(ws + WS2_VM)};
        gemm_phase<false, EpiUkv>(lds, (const bf16_t*)(ws + WS_CKVN), 128, (const bf16_t*)(ws + WS_WUKV), 128, NALL, 1024, 128, ek); SEAM(4); }
    if (IN(5)) { phase_attn(lds, p); SEAM(5); }
    if (IN(6)) {
        EpiRes e{p.x, p.out, (const float*)(ws + WS_MOD0)};
        gemm_phase<false, EpiRes>(lds, (const bf16_t*)(ws + WS2_OG), DM, (const bf16_t*)(ws + WS_WOUT), DM, NTOK, DM, DM, e); SEAM(6); }
    if (IN(7)) { phase_norm1(p); SEAM(7); }
    if (IN(8)) {
        EpiPT e{(bf16_t*)(ws + WS_PT)};
        gemm_phase<false, EpiPT>(lds, (const bf16_t*)(ws + WS_HWIN), DM, (const bf16_t*)(ws + WS_H1), DM, 4096, NTOK, DM, e); SEAM(8); }
    if (IN(9)) { for (int c = blockIdx.x; c < 1024; c += gridDim.x) conv_unit(lds, p, c); SEAM(9); }
    if (IN(10)) {
        EpiRes e{p.out, p.out, (const float*)(ws + WS_MOD1)};
        const bf16_t* OG2 = (const bf16_t*)(ws + WS_OG2); const bf16_t* W = (const bf16_t*)(ws + WS_HWOUT);
        const int nt = (NTOK / 256) * (DM / 128);
        for (int t = blockIdx.x; t < nt; t += gridDim.x) { const int ti = t / 8, tj = t % 8; const int b = ti >> 4, l0 = (ti & 15) * 256;
            gemm_tile<true, EpiRes>(lds, OG2 + (size_t)b * 1024 * 4096 + l0, 4096, W + (size_t)tj * 128 * DM, DM, DM, e, ti * 256, tj * 128); }
        SEAM(10); }
    if (IN(11)) { phase_final(p); }
#undef SEAM
#undef IN
}

extern "C" void kernel_launch(void* const* d_in, const int* in_sizes, int n_in, void* d_out, int out_size, void* d_ws, size_t ws_size, hipStream_t stream) {
    static int grid = 0;
    if (grid == 0) {
        if (n_in != 28 || out_size != NTOK * DM || ws_size < WS_END) { fprintf(stderr, "kernel_launch: unexpected shapes n_in %d out %d ws %zu\n", n_in, out_size, ws_size); grid = -1; return; }
        int dev = 0, cus = 0, per_cu = 0;
        hipGetDevice(&dev); hipDeviceGetAttribute(&cus, hipDeviceAttributeMultiprocessorCount, dev);
        if (hipFuncSetAttribute((const void*)fwd_kernel, hipFuncAttributeMaxDynamicSharedMemorySize, LDS_BYTES) != hipSuccess) { fprintf(stderr, "hipFuncSetAttribute failed\n"); grid = -1; return; }
        hipOccupancyMaxActiveBlocksPerMultiprocessor(&per_cu, (const void*)fwd_kernel, 512, LDS_BYTES);
        if (per_cu < 1) { fprintf(stderr, "occupancy query says %d\n", per_cu); per_cu = 1; }
        grid = cus * 1;
        (void)hipGetLastError();
    }
    if (grid < 0) return;
    Params p{};
    const float** pp = (const float**)&p;
    for (int i = 0; i < 28; ++i) pp[i] = (const float*)d_in[i];
    p.out = (float*)d_out; p.ws = (char*)d_ws;
#if MK_LAUNCHES == 1
    p.ph_lo = 0; p.ph_hi = NPHASE;
    void* args[] = {&p};
    hipError_t e = hipLaunchCooperativeKernel((const void*)fwd_kernel, dim3(grid), dim3(512), args, LDS_BYTES, stream);
    if (e != hipSuccess) fprintf(stderr, "cooperative launch failed: %s (grid %d)\n", hipGetErrorString(e), grid);
#else
    for (int k = 0; k < NPHASE; ++k) { p.ph_lo = k; p.ph_hi = k + 1; hipLaunchKernelGGL(fwd_kernel, dim3(grid), dim3(512), LDS_BYTES, stream, p); }
#endif
}
```

```cpp
#include <hip/hip_runtime.h>
#include <hip/hip_cooperative_groups.h>
#include <cstdio>
#include <cstdint>
namespace cg = cooperative_groups;

#ifndef MK_LAUNCHES
#define MK_LAUNCHES 1
#endif

#ifndef DBG_SKIP
#define DBG_SKIP 0
#endif
#define DEV __device__ __forceinline__
typedef unsigned short bf16_t;
typedef short bf16x8 __attribute__((ext_vector_type(8)));
typedef short s16x4 __attribute__((ext_vector_type(4)));
typedef float f32x16 __attribute__((ext_vector_type(16)));
typedef float f32x4 __attribute__((ext_vector_type(4)));
typedef float f32x2 __attribute__((ext_vector_type(2)));
typedef unsigned u32x4 __attribute__((ext_vector_type(4)));
typedef unsigned u32x2 __attribute__((ext_vector_type(2)));
typedef __bf16 bf16x2_t __attribute__((ext_vector_type(2)));
#define LAS __attribute__((address_space(3)))

constexpr int NB = 8, SEQ = 4096, DM = 1024, CTXL = 256, LK = SEQ + CTXL;
constexpr int NTOK = NB * SEQ, NCTX = NB * CTXL, NALL = NTOK + NCTX;
constexpr int AIN = 2208, AINP = 2304;
constexpr float EPS = 1e-6f;
constexpr float LOG2E = 1.4426950408889634f;
constexpr float QSC_A = 0.125f * LOG2E;
constexpr float QSC_M = 0.10206207261596575f * LOG2E;

constexpr size_t MiB = 1ull << 20;
constexpr size_t WS_WIN = 0;
constexpr size_t WS_WUQ = 5 * MiB;
constexpr size_t WS_WUKV = 6 * MiB;
constexpr size_t WS_WOUT = 7 * MiB;
constexpr size_t WS_HWIN = 9 * MiB;
constexpr size_t WS_HWOUT = 17 * MiB;
constexpr size_t WS_W3 = 19 * MiB;
constexpr size_t WS_HID2 = 20 * MiB;
constexpr size_t WS_MOD0 = 21 * MiB;
constexpr size_t WS_MOD1 = WS_MOD0 + 9 * 3072 * 4;
constexpr size_t WS_SSUM = WS_MOD1 + 8 * 3072 * 4;
constexpr size_t WS_ROPE = WS_SSUM + 2048 * 4;
constexpr size_t WS_GR = 22 * MiB;
constexpr size_t WS_H0 = 64 * MiB;
constexpr size_t WS_PRAW = 136 * MiB;
constexpr size_t WS_QA = 297 * MiB;
constexpr size_t WS_KA = 329 * MiB;
constexpr size_t WS_VA = 338 * MiB;
constexpr size_t WS_CQN = 347 * MiB;
constexpr size_t WS_CKVN = 363 * MiB;
constexpr size_t WS_G = 372 * MiB;
constexpr size_t WS_QM = 64 * MiB;
constexpr size_t WS_KM = 136 * MiB;
constexpr size_t WS_VM = 190 * MiB;
constexpr size_t WS_OG = 226 * MiB;
constexpr size_t WS_H1 = 436 * MiB;
constexpr size_t WS_PT = 64 * MiB;
constexpr size_t WS_OG2 = 320 * MiB;
constexpr size_t WS_END = 500 * MiB;
constexpr size_t WS2_KM = 436 * MiB;
constexpr size_t WS2_VM = 190 * MiB;
constexpr size_t WS2_OG = 226 * MiB;

constexpr int LDS_BYTES = 150 * 1024;

DEV float bf2f(bf16_t v) { return __uint_as_float(((unsigned)v) << 16); }
DEV unsigned pk2(float lo, float hi) { f32x2 v = {lo, hi}; bf16x2_t b = __builtin_convertvector(v, bf16x2_t); return __builtin_bit_cast(unsigned, b); }
DEV bf16_t f2bf(float f) { return (bf16_t)(pk2(f, 0.f) & 0xffffu); }
DEV float lo_bf(unsigned w) { return __uint_as_float(w << 16); }
DEV float hi_bf(unsigned w) { return __uint_as_float(w & 0xffff0000u); }
DEV int crow(int r, int hi) { return (r & 3) + 8 * (r >> 2) + 4 * hi; }
DEV float silu(float v) { return v / (1.f + __expf(-v)); }
DEV void unpack8(const u32x4 w, float* v) { v[0] = lo_bf(w.x); v[1] = hi_bf(w.x); v[2] = lo_bf(w.y); v[3] = hi_bf(w.y); v[4] = lo_bf(w.z); v[5] = hi_bf(w.z); v[6] = lo_bf(w.w); v[7] = hi_bf(w.w); }
DEV u32x4 pack8(const float* v) { u32x4 w; w.x = pk2(v[0], v[1]); w.y = pk2(v[2], v[3]); w.z = pk2(v[4], v[5]); w.w = pk2(v[6], v[7]); return w; }

struct Params {
    const float *x, *c, *ctx, *c_ctx, *ada_w, *ada_b, *norm_w, *w_in, *q_norm, *k_norm, *cq_norm, *ckv_norm, *w_uq, *w_ukv, *w_out,
        *hy_w_in, *conv_w, *conv_b, *f_w1, *f_b1, *f_w2, *f_b2, *f_w3, *f_b3, *freq, *skip, *hy_w_out, *final_w;
    float* out; char* ws; int ph_lo, ph_hi;
};

constexpr int G_RS = 144;
constexpr int G_RB = 256 * G_RS, G_CB = 128 * G_RS, G_STAGE = G_RB + G_CB;
constexpr int T_RS = 576;

template <bool TR, class Epi>
DEV void gemm_tile(char* lds, const bf16_t* __restrict__ R, size_t ldr, const bf16_t* __restrict__ C, size_t ldc, int K, const Epi& epi, int ti0, int tj0) {
    const int tid = threadIdx.x, lane = tid & 63, wid = tid >> 6;
    const int wi = wid >> 1, wj = wid & 1, l31 = lane & 31, hi = lane >> 5;
    f32x16 acc[2][2];
#pragma unroll
    for (int a = 0; a < 2; ++a)
#pragma unroll
        for (int b = 0; b < 2; ++b)
#pragma unroll
            for (int r = 0; r < 16; ++r) acc[a][b][r] = 0.f;
    u32x4 rr[4], rc[2];
    const bf16_t* Rp; const bf16_t* Cp; int rl_off, cl_off;
    if (TR) { const int c = tid & 31, kr = tid >> 5; Rp = R + (size_t)kr * ldr + c * 8; rl_off = kr * T_RS + c * 16; }
    else { const int lr = tid >> 3, lc = tid & 7; Rp = R + (size_t)lr * ldr + lc * 8; rl_off = lr * G_RS + lc * 16; }
    { const int lr = tid >> 3, lc = tid & 7; Cp = C + (size_t)lr * ldc + lc * 8; cl_off = lr * G_RS + lc * 16; }
    const int nk = K / 64;
    int ra_off[2], cb_off[2];
#pragma unroll
    for (int t = 0; t < 2; ++t) {
        if (TR) { const int g1 = (lane >> 4) & 1, q = (lane & 15) >> 2, p = lane & 3; ra_off[t] = (8 * hi + q) * T_RS + (wi * 64 + t * 32 + 16 * g1 + 4 * p) * 2; }
        else ra_off[t] = (wi * 64 + t * 32 + l31) * G_RS + hi * 16;
        cb_off[t] = G_RB + (wj * 64 + t * 32 + l31) * G_RS + hi * 16;
    }
#define G_LOAD(kt) do { \
        if (TR) { _Pragma("unroll") for (int p = 0; p < 4; ++p) rr[p] = *(const u32x4*)(Rp + ((size_t)(kt) * 64 + 16 * p) * ldr); } \
        else { _Pragma("unroll") for (int p = 0; p < 4; ++p) rr[p] = *(const u32x4*)(Rp + (size_t)(64 * p) * ldr + (kt) * 64); } \
        _Pragma("unroll") for (int p = 0; p < 2; ++p) rc[p] = *(const u32x4*)(Cp + (size_t)(64 * p) * ldc + (kt) * 64); } while (0)
#define G_STORE(buf) do { char* b_ = lds + (buf) * G_STAGE; \
        if (TR) { _Pragma("unroll") for (int p = 0; p < 4; ++p) *(u32x4*)(b_ + rl_off + 16 * p * T_RS) = rr[p]; } \
        else { _Pragma("unroll") for (int p = 0; p < 4; ++p) *(u32x4*)(b_ + rl_off + 64 * p * G_RS) = rr[p]; } \
        _Pragma("unroll") for (int p = 0; p < 2; ++p) *(u32x4*)(b_ + G_RB + cl_off + 64 * p * G_RS) = rc[p]; } while (0)
    G_LOAD(0); G_STORE(0);
    __syncthreads();
    for (int kt = 0; kt < nk; ++kt) {
        const bool more = (kt + 1 < nk);
        if (more) G_LOAD(kt + 1);
        const char* b_ = lds + (kt & 1) * G_STAGE;
#pragma unroll
        for (int ks = 0; ks < 4; ++ks) {
            bf16x8 fa[2], fb[2];
#pragma unroll
            for (int t = 0; t < 2; ++t) {
                if (TR) {
                    const s16x4 lo = __builtin_bit_cast(s16x4, __builtin_amdgcn_ds_read_tr16_b64_v4i16((LAS s16x4*)(b_ + ra_off[t] + ks * 16 * T_RS)));
                    const s16x4 hh = __builtin_bit_cast(s16x4, __builtin_amdgcn_ds_read_tr16_b64_v4i16((LAS s16x4*)(b_ + ra_off[t] + (ks * 16 + 4) * T_RS)));
                    fa[t] = (bf16x8){lo[0], lo[1], lo[2], lo[3], hh[0], hh[1], hh[2], hh[3]};
                } else fa[t] = *(const bf16x8*)(b_ + ra_off[t] + ks * 32);
                fb[t] = *(const bf16x8*)(b_ + cb_off[t] + ks * 32);
            }
#pragma unroll
            for (int a = 0; a < 2; ++a)
#pragma unroll
                for (int b = 0; b < 2; ++b) acc[a][b] = __builtin_amdgcn_mfma_f32_32x32x16_bf16(fa[a], fb[b], acc[a][b], 0, 0, 0);
        }
        if (more) G_STORE((kt + 1) & 1);
        __syncthreads();
    }
#undef G_LOAD
#undef G_STORE
#pragma unroll
    for (int a = 0; a < 2; ++a)
#pragma unroll
        for (int b = 0; b < 2; ++b) epi(ti0 + wi * 64 + a * 32, tj0 + wj * 64 + b * 32, acc[a][b], l31, hi);
}

template <bool TR, class Epi>
DEV void gemm_phase(char* lds, const bf16_t* R, size_t ldr, const bf16_t* C, size_t ldc, int nI, int nJ, int K, const Epi& epi) {
    const int tI = nI / 256, tJ = nJ / 128, nt = tI * tJ;
    for (int t = blockIdx.x; t < nt; t += gridDim.x) {
        const int ti = t / tJ, tj = t % tJ;
        gemm_tile<TR, Epi>(lds, R + (size_t)ti * 256 * ldr, ldr, C + (size_t)tj * 128 * ldc, ldc, K, epi, ti * 256, tj * 128);
    }
}

struct EpiRaw {
    bf16_t* O; size_t ld;
    DEV void operator()(int i0, int j0, const f32x16& a, int l31, int hi) const {
#pragma unroll
        for (int r = 0; r < 16; ++r) O[(size_t)(i0 + crow(r, hi)) * ld + j0 + l31] = f2bf(a[r]);
    }
};
struct EpiUq {
    bf16_t* QM; const float* cos32; const float* sin32;
    DEV void operator()(int i0, int j0, const f32x16& a, int l31, int hi) const {
        const bool pe = (j0 % 96) == 64;
        const int fi = l31 & 7; const bool colang = (l31 & 16) != 0; const bool bpart = (l31 & 8) != 0;
#pragma unroll
        for (int r = 0; r < 16; ++r) {
            const int tok = i0 + crow(r, hi); float v = a[r];
            const float o = __shfl_xor(v, 8);
            if (pe) { const int l = tok & (SEQ - 1); const int pos = colang ? (l & 63) : (l >> 6);
                const float cs = cos32[pos * 8 + fi], sn = sin32[pos * 8 + fi];
                v = bpart ? (v * cs + o * sn) : (v * cs - o * sn); }
            QM[(size_t)tok * 768 + j0 + l31] = f2bf(v * QSC_M);
        }
    }
};
struct EpiUkv {
    bf16_t* KM; bf16_t* VM;
    DEV void operator()(int i0, int j0, const f32x16& a, int l31, int hi) const {
        const int h = j0 >> 7, e = (j0 & 127) + l31;
#pragma unroll
        for (int r = 0; r < 16; ++r) { const size_t row = (size_t)(i0 + crow(r, hi));
            if (e < 64) KM[row * 768 + h * 96 + e] = f2bf(a[r]); else VM[row * 512 + h * 64 + (e - 64)] = f2bf(a[r]); }
    }
};
struct EpiRes {
    const float* base; float* out; const float* mod; float gmul;
    DEV void operator()(int i0, int j0, const f32x16& a, int l31, int hi) const {
        const int b = i0 >> 12; const float g = mod[b * 3072 + 2048 + j0 + l31] * gmul;
#pragma unroll
        for (int r = 0; r < 16; ++r) { const size_t o = (size_t)(i0 + crow(r, hi)) * DM + j0 + l31; out[o] = base[o] + g * a[r]; }
    }
};
struct EpiPT {
    bf16_t* PT;
    DEV void operator()(int i0, int j0, const f32x16& a, int l31, int hi) const {
        const int b = j0 >> 12, l = (j0 & 4095) + l31;
#pragma unroll
        for (int r = 0; r < 16; ++r) PT[((size_t)(b * 4096 + i0 + crow(r, hi))) * 4096 + l] = f2bf(a[r]);
    }
};
struct EpiFilt {
    bf16_t* GR; float* ssum; const float* b3;
    DEV void operator()(int i0, int j0, const f32x16& a, int l31, int hi) const {
        const int t = j0 + l31; const float tn = (float)t * (1.0f / 4095.0f);
        const float dmin = -3.0701134573253945f, dmax = -15.350567286626973f;
#pragma unroll
        for (int r = 0; r < 16; ++r) {
            const int n = i0 + crow(r, hi); const int c = n & 1023, od = n >> 10, o = od >> 1, dir = od & 1;
            const float delta = fabsf(dmin + (float)c * ((dmax - dmin) / 1023.0f));
            float v = (a[r] + b3[n]) * __expf(-tn * delta);
            bf16_t* g = GR + ((size_t)(o * 1024 + c)) * 8192;
            if (dir == 0) g[4096 - t] = f2bf(v);
            else { if (t == 0) { g[0] = 0; v = 0.f; } else g[4096 + t] = f2bf(v); }
            float s = fabsf(v);
            s += __shfl_xor(s, 16); s += __shfl_xor(s, 8); s += __shfl_xor(s, 4); s += __shfl_xor(s, 2); s += __shfl_xor(s, 1);
            if (l31 == 0) atomicAdd(ssum + o * 1024 + c, s);
        }
    }
};

DEV void transpose_item(char* lds, const float* W, int K, int N, int Npad, bf16_t* WT, int item) {
    float* tile = (float*)lds;
    const int nb = Npad / 64, kb = item / nb, nbi = item % nb, k0 = kb * 64, n0 = nbi * 64;
    const int tid = threadIdx.x;
    { const int kk = tid >> 4, n4 = (tid & 15) * 4;
#pragma unroll
        for (int p = 0; p < 2; ++p) { f32x4 v = {0.f, 0.f, 0.f, 0.f}; if (n0 + n4 < N) v = *(const f32x4*)(W + (size_t)(k0 + kk + 32 * p) * N + n0 + n4);
            float* d = tile + (kk + 32 * p) * 65 + n4; d[0] = v.x; d[1] = v.y; d[2] = v.z; d[3] = v.w; } }
    __syncthreads();
    { const int n = tid >> 3, kc = tid & 7; float v[8];
#pragma unroll
        for (int j = 0; j < 8; ++j) v[j] = tile[(kc * 8 + j) * 65 + n];
        *(u32x4*)(WT + (size_t)(n0 + n) * K + k0 + kc * 8) = pack8(v); }
    __syncthreads();
}

DEV void mod_item(char* lds, const Params& p, int item) {
    const int layer = item / 96, n0 = (item % 96) * 32, tid = threadIdx.x;
    float* s = (float*)lds;
    float* red = s + 9 * 1024;
    for (int i = tid; i < 9 * 1024; i += 512) { const int v = i >> 10, k = i & 1023; const float cv = (v < 8) ? p.c[v * 1024 + k] : p.c_ctx[k]; s[i] = silu(cv); }
    __syncthreads();
    const int kc = tid >> 5, n = tid & 31; const float* W = p.ada_w + (size_t)layer * DM * 3072 + n0 + n;
    float acc[9];
#pragma unroll
    for (int v = 0; v < 9; ++v) acc[v] = 0.f;
#pragma unroll 8
    for (int kk = 0; kk < 64; ++kk) { const int k = kc * 64 + kk; const float w = W[(size_t)k * 3072];
#pragma unroll
        for (int v = 0; v < 9; ++v) acc[v] += s[v * 1024 + k] * w; }
#pragma unroll
    for (int v = 0; v < 9; ++v) red[(kc * 9 + v) * 32 + n] = acc[v];
    __syncthreads();
    if (tid < 9 * 32) { const int v = tid >> 5, nn = tid & 31; float t = 0.f;
#pragma unroll
        for (int k2 = 0; k2 < 16; ++k2) t += red[(k2 * 9 + v) * 32 + nn];
        t += p.ada_b[layer * 3072 + n0 + nn];
        if (layer == 0) ((float*)(p.ws + WS_MOD0))[v * 3072 + n0 + nn] = t;
        else if (v < 8) ((float*)(p.ws + WS_MOD1))[v * 3072 + n0 + nn] = t; }
    __syncthreads();
}

DEV void hid2_row(char* lds, const Params& p, int t, int wid, int lane) {
    float* sc = (float*)lds + wid * 128;
    const float tn = (float)t * (1.0f / 4095.0f);
    const float w = (float)(2.0 * 3.14159265358979323846 / 4096.0) * (float)t;
    float e = 0.f;
    if (lane == 0) e = tn;
    else if (lane <= 32) { const int k = (lane - 1) & 15; const float band = 1e-4f + (float)k * ((15.0f - 1e-4f) / 15.0f); const float ang = w * band; e = (lane <= 16) ? cosf(ang) : -sinf(ang); }
    sc[lane] = e;
    asm volatile("s_waitcnt lgkmcnt(0)" ::: "memory");
    float a = p.f_b1[lane];
    for (int i = 0; i < 33; ++i) a += sc[i] * p.f_w1[i * 64 + lane];
    const float fr = p.freq[lane];
    const float h1 = sinf(fr * a);
    sc[64 + lane] = h1;
    asm volatile("s_waitcnt lgkmcnt(0)" ::: "memory");
    float a2 = p.f_b2[lane];
    for (int i = 0; i < 64; ++i) a2 += sc[64 + i] * p.f_w2[i * 64 + lane];
    const float h2 = sinf(fr * a2);
    ((bf16_t*)(p.ws + WS_HID2))[t * 64 + lane] = f2bf(h2);
    asm volatile("s_waitcnt lgkmcnt(0)" ::: "memory");
}

DEV void phase_prep(char* lds, const Params& p) {
    const int tid = threadIdx.x, wid = tid >> 6, lane = tid & 63;
    { const int gt = blockIdx.x * 512 + tid;
        if (gt < 2048) ((float*)(p.ws + WS_SSUM))[gt] = 0.f;
        float* rp = (float*)(p.ws + WS_ROPE);
        if (gt < 1024) { const int pos = gt >> 4, i = gt & 15; const float inv = exp2f(-(float)i * (13.287712379549449f / 16.0f)); const float ang = (float)pos * inv; rp[gt] = cosf(ang); rp[1024 + gt] = sinf(ang); }
        if (gt < 512) { const int pos = gt >> 3, i = gt & 7; const float inv = exp2f(-(float)i * (13.287712379549449f / 8.0f)); const float ang = (float)pos * inv; rp[2048 + gt] = cosf(ang); rp[2560 + gt] = sinf(ang); } }
    for (int it = blockIdx.x; it < 192; it += gridDim.x) mod_item(lds, p, it);
    for (int t = blockIdx.x * 8 + wid; t < 4096; t += gridDim.x * 8) hid2_row(lds, p, t, wid, lane);
    __syncthreads();
    constexpr int I_WIN = 16 * 36, I_UQ = 4 * 12, I_UKV = 2 * 16, I_WO = 256, I_HIN = 16 * 64, I_HO = 256, I_W3 = 64;
    constexpr int NIT = I_WIN + I_UQ + I_UKV + I_WO + I_HIN + I_HO + I_W3;
    for (int it = blockIdx.x; it < NIT; it += gridDim.x) {
        int r = it;
        if (r < I_WIN) { transpose_item(lds, p.w_in, 1024, AIN, AINP, (bf16_t*)(p.ws + WS_WIN), r); continue; } r -= I_WIN;
        if (r < I_UQ) { transpose_item(lds, p.w_uq, 256, 768, 768, (bf16_t*)(p.ws + WS_WUQ), r); continue; } r -= I_UQ;
        if (r < I_UKV) { transpose_item(lds, p.w_ukv, 128, 1024, 1024, (bf16_t*)(p.ws + WS_WUKV), r); continue; } r -= I_UKV;
        if (r < I_WO) { transpose_item(lds, p.w_out, 1024, 1024, 1024, (bf16_t*)(p.ws + WS_WOUT), r); continue; } r -= I_WO;
        if (r < I_HIN) { transpose_item(lds, p.hy_w_in, 1024, 4096, 4096, (bf16_t*)(p.ws + WS_HWIN), r); continue; } r -= I_HIN;
        if (r < I_HO) { transpose_item(lds, p.hy_w_out, 1024, 1024, 1024, (bf16_t*)(p.ws + WS_HWOUT), r); continue; } r -= I_HO;
        transpose_item(lds, p.f_w3, 64, 4096, 4096, (bf16_t*)(p.ws + WS_W3), r);
    }
}

DEV float wave_sum(float v) {
#pragma unroll
    for (int o = 1; o < 64; o <<= 1) v += __shfl_xor(v, o);
    return v;
}
DEV void modnorm_row(const float* xr, const float* nw, const float* shift, const float* scale, bf16_t* orow, int lane) {
    f32x4 v[4]; float s = 0.f;
#pragma unroll
    for (int j = 0; j < 4; ++j) { v[j] = *(const f32x4*)(xr + lane * 4 + 256 * j); s += v[j].x * v[j].x + v[j].y * v[j].y + v[j].z * v[j].z + v[j].w * v[j].w; }
    const float r = rsqrtf(wave_sum(s) * (1.0f / DM) + EPS);
#pragma unroll
    for (int j = 0; j < 4; ++j) { const int c0 = lane * 4 + 256 * j;
        const f32x4 w = *(const f32x4*)(nw + c0), sh = *(const f32x4*)(shift + c0), sc = *(const f32x4*)(scale + c0);
        const float o0 = v[j].x * r * w.x * (1.f + sc.x) + sh.x, o1 = v[j].y * r * w.y * (1.f + sc.y) + sh.y, o2 = v[j].z * r * w.z * (1.f + sc.z) + sh.z, o3 = v[j].w * r * w.w * (1.f + sc.w) + sh.w;
        u32x2 pk; pk.x = pk2(o0, o1); pk.y = pk2(o2, o3); *(u32x2*)(orow + c0) = pk; }
}

DEV void phase_norm0(const Params& p) {
    const int wid = threadIdx.x >> 6, lane = threadIdx.x & 63; const float* mod0 = (const float*)(p.ws + WS_MOD0); bf16_t* H0 = (bf16_t*)(p.ws + WS_H0);
    for (int row = blockIdx.x * 8 + wid; row < NALL; row += gridDim.x * 8) {
        const float* xr; int v;
        if (row < NTOK) { xr = p.x + (size_t)row * DM; v = row >> 12; } else { xr = p.ctx + (size_t)(row - NTOK) * DM; v = 8; }
        modnorm_row(xr, p.norm_w, mod0 + v * 3072, mod0 + v * 3072 + 1024, H0 + (size_t)row * DM, lane);
    }
}
DEV void phase_norm1(const Params& p) {
    const int wid = threadIdx.x >> 6, lane = threadIdx.x & 63; const float* mod1 = (const float*)(p.ws + WS_MOD1); bf16_t* H1 = (bf16_t*)(p.ws + WS_H1);
    for (int row = blockIdx.x * 8 + wid; row < NTOK; row += gridDim.x * 8) { const int v = row >> 12;
        modnorm_row(p.out + (size_t)row * DM, p.norm_w + DM, mod1 + v * 3072, mod1 + v * 3072 + 1024, H1 + (size_t)row * DM, lane); }
}
DEV void phase_final(const Params& p) {
    const int wid = threadIdx.x >> 6, lane = threadIdx.x & 63;
    for (int row = blockIdx.x * 8 + wid; row < NTOK; row += gridDim.x * 8) {
        float* xr = p.out + (size_t)row * DM; f32x4 v[4]; float s = 0.f;
#pragma unroll
        for (int j = 0; j < 4; ++j) { v[j] = *(const f32x4*)(xr + lane * 4 + 256 * j); s += v[j].x * v[j].x + v[j].y * v[j].y + v[j].z * v[j].z + v[j].w * v[j].w; }
        const float r = rsqrtf(wave_sum(s) * (1.0f / DM) + EPS);
#pragma unroll
        for (int j = 0; j < 4; ++j) { const int c0 = lane * 4 + 256 * j; const f32x4 w = *(const f32x4*)(p.final_w + c0);
            f32x4 o; o.x = v[j].x * r * w.x; o.y = v[j].y * r * w.y; o.z = v[j].z * r * w.z; o.w = v[j].w * r * w.w; *(f32x4*)(xr + c0) = o; }
    }
}

DEV void phase_post(const Params& p) {
    const int wid = threadIdx.x >> 6, lane = threadIdx.x & 63;
    const bf16_t* PRAW = (const bf16_t*)(p.ws + WS_PRAW);
    bf16_t* QA = (bf16_t*)(p.ws + WS_QA); bf16_t* KA = (bf16_t*)(p.ws + WS_KA); bf16_t* VA = (bf16_t*)(p.ws + WS_VA);
    bf16_t* CQN = (bf16_t*)(p.ws + WS_CQN); bf16_t* CKVN = (bf16_t*)(p.ws + WS_CKVN); bf16_t* G = (bf16_t*)(p.ws + WS_G); bf16_t* KM = (bf16_t*)(p.ws + WS2_KM);
    const float* rp = (const float*)(p.ws + WS_ROPE); const float *cos64 = rp, *sin64 = rp + 1024, *cos32 = rp + 2048, *sin32 = rp + 2560;
    for (int tok = blockIdx.x * 8 + wid; tok < NALL; tok += gridDim.x * 8) {
        const bool lat = tok < NTOK; int b, pos, prow = 0, pcol = 0;
        if (lat) { b = tok >> 12; const int l = tok & 4095; pos = CTXL + l; prow = l >> 6; pcol = l & 63; } else { const int j = tok - NTOK; b = j >> 8; pos = j & 255; }
        const bf16_t* pr = PRAW + (size_t)tok * AINP; const size_t kvrow = (size_t)b * LK + pos;
        float v[8], o[8];
        if (lat) {
            unpack8(*(const u32x4*)(pr + lane * 8), v);
            float ss = 0.f;
#pragma unroll
            for (int j = 0; j < 8; ++j) ss += v[j] * v[j];
            ss += __shfl_xor(ss, 1); ss += __shfl_xor(ss, 2); ss += __shfl_xor(ss, 4);
            const float r = rsqrtf(ss * (1.0f / 64.0f) + EPS); const int k = lane & 7;
#pragma unroll
            for (int j = 0; j < 8; ++j) v[j] = v[j] * r * p.q_norm[k * 8 + j];
            const int posv = (k < 4) ? prow : pcol; const int fb = posv * 16 + (k & 1) * 8;
#pragma unroll
            for (int j = 0; j < 8; ++j) { const float ot = __shfl_xor(v[j], 2); const float cs = cos64[fb + j], sn = sin64[fb + j];
                o[j] = ((k & 2) ? (v[j] * cs + ot * sn) : (v[j] * cs - ot * sn)) * QSC_A; }
            *(u32x4*)(QA + (size_t)tok * 512 + lane * 8) = pack8(o);
        }
        {
            const u32x4 raw = *(const u32x4*)(pr + 512 + lane * 8); unpack8(raw, v);
            float ss = 0.f;
#pragma unroll
            for (int j = 0; j < 8; ++j) ss += v[j] * v[j];
            ss += __shfl_xor(ss, 1); ss += __shfl_xor(ss, 2); ss += __shfl_xor(ss, 4);
            const float s8 = ss;
            ss += __shfl_xor(ss, 8); ss += __shfl_xor(ss, 16);
            const float s32 = ss;
            float vn[8]; const int k = lane & 7;
            { const float r = rsqrtf(s8 * (1.0f / 64.0f) + EPS);
#pragma unroll
                for (int j = 0; j < 8; ++j) vn[j] = v[j] * r * p.k_norm[k * 8 + j]; }
            const int posv = (k < 4) ? prow : pcol; const int fb = posv * 16 + (k & 1) * 8;
#pragma unroll
            for (int j = 0; j < 8; ++j) { const float ot = __shfl_xor(vn[j], 2); const float cs = cos64[fb + j], sn = sin64[fb + j];
                o[j] = lat ? ((k & 2) ? (vn[j] * cs + ot * sn) : (vn[j] * cs - ot * sn)) : vn[j]; }
            if (lane < 16) *(u32x4*)(KA + kvrow * 128 + lane * 8) = pack8(o);
            else if (lane < 32) *(u32x4*)(VA + kvrow * 128 + (lane - 16) * 8) = raw;
            else if (lat) { const float r = rsqrtf(s32 * (1.0f / 256.0f) + EPS); const int cb = (lane - 32) * 8;
#pragma unroll
                for (int j = 0; j < 8; ++j) o[j] = v[j] * r * p.cq_norm[cb + j];
                *(u32x4*)(CQN + (size_t)tok * 256 + cb) = pack8(o); }
        }
        {
            unpack8(*(const u32x4*)(pr + 1024 + lane * 8), v);
            float ss = 0.f;
#pragma unroll
            for (int j = 0; j < 8; ++j) ss += v[j] * v[j];
            ss += __shfl_xor(ss, 1); ss += __shfl_xor(ss, 2); ss += __shfl_xor(ss, 4); ss += __shfl_xor(ss, 8);
            const int k = lane & 3; const int posv = (k < 2) ? prow : pcol;
            float oth[8];
#pragma unroll
            for (int j = 0; j < 8; ++j) oth[j] = __shfl_xor(v[j], 1);
            if (lane < 16) { const float r = rsqrtf(ss * (1.0f / 128.0f) + EPS);
#pragma unroll
                for (int j = 0; j < 8; ++j) o[j] = v[j] * r * p.ckv_norm[lane * 8 + j];
                *(u32x4*)(CKVN + kvrow * 128 + lane * 8) = pack8(o); }
            else if (lane < 20) {
#pragma unroll
                for (int j = 0; j < 8; ++j) { const float cs = cos32[posv * 8 + j], sn = sin32[posv * 8 + j];
                    o[j] = lat ? ((k & 1) ? (v[j] * cs + oth[j] * sn) : (v[j] * cs - oth[j] * sn)) : v[j]; }
                const u32x4 w = pack8(o);
#pragma unroll
                for (int h = 0; h < 8; ++h) *(u32x4*)(KM + kvrow * 768 + h * 96 + 64 + k * 8) = w; }
            else if (lat) {
#pragma unroll
                for (int j = 0; j < 8; ++j) o[j] = silu(v[j]);
                *(u32x4*)(G + (size_t)tok * 1024 + (lane - 20) * 8) = pack8(o); }
        }
        if (lat) {
            unpack8(*(const u32x4*)(pr + 1536 + lane * 8), v);
#pragma unroll
            for (int j = 0; j < 8; ++j) o[j] = silu(v[j]);
            *(u32x4*)(G + (size_t)tok * 1024 + 352 + lane * 8) = pack8(o);
            if (lane < 20) { unpack8(*(const u32x4*)(pr + 2048 + lane * 8), v);
#pragma unroll
                for (int j = 0; j < 8; ++j) o[j] = silu(v[j]);
                *(u32x4*)(G + (size_t)tok * 1024 + 864 + lane * 8) = pack8(o); }
        }
    }
}

template <int DQK>
DEV void attn_unit(char* lds, const bf16_t* __restrict__ Q, int ldq, int qcol, const bf16_t* __restrict__ Kp, int ldk, int kcol, const bf16_t* __restrict__ Vp, int ldv, int vcol,
                   const bf16_t* __restrict__ Gt, bf16_t* OG, int ocol, int b, int q0) {
    constexpr int KRS = (DQK + 8) * 2, KB = 64 * KRS, VRS = 192, VB = 64 * VRS, STG = KB + VB, NKS = DQK / 16, KCH = DQK / 8;
    const int tid = threadIdx.x, lane = tid & 63, wid = tid >> 6, l31 = lane & 31, hi = lane >> 5;
    bf16x8 qf[NKS];
    { const bf16_t* qp = Q + (size_t)(b * SEQ + q0 + wid * 32 + l31) * ldq + qcol + hi * 8;
#pragma unroll
        for (int ks = 0; ks < NKS; ++ks) qf[ks] = *(const bf16x8*)(qp + ks * 16); }
    const bf16_t* kbase = Kp + (size_t)b * LK * ldk + kcol; const bf16_t* vbase = Vp + (size_t)b * LK * ldv + vcol;
    const int kr0 = tid / KCH, kc0 = tid % KCH;
    const int kr1 = (tid + 512) / KCH, kc1 = (tid + 512) % KCH;
    const bool k2 = (KCH * 64 > 512) && (tid + 512 < KCH * 64);
    const int vr = tid >> 3, vc = tid & 7;
    u32x4 sk0, sk1, sv;
#define A_LOAD(t) do { const size_t kp_ = (size_t)(t) * 64; sk0 = *(const u32x4*)(kbase + (kp_ + kr0) * ldk + kc0 * 8); \
        if (k2) sk1 = *(const u32x4*)(kbase + (kp_ + kr1) * ldk + kc1 * 8); sv = *(const u32x4*)(vbase + (kp_ + vr) * ldv + vc * 8); } while (0)
#define A_STORE(buf) do { char* b_ = lds + (buf) * STG; *(u32x4*)(b_ + kr0 * KRS + kc0 * 16) = sk0; if (k2) *(u32x4*)(b_ + kr1 * KRS + kc1 * 16) = sk1; \
        *(u32x4*)(b_ + KB + vr * VRS + vc * 16) = sv; } while (0)
    f32x16 o0, o1;
#pragma unroll
    for (int r = 0; r < 16; ++r) { o0[r] = 0.f; o1[r] = 0.f; }
    float m_run = -1e30f, l_run = 0.f;
    const int g1 = (lane >> 4) & 1, tq = (lane & 15) >> 2, tp = lane & 3;
    const int vt_off = KB + (4 * hi + tq) * VRS + (16 * g1 + 4 * tp) * 2;
    const int kf_off = l31 * KRS + hi * 16;
    constexpr int NT = LK / 64;
    A_LOAD(0); A_STORE(0);
    __syncthreads();
    for (int t = 0; t < NT; ++t) {
        const bool more = (t + 1 < NT);
        if (more) A_LOAD(t + 1);
        const char* b_ = lds + (t & 1) * STG;
        f32x16 p0, p1;
#pragma unroll
        for (int r = 0; r < 16; ++r) { p0[r] = 0.f; p1[r] = 0.f; }
#pragma unroll
        for (int ks = 0; ks < NKS; ++ks) {
            const bf16x8 ka = *(const bf16x8*)(b_ + kf_off + ks * 32);
            const bf16x8 kb = *(const bf16x8*)(b_ + kf_off + 32 * KRS + ks * 32);
            p0 = __builtin_amdgcn_mfma_f32_32x32x16_bf16(ka, qf[ks], p0, 0, 0, 0);
            p1 = __builtin_amdgcn_mfma_f32_32x32x16_bf16(kb, qf[ks], p1, 0, 0, 0);
        }
        float mx = p0[0];
#pragma unroll
        for (int r = 1; r < 16; ++r) mx = fmaxf(mx, p0[r]);
#pragma unroll
        for (int r = 0; r < 16; ++r) mx = fmaxf(mx, p1[r]);
        mx = fmaxf(mx, __shfl_xor(mx, 32));
        const float m_new = fmaxf(m_run, mx);
        const float alpha = __builtin_amdgcn_exp2f(m_run - m_new);
        m_run = m_new;
        float ls = 0.f;
#pragma unroll
        for (int r = 0; r < 16; ++r) { p0[r] = __builtin_amdgcn_exp2f(p0[r] - m_new); p1[r] = __builtin_amdgcn_exp2f(p1[r] - m_new); ls += p0[r] + p1[r]; }
        l_run = l_run * alpha + ls;
#pragma unroll
        for (int r = 0; r < 16; ++r) { o0[r] *= alpha; o1[r] *= alpha; }
        u32x4 pw[4];
        pw[0] = (u32x4){pk2(p0[0], p0[1]), pk2(p0[2], p0[3]), pk2(p0[4], p0[5]), pk2(p0[6], p0[7])};
        pw[1] = (u32x4){pk2(p0[8], p0[9]), pk2(p0[10], p0[11]), pk2(p0[12], p0[13]), pk2(p0[14], p0[15])};
        pw[2] = (u32x4){pk2(p1[0], p1[1]), pk2(p1[2], p1[3]), pk2(p1[4], p1[5]), pk2(p1[6], p1[7])};
        pw[3] = (u32x4){pk2(p1[8], p1[9]), pk2(p1[10], p1[11]), pk2(p1[12], p1[13]), pk2(p1[14], p1[15])};
#pragma unroll
        for (int s = 0; s < 4; ++s) {
            const bf16x8 pb = __builtin_bit_cast(bf16x8, pw[s]);
#pragma unroll
            for (int dt = 0; dt < 2; ++dt) {
                const char* vp = b_ + vt_off + s * 16 * VRS + dt * 64;
                const s16x4 lo = __builtin_bit_cast(s16x4, __builtin_amdgcn_ds_read_tr16_b64_v4i16((LAS s16x4*)vp));
                const s16x4 hh = __builtin_bit_cast(s16x4, __builtin_amdgcn_ds_read_tr16_b64_v4i16((LAS s16x4*)(vp + 8 * VRS)));
                const bf16x8 vf = (bf16x8){lo[0], lo[1], lo[2], lo[3], hh[0], hh[1], hh[2], hh[3]};
                if (dt == 0) o0 = __builtin_amdgcn_mfma_f32_32x32x16_bf16(vf, pb, o0, 0, 0, 0);
                else o1 = __builtin_amdgcn_mfma_f32_32x32x16_bf16(vf, pb, o1, 0, 0, 0);
            }
        }
        if (more) A_STORE((t + 1) & 1);
        __syncthreads();
    }
#undef A_LOAD
#undef A_STORE
    const float lt = l_run + __shfl_xor(l_run, 32); const float inv = 1.0f / lt;
    const size_t tok = (size_t)(b * SEQ + q0 + wid * 32 + l31);
#pragma unroll
    for (int dt = 0; dt < 2; ++dt)
#pragma unroll
        for (int g = 0; g < 4; ++g) { const int d = 32 * dt + 8 * g + 4 * hi; const size_t off = tok * 1024 + ocol + d;
            const u32x2 gw = *(const u32x2*)(Gt + off);
            const f32x16& oo = dt ? o1 : o0;
            u32x2 w; w.x = pk2(oo[4 * g] * inv * lo_bf(gw.x), oo[4 * g + 1] * inv * hi_bf(gw.x)); w.y = pk2(oo[4 * g + 2] * inv * lo_bf(gw.y), oo[4 * g + 3] * inv * hi_bf(gw.y));
            *(u32x2*)(OG + off) = w; }
}

DEV void phase_attn(char* lds, const Params& p) {
    const bf16_t* QA = (const bf16_t*)(p.ws + WS_QA); const bf16_t* KA = (const bf16_t*)(p.ws + WS_KA); const bf16_t* VA = (const bf16_t*)(p.ws + WS_VA);
    const bf16_t* QM = (const bf16_t*)(p.ws + WS_QM); const bf16_t* KM = (const bf16_t*)(p.ws + WS2_KM); const bf16_t* VM = (const bf16_t*)(p.ws + WS2_VM);
    const bf16_t* G = (const bf16_t*)(p.ws + WS_G); bf16_t* OG = (bf16_t*)(p.ws + WS2_OG);
    for (int u = blockIdx.x; u < 2048; u += gridDim.x) {
        const int type = u >> 10, rem = u & 1023, b = rem >> 7, h = (rem >> 4) & 7, qb = rem & 15;
        if (type == 0) attn_unit<64>(lds, QA, 512, h * 64, KA, 128, (h >> 2) * 64, VA, 128, (h >> 2) * 64, G, OG, h * 64, b, qb * 256);
        else attn_unit<96>(lds, QM, 768, h * 96, KM, 768, h * 96, VM, 512, h * 64, G, OG, 512 + h * 64, b, qb * 256);
    }
}

constexpr int CV_PADL = 192, CV_ROW = 4488, CV_RS = CV_ROW * 2;
constexpr int CV_UB = 8 * CV_RS;
constexpr int CV_FS = 16448;
DEV void conv_load_filter(char* lds, const bf16_t* gr) {
    const int tid = threadIdx.x;
#pragma unroll
    for (int rnd = 0; rnd < 2; ++rnd) {
        const int ch = tid + rnd * 512;
        const u32x4 a = *(const u32x4*)(gr + ch * 8);
        u32x4 bq = {0u, 0u, 0u, 0u}; if (ch + 1 < 1024) bq = *(const u32x4*)(gr + ch * 8 + 8);
        const unsigned w[8] = {a.x, a.y, a.z, a.w, bq.x, bq.y, bq.z, bq.w};
        char* f = lds + CV_UB + ch * 16;
        *(u32x4*)(f) = a;
        u32x4 c1, c2, c3;
        c1.x = __builtin_amdgcn_alignbit(w[1], w[0], 16); c1.y = __builtin_amdgcn_alignbit(w[2], w[1], 16); c1.z = __builtin_amdgcn_alignbit(w[3], w[2], 16); c1.w = __builtin_amdgcn_alignbit(w[4], w[3], 16);
        c2 = (u32x4){w[1], w[2], w[3], w[4]};
        c3.x = __builtin_amdgcn_alignbit(w[2], w[1], 16); c3.y = __builtin_amdgcn_alignbit(w[3], w[2], 16); c3.z = __builtin_amdgcn_alignbit(w[4], w[3], 16); c3.w = __builtin_amdgcn_alignbit(w[5], w[4], 16);
        *(u32x4*)(f + CV_FS) = c1; *(u32x4*)(f + 2 * CV_FS) = c2; *(u32x4*)(f + 3 * CV_FS) = c3;
    }
}
DEV void sconv4(const bf16_t* px, int t, float w0, float w1, float w2, float bias, float* u) {
    const u32x2 mid = *(const u32x2*)(px + t);
    const float pm = (t > 0) ? bf2f(px[t - 1]) : 0.f, pp = (t + 4 < SEQ) ? bf2f(px[t + 4]) : 0.f;
    const float q0 = lo_bf(mid.x), q1 = hi_bf(mid.x), q2 = lo_bf(mid.y), q3 = hi_bf(mid.y);
    u[0] = w0 * pm + w1 * q0 + w2 * q1 + bias; u[1] = w0 * q0 + w1 * q1 + w2 * q2 + bias; u[2] = w0 * q1 + w1 * q2 + w2 * q3 + bias; u[3] = w0 * q2 + w1 * q3 + w2 * pp + bias;
}
DEV void conv_mfma_loop(const char* lds, f32x16 (&acc)[2][2], int wid, int lane) {
    const int l31 = lane & 31, hi = lane >> 5;
#pragma unroll
    for (int a = 0; a < 2; ++a)
#pragma unroll
        for (int b = 0; b < 2; ++b)
#pragma unroll
            for (int r = 0; r < 16; ++r) acc[a][b][r] = 0.f;
    int a_off[2];
#pragma unroll
    for (int mt = 0; mt < 2; ++mt) { const int r = l31 + 32 * mt, q = (4 - (r & 3)) & 3; a_off[mt] = CV_UB + q * CV_FS + (4096 - r - q + 8 * hi) * 2; }
    int b_off[2];
#pragma unroll
    for (int n = 0; n < 2; ++n) { const int nt = 2 * wid + n; b_off[n] = (l31 & 7) * CV_RS + (CV_PADL + 64 * (4 * nt + (l31 >> 3)) + 8 * hi) * 2; }
    const int dlo = 8 * wid - 63, dhi = 8 * wid + 7;
    for (int d = dlo; d <= dhi; ++d) {
        bf16x8 fa[2][4];
#pragma unroll
        for (int mt = 0; mt < 2; ++mt)
#pragma unroll
            for (int ks = 0; ks < 4; ++ks) { const char* ap = lds + a_off[mt] - 128 * d + ks * 32;
                const u32x2 lo = *(const u32x2*)ap, hh = *(const u32x2*)(ap + 8);
                fa[mt][ks] = __builtin_bit_cast(bf16x8, (u32x4){lo.x, lo.y, hh.x, hh.y}); }
#pragma unroll
        for (int n = 0; n < 2; ++n) {
            const int nt = 2 * wid + n;
            if (d >= 4 * nt - 63 && d <= 4 * nt + 3) {
#pragma unroll
                for (int ks = 0; ks < 4; ++ks) { const bf16x8 fb = *(const bf16x8*)(lds + b_off[n] - 128 * d + ks * 32);
#pragma unroll
                    for (int mt = 0; mt < 2; ++mt) acc[n][mt] = __builtin_amdgcn_mfma_f32_32x32x16_bf16(fa[mt][ks], fb, acc[n][mt], 0, 0, 0); }
            }
        }
    }
}
DEV void conv_unit(char* lds, const Params& p, int c) {
    const int tid = threadIdx.x, lane = tid & 63, wid = tid >> 6, l31 = lane & 31, hi = lane >> 5;
    const bf16_t* PT = (const bf16_t*)(p.ws + WS_PT); const bf16_t* GR = (const bf16_t*)(p.ws + WS_GR); const float* ssum = (const float*)(p.ws + WS_SSUM);
    bf16_t* OG2 = (bf16_t*)(p.ws + WS_OG2);
    for (int i = tid; i < 8 * 98; i += 512) { const int b = i / 98, j = i % 98;
        const int e = (j < 48) ? j * 4 : (CV_PADL + SEQ + (j - 48) * 4); *(u32x2*)(lds + b * CV_RS + e * 2) = (u32x2){0u, 0u}; }
    { const float w0 = p.conv_w[c], w1 = p.conv_w[3072 + c], w2 = p.conv_w[6144 + c], bias = p.conv_b[c];
        for (int i = tid; i < 8 * 1024; i += 512) { const int b = i >> 10, t = (i & 1023) * 4; float u[4];
            sconv4(PT + ((size_t)(b * 4096 + c)) * 4096, t, w0, w1, w2, bias, u);
            u32x2 w; w.x = pk2(u[0], u[1]); w.y = pk2(u[2], u[3]); *(u32x2*)(lds + b * CV_RS + (CV_PADL + t) * 2) = w; } }
    conv_load_filter(lds, GR + (size_t)c * 8192);
    __syncthreads();
    f32x16 acc[2][2];
    conv_mfma_loop(lds, acc, wid, lane);
    __syncthreads();
    { const float invs = 1.0f / ssum[c], sk = p.skip[c];
        const float w0 = p.conv_w[1024 + c], w1 = p.conv_w[3072 + 1024 + c], w2 = p.conv_w[6144 + 1024 + c], bias = p.conv_b[1024 + c];
        const int b = l31 & 7;
#pragma unroll
        for (int n = 0; n < 2; ++n) { const int i = 4 * (2 * wid + n) + (l31 >> 3);
#pragma unroll
            for (int mt = 0; mt < 2; ++mt)
#pragma unroll
                for (int g = 0; g < 4; ++g) { const int t = 64 * i + 32 * mt + 8 * g + 4 * hi; float x1[4];
                    sconv4(PT + ((size_t)(b * 4096 + 1024 + c)) * 4096, t, w0, w1, w2, bias, x1);
                    char* up = lds + b * CV_RS + (CV_PADL + t) * 2; const u32x2 vw = *(const u32x2*)up;
                    const float z0 = x1[0] * (acc[n][mt][4 * g] * invs + sk * lo_bf(vw.x)), z1 = x1[1] * (acc[n][mt][4 * g + 1] * invs + sk * hi_bf(vw.x));
                    const float z2 = x1[2] * (acc[n][mt][4 * g + 2] * invs + sk * lo_bf(vw.y)), z3 = x1[3] * (acc[n][mt][4 * g + 3] * invs + sk * hi_bf(vw.y));
                    u32x2 w; w.x = pk2(z0, z1); w.y = pk2(z2, z3); *(u32x2*)up = w; } } }
    conv_load_filter(lds, GR + (size_t)(1024 + c) * 8192);
    __syncthreads();
    conv_mfma_loop(lds, acc, wid, lane);
    { const float invs = 1.0f / ssum[1024 + c], sk = p.skip[1024 + c];
        const float w0 = p.conv_w[2048 + c], w1 = p.conv_w[3072 + 2048 + c], w2 = p.conv_w[6144 + 2048 + c], bias = p.conv_b[2048 + c];
        const int b = l31 & 7;
#pragma unroll
        for (int n = 0; n < 2; ++n) { const int i = 4 * (2 * wid + n) + (l31 >> 3);
#pragma unroll
            for (int mt = 0; mt < 2; ++mt)
#pragma unroll
                for (int g = 0; g < 4; ++g) { const int t = 64 * i + 32 * mt + 8 * g + 4 * hi; float x2[4];
                    sconv4(PT + ((size_t)(b * 4096 + 2048 + c)) * 4096, t, w0, w1, w2, bias, x2);
                    const u32x2 zw = *(const u32x2*)(lds + b * CV_RS + (CV_PADL + t) * 2);
                    const u32x2 gw = *(const u32x2*)(PT + ((size_t)(b * 4096 + 3072 + c)) * 4096 + t);
                    const float y0 = x2[0] * (acc[n][mt][4 * g] * invs + sk * lo_bf(zw.x)) * silu(lo_bf(gw.x)), y1 = x2[1] * (acc[n][mt][4 * g + 1] * invs + sk * hi_bf(zw.x)) * silu(hi_bf(gw.x));
                    const float y2 = x2[2] * (acc[n][mt][4 * g + 2] * invs + sk * lo_bf(zw.y)) * silu(lo_bf(gw.y)), y3 = x2[3] * (acc[n][mt][4 * g + 3] * invs + sk * hi_bf(zw.y)) * silu(hi_bf(gw.y));
                    u32x2 w; w.x = pk2(y0, y1); w.y = pk2(y2, y3); *(u32x2*)(OG2 + ((size_t)(b * 1024 + c)) * 4096 + t) = w; } } }
    __syncthreads();
}

constexpr int NPHASE = 12;
__global__ void __launch_bounds__(512) fwd_kernel(Params p) {
    extern __shared__ __attribute__((aligned(16))) char lds[];
    char* ws = p.ws;
#define SEAM(k) do { if (MK_LAUNCHES == 1 && (k) + 1 < p.ph_hi) { cg::this_grid().sync(); } } while (0)
#define IN(k) (p.ph_lo <= (k) && (k) < p.ph_hi)
    if (IN(0)) { phase_prep(lds, p); SEAM(0); }
    if (IN(1)) {
        EpiFilt ef{(bf16_t*)(ws + WS_GR), (float*)(ws + WS_SSUM), p.f_b3};
        gemm_phase<false, EpiFilt>(lds, (const bf16_t*)(ws + WS_W3), 64, (const bf16_t*)(ws + WS_HID2), 64, 4096, 4096, 64, ef);
        phase_norm0(p); SEAM(1); }
    if (IN(2)) {
        EpiRaw e{(bf16_t*)(ws + WS_PRAW), (size_t)AINP};
        gemm_phase<false, EpiRaw>(lds, (const bf16_t*)(ws + WS_H0), DM, (const bf16_t*)(ws + WS_WIN), DM, NALL, AINP, DM, e); SEAM(2); }
    if (IN(3)) { phase_post(p); SEAM(3); }
    if (IN(4)) {
        const float* rp = (const float*)(ws + WS_ROPE);
        EpiUq eq{(bf16_t*)(ws + WS_QM), rp + 2048, rp + 2560};
        gemm_phase<false, EpiUq>(lds, (const bf16_t*)(ws + WS_CQN), 256, (const bf16_t*)(ws + WS_WUQ), 256, NTOK, 768, 256, eq);
        EpiUkv ek{(bf16_t*)(ws + WS2_KM), (bf16_t*)(ws + WS2_VM)};
        gemm_phase<false, EpiUkv>(lds, (const bf16_t*)(ws + WS_CKVN), 128, (const bf16_t*)(ws + WS_WUKV), 128, NALL, 1024, 128, ek); SEAM(4); }
    if (IN(5)) { phase_attn(lds, p); SEAM(5); }
    if (IN(6)) {
        EpiRes e{p.x, p.out, (const float*)(ws + WS_MOD0), (DBG_SKIP & 1) ? 0.f : 1.f};
        gemm_phase<false, EpiRes>(lds, (const bf16_t*)(ws + WS2_OG), DM, (const bf16_t*)(ws + WS_WOUT), DM, NTOK, DM, DM, e); SEAM(6); }
    if (IN(7)) { phase_norm1(p); SEAM(7); }
    if (IN(8)) {
        EpiPT e{(bf16_t*)(ws + WS_PT)};
        gemm_phase<false, EpiPT>(lds, (const bf16_t*)(ws + WS_HWIN), DM, (const bf16_t*)(ws + WS_H1), DM, 4096, NTOK, DM, e); SEAM(8); }
    if (IN(9)) { for (int c = blockIdx.x; c < 1024; c += gridDim.x) conv_unit(lds, p, c); SEAM(9); }
    if (IN(10)) {
        EpiRes e{p.out, p.out, (const float*)(ws + WS_MOD1), (DBG_SKIP & 2) ? 0.f : 1.f};
        const bf16_t* OG2 = (const bf16_t*)(ws + WS_OG2); const bf16_t* W = (const bf16_t*)(ws + WS_HWOUT);
        const int nt = (NTOK / 256) * (DM / 128);
        for (int t = blockIdx.x; t < nt; t += gridDim.x) { const int ti = t / 8, tj = t % 8; const int b = ti >> 4, l0 = (ti & 15) * 256;
            gemm_tile<true, EpiRes>(lds, OG2 + (size_t)b * 1024 * 4096 + l0, 4096, W + (size_t)tj * 128 * DM, DM, DM, e, ti * 256, tj * 128); }
        SEAM(10); }
    if (IN(11)) { phase_final(p); }
#undef SEAM
#undef IN
}

extern "C" void kernel_launch(void* const* d_in, const int* in_sizes, int n_in, void* d_out, int out_size, void* d_ws, size_t ws_size, hipStream_t stream) {
    static int grid = 0;
    if (grid == 0) {
        if (n_in != 28 || out_size != NTOK * DM || ws_size < WS_END) { fprintf(stderr, "kernel_launch: unexpected shapes n_in %d out %d ws %zu\n", n_in, out_size, ws_size); grid = -1; return; }
        int dev = 0, cus = 0, per_cu = 0;
        hipGetDevice(&dev); hipDeviceGetAttribute(&cus, hipDeviceAttributeMultiprocessorCount, dev);
        if (hipFuncSetAttribute((const void*)fwd_kernel, hipFuncAttributeMaxDynamicSharedMemorySize, LDS_BYTES) != hipSuccess) { fprintf(stderr, "hipFuncSetAttribute failed\n"); grid = -1; return; }
        hipOccupancyMaxActiveBlocksPerMultiprocessor(&per_cu, (const void*)fwd_kernel, 512, LDS_BYTES);
        if (per_cu < 1) { fprintf(stderr, "occupancy query says %d\n", per_cu); per_cu = 1; }
        grid = cus * 1;
        (void)hipGetLastError();
    }
    if (grid < 0) return;
    Params p{};
    const float** pp = (const float**)&p;
    for (int i = 0; i < 28; ++i) pp[i] = (const float*)d_in[i];
    p.out = (float*)d_out; p.ws = (char*)d_ws;
#if MK_LAUNCHES == 1
    p.ph_lo = 0; p.ph_hi = NPHASE;
    void* args[] = {&p};
    hipError_t e = hipLaunchCooperativeKernel((const void*)fwd_kernel, dim3(grid), dim3(512), args, LDS_BYTES, stream);
    if (e != hipSuccess) fprintf(stderr, "cooperative launch failed: %s (grid %d)\n", hipGetErrorString(e), grid);
#else
    for (int k = 0; k < NPHASE; ++k) { p.ph_lo = k; p.ph_hi = k + 1; hipLaunchKernelGGL(fwd_kernel, dim3(grid), dim3(512), LDS_BYTES, stream, p); }
#endif
}
```

```cpp
#include <hip/hip_runtime.h>
#include <hip/hip_cooperative_groups.h>
#include <cstdio>
#include <cstdint>
namespace cg = cooperative_groups;

#ifndef MK_LAUNCHES
#define MK_LAUNCHES 1
#endif

#ifndef PROBE_REPEAT
#define PROBE_REPEAT -1
#endif
#ifndef DBG_SKIP
#define DBG_SKIP 0
#endif
#define DEV __device__ __forceinline__
typedef unsigned short bf16_t;
typedef short bf16x8 __attribute__((ext_vector_type(8)));
typedef short s16x4 __attribute__((ext_vector_type(4)));
typedef float f32x16 __attribute__((ext_vector_type(16)));
typedef float f32x4 __attribute__((ext_vector_type(4)));
typedef float f32x2 __attribute__((ext_vector_type(2)));
typedef unsigned u32x4 __attribute__((ext_vector_type(4)));
typedef unsigned u32x2 __attribute__((ext_vector_type(2)));
typedef __bf16 bf16x2_t __attribute__((ext_vector_type(2)));
#define LAS __attribute__((address_space(3)))

constexpr int NB = 8, SEQ = 4096, DM = 1024, CTXL = 256, LK = SEQ + CTXL;
constexpr int NTOK = NB * SEQ, NCTX = NB * CTXL, NALL = NTOK + NCTX;
constexpr int AIN = 2208, AINP = 2304;
constexpr float EPS = 1e-6f;
constexpr float LOG2E = 1.4426950408889634f;
constexpr float QSC_A = 0.125f * LOG2E;
constexpr float QSC_M = 0.10206207261596575f * LOG2E;

constexpr size_t MiB = 1ull << 20;
constexpr size_t WS_WIN = 0;
constexpr size_t WS_WUQ = 5 * MiB;
constexpr size_t WS_WUKV = 6 * MiB;
constexpr size_t WS_WOUT = 7 * MiB;
constexpr size_t WS_HWIN = 9 * MiB;
constexpr size_t WS_HWOUT = 17 * MiB;
constexpr size_t WS_W3 = 19 * MiB;
constexpr size_t WS_HID2 = 20 * MiB;
constexpr size_t WS_MOD0 = 21 * MiB;
constexpr size_t WS_MOD1 = WS_MOD0 + 9 * 3072 * 4;
constexpr size_t WS_SSUM = WS_MOD1 + 8 * 3072 * 4;
constexpr size_t WS_ROPE = WS_SSUM + 2048 * 4;
constexpr size_t WS_GR = 22 * MiB;
constexpr size_t WS_H0 = 64 * MiB;
constexpr size_t WS_PRAW = 136 * MiB;
constexpr size_t WS_QA = 297 * MiB;
constexpr size_t WS_KA = 329 * MiB;
constexpr size_t WS_VA = 338 * MiB;
constexpr size_t WS_CQN = 347 * MiB;
constexpr size_t WS_CKVN = 363 * MiB;
constexpr size_t WS_G = 372 * MiB;
constexpr size_t WS_QM = 64 * MiB;
constexpr size_t WS_KM = 136 * MiB;
constexpr size_t WS_VM = 190 * MiB;
constexpr size_t WS_OG = 226 * MiB;
constexpr size_t WS_H1 = 436 * MiB;
constexpr size_t WS_PT = 64 * MiB;
constexpr size_t WS_OG2 = 320 * MiB;
constexpr size_t WS_CTL = 500 * MiB;
constexpr size_t CTL_BYTES = 16384;
constexpr size_t WS_END = 500 * MiB + CTL_BYTES;
constexpr size_t WS2_KM = 436 * MiB;
constexpr size_t WS2_VM = 190 * MiB;
constexpr size_t WS2_OG = 226 * MiB;

constexpr int LDS_BYTES = 150 * 1024;

DEV float bf2f(bf16_t v) { return __uint_as_float(((unsigned)v) << 16); }
DEV unsigned pk2(float lo, float hi) { f32x2 v = {lo, hi}; bf16x2_t b = __builtin_convertvector(v, bf16x2_t); return __builtin_bit_cast(unsigned, b); }
DEV bf16_t f2bf(float f) { return (bf16_t)(pk2(f, 0.f) & 0xffffu); }
DEV float lo_bf(unsigned w) { return __uint_as_float(w << 16); }
DEV float hi_bf(unsigned w) { return __uint_as_float(w & 0xffff0000u); }
DEV int crow(int r, int hi) { return (r & 3) + 8 * (r >> 2) + 4 * hi; }
DEV float silu(float v) { return v / (1.f + __expf(-v)); }
DEV void unpack8(const u32x4 w, float* v) { v[0] = lo_bf(w.x); v[1] = hi_bf(w.x); v[2] = lo_bf(w.y); v[3] = hi_bf(w.y); v[4] = lo_bf(w.z); v[5] = hi_bf(w.z); v[6] = lo_bf(w.w); v[7] = hi_bf(w.w); }
DEV u32x4 pack8(const float* v) { u32x4 w; w.x = pk2(v[0], v[1]); w.y = pk2(v[2], v[3]); w.z = pk2(v[4], v[5]); w.w = pk2(v[6], v[7]); return w; }

struct Params {
    const float *x, *c, *ctx, *c_ctx, *ada_w, *ada_b, *norm_w, *w_in, *q_norm, *k_norm, *cq_norm, *ckv_norm, *w_uq, *w_ukv, *w_out,
        *hy_w_in, *conv_w, *conv_b, *f_w1, *f_b1, *f_w2, *f_b2, *f_w3, *f_b3, *freq, *skip, *hy_w_out, *final_w;
    float* out; char* ws; int ph_lo, ph_hi;
};

constexpr int G_RS = 144;
constexpr int G_RB = 256 * G_RS, G_CB = 128 * G_RS, G_STAGE = G_RB + G_CB;
constexpr int T_RS = 576;

template <bool TR, class Epi>
DEV void gemm_tile(char* lds, const bf16_t* __restrict__ R, size_t ldr, const bf16_t* __restrict__ C, size_t ldc, int K, const Epi& epi, int ti0, int tj0) {
    const int tid = threadIdx.x, lane = tid & 63, wid = tid >> 6;
    const int wi = wid >> 1, wj = wid & 1, l31 = lane & 31, hi = lane >> 5;
    f32x16 acc[2][2];
#pragma unroll
    for (int a = 0; a < 2; ++a)
#pragma unroll
        for (int b = 0; b < 2; ++b)
#pragma unroll
            for (int r = 0; r < 16; ++r) acc[a][b][r] = 0.f;
    u32x4 rr[4], rc[2];
    const bf16_t* Rp; const bf16_t* Cp; int rl_off, cl_off;
    if (TR) { const int c = tid & 31, kr = tid >> 5; Rp = R + (size_t)kr * ldr + c * 8; rl_off = kr * T_RS + c * 16; }
    else { const int lr = tid >> 3, lc = tid & 7; Rp = R + (size_t)lr * ldr + lc * 8; rl_off = lr * G_RS + lc * 16; }
    { const int lr = tid >> 3, lc = tid & 7; Cp = C + (size_t)lr * ldc + lc * 8; cl_off = lr * G_RS + lc * 16; }
    const int nk = K / 64;
    int ra_off[2], cb_off[2];
#pragma unroll
    for (int t = 0; t < 2; ++t) {
        if (TR) { const int g1 = (lane >> 4) & 1, q = (lane & 15) >> 2, p = lane & 3; ra_off[t] = (8 * hi + q) * T_RS + (wi * 64 + t * 32 + 16 * g1 + 4 * p) * 2; }
        else ra_off[t] = (wi * 64 + t * 32 + l31) * G_RS + hi * 16;
        cb_off[t] = G_RB + (wj * 64 + t * 32 + l31) * G_RS + hi * 16;
    }
#define G_LOAD(kt) do { \
        if (TR) { _Pragma("unroll") for (int p = 0; p < 4; ++p) rr[p] = *(const u32x4*)(Rp + ((size_t)(kt) * 64 + 16 * p) * ldr); } \
        else { _Pragma("unroll") for (int p = 0; p < 4; ++p) rr[p] = *(const u32x4*)(Rp + (size_t)(64 * p) * ldr + (kt) * 64); } \
        _Pragma("unroll") for (int p = 0; p < 2; ++p) rc[p] = *(const u32x4*)(Cp + (size_t)(64 * p) * ldc + (kt) * 64); } while (0)
#define G_STORE(buf) do { char* b_ = lds + (buf) * G_STAGE; \
        if (TR) { _Pragma("unroll") for (int p = 0; p < 4; ++p) *(u32x4*)(b_ + rl_off + 16 * p * T_RS) = rr[p]; } \
        else { _Pragma("unroll") for (int p = 0; p < 4; ++p) *(u32x4*)(b_ + rl_off + 64 * p * G_RS) = rr[p]; } \
        _Pragma("unroll") for (int p = 0; p < 2; ++p) *(u32x4*)(b_ + G_RB + cl_off + 64 * p * G_RS) = rc[p]; } while (0)
    G_LOAD(0); G_STORE(0);
    __syncthreads();
    for (int kt = 0; kt < nk; ++kt) {
        const bool more = (kt + 1 < nk);
        if (more) G_LOAD(kt + 1);
        const char* b_ = lds + (kt & 1) * G_STAGE;
#pragma unroll
        for (int ks = 0; ks < 4; ++ks) {
            bf16x8 fa[2], fb[2];
#pragma unroll
            for (int t = 0; t < 2; ++t) {
                if (TR) {
                    const s16x4 lo = __builtin_bit_cast(s16x4, __builtin_amdgcn_ds_read_tr16_b64_v4i16((LAS s16x4*)(b_ + ra_off[t] + ks * 16 * T_RS)));
                    const s16x4 hh = __builtin_bit_cast(s16x4, __builtin_amdgcn_ds_read_tr16_b64_v4i16((LAS s16x4*)(b_ + ra_off[t] + (ks * 16 + 4) * T_RS)));
                    fa[t] = (bf16x8){lo[0], lo[1], lo[2], lo[3], hh[0], hh[1], hh[2], hh[3]};
                } else fa[t] = *(const bf16x8*)(b_ + ra_off[t] + ks * 32);
                fb[t] = *(const bf16x8*)(b_ + cb_off[t] + ks * 32);
            }
#pragma unroll
            for (int a = 0; a < 2; ++a)
#pragma unroll
                for (int b = 0; b < 2; ++b) acc[a][b] = __builtin_amdgcn_mfma_f32_32x32x16_bf16(fa[a], fb[b], acc[a][b], 0, 0, 0);
        }
        if (more) G_STORE((kt + 1) & 1);
        __syncthreads();
    }
#undef G_LOAD
#undef G_STORE
#pragma unroll
    for (int a = 0; a < 2; ++a)
#pragma unroll
        for (int b = 0; b < 2; ++b) epi(ti0 + wi * 64 + a * 32, tj0 + wj * 64 + b * 32, acc[a][b], l31, hi);
}

template <bool TR, class Epi>
DEV void gemm_phase(char* lds, const bf16_t* R, size_t ldr, const bf16_t* C, size_t ldc, int nI, int nJ, int K, const Epi& epi) {
    const int tI = nI / 256, tJ = nJ / 128, nt = tI * tJ;
    for (int t = blockIdx.x; t < nt; t += gridDim.x) {
        const int ti = t / tJ, tj = t % tJ;
        gemm_tile<TR, Epi>(lds, R + (size_t)ti * 256 * ldr, ldr, C + (size_t)tj * 128 * ldc, ldc, K, epi, ti * 256, tj * 128);
    }
}

struct EpiRaw {
    bf16_t* O; size_t ld;
    DEV void operator()(int i0, int j0, const f32x16& a, int l31, int hi) const {
#pragma unroll
        for (int r = 0; r < 16; ++r) O[(size_t)(i0 + crow(r, hi)) * ld + j0 + l31] = f2bf(a[r]);
    }
};
struct EpiUq {
    bf16_t* QM; const float* cos32; const float* sin32;
    DEV void operator()(int i0, int j0, const f32x16& a, int l31, int hi) const {
        const bool pe = (j0 % 96) == 64;
        const int fi = l31 & 7; const bool colang = (l31 & 16) != 0; const bool bpart = (l31 & 8) != 0;
#pragma unroll
        for (int r = 0; r < 16; ++r) {
            const int tok = i0 + crow(r, hi); float v = a[r];
            const float o = __shfl_xor(v, 8);
            if (pe) { const int l = tok & (SEQ - 1); const int pos = colang ? (l & 63) : (l >> 6);
                const float cs = cos32[pos * 8 + fi], sn = sin32[pos * 8 + fi];
                v = bpart ? (v * cs + o * sn) : (v * cs - o * sn); }
            QM[(size_t)tok * 768 + j0 + l31] = f2bf(v * QSC_M);
        }
    }
};
struct EpiUkv {
    bf16_t* KM; bf16_t* VM;
    DEV void operator()(int i0, int j0, const f32x16& a, int l31, int hi) const {
        const int h = j0 >> 7, e = (j0 & 127) + l31;
#pragma unroll
        for (int r = 0; r < 16; ++r) { const size_t row = (size_t)(i0 + crow(r, hi));
            if (e < 64) KM[row * 768 + h * 96 + e] = f2bf(a[r]); else VM[row * 512 + h * 64 + (e - 64)] = f2bf(a[r]); }
    }
};
struct EpiRes {
    const float* base; float* out; const float* mod; float gmul;
    DEV void operator()(int i0, int j0, const f32x16& a, int l31, int hi) const {
        const int b = i0 >> 12; const float g = mod[b * 3072 + 2048 + j0 + l31] * gmul;
#pragma unroll
        for (int h8 = 0; h8 < 2; ++h8) { float bv[8];
#pragma unroll
            for (int r = 0; r < 8; ++r) bv[r] = base[(size_t)(i0 + crow(8 * h8 + r, hi)) * DM + j0 + l31];
#pragma unroll
            for (int r = 0; r < 8; ++r) out[(size_t)(i0 + crow(8 * h8 + r, hi)) * DM + j0 + l31] = bv[r] + g * a[8 * h8 + r]; }
    }
};
struct EpiPT {
    bf16_t* PT;
    DEV void operator()(int i0, int j0, const f32x16& a, int l31, int hi) const {
        const int b = j0 >> 12, l = (j0 & 4095) + l31;
#pragma unroll
        for (int r = 0; r < 16; ++r) PT[((size_t)(b * 4096 + i0 + crow(r, hi))) * 4096 + l] = f2bf(a[r]);
    }
};
struct EpiFilt {
    bf16_t* GR; float* ssum; const float* b3;
    DEV void operator()(int i0, int j0, const f32x16& a, int l31, int hi) const {
        const int t = j0 + l31; const float tn = (float)t * (1.0f / 4095.0f);
        const float dmin = -3.0701134573253945f, dmax = -15.350567286626973f;
#pragma unroll
        for (int r = 0; r < 16; ++r) {
            const int n = i0 + crow(r, hi); const int c = n & 1023, od = n >> 10, o = od >> 1, dir = od & 1;
            const float delta = fabsf(dmin + (float)c * ((dmax - dmin) / 1023.0f));
            float v = (a[r] + b3[n]) * __expf(-tn * delta);
            bf16_t* g = GR + ((size_t)(o * 1024 + c)) * 8192;
            if (dir == 0) g[4096 - t] = f2bf(v);
            else { if (t == 0) { g[0] = 0; v = 0.f; } else g[4096 + t] = f2bf(v); }
            float s = fabsf(v);
            s += __shfl_xor(s, 16); s += __shfl_xor(s, 8); s += __shfl_xor(s, 4); s += __shfl_xor(s, 2); s += __shfl_xor(s, 1);
            if (l31 == 0) atomicAdd(ssum + o * 1024 + c, s);
        }
    }
};

DEV void transpose_item(char* lds, const float* W, int K, int N, int Npad, bf16_t* WT, int item) {
    float* tile = (float*)lds;
    const int nb = Npad / 64, kb = item / nb, nbi = item % nb, k0 = kb * 64, n0 = nbi * 64;
    const int tid = threadIdx.x;
    { const int kk = tid >> 4, n4 = (tid & 15) * 4;
#pragma unroll
        for (int p = 0; p < 2; ++p) { f32x4 v = {0.f, 0.f, 0.f, 0.f}; if (n0 + n4 < N) v = *(const f32x4*)(W + (size_t)(k0 + kk + 32 * p) * N + n0 + n4);
            float* d = tile + (kk + 32 * p) * 65 + n4; d[0] = v.x; d[1] = v.y; d[2] = v.z; d[3] = v.w; } }
    __syncthreads();
    { const int n = tid >> 3, kc = tid & 7; float v[8];
#pragma unroll
        for (int j = 0; j < 8; ++j) v[j] = tile[(kc * 8 + j) * 65 + n];
        *(u32x4*)(WT + (size_t)(n0 + n) * K + k0 + kc * 8) = pack8(v); }
    __syncthreads();
}

DEV void mod_item(char* lds, const Params& p, int item) {
    const int layer = item / 96, n0 = (item % 96) * 32, tid = threadIdx.x;
    float* s = (float*)lds;
    float* red = s + 9 * 1024;
    for (int i = tid; i < 9 * 1024; i += 512) { const int v = i >> 10, k = i & 1023; const float cv = (v < 8) ? p.c[v * 1024 + k] : p.c_ctx[k]; s[i] = silu(cv); }
    __syncthreads();
    const int kc = tid >> 5, n = tid & 31; const float* W = p.ada_w + (size_t)layer * DM * 3072 + n0 + n;
    float acc[9];
#pragma unroll
    for (int v = 0; v < 9; ++v) acc[v] = 0.f;
#pragma unroll 8
    for (int kk = 0; kk < 64; ++kk) { const int k = kc * 64 + kk; const float w = W[(size_t)k * 3072];
#pragma unroll
        for (int v = 0; v < 9; ++v) acc[v] += s[v * 1024 + k] * w; }
#pragma unroll
    for (int v = 0; v < 9; ++v) red[(kc * 9 + v) * 32 + n] = acc[v];
    __syncthreads();
    if (tid < 9 * 32) { const int v = tid >> 5, nn = tid & 31; float t = 0.f;
#pragma unroll
        for (int k2 = 0; k2 < 16; ++k2) t += red[(k2 * 9 + v) * 32 + nn];
        t += p.ada_b[layer * 3072 + n0 + nn];
        if (layer == 0) ((float*)(p.ws + WS_MOD0))[v * 3072 + n0 + nn] = t;
        else if (v < 8) ((float*)(p.ws + WS_MOD1))[v * 3072 + n0 + nn] = t; }
    __syncthreads();
}

DEV void hid2_row(char* lds, const Params& p, int t, int wid, int lane) {
    float* sc = (float*)lds + wid * 128;
    const float tn = (float)t * (1.0f / 4095.0f);
    const float w = (float)(2.0 * 3.14159265358979323846 / 4096.0) * (float)t;
    float e = 0.f;
    if (lane == 0) e = tn;
    else if (lane <= 32) { const int k = (lane - 1) & 15; const float band = 1e-4f + (float)k * ((15.0f - 1e-4f) / 15.0f); const float ang = w * band; e = (lane <= 16) ? cosf(ang) : -sinf(ang); }
    sc[lane] = e;
    asm volatile("s_waitcnt lgkmcnt(0)" ::: "memory");
    float a = p.f_b1[lane];
    for (int i = 0; i < 33; ++i) a += sc[i] * p.f_w1[i * 64 + lane];
    const float fr = p.freq[lane];
    const float h1 = sinf(fr * a);
    sc[64 + lane] = h1;
    asm volatile("s_waitcnt lgkmcnt(0)" ::: "memory");
    float a2 = p.f_b2[lane];
    for (int i = 0; i < 64; ++i) a2 += sc[64 + i] * p.f_w2[i * 64 + lane];
    const float h2 = sinf(fr * a2);
    ((bf16_t*)(p.ws + WS_HID2))[t * 64 + lane] = f2bf(h2);
    asm volatile("s_waitcnt lgkmcnt(0)" ::: "memory");
}

DEV void phase_prep(char* lds, const Params& p) {
    const int tid = threadIdx.x, wid = tid >> 6, lane = tid & 63;
    { const int gt = blockIdx.x * 512 + tid;
        if (gt < 2048) ((float*)(p.ws + WS_SSUM))[gt] = 0.f;
        float* rp = (float*)(p.ws + WS_ROPE);
        if (gt < 1024) { const int pos = gt >> 4, i = gt & 15; const float inv = exp2f(-(float)i * (13.287712379549449f / 16.0f)); const float ang = (float)pos * inv; rp[gt] = cosf(ang); rp[1024 + gt] = sinf(ang); }
        if (gt < 512) { const int pos = gt >> 3, i = gt & 7; const float inv = exp2f(-(float)i * (13.287712379549449f / 8.0f)); const float ang = (float)pos * inv; rp[2048 + gt] = cosf(ang); rp[2560 + gt] = sinf(ang); } }
    for (int it = blockIdx.x; it < 192; it += gridDim.x) mod_item(lds, p, it);
    for (int t = blockIdx.x * 8 + wid; t < 4096; t += gridDim.x * 8) hid2_row(lds, p, t, wid, lane);
    __syncthreads();
    constexpr int I_WIN = 16 * 36, I_UQ = 4 * 12, I_UKV = 2 * 16, I_WO = 256, I_HIN = 16 * 64, I_HO = 256, I_W3 = 64;
    constexpr int NIT = I_WIN + I_UQ + I_UKV + I_WO + I_HIN + I_HO + I_W3;
    for (int it = blockIdx.x; it < NIT; it += gridDim.x) {
        int r = it;
        if (r < I_WIN) { transpose_item(lds, p.w_in, 1024, AIN, AINP, (bf16_t*)(p.ws + WS_WIN), r); continue; } r -= I_WIN;
        if (r < I_UQ) { transpose_item(lds, p.w_uq, 256, 768, 768, (bf16_t*)(p.ws + WS_WUQ), r); continue; } r -= I_UQ;
        if (r < I_UKV) { transpose_item(lds, p.w_ukv, 128, 1024, 1024, (bf16_t*)(p.ws + WS_WUKV), r); continue; } r -= I_UKV;
        if (r < I_WO) { transpose_item(lds, p.w_out, 1024, 1024, 1024, (bf16_t*)(p.ws + WS_WOUT), r); continue; } r -= I_WO;
        if (r < I_HIN) { transpose_item(lds, p.hy_w_in, 1024, 4096, 4096, (bf16_t*)(p.ws + WS_HWIN), r); continue; } r -= I_HIN;
        if (r < I_HO) { transpose_item(lds, p.hy_w_out, 1024, 1024, 1024, (bf16_t*)(p.ws + WS_HWOUT), r); continue; } r -= I_HO;
        transpose_item(lds, p.f_w3, 64, 4096, 4096, (bf16_t*)(p.ws + WS_W3), r);
    }
}

DEV float wave_sum(float v) {
#pragma unroll
    for (int o = 1; o < 64; o <<= 1) v += __shfl_xor(v, o);
    return v;
}
DEV void modnorm_row(const float* xr, const float* nw, const float* shift, const float* scale, bf16_t* orow, int lane) {
    f32x4 v[4]; float s = 0.f;
#pragma unroll
    for (int j = 0; j < 4; ++j) { v[j] = *(const f32x4*)(xr + lane * 4 + 256 * j); s += v[j].x * v[j].x + v[j].y * v[j].y + v[j].z * v[j].z + v[j].w * v[j].w; }
    const float r = rsqrtf(wave_sum(s) * (1.0f / DM) + EPS);
#pragma unroll
    for (int j = 0; j < 4; ++j) { const int c0 = lane * 4 + 256 * j;
        const f32x4 w = *(const f32x4*)(nw + c0), sh = *(const f32x4*)(shift + c0), sc = *(const f32x4*)(scale + c0);
        const float o0 = v[j].x * r * w.x * (1.f + sc.x) + sh.x, o1 = v[j].y * r * w.y * (1.f + sc.y) + sh.y, o2 = v[j].z * r * w.z * (1.f + sc.z) + sh.z, o3 = v[j].w * r * w.w * (1.f + sc.w) + sh.w;
        u32x2 pk; pk.x = pk2(o0, o1); pk.y = pk2(o2, o3); *(u32x2*)(orow + c0) = pk; }
}

DEV void phase_norm0(const Params& p) {
    const int wid = threadIdx.x >> 6, lane = threadIdx.x & 63; const float* mod0 = (const float*)(p.ws + WS_MOD0); bf16_t* H0 = (bf16_t*)(p.ws + WS_H0);
    for (int row = blockIdx.x * 8 + wid; row < NALL; row += gridDim.x * 8) {
        const float* xr; int v;
        if (row < NTOK) { xr = p.x + (size_t)row * DM; v = row >> 12; } else { xr = p.ctx + (size_t)(row - NTOK) * DM; v = 8; }
        modnorm_row(xr, p.norm_w, mod0 + v * 3072, mod0 + v * 3072 + 1024, H0 + (size_t)row * DM, lane);
    }
}
DEV void phase_norm1(const Params& p) {
    const int wid = threadIdx.x >> 6, lane = threadIdx.x & 63; const float* mod1 = (const float*)(p.ws + WS_MOD1); bf16_t* H1 = (bf16_t*)(p.ws + WS_H1);
    for (int row = blockIdx.x * 8 + wid; row < NTOK; row += gridDim.x * 8) { const int v = row >> 12;
        modnorm_row(p.out + (size_t)row * DM, p.norm_w + DM, mod1 + v * 3072, mod1 + v * 3072 + 1024, H1 + (size_t)row * DM, lane); }
}
DEV void phase_final(const Params& p) {
    const int wid = threadIdx.x >> 6, lane = threadIdx.x & 63;
    for (int row = blockIdx.x * 8 + wid; row < NTOK; row += gridDim.x * 8) {
        float* xr = p.out + (size_t)row * DM; f32x4 v[4]; float s = 0.f;
#pragma unroll
        for (int j = 0; j < 4; ++j) { v[j] = *(const f32x4*)(xr + lane * 4 + 256 * j); s += v[j].x * v[j].x + v[j].y * v[j].y + v[j].z * v[j].z + v[j].w * v[j].w; }
        const float r = rsqrtf(wave_sum(s) * (1.0f / DM) + EPS);
#pragma unroll
        for (int j = 0; j < 4; ++j) { const int c0 = lane * 4 + 256 * j; const f32x4 w = *(const f32x4*)(p.final_w + c0);
            f32x4 o; o.x = v[j].x * r * w.x; o.y = v[j].y * r * w.y; o.z = v[j].z * r * w.z; o.w = v[j].w * r * w.w; *(f32x4*)(xr + c0) = o; }
    }
}

DEV void phase_post(const Params& p) {
    const int wid = threadIdx.x >> 6, lane = threadIdx.x & 63;
    const bf16_t* PRAW = (const bf16_t*)(p.ws + WS_PRAW);
    bf16_t* QA = (bf16_t*)(p.ws + WS_QA); bf16_t* KA = (bf16_t*)(p.ws + WS_KA); bf16_t* VA = (bf16_t*)(p.ws + WS_VA);
    bf16_t* CQN = (bf16_t*)(p.ws + WS_CQN); bf16_t* CKVN = (bf16_t*)(p.ws + WS_CKVN); bf16_t* G = (bf16_t*)(p.ws + WS_G); bf16_t* KM = (bf16_t*)(p.ws + WS2_KM);
    const float* rp = (const float*)(p.ws + WS_ROPE); const float *cos64 = rp, *sin64 = rp + 1024, *cos32 = rp + 2048, *sin32 = rp + 2560;
    for (int tok = blockIdx.x * 8 + wid; tok < NALL; tok += gridDim.x * 8) {
        const bool lat = tok < NTOK; int b, pos, prow = 0, pcol = 0;
        if (lat) { b = tok >> 12; const int l = tok & 4095; pos = CTXL + l; prow = l >> 6; pcol = l & 63; } else { const int j = tok - NTOK; b = j >> 8; pos = j & 255; }
        const bf16_t* pr = PRAW + (size_t)tok * AINP; const size_t kvrow = (size_t)b * LK + pos;
        float v[8], o[8];
        if (lat) {
            unpack8(*(const u32x4*)(pr + lane * 8), v);
            float ss = 0.f;
#pragma unroll
            for (int j = 0; j < 8; ++j) ss += v[j] * v[j];
            ss += __shfl_xor(ss, 1); ss += __shfl_xor(ss, 2); ss += __shfl_xor(ss, 4);
            const float r = rsqrtf(ss * (1.0f / 64.0f) + EPS); const int k = lane & 7;
#pragma unroll
            for (int j = 0; j < 8; ++j) v[j] = v[j] * r * p.q_norm[k * 8 + j];
            const int posv = (k < 4) ? prow : pcol; const int fb = posv * 16 + (k & 1) * 8;
#pragma unroll
            for (int j = 0; j < 8; ++j) { const float ot = __shfl_xor(v[j], 2); const float cs = cos64[fb + j], sn = sin64[fb + j];
                o[j] = ((k & 2) ? (v[j] * cs + ot * sn) : (v[j] * cs - ot * sn)) * QSC_A; }
            *(u32x4*)(QA + (size_t)tok * 512 + lane * 8) = pack8(o);
        }
        {
            const u32x4 raw = *(const u32x4*)(pr + 512 + lane * 8); unpack8(raw, v);
            float ss = 0.f;
#pragma unroll
            for (int j = 0; j < 8; ++j) ss += v[j] * v[j];
            ss += __shfl_xor(ss, 1); ss += __shfl_xor(ss, 2); ss += __shfl_xor(ss, 4);
            const float s8 = ss;
            ss += __shfl_xor(ss, 8); ss += __shfl_xor(ss, 16);
            const float s32 = ss;
            float vn[8]; const int k = lane & 7;
            { const float r = rsqrtf(s8 * (1.0f / 64.0f) + EPS);
#pragma unroll
                for (int j = 0; j < 8; ++j) vn[j] = v[j] * r * p.k_norm[k * 8 + j]; }
            const int posv = (k < 4) ? prow : pcol; const int fb = posv * 16 + (k & 1) * 8;
#pragma unroll
            for (int j = 0; j < 8; ++j) { const float ot = __shfl_xor(vn[j], 2); const float cs = cos64[fb + j], sn = sin64[fb + j];
                o[j] = lat ? ((k & 2) ? (vn[j] * cs + ot * sn) : (vn[j] * cs - ot * sn)) : vn[j]; }
            if (lane < 16) *(u32x4*)(KA + kvrow * 128 + lane * 8) = pack8(o);
            else if (lane < 32) *(u32x4*)(VA + kvrow * 128 + (lane - 16) * 8) = raw;
            else if (lat) { const float r = rsqrtf(s32 * (1.0f / 256.0f) + EPS); const int cb = (lane - 32) * 8;
#pragma unroll
                for (int j = 0; j < 8; ++j) o[j] = v[j] * r * p.cq_norm[cb + j];
                *(u32x4*)(CQN + (size_t)tok * 256 + cb) = pack8(o); }
        }
        {
            unpack8(*(const u32x4*)(pr + 1024 + lane * 8), v);
            float ss = 0.f;
#pragma unroll
            for (int j = 0; j < 8; ++j) ss += v[j] * v[j];
            ss += __shfl_xor(ss, 1); ss += __shfl_xor(ss, 2); ss += __shfl_xor(ss, 4); ss += __shfl_xor(ss, 8);
            const int k = lane & 3; const int posv = (k < 2) ? prow : pcol;
            float oth[8];
#pragma unroll
            for (int j = 0; j < 8; ++j) oth[j] = __shfl_xor(v[j], 1);
            if (lane < 16) { const float r = rsqrtf(ss * (1.0f / 128.0f) + EPS);
#pragma unroll
                for (int j = 0; j < 8; ++j) o[j] = v[j] * r * p.ckv_norm[lane * 8 + j];
                *(u32x4*)(CKVN + kvrow * 128 + lane * 8) = pack8(o); }
            else if (lane < 20) {
#pragma unroll
                for (int j = 0; j < 8; ++j) { const float cs = cos32[posv * 8 + j], sn = sin32[posv * 8 + j];
                    o[j] = lat ? ((k & 1) ? (v[j] * cs + oth[j] * sn) : (v[j] * cs - oth[j] * sn)) : v[j]; }
                const u32x4 w = pack8(o);
#pragma unroll
                for (int h = 0; h < 8; ++h) *(u32x4*)(KM + kvrow * 768 + h * 96 + 64 + k * 8) = w; }
            else if (lat) {
#pragma unroll
                for (int j = 0; j < 8; ++j) o[j] = silu(v[j]);
                *(u32x4*)(G + (size_t)tok * 1024 + (lane - 20) * 8) = pack8(o); }
        }
        if (lat) {
            unpack8(*(const u32x4*)(pr + 1536 + lane * 8), v);
#pragma unroll
            for (int j = 0; j < 8; ++j) o[j] = silu(v[j]);
            *(u32x4*)(G + (size_t)tok * 1024 + 352 + lane * 8) = pack8(o);
            if (lane < 20) { unpack8(*(const u32x4*)(pr + 2048 + lane * 8), v);
#pragma unroll
                for (int j = 0; j < 8; ++j) o[j] = silu(v[j]);
                *(u32x4*)(G + (size_t)tok * 1024 + 864 + lane * 8) = pack8(o); }
        }
    }
}

template <int DQK>
DEV void attn_unit(char* lds, const bf16_t* __restrict__ Q, int ldq, int qcol, const bf16_t* __restrict__ Kp, int ldk, int kcol, const bf16_t* __restrict__ Vp, int ldv, int vcol,
                   const bf16_t* __restrict__ Gt, bf16_t* OG, int ocol, int b, int q0) {
    constexpr int KRS = (DQK + 8) * 2, KB = 64 * KRS, VRS = 192, VB = 64 * VRS, STG = KB + VB, NKS = DQK / 16, KCH = DQK / 8;
    const int tid = threadIdx.x, lane = tid & 63, wid = tid >> 6, l31 = lane & 31, hi = lane >> 5;
    bf16x8 qf[NKS];
    { const bf16_t* qp = Q + (size_t)(b * SEQ + q0 + wid * 32 + l31) * ldq + qcol + hi * 8;
#pragma unroll
        for (int ks = 0; ks < NKS; ++ks) qf[ks] = *(const bf16x8*)(qp + ks * 16); }
    const bf16_t* kbase = Kp + (size_t)b * LK * ldk + kcol; const bf16_t* vbase = Vp + (size_t)b * LK * ldv + vcol;
    const int kr0 = tid / KCH, kc0 = tid % KCH;
    const int kr1 = (tid + 512) / KCH, kc1 = (tid + 512) % KCH;
    const bool k2 = (KCH * 64 > 512) && (tid + 512 < KCH * 64);
    const int vr = tid >> 3, vc = tid & 7;
    u32x4 sk0, sk1, sv;
#define A_LOAD(t) do { const size_t kp_ = (size_t)(t) * 64; sk0 = *(const u32x4*)(kbase + (kp_ + kr0) * ldk + kc0 * 8); \
        if (k2) sk1 = *(const u32x4*)(kbase + (kp_ + kr1) * ldk + kc1 * 8); sv = *(const u32x4*)(vbase + (kp_ + vr) * ldv + vc * 8); } while (0)
#define A_STORE(buf) do { char* b_ = lds + (buf) * STG; *(u32x4*)(b_ + kr0 * KRS + kc0 * 16) = sk0; if (k2) *(u32x4*)(b_ + kr1 * KRS + kc1 * 16) = sk1; \
        *(u32x4*)(b_ + KB + vr * VRS + vc * 16) = sv; } while (0)
    f32x16 o0, o1;
#pragma unroll
    for (int r = 0; r < 16; ++r) { o0[r] = 0.f; o1[r] = 0.f; }
    float m_run = -1e30f, l_run = 0.f;
    const int g1 = (lane >> 4) & 1, tq = (lane & 15) >> 2, tp = lane & 3;
    const int vt_off = KB + (4 * hi + tq) * VRS + (16 * g1 + 4 * tp) * 2;
    const int kf_off = l31 * KRS + hi * 16;
    constexpr int NT = LK / 64;
    A_LOAD(0); A_STORE(0);
    __syncthreads();
    for (int t = 0; t < NT; ++t) {
        const bool more = (t + 1 < NT);
        if (more) A_LOAD(t + 1);
        const char* b_ = lds + (t & 1) * STG;
        f32x16 p0, p1;
#pragma unroll
        for (int r = 0; r < 16; ++r) { p0[r] = 0.f; p1[r] = 0.f; }
#pragma unroll
        for (int ks = 0; ks < NKS; ++ks) {
            const bf16x8 ka = *(const bf16x8*)(b_ + kf_off + ks * 32);
            const bf16x8 kb = *(const bf16x8*)(b_ + kf_off + 32 * KRS + ks * 32);
            p0 = __builtin_amdgcn_mfma_f32_32x32x16_bf16(ka, qf[ks], p0, 0, 0, 0);
            p1 = __builtin_amdgcn_mfma_f32_32x32x16_bf16(kb, qf[ks], p1, 0, 0, 0);
        }
        float mx = p0[0];
#pragma unroll
        for (int r = 1; r < 16; ++r) mx = fmaxf(mx, p0[r]);
#pragma unroll
        for (int r = 0; r < 16; ++r) mx = fmaxf(mx, p1[r]);
        mx = fmaxf(mx, __shfl_xor(mx, 32));
        const float m_new = fmaxf(m_run, mx);
        const float alpha = __builtin_amdgcn_exp2f(m_run - m_new);
        m_run = m_new;
        float ls = 0.f;
#pragma unroll
        for (int r = 0; r < 16; ++r) { p0[r] = __builtin_amdgcn_exp2f(p0[r] - m_new); p1[r] = __builtin_amdgcn_exp2f(p1[r] - m_new); ls += p0[r] + p1[r]; }
        l_run = l_run * alpha + ls;
#pragma unroll
        for (int r = 0; r < 16; ++r) { o0[r] *= alpha; o1[r] *= alpha; }
        u32x4 pw[4];
        pw[0] = (u32x4){pk2(p0[0], p0[1]), pk2(p0[2], p0[3]), pk2(p0[4], p0[5]), pk2(p0[6], p0[7])};
        pw[1] = (u32x4){pk2(p0[8], p0[9]), pk2(p0[10], p0[11]), pk2(p0[12], p0[13]), pk2(p0[14], p0[15])};
        pw[2] = (u32x4){pk2(p1[0], p1[1]), pk2(p1[2], p1[3]), pk2(p1[4], p1[5]), pk2(p1[6], p1[7])};
        pw[3] = (u32x4){pk2(p1[8], p1[9]), pk2(p1[10], p1[11]), pk2(p1[12], p1[13]), pk2(p1[14], p1[15])};
#pragma unroll
        for (int s = 0; s < 4; ++s) {
            const bf16x8 pb = __builtin_bit_cast(bf16x8, pw[s]);
#pragma unroll
            for (int dt = 0; dt < 2; ++dt) {
                const char* vp = b_ + vt_off + s * 16 * VRS + dt * 64;
                const s16x4 lo = __builtin_bit_cast(s16x4, __builtin_amdgcn_ds_read_tr16_b64_v4i16((LAS s16x4*)vp));
                const s16x4 hh = __builtin_bit_cast(s16x4, __builtin_amdgcn_ds_read_tr16_b64_v4i16((LAS s16x4*)(vp + 8 * VRS)));
                const bf16x8 vf = (bf16x8){lo[0], lo[1], lo[2], lo[3], hh[0], hh[1], hh[2], hh[3]};
                if (dt == 0) o0 = __builtin_amdgcn_mfma_f32_32x32x16_bf16(vf, pb, o0, 0, 0, 0);
                else o1 = __builtin_amdgcn_mfma_f32_32x32x16_bf16(vf, pb, o1, 0, 0, 0);
            }
        }
        if (more) A_STORE((t + 1) & 1);
        __syncthreads();
    }
#undef A_LOAD
#undef A_STORE
    const float lt = l_run + __shfl_xor(l_run, 32); const float inv = 1.0f / lt;
    const size_t tok = (size_t)(b * SEQ + q0 + wid * 32 + l31);
#pragma unroll
    for (int dt = 0; dt < 2; ++dt)
#pragma unroll
        for (int g = 0; g < 4; ++g) { const int d = 32 * dt + 8 * g + 4 * hi; const size_t off = tok * 1024 + ocol + d;
            const u32x2 gw = *(const u32x2*)(Gt + off);
            const f32x16& oo = dt ? o1 : o0;
            u32x2 w; w.x = pk2(oo[4 * g] * inv * lo_bf(gw.x), oo[4 * g + 1] * inv * hi_bf(gw.x)); w.y = pk2(oo[4 * g + 2] * inv * lo_bf(gw.y), oo[4 * g + 3] * inv * hi_bf(gw.y));
            *(u32x2*)(OG + off) = w; }
}

DEV void phase_attn(char* lds, const Params& p) {
    const bf16_t* QA = (const bf16_t*)(p.ws + WS_QA); const bf16_t* KA = (const bf16_t*)(p.ws + WS_KA); const bf16_t* VA = (const bf16_t*)(p.ws + WS_VA);
    const bf16_t* QM = (const bf16_t*)(p.ws + WS_QM); const bf16_t* KM = (const bf16_t*)(p.ws + WS2_KM); const bf16_t* VM = (const bf16_t*)(p.ws + WS2_VM);
    const bf16_t* G = (const bf16_t*)(p.ws + WS_G); bf16_t* OG = (bf16_t*)(p.ws + WS2_OG);
    for (int u = blockIdx.x; u < 2048; u += gridDim.x) {
        const int type = u >> 10, rem = u & 1023, b = rem >> 7, h = (rem >> 4) & 7, qb = rem & 15;
        if (type == 0) attn_unit<64>(lds, QA, 512, h * 64, KA, 128, (h >> 2) * 64, VA, 128, (h >> 2) * 64, G, OG, h * 64, b, qb * 256);
        else attn_unit<96>(lds, QM, 768, h * 96, KM, 768, h * 96, VM, 512, h * 64, G, OG, 512 + h * 64, b, qb * 256);
    }
}

constexpr int CV_PADL = 192, CV_ROW = 4488, CV_RS = CV_ROW * 2;
constexpr int CV_UB = 8 * CV_RS;
constexpr int CV_FS = 16448;
DEV void conv_load_filter(char* lds, const bf16_t* gr) {
    const int tid = threadIdx.x;
#pragma unroll
    for (int rnd = 0; rnd < 2; ++rnd) {
        const int ch = tid + rnd * 512;
        const u32x4 a = *(const u32x4*)(gr + ch * 8);
        u32x4 bq = {0u, 0u, 0u, 0u}; if (ch + 1 < 1024) bq = *(const u32x4*)(gr + ch * 8 + 8);
        const unsigned w[8] = {a.x, a.y, a.z, a.w, bq.x, bq.y, bq.z, bq.w};
        char* f = lds + CV_UB + ch * 16;
        *(u32x4*)(f) = a;
        u32x4 c1, c2, c3;
        c1.x = __builtin_amdgcn_alignbit(w[1], w[0], 16); c1.y = __builtin_amdgcn_alignbit(w[2], w[1], 16); c1.z = __builtin_amdgcn_alignbit(w[3], w[2], 16); c1.w = __builtin_amdgcn_alignbit(w[4], w[3], 16);
        c2 = (u32x4){w[1], w[2], w[3], w[4]};
        c3.x = __builtin_amdgcn_alignbit(w[2], w[1], 16); c3.y = __builtin_amdgcn_alignbit(w[3], w[2], 16); c3.z = __builtin_amdgcn_alignbit(w[4], w[3], 16); c3.w = __builtin_amdgcn_alignbit(w[5], w[4], 16);
        *(u32x4*)(f + CV_FS) = c1; *(u32x4*)(f + 2 * CV_FS) = c2; *(u32x4*)(f + 3 * CV_FS) = c3;
    }
}
DEV void sconv4(const bf16_t* px, int t, float w0, float w1, float w2, float bias, float* u) {
    const u32x2 mid = *(const u32x2*)(px + t);
    const float pm = (t > 0) ? bf2f(px[t - 1]) : 0.f, pp = (t + 4 < SEQ) ? bf2f(px[t + 4]) : 0.f;
    const float q0 = lo_bf(mid.x), q1 = hi_bf(mid.x), q2 = lo_bf(mid.y), q3 = hi_bf(mid.y);
    u[0] = w0 * pm + w1 * q0 + w2 * q1 + bias; u[1] = w0 * q0 + w1 * q1 + w2 * q2 + bias; u[2] = w0 * q1 + w1 * q2 + w2 * q3 + bias; u[3] = w0 * q2 + w1 * q3 + w2 * pp + bias;
}
DEV void conv_mfma_loop(const char* lds, f32x16 (&acc)[2][2], int wid, int lane) {
    const int l31 = lane & 31, hi = lane >> 5;
#pragma unroll
    for (int a = 0; a < 2; ++a)
#pragma unroll
        for (int b = 0; b < 2; ++b)
#pragma unroll
            for (int r = 0; r < 16; ++r) acc[a][b][r] = 0.f;
    int a_off[2];
#pragma unroll
    for (int mt = 0; mt < 2; ++mt) { const int r = l31 + 32 * mt, q = (4 - (r & 3)) & 3; a_off[mt] = CV_UB + q * CV_FS + (4096 - r - q + 8 * hi) * 2; }
    int b_off[2];
#pragma unroll
    for (int n = 0; n < 2; ++n) { const int nt = 2 * wid + n; b_off[n] = (l31 & 7) * CV_RS + (CV_PADL + 64 * (4 * nt + (l31 >> 3)) + 8 * hi) * 2; }
    const int dlo = 8 * wid - 63, dhi = 8 * wid + 7;
    for (int d = dlo; d <= dhi; ++d) {
        bf16x8 fa[2][4];
#pragma unroll
        for (int mt = 0; mt < 2; ++mt)
#pragma unroll
            for (int ks = 0; ks < 4; ++ks) { const char* ap = lds + a_off[mt] - 128 * d + ks * 32;
                const u32x2 lo = *(const u32x2*)ap, hh = *(const u32x2*)(ap + 8);
                fa[mt][ks] = __builtin_bit_cast(bf16x8, (u32x4){lo.x, lo.y, hh.x, hh.y}); }
#pragma unroll
        for (int n = 0; n < 2; ++n) {
            const int nt = 2 * wid + n;
            if (d >= 4 * nt - 63 && d <= 4 * nt + 3) {
#pragma unroll
                for (int ks = 0; ks < 4; ++ks) { const bf16x8 fb = *(const bf16x8*)(lds + b_off[n] - 128 * d + ks * 32);
#pragma unroll
                    for (int mt = 0; mt < 2; ++mt) acc[n][mt] = __builtin_amdgcn_mfma_f32_32x32x16_bf16(fa[mt][ks], fb, acc[n][mt], 0, 0, 0); }
            }
        }
    }
}
DEV void conv_unit(char* lds, const Params& p, int c) {
    const int tid = threadIdx.x, lane = tid & 63, wid = tid >> 6, l31 = lane & 31, hi = lane >> 5;
    const bf16_t* PT = (const bf16_t*)(p.ws + WS_PT); const bf16_t* GR = (const bf16_t*)(p.ws + WS_GR); const float* ssum = (const float*)(p.ws + WS_SSUM);
    bf16_t* OG2 = (bf16_t*)(p.ws + WS_OG2);
    for (int i = tid; i < 8 * 98; i += 512) { const int b = i / 98, j = i % 98;
        const int e = (j < 48) ? j * 4 : (CV_PADL + SEQ + (j - 48) * 4); *(u32x2*)(lds + b * CV_RS + e * 2) = (u32x2){0u, 0u}; }
    { const float w0 = p.conv_w[c], w1 = p.conv_w[3072 + c], w2 = p.conv_w[6144 + c], bias = p.conv_b[c];
        for (int i = tid; i < 8 * 1024; i += 512) { const int b = i >> 10, t = (i & 1023) * 4; float u[4];
            sconv4(PT + ((size_t)(b * 4096 + c)) * 4096, t, w0, w1, w2, bias, u);
            u32x2 w; w.x = pk2(u[0], u[1]); w.y = pk2(u[2], u[3]); *(u32x2*)(lds + b * CV_RS + (CV_PADL + t) * 2) = w; } }
    conv_load_filter(lds, GR + (size_t)c * 8192);
    __syncthreads();
    f32x16 acc[2][2];
    conv_mfma_loop(lds, acc, wid, lane);
    __syncthreads();
    { const float invs = 1.0f / ssum[c], sk = p.skip[c];
        const float w0 = p.conv_w[1024 + c], w1 = p.conv_w[3072 + 1024 + c], w2 = p.conv_w[6144 + 1024 + c], bias = p.conv_b[1024 + c];
        const int b = l31 & 7;
#pragma unroll
        for (int n = 0; n < 2; ++n) { const int i = 4 * (2 * wid + n) + (l31 >> 3);
#pragma unroll
            for (int mt = 0; mt < 2; ++mt)
#pragma unroll
                for (int g = 0; g < 4; ++g) { const int t = 64 * i + 32 * mt + 8 * g + 4 * hi; float x1[4];
                    sconv4(PT + ((size_t)(b * 4096 + 1024 + c)) * 4096, t, w0, w1, w2, bias, x1);
                    char* up = lds + b * CV_RS + (CV_PADL + t) * 2; const u32x2 vw = *(const u32x2*)up;
                    const float z0 = x1[0] * (acc[n][mt][4 * g] * invs + sk * lo_bf(vw.x)), z1 = x1[1] * (acc[n][mt][4 * g + 1] * invs + sk * hi_bf(vw.x));
                    const float z2 = x1[2] * (acc[n][mt][4 * g + 2] * invs + sk * lo_bf(vw.y)), z3 = x1[3] * (acc[n][mt][4 * g + 3] * invs + sk * hi_bf(vw.y));
                    u32x2 w; w.x = pk2(z0, z1); w.y = pk2(z2, z3); *(u32x2*)up = w; } } }
    conv_load_filter(lds, GR + (size_t)(1024 + c) * 8192);
    __syncthreads();
    conv_mfma_loop(lds, acc, wid, lane);
    { const float invs = 1.0f / ssum[1024 + c], sk = p.skip[1024 + c];
        const float w0 = p.conv_w[2048 + c], w1 = p.conv_w[3072 + 2048 + c], w2 = p.conv_w[6144 + 2048 + c], bias = p.conv_b[2048 + c];
        const int b = l31 & 7;
#pragma unroll
        for (int n = 0; n < 2; ++n) { const int i = 4 * (2 * wid + n) + (l31 >> 3);
#pragma unroll
            for (int mt = 0; mt < 2; ++mt)
#pragma unroll
                for (int g = 0; g < 4; ++g) { const int t = 64 * i + 32 * mt + 8 * g + 4 * hi; float x2[4];
                    sconv4(PT + ((size_t)(b * 4096 + 2048 + c)) * 4096, t, w0, w1, w2, bias, x2);
                    const u32x2 zw = *(const u32x2*)(lds + b * CV_RS + (CV_PADL + t) * 2);
                    const u32x2 gw = *(const u32x2*)(PT + ((size_t)(b * 4096 + 3072 + c)) * 4096 + t);
                    const float y0 = x2[0] * (acc[n][mt][4 * g] * invs + sk * lo_bf(zw.x)) * silu(lo_bf(gw.x)), y1 = x2[1] * (acc[n][mt][4 * g + 1] * invs + sk * hi_bf(zw.x)) * silu(hi_bf(gw.x));
                    const float y2 = x2[2] * (acc[n][mt][4 * g + 2] * invs + sk * lo_bf(zw.y)) * silu(lo_bf(gw.y)), y3 = x2[3] * (acc[n][mt][4 * g + 3] * invs + sk * hi_bf(zw.y)) * silu(hi_bf(gw.y));
                    u32x2 w; w.x = pk2(y0, y1); w.y = pk2(y2, y3); *(u32x2*)(OG2 + ((size_t)(b * 1024 + c)) * 4096 + t) = w; } } }
    __syncthreads();
}

#define XB_TMO      128
#define XB_XCNT(j)  (256  + 64 * (j))
#define XB_XSUB(j)  (1280 + 64 * (j))
#define XB_XGEN(j)  (2304 + 64 * (j))
#define XB_TOP      3328
#define XB_TOPGEN   3392
#define XCD_BAR_WORDS 3456
#define XB_SPIN_CAP (1u << 20)
DEV unsigned xb_ld(unsigned* p) { return __hip_atomic_load(p, __ATOMIC_RELAXED, __HIP_MEMORY_SCOPE_AGENT); }
DEV unsigned xb_add(unsigned* p, unsigned v) { return __hip_atomic_fetch_add(p, v, __ATOMIC_RELAXED, __HIP_MEMORY_SCOPE_AGENT); }
DEV unsigned xb_xcc_id() { return (unsigned)__builtin_amdgcn_s_getreg((3 << 11) | 20) & 0xFu; }
#define XB_SPIN(cond, bar) do { unsigned _sp = 0; while (cond) { __builtin_amdgcn_s_sleep(1); \
    if ((++_sp & 255u) == 0u) { if (xb_ld(&(bar)[XB_TMO])) break; if (_sp > XB_SPIN_CAP) { atomicAdd(&(bar)[XB_TMO], 1u); break; } } } } while (0)
struct XcdBarrier { unsigned* bar; unsigned x; volatile LAS unsigned* st; };
DEV XcdBarrier xcd_barrier_post(unsigned* bar, volatile LAS unsigned* st) {
    XcdBarrier b; b.bar = bar; b.x = xb_xcc_id(); b.st = st;
    if (threadIdx.x == 0) (void)xb_add(&bar[XB_XCNT(b.x)], 1u);
    return b;
}
DEV void xcd_barrier_complete(unsigned* bar, unsigned x, unsigned& nloc, unsigned& nx) {
    const unsigned G = gridDim.x * gridDim.y * gridDim.z;
    unsigned sum, cnt, mine, sp = 0u;
    for (;;) {
        sum = 0u; cnt = 0u; mine = 0u;
#pragma unroll
        for (unsigned j = 0; j < 16; ++j) { const unsigned c = xb_ld(&bar[XB_XCNT(j)]); sum += c; cnt += (c > 0u) ? 1u : 0u; mine = (j == x) ? c : mine; }
        if (sum == G) break;
        __builtin_amdgcn_s_sleep(1);
        if ((++sp & 255u) == 0u) { if (xb_ld(&bar[XB_TMO])) break; if (sp > XB_SPIN_CAP) { atomicAdd(&bar[XB_TMO], 1u); break; } }
    }
    nloc = mine > 0u ? mine : 1u; nx = cnt > 0u ? cnt : 1u;
}
DEV void xcd_barrier(const XcdBarrier& b) {
    asm volatile("s_waitcnt vmcnt(0)" ::: "memory");
    __syncthreads();
    if (threadIdx.x == 0) {
        unsigned* bar = b.bar;
        __builtin_amdgcn_s_waitcnt(0);
        unsigned nloc = b.st[0], nx = b.st[1];
        if (nloc == 0u) { xcd_barrier_complete(bar, b.x, nloc, nx); b.st[0] = nloc; b.st[1] = nx; }
        const unsigned old = xb_add(&bar[XB_XSUB(b.x)], 1u);
        const unsigned gen = old / nloc;
        if (old + 1u == (gen + 1u) * nloc) {
            __builtin_amdgcn_fence(__ATOMIC_RELEASE, "agent");
            asm volatile("s_waitcnt vmcnt(0)" ::: "memory");
            const unsigned og = xb_add(&bar[XB_TOP], 1u);
            const unsigned tg = og / nx;
            if (og + 1u == (tg + 1u) * nx) xb_add(&bar[XB_TOPGEN], 1u);
            else XB_SPIN(xb_ld(&bar[XB_TOPGEN]) == tg, bar);
            __builtin_amdgcn_fence(__ATOMIC_ACQUIRE, "agent");
            xb_add(&bar[XB_XGEN(b.x)], 1u);
            asm volatile("s_waitcnt vmcnt(0)" ::: "memory");
        } else {
            XB_SPIN(xb_ld(&bar[XB_XGEN(b.x)]) == gen, bar);
            __builtin_amdgcn_fence(__ATOMIC_ACQUIRE, "agent");
            asm volatile("s_waitcnt vmcnt(0)" ::: "memory");
        }
    }
    __syncthreads();
}

constexpr int NPHASE = 12;
__global__ void __launch_bounds__(512) fwd_kernel(Params p) {
    extern __shared__ __attribute__((aligned(16))) char lds[];
    char* ws = p.ws;
    volatile LAS unsigned* bst = (volatile LAS unsigned*)(LAS char*)(lds + LDS_BYTES - 64);
    if (threadIdx.x < 16) bst[threadIdx.x] = 0u;
    __syncthreads();
    XcdBarrier xbar; xbar.bar = (unsigned*)(ws + WS_CTL); xbar.x = 0; xbar.st = bst;
    if (MK_LAUNCHES == 1) xbar = xcd_barrier_post((unsigned*)(ws + WS_CTL), bst);
#define SEAM(k) do { if (MK_LAUNCHES == 1 && (k) + 1 < p.ph_hi) { if ((k) == 0) cg::this_grid().sync(); else xcd_barrier(xbar); } } while (0)
#define IN(k) (p.ph_lo <= (k) && (k) < p.ph_hi)
#define REP(k) for (int rep_ = 0; rep_ < ((PROBE_REPEAT == (k)) ? 2 : 1); ++rep_)
    if (IN(0)) { REP(0) phase_prep(lds, p); SEAM(0); }
    if (IN(1)) {
        EpiFilt ef{(bf16_t*)(ws + WS_GR), (float*)(ws + WS_SSUM), p.f_b3};
        gemm_phase<false, EpiFilt>(lds, (const bf16_t*)(ws + WS_W3), 64, (const bf16_t*)(ws + WS_HID2), 64, 4096, 4096, 64, ef);
        phase_norm0(p); SEAM(1); }
    if (IN(2)) {
        EpiRaw e{(bf16_t*)(ws + WS_PRAW), (size_t)AINP};
        REP(2) gemm_phase<false, EpiRaw>(lds, (const bf16_t*)(ws + WS_H0), DM, (const bf16_t*)(ws + WS_WIN), DM, NALL, AINP, DM, e); SEAM(2); }
    if (IN(3)) { REP(3) phase_post(p); SEAM(3); }
    if (IN(4)) {
        const float* rp = (const float*)(ws + WS_ROPE);
        REP(4) {
        EpiUq eq{(bf16_t*)(ws + WS_QM), rp + 2048, rp + 2560};
        gemm_phase<false, EpiUq>(lds, (const bf16_t*)(ws + WS_CQN), 256, (const bf16_t*)(ws + WS_WUQ), 256, NTOK, 768, 256, eq);
        EpiUkv ek{(bf16_t*)(ws + WS2_KM), (bf16_t*)(ws + WS2_VM)};
        gemm_phase<false, EpiUkv>(lds, (const bf16_t*)(ws + WS_CKVN), 128, (const bf16_t*)(ws + WS_WUKV), 128, NALL, 1024, 128, ek); }
        SEAM(4); }
    if (IN(5)) { REP(5) phase_attn(lds, p); SEAM(5); }
    if (IN(6)) {
        EpiRes e{p.x, p.out, (const float*)(ws + WS_MOD0), (DBG_SKIP & 1) ? 0.f : 1.f};
        REP(6) gemm_phase<false, EpiRes>(lds, (const bf16_t*)(ws + WS2_OG), DM, (const bf16_t*)(ws + WS_WOUT), DM, NTOK, DM, DM, e); SEAM(6); }
    if (IN(7)) { REP(7) phase_norm1(p); SEAM(7); }
    if (IN(8)) {
        EpiPT e{(bf16_t*)(ws + WS_PT)};
        REP(8) gemm_phase<false, EpiPT>(lds, (const bf16_t*)(ws + WS_HWIN), DM, (const bf16_t*)(ws + WS_H1), DM, 4096, NTOK, DM, e); SEAM(8); }
    if (IN(9)) { REP(9) for (int c = blockIdx.x; c < 1024; c += gridDim.x) conv_unit(lds, p, c); SEAM(9); }
    if (IN(10)) {
        EpiRes e{p.out, p.out, (const float*)(ws + WS_MOD1), (DBG_SKIP & 2) ? 0.f : 1.f};
        const bf16_t* OG2 = (const bf16_t*)(ws + WS_OG2); const bf16_t* W = (const bf16_t*)(ws + WS_HWOUT);
        const int nt = (NTOK / 256) * (DM / 128);
        for (int t = blockIdx.x; t < nt; t += gridDim.x) { const int ti = t / 8, tj = t % 8; const int b = ti >> 4, l0 = (ti & 15) * 256;
            gemm_tile<true, EpiRes>(lds, OG2 + (size_t)b * 1024 * 4096 + l0, 4096, W + (size_t)tj * 128 * DM, DM, DM, e, ti * 256, tj * 128); }
        SEAM(10); }
    if (IN(11)) { phase_final(p); }
#undef SEAM
#undef IN
}

extern "C" void kernel_launch(void* const* d_in, const int* in_sizes, int n_in, void* d_out, int out_size, void* d_ws, size_t ws_size, hipStream_t stream) {
    static int grid = 0;
    if (grid == 0) {
        if (n_in != 28 || out_size != NTOK * DM || ws_size < WS_END) { fprintf(stderr, "kernel_launch: unexpected shapes n_in %d out %d ws %zu\n", n_in, out_size, ws_size); grid = -1; return; }
        int dev = 0, cus = 0, per_cu = 0;
        hipGetDevice(&dev); hipDeviceGetAttribute(&cus, hipDeviceAttributeMultiprocessorCount, dev);
        if (hipFuncSetAttribute((const void*)fwd_kernel, hipFuncAttributeMaxDynamicSharedMemorySize, LDS_BYTES) != hipSuccess) { fprintf(stderr, "hipFuncSetAttribute failed\n"); grid = -1; return; }
        hipOccupancyMaxActiveBlocksPerMultiprocessor(&per_cu, (const void*)fwd_kernel, 512, LDS_BYTES);
        if (per_cu < 1) { fprintf(stderr, "occupancy query says %d\n", per_cu); per_cu = 1; }
        grid = cus * 1;
        (void)hipGetLastError();
    }
    if (grid < 0) return;
    Params p{};
    const float** pp = (const float**)&p;
    for (int i = 0; i < 28; ++i) pp[i] = (const float*)d_in[i];
    p.out = (float*)d_out; p.ws = (char*)d_ws;
#if MK_LAUNCHES == 1
    if (hipMemsetAsync((char*)d_ws + WS_CTL, 0, CTL_BYTES, stream) != hipSuccess) { fprintf(stderr, "memset failed\n"); return; }
    p.ph_lo = 0; p.ph_hi = NPHASE;
    void* args[] = {&p};
    hipError_t e = hipLaunchCooperativeKernel((const void*)fwd_kernel, dim3(grid), dim3(512), args, LDS_BYTES, stream);
    if (e != hipSuccess) fprintf(stderr, "cooperative launch failed: %s (grid %d)\n", hipGetErrorString(e), grid);
#else
    for (int k = 0; k < NPHASE; ++k) { p.ph_lo = k; p.ph_hi = k + 1; hipLaunchKernelGGL(fwd_kernel, dim3(grid), dim3(512), LDS_BYTES, stream, p); }
#endif
}
```

```cpp
#include <hip/hip_runtime.h>
#include <hip/hip_cooperative_groups.h>
#include <cstdio>
#include <cstdint>
namespace cg = cooperative_groups;

#ifndef MK_LAUNCHES
#define MK_LAUNCHES 1
#endif

#ifndef PROBE_REPEAT
#define PROBE_REPEAT -1
#endif
#ifndef DBG_SKIP
#define DBG_SKIP 0
#endif
#define DEV __device__ __forceinline__
typedef unsigned short bf16_t;
typedef short bf16x8 __attribute__((ext_vector_type(8)));
typedef short s16x4 __attribute__((ext_vector_type(4)));
typedef float f32x16 __attribute__((ext_vector_type(16)));
typedef float f32x4 __attribute__((ext_vector_type(4)));
typedef float f32x2 __attribute__((ext_vector_type(2)));
typedef unsigned u32x4 __attribute__((ext_vector_type(4)));
typedef unsigned u32x2 __attribute__((ext_vector_type(2)));
typedef __bf16 bf16x2_t __attribute__((ext_vector_type(2)));
#define LAS __attribute__((address_space(3)))

constexpr int NB = 8, SEQ = 4096, DM = 1024, CTXL = 256, LK = SEQ + CTXL;
constexpr int NTOK = NB * SEQ, NCTX = NB * CTXL, NALL = NTOK + NCTX;
constexpr int AIN = 2208, AINP = 2304;
constexpr float EPS = 1e-6f;
constexpr float LOG2E = 1.4426950408889634f;
constexpr float QSC_A = 0.125f * LOG2E;
constexpr float QSC_M = 0.10206207261596575f * LOG2E;

constexpr size_t MiB = 1ull << 20;
constexpr size_t WS_WIN = 0;
constexpr size_t WS_WUQ = 5 * MiB;
constexpr size_t WS_WUKV = 6 * MiB;
constexpr size_t WS_WOUT = 7 * MiB;
constexpr size_t WS_HWIN = 9 * MiB;
constexpr size_t WS_HWOUT = 17 * MiB;
constexpr size_t WS_W3 = 19 * MiB;
constexpr size_t WS_HID2 = 20 * MiB;
constexpr size_t WS_MOD0 = 21 * MiB;
constexpr size_t WS_MOD1 = WS_MOD0 + 9 * 3072 * 4;
constexpr size_t WS_SSUM = WS_MOD1 + 8 * 3072 * 4;
constexpr size_t WS_ROPE = WS_SSUM + 2048 * 4;
constexpr size_t WS_GR = 22 * MiB;
constexpr size_t WS_H0 = 64 * MiB;
constexpr size_t WS_PRAW = 136 * MiB;
constexpr size_t WS_QA = 297 * MiB;
constexpr size_t WS_KA = 329 * MiB;
constexpr size_t WS_VA = 338 * MiB;
constexpr size_t WS_CQN = 347 * MiB;
constexpr size_t WS_CKVN = 363 * MiB;
constexpr size_t WS_G = 372 * MiB;
constexpr size_t WS_QM = 64 * MiB;
constexpr size_t WS_KM = 136 * MiB;
constexpr size_t WS_VM = 190 * MiB;
constexpr size_t WS_OG = 226 * MiB;
constexpr size_t WS_H1 = 436 * MiB;
constexpr size_t WS_PT = 64 * MiB;
constexpr size_t WS_OG2 = 320 * MiB;
constexpr size_t WS_CTL = 500 * MiB;
constexpr size_t CTL_BYTES = 16384;
constexpr size_t WS_END = 500 * MiB + CTL_BYTES;
constexpr size_t WS2_KM = 436 * MiB;
constexpr size_t WS2_VM = 190 * MiB;
constexpr size_t WS2_OG = 226 * MiB;

constexpr int LDS_BYTES = 150 * 1024;

DEV float bf2f(bf16_t v) { return __uint_as_float(((unsigned)v) << 16); }
DEV unsigned pk2(float lo, float hi) { f32x2 v = {lo, hi}; bf16x2_t b = __builtin_convertvector(v, bf16x2_t); return __builtin_bit_cast(unsigned, b); }
DEV bf16_t f2bf(float f) { return (bf16_t)(pk2(f, 0.f) & 0xffffu); }
DEV float lo_bf(unsigned w) { return __uint_as_float(w << 16); }
DEV float hi_bf(unsigned w) { return __uint_as_float(w & 0xffff0000u); }
DEV int crow(int r, int hi) { return (r & 3) + 8 * (r >> 2) + 4 * hi; }
DEV float silu(float v) { return v / (1.f + __expf(-v)); }
DEV void unpack8(const u32x4 w, float* v) { v[0] = lo_bf(w.x); v[1] = hi_bf(w.x); v[2] = lo_bf(w.y); v[3] = hi_bf(w.y); v[4] = lo_bf(w.z); v[5] = hi_bf(w.z); v[6] = lo_bf(w.w); v[7] = hi_bf(w.w); }
DEV u32x4 pack8(const float* v) { u32x4 w; w.x = pk2(v[0], v[1]); w.y = pk2(v[2], v[3]); w.z = pk2(v[4], v[5]); w.w = pk2(v[6], v[7]); return w; }

struct Params {
    const float *x, *c, *ctx, *c_ctx, *ada_w, *ada_b, *norm_w, *w_in, *q_norm, *k_norm, *cq_norm, *ckv_norm, *w_uq, *w_ukv, *w_out,
        *hy_w_in, *conv_w, *conv_b, *f_w1, *f_b1, *f_w2, *f_b2, *f_w3, *f_b3, *freq, *skip, *hy_w_out, *final_w;
    float* out; char* ws; int ph_lo, ph_hi;
};

constexpr int G_RS = 144;
constexpr int G_RB = 256 * G_RS, G_CB = 128 * G_RS, G_STAGE = G_RB + G_CB;
constexpr int T_RS = 576;

template <bool TR, class Epi>
DEV void gemm_tile(char* lds, const bf16_t* __restrict__ R, size_t ldr, const bf16_t* __restrict__ C, size_t ldc, int K, const Epi& epi, int ti0, int tj0) {
    const int tid = threadIdx.x, lane = tid & 63, wid = tid >> 6;
    const int wi = wid >> 1, wj = wid & 1, l31 = lane & 31, hi = lane >> 5;
    f32x16 acc[2][2];
#pragma unroll
    for (int a = 0; a < 2; ++a)
#pragma unroll
        for (int b = 0; b < 2; ++b)
#pragma unroll
            for (int r = 0; r < 16; ++r) acc[a][b][r] = 0.f;
    u32x4 rr[4], rc[2];
    const bf16_t* Rp; const bf16_t* Cp; int rl_off, cl_off;
    if (TR) { const int c = tid & 31, kr = tid >> 5; Rp = R + (size_t)kr * ldr + c * 8; rl_off = kr * T_RS + c * 16; }
    else { const int lr = tid >> 3, lc = tid & 7; Rp = R + (size_t)lr * ldr + lc * 8; rl_off = lr * G_RS + lc * 16; }
    { const int lr = tid >> 3, lc = tid & 7; Cp = C + (size_t)lr * ldc + lc * 8; cl_off = lr * G_RS + lc * 16; }
    const int nk = K / 64;
    int ra_off[2], cb_off[2];
#pragma unroll
    for (int t = 0; t < 2; ++t) {
        if (TR) { const int g1 = (lane >> 4) & 1, q = (lane & 15) >> 2, p = lane & 3; ra_off[t] = (8 * hi + q) * T_RS + (wi * 64 + t * 32 + 16 * g1 + 4 * p) * 2; }
        else ra_off[t] = (wi * 64 + t * 32 + l31) * G_RS + hi * 16;
        cb_off[t] = G_RB + (wj * 64 + t * 32 + l31) * G_RS + hi * 16;
    }
#define G_LOAD(kt) do { \
        if (TR) { _Pragma("unroll") for (int p = 0; p < 4; ++p) rr[p] = *(const u32x4*)(Rp + ((size_t)(kt) * 64 + 16 * p) * ldr); } \
        else { _Pragma("unroll") for (int p = 0; p < 4; ++p) rr[p] = *(const u32x4*)(Rp + (size_t)(64 * p) * ldr + (kt) * 64); } \
        _Pragma("unroll") for (int p = 0; p < 2; ++p) rc[p] = *(const u32x4*)(Cp + (size_t)(64 * p) * ldc + (kt) * 64); } while (0)
#define G_STORE(buf) do { char* b_ = lds + (buf) * G_STAGE; \
        if (TR) { _Pragma("unroll") for (int p = 0; p < 4; ++p) *(u32x4*)(b_ + rl_off + 16 * p * T_RS) = rr[p]; } \
        else { _Pragma("unroll") for (int p = 0; p < 4; ++p) *(u32x4*)(b_ + rl_off + 64 * p * G_RS) = rr[p]; } \
        _Pragma("unroll") for (int p = 0; p < 2; ++p) *(u32x4*)(b_ + G_RB + cl_off + 64 * p * G_RS) = rc[p]; } while (0)
    G_LOAD(0); G_STORE(0);
    __syncthreads();
    for (int kt = 0; kt < nk; ++kt) {
        const bool more = (kt + 1 < nk);
        if (more) G_LOAD(kt + 1);
        const char* b_ = lds + (kt & 1) * G_STAGE;
#pragma unroll
        for (int ks = 0; ks < 4; ++ks) {
            bf16x8 fa[2], fb[2];
#pragma unroll
            for (int t = 0; t < 2; ++t) {
                if (TR) {
                    const s16x4 lo = __builtin_bit_cast(s16x4, __builtin_amdgcn_ds_read_tr16_b64_v4i16((LAS s16x4*)(b_ + ra_off[t] + ks * 16 * T_RS)));
                    const s16x4 hh = __builtin_bit_cast(s16x4, __builtin_amdgcn_ds_read_tr16_b64_v4i16((LAS s16x4*)(b_ + ra_off[t] + (ks * 16 + 4) * T_RS)));
                    fa[t] = (bf16x8){lo[0], lo[1], lo[2], lo[3], hh[0], hh[1], hh[2], hh[3]};
                } else fa[t] = *(const bf16x8*)(b_ + ra_off[t] + ks * 32);
                fb[t] = *(const bf16x8*)(b_ + cb_off[t] + ks * 32);
            }
#pragma unroll
            for (int a = 0; a < 2; ++a)
#pragma unroll
                for (int b = 0; b < 2; ++b) acc[a][b] = __builtin_amdgcn_mfma_f32_32x32x16_bf16(fa[a], fb[b], acc[a][b], 0, 0, 0);
        }
        if (more) G_STORE((kt + 1) & 1);
        __syncthreads();
    }
#undef G_LOAD
#undef G_STORE
#pragma unroll
    for (int a = 0; a < 2; ++a)
#pragma unroll
        for (int b = 0; b < 2; ++b) epi(ti0 + wi * 64 + a * 32, tj0 + wj * 64 + b * 32, acc[a][b], l31, hi);
}

template <bool TR, class Epi>
DEV void gemm_phase(char* lds, const bf16_t* R, size_t ldr, const bf16_t* C, size_t ldc, int nI, int nJ, int K, const Epi& epi) {
    const int tI = nI / 256, tJ = nJ / 128, nt = tI * tJ;
    for (int t = blockIdx.x; t < nt; t += gridDim.x) {
        const int ti = t / tJ, tj = t % tJ;
        gemm_tile<TR, Epi>(lds, R + (size_t)ti * 256 * ldr, ldr, C + (size_t)tj * 128 * ldc, ldc, K, epi, ti * 256, tj * 128);
    }
}

struct EpiRaw {
    bf16_t* O; size_t ld;
    DEV void operator()(int i0, int j0, const f32x16& a, int l31, int hi) const {
#pragma unroll
        for (int r = 0; r < 16; ++r) O[(size_t)(i0 + crow(r, hi)) * ld + j0 + l31] = f2bf(a[r]);
    }
};
struct EpiUq {
    bf16_t* QM; const float* cos32; const float* sin32;
    DEV void operator()(int i0, int j0, const f32x16& a, int l31, int hi) const {
        const bool pe = (j0 % 96) == 64;
        const int fi = l31 & 7; const bool colang = (l31 & 16) != 0; const bool bpart = (l31 & 8) != 0;
#pragma unroll
        for (int r = 0; r < 16; ++r) {
            const int tok = i0 + crow(r, hi); float v = a[r];
            const float o = __shfl_xor(v, 8);
            if (pe) { const int l = tok & (SEQ - 1); const int pos = colang ? (l & 63) : (l >> 6);
                const float cs = cos32[pos * 8 + fi], sn = sin32[pos * 8 + fi];
                v = bpart ? (v * cs + o * sn) : (v * cs - o * sn); }
            QM[(size_t)tok * 768 + j0 + l31] = f2bf(v * QSC_M);
        }
    }
};
struct EpiUkv {
    bf16_t* KM; bf16_t* VM;
    DEV void operator()(int i0, int j0, const f32x16& a, int l31, int hi) const {
        const int h = j0 >> 7, e = (j0 & 127) + l31;
#pragma unroll
        for (int r = 0; r < 16; ++r) { const size_t row = (size_t)(i0 + crow(r, hi));
            if (e < 64) KM[row * 768 + h * 96 + e] = f2bf(a[r]); else VM[row * 512 + h * 64 + (e - 64)] = f2bf(a[r]); }
    }
};
struct EpiRes {
    const float* base; float* out; const float* mod; float gmul;
    DEV void operator()(int i0, int j0, const f32x16& a, int l31, int hi) const {
        const int b = i0 >> 12; const float g = mod[b * 3072 + 2048 + j0 + l31] * gmul;
#pragma unroll
        for (int h8 = 0; h8 < 2; ++h8) { float bv[8];
#pragma unroll
            for (int r = 0; r < 8; ++r) bv[r] = base[(size_t)(i0 + crow(8 * h8 + r, hi)) * DM + j0 + l31];
#pragma unroll
            for (int r = 0; r < 8; ++r) out[(size_t)(i0 + crow(8 * h8 + r, hi)) * DM + j0 + l31] = bv[r] + g * a[8 * h8 + r]; }
    }
};
struct EpiPT {
    bf16_t* PT;
    DEV void operator()(int i0, int j0, const f32x16& a, int l31, int hi) const {
        const int b = j0 >> 12, l = (j0 & 4095) + l31;
#pragma unroll
        for (int r = 0; r < 16; ++r) PT[((size_t)(b * 4096 + i0 + crow(r, hi))) * 4096 + l] = f2bf(a[r]);
    }
};
struct EpiFilt {
    bf16_t* GR; float* ssum; const float* b3;
    DEV void operator()(int i0, int j0, const f32x16& a, int l31, int hi) const {
        const int t = j0 + l31; const float tn = (float)t * (1.0f / 4095.0f);
        const float dmin = -3.0701134573253945f, dmax = -15.350567286626973f;
#pragma unroll
        for (int r = 0; r < 16; ++r) {
            const int n = i0 + crow(r, hi); const int c = n & 1023, od = n >> 10, o = od >> 1, dir = od & 1;
            const float delta = fabsf(dmin + (float)c * ((dmax - dmin) / 1023.0f));
            float v = (a[r] + b3[n]) * __expf(-tn * delta);
            bf16_t* g = GR + ((size_t)(o * 1024 + c)) * 8192;
            if (dir == 0) g[4096 - t] = f2bf(v);
            else { if (t == 0) { g[0] = 0; v = 0.f; } else g[4096 + t] = f2bf(v); }
            float s = fabsf(v);
            s += __shfl_xor(s, 16); s += __shfl_xor(s, 8); s += __shfl_xor(s, 4); s += __shfl_xor(s, 2); s += __shfl_xor(s, 1);
            if (l31 == 0) atomicAdd(ssum + o * 1024 + c, s);
        }
    }
};

namespace pg8 {
#define PG8_LAS __attribute__((address_space(3)))
typedef short bf16x8 __attribute__((ext_vector_type(8)));
typedef float f32x4 __attribute__((ext_vector_type(4)));
typedef unsigned u32x4 __attribute__((ext_vector_type(4)));
constexpr int BM = 256, BK = 64, HALF = 128, HTB = HALF * BK * 2  , STAGE_BYTES = 8 * HTB, NXCD = 8, WGM = 8;

__host__ __device__ __forceinline__ int lds_byte(int r, int c) { const int st = (r >> 4) * 2 + (c >> 5), rr = r & 15, cc = c & 31, ob = rr * 64 + cc * 2; return st * 1024 + (ob ^ (((ob >> 9) & 1) << 5)); }
__host__ __device__ __forceinline__ void stage_rc(int b, int& R, int& C) { const int st = b / 1024, sb = b % 1024, swz = sb ^ (((sb >> 9) & 1) << 5); R = (st >> 1) * 16 + swz / 64; C = (st & 1) * 32 + (swz % 64) / 2; }
__host__ __device__ __forceinline__ int perm32(int rho) { const int n = rho >> 4, i = rho & 15; return 8 * (i >> 2) + 4 * n + (i & 3); }

struct Unit { int pm, pn; };
struct Gemm { const bf16_t* A; const bf16_t* Bt; int M, N, K; };

struct StaticOrder {
    int nM, nN, nwg, G, c;
    __host__ __device__ void init(int M, int N, int G_, int c_) { nM = M / BM; nN = N / BM; nwg = nM * nN; G = G_; c = c_; }
    __host__ __device__ bool next(int i, Unit& u) const {
        const long L = (long)i * G + c; if (L >= nwg) return false;
        int wgid = (int)L; { const int q = nwg / NXCD, r = nwg % NXCD, xcd = wgid % NXCD, off = wgid / NXCD; wgid = (xcd < r ? xcd * (q + 1) : r * (q + 1) + (xcd - r) * q) + off; }
        const int nig = WGM * nN, gid = wgid / nig, fm = gid * WGM, gsz = (nM - fm) < WGM ? (nM - fm) : WGM;
        u.pm = fm + ((wgid % nig) % gsz); u.pn = (wgid % nig) / gsz; return true;
    }
    __device__ __forceinline__ void a_ready(const Unit&) const {}
    __device__ __forceinline__ void done(const Unit&) const {}
};

__device__ __forceinline__ unsigned cvt_pk_bf16(float lo, float hi) { unsigned r; asm volatile("v_cvt_pk_bf16_f32 %0, %1, %2" : "=v"(r) : "v"(lo), "v"(hi)); return r; }
typedef float f32x2 __attribute__((ext_vector_type(2)));

struct EpiBf16 {
    static constexpr bool PERM = true, AFTER_DRAIN = false;
    bf16_t* O; size_t ldc; int split_cols; size_t split_stride;
    __device__ __forceinline__ void operator()(const f32x4 (&acc)[2][2][4][2], const Unit& u, int wr, int wc, int fr, int fq) const {
        const int row0 = u.pm * BM + wr * 64 + fr; int colt = u.pn * BM; bf16_t* base = O;
        if (split_cols) { const int t = colt / split_cols; base += (size_t)t * split_stride; colt -= t * split_cols; }
        const int col0 = colt + wc * 32 + 8 * fq;
#pragma unroll
        for (int ai = 0; ai < 2; ++ai)
#pragma unroll
            for (int m = 0; m < 4; ++m) { bf16_t* rowp = base + (size_t)(row0 + ai * HALF + m * 16) * ldc + col0;
#pragma unroll
                for (int bj = 0; bj < 2; ++bj) { const f32x4 v0 = acc[ai][bj][m][0], v1 = acc[ai][bj][m][1];
                    u32x4 w; w.x = cvt_pk_bf16(v0[0], v0[1]); w.y = cvt_pk_bf16(v0[2], v0[3]); w.z = cvt_pk_bf16(v1[0], v1[1]); w.w = cvt_pk_bf16(v1[2], v1[3]);
                    *(u32x4*)(rowp + bj * HALF) = w; } }
    }
};
struct EpiResF32 {
    static constexpr bool PERM = false, AFTER_DRAIN = false;
    const float* base; float* out; const float* mod; float gmul;
    __device__ __forceinline__ void operator()(const f32x4 (&acc)[2][2][4][2], const Unit& u, int wr, int wc, int fr, int fq) const {
        const int row0 = u.pm * BM + wr * 64 + fr, col0 = u.pn * BM + wc * 32 + 4 * fq, b = (u.pm * BM) >> 12;
        f32x4 g[2][2];
#pragma unroll
        for (int bj = 0; bj < 2; ++bj)
#pragma unroll
            for (int n = 0; n < 2; ++n) g[bj][n] = *(const f32x4*)(mod + b * 3072 + 2048 + col0 + bj * HALF + n * 16) * gmul;
#pragma unroll
        for (int ai = 0; ai < 2; ++ai) {
            f32x4 pre[4][2][2];
#pragma unroll
            for (int m = 0; m < 4; ++m) { const size_t off = (size_t)(row0 + ai * HALF + m * 16) * 1024 + col0;
#pragma unroll
                for (int bj = 0; bj < 2; ++bj)
#pragma unroll
                    for (int n = 0; n < 2; ++n) pre[m][bj][n] = *(const f32x4*)(base + off + bj * HALF + n * 16); }
#pragma unroll
            for (int m = 0; m < 4; ++m) { const size_t off = (size_t)(row0 + ai * HALF + m * 16) * 1024 + col0;
#pragma unroll
                for (int bj = 0; bj < 2; ++bj)
#pragma unroll
                    for (int n = 0; n < 2; ++n) *(f32x4*)(out + off + bj * HALF + n * 16) = pre[m][bj][n] + g[bj][n] * acc[ai][bj][m][n]; }
        }
    }
};
template <class Epi, class Sched, bool ALIGN_EPI = false, bool SP2 = false>
__device__ __forceinline__ void gemm_phase(PG8_LAS unsigned char* lds, const Gemm g, const Sched& S, const Epi& E) {
    const int tid = threadIdx.x, wid = __builtin_amdgcn_readfirstlane(tid >> 6), lane = tid & 63, wr = wid >> 2, wc = wid & 3, fr = lane & 15, fq = lane >> 4;
    const int K = g.K, nt = K / BK;
    unsigned voffA[2], voffB[2];
#pragma unroll
    for (int i = 0; i < 2; ++i) { int R, C; stage_rc(tid * 16 + i * 8192, R, C); const int Rb = Epi::PERM ? ((R & ~31) + perm32(R & 31)) : R;
        voffA[i] = (unsigned)(R * K + C) * 2u; voffB[i] = (unsigned)(Rb * K + C) * 2u; }
    const size_t kstep = (size_t)(BK * 2);
    const size_t hstep = (size_t)HALF * K * 2;
    const size_t tstep = 2 * hstep;
    const unsigned ldsw = (unsigned)wid * 1024u;
    const int aoff = lds_byte(wr * 64 + fr, fq * 8), boff = lds_byte(wc * 32 + fr, fq * 8);
#define PG8_SA(b, h) (((b) * 2 + (h)) * HTB)
#define PG8_SB(b, h) ((4 + (b) * 2 + (h)) * HTB)
#define PG8_STAGE(bufoff, gbase, voff) do { _Pragma("unroll") for (int _i = 0; _i < 2; ++_i) \
        __builtin_amdgcn_global_load_lds((const unsigned*)((const char*)(gbase) + (voff)[_i]), (PG8_LAS unsigned*)(lds + (bufoff) + ldsw + _i * 8192), 16, 0, 0); } while (0)
#define PG8_LDA(dst, b, h) do { _Pragma("unroll") for (int m = 0; m < 4; ++m) _Pragma("unroll") for (int k = 0; k < 2; ++k) dst[m][k] = *(const PG8_LAS bf16x8*)(lds + PG8_SA(b, h) + aoff + m * 2048 + k * 1024); } while (0)
#define PG8_LDB(dst, b, h) do { _Pragma("unroll") for (int n = 0; n < 2; ++n) _Pragma("unroll") for (int k = 0; k < 2; ++k) dst[n][k] = *(const PG8_LAS bf16x8*)(lds + PG8_SB(b, h) + boff + n * 2048 + k * 1024); } while (0)
#define PG8_MMA(ai, bj, At, Bt) do { __builtin_amdgcn_s_setprio(1); _Pragma("unroll") for (int m = 0; m < 4; ++m) _Pragma("unroll") for (int n = 0; n < 2; ++n) _Pragma("unroll") for (int k = 0; k < 2; ++k) \
        acc[ai][bj][m][n] = __builtin_amdgcn_mfma_f32_16x16x32_bf16(Bt[n][k], At[m][k], acc[ai][bj][m][n], 0, 0, 0); __builtin_amdgcn_s_setprio(0); } while (0)
#define PG8_WAIT_V(n) asm volatile("s_waitcnt vmcnt(" #n ")" ::: "memory")
#define PG8_WAIT_L(n) asm volatile("s_waitcnt lgkmcnt(" #n ")" ::: "memory")
#define PG8_BAR __builtin_amdgcn_s_barrier()
#define PG8_SCHED __builtin_amdgcn_sched_barrier(0)
    Unit cur, nxt; int ui = 0;
    if (!S.next(0, cur)) return;
    f32x4 acc[2][2][4][2];
#pragma unroll
    for (int a = 0; a < 2; ++a)
#pragma unroll
        for (int b = 0; b < 2; ++b)
#pragma unroll
            for (int m = 0; m < 4; ++m)
#pragma unroll
                for (int n = 0; n < 2; ++n) acc[a][b][m][n] = (f32x4){0.f, 0.f, 0.f, 0.f};
    bf16x8 At[4][2], B0[2][2], B1[2][2];
    const char* cA = (const char*)g.A + (size_t)cur.pm * tstep; const char* cB = (const char*)g.Bt + (size_t)cur.pn * tstep;
    S.a_ready(cur);
    if constexpr (SP2) {
        PG8_STAGE(PG8_SB(0, 0), cB, voffB); PG8_STAGE(PG8_SB(0, 1), cB + hstep, voffB); PG8_STAGE(PG8_SA(0, 0), cA, voffA); PG8_STAGE(PG8_SA(0, 1), cA + hstep, voffA);
        if (wr == 1) PG8_BAR;
        PG8_WAIT_V(2); PG8_BAR;
        PG8_STAGE(PG8_SB(1, 0), cB + kstep, voffB); PG8_STAGE(PG8_SA(1, 0), cA + kstep, voffA); PG8_STAGE(PG8_SB(1, 1), cB + hstep + kstep, voffB);
        PG8_WAIT_V(6); PG8_BAR;
    } else {
        PG8_STAGE(PG8_SB(0, 0), cB, voffB); PG8_STAGE(PG8_SA(0, 0), cA, voffA); PG8_STAGE(PG8_SB(0, 1), cB + hstep, voffB); PG8_STAGE(PG8_SA(0, 1), cA + hstep, voffA);
        if (wr == 1) PG8_BAR;
        PG8_WAIT_V(4); PG8_BAR;
        PG8_STAGE(PG8_SB(1, 0), cB + kstep, voffB); PG8_STAGE(PG8_SA(1, 0), cA + kstep, voffA); PG8_STAGE(PG8_SB(1, 1), cB + hstep + kstep, voffB);
        PG8_WAIT_V(6); PG8_BAR;
    }
    for (;;) {
        const bool has_next = S.next(ui + 1, nxt);
        const char* nA = has_next ? (const char*)g.A + (size_t)nxt.pm * tstep : cA; const char* nB = has_next ? (const char*)g.Bt + (size_t)nxt.pn * tstep : cB;
        for (int t = 0; t < nt; t += 2) {
            const bool last = (t == nt - 2);
            const char* a1 = cA + (size_t)(t + 1) * kstep;
            const char* a2 = last ? nA : cA + (size_t)(t + 2) * kstep; const char* b2 = last ? nB : cB + (size_t)(t + 2) * kstep;
            const char* a3 = a2 + kstep; const char* b3 = b2 + kstep;
            if (last && has_next) S.a_ready(nxt);
            if constexpr (SP2) {
            PG8_LDB(B0, 0, 0); PG8_LDB(B1, 0, 1); PG8_SCHED; PG8_LDA(At, 0, 0); PG8_STAGE(PG8_SA(1, 1), a1 + hstep, voffA);
            PG8_WAIT_V(8); PG8_WAIT_L(0); PG8_BAR; PG8_MMA(0, 0, At, B0); PG8_MMA(0, 1, At, B1); PG8_BAR; PG8_SCHED;
            PG8_LDA(At, 0, 1); PG8_STAGE(PG8_SB(0, 0), b2, voffB); PG8_STAGE(PG8_SB(0, 1), b2 + hstep, voffB); PG8_STAGE(PG8_SA(0, 0), a2, voffA);
            PG8_WAIT_V(8); PG8_WAIT_L(0); PG8_BAR; PG8_MMA(1, 0, At, B0); PG8_MMA(1, 1, At, B1); PG8_BAR; PG8_SCHED;
            PG8_LDB(B0, 1, 0); PG8_LDB(B1, 1, 1); PG8_SCHED; PG8_LDA(At, 1, 0); PG8_STAGE(PG8_SA(0, 1), a2 + hstep, voffA);
            PG8_WAIT_V(8); PG8_WAIT_L(0); PG8_BAR; PG8_MMA(0, 0, At, B0); PG8_MMA(0, 1, At, B1); PG8_BAR; PG8_SCHED;
            PG8_LDA(At, 1, 1); PG8_STAGE(PG8_SB(1, 0), b3, voffB); PG8_STAGE(PG8_SB(1, 1), b3 + hstep, voffB); PG8_STAGE(PG8_SA(1, 0), a3, voffA);
            PG8_WAIT_V(8); PG8_WAIT_L(0); PG8_BAR; PG8_MMA(1, 0, At, B0); PG8_MMA(1, 1, At, B1); PG8_BAR; PG8_SCHED;
            } else {
            PG8_LDB(B0, 0, 0); PG8_SCHED; PG8_LDA(At, 0, 0); PG8_STAGE(PG8_SA(1, 1), a1 + hstep, voffA);
            PG8_WAIT_L(8); PG8_BAR; PG8_WAIT_L(0); PG8_MMA(0, 0, At, B0); PG8_BAR; PG8_SCHED;
            PG8_LDB(B1, 0, 1); PG8_STAGE(PG8_SB(0, 0), b2, voffB);
            PG8_BAR; PG8_WAIT_L(0); PG8_MMA(0, 1, At, B1); PG8_BAR;
            PG8_LDA(At, 0, 1); PG8_STAGE(PG8_SA(0, 0), a2, voffA);
            PG8_BAR; PG8_WAIT_L(0); PG8_MMA(1, 0, At, B0); PG8_BAR; PG8_SCHED;
            PG8_STAGE(PG8_SB(0, 1), b2 + hstep, voffB);
            PG8_WAIT_V(6); PG8_BAR; PG8_MMA(1, 1, At, B1); PG8_BAR;
            PG8_LDB(B0, 1, 0); PG8_SCHED; PG8_LDA(At, 1, 0); PG8_STAGE(PG8_SA(0, 1), a2 + hstep, voffA);
            PG8_WAIT_L(8); PG8_BAR; PG8_WAIT_L(0); PG8_MMA(0, 0, At, B0); PG8_BAR; PG8_SCHED;
            PG8_LDB(B1, 1, 1); PG8_STAGE(PG8_SB(1, 0), b3, voffB);
            PG8_BAR; PG8_WAIT_L(0); PG8_MMA(0, 1, At, B1); PG8_BAR;
            PG8_LDA(At, 1, 1); PG8_STAGE(PG8_SA(1, 0), a3, voffA);
            PG8_BAR; PG8_WAIT_L(0); PG8_MMA(1, 0, At, B0); PG8_BAR; PG8_SCHED;
            PG8_STAGE(PG8_SB(1, 1), b3 + hstep, voffB);
            PG8_WAIT_V(6); PG8_BAR; PG8_MMA(1, 1, At, B1); PG8_BAR;
            }
        }
        if constexpr (ALIGN_EPI) { if (wr == 0) PG8_BAR; }
        if constexpr (!Epi::AFTER_DRAIN) { E(acc, cur, wr, wc, fr, fq); S.done(cur); }
        if (!has_next) break;
#pragma unroll
        for (int a = 0; a < 2; ++a)
#pragma unroll
            for (int b = 0; b < 2; ++b)
#pragma unroll
                for (int m = 0; m < 4; ++m)
#pragma unroll
                    for (int n = 0; n < 2; ++n) acc[a][b][m][n] = (f32x4){0.f, 0.f, 0.f, 0.f};
        cur = nxt; cA = nA; cB = nB; ++ui;
        if constexpr (ALIGN_EPI) { if (wr == 1) PG8_BAR; }
    }
    PG8_WAIT_V(0);
    if constexpr (!ALIGN_EPI) { if (wr == 0) PG8_BAR; }
    PG8_BAR;
    if constexpr (Epi::AFTER_DRAIN) { E.fused(acc, cur, wr, wc, fr, fq, lds, wid, lane); S.done(cur); }
#undef PG8_SA
#undef PG8_SB
#undef PG8_STAGE
#undef PG8_LDA
#undef PG8_LDB
#undef PG8_MMA
#undef PG8_WAIT_V
#undef PG8_WAIT_L
#undef PG8_BAR
#undef PG8_SCHED
}
}

DEV void transpose_item(char* lds, const float* W, int K, int N, int Npad, bf16_t* WT, int item) {
    float* tile = (float*)lds;
    const int nb = Npad / 64, kb = item / nb, nbi = item % nb, k0 = kb * 64, n0 = nbi * 64;
    const int tid = threadIdx.x;
    { const int kk = tid >> 4, n4 = (tid & 15) * 4;
#pragma unroll
        for (int p = 0; p < 2; ++p) { f32x4 v = {0.f, 0.f, 0.f, 0.f}; if (n0 + n4 < N) v = *(const f32x4*)(W + (size_t)(k0 + kk + 32 * p) * N + n0 + n4);
            float* d = tile + (kk + 32 * p) * 65 + n4; d[0] = v.x; d[1] = v.y; d[2] = v.z; d[3] = v.w; } }
    __syncthreads();
    { const int n = tid >> 3, kc = tid & 7; float v[8];
#pragma unroll
        for (int j = 0; j < 8; ++j) v[j] = tile[(kc * 8 + j) * 65 + n];
        *(u32x4*)(WT + (size_t)(n0 + n) * K + k0 + kc * 8) = pack8(v); }
    __syncthreads();
}

DEV void mod_item(char* lds, const Params& p, int item) {
    const int layer = item / 96, n0 = (item % 96) * 32, tid = threadIdx.x;
    float* s = (float*)lds;
    float* red = s + 9 * 1024;
    for (int i = tid; i < 9 * 1024; i += 512) { const int v = i >> 10, k = i & 1023; const float cv = (v < 8) ? p.c[v * 1024 + k] : p.c_ctx[k]; s[i] = silu(cv); }
    __syncthreads();
    const int kc = tid >> 5, n = tid & 31; const float* W = p.ada_w + (size_t)layer * DM * 3072 + n0 + n;
    float acc[9];
#pragma unroll
    for (int v = 0; v < 9; ++v) acc[v] = 0.f;
#pragma unroll 8
    for (int kk = 0; kk < 64; ++kk) { const int k = kc * 64 + kk; const float w = W[(size_t)k * 3072];
#pragma unroll
        for (int v = 0; v < 9; ++v) acc[v] += s[v * 1024 + k] * w; }
#pragma unroll
    for (int v = 0; v < 9; ++v) red[(kc * 9 + v) * 32 + n] = acc[v];
    __syncthreads();
    if (tid < 9 * 32) { const int v = tid >> 5, nn = tid & 31; float t = 0.f;
#pragma unroll
        for (int k2 = 0; k2 < 16; ++k2) t += red[(k2 * 9 + v) * 32 + nn];
        t += p.ada_b[layer * 3072 + n0 + nn];
        if (layer == 0) ((float*)(p.ws + WS_MOD0))[v * 3072 + n0 + nn] = t;
        else if (v < 8) ((float*)(p.ws + WS_MOD1))[v * 3072 + n0 + nn] = t; }
    __syncthreads();
}

DEV void hid2_row(char* lds, const Params& p, int t, int wid, int lane) {
    float* sc = (float*)lds + wid * 128;
    const float tn = (float)t * (1.0f / 4095.0f);
    const float w = (float)(2.0 * 3.14159265358979323846 / 4096.0) * (float)t;
    float e = 0.f;
    if (lane == 0) e = tn;
    else if (lane <= 32) { const int k = (lane - 1) & 15; const float band = 1e-4f + (float)k * ((15.0f - 1e-4f) / 15.0f); const float ang = w * band; e = (lane <= 16) ? cosf(ang) : -sinf(ang); }
    sc[lane] = e;
    asm volatile("s_waitcnt lgkmcnt(0)" ::: "memory");
    float a = p.f_b1[lane];
    for (int i = 0; i < 33; ++i) a += sc[i] * p.f_w1[i * 64 + lane];
    const float fr = p.freq[lane];
    const float h1 = sinf(fr * a);
    sc[64 + lane] = h1;
    asm volatile("s_waitcnt lgkmcnt(0)" ::: "memory");
    float a2 = p.f_b2[lane];
    for (int i = 0; i < 64; ++i) a2 += sc[64 + i] * p.f_w2[i * 64 + lane];
    const float h2 = sinf(fr * a2);
    ((bf16_t*)(p.ws + WS_HID2))[t * 64 + lane] = f2bf(h2);
    asm volatile("s_waitcnt lgkmcnt(0)" ::: "memory");
}

DEV void phase_prep(char* lds, const Params& p) {
    const int tid = threadIdx.x, wid = tid >> 6, lane = tid & 63;
    { const int gt = blockIdx.x * 512 + tid;
        if (gt < 2048) ((float*)(p.ws + WS_SSUM))[gt] = 0.f;
        float* rp = (float*)(p.ws + WS_ROPE);
        if (gt < 1024) { const int pos = gt >> 4, i = gt & 15; const float inv = exp2f(-(float)i * (13.287712379549449f / 16.0f)); const float ang = (float)pos * inv; rp[gt] = cosf(ang); rp[1024 + gt] = sinf(ang); }
        if (gt < 512) { const int pos = gt >> 3, i = gt & 7; const float inv = exp2f(-(float)i * (13.287712379549449f / 8.0f)); const float ang = (float)pos * inv; rp[2048 + gt] = cosf(ang); rp[2560 + gt] = sinf(ang); } }
    for (int it = blockIdx.x; it < 192; it += gridDim.x) mod_item(lds, p, it);
    for (int t = blockIdx.x * 8 + wid; t < 4096; t += gridDim.x * 8) hid2_row(lds, p, t, wid, lane);
    __syncthreads();
    constexpr int I_WIN = 16 * 36, I_UQ = 4 * 12, I_UKV = 2 * 16, I_WO = 256, I_HIN = 16 * 64, I_HO = 256, I_W3 = 64;
    constexpr int NIT = I_WIN + I_UQ + I_UKV + I_WO + I_HIN + I_HO + I_W3;
    for (int it = blockIdx.x; it < NIT; it += gridDim.x) {
        int r = it;
        if (r < I_WIN) { transpose_item(lds, p.w_in, 1024, AIN, AINP, (bf16_t*)(p.ws + WS_WIN), r); continue; } r -= I_WIN;
        if (r < I_UQ) { transpose_item(lds, p.w_uq, 256, 768, 768, (bf16_t*)(p.ws + WS_WUQ), r); continue; } r -= I_UQ;
        if (r < I_UKV) { transpose_item(lds, p.w_ukv, 128, 1024, 1024, (bf16_t*)(p.ws + WS_WUKV), r); continue; } r -= I_UKV;
        if (r < I_WO) { transpose_item(lds, p.w_out, 1024, 1024, 1024, (bf16_t*)(p.ws + WS_WOUT), r); continue; } r -= I_WO;
        if (r < I_HIN) { transpose_item(lds, p.hy_w_in, 1024, 4096, 4096, (bf16_t*)(p.ws + WS_HWIN), r); continue; } r -= I_HIN;
        if (r < I_HO) { transpose_item(lds, p.hy_w_out, 1024, 1024, 1024, (bf16_t*)(p.ws + WS_HWOUT), r); continue; } r -= I_HO;
        transpose_item(lds, p.f_w3, 64, 4096, 4096, (bf16_t*)(p.ws + WS_W3), r);
    }
}

DEV float wave_sum(float v) {
#pragma unroll
    for (int o = 1; o < 64; o <<= 1) v += __shfl_xor(v, o);
    return v;
}
DEV void modnorm_row(const float* xr, const float* nw, const float* shift, const float* scale, bf16_t* orow, int lane) {
    f32x4 v[4]; float s = 0.f;
#pragma unroll
    for (int j = 0; j < 4; ++j) { v[j] = *(const f32x4*)(xr + lane * 4 + 256 * j); s += v[j].x * v[j].x + v[j].y * v[j].y + v[j].z * v[j].z + v[j].w * v[j].w; }
    const float r = rsqrtf(wave_sum(s) * (1.0f / DM) + EPS);
#pragma unroll
    for (int j = 0; j < 4; ++j) { const int c0 = lane * 4 + 256 * j;
        const f32x4 w = *(const f32x4*)(nw + c0), sh = *(const f32x4*)(shift + c0), sc = *(const f32x4*)(scale + c0);
        const float o0 = v[j].x * r * w.x * (1.f + sc.x) + sh.x, o1 = v[j].y * r * w.y * (1.f + sc.y) + sh.y, o2 = v[j].z * r * w.z * (1.f + sc.z) + sh.z, o3 = v[j].w * r * w.w * (1.f + sc.w) + sh.w;
        u32x2 pk; pk.x = pk2(o0, o1); pk.y = pk2(o2, o3); *(u32x2*)(orow + c0) = pk; }
}

DEV void phase_norm0(const Params& p) {
    const int wid = threadIdx.x >> 6, lane = threadIdx.x & 63; const float* mod0 = (const float*)(p.ws + WS_MOD0); bf16_t* H0 = (bf16_t*)(p.ws + WS_H0);
    for (int row = blockIdx.x * 8 + wid; row < NALL; row += gridDim.x * 8) {
        const float* xr; int v;
        if (row < NTOK) { xr = p.x + (size_t)row * DM; v = row >> 12; } else { xr = p.ctx + (size_t)(row - NTOK) * DM; v = 8; }
        modnorm_row(xr, p.norm_w, mod0 + v * 3072, mod0 + v * 3072 + 1024, H0 + (size_t)row * DM, lane);
    }
}
DEV void phase_norm1(const Params& p) {
    const int wid = threadIdx.x >> 6, lane = threadIdx.x & 63; const float* mod1 = (const float*)(p.ws + WS_MOD1); bf16_t* H1 = (bf16_t*)(p.ws + WS_H1);
    for (int row = blockIdx.x * 8 + wid; row < NTOK; row += gridDim.x * 8) { const int v = row >> 12;
        modnorm_row(p.out + (size_t)row * DM, p.norm_w + DM, mod1 + v * 3072, mod1 + v * 3072 + 1024, H1 + (size_t)row * DM, lane); }
}
DEV void phase_final(const Params& p) {
    const int wid = threadIdx.x >> 6, lane = threadIdx.x & 63;
    for (int row = blockIdx.x * 8 + wid; row < NTOK; row += gridDim.x * 8) {
        float* xr = p.out + (size_t)row * DM; f32x4 v[4]; float s = 0.f;
#pragma unroll
        for (int j = 0; j < 4; ++j) { v[j] = *(const f32x4*)(xr + lane * 4 + 256 * j); s += v[j].x * v[j].x + v[j].y * v[j].y + v[j].z * v[j].z + v[j].w * v[j].w; }
        const float r = rsqrtf(wave_sum(s) * (1.0f / DM) + EPS);
#pragma unroll
        for (int j = 0; j < 4; ++j) { const int c0 = lane * 4 + 256 * j; const f32x4 w = *(const f32x4*)(p.final_w + c0);
            f32x4 o; o.x = v[j].x * r * w.x; o.y = v[j].y * r * w.y; o.z = v[j].z * r * w.z; o.w = v[j].w * r * w.w; *(f32x4*)(xr + c0) = o; }
    }
}

DEV void phase_post(const Params& p) {
    const int wid = threadIdx.x >> 6, lane = threadIdx.x & 63;
    const bf16_t* PRAW = (const bf16_t*)(p.ws + WS_PRAW);
    bf16_t* QA = (bf16_t*)(p.ws + WS_QA); bf16_t* KA = (bf16_t*)(p.ws + WS_KA); bf16_t* VA = (bf16_t*)(p.ws + WS_VA);
    bf16_t* CQN = (bf16_t*)(p.ws + WS_CQN); bf16_t* CKVN = (bf16_t*)(p.ws + WS_CKVN); bf16_t* G = (bf16_t*)(p.ws + WS_G); bf16_t* KM = (bf16_t*)(p.ws + WS2_KM);
    const float* rp = (const float*)(p.ws + WS_ROPE); const float *cos64 = rp, *sin64 = rp + 1024, *cos32 = rp + 2048, *sin32 = rp + 2560;
    for (int tok = blockIdx.x * 8 + wid; tok < NALL; tok += gridDim.x * 8) {
        const bool lat = tok < NTOK; int b, pos, prow = 0, pcol = 0;
        if (lat) { b = tok >> 12; const int l = tok & 4095; pos = CTXL + l; prow = l >> 6; pcol = l & 63; } else { const int j = tok - NTOK; b = j >> 8; pos = j & 255; }
        const bf16_t* pr = PRAW + (size_t)tok * AINP; const size_t kvrow = (size_t)b * LK + pos;
        float v[8], o[8];
        if (lat) {
            unpack8(*(const u32x4*)(pr + lane * 8), v);
            float ss = 0.f;
#pragma unroll
            for (int j = 0; j < 8; ++j) ss += v[j] * v[j];
            ss += __shfl_xor(ss, 1); ss += __shfl_xor(ss, 2); ss += __shfl_xor(ss, 4);
            const float r = rsqrtf(ss * (1.0f / 64.0f) + EPS); const int k = lane & 7;
#pragma unroll
            for (int j = 0; j < 8; ++j) v[j] = v[j] * r * p.q_norm[k * 8 + j];
            const int posv = (k < 4) ? prow : pcol; const int fb = posv * 16 + (k & 1) * 8;
#pragma unroll
            for (int j = 0; j < 8; ++j) { const float ot = __shfl_xor(v[j], 2); const float cs = cos64[fb + j], sn = sin64[fb + j];
                o[j] = ((k & 2) ? (v[j] * cs + ot * sn) : (v[j] * cs - ot * sn)) * QSC_A; }
            *(u32x4*)(QA + (size_t)tok * 512 + lane * 8) = pack8(o);
        }
        {
            const u32x4 raw = *(const u32x4*)(pr + 512 + lane * 8); unpack8(raw, v);
            float ss = 0.f;
#pragma unroll
            for (int j = 0; j < 8; ++j) ss += v[j] * v[j];
            ss += __shfl_xor(ss, 1); ss += __shfl_xor(ss, 2); ss += __shfl_xor(ss, 4);
            const float s8 = ss;
            ss += __shfl_xor(ss, 8); ss += __shfl_xor(ss, 16);
            const float s32 = ss;
            float vn[8]; const int k = lane & 7;
            { const float r = rsqrtf(s8 * (1.0f / 64.0f) + EPS);
#pragma unroll
                for (int j = 0; j < 8; ++j) vn[j] = v[j] * r * p.k_norm[k * 8 + j]; }
            const int posv = (k < 4) ? prow : pcol; const int fb = posv * 16 + (k & 1) * 8;
#pragma unroll
            for (int j = 0; j < 8; ++j) { const float ot = __shfl_xor(vn[j], 2); const float cs = cos64[fb + j], sn = sin64[fb + j];
                o[j] = lat ? ((k & 2) ? (vn[j] * cs + ot * sn) : (vn[j] * cs - ot * sn)) : vn[j]; }
            if (lane < 16) *(u32x4*)(KA + kvrow * 128 + lane * 8) = pack8(o);
            else if (lane < 32) *(u32x4*)(VA + kvrow * 128 + (lane - 16) * 8) = raw;
            else if (lat) { const float r = rsqrtf(s32 * (1.0f / 256.0f) + EPS); const int cb = (lane - 32) * 8;
#pragma unroll
                for (int j = 0; j < 8; ++j) o[j] = v[j] * r * p.cq_norm[cb + j];
                *(u32x4*)(CQN + (size_t)tok * 256 + cb) = pack8(o); }
        }
        {
            unpack8(*(const u32x4*)(pr + 1024 + lane * 8), v);
            float ss = 0.f;
#pragma unroll
            for (int j = 0; j < 8; ++j) ss += v[j] * v[j];
            ss += __shfl_xor(ss, 1); ss += __shfl_xor(ss, 2); ss += __shfl_xor(ss, 4); ss += __shfl_xor(ss, 8);
            const int k = lane & 3; const int posv = (k < 2) ? prow : pcol;
            float oth[8];
#pragma unroll
            for (int j = 0; j < 8; ++j) oth[j] = __shfl_xor(v[j], 1);
            if (lane < 16) { const float r = rsqrtf(ss * (1.0f / 128.0f) + EPS);
#pragma unroll
                for (int j = 0; j < 8; ++j) o[j] = v[j] * r * p.ckv_norm[lane * 8 + j];
                *(u32x4*)(CKVN + kvrow * 128 + lane * 8) = pack8(o); }
            else if (lane < 20) {
#pragma unroll
                for (int j = 0; j < 8; ++j) { const float cs = cos32[posv * 8 + j], sn = sin32[posv * 8 + j];
                    o[j] = lat ? ((k & 1) ? (v[j] * cs + oth[j] * sn) : (v[j] * cs - oth[j] * sn)) : v[j]; }
                const u32x4 w = pack8(o);
#pragma unroll
                for (int h = 0; h < 8; ++h) *(u32x4*)(KM + kvrow * 768 + h * 96 + 64 + k * 8) = w; }
            else if (lat) {
#pragma unroll
                for (int j = 0; j < 8; ++j) o[j] = silu(v[j]);
                *(u32x4*)(G + (size_t)tok * 1024 + (lane - 20) * 8) = pack8(o); }
        }
        if (lat) {
            unpack8(*(const u32x4*)(pr + 1536 + lane * 8), v);
#pragma unroll
            for (int j = 0; j < 8; ++j) o[j] = silu(v[j]);
            *(u32x4*)(G + (size_t)tok * 1024 + 352 + lane * 8) = pack8(o);
            if (lane < 20) { unpack8(*(const u32x4*)(pr + 2048 + lane * 8), v);
#pragma unroll
                for (int j = 0; j < 8; ++j) o[j] = silu(v[j]);
                *(u32x4*)(G + (size_t)tok * 1024 + 864 + lane * 8) = pack8(o); }
        }
    }
}

template <int DQK>
DEV void attn_unit(char* lds, const bf16_t* __restrict__ Q, int ldq, int qcol, const bf16_t* __restrict__ Kp, int ldk, int kcol, const bf16_t* __restrict__ Vp, int ldv, int vcol,
                   const bf16_t* __restrict__ Gt, bf16_t* OG, int ocol, int b, int q0) {
    constexpr int KRS = (DQK + 8) * 2, KB = 64 * KRS, VRS = 192, VB = 64 * VRS, STG = KB + VB, NKS = DQK / 16, KCH = DQK / 8;
    const int tid = threadIdx.x, lane = tid & 63, wid = tid >> 6, l31 = lane & 31, hi = lane >> 5;
    bf16x8 qf[NKS];
    { const bf16_t* qp = Q + (size_t)(b * SEQ + q0 + wid * 32 + l31) * ldq + qcol + hi * 8;
#pragma unroll
        for (int ks = 0; ks < NKS; ++ks) qf[ks] = *(const bf16x8*)(qp + ks * 16); }
    const bf16_t* kbase = Kp + (size_t)b * LK * ldk + kcol; const bf16_t* vbase = Vp + (size_t)b * LK * ldv + vcol;
    const int kr0 = tid / KCH, kc0 = tid % KCH;
    const int kr1 = (tid + 512) / KCH, kc1 = (tid + 512) % KCH;
    const bool k2 = (KCH * 64 > 512) && (tid + 512 < KCH * 64);
    const int vr = tid >> 3, vc = tid & 7;
    u32x4 sk0, sk1, sv;
#define A_LOAD(t) do { const size_t kp_ = (size_t)(t) * 64; sk0 = *(const u32x4*)(kbase + (kp_ + kr0) * ldk + kc0 * 8); \
        if (k2) sk1 = *(const u32x4*)(kbase + (kp_ + kr1) * ldk + kc1 * 8); sv = *(const u32x4*)(vbase + (kp_ + vr) * ldv + vc * 8); } while (0)
#define A_STORE(buf) do { char* b_ = lds + (buf) * STG; *(u32x4*)(b_ + kr0 * KRS + kc0 * 16) = sk0; if (k2) *(u32x4*)(b_ + kr1 * KRS + kc1 * 16) = sk1; \
        *(u32x4*)(b_ + KB + vr * VRS + vc * 16) = sv; } while (0)
    f32x16 o0, o1;
#pragma unroll
    for (int r = 0; r < 16; ++r) { o0[r] = 0.f; o1[r] = 0.f; }
    float m_run = -1e30f, l_run = 0.f;
    const int g1 = (lane >> 4) & 1, tq = (lane & 15) >> 2, tp = lane & 3;
    const int vt_off = KB + (4 * hi + tq) * VRS + (16 * g1 + 4 * tp) * 2;
    const int kf_off = l31 * KRS + hi * 16;
    constexpr int NT = LK / 64;
    A_LOAD(0); A_STORE(0);
    __syncthreads();
    for (int t = 0; t < NT; ++t) {
        const bool more = (t + 1 < NT);
        if (more) A_LOAD(t + 1);
        const char* b_ = lds + (t & 1) * STG;
        f32x16 p0, p1;
#pragma unroll
        for (int r = 0; r < 16; ++r) { p0[r] = 0.f; p1[r] = 0.f; }
#pragma unroll
        for (int ks = 0; ks < NKS; ++ks) {
            const bf16x8 ka = *(const bf16x8*)(b_ + kf_off + ks * 32);
            const bf16x8 kb = *(const bf16x8*)(b_ + kf_off + 32 * KRS + ks * 32);
            p0 = __builtin_amdgcn_mfma_f32_32x32x16_bf16(ka, qf[ks], p0, 0, 0, 0);
            p1 = __builtin_amdgcn_mfma_f32_32x32x16_bf16(kb, qf[ks], p1, 0, 0, 0);
        }
        float mx = p0[0];
#pragma unroll
        for (int r = 1; r < 16; ++r) mx = fmaxf(mx, p0[r]);
#pragma unroll
        for (int r = 0; r < 16; ++r) mx = fmaxf(mx, p1[r]);
        mx = fmaxf(mx, __shfl_xor(mx, 32));
        const float m_new = fmaxf(m_run, mx);
        const float alpha = __builtin_amdgcn_exp2f(m_run - m_new);
        m_run = m_new;
        float ls = 0.f;
#pragma unroll
        for (int r = 0; r < 16; ++r) { p0[r] = __builtin_amdgcn_exp2f(p0[r] - m_new); p1[r] = __builtin_amdgcn_exp2f(p1[r] - m_new); ls += p0[r] + p1[r]; }
        l_run = l_run * alpha + ls;
#pragma unroll
        for (int r = 0; r < 16; ++r) { o0[r] *= alpha; o1[r] *= alpha; }
        u32x4 pw[4];
        pw[0] = (u32x4){pk2(p0[0], p0[1]), pk2(p0[2], p0[3]), pk2(p0[4], p0[5]), pk2(p0[6], p0[7])};
        pw[1] = (u32x4){pk2(p0[8], p0[9]), pk2(p0[10], p0[11]), pk2(p0[12], p0[13]), pk2(p0[14], p0[15])};
        pw[2] = (u32x4){pk2(p1[0], p1[1]), pk2(p1[2], p1[3]), pk2(p1[4], p1[5]), pk2(p1[6], p1[7])};
        pw[3] = (u32x4){pk2(p1[8], p1[9]), pk2(p1[10], p1[11]), pk2(p1[12], p1[13]), pk2(p1[14], p1[15])};
#pragma unroll
        for (int s = 0; s < 4; ++s) {
            const bf16x8 pb = __builtin_bit_cast(bf16x8, pw[s]);
#pragma unroll
            for (int dt = 0; dt < 2; ++dt) {
                const char* vp = b_ + vt_off + s * 16 * VRS + dt * 64;
                const s16x4 lo = __builtin_bit_cast(s16x4, __builtin_amdgcn_ds_read_tr16_b64_v4i16((LAS s16x4*)vp));
                const s16x4 hh = __builtin_bit_cast(s16x4, __builtin_amdgcn_ds_read_tr16_b64_v4i16((LAS s16x4*)(vp + 8 * VRS)));
                const bf16x8 vf = (bf16x8){lo[0], lo[1], lo[2], lo[3], hh[0], hh[1], hh[2], hh[3]};
                if (dt == 0) o0 = __builtin_amdgcn_mfma_f32_32x32x16_bf16(vf, pb, o0, 0, 0, 0);
                else o1 = __builtin_amdgcn_mfma_f32_32x32x16_bf16(vf, pb, o1, 0, 0, 0);
            }
        }
        if (more) A_STORE((t + 1) & 1);
        __syncthreads();
    }
#undef A_LOAD
#undef A_STORE
    const float lt = l_run + __shfl_xor(l_run, 32); const float inv = 1.0f / lt;
    const size_t tok = (size_t)(b * SEQ + q0 + wid * 32 + l31);
#pragma unroll
    for (int dt = 0; dt < 2; ++dt)
#pragma unroll
        for (int g = 0; g < 4; ++g) { const int d = 32 * dt + 8 * g + 4 * hi; const size_t off = tok * 1024 + ocol + d;
            const u32x2 gw = *(const u32x2*)(Gt + off);
            const f32x16& oo = dt ? o1 : o0;
            u32x2 w; w.x = pk2(oo[4 * g] * inv * lo_bf(gw.x), oo[4 * g + 1] * inv * hi_bf(gw.x)); w.y = pk2(oo[4 * g + 2] * inv * lo_bf(gw.y), oo[4 * g + 3] * inv * hi_bf(gw.y));
            *(u32x2*)(OG + off) = w; }
}

DEV float swapmax32(float v) { auto rr = __builtin_amdgcn_permlane32_swap(__float_as_uint(v), __float_as_uint(v), false, false); return fmaxf(__uint_as_float(rr[0]), __uint_as_float(rr[1])); }
DEV float swapsum32(float v) { auto rr = __builtin_amdgcn_permlane32_swap(__float_as_uint(v), __float_as_uint(v), false, false); return __uint_as_float(rr[0]) + __uint_as_float(rr[1]); }
template <int DQK>
DEV void attn_unit2(char* lds, const bf16_t* __restrict__ Q, int ldq, int qcol, const bf16_t* __restrict__ Kp, int ldk, int kcol, const bf16_t* __restrict__ Vp, int ldv, int vcol,
                    const bf16_t* __restrict__ Gt, bf16_t* OG, int ocol, int b, int q0) {
    constexpr int KRS = (DQK + 8) * 2, KB = 64 * KRS, VRS = 192, VB = 64 * VRS, NKS = DQK / 16, KCH = DQK / 8, VOFF = 2 * KB;
    constexpr float THR = 8.0f;
    constexpr int NT = LK / 64;
    const int tid = threadIdx.x, lane = tid & 63, wid = tid >> 6, l31 = lane & 31, hi = lane >> 5;
    bf16x8 qf[NKS];
    { const bf16_t* qp = Q + (size_t)(b * SEQ + q0 + wid * 32 + l31) * ldq + qcol + hi * 8;
#pragma unroll
        for (int ks = 0; ks < NKS; ++ks) qf[ks] = *(const bf16x8*)(qp + ks * 16); }
    const bf16_t* kbase = Kp + (size_t)b * LK * ldk + kcol; const bf16_t* vbase = Vp + (size_t)b * LK * ldv + vcol;
    constexpr bool K2 = (KCH * 64 > 512);
    const bool k2 = K2 && (tid + 512 < KCH * 64);
    const int kr0 = tid / KCH, kc0 = tid % KCH, kr1 = k2 ? (tid + 512) / KCH : kr0, kc1 = k2 ? (tid + 512) % KCH : kc0;
    const int vr = tid >> 3, vc = tid & 7;
    u32x4 skX0, skX1 = {0u, 0u, 0u, 0u}, svX, skY0, skY1 = {0u, 0u, 0u, 0u}, svY;
#define A_LOADK(t, S) do { const int tt_ = (t) < NT ? (t) : NT - 1; const size_t kp_ = (size_t)tt_ * 64; sk##S##0 = *(const u32x4*)(kbase + (kp_ + kr0) * ldk + kc0 * 8); if (K2) sk##S##1 = *(const u32x4*)(kbase + (kp_ + kr1) * ldk + kc1 * 8); } while (0)
#define A_LOADV(t, S) do { const int tt_ = (t) < NT ? (t) : NT - 1; sv##S = *(const u32x4*)(vbase + ((size_t)tt_ * 64 + vr) * ldv + vc * 8); } while (0)
#define A_STOREK(slot, S) do { char* b_ = lds + (slot) * KB; *(u32x4*)(b_ + kr0 * KRS + kc0 * 16) = sk##S##0; if (K2) *(u32x4*)(b_ + kr1 * KRS + kc1 * 16) = sk##S##1; } while (0)
#define A_STOREV(slot, S) do { *(u32x4*)(lds + VOFF + (slot) * VB + vr * VRS + vc * 16) = sv##S; } while (0)
    f32x16 o0, o1, negm;
#pragma unroll
    for (int r = 0; r < 16; ++r) { o0[r] = 0.f; o1[r] = 0.f; negm[r] = 0.f; }
    asm volatile("" : "+v"(negm));
    float mhat = 0.f, l_run = 0.f;
    const int g1 = (lane >> 4) & 1, tq = (lane & 15) >> 2, tp = lane & 3;
    const int vt_off = VOFF + (4 * hi + tq) * VRS + (16 * g1 + 4 * tp) * 2;
    const int kf_off = l31 * KRS + hi * 16;
#define A_QK(P0, P1, slot) do { const char* kb_ = lds + (slot) * KB + kf_off; \
        _Pragma("unroll") for (int ks = 0; ks < NKS; ++ks) { \
            const bf16x8 ka = *(const bf16x8*)(kb_ + ks * 32); const bf16x8 kb2 = *(const bf16x8*)(kb_ + 32 * KRS + ks * 32); \
            if (ks == 0) { P0 = __builtin_amdgcn_mfma_f32_32x32x16_bf16(ka, qf[0], negm, 0, 0, 0); P1 = __builtin_amdgcn_mfma_f32_32x32x16_bf16(kb2, qf[0], negm, 0, 0, 0); } \
            else { P0 = __builtin_amdgcn_mfma_f32_32x32x16_bf16(ka, qf[ks], P0, 0, 0, 0); P1 = __builtin_amdgcn_mfma_f32_32x32x16_bf16(kb2, qf[ks], P1, 0, 0, 0); } } } while (0)
    A_LOADK(0, X); A_LOADV(0, X); A_LOADK(1, Y); A_LOADV(1, Y); A_STOREK(0, X); A_STOREV(0, X); A_STOREK(1, Y);
    A_LOADK(2, Y);
    __syncthreads();
    f32x16 pA0, pA1, pB0, pB1;
#pragma unroll
    for (int r = 0; r < 16; ++r) { pB0[r] = 0.f; pB1[r] = 0.f; }
    A_QK(pA0, pA1, 0);
#define A_STEP(P0, P1, N0, N1, t, SL, SS) do { \
        A_LOADK((t) + 3, SL); A_LOADV((t) + 2, SL); \
        A_QK(N0, N1, ((t) + 1) & 1); \
        float a_ = fmaxf(fmaxf(P0[0], P0[1]), P1[0]), c_ = fmaxf(fmaxf(P0[2], P0[3]), P1[1]); a_ = fmaxf(fmaxf(a_, P1[2]), P1[3]); \
        _Pragma("unroll") for (int r = 4; r < 16; r += 4) { a_ = fmaxf(fmaxf(a_, P0[r]), P0[r + 1]); c_ = fmaxf(fmaxf(c_, P0[r + 2]), P0[r + 3]); a_ = fmaxf(fmaxf(a_, P1[r]), P1[r + 1]); c_ = fmaxf(fmaxf(c_, P1[r + 2]), P1[r + 3]); } \
        const float rm = swapmax32(fmaxf(a_, c_)); \
        if ((t) == 0 || __any(rm > THR)) { \
            const float dl = ((t) == 0) ? rm : fmaxf(rm, 0.f); mhat += dl; \
            _Pragma("unroll") for (int r = 0; r < 16; ++r) { P0[r] -= dl; P1[r] -= dl; N0[r] -= dl; N1[r] -= dl; } \
            if ((t) != 0) { const float f = __builtin_amdgcn_exp2f(-dl); l_run *= f; _Pragma("unroll") for (int r = 0; r < 16; ++r) { o0[r] *= f; o1[r] *= f; } } \
            _Pragma("unroll") for (int r = 0; r < 16; ++r) negm[r] = -mhat; asm volatile("" : "+v"(negm)); } \
        float ls = 0.f; \
        _Pragma("unroll") for (int r = 0; r < 16; ++r) { P0[r] = __builtin_amdgcn_exp2f(P0[r]); P1[r] = __builtin_amdgcn_exp2f(P1[r]); ls += P0[r] + P1[r]; } \
        l_run += ls; \
        u32x4 pw[4]; \
        pw[0] = (u32x4){pk2(P0[0], P0[1]), pk2(P0[2], P0[3]), pk2(P0[4], P0[5]), pk2(P0[6], P0[7])}; \
        pw[1] = (u32x4){pk2(P0[8], P0[9]), pk2(P0[10], P0[11]), pk2(P0[12], P0[13]), pk2(P0[14], P0[15])}; \
        pw[2] = (u32x4){pk2(P1[0], P1[1]), pk2(P1[2], P1[3]), pk2(P1[4], P1[5]), pk2(P1[6], P1[7])}; \
        pw[3] = (u32x4){pk2(P1[8], P1[9]), pk2(P1[10], P1[11]), pk2(P1[12], P1[13]), pk2(P1[14], P1[15])}; \
        { const char* vb_ = lds + ((t) & 1) * VB + vt_off; \
        _Pragma("unroll") for (int s = 0; s < 4; ++s) { const bf16x8 pb = __builtin_bit_cast(bf16x8, pw[s]); \
            _Pragma("unroll") for (int dt = 0; dt < 2; ++dt) { const char* vp = vb_ + s * 16 * VRS + dt * 64; \
                const s16x4 lo = __builtin_bit_cast(s16x4, __builtin_amdgcn_ds_read_tr16_b64_v4i16((LAS s16x4*)vp)); \
                const s16x4 hh = __builtin_bit_cast(s16x4, __builtin_amdgcn_ds_read_tr16_b64_v4i16((LAS s16x4*)(vp + 8 * VRS))); \
                const bf16x8 vf = (bf16x8){lo[0], lo[1], lo[2], lo[3], hh[0], hh[1], hh[2], hh[3]}; \
                if (dt == 0) o0 = __builtin_amdgcn_mfma_f32_32x32x16_bf16(vf, pb, o0, 0, 0, 0); else o1 = __builtin_amdgcn_mfma_f32_32x32x16_bf16(vf, pb, o1, 0, 0, 0); } } } \
        A_STOREK((t) & 1, SS); A_STOREV(((t) + 1) & 1, SS); \
        __syncthreads(); } while (0)
    for (int t = 0; t < NT; t += 2) {
        A_STEP(pA0, pA1, pB0, pB1, t, X, Y);
        A_STEP(pB0, pB1, pA0, pA1, t + 1, Y, X);
    }
#undef A_STEP
#undef A_QK
#undef A_LOADK
#undef A_LOADV
#undef A_STOREK
#undef A_STOREV
    const float inv = 1.0f / swapsum32(l_run);
    const size_t tok = (size_t)(b * SEQ + q0 + wid * 32 + l31);
#pragma unroll
    for (int dt = 0; dt < 2; ++dt)
#pragma unroll
        for (int g = 0; g < 4; ++g) { const int d = 32 * dt + 8 * g + 4 * hi; const size_t off = tok * 1024 + ocol + d;
            const u32x2 gw = *(const u32x2*)(Gt + off);
            const f32x16& oo = dt ? o1 : o0;
            u32x2 w; w.x = pk2(oo[4 * g] * inv * lo_bf(gw.x), oo[4 * g + 1] * inv * hi_bf(gw.x)); w.y = pk2(oo[4 * g + 2] * inv * lo_bf(gw.y), oo[4 * g + 3] * inv * hi_bf(gw.y));
            *(u32x2*)(OG + off) = w; }
}

DEV void phase_attn(char* lds, const Params& p) {
    const bf16_t* QA = (const bf16_t*)(p.ws + WS_QA); const bf16_t* KA = (const bf16_t*)(p.ws + WS_KA); const bf16_t* VA = (const bf16_t*)(p.ws + WS_VA);
    const bf16_t* QM = (const bf16_t*)(p.ws + WS_QM); const bf16_t* KM = (const bf16_t*)(p.ws + WS2_KM); const bf16_t* VM = (const bf16_t*)(p.ws + WS2_VM);
    const bf16_t* G = (const bf16_t*)(p.ws + WS_G); bf16_t* OG = (bf16_t*)(p.ws + WS2_OG);
    for (int u = blockIdx.x; u < 2048; u += gridDim.x) {
        const int type = u >> 10, rem = u & 1023, b = rem >> 7, h = (rem >> 4) & 7, qb = rem & 15;
        if (type == 0) attn_unit2<64>(lds, QA, 512, h * 64, KA, 128, (h >> 2) * 64, VA, 128, (h >> 2) * 64, G, OG, h * 64, b, qb * 256);
        else attn_unit2<96>(lds, QM, 768, h * 96, KM, 768, h * 96, VM, 512, h * 64, G, OG, 512 + h * 64, b, qb * 256);
    }
}

constexpr int CV_PADL = 192, CV_ROW = 4488, CV_RS = CV_ROW * 2;
constexpr int CV_UB = 8 * CV_RS;
constexpr int CV_FS = 16448;
DEV void conv_load_filter(char* lds, const bf16_t* gr) {
    const int tid = threadIdx.x;
#pragma unroll
    for (int rnd = 0; rnd < 2; ++rnd) {
        const int ch = tid + rnd * 512;
        const u32x4 a = *(const u32x4*)(gr + ch * 8);
        u32x4 bq = {0u, 0u, 0u, 0u}; if (ch + 1 < 1024) bq = *(const u32x4*)(gr + ch * 8 + 8);
        const unsigned w[8] = {a.x, a.y, a.z, a.w, bq.x, bq.y, bq.z, bq.w};
        char* f = lds + CV_UB + ch * 16;
        *(u32x4*)(f) = a;
        u32x4 c1, c2, c3;
        c1.x = __builtin_amdgcn_alignbit(w[1], w[0], 16); c1.y = __builtin_amdgcn_alignbit(w[2], w[1], 16); c1.z = __builtin_amdgcn_alignbit(w[3], w[2], 16); c1.w = __builtin_amdgcn_alignbit(w[4], w[3], 16);
        c2 = (u32x4){w[1], w[2], w[3], w[4]};
        c3.x = __builtin_amdgcn_alignbit(w[2], w[1], 16); c3.y = __builtin_amdgcn_alignbit(w[3], w[2], 16); c3.z = __builtin_amdgcn_alignbit(w[4], w[3], 16); c3.w = __builtin_amdgcn_alignbit(w[5], w[4], 16);
        *(u32x4*)(f + CV_FS) = c1; *(u32x4*)(f + 2 * CV_FS) = c2; *(u32x4*)(f + 3 * CV_FS) = c3;
    }
}
DEV void sconv4(const bf16_t* px, int t, float w0, float w1, float w2, float bias, float* u) {
    const u32x2 mid = *(const u32x2*)(px + t);
    const float pm = (t > 0) ? bf2f(px[t - 1]) : 0.f, pp = (t + 4 < SEQ) ? bf2f(px[t + 4]) : 0.f;
    const float q0 = lo_bf(mid.x), q1 = hi_bf(mid.x), q2 = lo_bf(mid.y), q3 = hi_bf(mid.y);
    u[0] = w0 * pm + w1 * q0 + w2 * q1 + bias; u[1] = w0 * q0 + w1 * q1 + w2 * q2 + bias; u[2] = w0 * q1 + w1 * q2 + w2 * q3 + bias; u[3] = w0 * q2 + w1 * q3 + w2 * pp + bias;
}
DEV void conv_mfma_loop(const char* lds, f32x16 (&acc)[2][2], int wid, int lane) {
    const int l31 = lane & 31, hi = lane >> 5;
#pragma unroll
    for (int a = 0; a < 2; ++a)
#pragma unroll
        for (int b = 0; b < 2; ++b)
#pragma unroll
            for (int r = 0; r < 16; ++r) acc[a][b][r] = 0.f;
    int a_off[2];
#pragma unroll
    for (int mt = 0; mt < 2; ++mt) { const int r = l31 + 32 * mt, q = (4 - (r & 3)) & 3; a_off[mt] = CV_UB + q * CV_FS + (4096 - r - q + 8 * hi) * 2; }
    int b_off[2];
#pragma unroll
    for (int n = 0; n < 2; ++n) { const int nt = 2 * wid + n; b_off[n] = (l31 & 7) * CV_RS + (CV_PADL + 64 * (4 * nt + (l31 >> 3)) + 8 * hi) * 2; }
    const int dlo = 8 * wid - 63, dhi = 8 * wid + 7;
    for (int d = dlo; d <= dhi; ++d) {
        bf16x8 fa[2][4];
#pragma unroll
        for (int mt = 0; mt < 2; ++mt)
#pragma unroll
            for (int ks = 0; ks < 4; ++ks) { const char* ap = lds + a_off[mt] - 128 * d + ks * 32;
                const u32x2 lo = *(const u32x2*)ap, hh = *(const u32x2*)(ap + 8);
                fa[mt][ks] = __builtin_bit_cast(bf16x8, (u32x4){lo.x, lo.y, hh.x, hh.y}); }
#pragma unroll
        for (int n = 0; n < 2; ++n) {
            const int nt = 2 * wid + n;
            if (d >= 4 * nt - 63 && d <= 4 * nt + 3) {
#pragma unroll
                for (int ks = 0; ks < 4; ++ks) { const bf16x8 fb = *(const bf16x8*)(lds + b_off[n] - 128 * d + ks * 32);
#pragma unroll
                    for (int mt = 0; mt < 2; ++mt) acc[n][mt] = __builtin_amdgcn_mfma_f32_32x32x16_bf16(fa[mt][ks], fb, acc[n][mt], 0, 0, 0); }
            }
        }
    }
}
DEV void conv_unit(char* lds, const Params& p, int c) {
    const int tid = threadIdx.x, lane = tid & 63, wid = tid >> 6, l31 = lane & 31, hi = lane >> 5;
    const bf16_t* PT = (const bf16_t*)(p.ws + WS_PT); const bf16_t* GR = (const bf16_t*)(p.ws + WS_GR); const float* ssum = (const float*)(p.ws + WS_SSUM);
    bf16_t* OG2 = (bf16_t*)(p.ws + WS_OG2);
    for (int i = tid; i < 8 * 98; i += 512) { const int b = i / 98, j = i % 98;
        const int e = (j < 48) ? j * 4 : (CV_PADL + SEQ + (j - 48) * 4); *(u32x2*)(lds + b * CV_RS + e * 2) = (u32x2){0u, 0u}; }
    { const float w0 = p.conv_w[c], w1 = p.conv_w[3072 + c], w2 = p.conv_w[6144 + c], bias = p.conv_b[c];
        for (int i = tid; i < 8 * 1024; i += 512) { const int b = i >> 10, t = (i & 1023) * 4; float u[4];
            sconv4(PT + ((size_t)(b * 4096 + c)) * 4096, t, w0, w1, w2, bias, u);
            u32x2 w; w.x = pk2(u[0], u[1]); w.y = pk2(u[2], u[3]); *(u32x2*)(lds + b * CV_RS + (CV_PADL + t) * 2) = w; } }
    conv_load_filter(lds, GR + (size_t)c * 8192);
    __syncthreads();
    f32x16 acc[2][2];
    conv_mfma_loop(lds, acc, wid, lane);
    __syncthreads();
    { const float invs = 1.0f / ssum[c], sk = p.skip[c];
        const float w0 = p.conv_w[1024 + c], w1 = p.conv_w[3072 + 1024 + c], w2 = p.conv_w[6144 + 1024 + c], bias = p.conv_b[1024 + c];
        const int b = l31 & 7;
#pragma unroll
        for (int n = 0; n < 2; ++n) { const int i = 4 * (2 * wid + n) + (l31 >> 3);
#pragma unroll
            for (int mt = 0; mt < 2; ++mt)
#pragma unroll
                for (int g = 0; g < 4; ++g) { const int t = 64 * i + 32 * mt + 8 * g + 4 * hi; float x1[4];
                    sconv4(PT + ((size_t)(b * 4096 + 1024 + c)) * 4096, t, w0, w1, w2, bias, x1);
                    char* up = lds + b * CV_RS + (CV_PADL + t) * 2; const u32x2 vw = *(const u32x2*)up;
                    const float z0 = x1[0] * (acc[n][mt][4 * g] * invs + sk * lo_bf(vw.x)), z1 = x1[1] * (acc[n][mt][4 * g + 1] * invs + sk * hi_bf(vw.x));
                    const float z2 = x1[2] * (acc[n][mt][4 * g + 2] * invs + sk * lo_bf(vw.y)), z3 = x1[3] * (acc[n][mt][4 * g + 3] * invs + sk * hi_bf(vw.y));
                    u32x2 w; w.x = pk2(z0, z1); w.y = pk2(z2, z3); *(u32x2*)up = w; } } }
    conv_load_filter(lds, GR + (size_t)(1024 + c) * 8192);
    __syncthreads();
    conv_mfma_loop(lds, acc, wid, lane);
    { const float invs = 1.0f / ssum[1024 + c], sk = p.skip[1024 + c];
        const float w0 = p.conv_w[2048 + c], w1 = p.conv_w[3072 + 2048 + c], w2 = p.conv_w[6144 + 2048 + c], bias = p.conv_b[2048 + c];
        const int b = l31 & 7;
#pragma unroll
        for (int n = 0; n < 2; ++n) { const int i = 4 * (2 * wid + n) + (l31 >> 3);
#pragma unroll
            for (int mt = 0; mt < 2; ++mt)
#pragma unroll
                for (int g = 0; g < 4; ++g) { const int t = 64 * i + 32 * mt + 8 * g + 4 * hi; float x2[4];
                    sconv4(PT + ((size_t)(b * 4096 + 2048 + c)) * 4096, t, w0, w1, w2, bias, x2);
                    const u32x2 zw = *(const u32x2*)(lds + b * CV_RS + (CV_PADL + t) * 2);
                    const u32x2 gw = *(const u32x2*)(PT + ((size_t)(b * 4096 + 3072 + c)) * 4096 + t);
                    const float y0 = x2[0] * (acc[n][mt][4 * g] * invs + sk * lo_bf(zw.x)) * silu(lo_bf(gw.x)), y1 = x2[1] * (acc[n][mt][4 * g + 1] * invs + sk * hi_bf(zw.x)) * silu(hi_bf(gw.x));
                    const float y2 = x2[2] * (acc[n][mt][4 * g + 2] * invs + sk * lo_bf(zw.y)) * silu(lo_bf(gw.y)), y3 = x2[3] * (acc[n][mt][4 * g + 3] * invs + sk * hi_bf(zw.y)) * silu(hi_bf(gw.y));
                    u32x2 w; w.x = pk2(y0, y1); w.y = pk2(y2, y3); *(u32x2*)(OG2 + ((size_t)(b * 1024 + c)) * 4096 + t) = w; } } }
    __syncthreads();
}

#define XB_TMO      128
#define XB_XCNT(j)  (256  + 64 * (j))
#define XB_XSUB(j)  (1280 + 64 * (j))
#define XB_XGEN(j)  (2304 + 64 * (j))
#define XB_TOP      3328
#define XB_TOPGEN   3392
#define XCD_BAR_WORDS 3456
#define XB_SPIN_CAP (1u << 20)
DEV unsigned xb_ld(unsigned* p) { return __hip_atomic_load(p, __ATOMIC_RELAXED, __HIP_MEMORY_SCOPE_AGENT); }
DEV unsigned xb_add(unsigned* p, unsigned v) { return __hip_atomic_fetch_add(p, v, __ATOMIC_RELAXED, __HIP_MEMORY_SCOPE_AGENT); }
DEV unsigned xb_xcc_id() { return (unsigned)__builtin_amdgcn_s_getreg((3 << 11) | 20) & 0xFu; }
#define XB_SPIN(cond, bar) do { unsigned _sp = 0; while (cond) { __builtin_amdgcn_s_sleep(1); \
    if ((++_sp & 255u) == 0u) { if (xb_ld(&(bar)[XB_TMO])) break; if (_sp > XB_SPIN_CAP) { atomicAdd(&(bar)[XB_TMO], 1u); break; } } } } while (0)
struct XcdBarrier { unsigned* bar; unsigned x; volatile LAS unsigned* st; };
DEV XcdBarrier xcd_barrier_post(unsigned* bar, volatile LAS unsigned* st) {
    XcdBarrier b; b.bar = bar; b.x = xb_xcc_id(); b.st = st;
    if (threadIdx.x == 0) (void)xb_add(&bar[XB_XCNT(b.x)], 1u);
    return b;
}
DEV void xcd_barrier_complete(unsigned* bar, unsigned x, unsigned& nloc, unsigned& nx) {
    const unsigned G = gridDim.x * gridDim.y * gridDim.z;
    unsigned sum, cnt, mine, sp = 0u;
    for (;;) {
        sum = 0u; cnt = 0u; mine = 0u;
#pragma unroll
        for (unsigned j = 0; j < 16; ++j) { const unsigned c = xb_ld(&bar[XB_XCNT(j)]); sum += c; cnt += (c > 0u) ? 1u : 0u; mine = (j == x) ? c : mine; }
        if (sum == G) break;
        __builtin_amdgcn_s_sleep(1);
        if ((++sp & 255u) == 0u) { if (xb_ld(&bar[XB_TMO])) break; if (sp > XB_SPIN_CAP) { atomicAdd(&bar[XB_TMO], 1u); break; } }
    }
    nloc = mine > 0u ? mine : 1u; nx = cnt > 0u ? cnt : 1u;
}
DEV void xcd_barrier(const XcdBarrier& b) {
    asm volatile("s_waitcnt vmcnt(0)" ::: "memory");
    __syncthreads();
    if (threadIdx.x == 0) {
        unsigned* bar = b.bar;
        __builtin_amdgcn_s_waitcnt(0);
        unsigned nloc = b.st[0], nx = b.st[1];
        if (nloc == 0u) { xcd_barrier_complete(bar, b.x, nloc, nx); b.st[0] = nloc; b.st[1] = nx; }
        const unsigned old = xb_add(&bar[XB_XSUB(b.x)], 1u);
        const unsigned gen = old / nloc;
        if (old + 1u == (gen + 1u) * nloc) {
            __builtin_amdgcn_fence(__ATOMIC_RELEASE, "agent");
            asm volatile("s_waitcnt vmcnt(0)" ::: "memory");
            const unsigned og = xb_add(&bar[XB_TOP], 1u);
            const unsigned tg = og / nx;
            if (og + 1u == (tg + 1u) * nx) xb_add(&bar[XB_TOPGEN], 1u);
            else XB_SPIN(xb_ld(&bar[XB_TOPGEN]) == tg, bar);
            __builtin_amdgcn_fence(__ATOMIC_ACQUIRE, "agent");
            xb_add(&bar[XB_XGEN(b.x)], 1u);
            asm volatile("s_waitcnt vmcnt(0)" ::: "memory");
        } else {
            XB_SPIN(xb_ld(&bar[XB_XGEN(b.x)]) == gen, bar);
            __builtin_amdgcn_fence(__ATOMIC_ACQUIRE, "agent");
            asm volatile("s_waitcnt vmcnt(0)" ::: "memory");
        }
    }
    __syncthreads();
}

constexpr int NPHASE = 12;
__global__ void __launch_bounds__(512) fwd_kernel(Params p) {
    extern __shared__ __attribute__((aligned(16))) char lds[];
    char* ws = p.ws;
    volatile LAS unsigned* bst = (volatile LAS unsigned*)(LAS char*)(lds + LDS_BYTES - 64);
    if (threadIdx.x < 16) bst[threadIdx.x] = 0u;
    __syncthreads();
    XcdBarrier xbar; xbar.bar = (unsigned*)(ws + WS_CTL); xbar.x = 0; xbar.st = bst;
    if (MK_LAUNCHES == 1) xbar = xcd_barrier_post((unsigned*)(ws + WS_CTL), bst);
#define SEAM(k) do { if (MK_LAUNCHES == 1 && (k) + 1 < p.ph_hi) { if ((k) == 0) cg::this_grid().sync(); else xcd_barrier(xbar); } } while (0)
#ifndef PHASE_MASK
#define PHASE_MASK 0xFFF
#endif
#define IN(k) (((PHASE_MASK >> (k)) & 1) && p.ph_lo <= (k) && (k) < p.ph_hi)
#define REP(k) for (int rep_ = 0; rep_ < ((PROBE_REPEAT == (k)) ? 2 : 1); ++rep_)
    if (IN(0)) { REP(0) phase_prep(lds, p); SEAM(0); }
    if (IN(1)) {
        EpiFilt ef{(bf16_t*)(ws + WS_GR), (float*)(ws + WS_SSUM), p.f_b3};
        gemm_phase<false, EpiFilt>(lds, (const bf16_t*)(ws + WS_W3), 64, (const bf16_t*)(ws + WS_HID2), 64, 4096, 4096, 64, ef);
        phase_norm0(p); SEAM(1); }
    if (IN(2)) {
        REP(2) { pg8::Gemm g{(const bf16_t*)(ws + WS_H0), (const bf16_t*)(ws + WS_WIN), NALL, AINP, DM}; pg8::StaticOrder S; S.init(NALL, AINP, (int)gridDim.x, (int)blockIdx.x);
            pg8::EpiBf16 E{(bf16_t*)(ws + WS_PRAW), (size_t)AINP, 0, 0};
            pg8::gemm_phase<pg8::EpiBf16, pg8::StaticOrder, true, true>((PG8_LAS unsigned char*)lds, g, S, E); }
        SEAM(2); }
    if (IN(3)) { REP(3) phase_post(p); SEAM(3); }
    if (IN(4)) {
        const float* rp = (const float*)(ws + WS_ROPE);
        REP(4) {
        EpiUq eq{(bf16_t*)(ws + WS_QM), rp + 2048, rp + 2560};
        gemm_phase<false, EpiUq>(lds, (const bf16_t*)(ws + WS_CQN), 256, (const bf16_t*)(ws + WS_WUQ), 256, NTOK, 768, 256, eq);
        EpiUkv ek{(bf16_t*)(ws + WS2_KM), (bf16_t*)(ws + WS2_VM)};
        gemm_phase<false, EpiUkv>(lds, (const bf16_t*)(ws + WS_CKVN), 128, (const bf16_t*)(ws + WS_WUKV), 128, NALL, 1024, 128, ek); }
        SEAM(4); }
    if (IN(5)) { REP(5) phase_attn(lds, p); SEAM(5); }
    if (IN(6)) {
        REP(6) { pg8::Gemm g{(const bf16_t*)(ws + WS2_OG), (const bf16_t*)(ws + WS_WOUT), NTOK, DM, DM}; pg8::StaticOrder S; S.init(NTOK, DM, (int)gridDim.x, (int)blockIdx.x);
            pg8::EpiResF32 E{p.x, p.out, (const float*)(ws + WS_MOD0), (DBG_SKIP & 1) ? 0.f : 1.f};
            pg8::gemm_phase<pg8::EpiResF32, pg8::StaticOrder, true, true>((PG8_LAS unsigned char*)lds, g, S, E); }
        SEAM(6); }
    if (IN(7)) { REP(7) phase_norm1(p); SEAM(7); }
    if (IN(8)) {
        REP(8) { pg8::Gemm g{(const bf16_t*)(ws + WS_HWIN), (const bf16_t*)(ws + WS_H1), 4096, NTOK, DM}; pg8::StaticOrder S; S.init(4096, NTOK, (int)gridDim.x, (int)blockIdx.x);
            pg8::EpiBf16 E{(bf16_t*)(ws + WS_PT), (size_t)4096, 4096, (size_t)4096 * 4096};
            pg8::gemm_phase<pg8::EpiBf16, pg8::StaticOrder, true, true>((PG8_LAS unsigned char*)lds, g, S, E); }
        SEAM(8); }
    if (IN(9)) { REP(9) for (int c = blockIdx.x; c < 1024; c += gridDim.x) conv_unit(lds, p, c); SEAM(9); }
    if (IN(10)) {
        EpiRes e{p.out, p.out, (const float*)(ws + WS_MOD1), (DBG_SKIP & 2) ? 0.f : 1.f};
        const bf16_t* OG2 = (const bf16_t*)(ws + WS_OG2); const bf16_t* W = (const bf16_t*)(ws + WS_HWOUT);
        const int nt = (NTOK / 256) * (DM / 128);
        for (int t = blockIdx.x; t < nt; t += gridDim.x) { const int ti = t / 8, tj = t % 8; const int b = ti >> 4, l0 = (ti & 15) * 256;
            gemm_tile<true, EpiRes>(lds, OG2 + (size_t)b * 1024 * 4096 + l0, 4096, W + (size_t)tj * 128 * DM, DM, DM, e, ti * 256, tj * 128); }
        SEAM(10); }
    if (IN(11)) { phase_final(p); }
#undef SEAM
#undef IN
}

extern "C" void kernel_launch(void* const* d_in, const int* in_sizes, int n_in, void* d_out, int out_size, void* d_ws, size_t ws_size, hipStream_t stream) {
    static int grid = 0;
    if (grid == 0) {
        if (n_in != 28 || out_size != NTOK * DM || ws_size < WS_END) { fprintf(stderr, "kernel_launch: unexpected shapes n_in %d out %d ws %zu\n", n_in, out_size, ws_size); grid = -1; return; }
        int dev = 0, cus = 0, per_cu = 0;
        hipGetDevice(&dev); hipDeviceGetAttribute(&cus, hipDeviceAttributeMultiprocessorCount, dev);
        if (hipFuncSetAttribute((const void*)fwd_kernel, hipFuncAttributeMaxDynamicSharedMemorySize, LDS_BYTES) != hipSuccess) { fprintf(stderr, "hipFuncSetAttribute failed\n"); grid = -1; return; }
        hipOccupancyMaxActiveBlocksPerMultiprocessor(&per_cu, (const void*)fwd_kernel, 512, LDS_BYTES);
        if (per_cu < 1) { fprintf(stderr, "occupancy query says %d\n", per_cu); per_cu = 1; }
        grid = cus * 1;
        (void)hipGetLastError();
    }
    if (grid < 0) return;
    Params p{};
    const float** pp = (const float**)&p;
    for (int i = 0; i < 28; ++i) pp[i] = (const float*)d_in[i];
    p.out = (float*)d_out; p.ws = (char*)d_ws;
#if MK_LAUNCHES == 1
    if (hipMemsetAsync((char*)d_ws + WS_CTL, 0, CTL_BYTES, stream) != hipSuccess) { fprintf(stderr, "memset failed\n"); return; }
    p.ph_lo = 0; p.ph_hi = NPHASE;
    void* args[] = {&p};
    hipError_t e = hipLaunchCooperativeKernel((const void*)fwd_kernel, dim3(grid), dim3(512), args, LDS_BYTES, stream);
    if (e != hipSuccess) fprintf(stderr, "cooperative launch failed: %s (grid %d)\n", hipGetErrorString(e), grid);
#else
    for (int k = 0; k < NPHASE; ++k) { p.ph_lo = k; p.ph_hi = k + 1; hipLaunchKernelGGL(fwd_kernel, dim3(grid), dim3(512), LDS_BYTES, stream, p); }
#endif
}
```

```cpp
#include <hip/hip_runtime.h>
#include <hip/hip_cooperative_groups.h>
#include <cstdio>
#include <cstdint>
namespace cg = cooperative_groups;

#ifndef MK_LAUNCHES
#define MK_LAUNCHES 1
#endif

#ifndef PROBE_REPEAT
#define PROBE_REPEAT -1
#endif
#ifndef DBG_SKIP
#define DBG_SKIP 0
#endif
#define DEV __device__ __forceinline__
typedef unsigned short bf16_t;
typedef short bf16x8 __attribute__((ext_vector_type(8)));
typedef short s16x4 __attribute__((ext_vector_type(4)));
typedef float f32x16 __attribute__((ext_vector_type(16)));
typedef float f32x4 __attribute__((ext_vector_type(4)));
typedef float f32x2 __attribute__((ext_vector_type(2)));
typedef unsigned u32x4 __attribute__((ext_vector_type(4)));
typedef unsigned u32x2 __attribute__((ext_vector_type(2)));
typedef __bf16 bf16x2_t __attribute__((ext_vector_type(2)));
#define LAS __attribute__((address_space(3)))

constexpr int NB = 8, SEQ = 4096, DM = 1024, CTXL = 256, LK = SEQ + CTXL;
constexpr int NTOK = NB * SEQ, NCTX = NB * CTXL, NALL = NTOK + NCTX;
constexpr int AIN = 2208, AINP = 2304;
constexpr float EPS = 1e-6f;
constexpr float LOG2E = 1.4426950408889634f;
constexpr float QSC_A = 0.125f * LOG2E;
constexpr float QSC_M = 0.10206207261596575f * LOG2E;

constexpr size_t MiB = 1ull << 20;
constexpr size_t WS_WIN = 0;
constexpr size_t WS_WUQ = 5 * MiB;
constexpr size_t WS_WUKV = 6 * MiB;
constexpr size_t WS_WOUT = 7 * MiB;
constexpr size_t WS_HWIN = 9 * MiB;
constexpr size_t WS_HWOUT = 17 * MiB;
constexpr size_t WS_W3 = 19 * MiB;
constexpr size_t WS_HID2 = 20 * MiB;
constexpr size_t WS_MOD0 = 21 * MiB;
constexpr size_t WS_MOD1 = WS_MOD0 + 9 * 3072 * 4;
constexpr size_t WS_SSUM = WS_MOD1 + 8 * 3072 * 4;
constexpr size_t WS_ROPE = WS_SSUM + 2048 * 4;
constexpr size_t WS_GR = 22 * MiB;
constexpr size_t WS_H0 = 64 * MiB;
constexpr size_t WS_PRAW = 136 * MiB;
constexpr size_t WS_QA = 297 * MiB;
constexpr size_t WS_KA = 329 * MiB;
constexpr size_t WS_VA = 338 * MiB;
constexpr size_t WS_CQN = 347 * MiB;
constexpr size_t WS_CKVN = 363 * MiB;
constexpr size_t WS_G = 372 * MiB;
constexpr size_t WS_QM = 64 * MiB;
constexpr size_t WS_KM = 136 * MiB;
constexpr size_t WS_VM = 190 * MiB;
constexpr size_t WS_OG = 226 * MiB;
constexpr size_t WS_H1 = 436 * MiB;
constexpr size_t WS_PT = 64 * MiB;
constexpr size_t WS_OG2 = 320 * MiB;
constexpr size_t WS_CTL = 500 * MiB;
constexpr size_t CTL_BYTES = 16384;
constexpr size_t WS_END = 500 * MiB + CTL_BYTES;
constexpr size_t WS2_KM = 436 * MiB;
constexpr size_t WS2_VM = 190 * MiB;
constexpr size_t WS2_OG = 226 * MiB;

constexpr int LDS_BYTES = 150 * 1024;

DEV float bf2f(bf16_t v) { return __uint_as_float(((unsigned)v) << 16); }
DEV unsigned pk2(float lo, float hi) { f32x2 v = {lo, hi}; bf16x2_t b = __builtin_convertvector(v, bf16x2_t); return __builtin_bit_cast(unsigned, b); }
DEV bf16_t f2bf(float f) { return (bf16_t)(pk2(f, 0.f) & 0xffffu); }
DEV float lo_bf(unsigned w) { return __uint_as_float(w << 16); }
DEV float hi_bf(unsigned w) { return __uint_as_float(w & 0xffff0000u); }
DEV int crow(int r, int hi) { return (r & 3) + 8 * (r >> 2) + 4 * hi; }
DEV float silu(float v) { return v / (1.f + __expf(-v)); }
DEV void unpack8(const u32x4 w, float* v) { v[0] = lo_bf(w.x); v[1] = hi_bf(w.x); v[2] = lo_bf(w.y); v[3] = hi_bf(w.y); v[4] = lo_bf(w.z); v[5] = hi_bf(w.z); v[6] = lo_bf(w.w); v[7] = hi_bf(w.w); }
DEV u32x4 pack8(const float* v) { u32x4 w; w.x = pk2(v[0], v[1]); w.y = pk2(v[2], v[3]); w.z = pk2(v[4], v[5]); w.w = pk2(v[6], v[7]); return w; }

struct Params {
    const float *x, *c, *ctx, *c_ctx, *ada_w, *ada_b, *norm_w, *w_in, *q_norm, *k_norm, *cq_norm, *ckv_norm, *w_uq, *w_ukv, *w_out,
        *hy_w_in, *conv_w, *conv_b, *f_w1, *f_b1, *f_w2, *f_b2, *f_w3, *f_b3, *freq, *skip, *hy_w_out, *final_w;
    float* out; char* ws; int ph_lo, ph_hi;
};

constexpr int G_RS = 144;
constexpr int G_RB = 256 * G_RS, G_CB = 128 * G_RS, G_STAGE = G_RB + G_CB;
constexpr int T_RS = 576;

template <bool TR, class Epi>
DEV void gemm_tile(char* lds, const bf16_t* __restrict__ R, size_t ldr, const bf16_t* __restrict__ C, size_t ldc, int K, const Epi& epi, int ti0, int tj0) {
    const int tid = threadIdx.x, lane = tid & 63, wid = tid >> 6;
    const int wi = wid >> 1, wj = wid & 1, l31 = lane & 31, hi = lane >> 5;
    f32x16 acc[2][2];
#pragma unroll
    for (int a = 0; a < 2; ++a)
#pragma unroll
        for (int b = 0; b < 2; ++b)
#pragma unroll
            for (int r = 0; r < 16; ++r) acc[a][b][r] = 0.f;
    u32x4 rr[4], rc[2];
    const bf16_t* Rp; const bf16_t* Cp; int rl_off, cl_off;
    if (TR) { const int c = tid & 31, kr = tid >> 5; Rp = R + (size_t)kr * ldr + c * 8; rl_off = kr * T_RS + c * 16; }
    else { const int lr = tid >> 3, lc = tid & 7; Rp = R + (size_t)lr * ldr + lc * 8; rl_off = lr * G_RS + lc * 16; }
    { const int lr = tid >> 3, lc = tid & 7; Cp = C + (size_t)lr * ldc + lc * 8; cl_off = lr * G_RS + lc * 16; }
    const int nk = K / 64;
    int ra_off[2], cb_off[2];
#pragma unroll
    for (int t = 0; t < 2; ++t) {
        if (TR) { const int g1 = (lane >> 4) & 1, q = (lane & 15) >> 2, p = lane & 3; ra_off[t] = (8 * hi + q) * T_RS + (wi * 64 + t * 32 + 16 * g1 + 4 * p) * 2; }
        else ra_off[t] = (wi * 64 + t * 32 + l31) * G_RS + hi * 16;
        cb_off[t] = G_RB + (wj * 64 + t * 32 + l31) * G_RS + hi * 16;
    }
#define G_LOAD(kt) do { \
        if (TR) { _Pragma("unroll") for (int p = 0; p < 4; ++p) rr[p] = *(const u32x4*)(Rp + ((size_t)(kt) * 64 + 16 * p) * ldr); } \
        else { _Pragma("unroll") for (int p = 0; p < 4; ++p) rr[p] = *(const u32x4*)(Rp + (size_t)(64 * p) * ldr + (kt) * 64); } \
        _Pragma("unroll") for (int p = 0; p < 2; ++p) rc[p] = *(const u32x4*)(Cp + (size_t)(64 * p) * ldc + (kt) * 64); } while (0)
#define G_STORE(buf) do { char* b_ = lds + (buf) * G_STAGE; \
        if (TR) { _Pragma("unroll") for (int p = 0; p < 4; ++p) *(u32x4*)(b_ + rl_off + 16 * p * T_RS) = rr[p]; } \
        else { _Pragma("unroll") for (int p = 0; p < 4; ++p) *(u32x4*)(b_ + rl_off + 64 * p * G_RS) = rr[p]; } \
        _Pragma("unroll") for (int p = 0; p < 2; ++p) *(u32x4*)(b_ + G_RB + cl_off + 64 * p * G_RS) = rc[p]; } while (0)
    G_LOAD(0); G_STORE(0);
    __syncthreads();
    for (int kt = 0; kt < nk; ++kt) {
        const bool more = (kt + 1 < nk);
        if (more) G_LOAD(kt + 1);
        const char* b_ = lds + (kt & 1) * G_STAGE;
#pragma unroll
        for (int ks = 0; ks < 4; ++ks) {
            bf16x8 fa[2], fb[2];
#pragma unroll
            for (int t = 0; t < 2; ++t) {
                if (TR) {
                    const s16x4 lo = __builtin_bit_cast(s16x4, __builtin_amdgcn_ds_read_tr16_b64_v4i16((LAS s16x4*)(b_ + ra_off[t] + ks * 16 * T_RS)));
                    const s16x4 hh = __builtin_bit_cast(s16x4, __builtin_amdgcn_ds_read_tr16_b64_v4i16((LAS s16x4*)(b_ + ra_off[t] + (ks * 16 + 4) * T_RS)));
                    fa[t] = (bf16x8){lo[0], lo[1], lo[2], lo[3], hh[0], hh[1], hh[2], hh[3]};
                } else fa[t] = *(const bf16x8*)(b_ + ra_off[t] + ks * 32);
                fb[t] = *(const bf16x8*)(b_ + cb_off[t] + ks * 32);
            }
#pragma unroll
            for (int a = 0; a < 2; ++a)
#pragma unroll
                for (int b = 0; b < 2; ++b) acc[a][b] = __builtin_amdgcn_mfma_f32_32x32x16_bf16(fa[a], fb[b], acc[a][b], 0, 0, 0);
        }
        if (more) G_STORE((kt + 1) & 1);
        __syncthreads();
    }
#undef G_LOAD
#undef G_STORE
#pragma unroll
    for (int a = 0; a < 2; ++a)
#pragma unroll
        for (int b = 0; b < 2; ++b) epi(ti0 + wi * 64 + a * 32, tj0 + wj * 64 + b * 32, acc[a][b], l31, hi);
}

template <bool TR, class Epi>
DEV void gemm_phase(char* lds, const bf16_t* R, size_t ldr, const bf16_t* C, size_t ldc, int nI, int nJ, int K, const Epi& epi) {
    const int tI = nI / 256, tJ = nJ / 128, nt = tI * tJ;
    for (int t = blockIdx.x; t < nt; t += gridDim.x) {
        const int ti = t / tJ, tj = t % tJ;
        gemm_tile<TR, Epi>(lds, R + (size_t)ti * 256 * ldr, ldr, C + (size_t)tj * 128 * ldc, ldc, K, epi, ti * 256, tj * 128);
    }
}

struct EpiRaw {
    bf16_t* O; size_t ld;
    DEV void operator()(int i0, int j0, const f32x16& a, int l31, int hi) const {
#pragma unroll
        for (int r = 0; r < 16; ++r) O[(size_t)(i0 + crow(r, hi)) * ld + j0 + l31] = f2bf(a[r]);
    }
};
struct EpiUq {
    bf16_t* QM; const float* cos32; const float* sin32;
    DEV void operator()(int i0, int j0, const f32x16& a, int l31, int hi) const {
        const bool pe = (j0 % 96) == 64;
        const int fi = l31 & 7; const bool colang = (l31 & 16) != 0; const bool bpart = (l31 & 8) != 0;
#pragma unroll
        for (int r = 0; r < 16; ++r) {
            const int tok = i0 + crow(r, hi); float v = a[r];
            const float o = __shfl_xor(v, 8);
            if (pe) { const int l = tok & (SEQ - 1); const int pos = colang ? (l & 63) : (l >> 6);
                const float cs = cos32[pos * 8 + fi], sn = sin32[pos * 8 + fi];
                v = bpart ? (v * cs + o * sn) : (v * cs - o * sn); }
            QM[(size_t)tok * 768 + j0 + l31] = f2bf(v * QSC_M);
        }
    }
};
struct EpiUkv {
    bf16_t* KM; bf16_t* VM;
    DEV void operator()(int i0, int j0, const f32x16& a, int l31, int hi) const {
        const int h = j0 >> 7, e = (j0 & 127) + l31;
#pragma unroll
        for (int r = 0; r < 16; ++r) { const size_t row = (size_t)(i0 + crow(r, hi));
            if (e < 64) KM[row * 768 + h * 96 + e] = f2bf(a[r]); else VM[row * 512 + h * 64 + (e - 64)] = f2bf(a[r]); }
    }
};
struct EpiRes {
    const float* base; float* out; const float* mod; float gmul;
    DEV void operator()(int i0, int j0, const f32x16& a, int l31, int hi) const {
        const int b = i0 >> 12; const float g = mod[b * 3072 + 2048 + j0 + l31] * gmul;
#pragma unroll
        for (int h8 = 0; h8 < 2; ++h8) { float bv[8];
#pragma unroll
            for (int r = 0; r < 8; ++r) bv[r] = base[(size_t)(i0 + crow(8 * h8 + r, hi)) * DM + j0 + l31];
#pragma unroll
            for (int r = 0; r < 8; ++r) out[(size_t)(i0 + crow(8 * h8 + r, hi)) * DM + j0 + l31] = bv[r] + g * a[8 * h8 + r]; }
    }
};
struct EpiPT {
    bf16_t* PT;
    DEV void operator()(int i0, int j0, const f32x16& a, int l31, int hi) const {
        const int b = j0 >> 12, l = (j0 & 4095) + l31;
#pragma unroll
        for (int r = 0; r < 16; ++r) PT[((size_t)(b * 4096 + i0 + crow(r, hi))) * 4096 + l] = f2bf(a[r]);
    }
};
struct EpiFilt {
    bf16_t* GR; float* ssum; const float* b3;
    DEV void operator()(int i0, int j0, const f32x16& a, int l31, int hi) const {
        const int t = j0 + l31; const float tn = (float)t * (1.0f / 4095.0f);
        const float dmin = -3.0701134573253945f, dmax = -15.350567286626973f;
#pragma unroll
        for (int r = 0; r < 16; ++r) {
            const int n = i0 + crow(r, hi); const int c = n & 1023, od = n >> 10, o = od >> 1, dir = od & 1;
            const float delta = fabsf(dmin + (float)c * ((dmax - dmin) / 1023.0f));
            float v = (a[r] + b3[n]) * __expf(-tn * delta);
            bf16_t* g = GR + ((size_t)(o * 1024 + c)) * 8192;
            if (dir == 0) g[4096 - t] = f2bf(v);
            else { if (t == 0) { g[0] = 0; v = 0.f; } else g[4096 + t] = f2bf(v); }
            float s = fabsf(v);
            s += __shfl_xor(s, 16); s += __shfl_xor(s, 8); s += __shfl_xor(s, 4); s += __shfl_xor(s, 2); s += __shfl_xor(s, 1);
            if (l31 == 0) atomicAdd(ssum + o * 1024 + c, s);
        }
    }
};

namespace pg8 {
#define PG8_LAS __attribute__((address_space(3)))
typedef short bf16x8 __attribute__((ext_vector_type(8)));
typedef float f32x4 __attribute__((ext_vector_type(4)));
typedef unsigned u32x4 __attribute__((ext_vector_type(4)));
constexpr int BM = 256, BK = 64, HALF = 128, HTB = HALF * BK * 2  , STAGE_BYTES = 8 * HTB, NXCD = 8, WGM = 8;

__host__ __device__ __forceinline__ int lds_byte(int r, int c) { const int st = (r >> 4) * 2 + (c >> 5), rr = r & 15, cc = c & 31, ob = rr * 64 + cc * 2; return st * 1024 + (ob ^ (((ob >> 9) & 1) << 5)); }
__host__ __device__ __forceinline__ void stage_rc(int b, int& R, int& C) { const int st = b / 1024, sb = b % 1024, swz = sb ^ (((sb >> 9) & 1) << 5); R = (st >> 1) * 16 + swz / 64; C = (st & 1) * 32 + (swz % 64) / 2; }
__host__ __device__ __forceinline__ int perm32(int rho) { const int n = rho >> 4, i = rho & 15; return 8 * (i >> 2) + 4 * n + (i & 3); }

struct Unit { int pm, pn; };
struct Gemm { const bf16_t* A; const bf16_t* Bt; int M, N, K; };

struct StaticOrder {
    int nM, nN, nwg, G, c;
    __host__ __device__ void init(int M, int N, int G_, int c_) { nM = M / BM; nN = N / BM; nwg = nM * nN; G = G_; c = c_; }
    __host__ __device__ bool next(int i, Unit& u) const {
        const long L = (long)i * G + c; if (L >= nwg) return false;
        int wgid = (int)L; { const int q = nwg / NXCD, r = nwg % NXCD, xcd = wgid % NXCD, off = wgid / NXCD; wgid = (xcd < r ? xcd * (q + 1) : r * (q + 1) + (xcd - r) * q) + off; }
        const int nig = WGM * nN, gid = wgid / nig, fm = gid * WGM, gsz = (nM - fm) < WGM ? (nM - fm) : WGM;
        u.pm = fm + ((wgid % nig) % gsz); u.pn = (wgid % nig) / gsz; return true;
    }
    __device__ __forceinline__ void a_ready(const Unit&) const {}
    __device__ __forceinline__ void done(const Unit&) const {}
};

__device__ __forceinline__ unsigned cvt_pk_bf16(float lo, float hi) { unsigned r; asm volatile("v_cvt_pk_bf16_f32 %0, %1, %2" : "=v"(r) : "v"(lo), "v"(hi)); return r; }
typedef float f32x2 __attribute__((ext_vector_type(2)));

struct EpiBf16 {
    static constexpr bool PERM = true, AFTER_DRAIN = false;
    bf16_t* O; size_t ldc; int split_cols; size_t split_stride;
    __device__ __forceinline__ void operator()(const f32x4 (&acc)[2][2][4][2], const Unit& u, int wr, int wc, int fr, int fq) const {
        const int row0 = u.pm * BM + wr * 64 + fr; int colt = u.pn * BM; bf16_t* base = O;
        if (split_cols) { const int t = colt / split_cols; base += (size_t)t * split_stride; colt -= t * split_cols; }
        const int col0 = colt + wc * 32 + 8 * fq;
#pragma unroll
        for (int ai = 0; ai < 2; ++ai)
#pragma unroll
            for (int m = 0; m < 4; ++m) { bf16_t* rowp = base + (size_t)(row0 + ai * HALF + m * 16) * ldc + col0;
#pragma unroll
                for (int bj = 0; bj < 2; ++bj) { const f32x4 v0 = acc[ai][bj][m][0], v1 = acc[ai][bj][m][1];
                    u32x4 w; w.x = cvt_pk_bf16(v0[0], v0[1]); w.y = cvt_pk_bf16(v0[2], v0[3]); w.z = cvt_pk_bf16(v1[0], v1[1]); w.w = cvt_pk_bf16(v1[2], v1[3]);
                    *(u32x4*)(rowp + bj * HALF) = w; } }
    }
};
struct EpiResF32 {
    static constexpr bool PERM = false, AFTER_DRAIN = false;
    const float* base; float* out; const float* mod; float gmul;
    __device__ __forceinline__ void operator()(const f32x4 (&acc)[2][2][4][2], const Unit& u, int wr, int wc, int fr, int fq) const {
        const int row0 = u.pm * BM + wr * 64 + fr, col0 = u.pn * BM + wc * 32 + 4 * fq, b = (u.pm * BM) >> 12;
        f32x4 g[2][2];
#pragma unroll
        for (int bj = 0; bj < 2; ++bj)
#pragma unroll
            for (int n = 0; n < 2; ++n) g[bj][n] = *(const f32x4*)(mod + b * 3072 + 2048 + col0 + bj * HALF + n * 16) * gmul;
#pragma unroll
        for (int ai = 0; ai < 2; ++ai) {
            f32x4 pre[4][2][2];
#pragma unroll
            for (int m = 0; m < 4; ++m) { const size_t off = (size_t)(row0 + ai * HALF + m * 16) * 1024 + col0;
#pragma unroll
                for (int bj = 0; bj < 2; ++bj)
#pragma unroll
                    for (int n = 0; n < 2; ++n) pre[m][bj][n] = *(const f32x4*)(base + off + bj * HALF + n * 16); }
#pragma unroll
            for (int m = 0; m < 4; ++m) { const size_t off = (size_t)(row0 + ai * HALF + m * 16) * 1024 + col0;
#pragma unroll
                for (int bj = 0; bj < 2; ++bj)
#pragma unroll
                    for (int n = 0; n < 2; ++n) *(f32x4*)(out + off + bj * HALF + n * 16) = pre[m][bj][n] + g[bj][n] * acc[ai][bj][m][n]; }
        }
    }
};
template <class Epi, class Sched, bool ALIGN_EPI = false, bool SP2 = false>
__device__ __forceinline__ void gemm_phase(PG8_LAS unsigned char* lds, const Gemm g, const Sched& S, const Epi& E) {
    const int tid = threadIdx.x, wid = __builtin_amdgcn_readfirstlane(tid >> 6), lane = tid & 63, wr = wid >> 2, wc = wid & 3, fr = lane & 15, fq = lane >> 4;
    const int K = g.K, nt = K / BK;
    unsigned voffA[2], voffB[2];
#pragma unroll
    for (int i = 0; i < 2; ++i) { int R, C; stage_rc(tid * 16 + i * 8192, R, C); const int Rb = Epi::PERM ? ((R & ~31) + perm32(R & 31)) : R;
        voffA[i] = (unsigned)(R * K + C) * 2u; voffB[i] = (unsigned)(Rb * K + C) * 2u; }
    const size_t kstep = (size_t)(BK * 2);
    const size_t hstep = (size_t)HALF * K * 2;
    const size_t tstep = 2 * hstep;
    const unsigned ldsw = (unsigned)wid * 1024u;
    const int aoff = lds_byte(wr * 64 + fr, fq * 8), boff = lds_byte(wc * 32 + fr, fq * 8);
#define PG8_SA(b, h) (((b) * 2 + (h)) * HTB)
#define PG8_SB(b, h) ((4 + (b) * 2 + (h)) * HTB)
#define PG8_STAGE(bufoff, gbase, voff) do { _Pragma("unroll") for (int _i = 0; _i < 2; ++_i) \
        __builtin_amdgcn_global_load_lds((const unsigned*)((const char*)(gbase) + (voff)[_i]), (PG8_LAS unsigned*)(lds + (bufoff) + ldsw + _i * 8192), 16, 0, 0); } while (0)
#define PG8_LDA(dst, b, h) do { _Pragma("unroll") for (int m = 0; m < 4; ++m) _Pragma("unroll") for (int k = 0; k < 2; ++k) dst[m][k] = *(const PG8_LAS bf16x8*)(lds + PG8_SA(b, h) + aoff + m * 2048 + k * 1024); } while (0)
#define PG8_LDB(dst, b, h) do { _Pragma("unroll") for (int n = 0; n < 2; ++n) _Pragma("unroll") for (int k = 0; k < 2; ++k) dst[n][k] = *(const PG8_LAS bf16x8*)(lds + PG8_SB(b, h) + boff + n * 2048 + k * 1024); } while (0)
#define PG8_MMA(ai, bj, At, Bt) do { __builtin_amdgcn_s_setprio(1); _Pragma("unroll") for (int m = 0; m < 4; ++m) _Pragma("unroll") for (int n = 0; n < 2; ++n) _Pragma("unroll") for (int k = 0; k < 2; ++k) \
        acc[ai][bj][m][n] = __builtin_amdgcn_mfma_f32_16x16x32_bf16(Bt[n][k], At[m][k], acc[ai][bj][m][n], 0, 0, 0); __builtin_amdgcn_s_setprio(0); } while (0)
#define PG8_WAIT_V(n) asm volatile("s_waitcnt vmcnt(" #n ")" ::: "memory")
#define PG8_WAIT_L(n) asm volatile("s_waitcnt lgkmcnt(" #n ")" ::: "memory")
#define PG8_BAR __builtin_amdgcn_s_barrier()
#define PG8_SCHED __builtin_amdgcn_sched_barrier(0)
    Unit cur, nxt; int ui = 0;
    if (!S.next(0, cur)) return;
    f32x4 acc[2][2][4][2];
#pragma unroll
    for (int a = 0; a < 2; ++a)
#pragma unroll
        for (int b = 0; b < 2; ++b)
#pragma unroll
            for (int m = 0; m < 4; ++m)
#pragma unroll
                for (int n = 0; n < 2; ++n) acc[a][b][m][n] = (f32x4){0.f, 0.f, 0.f, 0.f};
    bf16x8 At[4][2], B0[2][2], B1[2][2];
    const char* cA = (const char*)g.A + (size_t)cur.pm * tstep; const char* cB = (const char*)g.Bt + (size_t)cur.pn * tstep;
    S.a_ready(cur);
    if constexpr (SP2) {
        PG8_STAGE(PG8_SB(0, 0), cB, voffB); PG8_STAGE(PG8_SB(0, 1), cB + hstep, voffB); PG8_STAGE(PG8_SA(0, 0), cA, voffA); PG8_STAGE(PG8_SA(0, 1), cA + hstep, voffA);
        if (wr == 1) PG8_BAR;
        PG8_WAIT_V(2); PG8_BAR;
        PG8_STAGE(PG8_SB(1, 0), cB + kstep, voffB); PG8_STAGE(PG8_SA(1, 0), cA + kstep, voffA); PG8_STAGE(PG8_SB(1, 1), cB + hstep + kstep, voffB);
        PG8_WAIT_V(6); PG8_BAR;
    } else {
        PG8_STAGE(PG8_SB(0, 0), cB, voffB); PG8_STAGE(PG8_SA(0, 0), cA, voffA); PG8_STAGE(PG8_SB(0, 1), cB + hstep, voffB); PG8_STAGE(PG8_SA(0, 1), cA + hstep, voffA);
        if (wr == 1) PG8_BAR;
        PG8_WAIT_V(4); PG8_BAR;
        PG8_STAGE(PG8_SB(1, 0), cB + kstep, voffB); PG8_STAGE(PG8_SA(1, 0), cA + kstep, voffA); PG8_STAGE(PG8_SB(1, 1), cB + hstep + kstep, voffB);
        PG8_WAIT_V(6); PG8_BAR;
    }
    for (;;) {
        const bool has_next = S.next(ui + 1, nxt);
        const char* nA = has_next ? (const char*)g.A + (size_t)nxt.pm * tstep : cA; const char* nB = has_next ? (const char*)g.Bt + (size_t)nxt.pn * tstep : cB;
        for (int t = 0; t < nt; t += 2) {
            const bool last = (t == nt - 2);
            const char* a1 = cA + (size_t)(t + 1) * kstep;
            const char* a2 = last ? nA : cA + (size_t)(t + 2) * kstep; const char* b2 = last ? nB : cB + (size_t)(t + 2) * kstep;
            const char* a3 = a2 + kstep; const char* b3 = b2 + kstep;
            if (last && has_next) S.a_ready(nxt);
            if constexpr (SP2) {
            PG8_LDB(B0, 0, 0); PG8_LDB(B1, 0, 1); PG8_SCHED; PG8_LDA(At, 0, 0); PG8_STAGE(PG8_SA(1, 1), a1 + hstep, voffA);
            PG8_WAIT_V(8); PG8_WAIT_L(0); PG8_BAR; PG8_MMA(0, 0, At, B0); PG8_MMA(0, 1, At, B1); PG8_BAR; PG8_SCHED;
            PG8_LDA(At, 0, 1); PG8_STAGE(PG8_SB(0, 0), b2, voffB); PG8_STAGE(PG8_SB(0, 1), b2 + hstep, voffB); PG8_STAGE(PG8_SA(0, 0), a2, voffA);
            PG8_WAIT_V(8); PG8_WAIT_L(0); PG8_BAR; PG8_MMA(1, 0, At, B0); PG8_MMA(1, 1, At, B1); PG8_BAR; PG8_SCHED;
            PG8_LDB(B0, 1, 0); PG8_LDB(B1, 1, 1); PG8_SCHED; PG8_LDA(At, 1, 0); PG8_STAGE(PG8_SA(0, 1), a2 + hstep, voffA);
            PG8_WAIT_V(8); PG8_WAIT_L(0); PG8_BAR; PG8_MMA(0, 0, At, B0); PG8_MMA(0, 1, At, B1); PG8_BAR; PG8_SCHED;
            PG8_LDA(At, 1, 1); PG8_STAGE(PG8_SB(1, 0), b3, voffB); PG8_STAGE(PG8_SB(1, 1), b3 + hstep, voffB); PG8_STAGE(PG8_SA(1, 0), a3, voffA);
            PG8_WAIT_V(8); PG8_WAIT_L(0); PG8_BAR; PG8_MMA(1, 0, At, B0); PG8_MMA(1, 1, At, B1); PG8_BAR; PG8_SCHED;
            } else {
            PG8_LDB(B0, 0, 0); PG8_SCHED; PG8_LDA(At, 0, 0); PG8_STAGE(PG8_SA(1, 1), a1 + hstep, voffA);
            PG8_WAIT_L(8); PG8_BAR; PG8_WAIT_L(0); PG8_MMA(0, 0, At, B0); PG8_BAR; PG8_SCHED;
            PG8_LDB(B1, 0, 1); PG8_STAGE(PG8_SB(0, 0), b2, voffB);
            PG8_BAR; PG8_WAIT_L(0); PG8_MMA(0, 1, At, B1); PG8_BAR;
            PG8_LDA(At, 0, 1); PG8_STAGE(PG8_SA(0, 0), a2, voffA);
            PG8_BAR; PG8_WAIT_L(0); PG8_MMA(1, 0, At, B0); PG8_BAR; PG8_SCHED;
            PG8_STAGE(PG8_SB(0, 1), b2 + hstep, voffB);
            PG8_WAIT_V(6); PG8_BAR; PG8_MMA(1, 1, At, B1); PG8_BAR;
            PG8_LDB(B0, 1, 0); PG8_SCHED; PG8_LDA(At, 1, 0); PG8_STAGE(PG8_SA(0, 1), a2 + hstep, voffA);
            PG8_WAIT_L(8); PG8_BAR; PG8_WAIT_L(0); PG8_MMA(0, 0, At, B0); PG8_BAR; PG8_SCHED;
            PG8_LDB(B1, 1, 1); PG8_STAGE(PG8_SB(1, 0), b3, voffB);
            PG8_BAR; PG8_WAIT_L(0); PG8_MMA(0, 1, At, B1); PG8_BAR;
            PG8_LDA(At, 1, 1); PG8_STAGE(PG8_SA(1, 0), a3, voffA);
            PG8_BAR; PG8_WAIT_L(0); PG8_MMA(1, 0, At, B0); PG8_BAR; PG8_SCHED;
            PG8_STAGE(PG8_SB(1, 1), b3 + hstep, voffB);
            PG8_WAIT_V(6); PG8_BAR; PG8_MMA(1, 1, At, B1); PG8_BAR;
            }
        }
        if constexpr (ALIGN_EPI) { if (wr == 0) PG8_BAR; }
        if constexpr (!Epi::AFTER_DRAIN) { E(acc, cur, wr, wc, fr, fq); S.done(cur); }
        if (!has_next) break;
#pragma unroll
        for (int a = 0; a < 2; ++a)
#pragma unroll
            for (int b = 0; b < 2; ++b)
#pragma unroll
                for (int m = 0; m < 4; ++m)
#pragma unroll
                    for (int n = 0; n < 2; ++n) acc[a][b][m][n] = (f32x4){0.f, 0.f, 0.f, 0.f};
        cur = nxt; cA = nA; cB = nB; ++ui;
        if constexpr (ALIGN_EPI) { if (wr == 1) PG8_BAR; }
    }
    PG8_WAIT_V(0);
    if constexpr (!ALIGN_EPI) { if (wr == 0) PG8_BAR; }
    PG8_BAR;
    if constexpr (Epi::AFTER_DRAIN) { E.fused(acc, cur, wr, wc, fr, fq, lds, wid, lane); S.done(cur); }
#undef PG8_SA
#undef PG8_SB
#undef PG8_STAGE
#undef PG8_LDA
#undef PG8_LDB
#undef PG8_MMA
#undef PG8_WAIT_V
#undef PG8_WAIT_L
#undef PG8_BAR
#undef PG8_SCHED
}
}

DEV void transpose_item(char* lds, const float* W, int K, int N, int Npad, bf16_t* WT, int item) {
    float* tile = (float*)lds;
    const int nb = Npad / 64, kb = item / nb, nbi = item % nb, k0 = kb * 64, n0 = nbi * 64;
    const int tid = threadIdx.x;
    { const int kk = tid >> 4, n4 = (tid & 15) * 4;
#pragma unroll
        for (int p = 0; p < 2; ++p) { f32x4 v = {0.f, 0.f, 0.f, 0.f}; if (n0 + n4 < N) v = *(const f32x4*)(W + (size_t)(k0 + kk + 32 * p) * N + n0 + n4);
            float* d = tile + (kk + 32 * p) * 65 + n4; d[0] = v.x; d[1] = v.y; d[2] = v.z; d[3] = v.w; } }
    __syncthreads();
    { const int n = tid >> 3, kc = tid & 7; float v[8];
#pragma unroll
        for (int j = 0; j < 8; ++j) v[j] = tile[(kc * 8 + j) * 65 + n];
        *(u32x4*)(WT + (size_t)(n0 + n) * K + k0 + kc * 8) = pack8(v); }
    __syncthreads();
}

DEV void mod_item(char* lds, const Params& p, int item) {
    const int layer = item / 96, n0 = (item % 96) * 32, tid = threadIdx.x;
    float* s = (float*)lds;
    float* red = s + 9 * 1024;
    for (int i = tid; i < 9 * 1024; i += 512) { const int v = i >> 10, k = i & 1023; const float cv = (v < 8) ? p.c[v * 1024 + k] : p.c_ctx[k]; s[i] = silu(cv); }
    __syncthreads();
    const int kc = tid >> 5, n = tid & 31; const float* W = p.ada_w + (size_t)layer * DM * 3072 + n0 + n;
    float acc[9];
#pragma unroll
    for (int v = 0; v < 9; ++v) acc[v] = 0.f;
#pragma unroll 8
    for (int kk = 0; kk < 64; ++kk) { const int k = kc * 64 + kk; const float w = W[(size_t)k * 3072];
#pragma unroll
        for (int v = 0; v < 9; ++v) acc[v] += s[v * 1024 + k] * w; }
#pragma unroll
    for (int v = 0; v < 9; ++v) red[(kc * 9 + v) * 32 + n] = acc[v];
    __syncthreads();
    if (tid < 9 * 32) { const int v = tid >> 5, nn = tid & 31; float t = 0.f;
#pragma unroll
        for (int k2 = 0; k2 < 16; ++k2) t += red[(k2 * 9 + v) * 32 + nn];
        t += p.ada_b[layer * 3072 + n0 + nn];
        if (layer == 0) ((float*)(p.ws + WS_MOD0))[v * 3072 + n0 + nn] = t;
        else if (v < 8) ((float*)(p.ws + WS_MOD1))[v * 3072 + n0 + nn] = t; }
    __syncthreads();
}

DEV void hid2_row(char* lds, const Params& p, int t, int wid, int lane) {
    float* sc = (float*)lds + wid * 128;
    const float tn = (float)t * (1.0f / 4095.0f);
    const float w = (float)(2.0 * 3.14159265358979323846 / 4096.0) * (float)t;
    float e = 0.f;
    if (lane == 0) e = tn;
    else if (lane <= 32) { const int k = (lane - 1) & 15; const float band = 1e-4f + (float)k * ((15.0f - 1e-4f) / 15.0f); const float ang = w * band; e = (lane <= 16) ? cosf(ang) : -sinf(ang); }
    sc[lane] = e;
    asm volatile("s_waitcnt lgkmcnt(0)" ::: "memory");
    float a = p.f_b1[lane];
    for (int i = 0; i < 33; ++i) a += sc[i] * p.f_w1[i * 64 + lane];
    const float fr = p.freq[lane];
    const float h1 = sinf(fr * a);
    sc[64 + lane] = h1;
    asm volatile("s_waitcnt lgkmcnt(0)" ::: "memory");
    float a2 = p.f_b2[lane];
    for (int i = 0; i < 64; ++i) a2 += sc[64 + i] * p.f_w2[i * 64 + lane];
    const float h2 = sinf(fr * a2);
    ((bf16_t*)(p.ws + WS_HID2))[t * 64 + lane] = f2bf(h2);
    asm volatile("s_waitcnt lgkmcnt(0)" ::: "memory");
}

DEV void phase_prep(char* lds, const Params& p) {
    const int tid = threadIdx.x, wid = tid >> 6, lane = tid & 63;
    { const int gt = blockIdx.x * 512 + tid;
        if (gt < 2048) ((float*)(p.ws + WS_SSUM))[gt] = 0.f;
        float* rp = (float*)(p.ws + WS_ROPE);
        if (gt < 1024) { const int pos = gt >> 4, i = gt & 15; const float inv = exp2f(-(float)i * (13.287712379549449f / 16.0f)); const float ang = (float)pos * inv; rp[gt] = cosf(ang); rp[1024 + gt] = sinf(ang); }
        if (gt < 512) { const int pos = gt >> 3, i = gt & 7; const float inv = exp2f(-(float)i * (13.287712379549449f / 8.0f)); const float ang = (float)pos * inv; rp[2048 + gt] = cosf(ang); rp[2560 + gt] = sinf(ang); } }
    for (int it = blockIdx.x; it < 192; it += gridDim.x) mod_item(lds, p, it);
    for (int t = blockIdx.x * 8 + wid; t < 4096; t += gridDim.x * 8) hid2_row(lds, p, t, wid, lane);
    __syncthreads();
    constexpr int I_WIN = 16 * 36, I_UQ = 4 * 12, I_UKV = 2 * 16, I_WO = 256, I_HIN = 16 * 64, I_HO = 256, I_W3 = 64;
    constexpr int NIT = I_WIN + I_UQ + I_UKV + I_WO + I_HIN + I_HO + I_W3;
    for (int it = blockIdx.x; it < NIT; it += gridDim.x) {
        int r = it;
        if (r < I_WIN) { transpose_item(lds, p.w_in, 1024, AIN, AINP, (bf16_t*)(p.ws + WS_WIN), r); continue; } r -= I_WIN;
        if (r < I_UQ) { transpose_item(lds, p.w_uq, 256, 768, 768, (bf16_t*)(p.ws + WS_WUQ), r); continue; } r -= I_UQ;
        if (r < I_UKV) { transpose_item(lds, p.w_ukv, 128, 1024, 1024, (bf16_t*)(p.ws + WS_WUKV), r); continue; } r -= I_UKV;
        if (r < I_WO) { transpose_item(lds, p.w_out, 1024, 1024, 1024, (bf16_t*)(p.ws + WS_WOUT), r); continue; } r -= I_WO;
        if (r < I_HIN) { transpose_item(lds, p.hy_w_in, 1024, 4096, 4096, (bf16_t*)(p.ws + WS_HWIN), r); continue; } r -= I_HIN;
        if (r < I_HO) { transpose_item(lds, p.hy_w_out, 1024, 1024, 1024, (bf16_t*)(p.ws + WS_HWOUT), r); continue; } r -= I_HO;
        transpose_item(lds, p.f_w3, 64, 4096, 4096, (bf16_t*)(p.ws + WS_W3), r);
    }
}

DEV float wave_sum(float v) {
#pragma unroll
    for (int o = 1; o < 64; o <<= 1) v += __shfl_xor(v, o);
    return v;
}
DEV void modnorm_row(const float* xr, const float* nw, const float* shift, const float* scale, bf16_t* orow, int lane) {
    f32x4 v[4]; float s = 0.f;
#pragma unroll
    for (int j = 0; j < 4; ++j) { v[j] = *(const f32x4*)(xr + lane * 4 + 256 * j); s += v[j].x * v[j].x + v[j].y * v[j].y + v[j].z * v[j].z + v[j].w * v[j].w; }
    const float r = rsqrtf(wave_sum(s) * (1.0f / DM) + EPS);
#pragma unroll
    for (int j = 0; j < 4; ++j) { const int c0 = lane * 4 + 256 * j;
        const f32x4 w = *(const f32x4*)(nw + c0), sh = *(const f32x4*)(shift + c0), sc = *(const f32x4*)(scale + c0);
        const float o0 = v[j].x * r * w.x * (1.f + sc.x) + sh.x, o1 = v[j].y * r * w.y * (1.f + sc.y) + sh.y, o2 = v[j].z * r * w.z * (1.f + sc.z) + sh.z, o3 = v[j].w * r * w.w * (1.f + sc.w) + sh.w;
        u32x2 pk; pk.x = pk2(o0, o1); pk.y = pk2(o2, o3); *(u32x2*)(orow + c0) = pk; }
}

DEV void phase_norm0(const Params& p) {
    const int wid = threadIdx.x >> 6, lane = threadIdx.x & 63; const float* mod0 = (const float*)(p.ws + WS_MOD0); bf16_t* H0 = (bf16_t*)(p.ws + WS_H0);
    for (int row = blockIdx.x * 8 + wid; row < NALL; row += gridDim.x * 8) {
        const float* xr; int v;
        if (row < NTOK) { xr = p.x + (size_t)row * DM; v = row >> 12; } else { xr = p.ctx + (size_t)(row - NTOK) * DM; v = 8; }
        modnorm_row(xr, p.norm_w, mod0 + v * 3072, mod0 + v * 3072 + 1024, H0 + (size_t)row * DM, lane);
    }
}
DEV void phase_norm1(const Params& p) {
    const int wid = threadIdx.x >> 6, lane = threadIdx.x & 63; const float* mod1 = (const float*)(p.ws + WS_MOD1); bf16_t* H1 = (bf16_t*)(p.ws + WS_H1);
    for (int row = blockIdx.x * 8 + wid; row < NTOK; row += gridDim.x * 8) { const int v = row >> 12;
        modnorm_row(p.out + (size_t)row * DM, p.norm_w + DM, mod1 + v * 3072, mod1 + v * 3072 + 1024, H1 + (size_t)row * DM, lane); }
}
DEV void phase_final(const Params& p) {
    const int wid = threadIdx.x >> 6, lane = threadIdx.x & 63;
    for (int row = blockIdx.x * 8 + wid; row < NTOK; row += gridDim.x * 8) {
        float* xr = p.out + (size_t)row * DM; f32x4 v[4]; float s = 0.f;
#pragma unroll
        for (int j = 0; j < 4; ++j) { v[j] = *(const f32x4*)(xr + lane * 4 + 256 * j); s += v[j].x * v[j].x + v[j].y * v[j].y + v[j].z * v[j].z + v[j].w * v[j].w; }
        const float r = rsqrtf(wave_sum(s) * (1.0f / DM) + EPS);
#pragma unroll
        for (int j = 0; j < 4; ++j) { const int c0 = lane * 4 + 256 * j; const f32x4 w = *(const f32x4*)(p.final_w + c0);
            f32x4 o; o.x = v[j].x * r * w.x; o.y = v[j].y * r * w.y; o.z = v[j].z * r * w.z; o.w = v[j].w * r * w.w; *(f32x4*)(xr + c0) = o; }
    }
}

DEV void phase_post(const Params& p) {
    const int wid = threadIdx.x >> 6, lane = threadIdx.x & 63;
    const bf16_t* PRAW = (const bf16_t*)(p.ws + WS_PRAW);
    bf16_t* QA = (bf16_t*)(p.ws + WS_QA); bf16_t* KA = (bf16_t*)(p.ws + WS_KA); bf16_t* VA = (bf16_t*)(p.ws + WS_VA);
    bf16_t* CQN = (bf16_t*)(p.ws + WS_CQN); bf16_t* CKVN = (bf16_t*)(p.ws + WS_CKVN); bf16_t* G = (bf16_t*)(p.ws + WS_G); bf16_t* KM = (bf16_t*)(p.ws + WS2_KM);
    const float* rp = (const float*)(p.ws + WS_ROPE); const float *cos64 = rp, *sin64 = rp + 1024, *cos32 = rp + 2048, *sin32 = rp + 2560;
    for (int tok = blockIdx.x * 8 + wid; tok < NALL; tok += gridDim.x * 8) {
        const bool lat = tok < NTOK; int b, pos, prow = 0, pcol = 0;
        if (lat) { b = tok >> 12; const int l = tok & 4095; pos = CTXL + l; prow = l >> 6; pcol = l & 63; } else { const int j = tok - NTOK; b = j >> 8; pos = j & 255; }
        const bf16_t* pr = PRAW + (size_t)tok * AINP; const size_t kvrow = (size_t)b * LK + pos;
        float v[8], o[8];
        if (lat) {
            unpack8(*(const u32x4*)(pr + lane * 8), v);
            float ss = 0.f;
#pragma unroll
            for (int j = 0; j < 8; ++j) ss += v[j] * v[j];
            ss += __shfl_xor(ss, 1); ss += __shfl_xor(ss, 2); ss += __shfl_xor(ss, 4);
            const float r = rsqrtf(ss * (1.0f / 64.0f) + EPS); const int k = lane & 7;
#pragma unroll
            for (int j = 0; j < 8; ++j) v[j] = v[j] * r * p.q_norm[k * 8 + j];
            const int posv = (k < 4) ? prow : pcol; const int fb = posv * 16 + (k & 1) * 8;
#pragma unroll
            for (int j = 0; j < 8; ++j) { const float ot = __shfl_xor(v[j], 2); const float cs = cos64[fb + j], sn = sin64[fb + j];
                o[j] = ((k & 2) ? (v[j] * cs + ot * sn) : (v[j] * cs - ot * sn)) * QSC_A; }
            *(u32x4*)(QA + (size_t)tok * 512 + lane * 8) = pack8(o);
        }
        {
            const u32x4 raw = *(const u32x4*)(pr + 512 + lane * 8); unpack8(raw, v);
            float ss = 0.f;
#pragma unroll
            for (int j = 0; j < 8; ++j) ss += v[j] * v[j];
            ss += __shfl_xor(ss, 1); ss += __shfl_xor(ss, 2); ss += __shfl_xor(ss, 4);
            const float s8 = ss;
            ss += __shfl_xor(ss, 8); ss += __shfl_xor(ss, 16);
            const float s32 = ss;
            float vn[8]; const int k = lane & 7;
            { const float r = rsqrtf(s8 * (1.0f / 64.0f) + EPS);
#pragma unroll
                for (int j = 0; j < 8; ++j) vn[j] = v[j] * r * p.k_norm[k * 8 + j]; }
            const int posv = (k < 4) ? prow : pcol; const int fb = posv * 16 + (k & 1) * 8;
#pragma unroll
            for (int j = 0; j < 8; ++j) { const float ot = __shfl_xor(vn[j], 2); const float cs = cos64[fb + j], sn = sin64[fb + j];
                o[j] = lat ? ((k & 2) ? (vn[j] * cs + ot * sn) : (vn[j] * cs - ot * sn)) : vn[j]; }
            if (lane < 16) *(u32x4*)(KA + kvrow * 128 + lane * 8) = pack8(o);
            else if (lane < 32) *(u32x4*)(VA + kvrow * 128 + (lane - 16) * 8) = raw;
            else if (lat) { const float r = rsqrtf(s32 * (1.0f / 256.0f) + EPS); const int cb = (lane - 32) * 8;
#pragma unroll
                for (int j = 0; j < 8; ++j) o[j] = v[j] * r * p.cq_norm[cb + j];
                *(u32x4*)(CQN + (size_t)tok * 256 + cb) = pack8(o); }
        }
        {
            unpack8(*(const u32x4*)(pr + 1024 + lane * 8), v);
            float ss = 0.f;
#pragma unroll
            for (int j = 0; j < 8; ++j) ss += v[j] * v[j];
            ss += __shfl_xor(ss, 1); ss += __shfl_xor(ss, 2); ss += __shfl_xor(ss, 4); ss += __shfl_xor(ss, 8);
            const int k = lane & 3; const int posv = (k < 2) ? prow : pcol;
            float oth[8];
#pragma unroll
            for (int j = 0; j < 8; ++j) oth[j] = __shfl_xor(v[j], 1);
            if (lane < 16) { const float r = rsqrtf(ss * (1.0f / 128.0f) + EPS);
#pragma unroll
                for (int j = 0; j < 8; ++j) o[j] = v[j] * r * p.ckv_norm[lane * 8 + j];
                *(u32x4*)(CKVN + kvrow * 128 + lane * 8) = pack8(o); }
            else if (lane < 20) {
#pragma unroll
                for (int j = 0; j < 8; ++j) { const float cs = cos32[posv * 8 + j], sn = sin32[posv * 8 + j];
                    o[j] = lat ? ((k & 1) ? (v[j] * cs + oth[j] * sn) : (v[j] * cs - oth[j] * sn)) : v[j]; }
                const u32x4 w = pack8(o);
#pragma unroll
                for (int h = 0; h < 8; ++h) *(u32x4*)(KM + kvrow * 768 + h * 96 + 64 + k * 8) = w; }
            else if (lat) {
#pragma unroll
                for (int j = 0; j < 8; ++j) o[j] = silu(v[j]);
                *(u32x4*)(G + (size_t)tok * 1024 + (lane - 20) * 8) = pack8(o); }
        }
        if (lat) {
            unpack8(*(const u32x4*)(pr + 1536 + lane * 8), v);
#pragma unroll
            for (int j = 0; j < 8; ++j) o[j] = silu(v[j]);
            *(u32x4*)(G + (size_t)tok * 1024 + 352 + lane * 8) = pack8(o);
            if (lane < 20) { unpack8(*(const u32x4*)(pr + 2048 + lane * 8), v);
#pragma unroll
                for (int j = 0; j < 8; ++j) o[j] = silu(v[j]);
                *(u32x4*)(G + (size_t)tok * 1024 + 864 + lane * 8) = pack8(o); }
        }
    }
}

template <int DQK>
DEV void attn_unit(char* lds, const bf16_t* __restrict__ Q, int ldq, int qcol, const bf16_t* __restrict__ Kp, int ldk, int kcol, const bf16_t* __restrict__ Vp, int ldv, int vcol,
                   const bf16_t* __restrict__ Gt, bf16_t* OG, int ocol, int b, int q0) {
    constexpr int KRS = (DQK + 8) * 2, KB = 64 * KRS, VRS = 192, VB = 64 * VRS, STG = KB + VB, NKS = DQK / 16, KCH = DQK / 8;
    const int tid = threadIdx.x, lane = tid & 63, wid = tid >> 6, l31 = lane & 31, hi = lane >> 5;
    bf16x8 qf[NKS];
    { const bf16_t* qp = Q + (size_t)(b * SEQ + q0 + wid * 32 + l31) * ldq + qcol + hi * 8;
#pragma unroll
        for (int ks = 0; ks < NKS; ++ks) qf[ks] = *(const bf16x8*)(qp + ks * 16); }
    const bf16_t* kbase = Kp + (size_t)b * LK * ldk + kcol; const bf16_t* vbase = Vp + (size_t)b * LK * ldv + vcol;
    const int kr0 = tid / KCH, kc0 = tid % KCH;
    const int kr1 = (tid + 512) / KCH, kc1 = (tid + 512) % KCH;
    const bool k2 = (KCH * 64 > 512) && (tid + 512 < KCH * 64);
    const int vr = tid >> 3, vc = tid & 7;
    u32x4 sk0, sk1, sv;
#define A_LOAD(t) do { const size_t kp_ = (size_t)(t) * 64; sk0 = *(const u32x4*)(kbase + (kp_ + kr0) * ldk + kc0 * 8); \
        if (k2) sk1 = *(const u32x4*)(kbase + (kp_ + kr1) * ldk + kc1 * 8); sv = *(const u32x4*)(vbase + (kp_ + vr) * ldv + vc * 8); } while (0)
#define A_STORE(buf) do { char* b_ = lds + (buf) * STG; *(u32x4*)(b_ + kr0 * KRS + kc0 * 16) = sk0; if (k2) *(u32x4*)(b_ + kr1 * KRS + kc1 * 16) = sk1; \
        *(u32x4*)(b_ + KB + vr * VRS + vc * 16) = sv; } while (0)
    f32x16 o0, o1;
#pragma unroll
    for (int r = 0; r < 16; ++r) { o0[r] = 0.f; o1[r] = 0.f; }
    float m_run = -1e30f, l_run = 0.f;
    const int g1 = (lane >> 4) & 1, tq = (lane & 15) >> 2, tp = lane & 3;
    const int vt_off = KB + (4 * hi + tq) * VRS + (16 * g1 + 4 * tp) * 2;
    const int kf_off = l31 * KRS + hi * 16;
    constexpr int NT = LK / 64;
    A_LOAD(0); A_STORE(0);
    __syncthreads();
    for (int t = 0; t < NT; ++t) {
        const bool more = (t + 1 < NT);
        if (more) A_LOAD(t + 1);
        const char* b_ = lds + (t & 1) * STG;
        f32x16 p0, p1;
#pragma unroll
        for (int r = 0; r < 16; ++r) { p0[r] = 0.f; p1[r] = 0.f; }
#pragma unroll
        for (int ks = 0; ks < NKS; ++ks) {
            const bf16x8 ka = *(const bf16x8*)(b_ + kf_off + ks * 32);
            const bf16x8 kb = *(const bf16x8*)(b_ + kf_off + 32 * KRS + ks * 32);
            p0 = __builtin_amdgcn_mfma_f32_32x32x16_bf16(ka, qf[ks], p0, 0, 0, 0);
            p1 = __builtin_amdgcn_mfma_f32_32x32x16_bf16(kb, qf[ks], p1, 0, 0, 0);
        }
        float mx = p0[0];
#pragma unroll
        for (int r = 1; r < 16; ++r) mx = fmaxf(mx, p0[r]);
#pragma unroll
        for (int r = 0; r < 16; ++r) mx = fmaxf(mx, p1[r]);
        mx = fmaxf(mx, __shfl_xor(mx, 32));
        const float m_new = fmaxf(m_run, mx);
        const float alpha = __builtin_amdgcn_exp2f(m_run - m_new);
        m_run = m_new;
        float ls = 0.f;
#pragma unroll
        for (int r = 0; r < 16; ++r) { p0[r] = __builtin_amdgcn_exp2f(p0[r] - m_new); p1[r] = __builtin_amdgcn_exp2f(p1[r] - m_new); ls += p0[r] + p1[r]; }
        l_run = l_run * alpha + ls;
#pragma unroll
        for (int r = 0; r < 16; ++r) { o0[r] *= alpha; o1[r] *= alpha; }
        u32x4 pw[4];
        pw[0] = (u32x4){pk2(p0[0], p0[1]), pk2(p0[2], p0[3]), pk2(p0[4], p0[5]), pk2(p0[6], p0[7])};
        pw[1] = (u32x4){pk2(p0[8], p0[9]), pk2(p0[10], p0[11]), pk2(p0[12], p0[13]), pk2(p0[14], p0[15])};
        pw[2] = (u32x4){pk2(p1[0], p1[1]), pk2(p1[2], p1[3]), pk2(p1[4], p1[5]), pk2(p1[6], p1[7])};
        pw[3] = (u32x4){pk2(p1[8], p1[9]), pk2(p1[10], p1[11]), pk2(p1[12], p1[13]), pk2(p1[14], p1[15])};
#pragma unroll
        for (int s = 0; s < 4; ++s) {
            const bf16x8 pb = __builtin_bit_cast(bf16x8, pw[s]);
#pragma unroll
            for (int dt = 0; dt < 2; ++dt) {
                const char* vp = b_ + vt_off + s * 16 * VRS + dt * 64;
                const s16x4 lo = __builtin_bit_cast(s16x4, __builtin_amdgcn_ds_read_tr16_b64_v4i16((LAS s16x4*)vp));
                const s16x4 hh = __builtin_bit_cast(s16x4, __builtin_amdgcn_ds_read_tr16_b64_v4i16((LAS s16x4*)(vp + 8 * VRS)));
                const bf16x8 vf = (bf16x8){lo[0], lo[1], lo[2], lo[3], hh[0], hh[1], hh[2], hh[3]};
                if (dt == 0) o0 = __builtin_amdgcn_mfma_f32_32x32x16_bf16(vf, pb, o0, 0, 0, 0);
                else o1 = __builtin_amdgcn_mfma_f32_32x32x16_bf16(vf, pb, o1, 0, 0, 0);
            }
        }
        if (more) A_STORE((t + 1) & 1);
        __syncthreads();
    }
#undef A_LOAD
#undef A_STORE
    const float lt = l_run + __shfl_xor(l_run, 32); const float inv = 1.0f / lt;
    const size_t tok = (size_t)(b * SEQ + q0 + wid * 32 + l31);
#pragma unroll
    for (int dt = 0; dt < 2; ++dt)
#pragma unroll
        for (int g = 0; g < 4; ++g) { const int d = 32 * dt + 8 * g + 4 * hi; const size_t off = tok * 1024 + ocol + d;
            const u32x2 gw = *(const u32x2*)(Gt + off);
            const f32x16& oo = dt ? o1 : o0;
            u32x2 w; w.x = pk2(oo[4 * g] * inv * lo_bf(gw.x), oo[4 * g + 1] * inv * hi_bf(gw.x)); w.y = pk2(oo[4 * g + 2] * inv * lo_bf(gw.y), oo[4 * g + 3] * inv * hi_bf(gw.y));
            *(u32x2*)(OG + off) = w; }
}

DEV float swapmax32(float v) { auto rr = __builtin_amdgcn_permlane32_swap(__float_as_uint(v), __float_as_uint(v), false, false); return fmaxf(__uint_as_float(rr[0]), __uint_as_float(rr[1])); }
DEV float swapsum32(float v) { auto rr = __builtin_amdgcn_permlane32_swap(__float_as_uint(v), __float_as_uint(v), false, false); return __uint_as_float(rr[0]) + __uint_as_float(rr[1]); }
template <int DQK>
DEV void attn_unit2(char* lds, const bf16_t* __restrict__ Q, int ldq, int qcol, const bf16_t* __restrict__ Kp, int ldk, int kcol, const bf16_t* __restrict__ Vp, int ldv, int vcol,
                    const bf16_t* __restrict__ Gt, bf16_t* OG, int ocol, int b, int q0) {
    constexpr int KRS = (DQK + 8) * 2, KB = 64 * KRS, VRS = 192, VB = 64 * VRS, NKS = DQK / 16, KCH = DQK / 8, VOFF = 2 * KB;
    constexpr float THR = 8.0f;
    constexpr int NT = LK / 64;
    const int tid = threadIdx.x, lane = tid & 63, wid = tid >> 6, l31 = lane & 31, hi = lane >> 5;
    bf16x8 qf[NKS];
    { const bf16_t* qp = Q + (size_t)(b * SEQ + q0 + wid * 32 + l31) * ldq + qcol + hi * 8;
#pragma unroll
        for (int ks = 0; ks < NKS; ++ks) qf[ks] = *(const bf16x8*)(qp + ks * 16); }
    const bf16_t* kbase = Kp + (size_t)b * LK * ldk + kcol; const bf16_t* vbase = Vp + (size_t)b * LK * ldv + vcol;
    constexpr bool K2 = (KCH * 64 > 512);
    const bool k2 = K2 && (tid + 512 < KCH * 64);
    const int kr0 = tid / KCH, kc0 = tid % KCH, kr1 = k2 ? (tid + 512) / KCH : kr0, kc1 = k2 ? (tid + 512) % KCH : kc0;
    const int vr = tid >> 3, vc = tid & 7;
    u32x4 skX0, skX1 = {0u, 0u, 0u, 0u}, svX, skY0, skY1 = {0u, 0u, 0u, 0u}, svY;
#define A_LOADK(t, S) do { const int tt_ = (t) < NT ? (t) : NT - 1; const size_t kp_ = (size_t)tt_ * 64; sk##S##0 = *(const u32x4*)(kbase + (kp_ + kr0) * ldk + kc0 * 8); if (K2) sk##S##1 = *(const u32x4*)(kbase + (kp_ + kr1) * ldk + kc1 * 8); } while (0)
#define A_LOADV(t, S) do { const int tt_ = (t) < NT ? (t) : NT - 1; sv##S = *(const u32x4*)(vbase + ((size_t)tt_ * 64 + vr) * ldv + vc * 8); } while (0)
#define A_STOREK(slot, S) do { char* b_ = lds + (slot) * KB; *(u32x4*)(b_ + kr0 * KRS + kc0 * 16) = sk##S##0; if (K2) *(u32x4*)(b_ + kr1 * KRS + kc1 * 16) = sk##S##1; } while (0)
#define A_STOREV(slot, S) do { *(u32x4*)(lds + VOFF + (slot) * VB + vr * VRS + vc * 16) = sv##S; } while (0)
    f32x16 o0, o1, negm;
#pragma unroll
    for (int r = 0; r < 16; ++r) { o0[r] = 0.f; o1[r] = 0.f; negm[r] = 0.f; }
    asm volatile("" : "+v"(negm));
    float mhat = 0.f, l_run = 0.f;
    const int g1 = (lane >> 4) & 1, tq = (lane & 15) >> 2, tp = lane & 3;
    const int vt_off = VOFF + (4 * hi + tq) * VRS + (16 * g1 + 4 * tp) * 2;
    const int kf_off = l31 * KRS + hi * 16;
#define A_QK(P0, P1, slot) do { const char* kb_ = lds + (slot) * KB + kf_off; \
        _Pragma("unroll") for (int ks = 0; ks < NKS; ++ks) { \
            const bf16x8 ka = *(const bf16x8*)(kb_ + ks * 32); const bf16x8 kb2 = *(const bf16x8*)(kb_ + 32 * KRS + ks * 32); \
            if (ks == 0) { P0 = __builtin_amdgcn_mfma_f32_32x32x16_bf16(ka, qf[0], negm, 0, 0, 0); P1 = __builtin_amdgcn_mfma_f32_32x32x16_bf16(kb2, qf[0], negm, 0, 0, 0); } \
            else { P0 = __builtin_amdgcn_mfma_f32_32x32x16_bf16(ka, qf[ks], P0, 0, 0, 0); P1 = __builtin_amdgcn_mfma_f32_32x32x16_bf16(kb2, qf[ks], P1, 0, 0, 0); } } } while (0)
    A_LOADK(0, X); A_LOADV(0, X); A_LOADK(1, Y); A_LOADV(1, Y); A_STOREK(0, X); A_STOREV(0, X); A_STOREK(1, Y);
    A_LOADK(2, Y);
    __syncthreads();
    f32x16 pA0, pA1, pB0, pB1;
#pragma unroll
    for (int r = 0; r < 16; ++r) { pB0[r] = 0.f; pB1[r] = 0.f; }
    A_QK(pA0, pA1, 0);
#define A_STEP(P0, P1, N0, N1, t, SL, SS) do { \
        A_LOADK((t) + 3, SL); A_LOADV((t) + 2, SL); \
        A_QK(N0, N1, ((t) + 1) & 1); \
        float a_ = fmaxf(fmaxf(P0[0], P0[1]), P1[0]), c_ = fmaxf(fmaxf(P0[2], P0[3]), P1[1]); a_ = fmaxf(fmaxf(a_, P1[2]), P1[3]); \
        _Pragma("unroll") for (int r = 4; r < 16; r += 4) { a_ = fmaxf(fmaxf(a_, P0[r]), P0[r + 1]); c_ = fmaxf(fmaxf(c_, P0[r + 2]), P0[r + 3]); a_ = fmaxf(fmaxf(a_, P1[r]), P1[r + 1]); c_ = fmaxf(fmaxf(c_, P1[r + 2]), P1[r + 3]); } \
        const float rm = swapmax32(fmaxf(a_, c_)); \
        if ((t) == 0 || __any(rm > THR)) { \
            const float dl = ((t) == 0) ? rm : fmaxf(rm, 0.f); mhat += dl; \
            _Pragma("unroll") for (int r = 0; r < 16; ++r) { P0[r] -= dl; P1[r] -= dl; N0[r] -= dl; N1[r] -= dl; } \
            if ((t) != 0) { const float f = __builtin_amdgcn_exp2f(-dl); l_run *= f; _Pragma("unroll") for (int r = 0; r < 16; ++r) { o0[r] *= f; o1[r] *= f; } } \
            _Pragma("unroll") for (int r = 0; r < 16; ++r) negm[r] = -mhat; asm volatile("" : "+v"(negm)); } \
        float ls = 0.f; \
        _Pragma("unroll") for (int r = 0; r < 16; ++r) { P0[r] = __builtin_amdgcn_exp2f(P0[r]); P1[r] = __builtin_amdgcn_exp2f(P1[r]); ls += P0[r] + P1[r]; } \
        l_run += ls; \
        u32x4 pw[4]; \
        pw[0] = (u32x4){pk2(P0[0], P0[1]), pk2(P0[2], P0[3]), pk2(P0[4], P0[5]), pk2(P0[6], P0[7])}; \
        pw[1] = (u32x4){pk2(P0[8], P0[9]), pk2(P0[10], P0[11]), pk2(P0[12], P0[13]), pk2(P0[14], P0[15])}; \
        pw[2] = (u32x4){pk2(P1[0], P1[1]), pk2(P1[2], P1[3]), pk2(P1[4], P1[5]), pk2(P1[6], P1[7])}; \
        pw[3] = (u32x4){pk2(P1[8], P1[9]), pk2(P1[10], P1[11]), pk2(P1[12], P1[13]), pk2(P1[14], P1[15])}; \
        { const char* vb_ = lds + ((t) & 1) * VB + vt_off; \
        _Pragma("unroll") for (int s = 0; s < 4; ++s) { const bf16x8 pb = __builtin_bit_cast(bf16x8, pw[s]); \
            _Pragma("unroll") for (int dt = 0; dt < 2; ++dt) { const char* vp = vb_ + s * 16 * VRS + dt * 64; \
                const s16x4 lo = __builtin_bit_cast(s16x4, __builtin_amdgcn_ds_read_tr16_b64_v4i16((LAS s16x4*)vp)); \
                const s16x4 hh = __builtin_bit_cast(s16x4, __builtin_amdgcn_ds_read_tr16_b64_v4i16((LAS s16x4*)(vp + 8 * VRS))); \
                const bf16x8 vf = (bf16x8){lo[0], lo[1], lo[2], lo[3], hh[0], hh[1], hh[2], hh[3]}; \
                if (dt == 0) o0 = __builtin_amdgcn_mfma_f32_32x32x16_bf16(vf, pb, o0, 0, 0, 0); else o1 = __builtin_amdgcn_mfma_f32_32x32x16_bf16(vf, pb, o1, 0, 0, 0); } } } \
        A_STOREK((t) & 1, SS); A_STOREV(((t) + 1) & 1, SS); \
        __syncthreads(); } while (0)
    for (int t = 0; t < NT; t += 2) {
        A_STEP(pA0, pA1, pB0, pB1, t, X, Y);
        A_STEP(pB0, pB1, pA0, pA1, t + 1, Y, X);
    }
#undef A_STEP
#undef A_QK
#undef A_LOADK
#undef A_LOADV
#undef A_STOREK
#undef A_STOREV
    const float inv = 1.0f / swapsum32(l_run);
    const size_t tok = (size_t)(b * SEQ + q0 + wid * 32 + l31);
#pragma unroll
    for (int dt = 0; dt < 2; ++dt)
#pragma unroll
        for (int g = 0; g < 4; ++g) { const int d = 32 * dt + 8 * g + 4 * hi; const size_t off = tok * 1024 + ocol + d;
            const u32x2 gw = *(const u32x2*)(Gt + off);
            const f32x16& oo = dt ? o1 : o0;
            u32x2 w; w.x = pk2(oo[4 * g] * inv * lo_bf(gw.x), oo[4 * g + 1] * inv * hi_bf(gw.x)); w.y = pk2(oo[4 * g + 2] * inv * lo_bf(gw.y), oo[4 * g + 3] * inv * hi_bf(gw.y));
            *(u32x2*)(OG + off) = w; }
}

DEV void phase_attn(char* lds, const Params& p) {
    const bf16_t* QA = (const bf16_t*)(p.ws + WS_QA); const bf16_t* KA = (const bf16_t*)(p.ws + WS_KA); const bf16_t* VA = (const bf16_t*)(p.ws + WS_VA);
    const bf16_t* QM = (const bf16_t*)(p.ws + WS_QM); const bf16_t* KM = (const bf16_t*)(p.ws + WS2_KM); const bf16_t* VM = (const bf16_t*)(p.ws + WS2_VM);
    const bf16_t* G = (const bf16_t*)(p.ws + WS_G); bf16_t* OG = (bf16_t*)(p.ws + WS2_OG);
    for (int u = blockIdx.x; u < 2048; u += gridDim.x) {
        const int type = u >> 10, rem = u & 1023, b = rem >> 7, h = (rem >> 4) & 7, qb = rem & 15;
        if (type == 0) attn_unit2<64>(lds, QA, 512, h * 64, KA, 128, (h >> 2) * 64, VA, 128, (h >> 2) * 64, G, OG, h * 64, b, qb * 256);
        else attn_unit2<96>(lds, QM, 768, h * 96, KM, 768, h * 96, VM, 512, h * 64, G, OG, 512 + h * 64, b, qb * 256);
    }
}

constexpr int CV_PADL = 192, CV_ROW = 4488, CV_RS = CV_ROW * 2;
constexpr int CV_UB = 8 * CV_RS;
constexpr int CV_FS = 16416;
DEV void conv_load_filter(char* lds, const bf16_t* gr) {
    const int tid = threadIdx.x;
#pragma unroll
    for (int rnd = 0; rnd < 2; ++rnd) {
        const int ch = tid + rnd * 512;
        const u32x4 a = *(const u32x4*)(gr + ch * 8);
        u32x4 bq = {0u, 0u, 0u, 0u}; if (ch + 1 < 1024) bq = *(const u32x4*)(gr + ch * 8 + 8);
        const unsigned w[8] = {a.x, a.y, a.z, a.w, bq.x, bq.y, bq.z, bq.w};
        char* f = lds + CV_UB + ch * 16;
        *(u32x4*)(f) = a;
        u32x4 c1, c2, c3;
        c1.x = __builtin_amdgcn_alignbit(w[1], w[0], 16); c1.y = __builtin_amdgcn_alignbit(w[2], w[1], 16); c1.z = __builtin_amdgcn_alignbit(w[3], w[2], 16); c1.w = __builtin_amdgcn_alignbit(w[4], w[3], 16);
        c2 = (u32x4){w[1], w[2], w[3], w[4]};
        c3.x = __builtin_amdgcn_alignbit(w[2], w[1], 16); c3.y = __builtin_amdgcn_alignbit(w[3], w[2], 16); c3.z = __builtin_amdgcn_alignbit(w[4], w[3], 16); c3.w = __builtin_amdgcn_alignbit(w[5], w[4], 16);
        *(u32x4*)(f + CV_FS) = c1; *(u32x4*)(f + 2 * CV_FS) = c2; *(u32x4*)(f + 3 * CV_FS) = c3;
    }
}
DEV void sconv4(const bf16_t* px, int t, float w0, float w1, float w2, float bias, float* u) {
    const u32x2 mid = *(const u32x2*)(px + t);
    const float pm = (t > 0) ? bf2f(px[t - 1]) : 0.f, pp = (t + 4 < SEQ) ? bf2f(px[t + 4]) : 0.f;
    const float q0 = lo_bf(mid.x), q1 = hi_bf(mid.x), q2 = lo_bf(mid.y), q3 = hi_bf(mid.y);
    u[0] = w0 * pm + w1 * q0 + w2 * q1 + bias; u[1] = w0 * q0 + w1 * q1 + w2 * q2 + bias; u[2] = w0 * q1 + w1 * q2 + w2 * q3 + bias; u[3] = w0 * q2 + w1 * q3 + w2 * pp + bias;
}
template <bool V0, bool V1>
DEV void conv_step(const char* lds, f32x16 (&acc)[2][2], const int (&a_off)[2], const int (&b_off)[2], int d) {
    bf16x8 fa[2][4];
#pragma unroll
    for (int mt = 0; mt < 2; ++mt)
#pragma unroll
        for (int ks = 0; ks < 4; ++ks) { const char* ap = lds + a_off[mt] - 128 * d + ks * 32;
            const u32x2 lo = *(const u32x2*)ap, hh = *(const u32x2*)(ap + 8);
            fa[mt][ks] = __builtin_bit_cast(bf16x8, (u32x4){lo.x, lo.y, hh.x, hh.y}); }
#pragma unroll
    for (int n = 0; n < 2; ++n) {
        if ((n == 0 && V0) || (n == 1 && V1)) {
#pragma unroll
            for (int ks = 0; ks < 4; ++ks) { const bf16x8 fb = *(const bf16x8*)(lds + b_off[n] - 128 * d + ks * 32);
#pragma unroll
                for (int mt = 0; mt < 2; ++mt) acc[n][mt] = __builtin_amdgcn_mfma_f32_32x32x16_bf16(fa[mt][ks], fb, acc[n][mt], 0, 0, 0); }
        }
    }
}
struct ConvFrags { bf16x8 a[6], b0[4], b1[4]; };
DEV void conv_load_frags(ConvFrags& F, const char* lds, int a_off0, int a_off0h, int b_off0, int b_off1, int d) {
#pragma unroll
    for (int j = 0; j < 6; ++j) { const u32x2 lo = *(const u32x2*)(lds + a_off0 - 128 * d + (j - 2) * 32), hh = *(const u32x2*)(lds + a_off0h - 128 * d + (j - 2) * 32);
        F.a[j] = __builtin_bit_cast(bf16x8, (u32x4){lo.x, lo.y, hh.x, hh.y}); }
#pragma unroll
    for (int ks = 0; ks < 4; ++ks) { F.b0[ks] = *(const bf16x8*)(lds + b_off0 - 128 * d + ks * 32); F.b1[ks] = *(const bf16x8*)(lds + b_off1 - 128 * d + ks * 32); }
}
DEV void conv_mfma_frags(const ConvFrags& F, f32x16 (&acc)[2][2]) {
#pragma unroll
    for (int ks = 0; ks < 4; ++ks) {
        acc[0][0] = __builtin_amdgcn_mfma_f32_32x32x16_bf16(F.a[ks + 2], F.b0[ks], acc[0][0], 0, 0, 0);
        acc[0][1] = __builtin_amdgcn_mfma_f32_32x32x16_bf16(F.a[ks], F.b0[ks], acc[0][1], 0, 0, 0);
        acc[1][0] = __builtin_amdgcn_mfma_f32_32x32x16_bf16(F.a[ks + 2], F.b1[ks], acc[1][0], 0, 0, 0);
        acc[1][1] = __builtin_amdgcn_mfma_f32_32x32x16_bf16(F.a[ks], F.b1[ks], acc[1][1], 0, 0, 0);
    }
}
DEV void conv_mfma_loop(const char* lds, f32x16 (&acc)[2][2], int wid, int lane) {
    const int l31 = lane & 31, hi = lane >> 5;
#pragma unroll
    for (int a = 0; a < 2; ++a)
#pragma unroll
        for (int b = 0; b < 2; ++b)
#pragma unroll
            for (int r = 0; r < 16; ++r) acc[a][b][r] = 0.f;
    int a_off[2];
#pragma unroll
    for (int mt = 0; mt < 2; ++mt) { const int r = l31 + 32 * mt, q = (4 - (r & 3)) & 3; a_off[mt] = CV_UB + q * CV_FS + (4096 - r - q + 8 * hi) * 2; }
    int b_off[2];
#pragma unroll
    for (int n = 0; n < 2; ++n) { const int nt = 2 * wid + n; b_off[n] = (l31 & 7) * CV_RS + (CV_PADL + 64 * (4 * nt + (l31 >> 3)) + 8 * hi) * 2; }
    const int dlo = 8 * wid - 63;
#pragma unroll
    for (int j = 0; j < 4; ++j) conv_step<true, false>(lds, acc, a_off, b_off, dlo + j);
    ConvFrags F0, F1; const int d0 = dlo + 4; int a_hi = a_off[0] + 8; asm volatile("" : "+v"(a_hi));
    conv_load_frags(F0, lds, a_off[0], a_hi, b_off[0], b_off[1], d0);
#pragma unroll 1
    for (int j = 0; j < 31; ++j) { const int d = d0 + 2 * j;
        conv_load_frags(F1, lds, a_off[0], a_hi, b_off[0], b_off[1], d + 1); __builtin_amdgcn_sched_barrier(0);
        conv_mfma_frags(F0, acc); __builtin_amdgcn_sched_barrier(0);
        conv_load_frags(F0, lds, a_off[0], a_hi, b_off[0], b_off[1], d + 2); __builtin_amdgcn_sched_barrier(0);
        conv_mfma_frags(F1, acc); __builtin_amdgcn_sched_barrier(0); }
    conv_mfma_frags(F0, acc);
#pragma unroll
    for (int j = 0; j < 4; ++j) conv_step<false, true>(lds, acc, a_off, b_off, dlo + 67 + j);
}
DEV void conv_unit(char* lds, const Params& p, int c) {
    const int tid = threadIdx.x, lane = tid & 63, wid = tid >> 6, l31 = lane & 31, hi = lane >> 5;
    const bf16_t* PT = (const bf16_t*)(p.ws + WS_PT); const bf16_t* GR = (const bf16_t*)(p.ws + WS_GR); const float* ssum = (const float*)(p.ws + WS_SSUM);
    bf16_t* OG2 = (bf16_t*)(p.ws + WS_OG2);
    for (int i = tid; i < 8 * 98; i += 512) { const int b = i / 98, j = i % 98;
        const int e = (j < 48) ? j * 4 : (CV_PADL + SEQ + (j - 48) * 4); *(u32x2*)(lds + b * CV_RS + e * 2) = (u32x2){0u, 0u}; }
    { const float w0 = p.conv_w[c], w1 = p.conv_w[3072 + c], w2 = p.conv_w[6144 + c], bias = p.conv_b[c];
        for (int i = tid; i < 8 * 1024; i += 512) { const int b = i >> 10, t = (i & 1023) * 4; float u[4];
            sconv4(PT + ((size_t)(b * 4096 + c)) * 4096, t, w0, w1, w2, bias, u);
            u32x2 w; w.x = pk2(u[0], u[1]); w.y = pk2(u[2], u[3]); *(u32x2*)(lds + b * CV_RS + (CV_PADL + t) * 2) = w; } }
    conv_load_filter(lds, GR + (size_t)c * 8192);
    __syncthreads();
    f32x16 acc[2][2];
    conv_mfma_loop(lds, acc, wid, lane);
    __syncthreads();
    { const float invs = 1.0f / ssum[c], sk = p.skip[c];
        const float w0 = p.conv_w[1024 + c], w1 = p.conv_w[3072 + 1024 + c], w2 = p.conv_w[6144 + 1024 + c], bias = p.conv_b[1024 + c];
        const int b = l31 & 7;
#pragma unroll
        for (int n = 0; n < 2; ++n) { const int i = 4 * (2 * wid + n) + (l31 >> 3);
#pragma unroll
            for (int mt = 0; mt < 2; ++mt)
#pragma unroll
                for (int g = 0; g < 4; ++g) { const int t = 64 * i + 32 * mt + 8 * g + 4 * hi; float x1[4];
                    sconv4(PT + ((size_t)(b * 4096 + 1024 + c)) * 4096, t, w0, w1, w2, bias, x1);
                    char* up = lds + b * CV_RS + (CV_PADL + t) * 2; const u32x2 vw = *(const u32x2*)up;
                    const float z0 = x1[0] * (acc[n][mt][4 * g] * invs + sk * lo_bf(vw.x)), z1 = x1[1] * (acc[n][mt][4 * g + 1] * invs + sk * hi_bf(vw.x));
                    const float z2 = x1[2] * (acc[n][mt][4 * g + 2] * invs + sk * lo_bf(vw.y)), z3 = x1[3] * (acc[n][mt][4 * g + 3] * invs + sk * hi_bf(vw.y));
                    u32x2 w; w.x = pk2(z0, z1); w.y = pk2(z2, z3); *(u32x2*)up = w; } } }
    conv_load_filter(lds, GR + (size_t)(1024 + c) * 8192);
    __syncthreads();
    conv_mfma_loop(lds, acc, wid, lane);
    { const float invs = 1.0f / ssum[1024 + c], sk = p.skip[1024 + c];
        const float w0 = p.conv_w[2048 + c], w1 = p.conv_w[3072 + 2048 + c], w2 = p.conv_w[6144 + 2048 + c], bias = p.conv_b[2048 + c];
        const int b = l31 & 7;
#pragma unroll
        for (int n = 0; n < 2; ++n) { const int i = 4 * (2 * wid + n) + (l31 >> 3);
#pragma unroll
            for (int mt = 0; mt < 2; ++mt)
#pragma unroll
                for (int g = 0; g < 4; ++g) { const int t = 64 * i + 32 * mt + 8 * g + 4 * hi; float x2[4];
                    sconv4(PT + ((size_t)(b * 4096 + 2048 + c)) * 4096, t, w0, w1, w2, bias, x2);
                    const u32x2 zw = *(const u32x2*)(lds + b * CV_RS + (CV_PADL + t) * 2);
                    const u32x2 gw = *(const u32x2*)(PT + ((size_t)(b * 4096 + 3072 + c)) * 4096 + t);
                    const float y0 = x2[0] * (acc[n][mt][4 * g] * invs + sk * lo_bf(zw.x)) * silu(lo_bf(gw.x)), y1 = x2[1] * (acc[n][mt][4 * g + 1] * invs + sk * hi_bf(zw.x)) * silu(hi_bf(gw.x));
                    const float y2 = x2[2] * (acc[n][mt][4 * g + 2] * invs + sk * lo_bf(zw.y)) * silu(lo_bf(gw.y)), y3 = x2[3] * (acc[n][mt][4 * g + 3] * invs + sk * hi_bf(zw.y)) * silu(hi_bf(gw.y));
                    u32x2 w; w.x = pk2(y0, y1); w.y = pk2(y2, y3); *(u32x2*)(OG2 + ((size_t)(b * 1024 + c)) * 4096 + t) = w; } } }
    __syncthreads();
}

struct Raw3 { u32x2 mid; unsigned halo; };
DEV Raw3 ld_raw3(const bf16_t* px, int t) {
    Raw3 r; r.mid = *(const u32x2*)(px + t);
    const unsigned a = px[t - 1], b = px[t + 4];
    r.halo = (t > 0 ? a : 0u) | ((t + 4 < SEQ ? b : 0u) << 16);
    return r;
}
DEV void sconv_raw(const Raw3& r, float w0, float w1, float w2, float bias, float* u) {
    const float pm = lo_bf(r.halo), pp = hi_bf(r.halo), q0 = lo_bf(r.mid.x), q1 = hi_bf(r.mid.x), q2 = lo_bf(r.mid.y), q3 = hi_bf(r.mid.y);
    u[0] = w0 * pm + w1 * q0 + w2 * q1 + bias; u[1] = w0 * q0 + w1 * q1 + w2 * q2 + bias; u[2] = w0 * q1 + w1 * q2 + w2 * q3 + bias; u[3] = w0 * q2 + w1 * q3 + w2 * pp + bias;
}
struct FiltRegs { u32x4 a[2], b[2]; };
DEV void filt_load(FiltRegs& f, const bf16_t* gr, int tid) {
#pragma unroll
    for (int rnd = 0; rnd < 2; ++rnd) { const int ch = tid + rnd * 512; f.a[rnd] = *(const u32x4*)(gr + ch * 8);
        const int ch1 = ch + 1 < 1024 ? ch + 1 : ch; const u32x4 t = *(const u32x4*)(gr + ch1 * 8); f.b[rnd] = (ch + 1 < 1024) ? t : (u32x4){0u, 0u, 0u, 0u}; }
}
DEV void filt_store(char* lds, const FiltRegs& f, int tid) {
#pragma unroll
    for (int rnd = 0; rnd < 2; ++rnd) { const int ch = tid + rnd * 512; const u32x4 a = f.a[rnd], bq = f.b[rnd];
        const unsigned w[8] = {a.x, a.y, a.z, a.w, bq.x, bq.y, bq.z, bq.w};
        char* fp = lds + CV_UB + ch * 16;
        *(u32x4*)(fp) = a;
        u32x4 c1, c2, c3;
        c1.x = __builtin_amdgcn_alignbit(w[1], w[0], 16); c1.y = __builtin_amdgcn_alignbit(w[2], w[1], 16); c1.z = __builtin_amdgcn_alignbit(w[3], w[2], 16); c1.w = __builtin_amdgcn_alignbit(w[4], w[3], 16);
        c2 = (u32x4){w[1], w[2], w[3], w[4]};
        c3.x = __builtin_amdgcn_alignbit(w[2], w[1], 16); c3.y = __builtin_amdgcn_alignbit(w[3], w[2], 16); c3.z = __builtin_amdgcn_alignbit(w[4], w[3], 16); c3.w = __builtin_amdgcn_alignbit(w[5], w[4], 16);
        *(u32x4*)(fp + CV_FS) = c1; *(u32x4*)(fp + 2 * CV_FS) = c2; *(u32x4*)(fp + 3 * CV_FS) = c3; }
}
#define CV_T(k) (64 * (4 * (2 * wid + ((k) >> 3)) + (l31 >> 3)) + 32 * (((k) >> 2) & 1) + 8 * ((k) & 3) + 4 * hi)
#define CV_LANE_IDS() int tid = threadIdx.x; asm volatile("" : "+v"(tid));   \
    const int lane = tid & 63, wid = __builtin_amdgcn_readfirstlane(tid >> 6), l31 = lane & 31, hi = lane >> 5, eb = l31 & 7; (void)eb; (void)hi; (void)wid
DEV void conv_stage_load(char* lds, const Params& p, int c) {
    CV_LANE_IDS();
    const bf16_t* PT = (const bf16_t*)(p.ws + WS_PT); const bf16_t* GR = (const bf16_t*)(p.ws + WS_GR);
    FiltRegs f0; filt_load(f0, GR + (size_t)c * 8192, tid);
    Raw3 ru[16];
#pragma unroll
    for (int k = 0; k < 16; ++k) { const int i = tid + k * 512, b = i >> 10, t = (i & 1023) * 4; ru[k] = ld_raw3(PT + ((size_t)(b * 4096 + c)) * 4096, t); }
    for (int i = tid; i < 8 * 98; i += 512) { const int b = i / 98, j = i % 98;
        const int e = (j < 48) ? j * 4 : (CV_PADL + SEQ + (j - 48) * 4); *(u32x2*)(lds + b * CV_RS + e * 2) = (u32x2){0u, 0u}; }
    const float w0 = p.conv_w[c], w1 = p.conv_w[3072 + c], w2 = p.conv_w[6144 + c], bias = p.conv_b[c];
#pragma unroll
    for (int k = 0; k < 16; ++k) { const int i = tid + k * 512, b = i >> 10, t = (i & 1023) * 4; float u[4]; sconv_raw(ru[k], w0, w1, w2, bias, u);
        u32x2 w; w.x = pk2(u[0], u[1]); w.y = pk2(u[2], u[3]); *(u32x2*)(lds + b * CV_RS + (CV_PADL + t) * 2) = w; }
    filt_store(lds, f0, tid);
}
DEV void conv_stage_epi0(char* lds, const Params& p, int c, const f32x16 (&acc)[2][2]) {
    CV_LANE_IDS();
    const bf16_t* PT = (const bf16_t*)(p.ws + WS_PT); const bf16_t* GR = (const bf16_t*)(p.ws + WS_GR); const float* ssum = (const float*)(p.ws + WS_SSUM);
    FiltRegs f1; filt_load(f1, GR + (size_t)(1024 + c) * 8192, tid);
    const bf16_t* px1 = PT + ((size_t)(eb * 4096 + 1024 + c)) * 4096;
    Raw3 r1[16];
#pragma unroll
    for (int k = 0; k < 16; ++k) r1[k] = ld_raw3(px1, CV_T(k));
    const float a0 = p.conv_w[1024 + c], a1 = p.conv_w[3072 + 1024 + c], a2 = p.conv_w[6144 + 1024 + c], ab = p.conv_b[1024 + c];
    const float invs = 1.0f / ssum[c], sk = p.skip[c];
#pragma unroll
    for (int k = 0; k < 16; ++k) { const int n = k >> 3, mt = (k >> 2) & 1, g = k & 3; const int t = CV_T(k);
        float x1[4]; sconv_raw(r1[k], a0, a1, a2, ab, x1);
        char* up = lds + eb * CV_RS + (CV_PADL + t) * 2; const u32x2 vw = *(const u32x2*)up;
        const float z0 = x1[0] * (acc[n][mt][4 * g] * invs + sk * lo_bf(vw.x)), z1 = x1[1] * (acc[n][mt][4 * g + 1] * invs + sk * hi_bf(vw.x));
        const float z2 = x1[2] * (acc[n][mt][4 * g + 2] * invs + sk * lo_bf(vw.y)), z3 = x1[3] * (acc[n][mt][4 * g + 3] * invs + sk * hi_bf(vw.y));
        u32x2 w; w.x = pk2(z0, z1); w.y = pk2(z2, z3); *(u32x2*)up = w; }
    filt_store(lds, f1, tid);
}
DEV void conv_stage_epi1(char* lds, const Params& p, int c, const f32x16 (&acc)[2][2]) {
    CV_LANE_IDS();
    const bf16_t* PT = (const bf16_t*)(p.ws + WS_PT); const float* ssum = (const float*)(p.ws + WS_SSUM); bf16_t* OG2 = (bf16_t*)(p.ws + WS_OG2);
    const bf16_t* px2 = PT + ((size_t)(eb * 4096 + 2048 + c)) * 4096; const bf16_t* pg = PT + ((size_t)(eb * 4096 + 3072 + c)) * 4096;
    Raw3 r2[16]; u32x2 rg[16];
#pragma unroll
    for (int k = 0; k < 16; ++k) { r2[k] = ld_raw3(px2, CV_T(k)); rg[k] = *(const u32x2*)(pg + CV_T(k)); }
    const float b0 = p.conv_w[2048 + c], b1 = p.conv_w[3072 + 2048 + c], b2 = p.conv_w[6144 + 2048 + c], bb = p.conv_b[2048 + c];
    const float invs = 1.0f / ssum[1024 + c], sk = p.skip[1024 + c];
#pragma unroll
    for (int k = 0; k < 16; ++k) { const int n = k >> 3, mt = (k >> 2) & 1, g = k & 3; const int t = CV_T(k);
        float x2[4]; sconv_raw(r2[k], b0, b1, b2, bb, x2);
        const u32x2 zw = *(const u32x2*)(lds + eb * CV_RS + (CV_PADL + t) * 2);
        const float y0 = x2[0] * silu(lo_bf(rg[k].x)) * (acc[n][mt][4 * g] * invs + sk * lo_bf(zw.x)), y1 = x2[1] * silu(hi_bf(rg[k].x)) * (acc[n][mt][4 * g + 1] * invs + sk * hi_bf(zw.x));
        const float y2 = x2[2] * silu(lo_bf(rg[k].y)) * (acc[n][mt][4 * g + 2] * invs + sk * lo_bf(zw.y)), y3 = x2[3] * silu(hi_bf(rg[k].y)) * (acc[n][mt][4 * g + 3] * invs + sk * hi_bf(zw.y));
        u32x2 w; w.x = pk2(y0, y1); w.y = pk2(y2, y3); *(u32x2*)(OG2 + ((size_t)(eb * 1024 + c)) * 4096 + t) = w; }
}
DEV void conv_stage_mfma(const char* lds, f32x16 (&acc)[2][2]) { CV_LANE_IDS(); conv_mfma_loop(lds, acc, wid, lane); }
DEV void conv_unit2(char* lds, const Params& p, int c) {
    conv_stage_load(lds, p, c);
    __syncthreads();
    f32x16 acc[2][2];
    conv_stage_mfma(lds, acc);
    __syncthreads();
    conv_stage_epi0(lds, p, c, acc);
    __syncthreads();
    conv_stage_mfma(lds, acc);
    conv_stage_epi1(lds, p, c, acc);
    __syncthreads();
}
#undef CV_T
#undef CV_LANE_IDS

#define XB_TMO      128
#define XB_XCNT(j)  (256  + 64 * (j))
#define XB_XSUB(j)  (1280 + 64 * (j))
#define XB_XGEN(j)  (2304 + 64 * (j))
#define XB_TOP      3328
#define XB_TOPGEN   3392
#define XCD_BAR_WORDS 3456
#define XB_SPIN_CAP (1u << 20)
DEV unsigned xb_ld(unsigned* p) { return __hip_atomic_load(p, __ATOMIC_RELAXED, __HIP_MEMORY_SCOPE_AGENT); }
DEV unsigned xb_add(unsigned* p, unsigned v) { return __hip_atomic_fetch_add(p, v, __ATOMIC_RELAXED, __HIP_MEMORY_SCOPE_AGENT); }
DEV unsigned xb_xcc_id() { return (unsigned)__builtin_amdgcn_s_getreg((3 << 11) | 20) & 0xFu; }
#define XB_SPIN(cond, bar) do { unsigned _sp = 0; while (cond) { __builtin_amdgcn_s_sleep(1); \
    if ((++_sp & 255u) == 0u) { if (xb_ld(&(bar)[XB_TMO])) break; if (_sp > XB_SPIN_CAP) { atomicAdd(&(bar)[XB_TMO], 1u); break; } } } } while (0)
struct XcdBarrier { unsigned* bar; unsigned x; volatile LAS unsigned* st; };
DEV XcdBarrier xcd_barrier_post(unsigned* bar, volatile LAS unsigned* st) {
    XcdBarrier b; b.bar = bar; b.x = xb_xcc_id(); b.st = st;
    if (threadIdx.x == 0) (void)xb_add(&bar[XB_XCNT(b.x)], 1u);
    return b;
}
DEV void xcd_barrier_complete(unsigned* bar, unsigned x, unsigned& nloc, unsigned& nx) {
    const unsigned G = gridDim.x * gridDim.y * gridDim.z;
    unsigned sum, cnt, mine, sp = 0u;
    for (;;) {
        sum = 0u; cnt = 0u; mine = 0u;
#pragma unroll
        for (unsigned j = 0; j < 16; ++j) { const unsigned c = xb_ld(&bar[XB_XCNT(j)]); sum += c; cnt += (c > 0u) ? 1u : 0u; mine = (j == x) ? c : mine; }
        if (sum == G) break;
        __builtin_amdgcn_s_sleep(1);
        if ((++sp & 255u) == 0u) { if (xb_ld(&bar[XB_TMO])) break; if (sp > XB_SPIN_CAP) { atomicAdd(&bar[XB_TMO], 1u); break; } }
    }
    nloc = mine > 0u ? mine : 1u; nx = cnt > 0u ? cnt : 1u;
}
DEV void xcd_barrier(const XcdBarrier& b) {
    asm volatile("s_waitcnt vmcnt(0)" ::: "memory");
    __syncthreads();
    if (threadIdx.x == 0) {
        unsigned* bar = b.bar;
        __builtin_amdgcn_s_waitcnt(0);
        unsigned nloc = b.st[0], nx = b.st[1];
        if (nloc == 0u) { xcd_barrier_complete(bar, b.x, nloc, nx); b.st[0] = nloc; b.st[1] = nx; }
        const unsigned old = xb_add(&bar[XB_XSUB(b.x)], 1u);
        const unsigned gen = old / nloc;
        if (old + 1u == (gen + 1u) * nloc) {
            __builtin_amdgcn_fence(__ATOMIC_RELEASE, "agent");
            asm volatile("s_waitcnt vmcnt(0)" ::: "memory");
            const unsigned og = xb_add(&bar[XB_TOP], 1u);
            const unsigned tg = og / nx;
            if (og + 1u == (tg + 1u) * nx) xb_add(&bar[XB_TOPGEN], 1u);
            else XB_SPIN(xb_ld(&bar[XB_TOPGEN]) == tg, bar);
            __builtin_amdgcn_fence(__ATOMIC_ACQUIRE, "agent");
            xb_add(&bar[XB_XGEN(b.x)], 1u);
            asm volatile("s_waitcnt vmcnt(0)" ::: "memory");
        } else {
            XB_SPIN(xb_ld(&bar[XB_XGEN(b.x)]) == gen, bar);
            __builtin_amdgcn_fence(__ATOMIC_ACQUIRE, "agent");
            asm volatile("s_waitcnt vmcnt(0)" ::: "memory");
        }
    }
    __syncthreads();
}

constexpr int NPHASE = 12;
__global__ void __launch_bounds__(512) fwd_kernel(Params p) {
    extern __shared__ __attribute__((aligned(16))) char lds[];
    char* ws = p.ws;
    volatile LAS unsigned* bst = (volatile LAS unsigned*)(LAS char*)(lds + LDS_BYTES - 64);
    if (threadIdx.x < 16) bst[threadIdx.x] = 0u;
    __syncthreads();
    XcdBarrier xbar; xbar.bar = (unsigned*)(ws + WS_CTL); xbar.x = 0; xbar.st = bst;
    if (MK_LAUNCHES == 1) xbar = xcd_barrier_post((unsigned*)(ws + WS_CTL), bst);
#define SEAM(k) do { if (MK_LAUNCHES == 1 && (k) + 1 < p.ph_hi) { if ((k) == 0) cg::this_grid().sync(); else xcd_barrier(xbar); } } while (0)
#ifndef PHASE_MASK
#define PHASE_MASK 0xFFF
#endif
#define IN(k) (((PHASE_MASK >> (k)) & 1) && p.ph_lo <= (k) && (k) < p.ph_hi)
#define REP(k) for (int rep_ = 0; rep_ < ((PROBE_REPEAT == (k)) ? 2 : 1); ++rep_)
    if (IN(0)) { REP(0) phase_prep(lds, p); SEAM(0); }
    if (IN(1)) {
        EpiFilt ef{(bf16_t*)(ws + WS_GR), (float*)(ws + WS_SSUM), p.f_b3};
        gemm_phase<false, EpiFilt>(lds, (const bf16_t*)(ws + WS_W3), 64, (const bf16_t*)(ws + WS_HID2), 64, 4096, 4096, 64, ef);
        phase_norm0(p); SEAM(1); }
    if (IN(2)) {
        REP(2) { pg8::Gemm g{(const bf16_t*)(ws + WS_H0), (const bf16_t*)(ws + WS_WIN), NALL, AINP, DM}; pg8::StaticOrder S; S.init(NALL, AINP, (int)gridDim.x, (int)blockIdx.x);
            pg8::EpiBf16 E{(bf16_t*)(ws + WS_PRAW), (size_t)AINP, 0, 0};
            pg8::gemm_phase<pg8::EpiBf16, pg8::StaticOrder, true, true>((PG8_LAS unsigned char*)lds, g, S, E); }
        SEAM(2); }
    if (IN(3)) { REP(3) phase_post(p); SEAM(3); }
    if (IN(4)) {
        const float* rp = (const float*)(ws + WS_ROPE);
        REP(4) {
        EpiUq eq{(bf16_t*)(ws + WS_QM), rp + 2048, rp + 2560};
        gemm_phase<false, EpiUq>(lds, (const bf16_t*)(ws + WS_CQN), 256, (const bf16_t*)(ws + WS_WUQ), 256, NTOK, 768, 256, eq);
        EpiUkv ek{(bf16_t*)(ws + WS2_KM), (bf16_t*)(ws + WS2_VM)};
        gemm_phase<false, EpiUkv>(lds, (const bf16_t*)(ws + WS_CKVN), 128, (const bf16_t*)(ws + WS_WUKV), 128, NALL, 1024, 128, ek); }
        SEAM(4); }
    if (IN(5)) { REP(5) phase_attn(lds, p); SEAM(5); }
    if (IN(6)) {
        REP(6) { pg8::Gemm g{(const bf16_t*)(ws + WS2_OG), (const bf16_t*)(ws + WS_WOUT), NTOK, DM, DM}; pg8::StaticOrder S; S.init(NTOK, DM, (int)gridDim.x, (int)blockIdx.x);
            pg8::EpiResF32 E{p.x, p.out, (const float*)(ws + WS_MOD0), (DBG_SKIP & 1) ? 0.f : 1.f};
            pg8::gemm_phase<pg8::EpiResF32, pg8::StaticOrder, true, true>((PG8_LAS unsigned char*)lds, g, S, E); }
        SEAM(6); }
    if (IN(7)) { REP(7) phase_norm1(p); SEAM(7); }
    if (IN(8)) {
        REP(8) { pg8::Gemm g{(const bf16_t*)(ws + WS_HWIN), (const bf16_t*)(ws + WS_H1), 4096, NTOK, DM}; pg8::StaticOrder S; S.init(4096, NTOK, (int)gridDim.x, (int)blockIdx.x);
            pg8::EpiBf16 E{(bf16_t*)(ws + WS_PT), (size_t)4096, 4096, (size_t)4096 * 4096};
            pg8::gemm_phase<pg8::EpiBf16, pg8::StaticOrder, true, true>((PG8_LAS unsigned char*)lds, g, S, E); }
        SEAM(8); }
    if (IN(9)) { REP(9) for (int c = blockIdx.x; c < 1024; c += gridDim.x) conv_unit2(lds, p, c); SEAM(9); }
    if (IN(10)) {
        EpiRes e{p.out, p.out, (const float*)(ws + WS_MOD1), (DBG_SKIP & 2) ? 0.f : 1.f};
        const bf16_t* OG2 = (const bf16_t*)(ws + WS_OG2); const bf16_t* W = (const bf16_t*)(ws + WS_HWOUT);
        const int nt = (NTOK / 256) * (DM / 128);
        for (int t = blockIdx.x; t < nt; t += gridDim.x) { const int ti = t / 8, tj = t % 8; const int b = ti >> 4, l0 = (ti & 15) * 256;
            gemm_tile<true, EpiRes>(lds, OG2 + (size_t)b * 1024 * 4096 + l0, 4096, W + (size_t)tj * 128 * DM, DM, DM, e, ti * 256, tj * 128); }
        SEAM(10); }
    if (IN(11)) { phase_final(p); }
#undef SEAM
#undef IN
}

extern "C" void kernel_launch(void* const* d_in, const int* in_sizes, int n_in, void* d_out, int out_size, void* d_ws, size_t ws_size, hipStream_t stream) {
    static int grid = 0;
    if (grid == 0) {
        if (n_in != 28 || out_size != NTOK * DM || ws_size < WS_END) { fprintf(stderr, "kernel_launch: unexpected shapes n_in %d out %d ws %zu\n", n_in, out_size, ws_size); grid = -1; return; }
        int dev = 0, cus = 0, per_cu = 0;
        hipGetDevice(&dev); hipDeviceGetAttribute(&cus, hipDeviceAttributeMultiprocessorCount, dev);
        if (hipFuncSetAttribute((const void*)fwd_kernel, hipFuncAttributeMaxDynamicSharedMemorySize, LDS_BYTES) != hipSuccess) { fprintf(stderr, "hipFuncSetAttribute failed\n"); grid = -1; return; }
        hipOccupancyMaxActiveBlocksPerMultiprocessor(&per_cu, (const void*)fwd_kernel, 512, LDS_BYTES);
        if (per_cu < 1) { fprintf(stderr, "occupancy query says %d\n", per_cu); per_cu = 1; }
        grid = cus * 1;
        (void)hipGetLastError();
    }
    if (grid < 0) return;
    Params p{};
    const float** pp = (const float**)&p;
    for (int i = 0; i < 28; ++i) pp[i] = (const float*)d_in[i];
    p.out = (float*)d_out; p.ws = (char*)d_ws;
#if MK_LAUNCHES == 1
    if (hipMemsetAsync((char*)d_ws + WS_CTL, 0, CTL_BYTES, stream) != hipSuccess) { fprintf(stderr, "memset failed\n"); return; }
    p.ph_lo = 0; p.ph_hi = NPHASE;
    void* args[] = {&p};
    hipError_t e = hipLaunchCooperativeKernel((const void*)fwd_kernel, dim3(grid), dim3(512), args, LDS_BYTES, stream);
    if (e != hipSuccess) fprintf(stderr, "cooperative launch failed: %s (grid %d)\n", hipGetErrorString(e), grid);
#else
    for (int k = 0; k < NPHASE; ++k) { p.ph_lo = k; p.ph_hi = k + 1; hipLaunchKernelGGL(fwd_kernel, dim3(grid), dim3(512), LDS_BYTES, stream, p); }
#endif
}
```

```cpp
#include <hip/hip_runtime.h>
#include <hip/hip_cooperative_groups.h>
#include <cstdio>
#include <cstdint>
namespace cg = cooperative_groups;

#ifndef MK_LAUNCHES
#define MK_LAUNCHES 1
#endif

#ifndef PROBE_REPEAT
#define PROBE_REPEAT -1
#endif
#ifndef DBG_SKIP
#define DBG_SKIP 0
#endif
#define DEV __device__ __forceinline__
typedef unsigned short bf16_t;
typedef short bf16x8 __attribute__((ext_vector_type(8)));
typedef short s16x4 __attribute__((ext_vector_type(4)));
typedef float f32x16 __attribute__((ext_vector_type(16)));
typedef float f32x4 __attribute__((ext_vector_type(4)));
typedef float f32x2 __attribute__((ext_vector_type(2)));
typedef unsigned u32x4 __attribute__((ext_vector_type(4)));
typedef unsigned u32x2 __attribute__((ext_vector_type(2)));
typedef __bf16 bf16x2_t __attribute__((ext_vector_type(2)));
#define LAS __attribute__((address_space(3)))

constexpr int NB = 8, SEQ = 4096, DM = 1024, CTXL = 256, LK = SEQ + CTXL;
constexpr int NTOK = NB * SEQ, NCTX = NB * CTXL, NALL = NTOK + NCTX;
constexpr int AIN = 2208, AINP = 2304;
constexpr float EPS = 1e-6f;
constexpr float LOG2E = 1.4426950408889634f;
constexpr float QSC_A = 0.125f * LOG2E;
constexpr float QSC_M = 0.10206207261596575f * LOG2E;

constexpr size_t MiB = 1ull << 20;
constexpr size_t WS_WIN = 0;
constexpr size_t WS_WUQ = 5 * MiB;
constexpr size_t WS_WUKV = 6 * MiB;
constexpr size_t WS_WOUT = 7 * MiB;
constexpr size_t WS_HWIN = 9 * MiB;
constexpr size_t WS_HWOUT = 17 * MiB;
constexpr size_t WS_W3 = 19 * MiB;
constexpr size_t WS_HID2 = 20 * MiB;
constexpr size_t WS_MOD0 = 21 * MiB;
constexpr size_t WS_MOD1 = WS_MOD0 + 9 * 3072 * 4;
constexpr size_t WS_SSUM = WS_MOD1 + 8 * 3072 * 4;
constexpr size_t WS_ROPE = WS_SSUM + 2048 * 4;
constexpr size_t WS_GR = 22 * MiB;
constexpr size_t WS_H0 = 64 * MiB;
constexpr size_t WS_PRAW = 136 * MiB;
constexpr size_t WS_QA = 297 * MiB;
constexpr size_t WS_KA = 329 * MiB;
constexpr size_t WS_VA = 338 * MiB;
constexpr size_t WS_CQN = 347 * MiB;
constexpr size_t WS_CKVN = 363 * MiB;
constexpr size_t WS_G = 372 * MiB;
constexpr size_t WS_QM = 64 * MiB;
constexpr size_t WS_KM = 136 * MiB;
constexpr size_t WS_VM = 190 * MiB;
constexpr size_t WS_OG = 226 * MiB;
constexpr size_t WS_H1 = 436 * MiB;
constexpr size_t WS_PT = 64 * MiB;
constexpr size_t WS_OG2 = 320 * MiB;
constexpr size_t WS_CTL = 500 * MiB;
constexpr size_t CTL_BYTES = 16384;
constexpr size_t WS_END = 500 * MiB + CTL_BYTES;
constexpr size_t WS2_KM = 436 * MiB;
constexpr size_t WS2_VM = 190 * MiB;
constexpr size_t WS2_OG = 226 * MiB;

constexpr int LDS_BYTES = 150 * 1024;

DEV float bf2f(bf16_t v) { return __uint_as_float(((unsigned)v) << 16); }
DEV unsigned pk2(float lo, float hi) { f32x2 v = {lo, hi}; bf16x2_t b = __builtin_convertvector(v, bf16x2_t); return __builtin_bit_cast(unsigned, b); }
DEV bf16_t f2bf(float f) { return (bf16_t)(pk2(f, 0.f) & 0xffffu); }
DEV float lo_bf(unsigned w) { return __uint_as_float(w << 16); }
DEV float hi_bf(unsigned w) { return __uint_as_float(w & 0xffff0000u); }
DEV int crow(int r, int hi) { return (r & 3) + 8 * (r >> 2) + 4 * hi; }
DEV float silu(float v) { return v / (1.f + __expf(-v)); }
DEV void unpack8(const u32x4 w, float* v) { v[0] = lo_bf(w.x); v[1] = hi_bf(w.x); v[2] = lo_bf(w.y); v[3] = hi_bf(w.y); v[4] = lo_bf(w.z); v[5] = hi_bf(w.z); v[6] = lo_bf(w.w); v[7] = hi_bf(w.w); }
DEV u32x4 pack8(const float* v) { u32x4 w; w.x = pk2(v[0], v[1]); w.y = pk2(v[2], v[3]); w.z = pk2(v[4], v[5]); w.w = pk2(v[6], v[7]); return w; }

DEV float wave_sum(float v) {
#pragma unroll
    for (int o = 1; o < 64; o <<= 1) v += __shfl_xor(v, o);
    return v;
}
struct Params {
    const float *x, *c, *ctx, *c_ctx, *ada_w, *ada_b, *norm_w, *w_in, *q_norm, *k_norm, *cq_norm, *ckv_norm, *w_uq, *w_ukv, *w_out,
        *hy_w_in, *conv_w, *conv_b, *f_w1, *f_b1, *f_w2, *f_b2, *f_w3, *f_b3, *freq, *skip, *hy_w_out, *final_w;
    float* out; char* ws; int ph_lo, ph_hi;
};

constexpr int G_RS = 144;
constexpr int G_RB = 256 * G_RS, G_CB = 128 * G_RS, G_STAGE = G_RB + G_CB;
constexpr int T_RS = 576;

template <bool TR, class Epi>
DEV void gemm_tile(char* lds, const bf16_t* __restrict__ R, size_t ldr, const bf16_t* __restrict__ C, size_t ldc, int K, const Epi& epi, int ti0, int tj0) {
    const int tid = threadIdx.x, lane = tid & 63, wid = tid >> 6;
    const int wi = wid >> 1, wj = wid & 1, l31 = lane & 31, hi = lane >> 5;
    f32x16 acc[2][2];
#pragma unroll
    for (int a = 0; a < 2; ++a)
#pragma unroll
        for (int b = 0; b < 2; ++b)
#pragma unroll
            for (int r = 0; r < 16; ++r) acc[a][b][r] = 0.f;
    u32x4 rrX[4], rcX[2], rrY[4], rcY[2];
    const bf16_t* Rp; const bf16_t* Cp; int rl_off, cl_off;
    if (TR) { const int c = tid & 31, kr = tid >> 5; Rp = R + (size_t)kr * ldr + c * 8; rl_off = kr * T_RS + c * 16; }
    else { const int lr = tid >> 3, lc = tid & 7; Rp = R + (size_t)lr * ldr + lc * 8; rl_off = lr * G_RS + lc * 16; }
    { const int lr = tid >> 3, lc = tid & 7; Cp = C + (size_t)lr * ldc + lc * 8; cl_off = lr * G_RS + lc * 16; }
    const int nk = K / 64;
    int ra_off[2], cb_off[2];
#pragma unroll
    for (int t = 0; t < 2; ++t) {
        if (TR) { const int g1 = (lane >> 4) & 1, q = (lane & 15) >> 2, p = lane & 3; ra_off[t] = (8 * hi + q) * T_RS + (wi * 64 + t * 32 + 16 * g1 + 4 * p) * 2; }
        else ra_off[t] = (wi * 64 + t * 32 + l31) * G_RS + hi * 16;
        cb_off[t] = G_RB + (wj * 64 + t * 32 + l31) * G_RS + hi * 16;
    }
#define G_LOAD(kt, S) do { const int kk_ = (kt) < nk ? (kt) : nk - 1; \
        if (TR) { _Pragma("unroll") for (int p = 0; p < 4; ++p) rr##S[p] = *(const u32x4*)(Rp + ((size_t)kk_ * 64 + 16 * p) * ldr); } \
        else { _Pragma("unroll") for (int p = 0; p < 4; ++p) rr##S[p] = *(const u32x4*)(Rp + (size_t)(64 * p) * ldr + kk_ * 64); } \
        _Pragma("unroll") for (int p = 0; p < 2; ++p) rc##S[p] = *(const u32x4*)(Cp + (size_t)(64 * p) * ldc + kk_ * 64); } while (0)
#define G_STORE(buf, S) do { char* b_ = lds + (buf) * G_STAGE; \
        if (TR) { _Pragma("unroll") for (int p = 0; p < 4; ++p) *(u32x4*)(b_ + rl_off + 16 * p * T_RS) = rr##S[p]; } \
        else { _Pragma("unroll") for (int p = 0; p < 4; ++p) *(u32x4*)(b_ + rl_off + 64 * p * G_RS) = rr##S[p]; } \
        _Pragma("unroll") for (int p = 0; p < 2; ++p) *(u32x4*)(b_ + G_RB + cl_off + 64 * p * G_RS) = rc##S[p]; } while (0)
#define G_COMPUTE(buf) do { const char* b_ = lds + (buf) * G_STAGE; \
        _Pragma("unroll") for (int ks = 0; ks < 4; ++ks) { bf16x8 fa[2], fb[2]; \
            _Pragma("unroll") for (int t = 0; t < 2; ++t) { \
                if (TR) { \
                    const s16x4 lo = __builtin_bit_cast(s16x4, __builtin_amdgcn_ds_read_tr16_b64_v4i16((LAS s16x4*)(b_ + ra_off[t] + ks * 16 * T_RS))); \
                    const s16x4 hh = __builtin_bit_cast(s16x4, __builtin_amdgcn_ds_read_tr16_b64_v4i16((LAS s16x4*)(b_ + ra_off[t] + (ks * 16 + 4) * T_RS))); \
                    fa[t] = (bf16x8){lo[0], lo[1], lo[2], lo[3], hh[0], hh[1], hh[2], hh[3]}; \
                } else fa[t] = *(const bf16x8*)(b_ + ra_off[t] + ks * 32); \
                fb[t] = *(const bf16x8*)(b_ + cb_off[t] + ks * 32); } \
            _Pragma("unroll") for (int a = 0; a < 2; ++a) _Pragma("unroll") for (int b = 0; b < 2; ++b) acc[a][b] = __builtin_amdgcn_mfma_f32_32x32x16_bf16(fa[a], fb[b], acc[a][b], 0, 0, 0); } } while (0)
    G_LOAD(0, X); G_LOAD(1, Y); G_STORE(0, X);
    __syncthreads();
    for (int kt = 0; kt < nk; kt += 2) {
        G_LOAD(kt + 2, X);
        G_COMPUTE(0);
        G_STORE(1, Y);
        __syncthreads();
        if (kt + 1 >= nk) break;
        G_LOAD(kt + 3, Y);
        G_COMPUTE(1);
        G_STORE(0, X);
        __syncthreads();
    }
#undef G_LOAD
#undef G_STORE
#undef G_COMPUTE
#pragma unroll
    for (int a = 0; a < 2; ++a)
#pragma unroll
        for (int b = 0; b < 2; ++b) epi(ti0 + wi * 64 + a * 32, tj0 + wj * 64 + b * 32, acc[a][b], l31, hi);
}

template <bool TR, class Epi>
DEV void gemm_phase(char* lds, const bf16_t* R, size_t ldr, const bf16_t* C, size_t ldc, int nI, int nJ, int K, const Epi& epi) {
    const int tI = nI / 256, tJ = nJ / 128, nt = tI * tJ;
    for (int t = blockIdx.x; t < nt; t += gridDim.x) {
        const int ti = t / tJ, tj = t % tJ;
        gemm_tile<TR, Epi>(lds, R + (size_t)ti * 256 * ldr, ldr, C + (size_t)tj * 128 * ldc, ldc, K, epi, ti * 256, tj * 128);
    }
}

struct EpiRaw {
    bf16_t* O; size_t ld;
    DEV void operator()(int i0, int j0, const f32x16& a, int l31, int hi) const {
#pragma unroll
        for (int r = 0; r < 16; ++r) O[(size_t)(i0 + crow(r, hi)) * ld + j0 + l31] = f2bf(a[r]);
    }
};
struct EpiUq {
    bf16_t* QM; const float* cos32; const float* sin32;
    DEV void operator()(int i0, int j0, const f32x16& a, int l31, int hi) const {
        const bool pe = (j0 % 96) == 64;
        const int fi = l31 & 7; const bool colang = (l31 & 16) != 0; const bool bpart = (l31 & 8) != 0;
#pragma unroll
        for (int r = 0; r < 16; ++r) {
            const int tok = i0 + crow(r, hi); float v = a[r];
            const float o = __shfl_xor(v, 8);
            if (pe) { const int l = tok & (SEQ - 1); const int pos = colang ? (l & 63) : (l >> 6);
                const float cs = cos32[pos * 8 + fi], sn = sin32[pos * 8 + fi];
                v = bpart ? (v * cs + o * sn) : (v * cs - o * sn); }
            QM[(size_t)tok * 768 + j0 + l31] = f2bf(v * QSC_M);
        }
    }
};
struct EpiUkv {
    bf16_t* KM; bf16_t* VM;
    DEV void operator()(int i0, int j0, const f32x16& a, int l31, int hi) const {
        const int h = j0 >> 7, e = (j0 & 127) + l31;
#pragma unroll
        for (int r = 0; r < 16; ++r) { const size_t row = (size_t)(i0 + crow(r, hi));
            if (e < 64) KM[row * 768 + h * 96 + e] = f2bf(a[r]); else VM[row * 512 + h * 64 + (e - 64)] = f2bf(a[r]); }
    }
};
struct EpiRes {
    const float* base; float* out; const float* mod; float gmul;
    DEV void operator()(int i0, int j0, const f32x16& a, int l31, int hi) const {
        const int b = i0 >> 12; const float g = mod[b * 3072 + 2048 + j0 + l31] * gmul;
#pragma unroll
        for (int h8 = 0; h8 < 2; ++h8) { float bv[8];
#pragma unroll
            for (int r = 0; r < 8; ++r) bv[r] = base[(size_t)(i0 + crow(8 * h8 + r, hi)) * DM + j0 + l31];
#pragma unroll
            for (int r = 0; r < 8; ++r) out[(size_t)(i0 + crow(8 * h8 + r, hi)) * DM + j0 + l31] = bv[r] + g * a[8 * h8 + r]; }
    }
};
struct EpiPT {
    bf16_t* PT;
    DEV void operator()(int i0, int j0, const f32x16& a, int l31, int hi) const {
        const int b = j0 >> 12, l = (j0 & 4095) + l31;
#pragma unroll
        for (int r = 0; r < 16; ++r) PT[((size_t)(b * 4096 + i0 + crow(r, hi))) * 4096 + l] = f2bf(a[r]);
    }
};
struct EpiFilt {
    bf16_t* GR; const float* b3;
    DEV void operator()(int i0, int j0, const f32x16& a, int l31, int hi) const {
        const int t = j0 + l31; const float tn = (float)t * (1.0f / 4095.0f);
        const float dmin = -3.0701134573253945f, dmax = -15.350567286626973f;
#pragma unroll
        for (int r = 0; r < 16; ++r) {
            const int n = i0 + crow(r, hi); const int c = n & 1023, od = n >> 10, o = od >> 1, dir = od & 1;
            const float delta = fabsf(dmin + (float)c * ((dmax - dmin) / 1023.0f));
            const float v = (a[r] + b3[n]) * __expf(-tn * delta);
            bf16_t* g = GR + ((size_t)(o * 1024 + c)) * 8192;
            if (dir == 0) g[4096 - t] = f2bf(v);
            else { if (t == 0) g[0] = 0; else g[4096 + t] = f2bf(v); }
        }
    }
};
DEV void filt_sums(const Params& p) {
    const int wid = threadIdx.x >> 6, lane = threadIdx.x & 63; bf16_t* GR = (bf16_t*)(p.ws + WS_GR); float* ssum = (float*)(p.ws + WS_SSUM);
    for (int row = blockIdx.x * 8 + wid; row < 2048; row += gridDim.x * 8) {
        bf16_t* g = GR + (size_t)row * 8192; float s = 0.f;
        u32x4 w[16];
#pragma unroll
        for (int j = 0; j < 16; ++j) w[j] = *(const u32x4*)(g + (j * 64 + lane) * 8);
#pragma unroll
        for (int j = 0; j < 16; ++j) { float v[8]; unpack8(w[j], v);
            if (j == 0 && lane == 0) v[0] = 0.f;
#pragma unroll
            for (int e = 0; e < 8; ++e) s += fabsf(v[e]); }
        s = wave_sum(s);
        if (lane == 0) ssum[row] = s;
    }
}

namespace pg8 {
#define PG8_LAS __attribute__((address_space(3)))
typedef short bf16x8 __attribute__((ext_vector_type(8)));
typedef float f32x4 __attribute__((ext_vector_type(4)));
typedef unsigned u32x4 __attribute__((ext_vector_type(4)));
constexpr int BM = 256, BK = 64, HALF = 128, HTB = HALF * BK * 2  , STAGE_BYTES = 8 * HTB, NXCD = 8, WGM = 8;

__host__ __device__ __forceinline__ int lds_byte(int r, int c) { const int st = (r >> 4) * 2 + (c >> 5), rr = r & 15, cc = c & 31, ob = rr * 64 + cc * 2; return st * 1024 + (ob ^ (((ob >> 9) & 1) << 5)); }
__host__ __device__ __forceinline__ void stage_rc(int b, int& R, int& C) { const int st = b / 1024, sb = b % 1024, swz = sb ^ (((sb >> 9) & 1) << 5); R = (st >> 1) * 16 + swz / 64; C = (st & 1) * 32 + (swz % 64) / 2; }
__host__ __device__ __forceinline__ int perm32(int rho) { const int n = rho >> 4, i = rho & 15; return 8 * (i >> 2) + 4 * n + (i & 3); }

struct Unit { int pm, pn; };
struct Gemm { const bf16_t* A; const bf16_t* Bt; int M, N, K; };

struct StaticOrder {
    int nM, nN, nwg, G, c;
    __host__ __device__ void init(int M, int N, int G_, int c_) { nM = M / BM; nN = N / BM; nwg = nM * nN; G = G_; c = c_; }
    __host__ __device__ bool next(int i, Unit& u) const {
        const long L = (long)i * G + c; if (L >= nwg) return false;
        int wgid = (int)L; { const int q = nwg / NXCD, r = nwg % NXCD, xcd = wgid % NXCD, off = wgid / NXCD; wgid = (xcd < r ? xcd * (q + 1) : r * (q + 1) + (xcd - r) * q) + off; }
        const int nig = WGM * nN, gid = wgid / nig, fm = gid * WGM, gsz = (nM - fm) < WGM ? (nM - fm) : WGM;
        u.pm = fm + ((wgid % nig) % gsz); u.pn = (wgid % nig) / gsz; return true;
    }
    __device__ __forceinline__ void a_ready(const Unit&) const {}
    __device__ __forceinline__ void done(const Unit&) const {}
};

__device__ __forceinline__ unsigned cvt_pk_bf16(float lo, float hi) { unsigned r; asm volatile("v_cvt_pk_bf16_f32 %0, %1, %2" : "=v"(r) : "v"(lo), "v"(hi)); return r; }
typedef float f32x2 __attribute__((ext_vector_type(2)));

struct EpiBf16 {
    static constexpr bool PERM = true, AFTER_DRAIN = false;
    bf16_t* O; size_t ldc; int split_cols; size_t split_stride;
    __device__ __forceinline__ void operator()(const f32x4 (&acc)[2][2][4][2], const Unit& u, int wr, int wc, int fr, int fq) const {
        const int row0 = u.pm * BM + wr * 64 + fr; int colt = u.pn * BM; bf16_t* base = O;
        if (split_cols) { const int t = colt / split_cols; base += (size_t)t * split_stride; colt -= t * split_cols; }
        const int col0 = colt + wc * 32 + 8 * fq;
#pragma unroll
        for (int ai = 0; ai < 2; ++ai)
#pragma unroll
            for (int m = 0; m < 4; ++m) { bf16_t* rowp = base + (size_t)(row0 + ai * HALF + m * 16) * ldc + col0;
#pragma unroll
                for (int bj = 0; bj < 2; ++bj) { const f32x4 v0 = acc[ai][bj][m][0], v1 = acc[ai][bj][m][1];
                    u32x4 w; w.x = cvt_pk_bf16(v0[0], v0[1]); w.y = cvt_pk_bf16(v0[2], v0[3]); w.z = cvt_pk_bf16(v1[0], v1[1]); w.w = cvt_pk_bf16(v1[2], v1[3]);
                    *(u32x4*)(rowp + bj * HALF) = w; } }
    }
};
struct EpiResF32 {
    static constexpr bool PERM = false, AFTER_DRAIN = false;
    const float* base; float* out; const float* mod; float gmul;
    __device__ __forceinline__ void operator()(const f32x4 (&acc)[2][2][4][2], const Unit& u, int wr, int wc, int fr, int fq) const {
        const int row0 = u.pm * BM + wr * 64 + fr, col0 = u.pn * BM + wc * 32 + 4 * fq, b = (u.pm * BM) >> 12;
        f32x4 g[2][2];
#pragma unroll
        for (int bj = 0; bj < 2; ++bj)
#pragma unroll
            for (int n = 0; n < 2; ++n) g[bj][n] = *(const f32x4*)(mod + b * 3072 + 2048 + col0 + bj * HALF + n * 16) * gmul;
#pragma unroll
        for (int ai = 0; ai < 2; ++ai) {
            f32x4 pre[4][2][2];
#pragma unroll
            for (int m = 0; m < 4; ++m) { const size_t off = (size_t)(row0 + ai * HALF + m * 16) * 1024 + col0;
#pragma unroll
                for (int bj = 0; bj < 2; ++bj)
#pragma unroll
                    for (int n = 0; n < 2; ++n) pre[m][bj][n] = *(const f32x4*)(base + off + bj * HALF + n * 16); }
#pragma unroll
            for (int m = 0; m < 4; ++m) { const size_t off = (size_t)(row0 + ai * HALF + m * 16) * 1024 + col0;
#pragma unroll
                for (int bj = 0; bj < 2; ++bj)
#pragma unroll
                    for (int n = 0; n < 2; ++n) *(f32x4*)(out + off + bj * HALF + n * 16) = pre[m][bj][n] + g[bj][n] * acc[ai][bj][m][n]; }
        }
    }
};
template <class Epi, class Sched, bool ALIGN_EPI = false, bool SP2 = false>
__device__ __forceinline__ void gemm_phase(PG8_LAS unsigned char* lds, const Gemm g, const Sched& S, const Epi& E) {
    const int tid = threadIdx.x, wid = __builtin_amdgcn_readfirstlane(tid >> 6), lane = tid & 63, wr = wid >> 2, wc = wid & 3, fr = lane & 15, fq = lane >> 4;
    const int K = g.K, nt = K / BK;
    unsigned voffA[2], voffB[2];
#pragma unroll
    for (int i = 0; i < 2; ++i) { int R, C; stage_rc(tid * 16 + i * 8192, R, C); const int Rb = Epi::PERM ? ((R & ~31) + perm32(R & 31)) : R;
        voffA[i] = (unsigned)(R * K + C) * 2u; voffB[i] = (unsigned)(Rb * K + C) * 2u; }
    const size_t kstep = (size_t)(BK * 2);
    const size_t hstep = (size_t)HALF * K * 2;
    const size_t tstep = 2 * hstep;
    const unsigned ldsw = (unsigned)wid * 1024u;
    const int aoff = lds_byte(wr * 64 + fr, fq * 8), boff = lds_byte(wc * 32 + fr, fq * 8);
#define PG8_SA(b, h) (((b) * 2 + (h)) * HTB)
#define PG8_SB(b, h) ((4 + (b) * 2 + (h)) * HTB)
#define PG8_STAGE(bufoff, gbase, voff) do { _Pragma("unroll") for (int _i = 0; _i < 2; ++_i) \
        __builtin_amdgcn_global_load_lds((const unsigned*)((const char*)(gbase) + (voff)[_i]), (PG8_LAS unsigned*)(lds + (bufoff) + ldsw + _i * 8192), 16, 0, 0); } while (0)
#define PG8_LDA(dst, b, h) do { _Pragma("unroll") for (int m = 0; m < 4; ++m) _Pragma("unroll") for (int k = 0; k < 2; ++k) dst[m][k] = *(const PG8_LAS bf16x8*)(lds + PG8_SA(b, h) + aoff + m * 2048 + k * 1024); } while (0)
#define PG8_LDB(dst, b, h) do { _Pragma("unroll") for (int n = 0; n < 2; ++n) _Pragma("unroll") for (int k = 0; k < 2; ++k) dst[n][k] = *(const PG8_LAS bf16x8*)(lds + PG8_SB(b, h) + boff + n * 2048 + k * 1024); } while (0)
#define PG8_MMA(ai, bj, At, Bt) do { __builtin_amdgcn_s_setprio(1); _Pragma("unroll") for (int m = 0; m < 4; ++m) _Pragma("unroll") for (int n = 0; n < 2; ++n) _Pragma("unroll") for (int k = 0; k < 2; ++k) \
        acc[ai][bj][m][n] = __builtin_amdgcn_mfma_f32_16x16x32_bf16(Bt[n][k], At[m][k], acc[ai][bj][m][n], 0, 0, 0); __builtin_amdgcn_s_setprio(0); } while (0)
#define PG8_WAIT_V(n) asm volatile("s_waitcnt vmcnt(" #n ")" ::: "memory")
#define PG8_WAIT_L(n) asm volatile("s_waitcnt lgkmcnt(" #n ")" ::: "memory")
#define PG8_BAR __builtin_amdgcn_s_barrier()
#define PG8_SCHED __builtin_amdgcn_sched_barrier(0)
    Unit cur, nxt; int ui = 0;
    if (!S.next(0, cur)) return;
    f32x4 acc[2][2][4][2];
#pragma unroll
    for (int a = 0; a < 2; ++a)
#pragma unroll
        for (int b = 0; b < 2; ++b)
#pragma unroll
            for (int m = 0; m < 4; ++m)
#pragma unroll
                for (int n = 0; n < 2; ++n) acc[a][b][m][n] = (f32x4){0.f, 0.f, 0.f, 0.f};
    bf16x8 At[4][2], B0[2][2], B1[2][2];
    const char* cA = (const char*)g.A + (size_t)cur.pm * tstep; const char* cB = (const char*)g.Bt + (size_t)cur.pn * tstep;
    S.a_ready(cur);
    if constexpr (SP2) {
        PG8_STAGE(PG8_SB(0, 0), cB, voffB); PG8_STAGE(PG8_SB(0, 1), cB + hstep, voffB); PG8_STAGE(PG8_SA(0, 0), cA, voffA); PG8_STAGE(PG8_SA(0, 1), cA + hstep, voffA);
        if (wr == 1) PG8_BAR;
        PG8_WAIT_V(2); PG8_BAR;
        PG8_STAGE(PG8_SB(1, 0), cB + kstep, voffB); PG8_STAGE(PG8_SA(1, 0), cA + kstep, voffA); PG8_STAGE(PG8_SB(1, 1), cB + hstep + kstep, voffB);
        PG8_WAIT_V(6); PG8_BAR;
    } else {
        PG8_STAGE(PG8_SB(0, 0), cB, voffB); PG8_STAGE(PG8_SA(0, 0), cA, voffA); PG8_STAGE(PG8_SB(0, 1), cB + hstep, voffB); PG8_STAGE(PG8_SA(0, 1), cA + hstep, voffA);
        if (wr == 1) PG8_BAR;
        PG8_WAIT_V(4); PG8_BAR;
        PG8_STAGE(PG8_SB(1, 0), cB + kstep, voffB); PG8_STAGE(PG8_SA(1, 0), cA + kstep, voffA); PG8_STAGE(PG8_SB(1, 1), cB + hstep + kstep, voffB);
        PG8_WAIT_V(6); PG8_BAR;
    }
    for (;;) {
        const bool has_next = S.next(ui + 1, nxt);
        const char* nA = has_next ? (const char*)g.A + (size_t)nxt.pm * tstep : cA; const char* nB = has_next ? (const char*)g.Bt + (size_t)nxt.pn * tstep : cB;
        for (int t = 0; t < nt; t += 2) {
            const bool last = (t == nt - 2);
            const char* a1 = cA + (size_t)(t + 1) * kstep;
            const char* a2 = last ? nA : cA + (size_t)(t + 2) * kstep; const char* b2 = last ? nB : cB + (size_t)(t + 2) * kstep;
            const char* a3 = a2 + kstep; const char* b3 = b2 + kstep;
            if (last && has_next) S.a_ready(nxt);
            if constexpr (SP2) {
            PG8_LDB(B0, 0, 0); PG8_LDB(B1, 0, 1); PG8_SCHED; PG8_LDA(At, 0, 0); PG8_STAGE(PG8_SA(1, 1), a1 + hstep, voffA);
            PG8_WAIT_V(8); PG8_WAIT_L(0); PG8_BAR; PG8_MMA(0, 0, At, B0); PG8_MMA(0, 1, At, B1); PG8_BAR; PG8_SCHED;
            PG8_LDA(At, 0, 1); PG8_STAGE(PG8_SB(0, 0), b2, voffB); PG8_STAGE(PG8_SB(0, 1), b2 + hstep, voffB); PG8_STAGE(PG8_SA(0, 0), a2, voffA);
            PG8_WAIT_V(8); PG8_WAIT_L(0); PG8_BAR; PG8_MMA(1, 0, At, B0); PG8_MMA(1, 1, At, B1); PG8_BAR; PG8_SCHED;
            PG8_LDB(B0, 1, 0); PG8_LDB(B1, 1, 1); PG8_SCHED; PG8_LDA(At, 1, 0); PG8_STAGE(PG8_SA(0, 1), a2 + hstep, voffA);
            PG8_WAIT_V(8); PG8_WAIT_L(0); PG8_BAR; PG8_MMA(0, 0, At, B0); PG8_MMA(0, 1, At, B1); PG8_BAR; PG8_SCHED;
            PG8_LDA(At, 1, 1); PG8_STAGE(PG8_SB(1, 0), b3, voffB); PG8_STAGE(PG8_SB(1, 1), b3 + hstep, voffB); PG8_STAGE(PG8_SA(1, 0), a3, voffA);
            PG8_WAIT_V(8); PG8_WAIT_L(0); PG8_BAR; PG8_MMA(1, 0, At, B0); PG8_MMA(1, 1, At, B1); PG8_BAR; PG8_SCHED;
            } else {
            PG8_LDB(B0, 0, 0); PG8_SCHED; PG8_LDA(At, 0, 0); PG8_STAGE(PG8_SA(1, 1), a1 + hstep, voffA);
            PG8_WAIT_L(8); PG8_BAR; PG8_WAIT_L(0); PG8_MMA(0, 0, At, B0); PG8_BAR; PG8_SCHED;
            PG8_LDB(B1, 0, 1); PG8_STAGE(PG8_SB(0, 0), b2, voffB);
            PG8_BAR; PG8_WAIT_L(0); PG8_MMA(0, 1, At, B1); PG8_BAR;
            PG8_LDA(At, 0, 1); PG8_STAGE(PG8_SA(0, 0), a2, voffA);
            PG8_BAR; PG8_WAIT_L(0); PG8_MMA(1, 0, At, B0); PG8_BAR; PG8_SCHED;
            PG8_STAGE(PG8_SB(0, 1), b2 + hstep, voffB);
            PG8_WAIT_V(6); PG8_BAR; PG8_MMA(1, 1, At, B1); PG8_BAR;
            PG8_LDB(B0, 1, 0); PG8_SCHED; PG8_LDA(At, 1, 0); PG8_STAGE(PG8_SA(0, 1), a2 + hstep, voffA);
            PG8_WAIT_L(8); PG8_BAR; PG8_WAIT_L(0); PG8_MMA(0, 0, At, B0); PG8_BAR; PG8_SCHED;
            PG8_LDB(B1, 1, 1); PG8_STAGE(PG8_SB(1, 0), b3, voffB);
            PG8_BAR; PG8_WAIT_L(0); PG8_MMA(0, 1, At, B1); PG8_BAR;
            PG8_LDA(At, 1, 1); PG8_STAGE(PG8_SA(1, 0), a3, voffA);
            PG8_BAR; PG8_WAIT_L(0); PG8_MMA(1, 0, At, B0); PG8_BAR; PG8_SCHED;
            PG8_STAGE(PG8_SB(1, 1), b3 + hstep, voffB);
            PG8_WAIT_V(6); PG8_BAR; PG8_MMA(1, 1, At, B1); PG8_BAR;
            }
        }
        if constexpr (ALIGN_EPI) { if (wr == 0) PG8_BAR; }
        if constexpr (!Epi::AFTER_DRAIN) { E(acc, cur, wr, wc, fr, fq); S.done(cur); }
        if (!has_next) break;
#pragma unroll
        for (int a = 0; a < 2; ++a)
#pragma unroll
            for (int b = 0; b < 2; ++b)
#pragma unroll
                for (int m = 0; m < 4; ++m)
#pragma unroll
                    for (int n = 0; n < 2; ++n) acc[a][b][m][n] = (f32x4){0.f, 0.f, 0.f, 0.f};
        cur = nxt; cA = nA; cB = nB; ++ui;
        if constexpr (ALIGN_EPI) { if (wr == 1) PG8_BAR; }
    }
    PG8_WAIT_V(0);
    if constexpr (!ALIGN_EPI) { if (wr == 0) PG8_BAR; }
    PG8_BAR;
    if constexpr (Epi::AFTER_DRAIN) { E.fused(acc, cur, wr, wc, fr, fq, lds, wid, lane); S.done(cur); }
#undef PG8_SA
#undef PG8_SB
#undef PG8_STAGE
#undef PG8_LDA
#undef PG8_LDB
#undef PG8_MMA
#undef PG8_WAIT_V
#undef PG8_WAIT_L
#undef PG8_BAR
#undef PG8_SCHED
}
}

DEV void transpose_item(char* lds, const float* W, int K, int N, int Npad, bf16_t* WT, int item) {
    float* tile = (float*)lds;
    const int nb = Npad / 64, kb = item / nb, nbi = item % nb, k0 = kb * 64, n0 = nbi * 64;
    const int tid = threadIdx.x;
    { const int kk = tid >> 4, n4 = (tid & 15) * 4;
#pragma unroll
        for (int p = 0; p < 2; ++p) { f32x4 v = {0.f, 0.f, 0.f, 0.f}; if (n0 + n4 < N) v = *(const f32x4*)(W + (size_t)(k0 + kk + 32 * p) * N + n0 + n4);
            float* d = tile + (kk + 32 * p) * 65 + n4; d[0] = v.x; d[1] = v.y; d[2] = v.z; d[3] = v.w; } }
    __syncthreads();
    { const int n = tid >> 3, kc = tid & 7; float v[8];
#pragma unroll
        for (int j = 0; j < 8; ++j) v[j] = tile[(kc * 8 + j) * 65 + n];
        *(u32x4*)(WT + (size_t)(n0 + n) * K + k0 + kc * 8) = pack8(v); }
    __syncthreads();
}

DEV void mod_item(char* lds, const Params& p, int item) {
    const int layer = item / 96, n0 = (item % 96) * 32, tid = threadIdx.x;
    float* s = (float*)lds;
    float* red = s + 9 * 1024;
    for (int i = tid; i < 9 * 1024; i += 512) { const int v = i >> 10, k = i & 1023; const float cv = (v < 8) ? p.c[v * 1024 + k] : p.c_ctx[k]; s[i] = silu(cv); }
    __syncthreads();
    const int kc = tid >> 5, n = tid & 31; const float* W = p.ada_w + (size_t)layer * DM * 3072 + n0 + n;
    float acc[9];
#pragma unroll
    for (int v = 0; v < 9; ++v) acc[v] = 0.f;
#pragma unroll 8
    for (int kk = 0; kk < 64; ++kk) { const int k = kc * 64 + kk; const float w = W[(size_t)k * 3072];
#pragma unroll
        for (int v = 0; v < 9; ++v) acc[v] += s[v * 1024 + k] * w; }
#pragma unroll
    for (int v = 0; v < 9; ++v) red[(kc * 9 + v) * 32 + n] = acc[v];
    __syncthreads();
    if (tid < 9 * 32) { const int v = tid >> 5, nn = tid & 31; float t = 0.f;
#pragma unroll
        for (int k2 = 0; k2 < 16; ++k2) t += red[(k2 * 9 + v) * 32 + nn];
        t += p.ada_b[layer * 3072 + n0 + nn];
        if (layer == 0) ((float*)(p.ws + WS_MOD0))[v * 3072 + n0 + nn] = t;
        else if (v < 8) ((float*)(p.ws + WS_MOD1))[v * 3072 + n0 + nn] = t; }
    __syncthreads();
}

DEV void hid2_row(char* lds, const Params& p, int t, int wid, int lane) {
    float* sc = (float*)lds + wid * 128;
    const float tn = (float)t * (1.0f / 4095.0f);
    const float w = (float)(2.0 * 3.14159265358979323846 / 4096.0) * (float)t;
    float e = 0.f;
    if (lane == 0) e = tn;
    else if (lane <= 32) { const int k = (lane - 1) & 15; const float band = 1e-4f + (float)k * ((15.0f - 1e-4f) / 15.0f); const float ang = w * band; e = (lane <= 16) ? cosf(ang) : -sinf(ang); }
    sc[lane] = e;
    asm volatile("s_waitcnt lgkmcnt(0)" ::: "memory");
    float a = p.f_b1[lane];
    for (int i = 0; i < 33; ++i) a += sc[i] * p.f_w1[i * 64 + lane];
    const float fr = p.freq[lane];
    const float h1 = sinf(fr * a);
    sc[64 + lane] = h1;
    asm volatile("s_waitcnt lgkmcnt(0)" ::: "memory");
    float a2 = p.f_b2[lane];
    for (int i = 0; i < 64; ++i) a2 += sc[64 + i] * p.f_w2[i * 64 + lane];
    const float h2 = sinf(fr * a2);
    ((bf16_t*)(p.ws + WS_HID2))[t * 64 + lane] = f2bf(h2);
    asm volatile("s_waitcnt lgkmcnt(0)" ::: "memory");
}

DEV void phase_prep(char* lds, const Params& p) {
    const int tid = threadIdx.x, wid = tid >> 6, lane = tid & 63;
    { const int gt = blockIdx.x * 512 + tid;
        if (gt < 2048) ((float*)(p.ws + WS_SSUM))[gt] = 0.f;
        float* rp = (float*)(p.ws + WS_ROPE);
        if (gt < 1024) { const int pos = gt >> 4, i = gt & 15; const float inv = exp2f(-(float)i * (13.287712379549449f / 16.0f)); const float ang = (float)pos * inv; rp[gt] = cosf(ang); rp[1024 + gt] = sinf(ang); }
        if (gt < 512) { const int pos = gt >> 3, i = gt & 7; const float inv = exp2f(-(float)i * (13.287712379549449f / 8.0f)); const float ang = (float)pos * inv; rp[2048 + gt] = cosf(ang); rp[2560 + gt] = sinf(ang); } }
    for (int it = blockIdx.x; it < 192; it += gridDim.x) mod_item(lds, p, it);
    for (int t = blockIdx.x * 8 + wid; t < 4096; t += gridDim.x * 8) hid2_row(lds, p, t, wid, lane);
    __syncthreads();
    constexpr int I_WIN = 16 * 36, I_UQ = 4 * 12, I_UKV = 2 * 16, I_WO = 256, I_HIN = 16 * 64, I_HO = 256, I_W3 = 64;
    constexpr int NIT = I_WIN + I_UQ + I_UKV + I_WO + I_HIN + I_HO + I_W3;
    for (int it = blockIdx.x; it < NIT; it += gridDim.x) {
        int r = it;
        if (r < I_WIN) { transpose_item(lds, p.w_in, 1024, AIN, AINP, (bf16_t*)(p.ws + WS_WIN), r); continue; } r -= I_WIN;
        if (r < I_UQ) { transpose_item(lds, p.w_uq, 256, 768, 768, (bf16_t*)(p.ws + WS_WUQ), r); continue; } r -= I_UQ;
        if (r < I_UKV) { transpose_item(lds, p.w_ukv, 128, 1024, 1024, (bf16_t*)(p.ws + WS_WUKV), r); continue; } r -= I_UKV;
        if (r < I_WO) { transpose_item(lds, p.w_out, 1024, 1024, 1024, (bf16_t*)(p.ws + WS_WOUT), r); continue; } r -= I_WO;
        if (r < I_HIN) { transpose_item(lds, p.hy_w_in, 1024, 4096, 4096, (bf16_t*)(p.ws + WS_HWIN), r); continue; } r -= I_HIN;
        if (r < I_HO) { transpose_item(lds, p.hy_w_out, 1024, 1024, 1024, (bf16_t*)(p.ws + WS_HWOUT), r); continue; } r -= I_HO;
        transpose_item(lds, p.f_w3, 64, 4096, 4096, (bf16_t*)(p.ws + WS_W3), r);
    }
}

DEV void modnorm_row(const float* xr, const float* nw, const float* shift, const float* scale, bf16_t* orow, int lane) {
    f32x4 v[4]; float s = 0.f;
#pragma unroll
    for (int j = 0; j < 4; ++j) { v[j] = *(const f32x4*)(xr + lane * 4 + 256 * j); s += v[j].x * v[j].x + v[j].y * v[j].y + v[j].z * v[j].z + v[j].w * v[j].w; }
    const float r = rsqrtf(wave_sum(s) * (1.0f / DM) + EPS);
#pragma unroll
    for (int j = 0; j < 4; ++j) { const int c0 = lane * 4 + 256 * j;
        const f32x4 w = *(const f32x4*)(nw + c0), sh = *(const f32x4*)(shift + c0), sc = *(const f32x4*)(scale + c0);
        const float o0 = v[j].x * r * w.x * (1.f + sc.x) + sh.x, o1 = v[j].y * r * w.y * (1.f + sc.y) + sh.y, o2 = v[j].z * r * w.z * (1.f + sc.z) + sh.z, o3 = v[j].w * r * w.w * (1.f + sc.w) + sh.w;
        u32x2 pk; pk.x = pk2(o0, o1); pk.y = pk2(o2, o3); *(u32x2*)(orow + c0) = pk; }
}

DEV void phase_norm0(const Params& p) {
    const int wid = threadIdx.x >> 6, lane = threadIdx.x & 63; const float* mod0 = (const float*)(p.ws + WS_MOD0); bf16_t* H0 = (bf16_t*)(p.ws + WS_H0);
    for (int row = blockIdx.x * 8 + wid; row < NALL; row += gridDim.x * 8) {
        const float* xr; int v;
        if (row < NTOK) { xr = p.x + (size_t)row * DM; v = row >> 12; } else { xr = p.ctx + (size_t)(row - NTOK) * DM; v = 8; }
        modnorm_row(xr, p.norm_w, mod0 + v * 3072, mod0 + v * 3072 + 1024, H0 + (size_t)row * DM, lane);
    }
}
DEV void phase_norm1(const Params& p) {
    const int wid = threadIdx.x >> 6, lane = threadIdx.x & 63; const float* mod1 = (const float*)(p.ws + WS_MOD1); bf16_t* H1 = (bf16_t*)(p.ws + WS_H1);
    for (int row = blockIdx.x * 8 + wid; row < NTOK; row += gridDim.x * 8) { const int v = row >> 12;
        modnorm_row(p.out + (size_t)row * DM, p.norm_w + DM, mod1 + v * 3072, mod1 + v * 3072 + 1024, H1 + (size_t)row * DM, lane); }
}
DEV void phase_final(const Params& p) {
    const int wid = threadIdx.x >> 6, lane = threadIdx.x & 63;
    for (int row = blockIdx.x * 8 + wid; row < NTOK; row += gridDim.x * 8) {
        float* xr = p.out + (size_t)row * DM; f32x4 v[4]; float s = 0.f;
#pragma unroll
        for (int j = 0; j < 4; ++j) { v[j] = *(const f32x4*)(xr + lane * 4 + 256 * j); s += v[j].x * v[j].x + v[j].y * v[j].y + v[j].z * v[j].z + v[j].w * v[j].w; }
        const float r = rsqrtf(wave_sum(s) * (1.0f / DM) + EPS);
#pragma unroll
        for (int j = 0; j < 4; ++j) { const int c0 = lane * 4 + 256 * j; const f32x4 w = *(const f32x4*)(p.final_w + c0);
            f32x4 o; o.x = v[j].x * r * w.x; o.y = v[j].y * r * w.y; o.z = v[j].z * r * w.z; o.w = v[j].w * r * w.w; *(f32x4*)(xr + c0) = o; }
    }
}

struct PostIn { u32x4 raw[5]; f32x4 c64[2], s64[2], c32[2], s32[2]; };
DEV void post_load(PostIn& I, const bf16_t* PRAW, const float* rp, int tok, int lane) {
    const bf16_t* pr = PRAW + (size_t)tok * AINP;
#pragma unroll
    for (int sgm = 0; sgm < 4; ++sgm) I.raw[sgm] = *(const u32x4*)(pr + 512 * sgm + lane * 8);
    I.raw[4] = *(const u32x4*)(pr + 2048 + (lane & 31) * 8);
    const int l = tok & 4095, prow = l >> 6, pcol = l & 63;
    const int k = lane & 7, posv = (k < 4) ? prow : pcol; const float* t64 = rp + posv * 16 + (k & 1) * 8;
    I.c64[0] = *(const f32x4*)t64; I.c64[1] = *(const f32x4*)(t64 + 4); I.s64[0] = *(const f32x4*)(t64 + 1024); I.s64[1] = *(const f32x4*)(t64 + 1028);
    const int k3 = lane & 3, posm = (k3 < 2) ? prow : pcol; const float* t32 = rp + 2048 + posm * 8;
    I.c32[0] = *(const f32x4*)t32; I.c32[1] = *(const f32x4*)(t32 + 4); I.s32[0] = *(const f32x4*)(t32 + 512); I.s32[1] = *(const f32x4*)(t32 + 516);
}
DEV void phase_post(const Params& p) {
    const int wid = threadIdx.x >> 6, lane = threadIdx.x & 63;
    const bf16_t* PRAW = (const bf16_t*)(p.ws + WS_PRAW);
    bf16_t* QA = (bf16_t*)(p.ws + WS_QA); bf16_t* KA = (bf16_t*)(p.ws + WS_KA); bf16_t* VA = (bf16_t*)(p.ws + WS_VA);
    bf16_t* CQN = (bf16_t*)(p.ws + WS_CQN); bf16_t* CKVN = (bf16_t*)(p.ws + WS_CKVN); bf16_t* G = (bf16_t*)(p.ws + WS_G); bf16_t* KM = (bf16_t*)(p.ws + WS2_KM);
    const float* rp = (const float*)(p.ws + WS_ROPE);
    float wq[8], wk[8], wcq[8], wckv[8];
    { const int k = lane & 7;
#pragma unroll
        for (int j = 0; j < 8; ++j) { wq[j] = p.q_norm[k * 8 + j]; wk[j] = p.k_norm[k * 8 + j]; wcq[j] = p.cq_norm[(lane & 31) * 8 + j]; wckv[j] = p.ckv_norm[(lane & 15) * 8 + j]; } }
    const int stride = gridDim.x * 8;
    int tok = blockIdx.x * 8 + wid;
    PostIn cur, nxt;
    if (tok < NALL) post_load(cur, PRAW, rp, tok, lane);
    for (; tok < NALL; tok += stride) {
        { const int tn = tok + stride < NALL ? tok + stride : tok; post_load(nxt, PRAW, rp, tn, lane); }
        const bool lat = tok < NTOK; int b, pos;
        if (lat) { b = tok >> 12; pos = CTXL + (tok & 4095); } else { const int j = tok - NTOK; b = j >> 8; pos = j & 255; }
        const size_t kvrow = (size_t)b * LK + pos;
        const float cs64[8] = {cur.c64[0].x, cur.c64[0].y, cur.c64[0].z, cur.c64[0].w, cur.c64[1].x, cur.c64[1].y, cur.c64[1].z, cur.c64[1].w};
        const float sn64[8] = {cur.s64[0].x, cur.s64[0].y, cur.s64[0].z, cur.s64[0].w, cur.s64[1].x, cur.s64[1].y, cur.s64[1].z, cur.s64[1].w};
        float v[8], o[8];
        if (lat) {
            unpack8(cur.raw[0], v);
            float ss = 0.f;
#pragma unroll
            for (int j = 0; j < 8; ++j) ss += v[j] * v[j];
            ss += __shfl_xor(ss, 1); ss += __shfl_xor(ss, 2); ss += __shfl_xor(ss, 4);
            const float r = rsqrtf(ss * (1.0f / 64.0f) + EPS); const int k = lane & 7;
#pragma unroll
            for (int j = 0; j < 8; ++j) v[j] = v[j] * r * wq[j];
#pragma unroll
            for (int j = 0; j < 8; ++j) { const float ot = __shfl_xor(v[j], 2);
                o[j] = ((k & 2) ? (v[j] * cs64[j] + ot * sn64[j]) : (v[j] * cs64[j] - ot * sn64[j])) * QSC_A; }
            *(u32x4*)(QA + (size_t)tok * 512 + lane * 8) = pack8(o);
        }
        {
            const u32x4 raw = cur.raw[1]; unpack8(raw, v);
            float ss = 0.f;
#pragma unroll
            for (int j = 0; j < 8; ++j) ss += v[j] * v[j];
            ss += __shfl_xor(ss, 1); ss += __shfl_xor(ss, 2); ss += __shfl_xor(ss, 4);
            const float s8 = ss;
            ss += __shfl_xor(ss, 8); ss += __shfl_xor(ss, 16);
            const float s32 = ss;
            float vn[8]; const int k = lane & 7;
            { const float r = rsqrtf(s8 * (1.0f / 64.0f) + EPS);
#pragma unroll
                for (int j = 0; j < 8; ++j) vn[j] = v[j] * r * wk[j]; }
#pragma unroll
            for (int j = 0; j < 8; ++j) { const float ot = __shfl_xor(vn[j], 2);
                o[j] = lat ? ((k & 2) ? (vn[j] * cs64[j] + ot * sn64[j]) : (vn[j] * cs64[j] - ot * sn64[j])) : vn[j]; }
            if (lane < 16) *(u32x4*)(KA + kvrow * 128 + lane * 8) = pack8(o);
            else if (lane < 32) *(u32x4*)(VA + kvrow * 128 + (lane - 16) * 8) = raw;
            else if (lat) { const float r = rsqrtf(s32 * (1.0f / 256.0f) + EPS); const int cb = (lane - 32) * 8;
#pragma unroll
                for (int j = 0; j < 8; ++j) o[j] = v[j] * r * wcq[j];
                *(u32x4*)(CQN + (size_t)tok * 256 + cb) = pack8(o); }
        }
        {
            unpack8(cur.raw[2], v);
            float ss = 0.f;
#pragma unroll
            for (int j = 0; j < 8; ++j) ss += v[j] * v[j];
            ss += __shfl_xor(ss, 1); ss += __shfl_xor(ss, 2); ss += __shfl_xor(ss, 4); ss += __shfl_xor(ss, 8);
            const int k = lane & 3;
            float oth[8];
#pragma unroll
            for (int j = 0; j < 8; ++j) oth[j] = __shfl_xor(v[j], 1);
            if (lane < 16) { const float r = rsqrtf(ss * (1.0f / 128.0f) + EPS);
#pragma unroll
                for (int j = 0; j < 8; ++j) o[j] = v[j] * r * wckv[j];
                *(u32x4*)(CKVN + kvrow * 128 + lane * 8) = pack8(o); }
            else if (lane < 20) {
                const float cs32[8] = {cur.c32[0].x, cur.c32[0].y, cur.c32[0].z, cur.c32[0].w, cur.c32[1].x, cur.c32[1].y, cur.c32[1].z, cur.c32[1].w};
                const float sn32[8] = {cur.s32[0].x, cur.s32[0].y, cur.s32[0].z, cur.s32[0].w, cur.s32[1].x, cur.s32[1].y, cur.s32[1].z, cur.s32[1].w};
#pragma unroll
                for (int j = 0; j < 8; ++j) o[j] = lat ? ((k & 1) ? (v[j] * cs32[j] + oth[j] * sn32[j]) : (v[j] * cs32[j] - oth[j] * sn32[j])) : v[j];
                const u32x4 w = pack8(o);
#pragma unroll
                for (int h = 0; h < 8; ++h) *(u32x4*)(KM + kvrow * 768 + h * 96 + 64 + k * 8) = w; }
            else if (lat) {
#pragma unroll
                for (int j = 0; j < 8; ++j) o[j] = silu(v[j]);
                *(u32x4*)(G + (size_t)tok * 1024 + (lane - 20) * 8) = pack8(o); }
        }
        if (lat) {
            unpack8(cur.raw[3], v);
#pragma unroll
            for (int j = 0; j < 8; ++j) o[j] = silu(v[j]);
            *(u32x4*)(G + (size_t)tok * 1024 + 352 + lane * 8) = pack8(o);
            if (lane < 20) { unpack8(cur.raw[4], v);
#pragma unroll
                for (int j = 0; j < 8; ++j) o[j] = silu(v[j]);
                *(u32x4*)(G + (size_t)tok * 1024 + 864 + lane * 8) = pack8(o); }
        }
        cur = nxt;
    }
}

template <int DQK>
DEV void attn_unit(char* lds, const bf16_t* __restrict__ Q, int ldq, int qcol, const bf16_t* __restrict__ Kp, int ldk, int kcol, const bf16_t* __restrict__ Vp, int ldv, int vcol,
                   const bf16_t* __restrict__ Gt, bf16_t* OG, int ocol, int b, int q0) {
    constexpr int KRS = (DQK + 8) * 2, KB = 64 * KRS, VRS = 192, VB = 64 * VRS, STG = KB + VB, NKS = DQK / 16, KCH = DQK / 8;
    const int tid = threadIdx.x, lane = tid & 63, wid = tid >> 6, l31 = lane & 31, hi = lane >> 5;
    bf16x8 qf[NKS];
    { const bf16_t* qp = Q + (size_t)(b * SEQ + q0 + wid * 32 + l31) * ldq + qcol + hi * 8;
#pragma unroll
        for (int ks = 0; ks < NKS; ++ks) qf[ks] = *(const bf16x8*)(qp + ks * 16); }
    const bf16_t* kbase = Kp + (size_t)b * LK * ldk + kcol; const bf16_t* vbase = Vp + (size_t)b * LK * ldv + vcol;
    const int kr0 = tid / KCH, kc0 = tid % KCH;
    const int kr1 = (tid + 512) / KCH, kc1 = (tid + 512) % KCH;
    const bool k2 = (KCH * 64 > 512) && (tid + 512 < KCH * 64);
    const int vr = tid >> 3, vc = tid & 7;
    u32x4 sk0, sk1, sv;
#define A_LOAD(t) do { const size_t kp_ = (size_t)(t) * 64; sk0 = *(const u32x4*)(kbase + (kp_ + kr0) * ldk + kc0 * 8); \
        if (k2) sk1 = *(const u32x4*)(kbase + (kp_ + kr1) * ldk + kc1 * 8); sv = *(const u32x4*)(vbase + (kp_ + vr) * ldv + vc * 8); } while (0)
#define A_STORE(buf) do { char* b_ = lds + (buf) * STG; *(u32x4*)(b_ + kr0 * KRS + kc0 * 16) = sk0; if (k2) *(u32x4*)(b_ + kr1 * KRS + kc1 * 16) = sk1; \
        *(u32x4*)(b_ + KB + vr * VRS + vc * 16) = sv; } while (0)
    f32x16 o0, o1;
#pragma unroll
    for (int r = 0; r < 16; ++r) { o0[r] = 0.f; o1[r] = 0.f; }
    float m_run = -1e30f, l_run = 0.f;
    const int g1 = (lane >> 4) & 1, tq = (lane & 15) >> 2, tp = lane & 3;
    const int vt_off = KB + (4 * hi + tq) * VRS + (16 * g1 + 4 * tp) * 2;
    const int kf_off = l31 * KRS + hi * 16;
    constexpr int NT = LK / 64;
    A_LOAD(0); A_STORE(0);
    __syncthreads();
    for (int t = 0; t < NT; ++t) {
        const bool more = (t + 1 < NT);
        if (more) A_LOAD(t + 1);
        const char* b_ = lds + (t & 1) * STG;
        f32x16 p0, p1;
#pragma unroll
        for (int r = 0; r < 16; ++r) { p0[r] = 0.f; p1[r] = 0.f; }
#pragma unroll
        for (int ks = 0; ks < NKS; ++ks) {
            const bf16x8 ka = *(const bf16x8*)(b_ + kf_off + ks * 32);
            const bf16x8 kb = *(const bf16x8*)(b_ + kf_off + 32 * KRS + ks * 32);
            p0 = __builtin_amdgcn_mfma_f32_32x32x16_bf16(ka, qf[ks], p0, 0, 0, 0);
            p1 = __builtin_amdgcn_mfma_f32_32x32x16_bf16(kb, qf[ks], p1, 0, 0, 0);
        }
        float mx = p0[0];
#pragma unroll
        for (int r = 1; r < 16; ++r) mx = fmaxf(mx, p0[r]);
#pragma unroll
        for (int r = 0; r < 16; ++r) mx = fmaxf(mx, p1[r]);
        mx = fmaxf(mx, __shfl_xor(mx, 32));
        const float m_new = fmaxf(m_run, mx);
        const float alpha = __builtin_amdgcn_exp2f(m_run - m_new);
        m_run = m_new;
        float ls = 0.f;
#pragma unroll
        for (int r = 0; r < 16; ++r) { p0[r] = __builtin_amdgcn_exp2f(p0[r] - m_new); p1[r] = __builtin_amdgcn_exp2f(p1[r] - m_new); ls += p0[r] + p1[r]; }
        l_run = l_run * alpha + ls;
#pragma unroll
        for (int r = 0; r < 16; ++r) { o0[r] *= alpha; o1[r] *= alpha; }
        u32x4 pw[4];
        pw[0] = (u32x4){pk2(p0[0], p0[1]), pk2(p0[2], p0[3]), pk2(p0[4], p0[5]), pk2(p0[6], p0[7])};
        pw[1] = (u32x4){pk2(p0[8], p0[9]), pk2(p0[10], p0[11]), pk2(p0[12], p0[13]), pk2(p0[14], p0[15])};
        pw[2] = (u32x4){pk2(p1[0], p1[1]), pk2(p1[2], p1[3]), pk2(p1[4], p1[5]), pk2(p1[6], p1[7])};
        pw[3] = (u32x4){pk2(p1[8], p1[9]), pk2(p1[10], p1[11]), pk2(p1[12], p1[13]), pk2(p1[14], p1[15])};
#pragma unroll
        for (int s = 0; s < 4; ++s) {
            const bf16x8 pb = __builtin_bit_cast(bf16x8, pw[s]);
#pragma unroll
            for (int dt = 0; dt < 2; ++dt) {
                const char* vp = b_ + vt_off + s * 16 * VRS + dt * 64;
                const s16x4 lo = __builtin_bit_cast(s16x4, __builtin_amdgcn_ds_read_tr16_b64_v4i16((LAS s16x4*)vp));
                const s16x4 hh = __builtin_bit_cast(s16x4, __builtin_amdgcn_ds_read_tr16_b64_v4i16((LAS s16x4*)(vp + 8 * VRS)));
                const bf16x8 vf = (bf16x8){lo[0], lo[1], lo[2], lo[3], hh[0], hh[1], hh[2], hh[3]};
                if (dt == 0) o0 = __builtin_amdgcn_mfma_f32_32x32x16_bf16(vf, pb, o0, 0, 0, 0);
                else o1 = __builtin_amdgcn_mfma_f32_32x32x16_bf16(vf, pb, o1, 0, 0, 0);
            }
        }
        if (more) A_STORE((t + 1) & 1);
        __syncthreads();
    }
#undef A_LOAD
#undef A_STORE
    const float lt = l_run + __shfl_xor(l_run, 32); const float inv = 1.0f / lt;
    const size_t tok = (size_t)(b * SEQ + q0 + wid * 32 + l31);
#pragma unroll
    for (int dt = 0; dt < 2; ++dt)
#pragma unroll
        for (int g = 0; g < 4; ++g) { const int d = 32 * dt + 8 * g + 4 * hi; const size_t off = tok * 1024 + ocol + d;
            const u32x2 gw = *(const u32x2*)(Gt + off);
            const f32x16& oo = dt ? o1 : o0;
            u32x2 w; w.x = pk2(oo[4 * g] * inv * lo_bf(gw.x), oo[4 * g + 1] * inv * hi_bf(gw.x)); w.y = pk2(oo[4 * g + 2] * inv * lo_bf(gw.y), oo[4 * g + 3] * inv * hi_bf(gw.y));
            *(u32x2*)(OG + off) = w; }
}

DEV float swapmax32(float v) { auto rr = __builtin_amdgcn_permlane32_swap(__float_as_uint(v), __float_as_uint(v), false, false); return fmaxf(__uint_as_float(rr[0]), __uint_as_float(rr[1])); }
DEV float swapsum32(float v) { auto rr = __builtin_amdgcn_permlane32_swap(__float_as_uint(v), __float_as_uint(v), false, false); return __uint_as_float(rr[0]) + __uint_as_float(rr[1]); }
template <int DQK>
DEV void attn_unit2(char* lds, const bf16_t* __restrict__ Q, int ldq, int qcol, const bf16_t* __restrict__ Kp, int ldk, int kcol, const bf16_t* __restrict__ Vp, int ldv, int vcol,
                    const bf16_t* __restrict__ Gt, bf16_t* OG, int ocol, int b, int q0) {
    constexpr int KRS = (DQK + 8) * 2, KB = 64 * KRS, VRS = 192, VB = 64 * VRS, NKS = DQK / 16, KCH = DQK / 8, VOFF = 2 * KB;
    constexpr float THR = 8.0f;
    constexpr int NT = LK / 64;
    const int tid = threadIdx.x, lane = tid & 63, wid = tid >> 6, l31 = lane & 31, hi = lane >> 5;
    bf16x8 qf[NKS];
    { const bf16_t* qp = Q + (size_t)(b * SEQ + q0 + wid * 32 + l31) * ldq + qcol + hi * 8;
#pragma unroll
        for (int ks = 0; ks < NKS; ++ks) qf[ks] = *(const bf16x8*)(qp + ks * 16); }
    const bf16_t* kbase = Kp + (size_t)b * LK * ldk + kcol; const bf16_t* vbase = Vp + (size_t)b * LK * ldv + vcol;
    constexpr bool K2 = (KCH * 64 > 512);
    const bool k2 = K2 && (tid + 512 < KCH * 64);
    const int kr0 = tid / KCH, kc0 = tid % KCH, kr1 = k2 ? (tid + 512) / KCH : kr0, kc1 = k2 ? (tid + 512) % KCH : kc0;
    const int vr = tid >> 3, vc = tid & 7;
    u32x4 skX0, skX1 = {0u, 0u, 0u, 0u}, svX, skY0, skY1 = {0u, 0u, 0u, 0u}, svY;
#define A_LOADK(t, S) do { const int tt_ = (t) < NT ? (t) : NT - 1; const size_t kp_ = (size_t)tt_ * 64; sk##S##0 = *(const u32x4*)(kbase + (kp_ + kr0) * ldk + kc0 * 8); if (K2) sk##S##1 = *(const u32x4*)(kbase + (kp_ + kr1) * ldk + kc1 * 8); } while (0)
#define A_LOADV(t, S) do { const int tt_ = (t) < NT ? (t) : NT - 1; sv##S = *(const u32x4*)(vbase + ((size_t)tt_ * 64 + vr) * ldv + vc * 8); } while (0)
#define A_STOREK(slot, S) do { char* b_ = lds + (slot) * KB; *(u32x4*)(b_ + kr0 * KRS + kc0 * 16) = sk##S##0; if (K2) *(u32x4*)(b_ + kr1 * KRS + kc1 * 16) = sk##S##1; } while (0)
#define A_STOREV(slot, S) do { *(u32x4*)(lds + VOFF + (slot) * VB + vr * VRS + vc * 16) = sv##S; } while (0)
    f32x16 o0, o1, negm;
#pragma unroll
    for (int r = 0; r < 16; ++r) { o0[r] = 0.f; o1[r] = 0.f; negm[r] = 0.f; }
    asm volatile("" : "+v"(negm));
    float mhat = 0.f, l_run = 0.f;
    const int g1 = (lane >> 4) & 1, tq = (lane & 15) >> 2, tp = lane & 3;
    const int vt_off = VOFF + (4 * hi + tq) * VRS + (16 * g1 + 4 * tp) * 2;
    const int kf_off = l31 * KRS + hi * 16;
#define A_QK(P0, P1, slot) do { const char* kb_ = lds + (slot) * KB + kf_off; \
        _Pragma("unroll") for (int ks = 0; ks < NKS; ++ks) { \
            const bf16x8 ka = *(const bf16x8*)(kb_ + ks * 32); const bf16x8 kb2 = *(const bf16x8*)(kb_ + 32 * KRS + ks * 32); \
            if (ks == 0) { P0 = __builtin_amdgcn_mfma_f32_32x32x16_bf16(ka, qf[0], negm, 0, 0, 0); P1 = __builtin_amdgcn_mfma_f32_32x32x16_bf16(kb2, qf[0], negm, 0, 0, 0); } \
            else { P0 = __builtin_amdgcn_mfma_f32_32x32x16_bf16(ka, qf[ks], P0, 0, 0, 0); P1 = __builtin_amdgcn_mfma_f32_32x32x16_bf16(kb2, qf[ks], P1, 0, 0, 0); } } } while (0)
    A_LOADK(0, X); A_LOADV(0, X); A_LOADK(1, Y); A_LOADV(1, Y); A_STOREK(0, X); A_STOREV(0, X); A_STOREK(1, Y);
    A_LOADK(2, Y);
    __syncthreads();
    f32x16 pA0, pA1, pB0, pB1;
#pragma unroll
    for (int r = 0; r < 16; ++r) { pB0[r] = 0.f; pB1[r] = 0.f; }
    A_QK(pA0, pA1, 0);
#define A_STEP(P0, P1, N0, N1, t, SL, SS) do { \
        A_LOADK((t) + 3, SL); A_LOADV((t) + 2, SL); \
        A_QK(N0, N1, ((t) + 1) & 1); \
        float a_ = fmaxf(fmaxf(P0[0], P0[1]), P1[0]), c_ = fmaxf(fmaxf(P0[2], P0[3]), P1[1]); a_ = fmaxf(fmaxf(a_, P1[2]), P1[3]); \
        _Pragma("unroll") for (int r = 4; r < 16; r += 4) { a_ = fmaxf(fmaxf(a_, P0[r]), P0[r + 1]); c_ = fmaxf(fmaxf(c_, P0[r + 2]), P0[r + 3]); a_ = fmaxf(fmaxf(a_, P1[r]), P1[r + 1]); c_ = fmaxf(fmaxf(c_, P1[r + 2]), P1[r + 3]); } \
        const float rm = swapmax32(fmaxf(a_, c_)); \
        if ((t) == 0 || __any(rm > THR)) { \
            const float dl = ((t) == 0) ? rm : fmaxf(rm, 0.f); mhat += dl; \
            _Pragma("unroll") for (int r = 0; r < 16; ++r) { P0[r] -= dl; P1[r] -= dl; N0[r] -= dl; N1[r] -= dl; } \
            if ((t) != 0) { const float f = __builtin_amdgcn_exp2f(-dl); l_run *= f; _Pragma("unroll") for (int r = 0; r < 16; ++r) { o0[r] *= f; o1[r] *= f; } } \
            _Pragma("unroll") for (int r = 0; r < 16; ++r) negm[r] = -mhat; asm volatile("" : "+v"(negm)); } \
        float ls = 0.f; \
        _Pragma("unroll") for (int r = 0; r < 16; ++r) { P0[r] = __builtin_amdgcn_exp2f(P0[r]); P1[r] = __builtin_amdgcn_exp2f(P1[r]); ls += P0[r] + P1[r]; } \
        l_run += ls; \
        u32x4 pw[4]; \
        pw[0] = (u32x4){pk2(P0[0], P0[1]), pk2(P0[2], P0[3]), pk2(P0[4], P0[5]), pk2(P0[6], P0[7])}; \
        pw[1] = (u32x4){pk2(P0[8], P0[9]), pk2(P0[10], P0[11]), pk2(P0[12], P0[13]), pk2(P0[14], P0[15])}; \
        pw[2] = (u32x4){pk2(P1[0], P1[1]), pk2(P1[2], P1[3]), pk2(P1[4], P1[5]), pk2(P1[6], P1[7])}; \
        pw[3] = (u32x4){pk2(P1[8], P1[9]), pk2(P1[10], P1[11]), pk2(P1[12], P1[13]), pk2(P1[14], P1[15])}; \
        { const char* vb_ = lds + ((t) & 1) * VB + vt_off; \
        _Pragma("unroll") for (int s = 0; s < 4; ++s) { const bf16x8 pb = __builtin_bit_cast(bf16x8, pw[s]); \
            _Pragma("unroll") for (int dt = 0; dt < 2; ++dt) { const char* vp = vb_ + s * 16 * VRS + dt * 64; \
                const s16x4 lo = __builtin_bit_cast(s16x4, __builtin_amdgcn_ds_read_tr16_b64_v4i16((LAS s16x4*)vp)); \
                const s16x4 hh = __builtin_bit_cast(s16x4, __builtin_amdgcn_ds_read_tr16_b64_v4i16((LAS s16x4*)(vp + 8 * VRS))); \
                const bf16x8 vf = (bf16x8){lo[0], lo[1], lo[2], lo[3], hh[0], hh[1], hh[2], hh[3]}; \
                if (dt == 0) o0 = __builtin_amdgcn_mfma_f32_32x32x16_bf16(vf, pb, o0, 0, 0, 0); else o1 = __builtin_amdgcn_mfma_f32_32x32x16_bf16(vf, pb, o1, 0, 0, 0); } } } \
        A_STOREK((t) & 1, SS); A_STOREV(((t) + 1) & 1, SS); \
        __syncthreads(); } while (0)
    for (int t = 0; t < NT; t += 2) {
        A_STEP(pA0, pA1, pB0, pB1, t, X, Y);
        A_STEP(pB0, pB1, pA0, pA1, t + 1, Y, X);
    }
#undef A_STEP
#undef A_QK
#undef A_LOADK
#undef A_LOADV
#undef A_STOREK
#undef A_STOREV
    const float inv = 1.0f / swapsum32(l_run);
    const size_t tok = (size_t)(b * SEQ + q0 + wid * 32 + l31);
#pragma unroll
    for (int dt = 0; dt < 2; ++dt)
#pragma unroll
        for (int g = 0; g < 4; ++g) { const int d = 32 * dt + 8 * g + 4 * hi; const size_t off = tok * 1024 + ocol + d;
            const u32x2 gw = *(const u32x2*)(Gt + off);
            const f32x16& oo = dt ? o1 : o0;
            u32x2 w; w.x = pk2(oo[4 * g] * inv * lo_bf(gw.x), oo[4 * g + 1] * inv * hi_bf(gw.x)); w.y = pk2(oo[4 * g + 2] * inv * lo_bf(gw.y), oo[4 * g + 3] * inv * hi_bf(gw.y));
            *(u32x2*)(OG + off) = w; }
}

DEV void phase_attn(char* lds, const Params& p) {
    const bf16_t* QA = (const bf16_t*)(p.ws + WS_QA); const bf16_t* KA = (const bf16_t*)(p.ws + WS_KA); const bf16_t* VA = (const bf16_t*)(p.ws + WS_VA);
    const bf16_t* QM = (const bf16_t*)(p.ws + WS_QM); const bf16_t* KM = (const bf16_t*)(p.ws + WS2_KM); const bf16_t* VM = (const bf16_t*)(p.ws + WS2_VM);
    const bf16_t* G = (const bf16_t*)(p.ws + WS_G); bf16_t* OG = (bf16_t*)(p.ws + WS2_OG);
    for (int u = blockIdx.x; u < 2048; u += gridDim.x) {
        const int type = u >> 10, rem = u & 1023, b = rem >> 7, h = (rem >> 4) & 7, qb = rem & 15;
        if (type == 0) attn_unit2<64>(lds, QA, 512, h * 64, KA, 128, (h >> 2) * 64, VA, 128, (h >> 2) * 64, G, OG, h * 64, b, qb * 256);
        else attn_unit2<96>(lds, QM, 768, h * 96, KM, 768, h * 96, VM, 512, h * 64, G, OG, 512 + h * 64, b, qb * 256);
    }
}

constexpr int CV_PADL = 192, CV_ROW = 4488, CV_RS = CV_ROW * 2;
constexpr int CV_UB = 8 * CV_RS;
constexpr int CV_FS = 16416;
DEV void conv_load_filter(char* lds, const bf16_t* gr) {
    const int tid = threadIdx.x;
#pragma unroll
    for (int rnd = 0; rnd < 2; ++rnd) {
        const int ch = tid + rnd * 512;
        const u32x4 a = *(const u32x4*)(gr + ch * 8);
        u32x4 bq = {0u, 0u, 0u, 0u}; if (ch + 1 < 1024) bq = *(const u32x4*)(gr + ch * 8 + 8);
        const unsigned w[8] = {a.x, a.y, a.z, a.w, bq.x, bq.y, bq.z, bq.w};
        char* f = lds + CV_UB + ch * 16;
        *(u32x4*)(f) = a;
        u32x4 c1, c2, c3;
        c1.x = __builtin_amdgcn_alignbit(w[1], w[0], 16); c1.y = __builtin_amdgcn_alignbit(w[2], w[1], 16); c1.z = __builtin_amdgcn_alignbit(w[3], w[2], 16); c1.w = __builtin_amdgcn_alignbit(w[4], w[3], 16);
        c2 = (u32x4){w[1], w[2], w[3], w[4]};
        c3.x = __builtin_amdgcn_alignbit(w[2], w[1], 16); c3.y = __builtin_amdgcn_alignbit(w[3], w[2], 16); c3.z = __builtin_amdgcn_alignbit(w[4], w[3], 16); c3.w = __builtin_amdgcn_alignbit(w[5], w[4], 16);
        *(u32x4*)(f + CV_FS) = c1; *(u32x4*)(f + 2 * CV_FS) = c2; *(u32x4*)(f + 3 * CV_FS) = c3;
    }
}
DEV void sconv4(const bf16_t* px, int t, float w0, float w1, float w2, float bias, float* u) {
    const u32x2 mid = *(const u32x2*)(px + t);
    const float pm = (t > 0) ? bf2f(px[t - 1]) : 0.f, pp = (t + 4 < SEQ) ? bf2f(px[t + 4]) : 0.f;
    const float q0 = lo_bf(mid.x), q1 = hi_bf(mid.x), q2 = lo_bf(mid.y), q3 = hi_bf(mid.y);
    u[0] = w0 * pm + w1 * q0 + w2 * q1 + bias; u[1] = w0 * q0 + w1 * q1 + w2 * q2 + bias; u[2] = w0 * q1 + w1 * q2 + w2 * q3 + bias; u[3] = w0 * q2 + w1 * q3 + w2 * pp + bias;
}
template <bool V0, bool V1>
DEV void conv_step(const char* lds, f32x16 (&acc)[2][2], const int (&a_off)[2], const int (&b_off)[2], int d) {
    bf16x8 fa[2][4];
#pragma unroll
    for (int mt = 0; mt < 2; ++mt)
#pragma unroll
        for (int ks = 0; ks < 4; ++ks) { const char* ap = lds + a_off[mt] - 128 * d + ks * 32;
            const u32x2 lo = *(const u32x2*)ap, hh = *(const u32x2*)(ap + 8);
            fa[mt][ks] = __builtin_bit_cast(bf16x8, (u32x4){lo.x, lo.y, hh.x, hh.y}); }
#pragma unroll
    for (int n = 0; n < 2; ++n) {
        if ((n == 0 && V0) || (n == 1 && V1)) {
#pragma unroll
            for (int ks = 0; ks < 4; ++ks) { const bf16x8 fb = *(const bf16x8*)(lds + b_off[n] - 128 * d + ks * 32);
#pragma unroll
                for (int mt = 0; mt < 2; ++mt) acc[n][mt] = __builtin_amdgcn_mfma_f32_32x32x16_bf16(fa[mt][ks], fb, acc[n][mt], 0, 0, 0); }
        }
    }
}
struct ConvFrags { bf16x8 a[6], b0[4], b1[4]; };
DEV void conv_load_frags(ConvFrags& F, const char* lds, int a_off0, int a_off0h, int b_off0, int b_off1, int d) {
#pragma unroll
    for (int j = 0; j < 6; ++j) { const u32x2 lo = *(const u32x2*)(lds + a_off0 - 128 * d + (j - 2) * 32), hh = *(const u32x2*)(lds + a_off0h - 128 * d + (j - 2) * 32);
        F.a[j] = __builtin_bit_cast(bf16x8, (u32x4){lo.x, lo.y, hh.x, hh.y}); }
#pragma unroll
    for (int ks = 0; ks < 4; ++ks) { F.b0[ks] = *(const bf16x8*)(lds + b_off0 - 128 * d + ks * 32); F.b1[ks] = *(const bf16x8*)(lds + b_off1 - 128 * d + ks * 32); }
}
DEV void conv_mfma_frags(const ConvFrags& F, f32x16 (&acc)[2][2]) {
#pragma unroll
    for (int ks = 0; ks < 4; ++ks) {
        acc[0][0] = __builtin_amdgcn_mfma_f32_32x32x16_bf16(F.a[ks + 2], F.b0[ks], acc[0][0], 0, 0, 0);
        acc[0][1] = __builtin_amdgcn_mfma_f32_32x32x16_bf16(F.a[ks], F.b0[ks], acc[0][1], 0, 0, 0);
        acc[1][0] = __builtin_amdgcn_mfma_f32_32x32x16_bf16(F.a[ks + 2], F.b1[ks], acc[1][0], 0, 0, 0);
        acc[1][1] = __builtin_amdgcn_mfma_f32_32x32x16_bf16(F.a[ks], F.b1[ks], acc[1][1], 0, 0, 0);
    }
}
DEV void conv_mfma_loop(const char* lds, f32x16 (&acc)[2][2], int wid, int lane) {
    const int l31 = lane & 31, hi = lane >> 5;
#pragma unroll
    for (int a = 0; a < 2; ++a)
#pragma unroll
        for (int b = 0; b < 2; ++b)
#pragma unroll
            for (int r = 0; r < 16; ++r) acc[a][b][r] = 0.f;
    int a_off[2];
#pragma unroll
    for (int mt = 0; mt < 2; ++mt) { const int r = l31 + 32 * mt, q = (4 - (r & 3)) & 3; a_off[mt] = CV_UB + q * CV_FS + (4096 - r - q + 8 * hi) * 2; }
    int b_off[2];
#pragma unroll
    for (int n = 0; n < 2; ++n) { const int nt = 2 * wid + n; b_off[n] = (l31 & 7) * CV_RS + (CV_PADL + 64 * (4 * nt + (l31 >> 3)) + 8 * hi) * 2; }
    const int dlo = 8 * wid - 63;
#pragma unroll
    for (int j = 0; j < 4; ++j) conv_step<true, false>(lds, acc, a_off, b_off, dlo + j);
    ConvFrags F0, F1; const int d0 = dlo + 4; int a_hi = a_off[0] + 8; asm volatile("" : "+v"(a_hi));
    conv_load_frags(F0, lds, a_off[0], a_hi, b_off[0], b_off[1], d0);
#pragma unroll 1
    for (int j = 0; j < 31; ++j) { const int d = d0 + 2 * j;
        conv_load_frags(F1, lds, a_off[0], a_hi, b_off[0], b_off[1], d + 1); __builtin_amdgcn_sched_barrier(0);
        conv_mfma_frags(F0, acc); __builtin_amdgcn_sched_barrier(0);
        conv_load_frags(F0, lds, a_off[0], a_hi, b_off[0], b_off[1], d + 2); __builtin_amdgcn_sched_barrier(0);
        conv_mfma_frags(F1, acc); __builtin_amdgcn_sched_barrier(0); }
    conv_mfma_frags(F0, acc);
#pragma unroll
    for (int j = 0; j < 4; ++j) conv_step<false, true>(lds, acc, a_off, b_off, dlo + 67 + j);
}
DEV void conv_unit(char* lds, const Params& p, int c) {
    const int tid = threadIdx.x, lane = tid & 63, wid = tid >> 6, l31 = lane & 31, hi = lane >> 5;
    const bf16_t* PT = (const bf16_t*)(p.ws + WS_PT); const bf16_t* GR = (const bf16_t*)(p.ws + WS_GR); const float* ssum = (const float*)(p.ws + WS_SSUM);
    bf16_t* OG2 = (bf16_t*)(p.ws + WS_OG2);
    for (int i = tid; i < 8 * 98; i += 512) { const int b = i / 98, j = i % 98;
        const int e = (j < 48) ? j * 4 : (CV_PADL + SEQ + (j - 48) * 4); *(u32x2*)(lds + b * CV_RS + e * 2) = (u32x2){0u, 0u}; }
    { const float w0 = p.conv_w[c], w1 = p.conv_w[3072 + c], w2 = p.conv_w[6144 + c], bias = p.conv_b[c];
        for (int i = tid; i < 8 * 1024; i += 512) { const int b = i >> 10, t = (i & 1023) * 4; float u[4];
            sconv4(PT + ((size_t)(b * 4096 + c)) * 4096, t, w0, w1, w2, bias, u);
            u32x2 w; w.x = pk2(u[0], u[1]); w.y = pk2(u[2], u[3]); *(u32x2*)(lds + b * CV_RS + (CV_PADL + t) * 2) = w; } }
    conv_load_filter(lds, GR + (size_t)c * 8192);
    __syncthreads();
    f32x16 acc[2][2];
    conv_mfma_loop(lds, acc, wid, lane);
    __syncthreads();
    { const float invs = 1.0f / ssum[c], sk = p.skip[c];
        const float w0 = p.conv_w[1024 + c], w1 = p.conv_w[3072 + 1024 + c], w2 = p.conv_w[6144 + 1024 + c], bias = p.conv_b[1024 + c];
        const int b = l31 & 7;
#pragma unroll
        for (int n = 0; n < 2; ++n) { const int i = 4 * (2 * wid + n) + (l31 >> 3);
#pragma unroll
            for (int mt = 0; mt < 2; ++mt)
#pragma unroll
                for (int g = 0; g < 4; ++g) { const int t = 64 * i + 32 * mt + 8 * g + 4 * hi; float x1[4];
                    sconv4(PT + ((size_t)(b * 4096 + 1024 + c)) * 4096, t, w0, w1, w2, bias, x1);
                    char* up = lds + b * CV_RS + (CV_PADL + t) * 2; const u32x2 vw = *(const u32x2*)up;
                    const float z0 = x1[0] * (acc[n][mt][4 * g] * invs + sk * lo_bf(vw.x)), z1 = x1[1] * (acc[n][mt][4 * g + 1] * invs + sk * hi_bf(vw.x));
                    const float z2 = x1[2] * (acc[n][mt][4 * g + 2] * invs + sk * lo_bf(vw.y)), z3 = x1[3] * (acc[n][mt][4 * g + 3] * invs + sk * hi_bf(vw.y));
                    u32x2 w; w.x = pk2(z0, z1); w.y = pk2(z2, z3); *(u32x2*)up = w; } } }
    conv_load_filter(lds, GR + (size_t)(1024 + c) * 8192);
    __syncthreads();
    conv_mfma_loop(lds, acc, wid, lane);
    { const float invs = 1.0f / ssum[1024 + c], sk = p.skip[1024 + c];
        const float w0 = p.conv_w[2048 + c], w1 = p.conv_w[3072 + 2048 + c], w2 = p.conv_w[6144 + 2048 + c], bias = p.conv_b[2048 + c];
        const int b = l31 & 7;
#pragma unroll
        for (int n = 0; n < 2; ++n) { const int i = 4 * (2 * wid + n) + (l31 >> 3);
#pragma unroll
            for (int mt = 0; mt < 2; ++mt)
#pragma unroll
                for (int g = 0; g < 4; ++g) { const int t = 64 * i + 32 * mt + 8 * g + 4 * hi; float x2[4];
                    sconv4(PT + ((size_t)(b * 4096 + 2048 + c)) * 4096, t, w0, w1, w2, bias, x2);
                    const u32x2 zw = *(const u32x2*)(lds + b * CV_RS + (CV_PADL + t) * 2);
                    const u32x2 gw = *(const u32x2*)(PT + ((size_t)(b * 4096 + 3072 + c)) * 4096 + t);
                    const float y0 = x2[0] * (acc[n][mt][4 * g] * invs + sk * lo_bf(zw.x)) * silu(lo_bf(gw.x)), y1 = x2[1] * (acc[n][mt][4 * g + 1] * invs + sk * hi_bf(zw.x)) * silu(hi_bf(gw.x));
                    const float y2 = x2[2] * (acc[n][mt][4 * g + 2] * invs + sk * lo_bf(zw.y)) * silu(lo_bf(gw.y)), y3 = x2[3] * (acc[n][mt][4 * g + 3] * invs + sk * hi_bf(zw.y)) * silu(hi_bf(gw.y));
                    u32x2 w; w.x = pk2(y0, y1); w.y = pk2(y2, y3); *(u32x2*)(OG2 + ((size_t)(b * 1024 + c)) * 4096 + t) = w; } } }
    __syncthreads();
}

struct Raw3 { u32x2 mid; unsigned halo; };
DEV Raw3 ld_raw3(const bf16_t* px, int t) {
    Raw3 r; r.mid = *(const u32x2*)(px + t);
    const unsigned a = px[t - 1], b = px[t + 4];
    r.halo = (t > 0 ? a : 0u) | ((t + 4 < SEQ ? b : 0u) << 16);
    return r;
}
DEV void sconv_raw(const Raw3& r, float w0, float w1, float w2, float bias, float* u) {
    const float pm = lo_bf(r.halo), pp = hi_bf(r.halo), q0 = lo_bf(r.mid.x), q1 = hi_bf(r.mid.x), q2 = lo_bf(r.mid.y), q3 = hi_bf(r.mid.y);
    u[0] = w0 * pm + w1 * q0 + w2 * q1 + bias; u[1] = w0 * q0 + w1 * q1 + w2 * q2 + bias; u[2] = w0 * q1 + w1 * q2 + w2 * q3 + bias; u[3] = w0 * q2 + w1 * q3 + w2 * pp + bias;
}
struct FiltRegs { u32x4 a[2], b[2]; };
DEV void filt_load(FiltRegs& f, const bf16_t* gr, int tid) {
#pragma unroll
    for (int rnd = 0; rnd < 2; ++rnd) { const int ch = tid + rnd * 512; f.a[rnd] = *(const u32x4*)(gr + ch * 8);
        const int ch1 = ch + 1 < 1024 ? ch + 1 : ch; const u32x4 t = *(const u32x4*)(gr + ch1 * 8); f.b[rnd] = (ch + 1 < 1024) ? t : (u32x4){0u, 0u, 0u, 0u}; }
}
DEV void filt_store(char* lds, const FiltRegs& f, int tid) {
#pragma unroll
    for (int rnd = 0; rnd < 2; ++rnd) { const int ch = tid + rnd * 512; const u32x4 a = f.a[rnd], bq = f.b[rnd];
        const unsigned w[8] = {a.x, a.y, a.z, a.w, bq.x, bq.y, bq.z, bq.w};
        char* fp = lds + CV_UB + ch * 16;
        *(u32x4*)(fp) = a;
        u32x4 c1, c2, c3;
        c1.x = __builtin_amdgcn_alignbit(w[1], w[0], 16); c1.y = __builtin_amdgcn_alignbit(w[2], w[1], 16); c1.z = __builtin_amdgcn_alignbit(w[3], w[2], 16); c1.w = __builtin_amdgcn_alignbit(w[4], w[3], 16);
        c2 = (u32x4){w[1], w[2], w[3], w[4]};
        c3.x = __builtin_amdgcn_alignbit(w[2], w[1], 16); c3.y = __builtin_amdgcn_alignbit(w[3], w[2], 16); c3.z = __builtin_amdgcn_alignbit(w[4], w[3], 16); c3.w = __builtin_amdgcn_alignbit(w[5], w[4], 16);
        *(u32x4*)(fp + CV_FS) = c1; *(u32x4*)(fp + 2 * CV_FS) = c2; *(u32x4*)(fp + 3 * CV_FS) = c3; }
}
#define CV_T(k) (64 * (4 * (2 * wid + ((k) >> 3)) + (l31 >> 3)) + 32 * (((k) >> 2) & 1) + 8 * ((k) & 3) + 4 * hi)
#define CV_LANE_IDS() int tid = threadIdx.x; asm volatile("" : "+v"(tid));   \
    const int lane = tid & 63, wid = __builtin_amdgcn_readfirstlane(tid >> 6), l31 = lane & 31, hi = lane >> 5, eb = l31 & 7; (void)eb; (void)hi; (void)wid
DEV void conv_stage_load(char* lds, const Params& p, int c) {
    CV_LANE_IDS();
    const bf16_t* PT = (const bf16_t*)(p.ws + WS_PT); const bf16_t* GR = (const bf16_t*)(p.ws + WS_GR);
    FiltRegs f0; filt_load(f0, GR + (size_t)c * 8192, tid);
    Raw3 ru[16];
#pragma unroll
    for (int k = 0; k < 16; ++k) { const int i = tid + k * 512, b = i >> 10, t = (i & 1023) * 4; ru[k] = ld_raw3(PT + ((size_t)(b * 4096 + c)) * 4096, t); }
    for (int i = tid; i < 8 * 98; i += 512) { const int b = i / 98, j = i % 98;
        const int e = (j < 48) ? j * 4 : (CV_PADL + SEQ + (j - 48) * 4); *(u32x2*)(lds + b * CV_RS + e * 2) = (u32x2){0u, 0u}; }
    const float w0 = p.conv_w[c], w1 = p.conv_w[3072 + c], w2 = p.conv_w[6144 + c], bias = p.conv_b[c];
#pragma unroll
    for (int k = 0; k < 16; ++k) { const int i = tid + k * 512, b = i >> 10, t = (i & 1023) * 4; float u[4]; sconv_raw(ru[k], w0, w1, w2, bias, u);
        u32x2 w; w.x = pk2(u[0], u[1]); w.y = pk2(u[2], u[3]); *(u32x2*)(lds + b * CV_RS + (CV_PADL + t) * 2) = w; }
    filt_store(lds, f0, tid);
}
DEV void conv_stage_epi0(char* lds, const Params& p, int c, const f32x16 (&acc)[2][2]) {
    CV_LANE_IDS();
    const bf16_t* PT = (const bf16_t*)(p.ws + WS_PT); const bf16_t* GR = (const bf16_t*)(p.ws + WS_GR); const float* ssum = (const float*)(p.ws + WS_SSUM);
    FiltRegs f1; filt_load(f1, GR + (size_t)(1024 + c) * 8192, tid);
    const bf16_t* px1 = PT + ((size_t)(eb * 4096 + 1024 + c)) * 4096;
    Raw3 r1[16];
#pragma unroll
    for (int k = 0; k < 16; ++k) r1[k] = ld_raw3(px1, CV_T(k));
    const float a0 = p.conv_w[1024 + c], a1 = p.conv_w[3072 + 1024 + c], a2 = p.conv_w[6144 + 1024 + c], ab = p.conv_b[1024 + c];
    const float invs = 1.0f / ssum[c], sk = p.skip[c];
#pragma unroll
    for (int k = 0; k < 16; ++k) { const int n = k >> 3, mt = (k >> 2) & 1, g = k & 3; const int t = CV_T(k);
        float x1[4]; sconv_raw(r1[k], a0, a1, a2, ab, x1);
        char* up = lds + eb * CV_RS + (CV_PADL + t) * 2; const u32x2 vw = *(const u32x2*)up;
        const float z0 = x1[0] * (acc[n][mt][4 * g] * invs + sk * lo_bf(vw.x)), z1 = x1[1] * (acc[n][mt][4 * g + 1] * invs + sk * hi_bf(vw.x));
        const float z2 = x1[2] * (acc[n][mt][4 * g + 2] * invs + sk * lo_bf(vw.y)), z3 = x1[3] * (acc[n][mt][4 * g + 3] * invs + sk * hi_bf(vw.y));
        u32x2 w; w.x = pk2(z0, z1); w.y = pk2(z2, z3); *(u32x2*)up = w; }
    filt_store(lds, f1, tid);
}
DEV void conv_stage_epi1(char* lds, const Params& p, int c, const f32x16 (&acc)[2][2]) {
    CV_LANE_IDS();
    const bf16_t* PT = (const bf16_t*)(p.ws + WS_PT); const float* ssum = (const float*)(p.ws + WS_SSUM); bf16_t* OG2 = (bf16_t*)(p.ws + WS_OG2);
    const bf16_t* px2 = PT + ((size_t)(eb * 4096 + 2048 + c)) * 4096; const bf16_t* pg = PT + ((size_t)(eb * 4096 + 3072 + c)) * 4096;
    Raw3 r2[16]; u32x2 rg[16];
#pragma unroll
    for (int k = 0; k < 16; ++k) { r2[k] = ld_raw3(px2, CV_T(k)); rg[k] = *(const u32x2*)(pg + CV_T(k)); }
    const float b0 = p.conv_w[2048 + c], b1 = p.conv_w[3072 + 2048 + c], b2 = p.conv_w[6144 + 2048 + c], bb = p.conv_b[2048 + c];
    const float invs = 1.0f / ssum[1024 + c], sk = p.skip[1024 + c];
#pragma unroll
    for (int k = 0; k < 16; ++k) { const int n = k >> 3, mt = (k >> 2) & 1, g = k & 3; const int t = CV_T(k);
        float x2[4]; sconv_raw(r2[k], b0, b1, b2, bb, x2);
        const u32x2 zw = *(const u32x2*)(lds + eb * CV_RS + (CV_PADL + t) * 2);
        const float y0 = x2[0] * silu(lo_bf(rg[k].x)) * (acc[n][mt][4 * g] * invs + sk * lo_bf(zw.x)), y1 = x2[1] * silu(hi_bf(rg[k].x)) * (acc[n][mt][4 * g + 1] * invs + sk * hi_bf(zw.x));
        const float y2 = x2[2] * silu(lo_bf(rg[k].y)) * (acc[n][mt][4 * g + 2] * invs + sk * lo_bf(zw.y)), y3 = x2[3] * silu(hi_bf(rg[k].y)) * (acc[n][mt][4 * g + 3] * invs + sk * hi_bf(zw.y));
        u32x2 w; w.x = pk2(y0, y1); w.y = pk2(y2, y3); *(u32x2*)(OG2 + ((size_t)(eb * 1024 + c)) * 4096 + t) = w; }
}
DEV void conv_stage_mfma(const char* lds, f32x16 (&acc)[2][2]) { CV_LANE_IDS(); conv_mfma_loop(lds, acc, wid, lane); }
DEV void conv_unit2(char* lds, const Params& p, int c) {
    conv_stage_load(lds, p, c);
    __syncthreads();
    f32x16 acc[2][2];
    conv_stage_mfma(lds, acc);
    __syncthreads();
    conv_stage_epi0(lds, p, c, acc);
    __syncthreads();
    conv_stage_mfma(lds, acc);
    conv_stage_epi1(lds, p, c, acc);
    __syncthreads();
}
#undef CV_T
#undef CV_LANE_IDS

#define XB_TMO      128
#define XB_XCNT(j)  (256  + 64 * (j))
#define XB_XSUB(j)  (1280 + 64 * (j))
#define XB_XGEN(j)  (2304 + 64 * (j))
#define XB_TOP      3328
#define XB_TOPGEN   3392
#define XCD_BAR_WORDS 3456
#define XB_SPIN_CAP (1u << 20)
DEV unsigned xb_ld(unsigned* p) { return __hip_atomic_load(p, __ATOMIC_RELAXED, __HIP_MEMORY_SCOPE_AGENT); }
DEV unsigned xb_add(unsigned* p, unsigned v) { return __hip_atomic_fetch_add(p, v, __ATOMIC_RELAXED, __HIP_MEMORY_SCOPE_AGENT); }
DEV unsigned xb_xcc_id() { return (unsigned)__builtin_amdgcn_s_getreg((3 << 11) | 20) & 0xFu; }
#define XB_SPIN(cond, bar) do { unsigned _sp = 0; while (cond) { __builtin_amdgcn_s_sleep(1); \
    if ((++_sp & 255u) == 0u) { if (xb_ld(&(bar)[XB_TMO])) break; if (_sp > XB_SPIN_CAP) { atomicAdd(&(bar)[XB_TMO], 1u); break; } } } } while (0)
struct XcdBarrier { unsigned* bar; unsigned x; volatile LAS unsigned* st; };
DEV XcdBarrier xcd_barrier_post(unsigned* bar, volatile LAS unsigned* st) {
    XcdBarrier b; b.bar = bar; b.x = xb_xcc_id(); b.st = st;
    if (threadIdx.x == 0) (void)xb_add(&bar[XB_XCNT(b.x)], 1u);
    return b;
}
DEV void xcd_barrier_complete(unsigned* bar, unsigned x, unsigned& nloc, unsigned& nx) {
    const unsigned G = gridDim.x * gridDim.y * gridDim.z;
    unsigned sum, cnt, mine, sp = 0u;
    for (;;) {
        sum = 0u; cnt = 0u; mine = 0u;
#pragma unroll
        for (unsigned j = 0; j < 16; ++j) { const unsigned c = xb_ld(&bar[XB_XCNT(j)]); sum += c; cnt += (c > 0u) ? 1u : 0u; mine = (j == x) ? c : mine; }
        if (sum == G) break;
        __builtin_amdgcn_s_sleep(1);
        if ((++sp & 255u) == 0u) { if (xb_ld(&bar[XB_TMO])) break; if (sp > XB_SPIN_CAP) { atomicAdd(&bar[XB_TMO], 1u); break; } }
    }
    nloc = mine > 0u ? mine : 1u; nx = cnt > 0u ? cnt : 1u;
}
DEV void xcd_barrier(const XcdBarrier& b) {
    asm volatile("s_waitcnt vmcnt(0)" ::: "memory");
    __syncthreads();
    if (threadIdx.x == 0) {
        unsigned* bar = b.bar;
        __builtin_amdgcn_s_waitcnt(0);
        unsigned nloc = b.st[0], nx = b.st[1];
        if (nloc == 0u) { xcd_barrier_complete(bar, b.x, nloc, nx); b.st[0] = nloc; b.st[1] = nx; }
        const unsigned old = xb_add(&bar[XB_XSUB(b.x)], 1u);
        const unsigned gen = old / nloc;
        if (old + 1u == (gen + 1u) * nloc) {
            __builtin_amdgcn_fence(__ATOMIC_RELEASE, "agent");
            asm volatile("s_waitcnt vmcnt(0)" ::: "memory");
            const unsigned og = xb_add(&bar[XB_TOP], 1u);
            const unsigned tg = og / nx;
            if (og + 1u == (tg + 1u) * nx) xb_add(&bar[XB_TOPGEN], 1u);
            else XB_SPIN(xb_ld(&bar[XB_TOPGEN]) == tg, bar);
            __builtin_amdgcn_fence(__ATOMIC_ACQUIRE, "agent");
            xb_add(&bar[XB_XGEN(b.x)], 1u);
            asm volatile("s_waitcnt vmcnt(0)" ::: "memory");
        } else {
            XB_SPIN(xb_ld(&bar[XB_XGEN(b.x)]) == gen, bar);
            __builtin_amdgcn_fence(__ATOMIC_ACQUIRE, "agent");
            asm volatile("s_waitcnt vmcnt(0)" ::: "memory");
        }
    }
    __syncthreads();
}

constexpr int NPHASE = 12;
__global__ void __launch_bounds__(512) fwd_kernel(Params p) {
    extern __shared__ __attribute__((aligned(16))) char lds[];
    char* ws = p.ws;
    volatile LAS unsigned* bst = (volatile LAS unsigned*)(LAS char*)(lds + LDS_BYTES - 64);
    if (threadIdx.x < 16) bst[threadIdx.x] = 0u;
    __syncthreads();
    XcdBarrier xbar; xbar.bar = (unsigned*)(ws + WS_CTL); xbar.x = 0; xbar.st = bst;
    if (MK_LAUNCHES == 1) xbar = xcd_barrier_post((unsigned*)(ws + WS_CTL), bst);
#define SEAM(k) do { if (MK_LAUNCHES == 1 && (k) + 1 < p.ph_hi) { if ((k) == 0) cg::this_grid().sync(); else xcd_barrier(xbar); } } while (0)
#ifndef PHASE_MASK
#define PHASE_MASK 0xFFF
#endif
#define IN(k) (((PHASE_MASK >> (k)) & 1) && p.ph_lo <= (k) && (k) < p.ph_hi)
#define REP(k) for (int rep_ = 0; rep_ < ((PROBE_REPEAT == (k)) ? 2 : 1); ++rep_)
    if (IN(0)) { REP(0) phase_prep(lds, p); SEAM(0); }
    if (IN(1)) {
        for (int rep_ = 0; rep_ < ((PROBE_REPEAT == 21) ? 2 : 1); ++rep_) {
        const bool dummy = (PROBE_REPEAT == 21 && rep_ == 0);
        EpiFilt ef{(bf16_t*)(ws + (dummy ? WS_PRAW : WS_GR)), p.f_b3};
        gemm_phase<false, EpiFilt>(lds, (const bf16_t*)(ws + WS_W3), 64, (const bf16_t*)(ws + WS_HID2), 64, 4096, 4096, 64, ef); }
        REP(1) phase_norm0(p); SEAM(1); }
    if (IN(2)) {
        REP(2) { pg8::Gemm g{(const bf16_t*)(ws + WS_H0), (const bf16_t*)(ws + WS_WIN), NALL, AINP, DM}; pg8::StaticOrder S; S.init(NALL, AINP, (int)gridDim.x, (int)blockIdx.x);
            pg8::EpiBf16 E{(bf16_t*)(ws + WS_PRAW), (size_t)AINP, 0, 0};
            pg8::gemm_phase<pg8::EpiBf16, pg8::StaticOrder, true, true>((PG8_LAS unsigned char*)lds, g, S, E); }
        SEAM(2); }
    if (IN(3)) { filt_sums(p); REP(3) phase_post(p); SEAM(3); }
    if (IN(4)) {
        const float* rp = (const float*)(ws + WS_ROPE);
        REP(4) {
        EpiUq eq{(bf16_t*)(ws + WS_QM), rp + 2048, rp + 2560};
        gemm_phase<false, EpiUq>(lds, (const bf16_t*)(ws + WS_CQN), 256, (const bf16_t*)(ws + WS_WUQ), 256, NTOK, 768, 256, eq);
        EpiUkv ek{(bf16_t*)(ws + WS2_KM), (bf16_t*)(ws + WS2_VM)};
        gemm_phase<false, EpiUkv>(lds, (const bf16_t*)(ws + WS_CKVN), 128, (const bf16_t*)(ws + WS_WUKV), 128, NALL, 1024, 128, ek); }
        SEAM(4); }
    if (IN(5)) { REP(5) phase_attn(lds, p); SEAM(5); }
    if (IN(6)) {
        REP(6) { pg8::Gemm g{(const bf16_t*)(ws + WS2_OG), (const bf16_t*)(ws + WS_WOUT), NTOK, DM, DM}; pg8::StaticOrder S; S.init(NTOK, DM, (int)gridDim.x, (int)blockIdx.x);
            pg8::EpiResF32 E{p.x, p.out, (const float*)(ws + WS_MOD0), (DBG_SKIP & 1) ? 0.f : 1.f};
            pg8::gemm_phase<pg8::EpiResF32, pg8::StaticOrder, true, true>((PG8_LAS unsigned char*)lds, g, S, E); }
        SEAM(6); }
    if (IN(7)) { REP(7) phase_norm1(p); SEAM(7); }
    if (IN(8)) {
        REP(8) { pg8::Gemm g{(const bf16_t*)(ws + WS_HWIN), (const bf16_t*)(ws + WS_H1), 4096, NTOK, DM}; pg8::StaticOrder S; S.init(4096, NTOK, (int)gridDim.x, (int)blockIdx.x);
            pg8::EpiBf16 E{(bf16_t*)(ws + WS_PT), (size_t)4096, 4096, (size_t)4096 * 4096};
            pg8::gemm_phase<pg8::EpiBf16, pg8::StaticOrder, true, true>((PG8_LAS unsigned char*)lds, g, S, E); }
        SEAM(8); }
    if (IN(9)) { REP(9) for (int c = blockIdx.x; c < 1024; c += gridDim.x) conv_unit2(lds, p, c); SEAM(9); }
    if (IN(10)) {
        REP(10) {
        EpiRes e{p.out, (PROBE_REPEAT == 10 && rep_ == 0) ? (float*)(ws + WS_PT) : p.out, (const float*)(ws + WS_MOD1), (DBG_SKIP & 2) ? 0.f : 1.f};
        const bf16_t* OG2 = (const bf16_t*)(ws + WS_OG2); const bf16_t* W = (const bf16_t*)(ws + WS_HWOUT);
        const int nt = (NTOK / 256) * (DM / 128);
        for (int t = blockIdx.x; t < nt; t += gridDim.x) { const int ti = t / 8, tj = t % 8; const int b = ti >> 4, l0 = (ti & 15) * 256;
            gemm_tile<true, EpiRes>(lds, OG2 + (size_t)b * 1024 * 4096 + l0, 4096, W + (size_t)tj * 128 * DM, DM, DM, e, ti * 256, tj * 128); }
        }
        SEAM(10); }
    if (IN(11)) { phase_final(p); }
#undef SEAM
#undef IN
}

extern "C" void kernel_launch(void* const* d_in, const int* in_sizes, int n_in, void* d_out, int out_size, void* d_ws, size_t ws_size, hipStream_t stream) {
    static int grid = 0;
    if (grid == 0) {
        if (n_in != 28 || out_size != NTOK * DM || ws_size < WS_END) { fprintf(stderr, "kernel_launch: unexpected shapes n_in %d out %d ws %zu\n", n_in, out_size, ws_size); grid = -1; return; }
        int dev = 0, cus = 0, per_cu = 0;
        hipGetDevice(&dev); hipDeviceGetAttribute(&cus, hipDeviceAttributeMultiprocessorCount, dev);
        if (hipFuncSetAttribute((const void*)fwd_kernel, hipFuncAttributeMaxDynamicSharedMemorySize, LDS_BYTES) != hipSuccess) { fprintf(stderr, "hipFuncSetAttribute failed\n"); grid = -1; return; }
        hipOccupancyMaxActiveBlocksPerMultiprocessor(&per_cu, (const void*)fwd_kernel, 512, LDS_BYTES);
        if (per_cu < 1) { fprintf(stderr, "occupancy query says %d\n", per_cu); per_cu = 1; }
        grid = cus * 1;
        (void)hipGetLastError();
    }
    if (grid < 0) return;
    Params p{};
    const float** pp = (const float**)&p;
    for (int i = 0; i < 28; ++i) pp[i] = (const float*)d_in[i];
    p.out = (float*)d_out; p.ws = (char*)d_ws;
#if MK_LAUNCHES == 1
    if (hipMemsetAsync((char*)d_ws + WS_CTL, 0, CTL_BYTES, stream) != hipSuccess) { fprintf(stderr, "memset failed\n"); return; }
    p.ph_lo = 0; p.ph_hi = NPHASE;
    void* args[] = {&p};
    hipError_t e = hipLaunchCooperativeKernel((const void*)fwd_kernel, dim3(grid), dim3(512), args, LDS_BYTES, stream);
    if (e != hipSuccess) fprintf(stderr, "cooperative launch failed: %s (grid %d)\n", hipGetErrorString(e), grid);
#else
    for (int k = 0; k < NPHASE; ++k) { p.ph_lo = k; p.ph_hi = k + 1; hipLaunchKernelGGL(fwd_kernel, dim3(grid), dim3(512), LDS_BYTES, stream, p); }
#endif
}
```

```cpp
#include <hip/hip_runtime.h>
#include <hip/hip_cooperative_groups.h>
#include <cstdio>
#include <cstdint>
namespace cg = cooperative_groups;

#ifndef MK_LAUNCHES
#define MK_LAUNCHES 1
#endif

#ifndef PROBE_REPEAT
#define PROBE_REPEAT -1
#endif
#ifndef DBG_SKIP
#define DBG_SKIP 0
#endif
#define DEV __device__ __forceinline__
typedef unsigned short bf16_t;
typedef short bf16x8 __attribute__((ext_vector_type(8)));
typedef short s16x4 __attribute__((ext_vector_type(4)));
typedef float f32x16 __attribute__((ext_vector_type(16)));
typedef float f32x4 __attribute__((ext_vector_type(4)));
typedef float f32x2 __attribute__((ext_vector_type(2)));
typedef unsigned u32x4 __attribute__((ext_vector_type(4)));
typedef unsigned u32x2 __attribute__((ext_vector_type(2)));
typedef __bf16 bf16x2_t __attribute__((ext_vector_type(2)));
#define LAS __attribute__((address_space(3)))

constexpr int NB = 8, SEQ = 4096, DM = 1024, CTXL = 256, LK = SEQ + CTXL;
constexpr int NTOK = NB * SEQ, NCTX = NB * CTXL, NALL = NTOK + NCTX;
constexpr int AIN = 2208, AINP = 2304;
constexpr float EPS = 1e-6f;
constexpr float LOG2E = 1.4426950408889634f;
constexpr float QSC_A = 0.125f * LOG2E;
constexpr float QSC_M = 0.10206207261596575f * LOG2E;

constexpr size_t MiB = 1ull << 20;
constexpr size_t WS_WIN = 0;
constexpr size_t WS_WUQ = 5 * MiB;
constexpr size_t WS_WUKV = 6 * MiB;
constexpr size_t WS_WOUT = 7 * MiB;
constexpr size_t WS_HWIN = 9 * MiB;
constexpr size_t WS_HWOUT = 17 * MiB;
constexpr size_t WS_W3 = 19 * MiB;
constexpr size_t WS_HID2 = 20 * MiB;
constexpr size_t WS_MOD0 = 21 * MiB;
constexpr size_t WS_MOD1 = WS_MOD0 + 9 * 3072 * 4;
constexpr size_t WS_SSUM = WS_MOD1 + 8 * 3072 * 4;
constexpr size_t WS_ROPE = WS_SSUM + 2048 * 4;
constexpr size_t WS_GR = 22 * MiB;
constexpr size_t WS_H0 = 64 * MiB;
constexpr size_t WS_PRAW = 136 * MiB;
constexpr size_t WS_QA = 297 * MiB;
constexpr size_t WS_KA = 329 * MiB;
constexpr size_t WS_VA = 338 * MiB;
constexpr size_t WS_CQN = 347 * MiB;
constexpr size_t WS_CKVN = 363 * MiB;
constexpr size_t WS_G = 372 * MiB;
constexpr size_t WS_QM = 64 * MiB;
constexpr size_t WS_KM = 136 * MiB;
constexpr size_t WS_VM = 190 * MiB;
constexpr size_t WS_OG = 226 * MiB;
constexpr size_t WS_H1 = 436 * MiB;
constexpr size_t WS_PT = 64 * MiB;
constexpr size_t WS_OG2 = 320 * MiB;
constexpr size_t WS_CTL = 500 * MiB;
constexpr size_t CTL_BYTES = 16384;
constexpr size_t WS_END = 500 * MiB + CTL_BYTES;
constexpr size_t WS2_KM = 436 * MiB;
constexpr size_t WS2_VM = 190 * MiB;
constexpr size_t WS2_OG = 226 * MiB;

constexpr int LDS_BYTES = 150 * 1024;

extern __shared__ __attribute__((aligned(16))) char lds_dyn[];
constexpr int LDS_WTAB = LDS_BYTES - 64 - 256;
__device__ __forceinline__ int lane_id() { int r; asm volatile("v_mbcnt_lo_u32_b32 %0, -1, 0\n\tv_mbcnt_hi_u32_b32 %0, -1, %0" : "=v"(r)); return r; }
__device__ __forceinline__ int hw_slot() { return (int)(__builtin_amdgcn_s_getreg((5 << 11) | 4) & 63u); }
__device__ __forceinline__ int wave_idx() { return __builtin_amdgcn_readfirstlane(*(volatile __attribute__((address_space(3))) int*)(__attribute__((address_space(3))) char*)(lds_dyn + LDS_WTAB + 4 * hw_slot())); }
#define TID() (wave_idx() * 64 + lane_id())

DEV float bf2f(bf16_t v) { return __uint_as_float(((unsigned)v) << 16); }
DEV unsigned pk2(float lo, float hi) { f32x2 v = {lo, hi}; bf16x2_t b = __builtin_convertvector(v, bf16x2_t); return __builtin_bit_cast(unsigned, b); }
DEV bf16_t f2bf(float f) { return (bf16_t)(pk2(f, 0.f) & 0xffffu); }
DEV float lo_bf(unsigned w) { return __uint_as_float(w << 16); }
DEV float hi_bf(unsigned w) { return __uint_as_float(w & 0xffff0000u); }
DEV int crow(int r, int hi) { return (r & 3) + 8 * (r >> 2) + 4 * hi; }
DEV float silu(float v) { return v / (1.f + __expf(-v)); }
DEV void unpack8(const u32x4 w, float* v) { v[0] = lo_bf(w.x); v[1] = hi_bf(w.x); v[2] = lo_bf(w.y); v[3] = hi_bf(w.y); v[4] = lo_bf(w.z); v[5] = hi_bf(w.z); v[6] = lo_bf(w.w); v[7] = hi_bf(w.w); }
DEV u32x4 pack8(const float* v) { u32x4 w; w.x = pk2(v[0], v[1]); w.y = pk2(v[2], v[3]); w.z = pk2(v[4], v[5]); w.w = pk2(v[6], v[7]); return w; }

DEV float wave_sum(float v) {
#pragma unroll
    for (int o = 1; o < 64; o <<= 1) v += __shfl_xor(v, o);
    return v;
}
struct Params {
    const float *x, *c, *ctx, *c_ctx, *ada_w, *ada_b, *norm_w, *w_in, *q_norm, *k_norm, *cq_norm, *ckv_norm, *w_uq, *w_ukv, *w_out,
        *hy_w_in, *conv_w, *conv_b, *f_w1, *f_b1, *f_w2, *f_b2, *f_w3, *f_b3, *freq, *skip, *hy_w_out, *final_w;
    float* out; char* ws; int ph_lo, ph_hi;
};

constexpr int G_RS = 144;
constexpr int G_RB = 256 * G_RS, G_CB = 128 * G_RS, G_STAGE = G_RB + G_CB;
constexpr int T_RS = 576;

template <bool TR, class Epi>
DEV void gemm_tile(char* lds, const bf16_t* __restrict__ R, size_t ldr, const bf16_t* __restrict__ C, size_t ldc, int K, const Epi& epi, int ti0, int tj0) {
    const int tid = TID(), lane = tid & 63, wid = tid >> 6;
    const int wi = wid >> 1, wj = wid & 1, l31 = lane & 31, hi = lane >> 5;
    f32x16 acc[2][2];
#pragma unroll
    for (int a = 0; a < 2; ++a)
#pragma unroll
        for (int b = 0; b < 2; ++b)
#pragma unroll
            for (int r = 0; r < 16; ++r) acc[a][b][r] = 0.f;
    u32x4 rrX[4], rcX[2], rrY[4], rcY[2];
    const bf16_t* Rp; const bf16_t* Cp; int rl_off, cl_off;
    if (TR) { const int c = tid & 31, kr = tid >> 5; Rp = R + (size_t)kr * ldr + c * 8; rl_off = kr * T_RS + c * 16; }
    else { const int lr = tid >> 3, lc = tid & 7; Rp = R + (size_t)lr * ldr + lc * 8; rl_off = lr * G_RS + lc * 16; }
    { const int lr = tid >> 3, lc = tid & 7; Cp = C + (size_t)lr * ldc + lc * 8; cl_off = lr * G_RS + lc * 16; }
    const int nk = K / 64;
    int ra_off[2], cb_off[2];
#pragma unroll
    for (int t = 0; t < 2; ++t) {
        if (TR) { const int g1 = (lane >> 4) & 1, q = (lane & 15) >> 2, p = lane & 3; ra_off[t] = (8 * hi + q) * T_RS + (wi * 64 + t * 32 + 16 * g1 + 4 * p) * 2; }
        else ra_off[t] = (wi * 64 + t * 32 + l31) * G_RS + hi * 16;
        cb_off[t] = G_RB + (wj * 64 + t * 32 + l31) * G_RS + hi * 16;
    }
#define G_LOAD(kt, S) do { const int kk_ = (kt) < nk ? (kt) : nk - 1; \
        if (TR) { _Pragma("unroll") for (int p = 0; p < 4; ++p) rr##S[p] = *(const u32x4*)(Rp + ((size_t)kk_ * 64 + 16 * p) * ldr); } \
        else { _Pragma("unroll") for (int p = 0; p < 4; ++p) rr##S[p] = *(const u32x4*)(Rp + (size_t)(64 * p) * ldr + kk_ * 64); } \
        _Pragma("unroll") for (int p = 0; p < 2; ++p) rc##S[p] = *(const u32x4*)(Cp + (size_t)(64 * p) * ldc + kk_ * 64); } while (0)
#define G_STORE(buf, S) do { char* b_ = lds + (buf) * G_STAGE; \
        if (TR) { _Pragma("unroll") for (int p = 0; p < 4; ++p) *(u32x4*)(b_ + rl_off + 16 * p * T_RS) = rr##S[p]; } \
        else { _Pragma("unroll") for (int p = 0; p < 4; ++p) *(u32x4*)(b_ + rl_off + 64 * p * G_RS) = rr##S[p]; } \
        _Pragma("unroll") for (int p = 0; p < 2; ++p) *(u32x4*)(b_ + G_RB + cl_off + 64 * p * G_RS) = rc##S[p]; } while (0)
#define G_COMPUTE(buf) do { const char* b_ = lds + (buf) * G_STAGE; \
        _Pragma("unroll") for (int ks = 0; ks < 4; ++ks) { bf16x8 fa[2], fb[2]; \
            _Pragma("unroll") for (int t = 0; t < 2; ++t) { \
                if (TR) { \
                    const s16x4 lo = __builtin_bit_cast(s16x4, __builtin_amdgcn_ds_read_tr16_b64_v4i16((LAS s16x4*)(b_ + ra_off[t] + ks * 16 * T_RS))); \
                    const s16x4 hh = __builtin_bit_cast(s16x4, __builtin_amdgcn_ds_read_tr16_b64_v4i16((LAS s16x4*)(b_ + ra_off[t] + (ks * 16 + 4) * T_RS))); \
                    fa[t] = (bf16x8){lo[0], lo[1], lo[2], lo[3], hh[0], hh[1], hh[2], hh[3]}; \
                } else fa[t] = *(const bf16x8*)(b_ + ra_off[t] + ks * 32); \
                fb[t] = *(const bf16x8*)(b_ + cb_off[t] + ks * 32); } \
            _Pragma("unroll") for (int a = 0; a < 2; ++a) _Pragma("unroll") for (int b = 0; b < 2; ++b) acc[a][b] = __builtin_amdgcn_mfma_f32_32x32x16_bf16(fa[a], fb[b], acc[a][b], 0, 0, 0); } } while (0)
    G_LOAD(0, X); G_LOAD(1, Y); G_STORE(0, X);
    __syncthreads();
    for (int kt = 0; kt < nk; kt += 2) {
        G_LOAD(kt + 2, X);
        G_COMPUTE(0);
        G_STORE(1, Y);
        __syncthreads();
        if (kt + 1 >= nk) break;
        G_LOAD(kt + 3, Y);
        G_COMPUTE(1);
        G_STORE(0, X);
        __syncthreads();
    }
#undef G_LOAD
#undef G_STORE
#undef G_COMPUTE
#pragma unroll
    for (int a = 0; a < 2; ++a)
#pragma unroll
        for (int b = 0; b < 2; ++b) epi(ti0 + wi * 64 + a * 32, tj0 + wj * 64 + b * 32, acc[a][b], l31, hi);
}

template <bool TR, class Epi>
DEV void gemm_phase(char* lds, const bf16_t* R, size_t ldr, const bf16_t* C, size_t ldc, int nI, int nJ, int K, const Epi& epi) {
    const int tI = nI / 256, tJ = nJ / 128, nt = tI * tJ;
    for (int t = blockIdx.x; t < nt; t += gridDim.x) {
        const int ti = t / tJ, tj = t % tJ;
        gemm_tile<TR, Epi>(lds, R + (size_t)ti * 256 * ldr, ldr, C + (size_t)tj * 128 * ldc, ldc, K, epi, ti * 256, tj * 128);
    }
}

struct EpiRaw {
    bf16_t* O; size_t ld;
    DEV void operator()(int i0, int j0, const f32x16& a, int l31, int hi) const {
#pragma unroll
        for (int r = 0; r < 16; ++r) O[(size_t)(i0 + crow(r, hi)) * ld + j0 + l31] = f2bf(a[r]);
    }
};
struct EpiUq {
    bf16_t* QM; const float* cos32; const float* sin32;
    DEV void operator()(int i0, int j0, const f32x16& a, int l31, int hi) const {
        const bool pe = (j0 % 96) == 64;
        const int fi = l31 & 7; const bool colang = (l31 & 16) != 0; const bool bpart = (l31 & 8) != 0;
#pragma unroll
        for (int r = 0; r < 16; ++r) {
            const int tok = i0 + crow(r, hi); float v = a[r];
            const float o = __shfl_xor(v, 8);
            if (pe) { const int l = tok & (SEQ - 1); const int pos = colang ? (l & 63) : (l >> 6);
                const float cs = cos32[pos * 8 + fi], sn = sin32[pos * 8 + fi];
                v = bpart ? (v * cs + o * sn) : (v * cs - o * sn); }
            QM[(size_t)tok * 768 + j0 + l31] = f2bf(v * QSC_M);
        }
    }
};
struct EpiUkv {
    bf16_t* KM; bf16_t* VM;
    DEV void operator()(int i0, int j0, const f32x16& a, int l31, int hi) const {
        const int h = j0 >> 7, e = (j0 & 127) + l31;
#pragma unroll
        for (int r = 0; r < 16; ++r) { const size_t row = (size_t)(i0 + crow(r, hi));
            if (e < 64) KM[row * 768 + h * 96 + e] = f2bf(a[r]); else VM[row * 512 + h * 64 + (e - 64)] = f2bf(a[r]); }
    }
};
struct EpiRes {
    const float* base; float* out; const float* mod; float gmul;
    DEV void operator()(int i0, int j0, const f32x16& a, int l31, int hi) const {
        const int b = i0 >> 12; const float g = mod[b * 3072 + 2048 + j0 + l31] * gmul;
#pragma unroll
        for (int h8 = 0; h8 < 2; ++h8) { float bv[8];
#pragma unroll
            for (int r = 0; r < 8; ++r) bv[r] = base[(size_t)(i0 + crow(8 * h8 + r, hi)) * DM + j0 + l31];
#pragma unroll
            for (int r = 0; r < 8; ++r) out[(size_t)(i0 + crow(8 * h8 + r, hi)) * DM + j0 + l31] = bv[r] + g * a[8 * h8 + r]; }
    }
};
struct EpiPT {
    bf16_t* PT;
    DEV void operator()(int i0, int j0, const f32x16& a, int l31, int hi) const {
        const int b = j0 >> 12, l = (j0 & 4095) + l31;
#pragma unroll
        for (int r = 0; r < 16; ++r) PT[((size_t)(b * 4096 + i0 + crow(r, hi))) * 4096 + l] = f2bf(a[r]);
    }
};
struct EpiFilt {
    bf16_t* GR; const float* b3;
    DEV void operator()(int i0, int j0, const f32x16& a, int l31, int hi) const {
        const int t = j0 + l31; const float tn = (float)t * (1.0f / 4095.0f);
        const float dmin = -3.0701134573253945f, dmax = -15.350567286626973f;
#pragma unroll
        for (int r = 0; r < 16; ++r) {
            const int n = i0 + crow(r, hi); const int c = n & 1023, od = n >> 10, o = od >> 1, dir = od & 1;
            const float delta = fabsf(dmin + (float)c * ((dmax - dmin) / 1023.0f));
            const float v = (a[r] + b3[n]) * __expf(-tn * delta);
            bf16_t* g = GR + ((size_t)(o * 1024 + c)) * 8192;
            if (dir == 0) g[4096 - t] = f2bf(v);
            else { if (t == 0) g[0] = 0; else g[4096 + t] = f2bf(v); }
        }
    }
};
DEV void filt_sums(const Params& p) {
    const int wid = TID() >> 6, lane = TID() & 63; bf16_t* GR = (bf16_t*)(p.ws + WS_GR); float* ssum = (float*)(p.ws + WS_SSUM);
    for (int row = blockIdx.x * 8 + wid; row < 2048; row += gridDim.x * 8) {
        bf16_t* g = GR + (size_t)row * 8192; float s = 0.f;
        u32x4 w[16];
#pragma unroll
        for (int j = 0; j < 16; ++j) w[j] = *(const u32x4*)(g + (j * 64 + lane) * 8);
#pragma unroll
        for (int j = 0; j < 16; ++j) { float v[8]; unpack8(w[j], v);
            if (j == 0 && lane == 0) v[0] = 0.f;
#pragma unroll
            for (int e = 0; e < 8; ++e) s += fabsf(v[e]); }
        s = wave_sum(s);
        if (lane == 0) ssum[row] = s;
    }
}

namespace pg8 {
#define PG8_LAS __attribute__((address_space(3)))
typedef short bf16x8 __attribute__((ext_vector_type(8)));
typedef float f32x4 __attribute__((ext_vector_type(4)));
typedef unsigned u32x4 __attribute__((ext_vector_type(4)));
constexpr int BM = 256, BK = 64, HALF = 128, HTB = HALF * BK * 2  , STAGE_BYTES = 8 * HTB, NXCD = 8, WGM = 8;

__host__ __device__ __forceinline__ int lds_byte(int r, int c) { const int st = (r >> 4) * 2 + (c >> 5), rr = r & 15, cc = c & 31, ob = rr * 64 + cc * 2; return st * 1024 + (ob ^ (((ob >> 9) & 1) << 5)); }
__host__ __device__ __forceinline__ void stage_rc(int b, int& R, int& C) { const int st = b / 1024, sb = b % 1024, swz = sb ^ (((sb >> 9) & 1) << 5); R = (st >> 1) * 16 + swz / 64; C = (st & 1) * 32 + (swz % 64) / 2; }
__host__ __device__ __forceinline__ int perm32(int rho) { const int n = rho >> 4, i = rho & 15; return 8 * (i >> 2) + 4 * n + (i & 3); }

struct Unit { int pm, pn; };
struct Gemm { const bf16_t* A; const bf16_t* Bt; int M, N, K; };

struct StaticOrder {
    int nM, nN, nwg, G, c;
    __host__ __device__ void init(int M, int N, int G_, int c_) { nM = M / BM; nN = N / BM; nwg = nM * nN; G = G_; c = c_; }
    __host__ __device__ bool next(int i, Unit& u) const {
        const long L = (long)i * G + c; if (L >= nwg) return false;
        int wgid = (int)L; { const int q = nwg / NXCD, r = nwg % NXCD, xcd = wgid % NXCD, off = wgid / NXCD; wgid = (xcd < r ? xcd * (q + 1) : r * (q + 1) + (xcd - r) * q) + off; }
        const int nig = WGM * nN, gid = wgid / nig, fm = gid * WGM, gsz = (nM - fm) < WGM ? (nM - fm) : WGM;
        u.pm = fm + ((wgid % nig) % gsz); u.pn = (wgid % nig) / gsz; return true;
    }
    __device__ __forceinline__ void a_ready(const Unit&) const {}
    __device__ __forceinline__ void done(const Unit&) const {}
};

__device__ __forceinline__ unsigned cvt_pk_bf16(float lo, float hi) { unsigned r; asm volatile("v_cvt_pk_bf16_f32 %0, %1, %2" : "=v"(r) : "v"(lo), "v"(hi)); return r; }
typedef float f32x2 __attribute__((ext_vector_type(2)));

struct EpiBf16 {
    static constexpr bool PERM = true, AFTER_DRAIN = false;
    bf16_t* O; size_t ldc; int split_cols; size_t split_stride;
    __device__ __forceinline__ void operator()(const f32x4 (&acc)[2][2][4][2], const Unit& u, int wr, int wc, int fr, int fq) const {
        const int row0 = u.pm * BM + wr * 64 + fr; int colt = u.pn * BM; bf16_t* base = O;
        if (split_cols) { const int t = colt / split_cols; base += (size_t)t * split_stride; colt -= t * split_cols; }
        const int col0 = colt + wc * 32 + 8 * fq;
#pragma unroll
        for (int ai = 0; ai < 2; ++ai)
#pragma unroll
            for (int m = 0; m < 4; ++m) { bf16_t* rowp = base + (size_t)(row0 + ai * HALF + m * 16) * ldc + col0;
#pragma unroll
                for (int bj = 0; bj < 2; ++bj) { const f32x4 v0 = acc[ai][bj][m][0], v1 = acc[ai][bj][m][1];
                    u32x4 w; w.x = cvt_pk_bf16(v0[0], v0[1]); w.y = cvt_pk_bf16(v0[2], v0[3]); w.z = cvt_pk_bf16(v1[0], v1[1]); w.w = cvt_pk_bf16(v1[2], v1[3]);
                    *(u32x4*)(rowp + bj * HALF) = w; } }
    }
};

struct EpiUkvPg {
    static constexpr bool PERM = true, AFTER_DRAIN = false;
    bf16_t* KM; bf16_t* VM;
    __device__ __forceinline__ void operator()(const f32x4 (&acc)[2][2][4][2], const Unit& u, int wr, int wc, int fr, int fq) const {
        asm volatile("" : "+v"(fr), "+v"(fq));
        const int row0 = u.pm * BM + wr * 64 + fr; const int e0 = 32 * wc + 8 * fq;
        const bool isk = (wc < 2);
        bf16_t* base = isk ? KM + (size_t)row0 * 768 + 2 * u.pn * 96 + e0 : VM + (size_t)row0 * 512 + 2 * u.pn * 64 + (e0 - 64);
        const int ld = isk ? 768 : 512, hs = isk ? 96 : 64;
#pragma unroll
        for (int ai = 0; ai < 2; ++ai)
#pragma unroll
            for (int m = 0; m < 4; ++m)
#pragma unroll
                for (int bj = 0; bj < 2; ++bj) { const f32x4 v0 = acc[ai][bj][m][0], v1 = acc[ai][bj][m][1];
                    u32x4 w; w.x = cvt_pk_bf16(v0[0], v0[1]); w.y = cvt_pk_bf16(v0[2], v0[3]); w.z = cvt_pk_bf16(v1[0], v1[1]); w.w = cvt_pk_bf16(v1[2], v1[3]);
                    *(u32x4*)(base + (ai * HALF + m * 16) * ld + bj * hs) = w; }
    }
};
struct EpiUqPg {
    static constexpr bool PERM = true, AFTER_DRAIN = false;
    bf16_t* QM; const float* cos32; const float* sin32; float sc;
    __device__ __forceinline__ void operator()(const f32x4 (&acc)[2][2][4][2], const Unit& u, int wr, int wc, int fr, int fq) const {
        asm volatile("" : "+v"(fr), "+v"(fq));
        const int row0 = u.pm * BM + wr * 64 + fr;
        bf16_t* base = QM + (size_t)row0 * 768 + u.pn * BM + 32 * wc + 8 * fq;
        const int g0 = 8 * u.pn + wc;
        const bool sgn = (fq & 1) != 0;
#pragma unroll
        for (int bj = 0; bj < 2; ++bj) { const bool pe = (((g0 + 4 * bj) % 3) == 2);
#pragma unroll
            for (int ai = 0; ai < 2; ++ai)
#pragma unroll
                for (int m = 0; m < 4; ++m) { const int rr = ai * HALF + m * 16; u32x4 w;
#pragma unroll
                    for (int n = 0; n < 2; ++n) { f32x4 v = acc[ai][bj][m][n];
                        if (pe) { f32x4 o;
#pragma unroll
                            for (int e = 0; e < 4; ++e) o[e] = __shfl_xor(v[e], 16);
                            const int l = (row0 + rr) & 4095, pos = (fq < 2) ? (l >> 6) : (l & 63);
                            const f32x4 cv = *(const f32x4*)(cos32 + pos * 8 + 4 * n), sv = *(const f32x4*)(sin32 + pos * 8 + 4 * n);
                            v = sgn ? (v * cv + o * sv) : (v * cv - o * sv); }
                        v = v * sc;
                        if (n == 0) { w.x = cvt_pk_bf16(v[0], v[1]); w.y = cvt_pk_bf16(v[2], v[3]); } else { w.z = cvt_pk_bf16(v[0], v[1]); w.w = cvt_pk_bf16(v[2], v[3]); } }
                    *(u32x4*)(base + rr * 768 + bj * HALF) = w;
                    asm volatile("" ::: "memory"); } }
    }
};
struct EpiResF32 {
    static constexpr bool PERM = false, AFTER_DRAIN = false;
    const float* base; float* out; const float* mod; float gmul;
    __device__ __forceinline__ void operator()(const f32x4 (&acc)[2][2][4][2], const Unit& u, int wr, int wc, int fr, int fq) const {
        const int row0 = u.pm * BM + wr * 64 + fr, col0 = u.pn * BM + wc * 32 + 4 * fq, b = (u.pm * BM) >> 12;
        f32x4 g[2][2];
#pragma unroll
        for (int bj = 0; bj < 2; ++bj)
#pragma unroll
            for (int n = 0; n < 2; ++n) g[bj][n] = *(const f32x4*)(mod + b * 3072 + 2048 + col0 + bj * HALF + n * 16) * gmul;
#pragma unroll
        for (int ai = 0; ai < 2; ++ai) {
            f32x4 pre[4][2][2];
#pragma unroll
            for (int m = 0; m < 4; ++m) { const size_t off = (size_t)(row0 + ai * HALF + m * 16) * 1024 + col0;
#pragma unroll
                for (int bj = 0; bj < 2; ++bj)
#pragma unroll
                    for (int n = 0; n < 2; ++n) pre[m][bj][n] = *(const f32x4*)(base + off + bj * HALF + n * 16); }
#pragma unroll
            for (int m = 0; m < 4; ++m) { const size_t off = (size_t)(row0 + ai * HALF + m * 16) * 1024 + col0;
#pragma unroll
                for (int bj = 0; bj < 2; ++bj)
#pragma unroll
                    for (int n = 0; n < 2; ++n) *(f32x4*)(out + off + bj * HALF + n * 16) = pre[m][bj][n] + g[bj][n] * acc[ai][bj][m][n]; }
        }
    }
};
template <class Epi, class Sched, bool ALIGN_EPI = false, bool SP2 = false>
__device__ __forceinline__ void gemm_phase(PG8_LAS unsigned char* lds, const Gemm g, const Sched& S, const Epi& E) {
    int tid_ = TID(); asm volatile("" : "+v"(tid_));
    const int tid = tid_, wid = __builtin_amdgcn_readfirstlane(tid >> 6), lane = tid & 63, wr = wid >> 2, wc = wid & 3, fr = lane & 15, fq = lane >> 4;
    const int K = g.K, nt = K / BK;
    unsigned voffA[2], voffB[2];
#pragma unroll
    for (int i = 0; i < 2; ++i) { int R, C; stage_rc(tid * 16 + i * 8192, R, C); const int Rb = Epi::PERM ? ((R & ~31) + perm32(R & 31)) : R;
        voffA[i] = (unsigned)(R * K + C) * 2u; voffB[i] = (unsigned)(Rb * K + C) * 2u; }
    const size_t kstep = (size_t)(BK * 2);
    const size_t hstep = (size_t)HALF * K * 2;
    const size_t tstep = 2 * hstep;
    const unsigned ldsw = (unsigned)wid * 1024u;
    const int aoff = lds_byte(wr * 64 + fr, fq * 8), boff = lds_byte(wc * 32 + fr, fq * 8);
#define PG8_SA(b, h) (((b) * 2 + (h)) * HTB)
#define PG8_SB(b, h) ((4 + (b) * 2 + (h)) * HTB)
#define PG8_STAGE(bufoff, gbase, voff) do { _Pragma("unroll") for (int _i = 0; _i < 2; ++_i) \
        __builtin_amdgcn_global_load_lds((const unsigned*)((const char*)(gbase) + (voff)[_i]), (PG8_LAS unsigned*)(lds + (bufoff) + ldsw + _i * 8192), 16, 0, 0); } while (0)
#define PG8_LDA(dst, b, h) do { _Pragma("unroll") for (int m = 0; m < 4; ++m) _Pragma("unroll") for (int k = 0; k < 2; ++k) dst[m][k] = *(const PG8_LAS bf16x8*)(lds + PG8_SA(b, h) + aoff + m * 2048 + k * 1024); } while (0)
#define PG8_LDB(dst, b, h) do { _Pragma("unroll") for (int n = 0; n < 2; ++n) _Pragma("unroll") for (int k = 0; k < 2; ++k) dst[n][k] = *(const PG8_LAS bf16x8*)(lds + PG8_SB(b, h) + boff + n * 2048 + k * 1024); } while (0)
#define PG8_MMA(ai, bj, At, Bt) do { __builtin_amdgcn_s_setprio(1); _Pragma("unroll") for (int m = 0; m < 4; ++m) _Pragma("unroll") for (int n = 0; n < 2; ++n) _Pragma("unroll") for (int k = 0; k < 2; ++k) \
        acc[ai][bj][m][n] = __builtin_amdgcn_mfma_f32_16x16x32_bf16(Bt[n][k], At[m][k], acc[ai][bj][m][n], 0, 0, 0); __builtin_amdgcn_s_setprio(0); } while (0)
#define PG8_WAIT_V(n) asm volatile("s_waitcnt vmcnt(" #n ")" ::: "memory")
#define PG8_WAIT_L(n) asm volatile("s_waitcnt lgkmcnt(" #n ")" ::: "memory")
#define PG8_BAR __builtin_amdgcn_s_barrier()
#define PG8_SCHED __builtin_amdgcn_sched_barrier(0)
    Unit cur, nxt; int ui = 0;
    if (!S.next(0, cur)) return;
    f32x4 acc[2][2][4][2];
#pragma unroll
    for (int a = 0; a < 2; ++a)
#pragma unroll
        for (int b = 0; b < 2; ++b)
#pragma unroll
            for (int m = 0; m < 4; ++m)
#pragma unroll
                for (int n = 0; n < 2; ++n) acc[a][b][m][n] = (f32x4){0.f, 0.f, 0.f, 0.f};
    bf16x8 At[4][2], B0[2][2], B1[2][2];
    const char* cA = (const char*)g.A + (size_t)cur.pm * tstep; const char* cB = (const char*)g.Bt + (size_t)cur.pn * tstep;
    S.a_ready(cur);
    if constexpr (SP2) {
        PG8_STAGE(PG8_SB(0, 0), cB, voffB); PG8_STAGE(PG8_SB(0, 1), cB + hstep, voffB); PG8_STAGE(PG8_SA(0, 0), cA, voffA); PG8_STAGE(PG8_SA(0, 1), cA + hstep, voffA);
        if (wr == 1) PG8_BAR;
        PG8_WAIT_V(2); PG8_BAR;
        PG8_STAGE(PG8_SB(1, 0), cB + kstep, voffB); PG8_STAGE(PG8_SA(1, 0), cA + kstep, voffA); PG8_STAGE(PG8_SB(1, 1), cB + hstep + kstep, voffB);
        PG8_WAIT_V(6); PG8_BAR;
    } else {
        PG8_STAGE(PG8_SB(0, 0), cB, voffB); PG8_STAGE(PG8_SA(0, 0), cA, voffA); PG8_STAGE(PG8_SB(0, 1), cB + hstep, voffB); PG8_STAGE(PG8_SA(0, 1), cA + hstep, voffA);
        if (wr == 1) PG8_BAR;
        PG8_WAIT_V(4); PG8_BAR;
        PG8_STAGE(PG8_SB(1, 0), cB + kstep, voffB); PG8_STAGE(PG8_SA(1, 0), cA + kstep, voffA); PG8_STAGE(PG8_SB(1, 1), cB + hstep + kstep, voffB);
        PG8_WAIT_V(6); PG8_BAR;
    }
    for (;;) {
        const bool has_next = S.next(ui + 1, nxt);
        const char* nA = has_next ? (const char*)g.A + (size_t)nxt.pm * tstep : cA; const char* nB = has_next ? (const char*)g.Bt + (size_t)nxt.pn * tstep : cB;
        for (int t = 0; t < nt; t += 2) {
            const bool last = (t == nt - 2);
            const char* a1 = cA + (size_t)(t + 1) * kstep;
            const char* a2 = last ? nA : cA + (size_t)(t + 2) * kstep; const char* b2 = last ? nB : cB + (size_t)(t + 2) * kstep;
            const char* a3 = a2 + kstep; const char* b3 = b2 + kstep;
            if (last && has_next) S.a_ready(nxt);
            if constexpr (SP2) {
            PG8_LDB(B0, 0, 0); PG8_LDB(B1, 0, 1); PG8_SCHED; PG8_LDA(At, 0, 0); PG8_STAGE(PG8_SA(1, 1), a1 + hstep, voffA);
            PG8_WAIT_V(8); PG8_WAIT_L(0); PG8_BAR; PG8_MMA(0, 0, At, B0); PG8_MMA(0, 1, At, B1); PG8_BAR; PG8_SCHED;
            PG8_LDA(At, 0, 1); PG8_STAGE(PG8_SB(0, 0), b2, voffB); PG8_STAGE(PG8_SB(0, 1), b2 + hstep, voffB); PG8_STAGE(PG8_SA(0, 0), a2, voffA);
            PG8_WAIT_V(8); PG8_WAIT_L(0); PG8_BAR; PG8_MMA(1, 0, At, B0); PG8_MMA(1, 1, At, B1); PG8_BAR; PG8_SCHED;
            PG8_LDB(B0, 1, 0); PG8_LDB(B1, 1, 1); PG8_SCHED; PG8_LDA(At, 1, 0); PG8_STAGE(PG8_SA(0, 1), a2 + hstep, voffA);
            PG8_WAIT_V(8); PG8_WAIT_L(0); PG8_BAR; PG8_MMA(0, 0, At, B0); PG8_MMA(0, 1, At, B1); PG8_BAR; PG8_SCHED;
            PG8_LDA(At, 1, 1); PG8_STAGE(PG8_SB(1, 0), b3, voffB); PG8_STAGE(PG8_SB(1, 1), b3 + hstep, voffB); PG8_STAGE(PG8_SA(1, 0), a3, voffA);
            PG8_WAIT_V(8); PG8_WAIT_L(0); PG8_BAR; PG8_MMA(1, 0, At, B0); PG8_MMA(1, 1, At, B1); PG8_BAR; PG8_SCHED;
            } else {
            PG8_LDB(B0, 0, 0); PG8_SCHED; PG8_LDA(At, 0, 0); PG8_STAGE(PG8_SA(1, 1), a1 + hstep, voffA);
            PG8_WAIT_L(8); PG8_BAR; PG8_WAIT_L(0); PG8_MMA(0, 0, At, B0); PG8_BAR; PG8_SCHED;
            PG8_LDB(B1, 0, 1); PG8_STAGE(PG8_SB(0, 0), b2, voffB);
            PG8_BAR; PG8_WAIT_L(0); PG8_MMA(0, 1, At, B1); PG8_BAR;
            PG8_LDA(At, 0, 1); PG8_STAGE(PG8_SA(0, 0), a2, voffA);
            PG8_BAR; PG8_WAIT_L(0); PG8_MMA(1, 0, At, B0); PG8_BAR; PG8_SCHED;
            PG8_STAGE(PG8_SB(0, 1), b2 + hstep, voffB);
            PG8_WAIT_V(6); PG8_BAR; PG8_MMA(1, 1, At, B1); PG8_BAR;
            PG8_LDB(B0, 1, 0); PG8_SCHED; PG8_LDA(At, 1, 0); PG8_STAGE(PG8_SA(0, 1), a2 + hstep, voffA);
            PG8_WAIT_L(8); PG8_BAR; PG8_WAIT_L(0); PG8_MMA(0, 0, At, B0); PG8_BAR; PG8_SCHED;
            PG8_LDB(B1, 1, 1); PG8_STAGE(PG8_SB(1, 0), b3, voffB);
            PG8_BAR; PG8_WAIT_L(0); PG8_MMA(0, 1, At, B1); PG8_BAR;
            PG8_LDA(At, 1, 1); PG8_STAGE(PG8_SA(1, 0), a3, voffA);
            PG8_BAR; PG8_WAIT_L(0); PG8_MMA(1, 0, At, B0); PG8_BAR; PG8_SCHED;
            PG8_STAGE(PG8_SB(1, 1), b3 + hstep, voffB);
            PG8_WAIT_V(6); PG8_BAR; PG8_MMA(1, 1, At, B1); PG8_BAR;
            }
        }
        if constexpr (ALIGN_EPI) { if (wr == 0) PG8_BAR; }
        if constexpr (!Epi::AFTER_DRAIN) { E(acc, cur, wr, wc, fr, fq); S.done(cur); }
        if (!has_next) break;
#pragma unroll
        for (int a = 0; a < 2; ++a)
#pragma unroll
            for (int b = 0; b < 2; ++b)
#pragma unroll
                for (int m = 0; m < 4; ++m)
#pragma unroll
                    for (int n = 0; n < 2; ++n) acc[a][b][m][n] = (f32x4){0.f, 0.f, 0.f, 0.f};
        cur = nxt; cA = nA; cB = nB; ++ui;
        if constexpr (ALIGN_EPI) { if (wr == 1) PG8_BAR; }
    }
    PG8_WAIT_V(0);
    if constexpr (!ALIGN_EPI) { if (wr == 0) PG8_BAR; }
    PG8_BAR;
    if constexpr (Epi::AFTER_DRAIN) { E.fused(acc, cur, wr, wc, fr, fq, lds, wid, lane); S.done(cur); }
#undef PG8_SA
#undef PG8_SB
#undef PG8_STAGE
#undef PG8_LDA
#undef PG8_LDB
#undef PG8_MMA
#undef PG8_WAIT_V
#undef PG8_WAIT_L
#undef PG8_BAR
#undef PG8_SCHED
}
}

DEV void transpose_item(float* scr, const float* W, int K, int N, int Npad, bf16_t* WT, int item, int lane) {
    const int nblk = Npad / 32, kb = item / nblk, nb = item % nblk, k0 = 64 * kb, n0 = 32 * nb;
    const bool valid = (n0 < N);
    float v[32];
#pragma unroll
    for (int i = 0; i < 32; ++i) { const int kk = 2 * i + (lane >> 5); v[i] = valid ? W[(size_t)(k0 + kk) * N + n0 + (lane & 31)] : 0.f; }
#pragma unroll
    for (int i = 0; i < 32; ++i) { const int kk = 2 * i + (lane >> 5); scr[kk * 33 + (lane & 31)] = v[i]; }
    asm volatile("s_waitcnt lgkmcnt(0)" ::: "memory");
    const int c = lane & 7;
#pragma unroll
    for (int j = 0; j < 4; ++j) { const int n = (lane >> 3) + 8 * j; const float* sp = scr + (8 * c) * 33 + n; float o[8];
#pragma unroll
        for (int e = 0; e < 8; ++e) o[e] = sp[e * 33];
        *(u32x4*)(WT + (size_t)(n0 + n) * K + k0 + 8 * c) = pack8(o); }
    asm volatile("s_waitcnt lgkmcnt(0)" ::: "memory");
}

DEV void mod_item(char* lds, const Params& p, int item) {
    const int layer = item / 96, n0 = (item % 96) * 32, tid = TID();
    float* s = (float*)lds;
    float* red = s + 9 * 1024;
    for (int i = tid; i < 9 * 1024; i += 512) { const int v = i >> 10, k = i & 1023; const float cv = (v < 8) ? p.c[v * 1024 + k] : p.c_ctx[k]; s[i] = silu(cv); }
    __syncthreads();
    const int kc = tid >> 5, n = tid & 31; const float* W = p.ada_w + (size_t)layer * DM * 3072 + n0 + n;
    float acc[9];
#pragma unroll
    for (int v = 0; v < 9; ++v) acc[v] = 0.f;
#pragma unroll 16
    for (int kk = 0; kk < 64; ++kk) { const int k = kc * 64 + kk; const float w = W[(size_t)k * 3072];
#pragma unroll
        for (int v = 0; v < 9; ++v) acc[v] += s[v * 1024 + k] * w; }
#pragma unroll
    for (int v = 0; v < 9; ++v) red[(kc * 9 + v) * 32 + n] = acc[v];
    __syncthreads();
    if (tid < 9 * 32) { const int v = tid >> 5, nn = tid & 31; float t = 0.f;
#pragma unroll
        for (int k2 = 0; k2 < 16; ++k2) t += red[(k2 * 9 + v) * 32 + nn];
        t += p.ada_b[layer * 3072 + n0 + nn];
        if (layer == 0) ((float*)(p.ws + WS_MOD0))[v * 3072 + n0 + nn] = t;
        else if (v < 8) ((float*)(p.ws + WS_MOD1))[v * 3072 + n0 + nn] = t; }
    __syncthreads();
}

DEV void hid2_row(char* lds, const Params& p, int t, int wid, int lane) {
    float* sc = (float*)lds + wid * 128;
    const float tn = (float)t * (1.0f / 4095.0f);
    const float w = (float)(2.0 * 3.14159265358979323846 / 4096.0) * (float)t;
    float e = 0.f;
    if (lane == 0) e = tn;
    else if (lane <= 32) { const int k = (lane - 1) & 15; const float band = 1e-4f + (float)k * ((15.0f - 1e-4f) / 15.0f); const float ang = w * band; e = (lane <= 16) ? cosf(ang) : -sinf(ang); }
    sc[lane] = e;
    asm volatile("s_waitcnt lgkmcnt(0)" ::: "memory");
    float a = p.f_b1[lane];
    for (int i = 0; i < 33; ++i) a += sc[i] * p.f_w1[i * 64 + lane];
    const float fr = p.freq[lane];
    const float h1 = sinf(fr * a);
    sc[64 + lane] = h1;
    asm volatile("s_waitcnt lgkmcnt(0)" ::: "memory");
    float a2 = p.f_b2[lane];
    for (int i = 0; i < 64; ++i) a2 += sc[64 + i] * p.f_w2[i * 64 + lane];
    const float h2 = sinf(fr * a2);
    ((bf16_t*)(p.ws + WS_HID2))[t * 64 + lane] = f2bf(h2);
    asm volatile("s_waitcnt lgkmcnt(0)" ::: "memory");
}

DEV void phase_prep(char* lds, const Params& p) {
    const int tid = TID(), wid = tid >> 6, lane = tid & 63;
    { const int gt = blockIdx.x * 512 + tid;
        if (gt < 2048) ((float*)(p.ws + WS_SSUM))[gt] = 0.f;
        float* rp = (float*)(p.ws + WS_ROPE);
        if (gt < 1024) { const int pos = gt >> 4, i = gt & 15; const float inv = exp2f(-(float)i * (13.287712379549449f / 16.0f)); const float ang = (float)pos * inv; rp[gt] = cosf(ang); rp[1024 + gt] = sinf(ang); }
        if (gt < 512) { const int pos = gt >> 3, i = gt & 7; const float inv = exp2f(-(float)i * (13.287712379549449f / 8.0f)); const float ang = (float)pos * inv; rp[2048 + gt] = cosf(ang); rp[2560 + gt] = sinf(ang); } }
    for (int it = blockIdx.x; it < 192; it += gridDim.x) mod_item(lds, p, it);
    for (int t = blockIdx.x * 8 + wid; t < 4096; t += gridDim.x * 8) hid2_row(lds, p, t, wid, lane);
    __syncthreads();
    constexpr int I_WIN = 16 * (AINP / 32), I_UQ = 4 * 24, I_UKV = 2 * 32, I_WO = 16 * 32, I_HIN = 16 * 128, I_HO = 16 * 32, I_W3 = 128;
    constexpr int NIT = I_WIN + I_UQ + I_UKV + I_WO + I_HIN + I_HO + I_W3;
    float* scr = (float*)lds + wid * (64 * 33);
    for (int it = blockIdx.x * 8 + wid; it < NIT; it += gridDim.x * 8) {
        int r = it;
        if (r < I_HIN) { transpose_item(scr, p.hy_w_in, 1024, 4096, 4096, (bf16_t*)(p.ws + WS_HWIN), r, lane); continue; } r -= I_HIN;
        if (r < I_WIN) { transpose_item(scr, p.w_in, 1024, AIN, AINP, (bf16_t*)(p.ws + WS_WIN), r, lane); continue; } r -= I_WIN;
        if (r < I_WO) { transpose_item(scr, p.w_out, 1024, 1024, 1024, (bf16_t*)(p.ws + WS_WOUT), r, lane); continue; } r -= I_WO;
        if (r < I_HO) { transpose_item(scr, p.hy_w_out, 1024, 1024, 1024, (bf16_t*)(p.ws + WS_HWOUT), r, lane); continue; } r -= I_HO;
        if (r < I_UQ) { transpose_item(scr, p.w_uq, 256, 768, 768, (bf16_t*)(p.ws + WS_WUQ), r, lane); continue; } r -= I_UQ;
        if (r < I_UKV) { transpose_item(scr, p.w_ukv, 128, 1024, 1024, (bf16_t*)(p.ws + WS_WUKV), r, lane); continue; } r -= I_UKV;
        transpose_item(scr, p.f_w3, 64, 4096, 4096, (bf16_t*)(p.ws + WS_W3), r, lane);
    }
}

DEV void row_load(f32x4 (&v)[4], const float* xr, int lane) {
#pragma unroll
    for (int j = 0; j < 4; ++j) v[j] = *(const f32x4*)(xr + lane * 4 + 256 * j);
}
DEV void modnorm_row(const f32x4 (&v)[4], const float* nw, const float* shift, const float* scale, bf16_t* orow, int lane) {
    float s = 0.f;
#pragma unroll
    for (int j = 0; j < 4; ++j) s += v[j].x * v[j].x + v[j].y * v[j].y + v[j].z * v[j].z + v[j].w * v[j].w;
    const float r = rsqrtf(wave_sum(s) * (1.0f / DM) + EPS);
#pragma unroll
    for (int j = 0; j < 4; ++j) { const int c0 = lane * 4 + 256 * j;
        const f32x4 w = *(const f32x4*)(nw + c0), sh = *(const f32x4*)(shift + c0), sc = *(const f32x4*)(scale + c0);
        const float o0 = v[j].x * r * w.x * (1.f + sc.x) + sh.x, o1 = v[j].y * r * w.y * (1.f + sc.y) + sh.y, o2 = v[j].z * r * w.z * (1.f + sc.z) + sh.z, o3 = v[j].w * r * w.w * (1.f + sc.w) + sh.w;
        u32x2 pk; pk.x = pk2(o0, o1); pk.y = pk2(o2, o3); *(u32x2*)(orow + c0) = pk; }
}
DEV const float* norm0_src(const Params& p, int row) { return row < NTOK ? p.x + (size_t)row * DM : p.ctx + (size_t)(row - NTOK) * DM; }
DEV void phase_norm0(const Params& p) {
    const int wid = TID() >> 6, lane = TID() & 63; const float* mod0 = (const float*)(p.ws + WS_MOD0); bf16_t* H0 = (bf16_t*)(p.ws + WS_H0);
    const int stride = gridDim.x * 8; int row = blockIdx.x * 8 + wid;
    f32x4 cur[4], nxt[4];
    if (row < NALL) row_load(cur, norm0_src(p, row), lane);
    for (; row < NALL; row += stride) {
        { const int rn = row + stride < NALL ? row + stride : row; row_load(nxt, norm0_src(p, rn), lane); }
        const int v = row < NTOK ? (row >> 12) : 8;
        modnorm_row(cur, p.norm_w, mod0 + v * 3072, mod0 + v * 3072 + 1024, H0 + (size_t)row * DM, lane);
#pragma unroll
        for (int j = 0; j < 4; ++j) cur[j] = nxt[j];
    }
}
DEV void phase_norm1(const Params& p) {
    const int wid = TID() >> 6, lane = TID() & 63; const float* mod1 = (const float*)(p.ws + WS_MOD1); bf16_t* H1 = (bf16_t*)(p.ws + WS_H1);
    const int stride = gridDim.x * 8; int row = blockIdx.x * 8 + wid;
    f32x4 cur[4], nxt[4];
    if (row < NTOK) row_load(cur, p.out + (size_t)row * DM, lane);
    for (; row < NTOK; row += stride) {
        { const int rn = row + stride < NTOK ? row + stride : row; row_load(nxt, p.out + (size_t)rn * DM, lane); }
        const int v = row >> 12;
        modnorm_row(cur, p.norm_w + DM, mod1 + v * 3072, mod1 + v * 3072 + 1024, H1 + (size_t)row * DM, lane);
#pragma unroll
        for (int j = 0; j < 4; ++j) cur[j] = nxt[j];
    }
}
DEV void phase_final(const Params& p) {
    const int wid = TID() >> 6, lane = TID() & 63;
    const int stride = gridDim.x * 8; int row = blockIdx.x * 8 + wid;
    f32x4 v[4], nxt[4];
    if (row < NTOK) row_load(v, p.out + (size_t)row * DM, lane);
    for (; row < NTOK; row += stride) {
        { const int rn = row + stride < NTOK ? row + stride : row; row_load(nxt, p.out + (size_t)rn * DM, lane); }
        float* xr = p.out + (size_t)row * DM; float s = 0.f;
#pragma unroll
        for (int j = 0; j < 4; ++j) s += v[j].x * v[j].x + v[j].y * v[j].y + v[j].z * v[j].z + v[j].w * v[j].w;
        const float r = rsqrtf(wave_sum(s) * (1.0f / DM) + EPS);
#pragma unroll
        for (int j = 0; j < 4; ++j) { const int c0 = lane * 4 + 256 * j; const f32x4 w = *(const f32x4*)(p.final_w + c0);
            f32x4 o; o.x = v[j].x * r * w.x; o.y = v[j].y * r * w.y; o.z = v[j].z * r * w.z; o.w = v[j].w * r * w.w; *(f32x4*)(xr + c0) = o; }
#pragma unroll
        for (int j = 0; j < 4; ++j) v[j] = nxt[j];
    }
}

struct PostIn { u32x4 raw[5]; f32x4 c64[2], s64[2], c32[2], s32[2]; };
DEV void post_load(PostIn& I, const bf16_t* PRAW, const float* rp, int tok, int lane) {
    const bf16_t* pr = PRAW + (size_t)tok * AINP;
#pragma unroll
    for (int sgm = 0; sgm < 4; ++sgm) I.raw[sgm] = *(const u32x4*)(pr + 512 * sgm + lane * 8);
    I.raw[4] = *(const u32x4*)(pr + 2048 + (lane & 31) * 8);
    const int l = tok & 4095, prow = l >> 6, pcol = l & 63;
    const int k = lane & 7, posv = (k < 4) ? prow : pcol; const float* t64 = rp + posv * 16 + (k & 1) * 8;
    I.c64[0] = *(const f32x4*)t64; I.c64[1] = *(const f32x4*)(t64 + 4); I.s64[0] = *(const f32x4*)(t64 + 1024); I.s64[1] = *(const f32x4*)(t64 + 1028);
    const int k3 = lane & 3, posm = (k3 < 2) ? prow : pcol; const float* t32 = rp + 2048 + posm * 8;
    I.c32[0] = *(const f32x4*)t32; I.c32[1] = *(const f32x4*)(t32 + 4); I.s32[0] = *(const f32x4*)(t32 + 512); I.s32[1] = *(const f32x4*)(t32 + 516);
}
DEV void phase_post(const Params& p) {
    const int wid = TID() >> 6, lane = TID() & 63;
    const bf16_t* PRAW = (const bf16_t*)(p.ws + WS_PRAW);
    bf16_t* QA = (bf16_t*)(p.ws + WS_QA); bf16_t* KA = (bf16_t*)(p.ws + WS_KA); bf16_t* VA = (bf16_t*)(p.ws + WS_VA);
    bf16_t* CQN = (bf16_t*)(p.ws + WS_CQN); bf16_t* CKVN = (bf16_t*)(p.ws + WS_CKVN); bf16_t* G = (bf16_t*)(p.ws + WS_G); bf16_t* KM = (bf16_t*)(p.ws + WS2_KM);
    const float* rp = (const float*)(p.ws + WS_ROPE);
    float wq[8], wk[8], wcq[8], wckv[8];
    { const int k = lane & 7;
#pragma unroll
        for (int j = 0; j < 8; ++j) { wq[j] = p.q_norm[k * 8 + j]; wk[j] = p.k_norm[k * 8 + j]; wcq[j] = p.cq_norm[(lane & 31) * 8 + j]; wckv[j] = p.ckv_norm[(lane & 15) * 8 + j]; } }
    const int stride = gridDim.x * 8;
    int tok = blockIdx.x * 8 + wid;
    PostIn cur, nxt;
    if (tok < NALL) post_load(cur, PRAW, rp, tok, lane);
    for (; tok < NALL; tok += stride) {
        { const int tn = tok + stride < NALL ? tok + stride : tok; post_load(nxt, PRAW, rp, tn, lane); }
        const bool lat = tok < NTOK; int b, pos;
        if (lat) { b = tok >> 12; pos = CTXL + (tok & 4095); } else { const int j = tok - NTOK; b = j >> 8; pos = j & 255; }
        const size_t kvrow = (size_t)b * LK + pos;
        const float cs64[8] = {cur.c64[0].x, cur.c64[0].y, cur.c64[0].z, cur.c64[0].w, cur.c64[1].x, cur.c64[1].y, cur.c64[1].z, cur.c64[1].w};
        const float sn64[8] = {cur.s64[0].x, cur.s64[0].y, cur.s64[0].z, cur.s64[0].w, cur.s64[1].x, cur.s64[1].y, cur.s64[1].z, cur.s64[1].w};
        float v[8], o[8];
        if (lat) {
            unpack8(cur.raw[0], v);
            float ss = 0.f;
#pragma unroll
            for (int j = 0; j < 8; ++j) ss += v[j] * v[j];
            ss += __shfl_xor(ss, 1); ss += __shfl_xor(ss, 2); ss += __shfl_xor(ss, 4);
            const float r = rsqrtf(ss * (1.0f / 64.0f) + EPS); const int k = lane & 7;
#pragma unroll
            for (int j = 0; j < 8; ++j) v[j] = v[j] * r * wq[j];
#pragma unroll
            for (int j = 0; j < 8; ++j) { const float ot = __shfl_xor(v[j], 2);
                o[j] = ((k & 2) ? (v[j] * cs64[j] + ot * sn64[j]) : (v[j] * cs64[j] - ot * sn64[j])) * QSC_A; }
            *(u32x4*)(QA + (size_t)tok * 512 + lane * 8) = pack8(o);
        }
        {
            const u32x4 raw = cur.raw[1]; unpack8(raw, v);
            float ss = 0.f;
#pragma unroll
            for (int j = 0; j < 8; ++j) ss += v[j] * v[j];
            ss += __shfl_xor(ss, 1); ss += __shfl_xor(ss, 2); ss += __shfl_xor(ss, 4);
            const float s8 = ss;
            ss += __shfl_xor(ss, 8); ss += __shfl_xor(ss, 16);
            const float s32 = ss;
            float vn[8]; const int k = lane & 7;
            { const float r = rsqrtf(s8 * (1.0f / 64.0f) + EPS);
#pragma unroll
                for (int j = 0; j < 8; ++j) vn[j] = v[j] * r * wk[j]; }
#pragma unroll
            for (int j = 0; j < 8; ++j) { const float ot = __shfl_xor(vn[j], 2);
                o[j] = lat ? ((k & 2) ? (vn[j] * cs64[j] + ot * sn64[j]) : (vn[j] * cs64[j] - ot * sn64[j])) : vn[j]; }
            if (lane < 16) *(u32x4*)(KA + kvrow * 128 + lane * 8) = pack8(o);
            else if (lane < 32) *(u32x4*)(VA + kvrow * 128 + (lane - 16) * 8) = raw;
            else if (lat) { const float r = rsqrtf(s32 * (1.0f / 256.0f) + EPS); const int cb = (lane - 32) * 8;
#pragma unroll
                for (int j = 0; j < 8; ++j) o[j] = v[j] * r * wcq[j];
                *(u32x4*)(CQN + (size_t)tok * 256 + cb) = pack8(o); }
        }
        {
            unpack8(cur.raw[2], v);
            float ss = 0.f;
#pragma unroll
            for (int j = 0; j < 8; ++j) ss += v[j] * v[j];
            ss += __shfl_xor(ss, 1); ss += __shfl_xor(ss, 2); ss += __shfl_xor(ss, 4); ss += __shfl_xor(ss, 8);
            const int k = lane & 3;
            float oth[8];
#pragma unroll
            for (int j = 0; j < 8; ++j) oth[j] = __shfl_xor(v[j], 1);
            if (lane < 16) { const float r = rsqrtf(ss * (1.0f / 128.0f) + EPS);
#pragma unroll
                for (int j = 0; j < 8; ++j) o[j] = v[j] * r * wckv[j];
                *(u32x4*)(CKVN + kvrow * 128 + lane * 8) = pack8(o); }
            else if (lane < 20) {
                const float cs32[8] = {cur.c32[0].x, cur.c32[0].y, cur.c32[0].z, cur.c32[0].w, cur.c32[1].x, cur.c32[1].y, cur.c32[1].z, cur.c32[1].w};
                const float sn32[8] = {cur.s32[0].x, cur.s32[0].y, cur.s32[0].z, cur.s32[0].w, cur.s32[1].x, cur.s32[1].y, cur.s32[1].z, cur.s32[1].w};
#pragma unroll
                for (int j = 0; j < 8; ++j) o[j] = lat ? ((k & 1) ? (v[j] * cs32[j] + oth[j] * sn32[j]) : (v[j] * cs32[j] - oth[j] * sn32[j])) : v[j];
                const u32x4 w = pack8(o);
#pragma unroll
                for (int h = 0; h < 8; ++h) *(u32x4*)(KM + kvrow * 768 + h * 96 + 64 + k * 8) = w; }
            else if (lat) {
#pragma unroll
                for (int j = 0; j < 8; ++j) o[j] = silu(v[j]);
                *(u32x4*)(G + (size_t)tok * 1024 + (lane - 20) * 8) = pack8(o); }
        }
        if (lat) {
            unpack8(cur.raw[3], v);
#pragma unroll
            for (int j = 0; j < 8; ++j) o[j] = silu(v[j]);
            *(u32x4*)(G + (size_t)tok * 1024 + 352 + lane * 8) = pack8(o);
            if (lane < 20) { unpack8(cur.raw[4], v);
#pragma unroll
                for (int j = 0; j < 8; ++j) o[j] = silu(v[j]);
                *(u32x4*)(G + (size_t)tok * 1024 + 864 + lane * 8) = pack8(o); }
        }
        cur = nxt;
    }
}

template <int DQK>
DEV void attn_unit(char* lds, const bf16_t* __restrict__ Q, int ldq, int qcol, const bf16_t* __restrict__ Kp, int ldk, int kcol, const bf16_t* __restrict__ Vp, int ldv, int vcol,
                   const bf16_t* __restrict__ Gt, bf16_t* OG, int ocol, int b, int q0) {
    constexpr int KRS = (DQK + 8) * 2, KB = 64 * KRS, VRS = 192, VB = 64 * VRS, STG = KB + VB, NKS = DQK / 16, KCH = DQK / 8;
    const int tid = TID(), lane = tid & 63, wid = tid >> 6, l31 = lane & 31, hi = lane >> 5;
    bf16x8 qf[NKS];
    { const bf16_t* qp = Q + (size_t)(b * SEQ + q0 + wid * 32 + l31) * ldq + qcol + hi * 8;
#pragma unroll
        for (int ks = 0; ks < NKS; ++ks) qf[ks] = *(const bf16x8*)(qp + ks * 16); }
    const bf16_t* kbase = Kp + (size_t)b * LK * ldk + kcol; const bf16_t* vbase = Vp + (size_t)b * LK * ldv + vcol;
    const int kr0 = tid / KCH, kc0 = tid % KCH;
    const int kr1 = (tid + 512) / KCH, kc1 = (tid + 512) % KCH;
    const bool k2 = (KCH * 64 > 512) && (tid + 512 < KCH * 64);
    const int vr = tid >> 3, vc = tid & 7;
    u32x4 sk0, sk1, sv;
#define A_LOAD(t) do { const size_t kp_ = (size_t)(t) * 64; sk0 = *(const u32x4*)(kbase + (kp_ + kr0) * ldk + kc0 * 8); \
        if (k2) sk1 = *(const u32x4*)(kbase + (kp_ + kr1) * ldk + kc1 * 8); sv = *(const u32x4*)(vbase + (kp_ + vr) * ldv + vc * 8); } while (0)
#define A_STORE(buf) do { char* b_ = lds + (buf) * STG; *(u32x4*)(b_ + kr0 * KRS + kc0 * 16) = sk0; if (k2) *(u32x4*)(b_ + kr1 * KRS + kc1 * 16) = sk1; \
        *(u32x4*)(b_ + KB + vr * VRS + vc * 16) = sv; } while (0)
    f32x16 o0, o1;
#pragma unroll
    for (int r = 0; r < 16; ++r) { o0[r] = 0.f; o1[r] = 0.f; }
    float m_run = -1e30f, l_run = 0.f;
    const int g1 = (lane >> 4) & 1, tq = (lane & 15) >> 2, tp = lane & 3;
    const int vt_off = KB + (4 * hi + tq) * VRS + (16 * g1 + 4 * tp) * 2;
    const int kf_off = l31 * KRS + hi * 16;
    constexpr int NT = LK / 64;
    A_LOAD(0); A_STORE(0);
    __syncthreads();
    for (int t = 0; t < NT; ++t) {
        const bool more = (t + 1 < NT);
        if (more) A_LOAD(t + 1);
        const char* b_ = lds + (t & 1) * STG;
        f32x16 p0, p1;
#pragma unroll
        for (int r = 0; r < 16; ++r) { p0[r] = 0.f; p1[r] = 0.f; }
#pragma unroll
        for (int ks = 0; ks < NKS; ++ks) {
            const bf16x8 ka = *(const bf16x8*)(b_ + kf_off + ks * 32);
            const bf16x8 kb = *(const bf16x8*)(b_ + kf_off + 32 * KRS + ks * 32);
            p0 = __builtin_amdgcn_mfma_f32_32x32x16_bf16(ka, qf[ks], p0, 0, 0, 0);
            p1 = __builtin_amdgcn_mfma_f32_32x32x16_bf16(kb, qf[ks], p1, 0, 0, 0);
        }
        float mx = p0[0];
#pragma unroll
        for (int r = 1; r < 16; ++r) mx = fmaxf(mx, p0[r]);
#pragma unroll
        for (int r = 0; r < 16; ++r) mx = fmaxf(mx, p1[r]);
        mx = fmaxf(mx, __shfl_xor(mx, 32));
        const float m_new = fmaxf(m_run, mx);
        const float alpha = __builtin_amdgcn_exp2f(m_run - m_new);
        m_run = m_new;
        float ls = 0.f;
#pragma unroll
        for (int r = 0; r < 16; ++r) { p0[r] = __builtin_amdgcn_exp2f(p0[r] - m_new); p1[r] = __builtin_amdgcn_exp2f(p1[r] - m_new); ls += p0[r] + p1[r]; }
        l_run = l_run * alpha + ls;
#pragma unroll
        for (int r = 0; r < 16; ++r) { o0[r] *= alpha; o1[r] *= alpha; }
        u32x4 pw[4];
        pw[0] = (u32x4){pk2(p0[0], p0[1]), pk2(p0[2], p0[3]), pk2(p0[4], p0[5]), pk2(p0[6], p0[7])};
        pw[1] = (u32x4){pk2(p0[8], p0[9]), pk2(p0[10], p0[11]), pk2(p0[12], p0[13]), pk2(p0[14], p0[15])};
        pw[2] = (u32x4){pk2(p1[0], p1[1]), pk2(p1[2], p1[3]), pk2(p1[4], p1[5]), pk2(p1[6], p1[7])};
        pw[3] = (u32x4){pk2(p1[8], p1[9]), pk2(p1[10], p1[11]), pk2(p1[12], p1[13]), pk2(p1[14], p1[15])};
#pragma unroll
        for (int s = 0; s < 4; ++s) {
            const bf16x8 pb = __builtin_bit_cast(bf16x8, pw[s]);
#pragma unroll
            for (int dt = 0; dt < 2; ++dt) {
                const char* vp = b_ + vt_off + s * 16 * VRS + dt * 64;
                const s16x4 lo = __builtin_bit_cast(s16x4, __builtin_amdgcn_ds_read_tr16_b64_v4i16((LAS s16x4*)vp));
                const s16x4 hh = __builtin_bit_cast(s16x4, __builtin_amdgcn_ds_read_tr16_b64_v4i16((LAS s16x4*)(vp + 8 * VRS)));
                const bf16x8 vf = (bf16x8){lo[0], lo[1], lo[2], lo[3], hh[0], hh[1], hh[2], hh[3]};
                if (dt == 0) o0 = __builtin_amdgcn_mfma_f32_32x32x16_bf16(vf, pb, o0, 0, 0, 0);
                else o1 = __builtin_amdgcn_mfma_f32_32x32x16_bf16(vf, pb, o1, 0, 0, 0);
            }
        }
        if (more) A_STORE((t + 1) & 1);
        __syncthreads();
    }
#undef A_LOAD
#undef A_STORE
    const float lt = l_run + __shfl_xor(l_run, 32); const float inv = 1.0f / lt;
    const size_t tok = (size_t)(b * SEQ + q0 + wid * 32 + l31);
#pragma unroll
    for (int dt = 0; dt < 2; ++dt)
#pragma unroll
        for (int g = 0; g < 4; ++g) { const int d = 32 * dt + 8 * g + 4 * hi; const size_t off = tok * 1024 + ocol + d;
            const u32x2 gw = *(const u32x2*)(Gt + off);
            const f32x16& oo = dt ? o1 : o0;
            u32x2 w; w.x = pk2(oo[4 * g] * inv * lo_bf(gw.x), oo[4 * g + 1] * inv * hi_bf(gw.x)); w.y = pk2(oo[4 * g + 2] * inv * lo_bf(gw.y), oo[4 * g + 3] * inv * hi_bf(gw.y));
            *(u32x2*)(OG + off) = w; }
}

DEV float max3f_s(float a, float b, float c) { float r; asm("v_max3_f32 %0, %1, %2, %3" : "=v"(r) : "v"(a), "v"(b), "v"(c)); return r; }
DEV float max2f_s(float a, float b) { float r; asm("v_max_f32_e32 %0, %1, %2" : "=v"(r) : "v"(a), "v"(b)); return r; }
DEV float fadd_s(float a, float b) { float r; asm("v_add_f32_e32 %0, %1, %2" : "=v"(r) : "v"(a), "v"(b)); return r; }
DEV float swapmax32(float v) { auto rr = __builtin_amdgcn_permlane32_swap(__float_as_uint(v), __float_as_uint(v), false, false); return fmaxf(__uint_as_float(rr[0]), __uint_as_float(rr[1])); }
DEV float swapsum32(float v) { auto rr = __builtin_amdgcn_permlane32_swap(__float_as_uint(v), __float_as_uint(v), false, false); return __uint_as_float(rr[0]) + __uint_as_float(rr[1]); }
template <int DQK>
DEV void attn_unit2(char* lds, const bf16_t* __restrict__ Q, int ldq, int qcol, const bf16_t* __restrict__ Kp, int ldk, int kcol, const bf16_t* __restrict__ Vp, int ldv, int vcol,
                    const bf16_t* __restrict__ Gt, bf16_t* OG, int ocol, int b, int q0) {
    constexpr int KRS = (DQK + 8) * 2, KB = 64 * KRS, VRS = 192, VB = 64 * VRS, NKS = DQK / 16, KCH = DQK / 8, VOFF = 2 * KB;
    constexpr float THR = 8.0f;
    constexpr int NT = LK / 64;
    const int tid = TID(), lane = tid & 63, wid = tid >> 6, l31 = lane & 31, hi = lane >> 5;
    bf16x8 qf[NKS];
    { const bf16_t* qp = Q + (size_t)(b * SEQ + q0 + wid * 32 + l31) * ldq + qcol + hi * 8;
#pragma unroll
        for (int ks = 0; ks < NKS; ++ks) qf[ks] = *(const bf16x8*)(qp + ks * 16); }
    const bf16_t* kbase = Kp + (size_t)b * LK * ldk + kcol; const bf16_t* vbase = Vp + (size_t)b * LK * ldv + vcol;
    constexpr bool K2 = (KCH * 64 > 512);
    const bool k2 = K2 && (tid + 512 < KCH * 64);
    const int kr0 = tid / KCH, kc0 = tid % KCH, kr1 = k2 ? (tid + 512) / KCH : kr0, kc1 = k2 ? (tid + 512) % KCH : kc0;
    const int vr = tid >> 3, vc = tid & 7;
    u32x4 skX0, skX1 = {0u, 0u, 0u, 0u}, svX;
#define A_LOADK(t, S) do { const int tt_ = (t) < NT ? (t) : NT - 1; const size_t kp_ = (size_t)tt_ * 64; sk##S##0 = *(const u32x4*)(kbase + (kp_ + kr0) * ldk + kc0 * 8); if (K2) sk##S##1 = *(const u32x4*)(kbase + (kp_ + kr1) * ldk + kc1 * 8); } while (0)
#define A_LOADV(t, S) do { const int tt_ = (t) < NT ? (t) : NT - 1; sv##S = *(const u32x4*)(vbase + ((size_t)tt_ * 64 + vr) * ldv + vc * 8); } while (0)
#define A_STOREK(slot, S) do { char* b_ = lds + (slot) * KB; *(u32x4*)(b_ + kr0 * KRS + kc0 * 16) = sk##S##0; if (K2) *(u32x4*)(b_ + kr1 * KRS + kc1 * 16) = sk##S##1; } while (0)
#define A_STOREV(slot, S) do { *(u32x4*)(lds + VOFF + (slot) * VB + vr * VRS + vc * 16) = sv##S; } while (0)
    f32x16 o0, o1, negm;
#pragma unroll
    for (int r = 0; r < 16; ++r) { o0[r] = 0.f; o1[r] = 0.f; negm[r] = 0.f; }
    asm volatile("" : "+v"(negm));
    float mhat = 0.f, l_run = 0.f;
    const int g1 = (lane >> 4) & 1, tq = (lane & 15) >> 2, tp = lane & 3;
    const int vt_off = VOFF + (4 * hi + tq) * VRS + (16 * g1 + 4 * tp) * 2;
    const int kf_off = l31 * KRS + hi * 16;
#define A_QK(P0, P1, slot) do { const char* kb_ = lds + (slot) * KB + kf_off; \
        _Pragma("unroll") for (int ks = 0; ks < NKS; ++ks) { \
            const bf16x8 ka = *(const bf16x8*)(kb_ + ks * 32); const bf16x8 kb2 = *(const bf16x8*)(kb_ + 32 * KRS + ks * 32); \
            if (ks == 0) { P0 = __builtin_amdgcn_mfma_f32_32x32x16_bf16(ka, qf[0], negm, 0, 0, 0); P1 = __builtin_amdgcn_mfma_f32_32x32x16_bf16(kb2, qf[0], negm, 0, 0, 0); } \
            else { P0 = __builtin_amdgcn_mfma_f32_32x32x16_bf16(ka, qf[ks], P0, 0, 0, 0); P1 = __builtin_amdgcn_mfma_f32_32x32x16_bf16(kb2, qf[ks], P1, 0, 0, 0); } } } while (0)
    A_LOADK(0, X); A_LOADV(0, X); A_STOREK(0, X); A_STOREV(0, X); A_LOADK(1, X); A_STOREK(1, X);
    __syncthreads();
    f32x16 pA0, pA1, pB0, pB1;
#pragma unroll
    for (int r = 0; r < 16; ++r) { pB0[r] = 0.f; pB1[r] = 0.f; }
    A_QK(pA0, pA1, 0);
#define A_STEP(P0, P1, N0, N1, t, SL, SS) do { \
        A_LOADK((t) + 2, SL); A_LOADV((t) + 1, SL); \
        A_QK(N0, N1, ((t) + 1) & 1); \
        float a_ = fmaxf(fmaxf(P0[0], P0[1]), P1[0]), c_ = fmaxf(fmaxf(P0[2], P0[3]), P1[1]); a_ = fmaxf(fmaxf(a_, P1[2]), P1[3]); \
        _Pragma("unroll") for (int r = 4; r < 16; r += 4) { a_ = fmaxf(fmaxf(a_, P0[r]), P0[r + 1]); c_ = fmaxf(fmaxf(c_, P0[r + 2]), P0[r + 3]); a_ = fmaxf(fmaxf(a_, P1[r]), P1[r + 1]); c_ = fmaxf(fmaxf(c_, P1[r + 2]), P1[r + 3]); } \
        const float rm = swapmax32(fmaxf(a_, c_)); \
        if ((t) == 0 || __any(rm > THR)) { \
            const float dl = ((t) == 0) ? rm : fmaxf(rm, 0.f); mhat += dl; \
            _Pragma("unroll") for (int r = 0; r < 16; ++r) { P0[r] -= dl; P1[r] -= dl; N0[r] -= dl; N1[r] -= dl; } \
            if ((t) != 0) { const float f = __builtin_amdgcn_exp2f(-dl); l_run *= f; _Pragma("unroll") for (int r = 0; r < 16; ++r) { o0[r] *= f; o1[r] *= f; } } \
            _Pragma("unroll") for (int r = 0; r < 16; ++r) negm[r] = -mhat; asm volatile("" : "+v"(negm)); } \
        float ls = 0.f; \
        _Pragma("unroll") for (int r = 0; r < 16; ++r) { P0[r] = __builtin_amdgcn_exp2f(P0[r]); P1[r] = __builtin_amdgcn_exp2f(P1[r]); ls += P0[r] + P1[r]; } \
        l_run += ls; \
        u32x4 pw[4]; \
        pw[0] = (u32x4){pk2(P0[0], P0[1]), pk2(P0[2], P0[3]), pk2(P0[4], P0[5]), pk2(P0[6], P0[7])}; \
        pw[1] = (u32x4){pk2(P0[8], P0[9]), pk2(P0[10], P0[11]), pk2(P0[12], P0[13]), pk2(P0[14], P0[15])}; \
        pw[2] = (u32x4){pk2(P1[0], P1[1]), pk2(P1[2], P1[3]), pk2(P1[4], P1[5]), pk2(P1[6], P1[7])}; \
        pw[3] = (u32x4){pk2(P1[8], P1[9]), pk2(P1[10], P1[11]), pk2(P1[12], P1[13]), pk2(P1[14], P1[15])}; \
        { const char* vb_ = lds + ((t) & 1) * VB + vt_off; \
        _Pragma("unroll") for (int s = 0; s < 4; ++s) { const bf16x8 pb = __builtin_bit_cast(bf16x8, pw[s]); \
            _Pragma("unroll") for (int dt = 0; dt < 2; ++dt) { const char* vp = vb_ + s * 16 * VRS + dt * 64; \
                const s16x4 lo = __builtin_bit_cast(s16x4, __builtin_amdgcn_ds_read_tr16_b64_v4i16((LAS s16x4*)vp)); \
                const s16x4 hh = __builtin_bit_cast(s16x4, __builtin_amdgcn_ds_read_tr16_b64_v4i16((LAS s16x4*)(vp + 8 * VRS))); \
                const bf16x8 vf = (bf16x8){lo[0], lo[1], lo[2], lo[3], hh[0], hh[1], hh[2], hh[3]}; \
                if (dt == 0) o0 = __builtin_amdgcn_mfma_f32_32x32x16_bf16(vf, pb, o0, 0, 0, 0); else o1 = __builtin_amdgcn_mfma_f32_32x32x16_bf16(vf, pb, o1, 0, 0, 0); } } } \
        A_STOREK((t) & 1, SS); A_STOREV(((t) + 1) & 1, SS); \
        __syncthreads(); } while (0)
    for (int t = 0; t < NT; t += 2) {
        A_STEP(pA0, pA1, pB0, pB1, t, X, X);
        A_STEP(pB0, pB1, pA0, pA1, t + 1, X, X);
    }
#undef A_STEP
#undef A_QK
#undef A_LOADK
#undef A_LOADV
#undef A_STOREK
#undef A_STOREV
    const float inv = 1.0f / swapsum32(l_run);
    const size_t tok = (size_t)(b * SEQ + q0 + wid * 32 + l31);
#pragma unroll
    for (int dt = 0; dt < 2; ++dt)
#pragma unroll
        for (int g = 0; g < 4; ++g) { const int d = 32 * dt + 8 * g + 4 * hi; const size_t off = tok * 1024 + ocol + d;
            const u32x2 gw = *(const u32x2*)(Gt + off);
            const f32x16& oo = dt ? o1 : o0;
            u32x2 w; w.x = pk2(oo[4 * g] * inv * lo_bf(gw.x), oo[4 * g + 1] * inv * hi_bf(gw.x)); w.y = pk2(oo[4 * g + 2] * inv * lo_bf(gw.y), oo[4 * g + 3] * inv * hi_bf(gw.y));
            *(u32x2*)(OG + off) = w; }
}

DEV void phase_attn(char* lds, const Params& p) {
    const bf16_t* QA = (const bf16_t*)(p.ws + WS_QA); const bf16_t* KA = (const bf16_t*)(p.ws + WS_KA); const bf16_t* VA = (const bf16_t*)(p.ws + WS_VA);
    const bf16_t* QM = (const bf16_t*)(p.ws + WS_QM); const bf16_t* KM = (const bf16_t*)(p.ws + WS2_KM); const bf16_t* VM = (const bf16_t*)(p.ws + WS2_VM);
    const bf16_t* G = (const bf16_t*)(p.ws + WS_G); bf16_t* OG = (bf16_t*)(p.ws + WS2_OG);
    for (int u = blockIdx.x; u < 2048; u += gridDim.x) {
        const int type = u >> 10, rem = u & 1023, b = rem >> 7, h = (rem >> 4) & 7, qb = rem & 15;
        if (type == 0) attn_unit2<64>(lds, QA, 512, h * 64, KA, 128, (h >> 2) * 64, VA, 128, (h >> 2) * 64, G, OG, h * 64, b, qb * 256);
        else attn_unit2<96>(lds, QM, 768, h * 96, KM, 768, h * 96, VM, 512, h * 64, G, OG, 512 + h * 64, b, qb * 256);
    }
}

constexpr int CV_PADL = 192, CV_ROW = 4488, CV_RS = CV_ROW * 2;
constexpr int CV_UB = 8 * CV_RS;
constexpr int CV_FS = 16416;
DEV void conv_load_filter(char* lds, const bf16_t* gr) {
    const int tid = TID();
#pragma unroll
    for (int rnd = 0; rnd < 2; ++rnd) {
        const int ch = tid + rnd * 512;
        const u32x4 a = *(const u32x4*)(gr + ch * 8);
        u32x4 bq = {0u, 0u, 0u, 0u}; if (ch + 1 < 1024) bq = *(const u32x4*)(gr + ch * 8 + 8);
        const unsigned w[8] = {a.x, a.y, a.z, a.w, bq.x, bq.y, bq.z, bq.w};
        char* f = lds + CV_UB + ch * 16;
        *(u32x4*)(f) = a;
        u32x4 c1, c2, c3;
        c1.x = __builtin_amdgcn_alignbit(w[1], w[0], 16); c1.y = __builtin_amdgcn_alignbit(w[2], w[1], 16); c1.z = __builtin_amdgcn_alignbit(w[3], w[2], 16); c1.w = __builtin_amdgcn_alignbit(w[4], w[3], 16);
        c2 = (u32x4){w[1], w[2], w[3], w[4]};
        c3.x = __builtin_amdgcn_alignbit(w[2], w[1], 16); c3.y = __builtin_amdgcn_alignbit(w[3], w[2], 16); c3.z = __builtin_amdgcn_alignbit(w[4], w[3], 16); c3.w = __builtin_amdgcn_alignbit(w[5], w[4], 16);
        *(u32x4*)(f + CV_FS) = c1; *(u32x4*)(f + 2 * CV_FS) = c2; *(u32x4*)(f + 3 * CV_FS) = c3;
    }
}
DEV void sconv4(const bf16_t* px, int t, float w0, float w1, float w2, float bias, float* u) {
    const u32x2 mid = *(const u32x2*)(px + t);
    const float pm = (t > 0) ? bf2f(px[t - 1]) : 0.f, pp = (t + 4 < SEQ) ? bf2f(px[t + 4]) : 0.f;
    const float q0 = lo_bf(mid.x), q1 = hi_bf(mid.x), q2 = lo_bf(mid.y), q3 = hi_bf(mid.y);
    u[0] = w0 * pm + w1 * q0 + w2 * q1 + bias; u[1] = w0 * q0 + w1 * q1 + w2 * q2 + bias; u[2] = w0 * q1 + w1 * q2 + w2 * q3 + bias; u[3] = w0 * q2 + w1 * q3 + w2 * pp + bias;
}
template <bool V0, bool V1>
DEV void conv_step(const char* lds, f32x16 (&acc)[2][2], const int (&a_off)[2], const int (&b_off)[2], int d) {
    bf16x8 fa[2][4];
#pragma unroll
    for (int mt = 0; mt < 2; ++mt)
#pragma unroll
        for (int ks = 0; ks < 4; ++ks) { const char* ap = lds + a_off[mt] - 128 * d + ks * 32;
            const u32x2 lo = *(const u32x2*)ap, hh = *(const u32x2*)(ap + 8);
            fa[mt][ks] = __builtin_bit_cast(bf16x8, (u32x4){lo.x, lo.y, hh.x, hh.y}); }
#pragma unroll
    for (int n = 0; n < 2; ++n) {
        if ((n == 0 && V0) || (n == 1 && V1)) {
#pragma unroll
            for (int ks = 0; ks < 4; ++ks) { const bf16x8 fb = *(const bf16x8*)(lds + b_off[n] - 128 * d + ks * 32);
#pragma unroll
                for (int mt = 0; mt < 2; ++mt) acc[n][mt] = __builtin_amdgcn_mfma_f32_32x32x16_bf16(fa[mt][ks], fb, acc[n][mt], 0, 0, 0); }
        }
    }
}
struct ConvFrags { bf16x8 a[6], b0[4], b1[4]; };
DEV void conv_load_frags(ConvFrags& F, const char* lds, int a_off0, int a_off0h, int b_off0, int b_off1, int d) {
#pragma unroll
    for (int j = 0; j < 6; ++j) { const u32x2 lo = *(const u32x2*)(lds + a_off0 - 128 * d + (j - 2) * 32), hh = *(const u32x2*)(lds + a_off0h - 128 * d + (j - 2) * 32);
        F.a[j] = __builtin_bit_cast(bf16x8, (u32x4){lo.x, lo.y, hh.x, hh.y}); }
#pragma unroll
    for (int ks = 0; ks < 4; ++ks) { F.b0[ks] = *(const bf16x8*)(lds + b_off0 - 128 * d + ks * 32); F.b1[ks] = *(const bf16x8*)(lds + b_off1 - 128 * d + ks * 32); }
}
DEV void conv_mfma_frags(const ConvFrags& F, f32x16 (&acc)[2][2]) {
#pragma unroll
    for (int ks = 0; ks < 4; ++ks) {
        acc[0][0] = __builtin_amdgcn_mfma_f32_32x32x16_bf16(F.a[ks + 2], F.b0[ks], acc[0][0], 0, 0, 0);
        acc[0][1] = __builtin_amdgcn_mfma_f32_32x32x16_bf16(F.a[ks], F.b0[ks], acc[0][1], 0, 0, 0);
        acc[1][0] = __builtin_amdgcn_mfma_f32_32x32x16_bf16(F.a[ks + 2], F.b1[ks], acc[1][0], 0, 0, 0);
        acc[1][1] = __builtin_amdgcn_mfma_f32_32x32x16_bf16(F.a[ks], F.b1[ks], acc[1][1], 0, 0, 0);
    }
}
DEV void conv_mfma_loop(const char* lds, f32x16 (&acc)[2][2], int wid, int lane) {
    const int l31 = lane & 31, hi = lane >> 5;
#pragma unroll
    for (int a = 0; a < 2; ++a)
#pragma unroll
        for (int b = 0; b < 2; ++b)
#pragma unroll
            for (int r = 0; r < 16; ++r) acc[a][b][r] = 0.f;
    int a_off[2];
#pragma unroll
    for (int mt = 0; mt < 2; ++mt) { const int r = l31 + 32 * mt, q = (4 - (r & 3)) & 3; a_off[mt] = CV_UB + q * CV_FS + (4096 - r - q + 8 * hi) * 2; }
    int b_off[2];
#pragma unroll
    for (int n = 0; n < 2; ++n) { const int nt = 2 * wid + n; b_off[n] = (l31 & 7) * CV_RS + (CV_PADL + 64 * (4 * nt + (l31 >> 3)) + 8 * hi) * 2; }
    const int dlo = 8 * wid - 63;
#pragma unroll
    for (int j = 0; j < 4; ++j) conv_step<true, false>(lds, acc, a_off, b_off, dlo + j);
    ConvFrags F0, F1; const int d0 = dlo + 4; int a_hi = a_off[0] + 8; asm volatile("" : "+v"(a_hi));
    conv_load_frags(F0, lds, a_off[0], a_hi, b_off[0], b_off[1], d0);
#pragma unroll 1
    for (int j = 0; j < 31; ++j) { const int d = d0 + 2 * j;
        conv_load_frags(F1, lds, a_off[0], a_hi, b_off[0], b_off[1], d + 1); __builtin_amdgcn_sched_barrier(0);
        conv_mfma_frags(F0, acc); __builtin_amdgcn_sched_barrier(0);
        conv_load_frags(F0, lds, a_off[0], a_hi, b_off[0], b_off[1], d + 2); __builtin_amdgcn_sched_barrier(0);
        conv_mfma_frags(F1, acc); __builtin_amdgcn_sched_barrier(0); }
    conv_mfma_frags(F0, acc);
#pragma unroll
    for (int j = 0; j < 4; ++j) conv_step<false, true>(lds, acc, a_off, b_off, dlo + 67 + j);
}
DEV void conv_unit(char* lds, const Params& p, int c) {
    const int tid = TID(), lane = tid & 63, wid = tid >> 6, l31 = lane & 31, hi = lane >> 5;
    const bf16_t* PT = (const bf16_t*)(p.ws + WS_PT); const bf16_t* GR = (const bf16_t*)(p.ws + WS_GR); const float* ssum = (const float*)(p.ws + WS_SSUM);
    bf16_t* OG2 = (bf16_t*)(p.ws + WS_OG2);
    for (int i = tid; i < 8 * 98; i += 512) { const int b = i / 98, j = i % 98;
        const int e = (j < 48) ? j * 4 : (CV_PADL + SEQ + (j - 48) * 4); *(u32x2*)(lds + b * CV_RS + e * 2) = (u32x2){0u, 0u}; }
    { const float w0 = p.conv_w[c], w1 = p.conv_w[3072 + c], w2 = p.conv_w[6144 + c], bias = p.conv_b[c];
        for (int i = tid; i < 8 * 1024; i += 512) { const int b = i >> 10, t = (i & 1023) * 4; float u[4];
            sconv4(PT + ((size_t)(b * 4096 + c)) * 4096, t, w0, w1, w2, bias, u);
            u32x2 w; w.x = pk2(u[0], u[1]); w.y = pk2(u[2], u[3]); *(u32x2*)(lds + b * CV_RS + (CV_PADL + t) * 2) = w; } }
    conv_load_filter(lds, GR + (size_t)c * 8192);
    __syncthreads();
    f32x16 acc[2][2];
    conv_mfma_loop(lds, acc, wid, lane);
    __syncthreads();
    { const float invs = 1.0f / ssum[c], sk = p.skip[c];
        const float w0 = p.conv_w[1024 + c], w1 = p.conv_w[3072 + 1024 + c], w2 = p.conv_w[6144 + 1024 + c], bias = p.conv_b[1024 + c];
        const int b = l31 & 7;
#pragma unroll
        for (int n = 0; n < 2; ++n) { const int i = 4 * (2 * wid + n) + (l31 >> 3);
#pragma unroll
            for (int mt = 0; mt < 2; ++mt)
#pragma unroll
                for (int g = 0; g < 4; ++g) { const int t = 64 * i + 32 * mt + 8 * g + 4 * hi; float x1[4];
                    sconv4(PT + ((size_t)(b * 4096 + 1024 + c)) * 4096, t, w0, w1, w2, bias, x1);
                    char* up = lds + b * CV_RS + (CV_PADL + t) * 2; const u32x2 vw = *(const u32x2*)up;
                    const float z0 = x1[0] * (acc[n][mt][4 * g] * invs + sk * lo_bf(vw.x)), z1 = x1[1] * (acc[n][mt][4 * g + 1] * invs + sk * hi_bf(vw.x));
                    const float z2 = x1[2] * (acc[n][mt][4 * g + 2] * invs + sk * lo_bf(vw.y)), z3 = x1[3] * (acc[n][mt][4 * g + 3] * invs + sk * hi_bf(vw.y));
                    u32x2 w; w.x = pk2(z0, z1); w.y = pk2(z2, z3); *(u32x2*)up = w; } } }
    conv_load_filter(lds, GR + (size_t)(1024 + c) * 8192);
    __syncthreads();
    conv_mfma_loop(lds, acc, wid, lane);
    { const float invs = 1.0f / ssum[1024 + c], sk = p.skip[1024 + c];
        const float w0 = p.conv_w[2048 + c], w1 = p.conv_w[3072 + 2048 + c], w2 = p.conv_w[6144 + 2048 + c], bias = p.conv_b[2048 + c];
        const int b = l31 & 7;
#pragma unroll
        for (int n = 0; n < 2; ++n) { const int i = 4 * (2 * wid + n) + (l31 >> 3);
#pragma unroll
            for (int mt = 0; mt < 2; ++mt)
#pragma unroll
                for (int g = 0; g < 4; ++g) { const int t = 64 * i + 32 * mt + 8 * g + 4 * hi; float x2[4];
                    sconv4(PT + ((size_t)(b * 4096 + 2048 + c)) * 4096, t, w0, w1, w2, bias, x2);
                    const u32x2 zw = *(const u32x2*)(lds + b * CV_RS + (CV_PADL + t) * 2);
                    const u32x2 gw = *(const u32x2*)(PT + ((size_t)(b * 4096 + 3072 + c)) * 4096 + t);
                    const float y0 = x2[0] * (acc[n][mt][4 * g] * invs + sk * lo_bf(zw.x)) * silu(lo_bf(gw.x)), y1 = x2[1] * (acc[n][mt][4 * g + 1] * invs + sk * hi_bf(zw.x)) * silu(hi_bf(gw.x));
                    const float y2 = x2[2] * (acc[n][mt][4 * g + 2] * invs + sk * lo_bf(zw.y)) * silu(lo_bf(gw.y)), y3 = x2[3] * (acc[n][mt][4 * g + 3] * invs + sk * hi_bf(zw.y)) * silu(hi_bf(gw.y));
                    u32x2 w; w.x = pk2(y0, y1); w.y = pk2(y2, y3); *(u32x2*)(OG2 + ((size_t)(b * 1024 + c)) * 4096 + t) = w; } } }
    __syncthreads();
}

struct Raw3 { u32x2 mid; unsigned halo; };
DEV Raw3 ld_raw3(const bf16_t* px, int t) {
    Raw3 r; r.mid = *(const u32x2*)(px + t);
    const unsigned a = px[t - 1], b = px[t + 4];
    r.halo = (t > 0 ? a : 0u) | ((t + 4 < SEQ ? b : 0u) << 16);
    return r;
}
DEV void sconv_raw(const Raw3& r, float w0, float w1, float w2, float bias, float* u) {
    const float pm = lo_bf(r.halo), pp = hi_bf(r.halo), q0 = lo_bf(r.mid.x), q1 = hi_bf(r.mid.x), q2 = lo_bf(r.mid.y), q3 = hi_bf(r.mid.y);
    u[0] = w0 * pm + w1 * q0 + w2 * q1 + bias; u[1] = w0 * q0 + w1 * q1 + w2 * q2 + bias; u[2] = w0 * q1 + w1 * q2 + w2 * q3 + bias; u[3] = w0 * q2 + w1 * q3 + w2 * pp + bias;
}
struct FiltRegs { u32x4 a[2], b[2]; };
DEV void filt_load(FiltRegs& f, const bf16_t* gr, int tid) {
#pragma unroll
    for (int rnd = 0; rnd < 2; ++rnd) { const int ch = tid + rnd * 512; f.a[rnd] = *(const u32x4*)(gr + ch * 8);
        const int ch1 = ch + 1 < 1024 ? ch + 1 : ch; const u32x4 t = *(const u32x4*)(gr + ch1 * 8); f.b[rnd] = (ch + 1 < 1024) ? t : (u32x4){0u, 0u, 0u, 0u}; }
}
DEV void filt_store(char* lds, const FiltRegs& f, int tid) {
#pragma unroll
    for (int rnd = 0; rnd < 2; ++rnd) { const int ch = tid + rnd * 512; const u32x4 a = f.a[rnd], bq = f.b[rnd];
        const unsigned w[8] = {a.x, a.y, a.z, a.w, bq.x, bq.y, bq.z, bq.w};
        char* fp = lds + CV_UB + ch * 16;
        *(u32x4*)(fp) = a;
        u32x4 c1, c2, c3;
        c1.x = __builtin_amdgcn_alignbit(w[1], w[0], 16); c1.y = __builtin_amdgcn_alignbit(w[2], w[1], 16); c1.z = __builtin_amdgcn_alignbit(w[3], w[2], 16); c1.w = __builtin_amdgcn_alignbit(w[4], w[3], 16);
        c2 = (u32x4){w[1], w[2], w[3], w[4]};
        c3.x = __builtin_amdgcn_alignbit(w[2], w[1], 16); c3.y = __builtin_amdgcn_alignbit(w[3], w[2], 16); c3.z = __builtin_amdgcn_alignbit(w[4], w[3], 16); c3.w = __builtin_amdgcn_alignbit(w[5], w[4], 16);
        *(u32x4*)(fp + CV_FS) = c1; *(u32x4*)(fp + 2 * CV_FS) = c2; *(u32x4*)(fp + 3 * CV_FS) = c3; }
}
#define CV_T(k) (64 * (4 * (2 * wid + ((k) >> 3)) + (l31 >> 3)) + 32 * (((k) >> 2) & 1) + 8 * ((k) & 3) + 4 * hi)
#define CV_LANE_IDS() int tid = TID(); asm volatile("" : "+v"(tid));   \
    const int lane = tid & 63, wid = __builtin_amdgcn_readfirstlane(tid >> 6), l31 = lane & 31, hi = lane >> 5, eb = l31 & 7; (void)eb; (void)hi; (void)wid
DEV void conv_stage_load(char* lds, const Params& p, int c) {
    CV_LANE_IDS();
    const bf16_t* PT = (const bf16_t*)(p.ws + WS_PT); const bf16_t* GR = (const bf16_t*)(p.ws + WS_GR);
    FiltRegs f0; filt_load(f0, GR + (size_t)c * 8192, tid);
    Raw3 ru[16];
#pragma unroll
    for (int k = 0; k < 16; ++k) { const int i = tid + k * 512, b = i >> 10, t = (i & 1023) * 4; ru[k] = ld_raw3(PT + ((size_t)(b * 4096 + c)) * 4096, t); }
    for (int i = tid; i < 8 * 98; i += 512) { const int b = i / 98, j = i % 98;
        const int e = (j < 48) ? j * 4 : (CV_PADL + SEQ + (j - 48) * 4); *(u32x2*)(lds + b * CV_RS + e * 2) = (u32x2){0u, 0u}; }
    const float w0 = p.conv_w[c], w1 = p.conv_w[3072 + c], w2 = p.conv_w[6144 + c], bias = p.conv_b[c];
#pragma unroll
    for (int k = 0; k < 16; ++k) { const int i = tid + k * 512, b = i >> 10, t = (i & 1023) * 4; float u[4]; sconv_raw(ru[k], w0, w1, w2, bias, u);
        u32x2 w; w.x = pk2(u[0], u[1]); w.y = pk2(u[2], u[3]); *(u32x2*)(lds + b * CV_RS + (CV_PADL + t) * 2) = w; }
    filt_store(lds, f0, tid);
}
DEV void conv_stage_epi0(char* lds, const Params& p, int c, const f32x16 (&acc)[2][2]) {
    CV_LANE_IDS();
    const bf16_t* PT = (const bf16_t*)(p.ws + WS_PT); const bf16_t* GR = (const bf16_t*)(p.ws + WS_GR); const float* ssum = (const float*)(p.ws + WS_SSUM);
    FiltRegs f1; filt_load(f1, GR + (size_t)(1024 + c) * 8192, tid);
    const bf16_t* px1 = PT + ((size_t)(eb * 4096 + 1024 + c)) * 4096;
    Raw3 r1[16];
#pragma unroll
    for (int k = 0; k < 16; ++k) r1[k] = ld_raw3(px1, CV_T(k));
    const float a0 = p.conv_w[1024 + c], a1 = p.conv_w[3072 + 1024 + c], a2 = p.conv_w[6144 + 1024 + c], ab = p.conv_b[1024 + c];
    const float invs = 1.0f / ssum[c], sk = p.skip[c];
#pragma unroll
    for (int k = 0; k < 16; ++k) { const int n = k >> 3, mt = (k >> 2) & 1, g = k & 3; const int t = CV_T(k);
        float x1[4]; sconv_raw(r1[k], a0, a1, a2, ab, x1);
        char* up = lds + eb * CV_RS + (CV_PADL + t) * 2; const u32x2 vw = *(const u32x2*)up;
        const float z0 = x1[0] * (acc[n][mt][4 * g] * invs + sk * lo_bf(vw.x)), z1 = x1[1] * (acc[n][mt][4 * g + 1] * invs + sk * hi_bf(vw.x));
        const float z2 = x1[2] * (acc[n][mt][4 * g + 2] * invs + sk * lo_bf(vw.y)), z3 = x1[3] * (acc[n][mt][4 * g + 3] * invs + sk * hi_bf(vw.y));
        u32x2 w; w.x = pk2(z0, z1); w.y = pk2(z2, z3); *(u32x2*)up = w; }
    filt_store(lds, f1, tid);
}
DEV void conv_stage_epi1(char* lds, const Params& p, int c, const f32x16 (&acc)[2][2]) {
    CV_LANE_IDS();
    const bf16_t* PT = (const bf16_t*)(p.ws + WS_PT); const float* ssum = (const float*)(p.ws + WS_SSUM); bf16_t* OG2 = (bf16_t*)(p.ws + WS_OG2);
    const bf16_t* px2 = PT + ((size_t)(eb * 4096 + 2048 + c)) * 4096; const bf16_t* pg = PT + ((size_t)(eb * 4096 + 3072 + c)) * 4096;
    Raw3 r2[16]; u32x2 rg[16];
#pragma unroll
    for (int k = 0; k < 16; ++k) { r2[k] = ld_raw3(px2, CV_T(k)); rg[k] = *(const u32x2*)(pg + CV_T(k)); }
    const float b0 = p.conv_w[2048 + c], b1 = p.conv_w[3072 + 2048 + c], b2 = p.conv_w[6144 + 2048 + c], bb = p.conv_b[2048 + c];
    const float invs = 1.0f / ssum[1024 + c], sk = p.skip[1024 + c];
#pragma unroll
    for (int k = 0; k < 16; ++k) { const int n = k >> 3, mt = (k >> 2) & 1, g = k & 3; const int t = CV_T(k);
        float x2[4]; sconv_raw(r2[k], b0, b1, b2, bb, x2);
        const u32x2 zw = *(const u32x2*)(lds + eb * CV_RS + (CV_PADL + t) * 2);
        const float y0 = x2[0] * silu(lo_bf(rg[k].x)) * (acc[n][mt][4 * g] * invs + sk * lo_bf(zw.x)), y1 = x2[1] * silu(hi_bf(rg[k].x)) * (acc[n][mt][4 * g + 1] * invs + sk * hi_bf(zw.x));
        const float y2 = x2[2] * silu(lo_bf(rg[k].y)) * (acc[n][mt][4 * g + 2] * invs + sk * lo_bf(zw.y)), y3 = x2[3] * silu(hi_bf(rg[k].y)) * (acc[n][mt][4 * g + 3] * invs + sk * hi_bf(zw.y));
        u32x2 w; w.x = pk2(y0, y1); w.y = pk2(y2, y3); *(u32x2*)(OG2 + ((size_t)(eb * 1024 + c)) * 4096 + t) = w; }
}
DEV void conv_stage_mfma(const char* lds, f32x16 (&acc)[2][2]) { CV_LANE_IDS(); conv_mfma_loop(lds, acc, wid, lane); }
DEV void conv_unit2(char* lds, const Params& p, int c) {
    conv_stage_load(lds, p, c);
    __syncthreads();
    f32x16 acc[2][2];
    conv_stage_mfma(lds, acc);
    __syncthreads();
    conv_stage_epi0(lds, p, c, acc);
    __syncthreads();
    conv_stage_mfma(lds, acc);
    conv_stage_epi1(lds, p, c, acc);
    __syncthreads();
}
#undef CV_T
#undef CV_LANE_IDS

#define XB_TMO      128
#define XB_XCNT(j)  (256  + 64 * (j))
#define XB_XSUB(j)  (1280 + 64 * (j))
#define XB_XGEN(j)  (2304 + 64 * (j))
#define XB_TOP      3328
#define XB_TOPGEN   3392
#define XCD_BAR_WORDS 3456
#define XB_SPIN_CAP (1u << 20)
DEV unsigned xb_ld(unsigned* p) { return __hip_atomic_load(p, __ATOMIC_RELAXED, __HIP_MEMORY_SCOPE_AGENT); }
DEV unsigned xb_add(unsigned* p, unsigned v) { return __hip_atomic_fetch_add(p, v, __ATOMIC_RELAXED, __HIP_MEMORY_SCOPE_AGENT); }
DEV unsigned xb_xcc_id() { return (unsigned)__builtin_amdgcn_s_getreg((3 << 11) | 20) & 0xFu; }
#define XB_SPIN(cond, bar) do { unsigned _sp = 0; while (cond) { __builtin_amdgcn_s_sleep(1); \
    if ((++_sp & 255u) == 0u) { if (xb_ld(&(bar)[XB_TMO])) break; if (_sp > XB_SPIN_CAP) { atomicAdd(&(bar)[XB_TMO], 1u); break; } } } } while (0)
struct XcdBarrier { unsigned* bar; unsigned x; volatile LAS unsigned* st; };
DEV XcdBarrier xcd_barrier_post(unsigned* bar, volatile LAS unsigned* st) {
    XcdBarrier b; b.bar = bar; b.x = xb_xcc_id(); b.st = st;
    if (TID() == 0) (void)xb_add(&bar[XB_XCNT(b.x)], 1u);
    return b;
}
DEV void xcd_barrier_complete(unsigned* bar, unsigned x, unsigned& nloc, unsigned& nx) {
    const unsigned G = gridDim.x * gridDim.y * gridDim.z;
    unsigned sum, cnt, mine, sp = 0u;
    for (;;) {
        sum = 0u; cnt = 0u; mine = 0u;
#pragma unroll
        for (unsigned j = 0; j < 16; ++j) { const unsigned c = xb_ld(&bar[XB_XCNT(j)]); sum += c; cnt += (c > 0u) ? 1u : 0u; mine = (j == x) ? c : mine; }
        if (sum == G) break;
        __builtin_amdgcn_s_sleep(1);
        if ((++sp & 255u) == 0u) { if (xb_ld(&bar[XB_TMO])) break; if (sp > XB_SPIN_CAP) { atomicAdd(&bar[XB_TMO], 1u); break; } }
    }
    nloc = mine > 0u ? mine : 1u; nx = cnt > 0u ? cnt : 1u;
}
DEV void xcd_barrier(const XcdBarrier& b) {
    asm volatile("s_waitcnt vmcnt(0)" ::: "memory");
    __syncthreads();
    if (TID() == 0) {
        unsigned* bar = b.bar;
        __builtin_amdgcn_s_waitcnt(0);
        unsigned nloc = b.st[0], nx = b.st[1];
        if (nloc == 0u) { xcd_barrier_complete(bar, b.x, nloc, nx); b.st[0] = nloc; b.st[1] = nx; }
        const unsigned old = xb_add(&bar[XB_XSUB(b.x)], 1u);
        const unsigned gen = old / nloc;
        if (old + 1u == (gen + 1u) * nloc) {
            __builtin_amdgcn_fence(__ATOMIC_RELEASE, "agent");
            asm volatile("s_waitcnt vmcnt(0)" ::: "memory");
            const unsigned og = xb_add(&bar[XB_TOP], 1u);
            const unsigned tg = og / nx;
            if (og + 1u == (tg + 1u) * nx) xb_add(&bar[XB_TOPGEN], 1u);
            else XB_SPIN(xb_ld(&bar[XB_TOPGEN]) == tg, bar);
            __builtin_amdgcn_fence(__ATOMIC_ACQUIRE, "agent");
            xb_add(&bar[XB_XGEN(b.x)], 1u);
            asm volatile("s_waitcnt vmcnt(0)" ::: "memory");
        } else {
            XB_SPIN(xb_ld(&bar[XB_XGEN(b.x)]) == gen, bar);
            __builtin_amdgcn_fence(__ATOMIC_ACQUIRE, "agent");
            asm volatile("s_waitcnt vmcnt(0)" ::: "memory");
        }
    }
    __syncthreads();
}

constexpr int NPHASE = 12;
__global__ void __launch_bounds__(512) fwd_kernel(Params p) {
    char* lds = lds_dyn;
    char* ws = p.ws;
    volatile LAS unsigned* bst = (volatile LAS unsigned*)(LAS char*)(lds + LDS_BYTES - 64);
    { const int t0 = threadIdx.x;
        if (t0 < 16) bst[t0] = 0u;
        if ((t0 & 63) == 0) *(volatile LAS int*)(LAS char*)(lds + LDS_WTAB + 4 * hw_slot()) = t0 >> 6; }
    __syncthreads();
    if (MK_LAUNCHES == 1) (void)xcd_barrier_post((unsigned*)(ws + WS_CTL), bst);
    if (MK_LAUNCHES == 1 && p.ph_hi > NPHASE) cg::this_grid().sync();
#define SEAM(k) do { if (MK_LAUNCHES == 1 && (k) + 1 < p.ph_hi) { XcdBarrier xb_; xb_.bar = (unsigned*)(p.ws + WS_CTL); xb_.x = xb_xcc_id(); xb_.st = (volatile LAS unsigned*)(LAS char*)(lds + LDS_BYTES - 64); xcd_barrier(xb_); } } while (0)
#ifndef PHASE_MASK
#define PHASE_MASK 0xFFF
#endif
#define IN(k) (((PHASE_MASK >> (k)) & 1) && p.ph_lo <= (k) && (k) < p.ph_hi)
#define REP(k) for (int rep_ = 0; rep_ < ((PROBE_REPEAT == (k)) ? 2 : 1); ++rep_)
    if (IN(0)) { REP(0) phase_prep(lds, p); SEAM(0); }
    if (IN(1)) {
        for (int rep_ = 0; rep_ < ((PROBE_REPEAT == 21) ? 2 : 1); ++rep_) {
        const bool dummy = (PROBE_REPEAT == 21 && rep_ == 0);
        EpiFilt ef{(bf16_t*)(ws + (dummy ? WS_PRAW : WS_GR)), p.f_b3};
        gemm_phase<false, EpiFilt>(lds, (const bf16_t*)(ws + WS_W3), 64, (const bf16_t*)(ws + WS_HID2), 64, 4096, 4096, 64, ef); }
        REP(1) phase_norm0(p); SEAM(1); }
    if (IN(2)) {
        REP(2) { pg8::Gemm g{(const bf16_t*)(ws + WS_H0), (const bf16_t*)(ws + WS_WIN), NALL, AINP, DM}; pg8::StaticOrder S; S.init(NALL, AINP, (int)gridDim.x, (int)blockIdx.x);
            pg8::EpiBf16 E{(bf16_t*)(ws + WS_PRAW), (size_t)AINP, 0, 0};
            pg8::gemm_phase<pg8::EpiBf16, pg8::StaticOrder, true, true>((PG8_LAS unsigned char*)lds, g, S, E); }
        SEAM(2); }
    if (IN(3)) { filt_sums(p); REP(3) phase_post(p); SEAM(3); }
    if (IN(4)) {
        const float* rp = (const float*)(ws + WS_ROPE);
        REP(4) {
        { pg8::Gemm g{(const bf16_t*)(ws + WS_CQN), (const bf16_t*)(ws + WS_WUQ), NTOK, 768, 256}; pg8::StaticOrder S; S.init(NTOK, 768, (int)gridDim.x, (int)blockIdx.x);
            pg8::EpiUqPg E{(bf16_t*)(ws + WS_QM), rp + 2048, rp + 2560, QSC_M};
            pg8::gemm_phase<pg8::EpiUqPg, pg8::StaticOrder, true, true>((PG8_LAS unsigned char*)lds, g, S, E); }
        int opq_ = 0; asm volatile("" : "+s"(opq_));
        if (opq_ == 0) { pg8::Gemm g{(const bf16_t*)(ws + WS_CKVN), (const bf16_t*)(ws + WS_WUKV), NALL, 1024, 128}; pg8::StaticOrder S; S.init(NALL, 1024, (int)gridDim.x, (int)blockIdx.x);
            pg8::EpiUkvPg E{(bf16_t*)(ws + WS2_KM), (bf16_t*)(ws + WS2_VM)};
            pg8::gemm_phase<pg8::EpiUkvPg, pg8::StaticOrder, true, true>((PG8_LAS unsigned char*)lds, g, S, E); } }
        SEAM(4); }
    if (IN(5)) { REP(5) phase_attn(lds, p); SEAM(5); }
    if (IN(6)) {
        REP(6) { pg8::Gemm g{(const bf16_t*)(ws + WS2_OG), (const bf16_t*)(ws + WS_WOUT), NTOK, DM, DM}; pg8::StaticOrder S; S.init(NTOK, DM, (int)gridDim.x, (int)blockIdx.x);
            pg8::EpiResF32 E{p.x, p.out, (const float*)(ws + WS_MOD0), (DBG_SKIP & 1) ? 0.f : 1.f};
            pg8::gemm_phase<pg8::EpiResF32, pg8::StaticOrder, true, true>((PG8_LAS unsigned char*)lds, g, S, E); }
        SEAM(6); }
    if (IN(7)) { REP(7) phase_norm1(p); SEAM(7); }
    if (IN(8)) {
        REP(8) { pg8::Gemm g{(const bf16_t*)(ws + WS_HWIN), (const bf16_t*)(ws + WS_H1), 4096, NTOK, DM}; pg8::StaticOrder S; S.init(4096, NTOK, (int)gridDim.x, (int)blockIdx.x);
            pg8::EpiBf16 E{(bf16_t*)(ws + WS_PT), (size_t)4096, 4096, (size_t)4096 * 4096};
            pg8::gemm_phase<pg8::EpiBf16, pg8::StaticOrder, true, true>((PG8_LAS unsigned char*)lds, g, S, E); }
        SEAM(8); }
    if (IN(9)) { REP(9) for (int c = blockIdx.x; c < 1024; c += gridDim.x) conv_unit2(lds, p, c); SEAM(9); }
    if (IN(10)) {
        REP(10) {
        EpiRes e{p.out, (PROBE_REPEAT == 10 && rep_ == 0) ? (float*)(ws + WS_PT) : p.out, (const float*)(ws + WS_MOD1), (DBG_SKIP & 2) ? 0.f : 1.f};
        const bf16_t* OG2 = (const bf16_t*)(ws + WS_OG2); const bf16_t* W = (const bf16_t*)(ws + WS_HWOUT);
        const int nt = (NTOK / 256) * (DM / 128);
        for (int t = blockIdx.x; t < nt; t += gridDim.x) { const int ti = t / 8, tj = t % 8; const int b = ti >> 4, l0 = (ti & 15) * 256;
            gemm_tile<true, EpiRes>(lds, OG2 + (size_t)b * 1024 * 4096 + l0, 4096, W + (size_t)tj * 128 * DM, DM, DM, e, ti * 256, tj * 128); }
        }
        SEAM(10); }
    if (IN(11)) { phase_final(p); }
#undef SEAM
#undef IN
}

extern "C" void kernel_launch(void* const* d_in, const int* in_sizes, int n_in, void* d_out, int out_size, void* d_ws, size_t ws_size, hipStream_t stream) {
    static int grid = 0;
    if (grid == 0) {
        if (n_in != 28 || out_size != NTOK * DM || ws_size < WS_END) { fprintf(stderr, "kernel_launch: unexpected shapes n_in %d out %d ws %zu\n", n_in, out_size, ws_size); grid = -1; return; }
        int dev = 0, cus = 0, per_cu = 0;
        hipGetDevice(&dev); hipDeviceGetAttribute(&cus, hipDeviceAttributeMultiprocessorCount, dev);
        if (hipFuncSetAttribute((const void*)fwd_kernel, hipFuncAttributeMaxDynamicSharedMemorySize, LDS_BYTES) != hipSuccess) { fprintf(stderr, "hipFuncSetAttribute failed\n"); grid = -1; return; }
        hipOccupancyMaxActiveBlocksPerMultiprocessor(&per_cu, (const void*)fwd_kernel, 512, LDS_BYTES);
        if (per_cu < 1) { fprintf(stderr, "occupancy query says %d\n", per_cu); per_cu = 1; }
        grid = cus * 1;
        (void)hipGetLastError();
    }
    if (grid < 0) return;
    Params p{};
    const float** pp = (const float**)&p;
    for (int i = 0; i < 28; ++i) pp[i] = (const float*)d_in[i];
    p.out = (float*)d_out; p.ws = (char*)d_ws;
#if MK_LAUNCHES == 1
    if (hipMemsetAsync((char*)d_ws + WS_CTL, 0, CTL_BYTES, stream) != hipSuccess) { fprintf(stderr, "memset failed\n"); return; }
    p.ph_lo = 0; p.ph_hi = NPHASE;
    void* args[] = {&p};
    hipError_t e = hipLaunchCooperativeKernel((const void*)fwd_kernel, dim3(grid), dim3(512), args, LDS_BYTES, stream);
    if (e != hipSuccess) fprintf(stderr, "cooperative launch failed: %s (grid %d)\n", hipGetErrorString(e), grid);
#else
    for (int k = 0; k < NPHASE; ++k) { p.ph_lo = k; p.ph_hi = k + 1; hipLaunchKernelGGL(fwd_kernel, dim3(grid), dim3(512), LDS_BYTES, stream, p); }
#endif
}
```

```cpp
#include <hip/hip_runtime.h>
#include <hip/hip_cooperative_groups.h>
#include <cstdio>
#include <cstdint>
namespace cg = cooperative_groups;

#ifndef MK_LAUNCHES
#define MK_LAUNCHES 1
#endif

#ifndef PROBE_REPEAT
#define PROBE_REPEAT -1
#endif
#ifndef DBG_SKIP
#define DBG_SKIP 0
#endif
#define DEV __device__ __forceinline__
typedef unsigned short bf16_t;
typedef short bf16x8 __attribute__((ext_vector_type(8)));
typedef short s16x4 __attribute__((ext_vector_type(4)));
typedef float f32x16 __attribute__((ext_vector_type(16)));
typedef float f32x4 __attribute__((ext_vector_type(4)));
typedef float f32x2 __attribute__((ext_vector_type(2)));
typedef unsigned u32x4 __attribute__((ext_vector_type(4)));
typedef unsigned u32x2 __attribute__((ext_vector_type(2)));
typedef __bf16 bf16x2_t __attribute__((ext_vector_type(2)));
#define LAS __attribute__((address_space(3)))

constexpr int NB = 8, SEQ = 4096, DM = 1024, CTXL = 256, LK = SEQ + CTXL;
constexpr int NTOK = NB * SEQ, NCTX = NB * CTXL, NALL = NTOK + NCTX;
constexpr int AIN = 2208, AINP = 2304;
constexpr float EPS = 1e-6f;
constexpr float LOG2E = 1.4426950408889634f;
constexpr float QSC_A = 0.125f * LOG2E;
constexpr float QSC_M = 0.10206207261596575f * LOG2E;

constexpr size_t MiB = 1ull << 20;
constexpr size_t WS_WIN = 0;
constexpr size_t WS_WUQ = 5 * MiB;
constexpr size_t WS_WUKV = 6 * MiB;
constexpr size_t WS_WOUT = 7 * MiB;
constexpr size_t WS_HWIN = 9 * MiB;
constexpr size_t WS_HWOUT = 17 * MiB;
constexpr size_t WS_W3 = 19 * MiB;
constexpr size_t WS_HID2 = 20 * MiB;
constexpr size_t WS_MOD0 = 21 * MiB;
constexpr size_t WS_MOD1 = WS_MOD0 + 9 * 3072 * 4;
constexpr size_t WS_SSUM = WS_MOD1 + 8 * 3072 * 4;
constexpr size_t WS_ROPE = WS_SSUM + 2048 * 4;
constexpr size_t WS_GR = 22 * MiB;
constexpr size_t WS_H0 = 64 * MiB;
constexpr size_t WS_PRAW = 136 * MiB;
constexpr size_t WS_QA = 297 * MiB;
constexpr size_t WS_KA = 329 * MiB;
constexpr size_t WS_VA = 338 * MiB;
constexpr size_t WS_CQN = 347 * MiB;
constexpr size_t WS_CKVN = 363 * MiB;
constexpr size_t WS_G = 372 * MiB;
constexpr size_t WS_QM = 64 * MiB;
constexpr size_t WS_KM = 136 * MiB;
constexpr size_t WS_VM = 190 * MiB;
constexpr size_t WS_OG = 226 * MiB;
constexpr size_t WS_H1 = 436 * MiB;
constexpr size_t WS_PT = 64 * MiB;
constexpr size_t WS_OG2 = 320 * MiB;
constexpr size_t WS_CTL = 500 * MiB;
constexpr size_t CTL_BYTES = 16384;
constexpr size_t WS_END = 500 * MiB + CTL_BYTES;
constexpr size_t WS2_KM = 436 * MiB;
constexpr size_t WS2_VM = 190 * MiB;
constexpr size_t WS2_OG = 226 * MiB;

constexpr int LDS_BYTES = 150 * 1024;

extern __shared__ __attribute__((aligned(16))) char lds_dyn[];
constexpr int LDS_WTAB = LDS_BYTES - 64 - 256;
__device__ __forceinline__ int lane_id() { int r; asm volatile("v_mbcnt_lo_u32_b32 %0, -1, 0\n\tv_mbcnt_hi_u32_b32 %0, -1, %0" : "=v"(r)); return r; }
__device__ __forceinline__ int hw_slot() { return (int)(__builtin_amdgcn_s_getreg((5 << 11) | 4) & 63u); }
__device__ __forceinline__ int wave_idx() { return __builtin_amdgcn_readfirstlane(*(volatile __attribute__((address_space(3))) int*)(__attribute__((address_space(3))) char*)(lds_dyn + LDS_WTAB + 4 * hw_slot())); }
#define TID() (wave_idx() * 64 + lane_id())

DEV float bf2f(bf16_t v) { return __uint_as_float(((unsigned)v) << 16); }
DEV unsigned pk2(float lo, float hi) { f32x2 v = {lo, hi}; bf16x2_t b = __builtin_convertvector(v, bf16x2_t); return __builtin_bit_cast(unsigned, b); }
DEV bf16_t f2bf(float f) { return (bf16_t)(pk2(f, 0.f) & 0xffffu); }
DEV float lo_bf(unsigned w) { return __uint_as_float(w << 16); }
DEV float hi_bf(unsigned w) { return __uint_as_float(w & 0xffff0000u); }
DEV int crow(int r, int hi) { return (r & 3) + 8 * (r >> 2) + 4 * hi; }
DEV float silu(float v) { return v / (1.f + __expf(-v)); }
DEV void unpack8(const u32x4 w, float* v) { v[0] = lo_bf(w.x); v[1] = hi_bf(w.x); v[2] = lo_bf(w.y); v[3] = hi_bf(w.y); v[4] = lo_bf(w.z); v[5] = hi_bf(w.z); v[6] = lo_bf(w.w); v[7] = hi_bf(w.w); }
DEV u32x4 pack8(const float* v) { u32x4 w; w.x = pk2(v[0], v[1]); w.y = pk2(v[2], v[3]); w.z = pk2(v[4], v[5]); w.w = pk2(v[6], v[7]); return w; }

DEV float wave_sum(float v) {
#pragma unroll
    for (int o = 1; o < 64; o <<= 1) v += __shfl_xor(v, o);
    return v;
}
struct Params {
    const float *x, *c, *ctx, *c_ctx, *ada_w, *ada_b, *norm_w, *w_in, *q_norm, *k_norm, *cq_norm, *ckv_norm, *w_uq, *w_ukv, *w_out,
        *hy_w_in, *conv_w, *conv_b, *f_w1, *f_b1, *f_w2, *f_b2, *f_w3, *f_b3, *freq, *skip, *hy_w_out, *final_w;
    float* out; char* ws; int ph_lo, ph_hi;
};

constexpr int G_RS = 144;
constexpr int G_RB = 256 * G_RS, G_CB = 128 * G_RS, G_STAGE = G_RB + G_CB;
constexpr int T_RS = 576;

template <bool TR, class Epi>
DEV void gemm_tile(char* lds, const bf16_t* __restrict__ R, size_t ldr, const bf16_t* __restrict__ C, size_t ldc, int K, const Epi& epi, int ti0, int tj0) {
    const int tid = TID(), lane = tid & 63, wid = tid >> 6;
    const int wi = wid >> 1, wj = wid & 1, l31 = lane & 31, hi = lane >> 5;
    f32x16 acc[2][2];
#pragma unroll
    for (int a = 0; a < 2; ++a)
#pragma unroll
        for (int b = 0; b < 2; ++b)
#pragma unroll
            for (int r = 0; r < 16; ++r) acc[a][b][r] = 0.f;
    u32x4 rrX[4], rcX[2], rrY[4], rcY[2];
    const bf16_t* Rp; const bf16_t* Cp; int rl_off, cl_off;
    if (TR) { const int c = tid & 31, kr = tid >> 5; Rp = R + (size_t)kr * ldr + c * 8; rl_off = kr * T_RS + c * 16; }
    else { const int lr = tid >> 3, lc = tid & 7; Rp = R + (size_t)lr * ldr + lc * 8; rl_off = lr * G_RS + lc * 16; }
    { const int lr = tid >> 3, lc = tid & 7; Cp = C + (size_t)lr * ldc + lc * 8; cl_off = lr * G_RS + lc * 16; }
    const int nk = K / 64;
    int ra_off[2], cb_off[2];
#pragma unroll
    for (int t = 0; t < 2; ++t) {
        if (TR) { const int g1 = (lane >> 4) & 1, q = (lane & 15) >> 2, p = lane & 3; ra_off[t] = (8 * hi + q) * T_RS + (wi * 64 + t * 32 + 16 * g1 + 4 * p) * 2; }
        else ra_off[t] = (wi * 64 + t * 32 + l31) * G_RS + hi * 16;
        cb_off[t] = G_RB + (wj * 64 + t * 32 + l31) * G_RS + hi * 16;
    }
#define G_LOAD(kt, S) do { const int kk_ = (kt) < nk ? (kt) : nk - 1; \
        if (TR) { _Pragma("unroll") for (int p = 0; p < 4; ++p) rr##S[p] = *(const u32x4*)(Rp + ((size_t)kk_ * 64 + 16 * p) * ldr); } \
        else { _Pragma("unroll") for (int p = 0; p < 4; ++p) rr##S[p] = *(const u32x4*)(Rp + (size_t)(64 * p) * ldr + kk_ * 64); } \
        _Pragma("unroll") for (int p = 0; p < 2; ++p) rc##S[p] = *(const u32x4*)(Cp + (size_t)(64 * p) * ldc + kk_ * 64); } while (0)
#define G_STORE(buf, S) do { char* b_ = lds + (buf) * G_STAGE; \
        if (TR) { _Pragma("unroll") for (int p = 0; p < 4; ++p) *(u32x4*)(b_ + rl_off + 16 * p * T_RS) = rr##S[p]; } \
        else { _Pragma("unroll") for (int p = 0; p < 4; ++p) *(u32x4*)(b_ + rl_off + 64 * p * G_RS) = rr##S[p]; } \
        _Pragma("unroll") for (int p = 0; p < 2; ++p) *(u32x4*)(b_ + G_RB + cl_off + 64 * p * G_RS) = rc##S[p]; } while (0)
#define G_COMPUTE(buf) do { const char* b_ = lds + (buf) * G_STAGE; \
        _Pragma("unroll") for (int ks = 0; ks < 4; ++ks) { bf16x8 fa[2], fb[2]; \
            _Pragma("unroll") for (int t = 0; t < 2; ++t) { \
                if (TR) { \
                    const s16x4 lo = __builtin_bit_cast(s16x4, __builtin_amdgcn_ds_read_tr16_b64_v4i16((LAS s16x4*)(b_ + ra_off[t] + ks * 16 * T_RS))); \
                    const s16x4 hh = __builtin_bit_cast(s16x4, __builtin_amdgcn_ds_read_tr16_b64_v4i16((LAS s16x4*)(b_ + ra_off[t] + (ks * 16 + 4) * T_RS))); \
                    fa[t] = (bf16x8){lo[0], lo[1], lo[2], lo[3], hh[0], hh[1], hh[2], hh[3]}; \
                } else fa[t] = *(const bf16x8*)(b_ + ra_off[t] + ks * 32); \
                fb[t] = *(const bf16x8*)(b_ + cb_off[t] + ks * 32); } \
            _Pragma("unroll") for (int a = 0; a < 2; ++a) _Pragma("unroll") for (int b = 0; b < 2; ++b) acc[a][b] = __builtin_amdgcn_mfma_f32_32x32x16_bf16(fa[a], fb[b], acc[a][b], 0, 0, 0); } } while (0)
    G_LOAD(0, X); G_LOAD(1, Y); G_STORE(0, X);
    __syncthreads();
    for (int kt = 0; kt < nk; kt += 2) {
        G_LOAD(kt + 2, X);
        G_COMPUTE(0);
        G_STORE(1, Y);
        __syncthreads();
        if (kt + 1 >= nk) break;
        G_LOAD(kt + 3, Y);
        G_COMPUTE(1);
        G_STORE(0, X);
        __syncthreads();
    }
#undef G_LOAD
#undef G_STORE
#undef G_COMPUTE
#pragma unroll
    for (int a = 0; a < 2; ++a)
#pragma unroll
        for (int b = 0; b < 2; ++b) epi(ti0 + wi * 64 + a * 32, tj0 + wj * 64 + b * 32, acc[a][b], l31, hi);
}

template <bool TR, class Epi>
DEV void gemm_phase(char* lds, const bf16_t* R, size_t ldr, const bf16_t* C, size_t ldc, int nI, int nJ, int K, const Epi& epi) {
    const int tI = nI / 256, tJ = nJ / 128, nt = tI * tJ;
    for (int t = blockIdx.x; t < nt; t += gridDim.x) {
        const int ti = t / tJ, tj = t % tJ;
        gemm_tile<TR, Epi>(lds, R + (size_t)ti * 256 * ldr, ldr, C + (size_t)tj * 128 * ldc, ldc, K, epi, ti * 256, tj * 128);
    }
}

struct EpiRaw {
    bf16_t* O; size_t ld;
    DEV void operator()(int i0, int j0, const f32x16& a, int l31, int hi) const {
#pragma unroll
        for (int r = 0; r < 16; ++r) O[(size_t)(i0 + crow(r, hi)) * ld + j0 + l31] = f2bf(a[r]);
    }
};
struct EpiUq {
    bf16_t* QM; const float* cos32; const float* sin32;
    DEV void operator()(int i0, int j0, const f32x16& a, int l31, int hi) const {
        const bool pe = (j0 % 96) == 64;
        const int fi = l31 & 7; const bool colang = (l31 & 16) != 0; const bool bpart = (l31 & 8) != 0;
#pragma unroll
        for (int r = 0; r < 16; ++r) {
            const int tok = i0 + crow(r, hi); float v = a[r];
            const float o = __shfl_xor(v, 8);
            if (pe) { const int l = tok & (SEQ - 1); const int pos = colang ? (l & 63) : (l >> 6);
                const float cs = cos32[pos * 8 + fi], sn = sin32[pos * 8 + fi];
                v = bpart ? (v * cs + o * sn) : (v * cs - o * sn); }
            QM[(size_t)tok * 768 + j0 + l31] = f2bf(v * QSC_M);
        }
    }
};
struct EpiUkv {
    bf16_t* KM; bf16_t* VM;
    DEV void operator()(int i0, int j0, const f32x16& a, int l31, int hi) const {
        const int h = j0 >> 7, e = (j0 & 127) + l31;
#pragma unroll
        for (int r = 0; r < 16; ++r) { const size_t row = (size_t)(i0 + crow(r, hi));
            if (e < 64) KM[row * 768 + h * 96 + e] = f2bf(a[r]); else VM[row * 512 + h * 64 + (e - 64)] = f2bf(a[r]); }
    }
};
struct EpiRes {
    const float* base; float* out; const float* mod; float gmul;
    DEV void operator()(int i0, int j0, const f32x16& a, int l31, int hi) const {
        const int b = i0 >> 12; const float g = mod[b * 3072 + 2048 + j0 + l31] * gmul;
#pragma unroll
        for (int h8 = 0; h8 < 2; ++h8) { float bv[8];
#pragma unroll
            for (int r = 0; r < 8; ++r) bv[r] = base[(size_t)(i0 + crow(8 * h8 + r, hi)) * DM + j0 + l31];
#pragma unroll
            for (int r = 0; r < 8; ++r) out[(size_t)(i0 + crow(8 * h8 + r, hi)) * DM + j0 + l31] = bv[r] + g * a[8 * h8 + r]; }
    }
};
struct EpiPT {
    bf16_t* PT;
    DEV void operator()(int i0, int j0, const f32x16& a, int l31, int hi) const {
        const int b = j0 >> 12, l = (j0 & 4095) + l31;
#pragma unroll
        for (int r = 0; r < 16; ++r) PT[((size_t)(b * 4096 + i0 + crow(r, hi))) * 4096 + l] = f2bf(a[r]);
    }
};
struct EpiFilt {
    bf16_t* GR; const float* b3;
    DEV void operator()(int i0, int j0, const f32x16& a, int l31, int hi) const {
        const int t = j0 + l31; const float tn = (float)t * (1.0f / 4095.0f);
        const float dmin = -3.0701134573253945f, dmax = -15.350567286626973f;
#pragma unroll
        for (int r = 0; r < 16; ++r) {
            const int n = i0 + crow(r, hi); const int c = n & 1023, od = n >> 10, o = od >> 1, dir = od & 1;
            const float delta = fabsf(dmin + (float)c * ((dmax - dmin) / 1023.0f));
            const float v = (a[r] + b3[n]) * __expf(-tn * delta);
            bf16_t* g = GR + ((size_t)(o * 1024 + c)) * 8192;
            if (dir == 0) g[4096 - t] = f2bf(v);
            else { if (t == 0) g[0] = 0; else g[4096 + t] = f2bf(v); }
        }
    }
};
DEV void filt_sums(const Params& p) {
    const int wid = TID() >> 6, lane = TID() & 63; bf16_t* GR = (bf16_t*)(p.ws + WS_GR); float* ssum = (float*)(p.ws + WS_SSUM);
    for (int row = blockIdx.x * 8 + wid; row < 2048; row += gridDim.x * 8) {
        bf16_t* g = GR + (size_t)row * 8192; float s = 0.f;
        u32x4 w[16];
#pragma unroll
        for (int j = 0; j < 16; ++j) w[j] = *(const u32x4*)(g + (j * 64 + lane) * 8);
#pragma unroll
        for (int j = 0; j < 16; ++j) { float v[8]; unpack8(w[j], v);
            if (j == 0 && lane == 0) v[0] = 0.f;
#pragma unroll
            for (int e = 0; e < 8; ++e) s += fabsf(v[e]); }
        s = wave_sum(s);
        if (lane == 0) ssum[row] = s;
    }
}

namespace pg8 {
#define PG8_LAS __attribute__((address_space(3)))
typedef short bf16x8 __attribute__((ext_vector_type(8)));
typedef float f32x4 __attribute__((ext_vector_type(4)));
typedef unsigned u32x4 __attribute__((ext_vector_type(4)));
constexpr int BM = 256, BK = 64, HALF = 128, HTB = HALF * BK * 2  , STAGE_BYTES = 8 * HTB, NXCD = 8, WGM = 8;

__host__ __device__ __forceinline__ int lds_byte(int r, int c) { const int st = (r >> 4) * 2 + (c >> 5), rr = r & 15, cc = c & 31, ob = rr * 64 + cc * 2; return st * 1024 + (ob ^ (((ob >> 9) & 1) << 5)); }
__host__ __device__ __forceinline__ void stage_rc(int b, int& R, int& C) { const int st = b / 1024, sb = b % 1024, swz = sb ^ (((sb >> 9) & 1) << 5); R = (st >> 1) * 16 + swz / 64; C = (st & 1) * 32 + (swz % 64) / 2; }
__host__ __device__ __forceinline__ int perm32(int rho) { const int n = rho >> 4, i = rho & 15; return 8 * (i >> 2) + 4 * n + (i & 3); }

struct Unit { int pm, pn; };
struct Gemm { const bf16_t* A; const bf16_t* Bt; int M, N, K; };

struct StaticOrder {
    int nM, nN, nwg, G, c;
    __host__ __device__ void init(int M, int N, int G_, int c_) { nM = M / BM; nN = N / BM; nwg = nM * nN; G = G_; c = c_; }
    __host__ __device__ bool next(int i, Unit& u) const {
        const long L = (long)i * G + c; if (L >= nwg) return false;
        int wgid = (int)L; { const int q = nwg / NXCD, r = nwg % NXCD, xcd = wgid % NXCD, off = wgid / NXCD; wgid = (xcd < r ? xcd * (q + 1) : r * (q + 1) + (xcd - r) * q) + off; }
        const int nig = WGM * nN, gid = wgid / nig, fm = gid * WGM, gsz = (nM - fm) < WGM ? (nM - fm) : WGM;
        u.pm = fm + ((wgid % nig) % gsz); u.pn = (wgid % nig) / gsz; return true;
    }
    __device__ __forceinline__ void a_ready(const Unit&) const {}
    __device__ __forceinline__ void done(const Unit&) const {}
};

__device__ __forceinline__ unsigned cvt_pk_bf16(float lo, float hi) { unsigned r; asm volatile("v_cvt_pk_bf16_f32 %0, %1, %2" : "=v"(r) : "v"(lo), "v"(hi)); return r; }
typedef float f32x2 __attribute__((ext_vector_type(2)));

struct EpiBf16 {
    static constexpr bool PERM = true, AFTER_DRAIN = false;
    bf16_t* O; size_t ldc; int split_cols; size_t split_stride;
    __device__ __forceinline__ void operator()(const f32x4 (&acc)[2][2][4][2], const Unit& u, int wr, int wc, int fr, int fq) const {
        const int row0 = u.pm * BM + wr * 64 + fr; int colt = u.pn * BM; bf16_t* base = O;
        if (split_cols) { const int t = colt / split_cols; base += (size_t)t * split_stride; colt -= t * split_cols; }
        const int col0 = colt + wc * 32 + 8 * fq;
#pragma unroll
        for (int ai = 0; ai < 2; ++ai)
#pragma unroll
            for (int m = 0; m < 4; ++m) { bf16_t* rowp = base + (size_t)(row0 + ai * HALF + m * 16) * ldc + col0;
#pragma unroll
                for (int bj = 0; bj < 2; ++bj) { const f32x4 v0 = acc[ai][bj][m][0], v1 = acc[ai][bj][m][1];
                    u32x4 w; w.x = cvt_pk_bf16(v0[0], v0[1]); w.y = cvt_pk_bf16(v0[2], v0[3]); w.z = cvt_pk_bf16(v1[0], v1[1]); w.w = cvt_pk_bf16(v1[2], v1[3]);
                    *(u32x4*)(rowp + bj * HALF) = w; } }
    }
};

struct EpiUkvPg {
    static constexpr bool PERM = true, AFTER_DRAIN = false;
    bf16_t* KM; bf16_t* VM;
    __device__ __forceinline__ void operator()(const f32x4 (&acc)[2][2][4][2], const Unit& u, int wr, int wc, int fr, int fq) const {
        { const int ln = lane_id(); fr = ln & 15; fq = ln >> 4; }
        const int row0 = u.pm * BM + wr * 64 + fr; const int e0 = 32 * wc + 8 * fq;
        const bool isk = (wc < 2);
        bf16_t* base = isk ? KM + (size_t)row0 * 768 + 2 * u.pn * 96 + e0 : VM + (size_t)row0 * 512 + 2 * u.pn * 64 + (e0 - 64);
        const int ld = isk ? 768 : 512, hs = isk ? 96 : 64;
#pragma unroll
        for (int ai = 0; ai < 2; ++ai)
#pragma unroll
            for (int m = 0; m < 4; ++m)
#pragma unroll
                for (int bj = 0; bj < 2; ++bj) { const f32x4 v0 = acc[ai][bj][m][0], v1 = acc[ai][bj][m][1];
                    u32x4 w; w.x = cvt_pk_bf16(v0[0], v0[1]); w.y = cvt_pk_bf16(v0[2], v0[3]); w.z = cvt_pk_bf16(v1[0], v1[1]); w.w = cvt_pk_bf16(v1[2], v1[3]);
                    *(u32x4*)(base + (ai * HALF + m * 16) * ld + bj * hs) = w; }
    }
};
struct EpiUqPg {
    static constexpr bool PERM = true, AFTER_DRAIN = false;
    bf16_t* QM; const float* cos32; const float* sin32; float sc;
    __device__ __forceinline__ void operator()(const f32x4 (&acc)[2][2][4][2], const Unit& u, int wr, int wc, int fr, int fq) const {
        { const int ln = lane_id(); fr = ln & 15; fq = ln >> 4; }
        const int row0 = u.pm * BM + wr * 64 + fr;
        bf16_t* base = QM + (size_t)row0 * 768 + u.pn * BM + 32 * wc + 8 * fq;
        const int g0 = 8 * u.pn + wc;
        const bool sgn = (fq & 1) != 0;
#pragma unroll
        for (int bj = 0; bj < 2; ++bj) { const bool pe = (((g0 + 4 * bj) % 3) == 2);
#pragma unroll
            for (int ai = 0; ai < 2; ++ai)
#pragma unroll
                for (int m = 0; m < 4; ++m) { const int rr = ai * HALF + m * 16; u32x4 w;
#pragma unroll
                    for (int n = 0; n < 2; ++n) { f32x4 v = acc[ai][bj][m][n];
                        if (pe) { f32x4 o;
#pragma unroll
                            for (int e = 0; e < 4; ++e) o[e] = __shfl_xor(v[e], 16);
                            const int l = (row0 + rr) & 4095, pos = (fq < 2) ? (l >> 6) : (l & 63);
                            const f32x4 cv = *(const f32x4*)(cos32 + pos * 8 + 4 * n), sv = *(const f32x4*)(sin32 + pos * 8 + 4 * n);
                            v = sgn ? (v * cv + o * sv) : (v * cv - o * sv); }
                        v = v * sc;
                        if (n == 0) { w.x = cvt_pk_bf16(v[0], v[1]); w.y = cvt_pk_bf16(v[2], v[3]); } else { w.z = cvt_pk_bf16(v[0], v[1]); w.w = cvt_pk_bf16(v[2], v[3]); } }
                    *(u32x4*)(base + rr * 768 + bj * HALF) = w;
                    asm volatile("" ::: "memory"); } }
    }
};
struct EpiResF32 {
    static constexpr bool PERM = false, AFTER_DRAIN = false;
    const float* base; float* out; const float* mod; float gmul;
    __device__ __forceinline__ void operator()(const f32x4 (&acc)[2][2][4][2], const Unit& u, int wr, int wc, int fr, int fq) const {
        const int row0 = u.pm * BM + wr * 64 + fr, col0 = u.pn * BM + wc * 32 + 4 * fq, b = (u.pm * BM) >> 12;
        f32x4 g[2][2];
#pragma unroll
        for (int bj = 0; bj < 2; ++bj)
#pragma unroll
            for (int n = 0; n < 2; ++n) g[bj][n] = *(const f32x4*)(mod + b * 3072 + 2048 + col0 + bj * HALF + n * 16) * gmul;
#pragma unroll
        for (int ai = 0; ai < 2; ++ai) {
            f32x4 pre[4][2][2];
#pragma unroll
            for (int m = 0; m < 4; ++m) { const size_t off = (size_t)(row0 + ai * HALF + m * 16) * 1024 + col0;
#pragma unroll
                for (int bj = 0; bj < 2; ++bj)
#pragma unroll
                    for (int n = 0; n < 2; ++n) pre[m][bj][n] = *(const f32x4*)(base + off + bj * HALF + n * 16); }
#pragma unroll
            for (int m = 0; m < 4; ++m) { const size_t off = (size_t)(row0 + ai * HALF + m * 16) * 1024 + col0;
#pragma unroll
                for (int bj = 0; bj < 2; ++bj)
#pragma unroll
                    for (int n = 0; n < 2; ++n) *(f32x4*)(out + off + bj * HALF + n * 16) = pre[m][bj][n] + g[bj][n] * acc[ai][bj][m][n]; }
        }
    }
};
template <class Epi, class Sched, bool ALIGN_EPI = false, bool SP2 = false>
__device__ __forceinline__ void gemm_phase(PG8_LAS unsigned char* lds, const Gemm g, const Sched& S, const Epi& E) {
    int tid_ = TID(); asm volatile("" : "+v"(tid_));
    const int tid = tid_, wid = __builtin_amdgcn_readfirstlane(tid >> 6), lane = tid & 63, wr = wid >> 2, wc = wid & 3, fr = lane & 15, fq = lane >> 4;
    const int K = g.K, nt = K / BK;
    unsigned voffA[2], voffB[2];
#pragma unroll
    for (int i = 0; i < 2; ++i) { int R, C; stage_rc(tid * 16 + i * 8192, R, C); const int Rb = Epi::PERM ? ((R & ~31) + perm32(R & 31)) : R;
        voffA[i] = (unsigned)(R * K + C) * 2u; voffB[i] = (unsigned)(Rb * K + C) * 2u; }
    const size_t kstep = (size_t)(BK * 2);
    const size_t hstep = (size_t)HALF * K * 2;
    const size_t tstep = 2 * hstep;
    const unsigned ldsw = (unsigned)wid * 1024u;
    const int aoff = lds_byte(wr * 64 + fr, fq * 8), boff = lds_byte(wc * 32 + fr, fq * 8);
#define PG8_SA(b, h) (((b) * 2 + (h)) * HTB)
#define PG8_SB(b, h) ((4 + (b) * 2 + (h)) * HTB)
#define PG8_STAGE(bufoff, gbase, voff) do { _Pragma("unroll") for (int _i = 0; _i < 2; ++_i) \
        __builtin_amdgcn_global_load_lds((const unsigned*)((const char*)(gbase) + (voff)[_i]), (PG8_LAS unsigned*)(lds + (bufoff) + ldsw + _i * 8192), 16, 0, 0); } while (0)
#define PG8_LDA(dst, b, h) do { _Pragma("unroll") for (int m = 0; m < 4; ++m) _Pragma("unroll") for (int k = 0; k < 2; ++k) dst[m][k] = *(const PG8_LAS bf16x8*)(lds + PG8_SA(b, h) + aoff + m * 2048 + k * 1024); } while (0)
#define PG8_LDB(dst, b, h) do { _Pragma("unroll") for (int n = 0; n < 2; ++n) _Pragma("unroll") for (int k = 0; k < 2; ++k) dst[n][k] = *(const PG8_LAS bf16x8*)(lds + PG8_SB(b, h) + boff + n * 2048 + k * 1024); } while (0)
#define PG8_MMA(ai, bj, At, Bt) do { __builtin_amdgcn_s_setprio(1); _Pragma("unroll") for (int m = 0; m < 4; ++m) _Pragma("unroll") for (int n = 0; n < 2; ++n) _Pragma("unroll") for (int k = 0; k < 2; ++k) \
        acc[ai][bj][m][n] = __builtin_amdgcn_mfma_f32_16x16x32_bf16(Bt[n][k], At[m][k], acc[ai][bj][m][n], 0, 0, 0); __builtin_amdgcn_s_setprio(0); } while (0)
#define PG8_WAIT_V(n) asm volatile("s_waitcnt vmcnt(" #n ")" ::: "memory")
#define PG8_WAIT_L(n) asm volatile("s_waitcnt lgkmcnt(" #n ")" ::: "memory")
#define PG8_BAR __builtin_amdgcn_s_barrier()
#define PG8_SCHED __builtin_amdgcn_sched_barrier(0)
    Unit cur, nxt; int ui = 0;
    if (!S.next(0, cur)) return;
    f32x4 acc[2][2][4][2];
#pragma unroll
    for (int a = 0; a < 2; ++a)
#pragma unroll
        for (int b = 0; b < 2; ++b)
#pragma unroll
            for (int m = 0; m < 4; ++m)
#pragma unroll
                for (int n = 0; n < 2; ++n) acc[a][b][m][n] = (f32x4){0.f, 0.f, 0.f, 0.f};
    bf16x8 At[4][2], B0[2][2], B1[2][2];
    const char* cA = (const char*)g.A + (size_t)cur.pm * tstep; const char* cB = (const char*)g.Bt + (size_t)cur.pn * tstep;
    S.a_ready(cur);
    if constexpr (SP2) {
        PG8_STAGE(PG8_SB(0, 0), cB, voffB); PG8_STAGE(PG8_SB(0, 1), cB + hstep, voffB); PG8_STAGE(PG8_SA(0, 0), cA, voffA); PG8_STAGE(PG8_SA(0, 1), cA + hstep, voffA);
        if (wr == 1) PG8_BAR;
        PG8_WAIT_V(2); PG8_BAR;
        PG8_STAGE(PG8_SB(1, 0), cB + kstep, voffB); PG8_STAGE(PG8_SA(1, 0), cA + kstep, voffA); PG8_STAGE(PG8_SB(1, 1), cB + hstep + kstep, voffB);
        PG8_WAIT_V(6); PG8_BAR;
    } else {
        PG8_STAGE(PG8_SB(0, 0), cB, voffB); PG8_STAGE(PG8_SA(0, 0), cA, voffA); PG8_STAGE(PG8_SB(0, 1), cB + hstep, voffB); PG8_STAGE(PG8_SA(0, 1), cA + hstep, voffA);
        if (wr == 1) PG8_BAR;
        PG8_WAIT_V(4); PG8_BAR;
        PG8_STAGE(PG8_SB(1, 0), cB + kstep, voffB); PG8_STAGE(PG8_SA(1, 0), cA + kstep, voffA); PG8_STAGE(PG8_SB(1, 1), cB + hstep + kstep, voffB);
        PG8_WAIT_V(6); PG8_BAR;
    }
    for (;;) {
        const bool has_next = S.next(ui + 1, nxt);
        const char* nA = has_next ? (const char*)g.A + (size_t)nxt.pm * tstep : cA; const char* nB = has_next ? (const char*)g.Bt + (size_t)nxt.pn * tstep : cB;
        for (int t = 0; t < nt; t += 2) {
            const bool last = (t == nt - 2);
            const char* a1 = cA + (size_t)(t + 1) * kstep;
            const char* a2 = last ? nA : cA + (size_t)(t + 2) * kstep; const char* b2 = last ? nB : cB + (size_t)(t + 2) * kstep;
            const char* a3 = a2 + kstep; const char* b3 = b2 + kstep;
            if (last && has_next) S.a_ready(nxt);
            if constexpr (SP2) {
            PG8_LDB(B0, 0, 0); PG8_LDB(B1, 0, 1); PG8_SCHED; PG8_LDA(At, 0, 0); PG8_STAGE(PG8_SA(1, 1), a1 + hstep, voffA);
            PG8_WAIT_V(8); PG8_WAIT_L(0); PG8_BAR; PG8_MMA(0, 0, At, B0); PG8_MMA(0, 1, At, B1); PG8_BAR; PG8_SCHED;
            PG8_LDA(At, 0, 1); PG8_STAGE(PG8_SB(0, 0), b2, voffB); PG8_STAGE(PG8_SB(0, 1), b2 + hstep, voffB); PG8_STAGE(PG8_SA(0, 0), a2, voffA);
            PG8_WAIT_V(8); PG8_WAIT_L(0); PG8_BAR; PG8_MMA(1, 0, At, B0); PG8_MMA(1, 1, At, B1); PG8_BAR; PG8_SCHED;
            PG8_LDB(B0, 1, 0); PG8_LDB(B1, 1, 1); PG8_SCHED; PG8_LDA(At, 1, 0); PG8_STAGE(PG8_SA(0, 1), a2 + hstep, voffA);
            PG8_WAIT_V(8); PG8_WAIT_L(0); PG8_BAR; PG8_MMA(0, 0, At, B0); PG8_MMA(0, 1, At, B1); PG8_BAR; PG8_SCHED;
            PG8_LDA(At, 1, 1); PG8_STAGE(PG8_SB(1, 0), b3, voffB); PG8_STAGE(PG8_SB(1, 1), b3 + hstep, voffB); PG8_STAGE(PG8_SA(1, 0), a3, voffA);
            PG8_WAIT_V(8); PG8_WAIT_L(0); PG8_BAR; PG8_MMA(1, 0, At, B0); PG8_MMA(1, 1, At, B1); PG8_BAR; PG8_SCHED;
            } else {
            PG8_LDB(B0, 0, 0); PG8_SCHED; PG8_LDA(At, 0, 0); PG8_STAGE(PG8_SA(1, 1), a1 + hstep, voffA);
            PG8_WAIT_L(8); PG8_BAR; PG8_WAIT_L(0); PG8_MMA(0, 0, At, B0); PG8_BAR; PG8_SCHED;
            PG8_LDB(B1, 0, 1); PG8_STAGE(PG8_SB(0, 0), b2, voffB);
            PG8_BAR; PG8_WAIT_L(0); PG8_MMA(0, 1, At, B1); PG8_BAR;
            PG8_LDA(At, 0, 1); PG8_STAGE(PG8_SA(0, 0), a2, voffA);
            PG8_BAR; PG8_WAIT_L(0); PG8_MMA(1, 0, At, B0); PG8_BAR; PG8_SCHED;
            PG8_STAGE(PG8_SB(0, 1), b2 + hstep, voffB);
            PG8_WAIT_V(6); PG8_BAR; PG8_MMA(1, 1, At, B1); PG8_BAR;
            PG8_LDB(B0, 1, 0); PG8_SCHED; PG8_LDA(At, 1, 0); PG8_STAGE(PG8_SA(0, 1), a2 + hstep, voffA);
            PG8_WAIT_L(8); PG8_BAR; PG8_WAIT_L(0); PG8_MMA(0, 0, At, B0); PG8_BAR; PG8_SCHED;
            PG8_LDB(B1, 1, 1); PG8_STAGE(PG8_SB(1, 0), b3, voffB);
            PG8_BAR; PG8_WAIT_L(0); PG8_MMA(0, 1, At, B1); PG8_BAR;
            PG8_LDA(At, 1, 1); PG8_STAGE(PG8_SA(1, 0), a3, voffA);
            PG8_BAR; PG8_WAIT_L(0); PG8_MMA(1, 0, At, B0); PG8_BAR; PG8_SCHED;
            PG8_STAGE(PG8_SB(1, 1), b3 + hstep, voffB);
            PG8_WAIT_V(6); PG8_BAR; PG8_MMA(1, 1, At, B1); PG8_BAR;
            }
        }
        if constexpr (ALIGN_EPI) { if (wr == 0) PG8_BAR; }
        if constexpr (!Epi::AFTER_DRAIN) { E(acc, cur, wr, wc, fr, fq); S.done(cur); }
        if (!has_next) break;
#pragma unroll
        for (int a = 0; a < 2; ++a)
#pragma unroll
            for (int b = 0; b < 2; ++b)
#pragma unroll
                for (int m = 0; m < 4; ++m)
#pragma unroll
                    for (int n = 0; n < 2; ++n) acc[a][b][m][n] = (f32x4){0.f, 0.f, 0.f, 0.f};
        cur = nxt; cA = nA; cB = nB; ++ui;
        if constexpr (ALIGN_EPI) { if (wr == 1) PG8_BAR; }
    }
    PG8_WAIT_V(0);
    if constexpr (!ALIGN_EPI) { if (wr == 0) PG8_BAR; }
    PG8_BAR;
    if constexpr (Epi::AFTER_DRAIN) { E.fused(acc, cur, wr, wc, fr, fq, lds, wid, lane); S.done(cur); }
#undef PG8_SA
#undef PG8_SB
#undef PG8_STAGE
#undef PG8_LDA
#undef PG8_LDB
#undef PG8_MMA
#undef PG8_WAIT_V
#undef PG8_WAIT_L
#undef PG8_BAR
#undef PG8_SCHED
}
}

DEV void transpose_item(float* scr, const float* W, int K, int N, int Npad, bf16_t* WT, int item, int lane) {
    const int nblk = Npad / 32, kb = item / nblk, nb = item % nblk, k0 = 64 * kb, n0 = 32 * nb;
    const bool valid = (n0 < N);
    float v[32];
#pragma unroll
    for (int i = 0; i < 32; ++i) { const int kk = 2 * i + (lane >> 5); v[i] = valid ? W[(size_t)(k0 + kk) * N + n0 + (lane & 31)] : 0.f; }
#pragma unroll
    for (int i = 0; i < 32; ++i) { const int kk = 2 * i + (lane >> 5); scr[kk * 33 + (lane & 31)] = v[i]; }
    asm volatile("s_waitcnt lgkmcnt(0)" ::: "memory");
    const int c = lane & 7;
#pragma unroll
    for (int j = 0; j < 4; ++j) { const int n = (lane >> 3) + 8 * j; const float* sp = scr + (8 * c) * 33 + n; float o[8];
#pragma unroll
        for (int e = 0; e < 8; ++e) o[e] = sp[e * 33];
        *(u32x4*)(WT + (size_t)(n0 + n) * K + k0 + 8 * c) = pack8(o); }
    asm volatile("s_waitcnt lgkmcnt(0)" ::: "memory");
}

DEV void mod_item(char* lds, const Params& p, int item) {
    const int layer = item / 96, n0 = (item % 96) * 32, tid = TID();
    float* s = (float*)lds;
    float* red = s + 9 * 1024;
    for (int i = tid; i < 9 * 1024; i += 512) { const int v = i >> 10, k = i & 1023; const float cv = (v < 8) ? p.c[v * 1024 + k] : p.c_ctx[k]; s[i] = silu(cv); }
    __syncthreads();
    const int kc = tid >> 5, n = tid & 31; const float* W = p.ada_w + (size_t)layer * DM * 3072 + n0 + n;
    float acc[9];
#pragma unroll
    for (int v = 0; v < 9; ++v) acc[v] = 0.f;
#pragma unroll 16
    for (int kk = 0; kk < 64; ++kk) { const int k = kc * 64 + kk; const float w = W[(size_t)k * 3072];
#pragma unroll
        for (int v = 0; v < 9; ++v) acc[v] += s[v * 1024 + k] * w; }
#pragma unroll
    for (int v = 0; v < 9; ++v) red[(kc * 9 + v) * 32 + n] = acc[v];
    __syncthreads();
    if (tid < 9 * 32) { const int v = tid >> 5, nn = tid & 31; float t = 0.f;
#pragma unroll
        for (int k2 = 0; k2 < 16; ++k2) t += red[(k2 * 9 + v) * 32 + nn];
        t += p.ada_b[layer * 3072 + n0 + nn];
        if (layer == 0) ((float*)(p.ws + WS_MOD0))[v * 3072 + n0 + nn] = t;
        else if (v < 8) ((float*)(p.ws + WS_MOD1))[v * 3072 + n0 + nn] = t; }
    __syncthreads();
}

DEV void hid2_row(char* lds, const Params& p, int t, int wid, int lane) {
    float* sc = (float*)lds + wid * 128;
    const float tn = (float)t * (1.0f / 4095.0f);
    const float w = (float)(2.0 * 3.14159265358979323846 / 4096.0) * (float)t;
    float e = 0.f;
    if (lane == 0) e = tn;
    else if (lane <= 32) { const int k = (lane - 1) & 15; const float band = 1e-4f + (float)k * ((15.0f - 1e-4f) / 15.0f); const float ang = w * band; e = (lane <= 16) ? cosf(ang) : -sinf(ang); }
    sc[lane] = e;
    asm volatile("s_waitcnt lgkmcnt(0)" ::: "memory");
    float a = p.f_b1[lane];
    for (int i = 0; i < 33; ++i) a += sc[i] * p.f_w1[i * 64 + lane];
    const float fr = p.freq[lane];
    const float h1 = sinf(fr * a);
    sc[64 + lane] = h1;
    asm volatile("s_waitcnt lgkmcnt(0)" ::: "memory");
    float a2 = p.f_b2[lane];
    for (int i = 0; i < 64; ++i) a2 += sc[64 + i] * p.f_w2[i * 64 + lane];
    const float h2 = sinf(fr * a2);
    ((bf16_t*)(p.ws + WS_HID2))[t * 64 + lane] = f2bf(h2);
    asm volatile("s_waitcnt lgkmcnt(0)" ::: "memory");
}

DEV void phase_prep(char* lds, const Params& p) {
    const int tid = TID(), wid = tid >> 6, lane = tid & 63;
    { const int gt = blockIdx.x * 512 + tid;
        if (gt < 2048) ((float*)(p.ws + WS_SSUM))[gt] = 0.f;
        float* rp = (float*)(p.ws + WS_ROPE);
        if (gt < 1024) { const int pos = gt >> 4, i = gt & 15; const float inv = exp2f(-(float)i * (13.287712379549449f / 16.0f)); const float ang = (float)pos * inv; rp[gt] = cosf(ang); rp[1024 + gt] = sinf(ang); }
        if (gt < 512) { const int pos = gt >> 3, i = gt & 7; const float inv = exp2f(-(float)i * (13.287712379549449f / 8.0f)); const float ang = (float)pos * inv; rp[2048 + gt] = cosf(ang); rp[2560 + gt] = sinf(ang); } }
    for (int it = blockIdx.x; it < 192; it += gridDim.x) mod_item(lds, p, it);
    for (int t = blockIdx.x * 8 + wid; t < 4096; t += gridDim.x * 8) hid2_row(lds, p, t, wid, lane);
    __syncthreads();
    constexpr int I_WIN = 16 * (AINP / 32), I_UQ = 4 * 24, I_UKV = 2 * 32, I_WO = 16 * 32, I_HIN = 16 * 128, I_HO = 16 * 32, I_W3 = 128;
    constexpr int NIT = I_WIN + I_UQ + I_UKV + I_WO + I_HIN + I_HO + I_W3;
    float* scr = (float*)lds + wid * (64 * 33);
    for (int it = blockIdx.x * 8 + wid; it < NIT; it += gridDim.x * 8) {
        int r = it;
        if (r < I_HIN) { transpose_item(scr, p.hy_w_in, 1024, 4096, 4096, (bf16_t*)(p.ws + WS_HWIN), r, lane); continue; } r -= I_HIN;
        if (r < I_WIN) { transpose_item(scr, p.w_in, 1024, AIN, AINP, (bf16_t*)(p.ws + WS_WIN), r, lane); continue; } r -= I_WIN;
        if (r < I_WO) { transpose_item(scr, p.w_out, 1024, 1024, 1024, (bf16_t*)(p.ws + WS_WOUT), r, lane); continue; } r -= I_WO;
        if (r < I_HO) { transpose_item(scr, p.hy_w_out, 1024, 1024, 1024, (bf16_t*)(p.ws + WS_HWOUT), r, lane); continue; } r -= I_HO;
        if (r < I_UQ) { transpose_item(scr, p.w_uq, 256, 768, 768, (bf16_t*)(p.ws + WS_WUQ), r, lane); continue; } r -= I_UQ;
        if (r < I_UKV) { transpose_item(scr, p.w_ukv, 128, 1024, 1024, (bf16_t*)(p.ws + WS_WUKV), r, lane); continue; } r -= I_UKV;
        transpose_item(scr, p.f_w3, 64, 4096, 4096, (bf16_t*)(p.ws + WS_W3), r, lane);
    }
}

DEV void row_load(f32x4 (&v)[4], const float* xr, int lane) {
#pragma unroll
    for (int j = 0; j < 4; ++j) v[j] = *(const f32x4*)(xr + lane * 4 + 256 * j);
}
DEV void modnorm_row(const f32x4 (&v)[4], const float* nw, const float* shift, const float* scale, bf16_t* orow, int lane) {
    float s = 0.f;
#pragma unroll
    for (int j = 0; j < 4; ++j) s += v[j].x * v[j].x + v[j].y * v[j].y + v[j].z * v[j].z + v[j].w * v[j].w;
    const float r = rsqrtf(wave_sum(s) * (1.0f / DM) + EPS);
#pragma unroll
    for (int j = 0; j < 4; ++j) { const int c0 = lane * 4 + 256 * j;
        const f32x4 w = *(const f32x4*)(nw + c0), sh = *(const f32x4*)(shift + c0), sc = *(const f32x4*)(scale + c0);
        const float o0 = v[j].x * r * w.x * (1.f + sc.x) + sh.x, o1 = v[j].y * r * w.y * (1.f + sc.y) + sh.y, o2 = v[j].z * r * w.z * (1.f + sc.z) + sh.z, o3 = v[j].w * r * w.w * (1.f + sc.w) + sh.w;
        u32x2 pk; pk.x = pk2(o0, o1); pk.y = pk2(o2, o3); *(u32x2*)(orow + c0) = pk; }
}
DEV const float* norm0_src(const Params& p, int row) { return row < NTOK ? p.x + (size_t)row * DM : p.ctx + (size_t)(row - NTOK) * DM; }
DEV void phase_norm0(const Params& p) {
    const int wid = TID() >> 6, lane = TID() & 63; const float* mod0 = (const float*)(p.ws + WS_MOD0); bf16_t* H0 = (bf16_t*)(p.ws + WS_H0);
    const int stride = gridDim.x * 8; int row = blockIdx.x * 8 + wid;
    f32x4 cur[4], nxt[4];
    if (row < NALL) row_load(cur, norm0_src(p, row), lane);
    for (; row < NALL; row += stride) {
        { const int rn = row + stride < NALL ? row + stride : row; row_load(nxt, norm0_src(p, rn), lane); }
        const int v = row < NTOK ? (row >> 12) : 8;
        modnorm_row(cur, p.norm_w, mod0 + v * 3072, mod0 + v * 3072 + 1024, H0 + (size_t)row * DM, lane);
#pragma unroll
        for (int j = 0; j < 4; ++j) cur[j] = nxt[j];
    }
}
DEV void phase_norm1(const Params& p) {
    const int wid = TID() >> 6, lane = TID() & 63; const float* mod1 = (const float*)(p.ws + WS_MOD1); bf16_t* H1 = (bf16_t*)(p.ws + WS_H1);
    const int stride = gridDim.x * 8; int row = blockIdx.x * 8 + wid;
    f32x4 cur[4], nxt[4];
    if (row < NTOK) row_load(cur, p.out + (size_t)row * DM, lane);
    for (; row < NTOK; row += stride) {
        { const int rn = row + stride < NTOK ? row + stride : row; row_load(nxt, p.out + (size_t)rn * DM, lane); }
        const int v = row >> 12;
        modnorm_row(cur, p.norm_w + DM, mod1 + v * 3072, mod1 + v * 3072 + 1024, H1 + (size_t)row * DM, lane);
#pragma unroll
        for (int j = 0; j < 4; ++j) cur[j] = nxt[j];
    }
}
DEV void phase_final(const Params& p) {
    const int wid = TID() >> 6, lane = TID() & 63;
    const int stride = gridDim.x * 8; int row = blockIdx.x * 8 + wid;
    f32x4 v[4], nxt[4];
    if (row < NTOK) row_load(v, p.out + (size_t)row * DM, lane);
    for (; row < NTOK; row += stride) {
        { const int rn = row + stride < NTOK ? row + stride : row; row_load(nxt, p.out + (size_t)rn * DM, lane); }
        float* xr = p.out + (size_t)row * DM; float s = 0.f;
#pragma unroll
        for (int j = 0; j < 4; ++j) s += v[j].x * v[j].x + v[j].y * v[j].y + v[j].z * v[j].z + v[j].w * v[j].w;
        const float r = rsqrtf(wave_sum(s) * (1.0f / DM) + EPS);
#pragma unroll
        for (int j = 0; j < 4; ++j) { const int c0 = lane * 4 + 256 * j; const f32x4 w = *(const f32x4*)(p.final_w + c0);
            f32x4 o; o.x = v[j].x * r * w.x; o.y = v[j].y * r * w.y; o.z = v[j].z * r * w.z; o.w = v[j].w * r * w.w; *(f32x4*)(xr + c0) = o; }
#pragma unroll
        for (int j = 0; j < 4; ++j) v[j] = nxt[j];
    }
}

struct PostIn { u32x4 raw[5]; f32x4 c64[2], s64[2], c32[2], s32[2]; };
DEV void post_load(PostIn& I, const bf16_t* PRAW, const float* rp, int tok, int lane) {
    const bf16_t* pr = PRAW + (size_t)tok * AINP;
#pragma unroll
    for (int sgm = 0; sgm < 4; ++sgm) I.raw[sgm] = *(const u32x4*)(pr + 512 * sgm + lane * 8);
    I.raw[4] = *(const u32x4*)(pr + 2048 + (lane & 31) * 8);
    const int l = tok & 4095, prow = l >> 6, pcol = l & 63;
    const int k = lane & 7, posv = (k < 4) ? prow : pcol; const float* t64 = rp + posv * 16 + (k & 1) * 8;
    I.c64[0] = *(const f32x4*)t64; I.c64[1] = *(const f32x4*)(t64 + 4); I.s64[0] = *(const f32x4*)(t64 + 1024); I.s64[1] = *(const f32x4*)(t64 + 1028);
    const int k3 = lane & 3, posm = (k3 < 2) ? prow : pcol; const float* t32 = rp + 2048 + posm * 8;
    I.c32[0] = *(const f32x4*)t32; I.c32[1] = *(const f32x4*)(t32 + 4); I.s32[0] = *(const f32x4*)(t32 + 512); I.s32[1] = *(const f32x4*)(t32 + 516);
}
DEV void phase_post(const Params& p) {
    const int wid = TID() >> 6, lane = TID() & 63;
    const bf16_t* PRAW = (const bf16_t*)(p.ws + WS_PRAW);
    bf16_t* QA = (bf16_t*)(p.ws + WS_QA); bf16_t* KA = (bf16_t*)(p.ws + WS_KA); bf16_t* VA = (bf16_t*)(p.ws + WS_VA);
    bf16_t* CQN = (bf16_t*)(p.ws + WS_CQN); bf16_t* CKVN = (bf16_t*)(p.ws + WS_CKVN); bf16_t* G = (bf16_t*)(p.ws + WS_G); bf16_t* KM = (bf16_t*)(p.ws + WS2_KM);
    const float* rp = (const float*)(p.ws + WS_ROPE);
    float wq[8], wk[8], wcq[8], wckv[8];
    { const int k = lane & 7;
#pragma unroll
        for (int j = 0; j < 8; ++j) { wq[j] = p.q_norm[k * 8 + j]; wk[j] = p.k_norm[k * 8 + j]; wcq[j] = p.cq_norm[(lane & 31) * 8 + j]; wckv[j] = p.ckv_norm[(lane & 15) * 8 + j]; } }
    const int stride = gridDim.x * 8;
    int tok = blockIdx.x * 8 + wid;
    PostIn cur, nxt;
    if (tok < NALL) post_load(cur, PRAW, rp, tok, lane);
    for (; tok < NALL; tok += stride) {
        { const int tn = tok + stride < NALL ? tok + stride : tok; post_load(nxt, PRAW, rp, tn, lane); }
        const bool lat = tok < NTOK; int b, pos;
        if (lat) { b = tok >> 12; pos = CTXL + (tok & 4095); } else { const int j = tok - NTOK; b = j >> 8; pos = j & 255; }
        const size_t kvrow = (size_t)b * LK + pos;
        const float cs64[8] = {cur.c64[0].x, cur.c64[0].y, cur.c64[0].z, cur.c64[0].w, cur.c64[1].x, cur.c64[1].y, cur.c64[1].z, cur.c64[1].w};
        const float sn64[8] = {cur.s64[0].x, cur.s64[0].y, cur.s64[0].z, cur.s64[0].w, cur.s64[1].x, cur.s64[1].y, cur.s64[1].z, cur.s64[1].w};
        float v[8], o[8];
        if (lat) {
            unpack8(cur.raw[0], v);
            float ss = 0.f;
#pragma unroll
            for (int j = 0; j < 8; ++j) ss += v[j] * v[j];
            ss += __shfl_xor(ss, 1); ss += __shfl_xor(ss, 2); ss += __shfl_xor(ss, 4);
            const float r = rsqrtf(ss * (1.0f / 64.0f) + EPS); const int k = lane & 7;
#pragma unroll
            for (int j = 0; j < 8; ++j) v[j] = v[j] * r * wq[j];
#pragma unroll
            for (int j = 0; j < 8; ++j) { const float ot = __shfl_xor(v[j], 2);
                o[j] = ((k & 2) ? (v[j] * cs64[j] + ot * sn64[j]) : (v[j] * cs64[j] - ot * sn64[j])) * QSC_A; }
            *(u32x4*)(QA + (size_t)tok * 512 + lane * 8) = pack8(o);
        }
        {
            const u32x4 raw = cur.raw[1]; unpack8(raw, v);
            float ss = 0.f;
#pragma unroll
            for (int j = 0; j < 8; ++j) ss += v[j] * v[j];
            ss += __shfl_xor(ss, 1); ss += __shfl_xor(ss, 2); ss += __shfl_xor(ss, 4);
            const float s8 = ss;
            ss += __shfl_xor(ss, 8); ss += __shfl_xor(ss, 16);
            const float s32 = ss;
            float vn[8]; const int k = lane & 7;
            { const float r = rsqrtf(s8 * (1.0f / 64.0f) + EPS);
#pragma unroll
                for (int j = 0; j < 8; ++j) vn[j] = v[j] * r * wk[j]; }
#pragma unroll
            for (int j = 0; j < 8; ++j) { const float ot = __shfl_xor(vn[j], 2);
                o[j] = lat ? ((k & 2) ? (vn[j] * cs64[j] + ot * sn64[j]) : (vn[j] * cs64[j] - ot * sn64[j])) : vn[j]; }
            if (lane < 16) *(u32x4*)(KA + kvrow * 128 + lane * 8) = pack8(o);
            else if (lane < 32) *(u32x4*)(VA + kvrow * 128 + (lane - 16) * 8) = raw;
            else if (lat) { const float r = rsqrtf(s32 * (1.0f / 256.0f) + EPS); const int cb = (lane - 32) * 8;
#pragma unroll
                for (int j = 0; j < 8; ++j) o[j] = v[j] * r * wcq[j];
                *(u32x4*)(CQN + (size_t)tok * 256 + cb) = pack8(o); }
        }
        {
            unpack8(cur.raw[2], v);
            float ss = 0.f;
#pragma unroll
            for (int j = 0; j < 8; ++j) ss += v[j] * v[j];
            ss += __shfl_xor(ss, 1); ss += __shfl_xor(ss, 2); ss += __shfl_xor(ss, 4); ss += __shfl_xor(ss, 8);
            const int k = lane & 3;
            float oth[8];
#pragma unroll
            for (int j = 0; j < 8; ++j) oth[j] = __shfl_xor(v[j], 1);
            if (lane < 16) { const float r = rsqrtf(ss * (1.0f / 128.0f) + EPS);
#pragma unroll
                for (int j = 0; j < 8; ++j) o[j] = v[j] * r * wckv[j];
                *(u32x4*)(CKVN + kvrow * 128 + lane * 8) = pack8(o); }
            else if (lane < 20) {
                const float cs32[8] = {cur.c32[0].x, cur.c32[0].y, cur.c32[0].z, cur.c32[0].w, cur.c32[1].x, cur.c32[1].y, cur.c32[1].z, cur.c32[1].w};
                const float sn32[8] = {cur.s32[0].x, cur.s32[0].y, cur.s32[0].z, cur.s32[0].w, cur.s32[1].x, cur.s32[1].y, cur.s32[1].z, cur.s32[1].w};
#pragma unroll
                for (int j = 0; j < 8; ++j) o[j] = lat ? ((k & 1) ? (v[j] * cs32[j] + oth[j] * sn32[j]) : (v[j] * cs32[j] - oth[j] * sn32[j])) : v[j];
                const u32x4 w = pack8(o);
#pragma unroll
                for (int h = 0; h < 8; ++h) *(u32x4*)(KM + kvrow * 768 + h * 96 + 64 + k * 8) = w; }
            else if (lat) {
#pragma unroll
                for (int j = 0; j < 8; ++j) o[j] = silu(v[j]);
                *(u32x4*)(G + (size_t)tok * 1024 + (lane - 20) * 8) = pack8(o); }
        }
        if (lat) {
            unpack8(cur.raw[3], v);
#pragma unroll
            for (int j = 0; j < 8; ++j) o[j] = silu(v[j]);
            *(u32x4*)(G + (size_t)tok * 1024 + 352 + lane * 8) = pack8(o);
            if (lane < 20) { unpack8(cur.raw[4], v);
#pragma unroll
                for (int j = 0; j < 8; ++j) o[j] = silu(v[j]);
                *(u32x4*)(G + (size_t)tok * 1024 + 864 + lane * 8) = pack8(o); }
        }
        cur = nxt;
    }
}

template <int DQK>
DEV void attn_unit(char* lds, const bf16_t* __restrict__ Q, int ldq, int qcol, const bf16_t* __restrict__ Kp, int ldk, int kcol, const bf16_t* __restrict__ Vp, int ldv, int vcol,
                   const bf16_t* __restrict__ Gt, bf16_t* OG, int ocol, int b, int q0) {
    constexpr int KRS = (DQK + 8) * 2, KB = 64 * KRS, VRS = 192, VB = 64 * VRS, STG = KB + VB, NKS = DQK / 16, KCH = DQK / 8;
    const int tid = TID(), lane = tid & 63, wid = tid >> 6, l31 = lane & 31, hi = lane >> 5;
    bf16x8 qf[NKS];
    { const bf16_t* qp = Q + (size_t)(b * SEQ + q0 + wid * 32 + l31) * ldq + qcol + hi * 8;
#pragma unroll
        for (int ks = 0; ks < NKS; ++ks) qf[ks] = *(const bf16x8*)(qp + ks * 16); }
    const bf16_t* kbase = Kp + (size_t)b * LK * ldk + kcol; const bf16_t* vbase = Vp + (size_t)b * LK * ldv + vcol;
    const int kr0 = tid / KCH, kc0 = tid % KCH;
    const int kr1 = (tid + 512) / KCH, kc1 = (tid + 512) % KCH;
    const bool k2 = (KCH * 64 > 512) && (tid + 512 < KCH * 64);
    const int vr = tid >> 3, vc = tid & 7;
    u32x4 sk0, sk1, sv;
#define A_LOAD(t) do { const size_t kp_ = (size_t)(t) * 64; sk0 = *(const u32x4*)(kbase + (kp_ + kr0) * ldk + kc0 * 8); \
        if (k2) sk1 = *(const u32x4*)(kbase + (kp_ + kr1) * ldk + kc1 * 8); sv = *(const u32x4*)(vbase + (kp_ + vr) * ldv + vc * 8); } while (0)
#define A_STORE(buf) do { char* b_ = lds + (buf) * STG; *(u32x4*)(b_ + kr0 * KRS + kc0 * 16) = sk0; if (k2) *(u32x4*)(b_ + kr1 * KRS + kc1 * 16) = sk1; \
        *(u32x4*)(b_ + KB + vr * VRS + vc * 16) = sv; } while (0)
    f32x16 o0, o1;
#pragma unroll
    for (int r = 0; r < 16; ++r) { o0[r] = 0.f; o1[r] = 0.f; }
    float m_run = -1e30f, l_run = 0.f;
    const int g1 = (lane >> 4) & 1, tq = (lane & 15) >> 2, tp = lane & 3;
    const int vt_off = KB + (4 * hi + tq) * VRS + (16 * g1 + 4 * tp) * 2;
    const int kf_off = l31 * KRS + hi * 16;
    constexpr int NT = LK / 64;
    A_LOAD(0); A_STORE(0);
    __syncthreads();
    for (int t = 0; t < NT; ++t) {
        const bool more = (t + 1 < NT);
        if (more) A_LOAD(t + 1);
        const char* b_ = lds + (t & 1) * STG;
        f32x16 p0, p1;
#pragma unroll
        for (int r = 0; r < 16; ++r) { p0[r] = 0.f; p1[r] = 0.f; }
#pragma unroll
        for (int ks = 0; ks < NKS; ++ks) {
            const bf16x8 ka = *(const bf16x8*)(b_ + kf_off + ks * 32);
            const bf16x8 kb = *(const bf16x8*)(b_ + kf_off + 32 * KRS + ks * 32);
            p0 = __builtin_amdgcn_mfma_f32_32x32x16_bf16(ka, qf[ks], p0, 0, 0, 0);
            p1 = __builtin_amdgcn_mfma_f32_32x32x16_bf16(kb, qf[ks], p1, 0, 0, 0);
        }
        float mx = p0[0];
#pragma unroll
        for (int r = 1; r < 16; ++r) mx = fmaxf(mx, p0[r]);
#pragma unroll
        for (int r = 0; r < 16; ++r) mx = fmaxf(mx, p1[r]);
        mx = fmaxf(mx, __shfl_xor(mx, 32));
        const float m_new = fmaxf(m_run, mx);
        const float alpha = __builtin_amdgcn_exp2f(m_run - m_new);
        m_run = m_new;
        float ls = 0.f;
#pragma unroll
        for (int r = 0; r < 16; ++r) { p0[r] = __builtin_amdgcn_exp2f(p0[r] - m_new); p1[r] = __builtin_amdgcn_exp2f(p1[r] - m_new); ls += p0[r] + p1[r]; }
        l_run = l_run * alpha + ls;
#pragma unroll
        for (int r = 0; r < 16; ++r) { o0[r] *= alpha; o1[r] *= alpha; }
        u32x4 pw[4];
        pw[0] = (u32x4){pk2(p0[0], p0[1]), pk2(p0[2], p0[3]), pk2(p0[4], p0[5]), pk2(p0[6], p0[7])};
        pw[1] = (u32x4){pk2(p0[8], p0[9]), pk2(p0[10], p0[11]), pk2(p0[12], p0[13]), pk2(p0[14], p0[15])};
        pw[2] = (u32x4){pk2(p1[0], p1[1]), pk2(p1[2], p1[3]), pk2(p1[4], p1[5]), pk2(p1[6], p1[7])};
        pw[3] = (u32x4){pk2(p1[8], p1[9]), pk2(p1[10], p1[11]), pk2(p1[12], p1[13]), pk2(p1[14], p1[15])};
#pragma unroll
        for (int s = 0; s < 4; ++s) {
            const bf16x8 pb = __builtin_bit_cast(bf16x8, pw[s]);
#pragma unroll
            for (int dt = 0; dt < 2; ++dt) {
                const char* vp = b_ + vt_off + s * 16 * VRS + dt * 64;
                const s16x4 lo = __builtin_bit_cast(s16x4, __builtin_amdgcn_ds_read_tr16_b64_v4i16((LAS s16x4*)vp));
                const s16x4 hh = __builtin_bit_cast(s16x4, __builtin_amdgcn_ds_read_tr16_b64_v4i16((LAS s16x4*)(vp + 8 * VRS)));
                const bf16x8 vf = (bf16x8){lo[0], lo[1], lo[2], lo[3], hh[0], hh[1], hh[2], hh[3]};
                if (dt == 0) o0 = __builtin_amdgcn_mfma_f32_32x32x16_bf16(vf, pb, o0, 0, 0, 0);
                else o1 = __builtin_amdgcn_mfma_f32_32x32x16_bf16(vf, pb, o1, 0, 0, 0);
            }
        }
        if (more) A_STORE((t + 1) & 1);
        __syncthreads();
    }
#undef A_LOAD
#undef A_STORE
    const float lt = l_run + __shfl_xor(l_run, 32); const float inv = 1.0f / lt;
    const size_t tok = (size_t)(b * SEQ + q0 + wid * 32 + l31);
#pragma unroll
    for (int dt = 0; dt < 2; ++dt)
#pragma unroll
        for (int g = 0; g < 4; ++g) { const int d = 32 * dt + 8 * g + 4 * hi; const size_t off = tok * 1024 + ocol + d;
            const u32x2 gw = *(const u32x2*)(Gt + off);
            const f32x16& oo = dt ? o1 : o0;
            u32x2 w; w.x = pk2(oo[4 * g] * inv * lo_bf(gw.x), oo[4 * g + 1] * inv * hi_bf(gw.x)); w.y = pk2(oo[4 * g + 2] * inv * lo_bf(gw.y), oo[4 * g + 3] * inv * hi_bf(gw.y));
            *(u32x2*)(OG + off) = w; }
}

DEV float max3f_s(float a, float b, float c) { float r; asm("v_max3_f32 %0, %1, %2, %3" : "=v"(r) : "v"(a), "v"(b), "v"(c)); return r; }
DEV float max2f_s(float a, float b) { float r; asm("v_max_f32_e32 %0, %1, %2" : "=v"(r) : "v"(a), "v"(b)); return r; }
DEV float fadd_s(float a, float b) { float r; asm("v_add_f32_e32 %0, %1, %2" : "=v"(r) : "v"(a), "v"(b)); return r; }
DEV float swapmax32(float v) { auto rr = __builtin_amdgcn_permlane32_swap(__float_as_uint(v), __float_as_uint(v), false, false); return fmaxf(__uint_as_float(rr[0]), __uint_as_float(rr[1])); }
DEV float swapsum32(float v) { auto rr = __builtin_amdgcn_permlane32_swap(__float_as_uint(v), __float_as_uint(v), false, false); return __uint_as_float(rr[0]) + __uint_as_float(rr[1]); }
template <int DQK>
DEV void attn_unit2(char* lds, const bf16_t* __restrict__ Q, int ldq, int qcol, const bf16_t* __restrict__ Kp, int ldk, int kcol, const bf16_t* __restrict__ Vp, int ldv, int vcol,
                    const bf16_t* __restrict__ Gt, bf16_t* OG, int ocol, int b, int q0) {
    constexpr int KRS = (DQK + 8) * 2, KB = 64 * KRS, VRS = 192, VB = 64 * VRS, NKS = DQK / 16, KCH = DQK / 8, VOFF = 2 * KB;
    constexpr float THR = 8.0f;
    constexpr int NT = LK / 64;
    const int tid = TID(), lane = tid & 63, wid = tid >> 6, l31 = lane & 31, hi = lane >> 5;
    bf16x8 qf[NKS];
    { const bf16_t* qp = Q + (size_t)(b * SEQ + q0 + wid * 32 + l31) * ldq + qcol + hi * 8;
#pragma unroll
        for (int ks = 0; ks < NKS; ++ks) qf[ks] = *(const bf16x8*)(qp + ks * 16); }
    const bf16_t* kbase = Kp + (size_t)b * LK * ldk + kcol; const bf16_t* vbase = Vp + (size_t)b * LK * ldv + vcol;
    constexpr bool K2 = (KCH * 64 > 512);
    const bool k2 = K2 && (tid + 512 < KCH * 64);
    const int kr0 = tid / KCH, kc0 = tid % KCH, kr1 = k2 ? (tid + 512) / KCH : kr0, kc1 = k2 ? (tid + 512) % KCH : kc0;
    const int vr = tid >> 3, vc = tid & 7;
    u32x4 skX0, skX1 = {0u, 0u, 0u, 0u}, svX;
#define A_LOADK(t, S) do { const int tt_ = (t) < NT ? (t) : NT - 1; const size_t kp_ = (size_t)tt_ * 64; sk##S##0 = *(const u32x4*)(kbase + (kp_ + kr0) * ldk + kc0 * 8); if (K2) sk##S##1 = *(const u32x4*)(kbase + (kp_ + kr1) * ldk + kc1 * 8); } while (0)
#define A_LOADV(t, S) do { const int tt_ = (t) < NT ? (t) : NT - 1; sv##S = *(const u32x4*)(vbase + ((size_t)tt_ * 64 + vr) * ldv + vc * 8); } while (0)
#define A_STOREK(slot, S) do { char* b_ = lds + (slot) * KB; *(u32x4*)(b_ + kr0 * KRS + kc0 * 16) = sk##S##0; if (K2) *(u32x4*)(b_ + kr1 * KRS + kc1 * 16) = sk##S##1; } while (0)
#define A_STOREV(slot, S) do { *(u32x4*)(lds + VOFF + (slot) * VB + vr * VRS + vc * 16) = sv##S; } while (0)
    f32x16 o0, o1, negm;
#pragma unroll
    for (int r = 0; r < 16; ++r) { o0[r] = 0.f; o1[r] = 0.f; negm[r] = 0.f; }
    asm volatile("" : "+v"(negm));
    float mhat = 0.f, l_run = 0.f;
    const int g1 = (lane >> 4) & 1, tq = (lane & 15) >> 2, tp = lane & 3;
    const int vt_off = VOFF + (4 * hi + tq) * VRS + (16 * g1 + 4 * tp) * 2;
    const int kf_off = l31 * KRS + hi * 16;
#define A_QK(P0, P1, slot) do { const char* kb_ = lds + (slot) * KB + kf_off; \
        _Pragma("unroll") for (int ks = 0; ks < NKS; ++ks) { \
            const bf16x8 ka = *(const bf16x8*)(kb_ + ks * 32); const bf16x8 kb2 = *(const bf16x8*)(kb_ + 32 * KRS + ks * 32); \
            if (ks == 0) { P0 = __builtin_amdgcn_mfma_f32_32x32x16_bf16(ka, qf[0], negm, 0, 0, 0); P1 = __builtin_amdgcn_mfma_f32_32x32x16_bf16(kb2, qf[0], negm, 0, 0, 0); } \
            else { P0 = __builtin_amdgcn_mfma_f32_32x32x16_bf16(ka, qf[ks], P0, 0, 0, 0); P1 = __builtin_amdgcn_mfma_f32_32x32x16_bf16(kb2, qf[ks], P1, 0, 0, 0); } } } while (0)
    A_LOADK(0, X); A_LOADV(0, X); A_STOREK(0, X); A_STOREV(0, X); A_LOADK(1, X); A_STOREK(1, X);
    __syncthreads();
    f32x16 pA0, pA1, pB0, pB1;
#pragma unroll
    for (int r = 0; r < 16; ++r) { pB0[r] = 0.f; pB1[r] = 0.f; }
    A_QK(pA0, pA1, 0);
#define A_STEP(P0, P1, N0, N1, t, SL, SS) do { \
        A_LOADK((t) + 2, SL); A_LOADV((t) + 1, SL); \
        A_QK(N0, N1, ((t) + 1) & 1); \
        float a_ = fmaxf(fmaxf(P0[0], P0[1]), P1[0]), c_ = fmaxf(fmaxf(P0[2], P0[3]), P1[1]); a_ = fmaxf(fmaxf(a_, P1[2]), P1[3]); \
        _Pragma("unroll") for (int r = 4; r < 16; r += 4) { a_ = fmaxf(fmaxf(a_, P0[r]), P0[r + 1]); c_ = fmaxf(fmaxf(c_, P0[r + 2]), P0[r + 3]); a_ = fmaxf(fmaxf(a_, P1[r]), P1[r + 1]); c_ = fmaxf(fmaxf(c_, P1[r + 2]), P1[r + 3]); } \
        const float rm = swapmax32(fmaxf(a_, c_)); \
        if ((t) == 0 || __any(rm > THR)) { \
            const float dl = ((t) == 0) ? rm : fmaxf(rm, 0.f); mhat += dl; \
            _Pragma("unroll") for (int r = 0; r < 16; ++r) { P0[r] -= dl; P1[r] -= dl; N0[r] -= dl; N1[r] -= dl; } \
            if ((t) != 0) { const float f = __builtin_amdgcn_exp2f(-dl); l_run *= f; _Pragma("unroll") for (int r = 0; r < 16; ++r) { o0[r] *= f; o1[r] *= f; } } \
            _Pragma("unroll") for (int r = 0; r < 16; ++r) negm[r] = -mhat; asm volatile("" : "+v"(negm)); } \
        float ls = 0.f; \
        _Pragma("unroll") for (int r = 0; r < 16; ++r) { P0[r] = __builtin_amdgcn_exp2f(P0[r]); P1[r] = __builtin_amdgcn_exp2f(P1[r]); ls += P0[r] + P1[r]; } \
        l_run += ls; \
        u32x4 pw[4]; \
        pw[0] = (u32x4){pk2(P0[0], P0[1]), pk2(P0[2], P0[3]), pk2(P0[4], P0[5]), pk2(P0[6], P0[7])}; \
        pw[1] = (u32x4){pk2(P0[8], P0[9]), pk2(P0[10], P0[11]), pk2(P0[12], P0[13]), pk2(P0[14], P0[15])}; \
        pw[2] = (u32x4){pk2(P1[0], P1[1]), pk2(P1[2], P1[3]), pk2(P1[4], P1[5]), pk2(P1[6], P1[7])}; \
        pw[3] = (u32x4){pk2(P1[8], P1[9]), pk2(P1[10], P1[11]), pk2(P1[12], P1[13]), pk2(P1[14], P1[15])}; \
        { const char* vb_ = lds + ((t) & 1) * VB + vt_off; \
        _Pragma("unroll") for (int s = 0; s < 4; ++s) { const bf16x8 pb = __builtin_bit_cast(bf16x8, pw[s]); \
            _Pragma("unroll") for (int dt = 0; dt < 2; ++dt) { const char* vp = vb_ + s * 16 * VRS + dt * 64; \
                const s16x4 lo = __builtin_bit_cast(s16x4, __builtin_amdgcn_ds_read_tr16_b64_v4i16((LAS s16x4*)vp)); \
                const s16x4 hh = __builtin_bit_cast(s16x4, __builtin_amdgcn_ds_read_tr16_b64_v4i16((LAS s16x4*)(vp + 8 * VRS))); \
                const bf16x8 vf = (bf16x8){lo[0], lo[1], lo[2], lo[3], hh[0], hh[1], hh[2], hh[3]}; \
                if (dt == 0) o0 = __builtin_amdgcn_mfma_f32_32x32x16_bf16(vf, pb, o0, 0, 0, 0); else o1 = __builtin_amdgcn_mfma_f32_32x32x16_bf16(vf, pb, o1, 0, 0, 0); } } } \
        A_STOREK((t) & 1, SS); A_STOREV(((t) + 1) & 1, SS); \
        __syncthreads(); } while (0)
    for (int t = 0; t < NT; t += 2) {
        A_STEP(pA0, pA1, pB0, pB1, t, X, X);
        A_STEP(pB0, pB1, pA0, pA1, t + 1, X, X);
    }
#undef A_STEP
#undef A_QK
#undef A_LOADK
#undef A_LOADV
#undef A_STOREK
#undef A_STOREV
    const float inv = 1.0f / swapsum32(l_run);
    const size_t tok = (size_t)(b * SEQ + q0 + wid * 32 + l31);
#pragma unroll
    for (int dt = 0; dt < 2; ++dt)
#pragma unroll
        for (int g = 0; g < 4; ++g) { const int d = 32 * dt + 8 * g + 4 * hi; const size_t off = tok * 1024 + ocol + d;
            const u32x2 gw = *(const u32x2*)(Gt + off);
            const f32x16& oo = dt ? o1 : o0;
            u32x2 w; w.x = pk2(oo[4 * g] * inv * lo_bf(gw.x), oo[4 * g + 1] * inv * hi_bf(gw.x)); w.y = pk2(oo[4 * g + 2] * inv * lo_bf(gw.y), oo[4 * g + 3] * inv * hi_bf(gw.y));
            *(u32x2*)(OG + off) = w; }
}

DEV void phase_attn(char* lds, const Params& p) {
    const bf16_t* QA = (const bf16_t*)(p.ws + WS_QA); const bf16_t* KA = (const bf16_t*)(p.ws + WS_KA); const bf16_t* VA = (const bf16_t*)(p.ws + WS_VA);
    const bf16_t* QM = (const bf16_t*)(p.ws + WS_QM); const bf16_t* KM = (const bf16_t*)(p.ws + WS2_KM); const bf16_t* VM = (const bf16_t*)(p.ws + WS2_VM);
    const bf16_t* G = (const bf16_t*)(p.ws + WS_G); bf16_t* OG = (bf16_t*)(p.ws + WS2_OG);
    for (int u = blockIdx.x; u < 2048; u += gridDim.x) {
        const int type = u >> 10, rem = u & 1023, b = rem >> 7, h = (rem >> 4) & 7, qb = rem & 15;
        if (type == 0) attn_unit2<64>(lds, QA, 512, h * 64, KA, 128, (h >> 2) * 64, VA, 128, (h >> 2) * 64, G, OG, h * 64, b, qb * 256);
        else attn_unit2<96>(lds, QM, 768, h * 96, KM, 768, h * 96, VM, 512, h * 64, G, OG, 512 + h * 64, b, qb * 256);
    }
}

constexpr int CV_PADL = 192, CV_ROW = 4488, CV_RS = CV_ROW * 2;
constexpr int CV_UB = 8 * CV_RS;
constexpr int CV_FS = 16416;
DEV void conv_load_filter(char* lds, const bf16_t* gr) {
    const int tid = TID();
#pragma unroll
    for (int rnd = 0; rnd < 2; ++rnd) {
        const int ch = tid + rnd * 512;
        const u32x4 a = *(const u32x4*)(gr + ch * 8);
        u32x4 bq = {0u, 0u, 0u, 0u}; if (ch + 1 < 1024) bq = *(const u32x4*)(gr + ch * 8 + 8);
        const unsigned w[8] = {a.x, a.y, a.z, a.w, bq.x, bq.y, bq.z, bq.w};
        char* f = lds + CV_UB + ch * 16;
        *(u32x4*)(f) = a;
        u32x4 c1, c2, c3;
        c1.x = __builtin_amdgcn_alignbit(w[1], w[0], 16); c1.y = __builtin_amdgcn_alignbit(w[2], w[1], 16); c1.z = __builtin_amdgcn_alignbit(w[3], w[2], 16); c1.w = __builtin_amdgcn_alignbit(w[4], w[3], 16);
        c2 = (u32x4){w[1], w[2], w[3], w[4]};
        c3.x = __builtin_amdgcn_alignbit(w[2], w[1], 16); c3.y = __builtin_amdgcn_alignbit(w[3], w[2], 16); c3.z = __builtin_amdgcn_alignbit(w[4], w[3], 16); c3.w = __builtin_amdgcn_alignbit(w[5], w[4], 16);
        *(u32x4*)(f + CV_FS) = c1; *(u32x4*)(f + 2 * CV_FS) = c2; *(u32x4*)(f + 3 * CV_FS) = c3;
    }
}
DEV void sconv4(const bf16_t* px, int t, float w0, float w1, float w2, float bias, float* u) {
    const u32x2 mid = *(const u32x2*)(px + t);
    const float pm = (t > 0) ? bf2f(px[t - 1]) : 0.f, pp = (t + 4 < SEQ) ? bf2f(px[t + 4]) : 0.f;
    const float q0 = lo_bf(mid.x), q1 = hi_bf(mid.x), q2 = lo_bf(mid.y), q3 = hi_bf(mid.y);
    u[0] = w0 * pm + w1 * q0 + w2 * q1 + bias; u[1] = w0 * q0 + w1 * q1 + w2 * q2 + bias; u[2] = w0 * q1 + w1 * q2 + w2 * q3 + bias; u[3] = w0 * q2 + w1 * q3 + w2 * pp + bias;
}
template <bool V0, bool V1>
DEV void conv_step(const char* lds, f32x16 (&acc)[2][2], const int (&a_off)[2], const int (&b_off)[2], int d) {
    bf16x8 fa[2][4];
#pragma unroll
    for (int mt = 0; mt < 2; ++mt)
#pragma unroll
        for (int ks = 0; ks < 4; ++ks) { const char* ap = lds + a_off[mt] - 128 * d + ks * 32;
            const u32x2 lo = *(const u32x2*)ap, hh = *(const u32x2*)(ap + 8);
            fa[mt][ks] = __builtin_bit_cast(bf16x8, (u32x4){lo.x, lo.y, hh.x, hh.y}); }
#pragma unroll
    for (int n = 0; n < 2; ++n) {
        if ((n == 0 && V0) || (n == 1 && V1)) {
#pragma unroll
            for (int ks = 0; ks < 4; ++ks) { const bf16x8 fb = *(const bf16x8*)(lds + b_off[n] - 128 * d + ks * 32);
#pragma unroll
                for (int mt = 0; mt < 2; ++mt) acc[n][mt] = __builtin_amdgcn_mfma_f32_32x32x16_bf16(fa[mt][ks], fb, acc[n][mt], 0, 0, 0); }
        }
    }
}
struct ConvFrags { bf16x8 a[6], b0[4], b1[4]; };
DEV void conv_load_frags(ConvFrags& F, const char* lds, int a_off0, int a_off0h, int b_off0, int b_off1, int d) {
#pragma unroll
    for (int j = 0; j < 6; ++j) { const u32x2 lo = *(const u32x2*)(lds + a_off0 - 128 * d + (j - 2) * 32), hh = *(const u32x2*)(lds + a_off0h - 128 * d + (j - 2) * 32);
        F.a[j] = __builtin_bit_cast(bf16x8, (u32x4){lo.x, lo.y, hh.x, hh.y}); }
#pragma unroll
    for (int ks = 0; ks < 4; ++ks) { F.b0[ks] = *(const bf16x8*)(lds + b_off0 - 128 * d + ks * 32); F.b1[ks] = *(const bf16x8*)(lds + b_off1 - 128 * d + ks * 32); }
}
DEV void conv_mfma_frags(const ConvFrags& F, f32x16 (&acc)[2][2]) {
#pragma unroll
    for (int ks = 0; ks < 4; ++ks) {
        acc[0][0] = __builtin_amdgcn_mfma_f32_32x32x16_bf16(F.a[ks + 2], F.b0[ks], acc[0][0], 0, 0, 0);
        acc[0][1] = __builtin_amdgcn_mfma_f32_32x32x16_bf16(F.a[ks], F.b0[ks], acc[0][1], 0, 0, 0);
        acc[1][0] = __builtin_amdgcn_mfma_f32_32x32x16_bf16(F.a[ks + 2], F.b1[ks], acc[1][0], 0, 0, 0);
        acc[1][1] = __builtin_amdgcn_mfma_f32_32x32x16_bf16(F.a[ks], F.b1[ks], acc[1][1], 0, 0, 0);
    }
}
DEV void conv_mfma_loop(const char* lds, f32x16 (&acc)[2][2], int wid, int lane) {
    const int l31 = lane & 31, hi = lane >> 5;
#pragma unroll
    for (int a = 0; a < 2; ++a)
#pragma unroll
        for (int b = 0; b < 2; ++b)
#pragma unroll
            for (int r = 0; r < 16; ++r) acc[a][b][r] = 0.f;
    int a_off[2];
#pragma unroll
    for (int mt = 0; mt < 2; ++mt) { const int r = l31 + 32 * mt, q = (4 - (r & 3)) & 3; a_off[mt] = CV_UB + q * CV_FS + (4096 - r - q + 8 * hi) * 2; }
    int b_off[2];
#pragma unroll
    for (int n = 0; n < 2; ++n) { const int nt = 2 * wid + n; b_off[n] = (l31 & 7) * CV_RS + (CV_PADL + 64 * (4 * nt + (l31 >> 3)) + 8 * hi) * 2; }
    const int dlo = 8 * wid - 63;
#pragma unroll
    for (int j = 0; j < 4; ++j) conv_step<true, false>(lds, acc, a_off, b_off, dlo + j);
    ConvFrags F0, F1; const int d0 = dlo + 4; int a_hi = a_off[0] + 8; asm volatile("" : "+v"(a_hi));
    conv_load_frags(F0, lds, a_off[0], a_hi, b_off[0], b_off[1], d0);
#pragma unroll 1
    for (int j = 0; j < 31; ++j) { const int d = d0 + 2 * j;
        conv_load_frags(F1, lds, a_off[0], a_hi, b_off[0], b_off[1], d + 1); __builtin_amdgcn_sched_barrier(0);
        conv_mfma_frags(F0, acc); __builtin_amdgcn_sched_barrier(0);
        conv_load_frags(F0, lds, a_off[0], a_hi, b_off[0], b_off[1], d + 2); __builtin_amdgcn_sched_barrier(0);
        conv_mfma_frags(F1, acc); __builtin_amdgcn_sched_barrier(0); }
    conv_mfma_frags(F0, acc);
#pragma unroll
    for (int j = 0; j < 4; ++j) conv_step<false, true>(lds, acc, a_off, b_off, dlo + 67 + j);
}
DEV void conv_unit(char* lds, const Params& p, int c) {
    const int tid = TID(), lane = tid & 63, wid = tid >> 6, l31 = lane & 31, hi = lane >> 5;
    const bf16_t* PT = (const bf16_t*)(p.ws + WS_PT); const bf16_t* GR = (const bf16_t*)(p.ws + WS_GR); const float* ssum = (const float*)(p.ws + WS_SSUM);
    bf16_t* OG2 = (bf16_t*)(p.ws + WS_OG2);
    for (int i = tid; i < 8 * 98; i += 512) { const int b = i / 98, j = i % 98;
        const int e = (j < 48) ? j * 4 : (CV_PADL + SEQ + (j - 48) * 4); *(u32x2*)(lds + b * CV_RS + e * 2) = (u32x2){0u, 0u}; }
    { const float w0 = p.conv_w[c], w1 = p.conv_w[3072 + c], w2 = p.conv_w[6144 + c], bias = p.conv_b[c];
        for (int i = tid; i < 8 * 1024; i += 512) { const int b = i >> 10, t = (i & 1023) * 4; float u[4];
            sconv4(PT + ((size_t)(b * 4096 + c)) * 4096, t, w0, w1, w2, bias, u);
            u32x2 w; w.x = pk2(u[0], u[1]); w.y = pk2(u[2], u[3]); *(u32x2*)(lds + b * CV_RS + (CV_PADL + t) * 2) = w; } }
    conv_load_filter(lds, GR + (size_t)c * 8192);
    __syncthreads();
    f32x16 acc[2][2];
    conv_mfma_loop(lds, acc, wid, lane);
    __syncthreads();
    { const float invs = 1.0f / ssum[c], sk = p.skip[c];
        const float w0 = p.conv_w[1024 + c], w1 = p.conv_w[3072 + 1024 + c], w2 = p.conv_w[6144 + 1024 + c], bias = p.conv_b[1024 + c];
        const int b = l31 & 7;
#pragma unroll
        for (int n = 0; n < 2; ++n) { const int i = 4 * (2 * wid + n) + (l31 >> 3);
#pragma unroll
            for (int mt = 0; mt < 2; ++mt)
#pragma unroll
                for (int g = 0; g < 4; ++g) { const int t = 64 * i + 32 * mt + 8 * g + 4 * hi; float x1[4];
                    sconv4(PT + ((size_t)(b * 4096 + 1024 + c)) * 4096, t, w0, w1, w2, bias, x1);
                    char* up = lds + b * CV_RS + (CV_PADL + t) * 2; const u32x2 vw = *(const u32x2*)up;
                    const float z0 = x1[0] * (acc[n][mt][4 * g] * invs + sk * lo_bf(vw.x)), z1 = x1[1] * (acc[n][mt][4 * g + 1] * invs + sk * hi_bf(vw.x));
                    const float z2 = x1[2] * (acc[n][mt][4 * g + 2] * invs + sk * lo_bf(vw.y)), z3 = x1[3] * (acc[n][mt][4 * g + 3] * invs + sk * hi_bf(vw.y));
                    u32x2 w; w.x = pk2(z0, z1); w.y = pk2(z2, z3); *(u32x2*)up = w; } } }
    conv_load_filter(lds, GR + (size_t)(1024 + c) * 8192);
    __syncthreads();
    conv_mfma_loop(lds, acc, wid, lane);
    { const float invs = 1.0f / ssum[1024 + c], sk = p.skip[1024 + c];
        const float w0 = p.conv_w[2048 + c], w1 = p.conv_w[3072 + 2048 + c], w2 = p.conv_w[6144 + 2048 + c], bias = p.conv_b[2048 + c];
        const int b = l31 & 7;
#pragma unroll
        for (int n = 0; n < 2; ++n) { const int i = 4 * (2 * wid + n) + (l31 >> 3);
#pragma unroll
            for (int mt = 0; mt < 2; ++mt)
#pragma unroll
                for (int g = 0; g < 4; ++g) { const int t = 64 * i + 32 * mt + 8 * g + 4 * hi; float x2[4];
                    sconv4(PT + ((size_t)(b * 4096 + 2048 + c)) * 4096, t, w0, w1, w2, bias, x2);
                    const u32x2 zw = *(const u32x2*)(lds + b * CV_RS + (CV_PADL + t) * 2);
                    const u32x2 gw = *(const u32x2*)(PT + ((size_t)(b * 4096 + 3072 + c)) * 4096 + t);
                    const float y0 = x2[0] * (acc[n][mt][4 * g] * invs + sk * lo_bf(zw.x)) * silu(lo_bf(gw.x)), y1 = x2[1] * (acc[n][mt][4 * g + 1] * invs + sk * hi_bf(zw.x)) * silu(hi_bf(gw.x));
                    const float y2 = x2[2] * (acc[n][mt][4 * g + 2] * invs + sk * lo_bf(zw.y)) * silu(lo_bf(gw.y)), y3 = x2[3] * (acc[n][mt][4 * g + 3] * invs + sk * hi_bf(zw.y)) * silu(hi_bf(gw.y));
                    u32x2 w; w.x = pk2(y0, y1); w.y = pk2(y2, y3); *(u32x2*)(OG2 + ((size_t)(b * 1024 + c)) * 4096 + t) = w; } } }
    __syncthreads();
}

struct Raw3 { u32x2 mid; unsigned halo; };
DEV Raw3 ld_raw3(const bf16_t* px, int t) {
    Raw3 r; r.mid = *(const u32x2*)(px + t);
    const unsigned a = px[t - 1], b = px[t + 4];
    r.halo = (t > 0 ? a : 0u) | ((t + 4 < SEQ ? b : 0u) << 16);
    return r;
}
DEV void sconv_raw(const Raw3& r, float w0, float w1, float w2, float bias, float* u) {
    const float pm = lo_bf(r.halo), pp = hi_bf(r.halo), q0 = lo_bf(r.mid.x), q1 = hi_bf(r.mid.x), q2 = lo_bf(r.mid.y), q3 = hi_bf(r.mid.y);
    u[0] = w0 * pm + w1 * q0 + w2 * q1 + bias; u[1] = w0 * q0 + w1 * q1 + w2 * q2 + bias; u[2] = w0 * q1 + w1 * q2 + w2 * q3 + bias; u[3] = w0 * q2 + w1 * q3 + w2 * pp + bias;
}
struct FiltRegs { u32x4 a[2], b[2]; };
DEV void filt_load(FiltRegs& f, const bf16_t* gr, int tid) {
#pragma unroll
    for (int rnd = 0; rnd < 2; ++rnd) { const int ch = tid + rnd * 512; f.a[rnd] = *(const u32x4*)(gr + ch * 8);
        const int ch1 = ch + 1 < 1024 ? ch + 1 : ch; const u32x4 t = *(const u32x4*)(gr + ch1 * 8); f.b[rnd] = (ch + 1 < 1024) ? t : (u32x4){0u, 0u, 0u, 0u}; }
}
DEV void filt_store(char* lds, const FiltRegs& f, int tid) {
#pragma unroll
    for (int rnd = 0; rnd < 2; ++rnd) { const int ch = tid + rnd * 512; const u32x4 a = f.a[rnd], bq = f.b[rnd];
        const unsigned w[8] = {a.x, a.y, a.z, a.w, bq.x, bq.y, bq.z, bq.w};
        char* fp = lds + CV_UB + ch * 16;
        *(u32x4*)(fp) = a;
        u32x4 c1, c2, c3;
        c1.x = __builtin_amdgcn_alignbit(w[1], w[0], 16); c1.y = __builtin_amdgcn_alignbit(w[2], w[1], 16); c1.z = __builtin_amdgcn_alignbit(w[3], w[2], 16); c1.w = __builtin_amdgcn_alignbit(w[4], w[3], 16);
        c2 = (u32x4){w[1], w[2], w[3], w[4]};
        c3.x = __builtin_amdgcn_alignbit(w[2], w[1], 16); c3.y = __builtin_amdgcn_alignbit(w[3], w[2], 16); c3.z = __builtin_amdgcn_alignbit(w[4], w[3], 16); c3.w = __builtin_amdgcn_alignbit(w[5], w[4], 16);
        *(u32x4*)(fp + CV_FS) = c1; *(u32x4*)(fp + 2 * CV_FS) = c2; *(u32x4*)(fp + 3 * CV_FS) = c3; }
}
#define CV_T(k) (64 * (4 * (2 * wid + ((k) >> 3)) + (l31 >> 3)) + 32 * (((k) >> 2) & 1) + 8 * ((k) & 3) + 4 * hi)
#define CV_LANE_IDS() int tid = TID(); asm volatile("" : "+v"(tid));   \
    const int lane = tid & 63, wid = __builtin_amdgcn_readfirstlane(tid >> 6), l31 = lane & 31, hi = lane >> 5, eb = l31 & 7; (void)eb; (void)hi; (void)wid
DEV void conv_stage_load(char* lds, const Params& p, int c) {
    CV_LANE_IDS();
    const bf16_t* PT = (const bf16_t*)(p.ws + WS_PT); const bf16_t* GR = (const bf16_t*)(p.ws + WS_GR);
    FiltRegs f0; filt_load(f0, GR + (size_t)c * 8192, tid);
    Raw3 ru[16];
#pragma unroll
    for (int k = 0; k < 16; ++k) { const int i = tid + k * 512, b = i >> 10, t = (i & 1023) * 4; ru[k] = ld_raw3(PT + ((size_t)(b * 4096 + c)) * 4096, t); }
    for (int i = tid; i < 8 * 98; i += 512) { const int b = i / 98, j = i % 98;
        const int e = (j < 48) ? j * 4 : (CV_PADL + SEQ + (j - 48) * 4); *(u32x2*)(lds + b * CV_RS + e * 2) = (u32x2){0u, 0u}; }
    const float w0 = p.conv_w[c], w1 = p.conv_w[3072 + c], w2 = p.conv_w[6144 + c], bias = p.conv_b[c];
#pragma unroll
    for (int k = 0; k < 16; ++k) { const int i = tid + k * 512, b = i >> 10, t = (i & 1023) * 4; float u[4]; sconv_raw(ru[k], w0, w1, w2, bias, u);
        u32x2 w; w.x = pk2(u[0], u[1]); w.y = pk2(u[2], u[3]); *(u32x2*)(lds + b * CV_RS + (CV_PADL + t) * 2) = w; }
    filt_store(lds, f0, tid);
}
DEV void conv_stage_epi0(char* lds, const Params& p, int c, const f32x16 (&acc)[2][2]) {
    CV_LANE_IDS();
    const bf16_t* PT = (const bf16_t*)(p.ws + WS_PT); const bf16_t* GR = (const bf16_t*)(p.ws + WS_GR); const float* ssum = (const float*)(p.ws + WS_SSUM);
    FiltRegs f1; filt_load(f1, GR + (size_t)(1024 + c) * 8192, tid);
    const bf16_t* px1 = PT + ((size_t)(eb * 4096 + 1024 + c)) * 4096;
    Raw3 r1[16];
#pragma unroll
    for (int k = 0; k < 16; ++k) r1[k] = ld_raw3(px1, CV_T(k));
    const float a0 = p.conv_w[1024 + c], a1 = p.conv_w[3072 + 1024 + c], a2 = p.conv_w[6144 + 1024 + c], ab = p.conv_b[1024 + c];
    const float invs = 1.0f / ssum[c], sk = p.skip[c];
#pragma unroll
    for (int k = 0; k < 16; ++k) { const int n = k >> 3, mt = (k >> 2) & 1, g = k & 3; const int t = CV_T(k);
        float x1[4]; sconv_raw(r1[k], a0, a1, a2, ab, x1);
        char* up = lds + eb * CV_RS + (CV_PADL + t) * 2; const u32x2 vw = *(const u32x2*)up;
        const float z0 = x1[0] * (acc[n][mt][4 * g] * invs + sk * lo_bf(vw.x)), z1 = x1[1] * (acc[n][mt][4 * g + 1] * invs + sk * hi_bf(vw.x));
        const float z2 = x1[2] * (acc[n][mt][4 * g + 2] * invs + sk * lo_bf(vw.y)), z3 = x1[3] * (acc[n][mt][4 * g + 3] * invs + sk * hi_bf(vw.y));
        u32x2 w; w.x = pk2(z0, z1); w.y = pk2(z2, z3); *(u32x2*)up = w; }
    filt_store(lds, f1, tid);
}
DEV void conv_stage_epi1(char* lds, const Params& p, int c, const f32x16 (&acc)[2][2]) {
    CV_LANE_IDS();
    const bf16_t* PT = (const bf16_t*)(p.ws + WS_PT); const float* ssum = (const float*)(p.ws + WS_SSUM); bf16_t* OG2 = (bf16_t*)(p.ws + WS_OG2);
    const bf16_t* px2 = PT + ((size_t)(eb * 4096 + 2048 + c)) * 4096; const bf16_t* pg = PT + ((size_t)(eb * 4096 + 3072 + c)) * 4096;
    Raw3 r2[16]; u32x2 rg[16];
#pragma unroll
    for (int k = 0; k < 16; ++k) { r2[k] = ld_raw3(px2, CV_T(k)); rg[k] = *(const u32x2*)(pg + CV_T(k)); }
    const float b0 = p.conv_w[2048 + c], b1 = p.conv_w[3072 + 2048 + c], b2 = p.conv_w[6144 + 2048 + c], bb = p.conv_b[2048 + c];
    const float invs = 1.0f / ssum[1024 + c], sk = p.skip[1024 + c];
#pragma unroll
    for (int k = 0; k < 16; ++k) { const int n = k >> 3, mt = (k >> 2) & 1, g = k & 3; const int t = CV_T(k);
        float x2[4]; sconv_raw(r2[k], b0, b1, b2, bb, x2);
        const u32x2 zw = *(const u32x2*)(lds + eb * CV_RS + (CV_PADL + t) * 2);
        const float y0 = x2[0] * silu(lo_bf(rg[k].x)) * (acc[n][mt][4 * g] * invs + sk * lo_bf(zw.x)), y1 = x2[1] * silu(hi_bf(rg[k].x)) * (acc[n][mt][4 * g + 1] * invs + sk * hi_bf(zw.x));
        const float y2 = x2[2] * silu(lo_bf(rg[k].y)) * (acc[n][mt][4 * g + 2] * invs + sk * lo_bf(zw.y)), y3 = x2[3] * silu(hi_bf(rg[k].y)) * (acc[n][mt][4 * g + 3] * invs + sk * hi_bf(zw.y));
        u32x2 w; w.x = pk2(y0, y1); w.y = pk2(y2, y3); *(u32x2*)(OG2 + ((size_t)(eb * 1024 + c)) * 4096 + t) = w; }
}
DEV void conv_stage_mfma(const char* lds, f32x16 (&acc)[2][2]) { CV_LANE_IDS(); conv_mfma_loop(lds, acc, wid, lane); }
DEV void conv_unit2(char* lds, const Params& p, int c) {
    conv_stage_load(lds, p, c);
    __syncthreads();
    f32x16 acc[2][2];
    conv_stage_mfma(lds, acc);
    __syncthreads();
    conv_stage_epi0(lds, p, c, acc);
    __syncthreads();
    conv_stage_mfma(lds, acc);
    conv_stage_epi1(lds, p, c, acc);
    __syncthreads();
}
#undef CV_T
#undef CV_LANE_IDS

struct cf { float x, y; };
DEV cf cadd(cf a, cf b) { return cf{a.x + b.x, a.y + b.y}; }
DEV cf csub(cf a, cf b) { return cf{a.x - b.x, a.y - b.y}; }
DEV cf cmul(cf a, cf b) { return cf{a.x * b.x - a.y * b.y, a.x * b.y + a.y * b.x}; }
template <int M> DEV cf mulw16(cf a) {
    if constexpr (M == 0) return a;
    else if constexpr (M == 4) return cf{a.y, -a.x};
    else if constexpr (M == 2) return cf{(a.x + a.y) * 0.70710678118654752f, (a.y - a.x) * 0.70710678118654752f};
    else if constexpr (M == 6) return cf{(a.y - a.x) * 0.70710678118654752f, -(a.x + a.y) * 0.70710678118654752f};
    else { constexpr float c = (M == 1) ? 0.92387953251128674f : (M == 3) ? 0.38268343236508977f : (M == 5) ? -0.38268343236508977f : -0.92387953251128674f;
           constexpr float sn = (M == 1) ? -0.38268343236508977f : (M == 3) ? -0.92387953251128674f : (M == 5) ? -0.92387953251128674f : -0.38268343236508977f;
           return cf{a.x * c - a.y * sn, a.x * sn + a.y * c}; }
}
template <int HALF, int BLK, int J> DEV void dif_bfly(cf (&v)[16]) { const cf a = v[BLK + J], b = v[BLK + J + HALF]; v[BLK + J] = cadd(a, b); v[BLK + J + HALF] = mulw16<J * (8 / HALF)>(csub(a, b)); }
DEV void dft16(cf (&v)[16]) {
#define B8(j) dif_bfly<8, 0, j>(v)
    B8(0); B8(1); B8(2); B8(3); B8(4); B8(5); B8(6); B8(7);
#undef B8
#define B4(b, j) dif_bfly<4, b, j>(v)
    B4(0, 0); B4(0, 1); B4(0, 2); B4(0, 3); B4(8, 0); B4(8, 1); B4(8, 2); B4(8, 3);
#undef B4
#define B2(b, j) dif_bfly<2, b, j>(v)
    B2(0, 0); B2(0, 1); B2(4, 0); B2(4, 1); B2(8, 0); B2(8, 1); B2(12, 0); B2(12, 1);
#undef B2
#define B1(b) dif_bfly<1, b, 0>(v)
    B1(0); B1(2); B1(4); B1(6); B1(8); B1(10); B1(12); B1(14);
#undef B1
}
#define FFT_BR4(k) ((((k) & 1) << 3) | (((k) & 2) << 1) | (((k) & 4) >> 1) | (((k) & 8) >> 3))
constexpr int FF_BUF = (8192 + 512) * 8;
DEV int ffp(int idx) { return (idx + (idx >> 4)) * 8; }
struct FftTw { cf t3[16]; };
constexpr int FF_T2 = 2 * FF_BUF;
DEV void fft_twiddles(FftTw& T, char* lds, int tid) {
    if (tid < 240) { const int k = tid / 15, r = tid % 15 + 1; float sn, cs; sincospif(-(float)(k * r) * (1.0f / 128.0f), &sn, &cs); *(cf*)(lds + FF_T2 + tid * 8) = cf{cs, sn}; }
    __syncthreads();
    { const int i3 = tid & 255, h = tid >> 8; float sn, cs; sincospif(-(float)i3 * (1.0f / 4096.0f), &sn, &cs); const cf w1 = cf{cs, sn}; const cf w2 = cmul(w1, w1);
        cf t = h ? w1 : cf{1.f, 0.f};
#pragma unroll
        for (int sx = 0; sx < 16; ++sx) { T.t3[sx] = t; t = cmul(t, w2); } }
}
DEV void fft_pass23(char* A, char* B, const char* tw2, int tid, const FftTw& T) {
    asm volatile("" : "+v"(tid));
    cf v[16];
    {
        const int i = tid, k = i & 15;
        { const char* rb = A + ffp(i);
#pragma unroll
        for (int r = 0; r < 16; ++r) v[r] = *(const cf*)(rb + 4352 * r); }
#pragma unroll
        for (int r = 1; r < 16; ++r) v[r] = cmul(v[r], *(const cf*)(tw2 + k * 120 + (r - 1) * 8));
        dft16(v);
        const int j = ((i >> 4) << 8) + k;
        { char* wb = B + (j + 16 * (i >> 4)) * 8;
#pragma unroll
        for (int r = 0; r < 16; ++r) *(cf*)(wb + 136 * r) = v[FFT_BR4(r)]; }
        __syncthreads();
    }
    {
        const int i3 = tid & 255, h = tid >> 8;
        const char* rb3 = B + ffp(i3) + 2176 * h;
#pragma unroll
        for (int sx = 0; sx < 16; ++sx) v[sx] = *(const cf*)(rb3 + 4352 * sx);
#pragma unroll
        for (int sx = 0; sx < 16; ++sx) v[sx] = cmul(v[sx], T.t3[sx]);
        dft16(v);
        if (h) {
            const float c32[16] = {1.f, 0.98078528040323043f, 0.92387953251128674f, 0.83146961230254524f, 0.70710678118654752f, 0.55557023301960218f, 0.38268343236508977f, 0.19509032201612825f,
                                   0.f, -0.19509032201612825f, -0.38268343236508977f, -0.55557023301960218f, -0.70710678118654752f, -0.83146961230254524f, -0.92387953251128674f, -0.98078528040323043f};
            const float s32[16] = {0.f, -0.19509032201612825f, -0.38268343236508977f, -0.55557023301960218f, -0.70710678118654752f, -0.83146961230254524f, -0.92387953251128674f, -0.98078528040323043f,
                                   -1.f, -0.98078528040323043f, -0.92387953251128674f, -0.83146961230254524f, -0.70710678118654752f, -0.55557023301960218f, -0.38268343236508977f, -0.19509032201612825f};
#pragma unroll
            for (int m = 0; m < 16; ++m) { const cf x = v[FFT_BR4(m)]; v[FFT_BR4(m)] = cf{x.x * c32[m] - x.y * s32[m], x.x * s32[m] + x.y * c32[m]}; }
        }
        { char* wb3 = A + ffp(i3) + 34816 * h;
#pragma unroll
        for (int m = 0; m < 16; ++m) *(cf*)(wb3 + 2176 * m) = v[FFT_BR4(m)]; }
        __syncthreads();
    }
}
DEV void fft_pass1_store(char* D, cf (&v)[16], int tid) {
    dft16(v);
    { char* wb = D + 136 * tid;
#pragma unroll
    for (int r = 0; r < 16; ++r) *(cf*)(wb + 8 * r) = v[FFT_BR4(r)]; }
    __syncthreads();
}
constexpr size_t WS_CVIN = WS_H1;
DEV void fftconv_unit(char* lds, const Params& p, int c, const FftTw& T) {
    int tid = TID(); asm volatile("" : "+v"(tid));
    char* D0 = lds; char* D1 = lds + FF_BUF;
    const bf16_t* PT = (const bf16_t*)(p.ws + WS_PT); const bf16_t* GR = (const bf16_t*)(p.ws + WS_GR); const float* ssum = (const float*)(p.ws + WS_SSUM);
    bf16_t* OG2 = (bf16_t*)(p.ws + WS_OG2); float* IN = (float*)(p.ws + WS_CVIN) + (size_t)blockIdx.x * (8 * 4096);
    { const float w0 = p.conv_w[c], w1 = p.conv_w[3072 + c], w2 = p.conv_w[6144 + c], bias = p.conv_b[c];
#pragma unroll 2
        for (int k = 0; k < 8; ++k) { const int i = tid + k * 512, b = i >> 9, n0 = (i & 511) * 8;
            const bf16_t* px = PT + ((size_t)(b * 4096 + c)) * 4096;
            float q[10]; { const u32x4 m = *(const u32x4*)(px + n0); unpack8(m, q + 1); q[0] = (n0 > 0) ? bf2f(px[n0 - 1]) : 0.f; q[9] = (n0 + 8 < SEQ) ? bf2f(px[n0 + 8]) : 0.f; }
            f32x4 o0, o1;
#pragma unroll
            for (int e = 0; e < 4; ++e) { o0[e] = w0 * q[e] + w1 * q[e + 1] + w2 * q[e + 2] + bias; o1[e] = w0 * q[e + 4] + w1 * q[e + 5] + w2 * q[e + 6] + bias; }
            *(f32x4*)(IN + b * 4096 + n0) = o0; *(f32x4*)(IN + b * 4096 + n0 + 4) = o1; } }
    __syncthreads();
#pragma unroll 1
    for (int o = 0; o < 2; ++o) {
        cf KS[16];
        asm volatile("" : "+v"(tid));
        { const bf16_t* g = GR + (size_t)(o * 1024 + c) * 8192; const float invs = 1.0f / ssum[o * 1024 + c];
            cf v[16];
#pragma unroll
            for (int r = 0; r < 16; ++r) { const int n = tid + 512 * r; v[r] = cf{bf2f(g[(12288 - n) & 8191]) * invs, 0.f}; }
            fft_pass1_store(D0, v, tid);
            fft_pass23(D0, D1, lds + FF_T2, tid, T);
#pragma unroll
            for (int q = 0; q < 8; ++q) { const cf a = *(const cf*)(D0 + ffp(tid) + 4352 * q), b = *(const cf*)(D0 + ffp(tid) + 4352 * q + 34816); KS[q] = cadd(a, b); KS[q + 8] = csub(a, b); }
            __syncthreads(); }
        const float sk = p.skip[o * 1024 + c];
        const int part = (o == 0) ? 1024 : 2048;
        const float w0 = p.conv_w[part + c], w1 = p.conv_w[3072 + part + c], w2 = p.conv_w[6144 + part + c], bias = p.conv_b[part + c];
#pragma unroll 1
        for (int pr = 0; pr < 4; ++pr) {
            asm volatile("" : "+v"(tid));
            const float* ina = IN + (2 * pr) * 4096; const float* inb = ina + 4096;
            {
                cf v[16];
#pragma unroll
                for (int r = 0; r < 8; ++r) v[r] = cf{ina[tid + 512 * r], inb[tid + 512 * r]};
#pragma unroll
                for (int r = 8; r < 16; ++r) v[r] = cf{0.f, 0.f};
                fft_pass1_store(D0, v, tid);
                fft_pass23(D0, D1, lds + FF_T2, tid, T);
            }
            {
                cf v[16];
#pragma unroll
                for (int q = 0; q < 8; ++q) { const cf a = *(const cf*)(D0 + ffp(tid) + 4352 * q), b = *(const cf*)(D0 + ffp(tid) + 4352 * q + 34816);
                    const cf x0 = cmul(cadd(a, b), KS[q]), x1 = cmul(csub(a, b), KS[q + 8]);
                    v[q] = cf{x0.x, -x0.y}; v[q + 8] = cf{x1.x, -x1.y}; }
                fft_pass1_store(D1, v, tid);
                fft_pass23(D1, D0, lds + FF_T2, tid, T);
            }
            {
                const int n0 = 8 * tid; float ya[8], yb[8];
#pragma unroll
                for (int e = 0; e < 8; ++e) { const cf a = *(const cf*)(D1 + 64 * tid + 8 * (tid >> 1) + 8 * e), b = *(const cf*)(D1 + 64 * tid + 8 * (tid >> 1) + 8 * e + 34816); ya[e] = (a.x + b.x) * (1.0f / 8192.0f); yb[e] = -(a.y + b.y) * (1.0f / 8192.0f); }
#pragma unroll
                for (int hb = 0; hb < 2; ++hb) { const int b = 2 * pr + hb; float* inp = IN + b * 4096 + n0; const float* yy = hb ? yb : ya;
                    const bf16_t* px = PT + ((size_t)(b * 4096 + part + c)) * 4096;
                    float q[10]; { const u32x4 m = *(const u32x4*)(px + n0); unpack8(m, q + 1); q[0] = (n0 > 0) ? bf2f(px[n0 - 1]) : 0.f; q[9] = (n0 + 8 < SEQ) ? bf2f(px[n0 + 8]) : 0.f; }
                    const f32x4 u0 = *(const f32x4*)inp, u1 = *(const f32x4*)(inp + 4); const float uu[8] = {u0.x, u0.y, u0.z, u0.w, u1.x, u1.y, u1.z, u1.w};
                    float z[8];
#pragma unroll
                    for (int e = 0; e < 8; ++e) { const float xc = w0 * q[e] + w1 * q[e + 1] + w2 * q[e + 2] + bias; z[e] = xc * (yy[e] + sk * uu[e]); }
                    if (o == 0) { *(f32x4*)inp = (f32x4){z[0], z[1], z[2], z[3]}; *(f32x4*)(inp + 4) = (f32x4){z[4], z[5], z[6], z[7]}; }
                    else { float gg[8]; unpack8(*(const u32x4*)(PT + ((size_t)(b * 4096 + 3072 + c)) * 4096 + n0), gg);
#pragma unroll
                        for (int e = 0; e < 8; ++e) z[e] *= silu(gg[e]);
                        *(u32x4*)(OG2 + ((size_t)(b * 1024 + c)) * 4096 + n0) = pack8(z); } }
            }
        }
        __syncthreads();
    }
}

#define XB_TMO      128
#define XB_XCNT(j)  (256  + 64 * (j))
#define XB_XSUB(j)  (1280 + 64 * (j))
#define XB_XGEN(j)  (2304 + 64 * (j))
#define XB_TOP      3328
#define XB_TOPGEN   3392
#define XCD_BAR_WORDS 3456
#define XB_SPIN_CAP (1u << 20)
DEV unsigned xb_ld(unsigned* p) { return __hip_atomic_load(p, __ATOMIC_RELAXED, __HIP_MEMORY_SCOPE_AGENT); }
DEV unsigned xb_add(unsigned* p, unsigned v) { return __hip_atomic_fetch_add(p, v, __ATOMIC_RELAXED, __HIP_MEMORY_SCOPE_AGENT); }
DEV unsigned xb_xcc_id() { return (unsigned)__builtin_amdgcn_s_getreg((3 << 11) | 20) & 0xFu; }
#define XB_SPIN(cond, bar) do { unsigned _sp = 0; while (cond) { __builtin_amdgcn_s_sleep(1); \
    if ((++_sp & 255u) == 0u) { if (xb_ld(&(bar)[XB_TMO])) break; if (_sp > XB_SPIN_CAP) { atomicAdd(&(bar)[XB_TMO], 1u); break; } } } } while (0)
struct XcdBarrier { unsigned* bar; unsigned x; volatile LAS unsigned* st; };
DEV XcdBarrier xcd_barrier_post(unsigned* bar, volatile LAS unsigned* st) {
    XcdBarrier b; b.bar = bar; b.x = xb_xcc_id(); b.st = st;
    if (TID() == 0) (void)xb_add(&bar[XB_XCNT(b.x)], 1u);
    return b;
}
DEV void xcd_barrier_complete(unsigned* bar, unsigned x, unsigned& nloc, unsigned& nx) {
    const unsigned G = gridDim.x * gridDim.y * gridDim.z;
    unsigned sum, cnt, mine, sp = 0u;
    for (;;) {
        sum = 0u; cnt = 0u; mine = 0u;
#pragma unroll
        for (unsigned j = 0; j < 16; ++j) { const unsigned c = xb_ld(&bar[XB_XCNT(j)]); sum += c; cnt += (c > 0u) ? 1u : 0u; mine = (j == x) ? c : mine; }
        if (sum == G) break;
        __builtin_amdgcn_s_sleep(1);
        if ((++sp & 255u) == 0u) { if (xb_ld(&bar[XB_TMO])) break; if (sp > XB_SPIN_CAP) { atomicAdd(&bar[XB_TMO], 1u); break; } }
    }
    nloc = mine > 0u ? mine : 1u; nx = cnt > 0u ? cnt : 1u;
}
DEV void xcd_barrier(const XcdBarrier& b) {
    asm volatile("s_waitcnt vmcnt(0)" ::: "memory");
    __syncthreads();
    if (TID() == 0) {
        unsigned* bar = b.bar;
        __builtin_amdgcn_s_waitcnt(0);
        unsigned nloc = b.st[0], nx = b.st[1];
        if (nloc == 0u) { xcd_barrier_complete(bar, b.x, nloc, nx); b.st[0] = nloc; b.st[1] = nx; }
        const unsigned old = xb_add(&bar[XB_XSUB(b.x)], 1u);
        const unsigned gen = old / nloc;
        if (old + 1u == (gen + 1u) * nloc) {
            __builtin_amdgcn_fence(__ATOMIC_RELEASE, "agent");
            asm volatile("s_waitcnt vmcnt(0)" ::: "memory");
            const unsigned og = xb_add(&bar[XB_TOP], 1u);
            const unsigned tg = og / nx;
            if (og + 1u == (tg + 1u) * nx) xb_add(&bar[XB_TOPGEN], 1u);
            else XB_SPIN(xb_ld(&bar[XB_TOPGEN]) == tg, bar);
            __builtin_amdgcn_fence(__ATOMIC_ACQUIRE, "agent");
            xb_add(&bar[XB_XGEN(b.x)], 1u);
            asm volatile("s_waitcnt vmcnt(0)" ::: "memory");
        } else {
            XB_SPIN(xb_ld(&bar[XB_XGEN(b.x)]) == gen, bar);
            __builtin_amdgcn_fence(__ATOMIC_ACQUIRE, "agent");
            asm volatile("s_waitcnt vmcnt(0)" ::: "memory");
        }
    }
    __syncthreads();
}

constexpr int NPHASE = 12;
__global__ void __launch_bounds__(512) fwd_kernel(Params p) {
    char* lds = lds_dyn;
    char* ws = p.ws;
    volatile LAS unsigned* bst = (volatile LAS unsigned*)(LAS char*)(lds + LDS_BYTES - 64);
    { const int t0 = threadIdx.x;
        if (t0 < 16) bst[t0] = 0u;
        if ((t0 & 63) == 0) *(volatile LAS int*)(LAS char*)(lds + LDS_WTAB + 4 * hw_slot()) = t0 >> 6; }
    __syncthreads();
    if (MK_LAUNCHES == 1) (void)xcd_barrier_post((unsigned*)(ws + WS_CTL), bst);
    if (MK_LAUNCHES == 1 && p.ph_hi > NPHASE) cg::this_grid().sync();
#define SEAM(k) do { if (MK_LAUNCHES == 1 && (k) + 1 < p.ph_hi) { XcdBarrier xb_; xb_.bar = (unsigned*)(p.ws + WS_CTL); xb_.x = xb_xcc_id(); xb_.st = (volatile LAS unsigned*)(LAS char*)(lds + LDS_BYTES - 64); xcd_barrier(xb_); } } while (0)
#ifndef PHASE_MASK
#define PHASE_MASK 0xFFF
#endif
#define IN(k) (((PHASE_MASK >> (k)) & 1) && p.ph_lo <= (k) && (k) < p.ph_hi)
#define REP(k) for (int rep_ = 0; rep_ < ((PROBE_REPEAT == (k)) ? 2 : 1); ++rep_)
    if (IN(0)) { REP(0) phase_prep(lds, p); SEAM(0); }
    if (IN(1)) {
        for (int rep_ = 0; rep_ < ((PROBE_REPEAT == 21) ? 2 : 1); ++rep_) {
        const bool dummy = (PROBE_REPEAT == 21 && rep_ == 0);
        EpiFilt ef{(bf16_t*)(ws + (dummy ? WS_PRAW : WS_GR)), p.f_b3};
        gemm_phase<false, EpiFilt>(lds, (const bf16_t*)(ws + WS_W3), 64, (const bf16_t*)(ws + WS_HID2), 64, 4096, 4096, 64, ef); }
        REP(1) phase_norm0(p); SEAM(1); }
    if (IN(2)) {
        REP(2) { pg8::Gemm g{(const bf16_t*)(ws + WS_H0), (const bf16_t*)(ws + WS_WIN), NALL, AINP, DM}; pg8::StaticOrder S; S.init(NALL, AINP, (int)gridDim.x, (int)blockIdx.x);
            pg8::EpiBf16 E{(bf16_t*)(ws + WS_PRAW), (size_t)AINP, 0, 0};
            pg8::gemm_phase<pg8::EpiBf16, pg8::StaticOrder, true, true>((PG8_LAS unsigned char*)lds, g, S, E); }
        SEAM(2); }
    if (IN(3)) { filt_sums(p); REP(3) phase_post(p); SEAM(3); }
    if (IN(4)) {
        const float* rp = (const float*)(ws + WS_ROPE);
        REP(4) {
        { pg8::Gemm g{(const bf16_t*)(ws + WS_CQN), (const bf16_t*)(ws + WS_WUQ), NTOK, 768, 256}; pg8::StaticOrder S; S.init(NTOK, 768, (int)gridDim.x, (int)blockIdx.x);
            pg8::EpiUqPg E{(bf16_t*)(ws + WS_QM), rp + 2048, rp + 2560, QSC_M};
            pg8::gemm_phase<pg8::EpiUqPg, pg8::StaticOrder, true, true>((PG8_LAS unsigned char*)lds, g, S, E); }
        int opq_ = 0; asm volatile("" : "+s"(opq_));
        if (opq_ == 0) { pg8::Gemm g{(const bf16_t*)(ws + WS_CKVN), (const bf16_t*)(ws + WS_WUKV), NALL, 1024, 128}; pg8::StaticOrder S; S.init(NALL, 1024, (int)gridDim.x, (int)blockIdx.x);
            pg8::EpiUkvPg E{(bf16_t*)(ws + WS2_KM), (bf16_t*)(ws + WS2_VM)};
            pg8::gemm_phase<pg8::EpiUkvPg, pg8::StaticOrder, true, true>((PG8_LAS unsigned char*)lds, g, S, E); } }
        SEAM(4); }
    if (IN(5)) { REP(5) phase_attn(lds, p); SEAM(5); }
    if (IN(6)) {
        REP(6) { pg8::Gemm g{(const bf16_t*)(ws + WS2_OG), (const bf16_t*)(ws + WS_WOUT), NTOK, DM, DM}; pg8::StaticOrder S; S.init(NTOK, DM, (int)gridDim.x, (int)blockIdx.x);
            pg8::EpiResF32 E{p.x, p.out, (const float*)(ws + WS_MOD0), (DBG_SKIP & 1) ? 0.f : 1.f};
            pg8::gemm_phase<pg8::EpiResF32, pg8::StaticOrder, true, true>((PG8_LAS unsigned char*)lds, g, S, E); }
        SEAM(6); }
    if (IN(7)) { REP(7) phase_norm1(p); SEAM(7); }
    if (IN(8)) {
        REP(8) { pg8::Gemm g{(const bf16_t*)(ws + WS_HWIN), (const bf16_t*)(ws + WS_H1), 4096, NTOK, DM}; pg8::StaticOrder S; S.init(4096, NTOK, (int)gridDim.x, (int)blockIdx.x);
            pg8::EpiBf16 E{(bf16_t*)(ws + WS_PT), (size_t)4096, 4096, (size_t)4096 * 4096};
            pg8::gemm_phase<pg8::EpiBf16, pg8::StaticOrder, true, true>((PG8_LAS unsigned char*)lds, g, S, E); }
        SEAM(8); }
    if (IN(9)) { FftTw T; fft_twiddles(T, lds, TID()); REP(9) for (int c = blockIdx.x; c < 1024; c += gridDim.x) fftconv_unit(lds, p, c, T); SEAM(9); }
    if (IN(10)) {
        REP(10) {
        EpiRes e{p.out, (PROBE_REPEAT == 10 && rep_ == 0) ? (float*)(ws + WS_PT) : p.out, (const float*)(ws + WS_MOD1), (DBG_SKIP & 2) ? 0.f : 1.f};
        const bf16_t* OG2 = (const bf16_t*)(ws + WS_OG2); const bf16_t* W = (const bf16_t*)(ws + WS_HWOUT);
        const int nt = (NTOK / 256) * (DM / 128);
        for (int t = blockIdx.x; t < nt; t += gridDim.x) { const int ti = t / 8, tj = t % 8; const int b = ti >> 4, l0 = (ti & 15) * 256;
            gemm_tile<true, EpiRes>(lds, OG2 + (size_t)b * 1024 * 4096 + l0, 4096, W + (size_t)tj * 128 * DM, DM, DM, e, ti * 256, tj * 128); }
        }
        SEAM(10); }
    if (IN(11)) { phase_final(p); }
#undef SEAM
#undef IN
}

extern "C" void kernel_launch(void* const* d_in, const int* in_sizes, int n_in, void* d_out, int out_size, void* d_ws, size_t ws_size, hipStream_t stream) {
    static int grid = 0;
    if (grid == 0) {
        if (n_in != 28 || out_size != NTOK * DM || ws_size < WS_END) { fprintf(stderr, "kernel_launch: unexpected shapes n_in %d out %d ws %zu\n", n_in, out_size, ws_size); grid = -1; return; }
        int dev = 0, cus = 0, per_cu = 0;
        hipGetDevice(&dev); hipDeviceGetAttribute(&cus, hipDeviceAttributeMultiprocessorCount, dev);
        if (hipFuncSetAttribute((const void*)fwd_kernel, hipFuncAttributeMaxDynamicSharedMemorySize, LDS_BYTES) != hipSuccess) { fprintf(stderr, "hipFuncSetAttribute failed\n"); grid = -1; return; }
        hipOccupancyMaxActiveBlocksPerMultiprocessor(&per_cu, (const void*)fwd_kernel, 512, LDS_BYTES);
        if (per_cu < 1) { fprintf(stderr, "occupancy query says %d\n", per_cu); per_cu = 1; }
        grid = cus * 1;
        (void)hipGetLastError();
    }
    if (grid < 0) return;
    Params p{};
    const float** pp = (const float**)&p;
    for (int i = 0; i < 28; ++i) pp[i] = (const float*)d_in[i];
    p.out = (float*)d_out; p.ws = (char*)d_ws;
#if MK_LAUNCHES == 1
    if (hipMemsetAsync((char*)d_ws + WS_CTL, 0, CTL_BYTES, stream) != hipSuccess) { fprintf(stderr, "memset failed\n"); return; }
    p.ph_lo = 0; p.ph_hi = NPHASE;
    void* args[] = {&p};
    hipError_t e = hipLaunchCooperativeKernel((const void*)fwd_kernel, dim3(grid), dim3(512), args, LDS_BYTES, stream);
    if (e != hipSuccess) fprintf(stderr, "cooperative launch failed: %s (grid %d)\n", hipGetErrorString(e), grid);
#else
    for (int k = 0; k < NPHASE; ++k) { p.ph_lo = k; p.ph_hi = k + 1; hipLaunchKernelGGL(fwd_kernel, dim3(grid), dim3(512), LDS_BYTES, stream, p); }
#endif
}
```

```cpp
#include <hip/hip_runtime.h>
#include <hip/hip_cooperative_groups.h>
#include <cstdio>
#include <cstdint>
namespace cg = cooperative_groups;

#ifndef MK_LAUNCHES
#define MK_LAUNCHES 1
#endif

#ifndef PROBE_REPEAT
#define PROBE_REPEAT -1
#endif
#ifndef DBG_SKIP
#define DBG_SKIP 0
#endif
#define DEV __device__ __forceinline__
typedef unsigned short bf16_t;
typedef short bf16x8 __attribute__((ext_vector_type(8)));
typedef short s16x4 __attribute__((ext_vector_type(4)));
typedef float f32x16 __attribute__((ext_vector_type(16)));
typedef float f32x4 __attribute__((ext_vector_type(4)));
typedef float f32x2 __attribute__((ext_vector_type(2)));
typedef unsigned u32x4 __attribute__((ext_vector_type(4)));
typedef unsigned u32x2 __attribute__((ext_vector_type(2)));
typedef __bf16 bf16x2_t __attribute__((ext_vector_type(2)));
#define LAS __attribute__((address_space(3)))

constexpr int NB = 8, SEQ = 4096, DM = 1024, CTXL = 256, LK = SEQ + CTXL;
constexpr int NTOK = NB * SEQ, NCTX = NB * CTXL, NALL = NTOK + NCTX;
constexpr int AIN = 2208, AINP = 2304;
constexpr float EPS = 1e-6f;
constexpr float LOG2E = 1.4426950408889634f;
constexpr float QSC_A = 0.125f * LOG2E;
constexpr float QSC_M = 0.10206207261596575f * LOG2E;

constexpr size_t MiB = 1ull << 20;
constexpr size_t WS_WIN = 0;
constexpr size_t WS_WUQ = 5 * MiB;
constexpr size_t WS_WUKV = 6 * MiB;
constexpr size_t WS_WOUT = 7 * MiB;
constexpr size_t WS_HWIN = 9 * MiB;
constexpr size_t WS_HWOUT = 17 * MiB;
constexpr size_t WS_W3 = 19 * MiB;
constexpr size_t WS_HID2 = 20 * MiB;
constexpr size_t WS_MOD0 = 21 * MiB;
constexpr size_t WS_MOD1 = WS_MOD0 + 9 * 3072 * 4;
constexpr size_t WS_SSUM = WS_MOD1 + 8 * 3072 * 4;
constexpr size_t WS_ROPE = WS_SSUM + 2048 * 4;
constexpr size_t WS_GR = 22 * MiB;
constexpr size_t WS_H0 = 64 * MiB;
constexpr size_t WS_PRAW = 136 * MiB;
constexpr size_t WS_QA = 297 * MiB;
constexpr size_t WS_KA = 329 * MiB;
constexpr size_t WS_VA = 338 * MiB;
constexpr size_t WS_CQN = 347 * MiB;
constexpr size_t WS_CKVN = 363 * MiB;
constexpr size_t WS_G = 372 * MiB;
constexpr size_t WS_QM = 64 * MiB;
constexpr size_t WS_KM = 136 * MiB;
constexpr size_t WS_VM = 190 * MiB;
constexpr size_t WS_OG = 226 * MiB;
constexpr size_t WS_H1 = 436 * MiB;
constexpr size_t WS_PT = 64 * MiB;
constexpr size_t WS_OG2 = 320 * MiB;
constexpr size_t WS_CTL = 500 * MiB;
constexpr size_t CTL_BYTES = 16384;
constexpr size_t WS_END = 500 * MiB + CTL_BYTES;
constexpr size_t WS2_KM = 436 * MiB;
constexpr size_t WS2_VM = 190 * MiB;
constexpr size_t WS2_OG = 226 * MiB;

constexpr int LDS_BYTES = 150 * 1024;

extern __shared__ __attribute__((aligned(16))) char lds_dyn[];
constexpr int LDS_WTAB = LDS_BYTES - 64 - 256;
__device__ __forceinline__ int lane_id() { int r; asm volatile("v_mbcnt_lo_u32_b32 %0, -1, 0\n\tv_mbcnt_hi_u32_b32 %0, -1, %0" : "=v"(r)); return r; }
__device__ __forceinline__ int hw_slot() { return (int)(__builtin_amdgcn_s_getreg((5 << 11) | 4) & 63u); }
__device__ __forceinline__ int wave_idx() { return __builtin_amdgcn_readfirstlane(*(volatile __attribute__((address_space(3))) int*)(__attribute__((address_space(3))) char*)(lds_dyn + LDS_WTAB + 4 * hw_slot())); }
#define TID() (wave_idx() * 64 + lane_id())

DEV float bf2f(bf16_t v) { return __uint_as_float(((unsigned)v) << 16); }
DEV unsigned pk2(float lo, float hi) { f32x2 v = {lo, hi}; bf16x2_t b = __builtin_convertvector(v, bf16x2_t); return __builtin_bit_cast(unsigned, b); }
DEV bf16_t f2bf(float f) { return (bf16_t)(pk2(f, 0.f) & 0xffffu); }
DEV float lo_bf(unsigned w) { return __uint_as_float(w << 16); }
DEV float hi_bf(unsigned w) { return __uint_as_float(w & 0xffff0000u); }
DEV int crow(int r, int hi) { return (r & 3) + 8 * (r >> 2) + 4 * hi; }
DEV float silu(float v) { return v * __builtin_amdgcn_rcpf(1.f + __expf(-v)); }
DEV void unpack8(const u32x4 w, float* v) { v[0] = lo_bf(w.x); v[1] = hi_bf(w.x); v[2] = lo_bf(w.y); v[3] = hi_bf(w.y); v[4] = lo_bf(w.z); v[5] = hi_bf(w.z); v[6] = lo_bf(w.w); v[7] = hi_bf(w.w); }
DEV u32x4 pack8(const float* v) { u32x4 w; w.x = pk2(v[0], v[1]); w.y = pk2(v[2], v[3]); w.z = pk2(v[4], v[5]); w.w = pk2(v[6], v[7]); return w; }

DEV float wave_sum(float v) {
#pragma unroll
    for (int o = 1; o < 64; o <<= 1) v += __shfl_xor(v, o);
    return v;
}
struct Params {
    const float *x, *c, *ctx, *c_ctx, *ada_w, *ada_b, *norm_w, *w_in, *q_norm, *k_norm, *cq_norm, *ckv_norm, *w_uq, *w_ukv, *w_out,
        *hy_w_in, *conv_w, *conv_b, *f_w1, *f_b1, *f_w2, *f_b2, *f_w3, *f_b3, *freq, *skip, *hy_w_out, *final_w;
    float* out; char* ws; int ph_lo, ph_hi;
};

constexpr int G_RS = 144;
constexpr int G_RB = 256 * G_RS, G_CB = 128 * G_RS, G_STAGE = G_RB + G_CB;
constexpr int T_RS = 576;

template <bool TR, class Epi>
DEV void gemm_tile(char* lds, const bf16_t* __restrict__ R, size_t ldr, const bf16_t* __restrict__ C, size_t ldc, int K, const Epi& epi, int ti0, int tj0) {
    const int tid = TID(), lane = tid & 63, wid = tid >> 6;
    const int wi = wid >> 1, wj = wid & 1, l31 = lane & 31, hi = lane >> 5;
    f32x16 acc[2][2];
#pragma unroll
    for (int a = 0; a < 2; ++a)
#pragma unroll
        for (int b = 0; b < 2; ++b)
#pragma unroll
            for (int r = 0; r < 16; ++r) acc[a][b][r] = 0.f;
    u32x4 rrX[4], rcX[2], rrY[4], rcY[2];
    const bf16_t* Rp; const bf16_t* Cp; int rl_off, cl_off;
    if (TR) { const int c = tid & 31, kr = tid >> 5; Rp = R + (size_t)kr * ldr + c * 8; rl_off = kr * T_RS + c * 16; }
    else { const int lr = tid >> 3, lc = tid & 7; Rp = R + (size_t)lr * ldr + lc * 8; rl_off = lr * G_RS + lc * 16; }
    { const int lr = tid >> 3, lc = tid & 7; Cp = C + (size_t)lr * ldc + lc * 8; cl_off = lr * G_RS + lc * 16; }
    const int nk = K / 64;
    int ra_off[2], cb_off[2];
#pragma unroll
    for (int t = 0; t < 2; ++t) {
        if (TR) { const int g1 = (lane >> 4) & 1, q = (lane & 15) >> 2, p = lane & 3; ra_off[t] = (8 * hi + q) * T_RS + (wi * 64 + t * 32 + 16 * g1 + 4 * p) * 2; }
        else ra_off[t] = (wi * 64 + t * 32 + l31) * G_RS + hi * 16;
        cb_off[t] = G_RB + (wj * 64 + t * 32 + l31) * G_RS + hi * 16;
    }
#define G_LOAD(kt, S) do { const int kk_ = (kt) < nk ? (kt) : nk - 1; \
        if (TR) { _Pragma("unroll") for (int p = 0; p < 4; ++p) rr##S[p] = *(const u32x4*)(Rp + ((size_t)kk_ * 64 + 16 * p) * ldr); } \
        else { _Pragma("unroll") for (int p = 0; p < 4; ++p) rr##S[p] = *(const u32x4*)(Rp + (size_t)(64 * p) * ldr + kk_ * 64); } \
        _Pragma("unroll") for (int p = 0; p < 2; ++p) rc##S[p] = *(const u32x4*)(Cp + (size_t)(64 * p) * ldc + kk_ * 64); } while (0)
#define G_STORE(buf, S) do { char* b_ = lds + (buf) * G_STAGE; \
        if (TR) { _Pragma("unroll") for (int p = 0; p < 4; ++p) *(u32x4*)(b_ + rl_off + 16 * p * T_RS) = rr##S[p]; } \
        else { _Pragma("unroll") for (int p = 0; p < 4; ++p) *(u32x4*)(b_ + rl_off + 64 * p * G_RS) = rr##S[p]; } \
        _Pragma("unroll") for (int p = 0; p < 2; ++p) *(u32x4*)(b_ + G_RB + cl_off + 64 * p * G_RS) = rc##S[p]; } while (0)
#define G_COMPUTE(buf) do { const char* b_ = lds + (buf) * G_STAGE; \
        _Pragma("unroll") for (int ks = 0; ks < 4; ++ks) { bf16x8 fa[2], fb[2]; \
            _Pragma("unroll") for (int t = 0; t < 2; ++t) { \
                if (TR) { \
                    const s16x4 lo = __builtin_bit_cast(s16x4, __builtin_amdgcn_ds_read_tr16_b64_v4i16((LAS s16x4*)(b_ + ra_off[t] + ks * 16 * T_RS))); \
                    const s16x4 hh = __builtin_bit_cast(s16x4, __builtin_amdgcn_ds_read_tr16_b64_v4i16((LAS s16x4*)(b_ + ra_off[t] + (ks * 16 + 4) * T_RS))); \
                    fa[t] = (bf16x8){lo[0], lo[1], lo[2], lo[3], hh[0], hh[1], hh[2], hh[3]}; \
                } else fa[t] = *(const bf16x8*)(b_ + ra_off[t] + ks * 32); \
                fb[t] = *(const bf16x8*)(b_ + cb_off[t] + ks * 32); } \
            _Pragma("unroll") for (int a = 0; a < 2; ++a) _Pragma("unroll") for (int b = 0; b < 2; ++b) acc[a][b] = __builtin_amdgcn_mfma_f32_32x32x16_bf16(fa[a], fb[b], acc[a][b], 0, 0, 0); } } while (0)
    G_LOAD(0, X); G_LOAD(1, Y); G_STORE(0, X);
    __syncthreads();
    for (int kt = 0; kt < nk; kt += 2) {
        G_LOAD(kt + 2, X);
        G_COMPUTE(0);
        G_STORE(1, Y);
        __syncthreads();
        if (kt + 1 >= nk) break;
        G_LOAD(kt + 3, Y);
        G_COMPUTE(1);
        G_STORE(0, X);
        __syncthreads();
    }
#undef G_LOAD
#undef G_STORE
#undef G_COMPUTE
#pragma unroll
    for (int a = 0; a < 2; ++a)
#pragma unroll
        for (int b = 0; b < 2; ++b) epi(ti0 + wi * 64 + a * 32, tj0 + wj * 64 + b * 32, acc[a][b], l31, hi);
}

template <bool TR, class Epi>
DEV void gemm_phase(char* lds, const bf16_t* R, size_t ldr, const bf16_t* C, size_t ldc, int nI, int nJ, int K, const Epi& epi) {
    const int tI = nI / 256, tJ = nJ / 128, nt = tI * tJ;
    for (int t = blockIdx.x; t < nt; t += gridDim.x) {
        const int ti = t / tJ, tj = t % tJ;
        gemm_tile<TR, Epi>(lds, R + (size_t)ti * 256 * ldr, ldr, C + (size_t)tj * 128 * ldc, ldc, K, epi, ti * 256, tj * 128);
    }
}

struct EpiRaw {
    bf16_t* O; size_t ld;
    DEV void operator()(int i0, int j0, const f32x16& a, int l31, int hi) const {
#pragma unroll
        for (int r = 0; r < 16; ++r) O[(size_t)(i0 + crow(r, hi)) * ld + j0 + l31] = f2bf(a[r]);
    }
};
struct EpiUq {
    bf16_t* QM; const float* cos32; const float* sin32;
    DEV void operator()(int i0, int j0, const f32x16& a, int l31, int hi) const {
        const bool pe = (j0 % 96) == 64;
        const int fi = l31 & 7; const bool colang = (l31 & 16) != 0; const bool bpart = (l31 & 8) != 0;
#pragma unroll
        for (int r = 0; r < 16; ++r) {
            const int tok = i0 + crow(r, hi); float v = a[r];
            const float o = __shfl_xor(v, 8);
            if (pe) { const int l = tok & (SEQ - 1); const int pos = colang ? (l & 63) : (l >> 6);
                const float cs = cos32[pos * 8 + fi], sn = sin32[pos * 8 + fi];
                v = bpart ? (v * cs + o * sn) : (v * cs - o * sn); }
            QM[(size_t)tok * 768 + j0 + l31] = f2bf(v * QSC_M);
        }
    }
};
struct EpiUkv {
    bf16_t* KM; bf16_t* VM;
    DEV void operator()(int i0, int j0, const f32x16& a, int l31, int hi) const {
        const int h = j0 >> 7, e = (j0 & 127) + l31;
#pragma unroll
        for (int r = 0; r < 16; ++r) { const size_t row = (size_t)(i0 + crow(r, hi));
            if (e < 64) KM[row * 768 + h * 96 + e] = f2bf(a[r]); else VM[row * 512 + h * 64 + (e - 64)] = f2bf(a[r]); }
    }
};
struct EpiRes {
    const float* base; float* out; const float* mod; float gmul;
    DEV void operator()(int i0, int j0, const f32x16& a, int l31, int hi) const {
        const int b = i0 >> 12; const float g = mod[b * 3072 + 2048 + j0 + l31] * gmul;
#pragma unroll
        for (int h8 = 0; h8 < 2; ++h8) { float bv[8];
#pragma unroll
            for (int r = 0; r < 8; ++r) bv[r] = base[(size_t)(i0 + crow(8 * h8 + r, hi)) * DM + j0 + l31];
#pragma unroll
            for (int r = 0; r < 8; ++r) out[(size_t)(i0 + crow(8 * h8 + r, hi)) * DM + j0 + l31] = bv[r] + g * a[8 * h8 + r]; }
    }
};
struct EpiPT {
    bf16_t* PT;
    DEV void operator()(int i0, int j0, const f32x16& a, int l31, int hi) const {
        const int b = j0 >> 12, l = (j0 & 4095) + l31;
#pragma unroll
        for (int r = 0; r < 16; ++r) PT[((size_t)(b * 4096 + i0 + crow(r, hi))) * 4096 + l] = f2bf(a[r]);
    }
};
struct EpiFilt {
    bf16_t* GR; const float* b3;
    DEV void operator()(int i0, int j0, const f32x16& a, int l31, int hi) const {
        const int t = j0 + l31; const float tn = (float)t * (1.0f / 4095.0f);
        const float dmin = -3.0701134573253945f, dmax = -15.350567286626973f;
#pragma unroll
        for (int r = 0; r < 16; ++r) {
            const int n = i0 + crow(r, hi); const int c = n & 1023, od = n >> 10, o = od >> 1, dir = od & 1;
            const float delta = fabsf(dmin + (float)c * ((dmax - dmin) / 1023.0f));
            const float v = (a[r] + b3[n]) * __expf(-tn * delta);
            bf16_t* g = GR + ((size_t)(o * 1024 + c)) * 8192;
            if (dir == 0) g[4096 - t] = f2bf(v);
            else { if (t == 0) g[0] = 0; else g[4096 + t] = f2bf(v); }
        }
    }
};
DEV void filt_sums(const Params& p) {
    const int wid = TID() >> 6, lane = TID() & 63; bf16_t* GR = (bf16_t*)(p.ws + WS_GR); float* ssum = (float*)(p.ws + WS_SSUM);
    for (int row = blockIdx.x * 8 + wid; row < 2048; row += gridDim.x * 8) {
        bf16_t* g = GR + (size_t)row * 8192; float s = 0.f;
        u32x4 w[16];
#pragma unroll
        for (int j = 0; j < 16; ++j) w[j] = *(const u32x4*)(g + (j * 64 + lane) * 8);
#pragma unroll
        for (int j = 0; j < 16; ++j) { float v[8]; unpack8(w[j], v);
            if (j == 0 && lane == 0) v[0] = 0.f;
#pragma unroll
            for (int e = 0; e < 8; ++e) s += fabsf(v[e]); }
        s = wave_sum(s);
        if (lane == 0) ssum[row] = s;
    }
}

namespace pg8 {
#define PG8_LAS __attribute__((address_space(3)))
typedef short bf16x8 __attribute__((ext_vector_type(8)));
typedef float f32x4 __attribute__((ext_vector_type(4)));
typedef unsigned u32x4 __attribute__((ext_vector_type(4)));
constexpr int BM = 256, BK = 64, HALF = 128, HTB = HALF * BK * 2  , STAGE_BYTES = 8 * HTB, NXCD = 8, WGM = 8;

__host__ __device__ __forceinline__ int lds_byte(int r, int c) { const int st = (r >> 4) * 2 + (c >> 5), rr = r & 15, cc = c & 31, ob = rr * 64 + cc * 2; return st * 1024 + (ob ^ (((ob >> 9) & 1) << 5)); }
__host__ __device__ __forceinline__ void stage_rc(int b, int& R, int& C) { const int st = b / 1024, sb = b % 1024, swz = sb ^ (((sb >> 9) & 1) << 5); R = (st >> 1) * 16 + swz / 64; C = (st & 1) * 32 + (swz % 64) / 2; }
__host__ __device__ __forceinline__ int perm32(int rho) { const int n = rho >> 4, i = rho & 15; return 8 * (i >> 2) + 4 * n + (i & 3); }

struct Unit { int pm, pn; };
struct Gemm { const bf16_t* A; const bf16_t* Bt; int M, N, K; };

struct StaticOrder {
    int nM, nN, nwg, G, c;
    __host__ __device__ void init(int M, int N, int G_, int c_) { nM = M / BM; nN = N / BM; nwg = nM * nN; G = G_; c = c_; }
    __host__ __device__ bool next(int i, Unit& u) const {
        const long L = (long)i * G + c; if (L >= nwg) return false;
        int wgid = (int)L; { const int q = nwg / NXCD, r = nwg % NXCD, xcd = wgid % NXCD, off = wgid / NXCD; wgid = (xcd < r ? xcd * (q + 1) : r * (q + 1) + (xcd - r) * q) + off; }
        const int nig = WGM * nN, gid = wgid / nig, fm = gid * WGM, gsz = (nM - fm) < WGM ? (nM - fm) : WGM;
        u.pm = fm + ((wgid % nig) % gsz); u.pn = (wgid % nig) / gsz; return true;
    }
    __device__ __forceinline__ void a_ready(const Unit&) const {}
    __device__ __forceinline__ void done(const Unit&) const {}
};

__device__ __forceinline__ unsigned cvt_pk_bf16(float lo, float hi) { unsigned r; asm volatile("v_cvt_pk_bf16_f32 %0, %1, %2" : "=v"(r) : "v"(lo), "v"(hi)); return r; }
typedef float f32x2 __attribute__((ext_vector_type(2)));

struct EpiBf16 {
    static constexpr bool PERM = true, AFTER_DRAIN = false;
    bf16_t* O; size_t ldc; int split_cols; size_t split_stride;
    __device__ __forceinline__ void operator()(const f32x4 (&acc)[2][2][4][2], const Unit& u, int wr, int wc, int fr, int fq) const {
        const int row0 = u.pm * BM + wr * 64 + fr; int colt = u.pn * BM; bf16_t* base = O;
        if (split_cols) { const int t = colt / split_cols; base += (size_t)t * split_stride; colt -= t * split_cols; }
        const int col0 = colt + wc * 32 + 8 * fq;
#pragma unroll
        for (int ai = 0; ai < 2; ++ai)
#pragma unroll
            for (int m = 0; m < 4; ++m) { bf16_t* rowp = base + (size_t)(row0 + ai * HALF + m * 16) * ldc + col0;
#pragma unroll
                for (int bj = 0; bj < 2; ++bj) { const f32x4 v0 = acc[ai][bj][m][0], v1 = acc[ai][bj][m][1];
                    u32x4 w; w.x = cvt_pk_bf16(v0[0], v0[1]); w.y = cvt_pk_bf16(v0[2], v0[3]); w.z = cvt_pk_bf16(v1[0], v1[1]); w.w = cvt_pk_bf16(v1[2], v1[3]);
                    *(u32x4*)(rowp + bj * HALF) = w; } }
    }
};

struct EpiUkvPg {
    static constexpr bool PERM = true, AFTER_DRAIN = false;
    bf16_t* KM; bf16_t* VM;
    __device__ __forceinline__ void operator()(const f32x4 (&acc)[2][2][4][2], const Unit& u, int wr, int wc, int fr, int fq) const {
        { const int ln = lane_id(); fr = ln & 15; fq = ln >> 4; }
        const int row0 = u.pm * BM + wr * 64 + fr; const int e0 = 32 * wc + 8 * fq;
        const bool isk = (wc < 2);
        bf16_t* base = isk ? KM + (size_t)row0 * 768 + 2 * u.pn * 96 + e0 : VM + (size_t)row0 * 512 + 2 * u.pn * 64 + (e0 - 64);
        const int ld = isk ? 768 : 512, hs = isk ? 96 : 64;
#pragma unroll
        for (int ai = 0; ai < 2; ++ai)
#pragma unroll
            for (int m = 0; m < 4; ++m)
#pragma unroll
                for (int bj = 0; bj < 2; ++bj) { const f32x4 v0 = acc[ai][bj][m][0], v1 = acc[ai][bj][m][1];
                    u32x4 w; w.x = cvt_pk_bf16(v0[0], v0[1]); w.y = cvt_pk_bf16(v0[2], v0[3]); w.z = cvt_pk_bf16(v1[0], v1[1]); w.w = cvt_pk_bf16(v1[2], v1[3]);
                    *(u32x4*)(base + (ai * HALF + m * 16) * ld + bj * hs) = w; }
    }
};
struct EpiUqPg {
    static constexpr bool PERM = true, AFTER_DRAIN = false;
    bf16_t* QM; const float* cos32; const float* sin32; float sc;
    __device__ __forceinline__ void operator()(const f32x4 (&acc)[2][2][4][2], const Unit& u, int wr, int wc, int fr, int fq) const {
        { const int ln = lane_id(); fr = ln & 15; fq = ln >> 4; }
        const int row0 = u.pm * BM + wr * 64 + fr;
        bf16_t* base = QM + (size_t)row0 * 768 + u.pn * BM + 32 * wc + 8 * fq;
        const int g0 = 8 * u.pn + wc;
        const bool sgn = (fq & 1) != 0;
#pragma unroll
        for (int bj = 0; bj < 2; ++bj) { const bool pe = (((g0 + 4 * bj) % 3) == 2);
#pragma unroll
            for (int ai = 0; ai < 2; ++ai)
#pragma unroll
                for (int m = 0; m < 4; ++m) { const int rr = ai * HALF + m * 16; u32x4 w;
#pragma unroll
                    for (int n = 0; n < 2; ++n) { f32x4 v = acc[ai][bj][m][n];
                        if (pe) { f32x4 o;
#pragma unroll
                            for (int e = 0; e < 4; ++e) o[e] = __shfl_xor(v[e], 16);
                            const int l = (row0 + rr) & 4095, pos = (fq < 2) ? (l >> 6) : (l & 63);
                            const f32x4 cv = *(const f32x4*)(cos32 + pos * 8 + 4 * n), sv = *(const f32x4*)(sin32 + pos * 8 + 4 * n);
                            v = sgn ? (v * cv + o * sv) : (v * cv - o * sv); }
                        v = v * sc;
                        if (n == 0) { w.x = cvt_pk_bf16(v[0], v[1]); w.y = cvt_pk_bf16(v[2], v[3]); } else { w.z = cvt_pk_bf16(v[0], v[1]); w.w = cvt_pk_bf16(v[2], v[3]); } }
                    *(u32x4*)(base + rr * 768 + bj * HALF) = w;
                    asm volatile("" ::: "memory"); } }
    }
};
struct EpiResF32 {
    static constexpr bool PERM = false, AFTER_DRAIN = false;
    const float* base; float* out; const float* mod; float gmul;
    __device__ __forceinline__ void operator()(const f32x4 (&acc)[2][2][4][2], const Unit& u, int wr, int wc, int fr, int fq) const {
        const int row0 = u.pm * BM + wr * 64 + fr, col0 = u.pn * BM + wc * 32 + 4 * fq, b = (u.pm * BM) >> 12;
        f32x4 g[2][2];
#pragma unroll
        for (int bj = 0; bj < 2; ++bj)
#pragma unroll
            for (int n = 0; n < 2; ++n) g[bj][n] = *(const f32x4*)(mod + b * 3072 + 2048 + col0 + bj * HALF + n * 16) * gmul;
#pragma unroll
        for (int ai = 0; ai < 2; ++ai) {
            f32x4 pre[4][2][2];
#pragma unroll
            for (int m = 0; m < 4; ++m) { const size_t off = (size_t)(row0 + ai * HALF + m * 16) * 1024 + col0;
#pragma unroll
                for (int bj = 0; bj < 2; ++bj)
#pragma unroll
                    for (int n = 0; n < 2; ++n) pre[m][bj][n] = *(const f32x4*)(base + off + bj * HALF + n * 16); }
#pragma unroll
            for (int m = 0; m < 4; ++m) { const size_t off = (size_t)(row0 + ai * HALF + m * 16) * 1024 + col0;
#pragma unroll
                for (int bj = 0; bj < 2; ++bj)
#pragma unroll
                    for (int n = 0; n < 2; ++n) *(f32x4*)(out + off + bj * HALF + n * 16) = pre[m][bj][n] + g[bj][n] * acc[ai][bj][m][n]; }
        }
    }
};
template <class Epi, class Sched, bool ALIGN_EPI = false, bool SP2 = false>
__device__ __forceinline__ void gemm_phase(PG8_LAS unsigned char* lds, const Gemm g, const Sched& S, const Epi& E) {
    int tid_ = TID(); asm volatile("" : "+v"(tid_));
    const int tid = tid_, wid = __builtin_amdgcn_readfirstlane(tid >> 6), lane = tid & 63, wr = wid >> 2, wc = wid & 3, fr = lane & 15, fq = lane >> 4;
    const int K = g.K, nt = K / BK;
    unsigned voffA[2], voffB[2];
#pragma unroll
    for (int i = 0; i < 2; ++i) { int R, C; stage_rc(tid * 16 + i * 8192, R, C); const int Rb = Epi::PERM ? ((R & ~31) + perm32(R & 31)) : R;
        voffA[i] = (unsigned)(R * K + C) * 2u; voffB[i] = (unsigned)(Rb * K + C) * 2u; }
    const size_t kstep = (size_t)(BK * 2);
    const size_t hstep = (size_t)HALF * K * 2;
    const size_t tstep = 2 * hstep;
    const unsigned ldsw = (unsigned)wid * 1024u;
    const int aoff = lds_byte(wr * 64 + fr, fq * 8), boff = lds_byte(wc * 32 + fr, fq * 8);
#define PG8_SA(b, h) (((b) * 2 + (h)) * HTB)
#define PG8_SB(b, h) ((4 + (b) * 2 + (h)) * HTB)
#define PG8_STAGE(bufoff, gbase, voff) do { _Pragma("unroll") for (int _i = 0; _i < 2; ++_i) \
        __builtin_amdgcn_global_load_lds((const unsigned*)((const char*)(gbase) + (voff)[_i]), (PG8_LAS unsigned*)(lds + (bufoff) + ldsw + _i * 8192), 16, 0, 0); } while (0)
#define PG8_LDA(dst, b, h) do { _Pragma("unroll") for (int m = 0; m < 4; ++m) _Pragma("unroll") for (int k = 0; k < 2; ++k) dst[m][k] = *(const PG8_LAS bf16x8*)(lds + PG8_SA(b, h) + aoff + m * 2048 + k * 1024); } while (0)
#define PG8_LDB(dst, b, h) do { _Pragma("unroll") for (int n = 0; n < 2; ++n) _Pragma("unroll") for (int k = 0; k < 2; ++k) dst[n][k] = *(const PG8_LAS bf16x8*)(lds + PG8_SB(b, h) + boff + n * 2048 + k * 1024); } while (0)
#define PG8_MMA(ai, bj, At, Bt) do { __builtin_amdgcn_s_setprio(1); _Pragma("unroll") for (int m = 0; m < 4; ++m) _Pragma("unroll") for (int n = 0; n < 2; ++n) _Pragma("unroll") for (int k = 0; k < 2; ++k) \
        acc[ai][bj][m][n] = __builtin_amdgcn_mfma_f32_16x16x32_bf16(Bt[n][k], At[m][k], acc[ai][bj][m][n], 0, 0, 0); __builtin_amdgcn_s_setprio(0); } while (0)
#define PG8_WAIT_V(n) asm volatile("s_waitcnt vmcnt(" #n ")" ::: "memory")
#define PG8_WAIT_L(n) asm volatile("s_waitcnt lgkmcnt(" #n ")" ::: "memory")
#define PG8_BAR __builtin_amdgcn_s_barrier()
#define PG8_SCHED __builtin_amdgcn_sched_barrier(0)
    Unit cur, nxt; int ui = 0;
    if (!S.next(0, cur)) return;
    f32x4 acc[2][2][4][2];
#pragma unroll
    for (int a = 0; a < 2; ++a)
#pragma unroll
        for (int b = 0; b < 2; ++b)
#pragma unroll
            for (int m = 0; m < 4; ++m)
#pragma unroll
                for (int n = 0; n < 2; ++n) acc[a][b][m][n] = (f32x4){0.f, 0.f, 0.f, 0.f};
    bf16x8 At[4][2], B0[2][2], B1[2][2];
    const char* cA = (const char*)g.A + (size_t)cur.pm * tstep; const char* cB = (const char*)g.Bt + (size_t)cur.pn * tstep;
    S.a_ready(cur);
    if constexpr (SP2) {
        PG8_STAGE(PG8_SB(0, 0), cB, voffB); PG8_STAGE(PG8_SB(0, 1), cB + hstep, voffB); PG8_STAGE(PG8_SA(0, 0), cA, voffA); PG8_STAGE(PG8_SA(0, 1), cA + hstep, voffA);
        if (wr == 1) PG8_BAR;
        PG8_WAIT_V(2); PG8_BAR;
        PG8_STAGE(PG8_SB(1, 0), cB + kstep, voffB); PG8_STAGE(PG8_SA(1, 0), cA + kstep, voffA); PG8_STAGE(PG8_SB(1, 1), cB + hstep + kstep, voffB);
        PG8_WAIT_V(6); PG8_BAR;
    } else {
        PG8_STAGE(PG8_SB(0, 0), cB, voffB); PG8_STAGE(PG8_SA(0, 0), cA, voffA); PG8_STAGE(PG8_SB(0, 1), cB + hstep, voffB); PG8_STAGE(PG8_SA(0, 1), cA + hstep, voffA);
        if (wr == 1) PG8_BAR;
        PG8_WAIT_V(4); PG8_BAR;
        PG8_STAGE(PG8_SB(1, 0), cB + kstep, voffB); PG8_STAGE(PG8_SA(1, 0), cA + kstep, voffA); PG8_STAGE(PG8_SB(1, 1), cB + hstep + kstep, voffB);
        PG8_WAIT_V(6); PG8_BAR;
    }
    for (;;) {
        const bool has_next = S.next(ui + 1, nxt);
        const char* nA = has_next ? (const char*)g.A + (size_t)nxt.pm * tstep : cA; const char* nB = has_next ? (const char*)g.Bt + (size_t)nxt.pn * tstep : cB;
        for (int t = 0; t < nt; t += 2) {
            const bool last = (t == nt - 2);
            const char* a1 = cA + (size_t)(t + 1) * kstep;
            const char* a2 = last ? nA : cA + (size_t)(t + 2) * kstep; const char* b2 = last ? nB : cB + (size_t)(t + 2) * kstep;
            const char* a3 = a2 + kstep; const char* b3 = b2 + kstep;
            if (last && has_next) S.a_ready(nxt);
            if constexpr (SP2) {
            PG8_LDB(B0, 0, 0); PG8_LDB(B1, 0, 1); PG8_SCHED; PG8_LDA(At, 0, 0); PG8_STAGE(PG8_SA(1, 1), a1 + hstep, voffA);
            PG8_WAIT_V(8); PG8_WAIT_L(0); PG8_BAR; PG8_MMA(0, 0, At, B0); PG8_MMA(0, 1, At, B1); PG8_BAR; PG8_SCHED;
            PG8_LDA(At, 0, 1); PG8_STAGE(PG8_SB(0, 0), b2, voffB); PG8_STAGE(PG8_SB(0, 1), b2 + hstep, voffB); PG8_STAGE(PG8_SA(0, 0), a2, voffA);
            PG8_WAIT_V(8); PG8_WAIT_L(0); PG8_BAR; PG8_MMA(1, 0, At, B0); PG8_MMA(1, 1, At, B1); PG8_BAR; PG8_SCHED;
            PG8_LDB(B0, 1, 0); PG8_LDB(B1, 1, 1); PG8_SCHED; PG8_LDA(At, 1, 0); PG8_STAGE(PG8_SA(0, 1), a2 + hstep, voffA);
            PG8_WAIT_V(8); PG8_WAIT_L(0); PG8_BAR; PG8_MMA(0, 0, At, B0); PG8_MMA(0, 1, At, B1); PG8_BAR; PG8_SCHED;
            PG8_LDA(At, 1, 1); PG8_STAGE(PG8_SB(1, 0), b3, voffB); PG8_STAGE(PG8_SB(1, 1), b3 + hstep, voffB); PG8_STAGE(PG8_SA(1, 0), a3, voffA);
            PG8_WAIT_V(8); PG8_WAIT_L(0); PG8_BAR; PG8_MMA(1, 0, At, B0); PG8_MMA(1, 1, At, B1); PG8_BAR; PG8_SCHED;
            } else {
            PG8_LDB(B0, 0, 0); PG8_SCHED; PG8_LDA(At, 0, 0); PG8_STAGE(PG8_SA(1, 1), a1 + hstep, voffA);
            PG8_WAIT_L(8); PG8_BAR; PG8_WAIT_L(0); PG8_MMA(0, 0, At, B0); PG8_BAR; PG8_SCHED;
            PG8_LDB(B1, 0, 1); PG8_STAGE(PG8_SB(0, 0), b2, voffB);
            PG8_BAR; PG8_WAIT_L(0); PG8_MMA(0, 1, At, B1); PG8_BAR;
            PG8_LDA(At, 0, 1); PG8_STAGE(PG8_SA(0, 0), a2, voffA);
            PG8_BAR; PG8_WAIT_L(0); PG8_MMA(1, 0, At, B0); PG8_BAR; PG8_SCHED;
            PG8_STAGE(PG8_SB(0, 1), b2 + hstep, voffB);
            PG8_WAIT_V(6); PG8_BAR; PG8_MMA(1, 1, At, B1); PG8_BAR;
            PG8_LDB(B0, 1, 0); PG8_SCHED; PG8_LDA(At, 1, 0); PG8_STAGE(PG8_SA(0, 1), a2 + hstep, voffA);
            PG8_WAIT_L(8); PG8_BAR; PG8_WAIT_L(0); PG8_MMA(0, 0, At, B0); PG8_BAR; PG8_SCHED;
            PG8_LDB(B1, 1, 1); PG8_STAGE(PG8_SB(1, 0), b3, voffB);
            PG8_BAR; PG8_WAIT_L(0); PG8_MMA(0, 1, At, B1); PG8_BAR;
            PG8_LDA(At, 1, 1); PG8_STAGE(PG8_SA(1, 0), a3, voffA);
            PG8_BAR; PG8_WAIT_L(0); PG8_MMA(1, 0, At, B0); PG8_BAR; PG8_SCHED;
            PG8_STAGE(PG8_SB(1, 1), b3 + hstep, voffB);
            PG8_WAIT_V(6); PG8_BAR; PG8_MMA(1, 1, At, B1); PG8_BAR;
            }
        }
        if constexpr (ALIGN_EPI) { if (wr == 0) PG8_BAR; }
        if constexpr (!Epi::AFTER_DRAIN) { E(acc, cur, wr, wc, fr, fq); S.done(cur); }
        if (!has_next) break;
#pragma unroll
        for (int a = 0; a < 2; ++a)
#pragma unroll
            for (int b = 0; b < 2; ++b)
#pragma unroll
                for (int m = 0; m < 4; ++m)
#pragma unroll
                    for (int n = 0; n < 2; ++n) acc[a][b][m][n] = (f32x4){0.f, 0.f, 0.f, 0.f};
        cur = nxt; cA = nA; cB = nB; ++ui;
        if constexpr (ALIGN_EPI) { if (wr == 1) PG8_BAR; }
    }
    PG8_WAIT_V(0);
    if constexpr (!ALIGN_EPI) { if (wr == 0) PG8_BAR; }
    PG8_BAR;
    if constexpr (Epi::AFTER_DRAIN) { E.fused(acc, cur, wr, wc, fr, fq, lds, wid, lane); S.done(cur); }
#undef PG8_SA
#undef PG8_SB
#undef PG8_STAGE
#undef PG8_LDA
#undef PG8_LDB
#undef PG8_MMA
#undef PG8_WAIT_V
#undef PG8_WAIT_L
#undef PG8_BAR
#undef PG8_SCHED
}
}

DEV void transpose_item(float* scr, const float* W, int K, int N, int Npad, bf16_t* WT, int item, int lane) {
    const int nblk = Npad / 32, kb = item / nblk, nb = item % nblk, k0 = 64 * kb, n0 = 32 * nb;
    const bool valid = (n0 < N);
    float v[32];
#pragma unroll
    for (int i = 0; i < 32; ++i) { const int kk = 2 * i + (lane >> 5); v[i] = valid ? W[(size_t)(k0 + kk) * N + n0 + (lane & 31)] : 0.f; }
#pragma unroll
    for (int i = 0; i < 32; ++i) { const int kk = 2 * i + (lane >> 5); scr[kk * 33 + (lane & 31)] = v[i]; }
    asm volatile("s_waitcnt lgkmcnt(0)" ::: "memory");
    const int c = lane & 7;
#pragma unroll
    for (int j = 0; j < 4; ++j) { const int n = (lane >> 3) + 8 * j; const float* sp = scr + (8 * c) * 33 + n; float o[8];
#pragma unroll
        for (int e = 0; e < 8; ++e) o[e] = sp[e * 33];
        *(u32x4*)(WT + (size_t)(n0 + n) * K + k0 + 8 * c) = pack8(o); }
    asm volatile("s_waitcnt lgkmcnt(0)" ::: "memory");
}

DEV void mod_item(char* lds, const Params& p, int item) {
    const int layer = item / 96, n0 = (item % 96) * 32, tid = TID();
    float* s = (float*)lds;
    float* red = s + 9 * 1024;
    for (int i = tid; i < 9 * 1024; i += 512) { const int v = i >> 10, k = i & 1023; const float cv = (v < 8) ? p.c[v * 1024 + k] : p.c_ctx[k]; s[i] = silu(cv); }
    __syncthreads();
    const int kc = tid >> 5, n = tid & 31; const float* W = p.ada_w + (size_t)layer * DM * 3072 + n0 + n;
    float acc[9];
#pragma unroll
    for (int v = 0; v < 9; ++v) acc[v] = 0.f;
#pragma unroll 16
    for (int kk = 0; kk < 64; ++kk) { const int k = kc * 64 + kk; const float w = W[(size_t)k * 3072];
#pragma unroll
        for (int v = 0; v < 9; ++v) acc[v] += s[v * 1024 + k] * w; }
#pragma unroll
    for (int v = 0; v < 9; ++v) red[(kc * 9 + v) * 32 + n] = acc[v];
    __syncthreads();
    if (tid < 9 * 32) { const int v = tid >> 5, nn = tid & 31; float t = 0.f;
#pragma unroll
        for (int k2 = 0; k2 < 16; ++k2) t += red[(k2 * 9 + v) * 32 + nn];
        t += p.ada_b[layer * 3072 + n0 + nn];
        if (layer == 0) ((float*)(p.ws + WS_MOD0))[v * 3072 + n0 + nn] = t;
        else if (v < 8) ((float*)(p.ws + WS_MOD1))[v * 3072 + n0 + nn] = t; }
    __syncthreads();
}

DEV void hid2_row(char* lds, const Params& p, int t, int wid, int lane) {
    float* sc = (float*)lds + wid * 128;
    const float tn = (float)t * (1.0f / 4095.0f);
    const float w = (float)(2.0 * 3.14159265358979323846 / 4096.0) * (float)t;
    float e = 0.f;
    if (lane == 0) e = tn;
    else if (lane <= 32) { const int k = (lane - 1) & 15; const float band = 1e-4f + (float)k * ((15.0f - 1e-4f) / 15.0f); const float ang = w * band; e = (lane <= 16) ? cosf(ang) : -sinf(ang); }
    sc[lane] = e;
    asm volatile("s_waitcnt lgkmcnt(0)" ::: "memory");
    float a = p.f_b1[lane];
    for (int i = 0; i < 33; ++i) a += sc[i] * p.f_w1[i * 64 + lane];
    const float fr = p.freq[lane];
    const float h1 = sinf(fr * a);
    sc[64 + lane] = h1;
    asm volatile("s_waitcnt lgkmcnt(0)" ::: "memory");
    float a2 = p.f_b2[lane];
    for (int i = 0; i < 64; ++i) a2 += sc[64 + i] * p.f_w2[i * 64 + lane];
    const float h2 = sinf(fr * a2);
    ((bf16_t*)(p.ws + WS_HID2))[t * 64 + lane] = f2bf(h2);
    asm volatile("s_waitcnt lgkmcnt(0)" ::: "memory");
}

DEV void phase_prep(char* lds, const Params& p) {
    const int tid = TID(), wid = tid >> 6, lane = tid & 63;
    { const int gt = blockIdx.x * 512 + tid;
        if (gt < 2048) ((float*)(p.ws + WS_SSUM))[gt] = 0.f;
        float* rp = (float*)(p.ws + WS_ROPE);
        if (gt < 1024) { const int pos = gt >> 4, i = gt & 15; const float inv = exp2f(-(float)i * (13.287712379549449f / 16.0f)); const float ang = (float)pos * inv; rp[gt] = cosf(ang); rp[1024 + gt] = sinf(ang); }
        if (gt < 512) { const int pos = gt >> 3, i = gt & 7; const float inv = exp2f(-(float)i * (13.287712379549449f / 8.0f)); const float ang = (float)pos * inv; rp[2048 + gt] = cosf(ang); rp[2560 + gt] = sinf(ang); } }
    for (int it = blockIdx.x; it < 192; it += gridDim.x) mod_item(lds, p, it);
    for (int t = blockIdx.x * 8 + wid; t < 4096; t += gridDim.x * 8) hid2_row(lds, p, t, wid, lane);
    __syncthreads();
    constexpr int I_WIN = 16 * (AINP / 32), I_UQ = 4 * 24, I_UKV = 2 * 32, I_WO = 16 * 32, I_HIN = 16 * 128, I_HO = 16 * 32, I_W3 = 128;
    constexpr int NIT = I_WIN + I_UQ + I_UKV + I_WO + I_HIN + I_HO + I_W3;
    float* scr = (float*)lds + wid * (64 * 33);
    for (int it = blockIdx.x * 8 + wid; it < NIT; it += gridDim.x * 8) {
        int r = it;
        if (r < I_HIN) { transpose_item(scr, p.hy_w_in, 1024, 4096, 4096, (bf16_t*)(p.ws + WS_HWIN), r, lane); continue; } r -= I_HIN;
        if (r < I_WIN) { transpose_item(scr, p.w_in, 1024, AIN, AINP, (bf16_t*)(p.ws + WS_WIN), r, lane); continue; } r -= I_WIN;
        if (r < I_WO) { transpose_item(scr, p.w_out, 1024, 1024, 1024, (bf16_t*)(p.ws + WS_WOUT), r, lane); continue; } r -= I_WO;
        if (r < I_HO) { transpose_item(scr, p.hy_w_out, 1024, 1024, 1024, (bf16_t*)(p.ws + WS_HWOUT), r, lane); continue; } r -= I_HO;
        if (r < I_UQ) { transpose_item(scr, p.w_uq, 256, 768, 768, (bf16_t*)(p.ws + WS_WUQ), r, lane); continue; } r -= I_UQ;
        if (r < I_UKV) { transpose_item(scr, p.w_ukv, 128, 1024, 1024, (bf16_t*)(p.ws + WS_WUKV), r, lane); continue; } r -= I_UKV;
        transpose_item(scr, p.f_w3, 64, 4096, 4096, (bf16_t*)(p.ws + WS_W3), r, lane);
    }
}

DEV void row_load(f32x4 (&v)[4], const float* xr, int lane) {
#pragma unroll
    for (int j = 0; j < 4; ++j) v[j] = *(const f32x4*)(xr + lane * 4 + 256 * j);
}
DEV void modnorm_row(const f32x4 (&v)[4], const float* nw, const float* shift, const float* scale, bf16_t* orow, int lane) {
    float s = 0.f;
#pragma unroll
    for (int j = 0; j < 4; ++j) s += v[j].x * v[j].x + v[j].y * v[j].y + v[j].z * v[j].z + v[j].w * v[j].w;
    const float r = rsqrtf(wave_sum(s) * (1.0f / DM) + EPS);
#pragma unroll
    for (int j = 0; j < 4; ++j) { const int c0 = lane * 4 + 256 * j;
        const f32x4 w = *(const f32x4*)(nw + c0), sh = *(const f32x4*)(shift + c0), sc = *(const f32x4*)(scale + c0);
        const float o0 = v[j].x * r * w.x * (1.f + sc.x) + sh.x, o1 = v[j].y * r * w.y * (1.f + sc.y) + sh.y, o2 = v[j].z * r * w.z * (1.f + sc.z) + sh.z, o3 = v[j].w * r * w.w * (1.f + sc.w) + sh.w;
        u32x2 pk; pk.x = pk2(o0, o1); pk.y = pk2(o2, o3); *(u32x2*)(orow + c0) = pk; }
}
DEV const float* norm0_src(const Params& p, int row) { return row < NTOK ? p.x + (size_t)row * DM : p.ctx + (size_t)(row - NTOK) * DM; }
DEV void phase_norm0(const Params& p) {
    const int wid = TID() >> 6, lane = TID() & 63; const float* mod0 = (const float*)(p.ws + WS_MOD0); bf16_t* H0 = (bf16_t*)(p.ws + WS_H0);
    const int stride = gridDim.x * 8; int row = blockIdx.x * 8 + wid;
    f32x4 cur[4], nxt[4];
    if (row < NALL) row_load(cur, norm0_src(p, row), lane);
    for (; row < NALL; row += stride) {
        { const int rn = row + stride < NALL ? row + stride : row; row_load(nxt, norm0_src(p, rn), lane); }
        const int v = row < NTOK ? (row >> 12) : 8;
        modnorm_row(cur, p.norm_w, mod0 + v * 3072, mod0 + v * 3072 + 1024, H0 + (size_t)row * DM, lane);
#pragma unroll
        for (int j = 0; j < 4; ++j) cur[j] = nxt[j];
    }
}
DEV void phase_norm1(const Params& p) {
    const int wid = TID() >> 6, lane = TID() & 63; const float* mod1 = (const float*)(p.ws + WS_MOD1); bf16_t* H1 = (bf16_t*)(p.ws + WS_H1);
    const int stride = gridDim.x * 8; int row = blockIdx.x * 8 + wid;
    f32x4 cur[4], nxt[4];
    if (row < NTOK) row_load(cur, p.out + (size_t)row * DM, lane);
    for (; row < NTOK; row += stride) {
        { const int rn = row + stride < NTOK ? row + stride : row; row_load(nxt, p.out + (size_t)rn * DM, lane); }
        const int v = row >> 12;
        modnorm_row(cur, p.norm_w + DM, mod1 + v * 3072, mod1 + v * 3072 + 1024, H1 + (size_t)row * DM, lane);
#pragma unroll
        for (int j = 0; j < 4; ++j) cur[j] = nxt[j];
    }
}
DEV void phase_final(const Params& p) {
    const int wid = TID() >> 6, lane = TID() & 63;
    const int stride = gridDim.x * 8; int row = blockIdx.x * 8 + wid;
    f32x4 v[4], nxt[4];
    if (row < NTOK) row_load(v, p.out + (size_t)row * DM, lane);
    for (; row < NTOK; row += stride) {
        { const int rn = row + stride < NTOK ? row + stride : row; row_load(nxt, p.out + (size_t)rn * DM, lane); }
        float* xr = p.out + (size_t)row * DM; float s = 0.f;
#pragma unroll
        for (int j = 0; j < 4; ++j) s += v[j].x * v[j].x + v[j].y * v[j].y + v[j].z * v[j].z + v[j].w * v[j].w;
        const float r = rsqrtf(wave_sum(s) * (1.0f / DM) + EPS);
#pragma unroll
        for (int j = 0; j < 4; ++j) { const int c0 = lane * 4 + 256 * j; const f32x4 w = *(const f32x4*)(p.final_w + c0);
            f32x4 o; o.x = v[j].x * r * w.x; o.y = v[j].y * r * w.y; o.z = v[j].z * r * w.z; o.w = v[j].w * r * w.w; *(f32x4*)(xr + c0) = o; }
#pragma unroll
        for (int j = 0; j < 4; ++j) v[j] = nxt[j];
    }
}

struct PostIn { u32x4 raw[5]; f32x4 c64[2], s64[2], c32[2], s32[2]; };
DEV void post_load(PostIn& I, const bf16_t* PRAW, const float* rp, int tok, int lane) {
    const bf16_t* pr = PRAW + (size_t)tok * AINP;
#pragma unroll
    for (int sgm = 0; sgm < 4; ++sgm) I.raw[sgm] = *(const u32x4*)(pr + 512 * sgm + lane * 8);
    I.raw[4] = *(const u32x4*)(pr + 2048 + (lane & 31) * 8);
    const int l = tok & 4095, prow = l >> 6, pcol = l & 63;
    const int k = lane & 7, posv = (k < 4) ? prow : pcol; const float* t64 = rp + posv * 16 + (k & 1) * 8;
    I.c64[0] = *(const f32x4*)t64; I.c64[1] = *(const f32x4*)(t64 + 4); I.s64[0] = *(const f32x4*)(t64 + 1024); I.s64[1] = *(const f32x4*)(t64 + 1028);
    const int k3 = lane & 3, posm = (k3 < 2) ? prow : pcol; const float* t32 = rp + 2048 + posm * 8;
    I.c32[0] = *(const f32x4*)t32; I.c32[1] = *(const f32x4*)(t32 + 4); I.s32[0] = *(const f32x4*)(t32 + 512); I.s32[1] = *(const f32x4*)(t32 + 516);
}
DEV void phase_post(const Params& p) {
    const int wid = TID() >> 6, lane = TID() & 63;
    const bf16_t* PRAW = (const bf16_t*)(p.ws + WS_PRAW);
    bf16_t* QA = (bf16_t*)(p.ws + WS_QA); bf16_t* KA = (bf16_t*)(p.ws + WS_KA); bf16_t* VA = (bf16_t*)(p.ws + WS_VA);
    bf16_t* CQN = (bf16_t*)(p.ws + WS_CQN); bf16_t* CKVN = (bf16_t*)(p.ws + WS_CKVN); bf16_t* G = (bf16_t*)(p.ws + WS_G); bf16_t* KM = (bf16_t*)(p.ws + WS2_KM);
    const float* rp = (const float*)(p.ws + WS_ROPE);
    float wq[8], wk[8], wcq[8], wckv[8];
    { const int k = lane & 7;
#pragma unroll
        for (int j = 0; j < 8; ++j) { wq[j] = p.q_norm[k * 8 + j]; wk[j] = p.k_norm[k * 8 + j]; wcq[j] = p.cq_norm[(lane & 31) * 8 + j]; wckv[j] = p.ckv_norm[(lane & 15) * 8 + j]; } }
    const int stride = gridDim.x * 8;
    int tok = blockIdx.x * 8 + wid;
    PostIn cur, nxt;
    if (tok < NALL) post_load(cur, PRAW, rp, tok, lane);
    for (; tok < NALL; tok += stride) {
        { const int tn = tok + stride < NALL ? tok + stride : tok; post_load(nxt, PRAW, rp, tn, lane); }
        const bool lat = tok < NTOK; int b, pos;
        if (lat) { b = tok >> 12; pos = CTXL + (tok & 4095); } else { const int j = tok - NTOK; b = j >> 8; pos = j & 255; }
        const size_t kvrow = (size_t)b * LK + pos;
        const float cs64[8] = {cur.c64[0].x, cur.c64[0].y, cur.c64[0].z, cur.c64[0].w, cur.c64[1].x, cur.c64[1].y, cur.c64[1].z, cur.c64[1].w};
        const float sn64[8] = {cur.s64[0].x, cur.s64[0].y, cur.s64[0].z, cur.s64[0].w, cur.s64[1].x, cur.s64[1].y, cur.s64[1].z, cur.s64[1].w};
        float v[8], o[8];
        if (lat) {
            unpack8(cur.raw[0], v);
            float ss = 0.f;
#pragma unroll
            for (int j = 0; j < 8; ++j) ss += v[j] * v[j];
            ss += __shfl_xor(ss, 1); ss += __shfl_xor(ss, 2); ss += __shfl_xor(ss, 4);
            const float r = rsqrtf(ss * (1.0f / 64.0f) + EPS); const int k = lane & 7;
#pragma unroll
            for (int j = 0; j < 8; ++j) v[j] = v[j] * r * wq[j];
#pragma unroll
            for (int j = 0; j < 8; ++j) { const float ot = __shfl_xor(v[j], 2);
                o[j] = ((k & 2) ? (v[j] * cs64[j] + ot * sn64[j]) : (v[j] * cs64[j] - ot * sn64[j])) * QSC_A; }
            *(u32x4*)(QA + (size_t)tok * 512 + lane * 8) = pack8(o);
        }
        {
            const u32x4 raw = cur.raw[1]; unpack8(raw, v);
            float ss = 0.f;
#pragma unroll
            for (int j = 0; j < 8; ++j) ss += v[j] * v[j];
            ss += __shfl_xor(ss, 1); ss += __shfl_xor(ss, 2); ss += __shfl_xor(ss, 4);
            const float s8 = ss;
            ss += __shfl_xor(ss, 8); ss += __shfl_xor(ss, 16);
            const float s32 = ss;
            float vn[8]; const int k = lane & 7;
            { const float r = rsqrtf(s8 * (1.0f / 64.0f) + EPS);
#pragma unroll
                for (int j = 0; j < 8; ++j) vn[j] = v[j] * r * wk[j]; }
#pragma unroll
            for (int j = 0; j < 8; ++j) { const float ot = __shfl_xor(vn[j], 2);
                o[j] = lat ? ((k & 2) ? (vn[j] * cs64[j] + ot * sn64[j]) : (vn[j] * cs64[j] - ot * sn64[j])) : vn[j]; }
            if (lane < 16) *(u32x4*)(KA + kvrow * 128 + lane * 8) = pack8(o);
            else if (lane < 32) *(u32x4*)(VA + kvrow * 128 + (lane - 16) * 8) = raw;
            else if (lat) { const float r = rsqrtf(s32 * (1.0f / 256.0f) + EPS); const int cb = (lane - 32) * 8;
#pragma unroll
                for (int j = 0; j < 8; ++j) o[j] = v[j] * r * wcq[j];
                *(u32x4*)(CQN + (size_t)tok * 256 + cb) = pack8(o); }
        }
        {
            unpack8(cur.raw[2], v);
            float ss = 0.f;
#pragma unroll
            for (int j = 0; j < 8; ++j) ss += v[j] * v[j];
            ss += __shfl_xor(ss, 1); ss += __shfl_xor(ss, 2); ss += __shfl_xor(ss, 4); ss += __shfl_xor(ss, 8);
            const int k = lane & 3;
            float oth[8];
#pragma unroll
            for (int j = 0; j < 8; ++j) oth[j] = __shfl_xor(v[j], 1);
            if (lane < 16) { const float r = rsqrtf(ss * (1.0f / 128.0f) + EPS);
#pragma unroll
                for (int j = 0; j < 8; ++j) o[j] = v[j] * r * wckv[j];
                *(u32x4*)(CKVN + kvrow * 128 + lane * 8) = pack8(o); }
            else if (lane < 20) {
                const float cs32[8] = {cur.c32[0].x, cur.c32[0].y, cur.c32[0].z, cur.c32[0].w, cur.c32[1].x, cur.c32[1].y, cur.c32[1].z, cur.c32[1].w};
                const float sn32[8] = {cur.s32[0].x, cur.s32[0].y, cur.s32[0].z, cur.s32[0].w, cur.s32[1].x, cur.s32[1].y, cur.s32[1].z, cur.s32[1].w};
#pragma unroll
                for (int j = 0; j < 8; ++j) o[j] = lat ? ((k & 1) ? (v[j] * cs32[j] + oth[j] * sn32[j]) : (v[j] * cs32[j] - oth[j] * sn32[j])) : v[j];
                const u32x4 w = pack8(o);
#pragma unroll
                for (int h = 0; h < 8; ++h) *(u32x4*)(KM + kvrow * 768 + h * 96 + 64 + k * 8) = w; }
            else if (lat) {
#pragma unroll
                for (int j = 0; j < 8; ++j) o[j] = silu(v[j]);
                *(u32x4*)(G + (size_t)tok * 1024 + (lane - 20) * 8) = pack8(o); }
        }
        if (lat) {
            unpack8(cur.raw[3], v);
#pragma unroll
            for (int j = 0; j < 8; ++j) o[j] = silu(v[j]);
            *(u32x4*)(G + (size_t)tok * 1024 + 352 + lane * 8) = pack8(o);
            if (lane < 20) { unpack8(cur.raw[4], v);
#pragma unroll
                for (int j = 0; j < 8; ++j) o[j] = silu(v[j]);
                *(u32x4*)(G + (size_t)tok * 1024 + 864 + lane * 8) = pack8(o); }
        }
        cur = nxt;
    }
}

template <int DQK>
DEV void attn_unit(char* lds, const bf16_t* __restrict__ Q, int ldq, int qcol, const bf16_t* __restrict__ Kp, int ldk, int kcol, const bf16_t* __restrict__ Vp, int ldv, int vcol,
                   const bf16_t* __restrict__ Gt, bf16_t* OG, int ocol, int b, int q0) {
    constexpr int KRS = (DQK + 8) * 2, KB = 64 * KRS, VRS = 192, VB = 64 * VRS, STG = KB + VB, NKS = DQK / 16, KCH = DQK / 8;
    const int tid = TID(), lane = tid & 63, wid = tid >> 6, l31 = lane & 31, hi = lane >> 5;
    bf16x8 qf[NKS];
    { const bf16_t* qp = Q + (size_t)(b * SEQ + q0 + wid * 32 + l31) * ldq + qcol + hi * 8;
#pragma unroll
        for (int ks = 0; ks < NKS; ++ks) qf[ks] = *(const bf16x8*)(qp + ks * 16); }
    const bf16_t* kbase = Kp + (size_t)b * LK * ldk + kcol; const bf16_t* vbase = Vp + (size_t)b * LK * ldv + vcol;
    const int kr0 = tid / KCH, kc0 = tid % KCH;
    const int kr1 = (tid + 512) / KCH, kc1 = (tid + 512) % KCH;
    const bool k2 = (KCH * 64 > 512) && (tid + 512 < KCH * 64);
    const int vr = tid >> 3, vc = tid & 7;
    u32x4 sk0, sk1, sv;
#define A_LOAD(t) do { const size_t kp_ = (size_t)(t) * 64; sk0 = *(const u32x4*)(kbase + (kp_ + kr0) * ldk + kc0 * 8); \
        if (k2) sk1 = *(const u32x4*)(kbase + (kp_ + kr1) * ldk + kc1 * 8); sv = *(const u32x4*)(vbase + (kp_ + vr) * ldv + vc * 8); } while (0)
#define A_STORE(buf) do { char* b_ = lds + (buf) * STG; *(u32x4*)(b_ + kr0 * KRS + kc0 * 16) = sk0; if (k2) *(u32x4*)(b_ + kr1 * KRS + kc1 * 16) = sk1; \
        *(u32x4*)(b_ + KB + vr * VRS + vc * 16) = sv; } while (0)
    f32x16 o0, o1;
#pragma unroll
    for (int r = 0; r < 16; ++r) { o0[r] = 0.f; o1[r] = 0.f; }
    float m_run = -1e30f, l_run = 0.f;
    const int g1 = (lane >> 4) & 1, tq = (lane & 15) >> 2, tp = lane & 3;
    const int vt_off = KB + (4 * hi + tq) * VRS + (16 * g1 + 4 * tp) * 2;
    const int kf_off = l31 * KRS + hi * 16;
    constexpr int NT = LK / 64;
    A_LOAD(0); A_STORE(0);
    __syncthreads();
    for (int t = 0; t < NT; ++t) {
        const bool more = (t + 1 < NT);
        if (more) A_LOAD(t + 1);
        const char* b_ = lds + (t & 1) * STG;
        f32x16 p0, p1;
#pragma unroll
        for (int r = 0; r < 16; ++r) { p0[r] = 0.f; p1[r] = 0.f; }
#pragma unroll
        for (int ks = 0; ks < NKS; ++ks) {
            const bf16x8 ka = *(const bf16x8*)(b_ + kf_off + ks * 32);
            const bf16x8 kb = *(const bf16x8*)(b_ + kf_off + 32 * KRS + ks * 32);
            p0 = __builtin_amdgcn_mfma_f32_32x32x16_bf16(ka, qf[ks], p0, 0, 0, 0);
            p1 = __builtin_amdgcn_mfma_f32_32x32x16_bf16(kb, qf[ks], p1, 0, 0, 0);
        }
        float mx = p0[0];
#pragma unroll
        for (int r = 1; r < 16; ++r) mx = fmaxf(mx, p0[r]);
#pragma unroll
        for (int r = 0; r < 16; ++r) mx = fmaxf(mx, p1[r]);
        mx = fmaxf(mx, __shfl_xor(mx, 32));
        const float m_new = fmaxf(m_run, mx);
        const float alpha = __builtin_amdgcn_exp2f(m_run - m_new);
        m_run = m_new;
        float ls = 0.f;
#pragma unroll
        for (int r = 0; r < 16; ++r) { p0[r] = __builtin_amdgcn_exp2f(p0[r] - m_new); p1[r] = __builtin_amdgcn_exp2f(p1[r] - m_new); ls += p0[r] + p1[r]; }
        l_run = l_run * alpha + ls;
#pragma unroll
        for (int r = 0; r < 16; ++r) { o0[r] *= alpha; o1[r] *= alpha; }
        u32x4 pw[4];
        pw[0] = (u32x4){pk2(p0[0], p0[1]), pk2(p0[2], p0[3]), pk2(p0[4], p0[5]), pk2(p0[6], p0[7])};
        pw[1] = (u32x4){pk2(p0[8], p0[9]), pk2(p0[10], p0[11]), pk2(p0[12], p0[13]), pk2(p0[14], p0[15])};
        pw[2] = (u32x4){pk2(p1[0], p1[1]), pk2(p1[2], p1[3]), pk2(p1[4], p1[5]), pk2(p1[6], p1[7])};
        pw[3] = (u32x4){pk2(p1[8], p1[9]), pk2(p1[10], p1[11]), pk2(p1[12], p1[13]), pk2(p1[14], p1[15])};
#pragma unroll
        for (int s = 0; s < 4; ++s) {
            const bf16x8 pb = __builtin_bit_cast(bf16x8, pw[s]);
#pragma unroll
            for (int dt = 0; dt < 2; ++dt) {
                const char* vp = b_ + vt_off + s * 16 * VRS + dt * 64;
                const s16x4 lo = __builtin_bit_cast(s16x4, __builtin_amdgcn_ds_read_tr16_b64_v4i16((LAS s16x4*)vp));
                const s16x4 hh = __builtin_bit_cast(s16x4, __builtin_amdgcn_ds_read_tr16_b64_v4i16((LAS s16x4*)(vp + 8 * VRS)));
                const bf16x8 vf = (bf16x8){lo[0], lo[1], lo[2], lo[3], hh[0], hh[1], hh[2], hh[3]};
                if (dt == 0) o0 = __builtin_amdgcn_mfma_f32_32x32x16_bf16(vf, pb, o0, 0, 0, 0);
                else o1 = __builtin_amdgcn_mfma_f32_32x32x16_bf16(vf, pb, o1, 0, 0, 0);
            }
        }
        if (more) A_STORE((t + 1) & 1);
        __syncthreads();
    }
#undef A_LOAD
#undef A_STORE
    const float lt = l_run + __shfl_xor(l_run, 32); const float inv = 1.0f / lt;
    const size_t tok = (size_t)(b * SEQ + q0 + wid * 32 + l31);
#pragma unroll
    for (int dt = 0; dt < 2; ++dt)
#pragma unroll
        for (int g = 0; g < 4; ++g) { const int d = 32 * dt + 8 * g + 4 * hi; const size_t off = tok * 1024 + ocol + d;
            const u32x2 gw = *(const u32x2*)(Gt + off);
            const f32x16& oo = dt ? o1 : o0;
            u32x2 w; w.x = pk2(oo[4 * g] * inv * lo_bf(gw.x), oo[4 * g + 1] * inv * hi_bf(gw.x)); w.y = pk2(oo[4 * g + 2] * inv * lo_bf(gw.y), oo[4 * g + 3] * inv * hi_bf(gw.y));
            *(u32x2*)(OG + off) = w; }
}

DEV float max3f_s(float a, float b, float c) { float r; asm("v_max3_f32 %0, %1, %2, %3" : "=v"(r) : "v"(a), "v"(b), "v"(c)); return r; }
DEV float max2f_s(float a, float b) { float r; asm("v_max_f32_e32 %0, %1, %2" : "=v"(r) : "v"(a), "v"(b)); return r; }
DEV float fadd_s(float a, float b) { float r; asm("v_add_f32_e32 %0, %1, %2" : "=v"(r) : "v"(a), "v"(b)); return r; }
DEV float swapmax32(float v) { auto rr = __builtin_amdgcn_permlane32_swap(__float_as_uint(v), __float_as_uint(v), false, false); return fmaxf(__uint_as_float(rr[0]), __uint_as_float(rr[1])); }
DEV float swapsum32(float v) { auto rr = __builtin_amdgcn_permlane32_swap(__float_as_uint(v), __float_as_uint(v), false, false); return __uint_as_float(rr[0]) + __uint_as_float(rr[1]); }
template <int DQK>
DEV void attn_unit2(char* lds, const bf16_t* __restrict__ Q, int ldq, int qcol, const bf16_t* __restrict__ Kp, int ldk, int kcol, const bf16_t* __restrict__ Vp, int ldv, int vcol,
                    const bf16_t* __restrict__ Gt, bf16_t* OG, int ocol, int b, int q0) {
    constexpr int KRS = (DQK + 8) * 2, KB = 64 * KRS, VRS = 192, VB = 64 * VRS, NKS = DQK / 16, KCH = DQK / 8, VOFF = 2 * KB;
    constexpr float THR = 8.0f;
    constexpr int NT = LK / 64;
    const int tid = TID(), lane = tid & 63, wid = tid >> 6, l31 = lane & 31, hi = lane >> 5;
    bf16x8 qf[NKS];
    { const bf16_t* qp = Q + (size_t)(b * SEQ + q0 + wid * 32 + l31) * ldq + qcol + hi * 8;
#pragma unroll
        for (int ks = 0; ks < NKS; ++ks) qf[ks] = *(const bf16x8*)(qp + ks * 16); }
    const bf16_t* kbase = Kp + (size_t)b * LK * ldk + kcol; const bf16_t* vbase = Vp + (size_t)b * LK * ldv + vcol;
    constexpr bool K2 = (KCH * 64 > 512);
    const bool k2 = K2 && (tid + 512 < KCH * 64);
    const int kr0 = tid / KCH, kc0 = tid % KCH, kr1 = k2 ? (tid + 512) / KCH : kr0, kc1 = k2 ? (tid + 512) % KCH : kc0;
    const int vr = tid >> 3, vc = tid & 7;
    u32x4 skX0, skX1 = {0u, 0u, 0u, 0u}, svX;
#define A_LOADK(t, S) do { const int tt_ = (t) < NT ? (t) : NT - 1; const size_t kp_ = (size_t)tt_ * 64; sk##S##0 = *(const u32x4*)(kbase + (kp_ + kr0) * ldk + kc0 * 8); if (K2) sk##S##1 = *(const u32x4*)(kbase + (kp_ + kr1) * ldk + kc1 * 8); } while (0)
#define A_LOADV(t, S) do { const int tt_ = (t) < NT ? (t) : NT - 1; sv##S = *(const u32x4*)(vbase + ((size_t)tt_ * 64 + vr) * ldv + vc * 8); } while (0)
#define A_STOREK(slot, S) do { char* b_ = lds + (slot) * KB; *(u32x4*)(b_ + kr0 * KRS + kc0 * 16) = sk##S##0; if (K2) *(u32x4*)(b_ + kr1 * KRS + kc1 * 16) = sk##S##1; } while (0)
#define A_STOREV(slot, S) do { *(u32x4*)(lds + VOFF + (slot) * VB + vr * VRS + vc * 16) = sv##S; } while (0)
    f32x16 o0, o1, negm;
#pragma unroll
    for (int r = 0; r < 16; ++r) { o0[r] = 0.f; o1[r] = 0.f; negm[r] = 0.f; }
    asm volatile("" : "+v"(negm));
    float mhat = 0.f, l_run = 0.f;
    const int g1 = (lane >> 4) & 1, tq = (lane & 15) >> 2, tp = lane & 3;
    const int vt_off = VOFF + (4 * hi + tq) * VRS + (16 * g1 + 4 * tp) * 2;
    const int kf_off = l31 * KRS + hi * 16;
#define A_QK(P0, P1, slot) do { const char* kb_ = lds + (slot) * KB + kf_off; \
        _Pragma("unroll") for (int ks = 0; ks < NKS; ++ks) { \
            const bf16x8 ka = *(const bf16x8*)(kb_ + ks * 32); const bf16x8 kb2 = *(const bf16x8*)(kb_ + 32 * KRS + ks * 32); \
            if (ks == 0) { P0 = __builtin_amdgcn_mfma_f32_32x32x16_bf16(ka, qf[0], negm, 0, 0, 0); P1 = __builtin_amdgcn_mfma_f32_32x32x16_bf16(kb2, qf[0], negm, 0, 0, 0); } \
            else { P0 = __builtin_amdgcn_mfma_f32_32x32x16_bf16(ka, qf[ks], P0, 0, 0, 0); P1 = __builtin_amdgcn_mfma_f32_32x32x16_bf16(kb2, qf[ks], P1, 0, 0, 0); } } } while (0)
    A_LOADK(0, X); A_LOADV(0, X); A_STOREK(0, X); A_STOREV(0, X); A_LOADK(1, X); A_STOREK(1, X);
    __syncthreads();
    f32x16 pA0, pA1, pB0, pB1;
#pragma unroll
    for (int r = 0; r < 16; ++r) { pB0[r] = 0.f; pB1[r] = 0.f; }
    A_QK(pA0, pA1, 0);
#define A_STEP(P0, P1, N0, N1, t, SL, SS) do { \
        A_LOADK((t) + 2, SL); A_LOADV((t) + 1, SL); \
        __builtin_amdgcn_s_setprio(1); A_QK(N0, N1, ((t) + 1) & 1); __builtin_amdgcn_s_setprio(0); \
        float a_ = fmaxf(fmaxf(P0[0], P0[1]), P1[0]), c_ = fmaxf(fmaxf(P0[2], P0[3]), P1[1]); a_ = fmaxf(fmaxf(a_, P1[2]), P1[3]); \
        _Pragma("unroll") for (int r = 4; r < 16; r += 4) { a_ = fmaxf(fmaxf(a_, P0[r]), P0[r + 1]); c_ = fmaxf(fmaxf(c_, P0[r + 2]), P0[r + 3]); a_ = fmaxf(fmaxf(a_, P1[r]), P1[r + 1]); c_ = fmaxf(fmaxf(c_, P1[r + 2]), P1[r + 3]); } \
        const float rm = swapmax32(fmaxf(a_, c_)); \
        if ((t) == 0 || __any(rm > THR)) { \
            const float dl = ((t) == 0) ? rm : fmaxf(rm, 0.f); mhat += dl; \
            _Pragma("unroll") for (int r = 0; r < 16; ++r) { P0[r] -= dl; P1[r] -= dl; N0[r] -= dl; N1[r] -= dl; } \
            if ((t) != 0) { const float f = __builtin_amdgcn_exp2f(-dl); l_run *= f; _Pragma("unroll") for (int r = 0; r < 16; ++r) { o0[r] *= f; o1[r] *= f; } } \
            _Pragma("unroll") for (int r = 0; r < 16; ++r) negm[r] = -mhat; asm volatile("" : "+v"(negm)); } \
        float ls = 0.f; \
        _Pragma("unroll") for (int r = 0; r < 16; ++r) { P0[r] = __builtin_amdgcn_exp2f(P0[r]); P1[r] = __builtin_amdgcn_exp2f(P1[r]); ls += P0[r] + P1[r]; } \
        l_run += ls; \
        u32x4 pw[4]; \
        pw[0] = (u32x4){pk2(P0[0], P0[1]), pk2(P0[2], P0[3]), pk2(P0[4], P0[5]), pk2(P0[6], P0[7])}; \
        pw[1] = (u32x4){pk2(P0[8], P0[9]), pk2(P0[10], P0[11]), pk2(P0[12], P0[13]), pk2(P0[14], P0[15])}; \
        pw[2] = (u32x4){pk2(P1[0], P1[1]), pk2(P1[2], P1[3]), pk2(P1[4], P1[5]), pk2(P1[6], P1[7])}; \
        pw[3] = (u32x4){pk2(P1[8], P1[9]), pk2(P1[10], P1[11]), pk2(P1[12], P1[13]), pk2(P1[14], P1[15])}; \
        { const char* vb_ = lds + ((t) & 1) * VB + vt_off; \
        _Pragma("unroll") for (int s = 0; s < 4; ++s) { const bf16x8 pb = __builtin_bit_cast(bf16x8, pw[s]); \
            _Pragma("unroll") for (int dt = 0; dt < 2; ++dt) { const char* vp = vb_ + s * 16 * VRS + dt * 64; \
                const s16x4 lo = __builtin_bit_cast(s16x4, __builtin_amdgcn_ds_read_tr16_b64_v4i16((LAS s16x4*)vp)); \
                const s16x4 hh = __builtin_bit_cast(s16x4, __builtin_amdgcn_ds_read_tr16_b64_v4i16((LAS s16x4*)(vp + 8 * VRS))); \
                const bf16x8 vf = (bf16x8){lo[0], lo[1], lo[2], lo[3], hh[0], hh[1], hh[2], hh[3]}; \
                if (dt == 0) o0 = __builtin_amdgcn_mfma_f32_32x32x16_bf16(vf, pb, o0, 0, 0, 0); else o1 = __builtin_amdgcn_mfma_f32_32x32x16_bf16(vf, pb, o1, 0, 0, 0); } } } \
        A_STOREK((t) & 1, SS); A_STOREV(((t) + 1) & 1, SS); \
        __syncthreads(); } while (0)
    for (int t = 0; t < NT; t += 2) {
        A_STEP(pA0, pA1, pB0, pB1, t, X, X);
        A_STEP(pB0, pB1, pA0, pA1, t + 1, X, X);
    }
#undef A_STEP
#undef A_QK
#undef A_LOADK
#undef A_LOADV
#undef A_STOREK
#undef A_STOREV
    const float inv = 1.0f / swapsum32(l_run);
    const size_t tok = (size_t)(b * SEQ + q0 + wid * 32 + l31);
#pragma unroll
    for (int dt = 0; dt < 2; ++dt)
#pragma unroll
        for (int g = 0; g < 4; ++g) { const int d = 32 * dt + 8 * g + 4 * hi; const size_t off = tok * 1024 + ocol + d;
            const u32x2 gw = *(const u32x2*)(Gt + off);
            const f32x16& oo = dt ? o1 : o0;
            u32x2 w; w.x = pk2(oo[4 * g] * inv * lo_bf(gw.x), oo[4 * g + 1] * inv * hi_bf(gw.x)); w.y = pk2(oo[4 * g + 2] * inv * lo_bf(gw.y), oo[4 * g + 3] * inv * hi_bf(gw.y));
            *(u32x2*)(OG + off) = w; }
}

DEV void phase_attn(char* lds, const Params& p) {
    const bf16_t* QA = (const bf16_t*)(p.ws + WS_QA); const bf16_t* KA = (const bf16_t*)(p.ws + WS_KA); const bf16_t* VA = (const bf16_t*)(p.ws + WS_VA);
    const bf16_t* QM = (const bf16_t*)(p.ws + WS_QM); const bf16_t* KM = (const bf16_t*)(p.ws + WS2_KM); const bf16_t* VM = (const bf16_t*)(p.ws + WS2_VM);
    const bf16_t* G = (const bf16_t*)(p.ws + WS_G); bf16_t* OG = (bf16_t*)(p.ws + WS2_OG);
    for (int u = blockIdx.x; u < 2048; u += gridDim.x) {
        const int type = u >> 10, rem = u & 1023, b = rem >> 7, h = (rem >> 4) & 7, qb = rem & 15;
        if (type == 0) attn_unit2<64>(lds, QA, 512, h * 64, KA, 128, (h >> 2) * 64, VA, 128, (h >> 2) * 64, G, OG, h * 64, b, qb * 256);
        else attn_unit2<96>(lds, QM, 768, h * 96, KM, 768, h * 96, VM, 512, h * 64, G, OG, 512 + h * 64, b, qb * 256);
    }
}

constexpr int CV_PADL = 192, CV_ROW = 4488, CV_RS = CV_ROW * 2;
constexpr int CV_UB = 8 * CV_RS;
constexpr int CV_FS = 16416;
DEV void conv_load_filter(char* lds, const bf16_t* gr) {
    const int tid = TID();
#pragma unroll
    for (int rnd = 0; rnd < 2; ++rnd) {
        const int ch = tid + rnd * 512;
        const u32x4 a = *(const u32x4*)(gr + ch * 8);
        u32x4 bq = {0u, 0u, 0u, 0u}; if (ch + 1 < 1024) bq = *(const u32x4*)(gr + ch * 8 + 8);
        const unsigned w[8] = {a.x, a.y, a.z, a.w, bq.x, bq.y, bq.z, bq.w};
        char* f = lds + CV_UB + ch * 16;
        *(u32x4*)(f) = a;
        u32x4 c1, c2, c3;
        c1.x = __builtin_amdgcn_alignbit(w[1], w[0], 16); c1.y = __builtin_amdgcn_alignbit(w[2], w[1], 16); c1.z = __builtin_amdgcn_alignbit(w[3], w[2], 16); c1.w = __builtin_amdgcn_alignbit(w[4], w[3], 16);
        c2 = (u32x4){w[1], w[2], w[3], w[4]};
        c3.x = __builtin_amdgcn_alignbit(w[2], w[1], 16); c3.y = __builtin_amdgcn_alignbit(w[3], w[2], 16); c3.z = __builtin_amdgcn_alignbit(w[4], w[3], 16); c3.w = __builtin_amdgcn_alignbit(w[5], w[4], 16);
        *(u32x4*)(f + CV_FS) = c1; *(u32x4*)(f + 2 * CV_FS) = c2; *(u32x4*)(f + 3 * CV_FS) = c3;
    }
}
DEV void sconv4(const bf16_t* px, int t, float w0, float w1, float w2, float bias, float* u) {
    const u32x2 mid = *(const u32x2*)(px + t);
    const float pm = (t > 0) ? bf2f(px[t - 1]) : 0.f, pp = (t + 4 < SEQ) ? bf2f(px[t + 4]) : 0.f;
    const float q0 = lo_bf(mid.x), q1 = hi_bf(mid.x), q2 = lo_bf(mid.y), q3 = hi_bf(mid.y);
    u[0] = w0 * pm + w1 * q0 + w2 * q1 + bias; u[1] = w0 * q0 + w1 * q1 + w2 * q2 + bias; u[2] = w0 * q1 + w1 * q2 + w2 * q3 + bias; u[3] = w0 * q2 + w1 * q3 + w2 * pp + bias;
}
template <bool V0, bool V1>
DEV void conv_step(const char* lds, f32x16 (&acc)[2][2], const int (&a_off)[2], const int (&b_off)[2], int d) {
    bf16x8 fa[2][4];
#pragma unroll
    for (int mt = 0; mt < 2; ++mt)
#pragma unroll
        for (int ks = 0; ks < 4; ++ks) { const char* ap = lds + a_off[mt] - 128 * d + ks * 32;
            const u32x2 lo = *(const u32x2*)ap, hh = *(const u32x2*)(ap + 8);
            fa[mt][ks] = __builtin_bit_cast(bf16x8, (u32x4){lo.x, lo.y, hh.x, hh.y}); }
#pragma unroll
    for (int n = 0; n < 2; ++n) {
        if ((n == 0 && V0) || (n == 1 && V1)) {
#pragma unroll
            for (int ks = 0; ks < 4; ++ks) { const bf16x8 fb = *(const bf16x8*)(lds + b_off[n] - 128 * d + ks * 32);
#pragma unroll
                for (int mt = 0; mt < 2; ++mt) acc[n][mt] = __builtin_amdgcn_mfma_f32_32x32x16_bf16(fa[mt][ks], fb, acc[n][mt], 0, 0, 0); }
        }
    }
}
struct ConvFrags { bf16x8 a[6], b0[4], b1[4]; };
DEV void conv_load_frags(ConvFrags& F, const char* lds, int a_off0, int a_off0h, int b_off0, int b_off1, int d) {
#pragma unroll
    for (int j = 0; j < 6; ++j) { const u32x2 lo = *(const u32x2*)(lds + a_off0 - 128 * d + (j - 2) * 32), hh = *(const u32x2*)(lds + a_off0h - 128 * d + (j - 2) * 32);
        F.a[j] = __builtin_bit_cast(bf16x8, (u32x4){lo.x, lo.y, hh.x, hh.y}); }
#pragma unroll
    for (int ks = 0; ks < 4; ++ks) { F.b0[ks] = *(const bf16x8*)(lds + b_off0 - 128 * d + ks * 32); F.b1[ks] = *(const bf16x8*)(lds + b_off1 - 128 * d + ks * 32); }
}
DEV void conv_mfma_frags(const ConvFrags& F, f32x16 (&acc)[2][2]) {
#pragma unroll
    for (int ks = 0; ks < 4; ++ks) {
        acc[0][0] = __builtin_amdgcn_mfma_f32_32x32x16_bf16(F.a[ks + 2], F.b0[ks], acc[0][0], 0, 0, 0);
        acc[0][1] = __builtin_amdgcn_mfma_f32_32x32x16_bf16(F.a[ks], F.b0[ks], acc[0][1], 0, 0, 0);
        acc[1][0] = __builtin_amdgcn_mfma_f32_32x32x16_bf16(F.a[ks + 2], F.b1[ks], acc[1][0], 0, 0, 0);
        acc[1][1] = __builtin_amdgcn_mfma_f32_32x32x16_bf16(F.a[ks], F.b1[ks], acc[1][1], 0, 0, 0);
    }
}
DEV void conv_mfma_loop(const char* lds, f32x16 (&acc)[2][2], int wid, int lane) {
    const int l31 = lane & 31, hi = lane >> 5;
#pragma unroll
    for (int a = 0; a < 2; ++a)
#pragma unroll
        for (int b = 0; b < 2; ++b)
#pragma unroll
            for (int r = 0; r < 16; ++r) acc[a][b][r] = 0.f;
    int a_off[2];
#pragma unroll
    for (int mt = 0; mt < 2; ++mt) { const int r = l31 + 32 * mt, q = (4 - (r & 3)) & 3; a_off[mt] = CV_UB + q * CV_FS + (4096 - r - q + 8 * hi) * 2; }
    int b_off[2];
#pragma unroll
    for (int n = 0; n < 2; ++n) { const int nt = 2 * wid + n; b_off[n] = (l31 & 7) * CV_RS + (CV_PADL + 64 * (4 * nt + (l31 >> 3)) + 8 * hi) * 2; }
    const int dlo = 8 * wid - 63;
#pragma unroll
    for (int j = 0; j < 4; ++j) conv_step<true, false>(lds, acc, a_off, b_off, dlo + j);
    ConvFrags F0, F1; const int d0 = dlo + 4; int a_hi = a_off[0] + 8; asm volatile("" : "+v"(a_hi));
    conv_load_frags(F0, lds, a_off[0], a_hi, b_off[0], b_off[1], d0);
#pragma unroll 1
    for (int j = 0; j < 31; ++j) { const int d = d0 + 2 * j;
        conv_load_frags(F1, lds, a_off[0], a_hi, b_off[0], b_off[1], d + 1); __builtin_amdgcn_sched_barrier(0);
        conv_mfma_frags(F0, acc); __builtin_amdgcn_sched_barrier(0);
        conv_load_frags(F0, lds, a_off[0], a_hi, b_off[0], b_off[1], d + 2); __builtin_amdgcn_sched_barrier(0);
        conv_mfma_frags(F1, acc); __builtin_amdgcn_sched_barrier(0); }
    conv_mfma_frags(F0, acc);
#pragma unroll
    for (int j = 0; j < 4; ++j) conv_step<false, true>(lds, acc, a_off, b_off, dlo + 67 + j);
}
DEV void conv_unit(char* lds, const Params& p, int c) {
    const int tid = TID(), lane = tid & 63, wid = tid >> 6, l31 = lane & 31, hi = lane >> 5;
    const bf16_t* PT = (const bf16_t*)(p.ws + WS_PT); const bf16_t* GR = (const bf16_t*)(p.ws + WS_GR); const float* ssum = (const float*)(p.ws + WS_SSUM);
    bf16_t* OG2 = (bf16_t*)(p.ws + WS_OG2);
    for (int i = tid; i < 8 * 98; i += 512) { const int b = i / 98, j = i % 98;
        const int e = (j < 48) ? j * 4 : (CV_PADL + SEQ + (j - 48) * 4); *(u32x2*)(lds + b * CV_RS + e * 2) = (u32x2){0u, 0u}; }
    { const float w0 = p.conv_w[c], w1 = p.conv_w[3072 + c], w2 = p.conv_w[6144 + c], bias = p.conv_b[c];
        for (int i = tid; i < 8 * 1024; i += 512) { const int b = i >> 10, t = (i & 1023) * 4; float u[4];
            sconv4(PT + ((size_t)(b * 4096 + c)) * 4096, t, w0, w1, w2, bias, u);
            u32x2 w; w.x = pk2(u[0], u[1]); w.y = pk2(u[2], u[3]); *(u32x2*)(lds + b * CV_RS + (CV_PADL + t) * 2) = w; } }
    conv_load_filter(lds, GR + (size_t)c * 8192);
    __syncthreads();
    f32x16 acc[2][2];
    conv_mfma_loop(lds, acc, wid, lane);
    __syncthreads();
    { const float invs = 1.0f / ssum[c], sk = p.skip[c];
        const float w0 = p.conv_w[1024 + c], w1 = p.conv_w[3072 + 1024 + c], w2 = p.conv_w[6144 + 1024 + c], bias = p.conv_b[1024 + c];
        const int b = l31 & 7;
#pragma unroll
        for (int n = 0; n < 2; ++n) { const int i = 4 * (2 * wid + n) + (l31 >> 3);
#pragma unroll
            for (int mt = 0; mt < 2; ++mt)
#pragma unroll
                for (int g = 0; g < 4; ++g) { const int t = 64 * i + 32 * mt + 8 * g + 4 * hi; float x1[4];
                    sconv4(PT + ((size_t)(b * 4096 + 1024 + c)) * 4096, t, w0, w1, w2, bias, x1);
                    char* up = lds + b * CV_RS + (CV_PADL + t) * 2; const u32x2 vw = *(const u32x2*)up;
                    const float z0 = x1[0] * (acc[n][mt][4 * g] * invs + sk * lo_bf(vw.x)), z1 = x1[1] * (acc[n][mt][4 * g + 1] * invs + sk * hi_bf(vw.x));
                    const float z2 = x1[2] * (acc[n][mt][4 * g + 2] * invs + sk * lo_bf(vw.y)), z3 = x1[3] * (acc[n][mt][4 * g + 3] * invs + sk * hi_bf(vw.y));
                    u32x2 w; w.x = pk2(z0, z1); w.y = pk2(z2, z3); *(u32x2*)up = w; } } }
    conv_load_filter(lds, GR + (size_t)(1024 + c) * 8192);
    __syncthreads();
    conv_mfma_loop(lds, acc, wid, lane);
    { const float invs = 1.0f / ssum[1024 + c], sk = p.skip[1024 + c];
        const float w0 = p.conv_w[2048 + c], w1 = p.conv_w[3072 + 2048 + c], w2 = p.conv_w[6144 + 2048 + c], bias = p.conv_b[2048 + c];
        const int b = l31 & 7;
#pragma unroll
        for (int n = 0; n < 2; ++n) { const int i = 4 * (2 * wid + n) + (l31 >> 3);
#pragma unroll
            for (int mt = 0; mt < 2; ++mt)
#pragma unroll
                for (int g = 0; g < 4; ++g) { const int t = 64 * i + 32 * mt + 8 * g + 4 * hi; float x2[4];
                    sconv4(PT + ((size_t)(b * 4096 + 2048 + c)) * 4096, t, w0, w1, w2, bias, x2);
                    const u32x2 zw = *(const u32x2*)(lds + b * CV_RS + (CV_PADL + t) * 2);
                    const u32x2 gw = *(const u32x2*)(PT + ((size_t)(b * 4096 + 3072 + c)) * 4096 + t);
                    const float y0 = x2[0] * (acc[n][mt][4 * g] * invs + sk * lo_bf(zw.x)) * silu(lo_bf(gw.x)), y1 = x2[1] * (acc[n][mt][4 * g + 1] * invs + sk * hi_bf(zw.x)) * silu(hi_bf(gw.x));
                    const float y2 = x2[2] * (acc[n][mt][4 * g + 2] * invs + sk * lo_bf(zw.y)) * silu(lo_bf(gw.y)), y3 = x2[3] * (acc[n][mt][4 * g + 3] * invs + sk * hi_bf(zw.y)) * silu(hi_bf(gw.y));
                    u32x2 w; w.x = pk2(y0, y1); w.y = pk2(y2, y3); *(u32x2*)(OG2 + ((size_t)(b * 1024 + c)) * 4096 + t) = w; } } }
    __syncthreads();
}

struct Raw3 { u32x2 mid; unsigned halo; };
DEV Raw3 ld_raw3(const bf16_t* px, int t) {
    Raw3 r; r.mid = *(const u32x2*)(px + t);
    const unsigned a = px[t - 1], b = px[t + 4];
    r.halo = (t > 0 ? a : 0u) | ((t + 4 < SEQ ? b : 0u) << 16);
    return r;
}
DEV void sconv_raw(const Raw3& r, float w0, float w1, float w2, float bias, float* u) {
    const float pm = lo_bf(r.halo), pp = hi_bf(r.halo), q0 = lo_bf(r.mid.x), q1 = hi_bf(r.mid.x), q2 = lo_bf(r.mid.y), q3 = hi_bf(r.mid.y);
    u[0] = w0 * pm + w1 * q0 + w2 * q1 + bias; u[1] = w0 * q0 + w1 * q1 + w2 * q2 + bias; u[2] = w0 * q1 + w1 * q2 + w2 * q3 + bias; u[3] = w0 * q2 + w1 * q3 + w2 * pp + bias;
}
struct FiltRegs { u32x4 a[2], b[2]; };
DEV void filt_load(FiltRegs& f, const bf16_t* gr, int tid) {
#pragma unroll
    for (int rnd = 0; rnd < 2; ++rnd) { const int ch = tid + rnd * 512; f.a[rnd] = *(const u32x4*)(gr + ch * 8);
        const int ch1 = ch + 1 < 1024 ? ch + 1 : ch; const u32x4 t = *(const u32x4*)(gr + ch1 * 8); f.b[rnd] = (ch + 1 < 1024) ? t : (u32x4){0u, 0u, 0u, 0u}; }
}
DEV void filt_store(char* lds, const FiltRegs& f, int tid) {
#pragma unroll
    for (int rnd = 0; rnd < 2; ++rnd) { const int ch = tid + rnd * 512; const u32x4 a = f.a[rnd], bq = f.b[rnd];
        const unsigned w[8] = {a.x, a.y, a.z, a.w, bq.x, bq.y, bq.z, bq.w};
        char* fp = lds + CV_UB + ch * 16;
        *(u32x4*)(fp) = a;
        u32x4 c1, c2, c3;
        c1.x = __builtin_amdgcn_alignbit(w[1], w[0], 16); c1.y = __builtin_amdgcn_alignbit(w[2], w[1], 16); c1.z = __builtin_amdgcn_alignbit(w[3], w[2], 16); c1.w = __builtin_amdgcn_alignbit(w[4], w[3], 16);
        c2 = (u32x4){w[1], w[2], w[3], w[4]};
        c3.x = __builtin_amdgcn_alignbit(w[2], w[1], 16); c3.y = __builtin_amdgcn_alignbit(w[3], w[2], 16); c3.z = __builtin_amdgcn_alignbit(w[4], w[3], 16); c3.w = __builtin_amdgcn_alignbit(w[5], w[4], 16);
        *(u32x4*)(fp + CV_FS) = c1; *(u32x4*)(fp + 2 * CV_FS) = c2; *(u32x4*)(fp + 3 * CV_FS) = c3; }
}
#define CV_T(k) (64 * (4 * (2 * wid + ((k) >> 3)) + (l31 >> 3)) + 32 * (((k) >> 2) & 1) + 8 * ((k) & 3) + 4 * hi)
#define CV_LANE_IDS() int tid = TID(); asm volatile("" : "+v"(tid));   \
    const int lane = tid & 63, wid = __builtin_amdgcn_readfirstlane(tid >> 6), l31 = lane & 31, hi = lane >> 5, eb = l31 & 7; (void)eb; (void)hi; (void)wid
DEV void conv_stage_load(char* lds, const Params& p, int c) {
    CV_LANE_IDS();
    const bf16_t* PT = (const bf16_t*)(p.ws + WS_PT); const bf16_t* GR = (const bf16_t*)(p.ws + WS_GR);
    FiltRegs f0; filt_load(f0, GR + (size_t)c * 8192, tid);
    Raw3 ru[16];
#pragma unroll
    for (int k = 0; k < 16; ++k) { const int i = tid + k * 512, b = i >> 10, t = (i & 1023) * 4; ru[k] = ld_raw3(PT + ((size_t)(b * 4096 + c)) * 4096, t); }
    for (int i = tid; i < 8 * 98; i += 512) { const int b = i / 98, j = i % 98;
        const int e = (j < 48) ? j * 4 : (CV_PADL + SEQ + (j - 48) * 4); *(u32x2*)(lds + b * CV_RS + e * 2) = (u32x2){0u, 0u}; }
    const float w0 = p.conv_w[c], w1 = p.conv_w[3072 + c], w2 = p.conv_w[6144 + c], bias = p.conv_b[c];
#pragma unroll
    for (int k = 0; k < 16; ++k) { const int i = tid + k * 512, b = i >> 10, t = (i & 1023) * 4; float u[4]; sconv_raw(ru[k], w0, w1, w2, bias, u);
        u32x2 w; w.x = pk2(u[0], u[1]); w.y = pk2(u[2], u[3]); *(u32x2*)(lds + b * CV_RS + (CV_PADL + t) * 2) = w; }
    filt_store(lds, f0, tid);
}
DEV void conv_stage_epi0(char* lds, const Params& p, int c, const f32x16 (&acc)[2][2]) {
    CV_LANE_IDS();
    const bf16_t* PT = (const bf16_t*)(p.ws + WS_PT); const bf16_t* GR = (const bf16_t*)(p.ws + WS_GR); const float* ssum = (const float*)(p.ws + WS_SSUM);
    FiltRegs f1; filt_load(f1, GR + (size_t)(1024 + c) * 8192, tid);
    const bf16_t* px1 = PT + ((size_t)(eb * 4096 + 1024 + c)) * 4096;
    Raw3 r1[16];
#pragma unroll
    for (int k = 0; k < 16; ++k) r1[k] = ld_raw3(px1, CV_T(k));
    const float a0 = p.conv_w[1024 + c], a1 = p.conv_w[3072 + 1024 + c], a2 = p.conv_w[6144 + 1024 + c], ab = p.conv_b[1024 + c];
    const float invs = 1.0f / ssum[c], sk = p.skip[c];
#pragma unroll
    for (int k = 0; k < 16; ++k) { const int n = k >> 3, mt = (k >> 2) & 1, g = k & 3; const int t = CV_T(k);
        float x1[4]; sconv_raw(r1[k], a0, a1, a2, ab, x1);
        char* up = lds + eb * CV_RS + (CV_PADL + t) * 2; const u32x2 vw = *(const u32x2*)up;
        const float z0 = x1[0] * (acc[n][mt][4 * g] * invs + sk * lo_bf(vw.x)), z1 = x1[1] * (acc[n][mt][4 * g + 1] * invs + sk * hi_bf(vw.x));
        const float z2 = x1[2] * (acc[n][mt][4 * g + 2] * invs + sk * lo_bf(vw.y)), z3 = x1[3] * (acc[n][mt][4 * g + 3] * invs + sk * hi_bf(vw.y));
        u32x2 w; w.x = pk2(z0, z1); w.y = pk2(z2, z3); *(u32x2*)up = w; }
    filt_store(lds, f1, tid);
}
DEV void conv_stage_epi1(char* lds, const Params& p, int c, const f32x16 (&acc)[2][2]) {
    CV_LANE_IDS();
    const bf16_t* PT = (const bf16_t*)(p.ws + WS_PT); const float* ssum = (const float*)(p.ws + WS_SSUM); bf16_t* OG2 = (bf16_t*)(p.ws + WS_OG2);
    const bf16_t* px2 = PT + ((size_t)(eb * 4096 + 2048 + c)) * 4096; const bf16_t* pg = PT + ((size_t)(eb * 4096 + 3072 + c)) * 4096;
    Raw3 r2[16]; u32x2 rg[16];
#pragma unroll
    for (int k = 0; k < 16; ++k) { r2[k] = ld_raw3(px2, CV_T(k)); rg[k] = *(const u32x2*)(pg + CV_T(k)); }
    const float b0 = p.conv_w[2048 + c], b1 = p.conv_w[3072 + 2048 + c], b2 = p.conv_w[6144 + 2048 + c], bb = p.conv_b[2048 + c];
    const float invs = 1.0f / ssum[1024 + c], sk = p.skip[1024 + c];
#pragma unroll
    for (int k = 0; k < 16; ++k) { const int n = k >> 3, mt = (k >> 2) & 1, g = k & 3; const int t = CV_T(k);
        float x2[4]; sconv_raw(r2[k], b0, b1, b2, bb, x2);
        const u32x2 zw = *(const u32x2*)(lds + eb * CV_RS + (CV_PADL + t) * 2);
        const float y0 = x2[0] * silu(lo_bf(rg[k].x)) * (acc[n][mt][4 * g] * invs + sk * lo_bf(zw.x)), y1 = x2[1] * silu(hi_bf(rg[k].x)) * (acc[n][mt][4 * g + 1] * invs + sk * hi_bf(zw.x));
        const float y2 = x2[2] * silu(lo_bf(rg[k].y)) * (acc[n][mt][4 * g + 2] * invs + sk * lo_bf(zw.y)), y3 = x2[3] * silu(hi_bf(rg[k].y)) * (acc[n][mt][4 * g + 3] * invs + sk * hi_bf(zw.y));
        u32x2 w; w.x = pk2(y0, y1); w.y = pk2(y2, y3); *(u32x2*)(OG2 + ((size_t)(eb * 1024 + c)) * 4096 + t) = w; }
}
DEV void conv_stage_mfma(const char* lds, f32x16 (&acc)[2][2]) { CV_LANE_IDS(); conv_mfma_loop(lds, acc, wid, lane); }
DEV void conv_unit2(char* lds, const Params& p, int c) {
    conv_stage_load(lds, p, c);
    __syncthreads();
    f32x16 acc[2][2];
    conv_stage_mfma(lds, acc);
    __syncthreads();
    conv_stage_epi0(lds, p, c, acc);
    __syncthreads();
    conv_stage_mfma(lds, acc);
    conv_stage_epi1(lds, p, c, acc);
    __syncthreads();
}
#undef CV_T
#undef CV_LANE_IDS

struct cf { float x, y; };
DEV cf cadd(cf a, cf b) { return cf{a.x + b.x, a.y + b.y}; }
DEV cf csub(cf a, cf b) { return cf{a.x - b.x, a.y - b.y}; }
DEV cf cmul(cf a, cf b) { return cf{a.x * b.x - a.y * b.y, a.x * b.y + a.y * b.x}; }
template <int M> DEV cf mulw16(cf a) {
    if constexpr (M == 0) return a;
    else if constexpr (M == 4) return cf{a.y, -a.x};
    else if constexpr (M == 2) return cf{(a.x + a.y) * 0.70710678118654752f, (a.y - a.x) * 0.70710678118654752f};
    else if constexpr (M == 6) return cf{(a.y - a.x) * 0.70710678118654752f, -(a.x + a.y) * 0.70710678118654752f};
    else { constexpr float c = (M == 1) ? 0.92387953251128674f : (M == 3) ? 0.38268343236508977f : (M == 5) ? -0.38268343236508977f : -0.92387953251128674f;
           constexpr float sn = (M == 1) ? -0.38268343236508977f : (M == 3) ? -0.92387953251128674f : (M == 5) ? -0.92387953251128674f : -0.38268343236508977f;
           return cf{a.x * c - a.y * sn, a.x * sn + a.y * c}; }
}
template <int HALF, int BLK, int J> DEV void dif_bfly(cf (&v)[16]) { const cf a = v[BLK + J], b = v[BLK + J + HALF]; v[BLK + J] = cadd(a, b); v[BLK + J + HALF] = mulw16<J * (8 / HALF)>(csub(a, b)); }
DEV void dft16(cf (&v)[16]) {
#define B8(j) dif_bfly<8, 0, j>(v)
    B8(0); B8(1); B8(2); B8(3); B8(4); B8(5); B8(6); B8(7);
#undef B8
#define B4(b, j) dif_bfly<4, b, j>(v)
    B4(0, 0); B4(0, 1); B4(0, 2); B4(0, 3); B4(8, 0); B4(8, 1); B4(8, 2); B4(8, 3);
#undef B4
#define B2(b, j) dif_bfly<2, b, j>(v)
    B2(0, 0); B2(0, 1); B2(4, 0); B2(4, 1); B2(8, 0); B2(8, 1); B2(12, 0); B2(12, 1);
#undef B2
#define B1(b) dif_bfly<1, b, 0>(v)
    B1(0); B1(2); B1(4); B1(6); B1(8); B1(10); B1(12); B1(14);
#undef B1
}
#define FFT_BR4(k) ((((k) & 1) << 3) | (((k) & 2) << 1) | (((k) & 4) >> 1) | (((k) & 8) >> 3))
constexpr int FF_BUF = (8192 + 512) * 8;
DEV int ffp(int idx) { return (idx + (idx >> 4)) * 8; }
struct FftTw { cf t3[16]; };
constexpr int FF_T2 = 2 * FF_BUF;
DEV void fft_twiddles(FftTw& T, char* lds, int tid) {
    if (tid < 240) { const int k = tid / 15, r = tid % 15 + 1; float sn, cs; sincospif(-(float)(k * r) * (1.0f / 128.0f), &sn, &cs); *(cf*)(lds + FF_T2 + tid * 8) = cf{cs, sn}; }
    __syncthreads();
    { const int i3 = tid & 255, h = tid >> 8; float sn, cs; sincospif(-(float)i3 * (1.0f / 4096.0f), &sn, &cs); const cf w1 = cf{cs, sn}; const cf w2 = cmul(w1, w1);
        cf t = h ? w1 : cf{1.f, 0.f};
#pragma unroll
        for (int sx = 0; sx < 16; ++sx) { T.t3[sx] = t; t = cmul(t, w2); } }
}
DEV void fft_pass23(char* A, char* B, const char* tw2, int tid, const FftTw& T) {
    asm volatile("" : "+v"(tid));
    cf v[16];
    {
        const int i = tid, k = i & 15;
        { const char* rb = A + ffp(i);
#pragma unroll
        for (int r = 0; r < 16; ++r) v[r] = *(const cf*)(rb + 4352 * r); }
#pragma unroll
        for (int r = 1; r < 16; ++r) v[r] = cmul(v[r], *(const cf*)(tw2 + k * 120 + (r - 1) * 8));
        dft16(v);
        const int j = ((i >> 4) << 8) + k;
        { char* wb = B + (j + 16 * (i >> 4)) * 8;
#pragma unroll
        for (int r = 0; r < 16; ++r) *(cf*)(wb + 136 * r) = v[FFT_BR4(r)]; }
        __syncthreads();
    }
    {
        const int i3 = tid & 255, h = tid >> 8;
        const char* rb3 = B + ffp(i3) + 2176 * h;
#pragma unroll
        for (int sx = 0; sx < 16; ++sx) v[sx] = *(const cf*)(rb3 + 4352 * sx);
#pragma unroll
        for (int sx = 0; sx < 16; ++sx) v[sx] = cmul(v[sx], T.t3[sx]);
        dft16(v);
        if (h) {
            const float c32[16] = {1.f, 0.98078528040323043f, 0.92387953251128674f, 0.83146961230254524f, 0.70710678118654752f, 0.55557023301960218f, 0.38268343236508977f, 0.19509032201612825f,
                                   0.f, -0.19509032201612825f, -0.38268343236508977f, -0.55557023301960218f, -0.70710678118654752f, -0.83146961230254524f, -0.92387953251128674f, -0.98078528040323043f};
            const float s32[16] = {0.f, -0.19509032201612825f, -0.38268343236508977f, -0.55557023301960218f, -0.70710678118654752f, -0.83146961230254524f, -0.92387953251128674f, -0.98078528040323043f,
                                   -1.f, -0.98078528040323043f, -0.92387953251128674f, -0.83146961230254524f, -0.70710678118654752f, -0.55557023301960218f, -0.38268343236508977f, -0.19509032201612825f};
#pragma unroll
            for (int m = 0; m < 16; ++m) { const cf x = v[FFT_BR4(m)]; v[FFT_BR4(m)] = cf{x.x * c32[m] - x.y * s32[m], x.x * s32[m] + x.y * c32[m]}; }
        }
        { char* wb3 = A + ffp(i3) + 34816 * h;
#pragma unroll
        for (int m = 0; m < 16; ++m) *(cf*)(wb3 + 2176 * m) = v[FFT_BR4(m)]; }
        __syncthreads();
    }
}
DEV void fft_pass1_store(char* D, cf (&v)[16], int tid) {
    dft16(v);
    { char* wb = D + 136 * tid;
#pragma unroll
    for (int r = 0; r < 16; ++r) *(cf*)(wb + 8 * r) = v[FFT_BR4(r)]; }
    __syncthreads();
}
constexpr size_t WS_CVIN = WS_H1;
DEV void fftconv_unit(char* lds, const Params& p, int c, const FftTw& T) {
    int tid = TID(); asm volatile("" : "+v"(tid));
    char* D0 = lds; char* D1 = lds + FF_BUF;
    const bf16_t* PT = (const bf16_t*)(p.ws + WS_PT); const bf16_t* GR = (const bf16_t*)(p.ws + WS_GR); const float* ssum = (const float*)(p.ws + WS_SSUM);
    bf16_t* OG2 = (bf16_t*)(p.ws + WS_OG2); float* IN = (float*)(p.ws + WS_CVIN) + (size_t)blockIdx.x * (8 * 4096);
    { const float w0 = p.conv_w[c], w1 = p.conv_w[3072 + c], w2 = p.conv_w[6144 + c], bias = p.conv_b[c];
#pragma unroll 2
        for (int k = 0; k < 8; ++k) { const int i = tid + k * 512, b = i >> 9, n0 = (i & 511) * 8;
            const bf16_t* px = PT + ((size_t)(b * 4096 + c)) * 4096;
            float q[10]; { const u32x4 m = *(const u32x4*)(px + n0); unpack8(m, q + 1); q[0] = (n0 > 0) ? bf2f(px[n0 - 1]) : 0.f; q[9] = (n0 + 8 < SEQ) ? bf2f(px[n0 + 8]) : 0.f; }
            f32x4 o0, o1;
#pragma unroll
            for (int e = 0; e < 4; ++e) { o0[e] = w0 * q[e] + w1 * q[e + 1] + w2 * q[e + 2] + bias; o1[e] = w0 * q[e + 4] + w1 * q[e + 5] + w2 * q[e + 6] + bias; }
            *(f32x4*)(IN + b * 4096 + n0) = o0; *(f32x4*)(IN + b * 4096 + n0 + 4) = o1; } }
    __syncthreads();
#pragma unroll 1
    for (int o = 0; o < 2; ++o) {
        cf KS[16];
        asm volatile("" : "+v"(tid));
        { const bf16_t* g = GR + (size_t)(o * 1024 + c) * 8192; const float invs = 1.0f / ssum[o * 1024 + c];
            cf v[16];
#pragma unroll
            for (int r = 0; r < 16; ++r) { const int n = tid + 512 * r; v[r] = cf{bf2f(g[(12288 - n) & 8191]) * invs, 0.f}; }
            fft_pass1_store(D0, v, tid);
            fft_pass23(D0, D1, lds + FF_T2, tid, T);
#pragma unroll
            for (int q = 0; q < 8; ++q) { const cf a = *(const cf*)(D0 + ffp(tid) + 4352 * q), b = *(const cf*)(D0 + ffp(tid) + 4352 * q + 34816); KS[q] = cadd(a, b); KS[q + 8] = csub(a, b); }
            __syncthreads(); }
        const float sk = p.skip[o * 1024 + c];
        const int part = (o == 0) ? 1024 : 2048;
        const float w0 = p.conv_w[part + c], w1 = p.conv_w[3072 + part + c], w2 = p.conv_w[6144 + part + c], bias = p.conv_b[part + c];
#pragma unroll 1
        for (int pr = 0; pr < 4; ++pr) {
            asm volatile("" : "+v"(tid));
            const float* ina = IN + (2 * pr) * 4096; const float* inb = ina + 4096;
            {
                cf v[16];
#pragma unroll
                for (int r = 0; r < 8; ++r) v[r] = cf{ina[tid + 512 * r], inb[tid + 512 * r]};
#pragma unroll
                for (int r = 8; r < 16; ++r) v[r] = cf{0.f, 0.f};
                fft_pass1_store(D0, v, tid);
                fft_pass23(D0, D1, lds + FF_T2, tid, T);
            }
            {
                cf v[16];
#pragma unroll
                for (int q = 0; q < 8; ++q) { const cf a = *(const cf*)(D0 + ffp(tid) + 4352 * q), b = *(const cf*)(D0 + ffp(tid) + 4352 * q + 34816);
                    const cf x0 = cmul(cadd(a, b), KS[q]), x1 = cmul(csub(a, b), KS[q + 8]);
                    v[q] = cf{x0.x, -x0.y}; v[q + 8] = cf{x1.x, -x1.y}; }
                fft_pass1_store(D1, v, tid);
                fft_pass23(D1, D0, lds + FF_T2, tid, T);
            }
            {
                const int n0 = 8 * tid; float ya[8], yb[8];
#pragma unroll
                for (int e = 0; e < 8; ++e) { const cf a = *(const cf*)(D1 + 64 * tid + 8 * (tid >> 1) + 8 * e), b = *(const cf*)(D1 + 64 * tid + 8 * (tid >> 1) + 8 * e + 34816); ya[e] = (a.x + b.x) * (1.0f / 8192.0f); yb[e] = -(a.y + b.y) * (1.0f / 8192.0f); }
#pragma unroll
                for (int hb = 0; hb < 2; ++hb) { const int b = 2 * pr + hb; float* inp = IN + b * 4096 + n0; const float* yy = hb ? yb : ya;
                    const bf16_t* px = PT + ((size_t)(b * 4096 + part + c)) * 4096;
                    float q[10]; { const u32x4 m = *(const u32x4*)(px + n0); unpack8(m, q + 1); q[0] = (n0 > 0) ? bf2f(px[n0 - 1]) : 0.f; q[9] = (n0 + 8 < SEQ) ? bf2f(px[n0 + 8]) : 0.f; }
                    const f32x4 u0 = *(const f32x4*)inp, u1 = *(const f32x4*)(inp + 4); const float uu[8] = {u0.x, u0.y, u0.z, u0.w, u1.x, u1.y, u1.z, u1.w};
                    float z[8];
#pragma unroll
                    for (int e = 0; e < 8; ++e) { const float xc = w0 * q[e] + w1 * q[e + 1] + w2 * q[e + 2] + bias; z[e] = xc * (yy[e] + sk * uu[e]); }
                    if (o == 0) { *(f32x4*)inp = (f32x4){z[0], z[1], z[2], z[3]}; *(f32x4*)(inp + 4) = (f32x4){z[4], z[5], z[6], z[7]}; }
                    else { float gg[8]; unpack8(*(const u32x4*)(PT + ((size_t)(b * 4096 + 3072 + c)) * 4096 + n0), gg);
#pragma unroll
                        for (int e = 0; e < 8; ++e) z[e] *= silu(gg[e]);
                        *(u32x4*)(OG2 + ((size_t)(b * 1024 + c)) * 4096 + n0) = pack8(z); } }
            }
        }
        __syncthreads();
    }
}

#define XB_TMO      128
#define XB_XCNT(j)  (256  + 64 * (j))
#define XB_XSUB(j)  (1280 + 64 * (j))
#define XB_XGEN(j)  (2304 + 64 * (j))
#define XB_TOP      3328
#define XB_TOPGEN   3392
#define XCD_BAR_WORDS 3456
#define XB_SPIN_CAP (1u << 20)
DEV unsigned xb_ld(unsigned* p) { return __hip_atomic_load(p, __ATOMIC_RELAXED, __HIP_MEMORY_SCOPE_AGENT); }
DEV unsigned xb_add(unsigned* p, unsigned v) { return __hip_atomic_fetch_add(p, v, __ATOMIC_RELAXED, __HIP_MEMORY_SCOPE_AGENT); }
DEV unsigned xb_xcc_id() { return (unsigned)__builtin_amdgcn_s_getreg((3 << 11) | 20) & 0xFu; }
#define XB_SPIN(cond, bar) do { unsigned _sp = 0; while (cond) { __builtin_amdgcn_s_sleep(1); \
    if ((++_sp & 255u) == 0u) { if (xb_ld(&(bar)[XB_TMO])) break; if (_sp > XB_SPIN_CAP) { atomicAdd(&(bar)[XB_TMO], 1u); break; } } } } while (0)
struct XcdBarrier { unsigned* bar; unsigned x; volatile LAS unsigned* st; };
DEV XcdBarrier xcd_barrier_post(unsigned* bar, volatile LAS unsigned* st) {
    XcdBarrier b; b.bar = bar; b.x = xb_xcc_id(); b.st = st;
    if (TID() == 0) (void)xb_add(&bar[XB_XCNT(b.x)], 1u);
    return b;
}
DEV void xcd_barrier_complete(unsigned* bar, unsigned x, unsigned& nloc, unsigned& nx) {
    const unsigned G = gridDim.x * gridDim.y * gridDim.z;
    unsigned sum, cnt, mine, sp = 0u;
    for (;;) {
        sum = 0u; cnt = 0u; mine = 0u;
#pragma unroll
        for (unsigned j = 0; j < 16; ++j) { const unsigned c = xb_ld(&bar[XB_XCNT(j)]); sum += c; cnt += (c > 0u) ? 1u : 0u; mine = (j == x) ? c : mine; }
        if (sum == G) break;
        __builtin_amdgcn_s_sleep(1);
        if ((++sp & 255u) == 0u) { if (xb_ld(&bar[XB_TMO])) break; if (sp > XB_SPIN_CAP) { atomicAdd(&bar[XB_TMO], 1u); break; } }
    }
    nloc = mine > 0u ? mine : 1u; nx = cnt > 0u ? cnt : 1u;
}
DEV void xcd_barrier(const XcdBarrier& b) {
    asm volatile("s_waitcnt vmcnt(0)" ::: "memory");
    __syncthreads();
    if (TID() == 0) {
        unsigned* bar = b.bar;
        __builtin_amdgcn_s_waitcnt(0);
        unsigned nloc = b.st[0], nx = b.st[1];
        if (nloc == 0u) { xcd_barrier_complete(bar, b.x, nloc, nx); b.st[0] = nloc; b.st[1] = nx; }
        const unsigned old = xb_add(&bar[XB_XSUB(b.x)], 1u);
        const unsigned gen = old / nloc;
        if (old + 1u == (gen + 1u) * nloc) {
            __builtin_amdgcn_fence(__ATOMIC_RELEASE, "agent");
            asm volatile("s_waitcnt vmcnt(0)" ::: "memory");
            const unsigned og = xb_add(&bar[XB_TOP], 1u);
            const unsigned tg = og / nx;
            if (og + 1u == (tg + 1u) * nx) xb_add(&bar[XB_TOPGEN], 1u);
            else XB_SPIN(xb_ld(&bar[XB_TOPGEN]) == tg, bar);
            __builtin_amdgcn_fence(__ATOMIC_ACQUIRE, "agent");
            xb_add(&bar[XB_XGEN(b.x)], 1u);
            asm volatile("s_waitcnt vmcnt(0)" ::: "memory");
        } else {
            XB_SPIN(xb_ld(&bar[XB_XGEN(b.x)]) == gen, bar);
            __builtin_amdgcn_fence(__ATOMIC_ACQUIRE, "agent");
            asm volatile("s_waitcnt vmcnt(0)" ::: "memory");
        }
    }
    __syncthreads();
}

constexpr int NPHASE = 12;
__global__ void __launch_bounds__(512) fwd_kernel(Params p) {
    char* lds = lds_dyn;
    char* ws = p.ws;
    volatile LAS unsigned* bst = (volatile LAS unsigned*)(LAS char*)(lds + LDS_BYTES - 64);
    { const int t0 = threadIdx.x;
        if (t0 < 16) bst[t0] = 0u;
        if ((t0 & 63) == 0) *(volatile LAS int*)(LAS char*)(lds + LDS_WTAB + 4 * hw_slot()) = t0 >> 6; }
    __syncthreads();
    if (MK_LAUNCHES == 1) (void)xcd_barrier_post((unsigned*)(ws + WS_CTL), bst);
    if (MK_LAUNCHES == 1 && p.ph_hi > NPHASE) cg::this_grid().sync();
#define SEAM(k) do { if (MK_LAUNCHES == 1 && (k) + 1 < p.ph_hi) { XcdBarrier xb_; xb_.bar = (unsigned*)(p.ws + WS_CTL); xb_.x = xb_xcc_id(); xb_.st = (volatile LAS unsigned*)(LAS char*)(lds + LDS_BYTES - 64); xcd_barrier(xb_); } } while (0)
#ifndef PHASE_MASK
#define PHASE_MASK 0xFFF
#endif
#define IN(k) (((PHASE_MASK >> (k)) & 1) && p.ph_lo <= (k) && (k) < p.ph_hi)
#define REP(k) for (int rep_ = 0; rep_ < ((PROBE_REPEAT == (k)) ? 2 : 1); ++rep_)
    if (IN(0)) { REP(0) phase_prep(lds, p); SEAM(0); }
    if (IN(1)) {
        for (int rep_ = 0; rep_ < ((PROBE_REPEAT == 21) ? 2 : 1); ++rep_) {
        const bool dummy = (PROBE_REPEAT == 21 && rep_ == 0);
        EpiFilt ef{(bf16_t*)(ws + (dummy ? WS_PRAW : WS_GR)), p.f_b3};
        gemm_phase<false, EpiFilt>(lds, (const bf16_t*)(ws + WS_W3), 64, (const bf16_t*)(ws + WS_HID2), 64, 4096, 4096, 64, ef); }
        REP(1) phase_norm0(p); SEAM(1); }
    if (IN(2)) {
        REP(2) { pg8::Gemm g{(const bf16_t*)(ws + WS_H0), (const bf16_t*)(ws + WS_WIN), NALL, AINP, DM}; pg8::StaticOrder S; S.init(NALL, AINP, (int)gridDim.x, (int)blockIdx.x);
            pg8::EpiBf16 E{(bf16_t*)(ws + WS_PRAW), (size_t)AINP, 0, 0};
            pg8::gemm_phase<pg8::EpiBf16, pg8::StaticOrder, true, true>((PG8_LAS unsigned char*)lds, g, S, E); }
        SEAM(2); }
    if (IN(3)) { filt_sums(p); REP(3) phase_post(p); SEAM(3); }
    if (IN(4)) {
        const float* rp = (const float*)(ws + WS_ROPE);
        REP(4) {
        { pg8::Gemm g{(const bf16_t*)(ws + WS_CQN), (const bf16_t*)(ws + WS_WUQ), NTOK, 768, 256}; pg8::StaticOrder S; S.init(NTOK, 768, (int)gridDim.x, (int)blockIdx.x);
            pg8::EpiUqPg E{(bf16_t*)(ws + WS_QM), rp + 2048, rp + 2560, QSC_M};
            pg8::gemm_phase<pg8::EpiUqPg, pg8::StaticOrder, true, true>((PG8_LAS unsigned char*)lds, g, S, E); }
        int opq_ = 0; asm volatile("" : "+s"(opq_));
        if (opq_ == 0) { pg8::Gemm g{(const bf16_t*)(ws + WS_CKVN), (const bf16_t*)(ws + WS_WUKV), NALL, 1024, 128}; pg8::StaticOrder S; S.init(NALL, 1024, (int)gridDim.x, (int)blockIdx.x);
            pg8::EpiUkvPg E{(bf16_t*)(ws + WS2_KM), (bf16_t*)(ws + WS2_VM)};
            pg8::gemm_phase<pg8::EpiUkvPg, pg8::StaticOrder, true, true>((PG8_LAS unsigned char*)lds, g, S, E); } }
        SEAM(4); }
    if (IN(5)) { REP(5) phase_attn(lds, p); SEAM(5); }
    if (IN(6)) {
        REP(6) { pg8::Gemm g{(const bf16_t*)(ws + WS2_OG), (const bf16_t*)(ws + WS_WOUT), NTOK, DM, DM}; pg8::StaticOrder S; S.init(NTOK, DM, (int)gridDim.x, (int)blockIdx.x);
            pg8::EpiResF32 E{p.x, p.out, (const float*)(ws + WS_MOD0), (DBG_SKIP & 1) ? 0.f : 1.f};
            pg8::gemm_phase<pg8::EpiResF32, pg8::StaticOrder, true, true>((PG8_LAS unsigned char*)lds, g, S, E); }
        SEAM(6); }
    if (IN(7)) { REP(7) phase_norm1(p); SEAM(7); }
    if (IN(8)) {
        REP(8) { pg8::Gemm g{(const bf16_t*)(ws + WS_HWIN), (const bf16_t*)(ws + WS_H1), 4096, NTOK, DM}; pg8::StaticOrder S; S.init(4096, NTOK, (int)gridDim.x, (int)blockIdx.x);
            pg8::EpiBf16 E{(bf16_t*)(ws + WS_PT), (size_t)4096, 4096, (size_t)4096 * 4096};
            pg8::gemm_phase<pg8::EpiBf16, pg8::StaticOrder, true, true>((PG8_LAS unsigned char*)lds, g, S, E); }
        SEAM(8); }
    if (IN(9)) { FftTw T; fft_twiddles(T, lds, TID()); REP(9) for (int c = blockIdx.x; c < 1024; c += gridDim.x) fftconv_unit(lds, p, c, T); SEAM(9); }
    if (IN(10)) {
        REP(10) {
        EpiRes e{p.out, (PROBE_REPEAT == 10 && rep_ == 0) ? (float*)(ws + WS_PT) : p.out, (const float*)(ws + WS_MOD1), (DBG_SKIP & 2) ? 0.f : 1.f};
        const bf16_t* OG2 = (const bf16_t*)(ws + WS_OG2); const bf16_t* W = (const bf16_t*)(ws + WS_HWOUT);
        const int nt = (NTOK / 256) * (DM / 128);
        for (int t = blockIdx.x; t < nt; t += gridDim.x) { const int ti = t / 8, tj = t % 8; const int b = ti >> 4, l0 = (ti & 15) * 256;
            gemm_tile<true, EpiRes>(lds, OG2 + (size_t)b * 1024 * 4096 + l0, 4096, W + (size_t)tj * 128 * DM, DM, DM, e, ti * 256, tj * 128); }
        }
        SEAM(10); }
    if (IN(11)) { phase_final(p); }
#undef SEAM
#undef IN
}

extern "C" void kernel_launch(void* const* d_in, const int* in_sizes, int n_in, void* d_out, int out_size, void* d_ws, size_t ws_size, hipStream_t stream) {
    static int grid = 0;
    if (grid == 0) {
        if (n_in != 28 || out_size != NTOK * DM || ws_size < WS_END) { fprintf(stderr, "kernel_launch: unexpected shapes n_in %d out %d ws %zu\n", n_in, out_size, ws_size); grid = -1; return; }
        int dev = 0, cus = 0, per_cu = 0;
        hipGetDevice(&dev); hipDeviceGetAttribute(&cus, hipDeviceAttributeMultiprocessorCount, dev);
        if (hipFuncSetAttribute((const void*)fwd_kernel, hipFuncAttributeMaxDynamicSharedMemorySize, LDS_BYTES) != hipSuccess) { fprintf(stderr, "hipFuncSetAttribute failed\n"); grid = -1; return; }
        hipOccupancyMaxActiveBlocksPerMultiprocessor(&per_cu, (const void*)fwd_kernel, 512, LDS_BYTES);
        if (per_cu < 1) { fprintf(stderr, "occupancy query says %d\n", per_cu); per_cu = 1; }
        grid = cus * 1;
        (void)hipGetLastError();
    }
    if (grid < 0) return;
    Params p{};
    const float** pp = (const float**)&p;
    for (int i = 0; i < 28; ++i) pp[i] = (const float*)d_in[i];
    p.out = (float*)d_out; p.ws = (char*)d_ws;
#if MK_LAUNCHES == 1
    if (hipMemsetAsync((char*)d_ws + WS_CTL, 0, CTL_BYTES, stream) != hipSuccess) { fprintf(stderr, "memset failed\n"); return; }
    p.ph_lo = 0; p.ph_hi = NPHASE;
    void* args[] = {&p};
    hipError_t e = hipLaunchCooperativeKernel((const void*)fwd_kernel, dim3(grid), dim3(512), args, LDS_BYTES, stream);
    if (e != hipSuccess) fprintf(stderr, "cooperative launch failed: %s (grid %d)\n", hipGetErrorString(e), grid);
#else
    for (int k = 0; k < NPHASE; ++k) { p.ph_lo = k; p.ph_hi = k + 1; hipLaunchKernelGGL(fwd_kernel, dim3(grid), dim3(512), LDS_BYTES, stream, p); }
#endif
}
```

```cpp
#include <hip/hip_runtime.h>
#include <hip/hip_cooperative_groups.h>
#include <cstdio>
#include <cstdint>
namespace cg = cooperative_groups;

#ifndef MK_LAUNCHES
#define MK_LAUNCHES 1
#endif

#ifndef PROBE_REPEAT
#define PROBE_REPEAT -1
#endif
#ifndef DBG_SKIP
#define DBG_SKIP 0
#endif
#define DEV __device__ __forceinline__
typedef unsigned short bf16_t;
typedef short bf16x8 __attribute__((ext_vector_type(8)));
typedef short s16x4 __attribute__((ext_vector_type(4)));
typedef float f32x16 __attribute__((ext_vector_type(16)));
typedef float f32x4 __attribute__((ext_vector_type(4)));
typedef float f32x2 __attribute__((ext_vector_type(2)));
typedef unsigned u32x4 __attribute__((ext_vector_type(4)));
typedef unsigned u32x2 __attribute__((ext_vector_type(2)));
typedef __bf16 bf16x2_t __attribute__((ext_vector_type(2)));
#define LAS __attribute__((address_space(3)))

constexpr int NB = 8, SEQ = 4096, DM = 1024, CTXL = 256, LK = SEQ + CTXL;
constexpr int NTOK = NB * SEQ, NCTX = NB * CTXL, NALL = NTOK + NCTX;
constexpr int AIN = 2208, AINP = 2304;
constexpr float EPS = 1e-6f;
constexpr float LOG2E = 1.4426950408889634f;
constexpr float QSC_A = 0.125f * LOG2E;
constexpr float QSC_M = 0.10206207261596575f * LOG2E;

constexpr size_t MiB = 1ull << 20;
constexpr size_t WS_WIN = 0;
constexpr size_t WS_WUQ = 5 * MiB;
constexpr size_t WS_WUKV = 6 * MiB;
constexpr size_t WS_WOUT = 7 * MiB;
constexpr size_t WS_HWIN = 9 * MiB;
constexpr size_t WS_HWOUT = 17 * MiB;
constexpr size_t WS_W3 = 19 * MiB;
constexpr size_t WS_HID2 = 20 * MiB;
constexpr size_t WS_MOD0 = 21 * MiB;
constexpr size_t WS_MOD1 = WS_MOD0 + 9 * 3072 * 4;
constexpr size_t WS_SSUM = WS_MOD1 + 8 * 3072 * 4;
constexpr size_t WS_ROPE = WS_SSUM + 2048 * 4;
constexpr size_t WS_GR = 22 * MiB;
constexpr size_t WS_H0 = 64 * MiB;
constexpr size_t WS_PRAW = 136 * MiB;
constexpr size_t WS_QA = 297 * MiB;
constexpr size_t WS_KA = 329 * MiB;
constexpr size_t WS_VA = 338 * MiB;
constexpr size_t WS_CQN = 347 * MiB;
constexpr size_t WS_CKVN = 363 * MiB;
constexpr size_t WS_G = 372 * MiB;
constexpr size_t WS_QM = 64 * MiB;
constexpr size_t WS_KM = 136 * MiB;
constexpr size_t WS_VM = 190 * MiB;
constexpr size_t WS_OG = 226 * MiB;
constexpr size_t WS_H1 = 436 * MiB;
constexpr size_t WS_PT = 64 * MiB;
constexpr size_t WS_OG2 = 320 * MiB;
constexpr size_t WS_CTL = 500 * MiB;
constexpr size_t CTL_BYTES = 16384;
constexpr size_t WS_END = 500 * MiB + CTL_BYTES;
constexpr size_t WS2_KM = 436 * MiB;
constexpr size_t WS2_VM = 190 * MiB;
constexpr size_t WS2_OG = 226 * MiB;

constexpr int LDS_BYTES = 150 * 1024;

extern __shared__ __attribute__((aligned(16))) char lds_dyn[];
constexpr int LDS_WTAB = LDS_BYTES - 64 - 256;
__device__ __forceinline__ int lane_id() { int r; asm volatile("v_mbcnt_lo_u32_b32 %0, -1, 0\n\tv_mbcnt_hi_u32_b32 %0, -1, %0" : "=v"(r)); return r; }
__device__ __forceinline__ int hw_slot() { return (int)(__builtin_amdgcn_s_getreg((5 << 11) | 4) & 63u); }
__device__ __forceinline__ int wave_idx() { return __builtin_amdgcn_readfirstlane(*(volatile __attribute__((address_space(3))) int*)(__attribute__((address_space(3))) char*)(lds_dyn + LDS_WTAB + 4 * hw_slot())); }
#define TID() (wave_idx() * 64 + lane_id())

DEV float bf2f(bf16_t v) { return __uint_as_float(((unsigned)v) << 16); }
DEV unsigned pk2(float lo, float hi) { f32x2 v = {lo, hi}; bf16x2_t b = __builtin_convertvector(v, bf16x2_t); return __builtin_bit_cast(unsigned, b); }
DEV bf16_t f2bf(float f) { return (bf16_t)(pk2(f, 0.f) & 0xffffu); }
DEV float lo_bf(unsigned w) { return __uint_as_float(w << 16); }
DEV float hi_bf(unsigned w) { return __uint_as_float(w & 0xffff0000u); }
DEV int crow(int r, int hi) { return (r & 3) + 8 * (r >> 2) + 4 * hi; }
DEV float silu(float v) { return v * __builtin_amdgcn_rcpf(1.f + __expf(-v)); }
DEV void unpack8(const u32x4 w, float* v) { v[0] = lo_bf(w.x); v[1] = hi_bf(w.x); v[2] = lo_bf(w.y); v[3] = hi_bf(w.y); v[4] = lo_bf(w.z); v[5] = hi_bf(w.z); v[6] = lo_bf(w.w); v[7] = hi_bf(w.w); }
DEV u32x4 pack8(const float* v) { u32x4 w; w.x = pk2(v[0], v[1]); w.y = pk2(v[2], v[3]); w.z = pk2(v[4], v[5]); w.w = pk2(v[6], v[7]); return w; }

DEV float wave_sum(float v) {
#pragma unroll
    for (int o = 1; o < 64; o <<= 1) v += __shfl_xor(v, o);
    return v;
}
struct Params {
    const float *x, *c, *ctx, *c_ctx, *ada_w, *ada_b, *norm_w, *w_in, *q_norm, *k_norm, *cq_norm, *ckv_norm, *w_uq, *w_ukv, *w_out,
        *hy_w_in, *conv_w, *conv_b, *f_w1, *f_b1, *f_w2, *f_b2, *f_w3, *f_b3, *freq, *skip, *hy_w_out, *final_w;
    float* out; char* ws; int ph_lo, ph_hi;
};

constexpr int G_RS = 144;
constexpr int G_RB = 256 * G_RS, G_CB = 128 * G_RS, G_STAGE = G_RB + G_CB;
constexpr int T_RS = 576;

template <bool TR, class Epi>
DEV void gemm_tile(char* lds, const bf16_t* __restrict__ R, size_t ldr, const bf16_t* __restrict__ C, size_t ldc, int K, const Epi& epi, int ti0, int tj0) {
    const int tid = TID(), lane = tid & 63, wid = tid >> 6;
    const int wi = wid >> 1, wj = wid & 1, l31 = lane & 31, hi = lane >> 5;
    f32x16 acc[2][2];
#pragma unroll
    for (int a = 0; a < 2; ++a)
#pragma unroll
        for (int b = 0; b < 2; ++b)
#pragma unroll
            for (int r = 0; r < 16; ++r) acc[a][b][r] = 0.f;
    u32x4 rrX[4], rcX[2], rrY[4], rcY[2];
    const bf16_t* Rp; const bf16_t* Cp; int rl_off, cl_off;
    if (TR) { const int c = tid & 31, kr = tid >> 5; Rp = R + (size_t)kr * ldr + c * 8; rl_off = kr * T_RS + c * 16; }
    else { const int lr = tid >> 3, lc = tid & 7; Rp = R + (size_t)lr * ldr + lc * 8; rl_off = lr * G_RS + lc * 16; }
    { const int lr = tid >> 3, lc = tid & 7; Cp = C + (size_t)lr * ldc + lc * 8; cl_off = lr * G_RS + lc * 16; }
    const int nk = K / 64;
    int ra_off[2], cb_off[2];
#pragma unroll
    for (int t = 0; t < 2; ++t) {
        if (TR) { const int g1 = (lane >> 4) & 1, q = (lane & 15) >> 2, p = lane & 3; ra_off[t] = (8 * hi + q) * T_RS + (wi * 64 + t * 32 + 16 * g1 + 4 * p) * 2; }
        else ra_off[t] = (wi * 64 + t * 32 + l31) * G_RS + hi * 16;
        cb_off[t] = G_RB + (wj * 64 + t * 32 + l31) * G_RS + hi * 16;
    }
#define G_LOAD(kt, S) do { const int kk_ = (kt) < nk ? (kt) : nk - 1; \
        if (TR) { _Pragma("unroll") for (int p = 0; p < 4; ++p) rr##S[p] = *(const u32x4*)(Rp + ((size_t)kk_ * 64 + 16 * p) * ldr); } \
        else { _Pragma("unroll") for (int p = 0; p < 4; ++p) rr##S[p] = *(const u32x4*)(Rp + (size_t)(64 * p) * ldr + kk_ * 64); } \
        _Pragma("unroll") for (int p = 0; p < 2; ++p) rc##S[p] = *(const u32x4*)(Cp + (size_t)(64 * p) * ldc + kk_ * 64); } while (0)
#define G_STORE(buf, S) do { char* b_ = lds + (buf) * G_STAGE; \
        if (TR) { _Pragma("unroll") for (int p = 0; p < 4; ++p) *(u32x4*)(b_ + rl_off + 16 * p * T_RS) = rr##S[p]; } \
        else { _Pragma("unroll") for (int p = 0; p < 4; ++p) *(u32x4*)(b_ + rl_off + 64 * p * G_RS) = rr##S[p]; } \
        _Pragma("unroll") for (int p = 0; p < 2; ++p) *(u32x4*)(b_ + G_RB + cl_off + 64 * p * G_RS) = rc##S[p]; } while (0)
#define G_COMPUTE(buf) do { const char* b_ = lds + (buf) * G_STAGE; \
        _Pragma("unroll") for (int ks = 0; ks < 4; ++ks) { bf16x8 fa[2], fb[2]; \
            _Pragma("unroll") for (int t = 0; t < 2; ++t) { \
                if (TR) { \
                    const s16x4 lo = __builtin_bit_cast(s16x4, __builtin_amdgcn_ds_read_tr16_b64_v4i16((LAS s16x4*)(b_ + ra_off[t] + ks * 16 * T_RS))); \
                    const s16x4 hh = __builtin_bit_cast(s16x4, __builtin_amdgcn_ds_read_tr16_b64_v4i16((LAS s16x4*)(b_ + ra_off[t] + (ks * 16 + 4) * T_RS))); \
                    fa[t] = (bf16x8){lo[0], lo[1], lo[2], lo[3], hh[0], hh[1], hh[2], hh[3]}; \
                } else fa[t] = *(const bf16x8*)(b_ + ra_off[t] + ks * 32); \
                fb[t] = *(const bf16x8*)(b_ + cb_off[t] + ks * 32); } \
            _Pragma("unroll") for (int a = 0; a < 2; ++a) _Pragma("unroll") for (int b = 0; b < 2; ++b) acc[a][b] = __builtin_amdgcn_mfma_f32_32x32x16_bf16(fa[a], fb[b], acc[a][b], 0, 0, 0); } } while (0)
    G_LOAD(0, X); G_LOAD(1, Y); G_STORE(0, X);
    __syncthreads();
    for (int kt = 0; kt < nk; kt += 2) {
        G_LOAD(kt + 2, X);
        G_COMPUTE(0);
        G_STORE(1, Y);
        __syncthreads();
        if (kt + 1 >= nk) break;
        G_LOAD(kt + 3, Y);
        G_COMPUTE(1);
        G_STORE(0, X);
        __syncthreads();
    }
#undef G_LOAD
#undef G_STORE
#undef G_COMPUTE
#pragma unroll
    for (int a = 0; a < 2; ++a)
#pragma unroll
        for (int b = 0; b < 2; ++b) epi(ti0 + wi * 64 + a * 32, tj0 + wj * 64 + b * 32, acc[a][b], l31, hi);
}

template <bool TR, class Epi>
DEV void gemm_phase(char* lds, const bf16_t* R, size_t ldr, const bf16_t* C, size_t ldc, int nI, int nJ, int K, const Epi& epi) {
    const int tI = nI / 256, tJ = nJ / 128, nt = tI * tJ;
    for (int t = blockIdx.x; t < nt; t += gridDim.x) {
        const int ti = t / tJ, tj = t % tJ;
        gemm_tile<TR, Epi>(lds, R + (size_t)ti * 256 * ldr, ldr, C + (size_t)tj * 128 * ldc, ldc, K, epi, ti * 256, tj * 128);
    }
}

struct EpiRaw {
    bf16_t* O; size_t ld;
    DEV void operator()(int i0, int j0, const f32x16& a, int l31, int hi) const {
#pragma unroll
        for (int r = 0; r < 16; ++r) O[(size_t)(i0 + crow(r, hi)) * ld + j0 + l31] = f2bf(a[r]);
    }
};
struct EpiUq {
    bf16_t* QM; const float* cos32; const float* sin32;
    DEV void operator()(int i0, int j0, const f32x16& a, int l31, int hi) const {
        const bool pe = (j0 % 96) == 64;
        const int fi = l31 & 7; const bool colang = (l31 & 16) != 0; const bool bpart = (l31 & 8) != 0;
#pragma unroll
        for (int r = 0; r < 16; ++r) {
            const int tok = i0 + crow(r, hi); float v = a[r];
            const float o = __shfl_xor(v, 8);
            if (pe) { const int l = tok & (SEQ - 1); const int pos = colang ? (l & 63) : (l >> 6);
                const float cs = cos32[pos * 8 + fi], sn = sin32[pos * 8 + fi];
                v = bpart ? (v * cs + o * sn) : (v * cs - o * sn); }
            QM[(size_t)tok * 768 + j0 + l31] = f2bf(v * QSC_M);
        }
    }
};
struct EpiUkv {
    bf16_t* KM; bf16_t* VM;
    DEV void operator()(int i0, int j0, const f32x16& a, int l31, int hi) const {
        const int h = j0 >> 7, e = (j0 & 127) + l31;
#pragma unroll
        for (int r = 0; r < 16; ++r) { const size_t row = (size_t)(i0 + crow(r, hi));
            if (e < 64) KM[row * 768 + h * 96 + e] = f2bf(a[r]); else VM[row * 512 + h * 64 + (e - 64)] = f2bf(a[r]); }
    }
};
struct EpiRes {
    const float* base; float* out; const float* mod; float gmul;
    DEV void operator()(int i0, int j0, const f32x16& a, int l31, int hi) const {
        const int b = i0 >> 12; const float g = mod[b * 3072 + 2048 + j0 + l31] * gmul;
#pragma unroll
        for (int h8 = 0; h8 < 2; ++h8) { float bv[8];
#pragma unroll
            for (int r = 0; r < 8; ++r) bv[r] = base[(size_t)(i0 + crow(8 * h8 + r, hi)) * DM + j0 + l31];
#pragma unroll
            for (int r = 0; r < 8; ++r) out[(size_t)(i0 + crow(8 * h8 + r, hi)) * DM + j0 + l31] = bv[r] + g * a[8 * h8 + r]; }
    }
};
struct EpiPT {
    bf16_t* PT;
    DEV void operator()(int i0, int j0, const f32x16& a, int l31, int hi) const {
        const int b = j0 >> 12, l = (j0 & 4095) + l31;
#pragma unroll
        for (int r = 0; r < 16; ++r) PT[((size_t)(b * 4096 + i0 + crow(r, hi))) * 4096 + l] = f2bf(a[r]);
    }
};
struct EpiFilt {
    bf16_t* GR; const float* b3;
    DEV void operator()(int i0, int j0, const f32x16& a, int l31, int hi) const {
        const int t = j0 + l31; const float tn = (float)t * (1.0f / 4095.0f);
        const float dmin = -3.0701134573253945f, dmax = -15.350567286626973f;
#pragma unroll
        for (int r = 0; r < 16; ++r) {
            const int n = i0 + crow(r, hi); const int c = n & 1023, od = n >> 10, o = od >> 1, dir = od & 1;
            const float delta = fabsf(dmin + (float)c * ((dmax - dmin) / 1023.0f));
            const float v = (a[r] + b3[n]) * __expf(-tn * delta);
            bf16_t* g = GR + ((size_t)(o * 1024 + c)) * 8192;
            if (dir == 0) g[4096 - t] = f2bf(v);
            else { if (t == 0) g[0] = 0; else g[4096 + t] = f2bf(v); }
        }
    }
};
DEV void filt_sums(const Params& p) {
    const int wid = TID() >> 6, lane = TID() & 63; bf16_t* GR = (bf16_t*)(p.ws + WS_GR); float* ssum = (float*)(p.ws + WS_SSUM);
    for (int row = blockIdx.x * 8 + wid; row < 2048; row += gridDim.x * 8) {
        bf16_t* g = GR + (size_t)row * 8192; float s = 0.f;
        u32x4 w[16];
#pragma unroll
        for (int j = 0; j < 16; ++j) w[j] = *(const u32x4*)(g + (j * 64 + lane) * 8);
#pragma unroll
        for (int j = 0; j < 16; ++j) { float v[8]; unpack8(w[j], v);
            if (j == 0 && lane == 0) v[0] = 0.f;
#pragma unroll
            for (int e = 0; e < 8; ++e) s += fabsf(v[e]); }
        s = wave_sum(s);
        if (lane == 0) ssum[row] = s;
    }
}

namespace pg8 {
#define PG8_LAS __attribute__((address_space(3)))
typedef short bf16x8 __attribute__((ext_vector_type(8)));
typedef float f32x4 __attribute__((ext_vector_type(4)));
typedef unsigned u32x4 __attribute__((ext_vector_type(4)));
constexpr int BM = 256, BK = 64, HALF = 128, HTB = HALF * BK * 2  , STAGE_BYTES = 8 * HTB, NXCD = 8, WGM = 8;

__host__ __device__ __forceinline__ int lds_byte(int r, int c) { const int st = (r >> 4) * 2 + (c >> 5), rr = r & 15, cc = c & 31, ob = rr * 64 + cc * 2; return st * 1024 + (ob ^ (((ob >> 9) & 1) << 5)); }
__host__ __device__ __forceinline__ void stage_rc(int b, int& R, int& C) { const int st = b / 1024, sb = b % 1024, swz = sb ^ (((sb >> 9) & 1) << 5); R = (st >> 1) * 16 + swz / 64; C = (st & 1) * 32 + (swz % 64) / 2; }
__host__ __device__ __forceinline__ int perm32(int rho) { const int n = rho >> 4, i = rho & 15; return 8 * (i >> 2) + 4 * n + (i & 3); }

struct Unit { int pm, pn; };
struct Gemm { const bf16_t* A; const bf16_t* Bt; int M, N, K; };

struct StaticOrder {
    int nM, nN, nwg, G, c;
    __host__ __device__ void init(int M, int N, int G_, int c_) { nM = M / BM; nN = N / BM; nwg = nM * nN; G = G_; c = c_; }
    __host__ __device__ bool next(int i, Unit& u) const {
        const long L = (long)i * G + c; if (L >= nwg) return false;
        int wgid = (int)L; { const int q = nwg / NXCD, r = nwg % NXCD, xcd = wgid % NXCD, off = wgid / NXCD; wgid = (xcd < r ? xcd * (q + 1) : r * (q + 1) + (xcd - r) * q) + off; }
        const int nig = WGM * nN, gid = wgid / nig, fm = gid * WGM, gsz = (nM - fm) < WGM ? (nM - fm) : WGM;
        u.pm = fm + ((wgid % nig) % gsz); u.pn = (wgid % nig) / gsz; return true;
    }
    __device__ __forceinline__ void a_ready(const Unit&) const {}
    __device__ __forceinline__ void done(const Unit&) const {}
};

__device__ __forceinline__ unsigned cvt_pk_bf16(float lo, float hi) { unsigned r; asm volatile("v_cvt_pk_bf16_f32 %0, %1, %2" : "=v"(r) : "v"(lo), "v"(hi)); return r; }
typedef float f32x2 __attribute__((ext_vector_type(2)));

struct EpiBf16 {
    static constexpr bool PERM = true, AFTER_DRAIN = false;
    bf16_t* O; size_t ldc; int split_cols; size_t split_stride;
    __device__ __forceinline__ void operator()(const f32x4 (&acc)[2][2][4][2], const Unit& u, int wr, int wc, int fr, int fq) const {
        const int row0 = u.pm * BM + wr * 64 + fr; int colt = u.pn * BM; bf16_t* base = O;
        if (split_cols) { const int t = colt / split_cols; base += (size_t)t * split_stride; colt -= t * split_cols; }
        const int col0 = colt + wc * 32 + 8 * fq;
#pragma unroll
        for (int ai = 0; ai < 2; ++ai)
#pragma unroll
            for (int m = 0; m < 4; ++m) { bf16_t* rowp = base + (size_t)(row0 + ai * HALF + m * 16) * ldc + col0;
#pragma unroll
                for (int bj = 0; bj < 2; ++bj) { const f32x4 v0 = acc[ai][bj][m][0], v1 = acc[ai][bj][m][1];
                    u32x4 w; w.x = cvt_pk_bf16(v0[0], v0[1]); w.y = cvt_pk_bf16(v0[2], v0[3]); w.z = cvt_pk_bf16(v1[0], v1[1]); w.w = cvt_pk_bf16(v1[2], v1[3]);
                    *(u32x4*)(rowp + bj * HALF) = w; } }
    }
};

struct EpiUkvPg {
    static constexpr bool PERM = true, AFTER_DRAIN = false;
    bf16_t* KM; bf16_t* VM;
    __device__ __forceinline__ void operator()(const f32x4 (&acc)[2][2][4][2], const Unit& u, int wr, int wc, int fr, int fq) const {
        { const int ln = lane_id(); fr = ln & 15; fq = ln >> 4; }
        const int row0 = u.pm * BM + wr * 64 + fr; const int e0 = 32 * wc + 8 * fq;
        const bool isk = (wc < 2);
        bf16_t* base = isk ? KM + (size_t)row0 * 768 + 2 * u.pn * 96 + e0 : VM + (size_t)row0 * 512 + 2 * u.pn * 64 + (e0 - 64);
        const int ld = isk ? 768 : 512, hs = isk ? 96 : 64;
#pragma unroll
        for (int ai = 0; ai < 2; ++ai)
#pragma unroll
            for (int m = 0; m < 4; ++m)
#pragma unroll
                for (int bj = 0; bj < 2; ++bj) { const f32x4 v0 = acc[ai][bj][m][0], v1 = acc[ai][bj][m][1];
                    u32x4 w; w.x = cvt_pk_bf16(v0[0], v0[1]); w.y = cvt_pk_bf16(v0[2], v0[3]); w.z = cvt_pk_bf16(v1[0], v1[1]); w.w = cvt_pk_bf16(v1[2], v1[3]);
                    *(u32x4*)(base + (ai * HALF + m * 16) * ld + bj * hs) = w; }
    }
};
struct EpiUqPg {
    static constexpr bool PERM = true, AFTER_DRAIN = false;
    bf16_t* QM; const float* cos32; const float* sin32; float sc;
    __device__ __forceinline__ void operator()(const f32x4 (&acc)[2][2][4][2], const Unit& u, int wr, int wc, int fr, int fq) const {
        { const int ln = lane_id(); fr = ln & 15; fq = ln >> 4; }
        const int row0 = u.pm * BM + wr * 64 + fr;
        bf16_t* base = QM + (size_t)row0 * 768 + u.pn * BM + 32 * wc + 8 * fq;
        const int g0 = 8 * u.pn + wc;
        const bool sgn = (fq & 1) != 0;
#pragma unroll
        for (int bj = 0; bj < 2; ++bj) { const bool pe = (((g0 + 4 * bj) % 3) == 2);
#pragma unroll
            for (int ai = 0; ai < 2; ++ai)
#pragma unroll
                for (int m = 0; m < 4; ++m) { const int rr = ai * HALF + m * 16; u32x4 w;
#pragma unroll
                    for (int n = 0; n < 2; ++n) { f32x4 v = acc[ai][bj][m][n];
                        if (pe) { f32x4 o;
#pragma unroll
                            for (int e = 0; e < 4; ++e) o[e] = __shfl_xor(v[e], 16);
                            const int l = (row0 + rr) & 4095, pos = (fq < 2) ? (l >> 6) : (l & 63);
                            const f32x4 cv = *(const f32x4*)(cos32 + pos * 8 + 4 * n), sv = *(const f32x4*)(sin32 + pos * 8 + 4 * n);
                            v = sgn ? (v * cv + o * sv) : (v * cv - o * sv); }
                        v = v * sc;
                        if (n == 0) { w.x = cvt_pk_bf16(v[0], v[1]); w.y = cvt_pk_bf16(v[2], v[3]); } else { w.z = cvt_pk_bf16(v[0], v[1]); w.w = cvt_pk_bf16(v[2], v[3]); } }
                    *(u32x4*)(base + rr * 768 + bj * HALF) = w;
                    asm volatile("" ::: "memory"); } }
    }
};
struct EpiResF32 {
    static constexpr bool PERM = false, AFTER_DRAIN = false;
    const float* base; float* out; const float* mod; float gmul;
    __device__ __forceinline__ void operator()(const f32x4 (&acc)[2][2][4][2], const Unit& u, int wr, int wc, int fr, int fq) const {
        const int row0 = u.pm * BM + wr * 64 + fr, col0 = u.pn * BM + wc * 32 + 4 * fq, b = (u.pm * BM) >> 12;
        f32x4 g[2][2];
#pragma unroll
        for (int bj = 0; bj < 2; ++bj)
#pragma unroll
            for (int n = 0; n < 2; ++n) g[bj][n] = *(const f32x4*)(mod + b * 3072 + 2048 + col0 + bj * HALF + n * 16) * gmul;
#pragma unroll
        for (int ai = 0; ai < 2; ++ai) {
            f32x4 pre[4][2][2];
#pragma unroll
            for (int m = 0; m < 4; ++m) { const size_t off = (size_t)(row0 + ai * HALF + m * 16) * 1024 + col0;
#pragma unroll
                for (int bj = 0; bj < 2; ++bj)
#pragma unroll
                    for (int n = 0; n < 2; ++n) pre[m][bj][n] = *(const f32x4*)(base + off + bj * HALF + n * 16); }
#pragma unroll
            for (int m = 0; m < 4; ++m) { const size_t off = (size_t)(row0 + ai * HALF + m * 16) * 1024 + col0;
#pragma unroll
                for (int bj = 0; bj < 2; ++bj)
#pragma unroll
                    for (int n = 0; n < 2; ++n) *(f32x4*)(out + off + bj * HALF + n * 16) = pre[m][bj][n] + g[bj][n] * acc[ai][bj][m][n]; }
        }
    }
};
template <class Epi, class Sched, bool ALIGN_EPI = false, bool SP2 = false>
__device__ __forceinline__ void gemm_phase(PG8_LAS unsigned char* lds, const Gemm g, const Sched& S, const Epi& E) {
    int tid_ = TID(); asm volatile("" : "+v"(tid_));
    const int tid = tid_, wid = __builtin_amdgcn_readfirstlane(tid >> 6), lane = tid & 63, wr = wid >> 2, wc = wid & 3, fr = lane & 15, fq = lane >> 4;
    const int K = g.K, nt = K / BK;
    unsigned voffA[2], voffB[2];
#pragma unroll
    for (int i = 0; i < 2; ++i) { int R, C; stage_rc(tid * 16 + i * 8192, R, C); const int Rb = Epi::PERM ? ((R & ~31) + perm32(R & 31)) : R;
        voffA[i] = (unsigned)(R * K + C) * 2u; voffB[i] = (unsigned)(Rb * K + C) * 2u; }
    const size_t kstep = (size_t)(BK * 2);
    const size_t hstep = (size_t)HALF * K * 2;
    const size_t tstep = 2 * hstep;
    const unsigned ldsw = (unsigned)wid * 1024u;
    const int aoff = lds_byte(wr * 64 + fr, fq * 8), boff = lds_byte(wc * 32 + fr, fq * 8);
#define PG8_SA(b, h) (((b) * 2 + (h)) * HTB)
#define PG8_SB(b, h) ((4 + (b) * 2 + (h)) * HTB)
#define PG8_STAGE(bufoff, gbase, voff) do { _Pragma("unroll") for (int _i = 0; _i < 2; ++_i) \
        __builtin_amdgcn_global_load_lds((const unsigned*)((const char*)(gbase) + (voff)[_i]), (PG8_LAS unsigned*)(lds + (bufoff) + ldsw + _i * 8192), 16, 0, 0); } while (0)
#define PG8_LDA(dst, b, h) do { _Pragma("unroll") for (int m = 0; m < 4; ++m) _Pragma("unroll") for (int k = 0; k < 2; ++k) dst[m][k] = *(const PG8_LAS bf16x8*)(lds + PG8_SA(b, h) + aoff + m * 2048 + k * 1024); } while (0)
#define PG8_LDB(dst, b, h) do { _Pragma("unroll") for (int n = 0; n < 2; ++n) _Pragma("unroll") for (int k = 0; k < 2; ++k) dst[n][k] = *(const PG8_LAS bf16x8*)(lds + PG8_SB(b, h) + boff + n * 2048 + k * 1024); } while (0)
#define PG8_MMA(ai, bj, At, Bt) do { __builtin_amdgcn_s_setprio(1); _Pragma("unroll") for (int m = 0; m < 4; ++m) _Pragma("unroll") for (int n = 0; n < 2; ++n) _Pragma("unroll") for (int k = 0; k < 2; ++k) \
        acc[ai][bj][m][n] = __builtin_amdgcn_mfma_f32_16x16x32_bf16(Bt[n][k], At[m][k], acc[ai][bj][m][n], 0, 0, 0); __builtin_amdgcn_s_setprio(0); } while (0)
#define PG8_WAIT_V(n) asm volatile("s_waitcnt vmcnt(" #n ")" ::: "memory")
#define PG8_WAIT_L(n) asm volatile("s_waitcnt lgkmcnt(" #n ")" ::: "memory")
#define PG8_BAR __builtin_amdgcn_s_barrier()
#define PG8_SCHED __builtin_amdgcn_sched_barrier(0)
    Unit cur, nxt; int ui = 0;
    if (!S.next(0, cur)) return;
    f32x4 acc[2][2][4][2];
#pragma unroll
    for (int a = 0; a < 2; ++a)
#pragma unroll
        for (int b = 0; b < 2; ++b)
#pragma unroll
            for (int m = 0; m < 4; ++m)
#pragma unroll
                for (int n = 0; n < 2; ++n) acc[a][b][m][n] = (f32x4){0.f, 0.f, 0.f, 0.f};
    bf16x8 At[4][2], B0[2][2], B1[2][2];
    const char* cA = (const char*)g.A + (size_t)cur.pm * tstep; const char* cB = (const char*)g.Bt + (size_t)cur.pn * tstep;
    S.a_ready(cur);
    if constexpr (SP2) {
        PG8_STAGE(PG8_SB(0, 0), cB, voffB); PG8_STAGE(PG8_SB(0, 1), cB + hstep, voffB); PG8_STAGE(PG8_SA(0, 0), cA, voffA); PG8_STAGE(PG8_SA(0, 1), cA + hstep, voffA);
        if (wr == 1) PG8_BAR;
        PG8_WAIT_V(2); PG8_BAR;
        PG8_STAGE(PG8_SB(1, 0), cB + kstep, voffB); PG8_STAGE(PG8_SA(1, 0), cA + kstep, voffA); PG8_STAGE(PG8_SB(1, 1), cB + hstep + kstep, voffB);
        PG8_WAIT_V(6); PG8_BAR;
    } else {
        PG8_STAGE(PG8_SB(0, 0), cB, voffB); PG8_STAGE(PG8_SA(0, 0), cA, voffA); PG8_STAGE(PG8_SB(0, 1), cB + hstep, voffB); PG8_STAGE(PG8_SA(0, 1), cA + hstep, voffA);
        if (wr == 1) PG8_BAR;
        PG8_WAIT_V(4); PG8_BAR;
        PG8_STAGE(PG8_SB(1, 0), cB + kstep, voffB); PG8_STAGE(PG8_SA(1, 0), cA + kstep, voffA); PG8_STAGE(PG8_SB(1, 1), cB + hstep + kstep, voffB);
        PG8_WAIT_V(6); PG8_BAR;
    }
    for (;;) {
        const bool has_next = S.next(ui + 1, nxt);
        const char* nA = has_next ? (const char*)g.A + (size_t)nxt.pm * tstep : cA; const char* nB = has_next ? (const char*)g.Bt + (size_t)nxt.pn * tstep : cB;
        for (int t = 0; t < nt; t += 2) {
            const bool last = (t == nt - 2);
            const char* a1 = cA + (size_t)(t + 1) * kstep;
            const char* a2 = last ? nA : cA + (size_t)(t + 2) * kstep; const char* b2 = last ? nB : cB + (size_t)(t + 2) * kstep;
            const char* a3 = a2 + kstep; const char* b3 = b2 + kstep;
            if (last && has_next) S.a_ready(nxt);
            if constexpr (SP2) {
            PG8_LDB(B0, 0, 0); PG8_LDB(B1, 0, 1); PG8_SCHED; PG8_LDA(At, 0, 0); PG8_STAGE(PG8_SA(1, 1), a1 + hstep, voffA);
            PG8_WAIT_V(8); PG8_WAIT_L(0); PG8_BAR; PG8_MMA(0, 0, At, B0); PG8_MMA(0, 1, At, B1); PG8_BAR; PG8_SCHED;
            PG8_LDA(At, 0, 1); PG8_STAGE(PG8_SB(0, 0), b2, voffB); PG8_STAGE(PG8_SB(0, 1), b2 + hstep, voffB); PG8_STAGE(PG8_SA(0, 0), a2, voffA);
            PG8_WAIT_V(8); PG8_WAIT_L(0); PG8_BAR; PG8_MMA(1, 0, At, B0); PG8_MMA(1, 1, At, B1); PG8_BAR; PG8_SCHED;
            PG8_LDB(B0, 1, 0); PG8_LDB(B1, 1, 1); PG8_SCHED; PG8_LDA(At, 1, 0); PG8_STAGE(PG8_SA(0, 1), a2 + hstep, voffA);
            PG8_WAIT_V(8); PG8_WAIT_L(0); PG8_BAR; PG8_MMA(0, 0, At, B0); PG8_MMA(0, 1, At, B1); PG8_BAR; PG8_SCHED;
            PG8_LDA(At, 1, 1); PG8_STAGE(PG8_SB(1, 0), b3, voffB); PG8_STAGE(PG8_SB(1, 1), b3 + hstep, voffB); PG8_STAGE(PG8_SA(1, 0), a3, voffA);
            PG8_WAIT_V(8); PG8_WAIT_L(0); PG8_BAR; PG8_MMA(1, 0, At, B0); PG8_MMA(1, 1, At, B1); PG8_BAR; PG8_SCHED;
            } else {
            PG8_LDB(B0, 0, 0); PG8_SCHED; PG8_LDA(At, 0, 0); PG8_STAGE(PG8_SA(1, 1), a1 + hstep, voffA);
            PG8_WAIT_L(8); PG8_BAR; PG8_WAIT_L(0); PG8_MMA(0, 0, At, B0); PG8_BAR; PG8_SCHED;
            PG8_LDB(B1, 0, 1); PG8_STAGE(PG8_SB(0, 0), b2, voffB);
            PG8_BAR; PG8_WAIT_L(0); PG8_MMA(0, 1, At, B1); PG8_BAR;
            PG8_LDA(At, 0, 1); PG8_STAGE(PG8_SA(0, 0), a2, voffA);
            PG8_BAR; PG8_WAIT_L(0); PG8_MMA(1, 0, At, B0); PG8_BAR; PG8_SCHED;
            PG8_STAGE(PG8_SB(0, 1), b2 + hstep, voffB);
            PG8_WAIT_V(6); PG8_BAR; PG8_MMA(1, 1, At, B1); PG8_BAR;
            PG8_LDB(B0, 1, 0); PG8_SCHED; PG8_LDA(At, 1, 0); PG8_STAGE(PG8_SA(0, 1), a2 + hstep, voffA);
            PG8_WAIT_L(8); PG8_BAR; PG8_WAIT_L(0); PG8_MMA(0, 0, At, B0); PG8_BAR; PG8_SCHED;
            PG8_LDB(B1, 1, 1); PG8_STAGE(PG8_SB(1, 0), b3, voffB);
            PG8_BAR; PG8_WAIT_L(0); PG8_MMA(0, 1, At, B1); PG8_BAR;
            PG8_LDA(At, 1, 1); PG8_STAGE(PG8_SA(1, 0), a3, voffA);
            PG8_BAR; PG8_WAIT_L(0); PG8_MMA(1, 0, At, B0); PG8_BAR; PG8_SCHED;
            PG8_STAGE(PG8_SB(1, 1), b3 + hstep, voffB);
            PG8_WAIT_V(6); PG8_BAR; PG8_MMA(1, 1, At, B1); PG8_BAR;
            }
        }
        if constexpr (ALIGN_EPI) { if (wr == 0) PG8_BAR; }
        if constexpr (!Epi::AFTER_DRAIN) { E(acc, cur, wr, wc, fr, fq); S.done(cur); }
        if (!has_next) break;
#pragma unroll
        for (int a = 0; a < 2; ++a)
#pragma unroll
            for (int b = 0; b < 2; ++b)
#pragma unroll
                for (int m = 0; m < 4; ++m)
#pragma unroll
                    for (int n = 0; n < 2; ++n) acc[a][b][m][n] = (f32x4){0.f, 0.f, 0.f, 0.f};
        cur = nxt; cA = nA; cB = nB; ++ui;
        if constexpr (ALIGN_EPI) { if (wr == 1) PG8_BAR; }
    }
    PG8_WAIT_V(0);
    if constexpr (!ALIGN_EPI) { if (wr == 0) PG8_BAR; }
    PG8_BAR;
    if constexpr (Epi::AFTER_DRAIN) { E.fused(acc, cur, wr, wc, fr, fq, lds, wid, lane); S.done(cur); }
#undef PG8_SA
#undef PG8_SB
#undef PG8_STAGE
#undef PG8_LDA
#undef PG8_LDB
#undef PG8_MMA
#undef PG8_WAIT_V
#undef PG8_WAIT_L
#undef PG8_BAR
#undef PG8_SCHED
}
}

DEV void transpose_item(float* scr, const float* W, int K, int N, int Npad, bf16_t* WT, int item, int lane) {
    const int nblk = Npad / 32, kb = item / nblk, nb = item % nblk, k0 = 64 * kb, n0 = 32 * nb;
    const bool valid = (n0 < N);
    float v[32];
#pragma unroll
    for (int i = 0; i < 32; ++i) { const int kk = 2 * i + (lane >> 5); v[i] = valid ? W[(size_t)(k0 + kk) * N + n0 + (lane & 31)] : 0.f; }
#pragma unroll
    for (int i = 0; i < 32; ++i) { const int kk = 2 * i + (lane >> 5); scr[kk * 33 + (lane & 31)] = v[i]; }
    asm volatile("s_waitcnt lgkmcnt(0)" ::: "memory");
    const int c = lane & 7;
#pragma unroll
    for (int j = 0; j < 4; ++j) { const int n = (lane >> 3) + 8 * j; const float* sp = scr + (8 * c) * 33 + n; float o[8];
#pragma unroll
        for (int e = 0; e < 8; ++e) o[e] = sp[e * 33];
        *(u32x4*)(WT + (size_t)(n0 + n) * K + k0 + 8 * c) = pack8(o); }
    asm volatile("s_waitcnt lgkmcnt(0)" ::: "memory");
}

DEV void mod_item(char* lds, const Params& p, int item) {
    const int layer = item / 96, n0 = (item % 96) * 32, tid = TID();
    float* s = (float*)lds;
    float* red = s + 9 * 1024;
    for (int i = tid; i < 9 * 1024; i += 512) { const int v = i >> 10, k = i & 1023; const float cv = (v < 8) ? p.c[v * 1024 + k] : p.c_ctx[k]; s[i] = silu(cv); }
    __syncthreads();
    const int kc = tid >> 5, n = tid & 31; const float* W = p.ada_w + (size_t)layer * DM * 3072 + n0 + n;
    float acc[9];
#pragma unroll
    for (int v = 0; v < 9; ++v) acc[v] = 0.f;
#pragma unroll 16
    for (int kk = 0; kk < 64; ++kk) { const int k = kc * 64 + kk; const float w = W[(size_t)k * 3072];
#pragma unroll
        for (int v = 0; v < 9; ++v) acc[v] += s[v * 1024 + k] * w; }
#pragma unroll
    for (int v = 0; v < 9; ++v) red[(kc * 9 + v) * 32 + n] = acc[v];
    __syncthreads();
    if (tid < 9 * 32) { const int v = tid >> 5, nn = tid & 31; float t = 0.f;
#pragma unroll
        for (int k2 = 0; k2 < 16; ++k2) t += red[(k2 * 9 + v) * 32 + nn];
        t += p.ada_b[layer * 3072 + n0 + nn];
        if (layer == 0) ((float*)(p.ws + WS_MOD0))[v * 3072 + n0 + nn] = t;
        else if (v < 8) ((float*)(p.ws + WS_MOD1))[v * 3072 + n0 + nn] = t; }
    __syncthreads();
}

DEV void hid2_row(char* lds, const Params& p, int t, int wid, int lane) {
    float* sc = (float*)lds + wid * 128;
    const float tn = (float)t * (1.0f / 4095.0f);
    const float w = (float)(2.0 * 3.14159265358979323846 / 4096.0) * (float)t;
    float e = 0.f;
    if (lane == 0) e = tn;
    else if (lane <= 32) { const int k = (lane - 1) & 15; const float band = 1e-4f + (float)k * ((15.0f - 1e-4f) / 15.0f); const float ang = w * band; e = (lane <= 16) ? cosf(ang) : -sinf(ang); }
    sc[lane] = e;
    asm volatile("s_waitcnt lgkmcnt(0)" ::: "memory");
    float a = p.f_b1[lane];
    for (int i = 0; i < 33; ++i) a += sc[i] * p.f_w1[i * 64 + lane];
    const float fr = p.freq[lane];
    const float h1 = sinf(fr * a);
    sc[64 + lane] = h1;
    asm volatile("s_waitcnt lgkmcnt(0)" ::: "memory");
    float a2 = p.f_b2[lane];
    for (int i = 0; i < 64; ++i) a2 += sc[64 + i] * p.f_w2[i * 64 + lane];
    const float h2 = sinf(fr * a2);
    ((bf16_t*)(p.ws + WS_HID2))[t * 64 + lane] = f2bf(h2);
    asm volatile("s_waitcnt lgkmcnt(0)" ::: "memory");
}

DEV void phase_prep(char* lds, const Params& p) {
    const int tid = TID(), wid = tid >> 6, lane = tid & 63;
    { const int gt = blockIdx.x * 512 + tid;
        if (gt < 2048) ((float*)(p.ws + WS_SSUM))[gt] = 0.f;
        float* rp = (float*)(p.ws + WS_ROPE);
        if (gt < 1024) { const int pos = gt >> 4, i = gt & 15; const float inv = exp2f(-(float)i * (13.287712379549449f / 16.0f)); const float ang = (float)pos * inv; rp[gt] = cosf(ang); rp[1024 + gt] = sinf(ang); }
        if (gt < 512) { const int pos = gt >> 3, i = gt & 7; const float inv = exp2f(-(float)i * (13.287712379549449f / 8.0f)); const float ang = (float)pos * inv; rp[2048 + gt] = cosf(ang); rp[2560 + gt] = sinf(ang); } }
    for (int it = blockIdx.x; it < 192; it += gridDim.x) mod_item(lds, p, it);
    for (int t = blockIdx.x * 8 + wid; t < 4096; t += gridDim.x * 8) hid2_row(lds, p, t, wid, lane);
    __syncthreads();
    constexpr int I_WIN = 16 * (AINP / 32), I_UQ = 4 * 24, I_UKV = 2 * 32, I_WO = 16 * 32, I_HIN = 16 * 128, I_HO = 16 * 32, I_W3 = 128;
    constexpr int NIT = I_WIN + I_UQ + I_UKV + I_WO + I_HIN + I_HO + I_W3;
    float* scr = (float*)lds + wid * (64 * 33);
    for (int it = blockIdx.x * 8 + wid; it < NIT; it += gridDim.x * 8) {
        int r = it;
        if (r < I_HIN) { transpose_item(scr, p.hy_w_in, 1024, 4096, 4096, (bf16_t*)(p.ws + WS_HWIN), r, lane); continue; } r -= I_HIN;
        if (r < I_WIN) { transpose_item(scr, p.w_in, 1024, AIN, AINP, (bf16_t*)(p.ws + WS_WIN), r, lane); continue; } r -= I_WIN;
        if (r < I_WO) { transpose_item(scr, p.w_out, 1024, 1024, 1024, (bf16_t*)(p.ws + WS_WOUT), r, lane); continue; } r -= I_WO;
        if (r < I_HO) { transpose_item(scr, p.hy_w_out, 1024, 1024, 1024, (bf16_t*)(p.ws + WS_HWOUT), r, lane); continue; } r -= I_HO;
        if (r < I_UQ) { transpose_item(scr, p.w_uq, 256, 768, 768, (bf16_t*)(p.ws + WS_WUQ), r, lane); continue; } r -= I_UQ;
        if (r < I_UKV) { transpose_item(scr, p.w_ukv, 128, 1024, 1024, (bf16_t*)(p.ws + WS_WUKV), r, lane); continue; } r -= I_UKV;
        transpose_item(scr, p.f_w3, 64, 4096, 4096, (bf16_t*)(p.ws + WS_W3), r, lane);
    }
}

DEV void row_load(f32x4 (&v)[4], const float* xr, int lane) {
#pragma unroll
    for (int j = 0; j < 4; ++j) v[j] = *(const f32x4*)(xr + lane * 4 + 256 * j);
}
DEV void modnorm_row(const f32x4 (&v)[4], const float* nw, const float* shift, const float* scale, bf16_t* orow, int lane) {
    float s = 0.f;
#pragma unroll
    for (int j = 0; j < 4; ++j) s += v[j].x * v[j].x + v[j].y * v[j].y + v[j].z * v[j].z + v[j].w * v[j].w;
    const float r = rsqrtf(wave_sum(s) * (1.0f / DM) + EPS);
#pragma unroll
    for (int j = 0; j < 4; ++j) { const int c0 = lane * 4 + 256 * j;
        const f32x4 w = *(const f32x4*)(nw + c0), sh = *(const f32x4*)(shift + c0), sc = *(const f32x4*)(scale + c0);
        const float o0 = v[j].x * r * w.x * (1.f + sc.x) + sh.x, o1 = v[j].y * r * w.y * (1.f + sc.y) + sh.y, o2 = v[j].z * r * w.z * (1.f + sc.z) + sh.z, o3 = v[j].w * r * w.w * (1.f + sc.w) + sh.w;
        u32x2 pk; pk.x = pk2(o0, o1); pk.y = pk2(o2, o3); *(u32x2*)(orow + c0) = pk; }
}
DEV const float* norm0_src(const Params& p, int row) { return row < NTOK ? p.x + (size_t)row * DM : p.ctx + (size_t)(row - NTOK) * DM; }
DEV void phase_norm0(const Params& p) {
    const int wid = TID() >> 6, lane = TID() & 63; const float* mod0 = (const float*)(p.ws + WS_MOD0); bf16_t* H0 = (bf16_t*)(p.ws + WS_H0);
    const int stride = gridDim.x * 8; int row = blockIdx.x * 8 + wid;
    f32x4 cur[4], nxt[4];
    if (row < NALL) row_load(cur, norm0_src(p, row), lane);
    for (; row < NALL; row += stride) {
        { const int rn = row + stride < NALL ? row + stride : row; row_load(nxt, norm0_src(p, rn), lane); }
        const int v = row < NTOK ? (row >> 12) : 8;
        modnorm_row(cur, p.norm_w, mod0 + v * 3072, mod0 + v * 3072 + 1024, H0 + (size_t)row * DM, lane);
#pragma unroll
        for (int j = 0; j < 4; ++j) cur[j] = nxt[j];
    }
}
DEV void phase_norm1(const Params& p) {
    const int wid = TID() >> 6, lane = TID() & 63; const float* mod1 = (const float*)(p.ws + WS_MOD1); bf16_t* H1 = (bf16_t*)(p.ws + WS_H1);
    const int stride = gridDim.x * 8; int row = blockIdx.x * 8 + wid;
    f32x4 cur[4], nxt[4];
    if (row < NTOK) row_load(cur, p.out + (size_t)row * DM, lane);
    for (; row < NTOK; row += stride) {
        { const int rn = row + stride < NTOK ? row + stride : row; row_load(nxt, p.out + (size_t)rn * DM, lane); }
        const int v = row >> 12;
        modnorm_row(cur, p.norm_w + DM, mod1 + v * 3072, mod1 + v * 3072 + 1024, H1 + (size_t)row * DM, lane);
#pragma unroll
        for (int j = 0; j < 4; ++j) cur[j] = nxt[j];
    }
}
DEV void phase_final(const Params& p) {
    const int wid = TID() >> 6, lane = TID() & 63;
    const int stride = gridDim.x * 8; int row = blockIdx.x * 8 + wid;
    f32x4 v[4], nxt[4];
    if (row < NTOK) row_load(v, p.out + (size_t)row * DM, lane);
    for (; row < NTOK; row += stride) {
        { const int rn = row + stride < NTOK ? row + stride : row; row_load(nxt, p.out + (size_t)rn * DM, lane); }
        float* xr = p.out + (size_t)row * DM; float s = 0.f;
#pragma unroll
        for (int j = 0; j < 4; ++j) s += v[j].x * v[j].x + v[j].y * v[j].y + v[j].z * v[j].z + v[j].w * v[j].w;
        const float r = rsqrtf(wave_sum(s) * (1.0f / DM) + EPS);
#pragma unroll
        for (int j = 0; j < 4; ++j) { const int c0 = lane * 4 + 256 * j; const f32x4 w = *(const f32x4*)(p.final_w + c0);
            f32x4 o; o.x = v[j].x * r * w.x; o.y = v[j].y * r * w.y; o.z = v[j].z * r * w.z; o.w = v[j].w * r * w.w; *(f32x4*)(xr + c0) = o; }
#pragma unroll
        for (int j = 0; j < 4; ++j) v[j] = nxt[j];
    }
}

struct PostIn { u32x4 raw[5]; f32x4 c64[2], s64[2], c32[2], s32[2]; };
DEV void post_load(PostIn& I, const bf16_t* PRAW, const float* rp, int tok, int lane) {
    const bf16_t* pr = PRAW + (size_t)tok * AINP;
#pragma unroll
    for (int sgm = 0; sgm < 4; ++sgm) I.raw[sgm] = *(const u32x4*)(pr + 512 * sgm + lane * 8);
    I.raw[4] = *(const u32x4*)(pr + 2048 + (lane & 31) * 8);
    const int l = tok & 4095, prow = l >> 6, pcol = l & 63;
    const int k = lane & 7, posv = (k < 4) ? prow : pcol; const float* t64 = rp + posv * 16 + (k & 1) * 8;
    I.c64[0] = *(const f32x4*)t64; I.c64[1] = *(const f32x4*)(t64 + 4); I.s64[0] = *(const f32x4*)(t64 + 1024); I.s64[1] = *(const f32x4*)(t64 + 1028);
    const int k3 = lane & 3, posm = (k3 < 2) ? prow : pcol; const float* t32 = rp + 2048 + posm * 8;
    I.c32[0] = *(const f32x4*)t32; I.c32[1] = *(const f32x4*)(t32 + 4); I.s32[0] = *(const f32x4*)(t32 + 512); I.s32[1] = *(const f32x4*)(t32 + 516);
}
DEV void phase_post(const Params& p) {
    const int wid = TID() >> 6, lane = TID() & 63;
    const bf16_t* PRAW = (const bf16_t*)(p.ws + WS_PRAW);
    bf16_t* QA = (bf16_t*)(p.ws + WS_QA); bf16_t* KA = (bf16_t*)(p.ws + WS_KA); bf16_t* VA = (bf16_t*)(p.ws + WS_VA);
    bf16_t* CQN = (bf16_t*)(p.ws + WS_CQN); bf16_t* CKVN = (bf16_t*)(p.ws + WS_CKVN); bf16_t* G = (bf16_t*)(p.ws + WS_G); bf16_t* KM = (bf16_t*)(p.ws + WS2_KM);
    const float* rp = (const float*)(p.ws + WS_ROPE);
    float wq[8], wk[8], wcq[8], wckv[8];
    { const int k = lane & 7;
#pragma unroll
        for (int j = 0; j < 8; ++j) { wq[j] = p.q_norm[k * 8 + j]; wk[j] = p.k_norm[k * 8 + j]; wcq[j] = p.cq_norm[(lane & 31) * 8 + j]; wckv[j] = p.ckv_norm[(lane & 15) * 8 + j]; } }
    const int stride = gridDim.x * 8;
    int tok = blockIdx.x * 8 + wid;
    PostIn cur, nxt;
    if (tok < NALL) post_load(cur, PRAW, rp, tok, lane);
    for (; tok < NALL; tok += stride) {
        { const int tn = tok + stride < NALL ? tok + stride : tok; post_load(nxt, PRAW, rp, tn, lane); }
        const bool lat = tok < NTOK; int b, pos;
        if (lat) { b = tok >> 12; pos = CTXL + (tok & 4095); } else { const int j = tok - NTOK; b = j >> 8; pos = j & 255; }
        const size_t kvrow = (size_t)b * LK + pos;
        const float cs64[8] = {cur.c64[0].x, cur.c64[0].y, cur.c64[0].z, cur.c64[0].w, cur.c64[1].x, cur.c64[1].y, cur.c64[1].z, cur.c64[1].w};
        const float sn64[8] = {cur.s64[0].x, cur.s64[0].y, cur.s64[0].z, cur.s64[0].w, cur.s64[1].x, cur.s64[1].y, cur.s64[1].z, cur.s64[1].w};
        float v[8], o[8];
        if (lat) {
            unpack8(cur.raw[0], v);
            float ss = 0.f;
#pragma unroll
            for (int j = 0; j < 8; ++j) ss += v[j] * v[j];
            ss += __shfl_xor(ss, 1); ss += __shfl_xor(ss, 2); ss += __shfl_xor(ss, 4);
            const float r = rsqrtf(ss * (1.0f / 64.0f) + EPS); const int k = lane & 7;
#pragma unroll
            for (int j = 0; j < 8; ++j) v[j] = v[j] * r * wq[j];
#pragma unroll
            for (int j = 0; j < 8; ++j) { const float ot = __shfl_xor(v[j], 2);
                o[j] = ((k & 2) ? (v[j] * cs64[j] + ot * sn64[j]) : (v[j] * cs64[j] - ot * sn64[j])) * QSC_A; }
            *(u32x4*)(QA + (size_t)tok * 512 + lane * 8) = pack8(o);
        }
        {
            const u32x4 raw = cur.raw[1]; unpack8(raw, v);
            float ss = 0.f;
#pragma unroll
            for (int j = 0; j < 8; ++j) ss += v[j] * v[j];
            ss += __shfl_xor(ss, 1); ss += __shfl_xor(ss, 2); ss += __shfl_xor(ss, 4);
            const float s8 = ss;
            ss += __shfl_xor(ss, 8); ss += __shfl_xor(ss, 16);
            const float s32 = ss;
            float vn[8]; const int k = lane & 7;
            { const float r = rsqrtf(s8 * (1.0f / 64.0f) + EPS);
#pragma unroll
                for (int j = 0; j < 8; ++j) vn[j] = v[j] * r * wk[j]; }
#pragma unroll
            for (int j = 0; j < 8; ++j) { const float ot = __shfl_xor(vn[j], 2);
                o[j] = lat ? ((k & 2) ? (vn[j] * cs64[j] + ot * sn64[j]) : (vn[j] * cs64[j] - ot * sn64[j])) : vn[j]; }
            if (lane < 16) *(u32x4*)(KA + kvrow * 128 + lane * 8) = pack8(o);
            else if (lane < 32) *(u32x4*)(VA + kvrow * 128 + (lane - 16) * 8) = raw;
            else if (lat) { const float r = rsqrtf(s32 * (1.0f / 256.0f) + EPS); const int cb = (lane - 32) * 8;
#pragma unroll
                for (int j = 0; j < 8; ++j) o[j] = v[j] * r * wcq[j];
                *(u32x4*)(CQN + (size_t)tok * 256 + cb) = pack8(o); }
        }
        {
            unpack8(cur.raw[2], v);
            float ss = 0.f;
#pragma unroll
            for (int j = 0; j < 8; ++j) ss += v[j] * v[j];
            ss += __shfl_xor(ss, 1); ss += __shfl_xor(ss, 2); ss += __shfl_xor(ss, 4); ss += __shfl_xor(ss, 8);
            const int k = lane & 3;
            float oth[8];
#pragma unroll
            for (int j = 0; j < 8; ++j) oth[j] = __shfl_xor(v[j], 1);
            if (lane < 16) { const float r = rsqrtf(ss * (1.0f / 128.0f) + EPS);
#pragma unroll
                for (int j = 0; j < 8; ++j) o[j] = v[j] * r * wckv[j];
                *(u32x4*)(CKVN + kvrow * 128 + lane * 8) = pack8(o); }
            else if (lane < 20) {
                const float cs32[8] = {cur.c32[0].x, cur.c32[0].y, cur.c32[0].z, cur.c32[0].w, cur.c32[1].x, cur.c32[1].y, cur.c32[1].z, cur.c32[1].w};
                const float sn32[8] = {cur.s32[0].x, cur.s32[0].y, cur.s32[0].z, cur.s32[0].w, cur.s32[1].x, cur.s32[1].y, cur.s32[1].z, cur.s32[1].w};
#pragma unroll
                for (int j = 0; j < 8; ++j) o[j] = lat ? ((k & 1) ? (v[j] * cs32[j] + oth[j] * sn32[j]) : (v[j] * cs32[j] - oth[j] * sn32[j])) : v[j];
                const u32x4 w = pack8(o);
#pragma unroll
                for (int h = 0; h < 8; ++h) *(u32x4*)(KM + kvrow * 768 + h * 96 + 64 + k * 8) = w; }
            else if (lat) {
#pragma unroll
                for (int j = 0; j < 8; ++j) o[j] = silu(v[j]);
                *(u32x4*)(G + (size_t)tok * 1024 + (lane - 20) * 8) = pack8(o); }
        }
        if (lat) {
            unpack8(cur.raw[3], v);
#pragma unroll
            for (int j = 0; j < 8; ++j) o[j] = silu(v[j]);
            *(u32x4*)(G + (size_t)tok * 1024 + 352 + lane * 8) = pack8(o);
            if (lane < 20) { unpack8(cur.raw[4], v);
#pragma unroll
                for (int j = 0; j < 8; ++j) o[j] = silu(v[j]);
                *(u32x4*)(G + (size_t)tok * 1024 + 864 + lane * 8) = pack8(o); }
        }
        cur = nxt;
    }
}

template <int DQK>
DEV void attn_unit(char* lds, const bf16_t* __restrict__ Q, int ldq, int qcol, const bf16_t* __restrict__ Kp, int ldk, int kcol, const bf16_t* __restrict__ Vp, int ldv, int vcol,
                   const bf16_t* __restrict__ Gt, bf16_t* OG, int ocol, int b, int q0) {
    constexpr int KRS = (DQK + 8) * 2, KB = 64 * KRS, VRS = 192, VB = 64 * VRS, STG = KB + VB, NKS = DQK / 16, KCH = DQK / 8;
    const int tid = TID(), lane = tid & 63, wid = tid >> 6, l31 = lane & 31, hi = lane >> 5;
    bf16x8 qf[NKS];
    { const bf16_t* qp = Q + (size_t)(b * SEQ + q0 + wid * 32 + l31) * ldq + qcol + hi * 8;
#pragma unroll
        for (int ks = 0; ks < NKS; ++ks) qf[ks] = *(const bf16x8*)(qp + ks * 16); }
    const bf16_t* kbase = Kp + (size_t)b * LK * ldk + kcol; const bf16_t* vbase = Vp + (size_t)b * LK * ldv + vcol;
    const int kr0 = tid / KCH, kc0 = tid % KCH;
    const int kr1 = (tid + 512) / KCH, kc1 = (tid + 512) % KCH;
    const bool k2 = (KCH * 64 > 512) && (tid + 512 < KCH * 64);
    const int vr = tid >> 3, vc = tid & 7;
    u32x4 sk0, sk1, sv;
#define A_LOAD(t) do { const size_t kp_ = (size_t)(t) * 64; sk0 = *(const u32x4*)(kbase + (kp_ + kr0) * ldk + kc0 * 8); \
        if (k2) sk1 = *(const u32x4*)(kbase + (kp_ + kr1) * ldk + kc1 * 8); sv = *(const u32x4*)(vbase + (kp_ + vr) * ldv + vc * 8); } while (0)
#define A_STORE(buf) do { char* b_ = lds + (buf) * STG; *(u32x4*)(b_ + kr0 * KRS + kc0 * 16) = sk0; if (k2) *(u32x4*)(b_ + kr1 * KRS + kc1 * 16) = sk1; \
        *(u32x4*)(b_ + KB + vr * VRS + vc * 16) = sv; } while (0)
    f32x16 o0, o1;
#pragma unroll
    for (int r = 0; r < 16; ++r) { o0[r] = 0.f; o1[r] = 0.f; }
    float m_run = -1e30f, l_run = 0.f;
    const int g1 = (lane >> 4) & 1, tq = (lane & 15) >> 2, tp = lane & 3;
    const int vt_off = KB + (4 * hi + tq) * VRS + (16 * g1 + 4 * tp) * 2;
    const int kf_off = l31 * KRS + hi * 16;
    constexpr int NT = LK / 64;
    A_LOAD(0); A_STORE(0);
    __syncthreads();
    for (int t = 0; t < NT; ++t) {
        const bool more = (t + 1 < NT);
        if (more) A_LOAD(t + 1);
        const char* b_ = lds + (t & 1) * STG;
        f32x16 p0, p1;
#pragma unroll
        for (int r = 0; r < 16; ++r) { p0[r] = 0.f; p1[r] = 0.f; }
#pragma unroll
        for (int ks = 0; ks < NKS; ++ks) {
            const bf16x8 ka = *(const bf16x8*)(b_ + kf_off + ks * 32);
            const bf16x8 kb = *(const bf16x8*)(b_ + kf_off + 32 * KRS + ks * 32);
            p0 = __builtin_amdgcn_mfma_f32_32x32x16_bf16(ka, qf[ks], p0, 0, 0, 0);
            p1 = __builtin_amdgcn_mfma_f32_32x32x16_bf16(kb, qf[ks], p1, 0, 0, 0);
        }
        float mx = p0[0];
#pragma unroll
        for (int r = 1; r < 16; ++r) mx = fmaxf(mx, p0[r]);
#pragma unroll
        for (int r = 0; r < 16; ++r) mx = fmaxf(mx, p1[r]);
        mx = fmaxf(mx, __shfl_xor(mx, 32));
        const float m_new = fmaxf(m_run, mx);
        const float alpha = __builtin_amdgcn_exp2f(m_run - m_new);
        m_run = m_new;
        float ls = 0.f;
#pragma unroll
        for (int r = 0; r < 16; ++r) { p0[r] = __builtin_amdgcn_exp2f(p0[r] - m_new); p1[r] = __builtin_amdgcn_exp2f(p1[r] - m_new); ls += p0[r] + p1[r]; }
        l_run = l_run * alpha + ls;
#pragma unroll
        for (int r = 0; r < 16; ++r) { o0[r] *= alpha; o1[r] *= alpha; }
        u32x4 pw[4];
        pw[0] = (u32x4){pk2(p0[0], p0[1]), pk2(p0[2], p0[3]), pk2(p0[4], p0[5]), pk2(p0[6], p0[7])};
        pw[1] = (u32x4){pk2(p0[8], p0[9]), pk2(p0[10], p0[11]), pk2(p0[12], p0[13]), pk2(p0[14], p0[15])};
        pw[2] = (u32x4){pk2(p1[0], p1[1]), pk2(p1[2], p1[3]), pk2(p1[4], p1[5]), pk2(p1[6], p1[7])};
        pw[3] = (u32x4){pk2(p1[8], p1[9]), pk2(p1[10], p1[11]), pk2(p1[12], p1[13]), pk2(p1[14], p1[15])};
#pragma unroll
        for (int s = 0; s < 4; ++s) {
            const bf16x8 pb = __builtin_bit_cast(bf16x8, pw[s]);
#pragma unroll
            for (int dt = 0; dt < 2; ++dt) {
                const char* vp = b_ + vt_off + s * 16 * VRS + dt * 64;
                const s16x4 lo = __builtin_bit_cast(s16x4, __builtin_amdgcn_ds_read_tr16_b64_v4i16((LAS s16x4*)vp));
                const s16x4 hh = __builtin_bit_cast(s16x4, __builtin_amdgcn_ds_read_tr16_b64_v4i16((LAS s16x4*)(vp + 8 * VRS)));
                const bf16x8 vf = (bf16x8){lo[0], lo[1], lo[2], lo[3], hh[0], hh[1], hh[2], hh[3]};
                if (dt == 0) o0 = __builtin_amdgcn_mfma_f32_32x32x16_bf16(vf, pb, o0, 0, 0, 0);
                else o1 = __builtin_amdgcn_mfma_f32_32x32x16_bf16(vf, pb, o1, 0, 0, 0);
            }
        }
        if (more) A_STORE((t + 1) & 1);
        __syncthreads();
    }
#undef A_LOAD
#undef A_STORE
    const float lt = l_run + __shfl_xor(l_run, 32); const float inv = 1.0f / lt;
    const size_t tok = (size_t)(b * SEQ + q0 + wid * 32 + l31);
#pragma unroll
    for (int dt = 0; dt < 2; ++dt)
#pragma unroll
        for (int g = 0; g < 4; ++g) { const int d = 32 * dt + 8 * g + 4 * hi; const size_t off = tok * 1024 + ocol + d;
            const u32x2 gw = *(const u32x2*)(Gt + off);
            const f32x16& oo = dt ? o1 : o0;
            u32x2 w; w.x = pk2(oo[4 * g] * inv * lo_bf(gw.x), oo[4 * g + 1] * inv * hi_bf(gw.x)); w.y = pk2(oo[4 * g + 2] * inv * lo_bf(gw.y), oo[4 * g + 3] * inv * hi_bf(gw.y));
            *(u32x2*)(OG + off) = w; }
}

DEV float max3f_s(float a, float b, float c) { float r; asm("v_max3_f32 %0, %1, %2, %3" : "=v"(r) : "v"(a), "v"(b), "v"(c)); return r; }
DEV float max2f_s(float a, float b) { float r; asm("v_max_f32_e32 %0, %1, %2" : "=v"(r) : "v"(a), "v"(b)); return r; }
DEV float fadd_s(float a, float b) { float r; asm("v_add_f32_e32 %0, %1, %2" : "=v"(r) : "v"(a), "v"(b)); return r; }
DEV float swapmax32(float v) { auto rr = __builtin_amdgcn_permlane32_swap(__float_as_uint(v), __float_as_uint(v), false, false); return fmaxf(__uint_as_float(rr[0]), __uint_as_float(rr[1])); }
DEV float swapsum32(float v) { auto rr = __builtin_amdgcn_permlane32_swap(__float_as_uint(v), __float_as_uint(v), false, false); return __uint_as_float(rr[0]) + __uint_as_float(rr[1]); }
template <int DQK>
DEV void attn_unit2(char* lds, const bf16_t* __restrict__ Q, int ldq, int qcol, const bf16_t* __restrict__ Kp, int ldk, int kcol, const bf16_t* __restrict__ Vp, int ldv, int vcol,
                    const bf16_t* __restrict__ Gt, bf16_t* OG, int ocol, int b, int q0) {
    constexpr int KRS = (DQK + 8) * 2, KB = 64 * KRS, VRS = 192, VB = 64 * VRS, NKS = DQK / 16, KCH = DQK / 8, VOFF = 2 * KB;
    constexpr float THR = 8.0f;
    constexpr int NT = LK / 64;
    const int tid = TID(), lane = tid & 63, wid = tid >> 6, l31 = lane & 31, hi = lane >> 5;
    bf16x8 qf[NKS];
    { const bf16_t* qp = Q + (size_t)(b * SEQ + q0 + wid * 32 + l31) * ldq + qcol + hi * 8;
#pragma unroll
        for (int ks = 0; ks < NKS; ++ks) qf[ks] = *(const bf16x8*)(qp + ks * 16); }
    const bf16_t* kbase = Kp + (size_t)b * LK * ldk + kcol; const bf16_t* vbase = Vp + (size_t)b * LK * ldv + vcol;
    constexpr bool K2 = (KCH * 64 > 512);
    const bool k2 = K2 && (tid + 512 < KCH * 64);
    const int kr0 = tid / KCH, kc0 = tid % KCH, kr1 = k2 ? (tid + 512) / KCH : kr0, kc1 = k2 ? (tid + 512) % KCH : kc0;
    const int vr = tid >> 3, vc = tid & 7;
    u32x4 skX0, skX1 = {0u, 0u, 0u, 0u}, svX;
#define A_LOADK(t, S) do { const int tt_ = (t) < NT ? (t) : NT - 1; const size_t kp_ = (size_t)tt_ * 64; sk##S##0 = *(const u32x4*)(kbase + (kp_ + kr0) * ldk + kc0 * 8); if (K2) sk##S##1 = *(const u32x4*)(kbase + (kp_ + kr1) * ldk + kc1 * 8); } while (0)
#define A_LOADV(t, S) do { const int tt_ = (t) < NT ? (t) : NT - 1; sv##S = *(const u32x4*)(vbase + ((size_t)tt_ * 64 + vr) * ldv + vc * 8); } while (0)
#define A_STOREK(slot, S) do { char* b_ = lds + (slot) * KB; *(u32x4*)(b_ + kr0 * KRS + kc0 * 16) = sk##S##0; if (K2) *(u32x4*)(b_ + kr1 * KRS + kc1 * 16) = sk##S##1; } while (0)
#define A_STOREV(slot, S) do { *(u32x4*)(lds + VOFF + (slot) * VB + vr * VRS + vc * 16) = sv##S; } while (0)
    f32x16 o0, o1, negm;
#pragma unroll
    for (int r = 0; r < 16; ++r) { o0[r] = 0.f; o1[r] = 0.f; negm[r] = 0.f; }
    asm volatile("" : "+v"(negm));
    float mhat = 0.f, l_run = 0.f;
    const int g1 = (lane >> 4) & 1, tq = (lane & 15) >> 2, tp = lane & 3;
    const int vt_off = VOFF + (4 * hi + tq) * VRS + (16 * g1 + 4 * tp) * 2;
    const int kf_off = l31 * KRS + hi * 16;
#define A_QK(P0, P1, slot) do { const char* kb_ = lds + (slot) * KB + kf_off; \
        _Pragma("unroll") for (int ks = 0; ks < NKS; ++ks) { \
            const bf16x8 ka = *(const bf16x8*)(kb_ + ks * 32); const bf16x8 kb2 = *(const bf16x8*)(kb_ + 32 * KRS + ks * 32); \
            if (ks == 0) { P0 = __builtin_amdgcn_mfma_f32_32x32x16_bf16(ka, qf[0], negm, 0, 0, 0); P1 = __builtin_amdgcn_mfma_f32_32x32x16_bf16(kb2, qf[0], negm, 0, 0, 0); } \
            else { P0 = __builtin_amdgcn_mfma_f32_32x32x16_bf16(ka, qf[ks], P0, 0, 0, 0); P1 = __builtin_amdgcn_mfma_f32_32x32x16_bf16(kb2, qf[ks], P1, 0, 0, 0); } } } while (0)
    A_LOADK(0, X); A_LOADV(0, X); A_STOREK(0, X); A_STOREV(0, X); A_LOADK(1, X); A_STOREK(1, X);
    __syncthreads();
    f32x16 pA0, pA1, pB0, pB1;
#pragma unroll
    for (int r = 0; r < 16; ++r) { pB0[r] = 0.f; pB1[r] = 0.f; }
    A_QK(pA0, pA1, 0);
#define A_STEP(P0, P1, N0, N1, t, SL, SS) do { \
        A_LOADK((t) + 2, SL); A_LOADV((t) + 1, SL); \
        __builtin_amdgcn_s_setprio(1); A_QK(N0, N1, ((t) + 1) & 1); __builtin_amdgcn_s_setprio(0); \
        float a_ = fmaxf(fmaxf(P0[0], P0[1]), P1[0]), c_ = fmaxf(fmaxf(P0[2], P0[3]), P1[1]); a_ = fmaxf(fmaxf(a_, P1[2]), P1[3]); \
        _Pragma("unroll") for (int r = 4; r < 16; r += 4) { a_ = fmaxf(fmaxf(a_, P0[r]), P0[r + 1]); c_ = fmaxf(fmaxf(c_, P0[r + 2]), P0[r + 3]); a_ = fmaxf(fmaxf(a_, P1[r]), P1[r + 1]); c_ = fmaxf(fmaxf(c_, P1[r + 2]), P1[r + 3]); } \
        const float rm = swapmax32(fmaxf(a_, c_)); \
        if ((t) == 0 || __any(rm > THR)) { \
            const float dl = ((t) == 0) ? rm : fmaxf(rm, 0.f); mhat += dl; \
            _Pragma("unroll") for (int r = 0; r < 16; ++r) { P0[r] -= dl; P1[r] -= dl; N0[r] -= dl; N1[r] -= dl; } \
            if ((t) != 0) { const float f = __builtin_amdgcn_exp2f(-dl); l_run *= f; _Pragma("unroll") for (int r = 0; r < 16; ++r) { o0[r] *= f; o1[r] *= f; } } \
            _Pragma("unroll") for (int r = 0; r < 16; ++r) negm[r] = -mhat; asm volatile("" : "+v"(negm)); } \
        float ls = 0.f; \
        _Pragma("unroll") for (int r = 0; r < 16; ++r) { P0[r] = __builtin_amdgcn_exp2f(P0[r]); P1[r] = __builtin_amdgcn_exp2f(P1[r]); ls += P0[r] + P1[r]; } \
        l_run += ls; \
        u32x4 pw[4]; \
        pw[0] = (u32x4){pk2(P0[0], P0[1]), pk2(P0[2], P0[3]), pk2(P0[4], P0[5]), pk2(P0[6], P0[7])}; \
        pw[1] = (u32x4){pk2(P0[8], P0[9]), pk2(P0[10], P0[11]), pk2(P0[12], P0[13]), pk2(P0[14], P0[15])}; \
        pw[2] = (u32x4){pk2(P1[0], P1[1]), pk2(P1[2], P1[3]), pk2(P1[4], P1[5]), pk2(P1[6], P1[7])}; \
        pw[3] = (u32x4){pk2(P1[8], P1[9]), pk2(P1[10], P1[11]), pk2(P1[12], P1[13]), pk2(P1[14], P1[15])}; \
        { const char* vb_ = lds + ((t) & 1) * VB + vt_off; \
        _Pragma("unroll") for (int s = 0; s < 4; ++s) { const bf16x8 pb = __builtin_bit_cast(bf16x8, pw[s]); \
            _Pragma("unroll") for (int dt = 0; dt < 2; ++dt) { const char* vp = vb_ + s * 16 * VRS + dt * 64; \
                const s16x4 lo = __builtin_bit_cast(s16x4, __builtin_amdgcn_ds_read_tr16_b64_v4i16((LAS s16x4*)vp)); \
                const s16x4 hh = __builtin_bit_cast(s16x4, __builtin_amdgcn_ds_read_tr16_b64_v4i16((LAS s16x4*)(vp + 8 * VRS))); \
                const bf16x8 vf = (bf16x8){lo[0], lo[1], lo[2], lo[3], hh[0], hh[1], hh[2], hh[3]}; \
                if (dt == 0) o0 = __builtin_amdgcn_mfma_f32_32x32x16_bf16(vf, pb, o0, 0, 0, 0); else o1 = __builtin_amdgcn_mfma_f32_32x32x16_bf16(vf, pb, o1, 0, 0, 0); } } } \
        A_STOREK((t) & 1, SS); A_STOREV(((t) + 1) & 1, SS); \
        __syncthreads(); } while (0)
    for (int t = 0; t < NT; t += 2) {
        A_STEP(pA0, pA1, pB0, pB1, t, X, X);
        A_STEP(pB0, pB1, pA0, pA1, t + 1, X, X);
    }
#undef A_STEP
#undef A_QK
#undef A_LOADK
#undef A_LOADV
#undef A_STOREK
#undef A_STOREV
    const float inv = 1.0f / swapsum32(l_run);
    const size_t tok = (size_t)(b * SEQ + q0 + wid * 32 + l31);
#pragma unroll
    for (int dt = 0; dt < 2; ++dt)
#pragma unroll
        for (int g = 0; g < 4; ++g) { const int d = 32 * dt + 8 * g + 4 * hi; const size_t off = tok * 1024 + ocol + d;
            const u32x2 gw = *(const u32x2*)(Gt + off);
            const f32x16& oo = dt ? o1 : o0;
            u32x2 w; w.x = pk2(oo[4 * g] * inv * lo_bf(gw.x), oo[4 * g + 1] * inv * hi_bf(gw.x)); w.y = pk2(oo[4 * g + 2] * inv * lo_bf(gw.y), oo[4 * g + 3] * inv * hi_bf(gw.y));
            *(u32x2*)(OG + off) = w; }
}

DEV void phase_attn(char* lds, const Params& p) {
    const bf16_t* QA = (const bf16_t*)(p.ws + WS_QA); const bf16_t* KA = (const bf16_t*)(p.ws + WS_KA); const bf16_t* VA = (const bf16_t*)(p.ws + WS_VA);
    const bf16_t* QM = (const bf16_t*)(p.ws + WS_QM); const bf16_t* KM = (const bf16_t*)(p.ws + WS2_KM); const bf16_t* VM = (const bf16_t*)(p.ws + WS2_VM);
    const bf16_t* G = (const bf16_t*)(p.ws + WS_G); bf16_t* OG = (bf16_t*)(p.ws + WS2_OG);
    const int vblk = (gridDim.x % 8 == 0) ? (int)((blockIdx.x % 8) * (gridDim.x / 8) + blockIdx.x / 8) : (int)blockIdx.x;
    for (int u = vblk; u < 2048; u += gridDim.x) {
        const int type = u >> 10, rem = u & 1023, b = rem >> 7, h = (rem >> 4) & 7, qb = rem & 15;
        if (type == 0) attn_unit2<64>(lds, QA, 512, h * 64, KA, 128, (h >> 2) * 64, VA, 128, (h >> 2) * 64, G, OG, h * 64, b, qb * 256);
        else attn_unit2<96>(lds, QM, 768, h * 96, KM, 768, h * 96, VM, 512, h * 64, G, OG, 512 + h * 64, b, qb * 256);
    }
}

constexpr int CV_PADL = 192, CV_ROW = 4488, CV_RS = CV_ROW * 2;
constexpr int CV_UB = 8 * CV_RS;
constexpr int CV_FS = 16416;
DEV void conv_load_filter(char* lds, const bf16_t* gr) {
    const int tid = TID();
#pragma unroll
    for (int rnd = 0; rnd < 2; ++rnd) {
        const int ch = tid + rnd * 512;
        const u32x4 a = *(const u32x4*)(gr + ch * 8);
        u32x4 bq = {0u, 0u, 0u, 0u}; if (ch + 1 < 1024) bq = *(const u32x4*)(gr + ch * 8 + 8);
        const unsigned w[8] = {a.x, a.y, a.z, a.w, bq.x, bq.y, bq.z, bq.w};
        char* f = lds + CV_UB + ch * 16;
        *(u32x4*)(f) = a;
        u32x4 c1, c2, c3;
        c1.x = __builtin_amdgcn_alignbit(w[1], w[0], 16); c1.y = __builtin_amdgcn_alignbit(w[2], w[1], 16); c1.z = __builtin_amdgcn_alignbit(w[3], w[2], 16); c1.w = __builtin_amdgcn_alignbit(w[4], w[3], 16);
        c2 = (u32x4){w[1], w[2], w[3], w[4]};
        c3.x = __builtin_amdgcn_alignbit(w[2], w[1], 16); c3.y = __builtin_amdgcn_alignbit(w[3], w[2], 16); c3.z = __builtin_amdgcn_alignbit(w[4], w[3], 16); c3.w = __builtin_amdgcn_alignbit(w[5], w[4], 16);
        *(u32x4*)(f + CV_FS) = c1; *(u32x4*)(f + 2 * CV_FS) = c2; *(u32x4*)(f + 3 * CV_FS) = c3;
    }
}
DEV void sconv4(const bf16_t* px, int t, float w0, float w1, float w2, float bias, float* u) {
    const u32x2 mid = *(const u32x2*)(px + t);
    const float pm = (t > 0) ? bf2f(px[t - 1]) : 0.f, pp = (t + 4 < SEQ) ? bf2f(px[t + 4]) : 0.f;
    const float q0 = lo_bf(mid.x), q1 = hi_bf(mid.x), q2 = lo_bf(mid.y), q3 = hi_bf(mid.y);
    u[0] = w0 * pm + w1 * q0 + w2 * q1 + bias; u[1] = w0 * q0 + w1 * q1 + w2 * q2 + bias; u[2] = w0 * q1 + w1 * q2 + w2 * q3 + bias; u[3] = w0 * q2 + w1 * q3 + w2 * pp + bias;
}
template <bool V0, bool V1>
DEV void conv_step(const char* lds, f32x16 (&acc)[2][2], const int (&a_off)[2], const int (&b_off)[2], int d) {
    bf16x8 fa[2][4];
#pragma unroll
    for (int mt = 0; mt < 2; ++mt)
#pragma unroll
        for (int ks = 0; ks < 4; ++ks) { const char* ap = lds + a_off[mt] - 128 * d + ks * 32;
            const u32x2 lo = *(const u32x2*)ap, hh = *(const u32x2*)(ap + 8);
            fa[mt][ks] = __builtin_bit_cast(bf16x8, (u32x4){lo.x, lo.y, hh.x, hh.y}); }
#pragma unroll
    for (int n = 0; n < 2; ++n) {
        if ((n == 0 && V0) || (n == 1 && V1)) {
#pragma unroll
            for (int ks = 0; ks < 4; ++ks) { const bf16x8 fb = *(const bf16x8*)(lds + b_off[n] - 128 * d + ks * 32);
#pragma unroll
                for (int mt = 0; mt < 2; ++mt) acc[n][mt] = __builtin_amdgcn_mfma_f32_32x32x16_bf16(fa[mt][ks], fb, acc[n][mt], 0, 0, 0); }
        }
    }
}
struct ConvFrags { bf16x8 a[6], b0[4], b1[4]; };
DEV void conv_load_frags(ConvFrags& F, const char* lds, int a_off0, int a_off0h, int b_off0, int b_off1, int d) {
#pragma unroll
    for (int j = 0; j < 6; ++j) { const u32x2 lo = *(const u32x2*)(lds + a_off0 - 128 * d + (j - 2) * 32), hh = *(const u32x2*)(lds + a_off0h - 128 * d + (j - 2) * 32);
        F.a[j] = __builtin_bit_cast(bf16x8, (u32x4){lo.x, lo.y, hh.x, hh.y}); }
#pragma unroll
    for (int ks = 0; ks < 4; ++ks) { F.b0[ks] = *(const bf16x8*)(lds + b_off0 - 128 * d + ks * 32); F.b1[ks] = *(const bf16x8*)(lds + b_off1 - 128 * d + ks * 32); }
}
DEV void conv_mfma_frags(const ConvFrags& F, f32x16 (&acc)[2][2]) {
#pragma unroll
    for (int ks = 0; ks < 4; ++ks) {
        acc[0][0] = __builtin_amdgcn_mfma_f32_32x32x16_bf16(F.a[ks + 2], F.b0[ks], acc[0][0], 0, 0, 0);
        acc[0][1] = __builtin_amdgcn_mfma_f32_32x32x16_bf16(F.a[ks], F.b0[ks], acc[0][1], 0, 0, 0);
        acc[1][0] = __builtin_amdgcn_mfma_f32_32x32x16_bf16(F.a[ks + 2], F.b1[ks], acc[1][0], 0, 0, 0);
        acc[1][1] = __builtin_amdgcn_mfma_f32_32x32x16_bf16(F.a[ks], F.b1[ks], acc[1][1], 0, 0, 0);
    }
}
DEV void conv_mfma_loop(const char* lds, f32x16 (&acc)[2][2], int wid, int lane) {
    const int l31 = lane & 31, hi = lane >> 5;
#pragma unroll
    for (int a = 0; a < 2; ++a)
#pragma unroll
        for (int b = 0; b < 2; ++b)
#pragma unroll
            for (int r = 0; r < 16; ++r) acc[a][b][r] = 0.f;
    int a_off[2];
#pragma unroll
    for (int mt = 0; mt < 2; ++mt) { const int r = l31 + 32 * mt, q = (4 - (r & 3)) & 3; a_off[mt] = CV_UB + q * CV_FS + (4096 - r - q + 8 * hi) * 2; }
    int b_off[2];
#pragma unroll
    for (int n = 0; n < 2; ++n) { const int nt = 2 * wid + n; b_off[n] = (l31 & 7) * CV_RS + (CV_PADL + 64 * (4 * nt + (l31 >> 3)) + 8 * hi) * 2; }
    const int dlo = 8 * wid - 63;
#pragma unroll
    for (int j = 0; j < 4; ++j) conv_step<true, false>(lds, acc, a_off, b_off, dlo + j);
    ConvFrags F0, F1; const int d0 = dlo + 4; int a_hi = a_off[0] + 8; asm volatile("" : "+v"(a_hi));
    conv_load_frags(F0, lds, a_off[0], a_hi, b_off[0], b_off[1], d0);
#pragma unroll 1
    for (int j = 0; j < 31; ++j) { const int d = d0 + 2 * j;
        conv_load_frags(F1, lds, a_off[0], a_hi, b_off[0], b_off[1], d + 1); __builtin_amdgcn_sched_barrier(0);
        conv_mfma_frags(F0, acc); __builtin_amdgcn_sched_barrier(0);
        conv_load_frags(F0, lds, a_off[0], a_hi, b_off[0], b_off[1], d + 2); __builtin_amdgcn_sched_barrier(0);
        conv_mfma_frags(F1, acc); __builtin_amdgcn_sched_barrier(0); }
    conv_mfma_frags(F0, acc);
#pragma unroll
    for (int j = 0; j < 4; ++j) conv_step<false, true>(lds, acc, a_off, b_off, dlo + 67 + j);
}
DEV void conv_unit(char* lds, const Params& p, int c) {
    const int tid = TID(), lane = tid & 63, wid = tid >> 6, l31 = lane & 31, hi = lane >> 5;
    const bf16_t* PT = (const bf16_t*)(p.ws + WS_PT); const bf16_t* GR = (const bf16_t*)(p.ws + WS_GR); const float* ssum = (const float*)(p.ws + WS_SSUM);
    bf16_t* OG2 = (bf16_t*)(p.ws + WS_OG2);
    for (int i = tid; i < 8 * 98; i += 512) { const int b = i / 98, j = i % 98;
        const int e = (j < 48) ? j * 4 : (CV_PADL + SEQ + (j - 48) * 4); *(u32x2*)(lds + b * CV_RS + e * 2) = (u32x2){0u, 0u}; }
    { const float w0 = p.conv_w[c], w1 = p.conv_w[3072 + c], w2 = p.conv_w[6144 + c], bias = p.conv_b[c];
        for (int i = tid; i < 8 * 1024; i += 512) { const int b = i >> 10, t = (i & 1023) * 4; float u[4];
            sconv4(PT + ((size_t)(b * 4096 + c)) * 4096, t, w0, w1, w2, bias, u);
            u32x2 w; w.x = pk2(u[0], u[1]); w.y = pk2(u[2], u[3]); *(u32x2*)(lds + b * CV_RS + (CV_PADL + t) * 2) = w; } }
    conv_load_filter(lds, GR + (size_t)c * 8192);
    __syncthreads();
    f32x16 acc[2][2];
    conv_mfma_loop(lds, acc, wid, lane);
    __syncthreads();
    { const float invs = 1.0f / ssum[c], sk = p.skip[c];
        const float w0 = p.conv_w[1024 + c], w1 = p.conv_w[3072 + 1024 + c], w2 = p.conv_w[6144 + 1024 + c], bias = p.conv_b[1024 + c];
        const int b = l31 & 7;
#pragma unroll
        for (int n = 0; n < 2; ++n) { const int i = 4 * (2 * wid + n) + (l31 >> 3);
#pragma unroll
            for (int mt = 0; mt < 2; ++mt)
#pragma unroll
                for (int g = 0; g < 4; ++g) { const int t = 64 * i + 32 * mt + 8 * g + 4 * hi; float x1[4];
                    sconv4(PT + ((size_t)(b * 4096 + 1024 + c)) * 4096, t, w0, w1, w2, bias, x1);
                    char* up = lds + b * CV_RS + (CV_PADL + t) * 2; const u32x2 vw = *(const u32x2*)up;
                    const float z0 = x1[0] * (acc[n][mt][4 * g] * invs + sk * lo_bf(vw.x)), z1 = x1[1] * (acc[n][mt][4 * g + 1] * invs + sk * hi_bf(vw.x));
                    const float z2 = x1[2] * (acc[n][mt][4 * g + 2] * invs + sk * lo_bf(vw.y)), z3 = x1[3] * (acc[n][mt][4 * g + 3] * invs + sk * hi_bf(vw.y));
                    u32x2 w; w.x = pk2(z0, z1); w.y = pk2(z2, z3); *(u32x2*)up = w; } } }
    conv_load_filter(lds, GR + (size_t)(1024 + c) * 8192);
    __syncthreads();
    conv_mfma_loop(lds, acc, wid, lane);
    { const float invs = 1.0f / ssum[1024 + c], sk = p.skip[1024 + c];
        const float w0 = p.conv_w[2048 + c], w1 = p.conv_w[3072 + 2048 + c], w2 = p.conv_w[6144 + 2048 + c], bias = p.conv_b[2048 + c];
        const int b = l31 & 7;
#pragma unroll
        for (int n = 0; n < 2; ++n) { const int i = 4 * (2 * wid + n) + (l31 >> 3);
#pragma unroll
            for (int mt = 0; mt < 2; ++mt)
#pragma unroll
                for (int g = 0; g < 4; ++g) { const int t = 64 * i + 32 * mt + 8 * g + 4 * hi; float x2[4];
                    sconv4(PT + ((size_t)(b * 4096 + 2048 + c)) * 4096, t, w0, w1, w2, bias, x2);
                    const u32x2 zw = *(const u32x2*)(lds + b * CV_RS + (CV_PADL + t) * 2);
                    const u32x2 gw = *(const u32x2*)(PT + ((size_t)(b * 4096 + 3072 + c)) * 4096 + t);
                    const float y0 = x2[0] * (acc[n][mt][4 * g] * invs + sk * lo_bf(zw.x)) * silu(lo_bf(gw.x)), y1 = x2[1] * (acc[n][mt][4 * g + 1] * invs + sk * hi_bf(zw.x)) * silu(hi_bf(gw.x));
                    const float y2 = x2[2] * (acc[n][mt][4 * g + 2] * invs + sk * lo_bf(zw.y)) * silu(lo_bf(gw.y)), y3 = x2[3] * (acc[n][mt][4 * g + 3] * invs + sk * hi_bf(zw.y)) * silu(hi_bf(gw.y));
                    u32x2 w; w.x = pk2(y0, y1); w.y = pk2(y2, y3); *(u32x2*)(OG2 + ((size_t)(b * 1024 + c)) * 4096 + t) = w; } } }
    __syncthreads();
}

struct Raw3 { u32x2 mid; unsigned halo; };
DEV Raw3 ld_raw3(const bf16_t* px, int t) {
    Raw3 r; r.mid = *(const u32x2*)(px + t);
    const unsigned a = px[t - 1], b = px[t + 4];
    r.halo = (t > 0 ? a : 0u) | ((t + 4 < SEQ ? b : 0u) << 16);
    return r;
}
DEV void sconv_raw(const Raw3& r, float w0, float w1, float w2, float bias, float* u) {
    const float pm = lo_bf(r.halo), pp = hi_bf(r.halo), q0 = lo_bf(r.mid.x), q1 = hi_bf(r.mid.x), q2 = lo_bf(r.mid.y), q3 = hi_bf(r.mid.y);
    u[0] = w0 * pm + w1 * q0 + w2 * q1 + bias; u[1] = w0 * q0 + w1 * q1 + w2 * q2 + bias; u[2] = w0 * q1 + w1 * q2 + w2 * q3 + bias; u[3] = w0 * q2 + w1 * q3 + w2 * pp + bias;
}
struct FiltRegs { u32x4 a[2], b[2]; };
DEV void filt_load(FiltRegs& f, const bf16_t* gr, int tid) {
#pragma unroll
    for (int rnd = 0; rnd < 2; ++rnd) { const int ch = tid + rnd * 512; f.a[rnd] = *(const u32x4*)(gr + ch * 8);
        const int ch1 = ch + 1 < 1024 ? ch + 1 : ch; const u32x4 t = *(const u32x4*)(gr + ch1 * 8); f.b[rnd] = (ch + 1 < 1024) ? t : (u32x4){0u, 0u, 0u, 0u}; }
}
DEV void filt_store(char* lds, const FiltRegs& f, int tid) {
#pragma unroll
    for (int rnd = 0; rnd < 2; ++rnd) { const int ch = tid + rnd * 512; const u32x4 a = f.a[rnd], bq = f.b[rnd];
        const unsigned w[8] = {a.x, a.y, a.z, a.w, bq.x, bq.y, bq.z, bq.w};
        char* fp = lds + CV_UB + ch * 16;
        *(u32x4*)(fp) = a;
        u32x4 c1, c2, c3;
        c1.x = __builtin_amdgcn_alignbit(w[1], w[0], 16); c1.y = __builtin_amdgcn_alignbit(w[2], w[1], 16); c1.z = __builtin_amdgcn_alignbit(w[3], w[2], 16); c1.w = __builtin_amdgcn_alignbit(w[4], w[3], 16);
        c2 = (u32x4){w[1], w[2], w[3], w[4]};
        c3.x = __builtin_amdgcn_alignbit(w[2], w[1], 16); c3.y = __builtin_amdgcn_alignbit(w[3], w[2], 16); c3.z = __builtin_amdgcn_alignbit(w[4], w[3], 16); c3.w = __builtin_amdgcn_alignbit(w[5], w[4], 16);
        *(u32x4*)(fp + CV_FS) = c1; *(u32x4*)(fp + 2 * CV_FS) = c2; *(u32x4*)(fp + 3 * CV_FS) = c3; }
}
#define CV_T(k) (64 * (4 * (2 * wid + ((k) >> 3)) + (l31 >> 3)) + 32 * (((k) >> 2) & 1) + 8 * ((k) & 3) + 4 * hi)
#define CV_LANE_IDS() int tid = TID(); asm volatile("" : "+v"(tid));   \
    const int lane = tid & 63, wid = __builtin_amdgcn_readfirstlane(tid >> 6), l31 = lane & 31, hi = lane >> 5, eb = l31 & 7; (void)eb; (void)hi; (void)wid
DEV void conv_stage_load(char* lds, const Params& p, int c) {
    CV_LANE_IDS();
    const bf16_t* PT = (const bf16_t*)(p.ws + WS_PT); const bf16_t* GR = (const bf16_t*)(p.ws + WS_GR);
    FiltRegs f0; filt_load(f0, GR + (size_t)c * 8192, tid);
    Raw3 ru[16];
#pragma unroll
    for (int k = 0; k < 16; ++k) { const int i = tid + k * 512, b = i >> 10, t = (i & 1023) * 4; ru[k] = ld_raw3(PT + ((size_t)(b * 4096 + c)) * 4096, t); }
    for (int i = tid; i < 8 * 98; i += 512) { const int b = i / 98, j = i % 98;
        const int e = (j < 48) ? j * 4 : (CV_PADL + SEQ + (j - 48) * 4); *(u32x2*)(lds + b * CV_RS + e * 2) = (u32x2){0u, 0u}; }
    const float w0 = p.conv_w[c], w1 = p.conv_w[3072 + c], w2 = p.conv_w[6144 + c], bias = p.conv_b[c];
#pragma unroll
    for (int k = 0; k < 16; ++k) { const int i = tid + k * 512, b = i >> 10, t = (i & 1023) * 4; float u[4]; sconv_raw(ru[k], w0, w1, w2, bias, u);
        u32x2 w; w.x = pk2(u[0], u[1]); w.y = pk2(u[2], u[3]); *(u32x2*)(lds + b * CV_RS + (CV_PADL + t) * 2) = w; }
    filt_store(lds, f0, tid);
}
DEV void conv_stage_epi0(char* lds, const Params& p, int c, const f32x16 (&acc)[2][2]) {
    CV_LANE_IDS();
    const bf16_t* PT = (const bf16_t*)(p.ws + WS_PT); const bf16_t* GR = (const bf16_t*)(p.ws + WS_GR); const float* ssum = (const float*)(p.ws + WS_SSUM);
    FiltRegs f1; filt_load(f1, GR + (size_t)(1024 + c) * 8192, tid);
    const bf16_t* px1 = PT + ((size_t)(eb * 4096 + 1024 + c)) * 4096;
    Raw3 r1[16];
#pragma unroll
    for (int k = 0; k < 16; ++k) r1[k] = ld_raw3(px1, CV_T(k));
    const float a0 = p.conv_w[1024 + c], a1 = p.conv_w[3072 + 1024 + c], a2 = p.conv_w[6144 + 1024 + c], ab = p.conv_b[1024 + c];
    const float invs = 1.0f / ssum[c], sk = p.skip[c];
#pragma unroll
    for (int k = 0; k < 16; ++k) { const int n = k >> 3, mt = (k >> 2) & 1, g = k & 3; const int t = CV_T(k);
        float x1[4]; sconv_raw(r1[k], a0, a1, a2, ab, x1);
        char* up = lds + eb * CV_RS + (CV_PADL + t) * 2; const u32x2 vw = *(const u32x2*)up;
        const float z0 = x1[0] * (acc[n][mt][4 * g] * invs + sk * lo_bf(vw.x)), z1 = x1[1] * (acc[n][mt][4 * g + 1] * invs + sk * hi_bf(vw.x));
        const float z2 = x1[2] * (acc[n][mt][4 * g + 2] * invs + sk * lo_bf(vw.y)), z3 = x1[3] * (acc[n][mt][4 * g + 3] * invs + sk * hi_bf(vw.y));
        u32x2 w; w.x = pk2(z0, z1); w.y = pk2(z2, z3); *(u32x2*)up = w; }
    filt_store(lds, f1, tid);
}
DEV void conv_stage_epi1(char* lds, const Params& p, int c, const f32x16 (&acc)[2][2]) {
    CV_LANE_IDS();
    const bf16_t* PT = (const bf16_t*)(p.ws + WS_PT); const float* ssum = (const float*)(p.ws + WS_SSUM); bf16_t* OG2 = (bf16_t*)(p.ws + WS_OG2);
    const bf16_t* px2 = PT + ((size_t)(eb * 4096 + 2048 + c)) * 4096; const bf16_t* pg = PT + ((size_t)(eb * 4096 + 3072 + c)) * 4096;
    Raw3 r2[16]; u32x2 rg[16];
#pragma unroll
    for (int k = 0; k < 16; ++k) { r2[k] = ld_raw3(px2, CV_T(k)); rg[k] = *(const u32x2*)(pg + CV_T(k)); }
    const float b0 = p.conv_w[2048 + c], b1 = p.conv_w[3072 + 2048 + c], b2 = p.conv_w[6144 + 2048 + c], bb = p.conv_b[2048 + c];
    const float invs = 1.0f / ssum[1024 + c], sk = p.skip[1024 + c];
#pragma unroll
    for (int k = 0; k < 16; ++k) { const int n = k >> 3, mt = (k >> 2) & 1, g = k & 3; const int t = CV_T(k);
        float x2[4]; sconv_raw(r2[k], b0, b1, b2, bb, x2);
        const u32x2 zw = *(const u32x2*)(lds + eb * CV_RS + (CV_PADL + t) * 2);
        const float y0 = x2[0] * silu(lo_bf(rg[k].x)) * (acc[n][mt][4 * g] * invs + sk * lo_bf(zw.x)), y1 = x2[1] * silu(hi_bf(rg[k].x)) * (acc[n][mt][4 * g + 1] * invs + sk * hi_bf(zw.x));
        const float y2 = x2[2] * silu(lo_bf(rg[k].y)) * (acc[n][mt][4 * g + 2] * invs + sk * lo_bf(zw.y)), y3 = x2[3] * silu(hi_bf(rg[k].y)) * (acc[n][mt][4 * g + 3] * invs + sk * hi_bf(zw.y));
        u32x2 w; w.x = pk2(y0, y1); w.y = pk2(y2, y3); *(u32x2*)(OG2 + ((size_t)(eb * 1024 + c)) * 4096 + t) = w; }
}
DEV void conv_stage_mfma(const char* lds, f32x16 (&acc)[2][2]) { CV_LANE_IDS(); conv_mfma_loop(lds, acc, wid, lane); }
DEV void conv_unit2(char* lds, const Params& p, int c) {
    conv_stage_load(lds, p, c);
    __syncthreads();
    f32x16 acc[2][2];
    conv_stage_mfma(lds, acc);
    __syncthreads();
    conv_stage_epi0(lds, p, c, acc);
    __syncthreads();
    conv_stage_mfma(lds, acc);
    conv_stage_epi1(lds, p, c, acc);
    __syncthreads();
}
#undef CV_T
#undef CV_LANE_IDS

struct cf { float x, y; };
DEV cf cadd(cf a, cf b) { return cf{a.x + b.x, a.y + b.y}; }
DEV cf csub(cf a, cf b) { return cf{a.x - b.x, a.y - b.y}; }
DEV cf cmul(cf a, cf b) { return cf{a.x * b.x - a.y * b.y, a.x * b.y + a.y * b.x}; }
template <int M> DEV cf mulw16(cf a) {
    if constexpr (M == 0) return a;
    else if constexpr (M == 4) return cf{a.y, -a.x};
    else if constexpr (M == 2) return cf{(a.x + a.y) * 0.70710678118654752f, (a.y - a.x) * 0.70710678118654752f};
    else if constexpr (M == 6) return cf{(a.y - a.x) * 0.70710678118654752f, -(a.x + a.y) * 0.70710678118654752f};
    else { constexpr float c = (M == 1) ? 0.92387953251128674f : (M == 3) ? 0.38268343236508977f : (M == 5) ? -0.38268343236508977f : -0.92387953251128674f;
           constexpr float sn = (M == 1) ? -0.38268343236508977f : (M == 3) ? -0.92387953251128674f : (M == 5) ? -0.92387953251128674f : -0.38268343236508977f;
           return cf{a.x * c - a.y * sn, a.x * sn + a.y * c}; }
}
template <int HALF, int BLK, int J> DEV void dif_bfly(cf (&v)[16]) { const cf a = v[BLK + J], b = v[BLK + J + HALF]; v[BLK + J] = cadd(a, b); v[BLK + J + HALF] = mulw16<J * (8 / HALF)>(csub(a, b)); }
DEV void dft16(cf (&v)[16]) {
#define B8(j) dif_bfly<8, 0, j>(v)
    B8(0); B8(1); B8(2); B8(3); B8(4); B8(5); B8(6); B8(7);
#undef B8
#define B4(b, j) dif_bfly<4, b, j>(v)
    B4(0, 0); B4(0, 1); B4(0, 2); B4(0, 3); B4(8, 0); B4(8, 1); B4(8, 2); B4(8, 3);
#undef B4
#define B2(b, j) dif_bfly<2, b, j>(v)
    B2(0, 0); B2(0, 1); B2(4, 0); B2(4, 1); B2(8, 0); B2(8, 1); B2(12, 0); B2(12, 1);
#undef B2
#define B1(b) dif_bfly<1, b, 0>(v)
    B1(0); B1(2); B1(4); B1(6); B1(8); B1(10); B1(12); B1(14);
#undef B1
}
#define FFT_BR4(k) ((((k) & 1) << 3) | (((k) & 2) << 1) | (((k) & 4) >> 1) | (((k) & 8) >> 3))
constexpr int FF_BUF = (8192 + 512) * 8;
DEV int ffp(int idx) { return (idx + (idx >> 4)) * 8; }
struct FftTw { cf t3[16]; };
constexpr int FF_T2 = 2 * FF_BUF;
DEV void fft_twiddles(FftTw& T, char* lds, int tid) {
    if (tid < 240) { const int k = tid / 15, r = tid % 15 + 1; float sn, cs; sincospif(-(float)(k * r) * (1.0f / 128.0f), &sn, &cs); *(cf*)(lds + FF_T2 + tid * 8) = cf{cs, sn}; }
    __syncthreads();
    { const int i3 = tid & 255, h = tid >> 8; float sn, cs; sincospif(-(float)i3 * (1.0f / 4096.0f), &sn, &cs); const cf w1 = cf{cs, sn}; const cf w2 = cmul(w1, w1);
        cf t = h ? w1 : cf{1.f, 0.f};
#pragma unroll
        for (int sx = 0; sx < 16; ++sx) { T.t3[sx] = t; t = cmul(t, w2); } }
}
DEV void fft_pass23(char* A, char* B, const char* tw2, int tid, const FftTw& T) {
    asm volatile("" : "+v"(tid));
    cf v[16];
    {
        const int i = tid, k = i & 15;
        { const char* rb = A + ffp(i);
#pragma unroll
        for (int r = 0; r < 16; ++r) v[r] = *(const cf*)(rb + 4352 * r); }
#pragma unroll
        for (int r = 1; r < 16; ++r) v[r] = cmul(v[r], *(const cf*)(tw2 + k * 120 + (r - 1) * 8));
        dft16(v);
        const int j = ((i >> 4) << 8) + k;
        { char* wb = B + (j + 16 * (i >> 4)) * 8;
#pragma unroll
        for (int r = 0; r < 16; ++r) *(cf*)(wb + 136 * r) = v[FFT_BR4(r)]; }
        __syncthreads();
    }
    {
        const int i3 = tid & 255, h = tid >> 8;
        const char* rb3 = B + ffp(i3) + 2176 * h;
#pragma unroll
        for (int sx = 0; sx < 16; ++sx) v[sx] = *(const cf*)(rb3 + 4352 * sx);
#pragma unroll
        for (int sx = 0; sx < 16; ++sx) v[sx] = cmul(v[sx], T.t3[sx]);
        dft16(v);
        if (h) {
            const float c32[16] = {1.f, 0.98078528040323043f, 0.92387953251128674f, 0.83146961230254524f, 0.70710678118654752f, 0.55557023301960218f, 0.38268343236508977f, 0.19509032201612825f,
                                   0.f, -0.19509032201612825f, -0.38268343236508977f, -0.55557023301960218f, -0.70710678118654752f, -0.83146961230254524f, -0.92387953251128674f, -0.98078528040323043f};
            const float s32[16] = {0.f, -0.19509032201612825f, -0.38268343236508977f, -0.55557023301960218f, -0.70710678118654752f, -0.83146961230254524f, -0.92387953251128674f, -0.98078528040323043f,
                                   -1.f, -0.98078528040323043f, -0.92387953251128674f, -0.83146961230254524f, -0.70710678118654752f, -0.55557023301960218f, -0.38268343236508977f, -0.19509032201612825f};
#pragma unroll
            for (int m = 0; m < 16; ++m) { const cf x = v[FFT_BR4(m)]; v[FFT_BR4(m)] = cf{x.x * c32[m] - x.y * s32[m], x.x * s32[m] + x.y * c32[m]}; }
        }
        { char* wb3 = A + ffp(i3) + 34816 * h;
#pragma unroll
        for (int m = 0; m < 16; ++m) *(cf*)(wb3 + 2176 * m) = v[FFT_BR4(m)]; }
        __syncthreads();
    }
}
DEV void fft_pass1_store(char* D, cf (&v)[16], int tid) {
    dft16(v);
    { char* wb = D + 136 * tid;
#pragma unroll
    for (int r = 0; r < 16; ++r) *(cf*)(wb + 8 * r) = v[FFT_BR4(r)]; }
    __syncthreads();
}
constexpr size_t WS_CVIN = WS_H1;
DEV void fftconv_unit(char* lds, const Params& p, int c, const FftTw& T) {
    int tid = TID(); asm volatile("" : "+v"(tid));
    char* D0 = lds; char* D1 = lds + FF_BUF;
    const bf16_t* PT = (const bf16_t*)(p.ws + WS_PT); const bf16_t* GR = (const bf16_t*)(p.ws + WS_GR); const float* ssum = (const float*)(p.ws + WS_SSUM);
    bf16_t* OG2 = (bf16_t*)(p.ws + WS_OG2); float* IN = (float*)(p.ws + WS_CVIN) + (size_t)blockIdx.x * (8 * 4096);
    { const float w0 = p.conv_w[c], w1 = p.conv_w[3072 + c], w2 = p.conv_w[6144 + c], bias = p.conv_b[c];
#pragma unroll 2
        for (int k = 0; k < 8; ++k) { const int i = tid + k * 512, b = i >> 9, n0 = (i & 511) * 8;
            const bf16_t* px = PT + ((size_t)(b * 4096 + c)) * 4096;
            float q[10]; { const u32x4 m = *(const u32x4*)(px + n0); unpack8(m, q + 1); q[0] = (n0 > 0) ? bf2f(px[n0 - 1]) : 0.f; q[9] = (n0 + 8 < SEQ) ? bf2f(px[n0 + 8]) : 0.f; }
            f32x4 o0, o1;
#pragma unroll
            for (int e = 0; e < 4; ++e) { o0[e] = w0 * q[e] + w1 * q[e + 1] + w2 * q[e + 2] + bias; o1[e] = w0 * q[e + 4] + w1 * q[e + 5] + w2 * q[e + 6] + bias; }
            *(f32x4*)(IN + b * 4096 + n0) = o0; *(f32x4*)(IN + b * 4096 + n0 + 4) = o1; } }
    __syncthreads();
#pragma unroll 1
    for (int o = 0; o < 2; ++o) {
        cf KS[16];
        asm volatile("" : "+v"(tid));
        { const bf16_t* g = GR + (size_t)(o * 1024 + c) * 8192; const float invs = 1.0f / ssum[o * 1024 + c];
            cf v[16];
#pragma unroll
            for (int r = 0; r < 16; ++r) { const int n = tid + 512 * r; v[r] = cf{bf2f(g[(12288 - n) & 8191]) * invs, 0.f}; }
            fft_pass1_store(D0, v, tid);
            fft_pass23(D0, D1, lds + FF_T2, tid, T);
#pragma unroll
            for (int q = 0; q < 8; ++q) { const cf a = *(const cf*)(D0 + ffp(tid) + 4352 * q), b = *(const cf*)(D0 + ffp(tid) + 4352 * q + 34816); KS[q] = cadd(a, b); KS[q + 8] = csub(a, b); }
            __syncthreads(); }
        const float sk = p.skip[o * 1024 + c];
        const int part = (o == 0) ? 1024 : 2048;
        const float w0 = p.conv_w[part + c], w1 = p.conv_w[3072 + part + c], w2 = p.conv_w[6144 + part + c], bias = p.conv_b[part + c];
        cf vin[8];
#pragma unroll
        for (int r = 0; r < 8; ++r) vin[r] = cf{IN[tid + 512 * r], IN[4096 + tid + 512 * r]};
#pragma unroll 1
        for (int pr = 0; pr < 4; ++pr) {
            asm volatile("" : "+v"(tid));
            const int n0 = 8 * tid;
            u32x4 eraw[2], egate[2]; f32x4 eu[2][2]; unsigned ehalo[2];
#pragma unroll
            for (int hb = 0; hb < 2; ++hb) { const int b = 2 * pr + hb; const bf16_t* px = PT + ((size_t)(b * 4096 + part + c)) * 4096;
                eraw[hb] = *(const u32x4*)(px + n0);
                const unsigned ha = px[n0 - 1], hz = px[n0 + 8];
                ehalo[hb] = ((n0 > 0) ? ha : 0u) | (((n0 + 8 < SEQ) ? hz : 0u) << 16);
                eu[hb][0] = *(const f32x4*)(IN + b * 4096 + n0); eu[hb][1] = *(const f32x4*)(IN + b * 4096 + n0 + 4);
                egate[hb] = (o == 1) ? *(const u32x4*)(PT + ((size_t)(b * 4096 + 3072 + c)) * 4096 + n0) : (u32x4){0u, 0u, 0u, 0u}; }
            {
                cf v[16];
#pragma unroll
                for (int r = 0; r < 8; ++r) v[r] = vin[r];
#pragma unroll
                for (int r = 8; r < 16; ++r) v[r] = cf{0.f, 0.f};
                fft_pass1_store(D0, v, tid);
                fft_pass23(D0, D1, lds + FF_T2, tid, T);
            }
            {
                const int pn = (pr < 3) ? pr + 1 : pr; const float* ina = IN + (2 * pn) * 4096;
#pragma unroll
                for (int r = 0; r < 8; ++r) vin[r] = cf{ina[tid + 512 * r], ina[4096 + tid + 512 * r]};
            }
            {
                cf v[16];
#pragma unroll
                for (int q = 0; q < 8; ++q) { const cf a = *(const cf*)(D0 + ffp(tid) + 4352 * q), b = *(const cf*)(D0 + ffp(tid) + 4352 * q + 34816);
                    const cf x0 = cmul(cadd(a, b), KS[q]), x1 = cmul(csub(a, b), KS[q + 8]);
                    v[q] = cf{x0.x, -x0.y}; v[q + 8] = cf{x1.x, -x1.y}; }
                fft_pass1_store(D1, v, tid);
                fft_pass23(D1, D0, lds + FF_T2, tid, T);
            }
            {
                float ya[8], yb[8];
#pragma unroll
                for (int e = 0; e < 8; ++e) { const cf a = *(const cf*)(D1 + 64 * tid + 8 * (tid >> 1) + 8 * e), b = *(const cf*)(D1 + 64 * tid + 8 * (tid >> 1) + 8 * e + 34816); ya[e] = (a.x + b.x) * (1.0f / 8192.0f); yb[e] = -(a.y + b.y) * (1.0f / 8192.0f); }
#pragma unroll
                for (int hb = 0; hb < 2; ++hb) { const int b = 2 * pr + hb; float* inp = IN + b * 4096 + n0; const float* yy = hb ? yb : ya;
                    float q[10]; unpack8(eraw[hb], q + 1); q[0] = lo_bf(ehalo[hb]); q[9] = hi_bf(ehalo[hb]);
                    const f32x4 u0 = eu[hb][0], u1 = eu[hb][1]; const float uu[8] = {u0.x, u0.y, u0.z, u0.w, u1.x, u1.y, u1.z, u1.w};
                    float z[8];
#pragma unroll
                    for (int e = 0; e < 8; ++e) { const float xc = w0 * q[e] + w1 * q[e + 1] + w2 * q[e + 2] + bias; z[e] = xc * (yy[e] + sk * uu[e]); }
                    if (o == 0) { *(f32x4*)inp = (f32x4){z[0], z[1], z[2], z[3]}; *(f32x4*)(inp + 4) = (f32x4){z[4], z[5], z[6], z[7]}; }
                    else { float gg[8]; unpack8(egate[hb], gg);
#pragma unroll
                        for (int e = 0; e < 8; ++e) z[e] *= silu(gg[e]);
                        *(u32x4*)(OG2 + ((size_t)(b * 1024 + c)) * 4096 + n0) = pack8(z); } }
            }
        }
        __syncthreads();
    }
}

#define XB_TMO      128
#define XB_XCNT(j)  (256  + 64 * (j))
#define XB_XSUB(j)  (1280 + 64 * (j))
#define XB_XGEN(j)  (2304 + 64 * (j))
#define XB_TOP      3328
#define XB_TOPGEN   3392
#define XCD_BAR_WORDS 3456
#define XB_SPIN_CAP (1u << 20)
DEV unsigned xb_ld(unsigned* p) { return __hip_atomic_load(p, __ATOMIC_RELAXED, __HIP_MEMORY_SCOPE_AGENT); }
DEV unsigned xb_add(unsigned* p, unsigned v) { return __hip_atomic_fetch_add(p, v, __ATOMIC_RELAXED, __HIP_MEMORY_SCOPE_AGENT); }
DEV unsigned xb_xcc_id() { return (unsigned)__builtin_amdgcn_s_getreg((3 << 11) | 20) & 0xFu; }
#define XB_SPIN(cond, bar) do { unsigned _sp = 0; while (cond) { __builtin_amdgcn_s_sleep(1); \
    if ((++_sp & 255u) == 0u) { if (xb_ld(&(bar)[XB_TMO])) break; if (_sp > XB_SPIN_CAP) { atomicAdd(&(bar)[XB_TMO], 1u); break; } } } } while (0)
struct XcdBarrier { unsigned* bar; unsigned x; volatile LAS unsigned* st; };
DEV XcdBarrier xcd_barrier_post(unsigned* bar, volatile LAS unsigned* st) {
    XcdBarrier b; b.bar = bar; b.x = xb_xcc_id(); b.st = st;
    if (TID() == 0) (void)xb_add(&bar[XB_XCNT(b.x)], 1u);
    return b;
}
DEV void xcd_barrier_complete(unsigned* bar, unsigned x, unsigned& nloc, unsigned& nx) {
    const unsigned G = gridDim.x * gridDim.y * gridDim.z;
    unsigned sum, cnt, mine, sp = 0u;
    for (;;) {
        sum = 0u; cnt = 0u; mine = 0u;
#pragma unroll
        for (unsigned j = 0; j < 16; ++j) { const unsigned c = xb_ld(&bar[XB_XCNT(j)]); sum += c; cnt += (c > 0u) ? 1u : 0u; mine = (j == x) ? c : mine; }
        if (sum == G) break;
        __builtin_amdgcn_s_sleep(1);
        if ((++sp & 255u) == 0u) { if (xb_ld(&bar[XB_TMO])) break; if (sp > XB_SPIN_CAP) { atomicAdd(&bar[XB_TMO], 1u); break; } }
    }
    nloc = mine > 0u ? mine : 1u; nx = cnt > 0u ? cnt : 1u;
}
DEV void xcd_barrier(const XcdBarrier& b) {
    asm volatile("s_waitcnt vmcnt(0)" ::: "memory");
    __syncthreads();
    if (TID() == 0) {
        unsigned* bar = b.bar;
        __builtin_amdgcn_s_waitcnt(0);
        unsigned nloc = b.st[0], nx = b.st[1];
        if (nloc == 0u) { xcd_barrier_complete(bar, b.x, nloc, nx); b.st[0] = nloc; b.st[1] = nx; }
        const unsigned old = xb_add(&bar[XB_XSUB(b.x)], 1u);
        const unsigned gen = old / nloc;
        if (old + 1u == (gen + 1u) * nloc) {
            __builtin_amdgcn_fence(__ATOMIC_RELEASE, "agent");
            asm volatile("s_waitcnt vmcnt(0)" ::: "memory");
            const unsigned og = xb_add(&bar[XB_TOP], 1u);
            const unsigned tg = og / nx;
            if (og + 1u == (tg + 1u) * nx) xb_add(&bar[XB_TOPGEN], 1u);
            else XB_SPIN(xb_ld(&bar[XB_TOPGEN]) == tg, bar);
            __builtin_amdgcn_fence(__ATOMIC_ACQUIRE, "agent");
            xb_add(&bar[XB_XGEN(b.x)], 1u);
            asm volatile("s_waitcnt vmcnt(0)" ::: "memory");
        } else {
            XB_SPIN(xb_ld(&bar[XB_XGEN(b.x)]) == gen, bar);
            __builtin_amdgcn_fence(__ATOMIC_ACQUIRE, "agent");
            asm volatile("s_waitcnt vmcnt(0)" ::: "memory");
        }
    }
    __syncthreads();
}

constexpr int NPHASE = 12;
__global__ void __launch_bounds__(512) fwd_kernel(Params p) {
    char* lds = lds_dyn;
    char* ws = p.ws;
    volatile LAS unsigned* bst = (volatile LAS unsigned*)(LAS char*)(lds + LDS_BYTES - 64);
    { const int t0 = threadIdx.x;
        if (t0 < 16) bst[t0] = 0u;
        if ((t0 & 63) == 0) *(volatile LAS int*)(LAS char*)(lds + LDS_WTAB + 4 * hw_slot()) = t0 >> 6; }
    __syncthreads();
    if (MK_LAUNCHES == 1) (void)xcd_barrier_post((unsigned*)(ws + WS_CTL), bst);
    if (MK_LAUNCHES == 1 && p.ph_hi > NPHASE) cg::this_grid().sync();
#define SEAM(k) do { if (MK_LAUNCHES == 1 && (k) + 1 < p.ph_hi) { XcdBarrier xb_; xb_.bar = (unsigned*)(p.ws + WS_CTL); xb_.x = xb_xcc_id(); xb_.st = (volatile LAS unsigned*)(LAS char*)(lds + LDS_BYTES - 64); xcd_barrier(xb_); } } while (0)
#ifndef PHASE_MASK
#define PHASE_MASK 0xFFF
#endif
#define IN(k) (((PHASE_MASK >> (k)) & 1) && p.ph_lo <= (k) && (k) < p.ph_hi)
#define REP(k) for (int rep_ = 0; rep_ < ((PROBE_REPEAT == (k)) ? 2 : 1); ++rep_)
    if (IN(0)) { REP(0) phase_prep(lds, p); SEAM(0); }
    if (IN(1)) {
        for (int rep_ = 0; rep_ < ((PROBE_REPEAT == 21) ? 2 : 1); ++rep_) {
        const bool dummy = (PROBE_REPEAT == 21 && rep_ == 0);
        EpiFilt ef{(bf16_t*)(ws + (dummy ? WS_PRAW : WS_GR)), p.f_b3};
        gemm_phase<false, EpiFilt>(lds, (const bf16_t*)(ws + WS_W3), 64, (const bf16_t*)(ws + WS_HID2), 64, 4096, 4096, 64, ef); }
        REP(1) phase_norm0(p); SEAM(1); }
    if (IN(2)) {
        REP(2) { pg8::Gemm g{(const bf16_t*)(ws + WS_H0), (const bf16_t*)(ws + WS_WIN), NALL, AINP, DM}; pg8::StaticOrder S; S.init(NALL, AINP, (int)gridDim.x, (int)blockIdx.x);
            pg8::EpiBf16 E{(bf16_t*)(ws + WS_PRAW), (size_t)AINP, 0, 0};
            pg8::gemm_phase<pg8::EpiBf16, pg8::StaticOrder, true, true>((PG8_LAS unsigned char*)lds, g, S, E); }
        SEAM(2); }
    if (IN(3)) { filt_sums(p); REP(3) phase_post(p); SEAM(3); }
    if (IN(4)) {
        const float* rp = (const float*)(ws + WS_ROPE);
        REP(4) {
        { pg8::Gemm g{(const bf16_t*)(ws + WS_CQN), (const bf16_t*)(ws + WS_WUQ), NTOK, 768, 256}; pg8::StaticOrder S; S.init(NTOK, 768, (int)gridDim.x, (int)blockIdx.x);
            pg8::EpiUqPg E{(bf16_t*)(ws + WS_QM), rp + 2048, rp + 2560, QSC_M};
            pg8::gemm_phase<pg8::EpiUqPg, pg8::StaticOrder, true, true>((PG8_LAS unsigned char*)lds, g, S, E); }
        int opq_ = 0; asm volatile("" : "+s"(opq_));
        if (opq_ == 0) { pg8::Gemm g{(const bf16_t*)(ws + WS_CKVN), (const bf16_t*)(ws + WS_WUKV), NALL, 1024, 128}; pg8::StaticOrder S; S.init(NALL, 1024, (int)gridDim.x, (int)blockIdx.x);
            pg8::EpiUkvPg E{(bf16_t*)(ws + WS2_KM), (bf16_t*)(ws + WS2_VM)};
            pg8::gemm_phase<pg8::EpiUkvPg, pg8::StaticOrder, true, true>((PG8_LAS unsigned char*)lds, g, S, E); } }
        SEAM(4); }
    if (IN(5)) { REP(5) phase_attn(lds, p); SEAM(5); }
    if (IN(6)) {
        REP(6) { pg8::Gemm g{(const bf16_t*)(ws + WS2_OG), (const bf16_t*)(ws + WS_WOUT), NTOK, DM, DM}; pg8::StaticOrder S; S.init(NTOK, DM, (int)gridDim.x, (int)blockIdx.x);
            pg8::EpiResF32 E{p.x, p.out, (const float*)(ws + WS_MOD0), (DBG_SKIP & 1) ? 0.f : 1.f};
            pg8::gemm_phase<pg8::EpiResF32, pg8::StaticOrder, true, true>((PG8_LAS unsigned char*)lds, g, S, E); }
        SEAM(6); }
    if (IN(7)) { REP(7) phase_norm1(p); SEAM(7); }
    if (IN(8)) {
        REP(8) { pg8::Gemm g{(const bf16_t*)(ws + WS_HWIN), (const bf16_t*)(ws + WS_H1), 4096, NTOK, DM}; pg8::StaticOrder S; S.init(4096, NTOK, (int)gridDim.x, (int)blockIdx.x);
            pg8::EpiBf16 E{(bf16_t*)(ws + WS_PT), (size_t)4096, 4096, (size_t)4096 * 4096};
            pg8::gemm_phase<pg8::EpiBf16, pg8::StaticOrder, true, true>((PG8_LAS unsigned char*)lds, g, S, E); }
        SEAM(8); }
    if (IN(9)) { FftTw T; fft_twiddles(T, lds, TID()); REP(9) for (int c = blockIdx.x; c < 1024; c += gridDim.x) fftconv_unit(lds, p, c, T); SEAM(9); }
    if (IN(10)) {
        REP(10) {
        EpiRes e{p.out, (PROBE_REPEAT == 10 && rep_ == 0) ? (float*)(ws + WS_PT) : p.out, (const float*)(ws + WS_MOD1), (DBG_SKIP & 2) ? 0.f : 1.f};
        const bf16_t* OG2 = (const bf16_t*)(ws + WS_OG2); const bf16_t* W = (const bf16_t*)(ws + WS_HWOUT);
        const int nt = (NTOK / 256) * (DM / 128);
        for (int t = blockIdx.x; t < nt; t += gridDim.x) { const int ti = t / 8, tj = t % 8; const int b = ti >> 4, l0 = (ti & 15) * 256;
            gemm_tile<true, EpiRes>(lds, OG2 + (size_t)b * 1024 * 4096 + l0, 4096, W + (size_t)tj * 128 * DM, DM, DM, e, ti * 256, tj * 128); }
        }
        SEAM(10); }
    if (IN(11)) { phase_final(p); }
#undef SEAM
#undef IN
}

extern "C" void kernel_launch(void* const* d_in, const int* in_sizes, int n_in, void* d_out, int out_size, void* d_ws, size_t ws_size, hipStream_t stream) {
    static int grid = 0;
    if (grid == 0) {
        if (n_in != 28 || out_size != NTOK * DM || ws_size < WS_END) { fprintf(stderr, "kernel_launch: unexpected shapes n_in %d out %d ws %zu\n", n_in, out_size, ws_size); grid = -1; return; }
        int dev = 0, cus = 0, per_cu = 0;
        hipGetDevice(&dev); hipDeviceGetAttribute(&cus, hipDeviceAttributeMultiprocessorCount, dev);
        if (hipFuncSetAttribute((const void*)fwd_kernel, hipFuncAttributeMaxDynamicSharedMemorySize, LDS_BYTES) != hipSuccess) { fprintf(stderr, "hipFuncSetAttribute failed\n"); grid = -1; return; }
        hipOccupancyMaxActiveBlocksPerMultiprocessor(&per_cu, (const void*)fwd_kernel, 512, LDS_BYTES);
        if (per_cu < 1) { fprintf(stderr, "occupancy query says %d\n", per_cu); per_cu = 1; }
        grid = cus * 1;
        (void)hipGetLastError();
    }
    if (grid < 0) return;
    Params p{};
    const float** pp = (const float**)&p;
    for (int i = 0; i < 28; ++i) pp[i] = (const float*)d_in[i];
    p.out = (float*)d_out; p.ws = (char*)d_ws;
#if MK_LAUNCHES == 1
    if (hipMemsetAsync((char*)d_ws + WS_CTL, 0, CTL_BYTES, stream) != hipSuccess) { fprintf(stderr, "memset failed\n"); return; }
    p.ph_lo = 0; p.ph_hi = NPHASE;
    void* args[] = {&p};
    hipError_t e = hipLaunchCooperativeKernel((const void*)fwd_kernel, dim3(grid), dim3(512), args, LDS_BYTES, stream);
    if (e != hipSuccess) fprintf(stderr, "cooperative launch failed: %s (grid %d)\n", hipGetErrorString(e), grid);
#else
    for (int k = 0; k < NPHASE; ++k) { p.ph_lo = k; p.ph_hi = k + 1; hipLaunchKernelGGL(fwd_kernel, dim3(grid), dim3(512), LDS_BYTES, stream, p); }
#endif
}
```

```cpp
#include <hip/hip_runtime.h>
#include <hip/hip_cooperative_groups.h>
#include <cstdio>
#include <cstdint>
namespace cg = cooperative_groups;

#ifndef MK_LAUNCHES
#define MK_LAUNCHES 1
#endif

#ifndef PROBE_REPEAT
#define PROBE_REPEAT -1
#endif
#ifndef DBG_SKIP
#define DBG_SKIP 0
#endif
#define DEV __device__ __forceinline__
typedef unsigned short bf16_t;
typedef short bf16x8 __attribute__((ext_vector_type(8)));
typedef short s16x4 __attribute__((ext_vector_type(4)));
typedef float f32x16 __attribute__((ext_vector_type(16)));
typedef float f32x4 __attribute__((ext_vector_type(4)));
typedef float f32x2 __attribute__((ext_vector_type(2)));
typedef unsigned u32x4 __attribute__((ext_vector_type(4)));
typedef unsigned u32x2 __attribute__((ext_vector_type(2)));
typedef __bf16 bf16x2_t __attribute__((ext_vector_type(2)));
#define LAS __attribute__((address_space(3)))

constexpr int NB = 8, SEQ = 4096, DM = 1024, CTXL = 256, LK = SEQ + CTXL;
constexpr int NTOK = NB * SEQ, NCTX = NB * CTXL, NALL = NTOK + NCTX;
constexpr int AIN = 2208, AINP = 2304;
constexpr float EPS = 1e-6f;
constexpr float LOG2E = 1.4426950408889634f;
constexpr float QSC_A = 0.125f * LOG2E;
constexpr float QSC_M = 0.10206207261596575f * LOG2E;

constexpr size_t MiB = 1ull << 20;
constexpr size_t WS_WIN = 0;
constexpr size_t WS_WUQ = 5 * MiB;
constexpr size_t WS_WUKV = 6 * MiB;
constexpr size_t WS_WOUT = 7 * MiB;
constexpr size_t WS_HWIN = 9 * MiB;
constexpr size_t WS_HWOUT = 17 * MiB;
constexpr size_t WS_W3 = 19 * MiB;
constexpr size_t WS_HID2 = 20 * MiB;
constexpr size_t WS_MOD0 = 21 * MiB;
constexpr size_t WS_MOD1 = WS_MOD0 + 9 * 3072 * 4;
constexpr size_t WS_SSUM = WS_MOD1 + 8 * 3072 * 4;
constexpr size_t WS_ROPE = WS_SSUM + 2048 * 4;
constexpr size_t WS_GR = 22 * MiB;
constexpr size_t WS_H0 = 64 * MiB;
constexpr size_t WS_PRAW = 136 * MiB;
constexpr size_t WS_QA = 297 * MiB;
constexpr size_t WS_KA = 329 * MiB;
constexpr size_t WS_VA = 338 * MiB;
constexpr size_t WS_CQN = 347 * MiB;
constexpr size_t WS_CKVN = 363 * MiB;
constexpr size_t WS_G = 372 * MiB;
constexpr size_t WS_QM = 64 * MiB;
constexpr size_t WS_KM = 136 * MiB;
constexpr size_t WS_VM = 190 * MiB;
constexpr size_t WS_OG = 226 * MiB;
constexpr size_t WS_H1 = 436 * MiB;
constexpr size_t WS_PT = 64 * MiB;
constexpr size_t WS_OG2 = 320 * MiB;
constexpr size_t WS_CTL = 500 * MiB;
constexpr size_t CTL_BYTES = 16384;
constexpr size_t WS_END = 500 * MiB + CTL_BYTES;
constexpr size_t WS2_KM = 436 * MiB;
constexpr size_t WS2_VM = 190 * MiB;
constexpr size_t WS2_OG = 226 * MiB;

constexpr int LDS_BYTES = 150 * 1024;

extern __shared__ __attribute__((aligned(16))) char lds_dyn[];
constexpr int LDS_WTAB = LDS_BYTES - 64 - 256;
__device__ __forceinline__ int lane_id() { int r; asm volatile("v_mbcnt_lo_u32_b32 %0, -1, 0\n\tv_mbcnt_hi_u32_b32 %0, -1, %0" : "=v"(r)); return r; }
__device__ __forceinline__ int hw_slot() { return (int)(__builtin_amdgcn_s_getreg((5 << 11) | 4) & 63u); }
__device__ __forceinline__ int wave_idx() { return __builtin_amdgcn_readfirstlane(*(volatile __attribute__((address_space(3))) int*)(__attribute__((address_space(3))) char*)(lds_dyn + LDS_WTAB + 4 * hw_slot())); }
#define TID() (wave_idx() * 64 + lane_id())

DEV float bf2f(bf16_t v) { return __uint_as_float(((unsigned)v) << 16); }
DEV unsigned pk2(float lo, float hi) { f32x2 v = {lo, hi}; bf16x2_t b = __builtin_convertvector(v, bf16x2_t); return __builtin_bit_cast(unsigned, b); }
DEV bf16_t f2bf(float f) { return (bf16_t)(pk2(f, 0.f) & 0xffffu); }
DEV float lo_bf(unsigned w) { return __uint_as_float(w << 16); }
DEV float hi_bf(unsigned w) { return __uint_as_float(w & 0xffff0000u); }
DEV int crow(int r, int hi) { return (r & 3) + 8 * (r >> 2) + 4 * hi; }
DEV float silu(float v) { return v * __builtin_amdgcn_rcpf(1.f + __expf(-v)); }
DEV void unpack8(const u32x4 w, float* v) { v[0] = lo_bf(w.x); v[1] = hi_bf(w.x); v[2] = lo_bf(w.y); v[3] = hi_bf(w.y); v[4] = lo_bf(w.z); v[5] = hi_bf(w.z); v[6] = lo_bf(w.w); v[7] = hi_bf(w.w); }
DEV u32x4 pack8(const float* v) { u32x4 w; w.x = pk2(v[0], v[1]); w.y = pk2(v[2], v[3]); w.z = pk2(v[4], v[5]); w.w = pk2(v[6], v[7]); return w; }

DEV float wave_sum(float v) {
#pragma unroll
    for (int o = 1; o < 64; o <<= 1) v += __shfl_xor(v, o);
    return v;
}
struct Params {
    const float *x, *c, *ctx, *c_ctx, *ada_w, *ada_b, *norm_w, *w_in, *q_norm, *k_norm, *cq_norm, *ckv_norm, *w_uq, *w_ukv, *w_out,
        *hy_w_in, *conv_w, *conv_b, *f_w1, *f_b1, *f_w2, *f_b2, *f_w3, *f_b3, *freq, *skip, *hy_w_out, *final_w;
    float* out; char* ws; int ph_lo, ph_hi;
};

constexpr int G_RS = 144;
constexpr int G_RB = 256 * G_RS, G_CB = 128 * G_RS, G_STAGE = G_RB + G_CB;
constexpr int T_RS = 576;

template <bool TR, class Epi>
DEV void gemm_tile(char* lds, const bf16_t* __restrict__ R, size_t ldr, const bf16_t* __restrict__ C, size_t ldc, int K, const Epi& epi, int ti0, int tj0) {
    const int tid = TID(), lane = tid & 63, wid = tid >> 6;
    const int wi = wid >> 1, wj = wid & 1, l31 = lane & 31, hi = lane >> 5;
    f32x16 acc[2][2];
#pragma unroll
    for (int a = 0; a < 2; ++a)
#pragma unroll
        for (int b = 0; b < 2; ++b)
#pragma unroll
            for (int r = 0; r < 16; ++r) acc[a][b][r] = 0.f;
    u32x4 rrX[4], rcX[2], rrY[4], rcY[2];
    const bf16_t* Rp; const bf16_t* Cp; int rl_off, cl_off;
    if (TR) { const int c = tid & 31, kr = tid >> 5; Rp = R + (size_t)kr * ldr + c * 8; rl_off = kr * T_RS + c * 16; }
    else { const int lr = tid >> 3, lc = tid & 7; Rp = R + (size_t)lr * ldr + lc * 8; rl_off = lr * G_RS + lc * 16; }
    { const int lr = tid >> 3, lc = tid & 7; Cp = C + (size_t)lr * ldc + lc * 8; cl_off = lr * G_RS + lc * 16; }
    const int nk = K / 64;
    int ra_off[2], cb_off[2];
#pragma unroll
    for (int t = 0; t < 2; ++t) {
        if (TR) { const int g1 = (lane >> 4) & 1, q = (lane & 15) >> 2, p = lane & 3; ra_off[t] = (8 * hi + q) * T_RS + (wi * 64 + t * 32 + 16 * g1 + 4 * p) * 2; }
        else ra_off[t] = (wi * 64 + t * 32 + l31) * G_RS + hi * 16;
        cb_off[t] = G_RB + (wj * 64 + t * 32 + l31) * G_RS + hi * 16;
    }
#define G_LOAD(kt, S) do { const int kk_ = (kt) < nk ? (kt) : nk - 1; \
        if (TR) { _Pragma("unroll") for (int p = 0; p < 4; ++p) rr##S[p] = *(const u32x4*)(Rp + ((size_t)kk_ * 64 + 16 * p) * ldr); } \
        else { _Pragma("unroll") for (int p = 0; p < 4; ++p) rr##S[p] = *(const u32x4*)(Rp + (size_t)(64 * p) * ldr + kk_ * 64); } \
        _Pragma("unroll") for (int p = 0; p < 2; ++p) rc##S[p] = *(const u32x4*)(Cp + (size_t)(64 * p) * ldc + kk_ * 64); } while (0)
#define G_STORE(buf, S) do { char* b_ = lds + (buf) * G_STAGE; \
        if (TR) { _Pragma("unroll") for (int p = 0; p < 4; ++p) *(u32x4*)(b_ + rl_off + 16 * p * T_RS) = rr##S[p]; } \
        else { _Pragma("unroll") for (int p = 0; p < 4; ++p) *(u32x4*)(b_ + rl_off + 64 * p * G_RS) = rr##S[p]; } \
        _Pragma("unroll") for (int p = 0; p < 2; ++p) *(u32x4*)(b_ + G_RB + cl_off + 64 * p * G_RS) = rc##S[p]; } while (0)
#define G_COMPUTE(buf) do { const char* b_ = lds + (buf) * G_STAGE; \
        _Pragma("unroll") for (int ks = 0; ks < 4; ++ks) { bf16x8 fa[2], fb[2]; \
            _Pragma("unroll") for (int t = 0; t < 2; ++t) { \
                if (TR) { \
                    const s16x4 lo = __builtin_bit_cast(s16x4, __builtin_amdgcn_ds_read_tr16_b64_v4i16((LAS s16x4*)(b_ + ra_off[t] + ks * 16 * T_RS))); \
                    const s16x4 hh = __builtin_bit_cast(s16x4, __builtin_amdgcn_ds_read_tr16_b64_v4i16((LAS s16x4*)(b_ + ra_off[t] + (ks * 16 + 4) * T_RS))); \
                    fa[t] = (bf16x8){lo[0], lo[1], lo[2], lo[3], hh[0], hh[1], hh[2], hh[3]}; \
                } else fa[t] = *(const bf16x8*)(b_ + ra_off[t] + ks * 32); \
                fb[t] = *(const bf16x8*)(b_ + cb_off[t] + ks * 32); } \
            _Pragma("unroll") for (int a = 0; a < 2; ++a) _Pragma("unroll") for (int b = 0; b < 2; ++b) acc[a][b] = __builtin_amdgcn_mfma_f32_32x32x16_bf16(fa[a], fb[b], acc[a][b], 0, 0, 0); } } while (0)
    G_LOAD(0, X); G_LOAD(1, Y); G_STORE(0, X);
    __syncthreads();
    for (int kt = 0; kt < nk; kt += 2) {
        G_LOAD(kt + 2, X);
        G_COMPUTE(0);
        G_STORE(1, Y);
        __syncthreads();
        if (kt + 1 >= nk) break;
        G_LOAD(kt + 3, Y);
        G_COMPUTE(1);
        G_STORE(0, X);
        __syncthreads();
    }
#undef G_LOAD
#undef G_STORE
#undef G_COMPUTE
#pragma unroll
    for (int a = 0; a < 2; ++a)
#pragma unroll
        for (int b = 0; b < 2; ++b) epi(ti0 + wi * 64 + a * 32, tj0 + wj * 64 + b * 32, acc[a][b], l31, hi);
}

template <bool TR, class Epi>
DEV void gemm_phase(char* lds, const bf16_t* R, size_t ldr, const bf16_t* C, size_t ldc, int nI, int nJ, int K, const Epi& epi) {
    const int tI = nI / 256, tJ = nJ / 128, nt = tI * tJ;
    for (int t = blockIdx.x; t < nt; t += gridDim.x) {
        const int ti = t / tJ, tj = t % tJ;
        gemm_tile<TR, Epi>(lds, R + (size_t)ti * 256 * ldr, ldr, C + (size_t)tj * 128 * ldc, ldc, K, epi, ti * 256, tj * 128);
    }
}

struct EpiRaw {
    bf16_t* O; size_t ld;
    DEV void operator()(int i0, int j0, const f32x16& a, int l31, int hi) const {
#pragma unroll
        for (int r = 0; r < 16; ++r) O[(size_t)(i0 + crow(r, hi)) * ld + j0 + l31] = f2bf(a[r]);
    }
};
struct EpiUq {
    bf16_t* QM; const float* cos32; const float* sin32;
    DEV void operator()(int i0, int j0, const f32x16& a, int l31, int hi) const {
        const bool pe = (j0 % 96) == 64;
        const int fi = l31 & 7; const bool colang = (l31 & 16) != 0; const bool bpart = (l31 & 8) != 0;
#pragma unroll
        for (int r = 0; r < 16; ++r) {
            const int tok = i0 + crow(r, hi); float v = a[r];
            const float o = __shfl_xor(v, 8);
            if (pe) { const int l = tok & (SEQ - 1); const int pos = colang ? (l & 63) : (l >> 6);
                const float cs = cos32[pos * 8 + fi], sn = sin32[pos * 8 + fi];
                v = bpart ? (v * cs + o * sn) : (v * cs - o * sn); }
            QM[(size_t)tok * 768 + j0 + l31] = f2bf(v * QSC_M);
        }
    }
};
struct EpiUkv {
    bf16_t* KM; bf16_t* VM;
    DEV void operator()(int i0, int j0, const f32x16& a, int l31, int hi) const {
        const int h = j0 >> 7, e = (j0 & 127) + l31;
#pragma unroll
        for (int r = 0; r < 16; ++r) { const size_t row = (size_t)(i0 + crow(r, hi));
            if (e < 64) KM[row * 768 + h * 96 + e] = f2bf(a[r]); else VM[row * 512 + h * 64 + (e - 64)] = f2bf(a[r]); }
    }
};
struct EpiRes {
    const float* base; float* out; const float* mod; float gmul;
    DEV void operator()(int i0, int j0, const f32x16& a, int l31, int hi) const {
        const int b = i0 >> 12; const float g = mod[b * 3072 + 2048 + j0 + l31] * gmul;
#pragma unroll
        for (int h8 = 0; h8 < 2; ++h8) { float bv[8];
#pragma unroll
            for (int r = 0; r < 8; ++r) bv[r] = base[(size_t)(i0 + crow(8 * h8 + r, hi)) * DM + j0 + l31];
#pragma unroll
            for (int r = 0; r < 8; ++r) out[(size_t)(i0 + crow(8 * h8 + r, hi)) * DM + j0 + l31] = bv[r] + g * a[8 * h8 + r]; }
    }
};
struct EpiPT {
    bf16_t* PT;
    DEV void operator()(int i0, int j0, const f32x16& a, int l31, int hi) const {
        const int b = j0 >> 12, l = (j0 & 4095) + l31;
#pragma unroll
        for (int r = 0; r < 16; ++r) PT[((size_t)(b * 4096 + i0 + crow(r, hi))) * 4096 + l] = f2bf(a[r]);
    }
};
struct EpiFilt {
    bf16_t* GR; const float* b3;
    DEV void operator()(int i0, int j0, const f32x16& a, int l31, int hi) const {
        const int t = j0 + l31; const float tn = (float)t * (1.0f / 4095.0f);
        const float dmin = -3.0701134573253945f, dmax = -15.350567286626973f;
#pragma unroll
        for (int r = 0; r < 16; ++r) {
            const int n = i0 + crow(r, hi); const int c = n & 1023, od = n >> 10, o = od >> 1, dir = od & 1;
            const float delta = fabsf(dmin + (float)c * ((dmax - dmin) / 1023.0f));
            const float v = (a[r] + b3[n]) * __expf(-tn * delta);
            bf16_t* g = GR + ((size_t)(o * 1024 + c)) * 8192;
            if (dir == 0) g[4096 - t] = f2bf(v);
            else { if (t == 0) g[0] = 0; else g[4096 + t] = f2bf(v); }
        }
    }
};
DEV void filt_sums(const Params& p) {
    const int wid = TID() >> 6, lane = TID() & 63; bf16_t* GR = (bf16_t*)(p.ws + WS_GR); float* ssum = (float*)(p.ws + WS_SSUM);
    for (int row = blockIdx.x * 8 + wid; row < 2048; row += gridDim.x * 8) {
        bf16_t* g = GR + (size_t)row * 8192; float s = 0.f;
        u32x4 w[16];
#pragma unroll
        for (int j = 0; j < 16; ++j) w[j] = *(const u32x4*)(g + (j * 64 + lane) * 8);
#pragma unroll
        for (int j = 0; j < 16; ++j) { float v[8]; unpack8(w[j], v);
            if (j == 0 && lane == 0) v[0] = 0.f;
#pragma unroll
            for (int e = 0; e < 8; ++e) s += fabsf(v[e]); }
        s = wave_sum(s);
        if (lane == 0) ssum[row] = s;
    }
}

namespace pg8 {
#define PG8_LAS __attribute__((address_space(3)))
typedef short bf16x8 __attribute__((ext_vector_type(8)));
typedef float f32x4 __attribute__((ext_vector_type(4)));
typedef unsigned u32x4 __attribute__((ext_vector_type(4)));
constexpr int BM = 256, BK = 64, HALF = 128, HTB = HALF * BK * 2  , STAGE_BYTES = 8 * HTB, NXCD = 8, WGM = 8;

__host__ __device__ __forceinline__ int lds_byte(int r, int c) { const int st = (r >> 4) * 2 + (c >> 5), rr = r & 15, cc = c & 31, ob = rr * 64 + cc * 2; return st * 1024 + (ob ^ (((ob >> 9) & 1) << 5)); }
__host__ __device__ __forceinline__ void stage_rc(int b, int& R, int& C) { const int st = b / 1024, sb = b % 1024, swz = sb ^ (((sb >> 9) & 1) << 5); R = (st >> 1) * 16 + swz / 64; C = (st & 1) * 32 + (swz % 64) / 2; }
__host__ __device__ __forceinline__ int perm32(int rho) { const int n = rho >> 4, i = rho & 15; return 8 * (i >> 2) + 4 * n + (i & 3); }

struct Unit { int pm, pn; };
struct Gemm { const bf16_t* A; const bf16_t* Bt; int M, N, K; };

struct StaticOrder {
    int nM, nN, nwg, G, c;
    __host__ __device__ void init(int M, int N, int G_, int c_) { nM = M / BM; nN = N / BM; nwg = nM * nN; G = G_; c = c_; }
    __host__ __device__ bool next(int i, Unit& u) const {
        const long L = (long)i * G + c; if (L >= nwg) return false;
        int wgid = (int)L; { const int q = nwg / NXCD, r = nwg % NXCD, xcd = wgid % NXCD, off = wgid / NXCD; wgid = (xcd < r ? xcd * (q + 1) : r * (q + 1) + (xcd - r) * q) + off; }
        const int nig = WGM * nN, gid = wgid / nig, fm = gid * WGM, gsz = (nM - fm) < WGM ? (nM - fm) : WGM;
        u.pm = fm + ((wgid % nig) % gsz); u.pn = (wgid % nig) / gsz; return true;
    }
    __device__ __forceinline__ void a_ready(const Unit&) const {}
    __device__ __forceinline__ void done(const Unit&) const {}
};

__device__ __forceinline__ unsigned cvt_pk_bf16(float lo, float hi) { unsigned r; asm volatile("v_cvt_pk_bf16_f32 %0, %1, %2" : "=v"(r) : "v"(lo), "v"(hi)); return r; }
typedef float f32x2 __attribute__((ext_vector_type(2)));

struct EpiBf16 {
    static constexpr bool PERM = true, AFTER_DRAIN = false;
    bf16_t* O; size_t ldc; int split_cols; size_t split_stride;
    __device__ __forceinline__ void operator()(const f32x4 (&acc)[2][2][4][2], const Unit& u, int wr, int wc, int fr, int fq) const {
        const int row0 = u.pm * BM + wr * 64 + fr; int colt = u.pn * BM; bf16_t* base = O;
        if (split_cols) { const int t = colt / split_cols; base += (size_t)t * split_stride; colt -= t * split_cols; }
        const int col0 = colt + wc * 32 + 8 * fq;
#pragma unroll
        for (int ai = 0; ai < 2; ++ai)
#pragma unroll
            for (int m = 0; m < 4; ++m) { bf16_t* rowp = base + (size_t)(row0 + ai * HALF + m * 16) * ldc + col0;
#pragma unroll
                for (int bj = 0; bj < 2; ++bj) { const f32x4 v0 = acc[ai][bj][m][0], v1 = acc[ai][bj][m][1];
                    u32x4 w; w.x = cvt_pk_bf16(v0[0], v0[1]); w.y = cvt_pk_bf16(v0[2], v0[3]); w.z = cvt_pk_bf16(v1[0], v1[1]); w.w = cvt_pk_bf16(v1[2], v1[3]);
                    *(u32x4*)(rowp + bj * HALF) = w; } }
    }
};

struct EpiUkvPg {
    static constexpr bool PERM = true, AFTER_DRAIN = false;
    bf16_t* KM; bf16_t* VM;
    __device__ __forceinline__ void operator()(const f32x4 (&acc)[2][2][4][2], const Unit& u, int wr, int wc, int fr, int fq) const {
        { const int ln = lane_id(); fr = ln & 15; fq = ln >> 4; }
        const int row0 = u.pm * BM + wr * 64 + fr; const int e0 = 32 * wc + 8 * fq;
        const bool isk = (wc < 2);
        bf16_t* base = isk ? KM + (size_t)row0 * 768 + 2 * u.pn * 96 + e0 : VM + (size_t)row0 * 512 + 2 * u.pn * 64 + (e0 - 64);
        const int ld = isk ? 768 : 512, hs = isk ? 96 : 64;
#pragma unroll
        for (int ai = 0; ai < 2; ++ai)
#pragma unroll
            for (int m = 0; m < 4; ++m)
#pragma unroll
                for (int bj = 0; bj < 2; ++bj) { const f32x4 v0 = acc[ai][bj][m][0], v1 = acc[ai][bj][m][1];
                    u32x4 w; w.x = cvt_pk_bf16(v0[0], v0[1]); w.y = cvt_pk_bf16(v0[2], v0[3]); w.z = cvt_pk_bf16(v1[0], v1[1]); w.w = cvt_pk_bf16(v1[2], v1[3]);
                    *(u32x4*)(base + (ai * HALF + m * 16) * ld + bj * hs) = w; }
    }
};
struct EpiUqPg {
    static constexpr bool PERM = true, AFTER_DRAIN = false;
    bf16_t* QM; const float* cos32; const float* sin32; float sc;
    __device__ __forceinline__ void operator()(const f32x4 (&acc)[2][2][4][2], const Unit& u, int wr, int wc, int fr, int fq) const {
        { const int ln = lane_id(); fr = ln & 15; fq = ln >> 4; }
        const int row0 = u.pm * BM + wr * 64 + fr;
        bf16_t* base = QM + (size_t)row0 * 768 + u.pn * BM + 32 * wc + 8 * fq;
        const int g0 = 8 * u.pn + wc;
        const bool sgn = (fq & 1) != 0;
#pragma unroll
        for (int bj = 0; bj < 2; ++bj) { const bool pe = (((g0 + 4 * bj) % 3) == 2);
#pragma unroll
            for (int ai = 0; ai < 2; ++ai)
#pragma unroll
                for (int m = 0; m < 4; ++m) { const int rr = ai * HALF + m * 16; u32x4 w;
#pragma unroll
                    for (int n = 0; n < 2; ++n) { f32x4 v = acc[ai][bj][m][n];
                        if (pe) { f32x4 o;
#pragma unroll
                            for (int e = 0; e < 4; ++e) o[e] = __shfl_xor(v[e], 16);
                            const int l = (row0 + rr) & 4095, pos = (fq < 2) ? (l >> 6) : (l & 63);
                            const f32x4 cv = *(const f32x4*)(cos32 + pos * 8 + 4 * n), sv = *(const f32x4*)(sin32 + pos * 8 + 4 * n);
                            v = sgn ? (v * cv + o * sv) : (v * cv - o * sv); }
                        v = v * sc;
                        if (n == 0) { w.x = cvt_pk_bf16(v[0], v[1]); w.y = cvt_pk_bf16(v[2], v[3]); } else { w.z = cvt_pk_bf16(v[0], v[1]); w.w = cvt_pk_bf16(v[2], v[3]); } }
                    *(u32x4*)(base + rr * 768 + bj * HALF) = w;
                    asm volatile("" ::: "memory"); } }
    }
};
struct EpiResF32 {
    static constexpr bool PERM = false, AFTER_DRAIN = false;
    const float* base; float* out; const float* mod; float gmul;
    __device__ __forceinline__ void operator()(const f32x4 (&acc)[2][2][4][2], const Unit& u, int wr, int wc, int fr, int fq) const {
        const int row0 = u.pm * BM + wr * 64 + fr, col0 = u.pn * BM + wc * 32 + 4 * fq, b = (u.pm * BM) >> 12;
        f32x4 g[2][2];
#pragma unroll
        for (int bj = 0; bj < 2; ++bj)
#pragma unroll
            for (int n = 0; n < 2; ++n) g[bj][n] = *(const f32x4*)(mod + b * 3072 + 2048 + col0 + bj * HALF + n * 16) * gmul;
#pragma unroll
        for (int ai = 0; ai < 2; ++ai) {
            f32x4 pre[4][2][2];
#pragma unroll
            for (int m = 0; m < 4; ++m) { const size_t off = (size_t)(row0 + ai * HALF + m * 16) * 1024 + col0;
#pragma unroll
                for (int bj = 0; bj < 2; ++bj)
#pragma unroll
                    for (int n = 0; n < 2; ++n) pre[m][bj][n] = *(const f32x4*)(base + off + bj * HALF + n * 16); }
#pragma unroll
            for (int m = 0; m < 4; ++m) { const size_t off = (size_t)(row0 + ai * HALF + m * 16) * 1024 + col0;
#pragma unroll
                for (int bj = 0; bj < 2; ++bj)
#pragma unroll
                    for (int n = 0; n < 2; ++n) *(f32x4*)(out + off + bj * HALF + n * 16) = pre[m][bj][n] + g[bj][n] * acc[ai][bj][m][n]; }
        }
    }
};
template <class Epi, class Sched, bool ALIGN_EPI = false, bool SP2 = false>
__device__ __forceinline__ void gemm_phase(PG8_LAS unsigned char* lds, const Gemm g, const Sched& S, const Epi& E) {
    int tid_ = TID(); asm volatile("" : "+v"(tid_));
    const int tid = tid_, wid = __builtin_amdgcn_readfirstlane(tid >> 6), lane = tid & 63, wr = wid >> 2, wc = wid & 3, fr = lane & 15, fq = lane >> 4;
    const int K = g.K, nt = K / BK;
    unsigned voffA[2], voffB[2];
#pragma unroll
    for (int i = 0; i < 2; ++i) { int R, C; stage_rc(tid * 16 + i * 8192, R, C); const int Rb = Epi::PERM ? ((R & ~31) + perm32(R & 31)) : R;
        voffA[i] = (unsigned)(R * K + C) * 2u; voffB[i] = (unsigned)(Rb * K + C) * 2u; }
    const size_t kstep = (size_t)(BK * 2);
    const size_t hstep = (size_t)HALF * K * 2;
    const size_t tstep = 2 * hstep;
    const unsigned ldsw = (unsigned)wid * 1024u;
    const int aoff = lds_byte(wr * 64 + fr, fq * 8), boff = lds_byte(wc * 32 + fr, fq * 8);
#define PG8_SA(b, h) (((b) * 2 + (h)) * HTB)
#define PG8_SB(b, h) ((4 + (b) * 2 + (h)) * HTB)
#define PG8_STAGE(bufoff, gbase, voff) do { _Pragma("unroll") for (int _i = 0; _i < 2; ++_i) \
        __builtin_amdgcn_global_load_lds((const unsigned*)((const char*)(gbase) + (voff)[_i]), (PG8_LAS unsigned*)(lds + (bufoff) + ldsw + _i * 8192), 16, 0, 0); } while (0)
#define PG8_LDA(dst, b, h) do { _Pragma("unroll") for (int m = 0; m < 4; ++m) _Pragma("unroll") for (int k = 0; k < 2; ++k) dst[m][k] = *(const PG8_LAS bf16x8*)(lds + PG8_SA(b, h) + aoff + m * 2048 + k * 1024); } while (0)
#define PG8_LDB(dst, b, h) do { _Pragma("unroll") for (int n = 0; n < 2; ++n) _Pragma("unroll") for (int k = 0; k < 2; ++k) dst[n][k] = *(const PG8_LAS bf16x8*)(lds + PG8_SB(b, h) + boff + n * 2048 + k * 1024); } while (0)
#define PG8_MMA(ai, bj, At, Bt) do { __builtin_amdgcn_s_setprio(1); _Pragma("unroll") for (int m = 0; m < 4; ++m) _Pragma("unroll") for (int n = 0; n < 2; ++n) _Pragma("unroll") for (int k = 0; k < 2; ++k) \
        acc[ai][bj][m][n] = __builtin_amdgcn_mfma_f32_16x16x32_bf16(Bt[n][k], At[m][k], acc[ai][bj][m][n], 0, 0, 0); __builtin_amdgcn_s_setprio(0); } while (0)
#define PG8_WAIT_V(n) asm volatile("s_waitcnt vmcnt(" #n ")" ::: "memory")
#define PG8_WAIT_L(n) asm volatile("s_waitcnt lgkmcnt(" #n ")" ::: "memory")
#define PG8_BAR __builtin_amdgcn_s_barrier()
#define PG8_SCHED __builtin_amdgcn_sched_barrier(0)
    Unit cur, nxt; int ui = 0;
    if (!S.next(0, cur)) return;
    f32x4 acc[2][2][4][2];
#pragma unroll
    for (int a = 0; a < 2; ++a)
#pragma unroll
        for (int b = 0; b < 2; ++b)
#pragma unroll
            for (int m = 0; m < 4; ++m)
#pragma unroll
                for (int n = 0; n < 2; ++n) acc[a][b][m][n] = (f32x4){0.f, 0.f, 0.f, 0.f};
    bf16x8 At[4][2], B0[2][2], B1[2][2];
    const char* cA = (const char*)g.A + (size_t)cur.pm * tstep; const char* cB = (const char*)g.Bt + (size_t)cur.pn * tstep;
    S.a_ready(cur);
    if constexpr (SP2) {
        PG8_STAGE(PG8_SB(0, 0), cB, voffB); PG8_STAGE(PG8_SB(0, 1), cB + hstep, voffB); PG8_STAGE(PG8_SA(0, 0), cA, voffA); PG8_STAGE(PG8_SA(0, 1), cA + hstep, voffA);
        if (wr == 1) PG8_BAR;
        PG8_WAIT_V(2); PG8_BAR;
        PG8_STAGE(PG8_SB(1, 0), cB + kstep, voffB); PG8_STAGE(PG8_SA(1, 0), cA + kstep, voffA); PG8_STAGE(PG8_SB(1, 1), cB + hstep + kstep, voffB);
        PG8_WAIT_V(6); PG8_BAR;
    } else {
        PG8_STAGE(PG8_SB(0, 0), cB, voffB); PG8_STAGE(PG8_SA(0, 0), cA, voffA); PG8_STAGE(PG8_SB(0, 1), cB + hstep, voffB); PG8_STAGE(PG8_SA(0, 1), cA + hstep, voffA);
        if (wr == 1) PG8_BAR;
        PG8_WAIT_V(4); PG8_BAR;
        PG8_STAGE(PG8_SB(1, 0), cB + kstep, voffB); PG8_STAGE(PG8_SA(1, 0), cA + kstep, voffA); PG8_STAGE(PG8_SB(1, 1), cB + hstep + kstep, voffB);
        PG8_WAIT_V(6); PG8_BAR;
    }
    for (;;) {
        const bool has_next = S.next(ui + 1, nxt);
        const char* nA = has_next ? (const char*)g.A + (size_t)nxt.pm * tstep : cA; const char* nB = has_next ? (const char*)g.Bt + (size_t)nxt.pn * tstep : cB;
        for (int t = 0; t < nt; t += 2) {
            const bool last = (t == nt - 2);
            const char* a1 = cA + (size_t)(t + 1) * kstep;
            const char* a2 = last ? nA : cA + (size_t)(t + 2) * kstep; const char* b2 = last ? nB : cB + (size_t)(t + 2) * kstep;
            const char* a3 = a2 + kstep; const char* b3 = b2 + kstep;
            if (last && has_next) S.a_ready(nxt);
            if constexpr (SP2) {
            PG8_LDB(B0, 0, 0); PG8_LDB(B1, 0, 1); PG8_SCHED; PG8_LDA(At, 0, 0); PG8_STAGE(PG8_SA(1, 1), a1 + hstep, voffA);
            PG8_WAIT_V(8); PG8_WAIT_L(0); PG8_BAR; PG8_MMA(0, 0, At, B0); PG8_MMA(0, 1, At, B1); PG8_BAR; PG8_SCHED;
            PG8_LDA(At, 0, 1); PG8_STAGE(PG8_SB(0, 0), b2, voffB); PG8_STAGE(PG8_SB(0, 1), b2 + hstep, voffB); PG8_STAGE(PG8_SA(0, 0), a2, voffA);
            PG8_WAIT_V(8); PG8_WAIT_L(0); PG8_BAR; PG8_MMA(1, 0, At, B0); PG8_MMA(1, 1, At, B1); PG8_BAR; PG8_SCHED;
            PG8_LDB(B0, 1, 0); PG8_LDB(B1, 1, 1); PG8_SCHED; PG8_LDA(At, 1, 0); PG8_STAGE(PG8_SA(0, 1), a2 + hstep, voffA);
            PG8_WAIT_V(8); PG8_WAIT_L(0); PG8_BAR; PG8_MMA(0, 0, At, B0); PG8_MMA(0, 1, At, B1); PG8_BAR; PG8_SCHED;
            PG8_LDA(At, 1, 1); PG8_STAGE(PG8_SB(1, 0), b3, voffB); PG8_STAGE(PG8_SB(1, 1), b3 + hstep, voffB); PG8_STAGE(PG8_SA(1, 0), a3, voffA);
            PG8_WAIT_V(8); PG8_WAIT_L(0); PG8_BAR; PG8_MMA(1, 0, At, B0); PG8_MMA(1, 1, At, B1); PG8_BAR; PG8_SCHED;
            } else {
            PG8_LDB(B0, 0, 0); PG8_SCHED; PG8_LDA(At, 0, 0); PG8_STAGE(PG8_SA(1, 1), a1 + hstep, voffA);
            PG8_WAIT_L(8); PG8_BAR; PG8_WAIT_L(0); PG8_MMA(0, 0, At, B0); PG8_BAR; PG8_SCHED;
            PG8_LDB(B1, 0, 1); PG8_STAGE(PG8_SB(0, 0), b2, voffB);
            PG8_BAR; PG8_WAIT_L(0); PG8_MMA(0, 1, At, B1); PG8_BAR;
            PG8_LDA(At, 0, 1); PG8_STAGE(PG8_SA(0, 0), a2, voffA);
            PG8_BAR; PG8_WAIT_L(0); PG8_MMA(1, 0, At, B0); PG8_BAR; PG8_SCHED;
            PG8_STAGE(PG8_SB(0, 1), b2 + hstep, voffB);
            PG8_WAIT_V(6); PG8_BAR; PG8_MMA(1, 1, At, B1); PG8_BAR;
            PG8_LDB(B0, 1, 0); PG8_SCHED; PG8_LDA(At, 1, 0); PG8_STAGE(PG8_SA(0, 1), a2 + hstep, voffA);
            PG8_WAIT_L(8); PG8_BAR; PG8_WAIT_L(0); PG8_MMA(0, 0, At, B0); PG8_BAR; PG8_SCHED;
            PG8_LDB(B1, 1, 1); PG8_STAGE(PG8_SB(1, 0), b3, voffB);
            PG8_BAR; PG8_WAIT_L(0); PG8_MMA(0, 1, At, B1); PG8_BAR;
            PG8_LDA(At, 1, 1); PG8_STAGE(PG8_SA(1, 0), a3, voffA);
            PG8_BAR; PG8_WAIT_L(0); PG8_MMA(1, 0, At, B0); PG8_BAR; PG8_SCHED;
            PG8_STAGE(PG8_SB(1, 1), b3 + hstep, voffB);
            PG8_WAIT_V(6); PG8_BAR; PG8_MMA(1, 1, At, B1); PG8_BAR;
            }
        }
        if constexpr (ALIGN_EPI) { if (wr == 0) PG8_BAR; }
        if constexpr (!Epi::AFTER_DRAIN) { E(acc, cur, wr, wc, fr, fq); S.done(cur); }
        if (!has_next) break;
#pragma unroll
        for (int a = 0; a < 2; ++a)
#pragma unroll
            for (int b = 0; b < 2; ++b)
#pragma unroll
                for (int m = 0; m < 4; ++m)
#pragma unroll
                    for (int n = 0; n < 2; ++n) acc[a][b][m][n] = (f32x4){0.f, 0.f, 0.f, 0.f};
        cur = nxt; cA = nA; cB = nB; ++ui;
        if constexpr (ALIGN_EPI) { if (wr == 1) PG8_BAR; }
    }
    PG8_WAIT_V(0);
    if constexpr (!ALIGN_EPI) { if (wr == 0) PG8_BAR; }
    PG8_BAR;
    if constexpr (Epi::AFTER_DRAIN) { E.fused(acc, cur, wr, wc, fr, fq, lds, wid, lane); S.done(cur); }
#undef PG8_SA
#undef PG8_SB
#undef PG8_STAGE
#undef PG8_LDA
#undef PG8_LDB
#undef PG8_MMA
#undef PG8_WAIT_V
#undef PG8_WAIT_L
#undef PG8_BAR
#undef PG8_SCHED
}
}

DEV void transpose_item(float* scr, const float* W, int K, int N, int Npad, bf16_t* WT, int item, int lane) {
    const int nblk = Npad / 32, kb = item / nblk, nb = item % nblk, k0 = 64 * kb, n0 = 32 * nb;
    const bool valid = (n0 < N);
    float v[32];
#pragma unroll
    for (int i = 0; i < 32; ++i) { const int kk = 2 * i + (lane >> 5); v[i] = valid ? W[(size_t)(k0 + kk) * N + n0 + (lane & 31)] : 0.f; }
#pragma unroll
    for (int i = 0; i < 32; ++i) { const int kk = 2 * i + (lane >> 5); scr[kk * 33 + (lane & 31)] = v[i]; }
    asm volatile("s_waitcnt lgkmcnt(0)" ::: "memory");
    const int c = lane & 7;
#pragma unroll
    for (int j = 0; j < 4; ++j) { const int n = (lane >> 3) + 8 * j; const float* sp = scr + (8 * c) * 33 + n; float o[8];
#pragma unroll
        for (int e = 0; e < 8; ++e) o[e] = sp[e * 33];
        *(u32x4*)(WT + (size_t)(n0 + n) * K + k0 + 8 * c) = pack8(o); }
    asm volatile("s_waitcnt lgkmcnt(0)" ::: "memory");
}

DEV void mod_item(char* lds, const Params& p, int item) {
    const int layer = item / 96, n0 = (item % 96) * 32, tid = TID();
    float* s = (float*)lds;
    float* red = s + 9 * 1024;
    for (int i = tid; i < 9 * 1024; i += 512) { const int v = i >> 10, k = i & 1023; const float cv = (v < 8) ? p.c[v * 1024 + k] : p.c_ctx[k]; s[i] = silu(cv); }
    __syncthreads();
    const int kc = tid >> 5, n = tid & 31; const float* W = p.ada_w + (size_t)layer * DM * 3072 + n0 + n;
    float acc[9];
#pragma unroll
    for (int v = 0; v < 9; ++v) acc[v] = 0.f;
#pragma unroll 16
    for (int kk = 0; kk < 64; ++kk) { const int k = kc * 64 + kk; const float w = W[(size_t)k * 3072];
#pragma unroll
        for (int v = 0; v < 9; ++v) acc[v] += s[v * 1024 + k] * w; }
#pragma unroll
    for (int v = 0; v < 9; ++v) red[(kc * 9 + v) * 32 + n] = acc[v];
    __syncthreads();
    if (tid < 9 * 32) { const int v = tid >> 5, nn = tid & 31; float t = 0.f;
#pragma unroll
        for (int k2 = 0; k2 < 16; ++k2) t += red[(k2 * 9 + v) * 32 + nn];
        t += p.ada_b[layer * 3072 + n0 + nn];
        if (layer == 0) ((float*)(p.ws + WS_MOD0))[v * 3072 + n0 + nn] = t;
        else if (v < 8) ((float*)(p.ws + WS_MOD1))[v * 3072 + n0 + nn] = t; }
    __syncthreads();
}

DEV void hid2_row(char* lds, const Params& p, int t, int wid, int lane) {
    float* sc = (float*)lds + wid * 128;
    const float tn = (float)t * (1.0f / 4095.0f);
    const float w = (float)(2.0 * 3.14159265358979323846 / 4096.0) * (float)t;
    float e = 0.f;
    if (lane == 0) e = tn;
    else if (lane <= 32) { const int k = (lane - 1) & 15; const float band = 1e-4f + (float)k * ((15.0f - 1e-4f) / 15.0f); const float ang = w * band; e = (lane <= 16) ? cosf(ang) : -sinf(ang); }
    sc[lane] = e;
    asm volatile("s_waitcnt lgkmcnt(0)" ::: "memory");
    float a = p.f_b1[lane];
    for (int i = 0; i < 33; ++i) a += sc[i] * p.f_w1[i * 64 + lane];
    const float fr = p.freq[lane];
    const float h1 = sinf(fr * a);
    sc[64 + lane] = h1;
    asm volatile("s_waitcnt lgkmcnt(0)" ::: "memory");
    float a2 = p.f_b2[lane];
    for (int i = 0; i < 64; ++i) a2 += sc[64 + i] * p.f_w2[i * 64 + lane];
    const float h2 = sinf(fr * a2);
    ((bf16_t*)(p.ws + WS_HID2))[t * 64 + lane] = f2bf(h2);
    asm volatile("s_waitcnt lgkmcnt(0)" ::: "memory");
}

DEV void phase_prep(char* lds, const Params& p) {
    const int tid = TID(), wid = tid >> 6, lane = tid & 63;
    { const int gt = blockIdx.x * 512 + tid;
        if (gt < 2048) ((float*)(p.ws + WS_SSUM))[gt] = 0.f;
        float* rp = (float*)(p.ws + WS_ROPE);
        if (gt < 1024) { const int pos = gt >> 4, i = gt & 15; const float inv = exp2f(-(float)i * (13.287712379549449f / 16.0f)); const float ang = (float)pos * inv; rp[gt] = cosf(ang); rp[1024 + gt] = sinf(ang); }
        if (gt < 512) { const int pos = gt >> 3, i = gt & 7; const float inv = exp2f(-(float)i * (13.287712379549449f / 8.0f)); const float ang = (float)pos * inv; rp[2048 + gt] = cosf(ang); rp[2560 + gt] = sinf(ang); } }
    for (int it = blockIdx.x; it < 192; it += gridDim.x) mod_item(lds, p, it);
    for (int t = blockIdx.x * 8 + wid; t < 4096; t += gridDim.x * 8) hid2_row(lds, p, t, wid, lane);
    __syncthreads();
    constexpr int I_WIN = 16 * (AINP / 32), I_UQ = 4 * 24, I_UKV = 2 * 32, I_WO = 16 * 32, I_HIN = 16 * 128, I_HO = 16 * 32, I_W3 = 128;
    constexpr int NIT = I_WIN + I_UQ + I_UKV + I_WO + I_HIN + I_HO + I_W3;
    float* scr = (float*)lds + wid * (64 * 33);
    for (int it = blockIdx.x * 8 + wid; it < NIT; it += gridDim.x * 8) {
        int r = it;
        if (r < I_HIN) { transpose_item(scr, p.hy_w_in, 1024, 4096, 4096, (bf16_t*)(p.ws + WS_HWIN), r, lane); continue; } r -= I_HIN;
        if (r < I_WIN) { transpose_item(scr, p.w_in, 1024, AIN, AINP, (bf16_t*)(p.ws + WS_WIN), r, lane); continue; } r -= I_WIN;
        if (r < I_WO) { transpose_item(scr, p.w_out, 1024, 1024, 1024, (bf16_t*)(p.ws + WS_WOUT), r, lane); continue; } r -= I_WO;
        if (r < I_HO) { transpose_item(scr, p.hy_w_out, 1024, 1024, 1024, (bf16_t*)(p.ws + WS_HWOUT), r, lane); continue; } r -= I_HO;
        if (r < I_UQ) { transpose_item(scr, p.w_uq, 256, 768, 768, (bf16_t*)(p.ws + WS_WUQ), r, lane); continue; } r -= I_UQ;
        if (r < I_UKV) { transpose_item(scr, p.w_ukv, 128, 1024, 1024, (bf16_t*)(p.ws + WS_WUKV), r, lane); continue; } r -= I_UKV;
        transpose_item(scr, p.f_w3, 64, 4096, 4096, (bf16_t*)(p.ws + WS_W3), r, lane);
    }
}

DEV void row_load(f32x4 (&v)[4], const float* xr, int lane) {
#pragma unroll
    for (int j = 0; j < 4; ++j) v[j] = *(const f32x4*)(xr + lane * 4 + 256 * j);
}
DEV void modnorm_row(const f32x4 (&v)[4], const float* nw, const float* shift, const float* scale, bf16_t* orow, int lane) {
    float s = 0.f;
#pragma unroll
    for (int j = 0; j < 4; ++j) s += v[j].x * v[j].x + v[j].y * v[j].y + v[j].z * v[j].z + v[j].w * v[j].w;
    const float r = rsqrtf(wave_sum(s) * (1.0f / DM) + EPS);
#pragma unroll
    for (int j = 0; j < 4; ++j) { const int c0 = lane * 4 + 256 * j;
        const f32x4 w = *(const f32x4*)(nw + c0), sh = *(const f32x4*)(shift + c0), sc = *(const f32x4*)(scale + c0);
        const float o0 = v[j].x * r * w.x * (1.f + sc.x) + sh.x, o1 = v[j].y * r * w.y * (1.f + sc.y) + sh.y, o2 = v[j].z * r * w.z * (1.f + sc.z) + sh.z, o3 = v[j].w * r * w.w * (1.f + sc.w) + sh.w;
        u32x2 pk; pk.x = pk2(o0, o1); pk.y = pk2(o2, o3); *(u32x2*)(orow + c0) = pk; }
}
DEV const float* norm0_src(const Params& p, int row) { return row < NTOK ? p.x + (size_t)row * DM : p.ctx + (size_t)(row - NTOK) * DM; }
DEV void phase_norm0(const Params& p) {
    const int wid = TID() >> 6, lane = TID() & 63; const float* mod0 = (const float*)(p.ws + WS_MOD0); bf16_t* H0 = (bf16_t*)(p.ws + WS_H0);
    const int stride = gridDim.x * 8; int row = blockIdx.x * 8 + wid;
    f32x4 cur[4], nxt[4];
    if (row < NALL) row_load(cur, norm0_src(p, row), lane);
    for (; row < NALL; row += stride) {
        { const int rn = row + stride < NALL ? row + stride : row; row_load(nxt, norm0_src(p, rn), lane); }
        const int v = row < NTOK ? (row >> 12) : 8;
        modnorm_row(cur, p.norm_w, mod0 + v * 3072, mod0 + v * 3072 + 1024, H0 + (size_t)row * DM, lane);
#pragma unroll
        for (int j = 0; j < 4; ++j) cur[j] = nxt[j];
    }
}
DEV void phase_norm1(const Params& p) {
    const int wid = TID() >> 6, lane = TID() & 63; const float* mod1 = (const float*)(p.ws + WS_MOD1); bf16_t* H1 = (bf16_t*)(p.ws + WS_H1);
    const int stride = gridDim.x * 8; int row = blockIdx.x * 8 + wid;
    f32x4 cur[4], nxt[4];
    if (row < NTOK) row_load(cur, p.out + (size_t)row * DM, lane);
    for (; row < NTOK; row += stride) {
        { const int rn = row + stride < NTOK ? row + stride : row; row_load(nxt, p.out + (size_t)rn * DM, lane); }
        const int v = row >> 12;
        modnorm_row(cur, p.norm_w + DM, mod1 + v * 3072, mod1 + v * 3072 + 1024, H1 + (size_t)row * DM, lane);
#pragma unroll
        for (int j = 0; j < 4; ++j) cur[j] = nxt[j];
    }
}
DEV void phase_final(const Params& p) {
    const int wid = TID() >> 6, lane = TID() & 63;
    const int stride = gridDim.x * 8; int row = blockIdx.x * 8 + wid;
    f32x4 v[4], nxt[4];
    if (row < NTOK) row_load(v, p.out + (size_t)row * DM, lane);
    for (; row < NTOK; row += stride) {
        { const int rn = row + stride < NTOK ? row + stride : row; row_load(nxt, p.out + (size_t)rn * DM, lane); }
        float* xr = p.out + (size_t)row * DM; float s = 0.f;
#pragma unroll
        for (int j = 0; j < 4; ++j) s += v[j].x * v[j].x + v[j].y * v[j].y + v[j].z * v[j].z + v[j].w * v[j].w;
        const float r = rsqrtf(wave_sum(s) * (1.0f / DM) + EPS);
#pragma unroll
        for (int j = 0; j < 4; ++j) { const int c0 = lane * 4 + 256 * j; const f32x4 w = *(const f32x4*)(p.final_w + c0);
            f32x4 o; o.x = v[j].x * r * w.x; o.y = v[j].y * r * w.y; o.z = v[j].z * r * w.z; o.w = v[j].w * r * w.w; *(f32x4*)(xr + c0) = o; }
#pragma unroll
        for (int j = 0; j < 4; ++j) v[j] = nxt[j];
    }
}

struct PostIn { u32x4 raw[5]; f32x4 c64[2], s64[2], c32[2], s32[2]; };
DEV void post_load(PostIn& I, const bf16_t* PRAW, const float* rp, int tok, int lane) {
    const bf16_t* pr = PRAW + (size_t)tok * AINP;
#pragma unroll
    for (int sgm = 0; sgm < 4; ++sgm) I.raw[sgm] = *(const u32x4*)(pr + 512 * sgm + lane * 8);
    I.raw[4] = *(const u32x4*)(pr + 2048 + (lane & 31) * 8);
    const int l = tok & 4095, prow = l >> 6, pcol = l & 63;
    const int k = lane & 7, posv = (k < 4) ? prow : pcol; const float* t64 = rp + posv * 16 + (k & 1) * 8;
    I.c64[0] = *(const f32x4*)t64; I.c64[1] = *(const f32x4*)(t64 + 4); I.s64[0] = *(const f32x4*)(t64 + 1024); I.s64[1] = *(const f32x4*)(t64 + 1028);
    const int k3 = lane & 3, posm = (k3 < 2) ? prow : pcol; const float* t32 = rp + 2048 + posm * 8;
    I.c32[0] = *(const f32x4*)t32; I.c32[1] = *(const f32x4*)(t32 + 4); I.s32[0] = *(const f32x4*)(t32 + 512); I.s32[1] = *(const f32x4*)(t32 + 516);
}
DEV void phase_post(const Params& p) {
    const int wid = TID() >> 6, lane = TID() & 63;
    const bf16_t* PRAW = (const bf16_t*)(p.ws + WS_PRAW);
    bf16_t* QA = (bf16_t*)(p.ws + WS_QA); bf16_t* KA = (bf16_t*)(p.ws + WS_KA); bf16_t* VA = (bf16_t*)(p.ws + WS_VA);
    bf16_t* CQN = (bf16_t*)(p.ws + WS_CQN); bf16_t* CKVN = (bf16_t*)(p.ws + WS_CKVN); bf16_t* G = (bf16_t*)(p.ws + WS_G); bf16_t* KM = (bf16_t*)(p.ws + WS2_KM);
    const float* rp = (const float*)(p.ws + WS_ROPE);
    float wq[8], wk[8], wcq[8], wckv[8];
    { const int k = lane & 7;
#pragma unroll
        for (int j = 0; j < 8; ++j) { wq[j] = p.q_norm[k * 8 + j]; wk[j] = p.k_norm[k * 8 + j]; wcq[j] = p.cq_norm[(lane & 31) * 8 + j]; wckv[j] = p.ckv_norm[(lane & 15) * 8 + j]; } }
    const int stride = gridDim.x * 8;
    int tok = blockIdx.x * 8 + wid;
    PostIn cur, nxt;
    if (tok < NALL) post_load(cur, PRAW, rp, tok, lane);
    for (; tok < NALL; tok += stride) {
        { const int tn = tok + stride < NALL ? tok + stride : tok; post_load(nxt, PRAW, rp, tn, lane); }
        const bool lat = tok < NTOK; int b, pos;
        if (lat) { b = tok >> 12; pos = CTXL + (tok & 4095); } else { const int j = tok - NTOK; b = j >> 8; pos = j & 255; }
        const size_t kvrow = (size_t)b * LK + pos;
        const float cs64[8] = {cur.c64[0].x, cur.c64[0].y, cur.c64[0].z, cur.c64[0].w, cur.c64[1].x, cur.c64[1].y, cur.c64[1].z, cur.c64[1].w};
        const float sn64[8] = {cur.s64[0].x, cur.s64[0].y, cur.s64[0].z, cur.s64[0].w, cur.s64[1].x, cur.s64[1].y, cur.s64[1].z, cur.s64[1].w};
        float v[8], o[8];
        if (lat) {
            unpack8(cur.raw[0], v);
            float ss = 0.f;
#pragma unroll
            for (int j = 0; j < 8; ++j) ss += v[j] * v[j];
            ss += __shfl_xor(ss, 1); ss += __shfl_xor(ss, 2); ss += __shfl_xor(ss, 4);
            const float r = rsqrtf(ss * (1.0f / 64.0f) + EPS); const int k = lane & 7;
#pragma unroll
            for (int j = 0; j < 8; ++j) v[j] = v[j] * r * wq[j];
#pragma unroll
            for (int j = 0; j < 8; ++j) { const float ot = __shfl_xor(v[j], 2);
                o[j] = ((k & 2) ? (v[j] * cs64[j] + ot * sn64[j]) : (v[j] * cs64[j] - ot * sn64[j])) * QSC_A; }
            *(u32x4*)(QA + (size_t)tok * 512 + lane * 8) = pack8(o);
        }
        {
            const u32x4 raw = cur.raw[1]; unpack8(raw, v);
            float ss = 0.f;
#pragma unroll
            for (int j = 0; j < 8; ++j) ss += v[j] * v[j];
            ss += __shfl_xor(ss, 1); ss += __shfl_xor(ss, 2); ss += __shfl_xor(ss, 4);
            const float s8 = ss;
            ss += __shfl_xor(ss, 8); ss += __shfl_xor(ss, 16);
            const float s32 = ss;
            float vn[8]; const int k = lane & 7;
            { const float r = rsqrtf(s8 * (1.0f / 64.0f) + EPS);
#pragma unroll
                for (int j = 0; j < 8; ++j) vn[j] = v[j] * r * wk[j]; }
#pragma unroll
            for (int j = 0; j < 8; ++j) { const float ot = __shfl_xor(vn[j], 2);
                o[j] = lat ? ((k & 2) ? (vn[j] * cs64[j] + ot * sn64[j]) : (vn[j] * cs64[j] - ot * sn64[j])) : vn[j]; }
            if (lane < 16) *(u32x4*)(KA + kvrow * 128 + lane * 8) = pack8(o);
            else if (lane < 32) *(u32x4*)(VA + kvrow * 128 + (lane - 16) * 8) = raw;
            else if (lat) { const float r = rsqrtf(s32 * (1.0f / 256.0f) + EPS); const int cb = (lane - 32) * 8;
#pragma unroll
                for (int j = 0; j < 8; ++j) o[j] = v[j] * r * wcq[j];
                *(u32x4*)(CQN + (size_t)tok * 256 + cb) = pack8(o); }
        }
        {
            unpack8(cur.raw[2], v);
            float ss = 0.f;
#pragma unroll
            for (int j = 0; j < 8; ++j) ss += v[j] * v[j];
            ss += __shfl_xor(ss, 1); ss += __shfl_xor(ss, 2); ss += __shfl_xor(ss, 4); ss += __shfl_xor(ss, 8);
            const int k = lane & 3;
            float oth[8];
#pragma unroll
            for (int j = 0; j < 8; ++j) oth[j] = __shfl_xor(v[j], 1);
            if (lane < 16) { const float r = rsqrtf(ss * (1.0f / 128.0f) + EPS);
#pragma unroll
                for (int j = 0; j < 8; ++j) o[j] = v[j] * r * wckv[j];
                *(u32x4*)(CKVN + kvrow * 128 + lane * 8) = pack8(o); }
            else if (lane < 20) {
                const float cs32[8] = {cur.c32[0].x, cur.c32[0].y, cur.c32[0].z, cur.c32[0].w, cur.c32[1].x, cur.c32[1].y, cur.c32[1].z, cur.c32[1].w};
                const float sn32[8] = {cur.s32[0].x, cur.s32[0].y, cur.s32[0].z, cur.s32[0].w, cur.s32[1].x, cur.s32[1].y, cur.s32[1].z, cur.s32[1].w};
#pragma unroll
                for (int j = 0; j < 8; ++j) o[j] = lat ? ((k & 1) ? (v[j] * cs32[j] + oth[j] * sn32[j]) : (v[j] * cs32[j] - oth[j] * sn32[j])) : v[j];
                const u32x4 w = pack8(o);
#pragma unroll
                for (int h = 0; h < 8; ++h) *(u32x4*)(KM + kvrow * 768 + h * 96 + 64 + k * 8) = w; }
            else if (lat) {
#pragma unroll
                for (int j = 0; j < 8; ++j) o[j] = silu(v[j]);
                *(u32x4*)(G + (size_t)tok * 1024 + (lane - 20) * 8) = pack8(o); }
        }
        if (lat) {
            unpack8(cur.raw[3], v);
#pragma unroll
            for (int j = 0; j < 8; ++j) o[j] = silu(v[j]);
            *(u32x4*)(G + (size_t)tok * 1024 + 352 + lane * 8) = pack8(o);
            if (lane < 20) { unpack8(cur.raw[4], v);
#pragma unroll
                for (int j = 0; j < 8; ++j) o[j] = silu(v[j]);
                *(u32x4*)(G + (size_t)tok * 1024 + 864 + lane * 8) = pack8(o); }
        }
        cur = nxt;
    }
}

template <int DQK>
DEV void attn_unit(char* lds, const bf16_t* __restrict__ Q, int ldq, int qcol, const bf16_t* __restrict__ Kp, int ldk, int kcol, const bf16_t* __restrict__ Vp, int ldv, int vcol,
                   const bf16_t* __restrict__ Gt, bf16_t* OG, int ocol, int b, int q0) {
    constexpr int KRS = (DQK + 8) * 2, KB = 64 * KRS, VRS = 192, VB = 64 * VRS, STG = KB + VB, NKS = DQK / 16, KCH = DQK / 8;
    const int tid = TID(), lane = tid & 63, wid = tid >> 6, l31 = lane & 31, hi = lane >> 5;
    bf16x8 qf[NKS];
    { const bf16_t* qp = Q + (size_t)(b * SEQ + q0 + wid * 32 + l31) * ldq + qcol + hi * 8;
#pragma unroll
        for (int ks = 0; ks < NKS; ++ks) qf[ks] = *(const bf16x8*)(qp + ks * 16); }
    const bf16_t* kbase = Kp + (size_t)b * LK * ldk + kcol; const bf16_t* vbase = Vp + (size_t)b * LK * ldv + vcol;
    const int kr0 = tid / KCH, kc0 = tid % KCH;
    const int kr1 = (tid + 512) / KCH, kc1 = (tid + 512) % KCH;
    const bool k2 = (KCH * 64 > 512) && (tid + 512 < KCH * 64);
    const int vr = tid >> 3, vc = tid & 7;
    u32x4 sk0, sk1, sv;
#define A_LOAD(t) do { const size_t kp_ = (size_t)(t) * 64; sk0 = *(const u32x4*)(kbase + (kp_ + kr0) * ldk + kc0 * 8); \
        if (k2) sk1 = *(const u32x4*)(kbase + (kp_ + kr1) * ldk + kc1 * 8); sv = *(const u32x4*)(vbase + (kp_ + vr) * ldv + vc * 8); } while (0)
#define A_STORE(buf) do { char* b_ = lds + (buf) * STG; *(u32x4*)(b_ + kr0 * KRS + kc0 * 16) = sk0; if (k2) *(u32x4*)(b_ + kr1 * KRS + kc1 * 16) = sk1; \
        *(u32x4*)(b_ + KB + vr * VRS + vc * 16) = sv; } while (0)
    f32x16 o0, o1;
#pragma unroll
    for (int r = 0; r < 16; ++r) { o0[r] = 0.f; o1[r] = 0.f; }
    float m_run = -1e30f, l_run = 0.f;
    const int g1 = (lane >> 4) & 1, tq = (lane & 15) >> 2, tp = lane & 3;
    const int vt_off = KB + (4 * hi + tq) * VRS + (16 * g1 + 4 * tp) * 2;
    const int kf_off = l31 * KRS + hi * 16;
    constexpr int NT = LK / 64;
    A_LOAD(0); A_STORE(0);
    __syncthreads();
    for (int t = 0; t < NT; ++t) {
        const bool more = (t + 1 < NT);
        if (more) A_LOAD(t + 1);
        const char* b_ = lds + (t & 1) * STG;
        f32x16 p0, p1;
#pragma unroll
        for (int r = 0; r < 16; ++r) { p0[r] = 0.f; p1[r] = 0.f; }
#pragma unroll
        for (int ks = 0; ks < NKS; ++ks) {
            const bf16x8 ka = *(const bf16x8*)(b_ + kf_off + ks * 32);
            const bf16x8 kb = *(const bf16x8*)(b_ + kf_off + 32 * KRS + ks * 32);
            p0 = __builtin_amdgcn_mfma_f32_32x32x16_bf16(ka, qf[ks], p0, 0, 0, 0);
            p1 = __builtin_amdgcn_mfma_f32_32x32x16_bf16(kb, qf[ks], p1, 0, 0, 0);
        }
        float mx = p0[0];
#pragma unroll
        for (int r = 1; r < 16; ++r) mx = fmaxf(mx, p0[r]);
#pragma unroll
        for (int r = 0; r < 16; ++r) mx = fmaxf(mx, p1[r]);
        mx = fmaxf(mx, __shfl_xor(mx, 32));
        const float m_new = fmaxf(m_run, mx);
        const float alpha = __builtin_amdgcn_exp2f(m_run - m_new);
        m_run = m_new;
        float ls = 0.f;
#pragma unroll
        for (int r = 0; r < 16; ++r) { p0[r] = __builtin_amdgcn_exp2f(p0[r] - m_new); p1[r] = __builtin_amdgcn_exp2f(p1[r] - m_new); ls += p0[r] + p1[r]; }
        l_run = l_run * alpha + ls;
#pragma unroll
        for (int r = 0; r < 16; ++r) { o0[r] *= alpha; o1[r] *= alpha; }
        u32x4 pw[4];
        pw[0] = (u32x4){pk2(p0[0], p0[1]), pk2(p0[2], p0[3]), pk2(p0[4], p0[5]), pk2(p0[6], p0[7])};
        pw[1] = (u32x4){pk2(p0[8], p0[9]), pk2(p0[10], p0[11]), pk2(p0[12], p0[13]), pk2(p0[14], p0[15])};
        pw[2] = (u32x4){pk2(p1[0], p1[1]), pk2(p1[2], p1[3]), pk2(p1[4], p1[5]), pk2(p1[6], p1[7])};
        pw[3] = (u32x4){pk2(p1[8], p1[9]), pk2(p1[10], p1[11]), pk2(p1[12], p1[13]), pk2(p1[14], p1[15])};
#pragma unroll
        for (int s = 0; s < 4; ++s) {
            const bf16x8 pb = __builtin_bit_cast(bf16x8, pw[s]);
#pragma unroll
            for (int dt = 0; dt < 2; ++dt) {
                const char* vp = b_ + vt_off + s * 16 * VRS + dt * 64;
                const s16x4 lo = __builtin_bit_cast(s16x4, __builtin_amdgcn_ds_read_tr16_b64_v4i16((LAS s16x4*)vp));
                const s16x4 hh = __builtin_bit_cast(s16x4, __builtin_amdgcn_ds_read_tr16_b64_v4i16((LAS s16x4*)(vp + 8 * VRS)));
                const bf16x8 vf = (bf16x8){lo[0], lo[1], lo[2], lo[3], hh[0], hh[1], hh[2], hh[3]};
                if (dt == 0) o0 = __builtin_amdgcn_mfma_f32_32x32x16_bf16(vf, pb, o0, 0, 0, 0);
                else o1 = __builtin_amdgcn_mfma_f32_32x32x16_bf16(vf, pb, o1, 0, 0, 0);
            }
        }
        if (more) A_STORE((t + 1) & 1);
        __syncthreads();
    }
#undef A_LOAD
#undef A_STORE
    const float lt = l_run + __shfl_xor(l_run, 32); const float inv = 1.0f / lt;
    const size_t tok = (size_t)(b * SEQ + q0 + wid * 32 + l31);
#pragma unroll
    for (int dt = 0; dt < 2; ++dt)
#pragma unroll
        for (int g = 0; g < 4; ++g) { const int d = 32 * dt + 8 * g + 4 * hi; const size_t off = tok * 1024 + ocol + d;
            const u32x2 gw = *(const u32x2*)(Gt + off);
            const f32x16& oo = dt ? o1 : o0;
            u32x2 w; w.x = pk2(oo[4 * g] * inv * lo_bf(gw.x), oo[4 * g + 1] * inv * hi_bf(gw.x)); w.y = pk2(oo[4 * g + 2] * inv * lo_bf(gw.y), oo[4 * g + 3] * inv * hi_bf(gw.y));
            *(u32x2*)(OG + off) = w; }
}

DEV float max3f_s(float a, float b, float c) { float r; asm("v_max3_f32 %0, %1, %2, %3" : "=v"(r) : "v"(a), "v"(b), "v"(c)); return r; }
DEV float max2f_s(float a, float b) { float r; asm("v_max_f32_e32 %0, %1, %2" : "=v"(r) : "v"(a), "v"(b)); return r; }
DEV float fadd_s(float a, float b) { float r; asm("v_add_f32_e32 %0, %1, %2" : "=v"(r) : "v"(a), "v"(b)); return r; }
DEV float sum8_after_trans(float a, float b, float c, float d, float e, float f, float g, float h) {
    float r, t;
    asm("s_nop 0\n\tv_add_f32_e32 %0, %2, %3\n\tv_add_f32_e32 %1, %4, %5\n\tv_add_f32_e32 %0, %0, %6\n\tv_add_f32_e32 %1, %1, %7\n\tv_add_f32_e32 %0, %0, %8\n\tv_add_f32_e32 %1, %1, %9\n\tv_add_f32_e32 %0, %0, %1"
        : "=&v"(r), "=&v"(t) : "v"(a), "v"(b), "v"(c), "v"(d), "v"(e), "v"(f), "v"(g), "v"(h));
    return r;
}
DEV float swapmax32(float v) { auto rr = __builtin_amdgcn_permlane32_swap(__float_as_uint(v), __float_as_uint(v), false, false); return fmaxf(__uint_as_float(rr[0]), __uint_as_float(rr[1])); }
DEV float swapsum32(float v) { auto rr = __builtin_amdgcn_permlane32_swap(__float_as_uint(v), __float_as_uint(v), false, false); return __uint_as_float(rr[0]) + __uint_as_float(rr[1]); }
template <int DQK>
DEV void attn_unit2(char* lds, const bf16_t* __restrict__ Q, int ldq, int qcol, const bf16_t* __restrict__ Kp, int ldk, int kcol, const bf16_t* __restrict__ Vp, int ldv, int vcol,
                    const bf16_t* __restrict__ Gt, bf16_t* OG, int ocol, int b, int q0) {
    constexpr int KRS = (DQK + 8) * 2, KB = 64 * KRS, VRS = 192, VB = 64 * VRS, NKS = DQK / 16, KCH = DQK / 8, VOFF = 2 * KB;
    constexpr float THR = 8.0f;
    constexpr int NT = LK / 64;
    const int tid = TID(), lane = tid & 63, wid = tid >> 6, l31 = lane & 31, hi = lane >> 5;
    bf16x8 qf[NKS];
    { const bf16_t* qp = Q + (size_t)(b * SEQ + q0 + wid * 32 + l31) * ldq + qcol + hi * 8;
#pragma unroll
        for (int ks = 0; ks < NKS; ++ks) qf[ks] = *(const bf16x8*)(qp + ks * 16); }
    const bf16_t* kbase = Kp + (size_t)b * LK * ldk + kcol; const bf16_t* vbase = Vp + (size_t)b * LK * ldv + vcol;
    constexpr bool K2 = (KCH * 64 > 512);
    const bool k2 = K2 && (tid + 512 < KCH * 64);
    const int kr0 = tid / KCH, kc0 = tid % KCH, kr1 = k2 ? (tid + 512) / KCH : kr0, kc1 = k2 ? (tid + 512) % KCH : kc0;
    const int vr = tid >> 3, vc = tid & 7;
    u32x4 skX0, skX1 = {0u, 0u, 0u, 0u}, svX;
#define A_LOADK(t, S) do { const int tt_ = (t) < NT ? (t) : NT - 1; const size_t kp_ = (size_t)tt_ * 64; sk##S##0 = *(const u32x4*)(kbase + (kp_ + kr0) * ldk + kc0 * 8); if (K2) sk##S##1 = *(const u32x4*)(kbase + (kp_ + kr1) * ldk + kc1 * 8); } while (0)
#define A_LOADV(t, S) do { const int tt_ = (t) < NT ? (t) : NT - 1; sv##S = *(const u32x4*)(vbase + ((size_t)tt_ * 64 + vr) * ldv + vc * 8); } while (0)
#define A_STOREK(slot, S) do { char* b_ = lds + (slot) * KB; *(u32x4*)(b_ + kr0 * KRS + kc0 * 16) = sk##S##0; if (K2) *(u32x4*)(b_ + kr1 * KRS + kc1 * 16) = sk##S##1; } while (0)
#define A_STOREV(slot, S) do { *(u32x4*)(lds + VOFF + (slot) * VB + vr * VRS + vc * 16) = sv##S; } while (0)
    f32x16 o0, o1, negm;
#pragma unroll
    for (int r = 0; r < 16; ++r) { o0[r] = 0.f; o1[r] = 0.f; negm[r] = 0.f; }
    asm volatile("" : "+v"(negm));
    float mhat = 0.f, l_run = 0.f;
    const int g1 = (lane >> 4) & 1, tq = (lane & 15) >> 2, tp = lane & 3;
    const int vt_off = VOFF + (4 * hi + tq) * VRS + (16 * g1 + 4 * tp) * 2;
    const int kf_off = l31 * KRS + hi * 16;
#define A_QK(P0, P1, slot) do { const char* kb_ = lds + (slot) * KB + kf_off; \
        _Pragma("unroll") for (int ks = 0; ks < NKS; ++ks) { \
            const bf16x8 ka = *(const bf16x8*)(kb_ + ks * 32); const bf16x8 kb2 = *(const bf16x8*)(kb_ + 32 * KRS + ks * 32); \
            if (ks == 0) { P0 = __builtin_amdgcn_mfma_f32_32x32x16_bf16(ka, qf[0], negm, 0, 0, 0); P1 = __builtin_amdgcn_mfma_f32_32x32x16_bf16(kb2, qf[0], negm, 0, 0, 0); } \
            else { P0 = __builtin_amdgcn_mfma_f32_32x32x16_bf16(ka, qf[ks], P0, 0, 0, 0); P1 = __builtin_amdgcn_mfma_f32_32x32x16_bf16(kb2, qf[ks], P1, 0, 0, 0); } } } while (0)
    A_LOADK(0, X); A_LOADV(0, X); A_STOREK(0, X); A_STOREV(0, X); A_LOADK(1, X); A_STOREK(1, X);
    __syncthreads();
    f32x16 pA0, pA1, pB0, pB1;
#pragma unroll
    for (int r = 0; r < 16; ++r) { pB0[r] = 0.f; pB1[r] = 0.f; }
    A_QK(pA0, pA1, 0);
#define A_STEP(P0, P1, N0, N1, t, SL, SS) do { \
        A_LOADK((t) + 2, SL); A_LOADV((t) + 1, SL); \
        __builtin_amdgcn_s_setprio(1); A_QK(N0, N1, ((t) + 1) & 1); __builtin_amdgcn_s_setprio(0); \
        float a_ = fmaxf(fmaxf(P0[0], P0[1]), P1[0]), c_ = fmaxf(fmaxf(P0[2], P0[3]), P1[1]); a_ = fmaxf(fmaxf(a_, P1[2]), P1[3]); \
        _Pragma("unroll") for (int r = 4; r < 16; r += 4) { a_ = fmaxf(fmaxf(a_, P0[r]), P0[r + 1]); c_ = fmaxf(fmaxf(c_, P0[r + 2]), P0[r + 3]); a_ = fmaxf(fmaxf(a_, P1[r]), P1[r + 1]); c_ = fmaxf(fmaxf(c_, P1[r + 2]), P1[r + 3]); } \
        const float rm = swapmax32(fmaxf(a_, c_)); \
        if ((t) == 0 || __any(rm > THR)) { \
            const float dl = ((t) == 0) ? rm : fmaxf(rm, 0.f); mhat += dl; \
            _Pragma("unroll") for (int r = 0; r < 16; ++r) { P0[r] -= dl; P1[r] -= dl; N0[r] -= dl; N1[r] -= dl; } \
            if ((t) != 0) { const float f = __builtin_amdgcn_exp2f(-dl); l_run *= f; _Pragma("unroll") for (int r = 0; r < 16; ++r) { o0[r] *= f; o1[r] *= f; } } \
            _Pragma("unroll") for (int r = 0; r < 16; ++r) negm[r] = -mhat; asm volatile("" : "+v"(negm)); } \
        _Pragma("unroll") for (int r = 0; r < 16; ++r) { P0[r] = __builtin_amdgcn_exp2f(P0[r]); P1[r] = __builtin_amdgcn_exp2f(P1[r]); } \
        { const float q0_ = sum8_after_trans(P0[0], P0[1], P0[2], P0[3], P0[4], P0[5], P0[6], P0[7]), q1_ = sum8_after_trans(P0[8], P0[9], P0[10], P0[11], P0[12], P0[13], P0[14], P0[15]); \
          const float q2_ = sum8_after_trans(P1[0], P1[1], P1[2], P1[3], P1[4], P1[5], P1[6], P1[7]), q3_ = sum8_after_trans(P1[8], P1[9], P1[10], P1[11], P1[12], P1[13], P1[14], P1[15]); \
          l_run += (q0_ + q1_) + (q2_ + q3_); } \
        u32x4 pw[4]; \
        pw[0] = (u32x4){pk2(P0[0], P0[1]), pk2(P0[2], P0[3]), pk2(P0[4], P0[5]), pk2(P0[6], P0[7])}; \
        pw[1] = (u32x4){pk2(P0[8], P0[9]), pk2(P0[10], P0[11]), pk2(P0[12], P0[13]), pk2(P0[14], P0[15])}; \
        pw[2] = (u32x4){pk2(P1[0], P1[1]), pk2(P1[2], P1[3]), pk2(P1[4], P1[5]), pk2(P1[6], P1[7])}; \
        pw[3] = (u32x4){pk2(P1[8], P1[9]), pk2(P1[10], P1[11]), pk2(P1[12], P1[13]), pk2(P1[14], P1[15])}; \
        { const char* vb_ = lds + ((t) & 1) * VB + vt_off; \
        _Pragma("unroll") for (int s = 0; s < 4; ++s) { const bf16x8 pb = __builtin_bit_cast(bf16x8, pw[s]); \
            _Pragma("unroll") for (int dt = 0; dt < 2; ++dt) { const char* vp = vb_ + s * 16 * VRS + dt * 64; \
                const s16x4 lo = __builtin_bit_cast(s16x4, __builtin_amdgcn_ds_read_tr16_b64_v4i16((LAS s16x4*)vp)); \
                const s16x4 hh = __builtin_bit_cast(s16x4, __builtin_amdgcn_ds_read_tr16_b64_v4i16((LAS s16x4*)(vp + 8 * VRS))); \
                const bf16x8 vf = (bf16x8){lo[0], lo[1], lo[2], lo[3], hh[0], hh[1], hh[2], hh[3]}; \
                if (dt == 0) o0 = __builtin_amdgcn_mfma_f32_32x32x16_bf16(vf, pb, o0, 0, 0, 0); else o1 = __builtin_amdgcn_mfma_f32_32x32x16_bf16(vf, pb, o1, 0, 0, 0); } } } \
        A_STOREK((t) & 1, SS); A_STOREV(((t) + 1) & 1, SS); \
        __syncthreads(); } while (0)
    for (int t = 0; t < NT; t += 2) {
        A_STEP(pA0, pA1, pB0, pB1, t, X, X);
        A_STEP(pB0, pB1, pA0, pA1, t + 1, X, X);
    }
#undef A_STEP
#undef A_QK
#undef A_LOADK
#undef A_LOADV
#undef A_STOREK
#undef A_STOREV
    const float inv = 1.0f / swapsum32(l_run);
    const size_t tok = (size_t)(b * SEQ + q0 + wid * 32 + l31);
#pragma unroll
    for (int dt = 0; dt < 2; ++dt)
#pragma unroll
        for (int g = 0; g < 4; ++g) { const int d = 32 * dt + 8 * g + 4 * hi; const size_t off = tok * 1024 + ocol + d;
            const u32x2 gw = *(const u32x2*)(Gt + off);
            const f32x16& oo = dt ? o1 : o0;
            u32x2 w; w.x = pk2(oo[4 * g] * inv * lo_bf(gw.x), oo[4 * g + 1] * inv * hi_bf(gw.x)); w.y = pk2(oo[4 * g + 2] * inv * lo_bf(gw.y), oo[4 * g + 3] * inv * hi_bf(gw.y));
            *(u32x2*)(OG + off) = w; }
}

DEV void phase_attn(char* lds, const Params& p) {
    const bf16_t* QA = (const bf16_t*)(p.ws + WS_QA); const bf16_t* KA = (const bf16_t*)(p.ws + WS_KA); const bf16_t* VA = (const bf16_t*)(p.ws + WS_VA);
    const bf16_t* QM = (const bf16_t*)(p.ws + WS_QM); const bf16_t* KM = (const bf16_t*)(p.ws + WS2_KM); const bf16_t* VM = (const bf16_t*)(p.ws + WS2_VM);
    const bf16_t* G = (const bf16_t*)(p.ws + WS_G); bf16_t* OG = (bf16_t*)(p.ws + WS2_OG);
    const int vblk = (gridDim.x % 8 == 0) ? (int)((blockIdx.x % 8) * (gridDim.x / 8) + blockIdx.x / 8) : (int)blockIdx.x;
    for (int u = vblk; u < 2048; u += gridDim.x) {
        const int type = u >> 10, rem = u & 1023, b = rem >> 7, h = (rem >> 4) & 7, qb = rem & 15;
        if (type == 0) attn_unit2<64>(lds, QA, 512, h * 64, KA, 128, (h >> 2) * 64, VA, 128, (h >> 2) * 64, G, OG, h * 64, b, qb * 256);
        else attn_unit2<96>(lds, QM, 768, h * 96, KM, 768, h * 96, VM, 512, h * 64, G, OG, 512 + h * 64, b, qb * 256);
    }
}

constexpr int CV_PADL = 192, CV_ROW = 4488, CV_RS = CV_ROW * 2;
constexpr int CV_UB = 8 * CV_RS;
constexpr int CV_FS = 16416;
DEV void conv_load_filter(char* lds, const bf16_t* gr) {
    const int tid = TID();
#pragma unroll
    for (int rnd = 0; rnd < 2; ++rnd) {
        const int ch = tid + rnd * 512;
        const u32x4 a = *(const u32x4*)(gr + ch * 8);
        u32x4 bq = {0u, 0u, 0u, 0u}; if (ch + 1 < 1024) bq = *(const u32x4*)(gr + ch * 8 + 8);
        const unsigned w[8] = {a.x, a.y, a.z, a.w, bq.x, bq.y, bq.z, bq.w};
        char* f = lds + CV_UB + ch * 16;
        *(u32x4*)(f) = a;
        u32x4 c1, c2, c3;
        c1.x = __builtin_amdgcn_alignbit(w[1], w[0], 16); c1.y = __builtin_amdgcn_alignbit(w[2], w[1], 16); c1.z = __builtin_amdgcn_alignbit(w[3], w[2], 16); c1.w = __builtin_amdgcn_alignbit(w[4], w[3], 16);
        c2 = (u32x4){w[1], w[2], w[3], w[4]};
        c3.x = __builtin_amdgcn_alignbit(w[2], w[1], 16); c3.y = __builtin_amdgcn_alignbit(w[3], w[2], 16); c3.z = __builtin_amdgcn_alignbit(w[4], w[3], 16); c3.w = __builtin_amdgcn_alignbit(w[5], w[4], 16);
        *(u32x4*)(f + CV_FS) = c1; *(u32x4*)(f + 2 * CV_FS) = c2; *(u32x4*)(f + 3 * CV_FS) = c3;
    }
}
DEV void sconv4(const bf16_t* px, int t, float w0, float w1, float w2, float bias, float* u) {
    const u32x2 mid = *(const u32x2*)(px + t);
    const float pm = (t > 0) ? bf2f(px[t - 1]) : 0.f, pp = (t + 4 < SEQ) ? bf2f(px[t + 4]) : 0.f;
    const float q0 = lo_bf(mid.x), q1 = hi_bf(mid.x), q2 = lo_bf(mid.y), q3 = hi_bf(mid.y);
    u[0] = w0 * pm + w1 * q0 + w2 * q1 + bias; u[1] = w0 * q0 + w1 * q1 + w2 * q2 + bias; u[2] = w0 * q1 + w1 * q2 + w2 * q3 + bias; u[3] = w0 * q2 + w1 * q3 + w2 * pp + bias;
}
template <bool V0, bool V1>
DEV void conv_step(const char* lds, f32x16 (&acc)[2][2], const int (&a_off)[2], const int (&b_off)[2], int d) {
    bf16x8 fa[2][4];
#pragma unroll
    for (int mt = 0; mt < 2; ++mt)
#pragma unroll
        for (int ks = 0; ks < 4; ++ks) { const char* ap = lds + a_off[mt] - 128 * d + ks * 32;
            const u32x2 lo = *(const u32x2*)ap, hh = *(const u32x2*)(ap + 8);
            fa[mt][ks] = __builtin_bit_cast(bf16x8, (u32x4){lo.x, lo.y, hh.x, hh.y}); }
#pragma unroll
    for (int n = 0; n < 2; ++n) {
        if ((n == 0 && V0) || (n == 1 && V1)) {
#pragma unroll
            for (int ks = 0; ks < 4; ++ks) { const bf16x8 fb = *(const bf16x8*)(lds + b_off[n] - 128 * d + ks * 32);
#pragma unroll
                for (int mt = 0; mt < 2; ++mt) acc[n][mt] = __builtin_amdgcn_mfma_f32_32x32x16_bf16(fa[mt][ks], fb, acc[n][mt], 0, 0, 0); }
        }
    }
}
struct ConvFrags { bf16x8 a[6], b0[4], b1[4]; };
DEV void conv_load_frags(ConvFrags& F, const char* lds, int a_off0, int a_off0h, int b_off0, int b_off1, int d) {
#pragma unroll
    for (int j = 0; j < 6; ++j) { const u32x2 lo = *(const u32x2*)(lds + a_off0 - 128 * d + (j - 2) * 32), hh = *(const u32x2*)(lds + a_off0h - 128 * d + (j - 2) * 32);
        F.a[j] = __builtin_bit_cast(bf16x8, (u32x4){lo.x, lo.y, hh.x, hh.y}); }
#pragma unroll
    for (int ks = 0; ks < 4; ++ks) { F.b0[ks] = *(const bf16x8*)(lds + b_off0 - 128 * d + ks * 32); F.b1[ks] = *(const bf16x8*)(lds + b_off1 - 128 * d + ks * 32); }
}
DEV void conv_mfma_frags(const ConvFrags& F, f32x16 (&acc)[2][2]) {
#pragma unroll
    for (int ks = 0; ks < 4; ++ks) {
        acc[0][0] = __builtin_amdgcn_mfma_f32_32x32x16_bf16(F.a[ks + 2], F.b0[ks], acc[0][0], 0, 0, 0);
        acc[0][1] = __builtin_amdgcn_mfma_f32_32x32x16_bf16(F.a[ks], F.b0[ks], acc[0][1], 0, 0, 0);
        acc[1][0] = __builtin_amdgcn_mfma_f32_32x32x16_bf16(F.a[ks + 2], F.b1[ks], acc[1][0], 0, 0, 0);
        acc[1][1] = __builtin_amdgcn_mfma_f32_32x32x16_bf16(F.a[ks], F.b1[ks], acc[1][1], 0, 0, 0);
    }
}
DEV void conv_mfma_loop(const char* lds, f32x16 (&acc)[2][2], int wid, int lane) {
    const int l31 = lane & 31, hi = lane >> 5;
#pragma unroll
    for (int a = 0; a < 2; ++a)
#pragma unroll
        for (int b = 0; b < 2; ++b)
#pragma unroll
            for (int r = 0; r < 16; ++r) acc[a][b][r] = 0.f;
    int a_off[2];
#pragma unroll
    for (int mt = 0; mt < 2; ++mt) { const int r = l31 + 32 * mt, q = (4 - (r & 3)) & 3; a_off[mt] = CV_UB + q * CV_FS + (4096 - r - q + 8 * hi) * 2; }
    int b_off[2];
#pragma unroll
    for (int n = 0; n < 2; ++n) { const int nt = 2 * wid + n; b_off[n] = (l31 & 7) * CV_RS + (CV_PADL + 64 * (4 * nt + (l31 >> 3)) + 8 * hi) * 2; }
    const int dlo = 8 * wid - 63;
#pragma unroll
    for (int j = 0; j < 4; ++j) conv_step<true, false>(lds, acc, a_off, b_off, dlo + j);
    ConvFrags F0, F1; const int d0 = dlo + 4; int a_hi = a_off[0] + 8; asm volatile("" : "+v"(a_hi));
    conv_load_frags(F0, lds, a_off[0], a_hi, b_off[0], b_off[1], d0);
#pragma unroll 1
    for (int j = 0; j < 31; ++j) { const int d = d0 + 2 * j;
        conv_load_frags(F1, lds, a_off[0], a_hi, b_off[0], b_off[1], d + 1); __builtin_amdgcn_sched_barrier(0);
        conv_mfma_frags(F0, acc); __builtin_amdgcn_sched_barrier(0);
        conv_load_frags(F0, lds, a_off[0], a_hi, b_off[0], b_off[1], d + 2); __builtin_amdgcn_sched_barrier(0);
        conv_mfma_frags(F1, acc); __builtin_amdgcn_sched_barrier(0); }
    conv_mfma_frags(F0, acc);
#pragma unroll
    for (int j = 0; j < 4; ++j) conv_step<false, true>(lds, acc, a_off, b_off, dlo + 67 + j);
}
DEV void conv_unit(char* lds, const Params& p, int c) {
    const int tid = TID(), lane = tid & 63, wid = tid >> 6, l31 = lane & 31, hi = lane >> 5;
    const bf16_t* PT = (const bf16_t*)(p.ws + WS_PT); const bf16_t* GR = (const bf16_t*)(p.ws + WS_GR); const float* ssum = (const float*)(p.ws + WS_SSUM);
    bf16_t* OG2 = (bf16_t*)(p.ws + WS_OG2);
    for (int i = tid; i < 8 * 98; i += 512) { const int b = i / 98, j = i % 98;
        const int e = (j < 48) ? j * 4 : (CV_PADL + SEQ + (j - 48) * 4); *(u32x2*)(lds + b * CV_RS + e * 2) = (u32x2){0u, 0u}; }
    { const float w0 = p.conv_w[c], w1 = p.conv_w[3072 + c], w2 = p.conv_w[6144 + c], bias = p.conv_b[c];
        for (int i = tid; i < 8 * 1024; i += 512) { const int b = i >> 10, t = (i & 1023) * 4; float u[4];
            sconv4(PT + ((size_t)(b * 4096 + c)) * 4096, t, w0, w1, w2, bias, u);
            u32x2 w; w.x = pk2(u[0], u[1]); w.y = pk2(u[2], u[3]); *(u32x2*)(lds + b * CV_RS + (CV_PADL + t) * 2) = w; } }
    conv_load_filter(lds, GR + (size_t)c * 8192);
    __syncthreads();
    f32x16 acc[2][2];
    conv_mfma_loop(lds, acc, wid, lane);
    __syncthreads();
    { const float invs = 1.0f / ssum[c], sk = p.skip[c];
        const float w0 = p.conv_w[1024 + c], w1 = p.conv_w[3072 + 1024 + c], w2 = p.conv_w[6144 + 1024 + c], bias = p.conv_b[1024 + c];
        const int b = l31 & 7;
#pragma unroll
        for (int n = 0; n < 2; ++n) { const int i = 4 * (2 * wid + n) + (l31 >> 3);
#pragma unroll
            for (int mt = 0; mt < 2; ++mt)
#pragma unroll
                for (int g = 0; g < 4; ++g) { const int t = 64 * i + 32 * mt + 8 * g + 4 * hi; float x1[4];
                    sconv4(PT + ((size_t)(b * 4096 + 1024 + c)) * 4096, t, w0, w1, w2, bias, x1);
                    char* up = lds + b * CV_RS + (CV_PADL + t) * 2; const u32x2 vw = *(const u32x2*)up;
                    const float z0 = x1[0] * (acc[n][mt][4 * g] * invs + sk * lo_bf(vw.x)), z1 = x1[1] * (acc[n][mt][4 * g + 1] * invs + sk * hi_bf(vw.x));
                    const float z2 = x1[2] * (acc[n][mt][4 * g + 2] * invs + sk * lo_bf(vw.y)), z3 = x1[3] * (acc[n][mt][4 * g + 3] * invs + sk * hi_bf(vw.y));
                    u32x2 w; w.x = pk2(z0, z1); w.y = pk2(z2, z3); *(u32x2*)up = w; } } }
    conv_load_filter(lds, GR + (size_t)(1024 + c) * 8192);
    __syncthreads();
    conv_mfma_loop(lds, acc, wid, lane);
    { const float invs = 1.0f / ssum[1024 + c], sk = p.skip[1024 + c];
        const float w0 = p.conv_w[2048 + c], w1 = p.conv_w[3072 + 2048 + c], w2 = p.conv_w[6144 + 2048 + c], bias = p.conv_b[2048 + c];
        const int b = l31 & 7;
#pragma unroll
        for (int n = 0; n < 2; ++n) { const int i = 4 * (2 * wid + n) + (l31 >> 3);
#pragma unroll
            for (int mt = 0; mt < 2; ++mt)
#pragma unroll
                for (int g = 0; g < 4; ++g) { const int t = 64 * i + 32 * mt + 8 * g + 4 * hi; float x2[4];
                    sconv4(PT + ((size_t)(b * 4096 + 2048 + c)) * 4096, t, w0, w1, w2, bias, x2);
                    const u32x2 zw = *(const u32x2*)(lds + b * CV_RS + (CV_PADL + t) * 2);
                    const u32x2 gw = *(const u32x2*)(PT + ((size_t)(b * 4096 + 3072 + c)) * 4096 + t);
                    const float y0 = x2[0] * (acc[n][mt][4 * g] * invs + sk * lo_bf(zw.x)) * silu(lo_bf(gw.x)), y1 = x2[1] * (acc[n][mt][4 * g + 1] * invs + sk * hi_bf(zw.x)) * silu(hi_bf(gw.x));
                    const float y2 = x2[2] * (acc[n][mt][4 * g + 2] * invs + sk * lo_bf(zw.y)) * silu(lo_bf(gw.y)), y3 = x2[3] * (acc[n][mt][4 * g + 3] * invs + sk * hi_bf(zw.y)) * silu(hi_bf(gw.y));
                    u32x2 w; w.x = pk2(y0, y1); w.y = pk2(y2, y3); *(u32x2*)(OG2 + ((size_t)(b * 1024 + c)) * 4096 + t) = w; } } }
    __syncthreads();
}

struct Raw3 { u32x2 mid; unsigned halo; };
DEV Raw3 ld_raw3(const bf16_t* px, int t) {
    Raw3 r; r.mid = *(const u32x2*)(px + t);
    const unsigned a = px[t - 1], b = px[t + 4];
    r.halo = (t > 0 ? a : 0u) | ((t + 4 < SEQ ? b : 0u) << 16);
    return r;
}
DEV void sconv_raw(const Raw3& r, float w0, float w1, float w2, float bias, float* u) {
    const float pm = lo_bf(r.halo), pp = hi_bf(r.halo), q0 = lo_bf(r.mid.x), q1 = hi_bf(r.mid.x), q2 = lo_bf(r.mid.y), q3 = hi_bf(r.mid.y);
    u[0] = w0 * pm + w1 * q0 + w2 * q1 + bias; u[1] = w0 * q0 + w1 * q1 + w2 * q2 + bias; u[2] = w0 * q1 + w1 * q2 + w2 * q3 + bias; u[3] = w0 * q2 + w1 * q3 + w2 * pp + bias;
}
struct FiltRegs { u32x4 a[2], b[2]; };
DEV void filt_load(FiltRegs& f, const bf16_t* gr, int tid) {
#pragma unroll
    for (int rnd = 0; rnd < 2; ++rnd) { const int ch = tid + rnd * 512; f.a[rnd] = *(const u32x4*)(gr + ch * 8);
        const int ch1 = ch + 1 < 1024 ? ch + 1 : ch; const u32x4 t = *(const u32x4*)(gr + ch1 * 8); f.b[rnd] = (ch + 1 < 1024) ? t : (u32x4){0u, 0u, 0u, 0u}; }
}
DEV void filt_store(char* lds, const FiltRegs& f, int tid) {
#pragma unroll
    for (int rnd = 0; rnd < 2; ++rnd) { const int ch = tid + rnd * 512; const u32x4 a = f.a[rnd], bq = f.b[rnd];
        const unsigned w[8] = {a.x, a.y, a.z, a.w, bq.x, bq.y, bq.z, bq.w};
        char* fp = lds + CV_UB + ch * 16;
        *(u32x4*)(fp) = a;
        u32x4 c1, c2, c3;
        c1.x = __builtin_amdgcn_alignbit(w[1], w[0], 16); c1.y = __builtin_amdgcn_alignbit(w[2], w[1], 16); c1.z = __builtin_amdgcn_alignbit(w[3], w[2], 16); c1.w = __builtin_amdgcn_alignbit(w[4], w[3], 16);
        c2 = (u32x4){w[1], w[2], w[3], w[4]};
        c3.x = __builtin_amdgcn_alignbit(w[2], w[1], 16); c3.y = __builtin_amdgcn_alignbit(w[3], w[2], 16); c3.z = __builtin_amdgcn_alignbit(w[4], w[3], 16); c3.w = __builtin_amdgcn_alignbit(w[5], w[4], 16);
        *(u32x4*)(fp + CV_FS) = c1; *(u32x4*)(fp + 2 * CV_FS) = c2; *(u32x4*)(fp + 3 * CV_FS) = c3; }
}
#define CV_T(k) (64 * (4 * (2 * wid + ((k) >> 3)) + (l31 >> 3)) + 32 * (((k) >> 2) & 1) + 8 * ((k) & 3) + 4 * hi)
#define CV_LANE_IDS() int tid = TID(); asm volatile("" : "+v"(tid));   \
    const int lane = tid & 63, wid = __builtin_amdgcn_readfirstlane(tid >> 6), l31 = lane & 31, hi = lane >> 5, eb = l31 & 7; (void)eb; (void)hi; (void)wid
DEV void conv_stage_load(char* lds, const Params& p, int c) {
    CV_LANE_IDS();
    const bf16_t* PT = (const bf16_t*)(p.ws + WS_PT); const bf16_t* GR = (const bf16_t*)(p.ws + WS_GR);
    FiltRegs f0; filt_load(f0, GR + (size_t)c * 8192, tid);
    Raw3 ru[16];
#pragma unroll
    for (int k = 0; k < 16; ++k) { const int i = tid + k * 512, b = i >> 10, t = (i & 1023) * 4; ru[k] = ld_raw3(PT + ((size_t)(b * 4096 + c)) * 4096, t); }
    for (int i = tid; i < 8 * 98; i += 512) { const int b = i / 98, j = i % 98;
        const int e = (j < 48) ? j * 4 : (CV_PADL + SEQ + (j - 48) * 4); *(u32x2*)(lds + b * CV_RS + e * 2) = (u32x2){0u, 0u}; }
    const float w0 = p.conv_w[c], w1 = p.conv_w[3072 + c], w2 = p.conv_w[6144 + c], bias = p.conv_b[c];
#pragma unroll
    for (int k = 0; k < 16; ++k) { const int i = tid + k * 512, b = i >> 10, t = (i & 1023) * 4; float u[4]; sconv_raw(ru[k], w0, w1, w2, bias, u);
        u32x2 w; w.x = pk2(u[0], u[1]); w.y = pk2(u[2], u[3]); *(u32x2*)(lds + b * CV_RS + (CV_PADL + t) * 2) = w; }
    filt_store(lds, f0, tid);
}
DEV void conv_stage_epi0(char* lds, const Params& p, int c, const f32x16 (&acc)[2][2]) {
    CV_LANE_IDS();
    const bf16_t* PT = (const bf16_t*)(p.ws + WS_PT); const bf16_t* GR = (const bf16_t*)(p.ws + WS_GR); const float* ssum = (const float*)(p.ws + WS_SSUM);
    FiltRegs f1; filt_load(f1, GR + (size_t)(1024 + c) * 8192, tid);
    const bf16_t* px1 = PT + ((size_t)(eb * 4096 + 1024 + c)) * 4096;
    Raw3 r1[16];
#pragma unroll
    for (int k = 0; k < 16; ++k) r1[k] = ld_raw3(px1, CV_T(k));
    const float a0 = p.conv_w[1024 + c], a1 = p.conv_w[3072 + 1024 + c], a2 = p.conv_w[6144 + 1024 + c], ab = p.conv_b[1024 + c];
    const float invs = 1.0f / ssum[c], sk = p.skip[c];
#pragma unroll
    for (int k = 0; k < 16; ++k) { const int n = k >> 3, mt = (k >> 2) & 1, g = k & 3; const int t = CV_T(k);
        float x1[4]; sconv_raw(r1[k], a0, a1, a2, ab, x1);
        char* up = lds + eb * CV_RS + (CV_PADL + t) * 2; const u32x2 vw = *(const u32x2*)up;
        const float z0 = x1[0] * (acc[n][mt][4 * g] * invs + sk * lo_bf(vw.x)), z1 = x1[1] * (acc[n][mt][4 * g + 1] * invs + sk * hi_bf(vw.x));
        const float z2 = x1[2] * (acc[n][mt][4 * g + 2] * invs + sk * lo_bf(vw.y)), z3 = x1[3] * (acc[n][mt][4 * g + 3] * invs + sk * hi_bf(vw.y));
        u32x2 w; w.x = pk2(z0, z1); w.y = pk2(z2, z3); *(u32x2*)up = w; }
    filt_store(lds, f1, tid);
}
DEV void conv_stage_epi1(char* lds, const Params& p, int c, const f32x16 (&acc)[2][2]) {
    CV_LANE_IDS();
    const bf16_t* PT = (const bf16_t*)(p.ws + WS_PT); const float* ssum = (const float*)(p.ws + WS_SSUM); bf16_t* OG2 = (bf16_t*)(p.ws + WS_OG2);
    const bf16_t* px2 = PT + ((size_t)(eb * 4096 + 2048 + c)) * 4096; const bf16_t* pg = PT + ((size_t)(eb * 4096 + 3072 + c)) * 4096;
    Raw3 r2[16]; u32x2 rg[16];
#pragma unroll
    for (int k = 0; k < 16; ++k) { r2[k] = ld_raw3(px2, CV_T(k)); rg[k] = *(const u32x2*)(pg + CV_T(k)); }
    const float b0 = p.conv_w[2048 + c], b1 = p.conv_w[3072 + 2048 + c], b2 = p.conv_w[6144 + 2048 + c], bb = p.conv_b[2048 + c];
    const float invs = 1.0f / ssum[1024 + c], sk = p.skip[1024 + c];
#pragma unroll
    for (int k = 0; k < 16; ++k) { const int n = k >> 3, mt = (k >> 2) & 1, g = k & 3; const int t = CV_T(k);
        float x2[4]; sconv_raw(r2[k], b0, b1, b2, bb, x2);
        const u32x2 zw = *(const u32x2*)(lds + eb * CV_RS + (CV_PADL + t) * 2);
        const float y0 = x2[0] * silu(lo_bf(rg[k].x)) * (acc[n][mt][4 * g] * invs + sk * lo_bf(zw.x)), y1 = x2[1] * silu(hi_bf(rg[k].x)) * (acc[n][mt][4 * g + 1] * invs + sk * hi_bf(zw.x));
        const float y2 = x2[2] * silu(lo_bf(rg[k].y)) * (acc[n][mt][4 * g + 2] * invs + sk * lo_bf(zw.y)), y3 = x2[3] * silu(hi_bf(rg[k].y)) * (acc[n][mt][4 * g + 3] * invs + sk * hi_bf(zw.y));
        u32x2 w; w.x = pk2(y0, y1); w.y = pk2(y2, y3); *(u32x2*)(OG2 + ((size_t)(eb * 1024 + c)) * 4096 + t) = w; }
}
DEV void conv_stage_mfma(const char* lds, f32x16 (&acc)[2][2]) { CV_LANE_IDS(); conv_mfma_loop(lds, acc, wid, lane); }
DEV void conv_unit2(char* lds, const Params& p, int c) {
    conv_stage_load(lds, p, c);
    __syncthreads();
    f32x16 acc[2][2];
    conv_stage_mfma(lds, acc);
    __syncthreads();
    conv_stage_epi0(lds, p, c, acc);
    __syncthreads();
    conv_stage_mfma(lds, acc);
    conv_stage_epi1(lds, p, c, acc);
    __syncthreads();
}
#undef CV_T
#undef CV_LANE_IDS

struct cf { float x, y; };
DEV float s_add(float a, float b) { float r; asm("v_add_f32_e32 %0, %1, %2" : "=v"(r) : "v"(a), "v"(b)); return r; }
DEV float s_sub(float a, float b) { float r; asm("v_sub_f32_e32 %0, %1, %2" : "=v"(r) : "v"(a), "v"(b)); return r; }
DEV float s_mul(float a, float b) { float r; asm("v_mul_f32_e32 %0, %1, %2" : "=v"(r) : "v"(a), "v"(b)); return r; }
DEV float s_fma(float a, float b, float c) { float r; asm("v_fma_f32 %0, %1, %2, %3" : "=v"(r) : "v"(a), "v"(b), "v"(c)); return r; }
DEV float s_fnma(float a, float b, float c) { float r; asm("v_fma_f32 %0, -%1, %2, %3" : "=v"(r) : "v"(a), "v"(b), "v"(c)); return r; }
DEV cf cadd(cf a, cf b) { return cf{s_add(a.x, b.x), s_add(a.y, b.y)}; }
DEV cf csub(cf a, cf b) { return cf{s_sub(a.x, b.x), s_sub(a.y, b.y)}; }
DEV cf cmul(cf a, cf b) { cf r;
    asm("v_mul_f32_e32 %0, %2, %4\n\tv_mul_f32_e32 %1, %2, %5\n\tv_fma_f32 %0, -%3, %5, %0\n\tv_fma_f32 %1, %3, %4, %1" : "=&v"(r.x), "=&v"(r.y) : "v"(a.x), "v"(a.y), "v"(b.x), "v"(b.y)); return r; }
template <int M> DEV cf mulw16(cf a) {
    if constexpr (M == 0) return a;
    else if constexpr (M == 4) return cf{a.y, -a.x};
    else if constexpr (M == 2) return cf{s_mul(s_add(a.x, a.y), 0.70710678118654752f), s_mul(s_sub(a.y, a.x), 0.70710678118654752f)};
    else if constexpr (M == 6) return cf{s_mul(s_sub(a.y, a.x), 0.70710678118654752f), s_mul(s_add(a.x, a.y), -0.70710678118654752f)};
    else { constexpr float c = (M == 1) ? 0.92387953251128674f : (M == 3) ? 0.38268343236508977f : (M == 5) ? -0.38268343236508977f : -0.92387953251128674f;
           constexpr float sn = (M == 1) ? -0.38268343236508977f : (M == 3) ? -0.92387953251128674f : (M == 5) ? -0.92387953251128674f : -0.38268343236508977f;
           return cf{s_fnma(a.y, sn, s_mul(a.x, c)), s_fma(a.y, c, s_mul(a.x, sn))}; }
}
DEV void bfly4(cf a, cf b, cf& s_, cf& d_) {
    asm("v_add_f32_e32 %0, %4, %6\n\tv_add_f32_e32 %1, %5, %7\n\tv_sub_f32_e32 %2, %4, %6\n\tv_sub_f32_e32 %3, %5, %7" : "=&v"(s_.x), "=&v"(s_.y), "=&v"(d_.x), "=&v"(d_.y) : "v"(a.x), "v"(a.y), "v"(b.x), "v"(b.y)); }
template <int HALF, int BLK, int J> DEV void dif_bfly(cf (&v)[16]) { const cf a = v[BLK + J], b = v[BLK + J + HALF]; cf sm, df; bfly4(a, b, sm, df); v[BLK + J] = sm; v[BLK + J + HALF] = mulw16<J * (8 / HALF)>(df); }
DEV void dft16(cf (&v)[16]) {
#define B8(j) dif_bfly<8, 0, j>(v)
    B8(0); B8(1); B8(2); B8(3); B8(4); B8(5); B8(6); B8(7);
#undef B8
#define B4(b, j) dif_bfly<4, b, j>(v)
    B4(0, 0); B4(0, 1); B4(0, 2); B4(0, 3); B4(8, 0); B4(8, 1); B4(8, 2); B4(8, 3);
#undef B4
#define B2(b, j) dif_bfly<2, b, j>(v)
    B2(0, 0); B2(0, 1); B2(4, 0); B2(4, 1); B2(8, 0); B2(8, 1); B2(12, 0); B2(12, 1);
#undef B2
#define B1(b) dif_bfly<1, b, 0>(v)
    B1(0); B1(2); B1(4); B1(6); B1(8); B1(10); B1(12); B1(14);
#undef B1
}
#define FFT_BR4(k) ((((k) & 1) << 3) | (((k) & 2) << 1) | (((k) & 4) >> 1) | (((k) & 8) >> 3))
constexpr int FF_BUF = (8192 + 512) * 8;
DEV int ffp(int idx) { return (idx + (idx >> 4)) * 8; }
struct FftTw { cf t3[16]; };
constexpr int FF_T2 = 2 * FF_BUF;
DEV void fft_twiddles(FftTw& T, char* lds, int tid) {
    if (tid < 240) { const int k = tid / 15, r = tid % 15 + 1; float sn, cs; sincospif(-(float)(k * r) * (1.0f / 128.0f), &sn, &cs); *(cf*)(lds + FF_T2 + tid * 8) = cf{cs, sn}; }
    __syncthreads();
    { const int i3 = tid & 255, h = tid >> 8; float sn, cs; sincospif(-(float)i3 * (1.0f / 4096.0f), &sn, &cs); asm volatile("s_nop 1" : "+v"(sn), "+v"(cs));
        const cf w1 = cf{cs, sn}; const cf w2 = cmul(w1, w1);
        cf t = h ? w1 : cf{1.f, 0.f};
#pragma unroll
        for (int sx = 0; sx < 16; ++sx) { T.t3[sx] = t; t = cmul(t, w2); } }
}
DEV void fft_pass23(char* A, char* B, const char* tw2, int tid, const FftTw& T) {
    asm volatile("" : "+v"(tid));
    cf v[16];
    {
        const int i = tid, k = i & 15;
        { const char* rb = A + ffp(i);
#pragma unroll
        for (int r = 0; r < 16; ++r) v[r] = *(const cf*)(rb + 4352 * r); }
#pragma unroll
        for (int r = 1; r < 16; ++r) v[r] = cmul(v[r], *(const cf*)(tw2 + k * 120 + (r - 1) * 8));
        dft16(v);
        const int j = ((i >> 4) << 8) + k;
        { char* wb = B + (j + 16 * (i >> 4)) * 8;
#pragma unroll
        for (int r = 0; r < 16; ++r) *(cf*)(wb + 136 * r) = v[FFT_BR4(r)]; }
        __syncthreads();
    }
    {
        const int i3 = tid & 255, h = tid >> 8;
        const char* rb3 = B + ffp(i3) + 2176 * h;
#pragma unroll
        for (int sx = 0; sx < 16; ++sx) v[sx] = *(const cf*)(rb3 + 4352 * sx);
#pragma unroll
        for (int sx = 0; sx < 16; ++sx) v[sx] = cmul(v[sx], T.t3[sx]);
        dft16(v);
        if (h) {
            const float c32[16] = {1.f, 0.98078528040323043f, 0.92387953251128674f, 0.83146961230254524f, 0.70710678118654752f, 0.55557023301960218f, 0.38268343236508977f, 0.19509032201612825f,
                                   0.f, -0.19509032201612825f, -0.38268343236508977f, -0.55557023301960218f, -0.70710678118654752f, -0.83146961230254524f, -0.92387953251128674f, -0.98078528040323043f};
            const float s32[16] = {0.f, -0.19509032201612825f, -0.38268343236508977f, -0.55557023301960218f, -0.70710678118654752f, -0.83146961230254524f, -0.92387953251128674f, -0.98078528040323043f,
                                   -1.f, -0.98078528040323043f, -0.92387953251128674f, -0.83146961230254524f, -0.70710678118654752f, -0.55557023301960218f, -0.38268343236508977f, -0.19509032201612825f};
#pragma unroll
            for (int m = 0; m < 16; ++m) v[FFT_BR4(m)] = cmul(v[FFT_BR4(m)], cf{c32[m], s32[m]});
        }
        { char* wb3 = A + ffp(i3) + 34816 * h;
#pragma unroll
        for (int m = 0; m < 16; ++m) *(cf*)(wb3 + 2176 * m) = v[FFT_BR4(m)]; }
        __syncthreads();
    }
}
DEV void fft_pass1_store(char* D, cf (&v)[16], int tid) {
    dft16(v);
    { char* wb = D + 136 * tid;
#pragma unroll
    for (int r = 0; r < 16; ++r) *(cf*)(wb + 8 * r) = v[FFT_BR4(r)]; }
    __syncthreads();
}
constexpr size_t WS_CVIN = WS_H1;
DEV void fftconv_unit(char* lds, const Params& p, int c, const FftTw& T) {
    int tid = TID(); asm volatile("" : "+v"(tid));
    char* D0 = lds; char* D1 = lds + FF_BUF;
    const bf16_t* PT = (const bf16_t*)(p.ws + WS_PT); const bf16_t* GR = (const bf16_t*)(p.ws + WS_GR); const float* ssum = (const float*)(p.ws + WS_SSUM);
    bf16_t* OG2 = (bf16_t*)(p.ws + WS_OG2); float* IN = (float*)(p.ws + WS_CVIN) + (size_t)blockIdx.x * (8 * 4096);
    { const float w0 = p.conv_w[c], w1 = p.conv_w[3072 + c], w2 = p.conv_w[6144 + c], bias = p.conv_b[c];
#pragma unroll 2
        for (int k = 0; k < 8; ++k) { const int i = tid + k * 512, b = i >> 9, n0 = (i & 511) * 8;
            const bf16_t* px = PT + ((size_t)(b * 4096 + c)) * 4096;
            float q[10]; { const u32x4 m = *(const u32x4*)(px + n0); unpack8(m, q + 1); q[0] = (n0 > 0) ? bf2f(px[n0 - 1]) : 0.f; q[9] = (n0 + 8 < SEQ) ? bf2f(px[n0 + 8]) : 0.f; }
            f32x4 o0, o1;
#pragma unroll
            for (int e = 0; e < 4; ++e) { o0[e] = w0 * q[e] + w1 * q[e + 1] + w2 * q[e + 2] + bias; o1[e] = w0 * q[e + 4] + w1 * q[e + 5] + w2 * q[e + 6] + bias; }
            *(f32x4*)(IN + b * 4096 + n0) = o0; *(f32x4*)(IN + b * 4096 + n0 + 4) = o1; } }
    __syncthreads();
#pragma unroll 1
    for (int o = 0; o < 2; ++o) {
        cf KS[16];
        asm volatile("" : "+v"(tid));
        { const bf16_t* g = GR + (size_t)(o * 1024 + c) * 8192; const float invs = 1.0f / ssum[o * 1024 + c];
            cf v[16];
#pragma unroll
            for (int r = 0; r < 16; ++r) { const int n = tid + 512 * r; v[r] = cf{bf2f(g[(12288 - n) & 8191]) * invs, 0.f}; }
            fft_pass1_store(D0, v, tid);
            fft_pass23(D0, D1, lds + FF_T2, tid, T);
#pragma unroll
            for (int q = 0; q < 8; ++q) { const cf a = *(const cf*)(D0 + ffp(tid) + 4352 * q), b = *(const cf*)(D0 + ffp(tid) + 4352 * q + 34816); KS[q] = cadd(a, b); KS[q + 8] = csub(a, b); }
            __syncthreads(); }
        const float sk = p.skip[o * 1024 + c];
        const int part = (o == 0) ? 1024 : 2048;
        const float w0 = p.conv_w[part + c], w1 = p.conv_w[3072 + part + c], w2 = p.conv_w[6144 + part + c], bias = p.conv_b[part + c];
        cf vin[8];
#pragma unroll
        for (int r = 0; r < 8; ++r) vin[r] = cf{IN[tid + 512 * r], IN[4096 + tid + 512 * r]};
#pragma unroll 1
        for (int pr = 0; pr < 4; ++pr) {
            asm volatile("" : "+v"(tid));
            const int n0 = 8 * tid;
            u32x4 eraw[2], egate[2]; f32x4 eu[2][2]; unsigned ehalo[2];
#pragma unroll
            for (int hb = 0; hb < 2; ++hb) { const int b = 2 * pr + hb; const bf16_t* px = PT + ((size_t)(b * 4096 + part + c)) * 4096;
                eraw[hb] = *(const u32x4*)(px + n0);
                const unsigned ha = px[n0 - 1], hz = px[n0 + 8];
                ehalo[hb] = ((n0 > 0) ? ha : 0u) | (((n0 + 8 < SEQ) ? hz : 0u) << 16);
                eu[hb][0] = *(const f32x4*)(IN + b * 4096 + n0); eu[hb][1] = *(const f32x4*)(IN + b * 4096 + n0 + 4);
                egate[hb] = (o == 1) ? *(const u32x4*)(PT + ((size_t)(b * 4096 + 3072 + c)) * 4096 + n0) : (u32x4){0u, 0u, 0u, 0u}; }
            {
                cf v[16];
#pragma unroll
                for (int r = 0; r < 8; ++r) v[r] = vin[r];
#pragma unroll
                for (int r = 8; r < 16; ++r) v[r] = cf{0.f, 0.f};
                fft_pass1_store(D0, v, tid);
                fft_pass23(D0, D1, lds + FF_T2, tid, T);
            }
            {
                const int pn = (pr < 3) ? pr + 1 : pr; const float* ina = IN + (2 * pn) * 4096;
#pragma unroll
                for (int r = 0; r < 8; ++r) vin[r] = cf{ina[tid + 512 * r], ina[4096 + tid + 512 * r]};
            }
            {
                cf v[16];
#pragma unroll
                for (int q = 0; q < 8; ++q) { const cf a = *(const cf*)(D0 + ffp(tid) + 4352 * q), b = *(const cf*)(D0 + ffp(tid) + 4352 * q + 34816);
                    const cf x0 = cmul(cadd(a, b), KS[q]), x1 = cmul(csub(a, b), KS[q + 8]);
                    v[q] = cf{x0.x, -x0.y}; v[q + 8] = cf{x1.x, -x1.y}; }
                fft_pass1_store(D1, v, tid);
                fft_pass23(D1, D0, lds + FF_T2, tid, T);
            }
            {
                float ya[8], yb[8];
#pragma unroll
                for (int e = 0; e < 8; ++e) { const cf a = *(const cf*)(D1 + 64 * tid + 8 * (tid >> 1) + 8 * e), b = *(const cf*)(D1 + 64 * tid + 8 * (tid >> 1) + 8 * e + 34816); ya[e] = (a.x + b.x) * (1.0f / 8192.0f); yb[e] = -(a.y + b.y) * (1.0f / 8192.0f); }
#pragma unroll
                for (int hb = 0; hb < 2; ++hb) { const int b = 2 * pr + hb; float* inp = IN + b * 4096 + n0; const float* yy = hb ? yb : ya;
                    float q[10]; unpack8(eraw[hb], q + 1); q[0] = lo_bf(ehalo[hb]); q[9] = hi_bf(ehalo[hb]);
                    const f32x4 u0 = eu[hb][0], u1 = eu[hb][1]; const float uu[8] = {u0.x, u0.y, u0.z, u0.w, u1.x, u1.y, u1.z, u1.w};
                    float z[8];
#pragma unroll
                    for (int e = 0; e < 8; ++e) { const float xc = w0 * q[e] + w1 * q[e + 1] + w2 * q[e + 2] + bias; z[e] = xc * (yy[e] + sk * uu[e]); }
                    if (o == 0) { *(f32x4*)inp = (f32x4){z[0], z[1], z[2], z[3]}; *(f32x4*)(inp + 4) = (f32x4){z[4], z[5], z[6], z[7]}; }
                    else { float gg[8]; unpack8(egate[hb], gg);
#pragma unroll
                        for (int e = 0; e < 8; ++e) z[e] *= silu(gg[e]);
                        *(u32x4*)(OG2 + ((size_t)(b * 1024 + c)) * 4096 + n0) = pack8(z); } }
            }
        }
        __syncthreads();
    }
}

#define XB_TMO      128
#define XB_XCNT(j)  (256  + 64 * (j))
#define XB_XSUB(j)  (1280 + 64 * (j))
#define XB_XGEN(j)  (2304 + 64 * (j))
#define XB_TOP      3328
#define XB_TOPGEN   3392
#define XCD_BAR_WORDS 3456
#define XB_SPIN_CAP (1u << 20)
DEV unsigned xb_ld(unsigned* p) { return __hip_atomic_load(p, __ATOMIC_RELAXED, __HIP_MEMORY_SCOPE_AGENT); }
DEV unsigned xb_add(unsigned* p, unsigned v) { return __hip_atomic_fetch_add(p, v, __ATOMIC_RELAXED, __HIP_MEMORY_SCOPE_AGENT); }
DEV unsigned xb_xcc_id() { return (unsigned)__builtin_amdgcn_s_getreg((3 << 11) | 20) & 0xFu; }
#define XB_SPIN(cond, bar) do { unsigned _sp = 0; while (cond) { __builtin_amdgcn_s_sleep(1); \
    if ((++_sp & 255u) == 0u) { if (xb_ld(&(bar)[XB_TMO])) break; if (_sp > XB_SPIN_CAP) { atomicAdd(&(bar)[XB_TMO], 1u); break; } } } } while (0)
struct XcdBarrier { unsigned* bar; unsigned x; volatile LAS unsigned* st; };
DEV XcdBarrier xcd_barrier_post(unsigned* bar, volatile LAS unsigned* st) {
    XcdBarrier b; b.bar = bar; b.x = xb_xcc_id(); b.st = st;
    if (TID() == 0) (void)xb_add(&bar[XB_XCNT(b.x)], 1u);
    return b;
}
DEV void xcd_barrier_complete(unsigned* bar, unsigned x, unsigned& nloc, unsigned& nx) {
    const unsigned G = gridDim.x * gridDim.y * gridDim.z;
    unsigned sum, cnt, mine, sp = 0u;
    for (;;) {
        sum = 0u; cnt = 0u; mine = 0u;
#pragma unroll
        for (unsigned j = 0; j < 16; ++j) { const unsigned c = xb_ld(&bar[XB_XCNT(j)]); sum += c; cnt += (c > 0u) ? 1u : 0u; mine = (j == x) ? c : mine; }
        if (sum == G) break;
        __builtin_amdgcn_s_sleep(1);
        if ((++sp & 255u) == 0u) { if (xb_ld(&bar[XB_TMO])) break; if (sp > XB_SPIN_CAP) { atomicAdd(&bar[XB_TMO], 1u); break; } }
    }
    nloc = mine > 0u ? mine : 1u; nx = cnt > 0u ? cnt : 1u;
}
DEV void xcd_barrier(const XcdBarrier& b) {
    asm volatile("s_waitcnt vmcnt(0)" ::: "memory");
    __syncthreads();
    if (TID() == 0) {
        unsigned* bar = b.bar;
        __builtin_amdgcn_s_waitcnt(0);
        unsigned nloc = b.st[0], nx = b.st[1];
        if (nloc == 0u) { xcd_barrier_complete(bar, b.x, nloc, nx); b.st[0] = nloc; b.st[1] = nx; }
        const unsigned old = xb_add(&bar[XB_XSUB(b.x)], 1u);
        const unsigned gen = old / nloc;
        if (old + 1u == (gen + 1u) * nloc) {
            __builtin_amdgcn_fence(__ATOMIC_RELEASE, "agent");
            asm volatile("s_waitcnt vmcnt(0)" ::: "memory");
            const unsigned og = xb_add(&bar[XB_TOP], 1u);
            const unsigned tg = og / nx;
            if (og + 1u == (tg + 1u) * nx) xb_add(&bar[XB_TOPGEN], 1u);
            else XB_SPIN(xb_ld(&bar[XB_TOPGEN]) == tg, bar);
            __builtin_amdgcn_fence(__ATOMIC_ACQUIRE, "agent");
            xb_add(&bar[XB_XGEN(b.x)], 1u);
            asm volatile("s_waitcnt vmcnt(0)" ::: "memory");
        } else {
            XB_SPIN(xb_ld(&bar[XB_XGEN(b.x)]) == gen, bar);
            __builtin_amdgcn_fence(__ATOMIC_ACQUIRE, "agent");
            asm volatile("s_waitcnt vmcnt(0)" ::: "memory");
        }
    }
    __syncthreads();
}

constexpr int NPHASE = 12;
__global__ void __launch_bounds__(512) fwd_kernel(Params p) {
    char* lds = lds_dyn;
    char* ws = p.ws;
    volatile LAS unsigned* bst = (volatile LAS unsigned*)(LAS char*)(lds + LDS_BYTES - 64);
    { const int t0 = threadIdx.x;
        if (t0 < 16) bst[t0] = 0u;
        if ((t0 & 63) == 0) *(volatile LAS int*)(LAS char*)(lds + LDS_WTAB + 4 * hw_slot()) = t0 >> 6; }
    __syncthreads();
    if (MK_LAUNCHES == 1) (void)xcd_barrier_post((unsigned*)(ws + WS_CTL), bst);
    if (MK_LAUNCHES == 1 && p.ph_hi > NPHASE) cg::this_grid().sync();
#define SEAM(k) do { if (MK_LAUNCHES == 1 && (k) + 1 < p.ph_hi) { XcdBarrier xb_; xb_.bar = (unsigned*)(p.ws + WS_CTL); xb_.x = xb_xcc_id(); xb_.st = (volatile LAS unsigned*)(LAS char*)(lds + LDS_BYTES - 64); xcd_barrier(xb_); } } while (0)
#ifndef PHASE_MASK
#define PHASE_MASK 0xFFF
#endif
#define IN(k) (((PHASE_MASK >> (k)) & 1) && p.ph_lo <= (k) && (k) < p.ph_hi)
#define REP(k) for (int rep_ = 0; rep_ < ((PROBE_REPEAT == (k)) ? 2 : 1); ++rep_)
    if (IN(0)) { REP(0) phase_prep(lds, p); SEAM(0); }
    if (IN(1)) {
        for (int rep_ = 0; rep_ < ((PROBE_REPEAT == 21) ? 2 : 1); ++rep_) {
        const bool dummy = (PROBE_REPEAT == 21 && rep_ == 0);
        EpiFilt ef{(bf16_t*)(ws + (dummy ? WS_PRAW : WS_GR)), p.f_b3};
        gemm_phase<false, EpiFilt>(lds, (const bf16_t*)(ws + WS_W3), 64, (const bf16_t*)(ws + WS_HID2), 64, 4096, 4096, 64, ef); }
        REP(1) phase_norm0(p); SEAM(1); }
    if (IN(2)) {
        REP(2) { pg8::Gemm g{(const bf16_t*)(ws + WS_H0), (const bf16_t*)(ws + WS_WIN), NALL, AINP, DM}; pg8::StaticOrder S; S.init(NALL, AINP, (int)gridDim.x, (int)blockIdx.x);
            pg8::EpiBf16 E{(bf16_t*)(ws + WS_PRAW), (size_t)AINP, 0, 0};
            pg8::gemm_phase<pg8::EpiBf16, pg8::StaticOrder, true, true>((PG8_LAS unsigned char*)lds, g, S, E); }
        SEAM(2); }
    if (IN(3)) { filt_sums(p); REP(3) phase_post(p); SEAM(3); }
    if (IN(4)) {
        const float* rp = (const float*)(ws + WS_ROPE);
        REP(4) {
        { pg8::Gemm g{(const bf16_t*)(ws + WS_CQN), (const bf16_t*)(ws + WS_WUQ), NTOK, 768, 256}; pg8::StaticOrder S; S.init(NTOK, 768, (int)gridDim.x, (int)blockIdx.x);
            pg8::EpiUqPg E{(bf16_t*)(ws + WS_QM), rp + 2048, rp + 2560, QSC_M};
            pg8::gemm_phase<pg8::EpiUqPg, pg8::StaticOrder, true, true>((PG8_LAS unsigned char*)lds, g, S, E); }
        int opq_ = 0; asm volatile("" : "+s"(opq_));
        if (opq_ == 0) { pg8::Gemm g{(const bf16_t*)(ws + WS_CKVN), (const bf16_t*)(ws + WS_WUKV), NALL, 1024, 128}; pg8::StaticOrder S; S.init(NALL, 1024, (int)gridDim.x, (int)blockIdx.x);
            pg8::EpiUkvPg E{(bf16_t*)(ws + WS2_KM), (bf16_t*)(ws + WS2_VM)};
            pg8::gemm_phase<pg8::EpiUkvPg, pg8::StaticOrder, true, true>((PG8_LAS unsigned char*)lds, g, S, E); } }
        SEAM(4); }
    if (IN(5)) { REP(5) phase_attn(lds, p); SEAM(5); }
    if (IN(6)) {
        REP(6) { pg8::Gemm g{(const bf16_t*)(ws + WS2_OG), (const bf16_t*)(ws + WS_WOUT), NTOK, DM, DM}; pg8::StaticOrder S; S.init(NTOK, DM, (int)gridDim.x, (int)blockIdx.x);
            pg8::EpiResF32 E{p.x, p.out, (const float*)(ws + WS_MOD0), (DBG_SKIP & 1) ? 0.f : 1.f};
            pg8::gemm_phase<pg8::EpiResF32, pg8::StaticOrder, true, true>((PG8_LAS unsigned char*)lds, g, S, E); }
        SEAM(6); }
    if (IN(7)) { REP(7) phase_norm1(p); SEAM(7); }
    if (IN(8)) {
        REP(8) { pg8::Gemm g{(const bf16_t*)(ws + WS_HWIN), (const bf16_t*)(ws + WS_H1), 4096, NTOK, DM}; pg8::StaticOrder S; S.init(4096, NTOK, (int)gridDim.x, (int)blockIdx.x);
            pg8::EpiBf16 E{(bf16_t*)(ws + WS_PT), (size_t)4096, 4096, (size_t)4096 * 4096};
            pg8::gemm_phase<pg8::EpiBf16, pg8::StaticOrder, true, true>((PG8_LAS unsigned char*)lds, g, S, E); }
        SEAM(8); }
    if (IN(9)) { FftTw T; fft_twiddles(T, lds, TID()); REP(9) for (int c = blockIdx.x; c < 1024; c += gridDim.x) fftconv_unit(lds, p, c, T); SEAM(9); }
    if (IN(10)) {
        REP(10) {
        EpiRes e{p.out, (PROBE_REPEAT == 10 && rep_ == 0) ? (float*)(ws + WS_PT) : p.out, (const float*)(ws + WS_MOD1), (DBG_SKIP & 2) ? 0.f : 1.f};
        const bf16_t* OG2 = (const bf16_t*)(ws + WS_OG2); const bf16_t* W = (const bf16_t*)(ws + WS_HWOUT);
        const int nt = (NTOK / 256) * (DM / 128);
        for (int t = blockIdx.x; t < nt; t += gridDim.x) { const int ti = t / 8, tj = t % 8; const int b = ti >> 4, l0 = (ti & 15) * 256;
            gemm_tile<true, EpiRes>(lds, OG2 + (size_t)b * 1024 * 4096 + l0, 4096, W + (size_t)tj * 128 * DM, DM, DM, e, ti * 256, tj * 128); }
        }
        SEAM(10); }
    if (IN(11)) { phase_final(p); }
#undef SEAM
#undef IN
}

extern "C" void kernel_launch(void* const* d_in, const int* in_sizes, int n_in, void* d_out, int out_size, void* d_ws, size_t ws_size, hipStream_t stream) {
    static int grid = 0;
    if (grid == 0) {
        if (n_in != 28 || out_size != NTOK * DM || ws_size < WS_END) { fprintf(stderr, "kernel_launch: unexpected shapes n_in %d out %d ws %zu\n", n_in, out_size, ws_size); grid = -1; return; }
        int dev = 0, cus = 0, per_cu = 0;
        hipGetDevice(&dev); hipDeviceGetAttribute(&cus, hipDeviceAttributeMultiprocessorCount, dev);
        if (hipFuncSetAttribute((const void*)fwd_kernel, hipFuncAttributeMaxDynamicSharedMemorySize, LDS_BYTES) != hipSuccess) { fprintf(stderr, "hipFuncSetAttribute failed\n"); grid = -1; return; }
        hipOccupancyMaxActiveBlocksPerMultiprocessor(&per_cu, (const void*)fwd_kernel, 512, LDS_BYTES);
        if (per_cu < 1) { fprintf(stderr, "occupancy query says %d\n", per_cu); per_cu = 1; }
        grid = cus * 1;
        (void)hipGetLastError();
    }
    if (grid < 0) return;
    Params p{};
    const float** pp = (const float**)&p;
    for (int i = 0; i < 28; ++i) pp[i] = (const float*)d_in[i];
    p.out = (float*)d_out; p.ws = (char*)d_ws;
#if MK_LAUNCHES == 1
    if (hipMemsetAsync((char*)d_ws + WS_CTL, 0, CTL_BYTES, stream) != hipSuccess) { fprintf(stderr, "memset failed\n"); return; }
    p.ph_lo = 0; p.ph_hi = NPHASE;
    void* args[] = {&p};
    hipError_t e = hipLaunchCooperativeKernel((const void*)fwd_kernel, dim3(grid), dim3(512), args, LDS_BYTES, stream);
    if (e != hipSuccess) fprintf(stderr, "cooperative launch failed: %s (grid %d)\n", hipGetErrorString(e), grid);
#else
    for (int k = 0; k < NPHASE; ++k) { p.ph_lo = k; p.ph_hi = k + 1; hipLaunchKernelGGL(fwd_kernel, dim3(grid), dim3(512), LDS_BYTES, stream, p); }
#endif
}
```

```cpp
#include <hip/hip_runtime.h>
#include <hip/hip_cooperative_groups.h>
#include <cstdio>
#include <cstdint>
namespace cg = cooperative_groups;

#ifndef MK_LAUNCHES
#define MK_LAUNCHES 1
#endif

#ifndef PROBE_REPEAT
#define PROBE_REPEAT -1
#endif
#ifndef DBG_SKIP
#define DBG_SKIP 0
#endif
#define DEV __device__ __forceinline__
typedef unsigned short bf16_t;
typedef short bf16x8 __attribute__((ext_vector_type(8)));
typedef short s16x4 __attribute__((ext_vector_type(4)));
typedef float f32x16 __attribute__((ext_vector_type(16)));
typedef float f32x4 __attribute__((ext_vector_type(4)));
typedef float f32x2 __attribute__((ext_vector_type(2)));
typedef unsigned u32x4 __attribute__((ext_vector_type(4)));
typedef unsigned u32x2 __attribute__((ext_vector_type(2)));
typedef __bf16 bf16x2_t __attribute__((ext_vector_type(2)));
#define LAS __attribute__((address_space(3)))

constexpr int NB = 8, SEQ = 4096, DM = 1024, CTXL = 256, LK = SEQ + CTXL;
constexpr int NTOK = NB * SEQ, NCTX = NB * CTXL, NALL = NTOK + NCTX;
constexpr int AIN = 2208, AINP = 2304;
constexpr float EPS = 1e-6f;
constexpr float LOG2E = 1.4426950408889634f;
constexpr float QSC_A = 0.125f * LOG2E;
constexpr float QSC_M = 0.10206207261596575f * LOG2E;

constexpr size_t MiB = 1ull << 20;
constexpr size_t WS_WIN = 0;
constexpr size_t WS_WUQ = 5 * MiB;
constexpr size_t WS_WUKV = 6 * MiB;
constexpr size_t WS_WOUT = 7 * MiB;
constexpr size_t WS_HWIN = 9 * MiB;
constexpr size_t WS_HWOUT = 17 * MiB;
constexpr size_t WS_W3 = 19 * MiB;
constexpr size_t WS_HID2 = 20 * MiB;
constexpr size_t WS_MOD0 = 21 * MiB;
constexpr size_t WS_MOD1 = WS_MOD0 + 9 * 3072 * 4;
constexpr size_t WS_SSUM = WS_MOD1 + 8 * 3072 * 4;
constexpr size_t WS_ROPE = WS_SSUM + 2048 * 4;
constexpr size_t WS_GR = 22 * MiB;
constexpr size_t WS_H0 = 64 * MiB;
constexpr size_t WS_PRAW = 136 * MiB;
constexpr size_t WS_QA = 297 * MiB;
constexpr size_t WS_KA = 329 * MiB;
constexpr size_t WS_VA = 338 * MiB;
constexpr size_t WS_CQN = 347 * MiB;
constexpr size_t WS_CKVN = 363 * MiB;
constexpr size_t WS_G = 372 * MiB;
constexpr size_t WS_QM = 64 * MiB;
constexpr size_t WS_KM = 136 * MiB;
constexpr size_t WS_VM = 190 * MiB;
constexpr size_t WS_OG = 226 * MiB;
constexpr size_t WS_H1 = 436 * MiB;
constexpr size_t WS_PT = 64 * MiB;
constexpr size_t WS_OG2 = 320 * MiB;
constexpr size_t WS_CTL = 500 * MiB;
constexpr size_t CTL_BYTES = 16384;
constexpr size_t WS_END = 500 * MiB + CTL_BYTES;
constexpr size_t WS2_KM = 436 * MiB;
constexpr size_t WS2_VM = 190 * MiB;
constexpr size_t WS2_OG = 226 * MiB;

constexpr int LDS_BYTES = 150 * 1024;

extern __shared__ __attribute__((aligned(16))) char lds_dyn[];
constexpr int LDS_WTAB = LDS_BYTES - 64 - 256;
__device__ __forceinline__ int lane_id() { int r; asm volatile("v_mbcnt_lo_u32_b32 %0, -1, 0\n\tv_mbcnt_hi_u32_b32 %0, -1, %0" : "=v"(r)); return r; }
__device__ __forceinline__ int hw_slot() { return (int)(__builtin_amdgcn_s_getreg((5 << 11) | 4) & 63u); }
__device__ __forceinline__ int wave_idx() { return __builtin_amdgcn_readfirstlane(*(volatile __attribute__((address_space(3))) int*)(__attribute__((address_space(3))) char*)(lds_dyn + LDS_WTAB + 4 * hw_slot())); }
#define TID() (wave_idx() * 64 + lane_id())

DEV float bf2f(bf16_t v) { return __uint_as_float(((unsigned)v) << 16); }
DEV unsigned pk2(float lo, float hi) { f32x2 v = {lo, hi}; bf16x2_t b = __builtin_convertvector(v, bf16x2_t); return __builtin_bit_cast(unsigned, b); }
DEV bf16_t f2bf(float f) { return (bf16_t)(pk2(f, 0.f) & 0xffffu); }
DEV float lo_bf(unsigned w) { return __uint_as_float(w << 16); }
DEV float hi_bf(unsigned w) { return __uint_as_float(w & 0xffff0000u); }
DEV int crow(int r, int hi) { return (r & 3) + 8 * (r >> 2) + 4 * hi; }
DEV float silu(float v) { return v * __builtin_amdgcn_rcpf(1.f + __expf(-v)); }
DEV void unpack8(const u32x4 w, float* v) { v[0] = lo_bf(w.x); v[1] = hi_bf(w.x); v[2] = lo_bf(w.y); v[3] = hi_bf(w.y); v[4] = lo_bf(w.z); v[5] = hi_bf(w.z); v[6] = lo_bf(w.w); v[7] = hi_bf(w.w); }
DEV u32x4 pack8(const float* v) { u32x4 w; w.x = pk2(v[0], v[1]); w.y = pk2(v[2], v[3]); w.z = pk2(v[4], v[5]); w.w = pk2(v[6], v[7]); return w; }

DEV float wave_sum(float v) {
#pragma unroll
    for (int o = 1; o < 64; o <<= 1) v += __shfl_xor(v, o);
    return v;
}
struct Params {
    const float *x, *c, *ctx, *c_ctx, *ada_w, *ada_b, *norm_w, *w_in, *q_norm, *k_norm, *cq_norm, *ckv_norm, *w_uq, *w_ukv, *w_out,
        *hy_w_in, *conv_w, *conv_b, *f_w1, *f_b1, *f_w2, *f_b2, *f_w3, *f_b3, *freq, *skip, *hy_w_out, *final_w;
    float* out; char* ws; int ph_lo, ph_hi;
};

constexpr int G_RS = 144;
constexpr int G_RB = 256 * G_RS, G_CB = 128 * G_RS, G_STAGE = G_RB + G_CB;
constexpr int T_RS = 576;

template <bool TR, class Epi>
DEV void gemm_tile(char* lds, const bf16_t* __restrict__ R, size_t ldr, const bf16_t* __restrict__ C, size_t ldc, int K, const Epi& epi, int ti0, int tj0) {
    const int tid = TID(), lane = tid & 63, wid = tid >> 6;
    const int wi = wid >> 1, wj = wid & 1, l31 = lane & 31, hi = lane >> 5;
    f32x16 acc[2][2];
#pragma unroll
    for (int a = 0; a < 2; ++a)
#pragma unroll
        for (int b = 0; b < 2; ++b)
#pragma unroll
            for (int r = 0; r < 16; ++r) acc[a][b][r] = 0.f;
    u32x4 rrX[4], rcX[2], rrY[4], rcY[2];
    const bf16_t* Rp; const bf16_t* Cp; int rl_off, cl_off;
    if (TR) { const int c = tid & 31, kr = tid >> 5; Rp = R + (size_t)kr * ldr + c * 8; rl_off = kr * T_RS + c * 16; }
    else { const int lr = tid >> 3, lc = tid & 7; Rp = R + (size_t)lr * ldr + lc * 8; rl_off = lr * G_RS + lc * 16; }
    { const int lr = tid >> 3, lc = tid & 7; Cp = C + (size_t)lr * ldc + lc * 8; cl_off = lr * G_RS + lc * 16; }
    const int nk = K / 64;
    int ra_off[2], cb_off[2];
#pragma unroll
    for (int t = 0; t < 2; ++t) {
        if (TR) { const int g1 = (lane >> 4) & 1, q = (lane & 15) >> 2, p = lane & 3; ra_off[t] = (8 * hi + q) * T_RS + (wi * 64 + t * 32 + 16 * g1 + 4 * p) * 2; }
        else ra_off[t] = (wi * 64 + t * 32 + l31) * G_RS + hi * 16;
        cb_off[t] = G_RB + (wj * 64 + t * 32 + l31) * G_RS + hi * 16;
    }
#define G_LOAD(kt, S) do { const int kk_ = (kt) < nk ? (kt) : nk - 1; \
        if (TR) { _Pragma("unroll") for (int p = 0; p < 4; ++p) rr##S[p] = *(const u32x4*)(Rp + ((size_t)kk_ * 64 + 16 * p) * ldr); } \
        else { _Pragma("unroll") for (int p = 0; p < 4; ++p) rr##S[p] = *(const u32x4*)(Rp + (size_t)(64 * p) * ldr + kk_ * 64); } \
        _Pragma("unroll") for (int p = 0; p < 2; ++p) rc##S[p] = *(const u32x4*)(Cp + (size_t)(64 * p) * ldc + kk_ * 64); } while (0)
#define G_STORE(buf, S) do { char* b_ = lds + (buf) * G_STAGE; \
        if (TR) { _Pragma("unroll") for (int p = 0; p < 4; ++p) *(u32x4*)(b_ + rl_off + 16 * p * T_RS) = rr##S[p]; } \
        else { _Pragma("unroll") for (int p = 0; p < 4; ++p) *(u32x4*)(b_ + rl_off + 64 * p * G_RS) = rr##S[p]; } \
        _Pragma("unroll") for (int p = 0; p < 2; ++p) *(u32x4*)(b_ + G_RB + cl_off + 64 * p * G_RS) = rc##S[p]; } while (0)
#define G_COMPUTE(buf) do { const char* b_ = lds + (buf) * G_STAGE; \
        _Pragma("unroll") for (int ks = 0; ks < 4; ++ks) { bf16x8 fa[2], fb[2]; \
            _Pragma("unroll") for (int t = 0; t < 2; ++t) { \
                if (TR) { \
                    const s16x4 lo = __builtin_bit_cast(s16x4, __builtin_amdgcn_ds_read_tr16_b64_v4i16((LAS s16x4*)(b_ + ra_off[t] + ks * 16 * T_RS))); \
                    const s16x4 hh = __builtin_bit_cast(s16x4, __builtin_amdgcn_ds_read_tr16_b64_v4i16((LAS s16x4*)(b_ + ra_off[t] + (ks * 16 + 4) * T_RS))); \
                    fa[t] = (bf16x8){lo[0], lo[1], lo[2], lo[3], hh[0], hh[1], hh[2], hh[3]}; \
                } else fa[t] = *(const bf16x8*)(b_ + ra_off[t] + ks * 32); \
                fb[t] = *(const bf16x8*)(b_ + cb_off[t] + ks * 32); } \
            _Pragma("unroll") for (int a = 0; a < 2; ++a) _Pragma("unroll") for (int b = 0; b < 2; ++b) acc[a][b] = __builtin_amdgcn_mfma_f32_32x32x16_bf16(fa[a], fb[b], acc[a][b], 0, 0, 0); } } while (0)
    G_LOAD(0, X); G_LOAD(1, Y); G_STORE(0, X);
    __syncthreads();
    for (int kt = 0; kt < nk; kt += 2) {
        G_LOAD(kt + 2, X);
        G_COMPUTE(0);
        G_STORE(1, Y);
        __syncthreads();
        if (kt + 1 >= nk) break;
        G_LOAD(kt + 3, Y);
        G_COMPUTE(1);
        G_STORE(0, X);
        __syncthreads();
    }
#undef G_LOAD
#undef G_STORE
#undef G_COMPUTE
#pragma unroll
    for (int a = 0; a < 2; ++a)
#pragma unroll
        for (int b = 0; b < 2; ++b) epi(ti0 + wi * 64 + a * 32, tj0 + wj * 64 + b * 32, acc[a][b], l31, hi);
}


constexpr int G2_STAGE = 2 * G_RB;
template <class Epi>
DEV void gemm_tile256_tr(char* lds, const bf16_t* __restrict__ R, size_t ldr, const bf16_t* __restrict__ C, size_t ldc, int K, const Epi& epi, int ti0, int tj0) {
    int tid = TID(); asm volatile("" : "+v"(tid));
    const int lane = tid & 63, wid = __builtin_amdgcn_readfirstlane(tid >> 6), wi = wid >> 2, wj = wid & 3, l31 = lane & 31, hi = lane >> 5;
    f32x16 acc[4][2];
#pragma unroll
    for (int a = 0; a < 4; ++a)
#pragma unroll
        for (int b = 0; b < 2; ++b)
#pragma unroll
            for (int r = 0; r < 16; ++r) acc[a][b][r] = 0.f;
    u32x4 rr[4], rc[4];
    const bf16_t* Rp; const bf16_t* Cp; int rl_off, cl_off;
    { const int c = tid & 31, kr = tid >> 5; Rp = R + (size_t)kr * ldr + c * 8; rl_off = kr * T_RS + c * 16; }
    { const int lr = tid >> 3, lc = tid & 7; Cp = C + (size_t)lr * ldc + lc * 8; cl_off = lr * G_RS + lc * 16; }
    const int nk = K / 64;
    int ra_off[4], cb_off[2];
#pragma unroll
    for (int t = 0; t < 4; ++t) { const int g1 = (lane >> 4) & 1, q = (lane & 15) >> 2, p = lane & 3; ra_off[t] = (8 * hi + q) * T_RS + (wi * 128 + t * 32 + 16 * g1 + 4 * p) * 2; }
#pragma unroll
    for (int t = 0; t < 2; ++t) cb_off[t] = G_RB + (wj * 64 + t * 32 + l31) * G_RS + hi * 16;
#define G2_LOAD(kt) do { const int kk_ = (kt) < nk ? (kt) : nk - 1; \
        _Pragma("unroll") for (int p = 0; p < 4; ++p) rr[p] = *(const u32x4*)(Rp + ((size_t)kk_ * 64 + 16 * p) * ldr); \
        _Pragma("unroll") for (int p = 0; p < 4; ++p) rc[p] = *(const u32x4*)(Cp + (size_t)(64 * p) * ldc + kk_ * 64); } while (0)
#define G2_STORE(buf) do { char* b_ = lds + (buf) * G2_STAGE; \
        _Pragma("unroll") for (int p = 0; p < 4; ++p) *(u32x4*)(b_ + rl_off + 16 * p * T_RS) = rr[p]; \
        _Pragma("unroll") for (int p = 0; p < 4; ++p) *(u32x4*)(b_ + G_RB + cl_off + 64 * p * G_RS) = rc[p]; } while (0)
    G2_LOAD(0); G2_STORE(0);
    __syncthreads();
    for (int kt = 0; kt < nk; ++kt) {
        G2_LOAD(kt + 1);
        const char* b_ = lds + (kt & 1) * G2_STAGE;
#pragma unroll
        for (int ks = 0; ks < 4; ++ks) {
            bf16x8 fa[4], fb[2];
#pragma unroll
            for (int t = 0; t < 4; ++t) {
                const s16x4 lo = __builtin_bit_cast(s16x4, __builtin_amdgcn_ds_read_tr16_b64_v4i16((LAS s16x4*)(b_ + ra_off[t] + ks * 16 * T_RS)));
                const s16x4 hh = __builtin_bit_cast(s16x4, __builtin_amdgcn_ds_read_tr16_b64_v4i16((LAS s16x4*)(b_ + ra_off[t] + (ks * 16 + 4) * T_RS)));
                fa[t] = (bf16x8){lo[0], lo[1], lo[2], lo[3], hh[0], hh[1], hh[2], hh[3]}; }
#pragma unroll
            for (int t = 0; t < 2; ++t) fb[t] = *(const bf16x8*)(b_ + cb_off[t] + ks * 32);
#pragma unroll
            for (int a = 0; a < 4; ++a)
#pragma unroll
                for (int b = 0; b < 2; ++b) acc[a][b] = __builtin_amdgcn_mfma_f32_32x32x16_bf16(fa[a], fb[b], acc[a][b], 0, 0, 0);
        }
        G2_STORE((kt + 1) & 1);
        __syncthreads();
    }
#undef G2_LOAD
#undef G2_STORE
#pragma unroll
    for (int a = 0; a < 4; ++a)
#pragma unroll
        for (int b = 0; b < 2; ++b) epi(ti0 + wi * 128 + a * 32, tj0 + wj * 64 + b * 32, acc[a][b], l31, hi);
}
template <bool TR, class Epi>
DEV void gemm_phase(char* lds, const bf16_t* R, size_t ldr, const bf16_t* C, size_t ldc, int nI, int nJ, int K, const Epi& epi) {
    const int tI = nI / 256, tJ = nJ / 128, nt = tI * tJ;
    for (int t = blockIdx.x; t < nt; t += gridDim.x) {
        const int ti = t / tJ, tj = t % tJ;
        gemm_tile<TR, Epi>(lds, R + (size_t)ti * 256 * ldr, ldr, C + (size_t)tj * 128 * ldc, ldc, K, epi, ti * 256, tj * 128);
    }
}

struct EpiRaw {
    bf16_t* O; size_t ld;
    DEV void operator()(int i0, int j0, const f32x16& a, int l31, int hi) const {
#pragma unroll
        for (int r = 0; r < 16; ++r) O[(size_t)(i0 + crow(r, hi)) * ld + j0 + l31] = f2bf(a[r]);
    }
};
struct EpiUq {
    bf16_t* QM; const float* cos32; const float* sin32;
    DEV void operator()(int i0, int j0, const f32x16& a, int l31, int hi) const {
        const bool pe = (j0 % 96) == 64;
        const int fi = l31 & 7; const bool colang = (l31 & 16) != 0; const bool bpart = (l31 & 8) != 0;
#pragma unroll
        for (int r = 0; r < 16; ++r) {
            const int tok = i0 + crow(r, hi); float v = a[r];
            const float o = __shfl_xor(v, 8);
            if (pe) { const int l = tok & (SEQ - 1); const int pos = colang ? (l & 63) : (l >> 6);
                const float cs = cos32[pos * 8 + fi], sn = sin32[pos * 8 + fi];
                v = bpart ? (v * cs + o * sn) : (v * cs - o * sn); }
            QM[(size_t)tok * 768 + j0 + l31] = f2bf(v * QSC_M);
        }
    }
};
struct EpiUkv {
    bf16_t* KM; bf16_t* VM;
    DEV void operator()(int i0, int j0, const f32x16& a, int l31, int hi) const {
        const int h = j0 >> 7, e = (j0 & 127) + l31;
#pragma unroll
        for (int r = 0; r < 16; ++r) { const size_t row = (size_t)(i0 + crow(r, hi));
            if (e < 64) KM[row * 768 + h * 96 + e] = f2bf(a[r]); else VM[row * 512 + h * 64 + (e - 64)] = f2bf(a[r]); }
    }
};
struct EpiRes {
    const float* base; float* out; const float* mod; float gmul;
    DEV void operator()(int i0, int j0, const f32x16& a, int l31, int hi) const {
        const int b = i0 >> 12; const float g = mod[b * 3072 + 2048 + j0 + l31] * gmul;
#pragma unroll
        for (int h8 = 0; h8 < 2; ++h8) { float bv[8];
#pragma unroll
            for (int r = 0; r < 8; ++r) bv[r] = base[(size_t)(i0 + crow(8 * h8 + r, hi)) * DM + j0 + l31];
#pragma unroll
            for (int r = 0; r < 8; ++r) out[(size_t)(i0 + crow(8 * h8 + r, hi)) * DM + j0 + l31] = bv[r] + g * a[8 * h8 + r]; }
    }
};
struct EpiPT {
    bf16_t* PT;
    DEV void operator()(int i0, int j0, const f32x16& a, int l31, int hi) const {
        const int b = j0 >> 12, l = (j0 & 4095) + l31;
#pragma unroll
        for (int r = 0; r < 16; ++r) PT[((size_t)(b * 4096 + i0 + crow(r, hi))) * 4096 + l] = f2bf(a[r]);
    }
};
struct EpiFilt {
    bf16_t* GR; const float* b3;
    DEV void operator()(int i0, int j0, const f32x16& a, int l31, int hi) const {
        const int t = j0 + l31; const float tn = (float)t * (1.0f / 4095.0f);
        const float dmin = -3.0701134573253945f, dmax = -15.350567286626973f;
#pragma unroll
        for (int r = 0; r < 16; ++r) {
            const int n = i0 + crow(r, hi); const int c = n & 1023, od = n >> 10, o = od >> 1, dir = od & 1;
            const float delta = fabsf(dmin + (float)c * ((dmax - dmin) / 1023.0f));
            const float v = (a[r] + b3[n]) * __expf(-tn * delta);
            bf16_t* g = GR + ((size_t)(o * 1024 + c)) * 8192;
            if (dir == 0) g[4096 - t] = f2bf(v);
            else { if (t == 0) g[0] = 0; else g[4096 + t] = f2bf(v); }
        }
    }
};
DEV void filt_sums(const Params& p) {
    const int wid = TID() >> 6, lane = TID() & 63; bf16_t* GR = (bf16_t*)(p.ws + WS_GR); float* ssum = (float*)(p.ws + WS_SSUM);
    for (int row = blockIdx.x * 8 + wid; row < 2048; row += gridDim.x * 8) {
        bf16_t* g = GR + (size_t)row * 8192; float s = 0.f;
        u32x4 w[16];
#pragma unroll
        for (int j = 0; j < 16; ++j) w[j] = *(const u32x4*)(g + (j * 64 + lane) * 8);
#pragma unroll
        for (int j = 0; j < 16; ++j) { float v[8]; unpack8(w[j], v);
            if (j == 0 && lane == 0) v[0] = 0.f;
#pragma unroll
            for (int e = 0; e < 8; ++e) s += fabsf(v[e]); }
        s = wave_sum(s);
        if (lane == 0) ssum[row] = s;
    }
}

namespace pg8 {
#define PG8_LAS __attribute__((address_space(3)))
typedef short bf16x8 __attribute__((ext_vector_type(8)));
typedef float f32x4 __attribute__((ext_vector_type(4)));
typedef unsigned u32x4 __attribute__((ext_vector_type(4)));
constexpr int BM = 256, BK = 64, HALF = 128, HTB = HALF * BK * 2  , STAGE_BYTES = 8 * HTB, NXCD = 8, WGM = 8;

__host__ __device__ __forceinline__ int lds_byte(int r, int c) { const int st = (r >> 4) * 2 + (c >> 5), rr = r & 15, cc = c & 31, ob = rr * 64 + cc * 2; return st * 1024 + (ob ^ (((ob >> 9) & 1) << 5)); }
__host__ __device__ __forceinline__ void stage_rc(int b, int& R, int& C) { const int st = b / 1024, sb = b % 1024, swz = sb ^ (((sb >> 9) & 1) << 5); R = (st >> 1) * 16 + swz / 64; C = (st & 1) * 32 + (swz % 64) / 2; }
__host__ __device__ __forceinline__ int perm32(int rho) { const int n = rho >> 4, i = rho & 15; return 8 * (i >> 2) + 4 * n + (i & 3); }

struct Unit { int pm, pn; };
struct Gemm { const bf16_t* A; const bf16_t* Bt; int M, N, K; };

struct StaticOrder {
    int nM, nN, nwg, G, c;
    __host__ __device__ void init(int M, int N, int G_, int c_) { nM = M / BM; nN = N / BM; nwg = nM * nN; G = G_; c = c_; }
    __host__ __device__ bool next(int i, Unit& u) const {
        const long L = (long)i * G + c; if (L >= nwg) return false;
        int wgid = (int)L; { const int q = nwg / NXCD, r = nwg % NXCD, xcd = wgid % NXCD, off = wgid / NXCD; wgid = (xcd < r ? xcd * (q + 1) : r * (q + 1) + (xcd - r) * q) + off; }
        const int nig = WGM * nN, gid = wgid / nig, fm = gid * WGM, gsz = (nM - fm) < WGM ? (nM - fm) : WGM;
        u.pm = fm + ((wgid % nig) % gsz); u.pn = (wgid % nig) / gsz; return true;
    }
    __device__ __forceinline__ void a_ready(const Unit&) const {}
    __device__ __forceinline__ void done(const Unit&) const {}
};

__device__ __forceinline__ unsigned cvt_pk_bf16(float lo, float hi) { unsigned r; asm volatile("v_cvt_pk_bf16_f32 %0, %1, %2" : "=v"(r) : "v"(lo), "v"(hi)); return r; }
typedef float f32x2 __attribute__((ext_vector_type(2)));

struct EpiBf16 {
    static constexpr bool PERM = true, AFTER_DRAIN = false;
    bf16_t* O; size_t ldc; int split_cols; size_t split_stride;
    __device__ __forceinline__ void operator()(const f32x4 (&acc)[2][2][4][2], const Unit& u, int wr, int wc, int fr, int fq) const {
        const int row0 = u.pm * BM + wr * 64 + fr; int colt = u.pn * BM; bf16_t* base = O;
        if (split_cols) { const int t = colt / split_cols; base += (size_t)t * split_stride; colt -= t * split_cols; }
        const int col0 = colt + wc * 32 + 8 * fq;
#pragma unroll
        for (int ai = 0; ai < 2; ++ai)
#pragma unroll
            for (int m = 0; m < 4; ++m) { bf16_t* rowp = base + (size_t)(row0 + ai * HALF + m * 16) * ldc + col0;
#pragma unroll
                for (int bj = 0; bj < 2; ++bj) { const f32x4 v0 = acc[ai][bj][m][0], v1 = acc[ai][bj][m][1];
                    u32x4 w; w.x = cvt_pk_bf16(v0[0], v0[1]); w.y = cvt_pk_bf16(v0[2], v0[3]); w.z = cvt_pk_bf16(v1[0], v1[1]); w.w = cvt_pk_bf16(v1[2], v1[3]);
                    *(u32x4*)(rowp + bj * HALF) = w; } }
    }
};

struct EpiUkvPg {
    static constexpr bool PERM = true, AFTER_DRAIN = false;
    bf16_t* KM; bf16_t* VM;
    __device__ __forceinline__ void operator()(const f32x4 (&acc)[2][2][4][2], const Unit& u, int wr, int wc, int fr, int fq) const {
        { const int ln = lane_id(); fr = ln & 15; fq = ln >> 4; }
        const int row0 = u.pm * BM + wr * 64 + fr; const int e0 = 32 * wc + 8 * fq;
        const bool isk = (wc < 2);
        bf16_t* base = isk ? KM + (size_t)row0 * 768 + 2 * u.pn * 96 + e0 : VM + (size_t)row0 * 512 + 2 * u.pn * 64 + (e0 - 64);
        const int ld = isk ? 768 : 512, hs = isk ? 96 : 64;
#pragma unroll
        for (int ai = 0; ai < 2; ++ai)
#pragma unroll
            for (int m = 0; m < 4; ++m)
#pragma unroll
                for (int bj = 0; bj < 2; ++bj) { const f32x4 v0 = acc[ai][bj][m][0], v1 = acc[ai][bj][m][1];
                    u32x4 w; w.x = cvt_pk_bf16(v0[0], v0[1]); w.y = cvt_pk_bf16(v0[2], v0[3]); w.z = cvt_pk_bf16(v1[0], v1[1]); w.w = cvt_pk_bf16(v1[2], v1[3]);
                    *(u32x4*)(base + (ai * HALF + m * 16) * ld + bj * hs) = w; }
    }
};
struct EpiUqPg {
    static constexpr bool PERM = true, AFTER_DRAIN = false;
    bf16_t* QM; const float* cos32; const float* sin32; float sc;
    __device__ __forceinline__ void operator()(const f32x4 (&acc)[2][2][4][2], const Unit& u, int wr, int wc, int fr, int fq) const {
        { const int ln = lane_id(); fr = ln & 15; fq = ln >> 4; }
        const int row0 = u.pm * BM + wr * 64 + fr;
        bf16_t* base = QM + (size_t)row0 * 768 + u.pn * BM + 32 * wc + 8 * fq;
        const int g0 = 8 * u.pn + wc;
        const bool sgn = (fq & 1) != 0;
#pragma unroll
        for (int bj = 0; bj < 2; ++bj) { const bool pe = (((g0 + 4 * bj) % 3) == 2);
#pragma unroll
            for (int ai = 0; ai < 2; ++ai)
#pragma unroll
                for (int m = 0; m < 4; ++m) { const int rr = ai * HALF + m * 16; u32x4 w;
#pragma unroll
                    for (int n = 0; n < 2; ++n) { f32x4 v = acc[ai][bj][m][n];
                        if (pe) { f32x4 o;
#pragma unroll
                            for (int e = 0; e < 4; ++e) o[e] = __shfl_xor(v[e], 16);
                            const int l = (row0 + rr) & 4095, pos = (fq < 2) ? (l >> 6) : (l & 63);
                            const f32x4 cv = *(const f32x4*)(cos32 + pos * 8 + 4 * n), sv = *(const f32x4*)(sin32 + pos * 8 + 4 * n);
                            v = sgn ? (v * cv + o * sv) : (v * cv - o * sv); }
                        v = v * sc;
                        if (n == 0) { w.x = cvt_pk_bf16(v[0], v[1]); w.y = cvt_pk_bf16(v[2], v[3]); } else { w.z = cvt_pk_bf16(v[0], v[1]); w.w = cvt_pk_bf16(v[2], v[3]); } }
                    *(u32x4*)(base + rr * 768 + bj * HALF) = w;
                    asm volatile("" ::: "memory"); } }
    }
};
struct EpiResF32 {
    static constexpr bool PERM = false, AFTER_DRAIN = false;
    const float* base; float* out; const float* mod; float gmul;
    __device__ __forceinline__ void operator()(const f32x4 (&acc)[2][2][4][2], const Unit& u, int wr, int wc, int fr, int fq) const {
        const int row0 = u.pm * BM + wr * 64 + fr, col0 = u.pn * BM + wc * 32 + 4 * fq, b = (u.pm * BM) >> 12;
        f32x4 g[2][2];
#pragma unroll
        for (int bj = 0; bj < 2; ++bj)
#pragma unroll
            for (int n = 0; n < 2; ++n) g[bj][n] = *(const f32x4*)(mod + b * 3072 + 2048 + col0 + bj * HALF + n * 16) * gmul;
#pragma unroll
        for (int ai = 0; ai < 2; ++ai) {
            f32x4 pre[4][2][2];
#pragma unroll
            for (int m = 0; m < 4; ++m) { const size_t off = (size_t)(row0 + ai * HALF + m * 16) * 1024 + col0;
#pragma unroll
                for (int bj = 0; bj < 2; ++bj)
#pragma unroll
                    for (int n = 0; n < 2; ++n) pre[m][bj][n] = *(const f32x4*)(base + off + bj * HALF + n * 16); }
#pragma unroll
            for (int m = 0; m < 4; ++m) { const size_t off = (size_t)(row0 + ai * HALF + m * 16) * 1024 + col0;
#pragma unroll
                for (int bj = 0; bj < 2; ++bj)
#pragma unroll
                    for (int n = 0; n < 2; ++n) *(f32x4*)(out + off + bj * HALF + n * 16) = pre[m][bj][n] + g[bj][n] * acc[ai][bj][m][n]; }
        }
    }
};
template <class Epi, class Sched, bool ALIGN_EPI = false, bool SP2 = false>
__device__ __forceinline__ void gemm_phase(PG8_LAS unsigned char* lds, const Gemm g, const Sched& S, const Epi& E) {
    int tid_ = TID(); asm volatile("" : "+v"(tid_));
    const int tid = tid_, wid = __builtin_amdgcn_readfirstlane(tid >> 6), lane = tid & 63, wr = wid >> 2, wc = wid & 3, fr = lane & 15, fq = lane >> 4;
    const int K = g.K, nt = K / BK;
    unsigned voffA[2], voffB[2];
#pragma unroll
    for (int i = 0; i < 2; ++i) { int R, C; stage_rc(tid * 16 + i * 8192, R, C); const int Rb = Epi::PERM ? ((R & ~31) + perm32(R & 31)) : R;
        voffA[i] = (unsigned)(R * K + C) * 2u; voffB[i] = (unsigned)(Rb * K + C) * 2u; }
    const size_t kstep = (size_t)(BK * 2);
    const size_t hstep = (size_t)HALF * K * 2;
    const size_t tstep = 2 * hstep;
    const unsigned ldsw = (unsigned)wid * 1024u;
    const int aoff = lds_byte(wr * 64 + fr, fq * 8), boff = lds_byte(wc * 32 + fr, fq * 8);
#define PG8_SA(b, h) (((b) * 2 + (h)) * HTB)
#define PG8_SB(b, h) ((4 + (b) * 2 + (h)) * HTB)
#define PG8_STAGE(bufoff, gbase, voff) do { _Pragma("unroll") for (int _i = 0; _i < 2; ++_i) \
        __builtin_amdgcn_global_load_lds((const unsigned*)((const char*)(gbase) + (voff)[_i]), (PG8_LAS unsigned*)(lds + (bufoff) + ldsw + _i * 8192), 16, 0, 0); } while (0)
#define PG8_LDA(dst, b, h) do { _Pragma("unroll") for (int m = 0; m < 4; ++m) _Pragma("unroll") for (int k = 0; k < 2; ++k) dst[m][k] = *(const PG8_LAS bf16x8*)(lds + PG8_SA(b, h) + aoff + m * 2048 + k * 1024); } while (0)
#define PG8_LDB(dst, b, h) do { _Pragma("unroll") for (int n = 0; n < 2; ++n) _Pragma("unroll") for (int k = 0; k < 2; ++k) dst[n][k] = *(const PG8_LAS bf16x8*)(lds + PG8_SB(b, h) + boff + n * 2048 + k * 1024); } while (0)
#define PG8_MMA(ai, bj, At, Bt) do { __builtin_amdgcn_s_setprio(1); _Pragma("unroll") for (int m = 0; m < 4; ++m) _Pragma("unroll") for (int n = 0; n < 2; ++n) _Pragma("unroll") for (int k = 0; k < 2; ++k) \
        acc[ai][bj][m][n] = __builtin_amdgcn_mfma_f32_16x16x32_bf16(Bt[n][k], At[m][k], acc[ai][bj][m][n], 0, 0, 0); __builtin_amdgcn_s_setprio(0); } while (0)
#define PG8_WAIT_V(n) asm volatile("s_waitcnt vmcnt(" #n ")" ::: "memory")
#define PG8_WAIT_L(n) asm volatile("s_waitcnt lgkmcnt(" #n ")" ::: "memory")
#define PG8_BAR __builtin_amdgcn_s_barrier()
#define PG8_SCHED __builtin_amdgcn_sched_barrier(0)
    Unit cur, nxt; int ui = 0;
    if (!S.next(0, cur)) return;
    f32x4 acc[2][2][4][2];
#pragma unroll
    for (int a = 0; a < 2; ++a)
#pragma unroll
        for (int b = 0; b < 2; ++b)
#pragma unroll
            for (int m = 0; m < 4; ++m)
#pragma unroll
                for (int n = 0; n < 2; ++n) acc[a][b][m][n] = (f32x4){0.f, 0.f, 0.f, 0.f};
    bf16x8 At[4][2], B0[2][2], B1[2][2];
    const char* cA = (const char*)g.A + (size_t)cur.pm * tstep; const char* cB = (const char*)g.Bt + (size_t)cur.pn * tstep;
    S.a_ready(cur);
    if constexpr (SP2) {
        PG8_STAGE(PG8_SB(0, 0), cB, voffB); PG8_STAGE(PG8_SB(0, 1), cB + hstep, voffB); PG8_STAGE(PG8_SA(0, 0), cA, voffA); PG8_STAGE(PG8_SA(0, 1), cA + hstep, voffA);
        if (wr == 1) PG8_BAR;
        PG8_WAIT_V(2); PG8_BAR;
        PG8_STAGE(PG8_SB(1, 0), cB + kstep, voffB); PG8_STAGE(PG8_SA(1, 0), cA + kstep, voffA); PG8_STAGE(PG8_SB(1, 1), cB + hstep + kstep, voffB);
        PG8_WAIT_V(6); PG8_BAR;
    } else {
        PG8_STAGE(PG8_SB(0, 0), cB, voffB); PG8_STAGE(PG8_SA(0, 0), cA, voffA); PG8_STAGE(PG8_SB(0, 1), cB + hstep, voffB); PG8_STAGE(PG8_SA(0, 1), cA + hstep, voffA);
        if (wr == 1) PG8_BAR;
        PG8_WAIT_V(4); PG8_BAR;
        PG8_STAGE(PG8_SB(1, 0), cB + kstep, voffB); PG8_STAGE(PG8_SA(1, 0), cA + kstep, voffA); PG8_STAGE(PG8_SB(1, 1), cB + hstep + kstep, voffB);
        PG8_WAIT_V(6); PG8_BAR;
    }
    for (;;) {
        const bool has_next = S.next(ui + 1, nxt);
        const char* nA = has_next ? (const char*)g.A + (size_t)nxt.pm * tstep : cA; const char* nB = has_next ? (const char*)g.Bt + (size_t)nxt.pn * tstep : cB;
        for (int t = 0; t < nt; t += 2) {
            const bool last = (t == nt - 2);
            const char* a1 = cA + (size_t)(t + 1) * kstep;
            const char* a2 = last ? nA : cA + (size_t)(t + 2) * kstep; const char* b2 = last ? nB : cB + (size_t)(t + 2) * kstep;
            const char* a3 = a2 + kstep; const char* b3 = b2 + kstep;
            if (last && has_next) S.a_ready(nxt);
            if constexpr (SP2) {
            PG8_LDB(B0, 0, 0); PG8_LDB(B1, 0, 1); PG8_SCHED; PG8_LDA(At, 0, 0); PG8_STAGE(PG8_SA(1, 1), a1 + hstep, voffA);
            PG8_WAIT_V(8); PG8_WAIT_L(0); PG8_BAR; PG8_MMA(0, 0, At, B0); PG8_MMA(0, 1, At, B1); PG8_BAR; PG8_SCHED;
            PG8_LDA(At, 0, 1); PG8_STAGE(PG8_SB(0, 0), b2, voffB); PG8_STAGE(PG8_SB(0, 1), b2 + hstep, voffB); PG8_STAGE(PG8_SA(0, 0), a2, voffA);
            PG8_WAIT_V(8); PG8_WAIT_L(0); PG8_BAR; PG8_MMA(1, 0, At, B0); PG8_MMA(1, 1, At, B1); PG8_BAR; PG8_SCHED;
            PG8_LDB(B0, 1, 0); PG8_LDB(B1, 1, 1); PG8_SCHED; PG8_LDA(At, 1, 0); PG8_STAGE(PG8_SA(0, 1), a2 + hstep, voffA);
            PG8_WAIT_V(8); PG8_WAIT_L(0); PG8_BAR; PG8_MMA(0, 0, At, B0); PG8_MMA(0, 1, At, B1); PG8_BAR; PG8_SCHED;
            PG8_LDA(At, 1, 1); PG8_STAGE(PG8_SB(1, 0), b3, voffB); PG8_STAGE(PG8_SB(1, 1), b3 + hstep, voffB); PG8_STAGE(PG8_SA(1, 0), a3, voffA);
            PG8_WAIT_V(8); PG8_WAIT_L(0); PG8_BAR; PG8_MMA(1, 0, At, B0); PG8_MMA(1, 1, At, B1); PG8_BAR; PG8_SCHED;
            } else {
            PG8_LDB(B0, 0, 0); PG8_SCHED; PG8_LDA(At, 0, 0); PG8_STAGE(PG8_SA(1, 1), a1 + hstep, voffA);
            PG8_WAIT_L(8); PG8_BAR; PG8_WAIT_L(0); PG8_MMA(0, 0, At, B0); PG8_BAR; PG8_SCHED;
            PG8_LDB(B1, 0, 1); PG8_STAGE(PG8_SB(0, 0), b2, voffB);
            PG8_BAR; PG8_WAIT_L(0); PG8_MMA(0, 1, At, B1); PG8_BAR;
            PG8_LDA(At, 0, 1); PG8_STAGE(PG8_SA(0, 0), a2, voffA);
            PG8_BAR; PG8_WAIT_L(0); PG8_MMA(1, 0, At, B0); PG8_BAR; PG8_SCHED;
            PG8_STAGE(PG8_SB(0, 1), b2 + hstep, voffB);
            PG8_WAIT_V(6); PG8_BAR; PG8_MMA(1, 1, At, B1); PG8_BAR;
            PG8_LDB(B0, 1, 0); PG8_SCHED; PG8_LDA(At, 1, 0); PG8_STAGE(PG8_SA(0, 1), a2 + hstep, voffA);
            PG8_WAIT_L(8); PG8_BAR; PG8_WAIT_L(0); PG8_MMA(0, 0, At, B0); PG8_BAR; PG8_SCHED;
            PG8_LDB(B1, 1, 1); PG8_STAGE(PG8_SB(1, 0), b3, voffB);
            PG8_BAR; PG8_WAIT_L(0); PG8_MMA(0, 1, At, B1); PG8_BAR;
            PG8_LDA(At, 1, 1); PG8_STAGE(PG8_SA(1, 0), a3, voffA);
            PG8_BAR; PG8_WAIT_L(0); PG8_MMA(1, 0, At, B0); PG8_BAR; PG8_SCHED;
            PG8_STAGE(PG8_SB(1, 1), b3 + hstep, voffB);
            PG8_WAIT_V(6); PG8_BAR; PG8_MMA(1, 1, At, B1); PG8_BAR;
            }
        }
        if constexpr (ALIGN_EPI) { if (wr == 0) PG8_BAR; }
        if constexpr (!Epi::AFTER_DRAIN) { E(acc, cur, wr, wc, fr, fq); S.done(cur); }
        if (!has_next) break;
#pragma unroll
        for (int a = 0; a < 2; ++a)
#pragma unroll
            for (int b = 0; b < 2; ++b)
#pragma unroll
                for (int m = 0; m < 4; ++m)
#pragma unroll
                    for (int n = 0; n < 2; ++n) acc[a][b][m][n] = (f32x4){0.f, 0.f, 0.f, 0.f};
        cur = nxt; cA = nA; cB = nB; ++ui;
        if constexpr (ALIGN_EPI) { if (wr == 1) PG8_BAR; }
    }
    PG8_WAIT_V(0);
    if constexpr (!ALIGN_EPI) { if (wr == 0) PG8_BAR; }
    PG8_BAR;
    if constexpr (Epi::AFTER_DRAIN) { E.fused(acc, cur, wr, wc, fr, fq, lds, wid, lane); S.done(cur); }
#undef PG8_SA
#undef PG8_SB
#undef PG8_STAGE
#undef PG8_LDA
#undef PG8_LDB
#undef PG8_MMA
#undef PG8_WAIT_V
#undef PG8_WAIT_L
#undef PG8_BAR
#undef PG8_SCHED
}
}

DEV void transpose_item(float* scr, const float* W, int K, int N, int Npad, bf16_t* WT, int item, int lane) {
    const int nblk = Npad / 32, kb = item / nblk, nb = item % nblk, k0 = 64 * kb, n0 = 32 * nb;
    const bool valid = (n0 < N);
    float v[32];
#pragma unroll
    for (int i = 0; i < 32; ++i) { const int kk = 2 * i + (lane >> 5); v[i] = valid ? W[(size_t)(k0 + kk) * N + n0 + (lane & 31)] : 0.f; }
#pragma unroll
    for (int i = 0; i < 32; ++i) { const int kk = 2 * i + (lane >> 5); scr[kk * 33 + (lane & 31)] = v[i]; }
    asm volatile("s_waitcnt lgkmcnt(0)" ::: "memory");
    const int c = lane & 7;
#pragma unroll
    for (int j = 0; j < 4; ++j) { const int n = (lane >> 3) + 8 * j; const float* sp = scr + (8 * c) * 33 + n; float o[8];
#pragma unroll
        for (int e = 0; e < 8; ++e) o[e] = sp[e * 33];
        *(u32x4*)(WT + (size_t)(n0 + n) * K + k0 + 8 * c) = pack8(o); }
    asm volatile("s_waitcnt lgkmcnt(0)" ::: "memory");
}

DEV void mod_item(char* lds, const Params& p, int item) {
    const int layer = item / 96, n0 = (item % 96) * 32, tid = TID();
    float* s = (float*)lds;
    float* red = s + 9 * 1024;
    for (int i = tid; i < 9 * 1024; i += 512) { const int v = i >> 10, k = i & 1023; const float cv = (v < 8) ? p.c[v * 1024 + k] : p.c_ctx[k]; s[i] = silu(cv); }
    __syncthreads();
    const int kc = tid >> 5, n = tid & 31; const float* W = p.ada_w + (size_t)layer * DM * 3072 + n0 + n;
    float acc[9];
#pragma unroll
    for (int v = 0; v < 9; ++v) acc[v] = 0.f;
#pragma unroll 16
    for (int kk = 0; kk < 64; ++kk) { const int k = kc * 64 + kk; const float w = W[(size_t)k * 3072];
#pragma unroll
        for (int v = 0; v < 9; ++v) acc[v] += s[v * 1024 + k] * w; }
#pragma unroll
    for (int v = 0; v < 9; ++v) red[(kc * 9 + v) * 32 + n] = acc[v];
    __syncthreads();
    if (tid < 9 * 32) { const int v = tid >> 5, nn = tid & 31; float t = 0.f;
#pragma unroll
        for (int k2 = 0; k2 < 16; ++k2) t += red[(k2 * 9 + v) * 32 + nn];
        t += p.ada_b[layer * 3072 + n0 + nn];
        if (layer == 0) ((float*)(p.ws + WS_MOD0))[v * 3072 + n0 + nn] = t;
        else if (v < 8) ((float*)(p.ws + WS_MOD1))[v * 3072 + n0 + nn] = t; }
    __syncthreads();
}

DEV void hid2_row(char* lds, const Params& p, int t, int wid, int lane) {
    float* sc = (float*)lds + wid * 128;
    const float tn = (float)t * (1.0f / 4095.0f);
    const float w = (float)(2.0 * 3.14159265358979323846 / 4096.0) * (float)t;
    float e = 0.f;
    if (lane == 0) e = tn;
    else if (lane <= 32) { const int k = (lane - 1) & 15; const float band = 1e-4f + (float)k * ((15.0f - 1e-4f) / 15.0f); const float ang = w * band; e = (lane <= 16) ? cosf(ang) : -sinf(ang); }
    sc[lane] = e;
    asm volatile("s_waitcnt lgkmcnt(0)" ::: "memory");
    float a = p.f_b1[lane];
    for (int i = 0; i < 33; ++i) a += sc[i] * p.f_w1[i * 64 + lane];
    const float fr = p.freq[lane];
    const float h1 = sinf(fr * a);
    sc[64 + lane] = h1;
    asm volatile("s_waitcnt lgkmcnt(0)" ::: "memory");
    float a2 = p.f_b2[lane];
    for (int i = 0; i < 64; ++i) a2 += sc[64 + i] * p.f_w2[i * 64 + lane];
    const float h2 = sinf(fr * a2);
    ((bf16_t*)(p.ws + WS_HID2))[t * 64 + lane] = f2bf(h2);
    asm volatile("s_waitcnt lgkmcnt(0)" ::: "memory");
}

DEV void phase_prep(char* lds, const Params& p) {
    const int tid = TID(), wid = tid >> 6, lane = tid & 63;
    { const int gt = blockIdx.x * 512 + tid;
        if (gt < 2048) ((float*)(p.ws + WS_SSUM))[gt] = 0.f;
        float* rp = (float*)(p.ws + WS_ROPE);
        if (gt < 1024) { const int pos = gt >> 4, i = gt & 15; const float inv = exp2f(-(float)i * (13.287712379549449f / 16.0f)); const float ang = (float)pos * inv; rp[gt] = cosf(ang); rp[1024 + gt] = sinf(ang); }
        if (gt < 512) { const int pos = gt >> 3, i = gt & 7; const float inv = exp2f(-(float)i * (13.287712379549449f / 8.0f)); const float ang = (float)pos * inv; rp[2048 + gt] = cosf(ang); rp[2560 + gt] = sinf(ang); } }
    for (int it = blockIdx.x; it < 192; it += gridDim.x) mod_item(lds, p, it);
    for (int t = blockIdx.x * 8 + wid; t < 4096; t += gridDim.x * 8) hid2_row(lds, p, t, wid, lane);
    __syncthreads();
    constexpr int I_WIN = 16 * (AINP / 32), I_UQ = 4 * 24, I_UKV = 2 * 32, I_WO = 16 * 32, I_HIN = 16 * 128, I_HO = 16 * 32, I_W3 = 128;
    constexpr int NIT = I_WIN + I_UQ + I_UKV + I_WO + I_HIN + I_HO + I_W3;
    float* scr = (float*)lds + wid * (64 * 33);
    for (int it = blockIdx.x * 8 + wid; it < NIT; it += gridDim.x * 8) {
        int r = it;
        if (r < I_HIN) { transpose_item(scr, p.hy_w_in, 1024, 4096, 4096, (bf16_t*)(p.ws + WS_HWIN), r, lane); continue; } r -= I_HIN;
        if (r < I_WIN) { transpose_item(scr, p.w_in, 1024, AIN, AINP, (bf16_t*)(p.ws + WS_WIN), r, lane); continue; } r -= I_WIN;
        if (r < I_WO) { transpose_item(scr, p.w_out, 1024, 1024, 1024, (bf16_t*)(p.ws + WS_WOUT), r, lane); continue; } r -= I_WO;
        if (r < I_HO) { transpose_item(scr, p.hy_w_out, 1024, 1024, 1024, (bf16_t*)(p.ws + WS_HWOUT), r, lane); continue; } r -= I_HO;
        if (r < I_UQ) { transpose_item(scr, p.w_uq, 256, 768, 768, (bf16_t*)(p.ws + WS_WUQ), r, lane); continue; } r -= I_UQ;
        if (r < I_UKV) { transpose_item(scr, p.w_ukv, 128, 1024, 1024, (bf16_t*)(p.ws + WS_WUKV), r, lane); continue; } r -= I_UKV;
        transpose_item(scr, p.f_w3, 64, 4096, 4096, (bf16_t*)(p.ws + WS_W3), r, lane);
    }
}

DEV void row_load(f32x4 (&v)[4], const float* xr, int lane) {
#pragma unroll
    for (int j = 0; j < 4; ++j) v[j] = *(const f32x4*)(xr + lane * 4 + 256 * j);
}
DEV void modnorm_row(const f32x4 (&v)[4], const float* nw, const float* shift, const float* scale, bf16_t* orow, int lane) {
    float s = 0.f;
#pragma unroll
    for (int j = 0; j < 4; ++j) s += v[j].x * v[j].x + v[j].y * v[j].y + v[j].z * v[j].z + v[j].w * v[j].w;
    const float r = rsqrtf(wave_sum(s) * (1.0f / DM) + EPS);
#pragma unroll
    for (int j = 0; j < 4; ++j) { const int c0 = lane * 4 + 256 * j;
        const f32x4 w = *(const f32x4*)(nw + c0), sh = *(const f32x4*)(shift + c0), sc = *(const f32x4*)(scale + c0);
        const float o0 = v[j].x * r * w.x * (1.f + sc.x) + sh.x, o1 = v[j].y * r * w.y * (1.f + sc.y) + sh.y, o2 = v[j].z * r * w.z * (1.f + sc.z) + sh.z, o3 = v[j].w * r * w.w * (1.f + sc.w) + sh.w;
        u32x2 pk; pk.x = pk2(o0, o1); pk.y = pk2(o2, o3); *(u32x2*)(orow + c0) = pk; }
}
DEV const float* norm0_src(const Params& p, int row) { return row < NTOK ? p.x + (size_t)row * DM : p.ctx + (size_t)(row - NTOK) * DM; }
DEV void phase_norm0(const Params& p) {
    const int wid = TID() >> 6, lane = TID() & 63; const float* mod0 = (const float*)(p.ws + WS_MOD0); bf16_t* H0 = (bf16_t*)(p.ws + WS_H0);
    const int stride = gridDim.x * 8; int row = blockIdx.x * 8 + wid;
    f32x4 cur[4], nxt[4];
    if (row < NALL) row_load(cur, norm0_src(p, row), lane);
    for (; row < NALL; row += stride) {
        { const int rn = row + stride < NALL ? row + stride : row; row_load(nxt, norm0_src(p, rn), lane); }
        const int v = row < NTOK ? (row >> 12) : 8;
        modnorm_row(cur, p.norm_w, mod0 + v * 3072, mod0 + v * 3072 + 1024, H0 + (size_t)row * DM, lane);
#pragma unroll
        for (int j = 0; j < 4; ++j) cur[j] = nxt[j];
    }
}
DEV void phase_norm1(const Params& p) {
    const int wid = TID() >> 6, lane = TID() & 63; const float* mod1 = (const float*)(p.ws + WS_MOD1); bf16_t* H1 = (bf16_t*)(p.ws + WS_H1);
    const int stride = gridDim.x * 8; int row = blockIdx.x * 8 + wid;
    f32x4 cur[4], nxt[4];
    if (row < NTOK) row_load(cur, p.out + (size_t)row * DM, lane);
    for (; row < NTOK; row += stride) {
        { const int rn = row + stride < NTOK ? row + stride : row; row_load(nxt, p.out + (size_t)rn * DM, lane); }
        const int v = row >> 12;
        modnorm_row(cur, p.norm_w + DM, mod1 + v * 3072, mod1 + v * 3072 + 1024, H1 + (size_t)row * DM, lane);
#pragma unroll
        for (int j = 0; j < 4; ++j) cur[j] = nxt[j];
    }
}
DEV void phase_final(const Params& p) {
    const int wid = TID() >> 6, lane = TID() & 63;
    const int stride = gridDim.x * 8; int row = blockIdx.x * 8 + wid;
    f32x4 v[4], nxt[4];
    if (row < NTOK) row_load(v, p.out + (size_t)row * DM, lane);
    for (; row < NTOK; row += stride) {
        { const int rn = row + stride < NTOK ? row + stride : row; row_load(nxt, p.out + (size_t)rn * DM, lane); }
        float* xr = p.out + (size_t)row * DM; float s = 0.f;
#pragma unroll
        for (int j = 0; j < 4; ++j) s += v[j].x * v[j].x + v[j].y * v[j].y + v[j].z * v[j].z + v[j].w * v[j].w;
        const float r = rsqrtf(wave_sum(s) * (1.0f / DM) + EPS);
#pragma unroll
        for (int j = 0; j < 4; ++j) { const int c0 = lane * 4 + 256 * j; const f32x4 w = *(const f32x4*)(p.final_w + c0);
            f32x4 o; o.x = v[j].x * r * w.x; o.y = v[j].y * r * w.y; o.z = v[j].z * r * w.z; o.w = v[j].w * r * w.w; *(f32x4*)(xr + c0) = o; }
#pragma unroll
        for (int j = 0; j < 4; ++j) v[j] = nxt[j];
    }
}

struct PostIn { u32x4 raw[5]; f32x4 c64[2], s64[2], c32[2], s32[2]; };
DEV void post_load(PostIn& I, const bf16_t* PRAW, const float* rp, int tok, int lane) {
    const bf16_t* pr = PRAW + (size_t)tok * AINP;
#pragma unroll
    for (int sgm = 0; sgm < 4; ++sgm) I.raw[sgm] = *(const u32x4*)(pr + 512 * sgm + lane * 8);
    I.raw[4] = *(const u32x4*)(pr + 2048 + (lane & 31) * 8);
    const int l = tok & 4095, prow = l >> 6, pcol = l & 63;
    const int k = lane & 7, posv = (k < 4) ? prow : pcol; const float* t64 = rp + posv * 16 + (k & 1) * 8;
    I.c64[0] = *(const f32x4*)t64; I.c64[1] = *(const f32x4*)(t64 + 4); I.s64[0] = *(const f32x4*)(t64 + 1024); I.s64[1] = *(const f32x4*)(t64 + 1028);
    const int k3 = lane & 3, posm = (k3 < 2) ? prow : pcol; const float* t32 = rp + 2048 + posm * 8;
    I.c32[0] = *(const f32x4*)t32; I.c32[1] = *(const f32x4*)(t32 + 4); I.s32[0] = *(const f32x4*)(t32 + 512); I.s32[1] = *(const f32x4*)(t32 + 516);
}
DEV void phase_post(const Params& p) {
    const int wid = TID() >> 6, lane = TID() & 63;
    const bf16_t* PRAW = (const bf16_t*)(p.ws + WS_PRAW);
    bf16_t* QA = (bf16_t*)(p.ws + WS_QA); bf16_t* KA = (bf16_t*)(p.ws + WS_KA); bf16_t* VA = (bf16_t*)(p.ws + WS_VA);
    bf16_t* CQN = (bf16_t*)(p.ws + WS_CQN); bf16_t* CKVN = (bf16_t*)(p.ws + WS_CKVN); bf16_t* G = (bf16_t*)(p.ws + WS_G); bf16_t* KM = (bf16_t*)(p.ws + WS2_KM);
    const float* rp = (const float*)(p.ws + WS_ROPE);
    float wq[8], wk[8], wcq[8], wckv[8];
    { const int k = lane & 7;
#pragma unroll
        for (int j = 0; j < 8; ++j) { wq[j] = p.q_norm[k * 8 + j]; wk[j] = p.k_norm[k * 8 + j]; wcq[j] = p.cq_norm[(lane & 31) * 8 + j]; wckv[j] = p.ckv_norm[(lane & 15) * 8 + j]; } }
    const int stride = gridDim.x * 8;
    int tok = blockIdx.x * 8 + wid;
    PostIn cur, nxt;
    if (tok < NALL) post_load(cur, PRAW, rp, tok, lane);
    for (; tok < NALL; tok += stride) {
        { const int tn = tok + stride < NALL ? tok + stride : tok; post_load(nxt, PRAW, rp, tn, lane); }
        const bool lat = tok < NTOK; int b, pos;
        if (lat) { b = tok >> 12; pos = CTXL + (tok & 4095); } else { const int j = tok - NTOK; b = j >> 8; pos = j & 255; }
        const size_t kvrow = (size_t)b * LK + pos;
        const float cs64[8] = {cur.c64[0].x, cur.c64[0].y, cur.c64[0].z, cur.c64[0].w, cur.c64[1].x, cur.c64[1].y, cur.c64[1].z, cur.c64[1].w};
        const float sn64[8] = {cur.s64[0].x, cur.s64[0].y, cur.s64[0].z, cur.s64[0].w, cur.s64[1].x, cur.s64[1].y, cur.s64[1].z, cur.s64[1].w};
        float v[8], o[8];
        if (lat) {
            unpack8(cur.raw[0], v);
            float ss = 0.f;
#pragma unroll
            for (int j = 0; j < 8; ++j) ss += v[j] * v[j];
            ss += __shfl_xor(ss, 1); ss += __shfl_xor(ss, 2); ss += __shfl_xor(ss, 4);
            const float r = rsqrtf(ss * (1.0f / 64.0f) + EPS); const int k = lane & 7;
#pragma unroll
            for (int j = 0; j < 8; ++j) v[j] = v[j] * r * wq[j];
#pragma unroll
            for (int j = 0; j < 8; ++j) { const float ot = __shfl_xor(v[j], 2);
                o[j] = ((k & 2) ? (v[j] * cs64[j] + ot * sn64[j]) : (v[j] * cs64[j] - ot * sn64[j])) * QSC_A; }
            *(u32x4*)(QA + (size_t)tok * 512 + lane * 8) = pack8(o);
        }
        {
            const u32x4 raw = cur.raw[1]; unpack8(raw, v);
            float ss = 0.f;
#pragma unroll
            for (int j = 0; j < 8; ++j) ss += v[j] * v[j];
            ss += __shfl_xor(ss, 1); ss += __shfl_xor(ss, 2); ss += __shfl_xor(ss, 4);
            const float s8 = ss;
            ss += __shfl_xor(ss, 8); ss += __shfl_xor(ss, 16);
            const float s32 = ss;
            float vn[8]; const int k = lane & 7;
            { const float r = rsqrtf(s8 * (1.0f / 64.0f) + EPS);
#pragma unroll
                for (int j = 0; j < 8; ++j) vn[j] = v[j] * r * wk[j]; }
#pragma unroll
            for (int j = 0; j < 8; ++j) { const float ot = __shfl_xor(vn[j], 2);
                o[j] = lat ? ((k & 2) ? (vn[j] * cs64[j] + ot * sn64[j]) : (vn[j] * cs64[j] - ot * sn64[j])) : vn[j]; }
            if (lane < 16) *(u32x4*)(KA + kvrow * 128 + lane * 8) = pack8(o);
            else if (lane < 32) *(u32x4*)(VA + kvrow * 128 + (lane - 16) * 8) = raw;
            else if (lat) { const float r = rsqrtf(s32 * (1.0f / 256.0f) + EPS); const int cb = (lane - 32) * 8;
#pragma unroll
                for (int j = 0; j < 8; ++j) o[j] = v[j] * r * wcq[j];
                *(u32x4*)(CQN + (size_t)tok * 256 + cb) = pack8(o); }
        }
        {
            unpack8(cur.raw[2], v);
            float ss = 0.f;
#pragma unroll
            for (int j = 0; j < 8; ++j) ss += v[j] * v[j];
            ss += __shfl_xor(ss, 1); ss += __shfl_xor(ss, 2); ss += __shfl_xor(ss, 4); ss += __shfl_xor(ss, 8);
            const int k = lane & 3;
            float oth[8];
#pragma unroll
            for (int j = 0; j < 8; ++j) oth[j] = __shfl_xor(v[j], 1);
            if (lane < 16) { const float r = rsqrtf(ss * (1.0f / 128.0f) + EPS);
#pragma unroll
                for (int j = 0; j < 8; ++j) o[j] = v[j] * r * wckv[j];
                *(u32x4*)(CKVN + kvrow * 128 + lane * 8) = pack8(o); }
            else if (lane < 20) {
                const float cs32[8] = {cur.c32[0].x, cur.c32[0].y, cur.c32[0].z, cur.c32[0].w, cur.c32[1].x, cur.c32[1].y, cur.c32[1].z, cur.c32[1].w};
                const float sn32[8] = {cur.s32[0].x, cur.s32[0].y, cur.s32[0].z, cur.s32[0].w, cur.s32[1].x, cur.s32[1].y, cur.s32[1].z, cur.s32[1].w};
#pragma unroll
                for (int j = 0; j < 8; ++j) o[j] = lat ? ((k & 1) ? (v[j] * cs32[j] + oth[j] * sn32[j]) : (v[j] * cs32[j] - oth[j] * sn32[j])) : v[j];
                const u32x4 w = pack8(o);
#pragma unroll
                for (int h = 0; h < 8; ++h) *(u32x4*)(KM + kvrow * 768 + h * 96 + 64 + k * 8) = w; }
            else if (lat) {
#pragma unroll
                for (int j = 0; j < 8; ++j) o[j] = silu(v[j]);
                *(u32x4*)(G + (size_t)tok * 1024 + (lane - 20) * 8) = pack8(o); }
        }
        if (lat) {
            unpack8(cur.raw[3], v);
#pragma unroll
            for (int j = 0; j < 8; ++j) o[j] = silu(v[j]);
            *(u32x4*)(G + (size_t)tok * 1024 + 352 + lane * 8) = pack8(o);
            if (lane < 20) { unpack8(cur.raw[4], v);
#pragma unroll
                for (int j = 0; j < 8; ++j) o[j] = silu(v[j]);
                *(u32x4*)(G + (size_t)tok * 1024 + 864 + lane * 8) = pack8(o); }
        }
        cur = nxt;
    }
}

template <int DQK>
DEV void attn_unit(char* lds, const bf16_t* __restrict__ Q, int ldq, int qcol, const bf16_t* __restrict__ Kp, int ldk, int kcol, const bf16_t* __restrict__ Vp, int ldv, int vcol,
                   const bf16_t* __restrict__ Gt, bf16_t* OG, int ocol, int b, int q0) {
    constexpr int KRS = (DQK + 8) * 2, KB = 64 * KRS, VRS = 192, VB = 64 * VRS, STG = KB + VB, NKS = DQK / 16, KCH = DQK / 8;
    const int tid = TID(), lane = tid & 63, wid = tid >> 6, l31 = lane & 31, hi = lane >> 5;
    bf16x8 qf[NKS];
    { const bf16_t* qp = Q + (size_t)(b * SEQ + q0 + wid * 32 + l31) * ldq + qcol + hi * 8;
#pragma unroll
        for (int ks = 0; ks < NKS; ++ks) qf[ks] = *(const bf16x8*)(qp + ks * 16); }
    const bf16_t* kbase = Kp + (size_t)b * LK * ldk + kcol; const bf16_t* vbase = Vp + (size_t)b * LK * ldv + vcol;
    const int kr0 = tid / KCH, kc0 = tid % KCH;
    const int kr1 = (tid + 512) / KCH, kc1 = (tid + 512) % KCH;
    const bool k2 = (KCH * 64 > 512) && (tid + 512 < KCH * 64);
    const int vr = tid >> 3, vc = tid & 7;
    u32x4 sk0, sk1, sv;
#define A_LOAD(t) do { const size_t kp_ = (size_t)(t) * 64; sk0 = *(const u32x4*)(kbase + (kp_ + kr0) * ldk + kc0 * 8); \
        if (k2) sk1 = *(const u32x4*)(kbase + (kp_ + kr1) * ldk + kc1 * 8); sv = *(const u32x4*)(vbase + (kp_ + vr) * ldv + vc * 8); } while (0)
#define A_STORE(buf) do { char* b_ = lds + (buf) * STG; *(u32x4*)(b_ + kr0 * KRS + kc0 * 16) = sk0; if (k2) *(u32x4*)(b_ + kr1 * KRS + kc1 * 16) = sk1; \
        *(u32x4*)(b_ + KB + vr * VRS + vc * 16) = sv; } while (0)
    f32x16 o0, o1;
#pragma unroll
    for (int r = 0; r < 16; ++r) { o0[r] = 0.f; o1[r] = 0.f; }
    float m_run = -1e30f, l_run = 0.f;
    const int g1 = (lane >> 4) & 1, tq = (lane & 15) >> 2, tp = lane & 3;
    const int vt_off = KB + (4 * hi + tq) * VRS + (16 * g1 + 4 * tp) * 2;
    const int kf_off = l31 * KRS + hi * 16;
    constexpr int NT = LK / 64;
    A_LOAD(0); A_STORE(0);
    __syncthreads();
    for (int t = 0; t < NT; ++t) {
        const bool more = (t + 1 < NT);
        if (more) A_LOAD(t + 1);
        const char* b_ = lds + (t & 1) * STG;
        f32x16 p0, p1;
#pragma unroll
        for (int r = 0; r < 16; ++r) { p0[r] = 0.f; p1[r] = 0.f; }
#pragma unroll
        for (int ks = 0; ks < NKS; ++ks) {
            const bf16x8 ka = *(const bf16x8*)(b_ + kf_off + ks * 32);
            const bf16x8 kb = *(const bf16x8*)(b_ + kf_off + 32 * KRS + ks * 32);
            p0 = __builtin_amdgcn_mfma_f32_32x32x16_bf16(ka, qf[ks], p0, 0, 0, 0);
            p1 = __builtin_amdgcn_mfma_f32_32x32x16_bf16(kb, qf[ks], p1, 0, 0, 0);
        }
        float mx = p0[0];
#pragma unroll
        for (int r = 1; r < 16; ++r) mx = fmaxf(mx, p0[r]);
#pragma unroll
        for (int r = 0; r < 16; ++r) mx = fmaxf(mx, p1[r]);
        mx = fmaxf(mx, __shfl_xor(mx, 32));
        const float m_new = fmaxf(m_run, mx);
        const float alpha = __builtin_amdgcn_exp2f(m_run - m_new);
        m_run = m_new;
        float ls = 0.f;
#pragma unroll
        for (int r = 0; r < 16; ++r) { p0[r] = __builtin_amdgcn_exp2f(p0[r] - m_new); p1[r] = __builtin_amdgcn_exp2f(p1[r] - m_new); ls += p0[r] + p1[r]; }
        l_run = l_run * alpha + ls;
#pragma unroll
        for (int r = 0; r < 16; ++r) { o0[r] *= alpha; o1[r] *= alpha; }
        u32x4 pw[4];
        pw[0] = (u32x4){pk2(p0[0], p0[1]), pk2(p0[2], p0[3]), pk2(p0[4], p0[5]), pk2(p0[6], p0[7])};
        pw[1] = (u32x4){pk2(p0[8], p0[9]), pk2(p0[10], p0[11]), pk2(p0[12], p0[13]), pk2(p0[14], p0[15])};
        pw[2] = (u32x4){pk2(p1[0], p1[1]), pk2(p1[2], p1[3]), pk2(p1[4], p1[5]), pk2(p1[6], p1[7])};
        pw[3] = (u32x4){pk2(p1[8], p1[9]), pk2(p1[10], p1[11]), pk2(p1[12], p1[13]), pk2(p1[14], p1[15])};
#pragma unroll
        for (int s = 0; s < 4; ++s) {
            const bf16x8 pb = __builtin_bit_cast(bf16x8, pw[s]);
#pragma unroll
            for (int dt = 0; dt < 2; ++dt) {
                const char* vp = b_ + vt_off + s * 16 * VRS + dt * 64;
                const s16x4 lo = __builtin_bit_cast(s16x4, __builtin_amdgcn_ds_read_tr16_b64_v4i16((LAS s16x4*)vp));
                const s16x4 hh = __builtin_bit_cast(s16x4, __builtin_amdgcn_ds_read_tr16_b64_v4i16((LAS s16x4*)(vp + 8 * VRS)));
                const bf16x8 vf = (bf16x8){lo[0], lo[1], lo[2], lo[3], hh[0], hh[1], hh[2], hh[3]};
                if (dt == 0) o0 = __builtin_amdgcn_mfma_f32_32x32x16_bf16(vf, pb, o0, 0, 0, 0);
                else o1 = __builtin_amdgcn_mfma_f32_32x32x16_bf16(vf, pb, o1, 0, 0, 0);
            }
        }
        if (more) A_STORE((t + 1) & 1);
        __syncthreads();
    }
#undef A_LOAD
#undef A_STORE
    const float lt = l_run + __shfl_xor(l_run, 32); const float inv = 1.0f / lt;
    const size_t tok = (size_t)(b * SEQ + q0 + wid * 32 + l31);
#pragma unroll
    for (int dt = 0; dt < 2; ++dt)
#pragma unroll
        for (int g = 0; g < 4; ++g) { const int d = 32 * dt + 8 * g + 4 * hi; const size_t off = tok * 1024 + ocol + d;
            const u32x2 gw = *(const u32x2*)(Gt + off);
            const f32x16& oo = dt ? o1 : o0;
            u32x2 w; w.x = pk2(oo[4 * g] * inv * lo_bf(gw.x), oo[4 * g + 1] * inv * hi_bf(gw.x)); w.y = pk2(oo[4 * g + 2] * inv * lo_bf(gw.y), oo[4 * g + 3] * inv * hi_bf(gw.y));
            *(u32x2*)(OG + off) = w; }
}

DEV float max3f_s(float a, float b, float c) { float r; asm("v_max3_f32 %0, %1, %2, %3" : "=v"(r) : "v"(a), "v"(b), "v"(c)); return r; }
DEV float max2f_s(float a, float b) { float r; asm("v_max_f32_e32 %0, %1, %2" : "=v"(r) : "v"(a), "v"(b)); return r; }
DEV float fadd_s(float a, float b) { float r; asm("v_add_f32_e32 %0, %1, %2" : "=v"(r) : "v"(a), "v"(b)); return r; }
DEV float sum8_after_trans(float a, float b, float c, float d, float e, float f, float g, float h) {
    float r, t;
    asm("s_nop 0\n\tv_add_f32_e32 %0, %2, %3\n\tv_add_f32_e32 %1, %4, %5\n\tv_add_f32_e32 %0, %0, %6\n\tv_add_f32_e32 %1, %1, %7\n\tv_add_f32_e32 %0, %0, %8\n\tv_add_f32_e32 %1, %1, %9\n\tv_add_f32_e32 %0, %0, %1"
        : "=&v"(r), "=&v"(t) : "v"(a), "v"(b), "v"(c), "v"(d), "v"(e), "v"(f), "v"(g), "v"(h));
    return r;
}
DEV float swapmax32(float v) { auto rr = __builtin_amdgcn_permlane32_swap(__float_as_uint(v), __float_as_uint(v), false, false); return fmaxf(__uint_as_float(rr[0]), __uint_as_float(rr[1])); }
DEV float swapsum32(float v) { auto rr = __builtin_amdgcn_permlane32_swap(__float_as_uint(v), __float_as_uint(v), false, false); return __uint_as_float(rr[0]) + __uint_as_float(rr[1]); }
template <int DQK>
DEV void attn_unit2(char* lds, const bf16_t* __restrict__ Q, int ldq, int qcol, const bf16_t* __restrict__ Kp, int ldk, int kcol, const bf16_t* __restrict__ Vp, int ldv, int vcol,
                    const bf16_t* __restrict__ Gt, bf16_t* OG, int ocol, int b, int q0) {
    constexpr int KRS = (DQK + 8) * 2, KB = 64 * KRS, VRS = 192, VB = 64 * VRS, NKS = DQK / 16, KCH = DQK / 8, VOFF = 2 * KB;
    constexpr float THR = 8.0f;
    constexpr int NT = LK / 64;
    const int tid = TID(), lane = tid & 63, wid = tid >> 6, l31 = lane & 31, hi = lane >> 5;
    bf16x8 qf[NKS];
    { const bf16_t* qp = Q + (size_t)(b * SEQ + q0 + wid * 32 + l31) * ldq + qcol + hi * 8;
#pragma unroll
        for (int ks = 0; ks < NKS; ++ks) qf[ks] = *(const bf16x8*)(qp + ks * 16); }
    const bf16_t* kbase = Kp + (size_t)b * LK * ldk + kcol; const bf16_t* vbase = Vp + (size_t)b * LK * ldv + vcol;
    constexpr bool K2 = (KCH * 64 > 512);
    const bool k2 = K2 && (tid + 512 < KCH * 64);
    const int kr0 = tid / KCH, kc0 = tid % KCH, kr1 = k2 ? (tid + 512) / KCH : kr0, kc1 = k2 ? (tid + 512) % KCH : kc0;
    const int vr = tid >> 3, vc = tid & 7;
    u32x4 skX0, skX1 = {0u, 0u, 0u, 0u}, svX;
#define A_LOADK(t, S) do { const int tt_ = (t) < NT ? (t) : NT - 1; const size_t kp_ = (size_t)tt_ * 64; sk##S##0 = *(const u32x4*)(kbase + (kp_ + kr0) * ldk + kc0 * 8); if (K2) sk##S##1 = *(const u32x4*)(kbase + (kp_ + kr1) * ldk + kc1 * 8); } while (0)
#define A_LOADV(t, S) do { const int tt_ = (t) < NT ? (t) : NT - 1; sv##S = *(const u32x4*)(vbase + ((size_t)tt_ * 64 + vr) * ldv + vc * 8); } while (0)
#define A_STOREK(slot, S) do { char* b_ = lds + (slot) * KB; *(u32x4*)(b_ + kr0 * KRS + kc0 * 16) = sk##S##0; if (K2) *(u32x4*)(b_ + kr1 * KRS + kc1 * 16) = sk##S##1; } while (0)
#define A_STOREV(slot, S) do { *(u32x4*)(lds + VOFF + (slot) * VB + vr * VRS + vc * 16) = sv##S; } while (0)
    f32x16 o0, o1, negm;
#pragma unroll
    for (int r = 0; r < 16; ++r) { o0[r] = 0.f; o1[r] = 0.f; negm[r] = 0.f; }
    asm volatile("" : "+v"(negm));
    float mhat = 0.f, l_run = 0.f;
    const int g1 = (lane >> 4) & 1, tq = (lane & 15) >> 2, tp = lane & 3;
    const int vt_off = VOFF + (4 * hi + tq) * VRS + (16 * g1 + 4 * tp) * 2;
    const int kf_off = l31 * KRS + hi * 16;
#define A_QK(P0, P1, slot) do { const char* kb_ = lds + (slot) * KB + kf_off; \
        _Pragma("unroll") for (int ks = 0; ks < NKS; ++ks) { \
            const bf16x8 ka = *(const bf16x8*)(kb_ + ks * 32); const bf16x8 kb2 = *(const bf16x8*)(kb_ + 32 * KRS + ks * 32); \
            if (ks == 0) { P0 = __builtin_amdgcn_mfma_f32_32x32x16_bf16(ka, qf[0], negm, 0, 0, 0); P1 = __builtin_amdgcn_mfma_f32_32x32x16_bf16(kb2, qf[0], negm, 0, 0, 0); } \
            else { P0 = __builtin_amdgcn_mfma_f32_32x32x16_bf16(ka, qf[ks], P0, 0, 0, 0); P1 = __builtin_amdgcn_mfma_f32_32x32x16_bf16(kb2, qf[ks], P1, 0, 0, 0); } } } while (0)
    A_LOADK(0, X); A_LOADV(0, X); A_STOREK(0, X); A_STOREV(0, X); A_LOADK(1, X); A_STOREK(1, X);
    __syncthreads();
    f32x16 pA0, pA1, pB0, pB1;
#pragma unroll
    for (int r = 0; r < 16; ++r) { pB0[r] = 0.f; pB1[r] = 0.f; }
    A_QK(pA0, pA1, 0);
#define A_STEP(P0, P1, N0, N1, t, SL, SS) do { \
        A_LOADK((t) + 2, SL); A_LOADV((t) + 1, SL); \
        __builtin_amdgcn_s_setprio(1); A_QK(N0, N1, ((t) + 1) & 1); __builtin_amdgcn_s_setprio(0); \
        float a_ = fmaxf(fmaxf(P0[0], P0[1]), P1[0]), c_ = fmaxf(fmaxf(P0[2], P0[3]), P1[1]); a_ = fmaxf(fmaxf(a_, P1[2]), P1[3]); \
        _Pragma("unroll") for (int r = 4; r < 16; r += 4) { a_ = fmaxf(fmaxf(a_, P0[r]), P0[r + 1]); c_ = fmaxf(fmaxf(c_, P0[r + 2]), P0[r + 3]); a_ = fmaxf(fmaxf(a_, P1[r]), P1[r + 1]); c_ = fmaxf(fmaxf(c_, P1[r + 2]), P1[r + 3]); } \
        const float rm = swapmax32(fmaxf(a_, c_)); \
        if ((t) == 0 || __any(rm > THR)) { \
            const float dl = ((t) == 0) ? rm : fmaxf(rm, 0.f); mhat += dl; \
            _Pragma("unroll") for (int r = 0; r < 16; ++r) { P0[r] -= dl; P1[r] -= dl; N0[r] -= dl; N1[r] -= dl; } \
            if ((t) != 0) { const float f = __builtin_amdgcn_exp2f(-dl); l_run *= f; _Pragma("unroll") for (int r = 0; r < 16; ++r) { o0[r] *= f; o1[r] *= f; } } \
            _Pragma("unroll") for (int r = 0; r < 16; ++r) negm[r] = -mhat; asm volatile("" : "+v"(negm)); } \
        _Pragma("unroll") for (int r = 0; r < 16; ++r) { P0[r] = __builtin_amdgcn_exp2f(P0[r]); P1[r] = __builtin_amdgcn_exp2f(P1[r]); } \
        { const float q0_ = sum8_after_trans(P0[0], P0[1], P0[2], P0[3], P0[4], P0[5], P0[6], P0[7]), q1_ = sum8_after_trans(P0[8], P0[9], P0[10], P0[11], P0[12], P0[13], P0[14], P0[15]); \
          const float q2_ = sum8_after_trans(P1[0], P1[1], P1[2], P1[3], P1[4], P1[5], P1[6], P1[7]), q3_ = sum8_after_trans(P1[8], P1[9], P1[10], P1[11], P1[12], P1[13], P1[14], P1[15]); \
          l_run += (q0_ + q1_) + (q2_ + q3_); } \
        u32x4 pw[4]; \
        pw[0] = (u32x4){pk2(P0[0], P0[1]), pk2(P0[2], P0[3]), pk2(P0[4], P0[5]), pk2(P0[6], P0[7])}; \
        pw[1] = (u32x4){pk2(P0[8], P0[9]), pk2(P0[10], P0[11]), pk2(P0[12], P0[13]), pk2(P0[14], P0[15])}; \
        pw[2] = (u32x4){pk2(P1[0], P1[1]), pk2(P1[2], P1[3]), pk2(P1[4], P1[5]), pk2(P1[6], P1[7])}; \
        pw[3] = (u32x4){pk2(P1[8], P1[9]), pk2(P1[10], P1[11]), pk2(P1[12], P1[13]), pk2(P1[14], P1[15])}; \
        { const char* vb_ = lds + ((t) & 1) * VB + vt_off; \
        _Pragma("unroll") for (int s = 0; s < 4; ++s) { const bf16x8 pb = __builtin_bit_cast(bf16x8, pw[s]); \
            _Pragma("unroll") for (int dt = 0; dt < 2; ++dt) { const char* vp = vb_ + s * 16 * VRS + dt * 64; \
                const s16x4 lo = __builtin_bit_cast(s16x4, __builtin_amdgcn_ds_read_tr16_b64_v4i16((LAS s16x4*)vp)); \
                const s16x4 hh = __builtin_bit_cast(s16x4, __builtin_amdgcn_ds_read_tr16_b64_v4i16((LAS s16x4*)(vp + 8 * VRS))); \
                const bf16x8 vf = (bf16x8){lo[0], lo[1], lo[2], lo[3], hh[0], hh[1], hh[2], hh[3]}; \
                if (dt == 0) o0 = __builtin_amdgcn_mfma_f32_32x32x16_bf16(vf, pb, o0, 0, 0, 0); else o1 = __builtin_amdgcn_mfma_f32_32x32x16_bf16(vf, pb, o1, 0, 0, 0); } } } \
        A_STOREK((t) & 1, SS); A_STOREV(((t) + 1) & 1, SS); \
        __syncthreads(); } while (0)
    for (int t = 0; t < NT; t += 2) {
        A_STEP(pA0, pA1, pB0, pB1, t, X, X);
        A_STEP(pB0, pB1, pA0, pA1, t + 1, X, X);
    }
#undef A_STEP
#undef A_QK
#undef A_LOADK
#undef A_LOADV
#undef A_STOREK
#undef A_STOREV
    const float inv = 1.0f / swapsum32(l_run);
    const size_t tok = (size_t)(b * SEQ + q0 + wid * 32 + l31);
#pragma unroll
    for (int dt = 0; dt < 2; ++dt)
#pragma unroll
        for (int g = 0; g < 4; ++g) { const int d = 32 * dt + 8 * g + 4 * hi; const size_t off = tok * 1024 + ocol + d;
            const u32x2 gw = *(const u32x2*)(Gt + off);
            const f32x16& oo = dt ? o1 : o0;
            u32x2 w; w.x = pk2(oo[4 * g] * inv * lo_bf(gw.x), oo[4 * g + 1] * inv * hi_bf(gw.x)); w.y = pk2(oo[4 * g + 2] * inv * lo_bf(gw.y), oo[4 * g + 3] * inv * hi_bf(gw.y));
            *(u32x2*)(OG + off) = w; }
}

DEV void phase_attn(char* lds, const Params& p) {
    const bf16_t* QA = (const bf16_t*)(p.ws + WS_QA); const bf16_t* KA = (const bf16_t*)(p.ws + WS_KA); const bf16_t* VA = (const bf16_t*)(p.ws + WS_VA);
    const bf16_t* QM = (const bf16_t*)(p.ws + WS_QM); const bf16_t* KM = (const bf16_t*)(p.ws + WS2_KM); const bf16_t* VM = (const bf16_t*)(p.ws + WS2_VM);
    const bf16_t* G = (const bf16_t*)(p.ws + WS_G); bf16_t* OG = (bf16_t*)(p.ws + WS2_OG);
    const int vblk = (gridDim.x % 8 == 0) ? (int)((blockIdx.x % 8) * (gridDim.x / 8) + blockIdx.x / 8) : (int)blockIdx.x;
    for (int u = vblk; u < 2048; u += gridDim.x) {
        const int type = u >> 10, rem = u & 1023, b = rem >> 7, h = (rem >> 4) & 7, qb = rem & 15;
        if (type == 0) attn_unit2<64>(lds, QA, 512, h * 64, KA, 128, (h >> 2) * 64, VA, 128, (h >> 2) * 64, G, OG, h * 64, b, qb * 256);
        else attn_unit2<96>(lds, QM, 768, h * 96, KM, 768, h * 96, VM, 512, h * 64, G, OG, 512 + h * 64, b, qb * 256);
    }
}

constexpr int CV_PADL = 192, CV_ROW = 4488, CV_RS = CV_ROW * 2;
constexpr int CV_UB = 8 * CV_RS;
constexpr int CV_FS = 16416;
DEV void conv_load_filter(char* lds, const bf16_t* gr) {
    const int tid = TID();
#pragma unroll
    for (int rnd = 0; rnd < 2; ++rnd) {
        const int ch = tid + rnd * 512;
        const u32x4 a = *(const u32x4*)(gr + ch * 8);
        u32x4 bq = {0u, 0u, 0u, 0u}; if (ch + 1 < 1024) bq = *(const u32x4*)(gr + ch * 8 + 8);
        const unsigned w[8] = {a.x, a.y, a.z, a.w, bq.x, bq.y, bq.z, bq.w};
        char* f = lds + CV_UB + ch * 16;
        *(u32x4*)(f) = a;
        u32x4 c1, c2, c3;
        c1.x = __builtin_amdgcn_alignbit(w[1], w[0], 16); c1.y = __builtin_amdgcn_alignbit(w[2], w[1], 16); c1.z = __builtin_amdgcn_alignbit(w[3], w[2], 16); c1.w = __builtin_amdgcn_alignbit(w[4], w[3], 16);
        c2 = (u32x4){w[1], w[2], w[3], w[4]};
        c3.x = __builtin_amdgcn_alignbit(w[2], w[1], 16); c3.y = __builtin_amdgcn_alignbit(w[3], w[2], 16); c3.z = __builtin_amdgcn_alignbit(w[4], w[3], 16); c3.w = __builtin_amdgcn_alignbit(w[5], w[4], 16);
        *(u32x4*)(f + CV_FS) = c1; *(u32x4*)(f + 2 * CV_FS) = c2; *(u32x4*)(f + 3 * CV_FS) = c3;
    }
}
DEV void sconv4(const bf16_t* px, int t, float w0, float w1, float w2, float bias, float* u) {
    const u32x2 mid = *(const u32x2*)(px + t);
    const float pm = (t > 0) ? bf2f(px[t - 1]) : 0.f, pp = (t + 4 < SEQ) ? bf2f(px[t + 4]) : 0.f;
    const float q0 = lo_bf(mid.x), q1 = hi_bf(mid.x), q2 = lo_bf(mid.y), q3 = hi_bf(mid.y);
    u[0] = w0 * pm + w1 * q0 + w2 * q1 + bias; u[1] = w0 * q0 + w1 * q1 + w2 * q2 + bias; u[2] = w0 * q1 + w1 * q2 + w2 * q3 + bias; u[3] = w0 * q2 + w1 * q3 + w2 * pp + bias;
}
template <bool V0, bool V1>
DEV void conv_step(const char* lds, f32x16 (&acc)[2][2], const int (&a_off)[2], const int (&b_off)[2], int d) {
    bf16x8 fa[2][4];
#pragma unroll
    for (int mt = 0; mt < 2; ++mt)
#pragma unroll
        for (int ks = 0; ks < 4; ++ks) { const char* ap = lds + a_off[mt] - 128 * d + ks * 32;
            const u32x2 lo = *(const u32x2*)ap, hh = *(const u32x2*)(ap + 8);
            fa[mt][ks] = __builtin_bit_cast(bf16x8, (u32x4){lo.x, lo.y, hh.x, hh.y}); }
#pragma unroll
    for (int n = 0; n < 2; ++n) {
        if ((n == 0 && V0) || (n == 1 && V1)) {
#pragma unroll
            for (int ks = 0; ks < 4; ++ks) { const bf16x8 fb = *(const bf16x8*)(lds + b_off[n] - 128 * d + ks * 32);
#pragma unroll
                for (int mt = 0; mt < 2; ++mt) acc[n][mt] = __builtin_amdgcn_mfma_f32_32x32x16_bf16(fa[mt][ks], fb, acc[n][mt], 0, 0, 0); }
        }
    }
}
struct ConvFrags { bf16x8 a[6], b0[4], b1[4]; };
DEV void conv_load_frags(ConvFrags& F, const char* lds, int a_off0, int a_off0h, int b_off0, int b_off1, int d) {
#pragma unroll
    for (int j = 0; j < 6; ++j) { const u32x2 lo = *(const u32x2*)(lds + a_off0 - 128 * d + (j - 2) * 32), hh = *(const u32x2*)(lds + a_off0h - 128 * d + (j - 2) * 32);
        F.a[j] = __builtin_bit_cast(bf16x8, (u32x4){lo.x, lo.y, hh.x, hh.y}); }
#pragma unroll
    for (int ks = 0; ks < 4; ++ks) { F.b0[ks] = *(const bf16x8*)(lds + b_off0 - 128 * d + ks * 32); F.b1[ks] = *(const bf16x8*)(lds + b_off1 - 128 * d + ks * 32); }
}
DEV void conv_mfma_frags(const ConvFrags& F, f32x16 (&acc)[2][2]) {
#pragma unroll
    for (int ks = 0; ks < 4; ++ks) {
        acc[0][0] = __builtin_amdgcn_mfma_f32_32x32x16_bf16(F.a[ks + 2], F.b0[ks], acc[0][0], 0, 0, 0);
        acc[0][1] = __builtin_amdgcn_mfma_f32_32x32x16_bf16(F.a[ks], F.b0[ks], acc[0][1], 0, 0, 0);
        acc[1][0] = __builtin_amdgcn_mfma_f32_32x32x16_bf16(F.a[ks + 2], F.b1[ks], acc[1][0], 0, 0, 0);
        acc[1][1] = __builtin_amdgcn_mfma_f32_32x32x16_bf16(F.a[ks], F.b1[ks], acc[1][1], 0, 0, 0);
    }
}
DEV void conv_mfma_loop(const char* lds, f32x16 (&acc)[2][2], int wid, int lane) {
    const int l31 = lane & 31, hi = lane >> 5;
#pragma unroll
    for (int a = 0; a < 2; ++a)
#pragma unroll
        for (int b = 0; b < 2; ++b)
#pragma unroll
            for (int r = 0; r < 16; ++r) acc[a][b][r] = 0.f;
    int a_off[2];
#pragma unroll
    for (int mt = 0; mt < 2; ++mt) { const int r = l31 + 32 * mt, q = (4 - (r & 3)) & 3; a_off[mt] = CV_UB + q * CV_FS + (4096 - r - q + 8 * hi) * 2; }
    int b_off[2];
#pragma unroll
    for (int n = 0; n < 2; ++n) { const int nt = 2 * wid + n; b_off[n] = (l31 & 7) * CV_RS + (CV_PADL + 64 * (4 * nt + (l31 >> 3)) + 8 * hi) * 2; }
    const int dlo = 8 * wid - 63;
#pragma unroll
    for (int j = 0; j < 4; ++j) conv_step<true, false>(lds, acc, a_off, b_off, dlo + j);
    ConvFrags F0, F1; const int d0 = dlo + 4; int a_hi = a_off[0] + 8; asm volatile("" : "+v"(a_hi));
    conv_load_frags(F0, lds, a_off[0], a_hi, b_off[0], b_off[1], d0);
#pragma unroll 1
    for (int j = 0; j < 31; ++j) { const int d = d0 + 2 * j;
        conv_load_frags(F1, lds, a_off[0], a_hi, b_off[0], b_off[1], d + 1); __builtin_amdgcn_sched_barrier(0);
        conv_mfma_frags(F0, acc); __builtin_amdgcn_sched_barrier(0);
        conv_load_frags(F0, lds, a_off[0], a_hi, b_off[0], b_off[1], d + 2); __builtin_amdgcn_sched_barrier(0);
        conv_mfma_frags(F1, acc); __builtin_amdgcn_sched_barrier(0); }
    conv_mfma_frags(F0, acc);
#pragma unroll
    for (int j = 0; j < 4; ++j) conv_step<false, true>(lds, acc, a_off, b_off, dlo + 67 + j);
}
DEV void conv_unit(char* lds, const Params& p, int c) {
    const int tid = TID(), lane = tid & 63, wid = tid >> 6, l31 = lane & 31, hi = lane >> 5;
    const bf16_t* PT = (const bf16_t*)(p.ws + WS_PT); const bf16_t* GR = (const bf16_t*)(p.ws + WS_GR); const float* ssum = (const float*)(p.ws + WS_SSUM);
    bf16_t* OG2 = (bf16_t*)(p.ws + WS_OG2);
    for (int i = tid; i < 8 * 98; i += 512) { const int b = i / 98, j = i % 98;
        const int e = (j < 48) ? j * 4 : (CV_PADL + SEQ + (j - 48) * 4); *(u32x2*)(lds + b * CV_RS + e * 2) = (u32x2){0u, 0u}; }
    { const float w0 = p.conv_w[c], w1 = p.conv_w[3072 + c], w2 = p.conv_w[6144 + c], bias = p.conv_b[c];
        for (int i = tid; i < 8 * 1024; i += 512) { const int b = i >> 10, t = (i & 1023) * 4; float u[4];
            sconv4(PT + ((size_t)(b * 4096 + c)) * 4096, t, w0, w1, w2, bias, u);
            u32x2 w; w.x = pk2(u[0], u[1]); w.y = pk2(u[2], u[3]); *(u32x2*)(lds + b * CV_RS + (CV_PADL + t) * 2) = w; } }
    conv_load_filter(lds, GR + (size_t)c * 8192);
    __syncthreads();
    f32x16 acc[2][2];
    conv_mfma_loop(lds, acc, wid, lane);
    __syncthreads();
    { const float invs = 1.0f / ssum[c], sk = p.skip[c];
        const float w0 = p.conv_w[1024 + c], w1 = p.conv_w[3072 + 1024 + c], w2 = p.conv_w[6144 + 1024 + c], bias = p.conv_b[1024 + c];
        const int b = l31 & 7;
#pragma unroll
        for (int n = 0; n < 2; ++n) { const int i = 4 * (2 * wid + n) + (l31 >> 3);
#pragma unroll
            for (int mt = 0; mt < 2; ++mt)
#pragma unroll
                for (int g = 0; g < 4; ++g) { const int t = 64 * i + 32 * mt + 8 * g + 4 * hi; float x1[4];
                    sconv4(PT + ((size_t)(b * 4096 + 1024 + c)) * 4096, t, w0, w1, w2, bias, x1);
                    char* up = lds + b * CV_RS + (CV_PADL + t) * 2; const u32x2 vw = *(const u32x2*)up;
                    const float z0 = x1[0] * (acc[n][mt][4 * g] * invs + sk * lo_bf(vw.x)), z1 = x1[1] * (acc[n][mt][4 * g + 1] * invs + sk * hi_bf(vw.x));
                    const float z2 = x1[2] * (acc[n][mt][4 * g + 2] * invs + sk * lo_bf(vw.y)), z3 = x1[3] * (acc[n][mt][4 * g + 3] * invs + sk * hi_bf(vw.y));
                    u32x2 w; w.x = pk2(z0, z1); w.y = pk2(z2, z3); *(u32x2*)up = w; } } }
    conv_load_filter(lds, GR + (size_t)(1024 + c) * 8192);
    __syncthreads();
    conv_mfma_loop(lds, acc, wid, lane);
    { const float invs = 1.0f / ssum[1024 + c], sk = p.skip[1024 + c];
        const float w0 = p.conv_w[2048 + c], w1 = p.conv_w[3072 + 2048 + c], w2 = p.conv_w[6144 + 2048 + c], bias = p.conv_b[2048 + c];
        const int b = l31 & 7;
#pragma unroll
        for (int n = 0; n < 2; ++n) { const int i = 4 * (2 * wid + n) + (l31 >> 3);
#pragma unroll
            for (int mt = 0; mt < 2; ++mt)
#pragma unroll
                for (int g = 0; g < 4; ++g) { const int t = 64 * i + 32 * mt + 8 * g + 4 * hi; float x2[4];
                    sconv4(PT + ((size_t)(b * 4096 + 2048 + c)) * 4096, t, w0, w1, w2, bias, x2);
                    const u32x2 zw = *(const u32x2*)(lds + b * CV_RS + (CV_PADL + t) * 2);
                    const u32x2 gw = *(const u32x2*)(PT + ((size_t)(b * 4096 + 3072 + c)) * 4096 + t);
                    const float y0 = x2[0] * (acc[n][mt][4 * g] * invs + sk * lo_bf(zw.x)) * silu(lo_bf(gw.x)), y1 = x2[1] * (acc[n][mt][4 * g + 1] * invs + sk * hi_bf(zw.x)) * silu(hi_bf(gw.x));
                    const float y2 = x2[2] * (acc[n][mt][4 * g + 2] * invs + sk * lo_bf(zw.y)) * silu(lo_bf(gw.y)), y3 = x2[3] * (acc[n][mt][4 * g + 3] * invs + sk * hi_bf(zw.y)) * silu(hi_bf(gw.y));
                    u32x2 w; w.x = pk2(y0, y1); w.y = pk2(y2, y3); *(u32x2*)(OG2 + ((size_t)(b * 1024 + c)) * 4096 + t) = w; } } }
    __syncthreads();
}

struct Raw3 { u32x2 mid; unsigned halo; };
DEV Raw3 ld_raw3(const bf16_t* px, int t) {
    Raw3 r; r.mid = *(const u32x2*)(px + t);
    const unsigned a = px[t - 1], b = px[t + 4];
    r.halo = (t > 0 ? a : 0u) | ((t + 4 < SEQ ? b : 0u) << 16);
    return r;
}
DEV void sconv_raw(const Raw3& r, float w0, float w1, float w2, float bias, float* u) {
    const float pm = lo_bf(r.halo), pp = hi_bf(r.halo), q0 = lo_bf(r.mid.x), q1 = hi_bf(r.mid.x), q2 = lo_bf(r.mid.y), q3 = hi_bf(r.mid.y);
    u[0] = w0 * pm + w1 * q0 + w2 * q1 + bias; u[1] = w0 * q0 + w1 * q1 + w2 * q2 + bias; u[2] = w0 * q1 + w1 * q2 + w2 * q3 + bias; u[3] = w0 * q2 + w1 * q3 + w2 * pp + bias;
}
struct FiltRegs { u32x4 a[2], b[2]; };
DEV void filt_load(FiltRegs& f, const bf16_t* gr, int tid) {
#pragma unroll
    for (int rnd = 0; rnd < 2; ++rnd) { const int ch = tid + rnd * 512; f.a[rnd] = *(const u32x4*)(gr + ch * 8);
        const int ch1 = ch + 1 < 1024 ? ch + 1 : ch; const u32x4 t = *(const u32x4*)(gr + ch1 * 8); f.b[rnd] = (ch + 1 < 1024) ? t : (u32x4){0u, 0u, 0u, 0u}; }
}
DEV void filt_store(char* lds, const FiltRegs& f, int tid) {
#pragma unroll
    for (int rnd = 0; rnd < 2; ++rnd) { const int ch = tid + rnd * 512; const u32x4 a = f.a[rnd], bq = f.b[rnd];
        const unsigned w[8] = {a.x, a.y, a.z, a.w, bq.x, bq.y, bq.z, bq.w};
        char* fp = lds + CV_UB + ch * 16;
        *(u32x4*)(fp) = a;
        u32x4 c1, c2, c3;
        c1.x = __builtin_amdgcn_alignbit(w[1], w[0], 16); c1.y = __builtin_amdgcn_alignbit(w[2], w[1], 16); c1.z = __builtin_amdgcn_alignbit(w[3], w[2], 16); c1.w = __builtin_amdgcn_alignbit(w[4], w[3], 16);
        c2 = (u32x4){w[1], w[2], w[3], w[4]};
        c3.x = __builtin_amdgcn_alignbit(w[2], w[1], 16); c3.y = __builtin_amdgcn_alignbit(w[3], w[2], 16); c3.z = __builtin_amdgcn_alignbit(w[4], w[3], 16); c3.w = __builtin_amdgcn_alignbit(w[5], w[4], 16);
        *(u32x4*)(fp + CV_FS) = c1; *(u32x4*)(fp + 2 * CV_FS) = c2; *(u32x4*)(fp + 3 * CV_FS) = c3; }
}
#define CV_T(k) (64 * (4 * (2 * wid + ((k) >> 3)) + (l31 >> 3)) + 32 * (((k) >> 2) & 1) + 8 * ((k) & 3) + 4 * hi)
#define CV_LANE_IDS() int tid = TID(); asm volatile("" : "+v"(tid));   \
    const int lane = tid & 63, wid = __builtin_amdgcn_readfirstlane(tid >> 6), l31 = lane & 31, hi = lane >> 5, eb = l31 & 7; (void)eb; (void)hi; (void)wid
DEV void conv_stage_load(char* lds, const Params& p, int c) {
    CV_LANE_IDS();
    const bf16_t* PT = (const bf16_t*)(p.ws + WS_PT); const bf16_t* GR = (const bf16_t*)(p.ws + WS_GR);
    FiltRegs f0; filt_load(f0, GR + (size_t)c * 8192, tid);
    Raw3 ru[16];
#pragma unroll
    for (int k = 0; k < 16; ++k) { const int i = tid + k * 512, b = i >> 10, t = (i & 1023) * 4; ru[k] = ld_raw3(PT + ((size_t)(b * 4096 + c)) * 4096, t); }
    for (int i = tid; i < 8 * 98; i += 512) { const int b = i / 98, j = i % 98;
        const int e = (j < 48) ? j * 4 : (CV_PADL + SEQ + (j - 48) * 4); *(u32x2*)(lds + b * CV_RS + e * 2) = (u32x2){0u, 0u}; }
    const float w0 = p.conv_w[c], w1 = p.conv_w[3072 + c], w2 = p.conv_w[6144 + c], bias = p.conv_b[c];
#pragma unroll
    for (int k = 0; k < 16; ++k) { const int i = tid + k * 512, b = i >> 10, t = (i & 1023) * 4; float u[4]; sconv_raw(ru[k], w0, w1, w2, bias, u);
        u32x2 w; w.x = pk2(u[0], u[1]); w.y = pk2(u[2], u[3]); *(u32x2*)(lds + b * CV_RS + (CV_PADL + t) * 2) = w; }
    filt_store(lds, f0, tid);
}
DEV void conv_stage_epi0(char* lds, const Params& p, int c, const f32x16 (&acc)[2][2]) {
    CV_LANE_IDS();
    const bf16_t* PT = (const bf16_t*)(p.ws + WS_PT); const bf16_t* GR = (const bf16_t*)(p.ws + WS_GR); const float* ssum = (const float*)(p.ws + WS_SSUM);
    FiltRegs f1; filt_load(f1, GR + (size_t)(1024 + c) * 8192, tid);
    const bf16_t* px1 = PT + ((size_t)(eb * 4096 + 1024 + c)) * 4096;
    Raw3 r1[16];
#pragma unroll
    for (int k = 0; k < 16; ++k) r1[k] = ld_raw3(px1, CV_T(k));
    const float a0 = p.conv_w[1024 + c], a1 = p.conv_w[3072 + 1024 + c], a2 = p.conv_w[6144 + 1024 + c], ab = p.conv_b[1024 + c];
    const float invs = 1.0f / ssum[c], sk = p.skip[c];
#pragma unroll
    for (int k = 0; k < 16; ++k) { const int n = k >> 3, mt = (k >> 2) & 1, g = k & 3; const int t = CV_T(k);
        float x1[4]; sconv_raw(r1[k], a0, a1, a2, ab, x1);
        char* up = lds + eb * CV_RS + (CV_PADL + t) * 2; const u32x2 vw = *(const u32x2*)up;
        const float z0 = x1[0] * (acc[n][mt][4 * g] * invs + sk * lo_bf(vw.x)), z1 = x1[1] * (acc[n][mt][4 * g + 1] * invs + sk * hi_bf(vw.x));
        const float z2 = x1[2] * (acc[n][mt][4 * g + 2] * invs + sk * lo_bf(vw.y)), z3 = x1[3] * (acc[n][mt][4 * g + 3] * invs + sk * hi_bf(vw.y));
        u32x2 w; w.x = pk2(z0, z1); w.y = pk2(z2, z3); *(u32x2*)up = w; }
    filt_store(lds, f1, tid);
}
DEV void conv_stage_epi1(char* lds, const Params& p, int c, const f32x16 (&acc)[2][2]) {
    CV_LANE_IDS();
    const bf16_t* PT = (const bf16_t*)(p.ws + WS_PT); const float* ssum = (const float*)(p.ws + WS_SSUM); bf16_t* OG2 = (bf16_t*)(p.ws + WS_OG2);
    const bf16_t* px2 = PT + ((size_t)(eb * 4096 + 2048 + c)) * 4096; const bf16_t* pg = PT + ((size_t)(eb * 4096 + 3072 + c)) * 4096;
    Raw3 r2[16]; u32x2 rg[16];
#pragma unroll
    for (int k = 0; k < 16; ++k) { r2[k] = ld_raw3(px2, CV_T(k)); rg[k] = *(const u32x2*)(pg + CV_T(k)); }
    const float b0 = p.conv_w[2048 + c], b1 = p.conv_w[3072 + 2048 + c], b2 = p.conv_w[6144 + 2048 + c], bb = p.conv_b[2048 + c];
    const float invs = 1.0f / ssum[1024 + c], sk = p.skip[1024 + c];
#pragma unroll
    for (int k = 0; k < 16; ++k) { const int n = k >> 3, mt = (k >> 2) & 1, g = k & 3; const int t = CV_T(k);
        float x2[4]; sconv_raw(r2[k], b0, b1, b2, bb, x2);
        const u32x2 zw = *(const u32x2*)(lds + eb * CV_RS + (CV_PADL + t) * 2);
        const float y0 = x2[0] * silu(lo_bf(rg[k].x)) * (acc[n][mt][4 * g] * invs + sk * lo_bf(zw.x)), y1 = x2[1] * silu(hi_bf(rg[k].x)) * (acc[n][mt][4 * g + 1] * invs + sk * hi_bf(zw.x));
        const float y2 = x2[2] * silu(lo_bf(rg[k].y)) * (acc[n][mt][4 * g + 2] * invs + sk * lo_bf(zw.y)), y3 = x2[3] * silu(hi_bf(rg[k].y)) * (acc[n][mt][4 * g + 3] * invs + sk * hi_bf(zw.y));
        u32x2 w; w.x = pk2(y0, y1); w.y = pk2(y2, y3); *(u32x2*)(OG2 + ((size_t)(eb * 1024 + c)) * 4096 + t) = w; }
}
DEV void conv_stage_mfma(const char* lds, f32x16 (&acc)[2][2]) { CV_LANE_IDS(); conv_mfma_loop(lds, acc, wid, lane); }
DEV void conv_unit2(char* lds, const Params& p, int c) {
    conv_stage_load(lds, p, c);
    __syncthreads();
    f32x16 acc[2][2];
    conv_stage_mfma(lds, acc);
    __syncthreads();
    conv_stage_epi0(lds, p, c, acc);
    __syncthreads();
    conv_stage_mfma(lds, acc);
    conv_stage_epi1(lds, p, c, acc);
    __syncthreads();
}
#undef CV_T
#undef CV_LANE_IDS

struct cf { float x, y; };
DEV float s_add(float a, float b) { float r; asm("v_add_f32_e32 %0, %1, %2" : "=v"(r) : "v"(a), "v"(b)); return r; }
DEV float s_sub(float a, float b) { float r; asm("v_sub_f32_e32 %0, %1, %2" : "=v"(r) : "v"(a), "v"(b)); return r; }
DEV float s_mul(float a, float b) { float r; asm("v_mul_f32_e32 %0, %1, %2" : "=v"(r) : "v"(a), "v"(b)); return r; }
DEV float s_fma(float a, float b, float c) { float r; asm("v_fma_f32 %0, %1, %2, %3" : "=v"(r) : "v"(a), "v"(b), "v"(c)); return r; }
DEV float s_fnma(float a, float b, float c) { float r; asm("v_fma_f32 %0, -%1, %2, %3" : "=v"(r) : "v"(a), "v"(b), "v"(c)); return r; }
DEV cf cadd(cf a, cf b) { return cf{s_add(a.x, b.x), s_add(a.y, b.y)}; }
DEV cf csub(cf a, cf b) { return cf{s_sub(a.x, b.x), s_sub(a.y, b.y)}; }
DEV cf cmul(cf a, cf b) { cf r;
    asm("v_mul_f32_e32 %0, %2, %4\n\tv_mul_f32_e32 %1, %2, %5\n\tv_fma_f32 %0, -%3, %5, %0\n\tv_fma_f32 %1, %3, %4, %1" : "=&v"(r.x), "=&v"(r.y) : "v"(a.x), "v"(a.y), "v"(b.x), "v"(b.y)); return r; }
template <int M> DEV cf mulw16(cf a) {
    if constexpr (M == 0) return a;
    else if constexpr (M == 4) return cf{a.y, -a.x};
    else if constexpr (M == 2) return cf{s_mul(s_add(a.x, a.y), 0.70710678118654752f), s_mul(s_sub(a.y, a.x), 0.70710678118654752f)};
    else if constexpr (M == 6) return cf{s_mul(s_sub(a.y, a.x), 0.70710678118654752f), s_mul(s_add(a.x, a.y), -0.70710678118654752f)};
    else { constexpr float c = (M == 1) ? 0.92387953251128674f : (M == 3) ? 0.38268343236508977f : (M == 5) ? -0.38268343236508977f : -0.92387953251128674f;
           constexpr float sn = (M == 1) ? -0.38268343236508977f : (M == 3) ? -0.92387953251128674f : (M == 5) ? -0.92387953251128674f : -0.38268343236508977f;
           return cf{s_fnma(a.y, sn, s_mul(a.x, c)), s_fma(a.y, c, s_mul(a.x, sn))}; }
}
DEV void bfly4(cf a, cf b, cf& s_, cf& d_) {
    asm("v_add_f32_e32 %0, %4, %6\n\tv_add_f32_e32 %1, %5, %7\n\tv_sub_f32_e32 %2, %4, %6\n\tv_sub_f32_e32 %3, %5, %7" : "=&v"(s_.x), "=&v"(s_.y), "=&v"(d_.x), "=&v"(d_.y) : "v"(a.x), "v"(a.y), "v"(b.x), "v"(b.y)); }
template <int HALF, int BLK, int J> DEV void dif_bfly(cf (&v)[16]) { const cf a = v[BLK + J], b = v[BLK + J + HALF]; cf sm, df; bfly4(a, b, sm, df); v[BLK + J] = sm; v[BLK + J + HALF] = mulw16<J * (8 / HALF)>(df); }
DEV void dft16(cf (&v)[16]) {
#define B8(j) dif_bfly<8, 0, j>(v)
    B8(0); B8(1); B8(2); B8(3); B8(4); B8(5); B8(6); B8(7);
#undef B8
#define B4(b, j) dif_bfly<4, b, j>(v)
    B4(0, 0); B4(0, 1); B4(0, 2); B4(0, 3); B4(8, 0); B4(8, 1); B4(8, 2); B4(8, 3);
#undef B4
#define B2(b, j) dif_bfly<2, b, j>(v)
    B2(0, 0); B2(0, 1); B2(4, 0); B2(4, 1); B2(8, 0); B2(8, 1); B2(12, 0); B2(12, 1);
#undef B2
#define B1(b) dif_bfly<1, b, 0>(v)
    B1(0); B1(2); B1(4); B1(6); B1(8); B1(10); B1(12); B1(14);
#undef B1
}
#define FFT_BR4(k) ((((k) & 1) << 3) | (((k) & 2) << 1) | (((k) & 4) >> 1) | (((k) & 8) >> 3))
constexpr int FF_BUF = (8192 + 512) * 8;
DEV int ffp(int idx) { return (idx + (idx >> 4)) * 8; }
struct FftTw { cf t3[16]; };
constexpr int FF_T2 = 2 * FF_BUF;
DEV void fft_twiddles(FftTw& T, char* lds, int tid) {
    if (tid < 240) { const int k = tid / 15, r = tid % 15 + 1; float sn, cs; sincospif(-(float)(k * r) * (1.0f / 128.0f), &sn, &cs); *(cf*)(lds + FF_T2 + tid * 8) = cf{cs, sn}; }
    __syncthreads();
    { const int i3 = tid & 255, h = tid >> 8; float sn, cs; sincospif(-(float)i3 * (1.0f / 4096.0f), &sn, &cs); asm volatile("s_nop 1" : "+v"(sn), "+v"(cs));
        const cf w1 = cf{cs, sn}; const cf w2 = cmul(w1, w1);
        cf t = h ? w1 : cf{1.f, 0.f};
#pragma unroll
        for (int sx = 0; sx < 16; ++sx) { T.t3[sx] = t; t = cmul(t, w2); } }
}
DEV void fft_pass23(char* A, char* B, const char* tw2, int tid, const FftTw& T) {
    asm volatile("" : "+v"(tid));
    cf v[16];
    {
        const int i = tid, k = i & 15;
        { const char* rb = A + ffp(i);
#pragma unroll
        for (int r = 0; r < 16; ++r) v[r] = *(const cf*)(rb + 4352 * r); }
#pragma unroll
        for (int r = 1; r < 16; ++r) v[r] = cmul(v[r], *(const cf*)(tw2 + k * 120 + (r - 1) * 8));
        dft16(v);
        const int j = ((i >> 4) << 8) + k;
        { char* wb = B + (j + 16 * (i >> 4)) * 8;
#pragma unroll
        for (int r = 0; r < 16; ++r) *(cf*)(wb + 136 * r) = v[FFT_BR4(r)]; }
        __syncthreads();
    }
    {
        const int i3 = tid & 255, h = tid >> 8;
        const char* rb3 = B + ffp(i3) + 2176 * h;
#pragma unroll
        for (int sx = 0; sx < 16; ++sx) v[sx] = *(const cf*)(rb3 + 4352 * sx);
#pragma unroll
        for (int sx = 0; sx < 16; ++sx) v[sx] = cmul(v[sx], T.t3[sx]);
        dft16(v);
        if (h) {
            const float c32[16] = {1.f, 0.98078528040323043f, 0.92387953251128674f, 0.83146961230254524f, 0.70710678118654752f, 0.55557023301960218f, 0.38268343236508977f, 0.19509032201612825f,
                                   0.f, -0.19509032201612825f, -0.38268343236508977f, -0.55557023301960218f, -0.70710678118654752f, -0.83146961230254524f, -0.92387953251128674f, -0.98078528040323043f};
            const float s32[16] = {0.f, -0.19509032201612825f, -0.38268343236508977f, -0.55557023301960218f, -0.70710678118654752f, -0.83146961230254524f, -0.92387953251128674f, -0.98078528040323043f,
                                   -1.f, -0.98078528040323043f, -0.92387953251128674f, -0.83146961230254524f, -0.70710678118654752f, -0.55557023301960218f, -0.38268343236508977f, -0.19509032201612825f};
#pragma unroll
            for (int m = 0; m < 16; ++m) v[FFT_BR4(m)] = cmul(v[FFT_BR4(m)], cf{c32[m], s32[m]});
        }
        { char* wb3 = A + ffp(i3) + 34816 * h;
#pragma unroll
        for (int m = 0; m < 16; ++m) *(cf*)(wb3 + 2176 * m) = v[FFT_BR4(m)]; }
        __syncthreads();
    }
}
DEV void fft_pass1_store(char* D, cf (&v)[16], int tid) {
    dft16(v);
    { char* wb = D + 136 * tid;
#pragma unroll
    for (int r = 0; r < 16; ++r) *(cf*)(wb + 8 * r) = v[FFT_BR4(r)]; }
    __syncthreads();
}
constexpr size_t WS_CVIN = WS_H1;
DEV void fftconv_unit(char* lds, const Params& p, int c, const FftTw& T) {
    int tid = TID(); asm volatile("" : "+v"(tid));
    char* D0 = lds; char* D1 = lds + FF_BUF;
    const bf16_t* PT = (const bf16_t*)(p.ws + WS_PT); const bf16_t* GR = (const bf16_t*)(p.ws + WS_GR); const float* ssum = (const float*)(p.ws + WS_SSUM);
    bf16_t* OG2 = (bf16_t*)(p.ws + WS_OG2); float* IN = (float*)(p.ws + WS_CVIN) + (size_t)blockIdx.x * (8 * 4096);
    { const float w0 = p.conv_w[c], w1 = p.conv_w[3072 + c], w2 = p.conv_w[6144 + c], bias = p.conv_b[c];
#pragma unroll 2
        for (int k = 0; k < 8; ++k) { const int i = tid + k * 512, b = i >> 9, n0 = (i & 511) * 8;
            const bf16_t* px = PT + ((size_t)(b * 4096 + c)) * 4096;
            float q[10]; { const u32x4 m = *(const u32x4*)(px + n0); unpack8(m, q + 1); q[0] = (n0 > 0) ? bf2f(px[n0 - 1]) : 0.f; q[9] = (n0 + 8 < SEQ) ? bf2f(px[n0 + 8]) : 0.f; }
            f32x4 o0, o1;
#pragma unroll
            for (int e = 0; e < 4; ++e) { o0[e] = w0 * q[e] + w1 * q[e + 1] + w2 * q[e + 2] + bias; o1[e] = w0 * q[e + 4] + w1 * q[e + 5] + w2 * q[e + 6] + bias; }
            *(f32x4*)(IN + b * 4096 + n0) = o0; *(f32x4*)(IN + b * 4096 + n0 + 4) = o1; } }
    __syncthreads();
#pragma unroll 1
    for (int o = 0; o < 2; ++o) {
        cf KS[16];
        asm volatile("" : "+v"(tid));
        { const bf16_t* g = GR + (size_t)(o * 1024 + c) * 8192; const float invs = 1.0f / ssum[o * 1024 + c];
            cf v[16];
#pragma unroll
            for (int r = 0; r < 16; ++r) { const int n = tid + 512 * r; v[r] = cf{bf2f(g[(12288 - n) & 8191]) * invs, 0.f}; }
            fft_pass1_store(D0, v, tid);
            fft_pass23(D0, D1, lds + FF_T2, tid, T);
#pragma unroll
            for (int q = 0; q < 8; ++q) { const cf a = *(const cf*)(D0 + ffp(tid) + 4352 * q), b = *(const cf*)(D0 + ffp(tid) + 4352 * q + 34816); KS[q] = cadd(a, b); KS[q + 8] = csub(a, b); }
            __syncthreads(); }
        const float sk = p.skip[o * 1024 + c];
        const int part = (o == 0) ? 1024 : 2048;
        const float w0 = p.conv_w[part + c], w1 = p.conv_w[3072 + part + c], w2 = p.conv_w[6144 + part + c], bias = p.conv_b[part + c];
        cf vin[8];
#pragma unroll
        for (int r = 0; r < 8; ++r) vin[r] = cf{IN[tid + 512 * r], IN[4096 + tid + 512 * r]};
#pragma unroll 1
        for (int pr = 0; pr < 4; ++pr) {
            asm volatile("" : "+v"(tid));
            const int n0 = 8 * tid;
            u32x4 eraw[2], egate[2]; f32x4 eu[2][2]; unsigned ehalo[2];
#pragma unroll
            for (int hb = 0; hb < 2; ++hb) { const int b = 2 * pr + hb; const bf16_t* px = PT + ((size_t)(b * 4096 + part + c)) * 4096;
                eraw[hb] = *(const u32x4*)(px + n0);
                const unsigned ha = px[n0 - 1], hz = px[n0 + 8];
                ehalo[hb] = ((n0 > 0) ? ha : 0u) | (((n0 + 8 < SEQ) ? hz : 0u) << 16);
                eu[hb][0] = *(const f32x4*)(IN + b * 4096 + n0); eu[hb][1] = *(const f32x4*)(IN + b * 4096 + n0 + 4);
                egate[hb] = (o == 1) ? *(const u32x4*)(PT + ((size_t)(b * 4096 + 3072 + c)) * 4096 + n0) : (u32x4){0u, 0u, 0u, 0u}; }
            {
                cf v[16];
#pragma unroll
                for (int r = 0; r < 8; ++r) v[r] = vin[r];
#pragma unroll
                for (int r = 8; r < 16; ++r) v[r] = cf{0.f, 0.f};
                fft_pass1_store(D0, v, tid);
                fft_pass23(D0, D1, lds + FF_T2, tid, T);
            }
            {
                const int pn = (pr < 3) ? pr + 1 : pr; const float* ina = IN + (2 * pn) * 4096;
#pragma unroll
                for (int r = 0; r < 8; ++r) vin[r] = cf{ina[tid + 512 * r], ina[4096 + tid + 512 * r]};
            }
            {
                cf v[16];
#pragma unroll
                for (int q = 0; q < 8; ++q) { const cf a = *(const cf*)(D0 + ffp(tid) + 4352 * q), b = *(const cf*)(D0 + ffp(tid) + 4352 * q + 34816);
                    const cf x0 = cmul(cadd(a, b), KS[q]), x1 = cmul(csub(a, b), KS[q + 8]);
                    v[q] = cf{x0.x, -x0.y}; v[q + 8] = cf{x1.x, -x1.y}; }
                fft_pass1_store(D1, v, tid);
                fft_pass23(D1, D0, lds + FF_T2, tid, T);
            }
            {
                float ya[8], yb[8];
#pragma unroll
                for (int e = 0; e < 8; ++e) { const cf a = *(const cf*)(D1 + 64 * tid + 8 * (tid >> 1) + 8 * e), b = *(const cf*)(D1 + 64 * tid + 8 * (tid >> 1) + 8 * e + 34816); ya[e] = (a.x + b.x) * (1.0f / 8192.0f); yb[e] = -(a.y + b.y) * (1.0f / 8192.0f); }
#pragma unroll
                for (int hb = 0; hb < 2; ++hb) { const int b = 2 * pr + hb; float* inp = IN + b * 4096 + n0; const float* yy = hb ? yb : ya;
                    float q[10]; unpack8(eraw[hb], q + 1); q[0] = lo_bf(ehalo[hb]); q[9] = hi_bf(ehalo[hb]);
                    const f32x4 u0 = eu[hb][0], u1 = eu[hb][1]; const float uu[8] = {u0.x, u0.y, u0.z, u0.w, u1.x, u1.y, u1.z, u1.w};
                    float z[8];
#pragma unroll
                    for (int e = 0; e < 8; ++e) { const float xc = w0 * q[e] + w1 * q[e + 1] + w2 * q[e + 2] + bias; z[e] = xc * (yy[e] + sk * uu[e]); }
                    if (o == 0) { *(f32x4*)inp = (f32x4){z[0], z[1], z[2], z[3]}; *(f32x4*)(inp + 4) = (f32x4){z[4], z[5], z[6], z[7]}; }
                    else { float gg[8]; unpack8(egate[hb], gg);
#pragma unroll
                        for (int e = 0; e < 8; ++e) z[e] *= silu(gg[e]);
                        *(u32x4*)(OG2 + ((size_t)(b * 1024 + c)) * 4096 + n0) = pack8(z); } }
            }
        }
        __syncthreads();
    }
}

#define XB_TMO      128
#define XB_XCNT(j)  (256  + 64 * (j))
#define XB_XSUB(j)  (1280 + 64 * (j))
#define XB_XGEN(j)  (2304 + 64 * (j))
#define XB_TOP      3328
#define XB_TOPGEN   3392
#define XCD_BAR_WORDS 3456
#define XB_SPIN_CAP (1u << 20)
DEV unsigned xb_ld(unsigned* p) { return __hip_atomic_load(p, __ATOMIC_RELAXED, __HIP_MEMORY_SCOPE_AGENT); }
DEV unsigned xb_add(unsigned* p, unsigned v) { return __hip_atomic_fetch_add(p, v, __ATOMIC_RELAXED, __HIP_MEMORY_SCOPE_AGENT); }
DEV unsigned xb_xcc_id() { return (unsigned)__builtin_amdgcn_s_getreg((3 << 11) | 20) & 0xFu; }
#define XB_SPIN(cond, bar) do { unsigned _sp = 0; while (cond) { __builtin_amdgcn_s_sleep(1); \
    if ((++_sp & 255u) == 0u) { if (xb_ld(&(bar)[XB_TMO])) break; if (_sp > XB_SPIN_CAP) { atomicAdd(&(bar)[XB_TMO], 1u); break; } } } } while (0)
struct XcdBarrier { unsigned* bar; unsigned x; volatile LAS unsigned* st; };
DEV XcdBarrier xcd_barrier_post(unsigned* bar, volatile LAS unsigned* st) {
    XcdBarrier b; b.bar = bar; b.x = xb_xcc_id(); b.st = st;
    if (TID() == 0) (void)xb_add(&bar[XB_XCNT(b.x)], 1u);
    return b;
}
DEV void xcd_barrier_complete(unsigned* bar, unsigned x, unsigned& nloc, unsigned& nx) {
    const unsigned G = gridDim.x * gridDim.y * gridDim.z;
    unsigned sum, cnt, mine, sp = 0u;
    for (;;) {
        sum = 0u; cnt = 0u; mine = 0u;
#pragma unroll
        for (unsigned j = 0; j < 16; ++j) { const unsigned c = xb_ld(&bar[XB_XCNT(j)]); sum += c; cnt += (c > 0u) ? 1u : 0u; mine = (j == x) ? c : mine; }
        if (sum == G) break;
        __builtin_amdgcn_s_sleep(1);
        if ((++sp & 255u) == 0u) { if (xb_ld(&bar[XB_TMO])) break; if (sp > XB_SPIN_CAP) { atomicAdd(&bar[XB_TMO], 1u); break; } }
    }
    nloc = mine > 0u ? mine : 1u; nx = cnt > 0u ? cnt : 1u;
}
DEV void xcd_barrier(const XcdBarrier& b) {
    asm volatile("s_waitcnt vmcnt(0)" ::: "memory");
    __syncthreads();
    if (TID() == 0) {
        unsigned* bar = b.bar;
        __builtin_amdgcn_s_waitcnt(0);
        unsigned nloc = b.st[0], nx = b.st[1];
        if (nloc == 0u) { xcd_barrier_complete(bar, b.x, nloc, nx); b.st[0] = nloc; b.st[1] = nx; }
        const unsigned old = xb_add(&bar[XB_XSUB(b.x)], 1u);
        const unsigned gen = old / nloc;
        if (old + 1u == (gen + 1u) * nloc) {
            __builtin_amdgcn_fence(__ATOMIC_RELEASE, "agent");
            asm volatile("s_waitcnt vmcnt(0)" ::: "memory");
            const unsigned og = xb_add(&bar[XB_TOP], 1u);
            const unsigned tg = og / nx;
            if (og + 1u == (tg + 1u) * nx) xb_add(&bar[XB_TOPGEN], 1u);
            else XB_SPIN(xb_ld(&bar[XB_TOPGEN]) == tg, bar);
            __builtin_amdgcn_fence(__ATOMIC_ACQUIRE, "agent");
            xb_add(&bar[XB_XGEN(b.x)], 1u);
            asm volatile("s_waitcnt vmcnt(0)" ::: "memory");
        } else {
            XB_SPIN(xb_ld(&bar[XB_XGEN(b.x)]) == gen, bar);
            __builtin_amdgcn_fence(__ATOMIC_ACQUIRE, "agent");
            asm volatile("s_waitcnt vmcnt(0)" ::: "memory");
        }
    }
    __syncthreads();
}

constexpr int NPHASE = 12;
__global__ void __launch_bounds__(512) fwd_kernel(Params p) {
    char* lds = lds_dyn;
    char* ws = p.ws;
    volatile LAS unsigned* bst = (volatile LAS unsigned*)(LAS char*)(lds + LDS_BYTES - 64);
    { const int t0 = threadIdx.x;
        if (t0 < 16) bst[t0] = 0u;
        if ((t0 & 63) == 0) *(volatile LAS int*)(LAS char*)(lds + LDS_WTAB + 4 * hw_slot()) = t0 >> 6; }
    __syncthreads();
    if (MK_LAUNCHES == 1) (void)xcd_barrier_post((unsigned*)(ws + WS_CTL), bst);
    if (MK_LAUNCHES == 1 && p.ph_hi > NPHASE) cg::this_grid().sync();
#define SEAM(k) do { if (MK_LAUNCHES == 1 && (k) + 1 < p.ph_hi) { XcdBarrier xb_; xb_.bar = (unsigned*)(p.ws + WS_CTL); xb_.x = xb_xcc_id(); xb_.st = (volatile LAS unsigned*)(LAS char*)(lds + LDS_BYTES - 64); xcd_barrier(xb_); } } while (0)
#ifndef PHASE_MASK
#define PHASE_MASK 0xFFF
#endif
#define IN(k) (((PHASE_MASK >> (k)) & 1) && p.ph_lo <= (k) && (k) < p.ph_hi)
#define REP(k) for (int rep_ = 0; rep_ < ((PROBE_REPEAT == (k)) ? 2 : 1); ++rep_)
    if (IN(0)) { REP(0) phase_prep(lds, p); SEAM(0); }
    if (IN(1)) {
        for (int rep_ = 0; rep_ < ((PROBE_REPEAT == 21) ? 2 : 1); ++rep_) {
        const bool dummy = (PROBE_REPEAT == 21 && rep_ == 0);
        EpiFilt ef{(bf16_t*)(ws + (dummy ? WS_PRAW : WS_GR)), p.f_b3};
        gemm_phase<false, EpiFilt>(lds, (const bf16_t*)(ws + WS_W3), 64, (const bf16_t*)(ws + WS_HID2), 64, 4096, 4096, 64, ef); }
        REP(1) phase_norm0(p); SEAM(1); }
    if (IN(2)) {
        REP(2) { pg8::Gemm g{(const bf16_t*)(ws + WS_H0), (const bf16_t*)(ws + WS_WIN), NALL, AINP, DM}; pg8::StaticOrder S; S.init(NALL, AINP, (int)gridDim.x, (int)blockIdx.x);
            pg8::EpiBf16 E{(bf16_t*)(ws + WS_PRAW), (size_t)AINP, 0, 0};
            pg8::gemm_phase<pg8::EpiBf16, pg8::StaticOrder, true, true>((PG8_LAS unsigned char*)lds, g, S, E); }
        SEAM(2); }
    if (IN(3)) { filt_sums(p); REP(3) phase_post(p); SEAM(3); }
    if (IN(4)) {
        const float* rp = (const float*)(ws + WS_ROPE);
        REP(4) {
        { pg8::Gemm g{(const bf16_t*)(ws + WS_CQN), (const bf16_t*)(ws + WS_WUQ), NTOK, 768, 256}; pg8::StaticOrder S; S.init(NTOK, 768, (int)gridDim.x, (int)blockIdx.x);
            pg8::EpiUqPg E{(bf16_t*)(ws + WS_QM), rp + 2048, rp + 2560, QSC_M};
            pg8::gemm_phase<pg8::EpiUqPg, pg8::StaticOrder, true, true>((PG8_LAS unsigned char*)lds, g, S, E); }
        int opq_ = 0; asm volatile("" : "+s"(opq_));
        if (opq_ == 0) { pg8::Gemm g{(const bf16_t*)(ws + WS_CKVN), (const bf16_t*)(ws + WS_WUKV), NALL, 1024, 128}; pg8::StaticOrder S; S.init(NALL, 1024, (int)gridDim.x, (int)blockIdx.x);
            pg8::EpiUkvPg E{(bf16_t*)(ws + WS2_KM), (bf16_t*)(ws + WS2_VM)};
            pg8::gemm_phase<pg8::EpiUkvPg, pg8::StaticOrder, true, true>((PG8_LAS unsigned char*)lds, g, S, E); } }
        SEAM(4); }
    if (IN(5)) { REP(5) phase_attn(lds, p); SEAM(5); }
    if (IN(6)) {
        REP(6) { pg8::Gemm g{(const bf16_t*)(ws + WS2_OG), (const bf16_t*)(ws + WS_WOUT), NTOK, DM, DM}; pg8::StaticOrder S; S.init(NTOK, DM, (int)gridDim.x, (int)blockIdx.x);
            pg8::EpiResF32 E{p.x, p.out, (const float*)(ws + WS_MOD0), (DBG_SKIP & 1) ? 0.f : 1.f};
            pg8::gemm_phase<pg8::EpiResF32, pg8::StaticOrder, true, true>((PG8_LAS unsigned char*)lds, g, S, E); }
        SEAM(6); }
    if (IN(7)) { REP(7) phase_norm1(p); SEAM(7); }
    if (IN(8)) {
        REP(8) { pg8::Gemm g{(const bf16_t*)(ws + WS_HWIN), (const bf16_t*)(ws + WS_H1), 4096, NTOK, DM}; pg8::StaticOrder S; S.init(4096, NTOK, (int)gridDim.x, (int)blockIdx.x);
            pg8::EpiBf16 E{(bf16_t*)(ws + WS_PT), (size_t)4096, 4096, (size_t)4096 * 4096};
            pg8::gemm_phase<pg8::EpiBf16, pg8::StaticOrder, true, true>((PG8_LAS unsigned char*)lds, g, S, E); }
        SEAM(8); }
    if (IN(9)) { FftTw T; fft_twiddles(T, lds, TID()); REP(9) for (int c = blockIdx.x; c < 1024; c += gridDim.x) fftconv_unit(lds, p, c, T); SEAM(9); }
    if (IN(10)) {
        REP(10) {
        EpiRes e{p.out, (PROBE_REPEAT == 10 && rep_ == 0) ? (float*)(ws + WS_PT) : p.out, (const float*)(ws + WS_MOD1), (DBG_SKIP & 2) ? 0.f : 1.f};
        const bf16_t* OG2 = (const bf16_t*)(ws + WS_OG2); const bf16_t* W = (const bf16_t*)(ws + WS_HWOUT);
        const int nt = (NTOK / 256) * (DM / 256);
        for (int t = blockIdx.x; t < nt; t += gridDim.x) { const int ti = t / 4, tj = t % 4; const int b = ti >> 4, l0 = (ti & 15) * 256;
            gemm_tile256_tr<EpiRes>(lds, OG2 + (size_t)b * 1024 * 4096 + l0, 4096, W + (size_t)tj * 256 * DM, DM, DM, e, ti * 256, tj * 256); }
        }
        SEAM(10); }
    if (IN(11)) { phase_final(p); }
#undef SEAM
#undef IN
}

extern "C" void kernel_launch(void* const* d_in, const int* in_sizes, int n_in, void* d_out, int out_size, void* d_ws, size_t ws_size, hipStream_t stream) {
    static int grid = 0;
    if (grid == 0) {
        if (n_in != 28 || out_size != NTOK * DM || ws_size < WS_END) { fprintf(stderr, "kernel_launch: unexpected shapes n_in %d out %d ws %zu\n", n_in, out_size, ws_size); grid = -1; return; }
        int dev = 0, cus = 0, per_cu = 0;
        hipGetDevice(&dev); hipDeviceGetAttribute(&cus, hipDeviceAttributeMultiprocessorCount, dev);
        if (hipFuncSetAttribute((const void*)fwd_kernel, hipFuncAttributeMaxDynamicSharedMemorySize, LDS_BYTES) != hipSuccess) { fprintf(stderr, "hipFuncSetAttribute failed\n"); grid = -1; return; }
        hipOccupancyMaxActiveBlocksPerMultiprocessor(&per_cu, (const void*)fwd_kernel, 512, LDS_BYTES);
        if (per_cu < 1) { fprintf(stderr, "occupancy query says %d\n", per_cu); per_cu = 1; }
        grid = cus * 1;
        (void)hipGetLastError();
    }
    if (grid < 0) return;
    Params p{};
    const float** pp = (const float**)&p;
    for (int i = 0; i < 28; ++i) pp[i] = (const float*)d_in[i];
    p.out = (float*)d_out; p.ws = (char*)d_ws;
#if MK_LAUNCHES == 1
    if (hipMemsetAsync((char*)d_ws + WS_CTL, 0, CTL_BYTES, stream) != hipSuccess) { fprintf(stderr, "memset failed\n"); return; }
    p.ph_lo = 0; p.ph_hi = NPHASE;
    void* args[] = {&p};
    hipError_t e = hipLaunchCooperativeKernel((const void*)fwd_kernel, dim3(grid), dim3(512), args, LDS_BYTES, stream);
    if (e != hipSuccess) fprintf(stderr, "cooperative launch failed: %s (grid %d)\n", hipGetErrorString(e), grid);
#else
    for (int k = 0; k < NPHASE; ++k) { p.ph_lo = k; p.ph_hi = k + 1; hipLaunchKernelGGL(fwd_kernel, dim3(grid), dim3(512), LDS_BYTES, stream, p); }
#endif
}
```

```cpp
#include <hip/hip_runtime.h>
#include <hip/hip_cooperative_groups.h>
#include <cstdio>
#include <cstdint>
namespace cg = cooperative_groups;

#ifndef MK_LAUNCHES
#define MK_LAUNCHES 1
#endif

#ifndef PROBE_REPEAT
#define PROBE_REPEAT -1
#endif
#ifndef DBG_SKIP
#define DBG_SKIP 0
#endif
#define DEV __device__ __forceinline__
typedef unsigned short bf16_t;
typedef short bf16x8 __attribute__((ext_vector_type(8)));
typedef short s16x4 __attribute__((ext_vector_type(4)));
typedef float f32x16 __attribute__((ext_vector_type(16)));
typedef float f32x4 __attribute__((ext_vector_type(4)));
typedef float f32x2 __attribute__((ext_vector_type(2)));
typedef unsigned u32x4 __attribute__((ext_vector_type(4)));
typedef unsigned u32x2 __attribute__((ext_vector_type(2)));
typedef __bf16 bf16x2_t __attribute__((ext_vector_type(2)));
#define LAS __attribute__((address_space(3)))

constexpr int NB = 8, SEQ = 4096, DM = 1024, CTXL = 256, LK = SEQ + CTXL;
constexpr int NTOK = NB * SEQ, NCTX = NB * CTXL, NALL = NTOK + NCTX;
constexpr int AIN = 2208, AINP = 2304;
constexpr float EPS = 1e-6f;
constexpr float LOG2E = 1.4426950408889634f;
constexpr float QSC_A = 0.125f * LOG2E;
constexpr float QSC_M = 0.10206207261596575f * LOG2E;

constexpr size_t MiB = 1ull << 20;
constexpr size_t WS_WIN = 0;
constexpr size_t WS_WUQ = 5 * MiB;
constexpr size_t WS_WUKV = 6 * MiB;
constexpr size_t WS_WOUT = 7 * MiB;
constexpr size_t WS_HWIN = 9 * MiB;
constexpr size_t WS_HWOUT = 17 * MiB;
constexpr size_t WS_W3 = 19 * MiB;
constexpr size_t WS_HID2 = 20 * MiB;
constexpr size_t WS_MOD0 = 21 * MiB;
constexpr size_t WS_MOD1 = WS_MOD0 + 9 * 3072 * 4;
constexpr size_t WS_SSUM = WS_MOD1 + 8 * 3072 * 4;
constexpr size_t WS_ROPE = WS_SSUM + 2048 * 4;
constexpr size_t WS_GR = 22 * MiB;
constexpr size_t WS_H0 = 64 * MiB;
constexpr size_t WS_PRAW = 136 * MiB;
constexpr size_t WS_QA = 297 * MiB;
constexpr size_t WS_KA = 329 * MiB;
constexpr size_t WS_VA = 338 * MiB;
constexpr size_t WS_CQN = 347 * MiB;
constexpr size_t WS_CKVN = 363 * MiB;
constexpr size_t WS_G = 372 * MiB;
constexpr size_t WS_QM = 64 * MiB;
constexpr size_t WS_KM = 136 * MiB;
constexpr size_t WS_VM = 190 * MiB;
constexpr size_t WS_OG = 226 * MiB;
constexpr size_t WS_H1 = 436 * MiB;
constexpr size_t WS_PT = 64 * MiB;
constexpr size_t WS_OG2 = 320 * MiB;
constexpr size_t WS_CTL = 500 * MiB;
constexpr size_t CTL_BYTES = 16384;
constexpr size_t WS_END = 500 * MiB + CTL_BYTES;
constexpr size_t WS2_KM = 436 * MiB;
constexpr size_t WS2_VM = 190 * MiB;
constexpr size_t WS2_OG = 226 * MiB;

constexpr int LDS_BYTES = 150 * 1024;

extern __shared__ __attribute__((aligned(16))) char lds_dyn[];
constexpr int LDS_WTAB = LDS_BYTES - 64 - 256;
__device__ __forceinline__ int lane_id() { int r; asm volatile("v_mbcnt_lo_u32_b32 %0, -1, 0\n\tv_mbcnt_hi_u32_b32 %0, -1, %0" : "=v"(r)); return r; }
__device__ __forceinline__ int hw_slot() { return (int)(__builtin_amdgcn_s_getreg((5 << 11) | 4) & 63u); }
__device__ __forceinline__ int wave_idx() { return __builtin_amdgcn_readfirstlane(*(volatile __attribute__((address_space(3))) int*)(__attribute__((address_space(3))) char*)(lds_dyn + LDS_WTAB + 4 * hw_slot())); }
#define TID() (wave_idx() * 64 + lane_id())

DEV float bf2f(bf16_t v) { return __uint_as_float(((unsigned)v) << 16); }
DEV unsigned pk2(float lo, float hi) { f32x2 v = {lo, hi}; bf16x2_t b = __builtin_convertvector(v, bf16x2_t); return __builtin_bit_cast(unsigned, b); }
DEV bf16_t f2bf(float f) { return (bf16_t)(pk2(f, 0.f) & 0xffffu); }
DEV float lo_bf(unsigned w) { return __uint_as_float(w << 16); }
DEV float hi_bf(unsigned w) { return __uint_as_float(w & 0xffff0000u); }
DEV int crow(int r, int hi) { return (r & 3) + 8 * (r >> 2) + 4 * hi; }
DEV float silu(float v) { return v * __builtin_amdgcn_rcpf(1.f + __expf(-v)); }
DEV void unpack8(const u32x4 w, float* v) { v[0] = lo_bf(w.x); v[1] = hi_bf(w.x); v[2] = lo_bf(w.y); v[3] = hi_bf(w.y); v[4] = lo_bf(w.z); v[5] = hi_bf(w.z); v[6] = lo_bf(w.w); v[7] = hi_bf(w.w); }
DEV u32x4 pack8(const float* v) { u32x4 w; w.x = pk2(v[0], v[1]); w.y = pk2(v[2], v[3]); w.z = pk2(v[4], v[5]); w.w = pk2(v[6], v[7]); return w; }

DEV float wave_sum(float v) {
#pragma unroll
    for (int o = 1; o < 64; o <<= 1) v += __shfl_xor(v, o);
    return v;
}
struct Params {
    const float *x, *c, *ctx, *c_ctx, *ada_w, *ada_b, *norm_w, *w_in, *q_norm, *k_norm, *cq_norm, *ckv_norm, *w_uq, *w_ukv, *w_out,
        *hy_w_in, *conv_w, *conv_b, *f_w1, *f_b1, *f_w2, *f_b2, *f_w3, *f_b3, *freq, *skip, *hy_w_out, *final_w;
    float* out; char* ws; int ph_lo, ph_hi;
};

constexpr int G_RS = 144;
constexpr int G_RB = 256 * G_RS, G_CB = 128 * G_RS, G_STAGE = G_RB + G_CB;
constexpr int T_RS = 576;

template <bool TR, class Epi>
DEV void gemm_tile(char* lds, const bf16_t* __restrict__ R, size_t ldr, const bf16_t* __restrict__ C, size_t ldc, int K, const Epi& epi, int ti0, int tj0) {
    const int tid = TID(), lane = tid & 63, wid = tid >> 6;
    const int wi = wid >> 1, wj = wid & 1, l31 = lane & 31, hi = lane >> 5;
    f32x16 acc[2][2];
#pragma unroll
    for (int a = 0; a < 2; ++a)
#pragma unroll
        for (int b = 0; b < 2; ++b)
#pragma unroll
            for (int r = 0; r < 16; ++r) acc[a][b][r] = 0.f;
    u32x4 rrX[4], rcX[2], rrY[4], rcY[2];
    const bf16_t* Rp; const bf16_t* Cp; int rl_off, cl_off;
    if (TR) { const int c = tid & 31, kr = tid >> 5; Rp = R + (size_t)kr * ldr + c * 8; rl_off = kr * T_RS + c * 16; }
    else { const int lr = tid >> 3, lc = tid & 7; Rp = R + (size_t)lr * ldr + lc * 8; rl_off = lr * G_RS + lc * 16; }
    { const int lr = tid >> 3, lc = tid & 7; Cp = C + (size_t)lr * ldc + lc * 8; cl_off = lr * G_RS + lc * 16; }
    const int nk = K / 64;
    int ra_off[2], cb_off[2];
#pragma unroll
    for (int t = 0; t < 2; ++t) {
        if (TR) { const int g1 = (lane >> 4) & 1, q = (lane & 15) >> 2, p = lane & 3; ra_off[t] = (8 * hi + q) * T_RS + (wi * 64 + t * 32 + 16 * g1 + 4 * p) * 2; }
        else ra_off[t] = (wi * 64 + t * 32 + l31) * G_RS + hi * 16;
        cb_off[t] = G_RB + (wj * 64 + t * 32 + l31) * G_RS + hi * 16;
    }
#define G_LOAD(kt, S) do { const int kk_ = (kt) < nk ? (kt) : nk - 1; \
        if (TR) { _Pragma("unroll") for (int p = 0; p < 4; ++p) rr##S[p] = *(const u32x4*)(Rp + ((size_t)kk_ * 64 + 16 * p) * ldr); } \
        else { _Pragma("unroll") for (int p = 0; p < 4; ++p) rr##S[p] = *(const u32x4*)(Rp + (size_t)(64 * p) * ldr + kk_ * 64); } \
        _Pragma("unroll") for (int p = 0; p < 2; ++p) rc##S[p] = *(const u32x4*)(Cp + (size_t)(64 * p) * ldc + kk_ * 64); } while (0)
#define G_STORE(buf, S) do { char* b_ = lds + (buf) * G_STAGE; \
        if (TR) { _Pragma("unroll") for (int p = 0; p < 4; ++p) *(u32x4*)(b_ + rl_off + 16 * p * T_RS) = rr##S[p]; } \
        else { _Pragma("unroll") for (int p = 0; p < 4; ++p) *(u32x4*)(b_ + rl_off + 64 * p * G_RS) = rr##S[p]; } \
        _Pragma("unroll") for (int p = 0; p < 2; ++p) *(u32x4*)(b_ + G_RB + cl_off + 64 * p * G_RS) = rc##S[p]; } while (0)
#define G_COMPUTE(buf) do { const char* b_ = lds + (buf) * G_STAGE; \
        _Pragma("unroll") for (int ks = 0; ks < 4; ++ks) { bf16x8 fa[2], fb[2]; \
            _Pragma("unroll") for (int t = 0; t < 2; ++t) { \
                if (TR) { \
                    const s16x4 lo = __builtin_bit_cast(s16x4, __builtin_amdgcn_ds_read_tr16_b64_v4i16((LAS s16x4*)(b_ + ra_off[t] + ks * 16 * T_RS))); \
                    const s16x4 hh = __builtin_bit_cast(s16x4, __builtin_amdgcn_ds_read_tr16_b64_v4i16((LAS s16x4*)(b_ + ra_off[t] + (ks * 16 + 4) * T_RS))); \
                    fa[t] = (bf16x8){lo[0], lo[1], lo[2], lo[3], hh[0], hh[1], hh[2], hh[3]}; \
                } else fa[t] = *(const bf16x8*)(b_ + ra_off[t] + ks * 32); \
                fb[t] = *(const bf16x8*)(b_ + cb_off[t] + ks * 32); } \
            _Pragma("unroll") for (int a = 0; a < 2; ++a) _Pragma("unroll") for (int b = 0; b < 2; ++b) acc[a][b] = __builtin_amdgcn_mfma_f32_32x32x16_bf16(fa[a], fb[b], acc[a][b], 0, 0, 0); } } while (0)
    G_LOAD(0, X); G_LOAD(1, Y); G_STORE(0, X);
    __syncthreads();
    for (int kt = 0; kt < nk; kt += 2) {
        G_LOAD(kt + 2, X);
        G_COMPUTE(0);
        G_STORE(1, Y);
        __syncthreads();
        if (kt + 1 >= nk) break;
        G_LOAD(kt + 3, Y);
        G_COMPUTE(1);
        G_STORE(0, X);
        __syncthreads();
    }
#undef G_LOAD
#undef G_STORE
#undef G_COMPUTE
#pragma unroll
    for (int a = 0; a < 2; ++a)
#pragma unroll
        for (int b = 0; b < 2; ++b) epi(ti0 + wi * 64 + a * 32, tj0 + wj * 64 + b * 32, acc[a][b], l31, hi);
}


constexpr int G2_STAGE = 2 * G_RB;
template <class Epi>
DEV void gemm_tile256_tr(char* lds, const bf16_t* __restrict__ R, size_t ldr, const bf16_t* __restrict__ C, size_t ldc, int K, const Epi& epi, int ti0, int tj0) {
    int tid = TID(); asm volatile("" : "+v"(tid));
    const int lane = tid & 63, wid = __builtin_amdgcn_readfirstlane(tid >> 6), wi = wid >> 2, wj = wid & 3, l31 = lane & 31, hi = lane >> 5;
    f32x16 acc[4][2];
#pragma unroll
    for (int a = 0; a < 4; ++a)
#pragma unroll
        for (int b = 0; b < 2; ++b)
#pragma unroll
            for (int r = 0; r < 16; ++r) acc[a][b][r] = 0.f;
    u32x4 rr[4], rc[4];
    const bf16_t* Rp; const bf16_t* Cp; int rl_off, cl_off;
    { const int c = tid & 31, kr = tid >> 5; Rp = R + (size_t)kr * ldr + c * 8; rl_off = kr * T_RS + c * 16; }
    { const int lr = tid >> 3, lc = tid & 7; Cp = C + (size_t)lr * ldc + lc * 8; cl_off = lr * G_RS + lc * 16; }
    const int nk = K / 64;
    int ra_off[4], cb_off[2];
#pragma unroll
    for (int t = 0; t < 4; ++t) { const int g1 = (lane >> 4) & 1, q = (lane & 15) >> 2, p = lane & 3; ra_off[t] = (8 * hi + q) * T_RS + (wi * 128 + t * 32 + 16 * g1 + 4 * p) * 2; }
#pragma unroll
    for (int t = 0; t < 2; ++t) cb_off[t] = G_RB + (wj * 64 + t * 32 + l31) * G_RS + hi * 16;
#define G2_LOAD(kt) do { const int kk_ = (kt) < nk ? (kt) : nk - 1; \
        _Pragma("unroll") for (int p = 0; p < 4; ++p) rr[p] = *(const u32x4*)(Rp + ((size_t)kk_ * 64 + 16 * p) * ldr); \
        _Pragma("unroll") for (int p = 0; p < 4; ++p) rc[p] = *(const u32x4*)(Cp + (size_t)(64 * p) * ldc + kk_ * 64); } while (0)
#define G2_STORE(buf) do { char* b_ = lds + (buf) * G2_STAGE; \
        _Pragma("unroll") for (int p = 0; p < 4; ++p) *(u32x4*)(b_ + rl_off + 16 * p * T_RS) = rr[p]; \
        _Pragma("unroll") for (int p = 0; p < 4; ++p) *(u32x4*)(b_ + G_RB + cl_off + 64 * p * G_RS) = rc[p]; } while (0)
    G2_LOAD(0); G2_STORE(0);
    __syncthreads();
    for (int kt = 0; kt < nk; ++kt) {
        G2_LOAD(kt + 1);
        const char* b_ = lds + (kt & 1) * G2_STAGE;
#pragma unroll
        for (int ks = 0; ks < 4; ++ks) {
            bf16x8 fa[4], fb[2];
#pragma unroll
            for (int t = 0; t < 4; ++t) {
                const s16x4 lo = __builtin_bit_cast(s16x4, __builtin_amdgcn_ds_read_tr16_b64_v4i16((LAS s16x4*)(b_ + ra_off[t] + ks * 16 * T_RS)));
                const s16x4 hh = __builtin_bit_cast(s16x4, __builtin_amdgcn_ds_read_tr16_b64_v4i16((LAS s16x4*)(b_ + ra_off[t] + (ks * 16 + 4) * T_RS)));
                fa[t] = (bf16x8){lo[0], lo[1], lo[2], lo[3], hh[0], hh[1], hh[2], hh[3]}; }
#pragma unroll
            for (int t = 0; t < 2; ++t) fb[t] = *(const bf16x8*)(b_ + cb_off[t] + ks * 32);
#pragma unroll
            for (int a = 0; a < 4; ++a)
#pragma unroll
                for (int b = 0; b < 2; ++b) acc[a][b] = __builtin_amdgcn_mfma_f32_32x32x16_bf16(fa[a], fb[b], acc[a][b], 0, 0, 0);
        }
        G2_STORE((kt + 1) & 1);
        __syncthreads();
    }
#undef G2_LOAD
#undef G2_STORE
#pragma unroll
    for (int a = 0; a < 4; ++a)
#pragma unroll
        for (int b = 0; b < 2; ++b) epi(ti0 + wi * 128 + a * 32, tj0 + wj * 64 + b * 32, acc[a][b], l31, hi);
}
template <bool TR, class Epi>
DEV void gemm_phase(char* lds, const bf16_t* R, size_t ldr, const bf16_t* C, size_t ldc, int nI, int nJ, int K, const Epi& epi) {
    const int tI = nI / 256, tJ = nJ / 128, nt = tI * tJ;
    for (int t = blockIdx.x; t < nt; t += gridDim.x) {
        const int ti = t / tJ, tj = t % tJ;
        gemm_tile<TR, Epi>(lds, R + (size_t)ti * 256 * ldr, ldr, C + (size_t)tj * 128 * ldc, ldc, K, epi, ti * 256, tj * 128);
    }
}

struct EpiRaw {
    bf16_t* O; size_t ld;
    DEV void operator()(int i0, int j0, const f32x16& a, int l31, int hi) const {
#pragma unroll
        for (int r = 0; r < 16; ++r) O[(size_t)(i0 + crow(r, hi)) * ld + j0 + l31] = f2bf(a[r]);
    }
};
struct EpiUq {
    bf16_t* QM; const float* cos32; const float* sin32;
    DEV void operator()(int i0, int j0, const f32x16& a, int l31, int hi) const {
        const bool pe = (j0 % 96) == 64;
        const int fi = l31 & 7; const bool colang = (l31 & 16) != 0; const bool bpart = (l31 & 8) != 0;
#pragma unroll
        for (int r = 0; r < 16; ++r) {
            const int tok = i0 + crow(r, hi); float v = a[r];
            const float o = __shfl_xor(v, 8);
            if (pe) { const int l = tok & (SEQ - 1); const int pos = colang ? (l & 63) : (l >> 6);
                const float cs = cos32[pos * 8 + fi], sn = sin32[pos * 8 + fi];
                v = bpart ? (v * cs + o * sn) : (v * cs - o * sn); }
            QM[(size_t)tok * 768 + j0 + l31] = f2bf(v * QSC_M);
        }
    }
};
struct EpiUkv {
    bf16_t* KM; bf16_t* VM;
    DEV void operator()(int i0, int j0, const f32x16& a, int l31, int hi) const {
        const int h = j0 >> 7, e = (j0 & 127) + l31;
#pragma unroll
        for (int r = 0; r < 16; ++r) { const size_t row = (size_t)(i0 + crow(r, hi));
            if (e < 64) KM[row * 768 + h * 96 + e] = f2bf(a[r]); else VM[row * 512 + h * 64 + (e - 64)] = f2bf(a[r]); }
    }
};
struct EpiRes {
    const float* base; float* out; const float* mod; float gmul;
    DEV void operator()(int i0, int j0, const f32x16& a, int l31, int hi) const {
        const int b = i0 >> 12; const float g = mod[b * 3072 + 2048 + j0 + l31] * gmul;
#pragma unroll
        for (int h8 = 0; h8 < 2; ++h8) { float bv[8];
#pragma unroll
            for (int r = 0; r < 8; ++r) bv[r] = base[(size_t)(i0 + crow(8 * h8 + r, hi)) * DM + j0 + l31];
#pragma unroll
            for (int r = 0; r < 8; ++r) out[(size_t)(i0 + crow(8 * h8 + r, hi)) * DM + j0 + l31] = bv[r] + g * a[8 * h8 + r]; }
    }
};
struct EpiPT {
    bf16_t* PT;
    DEV void operator()(int i0, int j0, const f32x16& a, int l31, int hi) const {
        const int b = j0 >> 12, l = (j0 & 4095) + l31;
#pragma unroll
        for (int r = 0; r < 16; ++r) PT[((size_t)(b * 4096 + i0 + crow(r, hi))) * 4096 + l] = f2bf(a[r]);
    }
};
struct EpiFilt {
    bf16_t* GR; const float* b3;
    DEV void operator()(int i0, int j0, const f32x16& a, int l31, int hi) const {
        const int t = j0 + l31; const float tn = (float)t * (1.0f / 4095.0f);
        const float dmin = -3.0701134573253945f, dmax = -15.350567286626973f;
#pragma unroll
        for (int r = 0; r < 16; ++r) {
            const int n = i0 + crow(r, hi); const int c = n & 1023, od = n >> 10, o = od >> 1, dir = od & 1;
            const float delta = fabsf(dmin + (float)c * ((dmax - dmin) / 1023.0f));
            const float v = (a[r] + b3[n]) * __expf(-tn * delta);
            bf16_t* g = GR + ((size_t)(o * 1024 + c)) * 8192;
            if (dir == 0) g[4096 - t] = f2bf(v);
            else { if (t == 0) g[0] = 0; else g[4096 + t] = f2bf(v); }
        }
    }
};
DEV void filt_sums(const Params& p) {
    const int wid = TID() >> 6, lane = TID() & 63; bf16_t* GR = (bf16_t*)(p.ws + WS_GR); float* ssum = (float*)(p.ws + WS_SSUM);
    for (int row = blockIdx.x * 8 + wid; row < 2048; row += gridDim.x * 8) {
        bf16_t* g = GR + (size_t)row * 8192; float s = 0.f;
        u32x4 w[16];
#pragma unroll
        for (int j = 0; j < 16; ++j) w[j] = *(const u32x4*)(g + (j * 64 + lane) * 8);
#pragma unroll
        for (int j = 0; j < 16; ++j) { float v[8]; unpack8(w[j], v);
            if (j == 0 && lane == 0) v[0] = 0.f;
#pragma unroll
            for (int e = 0; e < 8; ++e) s += fabsf(v[e]); }
        s = wave_sum(s);
        if (lane == 0) ssum[row] = s;
    }
}

namespace pg8 {
#define PG8_LAS __attribute__((address_space(3)))
typedef short bf16x8 __attribute__((ext_vector_type(8)));
typedef float f32x4 __attribute__((ext_vector_type(4)));
typedef unsigned u32x4 __attribute__((ext_vector_type(4)));
constexpr int BM = 256, BK = 64, HALF = 128, HTB = HALF * BK * 2  , STAGE_BYTES = 8 * HTB, NXCD = 8, WGM = 8;

__host__ __device__ __forceinline__ int lds_byte(int r, int c) { const int st = (r >> 4) * 2 + (c >> 5), rr = r & 15, cc = c & 31, ob = rr * 64 + cc * 2; return st * 1024 + (ob ^ (((ob >> 9) & 1) << 5)); }
__host__ __device__ __forceinline__ void stage_rc(int b, int& R, int& C) { const int st = b / 1024, sb = b % 1024, swz = sb ^ (((sb >> 9) & 1) << 5); R = (st >> 1) * 16 + swz / 64; C = (st & 1) * 32 + (swz % 64) / 2; }
__host__ __device__ __forceinline__ int perm32(int rho) { const int n = rho >> 4, i = rho & 15; return 8 * (i >> 2) + 4 * n + (i & 3); }

struct Unit { int pm, pn; };
struct Gemm { const bf16_t* A; const bf16_t* Bt; int M, N, K; };

struct StaticOrder {
    int nM, nN, nwg, G, c;
    __host__ __device__ void init(int M, int N, int G_, int c_) { nM = M / BM; nN = N / BM; nwg = nM * nN; G = G_; c = c_; }
    __host__ __device__ bool next(int i, Unit& u) const {
        const long L = (long)i * G + c; if (L >= nwg) return false;
        int wgid = (int)L; { const int q = nwg / NXCD, r = nwg % NXCD, xcd = wgid % NXCD, off = wgid / NXCD; wgid = (xcd < r ? xcd * (q + 1) : r * (q + 1) + (xcd - r) * q) + off; }
        const int nig = WGM * nN, gid = wgid / nig, fm = gid * WGM, gsz = (nM - fm) < WGM ? (nM - fm) : WGM;
        u.pm = fm + ((wgid % nig) % gsz); u.pn = (wgid % nig) / gsz; return true;
    }
    __device__ __forceinline__ void a_ready(const Unit&) const {}
    __device__ __forceinline__ void done(const Unit&) const {}
};

__device__ __forceinline__ unsigned cvt_pk_bf16(float lo, float hi) { unsigned r; asm volatile("v_cvt_pk_bf16_f32 %0, %1, %2" : "=v"(r) : "v"(lo), "v"(hi)); return r; }
typedef float f32x2 __attribute__((ext_vector_type(2)));

struct EpiBf16 {
    static constexpr bool PERM = true, AFTER_DRAIN = false;
    bf16_t* O; size_t ldc; int split_cols; size_t split_stride;
    __device__ __forceinline__ void operator()(const f32x4 (&acc)[2][2][4][2], const Unit& u, int wr, int wc, int fr, int fq) const {
        const int row0 = u.pm * BM + wr * 64 + fr; int colt = u.pn * BM; bf16_t* base = O;
        if (split_cols) { const int t = colt / split_cols; base += (size_t)t * split_stride; colt -= t * split_cols; }
        const int col0 = colt + wc * 32 + 8 * fq;
#pragma unroll
        for (int ai = 0; ai < 2; ++ai)
#pragma unroll
            for (int m = 0; m < 4; ++m) { bf16_t* rowp = base + (size_t)(row0 + ai * HALF + m * 16) * ldc + col0;
#pragma unroll
                for (int bj = 0; bj < 2; ++bj) { const f32x4 v0 = acc[ai][bj][m][0], v1 = acc[ai][bj][m][1];
                    u32x4 w; w.x = cvt_pk_bf16(v0[0], v0[1]); w.y = cvt_pk_bf16(v0[2], v0[3]); w.z = cvt_pk_bf16(v1[0], v1[1]); w.w = cvt_pk_bf16(v1[2], v1[3]);
                    *(u32x4*)(rowp + bj * HALF) = w; } }
    }
};

struct EpiUkvPg {
    static constexpr bool PERM = true, AFTER_DRAIN = false;
    bf16_t* KM; bf16_t* VM;
    __device__ __forceinline__ void operator()(const f32x4 (&acc)[2][2][4][2], const Unit& u, int wr, int wc, int fr, int fq) const {
        { const int ln = lane_id(); fr = ln & 15; fq = ln >> 4; }
        const int row0 = u.pm * BM + wr * 64 + fr; const int e0 = 32 * wc + 8 * fq;
        const bool isk = (wc < 2);
        bf16_t* base = isk ? KM + (size_t)row0 * 768 + 2 * u.pn * 96 + e0 : VM + (size_t)row0 * 512 + 2 * u.pn * 64 + (e0 - 64);
        const int ld = isk ? 768 : 512, hs = isk ? 96 : 64;
#pragma unroll
        for (int ai = 0; ai < 2; ++ai)
#pragma unroll
            for (int m = 0; m < 4; ++m)
#pragma unroll
                for (int bj = 0; bj < 2; ++bj) { const f32x4 v0 = acc[ai][bj][m][0], v1 = acc[ai][bj][m][1];
                    u32x4 w; w.x = cvt_pk_bf16(v0[0], v0[1]); w.y = cvt_pk_bf16(v0[2], v0[3]); w.z = cvt_pk_bf16(v1[0], v1[1]); w.w = cvt_pk_bf16(v1[2], v1[3]);
                    *(u32x4*)(base + (ai * HALF + m * 16) * ld + bj * hs) = w; }
    }
};
struct EpiUqPg {
    static constexpr bool PERM = true, AFTER_DRAIN = false;
    bf16_t* QM; const float* cos32; const float* sin32; float sc;
    __device__ __forceinline__ void operator()(const f32x4 (&acc)[2][2][4][2], const Unit& u, int wr, int wc, int fr, int fq) const {
        { const int ln = lane_id(); fr = ln & 15; fq = ln >> 4; }
        const int row0 = u.pm * BM + wr * 64 + fr;
        bf16_t* base = QM + (size_t)row0 * 768 + u.pn * BM + 32 * wc + 8 * fq;
        const int g0 = 8 * u.pn + wc;
        const bool sgn = (fq & 1) != 0;
#pragma unroll
        for (int bj = 0; bj < 2; ++bj) { const bool pe = (((g0 + 4 * bj) % 3) == 2);
#pragma unroll
            for (int ai = 0; ai < 2; ++ai)
#pragma unroll
                for (int m = 0; m < 4; ++m) { const int rr = ai * HALF + m * 16; u32x4 w;
#pragma unroll
                    for (int n = 0; n < 2; ++n) { f32x4 v = acc[ai][bj][m][n];
                        if (pe) { f32x4 o;
#pragma unroll
                            for (int e = 0; e < 4; ++e) o[e] = __shfl_xor(v[e], 16);
                            const int l = (row0 + rr) & 4095, pos = (fq < 2) ? (l >> 6) : (l & 63);
                            const f32x4 cv = *(const f32x4*)(cos32 + pos * 8 + 4 * n), sv = *(const f32x4*)(sin32 + pos * 8 + 4 * n);
                            v = sgn ? (v * cv + o * sv) : (v * cv - o * sv); }
                        v = v * sc;
                        if (n == 0) { w.x = cvt_pk_bf16(v[0], v[1]); w.y = cvt_pk_bf16(v[2], v[3]); } else { w.z = cvt_pk_bf16(v[0], v[1]); w.w = cvt_pk_bf16(v[2], v[3]); } }
                    *(u32x4*)(base + rr * 768 + bj * HALF) = w;
                    asm volatile("" ::: "memory"); } }
    }
};
struct EpiResF32 {
    static constexpr bool PERM = false, AFTER_DRAIN = false;
    const float* base; float* out; const float* mod; float gmul;
    __device__ __forceinline__ void operator()(const f32x4 (&acc)[2][2][4][2], const Unit& u, int wr, int wc, int fr, int fq) const {
        const int row0 = u.pm * BM + wr * 64 + fr, col0 = u.pn * BM + wc * 32 + 4 * fq, b = (u.pm * BM) >> 12;
        f32x4 g[2][2];
#pragma unroll
        for (int bj = 0; bj < 2; ++bj)
#pragma unroll
            for (int n = 0; n < 2; ++n) g[bj][n] = *(const f32x4*)(mod + b * 3072 + 2048 + col0 + bj * HALF + n * 16) * gmul;
#pragma unroll
        for (int ai = 0; ai < 2; ++ai) {
            f32x4 pre[4][2][2];
#pragma unroll
            for (int m = 0; m < 4; ++m) { const size_t off = (size_t)(row0 + ai * HALF + m * 16) * 1024 + col0;
#pragma unroll
                for (int bj = 0; bj < 2; ++bj)
#pragma unroll
                    for (int n = 0; n < 2; ++n) pre[m][bj][n] = *(const f32x4*)(base + off + bj * HALF + n * 16); }
#pragma unroll
            for (int m = 0; m < 4; ++m) { const size_t off = (size_t)(row0 + ai * HALF + m * 16) * 1024 + col0;
#pragma unroll
                for (int bj = 0; bj < 2; ++bj)
#pragma unroll
                    for (int n = 0; n < 2; ++n) *(f32x4*)(out + off + bj * HALF + n * 16) = pre[m][bj][n] + g[bj][n] * acc[ai][bj][m][n]; }
        }
    }
};
template <class Epi, class Sched, bool ALIGN_EPI = false, bool SP2 = false>
__device__ __forceinline__ void gemm_phase(PG8_LAS unsigned char* lds, const Gemm g, const Sched& S, const Epi& E) {
    int tid_ = TID(); asm volatile("" : "+v"(tid_));
    const int tid = tid_, wid = __builtin_amdgcn_readfirstlane(tid >> 6), lane = tid & 63, wr = wid >> 2, wc = wid & 3, fr = lane & 15, fq = lane >> 4;
    const int K = g.K, nt = K / BK;
    unsigned voffA[2], voffB[2];
#pragma unroll
    for (int i = 0; i < 2; ++i) { int R, C; stage_rc(tid * 16 + i * 8192, R, C); const int Rb = Epi::PERM ? ((R & ~31) + perm32(R & 31)) : R;
        voffA[i] = (unsigned)(R * K + C) * 2u; voffB[i] = (unsigned)(Rb * K + C) * 2u; }
    const size_t kstep = (size_t)(BK * 2);
    const size_t hstep = (size_t)HALF * K * 2;
    const size_t tstep = 2 * hstep;
    const unsigned ldsw = (unsigned)wid * 1024u;
    const int aoff = lds_byte(wr * 64 + fr, fq * 8), boff = lds_byte(wc * 32 + fr, fq * 8);
#define PG8_SA(b, h) (((b) * 2 + (h)) * HTB)
#define PG8_SB(b, h) ((4 + (b) * 2 + (h)) * HTB)
#define PG8_STAGE(bufoff, gbase, voff) do { _Pragma("unroll") for (int _i = 0; _i < 2; ++_i) \
        __builtin_amdgcn_global_load_lds((const unsigned*)((const char*)(gbase) + (voff)[_i]), (PG8_LAS unsigned*)(lds + (bufoff) + ldsw + _i * 8192), 16, 0, 0); } while (0)
#define PG8_LDA(dst, b, h) do { _Pragma("unroll") for (int m = 0; m < 4; ++m) _Pragma("unroll") for (int k = 0; k < 2; ++k) dst[m][k] = *(const PG8_LAS bf16x8*)(lds + PG8_SA(b, h) + aoff + m * 2048 + k * 1024); } while (0)
#define PG8_LDB(dst, b, h) do { _Pragma("unroll") for (int n = 0; n < 2; ++n) _Pragma("unroll") for (int k = 0; k < 2; ++k) dst[n][k] = *(const PG8_LAS bf16x8*)(lds + PG8_SB(b, h) + boff + n * 2048 + k * 1024); } while (0)
#define PG8_MMA(ai, bj, At, Bt) do { __builtin_amdgcn_s_setprio(1); _Pragma("unroll") for (int m = 0; m < 4; ++m) _Pragma("unroll") for (int n = 0; n < 2; ++n) _Pragma("unroll") for (int k = 0; k < 2; ++k) \
        acc[ai][bj][m][n] = __builtin_amdgcn_mfma_f32_16x16x32_bf16(Bt[n][k], At[m][k], acc[ai][bj][m][n], 0, 0, 0); __builtin_amdgcn_s_setprio(0); } while (0)
#define PG8_WAIT_V(n) asm volatile("s_waitcnt vmcnt(" #n ")" ::: "memory")
#define PG8_WAIT_L(n) asm volatile("s_waitcnt lgkmcnt(" #n ")" ::: "memory")
#define PG8_BAR __builtin_amdgcn_s_barrier()
#define PG8_SCHED __builtin_amdgcn_sched_barrier(0)
    Unit cur, nxt; int ui = 0;
    if (!S.next(0, cur)) return;
    f32x4 acc[2][2][4][2];
#pragma unroll
    for (int a = 0; a < 2; ++a)
#pragma unroll
        for (int b = 0; b < 2; ++b)
#pragma unroll
            for (int m = 0; m < 4; ++m)
#pragma unroll
                for (int n = 0; n < 2; ++n) acc[a][b][m][n] = (f32x4){0.f, 0.f, 0.f, 0.f};
    bf16x8 At[4][2], B0[2][2], B1[2][2];
    const char* cA = (const char*)g.A + (size_t)cur.pm * tstep; const char* cB = (const char*)g.Bt + (size_t)cur.pn * tstep;
    S.a_ready(cur);
    if constexpr (SP2) {
        PG8_STAGE(PG8_SB(0, 0), cB, voffB); PG8_STAGE(PG8_SB(0, 1), cB + hstep, voffB); PG8_STAGE(PG8_SA(0, 0), cA, voffA); PG8_STAGE(PG8_SA(0, 1), cA + hstep, voffA);
        if (wr == 1) PG8_BAR;
        PG8_WAIT_V(2); PG8_BAR;
        PG8_STAGE(PG8_SB(1, 0), cB + kstep, voffB); PG8_STAGE(PG8_SA(1, 0), cA + kstep, voffA); PG8_STAGE(PG8_SB(1, 1), cB + hstep + kstep, voffB);
        PG8_WAIT_V(6); PG8_BAR;
    } else {
        PG8_STAGE(PG8_SB(0, 0), cB, voffB); PG8_STAGE(PG8_SA(0, 0), cA, voffA); PG8_STAGE(PG8_SB(0, 1), cB + hstep, voffB); PG8_STAGE(PG8_SA(0, 1), cA + hstep, voffA);
        if (wr == 1) PG8_BAR;
        PG8_WAIT_V(4); PG8_BAR;
        PG8_STAGE(PG8_SB(1, 0), cB + kstep, voffB); PG8_STAGE(PG8_SA(1, 0), cA + kstep, voffA); PG8_STAGE(PG8_SB(1, 1), cB + hstep + kstep, voffB);
        PG8_WAIT_V(6); PG8_BAR;
    }
    for (;;) {
        const bool has_next = S.next(ui + 1, nxt);
        const char* nA = has_next ? (const char*)g.A + (size_t)nxt.pm * tstep : cA; const char* nB = has_next ? (const char*)g.Bt + (size_t)nxt.pn * tstep : cB;
        for (int t = 0; t < nt; t += 2) {
            const bool last = (t == nt - 2);
            const char* a1 = cA + (size_t)(t + 1) * kstep;
            const char* a2 = last ? nA : cA + (size_t)(t + 2) * kstep; const char* b2 = last ? nB : cB + (size_t)(t + 2) * kstep;
            const char* a3 = a2 + kstep; const char* b3 = b2 + kstep;
            if (last && has_next) S.a_ready(nxt);
            if constexpr (SP2) {
            PG8_LDB(B0, 0, 0); PG8_LDB(B1, 0, 1); PG8_SCHED; PG8_LDA(At, 0, 0); PG8_STAGE(PG8_SA(1, 1), a1 + hstep, voffA);
            PG8_WAIT_V(8); PG8_WAIT_L(0); PG8_BAR; PG8_MMA(0, 0, At, B0); PG8_MMA(0, 1, At, B1); PG8_BAR; PG8_SCHED;
            PG8_LDA(At, 0, 1); PG8_STAGE(PG8_SB(0, 0), b2, voffB); PG8_STAGE(PG8_SB(0, 1), b2 + hstep, voffB); PG8_STAGE(PG8_SA(0, 0), a2, voffA);
            PG8_WAIT_V(8); PG8_WAIT_L(0); PG8_BAR; PG8_MMA(1, 0, At, B0); PG8_MMA(1, 1, At, B1); PG8_BAR; PG8_SCHED;
            PG8_LDB(B0, 1, 0); PG8_LDB(B1, 1, 1); PG8_SCHED; PG8_LDA(At, 1, 0); PG8_STAGE(PG8_SA(0, 1), a2 + hstep, voffA);
            PG8_WAIT_V(8); PG8_WAIT_L(0); PG8_BAR; PG8_MMA(0, 0, At, B0); PG8_MMA(0, 1, At, B1); PG8_BAR; PG8_SCHED;
            PG8_LDA(At, 1, 1); PG8_STAGE(PG8_SB(1, 0), b3, voffB); PG8_STAGE(PG8_SB(1, 1), b3 + hstep, voffB); PG8_STAGE(PG8_SA(1, 0), a3, voffA);
            PG8_WAIT_V(8); PG8_WAIT_L(0); PG8_BAR; PG8_MMA(1, 0, At, B0); PG8_MMA(1, 1, At, B1); PG8_BAR; PG8_SCHED;
            } else {
            PG8_LDB(B0, 0, 0); PG8_SCHED; PG8_LDA(At, 0, 0); PG8_STAGE(PG8_SA(1, 1), a1 + hstep, voffA);
            PG8_WAIT_L(8); PG8_BAR; PG8_WAIT_L(0); PG8_MMA(0, 0, At, B0); PG8_BAR; PG8_SCHED;
            PG8_LDB(B1, 0, 1); PG8_STAGE(PG8_SB(0, 0), b2, voffB);
            PG8_BAR; PG8_WAIT_L(0); PG8_MMA(0, 1, At, B1); PG8_BAR;
            PG8_LDA(At, 0, 1); PG8_STAGE(PG8_SA(0, 0), a2, voffA);
            PG8_BAR; PG8_WAIT_L(0); PG8_MMA(1, 0, At, B0); PG8_BAR; PG8_SCHED;
            PG8_STAGE(PG8_SB(0, 1), b2 + hstep, voffB);
            PG8_WAIT_V(6); PG8_BAR; PG8_MMA(1, 1, At, B1); PG8_BAR;
            PG8_LDB(B0, 1, 0); PG8_SCHED; PG8_LDA(At, 1, 0); PG8_STAGE(PG8_SA(0, 1), a2 + hstep, voffA);
            PG8_WAIT_L(8); PG8_BAR; PG8_WAIT_L(0); PG8_MMA(0, 0, At, B0); PG8_BAR; PG8_SCHED;
            PG8_LDB(B1, 1, 1); PG8_STAGE(PG8_SB(1, 0), b3, voffB);
            PG8_BAR; PG8_WAIT_L(0); PG8_MMA(0, 1, At, B1); PG8_BAR;
            PG8_LDA(At, 1, 1); PG8_STAGE(PG8_SA(1, 0), a3, voffA);
            PG8_BAR; PG8_WAIT_L(0); PG8_MMA(1, 0, At, B0); PG8_BAR; PG8_SCHED;
            PG8_STAGE(PG8_SB(1, 1), b3 + hstep, voffB);
            PG8_WAIT_V(6); PG8_BAR; PG8_MMA(1, 1, At, B1); PG8_BAR;
            }
        }
        if constexpr (ALIGN_EPI) { if (wr == 0) PG8_BAR; }
        if constexpr (!Epi::AFTER_DRAIN) { E(acc, cur, wr, wc, fr, fq); S.done(cur); }
        if (!has_next) break;
#pragma unroll
        for (int a = 0; a < 2; ++a)
#pragma unroll
            for (int b = 0; b < 2; ++b)
#pragma unroll
                for (int m = 0; m < 4; ++m)
#pragma unroll
                    for (int n = 0; n < 2; ++n) acc[a][b][m][n] = (f32x4){0.f, 0.f, 0.f, 0.f};
        cur = nxt; cA = nA; cB = nB; ++ui;
        if constexpr (ALIGN_EPI) { if (wr == 1) PG8_BAR; }
    }
    PG8_WAIT_V(0);
    if constexpr (!ALIGN_EPI) { if (wr == 0) PG8_BAR; }
    PG8_BAR;
    if constexpr (Epi::AFTER_DRAIN) { E.fused(acc, cur, wr, wc, fr, fq, lds, wid, lane); S.done(cur); }
#undef PG8_SA
#undef PG8_SB
#undef PG8_STAGE
#undef PG8_LDA
#undef PG8_LDB
#undef PG8_MMA
#undef PG8_WAIT_V
#undef PG8_WAIT_L
#undef PG8_BAR
#undef PG8_SCHED
}
}

DEV void transpose_item(float* scr, const float* W, int K, int N, int Npad, bf16_t* WT, int item, int lane) {
    const int nblk = Npad / 32, kb = item / nblk, nb = item % nblk, k0 = 64 * kb, n0 = 32 * nb;
    const bool valid = (n0 < N);
    float v[32];
#pragma unroll
    for (int i = 0; i < 32; ++i) { const int kk = 2 * i + (lane >> 5); v[i] = valid ? W[(size_t)(k0 + kk) * N + n0 + (lane & 31)] : 0.f; }
#pragma unroll
    for (int i = 0; i < 32; ++i) { const int kk = 2 * i + (lane >> 5); scr[kk * 33 + (lane & 31)] = v[i]; }
    asm volatile("s_waitcnt lgkmcnt(0)" ::: "memory");
    const int c = lane & 7;
#pragma unroll
    for (int j = 0; j < 4; ++j) { const int n = (lane >> 3) + 8 * j; const float* sp = scr + (8 * c) * 33 + n; float o[8];
#pragma unroll
        for (int e = 0; e < 8; ++e) o[e] = sp[e * 33];
        *(u32x4*)(WT + (size_t)(n0 + n) * K + k0 + 8 * c) = pack8(o); }
    asm volatile("s_waitcnt lgkmcnt(0)" ::: "memory");
}

DEV void mod_item(char* lds, const Params& p, int item) {
    const int layer = item / 96, n0 = (item % 96) * 32, tid = TID();
    float* s = (float*)lds;
    float* red = s + 9 * 1024;
    for (int i = tid; i < 9 * 1024; i += 512) { const int v = i >> 10, k = i & 1023; const float cv = (v < 8) ? p.c[v * 1024 + k] : p.c_ctx[k]; s[i] = silu(cv); }
    __syncthreads();
    const int kc = tid >> 5, n = tid & 31; const float* W = p.ada_w + (size_t)layer * DM * 3072 + n0 + n;
    float acc[9];
#pragma unroll
    for (int v = 0; v < 9; ++v) acc[v] = 0.f;
#pragma unroll 16
    for (int kk = 0; kk < 64; ++kk) { const int k = kc * 64 + kk; const float w = W[(size_t)k * 3072];
#pragma unroll
        for (int v = 0; v < 9; ++v) acc[v] += s[v * 1024 + k] * w; }
#pragma unroll
    for (int v = 0; v < 9; ++v) red[(kc * 9 + v) * 32 + n] = acc[v];
    __syncthreads();
    if (tid < 9 * 32) { const int v = tid >> 5, nn = tid & 31; float t = 0.f;
#pragma unroll
        for (int k2 = 0; k2 < 16; ++k2) t += red[(k2 * 9 + v) * 32 + nn];
        t += p.ada_b[layer * 3072 + n0 + nn];
        if (layer == 0) ((float*)(p.ws + WS_MOD0))[v * 3072 + n0 + nn] = t;
        else if (v < 8) ((float*)(p.ws + WS_MOD1))[v * 3072 + n0 + nn] = t; }
    __syncthreads();
}

DEV void hid2_row(char* lds, const Params& p, int t, int wid, int lane) {
    float* sc = (float*)lds + wid * 128;
    const float tn = (float)t * (1.0f / 4095.0f);
    const float w = (float)(2.0 * 3.14159265358979323846 / 4096.0) * (float)t;
    float e = 0.f;
    if (lane == 0) e = tn;
    else if (lane <= 32) { const int k = (lane - 1) & 15; const float band = 1e-4f + (float)k * ((15.0f - 1e-4f) / 15.0f); const float ang = w * band; e = (lane <= 16) ? cosf(ang) : -sinf(ang); }
    sc[lane] = e;
    asm volatile("s_waitcnt lgkmcnt(0)" ::: "memory");
    float a = p.f_b1[lane];
    for (int i = 0; i < 33; ++i) a += sc[i] * p.f_w1[i * 64 + lane];
    const float fr = p.freq[lane];
    const float h1 = sinf(fr * a);
    sc[64 + lane] = h1;
    asm volatile("s_waitcnt lgkmcnt(0)" ::: "memory");
    float a2 = p.f_b2[lane];
    for (int i = 0; i < 64; ++i) a2 += sc[64 + i] * p.f_w2[i * 64 + lane];
    const float h2 = sinf(fr * a2);
    ((bf16_t*)(p.ws + WS_HID2))[t * 64 + lane] = f2bf(h2);
    asm volatile("s_waitcnt lgkmcnt(0)" ::: "memory");
}

DEV void phase_prep(char* lds, const Params& p) {
    const int tid = TID(), wid = tid >> 6, lane = tid & 63;
    { const int gt = blockIdx.x * 512 + tid;
        if (gt < 2048) ((float*)(p.ws + WS_SSUM))[gt] = 0.f;
        float* rp = (float*)(p.ws + WS_ROPE);
        if (gt < 1024) { const int pos = gt >> 4, i = gt & 15; const float inv = exp2f(-(float)i * (13.287712379549449f / 16.0f)); const float ang = (float)pos * inv; rp[gt] = cosf(ang); rp[1024 + gt] = sinf(ang); }
        if (gt < 512) { const int pos = gt >> 3, i = gt & 7; const float inv = exp2f(-(float)i * (13.287712379549449f / 8.0f)); const float ang = (float)pos * inv; rp[2048 + gt] = cosf(ang); rp[2560 + gt] = sinf(ang); } }
    for (int it = blockIdx.x; it < 192; it += gridDim.x) mod_item(lds, p, it);
    for (int t = blockIdx.x * 8 + wid; t < 4096; t += gridDim.x * 8) hid2_row(lds, p, t, wid, lane);
    __syncthreads();
    constexpr int I_WIN = 16 * (AINP / 32), I_UQ = 4 * 24, I_UKV = 2 * 32, I_WO = 16 * 32, I_HIN = 16 * 128, I_HO = 16 * 32, I_W3 = 128;
    constexpr int NIT = I_WIN + I_UQ + I_UKV + I_WO + I_HIN + I_HO + I_W3;
    float* scr = (float*)lds + wid * (64 * 33);
    for (int it = blockIdx.x * 8 + wid; it < NIT; it += gridDim.x * 8) {
        int r = it;
        if (r < I_HIN) { transpose_item(scr, p.hy_w_in, 1024, 4096, 4096, (bf16_t*)(p.ws + WS_HWIN), r, lane); continue; } r -= I_HIN;
        if (r < I_WIN) { transpose_item(scr, p.w_in, 1024, AIN, AINP, (bf16_t*)(p.ws + WS_WIN), r, lane); continue; } r -= I_WIN;
        if (r < I_WO) { transpose_item(scr, p.w_out, 1024, 1024, 1024, (bf16_t*)(p.ws + WS_WOUT), r, lane); continue; } r -= I_WO;
        if (r < I_HO) { transpose_item(scr, p.hy_w_out, 1024, 1024, 1024, (bf16_t*)(p.ws + WS_HWOUT), r, lane); continue; } r -= I_HO;
        if (r < I_UQ) { transpose_item(scr, p.w_uq, 256, 768, 768, (bf16_t*)(p.ws + WS_WUQ), r, lane); continue; } r -= I_UQ;
        if (r < I_UKV) { transpose_item(scr, p.w_ukv, 128, 1024, 1024, (bf16_t*)(p.ws + WS_WUKV), r, lane); continue; } r -= I_UKV;
        transpose_item(scr, p.f_w3, 64, 4096, 4096, (bf16_t*)(p.ws + WS_W3), r, lane);
    }
}

DEV void row_load(f32x4 (&v)[4], const float* xr, int lane) {
#pragma unroll
    for (int j = 0; j < 4; ++j) v[j] = *(const f32x4*)(xr + lane * 4 + 256 * j);
}
DEV void modnorm_row(const f32x4 (&v)[4], const float* nw, const float* shift, const float* scale, bf16_t* orow, int lane) {
    float s = 0.f;
#pragma unroll
    for (int j = 0; j < 4; ++j) s += v[j].x * v[j].x + v[j].y * v[j].y + v[j].z * v[j].z + v[j].w * v[j].w;
    const float r = rsqrtf(wave_sum(s) * (1.0f / DM) + EPS);
#pragma unroll
    for (int j = 0; j < 4; ++j) { const int c0 = lane * 4 + 256 * j;
        const f32x4 w = *(const f32x4*)(nw + c0), sh = *(const f32x4*)(shift + c0), sc = *(const f32x4*)(scale + c0);
        const float o0 = v[j].x * r * w.x * (1.f + sc.x) + sh.x, o1 = v[j].y * r * w.y * (1.f + sc.y) + sh.y, o2 = v[j].z * r * w.z * (1.f + sc.z) + sh.z, o3 = v[j].w * r * w.w * (1.f + sc.w) + sh.w;
        u32x2 pk; pk.x = pk2(o0, o1); pk.y = pk2(o2, o3); *(u32x2*)(orow + c0) = pk; }
}
DEV const float* norm0_src(const Params& p, int row) { return row < NTOK ? p.x + (size_t)row * DM : p.ctx + (size_t)(row - NTOK) * DM; }
DEV void phase_norm0(const Params& p) {
    const int wid = TID() >> 6, lane = TID() & 63; const float* mod0 = (const float*)(p.ws + WS_MOD0); bf16_t* H0 = (bf16_t*)(p.ws + WS_H0);
    const int stride = gridDim.x * 8; int row = blockIdx.x * 8 + wid;
    f32x4 cur[4], nxt[4];
    if (row < NALL) row_load(cur, norm0_src(p, row), lane);
    for (; row < NALL; row += stride) {
        { const int rn = row + stride < NALL ? row + stride : row; row_load(nxt, norm0_src(p, rn), lane); }
        const int v = row < NTOK ? (row >> 12) : 8;
        modnorm_row(cur, p.norm_w, mod0 + v * 3072, mod0 + v * 3072 + 1024, H0 + (size_t)row * DM, lane);
#pragma unroll
        for (int j = 0; j < 4; ++j) cur[j] = nxt[j];
    }
}
DEV void phase_norm1(const Params& p) {
    const int wid = TID() >> 6, lane = TID() & 63; const float* mod1 = (const float*)(p.ws + WS_MOD1); bf16_t* H1 = (bf16_t*)(p.ws + WS_H1);
    const int stride = gridDim.x * 8; int row = blockIdx.x * 8 + wid;
    f32x4 cur[4], nxt[4];
    if (row < NTOK) row_load(cur, p.out + (size_t)row * DM, lane);
    for (; row < NTOK; row += stride) {
        { const int rn = row + stride < NTOK ? row + stride : row; row_load(nxt, p.out + (size_t)rn * DM, lane); }
        const int v = row >> 12;
        modnorm_row(cur, p.norm_w + DM, mod1 + v * 3072, mod1 + v * 3072 + 1024, H1 + (size_t)row * DM, lane);
#pragma unroll
        for (int j = 0; j < 4; ++j) cur[j] = nxt[j];
    }
}
DEV void phase_final(const Params& p) {
    const int wid = TID() >> 6, lane = TID() & 63;
    const int stride = gridDim.x * 8; int row = blockIdx.x * 8 + wid;
    f32x4 v[4], nxt[4];
    if (row < NTOK) row_load(v, p.out + (size_t)row * DM, lane);
    for (; row < NTOK; row += stride) {
        { const int rn = row + stride < NTOK ? row + stride : row; row_load(nxt, p.out + (size_t)rn * DM, lane); }
        float* xr = p.out + (size_t)row * DM; float s = 0.f;
#pragma unroll
        for (int j = 0; j < 4; ++j) s += v[j].x * v[j].x + v[j].y * v[j].y + v[j].z * v[j].z + v[j].w * v[j].w;
        const float r = rsqrtf(wave_sum(s) * (1.0f / DM) + EPS);
#pragma unroll
        for (int j = 0; j < 4; ++j) { const int c0 = lane * 4 + 256 * j; const f32x4 w = *(const f32x4*)(p.final_w + c0);
            f32x4 o; o.x = v[j].x * r * w.x; o.y = v[j].y * r * w.y; o.z = v[j].z * r * w.z; o.w = v[j].w * r * w.w; *(f32x4*)(xr + c0) = o; }
#pragma unroll
        for (int j = 0; j < 4; ++j) v[j] = nxt[j];
    }
}

struct PostIn { u32x4 raw[5]; f32x4 c64[2], s64[2], c32[2], s32[2]; };
DEV void post_load(PostIn& I, const bf16_t* PRAW, const float* rp, int tok, int lane) {
    const bf16_t* pr = PRAW + (size_t)tok * AINP;
#pragma unroll
    for (int sgm = 0; sgm < 4; ++sgm) I.raw[sgm] = *(const u32x4*)(pr + 512 * sgm + lane * 8);
    I.raw[4] = *(const u32x4*)(pr + 2048 + (lane & 31) * 8);
    const int l = tok & 4095, prow = l >> 6, pcol = l & 63;
    const int k = lane & 7, posv = (k < 4) ? prow : pcol; const float* t64 = rp + posv * 16 + (k & 1) * 8;
    I.c64[0] = *(const f32x4*)t64; I.c64[1] = *(const f32x4*)(t64 + 4); I.s64[0] = *(const f32x4*)(t64 + 1024); I.s64[1] = *(const f32x4*)(t64 + 1028);
    const int k3 = lane & 3, posm = (k3 < 2) ? prow : pcol; const float* t32 = rp + 2048 + posm * 8;
    I.c32[0] = *(const f32x4*)t32; I.c32[1] = *(const f32x4*)(t32 + 4); I.s32[0] = *(const f32x4*)(t32 + 512); I.s32[1] = *(const f32x4*)(t32 + 516);
}
DEV void phase_post(const Params& p) {
    const int wid = TID() >> 6, lane = TID() & 63;
    const bf16_t* PRAW = (const bf16_t*)(p.ws + WS_PRAW);
    bf16_t* QA = (bf16_t*)(p.ws + WS_QA); bf16_t* KA = (bf16_t*)(p.ws + WS_KA); bf16_t* VA = (bf16_t*)(p.ws + WS_VA);
    bf16_t* CQN = (bf16_t*)(p.ws + WS_CQN); bf16_t* CKVN = (bf16_t*)(p.ws + WS_CKVN); bf16_t* G = (bf16_t*)(p.ws + WS_G); bf16_t* KM = (bf16_t*)(p.ws + WS2_KM);
    const float* rp = (const float*)(p.ws + WS_ROPE);
    float wq[8], wk[8], wcq[8], wckv[8];
    { const int k = lane & 7;
#pragma unroll
        for (int j = 0; j < 8; ++j) { wq[j] = p.q_norm[k * 8 + j]; wk[j] = p.k_norm[k * 8 + j]; wcq[j] = p.cq_norm[(lane & 31) * 8 + j]; wckv[j] = p.ckv_norm[(lane & 15) * 8 + j]; } }
    const int stride = gridDim.x * 8;
    int tok = blockIdx.x * 8 + wid;
    PostIn cur, nxt;
    if (tok < NALL) post_load(cur, PRAW, rp, tok, lane);
    for (; tok < NALL; tok += stride) {
        { const int tn = tok + stride < NALL ? tok + stride : tok; post_load(nxt, PRAW, rp, tn, lane); }
        const bool lat = tok < NTOK; int b, pos;
        if (lat) { b = tok >> 12; pos = CTXL + (tok & 4095); } else { const int j = tok - NTOK; b = j >> 8; pos = j & 255; }
        const size_t kvrow = (size_t)b * LK + pos;
        const float cs64[8] = {cur.c64[0].x, cur.c64[0].y, cur.c64[0].z, cur.c64[0].w, cur.c64[1].x, cur.c64[1].y, cur.c64[1].z, cur.c64[1].w};
        const float sn64[8] = {cur.s64[0].x, cur.s64[0].y, cur.s64[0].z, cur.s64[0].w, cur.s64[1].x, cur.s64[1].y, cur.s64[1].z, cur.s64[1].w};
        float v[8], o[8];
        if (lat) {
            unpack8(cur.raw[0], v);
            float ss = 0.f;
#pragma unroll
            for (int j = 0; j < 8; ++j) ss += v[j] * v[j];
            ss += __shfl_xor(ss, 1); ss += __shfl_xor(ss, 2); ss += __shfl_xor(ss, 4);
            const float r = rsqrtf(ss * (1.0f / 64.0f) + EPS); const int k = lane & 7;
#pragma unroll
            for (int j = 0; j < 8; ++j) v[j] = v[j] * r * wq[j];
#pragma unroll
            for (int j = 0; j < 8; ++j) { const float ot = __shfl_xor(v[j], 2);
                o[j] = ((k & 2) ? (v[j] * cs64[j] + ot * sn64[j]) : (v[j] * cs64[j] - ot * sn64[j])) * QSC_A; }
            *(u32x4*)(QA + (size_t)tok * 512 + lane * 8) = pack8(o);
        }
        {
            const u32x4 raw = cur.raw[1]; unpack8(raw, v);
            float ss = 0.f;
#pragma unroll
            for (int j = 0; j < 8; ++j) ss += v[j] * v[j];
            ss += __shfl_xor(ss, 1); ss += __shfl_xor(ss, 2); ss += __shfl_xor(ss, 4);
            const float s8 = ss;
            ss += __shfl_xor(ss, 8); ss += __shfl_xor(ss, 16);
            const float s32 = ss;
            float vn[8]; const int k = lane & 7;
            { const float r = rsqrtf(s8 * (1.0f / 64.0f) + EPS);
#pragma unroll
                for (int j = 0; j < 8; ++j) vn[j] = v[j] * r * wk[j]; }
#pragma unroll
            for (int j = 0; j < 8; ++j) { const float ot = __shfl_xor(vn[j], 2);
                o[j] = lat ? ((k & 2) ? (vn[j] * cs64[j] + ot * sn64[j]) : (vn[j] * cs64[j] - ot * sn64[j])) : vn[j]; }
            if (lane < 16) *(u32x4*)(KA + kvrow * 128 + lane * 8) = pack8(o);
            else if (lane < 32) *(u32x4*)(VA + kvrow * 128 + (lane - 16) * 8) = raw;
            else if (lat) { const float r = rsqrtf(s32 * (1.0f / 256.0f) + EPS); const int cb = (lane - 32) * 8;
#pragma unroll
                for (int j = 0; j < 8; ++j) o[j] = v[j] * r * wcq[j];
                *(u32x4*)(CQN + (size_t)tok * 256 + cb) = pack8(o); }
        }
        {
            unpack8(cur.raw[2], v);
            float ss = 0.f;
#pragma unroll
            for (int j = 0; j < 8; ++j) ss += v[j] * v[j];
            ss += __shfl_xor(ss, 1); ss += __shfl_xor(ss, 2); ss += __shfl_xor(ss, 4); ss += __shfl_xor(ss, 8);
            const int k = lane & 3;
            float oth[8];
#pragma unroll
            for (int j = 0; j < 8; ++j) oth[j] = __shfl_xor(v[j], 1);
            if (lane < 16) { const float r = rsqrtf(ss * (1.0f / 128.0f) + EPS);
#pragma unroll
                for (int j = 0; j < 8; ++j) o[j] = v[j] * r * wckv[j];
                *(u32x4*)(CKVN + kvrow * 128 + lane * 8) = pack8(o); }
            else if (lane < 20) {
                const float cs32[8] = {cur.c32[0].x, cur.c32[0].y, cur.c32[0].z, cur.c32[0].w, cur.c32[1].x, cur.c32[1].y, cur.c32[1].z, cur.c32[1].w};
                const float sn32[8] = {cur.s32[0].x, cur.s32[0].y, cur.s32[0].z, cur.s32[0].w, cur.s32[1].x, cur.s32[1].y, cur.s32[1].z, cur.s32[1].w};
#pragma unroll
                for (int j = 0; j < 8; ++j) o[j] = lat ? ((k & 1) ? (v[j] * cs32[j] + oth[j] * sn32[j]) : (v[j] * cs32[j] - oth[j] * sn32[j])) : v[j];
                const u32x4 w = pack8(o);
#pragma unroll
                for (int h = 0; h < 8; ++h) *(u32x4*)(KM + kvrow * 768 + h * 96 + 64 + k * 8) = w; }
            else if (lat) {
#pragma unroll
                for (int j = 0; j < 8; ++j) o[j] = silu(v[j]);
                *(u32x4*)(G + (size_t)tok * 1024 + (lane - 20) * 8) = pack8(o); }
        }
        if (lat) {
            unpack8(cur.raw[3], v);
#pragma unroll
            for (int j = 0; j < 8; ++j) o[j] = silu(v[j]);
            *(u32x4*)(G + (size_t)tok * 1024 + 352 + lane * 8) = pack8(o);
            if (lane < 20) { unpack8(cur.raw[4], v);
#pragma unroll
                for (int j = 0; j < 8; ++j) o[j] = silu(v[j]);
                *(u32x4*)(G + (size_t)tok * 1024 + 864 + lane * 8) = pack8(o); }
        }
        cur = nxt;
    }
}

template <int DQK>
DEV void attn_unit(char* lds, const bf16_t* __restrict__ Q, int ldq, int qcol, const bf16_t* __restrict__ Kp, int ldk, int kcol, const bf16_t* __restrict__ Vp, int ldv, int vcol,
                   const bf16_t* __restrict__ Gt, bf16_t* OG, int ocol, int b, int q0) {
    constexpr int KRS = (DQK + 8) * 2, KB = 64 * KRS, VRS = 192, VB = 64 * VRS, STG = KB + VB, NKS = DQK / 16, KCH = DQK / 8;
    const int tid = TID(), lane = tid & 63, wid = tid >> 6, l31 = lane & 31, hi = lane >> 5;
    bf16x8 qf[NKS];
    { const bf16_t* qp = Q + (size_t)(b * SEQ + q0 + wid * 32 + l31) * ldq + qcol + hi * 8;
#pragma unroll
        for (int ks = 0; ks < NKS; ++ks) qf[ks] = *(const bf16x8*)(qp + ks * 16); }
    const bf16_t* kbase = Kp + (size_t)b * LK * ldk + kcol; const bf16_t* vbase = Vp + (size_t)b * LK * ldv + vcol;
    const int kr0 = tid / KCH, kc0 = tid % KCH;
    const int kr1 = (tid + 512) / KCH, kc1 = (tid + 512) % KCH;
    const bool k2 = (KCH * 64 > 512) && (tid + 512 < KCH * 64);
    const int vr = tid >> 3, vc = tid & 7;
    u32x4 sk0, sk1, sv;
#define A_LOAD(t) do { const size_t kp_ = (size_t)(t) * 64; sk0 = *(const u32x4*)(kbase + (kp_ + kr0) * ldk + kc0 * 8); \
        if (k2) sk1 = *(const u32x4*)(kbase + (kp_ + kr1) * ldk + kc1 * 8); sv = *(const u32x4*)(vbase + (kp_ + vr) * ldv + vc * 8); } while (0)
#define A_STORE(buf) do { char* b_ = lds + (buf) * STG; *(u32x4*)(b_ + kr0 * KRS + kc0 * 16) = sk0; if (k2) *(u32x4*)(b_ + kr1 * KRS + kc1 * 16) = sk1; \
        *(u32x4*)(b_ + KB + vr * VRS + vc * 16) = sv; } while (0)
    f32x16 o0, o1;
#pragma unroll
    for (int r = 0; r < 16; ++r) { o0[r] = 0.f; o1[r] = 0.f; }
    float m_run = -1e30f, l_run = 0.f;
    const int g1 = (lane >> 4) & 1, tq = (lane & 15) >> 2, tp = lane & 3;
    const int vt_off = KB + (4 * hi + tq) * VRS + (16 * g1 + 4 * tp) * 2;
    const int kf_off = l31 * KRS + hi * 16;
    constexpr int NT = LK / 64;
    A_LOAD(0); A_STORE(0);
    __syncthreads();
    for (int t = 0; t < NT; ++t) {
        const bool more = (t + 1 < NT);
        if (more) A_LOAD(t + 1);
        const char* b_ = lds + (t & 1) * STG;
        f32x16 p0, p1;
#pragma unroll
        for (int r = 0; r < 16; ++r) { p0[r] = 0.f; p1[r] = 0.f; }
#pragma unroll
        for (int ks = 0; ks < NKS; ++ks) {
            const bf16x8 ka = *(const bf16x8*)(b_ + kf_off + ks * 32);
            const bf16x8 kb = *(const bf16x8*)(b_ + kf_off + 32 * KRS + ks * 32);
            p0 = __builtin_amdgcn_mfma_f32_32x32x16_bf16(ka, qf[ks], p0, 0, 0, 0);
            p1 = __builtin_amdgcn_mfma_f32_32x32x16_bf16(kb, qf[ks], p1, 0, 0, 0);
        }
        float mx = p0[0];
#pragma unroll
        for (int r = 1; r < 16; ++r) mx = fmaxf(mx, p0[r]);
#pragma unroll
        for (int r = 0; r < 16; ++r) mx = fmaxf(mx, p1[r]);
        mx = fmaxf(mx, __shfl_xor(mx, 32));
        const float m_new = fmaxf(m_run, mx);
        const float alpha = __builtin_amdgcn_exp2f(m_run - m_new);
        m_run = m_new;
        float ls = 0.f;
#pragma unroll
        for (int r = 0; r < 16; ++r) { p0[r] = __builtin_amdgcn_exp2f(p0[r] - m_new); p1[r] = __builtin_amdgcn_exp2f(p1[r] - m_new); ls += p0[r] + p1[r]; }
        l_run = l_run * alpha + ls;
#pragma unroll
        for (int r = 0; r < 16; ++r) { o0[r] *= alpha; o1[r] *= alpha; }
        u32x4 pw[4];
        pw[0] = (u32x4){pk2(p0[0], p0[1]), pk2(p0[2], p0[3]), pk2(p0[4], p0[5]), pk2(p0[6], p0[7])};
        pw[1] = (u32x4){pk2(p0[8], p0[9]), pk2(p0[10], p0[11]), pk2(p0[12], p0[13]), pk2(p0[14], p0[15])};
        pw[2] = (u32x4){pk2(p1[0], p1[1]), pk2(p1[2], p1[3]), pk2(p1[4], p1[5]), pk2(p1[6], p1[7])};
        pw[3] = (u32x4){pk2(p1[8], p1[9]), pk2(p1[10], p1[11]), pk2(p1[12], p1[13]), pk2(p1[14], p1[15])};
#pragma unroll
        for (int s = 0; s < 4; ++s) {
            const bf16x8 pb = __builtin_bit_cast(bf16x8, pw[s]);
#pragma unroll
            for (int dt = 0; dt < 2; ++dt) {
                const char* vp = b_ + vt_off + s * 16 * VRS + dt * 64;
                const s16x4 lo = __builtin_bit_cast(s16x4, __builtin_amdgcn_ds_read_tr16_b64_v4i16((LAS s16x4*)vp));
                const s16x4 hh = __builtin_bit_cast(s16x4, __builtin_amdgcn_ds_read_tr16_b64_v4i16((LAS s16x4*)(vp + 8 * VRS)));
                const bf16x8 vf = (bf16x8){lo[0], lo[1], lo[2], lo[3], hh[0], hh[1], hh[2], hh[3]};
                if (dt == 0) o0 = __builtin_amdgcn_mfma_f32_32x32x16_bf16(vf, pb, o0, 0, 0, 0);
                else o1 = __builtin_amdgcn_mfma_f32_32x32x16_bf16(vf, pb, o1, 0, 0, 0);
            }
        }
        if (more) A_STORE((t + 1) & 1);
        __syncthreads();
    }
#undef A_LOAD
#undef A_STORE
    const float lt = l_run + __shfl_xor(l_run, 32); const float inv = 1.0f / lt;
    const size_t tok = (size_t)(b * SEQ + q0 + wid * 32 + l31);
#pragma unroll
    for (int dt = 0; dt < 2; ++dt)
#pragma unroll
        for (int g = 0; g < 4; ++g) { const int d = 32 * dt + 8 * g + 4 * hi; const size_t off = tok * 1024 + ocol + d;
            const u32x2 gw = *(const u32x2*)(Gt + off);
            const f32x16& oo = dt ? o1 : o0;
            u32x2 w; w.x = pk2(oo[4 * g] * inv * lo_bf(gw.x), oo[4 * g + 1] * inv * hi_bf(gw.x)); w.y = pk2(oo[4 * g + 2] * inv * lo_bf(gw.y), oo[4 * g + 3] * inv * hi_bf(gw.y));
            *(u32x2*)(OG + off) = w; }
}

DEV float max3f_s(float a, float b, float c) { float r; asm("v_max3_f32 %0, %1, %2, %3" : "=v"(r) : "v"(a), "v"(b), "v"(c)); return r; }
DEV float max2f_s(float a, float b) { float r; asm("v_max_f32_e32 %0, %1, %2" : "=v"(r) : "v"(a), "v"(b)); return r; }
DEV float fadd_s(float a, float b) { float r; asm("v_add_f32_e32 %0, %1, %2" : "=v"(r) : "v"(a), "v"(b)); return r; }
DEV float sum8_after_trans(float a, float b, float c, float d, float e, float f, float g, float h) {
    float r, t;
    asm("s_nop 0\n\tv_add_f32_e32 %0, %2, %3\n\tv_add_f32_e32 %1, %4, %5\n\tv_add_f32_e32 %0, %0, %6\n\tv_add_f32_e32 %1, %1, %7\n\tv_add_f32_e32 %0, %0, %8\n\tv_add_f32_e32 %1, %1, %9\n\tv_add_f32_e32 %0, %0, %1"
        : "=&v"(r), "=&v"(t) : "v"(a), "v"(b), "v"(c), "v"(d), "v"(e), "v"(f), "v"(g), "v"(h));
    return r;
}
DEV float swapmax32(float v) { auto rr = __builtin_amdgcn_permlane32_swap(__float_as_uint(v), __float_as_uint(v), false, false); return fmaxf(__uint_as_float(rr[0]), __uint_as_float(rr[1])); }
DEV float swapsum32(float v) { auto rr = __builtin_amdgcn_permlane32_swap(__float_as_uint(v), __float_as_uint(v), false, false); return __uint_as_float(rr[0]) + __uint_as_float(rr[1]); }
template <int DQK>
DEV void attn_unit2(char* lds, const bf16_t* __restrict__ Q, int ldq, int qcol, const bf16_t* __restrict__ Kp, int ldk, int kcol, const bf16_t* __restrict__ Vp, int ldv, int vcol,
                    const bf16_t* __restrict__ Gt, bf16_t* OG, int ocol, int b, int q0) {
    constexpr int KRS = (DQK + 8) * 2, KB = 64 * KRS, VRS = 192, VB = 64 * VRS, NKS = DQK / 16, KCH = DQK / 8, VOFF = 2 * KB;
    constexpr float THR = 8.0f;
    constexpr int NT = LK / 64;
    const int tid = TID(), lane = tid & 63, wid = tid >> 6, l31 = lane & 31, hi = lane >> 5;
    bf16x8 qf[NKS];
    { const bf16_t* qp = Q + (size_t)(b * SEQ + q0 + wid * 32 + l31) * ldq + qcol + hi * 8;
#pragma unroll
        for (int ks = 0; ks < NKS; ++ks) qf[ks] = *(const bf16x8*)(qp + ks * 16); }
    const bf16_t* kbase = Kp + (size_t)b * LK * ldk + kcol; const bf16_t* vbase = Vp + (size_t)b * LK * ldv + vcol;
    constexpr bool K2 = (KCH * 64 > 512);
    const bool k2 = K2 && (tid + 512 < KCH * 64);
    const int kr0 = tid / KCH, kc0 = tid % KCH, kr1 = k2 ? (tid + 512) / KCH : kr0, kc1 = k2 ? (tid + 512) % KCH : kc0;
    const int vr = tid >> 3, vc = tid & 7;
    u32x4 skX0, skX1 = {0u, 0u, 0u, 0u}, svX;
#define A_LOADK(t, S) do { const int tt_ = (t) < NT ? (t) : NT - 1; const size_t kp_ = (size_t)tt_ * 64; sk##S##0 = *(const u32x4*)(kbase + (kp_ + kr0) * ldk + kc0 * 8); if (K2) sk##S##1 = *(const u32x4*)(kbase + (kp_ + kr1) * ldk + kc1 * 8); } while (0)
#define A_LOADV(t, S) do { const int tt_ = (t) < NT ? (t) : NT - 1; sv##S = *(const u32x4*)(vbase + ((size_t)tt_ * 64 + vr) * ldv + vc * 8); } while (0)
#define A_STOREK(slot, S) do { char* b_ = lds + (slot) * KB; *(u32x4*)(b_ + kr0 * KRS + kc0 * 16) = sk##S##0; if (K2) *(u32x4*)(b_ + kr1 * KRS + kc1 * 16) = sk##S##1; } while (0)
#define A_STOREV(slot, S) do { *(u32x4*)(lds + VOFF + (slot) * VB + vr * VRS + vc * 16) = sv##S; } while (0)
    f32x16 o0, o1, negm;
#pragma unroll
    for (int r = 0; r < 16; ++r) { o0[r] = 0.f; o1[r] = 0.f; negm[r] = 0.f; }
    asm volatile("" : "+v"(negm));
    float mhat = 0.f, l_run = 0.f;
    const int g1 = (lane >> 4) & 1, tq = (lane & 15) >> 2, tp = lane & 3;
    const int vt_off = VOFF + (4 * hi + tq) * VRS + (16 * g1 + 4 * tp) * 2;
    const int kf_off = l31 * KRS + hi * 16;
#define A_QK(P0, P1, slot) do { const char* kb_ = lds + (slot) * KB + kf_off; \
        _Pragma("unroll") for (int ks = 0; ks < NKS; ++ks) { \
            const bf16x8 ka = *(const bf16x8*)(kb_ + ks * 32); const bf16x8 kb2 = *(const bf16x8*)(kb_ + 32 * KRS + ks * 32); \
            if (ks == 0) { P0 = __builtin_amdgcn_mfma_f32_32x32x16_bf16(ka, qf[0], negm, 0, 0, 0); P1 = __builtin_amdgcn_mfma_f32_32x32x16_bf16(kb2, qf[0], negm, 0, 0, 0); } \
            else { P0 = __builtin_amdgcn_mfma_f32_32x32x16_bf16(ka, qf[ks], P0, 0, 0, 0); P1 = __builtin_amdgcn_mfma_f32_32x32x16_bf16(kb2, qf[ks], P1, 0, 0, 0); } } } while (0)
    A_LOADK(0, X); A_LOADV(0, X); A_STOREK(0, X); A_STOREV(0, X); A_LOADK(1, X); A_STOREK(1, X);
    __syncthreads();
    f32x16 pA0, pA1, pB0, pB1;
#pragma unroll
    for (int r = 0; r < 16; ++r) { pB0[r] = 0.f; pB1[r] = 0.f; }
    A_QK(pA0, pA1, 0);
#define A_STEP(P0, P1, N0, N1, t, SL, SS) do { \
        A_LOADK((t) + 2, SL); A_LOADV((t) + 1, SL); \
        __builtin_amdgcn_s_setprio(1); A_QK(N0, N1, ((t) + 1) & 1); __builtin_amdgcn_s_setprio(0); \
        float a_ = fmaxf(fmaxf(P0[0], P0[1]), P1[0]), c_ = fmaxf(fmaxf(P0[2], P0[3]), P1[1]); a_ = fmaxf(fmaxf(a_, P1[2]), P1[3]); \
        _Pragma("unroll") for (int r = 4; r < 16; r += 4) { a_ = fmaxf(fmaxf(a_, P0[r]), P0[r + 1]); c_ = fmaxf(fmaxf(c_, P0[r + 2]), P0[r + 3]); a_ = fmaxf(fmaxf(a_, P1[r]), P1[r + 1]); c_ = fmaxf(fmaxf(c_, P1[r + 2]), P1[r + 3]); } \
        const float rm = swapmax32(fmaxf(a_, c_)); \
        if ((t) == 0 || __any(rm > THR)) { \
            const float dl = ((t) == 0) ? rm : fmaxf(rm, 0.f); mhat += dl; \
            _Pragma("unroll") for (int r = 0; r < 16; ++r) { P0[r] -= dl; P1[r] -= dl; N0[r] -= dl; N1[r] -= dl; } \
            if ((t) != 0) { const float f = __builtin_amdgcn_exp2f(-dl); l_run *= f; _Pragma("unroll") for (int r = 0; r < 16; ++r) { o0[r] *= f; o1[r] *= f; } } \
            _Pragma("unroll") for (int r = 0; r < 16; ++r) negm[r] = -mhat; asm volatile("" : "+v"(negm)); } \
        _Pragma("unroll") for (int r = 0; r < 16; ++r) { P0[r] = __builtin_amdgcn_exp2f(P0[r]); P1[r] = __builtin_amdgcn_exp2f(P1[r]); } \
        { const float q0_ = sum8_after_trans(P0[0], P0[1], P0[2], P0[3], P0[4], P0[5], P0[6], P0[7]), q1_ = sum8_after_trans(P0[8], P0[9], P0[10], P0[11], P0[12], P0[13], P0[14], P0[15]); \
          const float q2_ = sum8_after_trans(P1[0], P1[1], P1[2], P1[3], P1[4], P1[5], P1[6], P1[7]), q3_ = sum8_after_trans(P1[8], P1[9], P1[10], P1[11], P1[12], P1[13], P1[14], P1[15]); \
          l_run += (q0_ + q1_) + (q2_ + q3_); } \
        u32x4 pw[4]; \
        pw[0] = (u32x4){pk2(P0[0], P0[1]), pk2(P0[2], P0[3]), pk2(P0[4], P0[5]), pk2(P0[6], P0[7])}; \
        pw[1] = (u32x4){pk2(P0[8], P0[9]), pk2(P0[10], P0[11]), pk2(P0[12], P0[13]), pk2(P0[14], P0[15])}; \
        pw[2] = (u32x4){pk2(P1[0], P1[1]), pk2(P1[2], P1[3]), pk2(P1[4], P1[5]), pk2(P1[6], P1[7])}; \
        pw[3] = (u32x4){pk2(P1[8], P1[9]), pk2(P1[10], P1[11]), pk2(P1[12], P1[13]), pk2(P1[14], P1[15])}; \
        { const char* vb_ = lds + ((t) & 1) * VB + vt_off; \
        _Pragma("unroll") for (int s = 0; s < 4; ++s) { const bf16x8 pb = __builtin_bit_cast(bf16x8, pw[s]); \
            _Pragma("unroll") for (int dt = 0; dt < 2; ++dt) { const char* vp = vb_ + s * 16 * VRS + dt * 64; \
                const s16x4 lo = __builtin_bit_cast(s16x4, __builtin_amdgcn_ds_read_tr16_b64_v4i16((LAS s16x4*)vp)); \
                const s16x4 hh = __builtin_bit_cast(s16x4, __builtin_amdgcn_ds_read_tr16_b64_v4i16((LAS s16x4*)(vp + 8 * VRS))); \
                const bf16x8 vf = (bf16x8){lo[0], lo[1], lo[2], lo[3], hh[0], hh[1], hh[2], hh[3]}; \
                if (dt == 0) o0 = __builtin_amdgcn_mfma_f32_32x32x16_bf16(vf, pb, o0, 0, 0, 0); else o1 = __builtin_amdgcn_mfma_f32_32x32x16_bf16(vf, pb, o1, 0, 0, 0); } } } \
        A_STOREK((t) & 1, SS); A_STOREV(((t) + 1) & 1, SS); \
        __syncthreads(); } while (0)
    for (int t = 0; t < NT; t += 2) {
        A_STEP(pA0, pA1, pB0, pB1, t, X, X);
        A_STEP(pB0, pB1, pA0, pA1, t + 1, X, X);
    }
#undef A_STEP
#undef A_QK
#undef A_LOADK
#undef A_LOADV
#undef A_STOREK
#undef A_STOREV
    const float inv = 1.0f / swapsum32(l_run);
    const size_t tok = (size_t)(b * SEQ + q0 + wid * 32 + l31);
#pragma unroll
    for (int dt = 0; dt < 2; ++dt)
#pragma unroll
        for (int g = 0; g < 4; ++g) { const int d = 32 * dt + 8 * g + 4 * hi; const size_t off = tok * 1024 + ocol + d;
            const u32x2 gw = *(const u32x2*)(Gt + off);
            const f32x16& oo = dt ? o1 : o0;
            u32x2 w; w.x = pk2(oo[4 * g] * inv * lo_bf(gw.x), oo[4 * g + 1] * inv * hi_bf(gw.x)); w.y = pk2(oo[4 * g + 2] * inv * lo_bf(gw.y), oo[4 * g + 3] * inv * hi_bf(gw.y));
            *(u32x2*)(OG + off) = w; }
}

namespace at3 {
typedef LAS const char* lds_cptr;
constexpr int SLOTV = 8192;
DEV void glds16(const void* gsrc, unsigned lds_dst) { unsigned keep;
    asm volatile("s_mov_b32 %0, m0\n\ts_mov_b32 m0, %2\n\ts_nop 0\n\tglobal_load_lds_dwordx4 %1, off\n\ts_mov_b32 m0, %0" : "=&s"(keep) : "v"(gsrc), "s"(lds_dst) : "memory"); }
DEV float fsub_s(float a, float b) { float r; asm("v_sub_f32_e32 %0, %1, %2" : "=v"(r) : "v"(a), "v"(b)); return r; }
DEV s16x4 vtr(lds_cptr p) { return __builtin_bit_cast(s16x4, __builtin_amdgcn_ds_read_tr16_b64_v4i16((LAS s16x4*)p)); }
DEV void kload2(bf16x8* kf, lds_cptr kp, int j) { kf[2 * j] = *(const LAS bf16x8*)(kp + j * 2048); kf[2 * j + 1] = *(const LAS bf16x8*)(kp + j * 2048 + 512); }
DEV float rowmax(const f32x16& p0, const f32x16& p1) {
    float a = max3f_s(p0[0], p0[1], p1[0]), b = max3f_s(p0[2], p0[3], p1[1]); a = max3f_s(a, p1[2], p1[3]);
#pragma unroll
    for (int r = 4; r < 16; r += 4) { a = max3f_s(a, p0[r], p0[r + 1]); b = max3f_s(b, p0[r + 2], p0[r + 3]); a = max3f_s(a, p1[r], p1[r + 1]); b = max3f_s(b, p1[r + 2], p1[r + 3]); }
    const float m = max2f_s(a, b);
    auto rr = __builtin_amdgcn_permlane32_swap(__float_as_uint(m), __float_as_uint(m), false, false);
    return max2f_s(__uint_as_float(rr[0]), __uint_as_float(rr[1]));
}
DEV void pv(f32x16* o, int vb, bf16x8 pa0, bf16x8 pa1, bf16x8 pa2, bf16x8 pa3) {
#pragma unroll
    for (int d0 = 0; d0 < 2; ++d0) { s16x4 lo[4], hi[4];
#pragma unroll
        for (int ks = 0; ks < 4; ++ks) {
            asm volatile("ds_read_b64_tr_b16 %0,%1 offset:%c2" : "=&v"(lo[ks]) : "v"(vb), "i"(d0 * 4096 + ks * 1024) : "memory");
            asm volatile("ds_read_b64_tr_b16 %0,%1 offset:%c2" : "=&v"(hi[ks]) : "v"(vb), "i"(d0 * 4096 + ks * 1024 + 512) : "memory"); }
        asm volatile("s_waitcnt lgkmcnt(0)" ::: "memory"); __builtin_amdgcn_sched_barrier(0);
#define AT_PK(k) (bf16x8){lo[k][0], lo[k][1], lo[k][2], lo[k][3], hi[k][0], hi[k][1], hi[k][2], hi[k][3]}
        o[d0] = __builtin_amdgcn_mfma_f32_32x32x16_bf16(pa0, AT_PK(0), o[d0], 0, 0, 0);
        o[d0] = __builtin_amdgcn_mfma_f32_32x32x16_bf16(pa1, AT_PK(1), o[d0], 0, 0, 0);
        o[d0] = __builtin_amdgcn_mfma_f32_32x32x16_bf16(pa2, AT_PK(2), o[d0], 0, 0, 0);
        o[d0] = __builtin_amdgcn_mfma_f32_32x32x16_bf16(pa3, AT_PK(3), o[d0], 0, 0, 0);
#undef AT_PK
    }
}
#define AT_SBAR() __builtin_amdgcn_sched_barrier(0)
#define AT_WAIT_BAR(N) asm volatile("s_waitcnt vmcnt(%c0) lgkmcnt(0)\n\ts_barrier" :: "i"(N) : "memory")
#define AT_MFMA(a, b, c) __builtin_amdgcn_mfma_f32_32x32x16_bf16(a, b, c, 0, 0, 0)

template <int DQK>
DEV void attn_unit3(char* shm, const bf16_t* __restrict__ Q, int ldq, int qcol, const bf16_t* __restrict__ Kp, int ldk, int kcol, const bf16_t* __restrict__ Vp, int ldv, int vcol,
                    const bf16_t* __restrict__ Gt, bf16_t* OG, int ocol, int b, int q0) {
    constexpr int NKS = DQK / 16, KD = (DQK > 64) ? 2 : 1, SLOTK = DQK * 128;
    constexpr int L_K = 0, L_V = 3 * SLOTK, L_WS = L_V + 3 * SLOTV, L_OST = L_WS + 8 * 256;
    constexpr int NT = LK / 64;
    constexpr float THRL = 8.0f;
    const int tid = TID(), lane = tid & 63, r32 = lane & 31, hi = lane >> 5; const int wid = __builtin_amdgcn_readfirstlane(tid >> 6);
    const bf16_t* Qw = Q + (size_t)(b * SEQ + q0 + wid * 32) * ldq + qcol;
    const bf16_t* Kh = Kp + (size_t)b * LK * ldk + kcol; const bf16_t* Vh = Vp + (size_t)b * LK * ldv + vcol;
    const unsigned lds0 = (unsigned)(uintptr_t)shm;
    float* wsf = (float*)(shm + L_WS) + wid * 64;
    const bf16_t* ksrc = Kh + (size_t)lane * ldk + wid * 8;
    const int k2el = (8 + (wid & 3) - wid) * 8;
    const bf16_t* vsrc = Vh + (size_t)(16 * (wid & 3) + (lane >> 2)) * ldv + (wid >> 2) * 32 + (lane & 3) * 8;
    const unsigned kdst = lds0 + L_K + wid * 1024, kdst2 = lds0 + L_K + (8 + (wid & 3)) * 1024, vdst = lds0 + L_V + wid * 1024;
#define KOFF(sl) ((DQK == 64) ? (sl) : ((sl) + ((sl) >> 1)))
#define DMA_K(t, sl) do { const bf16_t* s_ = ksrc + (size_t)(t) * 64 * ldk; glds16(s_, (unsigned)__builtin_amdgcn_readfirstlane(kdst + KOFF(sl))); \
        if (KD == 2) glds16(s_ + k2el, (unsigned)__builtin_amdgcn_readfirstlane(kdst2 + KOFF(sl))); } while (0)
#define DMA_V(t, sl) glds16(vsrc + (size_t)(t) * 64 * ldv, (unsigned)__builtin_amdgcn_readfirstlane(vdst + (sl)))
    const int vb0 = (int)(lds0 + L_V) + ((lane >> 4) & 1) * 32 + (lane & 3) * 8 + (4 * hi + ((lane & 15) >> 2)) * 64;
    bf16x8 kf[2 * NKS];
    const lds_cptr shm3 = (lds_cptr)shm; const lds_cptr kp0 = shm3 + L_K + hi * 1024 + r32 * 16;
    const lds_cptr vp0 = shm3 + L_V + ((lane >> 4) & 1) * 32 + (lane & 3) * 8 + (4 * hi + ((lane & 15) >> 2)) * 64;
    DMA_K(0, 0); DMA_V(0, 0); DMA_K(1, SLOTV);
    bf16x8 qr[NKS];
#pragma unroll
    for (int d0 = 0; d0 < NKS; ++d0) qr[d0] = *(const bf16x8*)(Qw + (size_t)r32 * ldq + d0 * 16 + hi * 8);
    float mhat = 0.f, l_reg = 0.f; f32x16 o[2]; o[0] = f32x16{}; o[1] = f32x16{}; f32x16 negm = f32x16{}; asm volatile("" : "+v"(negm));
    bool resc = false;
#define RESC() do { if (resc) { asm volatile("s_waitcnt lgkmcnt(0)" ::: "memory"); \
        _Pragma("unroll") for (int d_ = 0; d_ < 2; ++d_) _Pragma("unroll") for (int r = 0; r < 16; ++r) o[d_][r] *= wsf[crow(r, hi)]; } } while (0)
    f32x16 pA0, pA1, pB0, pB1;
    int sl_prev = 0, sl_cur = 0, sl_next = SLOTV;
#define ROT() do { sl_prev = sl_cur; sl_cur = sl_next; sl_next = (sl_next == 2 * SLOTV) ? 0 : sl_next + SLOTV; } while (0)
    DMA_K(2, 2 * SLOTV);
    AT_WAIT_BAR(1 + 2 * KD);
    {
#pragma unroll
        for (int d0 = 0; d0 < NKS; ++d0) {
            const bf16x8 b0 = *(const LAS bf16x8*)(kp0 + d0 * 2048); const bf16x8 b1 = *(const LAS bf16x8*)(kp0 + d0 * 2048 + 512);
            if (d0 == 0) { pA0 = AT_MFMA(b0, qr[0], negm); pA1 = AT_MFMA(b1, qr[0], negm); } else { pA0 = AT_MFMA(b0, qr[d0], pA0); pA1 = AT_MFMA(b1, qr[d0], pA1); } }
        asm volatile("s_nop 15\n\ts_nop 7" : "+v"(pA0), "+v"(pA1));
        const float rm = rowmax(pA0, pA1);
        mhat = fadd_s(mhat, rm);
#pragma unroll
        for (int r = 0; r < 16; ++r) { pA0[r] = fsub_s(pA0[r], rm); pA1[r] = fsub_s(pA1[r], rm); }
#pragma unroll
        for (int r = 0; r < 16; ++r) negm[r] = -mhat;
        asm volatile("" : "+v"(negm));
#pragma unroll
        for (int r = 0; r < 16; ++r) pA0[r] = __builtin_amdgcn_exp2f(pA0[r]);
#pragma unroll
        for (int r = 0; r < 16; ++r) pA1[r] = __builtin_amdgcn_exp2f(pA1[r]);
    }
    AT_WAIT_BAR(0);
    DMA_K(3, 0); DMA_V(1, SLOTV);
    ROT();
#pragma unroll
    for (int j = 0; j < NKS; ++j) kload2(kf, kp0 + KOFF(sl_cur), j);
    AT_WAIT_BAR(KD + 1);
    s16x4 vlo[8], vhi[8]; u32x4 pw0, pw1, pw2, pw3;
#define PKW(P, B) pk2(P[B], P[B + 1])
#define PAF(k) __builtin_bit_cast(bf16x8, pw##k)
#define VFR(i) (bf16x8){vlo[i][0], vlo[i][1], vlo[i][2], vlo[i][3], vhi[i][0], vhi[i][1], vhi[i][2], vhi[i][3]}
#define PIN(x) asm volatile("" : "+v"(x))
#define MX3(a, b, c) __builtin_fmaxf(__builtin_fmaxf((a), (b)), (c))
#define GAPA(MF, A0, A1, A2, A3, W0, W1, PW) do { MF; sacc += A0; sacc += A1; sacc += A2; sacc += A3; PIN(sacc); W0; W1; PIN(PW); AT_SBAR(); } while (0)
#define EX(v) __builtin_amdgcn_exp2f(v)
#define GAPB(MF, X, B) do { MF; X[B] = EX(X[B]); X[B + 1] = EX(X[B + 1]); X[B + 2] = EX(X[B + 2]); X[B + 3] = EX(X[B + 3]); PIN(X); AT_SBAR(); } while (0)
#define VRD(i) do { vlo[i] = vtr(vp_ + (((i) >> 2) * 4096 + ((i) & 3) * 1024)); vhi[i] = vtr(vp_ + (((i) >> 2) * 4096 + ((i) & 3) * 1024 + 512)); } while (0)
#define KRD(G, j) do { if (G) { kload2(kf, kp0 + KOFF(sl_next), j); AT_SBAR(); } } while (0)
#define STEP(C0, C1, P0, P1, t, GK, GV, GL) do { AT_SBAR(); \
    const lds_cptr vp_ = vp0 + sl_prev; \
    VRD(0); AT_SBAR(); float sacc = (P0[0] + P0[1]); \
    GAPA(C0 = AT_MFMA(kf[0], qr[0], negm), P0[2], P0[3], P0[4], P0[5], pw0[0] = PKW(P0, 0), pw0[1] = PKW(P0, 2), pw0); \
    VRD(4); AT_SBAR(); GAPA(C1 = AT_MFMA(kf[1], qr[0], negm), P0[6], P0[7], P0[8], P0[9], pw0[2] = PKW(P0, 4), pw0[3] = PKW(P0, 6), pw0); \
    VRD(1); AT_SBAR(); GAPA(C0 = AT_MFMA(kf[2], qr[1], C0), P0[10], P0[11], P0[12], P0[13], pw1[0] = PKW(P0, 8), pw1[1] = PKW(P0, 10), pw1); \
    VRD(5); AT_SBAR(); GAPA(C1 = AT_MFMA(kf[3], qr[1], C1), P0[14], P0[15], P1[0], P1[1], pw1[2] = PKW(P0, 12), pw1[3] = PKW(P0, 14), pw1); \
    VRD(2); AT_SBAR(); GAPA(C0 = AT_MFMA(kf[4], qr[2], C0), P1[2], P1[3], P1[4], P1[5], pw2[0] = PKW(P1, 0), pw2[1] = PKW(P1, 2), pw2); \
    VRD(6); AT_SBAR(); GAPA(C1 = AT_MFMA(kf[5], qr[2], C1), P1[6], P1[7], P1[8], P1[9], pw2[2] = PKW(P1, 4), pw2[3] = PKW(P1, 6), pw2); \
    VRD(3); AT_SBAR(); GAPA(C0 = AT_MFMA(kf[6], qr[3], C0), P1[10], P1[11], P1[12], P1[13], pw3[0] = PKW(P1, 8), pw3[1] = PKW(P1, 10), pw3); \
    VRD(7); AT_SBAR(); GAPA(C1 = AT_MFMA(kf[7], qr[3], C1), P1[14], P1[15], 0.f, 0.f, pw3[2] = PKW(P1, 12), pw3[3] = PKW(P1, 14), pw3); \
    if (NKS == 6) { C0 = AT_MFMA(kf[8 % (2 * NKS)], qr[4 % NKS], C0); AT_SBAR(); C1 = AT_MFMA(kf[9 % (2 * NKS)], qr[4 % NKS], C1); AT_SBAR(); \
                    C0 = AT_MFMA(kf[10 % (2 * NKS)], qr[5 % NKS], C0); AT_SBAR(); C1 = AT_MFMA(kf[11 % (2 * NKS)], qr[5 % NKS], C1); AT_SBAR(); } \
    l_reg += sacc; \
    if (GK) { DMA_K((t) + 3, sl_cur); } if (GV) { DMA_V((t) + 1, sl_next); } \
    { float a = MX3(C0[0], C0[1], C1[0]), b_ = MX3(C0[2], C0[3], C1[1]); a = MX3(a, C1[2], C1[3]); \
      _Pragma("unroll") for (int r = 4; r < 16; r += 4) { a = MX3(a, C0[r], C0[r + 1]); b_ = MX3(b_, C0[r + 2], C0[r + 3]); a = MX3(a, C1[r], C1[r + 1]); b_ = MX3(b_, C1[r + 2], C1[r + 3]); } \
      float rm = __builtin_fmaxf(a, b_); { auto rr = __builtin_amdgcn_permlane32_swap(__float_as_uint(rm), __float_as_uint(rm), false, false); rm = __builtin_fmaxf(__uint_as_float(rr[0]), __uint_as_float(rr[1])); } \
      resc = false; \
      if (__builtin_expect(__any(rm > THRL), 0)) { const float dl = __builtin_fmaxf(rm, 0.f); mhat += dl; \
        _Pragma("unroll") for (int r = 0; r < 16; ++r) { C0[r] -= dl; C1[r] -= dl; } \
        _Pragma("unroll") for (int r = 0; r < 16; ++r) negm[r] = -mhat; asm volatile("" : "+v"(negm)); \
        const float f = __builtin_amdgcn_exp2f(-dl); l_reg *= f; if (hi == 0) wsf[r32] = f; resc = true; } } \
    AT_SBAR(); \
    GAPB(o[0] = AT_MFMA(PAF(0), VFR(0), o[0]), C0, 0); \
    GAPB(o[1] = AT_MFMA(PAF(0), VFR(4), o[1]), C0, 4); \
    KRD(GL, 0); GAPB(o[0] = AT_MFMA(PAF(1), VFR(1), o[0]), C0, 8); \
    KRD(GL, 1); GAPB(o[1] = AT_MFMA(PAF(1), VFR(5), o[1]), C0, 12); \
    KRD(GL, 2); GAPB(o[0] = AT_MFMA(PAF(2), VFR(2), o[0]), C1, 0); \
    KRD(GL, 3); GAPB(o[1] = AT_MFMA(PAF(2), VFR(6), o[1]), C1, 4); \
    if (NKS == 6) KRD(GL, 4 % NKS); GAPB(o[0] = AT_MFMA(PAF(3), VFR(3), o[0]), C1, 8); \
    if (NKS == 6) KRD(GL, 5 % NKS); GAPB(o[1] = AT_MFMA(PAF(3), VFR(7), o[1]), C1, 12); \
    } while (0)
    int t = 1;
    for (; t + 5 < NT; t += 2) {
        STEP(pB0, pB1, pA0, pA1, t, true, true, true);     AT_WAIT_BAR(KD + 1); RESC(); ROT();
        STEP(pA0, pA1, pB0, pB1, t + 1, true, true, true); AT_WAIT_BAR(KD + 1); RESC(); ROT();
    }
#define ENDW(tt) do { if ((tt) + 3 < NT) { AT_WAIT_BAR(KD + 1); } else if ((tt) + 2 < NT) { AT_WAIT_BAR(1); } else { AT_WAIT_BAR(0); } } while (0)
    for (; t + 1 < NT; t += 2) {
        STEP(pB0, pB1, pA0, pA1, t, (t + 3 < NT), (t + 1 < NT), (t + 1 < NT));         ENDW(t);     RESC(); ROT();
        STEP(pA0, pA1, pB0, pB1, t + 1, (t + 4 < NT), (t + 2 < NT), (t + 2 < NT));     ENDW(t + 1); RESC(); ROT();
    }
    STEP(pB0, pB1, pA0, pA1, NT - 1, false, false, false); RESC();
    { float sacc = pB0[0] + pB0[1];
#pragma unroll
      for (int r = 2; r < 16; ++r) sacc += pB0[r];
#pragma unroll
      for (int r = 0; r < 16; ++r) sacc += pB1[r];
      l_reg += sacc;
      pw0 = (u32x4){PKW(pB0, 0), PKW(pB0, 2), PKW(pB0, 4), PKW(pB0, 6)}; pw1 = (u32x4){PKW(pB0, 8), PKW(pB0, 10), PKW(pB0, 12), PKW(pB0, 14)};
      pw2 = (u32x4){PKW(pB1, 0), PKW(pB1, 2), PKW(pB1, 4), PKW(pB1, 6)}; pw3 = (u32x4){PKW(pB1, 8), PKW(pB1, 10), PKW(pB1, 12), PKW(pB1, 14)};
      AT_SBAR(); pv(o, vb0 + sl_cur, PAF(0), PAF(1), PAF(2), PAF(3)); }
#undef PKW
#undef PAF
#undef VFR
#undef PIN
#undef MX3
#undef GAPA
#undef GAPB
#undef EX
#undef VRD
#undef KRD
#undef STEP
#undef ENDW
    { auto rr = __builtin_amdgcn_permlane32_swap(__float_as_uint(l_reg), __float_as_uint(l_reg), false, false); l_reg = __uint_as_float(rr[0]) + __uint_as_float(rr[1]); }
    if (hi == 0) wsf[32 + r32] = l_reg; asm volatile("s_waitcnt lgkmcnt(0)" ::: "memory");
    float rli[16];
#pragma unroll
    for (int r = 0; r < 16; ++r) rli[r] = __builtin_amdgcn_rcpf(wsf[32 + crow(r, hi)]);
    { bf16_t* stg = (bf16_t*)(shm + L_OST) + wid * 2048;
#pragma unroll
      for (int r = 0; r < 16; ++r) { const int orow = crow(r, hi);
#pragma unroll
          for (int d0 = 0; d0 < 2; ++d0) stg[orow * 64 + d0 * 32 + r32] = f2bf(o[d0][r] * rli[r]); }
      asm volatile("s_waitcnt lgkmcnt(0)" ::: "memory");
      const size_t tok0 = (size_t)(b * SEQ + q0 + wid * 32);
#pragma unroll
      for (int i = 0; i < 4; ++i) { const int row = i * 8 + (lane >> 3), ch = lane & 7; const u32x4 v = *(const u32x4*)(stg + row * 64 + ch * 8);
          const size_t off = (tok0 + row) * 1024 + ocol + ch * 8; const u32x4 g = *(const u32x4*)(Gt + off);
          u32x4 w; w.x = pk2(lo_bf(v.x) * lo_bf(g.x), hi_bf(v.x) * hi_bf(g.x)); w.y = pk2(lo_bf(v.y) * lo_bf(g.y), hi_bf(v.y) * hi_bf(g.y));
          w.z = pk2(lo_bf(v.z) * lo_bf(g.z), hi_bf(v.z) * hi_bf(g.z)); w.w = pk2(lo_bf(v.w) * lo_bf(g.w), hi_bf(v.w) * hi_bf(g.w));
          *(u32x4*)(OG + off) = w; } }
    asm volatile("s_waitcnt vmcnt(0) lgkmcnt(0)\n\ts_barrier" ::: "memory");
#undef DMA_K
#undef DMA_V
#undef KOFF
#undef RESC
#undef ROT
}
#undef AT_SBAR
#undef AT_WAIT_BAR
#undef AT_MFMA
}

DEV void phase_attn(char* lds, const Params& p) {
    const bf16_t* QA = (const bf16_t*)(p.ws + WS_QA); const bf16_t* KA = (const bf16_t*)(p.ws + WS_KA); const bf16_t* VA = (const bf16_t*)(p.ws + WS_VA);
    const bf16_t* QM = (const bf16_t*)(p.ws + WS_QM); const bf16_t* KM = (const bf16_t*)(p.ws + WS2_KM); const bf16_t* VM = (const bf16_t*)(p.ws + WS2_VM);
    const bf16_t* G = (const bf16_t*)(p.ws + WS_G); bf16_t* OG = (bf16_t*)(p.ws + WS2_OG);
    const int vblk = (gridDim.x % 8 == 0) ? (int)((blockIdx.x % 8) * (gridDim.x / 8) + blockIdx.x / 8) : (int)blockIdx.x;
    for (int u = vblk; u < 2048; u += gridDim.x) {
        const int type = u >> 10, rem = u & 1023, b = rem >> 7, h = (rem >> 4) & 7, qb = rem & 15;
        if (type == 0) at3::attn_unit3<64>(lds, QA, 512, h * 64, KA, 128, (h >> 2) * 64, VA, 128, (h >> 2) * 64, G, OG, h * 64, b, qb * 256);
        else attn_unit2<96>(lds, QM, 768, h * 96, KM, 768, h * 96, VM, 512, h * 64, G, OG, 512 + h * 64, b, qb * 256);
    }
}

constexpr int CV_PADL = 192, CV_ROW = 4488, CV_RS = CV_ROW * 2;
constexpr int CV_UB = 8 * CV_RS;
constexpr int CV_FS = 16416;
DEV void conv_load_filter(char* lds, const bf16_t* gr) {
    const int tid = TID();
#pragma unroll
    for (int rnd = 0; rnd < 2; ++rnd) {
        const int ch = tid + rnd * 512;
        const u32x4 a = *(const u32x4*)(gr + ch * 8);
        u32x4 bq = {0u, 0u, 0u, 0u}; if (ch + 1 < 1024) bq = *(const u32x4*)(gr + ch * 8 + 8);
        const unsigned w[8] = {a.x, a.y, a.z, a.w, bq.x, bq.y, bq.z, bq.w};
        char* f = lds + CV_UB + ch * 16;
        *(u32x4*)(f) = a;
        u32x4 c1, c2, c3;
        c1.x = __builtin_amdgcn_alignbit(w[1], w[0], 16); c1.y = __builtin_amdgcn_alignbit(w[2], w[1], 16); c1.z = __builtin_amdgcn_alignbit(w[3], w[2], 16); c1.w = __builtin_amdgcn_alignbit(w[4], w[3], 16);
        c2 = (u32x4){w[1], w[2], w[3], w[4]};
        c3.x = __builtin_amdgcn_alignbit(w[2], w[1], 16); c3.y = __builtin_amdgcn_alignbit(w[3], w[2], 16); c3.z = __builtin_amdgcn_alignbit(w[4], w[3], 16); c3.w = __builtin_amdgcn_alignbit(w[5], w[4], 16);
        *(u32x4*)(f + CV_FS) = c1; *(u32x4*)(f + 2 * CV_FS) = c2; *(u32x4*)(f + 3 * CV_FS) = c3;
    }
}
DEV void sconv4(const bf16_t* px, int t, float w0, float w1, float w2, float bias, float* u) {
    const u32x2 mid = *(const u32x2*)(px + t);
    const float pm = (t > 0) ? bf2f(px[t - 1]) : 0.f, pp = (t + 4 < SEQ) ? bf2f(px[t + 4]) : 0.f;
    const float q0 = lo_bf(mid.x), q1 = hi_bf(mid.x), q2 = lo_bf(mid.y), q3 = hi_bf(mid.y);
    u[0] = w0 * pm + w1 * q0 + w2 * q1 + bias; u[1] = w0 * q0 + w1 * q1 + w2 * q2 + bias; u[2] = w0 * q1 + w1 * q2 + w2 * q3 + bias; u[3] = w0 * q2 + w1 * q3 + w2 * pp + bias;
}
template <bool V0, bool V1>
DEV void conv_step(const char* lds, f32x16 (&acc)[2][2], const int (&a_off)[2], const int (&b_off)[2], int d) {
    bf16x8 fa[2][4];
#pragma unroll
    for (int mt = 0; mt < 2; ++mt)
#pragma unroll
        for (int ks = 0; ks < 4; ++ks) { const char* ap = lds + a_off[mt] - 128 * d + ks * 32;
            const u32x2 lo = *(const u32x2*)ap, hh = *(const u32x2*)(ap + 8);
            fa[mt][ks] = __builtin_bit_cast(bf16x8, (u32x4){lo.x, lo.y, hh.x, hh.y}); }
#pragma unroll
    for (int n = 0; n < 2; ++n) {
        if ((n == 0 && V0) || (n == 1 && V1)) {
#pragma unroll
            for (int ks = 0; ks < 4; ++ks) { const bf16x8 fb = *(const bf16x8*)(lds + b_off[n] - 128 * d + ks * 32);
#pragma unroll
                for (int mt = 0; mt < 2; ++mt) acc[n][mt] = __builtin_amdgcn_mfma_f32_32x32x16_bf16(fa[mt][ks], fb, acc[n][mt], 0, 0, 0); }
        }
    }
}
struct ConvFrags { bf16x8 a[6], b0[4], b1[4]; };
DEV void conv_load_frags(ConvFrags& F, const char* lds, int a_off0, int a_off0h, int b_off0, int b_off1, int d) {
#pragma unroll
    for (int j = 0; j < 6; ++j) { const u32x2 lo = *(const u32x2*)(lds + a_off0 - 128 * d + (j - 2) * 32), hh = *(const u32x2*)(lds + a_off0h - 128 * d + (j - 2) * 32);
        F.a[j] = __builtin_bit_cast(bf16x8, (u32x4){lo.x, lo.y, hh.x, hh.y}); }
#pragma unroll
    for (int ks = 0; ks < 4; ++ks) { F.b0[ks] = *(const bf16x8*)(lds + b_off0 - 128 * d + ks * 32); F.b1[ks] = *(const bf16x8*)(lds + b_off1 - 128 * d + ks * 32); }
}
DEV void conv_mfma_frags(const ConvFrags& F, f32x16 (&acc)[2][2]) {
#pragma unroll
    for (int ks = 0; ks < 4; ++ks) {
        acc[0][0] = __builtin_amdgcn_mfma_f32_32x32x16_bf16(F.a[ks + 2], F.b0[ks], acc[0][0], 0, 0, 0);
        acc[0][1] = __builtin_amdgcn_mfma_f32_32x32x16_bf16(F.a[ks], F.b0[ks], acc[0][1], 0, 0, 0);
        acc[1][0] = __builtin_amdgcn_mfma_f32_32x32x16_bf16(F.a[ks + 2], F.b1[ks], acc[1][0], 0, 0, 0);
        acc[1][1] = __builtin_amdgcn_mfma_f32_32x32x16_bf16(F.a[ks], F.b1[ks], acc[1][1], 0, 0, 0);
    }
}
DEV void conv_mfma_loop(const char* lds, f32x16 (&acc)[2][2], int wid, int lane) {
    const int l31 = lane & 31, hi = lane >> 5;
#pragma unroll
    for (int a = 0; a < 2; ++a)
#pragma unroll
        for (int b = 0; b < 2; ++b)
#pragma unroll
            for (int r = 0; r < 16; ++r) acc[a][b][r] = 0.f;
    int a_off[2];
#pragma unroll
    for (int mt = 0; mt < 2; ++mt) { const int r = l31 + 32 * mt, q = (4 - (r & 3)) & 3; a_off[mt] = CV_UB + q * CV_FS + (4096 - r - q + 8 * hi) * 2; }
    int b_off[2];
#pragma unroll
    for (int n = 0; n < 2; ++n) { const int nt = 2 * wid + n; b_off[n] = (l31 & 7) * CV_RS + (CV_PADL + 64 * (4 * nt + (l31 >> 3)) + 8 * hi) * 2; }
    const int dlo = 8 * wid - 63;
#pragma unroll
    for (int j = 0; j < 4; ++j) conv_step<true, false>(lds, acc, a_off, b_off, dlo + j);
    ConvFrags F0, F1; const int d0 = dlo + 4; int a_hi = a_off[0] + 8; asm volatile("" : "+v"(a_hi));
    conv_load_frags(F0, lds, a_off[0], a_hi, b_off[0], b_off[1], d0);
#pragma unroll 1
    for (int j = 0; j < 31; ++j) { const int d = d0 + 2 * j;
        conv_load_frags(F1, lds, a_off[0], a_hi, b_off[0], b_off[1], d + 1); __builtin_amdgcn_sched_barrier(0);
        conv_mfma_frags(F0, acc); __builtin_amdgcn_sched_barrier(0);
        conv_load_frags(F0, lds, a_off[0], a_hi, b_off[0], b_off[1], d + 2); __builtin_amdgcn_sched_barrier(0);
        conv_mfma_frags(F1, acc); __builtin_amdgcn_sched_barrier(0); }
    conv_mfma_frags(F0, acc);
#pragma unroll
    for (int j = 0; j < 4; ++j) conv_step<false, true>(lds, acc, a_off, b_off, dlo + 67 + j);
}
DEV void conv_unit(char* lds, const Params& p, int c) {
    const int tid = TID(), lane = tid & 63, wid = tid >> 6, l31 = lane & 31, hi = lane >> 5;
    const bf16_t* PT = (const bf16_t*)(p.ws + WS_PT); const bf16_t* GR = (const bf16_t*)(p.ws + WS_GR); const float* ssum = (const float*)(p.ws + WS_SSUM);
    bf16_t* OG2 = (bf16_t*)(p.ws + WS_OG2);
    for (int i = tid; i < 8 * 98; i += 512) { const int b = i / 98, j = i % 98;
        const int e = (j < 48) ? j * 4 : (CV_PADL + SEQ + (j - 48) * 4); *(u32x2*)(lds + b * CV_RS + e * 2) = (u32x2){0u, 0u}; }
    { const float w0 = p.conv_w[c], w1 = p.conv_w[3072 + c], w2 = p.conv_w[6144 + c], bias = p.conv_b[c];
        for (int i = tid; i < 8 * 1024; i += 512) { const int b = i >> 10, t = (i & 1023) * 4; float u[4];
            sconv4(PT + ((size_t)(b * 4096 + c)) * 4096, t, w0, w1, w2, bias, u);
            u32x2 w; w.x = pk2(u[0], u[1]); w.y = pk2(u[2], u[3]); *(u32x2*)(lds + b * CV_RS + (CV_PADL + t) * 2) = w; } }
    conv_load_filter(lds, GR + (size_t)c * 8192);
    __syncthreads();
    f32x16 acc[2][2];
    conv_mfma_loop(lds, acc, wid, lane);
    __syncthreads();
    { const float invs = 1.0f / ssum[c], sk = p.skip[c];
        const float w0 = p.conv_w[1024 + c], w1 = p.conv_w[3072 + 1024 + c], w2 = p.conv_w[6144 + 1024 + c], bias = p.conv_b[1024 + c];
        const int b = l31 & 7;
#pragma unroll
        for (int n = 0; n < 2; ++n) { const int i = 4 * (2 * wid + n) + (l31 >> 3);
#pragma unroll
            for (int mt = 0; mt < 2; ++mt)
#pragma unroll
                for (int g = 0; g < 4; ++g) { const int t = 64 * i + 32 * mt + 8 * g + 4 * hi; float x1[4];
                    sconv4(PT + ((size_t)(b * 4096 + 1024 + c)) * 4096, t, w0, w1, w2, bias, x1);
                    char* up = lds + b * CV_RS + (CV_PADL + t) * 2; const u32x2 vw = *(const u32x2*)up;
                    const float z0 = x1[0] * (acc[n][mt][4 * g] * invs + sk * lo_bf(vw.x)), z1 = x1[1] * (acc[n][mt][4 * g + 1] * invs + sk * hi_bf(vw.x));
                    const float z2 = x1[2] * (acc[n][mt][4 * g + 2] * invs + sk * lo_bf(vw.y)), z3 = x1[3] * (acc[n][mt][4 * g + 3] * invs + sk * hi_bf(vw.y));
                    u32x2 w; w.x = pk2(z0, z1); w.y = pk2(z2, z3); *(u32x2*)up = w; } } }
    conv_load_filter(lds, GR + (size_t)(1024 + c) * 8192);
    __syncthreads();
    conv_mfma_loop(lds, acc, wid, lane);
    { const float invs = 1.0f / ssum[1024 + c], sk = p.skip[1024 + c];
        const float w0 = p.conv_w[2048 + c], w1 = p.conv_w[3072 + 2048 + c], w2 = p.conv_w[6144 + 2048 + c], bias = p.conv_b[2048 + c];
        const int b = l31 & 7;
#pragma unroll
        for (int n = 0; n < 2; ++n) { const int i = 4 * (2 * wid + n) + (l31 >> 3);
#pragma unroll
            for (int mt = 0; mt < 2; ++mt)
#pragma unroll
                for (int g = 0; g < 4; ++g) { const int t = 64 * i + 32 * mt + 8 * g + 4 * hi; float x2[4];
                    sconv4(PT + ((size_t)(b * 4096 + 2048 + c)) * 4096, t, w0, w1, w2, bias, x2);
                    const u32x2 zw = *(const u32x2*)(lds + b * CV_RS + (CV_PADL + t) * 2);
                    const u32x2 gw = *(const u32x2*)(PT + ((size_t)(b * 4096 + 3072 + c)) * 4096 + t);
                    const float y0 = x2[0] * (acc[n][mt][4 * g] * invs + sk * lo_bf(zw.x)) * silu(lo_bf(gw.x)), y1 = x2[1] * (acc[n][mt][4 * g + 1] * invs + sk * hi_bf(zw.x)) * silu(hi_bf(gw.x));
                    const float y2 = x2[2] * (acc[n][mt][4 * g + 2] * invs + sk * lo_bf(zw.y)) * silu(lo_bf(gw.y)), y3 = x2[3] * (acc[n][mt][4 * g + 3] * invs + sk * hi_bf(zw.y)) * silu(hi_bf(gw.y));
                    u32x2 w; w.x = pk2(y0, y1); w.y = pk2(y2, y3); *(u32x2*)(OG2 + ((size_t)(b * 1024 + c)) * 4096 + t) = w; } } }
    __syncthreads();
}

struct Raw3 { u32x2 mid; unsigned halo; };
DEV Raw3 ld_raw3(const bf16_t* px, int t) {
    Raw3 r; r.mid = *(const u32x2*)(px + t);
    const unsigned a = px[t - 1], b = px[t + 4];
    r.halo = (t > 0 ? a : 0u) | ((t + 4 < SEQ ? b : 0u) << 16);
    return r;
}
DEV void sconv_raw(const Raw3& r, float w0, float w1, float w2, float bias, float* u) {
    const float pm = lo_bf(r.halo), pp = hi_bf(r.halo), q0 = lo_bf(r.mid.x), q1 = hi_bf(r.mid.x), q2 = lo_bf(r.mid.y), q3 = hi_bf(r.mid.y);
    u[0] = w0 * pm + w1 * q0 + w2 * q1 + bias; u[1] = w0 * q0 + w1 * q1 + w2 * q2 + bias; u[2] = w0 * q1 + w1 * q2 + w2 * q3 + bias; u[3] = w0 * q2 + w1 * q3 + w2 * pp + bias;
}
struct FiltRegs { u32x4 a[2], b[2]; };
DEV void filt_load(FiltRegs& f, const bf16_t* gr, int tid) {
#pragma unroll
    for (int rnd = 0; rnd < 2; ++rnd) { const int ch = tid + rnd * 512; f.a[rnd] = *(const u32x4*)(gr + ch * 8);
        const int ch1 = ch + 1 < 1024 ? ch + 1 : ch; const u32x4 t = *(const u32x4*)(gr + ch1 * 8); f.b[rnd] = (ch + 1 < 1024) ? t : (u32x4){0u, 0u, 0u, 0u}; }
}
DEV void filt_store(char* lds, const FiltRegs& f, int tid) {
#pragma unroll
    for (int rnd = 0; rnd < 2; ++rnd) { const int ch = tid + rnd * 512; const u32x4 a = f.a[rnd], bq = f.b[rnd];
        const unsigned w[8] = {a.x, a.y, a.z, a.w, bq.x, bq.y, bq.z, bq.w};
        char* fp = lds + CV_UB + ch * 16;
        *(u32x4*)(fp) = a;
        u32x4 c1, c2, c3;
        c1.x = __builtin_amdgcn_alignbit(w[1], w[0], 16); c1.y = __builtin_amdgcn_alignbit(w[2], w[1], 16); c1.z = __builtin_amdgcn_alignbit(w[3], w[2], 16); c1.w = __builtin_amdgcn_alignbit(w[4], w[3], 16);
        c2 = (u32x4){w[1], w[2], w[3], w[4]};
        c3.x = __builtin_amdgcn_alignbit(w[2], w[1], 16); c3.y = __builtin_amdgcn_alignbit(w[3], w[2], 16); c3.z = __builtin_amdgcn_alignbit(w[4], w[3], 16); c3.w = __builtin_amdgcn_alignbit(w[5], w[4], 16);
        *(u32x4*)(fp + CV_FS) = c1; *(u32x4*)(fp + 2 * CV_FS) = c2; *(u32x4*)(fp + 3 * CV_FS) = c3; }
}
#define CV_T(k) (64 * (4 * (2 * wid + ((k) >> 3)) + (l31 >> 3)) + 32 * (((k) >> 2) & 1) + 8 * ((k) & 3) + 4 * hi)
#define CV_LANE_IDS() int tid = TID(); asm volatile("" : "+v"(tid));   \
    const int lane = tid & 63, wid = __builtin_amdgcn_readfirstlane(tid >> 6), l31 = lane & 31, hi = lane >> 5, eb = l31 & 7; (void)eb; (void)hi; (void)wid
DEV void conv_stage_load(char* lds, const Params& p, int c) {
    CV_LANE_IDS();
    const bf16_t* PT = (const bf16_t*)(p.ws + WS_PT); const bf16_t* GR = (const bf16_t*)(p.ws + WS_GR);
    FiltRegs f0; filt_load(f0, GR + (size_t)c * 8192, tid);
    Raw3 ru[16];
#pragma unroll
    for (int k = 0; k < 16; ++k) { const int i = tid + k * 512, b = i >> 10, t = (i & 1023) * 4; ru[k] = ld_raw3(PT + ((size_t)(b * 4096 + c)) * 4096, t); }
    for (int i = tid; i < 8 * 98; i += 512) { const int b = i / 98, j = i % 98;
        const int e = (j < 48) ? j * 4 : (CV_PADL + SEQ + (j - 48) * 4); *(u32x2*)(lds + b * CV_RS + e * 2) = (u32x2){0u, 0u}; }
    const float w0 = p.conv_w[c], w1 = p.conv_w[3072 + c], w2 = p.conv_w[6144 + c], bias = p.conv_b[c];
#pragma unroll
    for (int k = 0; k < 16; ++k) { const int i = tid + k * 512, b = i >> 10, t = (i & 1023) * 4; float u[4]; sconv_raw(ru[k], w0, w1, w2, bias, u);
        u32x2 w; w.x = pk2(u[0], u[1]); w.y = pk2(u[2], u[3]); *(u32x2*)(lds + b * CV_RS + (CV_PADL + t) * 2) = w; }
    filt_store(lds, f0, tid);
}
DEV void conv_stage_epi0(char* lds, const Params& p, int c, const f32x16 (&acc)[2][2]) {
    CV_LANE_IDS();
    const bf16_t* PT = (const bf16_t*)(p.ws + WS_PT); const bf16_t* GR = (const bf16_t*)(p.ws + WS_GR); const float* ssum = (const float*)(p.ws + WS_SSUM);
    FiltRegs f1; filt_load(f1, GR + (size_t)(1024 + c) * 8192, tid);
    const bf16_t* px1 = PT + ((size_t)(eb * 4096 + 1024 + c)) * 4096;
    Raw3 r1[16];
#pragma unroll
    for (int k = 0; k < 16; ++k) r1[k] = ld_raw3(px1, CV_T(k));
    const float a0 = p.conv_w[1024 + c], a1 = p.conv_w[3072 + 1024 + c], a2 = p.conv_w[6144 + 1024 + c], ab = p.conv_b[1024 + c];
    const float invs = 1.0f / ssum[c], sk = p.skip[c];
#pragma unroll
    for (int k = 0; k < 16; ++k) { const int n = k >> 3, mt = (k >> 2) & 1, g = k & 3; const int t = CV_T(k);
        float x1[4]; sconv_raw(r1[k], a0, a1, a2, ab, x1);
        char* up = lds + eb * CV_RS + (CV_PADL + t) * 2; const u32x2 vw = *(const u32x2*)up;
        const float z0 = x1[0] * (acc[n][mt][4 * g] * invs + sk * lo_bf(vw.x)), z1 = x1[1] * (acc[n][mt][4 * g + 1] * invs + sk * hi_bf(vw.x));
        const float z2 = x1[2] * (acc[n][mt][4 * g + 2] * invs + sk * lo_bf(vw.y)), z3 = x1[3] * (acc[n][mt][4 * g + 3] * invs + sk * hi_bf(vw.y));
        u32x2 w; w.x = pk2(z0, z1); w.y = pk2(z2, z3); *(u32x2*)up = w; }
    filt_store(lds, f1, tid);
}
DEV void conv_stage_epi1(char* lds, const Params& p, int c, const f32x16 (&acc)[2][2]) {
    CV_LANE_IDS();
    const bf16_t* PT = (const bf16_t*)(p.ws + WS_PT); const float* ssum = (const float*)(p.ws + WS_SSUM); bf16_t* OG2 = (bf16_t*)(p.ws + WS_OG2);
    const bf16_t* px2 = PT + ((size_t)(eb * 4096 + 2048 + c)) * 4096; const bf16_t* pg = PT + ((size_t)(eb * 4096 + 3072 + c)) * 4096;
    Raw3 r2[16]; u32x2 rg[16];
#pragma unroll
    for (int k = 0; k < 16; ++k) { r2[k] = ld_raw3(px2, CV_T(k)); rg[k] = *(const u32x2*)(pg + CV_T(k)); }
    const float b0 = p.conv_w[2048 + c], b1 = p.conv_w[3072 + 2048 + c], b2 = p.conv_w[6144 + 2048 + c], bb = p.conv_b[2048 + c];
    const float invs = 1.0f / ssum[1024 + c], sk = p.skip[1024 + c];
#pragma unroll
    for (int k = 0; k < 16; ++k) { const int n = k >> 3, mt = (k >> 2) & 1, g = k & 3; const int t = CV_T(k);
        float x2[4]; sconv_raw(r2[k], b0, b1, b2, bb, x2);
        const u32x2 zw = *(const u32x2*)(lds + eb * CV_RS + (CV_PADL + t) * 2);
        const float y0 = x2[0] * silu(lo_bf(rg[k].x)) * (acc[n][mt][4 * g] * invs + sk * lo_bf(zw.x)), y1 = x2[1] * silu(hi_bf(rg[k].x)) * (acc[n][mt][4 * g + 1] * invs + sk * hi_bf(zw.x));
        const float y2 = x2[2] * silu(lo_bf(rg[k].y)) * (acc[n][mt][4 * g + 2] * invs + sk * lo_bf(zw.y)), y3 = x2[3] * silu(hi_bf(rg[k].y)) * (acc[n][mt][4 * g + 3] * invs + sk * hi_bf(zw.y));
        u32x2 w; w.x = pk2(y0, y1); w.y = pk2(y2, y3); *(u32x2*)(OG2 + ((size_t)(eb * 1024 + c)) * 4096 + t) = w; }
}
DEV void conv_stage_mfma(const char* lds, f32x16 (&acc)[2][2]) { CV_LANE_IDS(); conv_mfma_loop(lds, acc, wid, lane); }
DEV void conv_unit2(char* lds, const Params& p, int c) {
    conv_stage_load(lds, p, c);
    __syncthreads();
    f32x16 acc[2][2];
    conv_stage_mfma(lds, acc);
    __syncthreads();
    conv_stage_epi0(lds, p, c, acc);
    __syncthreads();
    conv_stage_mfma(lds, acc);
    conv_stage_epi1(lds, p, c, acc);
    __syncthreads();
}
#undef CV_T
#undef CV_LANE_IDS

struct cf { float x, y; };
DEV float s_add(float a, float b) { float r; asm("v_add_f32_e32 %0, %1, %2" : "=v"(r) : "v"(a), "v"(b)); return r; }
DEV float s_sub(float a, float b) { float r; asm("v_sub_f32_e32 %0, %1, %2" : "=v"(r) : "v"(a), "v"(b)); return r; }
DEV float s_mul(float a, float b) { float r; asm("v_mul_f32_e32 %0, %1, %2" : "=v"(r) : "v"(a), "v"(b)); return r; }
DEV float s_fma(float a, float b, float c) { float r; asm("v_fma_f32 %0, %1, %2, %3" : "=v"(r) : "v"(a), "v"(b), "v"(c)); return r; }
DEV float s_fnma(float a, float b, float c) { float r; asm("v_fma_f32 %0, -%1, %2, %3" : "=v"(r) : "v"(a), "v"(b), "v"(c)); return r; }
DEV cf cadd(cf a, cf b) { return cf{s_add(a.x, b.x), s_add(a.y, b.y)}; }
DEV cf csub(cf a, cf b) { return cf{s_sub(a.x, b.x), s_sub(a.y, b.y)}; }
DEV cf cmul(cf a, cf b) { cf r;
    asm("v_mul_f32_e32 %0, %2, %4\n\tv_mul_f32_e32 %1, %2, %5\n\tv_fma_f32 %0, -%3, %5, %0\n\tv_fma_f32 %1, %3, %4, %1" : "=&v"(r.x), "=&v"(r.y) : "v"(a.x), "v"(a.y), "v"(b.x), "v"(b.y)); return r; }
template <int M> DEV cf mulw16(cf a) {
    if constexpr (M == 0) return a;
    else if constexpr (M == 4) return cf{a.y, -a.x};
    else if constexpr (M == 2) return cf{s_mul(s_add(a.x, a.y), 0.70710678118654752f), s_mul(s_sub(a.y, a.x), 0.70710678118654752f)};
    else if constexpr (M == 6) return cf{s_mul(s_sub(a.y, a.x), 0.70710678118654752f), s_mul(s_add(a.x, a.y), -0.70710678118654752f)};
    else { constexpr float c = (M == 1) ? 0.92387953251128674f : (M == 3) ? 0.38268343236508977f : (M == 5) ? -0.38268343236508977f : -0.92387953251128674f;
           constexpr float sn = (M == 1) ? -0.38268343236508977f : (M == 3) ? -0.92387953251128674f : (M == 5) ? -0.92387953251128674f : -0.38268343236508977f;
           return cf{s_fnma(a.y, sn, s_mul(a.x, c)), s_fma(a.y, c, s_mul(a.x, sn))}; }
}
DEV void bfly4(cf a, cf b, cf& s_, cf& d_) {
    asm("v_add_f32_e32 %0, %4, %6\n\tv_add_f32_e32 %1, %5, %7\n\tv_sub_f32_e32 %2, %4, %6\n\tv_sub_f32_e32 %3, %5, %7" : "=&v"(s_.x), "=&v"(s_.y), "=&v"(d_.x), "=&v"(d_.y) : "v"(a.x), "v"(a.y), "v"(b.x), "v"(b.y)); }
template <int HALF, int BLK, int J> DEV void dif_bfly(cf (&v)[16]) { const cf a = v[BLK + J], b = v[BLK + J + HALF]; cf sm, df; bfly4(a, b, sm, df); v[BLK + J] = sm; v[BLK + J + HALF] = mulw16<J * (8 / HALF)>(df); }
DEV void dft16(cf (&v)[16]) {
#define B8(j) dif_bfly<8, 0, j>(v)
    B8(0); B8(1); B8(2); B8(3); B8(4); B8(5); B8(6); B8(7);
#undef B8
#define B4(b, j) dif_bfly<4, b, j>(v)
    B4(0, 0); B4(0, 1); B4(0, 2); B4(0, 3); B4(8, 0); B4(8, 1); B4(8, 2); B4(8, 3);
#undef B4
#define B2(b, j) dif_bfly<2, b, j>(v)
    B2(0, 0); B2(0, 1); B2(4, 0); B2(4, 1); B2(8, 0); B2(8, 1); B2(12, 0); B2(12, 1);
#undef B2
#define B1(b) dif_bfly<1, b, 0>(v)
    B1(0); B1(2); B1(4); B1(6); B1(8); B1(10); B1(12); B1(14);
#undef B1
}
#define FFT_BR4(k) ((((k) & 1) << 3) | (((k) & 2) << 1) | (((k) & 4) >> 1) | (((k) & 8) >> 3))
constexpr int FF_BUF = (8192 + 512) * 8;
DEV int ffp(int idx) { return (idx + (idx >> 4)) * 8; }
struct FftTw { cf t3[16]; };
constexpr int FF_T2 = 2 * FF_BUF;
DEV void fft_twiddles(FftTw& T, char* lds, int tid) {
    if (tid < 240) { const int k = tid / 15, r = tid % 15 + 1; float sn, cs; sincospif(-(float)(k * r) * (1.0f / 128.0f), &sn, &cs); *(cf*)(lds + FF_T2 + tid * 8) = cf{cs, sn}; }
    __syncthreads();
    { const int i3 = tid & 255, h = tid >> 8; float sn, cs; sincospif(-(float)i3 * (1.0f / 4096.0f), &sn, &cs); asm volatile("s_nop 1" : "+v"(sn), "+v"(cs));
        const cf w1 = cf{cs, sn}; const cf w2 = cmul(w1, w1);
        cf t = h ? w1 : cf{1.f, 0.f};
#pragma unroll
        for (int sx = 0; sx < 16; ++sx) { T.t3[sx] = t; t = cmul(t, w2); } }
}
DEV void fft_pass23(char* A, char* B, const char* tw2, int tid, const FftTw& T) {
    asm volatile("" : "+v"(tid));
    cf v[16];
    {
        const int i = tid, k = i & 15;
        { const char* rb = A + ffp(i);
#pragma unroll
        for (int r = 0; r < 16; ++r) v[r] = *(const cf*)(rb + 4352 * r); }
#pragma unroll
        for (int r = 1; r < 16; ++r) v[r] = cmul(v[r], *(const cf*)(tw2 + k * 120 + (r - 1) * 8));
        dft16(v);
        const int j = ((i >> 4) << 8) + k;
        { char* wb = B + (j + 16 * (i >> 4)) * 8;
#pragma unroll
        for (int r = 0; r < 16; ++r) *(cf*)(wb + 136 * r) = v[FFT_BR4(r)]; }
        __syncthreads();
    }
    {
        const int i3 = tid & 255, h = tid >> 8;
        const char* rb3 = B + ffp(i3) + 2176 * h;
#pragma unroll
        for (int sx = 0; sx < 16; ++sx) v[sx] = *(const cf*)(rb3 + 4352 * sx);
#pragma unroll
        for (int sx = 0; sx < 16; ++sx) v[sx] = cmul(v[sx], T.t3[sx]);
        dft16(v);
        if (h) {
            const float c32[16] = {1.f, 0.98078528040323043f, 0.92387953251128674f, 0.83146961230254524f, 0.70710678118654752f, 0.55557023301960218f, 0.38268343236508977f, 0.19509032201612825f,
                                   0.f, -0.19509032201612825f, -0.38268343236508977f, -0.55557023301960218f, -0.70710678118654752f, -0.83146961230254524f, -0.92387953251128674f, -0.98078528040323043f};
            const float s32[16] = {0.f, -0.19509032201612825f, -0.38268343236508977f, -0.55557023301960218f, -0.70710678118654752f, -0.83146961230254524f, -0.92387953251128674f, -0.98078528040323043f,
                                   -1.f, -0.98078528040323043f, -0.92387953251128674f, -0.83146961230254524f, -0.70710678118654752f, -0.55557023301960218f, -0.38268343236508977f, -0.19509032201612825f};
#pragma unroll
            for (int m = 0; m < 16; ++m) v[FFT_BR4(m)] = cmul(v[FFT_BR4(m)], cf{c32[m], s32[m]});
        }
        { char* wb3 = A + ffp(i3) + 34816 * h;
#pragma unroll
        for (int m = 0; m < 16; ++m) *(cf*)(wb3 + 2176 * m) = v[FFT_BR4(m)]; }
        __syncthreads();
    }
}
DEV void fft_pass1_store(char* D, cf (&v)[16], int tid) {
    dft16(v);
    { char* wb = D + 136 * tid;
#pragma unroll
    for (int r = 0; r < 16; ++r) *(cf*)(wb + 8 * r) = v[FFT_BR4(r)]; }
    __syncthreads();
}
constexpr size_t WS_CVIN = WS_H1;
DEV void fftconv_unit(char* lds, const Params& p, int c, const FftTw& T) {
    int tid = TID(); asm volatile("" : "+v"(tid));
    char* D0 = lds; char* D1 = lds + FF_BUF;
    const bf16_t* PT = (const bf16_t*)(p.ws + WS_PT); const bf16_t* GR = (const bf16_t*)(p.ws + WS_GR); const float* ssum = (const float*)(p.ws + WS_SSUM);
    bf16_t* OG2 = (bf16_t*)(p.ws + WS_OG2); float* IN = (float*)(p.ws + WS_CVIN) + (size_t)blockIdx.x * (8 * 4096);
    { const float w0 = p.conv_w[c], w1 = p.conv_w[3072 + c], w2 = p.conv_w[6144 + c], bias = p.conv_b[c];
#pragma unroll 2
        for (int k = 0; k < 8; ++k) { const int i = tid + k * 512, b = i >> 9, n0 = (i & 511) * 8;
            const bf16_t* px = PT + ((size_t)(b * 4096 + c)) * 4096;
            float q[10]; { const u32x4 m = *(const u32x4*)(px + n0); unpack8(m, q + 1); q[0] = (n0 > 0) ? bf2f(px[n0 - 1]) : 0.f; q[9] = (n0 + 8 < SEQ) ? bf2f(px[n0 + 8]) : 0.f; }
            f32x4 o0, o1;
#pragma unroll
            for (int e = 0; e < 4; ++e) { o0[e] = w0 * q[e] + w1 * q[e + 1] + w2 * q[e + 2] + bias; o1[e] = w0 * q[e + 4] + w1 * q[e + 5] + w2 * q[e + 6] + bias; }
            *(f32x4*)(IN + b * 4096 + n0) = o0; *(f32x4*)(IN + b * 4096 + n0 + 4) = o1; } }
    __syncthreads();
#pragma unroll 1
    for (int o = 0; o < 2; ++o) {
        cf KS[16];
        asm volatile("" : "+v"(tid));
        { const bf16_t* g = GR + (size_t)(o * 1024 + c) * 8192; const float invs = 1.0f / ssum[o * 1024 + c];
            cf v[16];
#pragma unroll
            for (int r = 0; r < 16; ++r) { const int n = tid + 512 * r; v[r] = cf{bf2f(g[(12288 - n) & 8191]) * invs, 0.f}; }
            fft_pass1_store(D0, v, tid);
            fft_pass23(D0, D1, lds + FF_T2, tid, T);
#pragma unroll
            for (int q = 0; q < 8; ++q) { const cf a = *(const cf*)(D0 + ffp(tid) + 4352 * q), b = *(const cf*)(D0 + ffp(tid) + 4352 * q + 34816); KS[q] = cadd(a, b); KS[q + 8] = csub(a, b); }
            __syncthreads(); }
        const float sk = p.skip[o * 1024 + c];
        const int part = (o == 0) ? 1024 : 2048;
        const float w0 = p.conv_w[part + c], w1 = p.conv_w[3072 + part + c], w2 = p.conv_w[6144 + part + c], bias = p.conv_b[part + c];
        cf vin[8];
#pragma unroll
        for (int r = 0; r < 8; ++r) vin[r] = cf{IN[tid + 512 * r], IN[4096 + tid + 512 * r]};
#pragma unroll 1
        for (int pr = 0; pr < 4; ++pr) {
            asm volatile("" : "+v"(tid));
            const int n0 = 8 * tid;
            u32x4 eraw[2], egate[2]; f32x4 eu[2][2]; unsigned ehalo[2];
#pragma unroll
            for (int hb = 0; hb < 2; ++hb) { const int b = 2 * pr + hb; const bf16_t* px = PT + ((size_t)(b * 4096 + part + c)) * 4096;
                eraw[hb] = *(const u32x4*)(px + n0);
                const unsigned ha = px[n0 - 1], hz = px[n0 + 8];
                ehalo[hb] = ((n0 > 0) ? ha : 0u) | (((n0 + 8 < SEQ) ? hz : 0u) << 16);
                eu[hb][0] = *(const f32x4*)(IN + b * 4096 + n0); eu[hb][1] = *(const f32x4*)(IN + b * 4096 + n0 + 4);
                egate[hb] = (o == 1) ? *(const u32x4*)(PT + ((size_t)(b * 4096 + 3072 + c)) * 4096 + n0) : (u32x4){0u, 0u, 0u, 0u}; }
            {
                cf v[16];
#pragma unroll
                for (int r = 0; r < 8; ++r) v[r] = vin[r];
#pragma unroll
                for (int r = 8; r < 16; ++r) v[r] = cf{0.f, 0.f};
                fft_pass1_store(D0, v, tid);
                fft_pass23(D0, D1, lds + FF_T2, tid, T);
            }
            {
                const int pn = (pr < 3) ? pr + 1 : pr; const float* ina = IN + (2 * pn) * 4096;
#pragma unroll
                for (int r = 0; r < 8; ++r) vin[r] = cf{ina[tid + 512 * r], ina[4096 + tid + 512 * r]};
            }
            {
                cf v[16];
#pragma unroll
                for (int q = 0; q < 8; ++q) { const cf a = *(const cf*)(D0 + ffp(tid) + 4352 * q), b = *(const cf*)(D0 + ffp(tid) + 4352 * q + 34816);
                    const cf x0 = cmul(cadd(a, b), KS[q]), x1 = cmul(csub(a, b), KS[q + 8]);
                    v[q] = cf{x0.x, -x0.y}; v[q + 8] = cf{x1.x, -x1.y}; }
                fft_pass1_store(D1, v, tid);
                fft_pass23(D1, D0, lds + FF_T2, tid, T);
            }
            {
                float ya[8], yb[8];
#pragma unroll
                for (int e = 0; e < 8; ++e) { const cf a = *(const cf*)(D1 + 64 * tid + 8 * (tid >> 1) + 8 * e), b = *(const cf*)(D1 + 64 * tid + 8 * (tid >> 1) + 8 * e + 34816); ya[e] = (a.x + b.x) * (1.0f / 8192.0f); yb[e] = -(a.y + b.y) * (1.0f / 8192.0f); }
#pragma unroll
                for (int hb = 0; hb < 2; ++hb) { const int b = 2 * pr + hb; float* inp = IN + b * 4096 + n0; const float* yy = hb ? yb : ya;
                    float q[10]; unpack8(eraw[hb], q + 1); q[0] = lo_bf(ehalo[hb]); q[9] = hi_bf(ehalo[hb]);
                    const f32x4 u0 = eu[hb][0], u1 = eu[hb][1]; const float uu[8] = {u0.x, u0.y, u0.z, u0.w, u1.x, u1.y, u1.z, u1.w};
                    float z[8];
#pragma unroll
                    for (int e = 0; e < 8; ++e) { const float xc = w0 * q[e] + w1 * q[e + 1] + w2 * q[e + 2] + bias; z[e] = xc * (yy[e] + sk * uu[e]); }
                    if (o == 0) { *(f32x4*)inp = (f32x4){z[0], z[1], z[2], z[3]}; *(f32x4*)(inp + 4) = (f32x4){z[4], z[5], z[6], z[7]}; }
                    else { float gg[8]; unpack8(egate[hb], gg);
#pragma unroll
                        for (int e = 0; e < 8; ++e) z[e] *= silu(gg[e]);
                        *(u32x4*)(OG2 + ((size_t)(b * 1024 + c)) * 4096 + n0) = pack8(z); } }
            }
        }
        __syncthreads();
    }
}

#define XB_TMO      128
#define XB_XCNT(j)  (256  + 64 * (j))
#define XB_XSUB(j)  (1280 + 64 * (j))
#define XB_XGEN(j)  (2304 + 64 * (j))
#define XB_TOP      3328
#define XB_TOPGEN   3392
#define XCD_BAR_WORDS 3456
#define XB_SPIN_CAP (1u << 20)
DEV unsigned xb_ld(unsigned* p) { return __hip_atomic_load(p, __ATOMIC_RELAXED, __HIP_MEMORY_SCOPE_AGENT); }
DEV unsigned xb_add(unsigned* p, unsigned v) { return __hip_atomic_fetch_add(p, v, __ATOMIC_RELAXED, __HIP_MEMORY_SCOPE_AGENT); }
DEV unsigned xb_xcc_id() { return (unsigned)__builtin_amdgcn_s_getreg((3 << 11) | 20) & 0xFu; }
#define XB_SPIN(cond, bar) do { unsigned _sp = 0; while (cond) { __builtin_amdgcn_s_sleep(1); \
    if ((++_sp & 255u) == 0u) { if (xb_ld(&(bar)[XB_TMO])) break; if (_sp > XB_SPIN_CAP) { atomicAdd(&(bar)[XB_TMO], 1u); break; } } } } while (0)
struct XcdBarrier { unsigned* bar; unsigned x; volatile LAS unsigned* st; };
DEV XcdBarrier xcd_barrier_post(unsigned* bar, volatile LAS unsigned* st) {
    XcdBarrier b; b.bar = bar; b.x = xb_xcc_id(); b.st = st;
    if (TID() == 0) (void)xb_add(&bar[XB_XCNT(b.x)], 1u);
    return b;
}
DEV void xcd_barrier_complete(unsigned* bar, unsigned x, unsigned& nloc, unsigned& nx) {
    const unsigned G = gridDim.x * gridDim.y * gridDim.z;
    unsigned sum, cnt, mine, sp = 0u;
    for (;;) {
        sum = 0u; cnt = 0u; mine = 0u;
#pragma unroll
        for (unsigned j = 0; j < 16; ++j) { const unsigned c = xb_ld(&bar[XB_XCNT(j)]); sum += c; cnt += (c > 0u) ? 1u : 0u; mine = (j == x) ? c : mine; }
        if (sum == G) break;
        __builtin_amdgcn_s_sleep(1);
        if ((++sp & 255u) == 0u) { if (xb_ld(&bar[XB_TMO])) break; if (sp > XB_SPIN_CAP) { atomicAdd(&bar[XB_TMO], 1u); break; } }
    }
    nloc = mine > 0u ? mine : 1u; nx = cnt > 0u ? cnt : 1u;
}
DEV void xcd_barrier(const XcdBarrier& b) {
    asm volatile("s_waitcnt vmcnt(0)" ::: "memory");
    __syncthreads();
    if (TID() == 0) {
        unsigned* bar = b.bar;
        __builtin_amdgcn_s_waitcnt(0);
        unsigned nloc = b.st[0], nx = b.st[1];
        if (nloc == 0u) { xcd_barrier_complete(bar, b.x, nloc, nx); b.st[0] = nloc; b.st[1] = nx; }
        const unsigned old = xb_add(&bar[XB_XSUB(b.x)], 1u);
        const unsigned gen = old / nloc;
        if (old + 1u == (gen + 1u) * nloc) {
            __builtin_amdgcn_fence(__ATOMIC_RELEASE, "agent");
            asm volatile("s_waitcnt vmcnt(0)" ::: "memory");
            const unsigned og = xb_add(&bar[XB_TOP], 1u);
            const unsigned tg = og / nx;
            if (og + 1u == (tg + 1u) * nx) xb_add(&bar[XB_TOPGEN], 1u);
            else XB_SPIN(xb_ld(&bar[XB_TOPGEN]) == tg, bar);
            __builtin_amdgcn_fence(__ATOMIC_ACQUIRE, "agent");
            xb_add(&bar[XB_XGEN(b.x)], 1u);
            asm volatile("s_waitcnt vmcnt(0)" ::: "memory");
        } else {
            XB_SPIN(xb_ld(&bar[XB_XGEN(b.x)]) == gen, bar);
            __builtin_amdgcn_fence(__ATOMIC_ACQUIRE, "agent");
            asm volatile("s_waitcnt vmcnt(0)" ::: "memory");
        }
    }
    __syncthreads();
}

constexpr int NPHASE = 12;
__global__ void __launch_bounds__(512) fwd_kernel(Params p) {
    char* lds = lds_dyn;
    char* ws = p.ws;
    volatile LAS unsigned* bst = (volatile LAS unsigned*)(LAS char*)(lds + LDS_BYTES - 64);
    { const int t0 = threadIdx.x;
        if (t0 < 16) bst[t0] = 0u;
        if ((t0 & 63) == 0) *(volatile LAS int*)(LAS char*)(lds + LDS_WTAB + 4 * hw_slot()) = t0 >> 6; }
    __syncthreads();
    if (MK_LAUNCHES == 1) (void)xcd_barrier_post((unsigned*)(ws + WS_CTL), bst);
    if (MK_LAUNCHES == 1 && p.ph_hi > NPHASE) cg::this_grid().sync();
#define SEAM(k) do { if (MK_LAUNCHES == 1 && (k) + 1 < p.ph_hi) { XcdBarrier xb_; xb_.bar = (unsigned*)(p.ws + WS_CTL); xb_.x = xb_xcc_id(); xb_.st = (volatile LAS unsigned*)(LAS char*)(lds + LDS_BYTES - 64); xcd_barrier(xb_); } } while (0)
#ifndef PHASE_MASK
#define PHASE_MASK 0xFFF
#endif
#define IN(k) (((PHASE_MASK >> (k)) & 1) && p.ph_lo <= (k) && (k) < p.ph_hi)
#define REP(k) for (int rep_ = 0; rep_ < ((PROBE_REPEAT == (k)) ? 2 : 1); ++rep_)
    if (IN(0)) { REP(0) phase_prep(lds, p); SEAM(0); }
    if (IN(1)) {
        for (int rep_ = 0; rep_ < ((PROBE_REPEAT == 21) ? 2 : 1); ++rep_) {
        const bool dummy = (PROBE_REPEAT == 21 && rep_ == 0);
        EpiFilt ef{(bf16_t*)(ws + (dummy ? WS_PRAW : WS_GR)), p.f_b3};
        gemm_phase<false, EpiFilt>(lds, (const bf16_t*)(ws + WS_W3), 64, (const bf16_t*)(ws + WS_HID2), 64, 4096, 4096, 64, ef); }
        REP(1) phase_norm0(p); SEAM(1); }
    if (IN(2)) {
        REP(2) { pg8::Gemm g{(const bf16_t*)(ws + WS_H0), (const bf16_t*)(ws + WS_WIN), NALL, AINP, DM}; pg8::StaticOrder S; S.init(NALL, AINP, (int)gridDim.x, (int)blockIdx.x);
            pg8::EpiBf16 E{(bf16_t*)(ws + WS_PRAW), (size_t)AINP, 0, 0};
            pg8::gemm_phase<pg8::EpiBf16, pg8::StaticOrder, true, true>((PG8_LAS unsigned char*)lds, g, S, E); }
        SEAM(2); }
    if (IN(3)) { filt_sums(p); REP(3) phase_post(p); SEAM(3); }
    if (IN(4)) {
        const float* rp = (const float*)(ws + WS_ROPE);
        REP(4) {
        { pg8::Gemm g{(const bf16_t*)(ws + WS_CQN), (const bf16_t*)(ws + WS_WUQ), NTOK, 768, 256}; pg8::StaticOrder S; S.init(NTOK, 768, (int)gridDim.x, (int)blockIdx.x);
            pg8::EpiUqPg E{(bf16_t*)(ws + WS_QM), rp + 2048, rp + 2560, QSC_M};
            pg8::gemm_phase<pg8::EpiUqPg, pg8::StaticOrder, true, true>((PG8_LAS unsigned char*)lds, g, S, E); }
        int opq_ = 0; asm volatile("" : "+s"(opq_));
        if (opq_ == 0) { pg8::Gemm g{(const bf16_t*)(ws + WS_CKVN), (const bf16_t*)(ws + WS_WUKV), NALL, 1024, 128}; pg8::StaticOrder S; S.init(NALL, 1024, (int)gridDim.x, (int)blockIdx.x);
            pg8::EpiUkvPg E{(bf16_t*)(ws + WS2_KM), (bf16_t*)(ws + WS2_VM)};
            pg8::gemm_phase<pg8::EpiUkvPg, pg8::StaticOrder, true, true>((PG8_LAS unsigned char*)lds, g, S, E); } }
        SEAM(4); }
    if (IN(5)) { REP(5) phase_attn(lds, p); SEAM(5); }
    if (IN(6)) {
        REP(6) { pg8::Gemm g{(const bf16_t*)(ws + WS2_OG), (const bf16_t*)(ws + WS_WOUT), NTOK, DM, DM}; pg8::StaticOrder S; S.init(NTOK, DM, (int)gridDim.x, (int)blockIdx.x);
            pg8::EpiResF32 E{p.x, p.out, (const float*)(ws + WS_MOD0), (DBG_SKIP & 1) ? 0.f : 1.f};
            pg8::gemm_phase<pg8::EpiResF32, pg8::StaticOrder, true, true>((PG8_LAS unsigned char*)lds, g, S, E); }
        SEAM(6); }
    if (IN(7)) { REP(7) phase_norm1(p); SEAM(7); }
    if (IN(8)) {
        REP(8) { pg8::Gemm g{(const bf16_t*)(ws + WS_HWIN), (const bf16_t*)(ws + WS_H1), 4096, NTOK, DM}; pg8::StaticOrder S; S.init(4096, NTOK, (int)gridDim.x, (int)blockIdx.x);
            pg8::EpiBf16 E{(bf16_t*)(ws + WS_PT), (size_t)4096, 4096, (size_t)4096 * 4096};
            pg8::gemm_phase<pg8::EpiBf16, pg8::StaticOrder, true, true>((PG8_LAS unsigned char*)lds, g, S, E); }
        SEAM(8); }
    if (IN(9)) { FftTw T; fft_twiddles(T, lds, TID()); REP(9) for (int c = blockIdx.x; c < 1024; c += gridDim.x) fftconv_unit(lds, p, c, T); SEAM(9); }
    if (IN(10)) {
        REP(10) {
        EpiRes e{p.out, (PROBE_REPEAT == 10 && rep_ == 0) ? (float*)(ws + WS_PT) : p.out, (const float*)(ws + WS_MOD1), (DBG_SKIP & 2) ? 0.f : 1.f};
        const bf16_t* OG2 = (const bf16_t*)(ws + WS_OG2); const bf16_t* W = (const bf16_t*)(ws + WS_HWOUT);
        const int nt = (NTOK / 256) * (DM / 256);
        for (int t = blockIdx.x; t < nt; t += gridDim.x) { const int ti = t / 4, tj = t % 4; const int b = ti >> 4, l0 = (ti & 15) * 256;
            gemm_tile256_tr<EpiRes>(lds, OG2 + (size_t)b * 1024 * 4096 + l0, 4096, W + (size_t)tj * 256 * DM, DM, DM, e, ti * 256, tj * 256); }
        }
        SEAM(10); }
    if (IN(11)) { phase_final(p); }
#undef SEAM
#undef IN
}

extern "C" void kernel_launch(void* const* d_in, const int* in_sizes, int n_in, void* d_out, int out_size, void* d_ws, size_t ws_size, hipStream_t stream) {
    static int grid = 0;
    if (grid == 0) {
        if (n_in != 28 || out_size != NTOK * DM || ws_size < WS_END) { fprintf(stderr, "kernel_launch: unexpected shapes n_in %d out %d ws %zu\n", n_in, out_size, ws_size); grid = -1; return; }
        int dev = 0, cus = 0, per_cu = 0;
        hipGetDevice(&dev); hipDeviceGetAttribute(&cus, hipDeviceAttributeMultiprocessorCount, dev);
        if (hipFuncSetAttribute((const void*)fwd_kernel, hipFuncAttributeMaxDynamicSharedMemorySize, LDS_BYTES) != hipSuccess) { fprintf(stderr, "hipFuncSetAttribute failed\n"); grid = -1; return; }
        hipOccupancyMaxActiveBlocksPerMultiprocessor(&per_cu, (const void*)fwd_kernel, 512, LDS_BYTES);
        if (per_cu < 1) { fprintf(stderr, "occupancy query says %d\n", per_cu); per_cu = 1; }
        grid = cus * 1;
        (void)hipGetLastError();
    }
    if (grid < 0) return;
    Params p{};
    const float** pp = (const float**)&p;
    for (int i = 0; i < 28; ++i) pp[i] = (const float*)d_in[i];
    p.out = (float*)d_out; p.ws = (char*)d_ws;
#if MK_LAUNCHES == 1
    if (hipMemsetAsync((char*)d_ws + WS_CTL, 0, CTL_BYTES, stream) != hipSuccess) { fprintf(stderr, "memset failed\n"); return; }
    p.ph_lo = 0; p.ph_hi = NPHASE;
    void* args[] = {&p};
    hipError_t e = hipLaunchCooperativeKernel((const void*)fwd_kernel, dim3(grid), dim3(512), args, LDS_BYTES, stream);
    if (e != hipSuccess) fprintf(stderr, "cooperative launch failed: %s (grid %d)\n", hipGetErrorString(e), grid);
#else
    for (int k = 0; k < NPHASE; ++k) { p.ph_lo = k; p.ph_hi = k + 1; hipLaunchKernelGGL(fwd_kernel, dim3(grid), dim3(512), LDS_BYTES, stream, p); }
#endif
}
```

```cpp
#include <hip/hip_runtime.h>
#include <hip/hip_cooperative_groups.h>
#include <cstdio>
#include <cstdint>
namespace cg = cooperative_groups;

#ifndef MK_LAUNCHES
#define MK_LAUNCHES 1
#endif

#ifndef PROBE_REPEAT
#define PROBE_REPEAT -1
#endif
#ifndef DBG_SKIP
#define DBG_SKIP 0
#endif
#define DEV __device__ __forceinline__
typedef unsigned short bf16_t;
typedef short bf16x8 __attribute__((ext_vector_type(8)));
typedef short s16x4 __attribute__((ext_vector_type(4)));
typedef float f32x16 __attribute__((ext_vector_type(16)));
typedef float f32x4 __attribute__((ext_vector_type(4)));
typedef float f32x2 __attribute__((ext_vector_type(2)));
typedef unsigned u32x4 __attribute__((ext_vector_type(4)));
typedef unsigned u32x2 __attribute__((ext_vector_type(2)));
typedef __bf16 bf16x2_t __attribute__((ext_vector_type(2)));
#define LAS __attribute__((address_space(3)))

constexpr int NB = 8, SEQ = 4096, DM = 1024, CTXL = 256, LK = SEQ + CTXL;
constexpr int NTOK = NB * SEQ, NCTX = NB * CTXL, NALL = NTOK + NCTX;
constexpr int AIN = 2208, AINP = 2304;
constexpr float EPS = 1e-6f;
constexpr float LOG2E = 1.4426950408889634f;
constexpr float QSC_A = 0.125f * LOG2E;
constexpr float QSC_M = 0.10206207261596575f * LOG2E;

constexpr size_t MiB = 1ull << 20;
constexpr size_t WS_WIN = 0;
constexpr size_t WS_WUQ = 5 * MiB;
constexpr size_t WS_WUKV = 6 * MiB;
constexpr size_t WS_WOUT = 7 * MiB;
constexpr size_t WS_HWIN = 9 * MiB;
constexpr size_t WS_HWOUT = 17 * MiB;
constexpr size_t WS_W3 = 19 * MiB;
constexpr size_t WS_HID2 = 20 * MiB;
constexpr size_t WS_MOD0 = 21 * MiB;
constexpr size_t WS_MOD1 = WS_MOD0 + 9 * 3072 * 4;
constexpr size_t WS_SSUM = WS_MOD1 + 8 * 3072 * 4;
constexpr size_t WS_ROPE = WS_SSUM + 2048 * 4;
constexpr size_t WS_GR = 22 * MiB;
constexpr size_t WS_H0 = 64 * MiB;
constexpr size_t WS_PRAW = 136 * MiB;
constexpr size_t WS_QA = 297 * MiB;
constexpr size_t WS_KA = 329 * MiB;
constexpr size_t WS_VA = 338 * MiB;
constexpr size_t WS_CQN = 347 * MiB;
constexpr size_t WS_CKVN = 363 * MiB;
constexpr size_t WS_G = 372 * MiB;
constexpr size_t WS_QM = 64 * MiB;
constexpr size_t WS_KM = 136 * MiB;
constexpr size_t WS_VM = 190 * MiB;
constexpr size_t WS_OG = 226 * MiB;
constexpr size_t WS_H1 = 436 * MiB;
constexpr size_t WS_PT = 64 * MiB;
constexpr size_t WS_OG2 = 320 * MiB;
constexpr size_t WS_CTL = 500 * MiB;
constexpr size_t CTL_BYTES = 16384;
constexpr size_t WS_END = 500 * MiB + CTL_BYTES;
constexpr size_t WS2_KM = 436 * MiB;
constexpr size_t WS2_VM = 190 * MiB;
constexpr size_t WS2_OG = 226 * MiB;

constexpr int LDS_BYTES = 150 * 1024;

extern __shared__ __attribute__((aligned(16))) char lds_dyn[];
constexpr int LDS_WTAB = LDS_BYTES - 64 - 256;
__device__ __forceinline__ int lane_id() { int r; asm volatile("v_mbcnt_lo_u32_b32 %0, -1, 0\n\tv_mbcnt_hi_u32_b32 %0, -1, %0" : "=v"(r)); return r; }
__device__ __forceinline__ int hw_slot() { return (int)(__builtin_amdgcn_s_getreg((5 << 11) | 4) & 63u); }
__device__ __forceinline__ int wave_idx() { return __builtin_amdgcn_readfirstlane(*(volatile __attribute__((address_space(3))) int*)(__attribute__((address_space(3))) char*)(lds_dyn + LDS_WTAB + 4 * hw_slot())); }
#define TID() (wave_idx() * 64 + lane_id())

DEV float bf2f(bf16_t v) { return __uint_as_float(((unsigned)v) << 16); }
DEV unsigned pk2(float lo, float hi) { f32x2 v = {lo, hi}; bf16x2_t b = __builtin_convertvector(v, bf16x2_t); return __builtin_bit_cast(unsigned, b); }
DEV bf16_t f2bf(float f) { return (bf16_t)(pk2(f, 0.f) & 0xffffu); }
DEV float lo_bf(unsigned w) { return __uint_as_float(w << 16); }
DEV float hi_bf(unsigned w) { return __uint_as_float(w & 0xffff0000u); }
DEV int crow(int r, int hi) { return (r & 3) + 8 * (r >> 2) + 4 * hi; }
DEV float silu(float v) { return v * __builtin_amdgcn_rcpf(1.f + __expf(-v)); }
DEV void unpack8(const u32x4 w, float* v) { v[0] = lo_bf(w.x); v[1] = hi_bf(w.x); v[2] = lo_bf(w.y); v[3] = hi_bf(w.y); v[4] = lo_bf(w.z); v[5] = hi_bf(w.z); v[6] = lo_bf(w.w); v[7] = hi_bf(w.w); }
DEV u32x4 pack8(const float* v) { u32x4 w; w.x = pk2(v[0], v[1]); w.y = pk2(v[2], v[3]); w.z = pk2(v[4], v[5]); w.w = pk2(v[6], v[7]); return w; }

DEV float wave_sum(float v) {
#pragma unroll
    for (int o = 1; o < 64; o <<= 1) v += __shfl_xor(v, o);
    return v;
}
struct Params {
    const float *x, *c, *ctx, *c_ctx, *ada_w, *ada_b, *norm_w, *w_in, *q_norm, *k_norm, *cq_norm, *ckv_norm, *w_uq, *w_ukv, *w_out,
        *hy_w_in, *conv_w, *conv_b, *f_w1, *f_b1, *f_w2, *f_b2, *f_w3, *f_b3, *freq, *skip, *hy_w_out, *final_w;
    float* out; char* ws; int ph_lo, ph_hi;
};

constexpr int G_RS = 144;
constexpr int G_RB = 256 * G_RS, G_CB = 128 * G_RS, G_STAGE = G_RB + G_CB;
constexpr int T_RS = 576;

template <bool TR, class Epi>
DEV void gemm_tile(char* lds, const bf16_t* __restrict__ R, size_t ldr, const bf16_t* __restrict__ C, size_t ldc, int K, const Epi& epi, int ti0, int tj0) {
    const int tid = TID(), lane = tid & 63, wid = tid >> 6;
    const int wi = wid >> 1, wj = wid & 1, l31 = lane & 31, hi = lane >> 5;
    f32x16 acc[2][2];
#pragma unroll
    for (int a = 0; a < 2; ++a)
#pragma unroll
        for (int b = 0; b < 2; ++b)
#pragma unroll
            for (int r = 0; r < 16; ++r) acc[a][b][r] = 0.f;
    u32x4 rrX[4], rcX[2], rrY[4], rcY[2];
    const bf16_t* Rp; const bf16_t* Cp; int rl_off, cl_off;
    if (TR) { const int c = tid & 31, kr = tid >> 5; Rp = R + (size_t)kr * ldr + c * 8; rl_off = kr * T_RS + c * 16; }
    else { const int lr = tid >> 3, lc = tid & 7; Rp = R + (size_t)lr * ldr + lc * 8; rl_off = lr * G_RS + lc * 16; }
    { const int lr = tid >> 3, lc = tid & 7; Cp = C + (size_t)lr * ldc + lc * 8; cl_off = lr * G_RS + lc * 16; }
    const int nk = K / 64;
    int ra_off[2], cb_off[2];
#pragma unroll
    for (int t = 0; t < 2; ++t) {
        if (TR) { const int g1 = (lane >> 4) & 1, q = (lane & 15) >> 2, p = lane & 3; ra_off[t] = (8 * hi + q) * T_RS + (wi * 64 + t * 32 + 16 * g1 + 4 * p) * 2; }
        else ra_off[t] = (wi * 64 + t * 32 + l31) * G_RS + hi * 16;
        cb_off[t] = G_RB + (wj * 64 + t * 32 + l31) * G_RS + hi * 16;
    }
#define G_LOAD(kt, S) do { const int kk_ = (kt) < nk ? (kt) : nk - 1; \
        if (TR) { _Pragma("unroll") for (int p = 0; p < 4; ++p) rr##S[p] = *(const u32x4*)(Rp + ((size_t)kk_ * 64 + 16 * p) * ldr); } \
        else { _Pragma("unroll") for (int p = 0; p < 4; ++p) rr##S[p] = *(const u32x4*)(Rp + (size_t)(64 * p) * ldr + kk_ * 64); } \
        _Pragma("unroll") for (int p = 0; p < 2; ++p) rc##S[p] = *(const u32x4*)(Cp + (size_t)(64 * p) * ldc + kk_ * 64); } while (0)
#define G_STORE(buf, S) do { char* b_ = lds + (buf) * G_STAGE; \
        if (TR) { _Pragma("unroll") for (int p = 0; p < 4; ++p) *(u32x4*)(b_ + rl_off + 16 * p * T_RS) = rr##S[p]; } \
        else { _Pragma("unroll") for (int p = 0; p < 4; ++p) *(u32x4*)(b_ + rl_off + 64 * p * G_RS) = rr##S[p]; } \
        _Pragma("unroll") for (int p = 0; p < 2; ++p) *(u32x4*)(b_ + G_RB + cl_off + 64 * p * G_RS) = rc##S[p]; } while (0)
#define G_COMPUTE(buf) do { const char* b_ = lds + (buf) * G_STAGE; \
        _Pragma("unroll") for (int ks = 0; ks < 4; ++ks) { bf16x8 fa[2], fb[2]; \
            _Pragma("unroll") for (int t = 0; t < 2; ++t) { \
                if (TR) { \
                    const s16x4 lo = __builtin_bit_cast(s16x4, __builtin_amdgcn_ds_read_tr16_b64_v4i16((LAS s16x4*)(b_ + ra_off[t] + ks * 16 * T_RS))); \
                    const s16x4 hh = __builtin_bit_cast(s16x4, __builtin_amdgcn_ds_read_tr16_b64_v4i16((LAS s16x4*)(b_ + ra_off[t] + (ks * 16 + 4) * T_RS))); \
                    fa[t] = (bf16x8){lo[0], lo[1], lo[2], lo[3], hh[0], hh[1], hh[2], hh[3]}; \
                } else fa[t] = *(const bf16x8*)(b_ + ra_off[t] + ks * 32); \
                fb[t] = *(const bf16x8*)(b_ + cb_off[t] + ks * 32); } \
            _Pragma("unroll") for (int a = 0; a < 2; ++a) _Pragma("unroll") for (int b = 0; b < 2; ++b) acc[a][b] = __builtin_amdgcn_mfma_f32_32x32x16_bf16(fa[a], fb[b], acc[a][b], 0, 0, 0); } } while (0)
    G_LOAD(0, X); G_LOAD(1, Y); G_STORE(0, X);
    __syncthreads();
    for (int kt = 0; kt < nk; kt += 2) {
        G_LOAD(kt + 2, X);
        G_COMPUTE(0);
        G_STORE(1, Y);
        __syncthreads();
        if (kt + 1 >= nk) break;
        G_LOAD(kt + 3, Y);
        G_COMPUTE(1);
        G_STORE(0, X);
        __syncthreads();
    }
#undef G_LOAD
#undef G_STORE
#undef G_COMPUTE
#pragma unroll
    for (int a = 0; a < 2; ++a)
#pragma unroll
        for (int b = 0; b < 2; ++b) epi(ti0 + wi * 64 + a * 32, tj0 + wj * 64 + b * 32, acc[a][b], l31, hi);
}


constexpr int G2_STAGE = 2 * G_RB;
template <class Epi>
DEV void gemm_tile256_tr(char* lds, const bf16_t* __restrict__ R, size_t ldr, const bf16_t* __restrict__ C, size_t ldc, int K, const Epi& epi, int ti0, int tj0) {
    int tid = TID(); asm volatile("" : "+v"(tid));
    const int lane = tid & 63, wid = __builtin_amdgcn_readfirstlane(tid >> 6), wi = wid >> 2, wj = wid & 3, l31 = lane & 31, hi = lane >> 5;
    f32x16 acc[4][2];
#pragma unroll
    for (int a = 0; a < 4; ++a)
#pragma unroll
        for (int b = 0; b < 2; ++b)
#pragma unroll
            for (int r = 0; r < 16; ++r) acc[a][b][r] = 0.f;
    u32x4 rr[4], rc[4];
    const bf16_t* Rp; const bf16_t* Cp; int rl_off, cl_off;
    { const int c = tid & 31, kr = tid >> 5; Rp = R + (size_t)kr * ldr + c * 8; rl_off = kr * T_RS + c * 16; }
    { const int lr = tid >> 3, lc = tid & 7; Cp = C + (size_t)lr * ldc + lc * 8; cl_off = lr * G_RS + lc * 16; }
    const int nk = K / 64;
    int ra_off[4], cb_off[2];
#pragma unroll
    for (int t = 0; t < 4; ++t) { const int g1 = (lane >> 4) & 1, q = (lane & 15) >> 2, p = lane & 3; ra_off[t] = (8 * hi + q) * T_RS + (wi * 128 + t * 32 + 16 * g1 + 4 * p) * 2; }
#pragma unroll
    for (int t = 0; t < 2; ++t) cb_off[t] = G_RB + (wj * 64 + t * 32 + l31) * G_RS + hi * 16;
#define G2_LOAD(kt) do { const int kk_ = (kt) < nk ? (kt) : nk - 1; \
        _Pragma("unroll") for (int p = 0; p < 4; ++p) rr[p] = *(const u32x4*)(Rp + ((size_t)kk_ * 64 + 16 * p) * ldr); \
        _Pragma("unroll") for (int p = 0; p < 4; ++p) rc[p] = *(const u32x4*)(Cp + (size_t)(64 * p) * ldc + kk_ * 64); } while (0)
#define G2_STORE(buf) do { char* b_ = lds + (buf) * G2_STAGE; \
        _Pragma("unroll") for (int p = 0; p < 4; ++p) *(u32x4*)(b_ + rl_off + 16 * p * T_RS) = rr[p]; \
        _Pragma("unroll") for (int p = 0; p < 4; ++p) *(u32x4*)(b_ + G_RB + cl_off + 64 * p * G_RS) = rc[p]; } while (0)
    G2_LOAD(0); G2_STORE(0);
    __syncthreads();
    for (int kt = 0; kt < nk; ++kt) {
        G2_LOAD(kt + 1);
        const char* b_ = lds + (kt & 1) * G2_STAGE;
#pragma unroll
        for (int ks = 0; ks < 4; ++ks) {
            bf16x8 fa[4], fb[2];
#pragma unroll
            for (int t = 0; t < 4; ++t) {
                const s16x4 lo = __builtin_bit_cast(s16x4, __builtin_amdgcn_ds_read_tr16_b64_v4i16((LAS s16x4*)(b_ + ra_off[t] + ks * 16 * T_RS)));
                const s16x4 hh = __builtin_bit_cast(s16x4, __builtin_amdgcn_ds_read_tr16_b64_v4i16((LAS s16x4*)(b_ + ra_off[t] + (ks * 16 + 4) * T_RS)));
                fa[t] = (bf16x8){lo[0], lo[1], lo[2], lo[3], hh[0], hh[1], hh[2], hh[3]}; }
#pragma unroll
            for (int t = 0; t < 2; ++t) fb[t] = *(const bf16x8*)(b_ + cb_off[t] + ks * 32);
#pragma unroll
            for (int a = 0; a < 4; ++a)
#pragma unroll
                for (int b = 0; b < 2; ++b) acc[a][b] = __builtin_amdgcn_mfma_f32_32x32x16_bf16(fa[a], fb[b], acc[a][b], 0, 0, 0);
        }
        G2_STORE((kt + 1) & 1);
        __syncthreads();
    }
#undef G2_LOAD
#undef G2_STORE
#pragma unroll
    for (int a = 0; a < 4; ++a)
#pragma unroll
        for (int b = 0; b < 2; ++b) epi(ti0 + wi * 128 + a * 32, tj0 + wj * 64 + b * 32, acc[a][b], l31, hi);
}
template <bool TR, class Epi>
DEV void gemm_phase(char* lds, const bf16_t* R, size_t ldr, const bf16_t* C, size_t ldc, int nI, int nJ, int K, const Epi& epi) {
    const int tI = nI / 256, tJ = nJ / 128, nt = tI * tJ;
    for (int t = blockIdx.x; t < nt; t += gridDim.x) {
        const int ti = t / tJ, tj = t % tJ;
        gemm_tile<TR, Epi>(lds, R + (size_t)ti * 256 * ldr, ldr, C + (size_t)tj * 128 * ldc, ldc, K, epi, ti * 256, tj * 128);
    }
}

struct EpiRaw {
    bf16_t* O; size_t ld;
    DEV void operator()(int i0, int j0, const f32x16& a, int l31, int hi) const {
#pragma unroll
        for (int r = 0; r < 16; ++r) O[(size_t)(i0 + crow(r, hi)) * ld + j0 + l31] = f2bf(a[r]);
    }
};
struct EpiUq {
    bf16_t* QM; const float* cos32; const float* sin32;
    DEV void operator()(int i0, int j0, const f32x16& a, int l31, int hi) const {
        const bool pe = (j0 % 96) == 64;
        const int fi = l31 & 7; const bool colang = (l31 & 16) != 0; const bool bpart = (l31 & 8) != 0;
#pragma unroll
        for (int r = 0; r < 16; ++r) {
            const int tok = i0 + crow(r, hi); float v = a[r];
            const float o = __shfl_xor(v, 8);
            if (pe) { const int l = tok & (SEQ - 1); const int pos = colang ? (l & 63) : (l >> 6);
                const float cs = cos32[pos * 8 + fi], sn = sin32[pos * 8 + fi];
                v = bpart ? (v * cs + o * sn) : (v * cs - o * sn); }
            QM[(size_t)tok * 768 + j0 + l31] = f2bf(v * QSC_M);
        }
    }
};
struct EpiUkv {
    bf16_t* KM; bf16_t* VM;
    DEV void operator()(int i0, int j0, const f32x16& a, int l31, int hi) const {
        const int h = j0 >> 7, e = (j0 & 127) + l31;
#pragma unroll
        for (int r = 0; r < 16; ++r) { const size_t row = (size_t)(i0 + crow(r, hi));
            if (e < 64) KM[row * 768 + h * 96 + e] = f2bf(a[r]); else VM[row * 512 + h * 64 + (e - 64)] = f2bf(a[r]); }
    }
};
struct EpiRes {
    const float* base; float* out; const float* mod; float gmul;
    DEV void operator()(int i0, int j0, const f32x16& a, int l31, int hi) const {
        const int b = i0 >> 12; const float g = mod[b * 3072 + 2048 + j0 + l31] * gmul;
#pragma unroll
        for (int h8 = 0; h8 < 2; ++h8) { float bv[8];
#pragma unroll
            for (int r = 0; r < 8; ++r) bv[r] = base[(size_t)(i0 + crow(8 * h8 + r, hi)) * DM + j0 + l31];
#pragma unroll
            for (int r = 0; r < 8; ++r) out[(size_t)(i0 + crow(8 * h8 + r, hi)) * DM + j0 + l31] = bv[r] + g * a[8 * h8 + r]; }
    }
};
struct EpiPT {
    bf16_t* PT;
    DEV void operator()(int i0, int j0, const f32x16& a, int l31, int hi) const {
        const int b = j0 >> 12, l = (j0 & 4095) + l31;
#pragma unroll
        for (int r = 0; r < 16; ++r) PT[((size_t)(b * 4096 + i0 + crow(r, hi))) * 4096 + l] = f2bf(a[r]);
    }
};
struct EpiFilt {
    bf16_t* GR; const float* b3;
    DEV void operator()(int i0, int j0, const f32x16& a, int l31, int hi) const {
        const int t = j0 + l31; const float tn = (float)t * (1.0f / 4095.0f);
        const float dmin = -3.0701134573253945f, dmax = -15.350567286626973f;
#pragma unroll
        for (int r = 0; r < 16; ++r) {
            const int n = i0 + crow(r, hi); const int c = n & 1023, od = n >> 10, o = od >> 1, dir = od & 1;
            const float delta = fabsf(dmin + (float)c * ((dmax - dmin) / 1023.0f));
            const float v = (a[r] + b3[n]) * __expf(-tn * delta);
            bf16_t* g = GR + ((size_t)(o * 1024 + c)) * 8192;
            if (dir == 0) g[4096 - t] = f2bf(v);
            else { if (t == 0) g[0] = 0; else g[4096 + t] = f2bf(v); }
        }
    }
};
DEV void filt_sums(const Params& p) {
    const int wid = TID() >> 6, lane = TID() & 63; bf16_t* GR = (bf16_t*)(p.ws + WS_GR); float* ssum = (float*)(p.ws + WS_SSUM);
    for (int row = blockIdx.x * 8 + wid; row < 2048; row += gridDim.x * 8) {
        bf16_t* g = GR + (size_t)row * 8192; float s = 0.f;
        u32x4 w[16];
#pragma unroll
        for (int j = 0; j < 16; ++j) w[j] = *(const u32x4*)(g + (j * 64 + lane) * 8);
#pragma unroll
        for (int j = 0; j < 16; ++j) { float v[8]; unpack8(w[j], v);
            if (j == 0 && lane == 0) v[0] = 0.f;
#pragma unroll
            for (int e = 0; e < 8; ++e) s += fabsf(v[e]); }
        s = wave_sum(s);
        if (lane == 0) ssum[row] = s;
    }
}

namespace pg8 {
#define PG8_LAS __attribute__((address_space(3)))
typedef short bf16x8 __attribute__((ext_vector_type(8)));
typedef float f32x4 __attribute__((ext_vector_type(4)));
typedef unsigned u32x4 __attribute__((ext_vector_type(4)));
constexpr int BM = 256, BK = 64, HALF = 128, HTB = HALF * BK * 2  , STAGE_BYTES = 8 * HTB, NXCD = 8, WGM = 8;

__host__ __device__ __forceinline__ int lds_byte(int r, int c) { const int st = (r >> 4) * 2 + (c >> 5), rr = r & 15, cc = c & 31, ob = rr * 64 + cc * 2; return st * 1024 + (ob ^ (((ob >> 9) & 1) << 5)); }
__host__ __device__ __forceinline__ void stage_rc(int b, int& R, int& C) { const int st = b / 1024, sb = b % 1024, swz = sb ^ (((sb >> 9) & 1) << 5); R = (st >> 1) * 16 + swz / 64; C = (st & 1) * 32 + (swz % 64) / 2; }
__host__ __device__ __forceinline__ int perm32(int rho) { const int n = rho >> 4, i = rho & 15; return 8 * (i >> 2) + 4 * n + (i & 3); }

struct Unit { int pm, pn; };
struct Gemm { const bf16_t* A; const bf16_t* Bt; int M, N, K; };

struct StaticOrder {
    int nM, nN, nwg, G, c;
    __host__ __device__ void init(int M, int N, int G_, int c_) { nM = M / BM; nN = N / BM; nwg = nM * nN; G = G_; c = c_; }
    __host__ __device__ bool next(int i, Unit& u) const {
        const long L = (long)i * G + c; if (L >= nwg) return false;
        int wgid = (int)L; { const int q = nwg / NXCD, r = nwg % NXCD, xcd = wgid % NXCD, off = wgid / NXCD; wgid = (xcd < r ? xcd * (q + 1) : r * (q + 1) + (xcd - r) * q) + off; }
        const int nig = WGM * nN, gid = wgid / nig, fm = gid * WGM, gsz = (nM - fm) < WGM ? (nM - fm) : WGM;
        u.pm = fm + ((wgid % nig) % gsz); u.pn = (wgid % nig) / gsz; return true;
    }
    __device__ __forceinline__ void a_ready(const Unit&) const {}
    __device__ __forceinline__ void done(const Unit&) const {}
};

__device__ __forceinline__ unsigned cvt_pk_bf16(float lo, float hi) { unsigned r; asm volatile("v_cvt_pk_bf16_f32 %0, %1, %2" : "=v"(r) : "v"(lo), "v"(hi)); return r; }
typedef float f32x2 __attribute__((ext_vector_type(2)));

struct EpiBf16 {
    static constexpr bool PERM = true, AFTER_DRAIN = false;
    bf16_t* O; size_t ldc; int split_cols; size_t split_stride;
    __device__ __forceinline__ void operator()(const f32x4 (&acc)[2][2][4][2], const Unit& u, int wr, int wc, int fr, int fq) const {
        const int row0 = u.pm * BM + wr * 64 + fr; int colt = u.pn * BM; bf16_t* base = O;
        if (split_cols) { const int t = colt / split_cols; base += (size_t)t * split_stride; colt -= t * split_cols; }
        const int col0 = colt + wc * 32 + 8 * fq;
#pragma unroll
        for (int ai = 0; ai < 2; ++ai)
#pragma unroll
            for (int m = 0; m < 4; ++m) { bf16_t* rowp = base + (size_t)(row0 + ai * HALF + m * 16) * ldc + col0;
#pragma unroll
                for (int bj = 0; bj < 2; ++bj) { const f32x4 v0 = acc[ai][bj][m][0], v1 = acc[ai][bj][m][1];
                    u32x4 w; w.x = cvt_pk_bf16(v0[0], v0[1]); w.y = cvt_pk_bf16(v0[2], v0[3]); w.z = cvt_pk_bf16(v1[0], v1[1]); w.w = cvt_pk_bf16(v1[2], v1[3]);
                    *(u32x4*)(rowp + bj * HALF) = w; } }
    }
};

struct EpiUkvPg {
    static constexpr bool PERM = true, AFTER_DRAIN = false;
    bf16_t* KM; bf16_t* VM;
    __device__ __forceinline__ void operator()(const f32x4 (&acc)[2][2][4][2], const Unit& u, int wr, int wc, int fr, int fq) const {
        { const int ln = lane_id(); fr = ln & 15; fq = ln >> 4; }
        const int row0 = u.pm * BM + wr * 64 + fr; const int e0 = 32 * wc + 8 * fq;
        const bool isk = (wc < 2);
        bf16_t* base = isk ? KM + (size_t)row0 * 768 + 2 * u.pn * 96 + e0 : VM + (size_t)row0 * 512 + 2 * u.pn * 64 + (e0 - 64);
        const int ld = isk ? 768 : 512, hs = isk ? 96 : 64;
#pragma unroll
        for (int ai = 0; ai < 2; ++ai)
#pragma unroll
            for (int m = 0; m < 4; ++m)
#pragma unroll
                for (int bj = 0; bj < 2; ++bj) { const f32x4 v0 = acc[ai][bj][m][0], v1 = acc[ai][bj][m][1];
                    u32x4 w; w.x = cvt_pk_bf16(v0[0], v0[1]); w.y = cvt_pk_bf16(v0[2], v0[3]); w.z = cvt_pk_bf16(v1[0], v1[1]); w.w = cvt_pk_bf16(v1[2], v1[3]);
                    *(u32x4*)(base + (ai * HALF + m * 16) * ld + bj * hs) = w; }
    }
};
struct EpiUqPg {
    static constexpr bool PERM = true, AFTER_DRAIN = false;
    bf16_t* QM; const float* cos32; const float* sin32; float sc;
    __device__ __forceinline__ void operator()(const f32x4 (&acc)[2][2][4][2], const Unit& u, int wr, int wc, int fr, int fq) const {
        { const int ln = lane_id(); fr = ln & 15; fq = ln >> 4; }
        const int row0 = u.pm * BM + wr * 64 + fr;
        bf16_t* base = QM + (size_t)row0 * 768 + u.pn * BM + 32 * wc + 8 * fq;
        const int g0 = 8 * u.pn + wc;
        const bool sgn = (fq & 1) != 0;
#pragma unroll
        for (int bj = 0; bj < 2; ++bj) { const bool pe = (((g0 + 4 * bj) % 3) == 2);
#pragma unroll
            for (int ai = 0; ai < 2; ++ai)
#pragma unroll
                for (int m = 0; m < 4; ++m) { const int rr = ai * HALF + m * 16; u32x4 w;
#pragma unroll
                    for (int n = 0; n < 2; ++n) { f32x4 v = acc[ai][bj][m][n];
                        if (pe) { f32x4 o;
#pragma unroll
                            for (int e = 0; e < 4; ++e) o[e] = __shfl_xor(v[e], 16);
                            const int l = (row0 + rr) & 4095, pos = (fq < 2) ? (l >> 6) : (l & 63);
                            const f32x4 cv = *(const f32x4*)(cos32 + pos * 8 + 4 * n), sv = *(const f32x4*)(sin32 + pos * 8 + 4 * n);
                            v = sgn ? (v * cv + o * sv) : (v * cv - o * sv); }
                        v = v * sc;
                        if (n == 0) { w.x = cvt_pk_bf16(v[0], v[1]); w.y = cvt_pk_bf16(v[2], v[3]); } else { w.z = cvt_pk_bf16(v[0], v[1]); w.w = cvt_pk_bf16(v[2], v[3]); } }
                    *(u32x4*)(base + rr * 768 + bj * HALF) = w;
                    asm volatile("" ::: "memory"); } }
    }
};
struct EpiResF32 {
    static constexpr bool PERM = false, AFTER_DRAIN = false;
    const float* base; float* out; const float* mod; float gmul;
    __device__ __forceinline__ void operator()(const f32x4 (&acc)[2][2][4][2], const Unit& u, int wr, int wc, int fr, int fq) const {
        const int row0 = u.pm * BM + wr * 64 + fr, col0 = u.pn * BM + wc * 32 + 4 * fq, b = (u.pm * BM) >> 12;
        f32x4 g[2][2];
#pragma unroll
        for (int bj = 0; bj < 2; ++bj)
#pragma unroll
            for (int n = 0; n < 2; ++n) g[bj][n] = *(const f32x4*)(mod + b * 3072 + 2048 + col0 + bj * HALF + n * 16) * gmul;
#pragma unroll
        for (int ai = 0; ai < 2; ++ai) {
            f32x4 pre[4][2][2];
#pragma unroll
            for (int m = 0; m < 4; ++m) { const size_t off = (size_t)(row0 + ai * HALF + m * 16) * 1024 + col0;
#pragma unroll
                for (int bj = 0; bj < 2; ++bj)
#pragma unroll
                    for (int n = 0; n < 2; ++n) pre[m][bj][n] = *(const f32x4*)(base + off + bj * HALF + n * 16); }
#pragma unroll
            for (int m = 0; m < 4; ++m) { const size_t off = (size_t)(row0 + ai * HALF + m * 16) * 1024 + col0;
#pragma unroll
                for (int bj = 0; bj < 2; ++bj)
#pragma unroll
                    for (int n = 0; n < 2; ++n) *(f32x4*)(out + off + bj * HALF + n * 16) = pre[m][bj][n] + g[bj][n] * acc[ai][bj][m][n]; }
        }
    }
};
template <class Epi, class Sched, bool ALIGN_EPI = false, bool SP2 = false>
__device__ __forceinline__ void gemm_phase(PG8_LAS unsigned char* lds, const Gemm g, const Sched& S, const Epi& E) {
    int tid_ = TID(); asm volatile("" : "+v"(tid_));
    const int tid = tid_, wid = __builtin_amdgcn_readfirstlane(tid >> 6), lane = tid & 63, wr = wid >> 2, wc = wid & 3, fr = lane & 15, fq = lane >> 4;
    const int K = g.K, nt = K / BK;
    unsigned voffA[2], voffB[2];
#pragma unroll
    for (int i = 0; i < 2; ++i) { int R, C; stage_rc(tid * 16 + i * 8192, R, C); const int Rb = Epi::PERM ? ((R & ~31) + perm32(R & 31)) : R;
        voffA[i] = (unsigned)(R * K + C) * 2u; voffB[i] = (unsigned)(Rb * K + C) * 2u; }
    const size_t kstep = (size_t)(BK * 2);
    const size_t hstep = (size_t)HALF * K * 2;
    const size_t tstep = 2 * hstep;
    const unsigned ldsw = (unsigned)wid * 1024u;
    const int aoff = lds_byte(wr * 64 + fr, fq * 8), boff = lds_byte(wc * 32 + fr, fq * 8);
#define PG8_SA(b, h) (((b) * 2 + (h)) * HTB)
#define PG8_SB(b, h) ((4 + (b) * 2 + (h)) * HTB)
#define PG8_STAGE(bufoff, gbase, voff) do { _Pragma("unroll") for (int _i = 0; _i < 2; ++_i) \
        __builtin_amdgcn_global_load_lds((const unsigned*)((const char*)(gbase) + (voff)[_i]), (PG8_LAS unsigned*)(lds + (bufoff) + ldsw + _i * 8192), 16, 0, 0); } while (0)
#define PG8_LDA(dst, b, h) do { _Pragma("unroll") for (int m = 0; m < 4; ++m) _Pragma("unroll") for (int k = 0; k < 2; ++k) dst[m][k] = *(const PG8_LAS bf16x8*)(lds + PG8_SA(b, h) + aoff + m * 2048 + k * 1024); } while (0)
#define PG8_LDB(dst, b, h) do { _Pragma("unroll") for (int n = 0; n < 2; ++n) _Pragma("unroll") for (int k = 0; k < 2; ++k) dst[n][k] = *(const PG8_LAS bf16x8*)(lds + PG8_SB(b, h) + boff + n * 2048 + k * 1024); } while (0)
#define PG8_MMA(ai, bj, At, Bt) do { __builtin_amdgcn_s_setprio(1); _Pragma("unroll") for (int m = 0; m < 4; ++m) _Pragma("unroll") for (int n = 0; n < 2; ++n) _Pragma("unroll") for (int k = 0; k < 2; ++k) \
        acc[ai][bj][m][n] = __builtin_amdgcn_mfma_f32_16x16x32_bf16(Bt[n][k], At[m][k], acc[ai][bj][m][n], 0, 0, 0); __builtin_amdgcn_s_setprio(0); } while (0)
#define PG8_WAIT_V(n) asm volatile("s_waitcnt vmcnt(" #n ")" ::: "memory")
#define PG8_WAIT_L(n) asm volatile("s_waitcnt lgkmcnt(" #n ")" ::: "memory")
#define PG8_BAR __builtin_amdgcn_s_barrier()
#define PG8_SCHED __builtin_amdgcn_sched_barrier(0)
    Unit cur, nxt; int ui = 0;
    if (!S.next(0, cur)) return;
    f32x4 acc[2][2][4][2];
#pragma unroll
    for (int a = 0; a < 2; ++a)
#pragma unroll
        for (int b = 0; b < 2; ++b)
#pragma unroll
            for (int m = 0; m < 4; ++m)
#pragma unroll
                for (int n = 0; n < 2; ++n) acc[a][b][m][n] = (f32x4){0.f, 0.f, 0.f, 0.f};
    bf16x8 At[4][2], B0[2][2], B1[2][2];
    const char* cA = (const char*)g.A + (size_t)cur.pm * tstep; const char* cB = (const char*)g.Bt + (size_t)cur.pn * tstep;
    S.a_ready(cur);
    if constexpr (SP2) {
        PG8_STAGE(PG8_SB(0, 0), cB, voffB); PG8_STAGE(PG8_SB(0, 1), cB + hstep, voffB); PG8_STAGE(PG8_SA(0, 0), cA, voffA); PG8_STAGE(PG8_SA(0, 1), cA + hstep, voffA);
        if (wr == 1) PG8_BAR;
        PG8_WAIT_V(2); PG8_BAR;
        PG8_STAGE(PG8_SB(1, 0), cB + kstep, voffB); PG8_STAGE(PG8_SA(1, 0), cA + kstep, voffA); PG8_STAGE(PG8_SB(1, 1), cB + hstep + kstep, voffB);
        PG8_WAIT_V(6); PG8_BAR;
    } else {
        PG8_STAGE(PG8_SB(0, 0), cB, voffB); PG8_STAGE(PG8_SA(0, 0), cA, voffA); PG8_STAGE(PG8_SB(0, 1), cB + hstep, voffB); PG8_STAGE(PG8_SA(0, 1), cA + hstep, voffA);
        if (wr == 1) PG8_BAR;
        PG8_WAIT_V(4); PG8_BAR;
        PG8_STAGE(PG8_SB(1, 0), cB + kstep, voffB); PG8_STAGE(PG8_SA(1, 0), cA + kstep, voffA); PG8_STAGE(PG8_SB(1, 1), cB + hstep + kstep, voffB);
        PG8_WAIT_V(6); PG8_BAR;
    }
    for (;;) {
        const bool has_next = S.next(ui + 1, nxt);
        const char* nA = has_next ? (const char*)g.A + (size_t)nxt.pm * tstep : cA; const char* nB = has_next ? (const char*)g.Bt + (size_t)nxt.pn * tstep : cB;
        for (int t = 0; t < nt; t += 2) {
            const bool last = (t == nt - 2);
            const char* a1 = cA + (size_t)(t + 1) * kstep;
            const char* a2 = last ? nA : cA + (size_t)(t + 2) * kstep; const char* b2 = last ? nB : cB + (size_t)(t + 2) * kstep;
            const char* a3 = a2 + kstep; const char* b3 = b2 + kstep;
            if (last && has_next) S.a_ready(nxt);
            if constexpr (SP2) {
            PG8_LDB(B0, 0, 0); PG8_LDB(B1, 0, 1); PG8_SCHED; PG8_LDA(At, 0, 0); PG8_STAGE(PG8_SA(1, 1), a1 + hstep, voffA);
            PG8_WAIT_V(8); PG8_WAIT_L(0); PG8_BAR; PG8_MMA(0, 0, At, B0); PG8_MMA(0, 1, At, B1); PG8_BAR; PG8_SCHED;
            PG8_LDA(At, 0, 1); PG8_STAGE(PG8_SB(0, 0), b2, voffB); PG8_STAGE(PG8_SB(0, 1), b2 + hstep, voffB); PG8_STAGE(PG8_SA(0, 0), a2, voffA);
            PG8_WAIT_V(8); PG8_WAIT_L(0); PG8_BAR; PG8_MMA(1, 0, At, B0); PG8_MMA(1, 1, At, B1); PG8_BAR; PG8_SCHED;
            PG8_LDB(B0, 1, 0); PG8_LDB(B1, 1, 1); PG8_SCHED; PG8_LDA(At, 1, 0); PG8_STAGE(PG8_SA(0, 1), a2 + hstep, voffA);
            PG8_WAIT_V(8); PG8_WAIT_L(0); PG8_BAR; PG8_MMA(0, 0, At, B0); PG8_MMA(0, 1, At, B1); PG8_BAR; PG8_SCHED;
            PG8_LDA(At, 1, 1); PG8_STAGE(PG8_SB(1, 0), b3, voffB); PG8_STAGE(PG8_SB(1, 1), b3 + hstep, voffB); PG8_STAGE(PG8_SA(1, 0), a3, voffA);
            PG8_WAIT_V(8); PG8_WAIT_L(0); PG8_BAR; PG8_MMA(1, 0, At, B0); PG8_MMA(1, 1, At, B1); PG8_BAR; PG8_SCHED;
            } else {
            PG8_LDB(B0, 0, 0); PG8_SCHED; PG8_LDA(At, 0, 0); PG8_STAGE(PG8_SA(1, 1), a1 + hstep, voffA);
            PG8_WAIT_L(8); PG8_BAR; PG8_WAIT_L(0); PG8_MMA(0, 0, At, B0); PG8_BAR; PG8_SCHED;
            PG8_LDB(B1, 0, 1); PG8_STAGE(PG8_SB(0, 0), b2, voffB);
            PG8_BAR; PG8_WAIT_L(0); PG8_MMA(0, 1, At, B1); PG8_BAR;
            PG8_LDA(At, 0, 1); PG8_STAGE(PG8_SA(0, 0), a2, voffA);
            PG8_BAR; PG8_WAIT_L(0); PG8_MMA(1, 0, At, B0); PG8_BAR; PG8_SCHED;
            PG8_STAGE(PG8_SB(0, 1), b2 + hstep, voffB);
            PG8_WAIT_V(6); PG8_BAR; PG8_MMA(1, 1, At, B1); PG8_BAR;
            PG8_LDB(B0, 1, 0); PG8_SCHED; PG8_LDA(At, 1, 0); PG8_STAGE(PG8_SA(0, 1), a2 + hstep, voffA);
            PG8_WAIT_L(8); PG8_BAR; PG8_WAIT_L(0); PG8_MMA(0, 0, At, B0); PG8_BAR; PG8_SCHED;
            PG8_LDB(B1, 1, 1); PG8_STAGE(PG8_SB(1, 0), b3, voffB);
            PG8_BAR; PG8_WAIT_L(0); PG8_MMA(0, 1, At, B1); PG8_BAR;
            PG8_LDA(At, 1, 1); PG8_STAGE(PG8_SA(1, 0), a3, voffA);
            PG8_BAR; PG8_WAIT_L(0); PG8_MMA(1, 0, At, B0); PG8_BAR; PG8_SCHED;
            PG8_STAGE(PG8_SB(1, 1), b3 + hstep, voffB);
            PG8_WAIT_V(6); PG8_BAR; PG8_MMA(1, 1, At, B1); PG8_BAR;
            }
        }
        if constexpr (ALIGN_EPI) { if (wr == 0) PG8_BAR; }
        if constexpr (!Epi::AFTER_DRAIN) { E(acc, cur, wr, wc, fr, fq); S.done(cur); }
        if (!has_next) break;
#pragma unroll
        for (int a = 0; a < 2; ++a)
#pragma unroll
            for (int b = 0; b < 2; ++b)
#pragma unroll
                for (int m = 0; m < 4; ++m)
#pragma unroll
                    for (int n = 0; n < 2; ++n) acc[a][b][m][n] = (f32x4){0.f, 0.f, 0.f, 0.f};
        cur = nxt; cA = nA; cB = nB; ++ui;
        if constexpr (ALIGN_EPI) { if (wr == 1) PG8_BAR; }
    }
    PG8_WAIT_V(0);
    if constexpr (!ALIGN_EPI) { if (wr == 0) PG8_BAR; }
    PG8_BAR;
    if constexpr (Epi::AFTER_DRAIN) { E.fused(acc, cur, wr, wc, fr, fq, lds, wid, lane); S.done(cur); }
#undef PG8_SA
#undef PG8_SB
#undef PG8_STAGE
#undef PG8_LDA
#undef PG8_LDB
#undef PG8_MMA
#undef PG8_WAIT_V
#undef PG8_WAIT_L
#undef PG8_BAR
#undef PG8_SCHED
}
}

DEV void transpose_item(float* scr, const float* W, int K, int N, int Npad, bf16_t* WT, int item, int lane) {
    const int nblk = Npad / 32, kb = item / nblk, nb = item % nblk, k0 = 64 * kb, n0 = 32 * nb;
    const bool valid = (n0 < N);
    float v[32];
#pragma unroll
    for (int i = 0; i < 32; ++i) { const int kk = 2 * i + (lane >> 5); v[i] = valid ? W[(size_t)(k0 + kk) * N + n0 + (lane & 31)] : 0.f; }
#pragma unroll
    for (int i = 0; i < 32; ++i) { const int kk = 2 * i + (lane >> 5); scr[kk * 33 + (lane & 31)] = v[i]; }
    asm volatile("s_waitcnt lgkmcnt(0)" ::: "memory");
    const int c = lane & 7;
#pragma unroll
    for (int j = 0; j < 4; ++j) { const int n = (lane >> 3) + 8 * j; const float* sp = scr + (8 * c) * 33 + n; float o[8];
#pragma unroll
        for (int e = 0; e < 8; ++e) o[e] = sp[e * 33];
        *(u32x4*)(WT + (size_t)(n0 + n) * K + k0 + 8 * c) = pack8(o); }
    asm volatile("s_waitcnt lgkmcnt(0)" ::: "memory");
}

DEV void mod_item(char* lds, const Params& p, int item) {
    const int layer = item / 96, n0 = (item % 96) * 32, tid = TID();
    float* s = (float*)lds;
    float* red = s + 9 * 1024;
    for (int i = tid; i < 9 * 1024; i += 512) { const int v = i >> 10, k = i & 1023; const float cv = (v < 8) ? p.c[v * 1024 + k] : p.c_ctx[k]; s[i] = silu(cv); }
    __syncthreads();
    const int kc = tid >> 5, n = tid & 31; const float* W = p.ada_w + (size_t)layer * DM * 3072 + n0 + n;
    float acc[9];
#pragma unroll
    for (int v = 0; v < 9; ++v) acc[v] = 0.f;
#pragma unroll 16
    for (int kk = 0; kk < 64; ++kk) { const int k = kc * 64 + kk; const float w = W[(size_t)k * 3072];
#pragma unroll
        for (int v = 0; v < 9; ++v) acc[v] += s[v * 1024 + k] * w; }
#pragma unroll
    for (int v = 0; v < 9; ++v) red[(kc * 9 + v) * 32 + n] = acc[v];
    __syncthreads();
    if (tid < 9 * 32) { const int v = tid >> 5, nn = tid & 31; float t = 0.f;
#pragma unroll
        for (int k2 = 0; k2 < 16; ++k2) t += red[(k2 * 9 + v) * 32 + nn];
        t += p.ada_b[layer * 3072 + n0 + nn];
        if (layer == 0) ((float*)(p.ws + WS_MOD0))[v * 3072 + n0 + nn] = t;
        else if (v < 8) ((float*)(p.ws + WS_MOD1))[v * 3072 + n0 + nn] = t; }
    __syncthreads();
}

DEV void hid2_row(char* lds, const Params& p, int t, int wid, int lane) {
    float* sc = (float*)lds + wid * 128;
    const float tn = (float)t * (1.0f / 4095.0f);
    const float w = (float)(2.0 * 3.14159265358979323846 / 4096.0) * (float)t;
    float e = 0.f;
    if (lane == 0) e = tn;
    else if (lane <= 32) { const int k = (lane - 1) & 15; const float band = 1e-4f + (float)k * ((15.0f - 1e-4f) / 15.0f); const float ang = w * band; e = (lane <= 16) ? cosf(ang) : -sinf(ang); }
    sc[lane] = e;
    asm volatile("s_waitcnt lgkmcnt(0)" ::: "memory");
    float a = p.f_b1[lane];
    for (int i = 0; i < 33; ++i) a += sc[i] * p.f_w1[i * 64 + lane];
    const float fr = p.freq[lane];
    const float h1 = sinf(fr * a);
    sc[64 + lane] = h1;
    asm volatile("s_waitcnt lgkmcnt(0)" ::: "memory");
    float a2 = p.f_b2[lane];
    for (int i = 0; i < 64; ++i) a2 += sc[64 + i] * p.f_w2[i * 64 + lane];
    const float h2 = sinf(fr * a2);
    ((bf16_t*)(p.ws + WS_HID2))[t * 64 + lane] = f2bf(h2);
    asm volatile("s_waitcnt lgkmcnt(0)" ::: "memory");
}

DEV void phase_prep(char* lds, const Params& p) {
    const int tid = TID(), wid = tid >> 6, lane = tid & 63;
    { const int gt = blockIdx.x * 512 + tid;
        if (gt < 2048) ((float*)(p.ws + WS_SSUM))[gt] = 0.f;
        float* rp = (float*)(p.ws + WS_ROPE);
        if (gt < 1024) { const int pos = gt >> 4, i = gt & 15; const float inv = exp2f(-(float)i * (13.287712379549449f / 16.0f)); const float ang = (float)pos * inv; rp[gt] = cosf(ang); rp[1024 + gt] = sinf(ang); }
        if (gt < 512) { const int pos = gt >> 3, i = gt & 7; const float inv = exp2f(-(float)i * (13.287712379549449f / 8.0f)); const float ang = (float)pos * inv; rp[2048 + gt] = cosf(ang); rp[2560 + gt] = sinf(ang); } }
    for (int it = blockIdx.x; it < 192; it += gridDim.x) mod_item(lds, p, it);
    for (int t = blockIdx.x * 8 + wid; t < 4096; t += gridDim.x * 8) hid2_row(lds, p, t, wid, lane);
    __syncthreads();
    constexpr int I_WIN = 16 * (AINP / 32), I_UQ = 4 * 24, I_UKV = 2 * 32, I_WO = 16 * 32, I_HIN = 16 * 128, I_HO = 16 * 32, I_W3 = 128;
    constexpr int NIT = I_WIN + I_UQ + I_UKV + I_WO + I_HIN + I_HO + I_W3;
    float* scr = (float*)lds + wid * (64 * 33);
    for (int it = blockIdx.x * 8 + wid; it < NIT; it += gridDim.x * 8) {
        int r = it;
        if (r < I_HIN) { transpose_item(scr, p.hy_w_in, 1024, 4096, 4096, (bf16_t*)(p.ws + WS_HWIN), r, lane); continue; } r -= I_HIN;
        if (r < I_WIN) { transpose_item(scr, p.w_in, 1024, AIN, AINP, (bf16_t*)(p.ws + WS_WIN), r, lane); continue; } r -= I_WIN;
        if (r < I_WO) { transpose_item(scr, p.w_out, 1024, 1024, 1024, (bf16_t*)(p.ws + WS_WOUT), r, lane); continue; } r -= I_WO;
        if (r < I_HO) { transpose_item(scr, p.hy_w_out, 1024, 1024, 1024, (bf16_t*)(p.ws + WS_HWOUT), r, lane); continue; } r -= I_HO;
        if (r < I_UQ) { transpose_item(scr, p.w_uq, 256, 768, 768, (bf16_t*)(p.ws + WS_WUQ), r, lane); continue; } r -= I_UQ;
        if (r < I_UKV) { transpose_item(scr, p.w_ukv, 128, 1024, 1024, (bf16_t*)(p.ws + WS_WUKV), r, lane); continue; } r -= I_UKV;
        transpose_item(scr, p.f_w3, 64, 4096, 4096, (bf16_t*)(p.ws + WS_W3), r, lane);
    }
}

DEV void row_load(f32x4 (&v)[4], const float* xr, int lane) {
#pragma unroll
    for (int j = 0; j < 4; ++j) v[j] = *(const f32x4*)(xr + lane * 4 + 256 * j);
}
DEV void modnorm_row(const f32x4 (&v)[4], const float* nw, const float* shift, const float* scale, bf16_t* orow, int lane) {
    float s = 0.f;
#pragma unroll
    for (int j = 0; j < 4; ++j) s += v[j].x * v[j].x + v[j].y * v[j].y + v[j].z * v[j].z + v[j].w * v[j].w;
    const float r = rsqrtf(wave_sum(s) * (1.0f / DM) + EPS);
#pragma unroll
    for (int j = 0; j < 4; ++j) { const int c0 = lane * 4 + 256 * j;
        const f32x4 w = *(const f32x4*)(nw + c0), sh = *(const f32x4*)(shift + c0), sc = *(const f32x4*)(scale + c0);
        const float o0 = v[j].x * r * w.x * (1.f + sc.x) + sh.x, o1 = v[j].y * r * w.y * (1.f + sc.y) + sh.y, o2 = v[j].z * r * w.z * (1.f + sc.z) + sh.z, o3 = v[j].w * r * w.w * (1.f + sc.w) + sh.w;
        u32x2 pk; pk.x = pk2(o0, o1); pk.y = pk2(o2, o3); *(u32x2*)(orow + c0) = pk; }
}
DEV const float* norm0_src(const Params& p, int row) { return row < NTOK ? p.x + (size_t)row * DM : p.ctx + (size_t)(row - NTOK) * DM; }
DEV void phase_norm0(const Params& p) {
    const int wid = TID() >> 6, lane = TID() & 63; const float* mod0 = (const float*)(p.ws + WS_MOD0); bf16_t* H0 = (bf16_t*)(p.ws + WS_H0);
    const int stride = gridDim.x * 8; int row = blockIdx.x * 8 + wid;
    f32x4 cur[4], nxt[4];
    if (row < NALL) row_load(cur, norm0_src(p, row), lane);
    for (; row < NALL; row += stride) {
        { const int rn = row + stride < NALL ? row + stride : row; row_load(nxt, norm0_src(p, rn), lane); }
        const int v = row < NTOK ? (row >> 12) : 8;
        modnorm_row(cur, p.norm_w, mod0 + v * 3072, mod0 + v * 3072 + 1024, H0 + (size_t)row * DM, lane);
#pragma unroll
        for (int j = 0; j < 4; ++j) cur[j] = nxt[j];
    }
}
DEV void phase_norm1(const Params& p) {
    const int wid = TID() >> 6, lane = TID() & 63; const float* mod1 = (const float*)(p.ws + WS_MOD1); bf16_t* H1 = (bf16_t*)(p.ws + WS_H1);
    const int stride = gridDim.x * 8; int row = blockIdx.x * 8 + wid;
    f32x4 cur[4], nxt[4];
    if (row < NTOK) row_load(cur, p.out + (size_t)row * DM, lane);
    for (; row < NTOK; row += stride) {
        { const int rn = row + stride < NTOK ? row + stride : row; row_load(nxt, p.out + (size_t)rn * DM, lane); }
        const int v = row >> 12;
        modnorm_row(cur, p.norm_w + DM, mod1 + v * 3072, mod1 + v * 3072 + 1024, H1 + (size_t)row * DM, lane);
#pragma unroll
        for (int j = 0; j < 4; ++j) cur[j] = nxt[j];
    }
}
DEV void phase_final(const Params& p) {
    const int wid = TID() >> 6, lane = TID() & 63;
    const int stride = gridDim.x * 8; int row = blockIdx.x * 8 + wid;
    f32x4 v[4], nxt[4];
    if (row < NTOK) row_load(v, p.out + (size_t)row * DM, lane);
    for (; row < NTOK; row += stride) {
        { const int rn = row + stride < NTOK ? row + stride : row; row_load(nxt, p.out + (size_t)rn * DM, lane); }
        float* xr = p.out + (size_t)row * DM; float s = 0.f;
#pragma unroll
        for (int j = 0; j < 4; ++j) s += v[j].x * v[j].x + v[j].y * v[j].y + v[j].z * v[j].z + v[j].w * v[j].w;
        const float r = rsqrtf(wave_sum(s) * (1.0f / DM) + EPS);
#pragma unroll
        for (int j = 0; j < 4; ++j) { const int c0 = lane * 4 + 256 * j; const f32x4 w = *(const f32x4*)(p.final_w + c0);
            f32x4 o; o.x = v[j].x * r * w.x; o.y = v[j].y * r * w.y; o.z = v[j].z * r * w.z; o.w = v[j].w * r * w.w; *(f32x4*)(xr + c0) = o; }
#pragma unroll
        for (int j = 0; j < 4; ++j) v[j] = nxt[j];
    }
}

struct PostIn { u32x4 raw[5]; f32x4 c64[2], s64[2], c32[2], s32[2]; };
DEV void post_load(PostIn& I, const bf16_t* PRAW, const float* rp, int tok, int lane) {
    const bf16_t* pr = PRAW + (size_t)tok * AINP;
#pragma unroll
    for (int sgm = 0; sgm < 4; ++sgm) I.raw[sgm] = *(const u32x4*)(pr + 512 * sgm + lane * 8);
    I.raw[4] = *(const u32x4*)(pr + 2048 + (lane & 31) * 8);
    const int l = tok & 4095, prow = l >> 6, pcol = l & 63;
    const int k = lane & 7, posv = (k < 4) ? prow : pcol; const float* t64 = rp + posv * 16 + (k & 1) * 8;
    I.c64[0] = *(const f32x4*)t64; I.c64[1] = *(const f32x4*)(t64 + 4); I.s64[0] = *(const f32x4*)(t64 + 1024); I.s64[1] = *(const f32x4*)(t64 + 1028);
    const int k3 = lane & 3, posm = (k3 < 2) ? prow : pcol; const float* t32 = rp + 2048 + posm * 8;
    I.c32[0] = *(const f32x4*)t32; I.c32[1] = *(const f32x4*)(t32 + 4); I.s32[0] = *(const f32x4*)(t32 + 512); I.s32[1] = *(const f32x4*)(t32 + 516);
}
DEV void phase_post(const Params& p) {
    const int wid = TID() >> 6, lane = TID() & 63;
    const bf16_t* PRAW = (const bf16_t*)(p.ws + WS_PRAW);
    bf16_t* QA = (bf16_t*)(p.ws + WS_QA); bf16_t* KA = (bf16_t*)(p.ws + WS_KA); bf16_t* VA = (bf16_t*)(p.ws + WS_VA);
    bf16_t* CQN = (bf16_t*)(p.ws + WS_CQN); bf16_t* CKVN = (bf16_t*)(p.ws + WS_CKVN); bf16_t* G = (bf16_t*)(p.ws + WS_G); bf16_t* KM = (bf16_t*)(p.ws + WS2_KM);
    const float* rp = (const float*)(p.ws + WS_ROPE);
    float wq[8], wk[8], wcq[8], wckv[8];
    { const int k = lane & 7;
#pragma unroll
        for (int j = 0; j < 8; ++j) { wq[j] = p.q_norm[k * 8 + j]; wk[j] = p.k_norm[k * 8 + j]; wcq[j] = p.cq_norm[(lane & 31) * 8 + j]; wckv[j] = p.ckv_norm[(lane & 15) * 8 + j]; } }
    const int stride = gridDim.x * 8;
    int tok = blockIdx.x * 8 + wid;
    PostIn cur, nxt;
    if (tok < NALL) post_load(cur, PRAW, rp, tok, lane);
    for (; tok < NALL; tok += stride) {
        { const int tn = tok + stride < NALL ? tok + stride : tok; post_load(nxt, PRAW, rp, tn, lane); }
        const bool lat = tok < NTOK; int b, pos;
        if (lat) { b = tok >> 12; pos = CTXL + (tok & 4095); } else { const int j = tok - NTOK; b = j >> 8; pos = j & 255; }
        const size_t kvrow = (size_t)b * LK + pos;
        const float cs64[8] = {cur.c64[0].x, cur.c64[0].y, cur.c64[0].z, cur.c64[0].w, cur.c64[1].x, cur.c64[1].y, cur.c64[1].z, cur.c64[1].w};
        const float sn64[8] = {cur.s64[0].x, cur.s64[0].y, cur.s64[0].z, cur.s64[0].w, cur.s64[1].x, cur.s64[1].y, cur.s64[1].z, cur.s64[1].w};
        float v[8], o[8];
        if (lat) {
            unpack8(cur.raw[0], v);
            float ss = 0.f;
#pragma unroll
            for (int j = 0; j < 8; ++j) ss += v[j] * v[j];
            ss += __shfl_xor(ss, 1); ss += __shfl_xor(ss, 2); ss += __shfl_xor(ss, 4);
            const float r = rsqrtf(ss * (1.0f / 64.0f) + EPS); const int k = lane & 7;
#pragma unroll
            for (int j = 0; j < 8; ++j) v[j] = v[j] * r * wq[j];
#pragma unroll
            for (int j = 0; j < 8; ++j) { const float ot = __shfl_xor(v[j], 2);
                o[j] = ((k & 2) ? (v[j] * cs64[j] + ot * sn64[j]) : (v[j] * cs64[j] - ot * sn64[j])) * QSC_A; }
            *(u32x4*)(QA + (size_t)tok * 512 + lane * 8) = pack8(o);
        }
        {
            const u32x4 raw = cur.raw[1]; unpack8(raw, v);
            float ss = 0.f;
#pragma unroll
            for (int j = 0; j < 8; ++j) ss += v[j] * v[j];
            ss += __shfl_xor(ss, 1); ss += __shfl_xor(ss, 2); ss += __shfl_xor(ss, 4);
            const float s8 = ss;
            ss += __shfl_xor(ss, 8); ss += __shfl_xor(ss, 16);
            const float s32 = ss;
            float vn[8]; const int k = lane & 7;
            { const float r = rsqrtf(s8 * (1.0f / 64.0f) + EPS);
#pragma unroll
                for (int j = 0; j < 8; ++j) vn[j] = v[j] * r * wk[j]; }
#pragma unroll
            for (int j = 0; j < 8; ++j) { const float ot = __shfl_xor(vn[j], 2);
                o[j] = lat ? ((k & 2) ? (vn[j] * cs64[j] + ot * sn64[j]) : (vn[j] * cs64[j] - ot * sn64[j])) : vn[j]; }
            if (lane < 16) *(u32x4*)(KA + kvrow * 128 + lane * 8) = pack8(o);
            else if (lane < 32) *(u32x4*)(VA + kvrow * 128 + (lane - 16) * 8) = raw;
            else if (lat) { const float r = rsqrtf(s32 * (1.0f / 256.0f) + EPS); const int cb = (lane - 32) * 8;
#pragma unroll
                for (int j = 0; j < 8; ++j) o[j] = v[j] * r * wcq[j];
                *(u32x4*)(CQN + (size_t)tok * 256 + cb) = pack8(o); }
        }
        {
            unpack8(cur.raw[2], v);
            float ss = 0.f;
#pragma unroll
            for (int j = 0; j < 8; ++j) ss += v[j] * v[j];
            ss += __shfl_xor(ss, 1); ss += __shfl_xor(ss, 2); ss += __shfl_xor(ss, 4); ss += __shfl_xor(ss, 8);
            const int k = lane & 3;
            float oth[8];
#pragma unroll
            for (int j = 0; j < 8; ++j) oth[j] = __shfl_xor(v[j], 1);
            if (lane < 16) { const float r = rsqrtf(ss * (1.0f / 128.0f) + EPS);
#pragma unroll
                for (int j = 0; j < 8; ++j) o[j] = v[j] * r * wckv[j];
                *(u32x4*)(CKVN + kvrow * 128 + lane * 8) = pack8(o); }
            else if (lane < 20) {
                const float cs32[8] = {cur.c32[0].x, cur.c32[0].y, cur.c32[0].z, cur.c32[0].w, cur.c32[1].x, cur.c32[1].y, cur.c32[1].z, cur.c32[1].w};
                const float sn32[8] = {cur.s32[0].x, cur.s32[0].y, cur.s32[0].z, cur.s32[0].w, cur.s32[1].x, cur.s32[1].y, cur.s32[1].z, cur.s32[1].w};
#pragma unroll
                for (int j = 0; j < 8; ++j) o[j] = lat ? ((k & 1) ? (v[j] * cs32[j] + oth[j] * sn32[j]) : (v[j] * cs32[j] - oth[j] * sn32[j])) : v[j];
                const u32x4 w = pack8(o);
#pragma unroll
                for (int h = 0; h < 8; ++h) *(u32x4*)(KM + kvrow * 768 + h * 96 + 64 + k * 8) = w; }
            else if (lat) {
#pragma unroll
                for (int j = 0; j < 8; ++j) o[j] = silu(v[j]);
                *(u32x4*)(G + (size_t)tok * 1024 + (lane - 20) * 8) = pack8(o); }
        }
        if (lat) {
            unpack8(cur.raw[3], v);
#pragma unroll
            for (int j = 0; j < 8; ++j) o[j] = silu(v[j]);
            *(u32x4*)(G + (size_t)tok * 1024 + 352 + lane * 8) = pack8(o);
            if (lane < 20) { unpack8(cur.raw[4], v);
#pragma unroll
                for (int j = 0; j < 8; ++j) o[j] = silu(v[j]);
                *(u32x4*)(G + (size_t)tok * 1024 + 864 + lane * 8) = pack8(o); }
        }
        cur = nxt;
    }
}

template <int DQK>
DEV void attn_unit(char* lds, const bf16_t* __restrict__ Q, int ldq, int qcol, const bf16_t* __restrict__ Kp, int ldk, int kcol, const bf16_t* __restrict__ Vp, int ldv, int vcol,
                   const bf16_t* __restrict__ Gt, bf16_t* OG, int ocol, int b, int q0) {
    constexpr int KRS = (DQK + 8) * 2, KB = 64 * KRS, VRS = 192, VB = 64 * VRS, STG = KB + VB, NKS = DQK / 16, KCH = DQK / 8;
    const int tid = TID(), lane = tid & 63, wid = tid >> 6, l31 = lane & 31, hi = lane >> 5;
    bf16x8 qf[NKS];
    { const bf16_t* qp = Q + (size_t)(b * SEQ + q0 + wid * 32 + l31) * ldq + qcol + hi * 8;
#pragma unroll
        for (int ks = 0; ks < NKS; ++ks) qf[ks] = *(const bf16x8*)(qp + ks * 16); }
    const bf16_t* kbase = Kp + (size_t)b * LK * ldk + kcol; const bf16_t* vbase = Vp + (size_t)b * LK * ldv + vcol;
    const int kr0 = tid / KCH, kc0 = tid % KCH;
    const int kr1 = (tid + 512) / KCH, kc1 = (tid + 512) % KCH;
    const bool k2 = (KCH * 64 > 512) && (tid + 512 < KCH * 64);
    const int vr = tid >> 3, vc = tid & 7;
    u32x4 sk0, sk1, sv;
#define A_LOAD(t) do { const size_t kp_ = (size_t)(t) * 64; sk0 = *(const u32x4*)(kbase + (kp_ + kr0) * ldk + kc0 * 8); \
        if (k2) sk1 = *(const u32x4*)(kbase + (kp_ + kr1) * ldk + kc1 * 8); sv = *(const u32x4*)(vbase + (kp_ + vr) * ldv + vc * 8); } while (0)
#define A_STORE(buf) do { char* b_ = lds + (buf) * STG; *(u32x4*)(b_ + kr0 * KRS + kc0 * 16) = sk0; if (k2) *(u32x4*)(b_ + kr1 * KRS + kc1 * 16) = sk1; \
        *(u32x4*)(b_ + KB + vr * VRS + vc * 16) = sv; } while (0)
    f32x16 o0, o1;
#pragma unroll
    for (int r = 0; r < 16; ++r) { o0[r] = 0.f; o1[r] = 0.f; }
    float m_run = -1e30f, l_run = 0.f;
    const int g1 = (lane >> 4) & 1, tq = (lane & 15) >> 2, tp = lane & 3;
    const int vt_off = KB + (4 * hi + tq) * VRS + (16 * g1 + 4 * tp) * 2;
    const int kf_off = l31 * KRS + hi * 16;
    constexpr int NT = LK / 64;
    A_LOAD(0); A_STORE(0);
    __syncthreads();
    for (int t = 0; t < NT; ++t) {
        const bool more = (t + 1 < NT);
        if (more) A_LOAD(t + 1);
        const char* b_ = lds + (t & 1) * STG;
        f32x16 p0, p1;
#pragma unroll
        for (int r = 0; r < 16; ++r) { p0[r] = 0.f; p1[r] = 0.f; }
#pragma unroll
        for (int ks = 0; ks < NKS; ++ks) {
            const bf16x8 ka = *(const bf16x8*)(b_ + kf_off + ks * 32);
            const bf16x8 kb = *(const bf16x8*)(b_ + kf_off + 32 * KRS + ks * 32);
            p0 = __builtin_amdgcn_mfma_f32_32x32x16_bf16(ka, qf[ks], p0, 0, 0, 0);
            p1 = __builtin_amdgcn_mfma_f32_32x32x16_bf16(kb, qf[ks], p1, 0, 0, 0);
        }
        float mx = p0[0];
#pragma unroll
        for (int r = 1; r < 16; ++r) mx = fmaxf(mx, p0[r]);
#pragma unroll
        for (int r = 0; r < 16; ++r) mx = fmaxf(mx, p1[r]);
        mx = fmaxf(mx, __shfl_xor(mx, 32));
        const float m_new = fmaxf(m_run, mx);
        const float alpha = __builtin_amdgcn_exp2f(m_run - m_new);
        m_run = m_new;
        float ls = 0.f;
#pragma unroll
        for (int r = 0; r < 16; ++r) { p0[r] = __builtin_amdgcn_exp2f(p0[r] - m_new); p1[r] = __builtin_amdgcn_exp2f(p1[r] - m_new); ls += p0[r] + p1[r]; }
        l_run = l_run * alpha + ls;
#pragma unroll
        for (int r = 0; r < 16; ++r) { o0[r] *= alpha; o1[r] *= alpha; }
        u32x4 pw[4];
        pw[0] = (u32x4){pk2(p0[0], p0[1]), pk2(p0[2], p0[3]), pk2(p0[4], p0[5]), pk2(p0[6], p0[7])};
        pw[1] = (u32x4){pk2(p0[8], p0[9]), pk2(p0[10], p0[11]), pk2(p0[12], p0[13]), pk2(p0[14], p0[15])};
        pw[2] = (u32x4){pk2(p1[0], p1[1]), pk2(p1[2], p1[3]), pk2(p1[4], p1[5]), pk2(p1[6], p1[7])};
        pw[3] = (u32x4){pk2(p1[8], p1[9]), pk2(p1[10], p1[11]), pk2(p1[12], p1[13]), pk2(p1[14], p1[15])};
#pragma unroll
        for (int s = 0; s < 4; ++s) {
            const bf16x8 pb = __builtin_bit_cast(bf16x8, pw[s]);
#pragma unroll
            for (int dt = 0; dt < 2; ++dt) {
                const char* vp = b_ + vt_off + s * 16 * VRS + dt * 64;
                const s16x4 lo = __builtin_bit_cast(s16x4, __builtin_amdgcn_ds_read_tr16_b64_v4i16((LAS s16x4*)vp));
                const s16x4 hh = __builtin_bit_cast(s16x4, __builtin_amdgcn_ds_read_tr16_b64_v4i16((LAS s16x4*)(vp + 8 * VRS)));
                const bf16x8 vf = (bf16x8){lo[0], lo[1], lo[2], lo[3], hh[0], hh[1], hh[2], hh[3]};
                if (dt == 0) o0 = __builtin_amdgcn_mfma_f32_32x32x16_bf16(vf, pb, o0, 0, 0, 0);
                else o1 = __builtin_amdgcn_mfma_f32_32x32x16_bf16(vf, pb, o1, 0, 0, 0);
            }
        }
        if (more) A_STORE((t + 1) & 1);
        __syncthreads();
    }
#undef A_LOAD
#undef A_STORE
    const float lt = l_run + __shfl_xor(l_run, 32); const float inv = 1.0f / lt;
    const size_t tok = (size_t)(b * SEQ + q0 + wid * 32 + l31);
#pragma unroll
    for (int dt = 0; dt < 2; ++dt)
#pragma unroll
        for (int g = 0; g < 4; ++g) { const int d = 32 * dt + 8 * g + 4 * hi; const size_t off = tok * 1024 + ocol + d;
            const u32x2 gw = *(const u32x2*)(Gt + off);
            const f32x16& oo = dt ? o1 : o0;
            u32x2 w; w.x = pk2(oo[4 * g] * inv * lo_bf(gw.x), oo[4 * g + 1] * inv * hi_bf(gw.x)); w.y = pk2(oo[4 * g + 2] * inv * lo_bf(gw.y), oo[4 * g + 3] * inv * hi_bf(gw.y));
            *(u32x2*)(OG + off) = w; }
}

DEV float max3f_s(float a, float b, float c) { float r; asm("v_max3_f32 %0, %1, %2, %3" : "=v"(r) : "v"(a), "v"(b), "v"(c)); return r; }
DEV float max2f_s(float a, float b) { float r; asm("v_max_f32_e32 %0, %1, %2" : "=v"(r) : "v"(a), "v"(b)); return r; }
DEV float fadd_s(float a, float b) { float r; asm("v_add_f32_e32 %0, %1, %2" : "=v"(r) : "v"(a), "v"(b)); return r; }
DEV float sum8_after_trans(float a, float b, float c, float d, float e, float f, float g, float h) {
    float r, t;
    asm("s_nop 0\n\tv_add_f32_e32 %0, %2, %3\n\tv_add_f32_e32 %1, %4, %5\n\tv_add_f32_e32 %0, %0, %6\n\tv_add_f32_e32 %1, %1, %7\n\tv_add_f32_e32 %0, %0, %8\n\tv_add_f32_e32 %1, %1, %9\n\tv_add_f32_e32 %0, %0, %1"
        : "=&v"(r), "=&v"(t) : "v"(a), "v"(b), "v"(c), "v"(d), "v"(e), "v"(f), "v"(g), "v"(h));
    return r;
}
DEV float swapmax32(float v) { auto rr = __builtin_amdgcn_permlane32_swap(__float_as_uint(v), __float_as_uint(v), false, false); return fmaxf(__uint_as_float(rr[0]), __uint_as_float(rr[1])); }
DEV float swapsum32(float v) { auto rr = __builtin_amdgcn_permlane32_swap(__float_as_uint(v), __float_as_uint(v), false, false); return __uint_as_float(rr[0]) + __uint_as_float(rr[1]); }
template <int DQK>
DEV void attn_unit2(char* lds, const bf16_t* __restrict__ Q, int ldq, int qcol, const bf16_t* __restrict__ Kp, int ldk, int kcol, const bf16_t* __restrict__ Vp, int ldv, int vcol,
                    const bf16_t* __restrict__ Gt, bf16_t* OG, int ocol, int b, int q0) {
    constexpr int KRS = (DQK + 8) * 2, KB = 64 * KRS, VRS = 192, VB = 64 * VRS, NKS = DQK / 16, KCH = DQK / 8, VOFF = 2 * KB;
    constexpr float THR = 8.0f;
    constexpr int NT = LK / 64;
    const int tid = TID(), lane = tid & 63, wid = tid >> 6, l31 = lane & 31, hi = lane >> 5;
    bf16x8 qf[NKS];
    { const bf16_t* qp = Q + (size_t)(b * SEQ + q0 + wid * 32 + l31) * ldq + qcol + hi * 8;
#pragma unroll
        for (int ks = 0; ks < NKS; ++ks) qf[ks] = *(const bf16x8*)(qp + ks * 16); }
    const bf16_t* kbase = Kp + (size_t)b * LK * ldk + kcol; const bf16_t* vbase = Vp + (size_t)b * LK * ldv + vcol;
    constexpr bool K2 = (KCH * 64 > 512);
    const bool k2 = K2 && (tid + 512 < KCH * 64);
    const int kr0 = tid / KCH, kc0 = tid % KCH, kr1 = k2 ? (tid + 512) / KCH : kr0, kc1 = k2 ? (tid + 512) % KCH : kc0;
    const int vr = tid >> 3, vc = tid & 7;
    u32x4 skX0, skX1 = {0u, 0u, 0u, 0u}, svX;
#define A_LOADK(t, S) do { const int tt_ = (t) < NT ? (t) : NT - 1; const size_t kp_ = (size_t)tt_ * 64; sk##S##0 = *(const u32x4*)(kbase + (kp_ + kr0) * ldk + kc0 * 8); if (K2) sk##S##1 = *(const u32x4*)(kbase + (kp_ + kr1) * ldk + kc1 * 8); } while (0)
#define A_LOADV(t, S) do { const int tt_ = (t) < NT ? (t) : NT - 1; sv##S = *(const u32x4*)(vbase + ((size_t)tt_ * 64 + vr) * ldv + vc * 8); } while (0)
#define A_STOREK(slot, S) do { char* b_ = lds + (slot) * KB; *(u32x4*)(b_ + kr0 * KRS + kc0 * 16) = sk##S##0; if (K2) *(u32x4*)(b_ + kr1 * KRS + kc1 * 16) = sk##S##1; } while (0)
#define A_STOREV(slot, S) do { *(u32x4*)(lds + VOFF + (slot) * VB + vr * VRS + vc * 16) = sv##S; } while (0)
    f32x16 o0, o1, negm;
#pragma unroll
    for (int r = 0; r < 16; ++r) { o0[r] = 0.f; o1[r] = 0.f; negm[r] = 0.f; }
    asm volatile("" : "+v"(negm));
    float mhat = 0.f, l_run = 0.f;
    const int g1 = (lane >> 4) & 1, tq = (lane & 15) >> 2, tp = lane & 3;
    const int vt_off = VOFF + (4 * hi + tq) * VRS + (16 * g1 + 4 * tp) * 2;
    const int kf_off = l31 * KRS + hi * 16;
#define A_QK(P0, P1, slot) do { const char* kb_ = lds + (slot) * KB + kf_off; \
        _Pragma("unroll") for (int ks = 0; ks < NKS; ++ks) { \
            const bf16x8 ka = *(const bf16x8*)(kb_ + ks * 32); const bf16x8 kb2 = *(const bf16x8*)(kb_ + 32 * KRS + ks * 32); \
            if (ks == 0) { P0 = __builtin_amdgcn_mfma_f32_32x32x16_bf16(ka, qf[0], negm, 0, 0, 0); P1 = __builtin_amdgcn_mfma_f32_32x32x16_bf16(kb2, qf[0], negm, 0, 0, 0); } \
            else { P0 = __builtin_amdgcn_mfma_f32_32x32x16_bf16(ka, qf[ks], P0, 0, 0, 0); P1 = __builtin_amdgcn_mfma_f32_32x32x16_bf16(kb2, qf[ks], P1, 0, 0, 0); } } } while (0)
    A_LOADK(0, X); A_LOADV(0, X); A_STOREK(0, X); A_STOREV(0, X); A_LOADK(1, X); A_STOREK(1, X);
    __syncthreads();
    f32x16 pA0, pA1, pB0, pB1;
#pragma unroll
    for (int r = 0; r < 16; ++r) { pB0[r] = 0.f; pB1[r] = 0.f; }
    A_QK(pA0, pA1, 0);
#define A_STEP(P0, P1, N0, N1, t, SL, SS) do { \
        A_LOADK((t) + 2, SL); A_LOADV((t) + 1, SL); \
        __builtin_amdgcn_s_setprio(1); A_QK(N0, N1, ((t) + 1) & 1); __builtin_amdgcn_s_setprio(0); \
        float a_ = fmaxf(fmaxf(P0[0], P0[1]), P1[0]), c_ = fmaxf(fmaxf(P0[2], P0[3]), P1[1]); a_ = fmaxf(fmaxf(a_, P1[2]), P1[3]); \
        _Pragma("unroll") for (int r = 4; r < 16; r += 4) { a_ = fmaxf(fmaxf(a_, P0[r]), P0[r + 1]); c_ = fmaxf(fmaxf(c_, P0[r + 2]), P0[r + 3]); a_ = fmaxf(fmaxf(a_, P1[r]), P1[r + 1]); c_ = fmaxf(fmaxf(c_, P1[r + 2]), P1[r + 3]); } \
        const float rm = swapmax32(fmaxf(a_, c_)); \
        if ((t) == 0 || __any(rm > THR)) { \
            const float dl = ((t) == 0) ? rm : fmaxf(rm, 0.f); mhat += dl; \
            _Pragma("unroll") for (int r = 0; r < 16; ++r) { P0[r] -= dl; P1[r] -= dl; N0[r] -= dl; N1[r] -= dl; } \
            if ((t) != 0) { const float f = __builtin_amdgcn_exp2f(-dl); l_run *= f; _Pragma("unroll") for (int r = 0; r < 16; ++r) { o0[r] *= f; o1[r] *= f; } } \
            _Pragma("unroll") for (int r = 0; r < 16; ++r) negm[r] = -mhat; asm volatile("" : "+v"(negm)); } \
        _Pragma("unroll") for (int r = 0; r < 16; ++r) { P0[r] = __builtin_amdgcn_exp2f(P0[r]); P1[r] = __builtin_amdgcn_exp2f(P1[r]); } \
        { const float q0_ = sum8_after_trans(P0[0], P0[1], P0[2], P0[3], P0[4], P0[5], P0[6], P0[7]), q1_ = sum8_after_trans(P0[8], P0[9], P0[10], P0[11], P0[12], P0[13], P0[14], P0[15]); \
          const float q2_ = sum8_after_trans(P1[0], P1[1], P1[2], P1[3], P1[4], P1[5], P1[6], P1[7]), q3_ = sum8_after_trans(P1[8], P1[9], P1[10], P1[11], P1[12], P1[13], P1[14], P1[15]); \
          l_run += (q0_ + q1_) + (q2_ + q3_); } \
        u32x4 pw[4]; \
        pw[0] = (u32x4){pk2(P0[0], P0[1]), pk2(P0[2], P0[3]), pk2(P0[4], P0[5]), pk2(P0[6], P0[7])}; \
        pw[1] = (u32x4){pk2(P0[8], P0[9]), pk2(P0[10], P0[11]), pk2(P0[12], P0[13]), pk2(P0[14], P0[15])}; \
        pw[2] = (u32x4){pk2(P1[0], P1[1]), pk2(P1[2], P1[3]), pk2(P1[4], P1[5]), pk2(P1[6], P1[7])}; \
        pw[3] = (u32x4){pk2(P1[8], P1[9]), pk2(P1[10], P1[11]), pk2(P1[12], P1[13]), pk2(P1[14], P1[15])}; \
        { const char* vb_ = lds + ((t) & 1) * VB + vt_off; \
        _Pragma("unroll") for (int s = 0; s < 4; ++s) { const bf16x8 pb = __builtin_bit_cast(bf16x8, pw[s]); \
            _Pragma("unroll") for (int dt = 0; dt < 2; ++dt) { const char* vp = vb_ + s * 16 * VRS + dt * 64; \
                const s16x4 lo = __builtin_bit_cast(s16x4, __builtin_amdgcn_ds_read_tr16_b64_v4i16((LAS s16x4*)vp)); \
                const s16x4 hh = __builtin_bit_cast(s16x4, __builtin_amdgcn_ds_read_tr16_b64_v4i16((LAS s16x4*)(vp + 8 * VRS))); \
                const bf16x8 vf = (bf16x8){lo[0], lo[1], lo[2], lo[3], hh[0], hh[1], hh[2], hh[3]}; \
                if (dt == 0) o0 = __builtin_amdgcn_mfma_f32_32x32x16_bf16(vf, pb, o0, 0, 0, 0); else o1 = __builtin_amdgcn_mfma_f32_32x32x16_bf16(vf, pb, o1, 0, 0, 0); } } } \
        A_STOREK((t) & 1, SS); A_STOREV(((t) + 1) & 1, SS); \
        __syncthreads(); } while (0)
    for (int t = 0; t < NT; t += 2) {
        A_STEP(pA0, pA1, pB0, pB1, t, X, X);
        A_STEP(pB0, pB1, pA0, pA1, t + 1, X, X);
    }
#undef A_STEP
#undef A_QK
#undef A_LOADK
#undef A_LOADV
#undef A_STOREK
#undef A_STOREV
    const float inv = 1.0f / swapsum32(l_run);
    const size_t tok = (size_t)(b * SEQ + q0 + wid * 32 + l31);
#pragma unroll
    for (int dt = 0; dt < 2; ++dt)
#pragma unroll
        for (int g = 0; g < 4; ++g) { const int d = 32 * dt + 8 * g + 4 * hi; const size_t off = tok * 1024 + ocol + d;
            const u32x2 gw = *(const u32x2*)(Gt + off);
            const f32x16& oo = dt ? o1 : o0;
            u32x2 w; w.x = pk2(oo[4 * g] * inv * lo_bf(gw.x), oo[4 * g + 1] * inv * hi_bf(gw.x)); w.y = pk2(oo[4 * g + 2] * inv * lo_bf(gw.y), oo[4 * g + 3] * inv * hi_bf(gw.y));
            *(u32x2*)(OG + off) = w; }
}

namespace at3 {
typedef LAS const char* lds_cptr;
constexpr int SLOTV = 8192;
DEV void glds16(const void* gsrc, unsigned lds_dst) { unsigned keep;
    asm volatile("s_mov_b32 %0, m0\n\ts_mov_b32 m0, %2\n\ts_nop 0\n\tglobal_load_lds_dwordx4 %1, off\n\ts_mov_b32 m0, %0" : "=&s"(keep) : "v"(gsrc), "s"(lds_dst) : "memory"); }
DEV float fsub_s(float a, float b) { float r; asm("v_sub_f32_e32 %0, %1, %2" : "=v"(r) : "v"(a), "v"(b)); return r; }
DEV s16x4 vtr(lds_cptr p) { return __builtin_bit_cast(s16x4, __builtin_amdgcn_ds_read_tr16_b64_v4i16((LAS s16x4*)p)); }
DEV void kload2(bf16x8* kf, lds_cptr kp, int j) { kf[2 * j] = *(const LAS bf16x8*)(kp + j * 2048); kf[2 * j + 1] = *(const LAS bf16x8*)(kp + j * 2048 + 512); }
DEV float rowmax(const f32x16& p0, const f32x16& p1) {
    float a = max3f_s(p0[0], p0[1], p1[0]), b = max3f_s(p0[2], p0[3], p1[1]); a = max3f_s(a, p1[2], p1[3]);
#pragma unroll
    for (int r = 4; r < 16; r += 4) { a = max3f_s(a, p0[r], p0[r + 1]); b = max3f_s(b, p0[r + 2], p0[r + 3]); a = max3f_s(a, p1[r], p1[r + 1]); b = max3f_s(b, p1[r + 2], p1[r + 3]); }
    const float m = max2f_s(a, b);
    auto rr = __builtin_amdgcn_permlane32_swap(__float_as_uint(m), __float_as_uint(m), false, false);
    return max2f_s(__uint_as_float(rr[0]), __uint_as_float(rr[1]));
}
DEV void pv(f32x16* o, int vb, bf16x8 pa0, bf16x8 pa1, bf16x8 pa2, bf16x8 pa3) {
#pragma unroll
    for (int d0 = 0; d0 < 2; ++d0) { s16x4 lo[4], hi[4];
#pragma unroll
        for (int ks = 0; ks < 4; ++ks) {
            asm volatile("ds_read_b64_tr_b16 %0,%1 offset:%c2" : "=&v"(lo[ks]) : "v"(vb), "i"(d0 * 4096 + ks * 1024) : "memory");
            asm volatile("ds_read_b64_tr_b16 %0,%1 offset:%c2" : "=&v"(hi[ks]) : "v"(vb), "i"(d0 * 4096 + ks * 1024 + 512) : "memory"); }
        asm volatile("s_waitcnt lgkmcnt(0)" ::: "memory"); __builtin_amdgcn_sched_barrier(0);
#define AT_PK(k) (bf16x8){lo[k][0], lo[k][1], lo[k][2], lo[k][3], hi[k][0], hi[k][1], hi[k][2], hi[k][3]}
        o[d0] = __builtin_amdgcn_mfma_f32_32x32x16_bf16(pa0, AT_PK(0), o[d0], 0, 0, 0);
        o[d0] = __builtin_amdgcn_mfma_f32_32x32x16_bf16(pa1, AT_PK(1), o[d0], 0, 0, 0);
        o[d0] = __builtin_amdgcn_mfma_f32_32x32x16_bf16(pa2, AT_PK(2), o[d0], 0, 0, 0);
        o[d0] = __builtin_amdgcn_mfma_f32_32x32x16_bf16(pa3, AT_PK(3), o[d0], 0, 0, 0);
#undef AT_PK
    }
}
#define AT_SBAR() __builtin_amdgcn_sched_barrier(0)
#define AT_WAIT_BAR(N) asm volatile("s_waitcnt vmcnt(%c0) lgkmcnt(0)\n\ts_barrier" :: "i"(N) : "memory")
#define AT_MFMA(a, b, c) __builtin_amdgcn_mfma_f32_32x32x16_bf16(a, b, c, 0, 0, 0)

template <int DQK>
DEV void attn_unit3(char* shm, const bf16_t* __restrict__ Q, int ldq, int qcol, const bf16_t* __restrict__ Kp, int ldk, int kcol, const bf16_t* __restrict__ Vp, int ldv, int vcol,
                    const bf16_t* __restrict__ Gt, bf16_t* OG, int ocol, int b, int q0) {
    constexpr int NKS = DQK / 16, KD = (DQK > 64) ? 2 : 1, SLOTK = DQK * 128;
    constexpr int L_K = 0, L_V = 3 * SLOTK, L_WS = L_V + 3 * SLOTV, L_OST = L_WS + 8 * 256;
    constexpr int NT = LK / 64;
    constexpr float THRL = 8.0f;
    const int tid = TID(), lane = tid & 63, r32 = lane & 31, hi = lane >> 5; const int wid = __builtin_amdgcn_readfirstlane(tid >> 6);
    const bf16_t* Qw = Q + (size_t)(b * SEQ + q0 + wid * 32) * ldq + qcol;
    const bf16_t* Kh = Kp + (size_t)b * LK * ldk + kcol; const bf16_t* Vh = Vp + (size_t)b * LK * ldv + vcol;
    const unsigned lds0 = (unsigned)(uintptr_t)shm;
    float* wsf = (float*)(shm + L_WS) + wid * 64;
    const bf16_t* ksrc = Kh + (size_t)lane * ldk + wid * 8;
    const int k2el = (8 + (wid & 3) - wid) * 8;
    const bf16_t* vsrc = Vh + (size_t)(16 * (wid & 3) + (lane >> 2)) * ldv + (wid >> 2) * 32 + (lane & 3) * 8;
    const unsigned kdst = lds0 + L_K + wid * 1024, kdst2 = lds0 + L_K + (8 + (wid & 3)) * 1024, vdst = lds0 + L_V + wid * 1024;
#define KOFF(sl) ((DQK == 64) ? (sl) : ((sl) + ((sl) >> 1)))
#define DMA_K(t, sl) do { const bf16_t* s_ = ksrc + (size_t)(t) * 64 * ldk; glds16(s_, (unsigned)__builtin_amdgcn_readfirstlane(kdst + KOFF(sl))); \
        if (KD == 2) glds16(s_ + k2el, (unsigned)__builtin_amdgcn_readfirstlane(kdst2 + KOFF(sl))); } while (0)
#define DMA_V(t, sl) glds16(vsrc + (size_t)(t) * 64 * ldv, (unsigned)__builtin_amdgcn_readfirstlane(vdst + (sl)))
    const int vb0 = (int)(lds0 + L_V) + ((lane >> 4) & 1) * 32 + (lane & 3) * 8 + (4 * hi + ((lane & 15) >> 2)) * 64;
    bf16x8 kf[2 * NKS];
    const lds_cptr shm3 = (lds_cptr)shm; const lds_cptr kp0 = shm3 + L_K + hi * 1024 + r32 * 16;
    const lds_cptr vp0 = shm3 + L_V + ((lane >> 4) & 1) * 32 + (lane & 3) * 8 + (4 * hi + ((lane & 15) >> 2)) * 64;
    DMA_K(0, 0); DMA_V(0, 0); DMA_K(1, SLOTV);
    bf16x8 qr[NKS];
#pragma unroll
    for (int d0 = 0; d0 < NKS; ++d0) qr[d0] = *(const bf16x8*)(Qw + (size_t)r32 * ldq + d0 * 16 + hi * 8);
    float mhat = 0.f, l_reg = 0.f; f32x16 o[2]; o[0] = f32x16{}; o[1] = f32x16{}; f32x16 negm = f32x16{}; asm volatile("" : "+v"(negm));
    bool resc = false;
#define RESC() do { if (resc) { asm volatile("s_waitcnt lgkmcnt(0)" ::: "memory"); \
        _Pragma("unroll") for (int d_ = 0; d_ < 2; ++d_) _Pragma("unroll") for (int r = 0; r < 16; ++r) o[d_][r] *= wsf[crow(r, hi)]; } } while (0)
    f32x16 pA0, pA1, pB0, pB1;
    int sl_prev = 0, sl_cur = 0, sl_next = SLOTV;
#define ROT() do { sl_prev = sl_cur; sl_cur = sl_next; sl_next = (sl_next == 2 * SLOTV) ? 0 : sl_next + SLOTV; } while (0)
    DMA_K(2, 2 * SLOTV);
    AT_WAIT_BAR(1 + 2 * KD);
    {
#pragma unroll
        for (int d0 = 0; d0 < NKS; ++d0) {
            const bf16x8 b0 = *(const LAS bf16x8*)(kp0 + d0 * 2048); const bf16x8 b1 = *(const LAS bf16x8*)(kp0 + d0 * 2048 + 512);
            if (d0 == 0) { pA0 = AT_MFMA(b0, qr[0], negm); pA1 = AT_MFMA(b1, qr[0], negm); } else { pA0 = AT_MFMA(b0, qr[d0], pA0); pA1 = AT_MFMA(b1, qr[d0], pA1); } }
        asm volatile("s_nop 15\n\ts_nop 7" : "+v"(pA0), "+v"(pA1));
        const float rm = rowmax(pA0, pA1);
        mhat = fadd_s(mhat, rm);
#pragma unroll
        for (int r = 0; r < 16; ++r) { pA0[r] = fsub_s(pA0[r], rm); pA1[r] = fsub_s(pA1[r], rm); }
#pragma unroll
        for (int r = 0; r < 16; ++r) negm[r] = -mhat;
        asm volatile("" : "+v"(negm));
#pragma unroll
        for (int r = 0; r < 16; ++r) pA0[r] = __builtin_amdgcn_exp2f(pA0[r]);
#pragma unroll
        for (int r = 0; r < 16; ++r) pA1[r] = __builtin_amdgcn_exp2f(pA1[r]);
    }
    AT_WAIT_BAR(0);
    DMA_K(3, 0); DMA_V(1, SLOTV);
    ROT();
#pragma unroll
    for (int j = 0; j < NKS; ++j) kload2(kf, kp0 + KOFF(sl_cur), j);
    AT_WAIT_BAR(KD + 1);
    s16x4 vlo[8], vhi[8]; u32x4 pw0, pw1, pw2, pw3;
#define PKW(P, B) pk2(P[B], P[B + 1])
#define PAF(k) __builtin_bit_cast(bf16x8, pw##k)
#define VFR(i) (bf16x8){vlo[i][0], vlo[i][1], vlo[i][2], vlo[i][3], vhi[i][0], vhi[i][1], vhi[i][2], vhi[i][3]}
#define PIN(x) asm volatile("" : "+v"(x))
#define MX3(a, b, c) __builtin_fmaxf(__builtin_fmaxf((a), (b)), (c))
#define GAPA(MF, A0, A1, A2, A3, W0, W1, PW) do { MF; sacc += A0; sacc += A1; sacc += A2; sacc += A3; PIN(sacc); W0; W1; PIN(PW); AT_SBAR(); } while (0)
#define EX(v) __builtin_amdgcn_exp2f(v)
#define GAPB(MF, X, B) do { MF; X[B] = EX(X[B]); X[B + 1] = EX(X[B + 1]); X[B + 2] = EX(X[B + 2]); X[B + 3] = EX(X[B + 3]); PIN(X); AT_SBAR(); } while (0)
#define VRD(i) do { vlo[i] = vtr(vp_ + (((i) >> 2) * 4096 + ((i) & 3) * 1024)); vhi[i] = vtr(vp_ + (((i) >> 2) * 4096 + ((i) & 3) * 1024 + 512)); } while (0)
#define KRD(G, j) do { if (G) { kload2(kf, kp0 + KOFF(sl_next), j); AT_SBAR(); } } while (0)
#define STEP(C0, C1, P0, P1, t, GK, GV, GL) do { AT_SBAR(); \
    const lds_cptr vp_ = vp0 + sl_prev; \
    VRD(0); AT_SBAR(); float sacc = (P0[0] + P0[1]); \
    GAPA(C0 = AT_MFMA(kf[0], qr[0], negm), P0[2], P0[3], P0[4], P0[5], pw0[0] = PKW(P0, 0), pw0[1] = PKW(P0, 2), pw0); \
    VRD(4); AT_SBAR(); GAPA(C1 = AT_MFMA(kf[1], qr[0], negm), P0[6], P0[7], P0[8], P0[9], pw0[2] = PKW(P0, 4), pw0[3] = PKW(P0, 6), pw0); \
    VRD(1); AT_SBAR(); GAPA(C0 = AT_MFMA(kf[2], qr[1], C0), P0[10], P0[11], P0[12], P0[13], pw1[0] = PKW(P0, 8), pw1[1] = PKW(P0, 10), pw1); \
    VRD(5); AT_SBAR(); GAPA(C1 = AT_MFMA(kf[3], qr[1], C1), P0[14], P0[15], P1[0], P1[1], pw1[2] = PKW(P0, 12), pw1[3] = PKW(P0, 14), pw1); \
    VRD(2); AT_SBAR(); GAPA(C0 = AT_MFMA(kf[4], qr[2], C0), P1[2], P1[3], P1[4], P1[5], pw2[0] = PKW(P1, 0), pw2[1] = PKW(P1, 2), pw2); \
    VRD(6); AT_SBAR(); GAPA(C1 = AT_MFMA(kf[5], qr[2], C1), P1[6], P1[7], P1[8], P1[9], pw2[2] = PKW(P1, 4), pw2[3] = PKW(P1, 6), pw2); \
    VRD(3); AT_SBAR(); GAPA(C0 = AT_MFMA(kf[6], qr[3], C0), P1[10], P1[11], P1[12], P1[13], pw3[0] = PKW(P1, 8), pw3[1] = PKW(P1, 10), pw3); \
    VRD(7); AT_SBAR(); GAPA(C1 = AT_MFMA(kf[7], qr[3], C1), P1[14], P1[15], 0.f, 0.f, pw3[2] = PKW(P1, 12), pw3[3] = PKW(P1, 14), pw3); \
    if (NKS == 6) { C0 = AT_MFMA(kf[8 % (2 * NKS)], qr[4 % NKS], C0); AT_SBAR(); C1 = AT_MFMA(kf[9 % (2 * NKS)], qr[4 % NKS], C1); AT_SBAR(); \
                    C0 = AT_MFMA(kf[10 % (2 * NKS)], qr[5 % NKS], C0); AT_SBAR(); C1 = AT_MFMA(kf[11 % (2 * NKS)], qr[5 % NKS], C1); AT_SBAR(); } \
    l_reg += sacc; \
    if (GK) { DMA_K((t) + 3, sl_cur); } if (GV) { DMA_V((t) + 1, sl_next); } \
    { float a = MX3(C0[0], C0[1], C1[0]), b_ = MX3(C0[2], C0[3], C1[1]); a = MX3(a, C1[2], C1[3]); \
      _Pragma("unroll") for (int r = 4; r < 16; r += 4) { a = MX3(a, C0[r], C0[r + 1]); b_ = MX3(b_, C0[r + 2], C0[r + 3]); a = MX3(a, C1[r], C1[r + 1]); b_ = MX3(b_, C1[r + 2], C1[r + 3]); } \
      float rm = __builtin_fmaxf(a, b_); { auto rr = __builtin_amdgcn_permlane32_swap(__float_as_uint(rm), __float_as_uint(rm), false, false); rm = __builtin_fmaxf(__uint_as_float(rr[0]), __uint_as_float(rr[1])); } \
      resc = false; \
      if (__builtin_expect(__any(rm > THRL), 0)) { const float dl = __builtin_fmaxf(rm, 0.f); mhat += dl; \
        _Pragma("unroll") for (int r = 0; r < 16; ++r) { C0[r] -= dl; C1[r] -= dl; } \
        _Pragma("unroll") for (int r = 0; r < 16; ++r) negm[r] = -mhat; asm volatile("" : "+v"(negm)); \
        const float f = __builtin_amdgcn_exp2f(-dl); l_reg *= f; if (hi == 0) wsf[r32] = f; resc = true; } } \
    AT_SBAR(); \
    GAPB(o[0] = AT_MFMA(PAF(0), VFR(0), o[0]), C0, 0); \
    GAPB(o[1] = AT_MFMA(PAF(0), VFR(4), o[1]), C0, 4); \
    KRD(GL, 0); GAPB(o[0] = AT_MFMA(PAF(1), VFR(1), o[0]), C0, 8); \
    KRD(GL, 1); GAPB(o[1] = AT_MFMA(PAF(1), VFR(5), o[1]), C0, 12); \
    KRD(GL, 2); GAPB(o[0] = AT_MFMA(PAF(2), VFR(2), o[0]), C1, 0); \
    KRD(GL, 3); GAPB(o[1] = AT_MFMA(PAF(2), VFR(6), o[1]), C1, 4); \
    if (NKS == 6) KRD(GL, 4 % NKS); GAPB(o[0] = AT_MFMA(PAF(3), VFR(3), o[0]), C1, 8); \
    if (NKS == 6) KRD(GL, 5 % NKS); GAPB(o[1] = AT_MFMA(PAF(3), VFR(7), o[1]), C1, 12); \
    } while (0)
    int t = 1;
    for (; t + 5 < NT; t += 2) {
        STEP(pB0, pB1, pA0, pA1, t, true, true, true);     AT_WAIT_BAR(KD + 1); RESC(); ROT();
        STEP(pA0, pA1, pB0, pB1, t + 1, true, true, true); AT_WAIT_BAR(KD + 1); RESC(); ROT();
    }
#define ENDW(tt) do { if ((tt) + 3 < NT) { AT_WAIT_BAR(KD + 1); } else if ((tt) + 2 < NT) { AT_WAIT_BAR(1); } else { AT_WAIT_BAR(0); } } while (0)
    for (; t + 1 < NT; t += 2) {
        STEP(pB0, pB1, pA0, pA1, t, (t + 3 < NT), (t + 1 < NT), (t + 1 < NT));         ENDW(t);     RESC(); ROT();
        STEP(pA0, pA1, pB0, pB1, t + 1, (t + 4 < NT), (t + 2 < NT), (t + 2 < NT));     ENDW(t + 1); RESC(); ROT();
    }
    STEP(pB0, pB1, pA0, pA1, NT - 1, false, false, false); RESC();
    { float sacc = pB0[0] + pB0[1];
#pragma unroll
      for (int r = 2; r < 16; ++r) sacc += pB0[r];
#pragma unroll
      for (int r = 0; r < 16; ++r) sacc += pB1[r];
      l_reg += sacc;
      pw0 = (u32x4){PKW(pB0, 0), PKW(pB0, 2), PKW(pB0, 4), PKW(pB0, 6)}; pw1 = (u32x4){PKW(pB0, 8), PKW(pB0, 10), PKW(pB0, 12), PKW(pB0, 14)};
      pw2 = (u32x4){PKW(pB1, 0), PKW(pB1, 2), PKW(pB1, 4), PKW(pB1, 6)}; pw3 = (u32x4){PKW(pB1, 8), PKW(pB1, 10), PKW(pB1, 12), PKW(pB1, 14)};
      AT_SBAR(); pv(o, vb0 + sl_cur, PAF(0), PAF(1), PAF(2), PAF(3)); }
#undef PKW
#undef PAF
#undef VFR
#undef PIN
#undef MX3
#undef GAPA
#undef GAPB
#undef EX
#undef VRD
#undef KRD
#undef STEP
#undef ENDW
    { auto rr = __builtin_amdgcn_permlane32_swap(__float_as_uint(l_reg), __float_as_uint(l_reg), false, false); l_reg = __uint_as_float(rr[0]) + __uint_as_float(rr[1]); }
    if (hi == 0) wsf[32 + r32] = l_reg; asm volatile("s_waitcnt lgkmcnt(0)" ::: "memory");
    float rli[16];
#pragma unroll
    for (int r = 0; r < 16; ++r) rli[r] = __builtin_amdgcn_rcpf(wsf[32 + crow(r, hi)]);
    { bf16_t* stg = (bf16_t*)(shm + L_OST) + wid * 2048;
#pragma unroll
      for (int r = 0; r < 16; ++r) { const int orow = crow(r, hi);
#pragma unroll
          for (int d0 = 0; d0 < 2; ++d0) stg[orow * 64 + d0 * 32 + r32] = f2bf(o[d0][r] * rli[r]); }
      asm volatile("s_waitcnt lgkmcnt(0)" ::: "memory");
      const size_t tok0 = (size_t)(b * SEQ + q0 + wid * 32);
#pragma unroll
      for (int i = 0; i < 4; ++i) { const int row = i * 8 + (lane >> 3), ch = lane & 7; const u32x4 v = *(const u32x4*)(stg + row * 64 + ch * 8);
          const size_t off = (tok0 + row) * 1024 + ocol + ch * 8; const u32x4 g = *(const u32x4*)(Gt + off);
          u32x4 w; w.x = pk2(lo_bf(v.x) * lo_bf(g.x), hi_bf(v.x) * hi_bf(g.x)); w.y = pk2(lo_bf(v.y) * lo_bf(g.y), hi_bf(v.y) * hi_bf(g.y));
          w.z = pk2(lo_bf(v.z) * lo_bf(g.z), hi_bf(v.z) * hi_bf(g.z)); w.w = pk2(lo_bf(v.w) * lo_bf(g.w), hi_bf(v.w) * hi_bf(g.w));
          *(u32x4*)(OG + off) = w; } }
    asm volatile("s_waitcnt vmcnt(0) lgkmcnt(0)\n\ts_barrier" ::: "memory");
#undef DMA_K
#undef DMA_V
#undef KOFF
#undef RESC
#undef ROT
}
#undef AT_SBAR
#undef AT_WAIT_BAR
#undef AT_MFMA
}

DEV void phase_attn(char* lds, const Params& p) {
    const bf16_t* QA = (const bf16_t*)(p.ws + WS_QA); const bf16_t* KA = (const bf16_t*)(p.ws + WS_KA); const bf16_t* VA = (const bf16_t*)(p.ws + WS_VA);
    const bf16_t* QM = (const bf16_t*)(p.ws + WS_QM); const bf16_t* KM = (const bf16_t*)(p.ws + WS2_KM); const bf16_t* VM = (const bf16_t*)(p.ws + WS2_VM);
    const bf16_t* G = (const bf16_t*)(p.ws + WS_G); bf16_t* OG = (bf16_t*)(p.ws + WS2_OG);
    const int vblk = (gridDim.x % 8 == 0) ? (int)((blockIdx.x % 8) * (gridDim.x / 8) + blockIdx.x / 8) : (int)blockIdx.x;
    for (int u = vblk; u < 2048; u += gridDim.x) {
        const int type = u >> 10, rem = u & 1023, b = rem >> 7, h = (rem >> 4) & 7, qb = rem & 15;
        if (type == 0) at3::attn_unit3<64>(lds, QA, 512, h * 64, KA, 128, (h >> 2) * 64, VA, 128, (h >> 2) * 64, G, OG, h * 64, b, qb * 256);
        else at3::attn_unit3<96>(lds, QM, 768, h * 96, KM, 768, h * 96, VM, 512, h * 64, G, OG, 512 + h * 64, b, qb * 256);
    }
}

constexpr int CV_PADL = 192, CV_ROW = 4488, CV_RS = CV_ROW * 2;
constexpr int CV_UB = 8 * CV_RS;
constexpr int CV_FS = 16416;
DEV void conv_load_filter(char* lds, const bf16_t* gr) {
    const int tid = TID();
#pragma unroll
    for (int rnd = 0; rnd < 2; ++rnd) {
        const int ch = tid + rnd * 512;
        const u32x4 a = *(const u32x4*)(gr + ch * 8);
        u32x4 bq = {0u, 0u, 0u, 0u}; if (ch + 1 < 1024) bq = *(const u32x4*)(gr + ch * 8 + 8);
        const unsigned w[8] = {a.x, a.y, a.z, a.w, bq.x, bq.y, bq.z, bq.w};
        char* f = lds + CV_UB + ch * 16;
        *(u32x4*)(f) = a;
        u32x4 c1, c2, c3;
        c1.x = __builtin_amdgcn_alignbit(w[1], w[0], 16); c1.y = __builtin_amdgcn_alignbit(w[2], w[1], 16); c1.z = __builtin_amdgcn_alignbit(w[3], w[2], 16); c1.w = __builtin_amdgcn_alignbit(w[4], w[3], 16);
        c2 = (u32x4){w[1], w[2], w[3], w[4]};
        c3.x = __builtin_amdgcn_alignbit(w[2], w[1], 16); c3.y = __builtin_amdgcn_alignbit(w[3], w[2], 16); c3.z = __builtin_amdgcn_alignbit(w[4], w[3], 16); c3.w = __builtin_amdgcn_alignbit(w[5], w[4], 16);
        *(u32x4*)(f + CV_FS) = c1; *(u32x4*)(f + 2 * CV_FS) = c2; *(u32x4*)(f + 3 * CV_FS) = c3;
    }
}
DEV void sconv4(const bf16_t* px, int t, float w0, float w1, float w2, float bias, float* u) {
    const u32x2 mid = *(const u32x2*)(px + t);
    const float pm = (t > 0) ? bf2f(px[t - 1]) : 0.f, pp = (t + 4 < SEQ) ? bf2f(px[t + 4]) : 0.f;
    const float q0 = lo_bf(mid.x), q1 = hi_bf(mid.x), q2 = lo_bf(mid.y), q3 = hi_bf(mid.y);
    u[0] = w0 * pm + w1 * q0 + w2 * q1 + bias; u[1] = w0 * q0 + w1 * q1 + w2 * q2 + bias; u[2] = w0 * q1 + w1 * q2 + w2 * q3 + bias; u[3] = w0 * q2 + w1 * q3 + w2 * pp + bias;
}
template <bool V0, bool V1>
DEV void conv_step(const char* lds, f32x16 (&acc)[2][2], const int (&a_off)[2], const int (&b_off)[2], int d) {
    bf16x8 fa[2][4];
#pragma unroll
    for (int mt = 0; mt < 2; ++mt)
#pragma unroll
        for (int ks = 0; ks < 4; ++ks) { const char* ap = lds + a_off[mt] - 128 * d + ks * 32;
            const u32x2 lo = *(const u32x2*)ap, hh = *(const u32x2*)(ap + 8);
            fa[mt][ks] = __builtin_bit_cast(bf16x8, (u32x4){lo.x, lo.y, hh.x, hh.y}); }
#pragma unroll
    for (int n = 0; n < 2; ++n) {
        if ((n == 0 && V0) || (n == 1 && V1)) {
#pragma unroll
            for (int ks = 0; ks < 4; ++ks) { const bf16x8 fb = *(const bf16x8*)(lds + b_off[n] - 128 * d + ks * 32);
#pragma unroll
                for (int mt = 0; mt < 2; ++mt) acc[n][mt] = __builtin_amdgcn_mfma_f32_32x32x16_bf16(fa[mt][ks], fb, acc[n][mt], 0, 0, 0); }
        }
    }
}
struct ConvFrags { bf16x8 a[6], b0[4], b1[4]; };
DEV void conv_load_frags(ConvFrags& F, const char* lds, int a_off0, int a_off0h, int b_off0, int b_off1, int d) {
#pragma unroll
    for (int j = 0; j < 6; ++j) { const u32x2 lo = *(const u32x2*)(lds + a_off0 - 128 * d + (j - 2) * 32), hh = *(const u32x2*)(lds + a_off0h - 128 * d + (j - 2) * 32);
        F.a[j] = __builtin_bit_cast(bf16x8, (u32x4){lo.x, lo.y, hh.x, hh.y}); }
#pragma unroll
    for (int ks = 0; ks < 4; ++ks) { F.b0[ks] = *(const bf16x8*)(lds + b_off0 - 128 * d + ks * 32); F.b1[ks] = *(const bf16x8*)(lds + b_off1 - 128 * d + ks * 32); }
}
DEV void conv_mfma_frags(const ConvFrags& F, f32x16 (&acc)[2][2]) {
#pragma unroll
    for (int ks = 0; ks < 4; ++ks) {
        acc[0][0] = __builtin_amdgcn_mfma_f32_32x32x16_bf16(F.a[ks + 2], F.b0[ks], acc[0][0], 0, 0, 0);
        acc[0][1] = __builtin_amdgcn_mfma_f32_32x32x16_bf16(F.a[ks], F.b0[ks], acc[0][1], 0, 0, 0);
        acc[1][0] = __builtin_amdgcn_mfma_f32_32x32x16_bf16(F.a[ks + 2], F.b1[ks], acc[1][0], 0, 0, 0);
        acc[1][1] = __builtin_amdgcn_mfma_f32_32x32x16_bf16(F.a[ks], F.b1[ks], acc[1][1], 0, 0, 0);
    }
}
DEV void conv_mfma_loop(const char* lds, f32x16 (&acc)[2][2], int wid, int lane) {
    const int l31 = lane & 31, hi = lane >> 5;
#pragma unroll
    for (int a = 0; a < 2; ++a)
#pragma unroll
        for (int b = 0; b < 2; ++b)
#pragma unroll
            for (int r = 0; r < 16; ++r) acc[a][b][r] = 0.f;
    int a_off[2];
#pragma unroll
    for (int mt = 0; mt < 2; ++mt) { const int r = l31 + 32 * mt, q = (4 - (r & 3)) & 3; a_off[mt] = CV_UB + q * CV_FS + (4096 - r - q + 8 * hi) * 2; }
    int b_off[2];
#pragma unroll
    for (int n = 0; n < 2; ++n) { const int nt = 2 * wid + n; b_off[n] = (l31 & 7) * CV_RS + (CV_PADL + 64 * (4 * nt + (l31 >> 3)) + 8 * hi) * 2; }
    const int dlo = 8 * wid - 63;
#pragma unroll
    for (int j = 0; j < 4; ++j) conv_step<true, false>(lds, acc, a_off, b_off, dlo + j);
    ConvFrags F0, F1; const int d0 = dlo + 4; int a_hi = a_off[0] + 8; asm volatile("" : "+v"(a_hi));
    conv_load_frags(F0, lds, a_off[0], a_hi, b_off[0], b_off[1], d0);
#pragma unroll 1
    for (int j = 0; j < 31; ++j) { const int d = d0 + 2 * j;
        conv_load_frags(F1, lds, a_off[0], a_hi, b_off[0], b_off[1], d + 1); __builtin_amdgcn_sched_barrier(0);
        conv_mfma_frags(F0, acc); __builtin_amdgcn_sched_barrier(0);
        conv_load_frags(F0, lds, a_off[0], a_hi, b_off[0], b_off[1], d + 2); __builtin_amdgcn_sched_barrier(0);
        conv_mfma_frags(F1, acc); __builtin_amdgcn_sched_barrier(0); }
    conv_mfma_frags(F0, acc);
#pragma unroll
    for (int j = 0; j < 4; ++j) conv_step<false, true>(lds, acc, a_off, b_off, dlo + 67 + j);
}
DEV void conv_unit(char* lds, const Params& p, int c) {
    const int tid = TID(), lane = tid & 63, wid = tid >> 6, l31 = lane & 31, hi = lane >> 5;
    const bf16_t* PT = (const bf16_t*)(p.ws + WS_PT); const bf16_t* GR = (const bf16_t*)(p.ws + WS_GR); const float* ssum = (const float*)(p.ws + WS_SSUM);
    bf16_t* OG2 = (bf16_t*)(p.ws + WS_OG2);
    for (int i = tid; i < 8 * 98; i += 512) { const int b = i / 98, j = i % 98;
        const int e = (j < 48) ? j * 4 : (CV_PADL + SEQ + (j - 48) * 4); *(u32x2*)(lds + b * CV_RS + e * 2) = (u32x2){0u, 0u}; }
    { const float w0 = p.conv_w[c], w1 = p.conv_w[3072 + c], w2 = p.conv_w[6144 + c], bias = p.conv_b[c];
        for (int i = tid; i < 8 * 1024; i += 512) { const int b = i >> 10, t = (i & 1023) * 4; float u[4];
            sconv4(PT + ((size_t)(b * 4096 + c)) * 4096, t, w0, w1, w2, bias, u);
            u32x2 w; w.x = pk2(u[0], u[1]); w.y = pk2(u[2], u[3]); *(u32x2*)(lds + b * CV_RS + (CV_PADL + t) * 2) = w; } }
    conv_load_filter(lds, GR + (size_t)c * 8192);
    __syncthreads();
    f32x16 acc[2][2];
    conv_mfma_loop(lds, acc, wid, lane);
    __syncthreads();
    { const float invs = 1.0f / ssum[c], sk = p.skip[c];
        const float w0 = p.conv_w[1024 + c], w1 = p.conv_w[3072 + 1024 + c], w2 = p.conv_w[6144 + 1024 + c], bias = p.conv_b[1024 + c];
        const int b = l31 & 7;
#pragma unroll
        for (int n = 0; n < 2; ++n) { const int i = 4 * (2 * wid + n) + (l31 >> 3);
#pragma unroll
            for (int mt = 0; mt < 2; ++mt)
#pragma unroll
                for (int g = 0; g < 4; ++g) { const int t = 64 * i + 32 * mt + 8 * g + 4 * hi; float x1[4];
                    sconv4(PT + ((size_t)(b * 4096 + 1024 + c)) * 4096, t, w0, w1, w2, bias, x1);
                    char* up = lds + b * CV_RS + (CV_PADL + t) * 2; const u32x2 vw = *(const u32x2*)up;
                    const float z0 = x1[0] * (acc[n][mt][4 * g] * invs + sk * lo_bf(vw.x)), z1 = x1[1] * (acc[n][mt][4 * g + 1] * invs + sk * hi_bf(vw.x));
                    const float z2 = x1[2] * (acc[n][mt][4 * g + 2] * invs + sk * lo_bf(vw.y)), z3 = x1[3] * (acc[n][mt][4 * g + 3] * invs + sk * hi_bf(vw.y));
                    u32x2 w; w.x = pk2(z0, z1); w.y = pk2(z2, z3); *(u32x2*)up = w; } } }
    conv_load_filter(lds, GR + (size_t)(1024 + c) * 8192);
    __syncthreads();
    conv_mfma_loop(lds, acc, wid, lane);
    { const float invs = 1.0f / ssum[1024 + c], sk = p.skip[1024 + c];
        const float w0 = p.conv_w[2048 + c], w1 = p.conv_w[3072 + 2048 + c], w2 = p.conv_w[6144 + 2048 + c], bias = p.conv_b[2048 + c];
        const int b = l31 & 7;
#pragma unroll
        for (int n = 0; n < 2; ++n) { const int i = 4 * (2 * wid + n) + (l31 >> 3);
#pragma unroll
            for (int mt = 0; mt < 2; ++mt)
#pragma unroll
                for (int g = 0; g < 4; ++g) { const int t = 64 * i + 32 * mt + 8 * g + 4 * hi; float x2[4];
                    sconv4(PT + ((size_t)(b * 4096 + 2048 + c)) * 4096, t, w0, w1, w2, bias, x2);
                    const u32x2 zw = *(const u32x2*)(lds + b * CV_RS + (CV_PADL + t) * 2);
                    const u32x2 gw = *(const u32x2*)(PT + ((size_t)(b * 4096 + 3072 + c)) * 4096 + t);
                    const float y0 = x2[0] * (acc[n][mt][4 * g] * invs + sk * lo_bf(zw.x)) * silu(lo_bf(gw.x)), y1 = x2[1] * (acc[n][mt][4 * g + 1] * invs + sk * hi_bf(zw.x)) * silu(hi_bf(gw.x));
                    const float y2 = x2[2] * (acc[n][mt][4 * g + 2] * invs + sk * lo_bf(zw.y)) * silu(lo_bf(gw.y)), y3 = x2[3] * (acc[n][mt][4 * g + 3] * invs + sk * hi_bf(zw.y)) * silu(hi_bf(gw.y));
                    u32x2 w; w.x = pk2(y0, y1); w.y = pk2(y2, y3); *(u32x2*)(OG2 + ((size_t)(b * 1024 + c)) * 4096 + t) = w; } } }
    __syncthreads();
}

struct Raw3 { u32x2 mid; unsigned halo; };
DEV Raw3 ld_raw3(const bf16_t* px, int t) {
    Raw3 r; r.mid = *(const u32x2*)(px + t);
    const unsigned a = px[t - 1], b = px[t + 4];
    r.halo = (t > 0 ? a : 0u) | ((t + 4 < SEQ ? b : 0u) << 16);
    return r;
}
DEV void sconv_raw(const Raw3& r, float w0, float w1, float w2, float bias, float* u) {
    const float pm = lo_bf(r.halo), pp = hi_bf(r.halo), q0 = lo_bf(r.mid.x), q1 = hi_bf(r.mid.x), q2 = lo_bf(r.mid.y), q3 = hi_bf(r.mid.y);
    u[0] = w0 * pm + w1 * q0 + w2 * q1 + bias; u[1] = w0 * q0 + w1 * q1 + w2 * q2 + bias; u[2] = w0 * q1 + w1 * q2 + w2 * q3 + bias; u[3] = w0 * q2 + w1 * q3 + w2 * pp + bias;
}
struct FiltRegs { u32x4 a[2], b[2]; };
DEV void filt_load(FiltRegs& f, const bf16_t* gr, int tid) {
#pragma unroll
    for (int rnd = 0; rnd < 2; ++rnd) { const int ch = tid + rnd * 512; f.a[rnd] = *(const u32x4*)(gr + ch * 8);
        const int ch1 = ch + 1 < 1024 ? ch + 1 : ch; const u32x4 t = *(const u32x4*)(gr + ch1 * 8); f.b[rnd] = (ch + 1 < 1024) ? t : (u32x4){0u, 0u, 0u, 0u}; }
}
DEV void filt_store(char* lds, const FiltRegs& f, int tid) {
#pragma unroll
    for (int rnd = 0; rnd < 2; ++rnd) { const int ch = tid + rnd * 512; const u32x4 a = f.a[rnd], bq = f.b[rnd];
        const unsigned w[8] = {a.x, a.y, a.z, a.w, bq.x, bq.y, bq.z, bq.w};
        char* fp = lds + CV_UB + ch * 16;
        *(u32x4*)(fp) = a;
        u32x4 c1, c2, c3;
        c1.x = __builtin_amdgcn_alignbit(w[1], w[0], 16); c1.y = __builtin_amdgcn_alignbit(w[2], w[1], 16); c1.z = __builtin_amdgcn_alignbit(w[3], w[2], 16); c1.w = __builtin_amdgcn_alignbit(w[4], w[3], 16);
        c2 = (u32x4){w[1], w[2], w[3], w[4]};
        c3.x = __builtin_amdgcn_alignbit(w[2], w[1], 16); c3.y = __builtin_amdgcn_alignbit(w[3], w[2], 16); c3.z = __builtin_amdgcn_alignbit(w[4], w[3], 16); c3.w = __builtin_amdgcn_alignbit(w[5], w[4], 16);
        *(u32x4*)(fp + CV_FS) = c1; *(u32x4*)(fp + 2 * CV_FS) = c2; *(u32x4*)(fp + 3 * CV_FS) = c3; }
}
#define CV_T(k) (64 * (4 * (2 * wid + ((k) >> 3)) + (l31 >> 3)) + 32 * (((k) >> 2) & 1) + 8 * ((k) & 3) + 4 * hi)
#define CV_LANE_IDS() int tid = TID(); asm volatile("" : "+v"(tid));   \
    const int lane = tid & 63, wid = __builtin_amdgcn_readfirstlane(tid >> 6), l31 = lane & 31, hi = lane >> 5, eb = l31 & 7; (void)eb; (void)hi; (void)wid
DEV void conv_stage_load(char* lds, const Params& p, int c) {
    CV_LANE_IDS();
    const bf16_t* PT = (const bf16_t*)(p.ws + WS_PT); const bf16_t* GR = (const bf16_t*)(p.ws + WS_GR);
    FiltRegs f0; filt_load(f0, GR + (size_t)c * 8192, tid);
    Raw3 ru[16];
#pragma unroll
    for (int k = 0; k < 16; ++k) { const int i = tid + k * 512, b = i >> 10, t = (i & 1023) * 4; ru[k] = ld_raw3(PT + ((size_t)(b * 4096 + c)) * 4096, t); }
    for (int i = tid; i < 8 * 98; i += 512) { const int b = i / 98, j = i % 98;
        const int e = (j < 48) ? j * 4 : (CV_PADL + SEQ + (j - 48) * 4); *(u32x2*)(lds + b * CV_RS + e * 2) = (u32x2){0u, 0u}; }
    const float w0 = p.conv_w[c], w1 = p.conv_w[3072 + c], w2 = p.conv_w[6144 + c], bias = p.conv_b[c];
#pragma unroll
    for (int k = 0; k < 16; ++k) { const int i = tid + k * 512, b = i >> 10, t = (i & 1023) * 4; float u[4]; sconv_raw(ru[k], w0, w1, w2, bias, u);
        u32x2 w; w.x = pk2(u[0], u[1]); w.y = pk2(u[2], u[3]); *(u32x2*)(lds + b * CV_RS + (CV_PADL + t) * 2) = w; }
    filt_store(lds, f0, tid);
}
DEV void conv_stage_epi0(char* lds, const Params& p, int c, const f32x16 (&acc)[2][2]) {
    CV_LANE_IDS();
    const bf16_t* PT = (const bf16_t*)(p.ws + WS_PT); const bf16_t* GR = (const bf16_t*)(p.ws + WS_GR); const float* ssum = (const float*)(p.ws + WS_SSUM);
    FiltRegs f1; filt_load(f1, GR + (size_t)(1024 + c) * 8192, tid);
    const bf16_t* px1 = PT + ((size_t)(eb * 4096 + 1024 + c)) * 4096;
    Raw3 r1[16];
#pragma unroll
    for (int k = 0; k < 16; ++k) r1[k] = ld_raw3(px1, CV_T(k));
    const float a0 = p.conv_w[1024 + c], a1 = p.conv_w[3072 + 1024 + c], a2 = p.conv_w[6144 + 1024 + c], ab = p.conv_b[1024 + c];
    const float invs = 1.0f / ssum[c], sk = p.skip[c];
#pragma unroll
    for (int k = 0; k < 16; ++k) { const int n = k >> 3, mt = (k >> 2) & 1, g = k & 3; const int t = CV_T(k);
        float x1[4]; sconv_raw(r1[k], a0, a1, a2, ab, x1);
        char* up = lds + eb * CV_RS + (CV_PADL + t) * 2; const u32x2 vw = *(const u32x2*)up;
        const float z0 = x1[0] * (acc[n][mt][4 * g] * invs + sk * lo_bf(vw.x)), z1 = x1[1] * (acc[n][mt][4 * g + 1] * invs + sk * hi_bf(vw.x));
        const float z2 = x1[2] * (acc[n][mt][4 * g + 2] * invs + sk * lo_bf(vw.y)), z3 = x1[3] * (acc[n][mt][4 * g + 3] * invs + sk * hi_bf(vw.y));
        u32x2 w; w.x = pk2(z0, z1); w.y = pk2(z2, z3); *(u32x2*)up = w; }
    filt_store(lds, f1, tid);
}
DEV void conv_stage_epi1(char* lds, const Params& p, int c, const f32x16 (&acc)[2][2]) {
    CV_LANE_IDS();
    const bf16_t* PT = (const bf16_t*)(p.ws + WS_PT); const float* ssum = (const float*)(p.ws + WS_SSUM); bf16_t* OG2 = (bf16_t*)(p.ws + WS_OG2);
    const bf16_t* px2 = PT + ((size_t)(eb * 4096 + 2048 + c)) * 4096; const bf16_t* pg = PT + ((size_t)(eb * 4096 + 3072 + c)) * 4096;
    Raw3 r2[16]; u32x2 rg[16];
#pragma unroll
    for (int k = 0; k < 16; ++k) { r2[k] = ld_raw3(px2, CV_T(k)); rg[k] = *(const u32x2*)(pg + CV_T(k)); }
    const float b0 = p.conv_w[2048 + c], b1 = p.conv_w[3072 + 2048 + c], b2 = p.conv_w[6144 + 2048 + c], bb = p.conv_b[2048 + c];
    const float invs = 1.0f / ssum[1024 + c], sk = p.skip[1024 + c];
#pragma unroll
    for (int k = 0; k < 16; ++k) { const int n = k >> 3, mt = (k >> 2) & 1, g = k & 3; const int t = CV_T(k);
        float x2[4]; sconv_raw(r2[k], b0, b1, b2, bb, x2);
        const u32x2 zw = *(const u32x2*)(lds + eb * CV_RS + (CV_PADL + t) * 2);
        const float y0 = x2[0] * silu(lo_bf(rg[k].x)) * (acc[n][mt][4 * g] * invs + sk * lo_bf(zw.x)), y1 = x2[1] * silu(hi_bf(rg[k].x)) * (acc[n][mt][4 * g + 1] * invs + sk * hi_bf(zw.x));
        const float y2 = x2[2] * silu(lo_bf(rg[k].y)) * (acc[n][mt][4 * g + 2] * invs + sk * lo_bf(zw.y)), y3 = x2[3] * silu(hi_bf(rg[k].y)) * (acc[n][mt][4 * g + 3] * invs + sk * hi_bf(zw.y));
        u32x2 w; w.x = pk2(y0, y1); w.y = pk2(y2, y3); *(u32x2*)(OG2 + ((size_t)(eb * 1024 + c)) * 4096 + t) = w; }
}
DEV void conv_stage_mfma(const char* lds, f32x16 (&acc)[2][2]) { CV_LANE_IDS(); conv_mfma_loop(lds, acc, wid, lane); }
DEV void conv_unit2(char* lds, const Params& p, int c) {
    conv_stage_load(lds, p, c);
    __syncthreads();
    f32x16 acc[2][2];
    conv_stage_mfma(lds, acc);
    __syncthreads();
    conv_stage_epi0(lds, p, c, acc);
    __syncthreads();
    conv_stage_mfma(lds, acc);
    conv_stage_epi1(lds, p, c, acc);
    __syncthreads();
}
#undef CV_T
#undef CV_LANE_IDS

struct cf { float x, y; };
DEV float s_add(float a, float b) { float r; asm("v_add_f32_e32 %0, %1, %2" : "=v"(r) : "v"(a), "v"(b)); return r; }
DEV float s_sub(float a, float b) { float r; asm("v_sub_f32_e32 %0, %1, %2" : "=v"(r) : "v"(a), "v"(b)); return r; }
DEV float s_mul(float a, float b) { float r; asm("v_mul_f32_e32 %0, %1, %2" : "=v"(r) : "v"(a), "v"(b)); return r; }
DEV float s_fma(float a, float b, float c) { float r; asm("v_fma_f32 %0, %1, %2, %3" : "=v"(r) : "v"(a), "v"(b), "v"(c)); return r; }
DEV float s_fnma(float a, float b, float c) { float r; asm("v_fma_f32 %0, -%1, %2, %3" : "=v"(r) : "v"(a), "v"(b), "v"(c)); return r; }
DEV cf cadd(cf a, cf b) { return cf{s_add(a.x, b.x), s_add(a.y, b.y)}; }
DEV cf csub(cf a, cf b) { return cf{s_sub(a.x, b.x), s_sub(a.y, b.y)}; }
DEV cf cmul(cf a, cf b) { cf r;
    asm("v_mul_f32_e32 %0, %2, %4\n\tv_mul_f32_e32 %1, %2, %5\n\tv_fma_f32 %0, -%3, %5, %0\n\tv_fma_f32 %1, %3, %4, %1" : "=&v"(r.x), "=&v"(r.y) : "v"(a.x), "v"(a.y), "v"(b.x), "v"(b.y)); return r; }
template <int M> DEV cf mulw16(cf a) {
    if constexpr (M == 0) return a;
    else if constexpr (M == 4) return cf{a.y, -a.x};
    else if constexpr (M == 2) return cf{s_mul(s_add(a.x, a.y), 0.70710678118654752f), s_mul(s_sub(a.y, a.x), 0.70710678118654752f)};
    else if constexpr (M == 6) return cf{s_mul(s_sub(a.y, a.x), 0.70710678118654752f), s_mul(s_add(a.x, a.y), -0.70710678118654752f)};
    else { constexpr float c = (M == 1) ? 0.92387953251128674f : (M == 3) ? 0.38268343236508977f : (M == 5) ? -0.38268343236508977f : -0.92387953251128674f;
           constexpr float sn = (M == 1) ? -0.38268343236508977f : (M == 3) ? -0.92387953251128674f : (M == 5) ? -0.92387953251128674f : -0.38268343236508977f;
           return cf{s_fnma(a.y, sn, s_mul(a.x, c)), s_fma(a.y, c, s_mul(a.x, sn))}; }
}
DEV void bfly4(cf a, cf b, cf& s_, cf& d_) {
    asm("v_add_f32_e32 %0, %4, %6\n\tv_add_f32_e32 %1, %5, %7\n\tv_sub_f32_e32 %2, %4, %6\n\tv_sub_f32_e32 %3, %5, %7" : "=&v"(s_.x), "=&v"(s_.y), "=&v"(d_.x), "=&v"(d_.y) : "v"(a.x), "v"(a.y), "v"(b.x), "v"(b.y)); }
template <int HALF, int BLK, int J> DEV void dif_bfly(cf (&v)[16]) { const cf a = v[BLK + J], b = v[BLK + J + HALF]; cf sm, df; bfly4(a, b, sm, df); v[BLK + J] = sm; v[BLK + J + HALF] = mulw16<J * (8 / HALF)>(df); }
DEV void dft16(cf (&v)[16]) {
#define B8(j) dif_bfly<8, 0, j>(v)
    B8(0); B8(1); B8(2); B8(3); B8(4); B8(5); B8(6); B8(7);
#undef B8
#define B4(b, j) dif_bfly<4, b, j>(v)
    B4(0, 0); B4(0, 1); B4(0, 2); B4(0, 3); B4(8, 0); B4(8, 1); B4(8, 2); B4(8, 3);
#undef B4
#define B2(b, j) dif_bfly<2, b, j>(v)
    B2(0, 0); B2(0, 1); B2(4, 0); B2(4, 1); B2(8, 0); B2(8, 1); B2(12, 0); B2(12, 1);
#undef B2
#define B1(b) dif_bfly<1, b, 0>(v)
    B1(0); B1(2); B1(4); B1(6); B1(8); B1(10); B1(12); B1(14);
#undef B1
}
#define FFT_BR4(k) ((((k) & 1) << 3) | (((k) & 2) << 1) | (((k) & 4) >> 1) | (((k) & 8) >> 3))
constexpr int FF_BUF = (8192 + 512) * 8;
DEV int ffp(int idx) { return (idx + (idx >> 4)) * 8; }
struct FftTw { cf t3[16]; };
constexpr int FF_T2 = 2 * FF_BUF;
DEV void fft_twiddles(FftTw& T, char* lds, int tid) {
    if (tid < 240) { const int k = tid / 15, r = tid % 15 + 1; float sn, cs; sincospif(-(float)(k * r) * (1.0f / 128.0f), &sn, &cs); *(cf*)(lds + FF_T2 + tid * 8) = cf{cs, sn}; }
    __syncthreads();
    { const int i3 = tid & 255, h = tid >> 8; float sn, cs; sincospif(-(float)i3 * (1.0f / 4096.0f), &sn, &cs); asm volatile("s_nop 1" : "+v"(sn), "+v"(cs));
        const cf w1 = cf{cs, sn}; const cf w2 = cmul(w1, w1);
        cf t = h ? w1 : cf{1.f, 0.f};
#pragma unroll
        for (int sx = 0; sx < 16; ++sx) { T.t3[sx] = t; t = cmul(t, w2); } }
}
DEV void fft_pass23(char* A, char* B, const char* tw2, int tid, const FftTw& T) {
    asm volatile("" : "+v"(tid));
    cf v[16];
    {
        const int i = tid, k = i & 15;
        { const char* rb = A + ffp(i);
#pragma unroll
        for (int r = 0; r < 16; ++r) v[r] = *(const cf*)(rb + 4352 * r); }
#pragma unroll
        for (int r = 1; r < 16; ++r) v[r] = cmul(v[r], *(const cf*)(tw2 + k * 120 + (r - 1) * 8));
        dft16(v);
        const int j = ((i >> 4) << 8) + k;
        { char* wb = B + (j + 16 * (i >> 4)) * 8;
#pragma unroll
        for (int r = 0; r < 16; ++r) *(cf*)(wb + 136 * r) = v[FFT_BR4(r)]; }
        __syncthreads();
    }
    {
        const int i3 = tid & 255, h = tid >> 8;
        const char* rb3 = B + ffp(i3) + 2176 * h;
#pragma unroll
        for (int sx = 0; sx < 16; ++sx) v[sx] = *(const cf*)(rb3 + 4352 * sx);
#pragma unroll
        for (int sx = 0; sx < 16; ++sx) v[sx] = cmul(v[sx], T.t3[sx]);
        dft16(v);
        if (h) {
            const float c32[16] = {1.f, 0.98078528040323043f, 0.92387953251128674f, 0.83146961230254524f, 0.70710678118654752f, 0.55557023301960218f, 0.38268343236508977f, 0.19509032201612825f,
                                   0.f, -0.19509032201612825f, -0.38268343236508977f, -0.55557023301960218f, -0.70710678118654752f, -0.83146961230254524f, -0.92387953251128674f, -0.98078528040323043f};
            const float s32[16] = {0.f, -0.19509032201612825f, -0.38268343236508977f, -0.55557023301960218f, -0.70710678118654752f, -0.83146961230254524f, -0.92387953251128674f, -0.98078528040323043f,
                                   -1.f, -0.98078528040323043f, -0.92387953251128674f, -0.83146961230254524f, -0.70710678118654752f, -0.55557023301960218f, -0.38268343236508977f, -0.19509032201612825f};
#pragma unroll
            for (int m = 0; m < 16; ++m) v[FFT_BR4(m)] = cmul(v[FFT_BR4(m)], cf{c32[m], s32[m]});
        }
        { char* wb3 = A + ffp(i3) + 34816 * h;
#pragma unroll
        for (int m = 0; m < 16; ++m) *(cf*)(wb3 + 2176 * m) = v[FFT_BR4(m)]; }
        __syncthreads();
    }
}
DEV void fft_pass1_store(char* D, cf (&v)[16], int tid) {
    dft16(v);
    { char* wb = D + 136 * tid;
#pragma unroll
    for (int r = 0; r < 16; ++r) *(cf*)(wb + 8 * r) = v[FFT_BR4(r)]; }
    __syncthreads();
}
constexpr size_t WS_CVIN = WS_H1;
DEV void fftconv_unit(char* lds, const Params& p, int c, const FftTw& T) {
    int tid = TID(); asm volatile("" : "+v"(tid));
    char* D0 = lds; char* D1 = lds + FF_BUF;
    const bf16_t* PT = (const bf16_t*)(p.ws + WS_PT); const bf16_t* GR = (const bf16_t*)(p.ws + WS_GR); const float* ssum = (const float*)(p.ws + WS_SSUM);
    bf16_t* OG2 = (bf16_t*)(p.ws + WS_OG2); float* IN = (float*)(p.ws + WS_CVIN) + (size_t)blockIdx.x * (8 * 4096);
    { const float w0 = p.conv_w[c], w1 = p.conv_w[3072 + c], w2 = p.conv_w[6144 + c], bias = p.conv_b[c];
#pragma unroll 2
        for (int k = 0; k < 8; ++k) { const int i = tid + k * 512, b = i >> 9, n0 = (i & 511) * 8;
            const bf16_t* px = PT + ((size_t)(b * 4096 + c)) * 4096;
            float q[10]; { const u32x4 m = *(const u32x4*)(px + n0); unpack8(m, q + 1); q[0] = (n0 > 0) ? bf2f(px[n0 - 1]) : 0.f; q[9] = (n0 + 8 < SEQ) ? bf2f(px[n0 + 8]) : 0.f; }
            f32x4 o0, o1;
#pragma unroll
            for (int e = 0; e < 4; ++e) { o0[e] = w0 * q[e] + w1 * q[e + 1] + w2 * q[e + 2] + bias; o1[e] = w0 * q[e + 4] + w1 * q[e + 5] + w2 * q[e + 6] + bias; }
            *(f32x4*)(IN + b * 4096 + n0) = o0; *(f32x4*)(IN + b * 4096 + n0 + 4) = o1; } }
    __syncthreads();
#pragma unroll 1
    for (int o = 0; o < 2; ++o) {
        cf KS[16];
        asm volatile("" : "+v"(tid));
        { const bf16_t* g = GR + (size_t)(o * 1024 + c) * 8192; const float invs = 1.0f / ssum[o * 1024 + c];
            cf v[16];
#pragma unroll
            for (int r = 0; r < 16; ++r) { const int n = tid + 512 * r; v[r] = cf{bf2f(g[(12288 - n) & 8191]) * invs, 0.f}; }
            fft_pass1_store(D0, v, tid);
            fft_pass23(D0, D1, lds + FF_T2, tid, T);
#pragma unroll
            for (int q = 0; q < 8; ++q) { const cf a = *(const cf*)(D0 + ffp(tid) + 4352 * q), b = *(const cf*)(D0 + ffp(tid) + 4352 * q + 34816); KS[q] = cadd(a, b); KS[q + 8] = csub(a, b); }
            __syncthreads(); }
        const float sk = p.skip[o * 1024 + c];
        const int part = (o == 0) ? 1024 : 2048;
        const float w0 = p.conv_w[part + c], w1 = p.conv_w[3072 + part + c], w2 = p.conv_w[6144 + part + c], bias = p.conv_b[part + c];
        cf vin[8];
#pragma unroll
        for (int r = 0; r < 8; ++r) vin[r] = cf{IN[tid + 512 * r], IN[4096 + tid + 512 * r]};
#pragma unroll 1
        for (int pr = 0; pr < 4; ++pr) {
            asm volatile("" : "+v"(tid));
            const int n0 = 8 * tid;
            u32x4 eraw[2], egate[2]; f32x4 eu[2][2]; unsigned ehalo[2];
#pragma unroll
            for (int hb = 0; hb < 2; ++hb) { const int b = 2 * pr + hb; const bf16_t* px = PT + ((size_t)(b * 4096 + part + c)) * 4096;
                eraw[hb] = *(const u32x4*)(px + n0);
                const unsigned ha = px[n0 - 1], hz = px[n0 + 8];
                ehalo[hb] = ((n0 > 0) ? ha : 0u) | (((n0 + 8 < SEQ) ? hz : 0u) << 16);
                eu[hb][0] = *(const f32x4*)(IN + b * 4096 + n0); eu[hb][1] = *(const f32x4*)(IN + b * 4096 + n0 + 4);
                egate[hb] = (o == 1) ? *(const u32x4*)(PT + ((size_t)(b * 4096 + 3072 + c)) * 4096 + n0) : (u32x4){0u, 0u, 0u, 0u}; }
            {
                cf v[16];
#pragma unroll
                for (int r = 0; r < 8; ++r) v[r] = vin[r];
#pragma unroll
                for (int r = 8; r < 16; ++r) v[r] = cf{0.f, 0.f};
                fft_pass1_store(D0, v, tid);
                fft_pass23(D0, D1, lds + FF_T2, tid, T);
            }
            {
                const int pn = (pr < 3) ? pr + 1 : pr; const float* ina = IN + (2 * pn) * 4096;
#pragma unroll
                for (int r = 0; r < 8; ++r) vin[r] = cf{ina[tid + 512 * r], ina[4096 + tid + 512 * r]};
            }
            {
                cf v[16];
#pragma unroll
                for (int q = 0; q < 8; ++q) { const cf a = *(const cf*)(D0 + ffp(tid) + 4352 * q), b = *(const cf*)(D0 + ffp(tid) + 4352 * q + 34816);
                    const cf x0 = cmul(cadd(a, b), KS[q]), x1 = cmul(csub(a, b), KS[q + 8]);
                    v[q] = cf{x0.x, -x0.y}; v[q + 8] = cf{x1.x, -x1.y}; }
                fft_pass1_store(D1, v, tid);
                fft_pass23(D1, D0, lds + FF_T2, tid, T);
            }
            {
                float ya[8], yb[8];
#pragma unroll
                for (int e = 0; e < 8; ++e) { const cf a = *(const cf*)(D1 + 64 * tid + 8 * (tid >> 1) + 8 * e), b = *(const cf*)(D1 + 64 * tid + 8 * (tid >> 1) + 8 * e + 34816); ya[e] = (a.x + b.x) * (1.0f / 8192.0f); yb[e] = -(a.y + b.y) * (1.0f / 8192.0f); }
#pragma unroll
                for (int hb = 0; hb < 2; ++hb) { const int b = 2 * pr + hb; float* inp = IN + b * 4096 + n0; const float* yy = hb ? yb : ya;
                    float q[10]; unpack8(eraw[hb], q + 1); q[0] = lo_bf(ehalo[hb]); q[9] = hi_bf(ehalo[hb]);
                    const f32x4 u0 = eu[hb][0], u1 = eu[hb][1]; const float uu[8] = {u0.x, u0.y, u0.z, u0.w, u1.x, u1.y, u1.z, u1.w};
                    float z[8];
#pragma unroll
                    for (int e = 0; e < 8; ++e) { const float xc = w0 * q[e] + w1 * q[e + 1] + w2 * q[e + 2] + bias; z[e] = xc * (yy[e] + sk * uu[e]); }
                    if (o == 0) { *(f32x4*)inp = (f32x4){z[0], z[1], z[2], z[3]}; *(f32x4*)(inp + 4) = (f32x4){z[4], z[5], z[6], z[7]}; }
                    else { float gg[8]; unpack8(egate[hb], gg);
#pragma unroll
                        for (int e = 0; e < 8; ++e) z[e] *= silu(gg[e]);
                        *(u32x4*)(OG2 + ((size_t)(b * 1024 + c)) * 4096 + n0) = pack8(z); } }
            }
        }
        __syncthreads();
    }
}

#define XB_TMO      128
#define XB_XCNT(j)  (256  + 64 * (j))
#define XB_XSUB(j)  (1280 + 64 * (j))
#define XB_XGEN(j)  (2304 + 64 * (j))
#define XB_TOP      3328
#define XB_TOPGEN   3392
#define XCD_BAR_WORDS 3456
#define XB_SPIN_CAP (1u << 20)
DEV unsigned xb_ld(unsigned* p) { return __hip_atomic_load(p, __ATOMIC_RELAXED, __HIP_MEMORY_SCOPE_AGENT); }
DEV unsigned xb_add(unsigned* p, unsigned v) { return __hip_atomic_fetch_add(p, v, __ATOMIC_RELAXED, __HIP_MEMORY_SCOPE_AGENT); }
DEV unsigned xb_xcc_id() { return (unsigned)__builtin_amdgcn_s_getreg((3 << 11) | 20) & 0xFu; }
#define XB_SPIN(cond, bar) do { unsigned _sp = 0; while (cond) { __builtin_amdgcn_s_sleep(1); \
    if ((++_sp & 255u) == 0u) { if (xb_ld(&(bar)[XB_TMO])) break; if (_sp > XB_SPIN_CAP) { atomicAdd(&(bar)[XB_TMO], 1u); break; } } } } while (0)
struct XcdBarrier { unsigned* bar; unsigned x; volatile LAS unsigned* st; };
DEV XcdBarrier xcd_barrier_post(unsigned* bar, volatile LAS unsigned* st) {
    XcdBarrier b; b.bar = bar; b.x = xb_xcc_id(); b.st = st;
    if (TID() == 0) (void)xb_add(&bar[XB_XCNT(b.x)], 1u);
    return b;
}
DEV void xcd_barrier_complete(unsigned* bar, unsigned x, unsigned& nloc, unsigned& nx) {
    const unsigned G = gridDim.x * gridDim.y * gridDim.z;
    unsigned sum, cnt, mine, sp = 0u;
    for (;;) {
        sum = 0u; cnt = 0u; mine = 0u;
#pragma unroll
        for (unsigned j = 0; j < 16; ++j) { const unsigned c = xb_ld(&bar[XB_XCNT(j)]); sum += c; cnt += (c > 0u) ? 1u : 0u; mine = (j == x) ? c : mine; }
        if (sum == G) break;
        __builtin_amdgcn_s_sleep(1);
        if ((++sp & 255u) == 0u) { if (xb_ld(&bar[XB_TMO])) break; if (sp > XB_SPIN_CAP) { atomicAdd(&bar[XB_TMO], 1u); break; } }
    }
    nloc = mine > 0u ? mine : 1u; nx = cnt > 0u ? cnt : 1u;
}
DEV void xcd_barrier(const XcdBarrier& b) {
    asm volatile("s_waitcnt vmcnt(0)" ::: "memory");
    __syncthreads();
    if (TID() == 0) {
        unsigned* bar = b.bar;
        __builtin_amdgcn_s_waitcnt(0);
        unsigned nloc = b.st[0], nx = b.st[1];
        if (nloc == 0u) { xcd_barrier_complete(bar, b.x, nloc, nx); b.st[0] = nloc; b.st[1] = nx; }
        const unsigned old = xb_add(&bar[XB_XSUB(b.x)], 1u);
        const unsigned gen = old / nloc;
        if (old + 1u == (gen + 1u) * nloc) {
            __builtin_amdgcn_fence(__ATOMIC_RELEASE, "agent");
            asm volatile("s_waitcnt vmcnt(0)" ::: "memory");
            const unsigned og = xb_add(&bar[XB_TOP], 1u);
            const unsigned tg = og / nx;
            if (og + 1u == (tg + 1u) * nx) xb_add(&bar[XB_TOPGEN], 1u);
            else XB_SPIN(xb_ld(&bar[XB_TOPGEN]) == tg, bar);
            __builtin_amdgcn_fence(__ATOMIC_ACQUIRE, "agent");
            xb_add(&bar[XB_XGEN(b.x)], 1u);
            asm volatile("s_waitcnt vmcnt(0)" ::: "memory");
        } else {
            XB_SPIN(xb_ld(&bar[XB_XGEN(b.x)]) == gen, bar);
            __builtin_amdgcn_fence(__ATOMIC_ACQUIRE, "agent");
            asm volatile("s_waitcnt vmcnt(0)" ::: "memory");
        }
    }
    __syncthreads();
}

constexpr int NPHASE = 12;
__global__ void __launch_bounds__(512) fwd_kernel(Params p) {
    char* lds = lds_dyn;
    char* ws = p.ws;
    volatile LAS unsigned* bst = (volatile LAS unsigned*)(LAS char*)(lds + LDS_BYTES - 64);
    { const int t0 = threadIdx.x;
        if (t0 < 16) bst[t0] = 0u;
        if ((t0 & 63) == 0) *(volatile LAS int*)(LAS char*)(lds + LDS_WTAB + 4 * hw_slot()) = t0 >> 6; }
    __syncthreads();
    if (MK_LAUNCHES == 1) (void)xcd_barrier_post((unsigned*)(ws + WS_CTL), bst);
    if (MK_LAUNCHES == 1 && p.ph_hi > NPHASE) cg::this_grid().sync();
#define SEAM(k) do { if (MK_LAUNCHES == 1 && (k) + 1 < p.ph_hi) { XcdBarrier xb_; xb_.bar = (unsigned*)(p.ws + WS_CTL); xb_.x = xb_xcc_id(); xb_.st = (volatile LAS unsigned*)(LAS char*)(lds + LDS_BYTES - 64); xcd_barrier(xb_); } } while (0)
#ifndef PHASE_MASK
#define PHASE_MASK 0xFFF
#endif
#define IN(k) (((PHASE_MASK >> (k)) & 1) && p.ph_lo <= (k) && (k) < p.ph_hi)
#define REP(k) for (int rep_ = 0; rep_ < ((PROBE_REPEAT == (k)) ? 2 : 1); ++rep_)
    if (IN(0)) { REP(0) phase_prep(lds, p); SEAM(0); }
    if (IN(1)) {
        for (int rep_ = 0; rep_ < ((PROBE_REPEAT == 21) ? 2 : 1); ++rep_) {
        const bool dummy = (PROBE_REPEAT == 21 && rep_ == 0);
        EpiFilt ef{(bf16_t*)(ws + (dummy ? WS_PRAW : WS_GR)), p.f_b3};
        gemm_phase<false, EpiFilt>(lds, (const bf16_t*)(ws + WS_W3), 64, (const bf16_t*)(ws + WS_HID2), 64, 4096, 4096, 64, ef); }
        REP(1) phase_norm0(p); SEAM(1); }
    if (IN(2)) {
        REP(2) { pg8::Gemm g{(const bf16_t*)(ws + WS_H0), (const bf16_t*)(ws + WS_WIN), NALL, AINP, DM}; pg8::StaticOrder S; S.init(NALL, AINP, (int)gridDim.x, (int)blockIdx.x);
            pg8::EpiBf16 E{(bf16_t*)(ws + WS_PRAW), (size_t)AINP, 0, 0};
            pg8::gemm_phase<pg8::EpiBf16, pg8::StaticOrder, true, true>((PG8_LAS unsigned char*)lds, g, S, E); }
        SEAM(2); }
    if (IN(3)) { filt_sums(p); REP(3) phase_post(p); SEAM(3); }
    if (IN(4)) {
        const float* rp = (const float*)(ws + WS_ROPE);
        REP(4) {
        { pg8::Gemm g{(const bf16_t*)(ws + WS_CQN), (const bf16_t*)(ws + WS_WUQ), NTOK, 768, 256}; pg8::StaticOrder S; S.init(NTOK, 768, (int)gridDim.x, (int)blockIdx.x);
            pg8::EpiUqPg E{(bf16_t*)(ws + WS_QM), rp + 2048, rp + 2560, QSC_M};
            pg8::gemm_phase<pg8::EpiUqPg, pg8::StaticOrder, true, true>((PG8_LAS unsigned char*)lds, g, S, E); }
        int opq_ = 0; asm volatile("" : "+s"(opq_));
        if (opq_ == 0) { pg8::Gemm g{(const bf16_t*)(ws + WS_CKVN), (const bf16_t*)(ws + WS_WUKV), NALL, 1024, 128}; pg8::StaticOrder S; S.init(NALL, 1024, (int)gridDim.x, (int)blockIdx.x);
            pg8::EpiUkvPg E{(bf16_t*)(ws + WS2_KM), (bf16_t*)(ws + WS2_VM)};
            pg8::gemm_phase<pg8::EpiUkvPg, pg8::StaticOrder, true, true>((PG8_LAS unsigned char*)lds, g, S, E); } }
        SEAM(4); }
    if (IN(5)) { REP(5) phase_attn(lds, p); SEAM(5); }
    if (IN(6)) {
        REP(6) { pg8::Gemm g{(const bf16_t*)(ws + WS2_OG), (const bf16_t*)(ws + WS_WOUT), NTOK, DM, DM}; pg8::StaticOrder S; S.init(NTOK, DM, (int)gridDim.x, (int)blockIdx.x);
            pg8::EpiResF32 E{p.x, p.out, (const float*)(ws + WS_MOD0), (DBG_SKIP & 1) ? 0.f : 1.f};
            pg8::gemm_phase<pg8::EpiResF32, pg8::StaticOrder, true, true>((PG8_LAS unsigned char*)lds, g, S, E); }
        SEAM(6); }
    if (IN(7)) { REP(7) phase_norm1(p); SEAM(7); }
    if (IN(8)) {
        REP(8) { pg8::Gemm g{(const bf16_t*)(ws + WS_HWIN), (const bf16_t*)(ws + WS_H1), 4096, NTOK, DM}; pg8::StaticOrder S; S.init(4096, NTOK, (int)gridDim.x, (int)blockIdx.x);
            pg8::EpiBf16 E{(bf16_t*)(ws + WS_PT), (size_t)4096, 4096, (size_t)4096 * 4096};
            pg8::gemm_phase<pg8::EpiBf16, pg8::StaticOrder, true, true>((PG8_LAS unsigned char*)lds, g, S, E); }
        SEAM(8); }
    if (IN(9)) { FftTw T; fft_twiddles(T, lds, TID()); REP(9) for (int c = blockIdx.x; c < 1024; c += gridDim.x) fftconv_unit(lds, p, c, T); SEAM(9); }
    if (IN(10)) {
        REP(10) {
        EpiRes e{p.out, (PROBE_REPEAT == 10 && rep_ == 0) ? (float*)(ws + WS_PT) : p.out, (const float*)(ws + WS_MOD1), (DBG_SKIP & 2) ? 0.f : 1.f};
        const bf16_t* OG2 = (const bf16_t*)(ws + WS_OG2); const bf16_t* W = (const bf16_t*)(ws + WS_HWOUT);
        const int nt = (NTOK / 256) * (DM / 256);
        for (int t = blockIdx.x; t < nt; t += gridDim.x) { const int ti = t / 4, tj = t % 4; const int b = ti >> 4, l0 = (ti & 15) * 256;
            gemm_tile256_tr<EpiRes>(lds, OG2 + (size_t)b * 1024 * 4096 + l0, 4096, W + (size_t)tj * 256 * DM, DM, DM, e, ti * 256, tj * 256); }
        }
        SEAM(10); }
    if (IN(11)) { phase_final(p); }
#undef SEAM
#undef IN
}

extern "C" void kernel_launch(void* const* d_in, const int* in_sizes, int n_in, void* d_out, int out_size, void* d_ws, size_t ws_size, hipStream_t stream) {
    static int grid = 0;
    if (grid == 0) {
        if (n_in != 28 || out_size != NTOK * DM || ws_size < WS_END) { fprintf(stderr, "kernel_launch: unexpected shapes n_in %d out %d ws %zu\n", n_in, out_size, ws_size); grid = -1; return; }
        int dev = 0, cus = 0, per_cu = 0;
        hipGetDevice(&dev); hipDeviceGetAttribute(&cus, hipDeviceAttributeMultiprocessorCount, dev);
        if (hipFuncSetAttribute((const void*)fwd_kernel, hipFuncAttributeMaxDynamicSharedMemorySize, LDS_BYTES) != hipSuccess) { fprintf(stderr, "hipFuncSetAttribute failed\n"); grid = -1; return; }
        hipOccupancyMaxActiveBlocksPerMultiprocessor(&per_cu, (const void*)fwd_kernel, 512, LDS_BYTES);
        if (per_cu < 1) { fprintf(stderr, "occupancy query says %d\n", per_cu); per_cu = 1; }
        grid = cus * 1;
        (void)hipGetLastError();
    }
    if (grid < 0) return;
    Params p{};
    const float** pp = (const float**)&p;
    for (int i = 0; i < 28; ++i) pp[i] = (const float*)d_in[i];
    p.out = (float*)d_out; p.ws = (char*)d_ws;
#if MK_LAUNCHES == 1
    if (hipMemsetAsync((char*)d_ws + WS_CTL, 0, CTL_BYTES, stream) != hipSuccess) { fprintf(stderr, "memset failed\n"); return; }
    p.ph_lo = 0; p.ph_hi = NPHASE;
    void* args[] = {&p};
    hipError_t e = hipLaunchCooperativeKernel((const void*)fwd_kernel, dim3(grid), dim3(512), args, LDS_BYTES, stream);
    if (e != hipSuccess) fprintf(stderr, "cooperative launch failed: %s (grid %d)\n", hipGetErrorString(e), grid);
#else
    for (int k = 0; k < NPHASE; ++k) { p.ph_lo = k; p.ph_hi = k + 1; hipLaunchKernelGGL(fwd_kernel, dim3(grid), dim3(512), LDS_BYTES, stream, p); }
#endif
}
```

```cpp
#include <hip/hip_runtime.h>
#include <hip/hip_cooperative_groups.h>
#include <cstdio>
#include <cstdint>
namespace cg = cooperative_groups;

#ifndef MK_LAUNCHES
#define MK_LAUNCHES 1
#endif

#ifndef PROBE_REPEAT
#define PROBE_REPEAT -1
#endif
#ifndef DBG_SKIP
#define DBG_SKIP 0
#endif
#define DEV __device__ __forceinline__
typedef unsigned short bf16_t;
typedef short bf16x8 __attribute__((ext_vector_type(8)));
typedef short s16x4 __attribute__((ext_vector_type(4)));
typedef float f32x16 __attribute__((ext_vector_type(16)));
typedef float f32x4 __attribute__((ext_vector_type(4)));
typedef float f32x2 __attribute__((ext_vector_type(2)));
typedef unsigned u32x4 __attribute__((ext_vector_type(4)));
typedef unsigned u32x2 __attribute__((ext_vector_type(2)));
typedef __bf16 bf16x2_t __attribute__((ext_vector_type(2)));
#define LAS __attribute__((address_space(3)))

constexpr int NB = 8, SEQ = 4096, DM = 1024, CTXL = 256, LK = SEQ + CTXL;
constexpr int NTOK = NB * SEQ, NCTX = NB * CTXL, NALL = NTOK + NCTX;
constexpr int AIN = 2208, AINP = 2304;
constexpr float EPS = 1e-6f;
constexpr float LOG2E = 1.4426950408889634f;
constexpr float QSC_A = 0.125f * LOG2E;
constexpr float QSC_M = 0.10206207261596575f * LOG2E;

constexpr size_t MiB = 1ull << 20;
constexpr size_t WS_WIN = 0;
constexpr size_t WS_WUQ = 5 * MiB;
constexpr size_t WS_WUKV = 6 * MiB;
constexpr size_t WS_WOUT = 7 * MiB;
constexpr size_t WS_HWIN = 9 * MiB;
constexpr size_t WS_HWOUT = 17 * MiB;
constexpr size_t WS_W3 = 19 * MiB;
constexpr size_t WS_HID2 = 20 * MiB;
constexpr size_t WS_MOD0 = 21 * MiB;
constexpr size_t WS_MOD1 = WS_MOD0 + 9 * 3072 * 4;
constexpr size_t WS_SSUM = WS_MOD1 + 8 * 3072 * 4;
constexpr size_t WS_ROPE = WS_SSUM + 2048 * 4;
constexpr size_t WS_GR = 22 * MiB;
constexpr size_t WS_H0 = 64 * MiB;
constexpr size_t WS_PRAW = 136 * MiB;
constexpr size_t WS_QA = 297 * MiB;
constexpr size_t WS_KA = 329 * MiB;
constexpr size_t WS_VA = 338 * MiB;
constexpr size_t WS_CQN = 347 * MiB;
constexpr size_t WS_CKVN = 363 * MiB;
constexpr size_t WS_G = 372 * MiB;
constexpr size_t WS_QM = 64 * MiB;
constexpr size_t WS_KM = 136 * MiB;
constexpr size_t WS_VM = 190 * MiB;
constexpr size_t WS_OG = 226 * MiB;
constexpr size_t WS_H1 = 436 * MiB;
constexpr size_t WS_PT = 64 * MiB;
constexpr size_t WS_OG2 = 320 * MiB;
constexpr size_t WS_CTL = 500 * MiB;
constexpr size_t CTL_BYTES = 16384;
constexpr size_t WS_END = 500 * MiB + CTL_BYTES;
constexpr size_t WS2_KM = 436 * MiB;
constexpr size_t WS2_VM = 190 * MiB;
constexpr size_t WS2_OG = 226 * MiB;

constexpr int LDS_BYTES = 150 * 1024;

extern __shared__ __attribute__((aligned(16))) char lds_dyn[];
constexpr int LDS_WTAB = LDS_BYTES - 64 - 256;
__device__ __forceinline__ int lane_id() { int r; asm volatile("v_mbcnt_lo_u32_b32 %0, -1, 0\n\tv_mbcnt_hi_u32_b32 %0, -1, %0" : "=v"(r)); return r; }
__device__ __forceinline__ int hw_slot() { return (int)(__builtin_amdgcn_s_getreg((5 << 11) | 4) & 63u); }
__device__ __forceinline__ int wave_idx() { return __builtin_amdgcn_readfirstlane(*(volatile __attribute__((address_space(3))) int*)(__attribute__((address_space(3))) char*)(lds_dyn + LDS_WTAB + 4 * hw_slot())); }
#define TID() (wave_idx() * 64 + lane_id())

DEV float bf2f(bf16_t v) { return __uint_as_float(((unsigned)v) << 16); }
DEV unsigned pk2(float lo, float hi) { f32x2 v = {lo, hi}; bf16x2_t b = __builtin_convertvector(v, bf16x2_t); return __builtin_bit_cast(unsigned, b); }
DEV bf16_t f2bf(float f) { return (bf16_t)(pk2(f, 0.f) & 0xffffu); }
DEV float lo_bf(unsigned w) { return __uint_as_float(w << 16); }
DEV float hi_bf(unsigned w) { return __uint_as_float(w & 0xffff0000u); }
DEV int crow(int r, int hi) { return (r & 3) + 8 * (r >> 2) + 4 * hi; }
DEV float silu(float v) { return v * __builtin_amdgcn_rcpf(1.f + __expf(-v)); }
DEV void unpack8(const u32x4 w, float* v) { v[0] = lo_bf(w.x); v[1] = hi_bf(w.x); v[2] = lo_bf(w.y); v[3] = hi_bf(w.y); v[4] = lo_bf(w.z); v[5] = hi_bf(w.z); v[6] = lo_bf(w.w); v[7] = hi_bf(w.w); }
DEV u32x4 pack8(const float* v) { u32x4 w; w.x = pk2(v[0], v[1]); w.y = pk2(v[2], v[3]); w.z = pk2(v[4], v[5]); w.w = pk2(v[6], v[7]); return w; }

DEV float wave_sum(float v) {
#pragma unroll
    for (int o = 1; o < 64; o <<= 1) v += __shfl_xor(v, o);
    return v;
}
struct Params {
    const float *x, *c, *ctx, *c_ctx, *ada_w, *ada_b, *norm_w, *w_in, *q_norm, *k_norm, *cq_norm, *ckv_norm, *w_uq, *w_ukv, *w_out,
        *hy_w_in, *conv_w, *conv_b, *f_w1, *f_b1, *f_w2, *f_b2, *f_w3, *f_b3, *freq, *skip, *hy_w_out, *final_w;
    float* out; char* ws; int ph_lo, ph_hi;
};

constexpr int G_RS = 144;
constexpr int G_RB = 256 * G_RS, G_CB = 128 * G_RS, G_STAGE = G_RB + G_CB;
constexpr int T_RS = 576;

template <bool TR, class Epi>
DEV void gemm_tile(char* lds, const bf16_t* __restrict__ R, size_t ldr, const bf16_t* __restrict__ C, size_t ldc, int K, const Epi& epi, int ti0, int tj0) {
    const int tid = TID(), lane = tid & 63, wid = tid >> 6;
    const int wi = wid >> 1, wj = wid & 1, l31 = lane & 31, hi = lane >> 5;
    f32x16 acc[2][2];
#pragma unroll
    for (int a = 0; a < 2; ++a)
#pragma unroll
        for (int b = 0; b < 2; ++b)
#pragma unroll
            for (int r = 0; r < 16; ++r) acc[a][b][r] = 0.f;
    u32x4 rrX[4], rcX[2], rrY[4], rcY[2];
    const bf16_t* Rp; const bf16_t* Cp; int rl_off, cl_off;
    if (TR) { const int c = tid & 31, kr = tid >> 5; Rp = R + (size_t)kr * ldr + c * 8; rl_off = kr * T_RS + c * 16; }
    else { const int lr = tid >> 3, lc = tid & 7; Rp = R + (size_t)lr * ldr + lc * 8; rl_off = lr * G_RS + lc * 16; }
    { const int lr = tid >> 3, lc = tid & 7; Cp = C + (size_t)lr * ldc + lc * 8; cl_off = lr * G_RS + lc * 16; }
    const int nk = K / 64;
    int ra_off[2], cb_off[2];
#pragma unroll
    for (int t = 0; t < 2; ++t) {
        if (TR) { const int g1 = (lane >> 4) & 1, q = (lane & 15) >> 2, p = lane & 3; ra_off[t] = (8 * hi + q) * T_RS + (wi * 64 + t * 32 + 16 * g1 + 4 * p) * 2; }
        else ra_off[t] = (wi * 64 + t * 32 + l31) * G_RS + hi * 16;
        cb_off[t] = G_RB + (wj * 64 + t * 32 + l31) * G_RS + hi * 16;
    }
#define G_LOAD(kt, S) do { const int kk_ = (kt) < nk ? (kt) : nk - 1; \
        if (TR) { _Pragma("unroll") for (int p = 0; p < 4; ++p) rr##S[p] = *(const u32x4*)(Rp + ((size_t)kk_ * 64 + 16 * p) * ldr); } \
        else { _Pragma("unroll") for (int p = 0; p < 4; ++p) rr##S[p] = *(const u32x4*)(Rp + (size_t)(64 * p) * ldr + kk_ * 64); } \
        _Pragma("unroll") for (int p = 0; p < 2; ++p) rc##S[p] = *(const u32x4*)(Cp + (size_t)(64 * p) * ldc + kk_ * 64); } while (0)
#define G_STORE(buf, S) do { char* b_ = lds + (buf) * G_STAGE; \
        if (TR) { _Pragma("unroll") for (int p = 0; p < 4; ++p) *(u32x4*)(b_ + rl_off + 16 * p * T_RS) = rr##S[p]; } \
        else { _Pragma("unroll") for (int p = 0; p < 4; ++p) *(u32x4*)(b_ + rl_off + 64 * p * G_RS) = rr##S[p]; } \
        _Pragma("unroll") for (int p = 0; p < 2; ++p) *(u32x4*)(b_ + G_RB + cl_off + 64 * p * G_RS) = rc##S[p]; } while (0)
#define G_COMPUTE(buf) do { const char* b_ = lds + (buf) * G_STAGE; \
        _Pragma("unroll") for (int ks = 0; ks < 4; ++ks) { bf16x8 fa[2], fb[2]; \
            _Pragma("unroll") for (int t = 0; t < 2; ++t) { \
                if (TR) { \
                    const s16x4 lo = __builtin_bit_cast(s16x4, __builtin_amdgcn_ds_read_tr16_b64_v4i16((LAS s16x4*)(b_ + ra_off[t] + ks * 16 * T_RS))); \
                    const s16x4 hh = __builtin_bit_cast(s16x4, __builtin_amdgcn_ds_read_tr16_b64_v4i16((LAS s16x4*)(b_ + ra_off[t] + (ks * 16 + 4) * T_RS))); \
                    fa[t] = (bf16x8){lo[0], lo[1], lo[2], lo[3], hh[0], hh[1], hh[2], hh[3]}; \
                } else fa[t] = *(const bf16x8*)(b_ + ra_off[t] + ks * 32); \
                fb[t] = *(const bf16x8*)(b_ + cb_off[t] + ks * 32); } \
            _Pragma("unroll") for (int a = 0; a < 2; ++a) _Pragma("unroll") for (int b = 0; b < 2; ++b) acc[a][b] = __builtin_amdgcn_mfma_f32_32x32x16_bf16(fa[a], fb[b], acc[a][b], 0, 0, 0); } } while (0)
    G_LOAD(0, X); G_LOAD(1, Y); G_STORE(0, X);
    __syncthreads();
    for (int kt = 0; kt < nk; kt += 2) {
        G_LOAD(kt + 2, X);
        G_COMPUTE(0);
        G_STORE(1, Y);
        __syncthreads();
        if (kt + 1 >= nk) break;
        G_LOAD(kt + 3, Y);
        G_COMPUTE(1);
        G_STORE(0, X);
        __syncthreads();
    }
#undef G_LOAD
#undef G_STORE
#undef G_COMPUTE
#pragma unroll
    for (int a = 0; a < 2; ++a)
#pragma unroll
        for (int b = 0; b < 2; ++b) epi(ti0 + wi * 64 + a * 32, tj0 + wj * 64 + b * 32, acc[a][b], l31, hi);
}


constexpr int G2_STAGE = 2 * G_RB;
template <class Epi>
DEV void gemm_tile256_tr(char* lds, const bf16_t* __restrict__ R, size_t ldr, const bf16_t* __restrict__ C, size_t ldc, int K, const Epi& epi, int ti0, int tj0) {
    int tid = TID(); asm volatile("" : "+v"(tid));
    const int lane = tid & 63, wid = __builtin_amdgcn_readfirstlane(tid >> 6), wi = wid >> 2, wj = wid & 3, l31 = lane & 31, hi = lane >> 5;
    f32x16 acc[4][2];
#pragma unroll
    for (int a = 0; a < 4; ++a)
#pragma unroll
        for (int b = 0; b < 2; ++b)
#pragma unroll
            for (int r = 0; r < 16; ++r) acc[a][b][r] = 0.f;
    u32x4 rr[4], rc[4];
    const bf16_t* Rp; const bf16_t* Cp; int rl_off, cl_off;
    { const int c = tid & 31, kr = tid >> 5; Rp = R + (size_t)kr * ldr + c * 8; rl_off = kr * T_RS + c * 16; }
    { const int lr = tid >> 3, lc = tid & 7; Cp = C + (size_t)lr * ldc + lc * 8; cl_off = lr * G_RS + lc * 16; }
    const int nk = K / 64;
    int ra_off[4], cb_off[2];
#pragma unroll
    for (int t = 0; t < 4; ++t) { const int g1 = (lane >> 4) & 1, q = (lane & 15) >> 2, p = lane & 3; ra_off[t] = (8 * hi + q) * T_RS + (wi * 128 + t * 32 + 16 * g1 + 4 * p) * 2; }
#pragma unroll
    for (int t = 0; t < 2; ++t) cb_off[t] = G_RB + (wj * 64 + t * 32 + l31) * G_RS + hi * 16;
#define G2_LOAD(kt) do { const int kk_ = (kt) < nk ? (kt) : nk - 1; \
        _Pragma("unroll") for (int p = 0; p < 4; ++p) rr[p] = *(const u32x4*)(Rp + ((size_t)kk_ * 64 + 16 * p) * ldr); \
        _Pragma("unroll") for (int p = 0; p < 4; ++p) rc[p] = *(const u32x4*)(Cp + (size_t)(64 * p) * ldc + kk_ * 64); } while (0)
#define G2_STORE(buf) do { char* b_ = lds + (buf) * G2_STAGE; \
        _Pragma("unroll") for (int p = 0; p < 4; ++p) *(u32x4*)(b_ + rl_off + 16 * p * T_RS) = rr[p]; \
        _Pragma("unroll") for (int p = 0; p < 4; ++p) *(u32x4*)(b_ + G_RB + cl_off + 64 * p * G_RS) = rc[p]; } while (0)
    G2_LOAD(0); G2_STORE(0);
    __syncthreads();
    for (int kt = 0; kt < nk; ++kt) {
        G2_LOAD(kt + 1);
        const char* b_ = lds + (kt & 1) * G2_STAGE;
#pragma unroll
        for (int ks = 0; ks < 4; ++ks) {
            bf16x8 fa[4], fb[2];
#pragma unroll
            for (int t = 0; t < 4; ++t) {
                const s16x4 lo = __builtin_bit_cast(s16x4, __builtin_amdgcn_ds_read_tr16_b64_v4i16((LAS s16x4*)(b_ + ra_off[t] + ks * 16 * T_RS)));
                const s16x4 hh = __builtin_bit_cast(s16x4, __builtin_amdgcn_ds_read_tr16_b64_v4i16((LAS s16x4*)(b_ + ra_off[t] + (ks * 16 + 4) * T_RS)));
                fa[t] = (bf16x8){lo[0], lo[1], lo[2], lo[3], hh[0], hh[1], hh[2], hh[3]}; }
#pragma unroll
            for (int t = 0; t < 2; ++t) fb[t] = *(const bf16x8*)(b_ + cb_off[t] + ks * 32);
#pragma unroll
            for (int a = 0; a < 4; ++a)
#pragma unroll
                for (int b = 0; b < 2; ++b) acc[a][b] = __builtin_amdgcn_mfma_f32_32x32x16_bf16(fa[a], fb[b], acc[a][b], 0, 0, 0);
        }
        G2_STORE((kt + 1) & 1);
        __syncthreads();
    }
#undef G2_LOAD
#undef G2_STORE
#pragma unroll
    for (int a = 0; a < 4; ++a)
#pragma unroll
        for (int b = 0; b < 2; ++b) epi(ti0 + wi * 128 + a * 32, tj0 + wj * 64 + b * 32, acc[a][b], l31, hi);
}
template <bool TR, class Epi>
DEV void gemm_phase(char* lds, const bf16_t* R, size_t ldr, const bf16_t* C, size_t ldc, int nI, int nJ, int K, const Epi& epi) {
    const int tI = nI / 256, tJ = nJ / 128, nt = tI * tJ;
    for (int t = blockIdx.x; t < nt; t += gridDim.x) {
        const int ti = t / tJ, tj = t % tJ;
        gemm_tile<TR, Epi>(lds, R + (size_t)ti * 256 * ldr, ldr, C + (size_t)tj * 128 * ldc, ldc, K, epi, ti * 256, tj * 128);
    }
}

struct EpiRaw {
    bf16_t* O; size_t ld;
    DEV void operator()(int i0, int j0, const f32x16& a, int l31, int hi) const {
#pragma unroll
        for (int r = 0; r < 16; ++r) O[(size_t)(i0 + crow(r, hi)) * ld + j0 + l31] = f2bf(a[r]);
    }
};
struct EpiUq {
    bf16_t* QM; const float* cos32; const float* sin32;
    DEV void operator()(int i0, int j0, const f32x16& a, int l31, int hi) const {
        const bool pe = (j0 % 96) == 64;
        const int fi = l31 & 7; const bool colang = (l31 & 16) != 0; const bool bpart = (l31 & 8) != 0;
#pragma unroll
        for (int r = 0; r < 16; ++r) {
            const int tok = i0 + crow(r, hi); float v = a[r];
            const float o = __shfl_xor(v, 8);
            if (pe) { const int l = tok & (SEQ - 1); const int pos = colang ? (l & 63) : (l >> 6);
                const float cs = cos32[pos * 8 + fi], sn = sin32[pos * 8 + fi];
                v = bpart ? (v * cs + o * sn) : (v * cs - o * sn); }
            QM[(size_t)tok * 768 + j0 + l31] = f2bf(v * QSC_M);
        }
    }
};
struct EpiUkv {
    bf16_t* KM; bf16_t* VM;
    DEV void operator()(int i0, int j0, const f32x16& a, int l31, int hi) const {
        const int h = j0 >> 7, e = (j0 & 127) + l31;
#pragma unroll
        for (int r = 0; r < 16; ++r) { const size_t row = (size_t)(i0 + crow(r, hi));
            if (e < 64) KM[row * 768 + h * 96 + e] = f2bf(a[r]); else VM[row * 512 + h * 64 + (e - 64)] = f2bf(a[r]); }
    }
};
struct EpiRes {
    const bf16_t* base; bf16_t* out; const float* mod; float gmul;
    DEV void operator()(int i0, int j0, const f32x16& a, int l31, int hi) const {
        const int b = i0 >> 12; const float g = mod[b * 3072 + 2048 + j0 + l31] * gmul;
#pragma unroll
        for (int h8 = 0; h8 < 2; ++h8) { float bv[8];
#pragma unroll
            for (int r = 0; r < 8; ++r) bv[r] = bf2f(base[(size_t)(i0 + crow(8 * h8 + r, hi)) * DM + j0 + l31]);
#pragma unroll
            for (int r = 0; r < 8; ++r) out[(size_t)(i0 + crow(8 * h8 + r, hi)) * DM + j0 + l31] = f2bf(bv[r] + g * a[8 * h8 + r]); }
    }
};
struct EpiPT {
    bf16_t* PT;
    DEV void operator()(int i0, int j0, const f32x16& a, int l31, int hi) const {
        const int b = j0 >> 12, l = (j0 & 4095) + l31;
#pragma unroll
        for (int r = 0; r < 16; ++r) PT[((size_t)(b * 4096 + i0 + crow(r, hi))) * 4096 + l] = f2bf(a[r]);
    }
};
struct EpiFilt {
    bf16_t* GR; const float* b3;
    DEV void operator()(int i0, int j0, const f32x16& a, int l31, int hi) const {
        const int t = j0 + l31; const float tn = (float)t * (1.0f / 4095.0f);
        const float dmin = -3.0701134573253945f, dmax = -15.350567286626973f;
#pragma unroll
        for (int r = 0; r < 16; ++r) {
            const int n = i0 + crow(r, hi); const int c = n & 1023, od = n >> 10, o = od >> 1, dir = od & 1;
            const float delta = fabsf(dmin + (float)c * ((dmax - dmin) / 1023.0f));
            const float v = (a[r] + b3[n]) * __expf(-tn * delta);
            bf16_t* g = GR + ((size_t)(o * 1024 + c)) * 8192;
            if (dir == 0) g[4096 - t] = f2bf(v);
            else { if (t == 0) g[0] = 0; else g[4096 + t] = f2bf(v); }
        }
    }
};
DEV void filt_sums(const Params& p) {
    const int wid = TID() >> 6, lane = TID() & 63; bf16_t* GR = (bf16_t*)(p.ws + WS_GR); float* ssum = (float*)(p.ws + WS_SSUM);
    for (int row = blockIdx.x * 8 + wid; row < 2048; row += gridDim.x * 8) {
        bf16_t* g = GR + (size_t)row * 8192; float s = 0.f;
        u32x4 w[16];
#pragma unroll
        for (int j = 0; j < 16; ++j) w[j] = *(const u32x4*)(g + (j * 64 + lane) * 8);
#pragma unroll
        for (int j = 0; j < 16; ++j) { float v[8]; unpack8(w[j], v);
            if (j == 0 && lane == 0) v[0] = 0.f;
#pragma unroll
            for (int e = 0; e < 8; ++e) s += fabsf(v[e]); }
        s = wave_sum(s);
        if (lane == 0) ssum[row] = s;
    }
}

namespace pg8 {
#define PG8_LAS __attribute__((address_space(3)))
typedef short bf16x8 __attribute__((ext_vector_type(8)));
typedef float f32x4 __attribute__((ext_vector_type(4)));
typedef unsigned u32x4 __attribute__((ext_vector_type(4)));
constexpr int BM = 256, BK = 64, HALF = 128, HTB = HALF * BK * 2  , STAGE_BYTES = 8 * HTB, NXCD = 8, WGM = 8;

__host__ __device__ __forceinline__ int lds_byte(int r, int c) { const int st = (r >> 4) * 2 + (c >> 5), rr = r & 15, cc = c & 31, ob = rr * 64 + cc * 2; return st * 1024 + (ob ^ (((ob >> 9) & 1) << 5)); }
__host__ __device__ __forceinline__ void stage_rc(int b, int& R, int& C) { const int st = b / 1024, sb = b % 1024, swz = sb ^ (((sb >> 9) & 1) << 5); R = (st >> 1) * 16 + swz / 64; C = (st & 1) * 32 + (swz % 64) / 2; }
__host__ __device__ __forceinline__ int perm32(int rho) { const int n = rho >> 4, i = rho & 15; return 8 * (i >> 2) + 4 * n + (i & 3); }

struct Unit { int pm, pn; };
struct Gemm { const bf16_t* A; const bf16_t* Bt; int M, N, K; };

struct StaticOrder {
    int nM, nN, nwg, G, c;
    __host__ __device__ void init(int M, int N, int G_, int c_) { nM = M / BM; nN = N / BM; nwg = nM * nN; G = G_; c = c_; }
    __host__ __device__ bool next(int i, Unit& u) const {
        const long L = (long)i * G + c; if (L >= nwg) return false;
        int wgid = (int)L; { const int q = nwg / NXCD, r = nwg % NXCD, xcd = wgid % NXCD, off = wgid / NXCD; wgid = (xcd < r ? xcd * (q + 1) : r * (q + 1) + (xcd - r) * q) + off; }
        const int nig = WGM * nN, gid = wgid / nig, fm = gid * WGM, gsz = (nM - fm) < WGM ? (nM - fm) : WGM;
        u.pm = fm + ((wgid % nig) % gsz); u.pn = (wgid % nig) / gsz; return true;
    }
    __device__ __forceinline__ void a_ready(const Unit&) const {}
    __device__ __forceinline__ void done(const Unit&) const {}
};

__device__ __forceinline__ unsigned cvt_pk_bf16(float lo, float hi) { unsigned r; asm volatile("v_cvt_pk_bf16_f32 %0, %1, %2" : "=v"(r) : "v"(lo), "v"(hi)); return r; }
typedef float f32x2 __attribute__((ext_vector_type(2)));

struct EpiBf16 {
    static constexpr bool PERM = true, AFTER_DRAIN = false;
    bf16_t* O; size_t ldc; int split_cols; size_t split_stride;
    __device__ __forceinline__ void operator()(const f32x4 (&acc)[2][2][4][2], const Unit& u, int wr, int wc, int fr, int fq) const {
        const int row0 = u.pm * BM + wr * 64 + fr; int colt = u.pn * BM; bf16_t* base = O;
        if (split_cols) { const int t = colt / split_cols; base += (size_t)t * split_stride; colt -= t * split_cols; }
        const int col0 = colt + wc * 32 + 8 * fq;
#pragma unroll
        for (int ai = 0; ai < 2; ++ai)
#pragma unroll
            for (int m = 0; m < 4; ++m) { bf16_t* rowp = base + (size_t)(row0 + ai * HALF + m * 16) * ldc + col0;
#pragma unroll
                for (int bj = 0; bj < 2; ++bj) { const f32x4 v0 = acc[ai][bj][m][0], v1 = acc[ai][bj][m][1];
                    u32x4 w; w.x = cvt_pk_bf16(v0[0], v0[1]); w.y = cvt_pk_bf16(v0[2], v0[3]); w.z = cvt_pk_bf16(v1[0], v1[1]); w.w = cvt_pk_bf16(v1[2], v1[3]);
                    *(u32x4*)(rowp + bj * HALF) = w; } }
    }
};

struct EpiUkvPg {
    static constexpr bool PERM = true, AFTER_DRAIN = false;
    bf16_t* KM; bf16_t* VM;
    __device__ __forceinline__ void operator()(const f32x4 (&acc)[2][2][4][2], const Unit& u, int wr, int wc, int fr, int fq) const {
        { const int ln = lane_id(); fr = ln & 15; fq = ln >> 4; }
        const int row0 = u.pm * BM + wr * 64 + fr; const int e0 = 32 * wc + 8 * fq;
        const bool isk = (wc < 2);
        bf16_t* base = isk ? KM + (size_t)row0 * 768 + 2 * u.pn * 96 + e0 : VM + (size_t)row0 * 512 + 2 * u.pn * 64 + (e0 - 64);
        const int ld = isk ? 768 : 512, hs = isk ? 96 : 64;
#pragma unroll
        for (int ai = 0; ai < 2; ++ai)
#pragma unroll
            for (int m = 0; m < 4; ++m)
#pragma unroll
                for (int bj = 0; bj < 2; ++bj) { const f32x4 v0 = acc[ai][bj][m][0], v1 = acc[ai][bj][m][1];
                    u32x4 w; w.x = cvt_pk_bf16(v0[0], v0[1]); w.y = cvt_pk_bf16(v0[2], v0[3]); w.z = cvt_pk_bf16(v1[0], v1[1]); w.w = cvt_pk_bf16(v1[2], v1[3]);
                    *(u32x4*)(base + (ai * HALF + m * 16) * ld + bj * hs) = w; }
    }
};
struct EpiUqPg {
    static constexpr bool PERM = true, AFTER_DRAIN = false;
    bf16_t* QM; const float* cos32; const float* sin32; float sc;
    __device__ __forceinline__ void operator()(const f32x4 (&acc)[2][2][4][2], const Unit& u, int wr, int wc, int fr, int fq) const {
        { const int ln = lane_id(); fr = ln & 15; fq = ln >> 4; }
        const int row0 = u.pm * BM + wr * 64 + fr;
        bf16_t* base = QM + (size_t)row0 * 768 + u.pn * BM + 32 * wc + 8 * fq;
        const int g0 = 8 * u.pn + wc;
        const bool sgn = (fq & 1) != 0;
#pragma unroll
        for (int bj = 0; bj < 2; ++bj) { const bool pe = (((g0 + 4 * bj) % 3) == 2);
#pragma unroll
            for (int ai = 0; ai < 2; ++ai)
#pragma unroll
                for (int m = 0; m < 4; ++m) { const int rr = ai * HALF + m * 16; u32x4 w;
#pragma unroll
                    for (int n = 0; n < 2; ++n) { f32x4 v = acc[ai][bj][m][n];
                        if (pe) { f32x4 o;
#pragma unroll
                            for (int e = 0; e < 4; ++e) o[e] = __shfl_xor(v[e], 16);
                            const int l = (row0 + rr) & 4095, pos = (fq < 2) ? (l >> 6) : (l & 63);
                            const f32x4 cv = *(const f32x4*)(cos32 + pos * 8 + 4 * n), sv = *(const f32x4*)(sin32 + pos * 8 + 4 * n);
                            v = sgn ? (v * cv + o * sv) : (v * cv - o * sv); }
                        v = v * sc;
                        if (n == 0) { w.x = cvt_pk_bf16(v[0], v[1]); w.y = cvt_pk_bf16(v[2], v[3]); } else { w.z = cvt_pk_bf16(v[0], v[1]); w.w = cvt_pk_bf16(v[2], v[3]); } }
                    *(u32x4*)(base + rr * 768 + bj * HALF) = w;
                    asm volatile("" ::: "memory"); } }
    }
};
struct EpiResF32 {
    static constexpr bool PERM = false, AFTER_DRAIN = false;
    const float* base; float* out; const float* mod; float gmul;
    __device__ __forceinline__ void operator()(const f32x4 (&acc)[2][2][4][2], const Unit& u, int wr, int wc, int fr, int fq) const {
        const int row0 = u.pm * BM + wr * 64 + fr, col0 = u.pn * BM + wc * 32 + 4 * fq, b = (u.pm * BM) >> 12;
        f32x4 g[2][2];
#pragma unroll
        for (int bj = 0; bj < 2; ++bj)
#pragma unroll
            for (int n = 0; n < 2; ++n) g[bj][n] = *(const f32x4*)(mod + b * 3072 + 2048 + col0 + bj * HALF + n * 16) * gmul;
#pragma unroll
        for (int ai = 0; ai < 2; ++ai) {
            f32x4 pre[4][2][2];
#pragma unroll
            for (int m = 0; m < 4; ++m) { const size_t off = (size_t)(row0 + ai * HALF + m * 16) * 1024 + col0;
#pragma unroll
                for (int bj = 0; bj < 2; ++bj)
#pragma unroll
                    for (int n = 0; n < 2; ++n) pre[m][bj][n] = *(const f32x4*)(base + off + bj * HALF + n * 16); }
#pragma unroll
            for (int m = 0; m < 4; ++m) { const size_t off = (size_t)(row0 + ai * HALF + m * 16) * 1024 + col0;
#pragma unroll
                for (int bj = 0; bj < 2; ++bj)
#pragma unroll
                    for (int n = 0; n < 2; ++n) *(f32x4*)(out + off + bj * HALF + n * 16) = pre[m][bj][n] + g[bj][n] * acc[ai][bj][m][n]; }
        }
    }
};
struct EpiResBf16 {
    static constexpr bool PERM = true, AFTER_DRAIN = false;
    const float* base; bf16_t* out; const float* mod; float gmul;
    __device__ __forceinline__ void operator()(const f32x4 (&acc)[2][2][4][2], const Unit& u, int wr, int wc, int fr, int fq) const {
        const int row0 = u.pm * BM + wr * 64 + fr, col0 = u.pn * BM + wc * 32 + 8 * fq, b = (u.pm * BM) >> 12;
        f32x4 g[2][2];
#pragma unroll
        for (int bj = 0; bj < 2; ++bj)
#pragma unroll
            for (int n = 0; n < 2; ++n) g[bj][n] = *(const f32x4*)(mod + b * 3072 + 2048 + col0 + bj * HALF + n * 4) * gmul;
#pragma unroll
        for (int ai = 0; ai < 2; ++ai) {
            f32x4 pre[4][2][2];
#pragma unroll
            for (int m = 0; m < 4; ++m) { const size_t off = (size_t)(row0 + ai * HALF + m * 16) * 1024 + col0;
#pragma unroll
                for (int bj = 0; bj < 2; ++bj)
#pragma unroll
                    for (int n = 0; n < 2; ++n) pre[m][bj][n] = *(const f32x4*)(base + off + bj * HALF + n * 4); }
#pragma unroll
            for (int m = 0; m < 4; ++m) { const size_t off = (size_t)(row0 + ai * HALF + m * 16) * 1024 + col0;
#pragma unroll
                for (int bj = 0; bj < 2; ++bj) { const f32x4 v0 = pre[m][bj][0] + g[bj][0] * acc[ai][bj][m][0], v1 = pre[m][bj][1] + g[bj][1] * acc[ai][bj][m][1];
                    u32x4 w; w.x = cvt_pk_bf16(v0[0], v0[1]); w.y = cvt_pk_bf16(v0[2], v0[3]); w.z = cvt_pk_bf16(v1[0], v1[1]); w.w = cvt_pk_bf16(v1[2], v1[3]);
                    *(u32x4*)(out + off + bj * HALF) = w; } }
        }
    }
};
template <class Epi, class Sched, bool ALIGN_EPI = false, bool SP2 = false>
__device__ __forceinline__ void gemm_phase(PG8_LAS unsigned char* lds, const Gemm g, const Sched& S, const Epi& E) {
    int tid_ = TID(); asm volatile("" : "+v"(tid_));
    const int tid = tid_, wid = __builtin_amdgcn_readfirstlane(tid >> 6), lane = tid & 63, wr = wid >> 2, wc = wid & 3, fr = lane & 15, fq = lane >> 4;
    const int K = g.K, nt = K / BK;
    unsigned voffA[2], voffB[2];
#pragma unroll
    for (int i = 0; i < 2; ++i) { int R, C; stage_rc(tid * 16 + i * 8192, R, C); const int Rb = Epi::PERM ? ((R & ~31) + perm32(R & 31)) : R;
        voffA[i] = (unsigned)(R * K + C) * 2u; voffB[i] = (unsigned)(Rb * K + C) * 2u; }
    const size_t kstep = (size_t)(BK * 2);
    const size_t hstep = (size_t)HALF * K * 2;
    const size_t tstep = 2 * hstep;
    const unsigned ldsw = (unsigned)wid * 1024u;
    const int aoff = lds_byte(wr * 64 + fr, fq * 8), boff = lds_byte(wc * 32 + fr, fq * 8);
#define PG8_SA(b, h) (((b) * 2 + (h)) * HTB)
#define PG8_SB(b, h) ((4 + (b) * 2 + (h)) * HTB)
#define PG8_STAGE(bufoff, gbase, voff) do { _Pragma("unroll") for (int _i = 0; _i < 2; ++_i) \
        __builtin_amdgcn_global_load_lds((const unsigned*)((const char*)(gbase) + (voff)[_i]), (PG8_LAS unsigned*)(lds + (bufoff) + ldsw + _i * 8192), 16, 0, 0); } while (0)
#define PG8_LDA(dst, b, h) do { _Pragma("unroll") for (int m = 0; m < 4; ++m) _Pragma("unroll") for (int k = 0; k < 2; ++k) dst[m][k] = *(const PG8_LAS bf16x8*)(lds + PG8_SA(b, h) + aoff + m * 2048 + k * 1024); } while (0)
#define PG8_LDB(dst, b, h) do { _Pragma("unroll") for (int n = 0; n < 2; ++n) _Pragma("unroll") for (int k = 0; k < 2; ++k) dst[n][k] = *(const PG8_LAS bf16x8*)(lds + PG8_SB(b, h) + boff + n * 2048 + k * 1024); } while (0)
#define PG8_MMA(ai, bj, At, Bt) do { __builtin_amdgcn_s_setprio(1); _Pragma("unroll") for (int m = 0; m < 4; ++m) _Pragma("unroll") for (int n = 0; n < 2; ++n) _Pragma("unroll") for (int k = 0; k < 2; ++k) \
        acc[ai][bj][m][n] = __builtin_amdgcn_mfma_f32_16x16x32_bf16(Bt[n][k], At[m][k], acc[ai][bj][m][n], 0, 0, 0); __builtin_amdgcn_s_setprio(0); } while (0)
#define PG8_WAIT_V(n) asm volatile("s_waitcnt vmcnt(" #n ")" ::: "memory")
#define PG8_WAIT_L(n) asm volatile("s_waitcnt lgkmcnt(" #n ")" ::: "memory")
#define PG8_BAR __builtin_amdgcn_s_barrier()
#define PG8_SCHED __builtin_amdgcn_sched_barrier(0)
    Unit cur, nxt; int ui = 0;
    if (!S.next(0, cur)) return;
    f32x4 acc[2][2][4][2];
#pragma unroll
    for (int a = 0; a < 2; ++a)
#pragma unroll
        for (int b = 0; b < 2; ++b)
#pragma unroll
            for (int m = 0; m < 4; ++m)
#pragma unroll
                for (int n = 0; n < 2; ++n) acc[a][b][m][n] = (f32x4){0.f, 0.f, 0.f, 0.f};
    bf16x8 At[4][2], B0[2][2], B1[2][2];
    const char* cA = (const char*)g.A + (size_t)cur.pm * tstep; const char* cB = (const char*)g.Bt + (size_t)cur.pn * tstep;
    S.a_ready(cur);
    if constexpr (SP2) {
        PG8_STAGE(PG8_SB(0, 0), cB, voffB); PG8_STAGE(PG8_SB(0, 1), cB + hstep, voffB); PG8_STAGE(PG8_SA(0, 0), cA, voffA); PG8_STAGE(PG8_SA(0, 1), cA + hstep, voffA);
        if (wr == 1) PG8_BAR;
        PG8_WAIT_V(2); PG8_BAR;
        PG8_STAGE(PG8_SB(1, 0), cB + kstep, voffB); PG8_STAGE(PG8_SA(1, 0), cA + kstep, voffA); PG8_STAGE(PG8_SB(1, 1), cB + hstep + kstep, voffB);
        PG8_WAIT_V(6); PG8_BAR;
    } else {
        PG8_STAGE(PG8_SB(0, 0), cB, voffB); PG8_STAGE(PG8_SA(0, 0), cA, voffA); PG8_STAGE(PG8_SB(0, 1), cB + hstep, voffB); PG8_STAGE(PG8_SA(0, 1), cA + hstep, voffA);
        if (wr == 1) PG8_BAR;
        PG8_WAIT_V(4); PG8_BAR;
        PG8_STAGE(PG8_SB(1, 0), cB + kstep, voffB); PG8_STAGE(PG8_SA(1, 0), cA + kstep, voffA); PG8_STAGE(PG8_SB(1, 1), cB + hstep + kstep, voffB);
        PG8_WAIT_V(6); PG8_BAR;
    }
    for (;;) {
        const bool has_next = S.next(ui + 1, nxt);
        const char* nA = has_next ? (const char*)g.A + (size_t)nxt.pm * tstep : cA; const char* nB = has_next ? (const char*)g.Bt + (size_t)nxt.pn * tstep : cB;
        for (int t = 0; t < nt; t += 2) {
            const bool last = (t == nt - 2);
            const char* a1 = cA + (size_t)(t + 1) * kstep;
            const char* a2 = last ? nA : cA + (size_t)(t + 2) * kstep; const char* b2 = last ? nB : cB + (size_t)(t + 2) * kstep;
            const char* a3 = a2 + kstep; const char* b3 = b2 + kstep;
            if (last && has_next) S.a_ready(nxt);
            if constexpr (SP2) {
            PG8_LDB(B0, 0, 0); PG8_LDB(B1, 0, 1); PG8_SCHED; PG8_LDA(At, 0, 0); PG8_STAGE(PG8_SA(1, 1), a1 + hstep, voffA);
            PG8_WAIT_V(8); PG8_WAIT_L(0); PG8_BAR; PG8_MMA(0, 0, At, B0); PG8_MMA(0, 1, At, B1); PG8_BAR; PG8_SCHED;
            PG8_LDA(At, 0, 1); PG8_STAGE(PG8_SB(0, 0), b2, voffB); PG8_STAGE(PG8_SB(0, 1), b2 + hstep, voffB); PG8_STAGE(PG8_SA(0, 0), a2, voffA);
            PG8_WAIT_V(8); PG8_WAIT_L(0); PG8_BAR; PG8_MMA(1, 0, At, B0); PG8_MMA(1, 1, At, B1); PG8_BAR; PG8_SCHED;
            PG8_LDB(B0, 1, 0); PG8_LDB(B1, 1, 1); PG8_SCHED; PG8_LDA(At, 1, 0); PG8_STAGE(PG8_SA(0, 1), a2 + hstep, voffA);
            PG8_WAIT_V(8); PG8_WAIT_L(0); PG8_BAR; PG8_MMA(0, 0, At, B0); PG8_MMA(0, 1, At, B1); PG8_BAR; PG8_SCHED;
            PG8_LDA(At, 1, 1); PG8_STAGE(PG8_SB(1, 0), b3, voffB); PG8_STAGE(PG8_SB(1, 1), b3 + hstep, voffB); PG8_STAGE(PG8_SA(1, 0), a3, voffA);
            PG8_WAIT_V(8); PG8_WAIT_L(0); PG8_BAR; PG8_MMA(1, 0, At, B0); PG8_MMA(1, 1, At, B1); PG8_BAR; PG8_SCHED;
            } else {
            PG8_LDB(B0, 0, 0); PG8_SCHED; PG8_LDA(At, 0, 0); PG8_STAGE(PG8_SA(1, 1), a1 + hstep, voffA);
            PG8_WAIT_L(8); PG8_BAR; PG8_WAIT_L(0); PG8_MMA(0, 0, At, B0); PG8_BAR; PG8_SCHED;
            PG8_LDB(B1, 0, 1); PG8_STAGE(PG8_SB(0, 0), b2, voffB);
            PG8_BAR; PG8_WAIT_L(0); PG8_MMA(0, 1, At, B1); PG8_BAR;
            PG8_LDA(At, 0, 1); PG8_STAGE(PG8_SA(0, 0), a2, voffA);
            PG8_BAR; PG8_WAIT_L(0); PG8_MMA(1, 0, At, B0); PG8_BAR; PG8_SCHED;
            PG8_STAGE(PG8_SB(0, 1), b2 + hstep, voffB);
            PG8_WAIT_V(6); PG8_BAR; PG8_MMA(1, 1, At, B1); PG8_BAR;
            PG8_LDB(B0, 1, 0); PG8_SCHED; PG8_LDA(At, 1, 0); PG8_STAGE(PG8_SA(0, 1), a2 + hstep, voffA);
            PG8_WAIT_L(8); PG8_BAR; PG8_WAIT_L(0); PG8_MMA(0, 0, At, B0); PG8_BAR; PG8_SCHED;
            PG8_LDB(B1, 1, 1); PG8_STAGE(PG8_SB(1, 0), b3, voffB);
            PG8_BAR; PG8_WAIT_L(0); PG8_MMA(0, 1, At, B1); PG8_BAR;
            PG8_LDA(At, 1, 1); PG8_STAGE(PG8_SA(1, 0), a3, voffA);
            PG8_BAR; PG8_WAIT_L(0); PG8_MMA(1, 0, At, B0); PG8_BAR; PG8_SCHED;
            PG8_STAGE(PG8_SB(1, 1), b3 + hstep, voffB);
            PG8_WAIT_V(6); PG8_BAR; PG8_MMA(1, 1, At, B1); PG8_BAR;
            }
        }
        if constexpr (ALIGN_EPI) { if (wr == 0) PG8_BAR; }
        if constexpr (!Epi::AFTER_DRAIN) { E(acc, cur, wr, wc, fr, fq); S.done(cur); }
        if (!has_next) break;
#pragma unroll
        for (int a = 0; a < 2; ++a)
#pragma unroll
            for (int b = 0; b < 2; ++b)
#pragma unroll
                for (int m = 0; m < 4; ++m)
#pragma unroll
                    for (int n = 0; n < 2; ++n) acc[a][b][m][n] = (f32x4){0.f, 0.f, 0.f, 0.f};
        cur = nxt; cA = nA; cB = nB; ++ui;
        if constexpr (ALIGN_EPI) { if (wr == 1) PG8_BAR; }
    }
    PG8_WAIT_V(0);
    if constexpr (!ALIGN_EPI) { if (wr == 0) PG8_BAR; }
    PG8_BAR;
    if constexpr (Epi::AFTER_DRAIN) { E.fused(acc, cur, wr, wc, fr, fq, lds, wid, lane); S.done(cur); }
#undef PG8_SA
#undef PG8_SB
#undef PG8_STAGE
#undef PG8_LDA
#undef PG8_LDB
#undef PG8_MMA
#undef PG8_WAIT_V
#undef PG8_WAIT_L
#undef PG8_BAR
#undef PG8_SCHED
}
}

DEV void transpose_item(float* scr, const float* W, int K, int N, int Npad, bf16_t* WT, int item, int lane) {
    const int nblk = Npad / 32, kb = item / nblk, nb = item % nblk, k0 = 64 * kb, n0 = 32 * nb;
    const bool valid = (n0 < N);
    float v[32];
#pragma unroll
    for (int i = 0; i < 32; ++i) { const int kk = 2 * i + (lane >> 5); v[i] = valid ? W[(size_t)(k0 + kk) * N + n0 + (lane & 31)] : 0.f; }
#pragma unroll
    for (int i = 0; i < 32; ++i) { const int kk = 2 * i + (lane >> 5); scr[kk * 33 + (lane & 31)] = v[i]; }
    asm volatile("s_waitcnt lgkmcnt(0)" ::: "memory");
    const int c = lane & 7;
#pragma unroll
    for (int j = 0; j < 4; ++j) { const int n = (lane >> 3) + 8 * j; const float* sp = scr + (8 * c) * 33 + n; float o[8];
#pragma unroll
        for (int e = 0; e < 8; ++e) o[e] = sp[e * 33];
        *(u32x4*)(WT + (size_t)(n0 + n) * K + k0 + 8 * c) = pack8(o); }
    asm volatile("s_waitcnt lgkmcnt(0)" ::: "memory");
}

DEV void mod_item(char* lds, const Params& p, int item) {
    const int layer = item / 96, n0 = (item % 96) * 32, tid = TID();
    float* s = (float*)lds;
    float* red = s + 9 * 1024;
    for (int i = tid; i < 9 * 1024; i += 512) { const int v = i >> 10, k = i & 1023; const float cv = (v < 8) ? p.c[v * 1024 + k] : p.c_ctx[k]; s[i] = silu(cv); }
    __syncthreads();
    const int kc = tid >> 5, n = tid & 31; const float* W = p.ada_w + (size_t)layer * DM * 3072 + n0 + n;
    float acc[9];
#pragma unroll
    for (int v = 0; v < 9; ++v) acc[v] = 0.f;
#pragma unroll 16
    for (int kk = 0; kk < 64; ++kk) { const int k = kc * 64 + kk; const float w = W[(size_t)k * 3072];
#pragma unroll
        for (int v = 0; v < 9; ++v) acc[v] += s[v * 1024 + k] * w; }
#pragma unroll
    for (int v = 0; v < 9; ++v) red[(kc * 9 + v) * 32 + n] = acc[v];
    __syncthreads();
    if (tid < 9 * 32) { const int v = tid >> 5, nn = tid & 31; float t = 0.f;
#pragma unroll
        for (int k2 = 0; k2 < 16; ++k2) t += red[(k2 * 9 + v) * 32 + nn];
        t += p.ada_b[layer * 3072 + n0 + nn];
        if (layer == 0) ((float*)(p.ws + WS_MOD0))[v * 3072 + n0 + nn] = t;
        else if (v < 8) ((float*)(p.ws + WS_MOD1))[v * 3072 + n0 + nn] = t; }
    __syncthreads();
}

DEV void hid2_row(char* lds, const Params& p, int t, int wid, int lane) {
    float* sc = (float*)lds + wid * 128;
    const float tn = (float)t * (1.0f / 4095.0f);
    const float w = (float)(2.0 * 3.14159265358979323846 / 4096.0) * (float)t;
    float e = 0.f;
    if (lane == 0) e = tn;
    else if (lane <= 32) { const int k = (lane - 1) & 15; const float band = 1e-4f + (float)k * ((15.0f - 1e-4f) / 15.0f); const float ang = w * band; e = (lane <= 16) ? cosf(ang) : -sinf(ang); }
    sc[lane] = e;
    asm volatile("s_waitcnt lgkmcnt(0)" ::: "memory");
    float a = p.f_b1[lane];
    for (int i = 0; i < 33; ++i) a += sc[i] * p.f_w1[i * 64 + lane];
    const float fr = p.freq[lane];
    const float h1 = sinf(fr * a);
    sc[64 + lane] = h1;
    asm volatile("s_waitcnt lgkmcnt(0)" ::: "memory");
    float a2 = p.f_b2[lane];
    for (int i = 0; i < 64; ++i) a2 += sc[64 + i] * p.f_w2[i * 64 + lane];
    const float h2 = sinf(fr * a2);
    ((bf16_t*)(p.ws + WS_HID2))[t * 64 + lane] = f2bf(h2);
    asm volatile("s_waitcnt lgkmcnt(0)" ::: "memory");
}

DEV void phase_prep(char* lds, const Params& p) {
    const int tid = TID(), wid = tid >> 6, lane = tid & 63;
    { const int gt = blockIdx.x * 512 + tid;
        if (gt < 2048) ((float*)(p.ws + WS_SSUM))[gt] = 0.f;
        float* rp = (float*)(p.ws + WS_ROPE);
        if (gt < 1024) { const int pos = gt >> 4, i = gt & 15; const float inv = exp2f(-(float)i * (13.287712379549449f / 16.0f)); const float ang = (float)pos * inv; rp[gt] = cosf(ang); rp[1024 + gt] = sinf(ang); }
        if (gt < 512) { const int pos = gt >> 3, i = gt & 7; const float inv = exp2f(-(float)i * (13.287712379549449f / 8.0f)); const float ang = (float)pos * inv; rp[2048 + gt] = cosf(ang); rp[2560 + gt] = sinf(ang); } }
    for (int it = blockIdx.x; it < 192; it += gridDim.x) mod_item(lds, p, it);
    for (int t = blockIdx.x * 8 + wid; t < 4096; t += gridDim.x * 8) hid2_row(lds, p, t, wid, lane);
    __syncthreads();
    constexpr int I_WIN = 16 * (AINP / 32), I_UQ = 4 * 24, I_UKV = 2 * 32, I_WO = 16 * 32, I_HIN = 16 * 128, I_HO = 16 * 32, I_W3 = 128;
    constexpr int NIT = I_WIN + I_UQ + I_UKV + I_WO + I_HIN + I_HO + I_W3;
    float* scr = (float*)lds + wid * (64 * 33);
    for (int it = blockIdx.x * 8 + wid; it < NIT; it += gridDim.x * 8) {
        int r = it;
        if (r < I_HIN) { transpose_item(scr, p.hy_w_in, 1024, 4096, 4096, (bf16_t*)(p.ws + WS_HWIN), r, lane); continue; } r -= I_HIN;
        if (r < I_WIN) { transpose_item(scr, p.w_in, 1024, AIN, AINP, (bf16_t*)(p.ws + WS_WIN), r, lane); continue; } r -= I_WIN;
        if (r < I_WO) { transpose_item(scr, p.w_out, 1024, 1024, 1024, (bf16_t*)(p.ws + WS_WOUT), r, lane); continue; } r -= I_WO;
        if (r < I_HO) { transpose_item(scr, p.hy_w_out, 1024, 1024, 1024, (bf16_t*)(p.ws + WS_HWOUT), r, lane); continue; } r -= I_HO;
        if (r < I_UQ) { transpose_item(scr, p.w_uq, 256, 768, 768, (bf16_t*)(p.ws + WS_WUQ), r, lane); continue; } r -= I_UQ;
        if (r < I_UKV) { transpose_item(scr, p.w_ukv, 128, 1024, 1024, (bf16_t*)(p.ws + WS_WUKV), r, lane); continue; } r -= I_UKV;
        transpose_item(scr, p.f_w3, 64, 4096, 4096, (bf16_t*)(p.ws + WS_W3), r, lane);
    }
}

DEV void row_load(f32x4 (&v)[4], const float* xr, int lane) {
#pragma unroll
    for (int j = 0; j < 4; ++j) v[j] = *(const f32x4*)(xr + lane * 4 + 256 * j);
}
DEV void row_load_bf(f32x4 (&v)[4], const bf16_t* xr, int lane) {
#pragma unroll
    for (int j = 0; j < 4; ++j) { const u32x2 w = *(const u32x2*)(xr + lane * 4 + 256 * j); v[j] = (f32x4){lo_bf(w.x), hi_bf(w.x), lo_bf(w.y), hi_bf(w.y)}; }
}
DEV void modnorm_row(const f32x4 (&v)[4], const float* nw, const float* shift, const float* scale, bf16_t* orow, int lane) {
    float s = 0.f;
#pragma unroll
    for (int j = 0; j < 4; ++j) s += v[j].x * v[j].x + v[j].y * v[j].y + v[j].z * v[j].z + v[j].w * v[j].w;
    const float r = rsqrtf(wave_sum(s) * (1.0f / DM) + EPS);
#pragma unroll
    for (int j = 0; j < 4; ++j) { const int c0 = lane * 4 + 256 * j;
        const f32x4 w = *(const f32x4*)(nw + c0), sh = *(const f32x4*)(shift + c0), sc = *(const f32x4*)(scale + c0);
        const float o0 = v[j].x * r * w.x * (1.f + sc.x) + sh.x, o1 = v[j].y * r * w.y * (1.f + sc.y) + sh.y, o2 = v[j].z * r * w.z * (1.f + sc.z) + sh.z, o3 = v[j].w * r * w.w * (1.f + sc.w) + sh.w;
        u32x2 pk; pk.x = pk2(o0, o1); pk.y = pk2(o2, o3); *(u32x2*)(orow + c0) = pk; }
}
DEV const float* norm0_src(const Params& p, int row) { return row < NTOK ? p.x + (size_t)row * DM : p.ctx + (size_t)(row - NTOK) * DM; }
DEV void phase_norm0(const Params& p) {
    const int wid = TID() >> 6, lane = TID() & 63; const float* mod0 = (const float*)(p.ws + WS_MOD0); bf16_t* H0 = (bf16_t*)(p.ws + WS_H0);
    const int stride = gridDim.x * 8; int row = blockIdx.x * 8 + wid;
    f32x4 cur[4], nxt[4];
    if (row < NALL) row_load(cur, norm0_src(p, row), lane);
    for (; row < NALL; row += stride) {
        { const int rn = row + stride < NALL ? row + stride : row; row_load(nxt, norm0_src(p, rn), lane); }
        const int v = row < NTOK ? (row >> 12) : 8;
        modnorm_row(cur, p.norm_w, mod0 + v * 3072, mod0 + v * 3072 + 1024, H0 + (size_t)row * DM, lane);
#pragma unroll
        for (int j = 0; j < 4; ++j) cur[j] = nxt[j];
    }
}
DEV void phase_norm1(const Params& p) {
    const int wid = TID() >> 6, lane = TID() & 63; const float* mod1 = (const float*)(p.ws + WS_MOD1); bf16_t* H1 = (bf16_t*)(p.ws + WS_H1);
    const int stride = gridDim.x * 8; int row = blockIdx.x * 8 + wid;
    f32x4 cur[4], nxt[4];
    const bf16_t* X1b = (const bf16_t*)p.out;
    if (row < NTOK) row_load_bf(cur, X1b + (size_t)row * DM, lane);
    for (; row < NTOK; row += stride) {
        { const int rn = row + stride < NTOK ? row + stride : row; row_load_bf(nxt, X1b + (size_t)rn * DM, lane); }
        const int v = row >> 12;
        modnorm_row(cur, p.norm_w + DM, mod1 + v * 3072, mod1 + v * 3072 + 1024, H1 + (size_t)row * DM, lane);
#pragma unroll
        for (int j = 0; j < 4; ++j) cur[j] = nxt[j];
    }
}
DEV void phase_final(const Params& p) {
    const int wid = TID() >> 6, lane = TID() & 63;
    const int stride = gridDim.x * 8; int row = blockIdx.x * 8 + wid;
    f32x4 v[4], nxt[4];
    const bf16_t* X2b = (const bf16_t*)(p.ws + WS_PT);
    if (row < NTOK) row_load_bf(v, X2b + (size_t)row * DM, lane);
    for (; row < NTOK; row += stride) {
        { const int rn = row + stride < NTOK ? row + stride : row; row_load_bf(nxt, X2b + (size_t)rn * DM, lane); }
        float* xr = p.out + (size_t)row * DM; float s = 0.f;
#pragma unroll
        for (int j = 0; j < 4; ++j) s += v[j].x * v[j].x + v[j].y * v[j].y + v[j].z * v[j].z + v[j].w * v[j].w;
        const float r = rsqrtf(wave_sum(s) * (1.0f / DM) + EPS);
#pragma unroll
        for (int j = 0; j < 4; ++j) { const int c0 = lane * 4 + 256 * j; const f32x4 w = *(const f32x4*)(p.final_w + c0);
            f32x4 o; o.x = v[j].x * r * w.x; o.y = v[j].y * r * w.y; o.z = v[j].z * r * w.z; o.w = v[j].w * r * w.w; *(f32x4*)(xr + c0) = o; }
#pragma unroll
        for (int j = 0; j < 4; ++j) v[j] = nxt[j];
    }
}

struct PostIn { u32x4 raw[5]; f32x4 c64[2], s64[2], c32[2], s32[2]; };
DEV void post_load(PostIn& I, const bf16_t* PRAW, const float* rp, int tok, int lane) {
    const bf16_t* pr = PRAW + (size_t)tok * AINP;
#pragma unroll
    for (int sgm = 0; sgm < 4; ++sgm) I.raw[sgm] = *(const u32x4*)(pr + 512 * sgm + lane * 8);
    I.raw[4] = *(const u32x4*)(pr + 2048 + (lane & 31) * 8);
    const int l = tok & 4095, prow = l >> 6, pcol = l & 63;
    const int k = lane & 7, posv = (k < 4) ? prow : pcol; const float* t64 = rp + posv * 16 + (k & 1) * 8;
    I.c64[0] = *(const f32x4*)t64; I.c64[1] = *(const f32x4*)(t64 + 4); I.s64[0] = *(const f32x4*)(t64 + 1024); I.s64[1] = *(const f32x4*)(t64 + 1028);
    const int k3 = lane & 3, posm = (k3 < 2) ? prow : pcol; const float* t32 = rp + 2048 + posm * 8;
    I.c32[0] = *(const f32x4*)t32; I.c32[1] = *(const f32x4*)(t32 + 4); I.s32[0] = *(const f32x4*)(t32 + 512); I.s32[1] = *(const f32x4*)(t32 + 516);
}
DEV void phase_post(const Params& p) {
    const int wid = TID() >> 6, lane = TID() & 63;
    const bf16_t* PRAW = (const bf16_t*)(p.ws + WS_PRAW);
    bf16_t* QA = (bf16_t*)(p.ws + WS_QA); bf16_t* KA = (bf16_t*)(p.ws + WS_KA); bf16_t* VA = (bf16_t*)(p.ws + WS_VA);
    bf16_t* CQN = (bf16_t*)(p.ws + WS_CQN); bf16_t* CKVN = (bf16_t*)(p.ws + WS_CKVN); bf16_t* G = (bf16_t*)(p.ws + WS_G); bf16_t* KM = (bf16_t*)(p.ws + WS2_KM);
    const float* rp = (const float*)(p.ws + WS_ROPE);
    float wq[8], wk[8], wcq[8], wckv[8];
    { const int k = lane & 7;
#pragma unroll
        for (int j = 0; j < 8; ++j) { wq[j] = p.q_norm[k * 8 + j]; wk[j] = p.k_norm[k * 8 + j]; wcq[j] = p.cq_norm[(lane & 31) * 8 + j]; wckv[j] = p.ckv_norm[(lane & 15) * 8 + j]; } }
    const int stride = gridDim.x * 8;
    int tok = blockIdx.x * 8 + wid;
    PostIn cur, nxt;
    if (tok < NALL) post_load(cur, PRAW, rp, tok, lane);
    for (; tok < NALL; tok += stride) {
        { const int tn = tok + stride < NALL ? tok + stride : tok; post_load(nxt, PRAW, rp, tn, lane); }
        const bool lat = tok < NTOK; int b, pos;
        if (lat) { b = tok >> 12; pos = CTXL + (tok & 4095); } else { const int j = tok - NTOK; b = j >> 8; pos = j & 255; }
        const size_t kvrow = (size_t)b * LK + pos;
        const float cs64[8] = {cur.c64[0].x, cur.c64[0].y, cur.c64[0].z, cur.c64[0].w, cur.c64[1].x, cur.c64[1].y, cur.c64[1].z, cur.c64[1].w};
        const float sn64[8] = {cur.s64[0].x, cur.s64[0].y, cur.s64[0].z, cur.s64[0].w, cur.s64[1].x, cur.s64[1].y, cur.s64[1].z, cur.s64[1].w};
        float v[8], o[8];
        if (lat) {
            unpack8(cur.raw[0], v);
            float ss = 0.f;
#pragma unroll
            for (int j = 0; j < 8; ++j) ss += v[j] * v[j];
            ss += __shfl_xor(ss, 1); ss += __shfl_xor(ss, 2); ss += __shfl_xor(ss, 4);
            const float r = rsqrtf(ss * (1.0f / 64.0f) + EPS); const int k = lane & 7;
#pragma unroll
            for (int j = 0; j < 8; ++j) v[j] = v[j] * r * wq[j];
#pragma unroll
            for (int j = 0; j < 8; ++j) { const float ot = __shfl_xor(v[j], 2);
                o[j] = ((k & 2) ? (v[j] * cs64[j] + ot * sn64[j]) : (v[j] * cs64[j] - ot * sn64[j])) * QSC_A; }
            *(u32x4*)(QA + (size_t)tok * 512 + lane * 8) = pack8(o);
        }
        {
            const u32x4 raw = cur.raw[1]; unpack8(raw, v);
            float ss = 0.f;
#pragma unroll
            for (int j = 0; j < 8; ++j) ss += v[j] * v[j];
            ss += __shfl_xor(ss, 1); ss += __shfl_xor(ss, 2); ss += __shfl_xor(ss, 4);
            const float s8 = ss;
            ss += __shfl_xor(ss, 8); ss += __shfl_xor(ss, 16);
            const float s32 = ss;
            float vn[8]; const int k = lane & 7;
            { const float r = rsqrtf(s8 * (1.0f / 64.0f) + EPS);
#pragma unroll
                for (int j = 0; j < 8; ++j) vn[j] = v[j] * r * wk[j]; }
#pragma unroll
            for (int j = 0; j < 8; ++j) { const float ot = __shfl_xor(vn[j], 2);
                o[j] = lat ? ((k & 2) ? (vn[j] * cs64[j] + ot * sn64[j]) : (vn[j] * cs64[j] - ot * sn64[j])) : vn[j]; }
            if (lane < 16) *(u32x4*)(KA + kvrow * 128 + lane * 8) = pack8(o);
            else if (lane < 32) *(u32x4*)(VA + kvrow * 128 + (lane - 16) * 8) = raw;
            else if (lat) { const float r = rsqrtf(s32 * (1.0f / 256.0f) + EPS); const int cb = (lane - 32) * 8;
#pragma unroll
                for (int j = 0; j < 8; ++j) o[j] = v[j] * r * wcq[j];
                *(u32x4*)(CQN + (size_t)tok * 256 + cb) = pack8(o); }
        }
        {
            unpack8(cur.raw[2], v);
            float ss = 0.f;
#pragma unroll
            for (int j = 0; j < 8; ++j) ss += v[j] * v[j];
            ss += __shfl_xor(ss, 1); ss += __shfl_xor(ss, 2); ss += __shfl_xor(ss, 4); ss += __shfl_xor(ss, 8);
            const int k = lane & 3;
            float oth[8];
#pragma unroll
            for (int j = 0; j < 8; ++j) oth[j] = __shfl_xor(v[j], 1);
            if (lane < 16) { const float r = rsqrtf(ss * (1.0f / 128.0f) + EPS);
#pragma unroll
                for (int j = 0; j < 8; ++j) o[j] = v[j] * r * wckv[j];
                *(u32x4*)(CKVN + kvrow * 128 + lane * 8) = pack8(o); }
            else if (lane < 20) {
                const float cs32[8] = {cur.c32[0].x, cur.c32[0].y, cur.c32[0].z, cur.c32[0].w, cur.c32[1].x, cur.c32[1].y, cur.c32[1].z, cur.c32[1].w};
                const float sn32[8] = {cur.s32[0].x, cur.s32[0].y, cur.s32[0].z, cur.s32[0].w, cur.s32[1].x, cur.s32[1].y, cur.s32[1].z, cur.s32[1].w};
#pragma unroll
                for (int j = 0; j < 8; ++j) o[j] = lat ? ((k & 1) ? (v[j] * cs32[j] + oth[j] * sn32[j]) : (v[j] * cs32[j] - oth[j] * sn32[j])) : v[j];
                const u32x4 w = pack8(o);
#pragma unroll
                for (int h = 0; h < 8; ++h) *(u32x4*)(KM + kvrow * 768 + h * 96 + 64 + k * 8) = w; }
            else if (lat) {
#pragma unroll
                for (int j = 0; j < 8; ++j) o[j] = silu(v[j]);
                *(u32x4*)(G + (size_t)tok * 1024 + (lane - 20) * 8) = pack8(o); }
        }
        if (lat) {
            unpack8(cur.raw[3], v);
#pragma unroll
            for (int j = 0; j < 8; ++j) o[j] = silu(v[j]);
            *(u32x4*)(G + (size_t)tok * 1024 + 352 + lane * 8) = pack8(o);
            if (lane < 20) { unpack8(cur.raw[4], v);
#pragma unroll
                for (int j = 0; j < 8; ++j) o[j] = silu(v[j]);
                *(u32x4*)(G + (size_t)tok * 1024 + 864 + lane * 8) = pack8(o); }
        }
        cur = nxt;
    }
}

template <int DQK>
DEV void attn_unit(char* lds, const bf16_t* __restrict__ Q, int ldq, int qcol, const bf16_t* __restrict__ Kp, int ldk, int kcol, const bf16_t* __restrict__ Vp, int ldv, int vcol,
                   const bf16_t* __restrict__ Gt, bf16_t* OG, int ocol, int b, int q0) {
    constexpr int KRS = (DQK + 8) * 2, KB = 64 * KRS, VRS = 192, VB = 64 * VRS, STG = KB + VB, NKS = DQK / 16, KCH = DQK / 8;
    const int tid = TID(), lane = tid & 63, wid = tid >> 6, l31 = lane & 31, hi = lane >> 5;
    bf16x8 qf[NKS];
    { const bf16_t* qp = Q + (size_t)(b * SEQ + q0 + wid * 32 + l31) * ldq + qcol + hi * 8;
#pragma unroll
        for (int ks = 0; ks < NKS; ++ks) qf[ks] = *(const bf16x8*)(qp + ks * 16); }
    const bf16_t* kbase = Kp + (size_t)b * LK * ldk + kcol; const bf16_t* vbase = Vp + (size_t)b * LK * ldv + vcol;
    const int kr0 = tid / KCH, kc0 = tid % KCH;
    const int kr1 = (tid + 512) / KCH, kc1 = (tid + 512) % KCH;
    const bool k2 = (KCH * 64 > 512) && (tid + 512 < KCH * 64);
    const int vr = tid >> 3, vc = tid & 7;
    u32x4 sk0, sk1, sv;
#define A_LOAD(t) do { const size_t kp_ = (size_t)(t) * 64; sk0 = *(const u32x4*)(kbase + (kp_ + kr0) * ldk + kc0 * 8); \
        if (k2) sk1 = *(const u32x4*)(kbase + (kp_ + kr1) * ldk + kc1 * 8); sv = *(const u32x4*)(vbase + (kp_ + vr) * ldv + vc * 8); } while (0)
#define A_STORE(buf) do { char* b_ = lds + (buf) * STG; *(u32x4*)(b_ + kr0 * KRS + kc0 * 16) = sk0; if (k2) *(u32x4*)(b_ + kr1 * KRS + kc1 * 16) = sk1; \
        *(u32x4*)(b_ + KB + vr * VRS + vc * 16) = sv; } while (0)
    f32x16 o0, o1;
#pragma unroll
    for (int r = 0; r < 16; ++r) { o0[r] = 0.f; o1[r] = 0.f; }
    float m_run = -1e30f, l_run = 0.f;
    const int g1 = (lane >> 4) & 1, tq = (lane & 15) >> 2, tp = lane & 3;
    const int vt_off = KB + (4 * hi + tq) * VRS + (16 * g1 + 4 * tp) * 2;
    const int kf_off = l31 * KRS + hi * 16;
    constexpr int NT = LK / 64;
    A_LOAD(0); A_STORE(0);
    __syncthreads();
    for (int t = 0; t < NT; ++t) {
        const bool more = (t + 1 < NT);
        if (more) A_LOAD(t + 1);
        const char* b_ = lds + (t & 1) * STG;
        f32x16 p0, p1;
#pragma unroll
        for (int r = 0; r < 16; ++r) { p0[r] = 0.f; p1[r] = 0.f; }
#pragma unroll
        for (int ks = 0; ks < NKS; ++ks) {
            const bf16x8 ka = *(const bf16x8*)(b_ + kf_off + ks * 32);
            const bf16x8 kb = *(const bf16x8*)(b_ + kf_off + 32 * KRS + ks * 32);
            p0 = __builtin_amdgcn_mfma_f32_32x32x16_bf16(ka, qf[ks], p0, 0, 0, 0);
            p1 = __builtin_amdgcn_mfma_f32_32x32x16_bf16(kb, qf[ks], p1, 0, 0, 0);
        }
        float mx = p0[0];
#pragma unroll
        for (int r = 1; r < 16; ++r) mx = fmaxf(mx, p0[r]);
#pragma unroll
        for (int r = 0; r < 16; ++r) mx = fmaxf(mx, p1[r]);
        mx = fmaxf(mx, __shfl_xor(mx, 32));
        const float m_new = fmaxf(m_run, mx);
        const float alpha = __builtin_amdgcn_exp2f(m_run - m_new);
        m_run = m_new;
        float ls = 0.f;
#pragma unroll
        for (int r = 0; r < 16; ++r) { p0[r] = __builtin_amdgcn_exp2f(p0[r] - m_new); p1[r] = __builtin_amdgcn_exp2f(p1[r] - m_new); ls += p0[r] + p1[r]; }
        l_run = l_run * alpha + ls;
#pragma unroll
        for (int r = 0; r < 16; ++r) { o0[r] *= alpha; o1[r] *= alpha; }
        u32x4 pw[4];
        pw[0] = (u32x4){pk2(p0[0], p0[1]), pk2(p0[2], p0[3]), pk2(p0[4], p0[5]), pk2(p0[6], p0[7])};
        pw[1] = (u32x4){pk2(p0[8], p0[9]), pk2(p0[10], p0[11]), pk2(p0[12], p0[13]), pk2(p0[14], p0[15])};
        pw[2] = (u32x4){pk2(p1[0], p1[1]), pk2(p1[2], p1[3]), pk2(p1[4], p1[5]), pk2(p1[6], p1[7])};
        pw[3] = (u32x4){pk2(p1[8], p1[9]), pk2(p1[10], p1[11]), pk2(p1[12], p1[13]), pk2(p1[14], p1[15])};
#pragma unroll
        for (int s = 0; s < 4; ++s) {
            const bf16x8 pb = __builtin_bit_cast(bf16x8, pw[s]);
#pragma unroll
            for (int dt = 0; dt < 2; ++dt) {
                const char* vp = b_ + vt_off + s * 16 * VRS + dt * 64;
                const s16x4 lo = __builtin_bit_cast(s16x4, __builtin_amdgcn_ds_read_tr16_b64_v4i16((LAS s16x4*)vp));
                const s16x4 hh = __builtin_bit_cast(s16x4, __builtin_amdgcn_ds_read_tr16_b64_v4i16((LAS s16x4*)(vp + 8 * VRS)));
                const bf16x8 vf = (bf16x8){lo[0], lo[1], lo[2], lo[3], hh[0], hh[1], hh[2], hh[3]};
                if (dt == 0) o0 = __builtin_amdgcn_mfma_f32_32x32x16_bf16(vf, pb, o0, 0, 0, 0);
                else o1 = __builtin_amdgcn_mfma_f32_32x32x16_bf16(vf, pb, o1, 0, 0, 0);
            }
        }
        if (more) A_STORE((t + 1) & 1);
        __syncthreads();
    }
#undef A_LOAD
#undef A_STORE
    const float lt = l_run + __shfl_xor(l_run, 32); const float inv = 1.0f / lt;
    const size_t tok = (size_t)(b * SEQ + q0 + wid * 32 + l31);
#pragma unroll
    for (int dt = 0; dt < 2; ++dt)
#pragma unroll
        for (int g = 0; g < 4; ++g) { const int d = 32 * dt + 8 * g + 4 * hi; const size_t off = tok * 1024 + ocol + d;
            const u32x2 gw = *(const u32x2*)(Gt + off);
            const f32x16& oo = dt ? o1 : o0;
            u32x2 w; w.x = pk2(oo[4 * g] * inv * lo_bf(gw.x), oo[4 * g + 1] * inv * hi_bf(gw.x)); w.y = pk2(oo[4 * g + 2] * inv * lo_bf(gw.y), oo[4 * g + 3] * inv * hi_bf(gw.y));
            *(u32x2*)(OG + off) = w; }
}

DEV float max3f_s(float a, float b, float c) { float r; asm("v_max3_f32 %0, %1, %2, %3" : "=v"(r) : "v"(a), "v"(b), "v"(c)); return r; }
DEV float max2f_s(float a, float b) { float r; asm("v_max_f32_e32 %0, %1, %2" : "=v"(r) : "v"(a), "v"(b)); return r; }
DEV float fadd_s(float a, float b) { float r; asm("v_add_f32_e32 %0, %1, %2" : "=v"(r) : "v"(a), "v"(b)); return r; }
DEV float sum8_after_trans(float a, float b, float c, float d, float e, float f, float g, float h) {
    float r, t;
    asm("s_nop 0\n\tv_add_f32_e32 %0, %2, %3\n\tv_add_f32_e32 %1, %4, %5\n\tv_add_f32_e32 %0, %0, %6\n\tv_add_f32_e32 %1, %1, %7\n\tv_add_f32_e32 %0, %0, %8\n\tv_add_f32_e32 %1, %1, %9\n\tv_add_f32_e32 %0, %0, %1"
        : "=&v"(r), "=&v"(t) : "v"(a), "v"(b), "v"(c), "v"(d), "v"(e), "v"(f), "v"(g), "v"(h));
    return r;
}
DEV float swapmax32(float v) { auto rr = __builtin_amdgcn_permlane32_swap(__float_as_uint(v), __float_as_uint(v), false, false); return fmaxf(__uint_as_float(rr[0]), __uint_as_float(rr[1])); }
DEV float swapsum32(float v) { auto rr = __builtin_amdgcn_permlane32_swap(__float_as_uint(v), __float_as_uint(v), false, false); return __uint_as_float(rr[0]) + __uint_as_float(rr[1]); }
template <int DQK>
DEV void attn_unit2(char* lds, const bf16_t* __restrict__ Q, int ldq, int qcol, const bf16_t* __restrict__ Kp, int ldk, int kcol, const bf16_t* __restrict__ Vp, int ldv, int vcol,
                    const bf16_t* __restrict__ Gt, bf16_t* OG, int ocol, int b, int q0) {
    constexpr int KRS = (DQK + 8) * 2, KB = 64 * KRS, VRS = 192, VB = 64 * VRS, NKS = DQK / 16, KCH = DQK / 8, VOFF = 2 * KB;
    constexpr float THR = 8.0f;
    constexpr int NT = LK / 64;
    const int tid = TID(), lane = tid & 63, wid = tid >> 6, l31 = lane & 31, hi = lane >> 5;
    bf16x8 qf[NKS];
    { const bf16_t* qp = Q + (size_t)(b * SEQ + q0 + wid * 32 + l31) * ldq + qcol + hi * 8;
#pragma unroll
        for (int ks = 0; ks < NKS; ++ks) qf[ks] = *(const bf16x8*)(qp + ks * 16); }
    const bf16_t* kbase = Kp + (size_t)b * LK * ldk + kcol; const bf16_t* vbase = Vp + (size_t)b * LK * ldv + vcol;
    constexpr bool K2 = (KCH * 64 > 512);
    const bool k2 = K2 && (tid + 512 < KCH * 64);
    const int kr0 = tid / KCH, kc0 = tid % KCH, kr1 = k2 ? (tid + 512) / KCH : kr0, kc1 = k2 ? (tid + 512) % KCH : kc0;
    const int vr = tid >> 3, vc = tid & 7;
    u32x4 skX0, skX1 = {0u, 0u, 0u, 0u}, svX;
#define A_LOADK(t, S) do { const int tt_ = (t) < NT ? (t) : NT - 1; const size_t kp_ = (size_t)tt_ * 64; sk##S##0 = *(const u32x4*)(kbase + (kp_ + kr0) * ldk + kc0 * 8); if (K2) sk##S##1 = *(const u32x4*)(kbase + (kp_ + kr1) * ldk + kc1 * 8); } while (0)
#define A_LOADV(t, S) do { const int tt_ = (t) < NT ? (t) : NT - 1; sv##S = *(const u32x4*)(vbase + ((size_t)tt_ * 64 + vr) * ldv + vc * 8); } while (0)
#define A_STOREK(slot, S) do { char* b_ = lds + (slot) * KB; *(u32x4*)(b_ + kr0 * KRS + kc0 * 16) = sk##S##0; if (K2) *(u32x4*)(b_ + kr1 * KRS + kc1 * 16) = sk##S##1; } while (0)
#define A_STOREV(slot, S) do { *(u32x4*)(lds + VOFF + (slot) * VB + vr * VRS + vc * 16) = sv##S; } while (0)
    f32x16 o0, o1, negm;
#pragma unroll
    for (int r = 0; r < 16; ++r) { o0[r] = 0.f; o1[r] = 0.f; negm[r] = 0.f; }
    asm volatile("" : "+v"(negm));
    float mhat = 0.f, l_run = 0.f;
    const int g1 = (lane >> 4) & 1, tq = (lane & 15) >> 2, tp = lane & 3;
    const int vt_off = VOFF + (4 * hi + tq) * VRS + (16 * g1 + 4 * tp) * 2;
    const int kf_off = l31 * KRS + hi * 16;
#define A_QK(P0, P1, slot) do { const char* kb_ = lds + (slot) * KB + kf_off; \
        _Pragma("unroll") for (int ks = 0; ks < NKS; ++ks) { \
            const bf16x8 ka = *(const bf16x8*)(kb_ + ks * 32); const bf16x8 kb2 = *(const bf16x8*)(kb_ + 32 * KRS + ks * 32); \
            if (ks == 0) { P0 = __builtin_amdgcn_mfma_f32_32x32x16_bf16(ka, qf[0], negm, 0, 0, 0); P1 = __builtin_amdgcn_mfma_f32_32x32x16_bf16(kb2, qf[0], negm, 0, 0, 0); } \
            else { P0 = __builtin_amdgcn_mfma_f32_32x32x16_bf16(ka, qf[ks], P0, 0, 0, 0); P1 = __builtin_amdgcn_mfma_f32_32x32x16_bf16(kb2, qf[ks], P1, 0, 0, 0); } } } while (0)
    A_LOADK(0, X); A_LOADV(0, X); A_STOREK(0, X); A_STOREV(0, X); A_LOADK(1, X); A_STOREK(1, X);
    __syncthreads();
    f32x16 pA0, pA1, pB0, pB1;
#pragma unroll
    for (int r = 0; r < 16; ++r) { pB0[r] = 0.f; pB1[r] = 0.f; }
    A_QK(pA0, pA1, 0);
#define A_STEP(P0, P1, N0, N1, t, SL, SS) do { \
        A_LOADK((t) + 2, SL); A_LOADV((t) + 1, SL); \
        __builtin_amdgcn_s_setprio(1); A_QK(N0, N1, ((t) + 1) & 1); __builtin_amdgcn_s_setprio(0); \
        float a_ = fmaxf(fmaxf(P0[0], P0[1]), P1[0]), c_ = fmaxf(fmaxf(P0[2], P0[3]), P1[1]); a_ = fmaxf(fmaxf(a_, P1[2]), P1[3]); \
        _Pragma("unroll") for (int r = 4; r < 16; r += 4) { a_ = fmaxf(fmaxf(a_, P0[r]), P0[r + 1]); c_ = fmaxf(fmaxf(c_, P0[r + 2]), P0[r + 3]); a_ = fmaxf(fmaxf(a_, P1[r]), P1[r + 1]); c_ = fmaxf(fmaxf(c_, P1[r + 2]), P1[r + 3]); } \
        const float rm = swapmax32(fmaxf(a_, c_)); \
        if ((t) == 0 || __any(rm > THR)) { \
            const float dl = ((t) == 0) ? rm : fmaxf(rm, 0.f); mhat += dl; \
            _Pragma("unroll") for (int r = 0; r < 16; ++r) { P0[r] -= dl; P1[r] -= dl; N0[r] -= dl; N1[r] -= dl; } \
            if ((t) != 0) { const float f = __builtin_amdgcn_exp2f(-dl); l_run *= f; _Pragma("unroll") for (int r = 0; r < 16; ++r) { o0[r] *= f; o1[r] *= f; } } \
            _Pragma("unroll") for (int r = 0; r < 16; ++r) negm[r] = -mhat; asm volatile("" : "+v"(negm)); } \
        _Pragma("unroll") for (int r = 0; r < 16; ++r) { P0[r] = __builtin_amdgcn_exp2f(P0[r]); P1[r] = __builtin_amdgcn_exp2f(P1[r]); } \
        { const float q0_ = sum8_after_trans(P0[0], P0[1], P0[2], P0[3], P0[4], P0[5], P0[6], P0[7]), q1_ = sum8_after_trans(P0[8], P0[9], P0[10], P0[11], P0[12], P0[13], P0[14], P0[15]); \
          const float q2_ = sum8_after_trans(P1[0], P1[1], P1[2], P1[3], P1[4], P1[5], P1[6], P1[7]), q3_ = sum8_after_trans(P1[8], P1[9], P1[10], P1[11], P1[12], P1[13], P1[14], P1[15]); \
          l_run += (q0_ + q1_) + (q2_ + q3_); } \
        u32x4 pw[4]; \
        pw[0] = (u32x4){pk2(P0[0], P0[1]), pk2(P0[2], P0[3]), pk2(P0[4], P0[5]), pk2(P0[6], P0[7])}; \
        pw[1] = (u32x4){pk2(P0[8], P0[9]), pk2(P0[10], P0[11]), pk2(P0[12], P0[13]), pk2(P0[14], P0[15])}; \
        pw[2] = (u32x4){pk2(P1[0], P1[1]), pk2(P1[2], P1[3]), pk2(P1[4], P1[5]), pk2(P1[6], P1[7])}; \
        pw[3] = (u32x4){pk2(P1[8], P1[9]), pk2(P1[10], P1[11]), pk2(P1[12], P1[13]), pk2(P1[14], P1[15])}; \
        { const char* vb_ = lds + ((t) & 1) * VB + vt_off; \
        _Pragma("unroll") for (int s = 0; s < 4; ++s) { const bf16x8 pb = __builtin_bit_cast(bf16x8, pw[s]); \
            _Pragma("unroll") for (int dt = 0; dt < 2; ++dt) { const char* vp = vb_ + s * 16 * VRS + dt * 64; \
                const s16x4 lo = __builtin_bit_cast(s16x4, __builtin_amdgcn_ds_read_tr16_b64_v4i16((LAS s16x4*)vp)); \
                const s16x4 hh = __builtin_bit_cast(s16x4, __builtin_amdgcn_ds_read_tr16_b64_v4i16((LAS s16x4*)(vp + 8 * VRS))); \
                const bf16x8 vf = (bf16x8){lo[0], lo[1], lo[2], lo[3], hh[0], hh[1], hh[2], hh[3]}; \
                if (dt == 0) o0 = __builtin_amdgcn_mfma_f32_32x32x16_bf16(vf, pb, o0, 0, 0, 0); else o1 = __builtin_amdgcn_mfma_f32_32x32x16_bf16(vf, pb, o1, 0, 0, 0); } } } \
        A_STOREK((t) & 1, SS); A_STOREV(((t) + 1) & 1, SS); \
        __syncthreads(); } while (0)
    for (int t = 0; t < NT; t += 2) {
        A_STEP(pA0, pA1, pB0, pB1, t, X, X);
        A_STEP(pB0, pB1, pA0, pA1, t + 1, X, X);
    }
#undef A_STEP
#undef A_QK
#undef A_LOADK
#undef A_LOADV
#undef A_STOREK
#undef A_STOREV
    const float inv = 1.0f / swapsum32(l_run);
    const size_t tok = (size_t)(b * SEQ + q0 + wid * 32 + l31);
#pragma unroll
    for (int dt = 0; dt < 2; ++dt)
#pragma unroll
        for (int g = 0; g < 4; ++g) { const int d = 32 * dt + 8 * g + 4 * hi; const size_t off = tok * 1024 + ocol + d;
            const u32x2 gw = *(const u32x2*)(Gt + off);
            const f32x16& oo = dt ? o1 : o0;
            u32x2 w; w.x = pk2(oo[4 * g] * inv * lo_bf(gw.x), oo[4 * g + 1] * inv * hi_bf(gw.x)); w.y = pk2(oo[4 * g + 2] * inv * lo_bf(gw.y), oo[4 * g + 3] * inv * hi_bf(gw.y));
            *(u32x2*)(OG + off) = w; }
}

namespace at3 {
typedef LAS const char* lds_cptr;
constexpr int SLOTV = 8192;
DEV void glds16(const void* gsrc, unsigned lds_dst) { unsigned keep;
    asm volatile("s_mov_b32 %0, m0\n\ts_mov_b32 m0, %2\n\ts_nop 0\n\tglobal_load_lds_dwordx4 %1, off\n\ts_mov_b32 m0, %0" : "=&s"(keep) : "v"(gsrc), "s"(lds_dst) : "memory"); }
DEV float fsub_s(float a, float b) { float r; asm("v_sub_f32_e32 %0, %1, %2" : "=v"(r) : "v"(a), "v"(b)); return r; }
DEV s16x4 vtr(lds_cptr p) { return __builtin_bit_cast(s16x4, __builtin_amdgcn_ds_read_tr16_b64_v4i16((LAS s16x4*)p)); }
DEV void kload2(bf16x8* kf, lds_cptr kp, int j) { kf[2 * j] = *(const LAS bf16x8*)(kp + j * 2048); kf[2 * j + 1] = *(const LAS bf16x8*)(kp + j * 2048 + 512); }
DEV float rowmax(const f32x16& p0, const f32x16& p1) {
    float a = max3f_s(p0[0], p0[1], p1[0]), b = max3f_s(p0[2], p0[3], p1[1]); a = max3f_s(a, p1[2], p1[3]);
#pragma unroll
    for (int r = 4; r < 16; r += 4) { a = max3f_s(a, p0[r], p0[r + 1]); b = max3f_s(b, p0[r + 2], p0[r + 3]); a = max3f_s(a, p1[r], p1[r + 1]); b = max3f_s(b, p1[r + 2], p1[r + 3]); }
    const float m = max2f_s(a, b);
    auto rr = __builtin_amdgcn_permlane32_swap(__float_as_uint(m), __float_as_uint(m), false, false);
    return max2f_s(__uint_as_float(rr[0]), __uint_as_float(rr[1]));
}
DEV void pv(f32x16* o, int vb, bf16x8 pa0, bf16x8 pa1, bf16x8 pa2, bf16x8 pa3) {
#pragma unroll
    for (int d0 = 0; d0 < 2; ++d0) { s16x4 lo[4], hi[4];
#pragma unroll
        for (int ks = 0; ks < 4; ++ks) {
            asm volatile("ds_read_b64_tr_b16 %0,%1 offset:%c2" : "=&v"(lo[ks]) : "v"(vb), "i"(d0 * 4096 + ks * 1024) : "memory");
            asm volatile("ds_read_b64_tr_b16 %0,%1 offset:%c2" : "=&v"(hi[ks]) : "v"(vb), "i"(d0 * 4096 + ks * 1024 + 512) : "memory"); }
        asm volatile("s_waitcnt lgkmcnt(0)" ::: "memory"); __builtin_amdgcn_sched_barrier(0);
#define AT_PK(k) (bf16x8){lo[k][0], lo[k][1], lo[k][2], lo[k][3], hi[k][0], hi[k][1], hi[k][2], hi[k][3]}
        o[d0] = __builtin_amdgcn_mfma_f32_32x32x16_bf16(pa0, AT_PK(0), o[d0], 0, 0, 0);
        o[d0] = __builtin_amdgcn_mfma_f32_32x32x16_bf16(pa1, AT_PK(1), o[d0], 0, 0, 0);
        o[d0] = __builtin_amdgcn_mfma_f32_32x32x16_bf16(pa2, AT_PK(2), o[d0], 0, 0, 0);
        o[d0] = __builtin_amdgcn_mfma_f32_32x32x16_bf16(pa3, AT_PK(3), o[d0], 0, 0, 0);
#undef AT_PK
    }
}
#define AT_SBAR() __builtin_amdgcn_sched_barrier(0)
#define AT_WAIT_BAR(N) asm volatile("s_waitcnt vmcnt(%c0) lgkmcnt(0)\n\ts_barrier" :: "i"(N) : "memory")
#define AT_MFMA(a, b, c) __builtin_amdgcn_mfma_f32_32x32x16_bf16(a, b, c, 0, 0, 0)

template <int DQK>
DEV void attn_unit3(char* shm, const bf16_t* __restrict__ Q, int ldq, int qcol, const bf16_t* __restrict__ Kp, int ldk, int kcol, const bf16_t* __restrict__ Vp, int ldv, int vcol,
                    const bf16_t* __restrict__ Gt, bf16_t* OG, int ocol, int b, int q0) {
    constexpr int NKS = DQK / 16, KD = (DQK > 64) ? 2 : 1, SLOTK = DQK * 128;
    constexpr int L_K = 0, L_V = 3 * SLOTK, L_WS = L_V + 3 * SLOTV, L_OST = L_WS + 8 * 256;
    constexpr int NT = LK / 64;
    constexpr float THRL = 8.0f;
    const int tid = TID(), lane = tid & 63, r32 = lane & 31, hi = lane >> 5; const int wid = __builtin_amdgcn_readfirstlane(tid >> 6);
    const bf16_t* Qw = Q + (size_t)(b * SEQ + q0 + wid * 32) * ldq + qcol;
    const bf16_t* Kh = Kp + (size_t)b * LK * ldk + kcol; const bf16_t* Vh = Vp + (size_t)b * LK * ldv + vcol;
    const unsigned lds0 = (unsigned)(uintptr_t)shm;
    float* wsf = (float*)(shm + L_WS) + wid * 64;
    const bf16_t* ksrc = Kh + (size_t)lane * ldk + wid * 8;
    const int k2el = (8 + (wid & 3) - wid) * 8;
    const bf16_t* vsrc = Vh + (size_t)(16 * (wid & 3) + (lane >> 2)) * ldv + (wid >> 2) * 32 + (lane & 3) * 8;
    const unsigned kdst = lds0 + L_K + wid * 1024, kdst2 = lds0 + L_K + (8 + (wid & 3)) * 1024, vdst = lds0 + L_V + wid * 1024;
#define KOFF(sl) ((DQK == 64) ? (sl) : ((sl) + ((sl) >> 1)))
#define DMA_K(t, sl) do { const bf16_t* s_ = ksrc + (size_t)(t) * 64 * ldk; glds16(s_, (unsigned)__builtin_amdgcn_readfirstlane(kdst + KOFF(sl))); \
        if (KD == 2) glds16(s_ + k2el, (unsigned)__builtin_amdgcn_readfirstlane(kdst2 + KOFF(sl))); } while (0)
#define DMA_V(t, sl) glds16(vsrc + (size_t)(t) * 64 * ldv, (unsigned)__builtin_amdgcn_readfirstlane(vdst + (sl)))
    const int vb0 = (int)(lds0 + L_V) + ((lane >> 4) & 1) * 32 + (lane & 3) * 8 + (4 * hi + ((lane & 15) >> 2)) * 64;
    bf16x8 kf[2 * NKS];
    const lds_cptr shm3 = (lds_cptr)shm; const lds_cptr kp0 = shm3 + L_K + hi * 1024 + r32 * 16;
    const lds_cptr vp0 = shm3 + L_V + ((lane >> 4) & 1) * 32 + (lane & 3) * 8 + (4 * hi + ((lane & 15) >> 2)) * 64;
    DMA_K(0, 0); DMA_V(0, 0); DMA_K(1, SLOTV);
    bf16x8 qr[NKS];
#pragma unroll
    for (int d0 = 0; d0 < NKS; ++d0) qr[d0] = *(const bf16x8*)(Qw + (size_t)r32 * ldq + d0 * 16 + hi * 8);
    float mhat = 0.f, l_reg = 0.f; f32x16 o[2]; o[0] = f32x16{}; o[1] = f32x16{}; f32x16 negm = f32x16{}; asm volatile("" : "+v"(negm));
    bool resc = false;
#define RESC() do { if (resc) { asm volatile("s_waitcnt lgkmcnt(0)" ::: "memory"); \
        _Pragma("unroll") for (int d_ = 0; d_ < 2; ++d_) _Pragma("unroll") for (int r = 0; r < 16; ++r) o[d_][r] *= wsf[crow(r, hi)]; } } while (0)
    f32x16 pA0, pA1, pB0, pB1;
    int sl_prev = 0, sl_cur = 0, sl_next = SLOTV;
#define ROT() do { sl_prev = sl_cur; sl_cur = sl_next; sl_next = (sl_next == 2 * SLOTV) ? 0 : sl_next + SLOTV; } while (0)
    DMA_K(2, 2 * SLOTV);
    AT_WAIT_BAR(1 + 2 * KD);
    {
#pragma unroll
        for (int d0 = 0; d0 < NKS; ++d0) {
            const bf16x8 b0 = *(const LAS bf16x8*)(kp0 + d0 * 2048); const bf16x8 b1 = *(const LAS bf16x8*)(kp0 + d0 * 2048 + 512);
            if (d0 == 0) { pA0 = AT_MFMA(b0, qr[0], negm); pA1 = AT_MFMA(b1, qr[0], negm); } else { pA0 = AT_MFMA(b0, qr[d0], pA0); pA1 = AT_MFMA(b1, qr[d0], pA1); } }
        asm volatile("s_nop 15\n\ts_nop 7" : "+v"(pA0), "+v"(pA1));
        const float rm = rowmax(pA0, pA1);
        mhat = fadd_s(mhat, rm);
#pragma unroll
        for (int r = 0; r < 16; ++r) { pA0[r] = fsub_s(pA0[r], rm); pA1[r] = fsub_s(pA1[r], rm); }
#pragma unroll
        for (int r = 0; r < 16; ++r) negm[r] = -mhat;
        asm volatile("" : "+v"(negm));
#pragma unroll
        for (int r = 0; r < 16; ++r) pA0[r] = __builtin_amdgcn_exp2f(pA0[r]);
#pragma unroll
        for (int r = 0; r < 16; ++r) pA1[r] = __builtin_amdgcn_exp2f(pA1[r]);
    }
    AT_WAIT_BAR(0);
    DMA_K(3, 0); DMA_V(1, SLOTV);
    ROT();
#pragma unroll
    for (int j = 0; j < NKS; ++j) kload2(kf, kp0 + KOFF(sl_cur), j);
    AT_WAIT_BAR(KD + 1);
    s16x4 vlo[8], vhi[8]; u32x4 pw0, pw1, pw2, pw3;
#define PKW(P, B) pk2(P[B], P[B + 1])
#define PAF(k) __builtin_bit_cast(bf16x8, pw##k)
#define VFR(i) (bf16x8){vlo[i][0], vlo[i][1], vlo[i][2], vlo[i][3], vhi[i][0], vhi[i][1], vhi[i][2], vhi[i][3]}
#define PIN(x) asm volatile("" : "+v"(x))
#define MX3(a, b, c) __builtin_fmaxf(__builtin_fmaxf((a), (b)), (c))
#define GAPA(MF, A0, A1, A2, A3, W0, W1, PW) do { MF; sacc += A0; sacc += A1; sacc += A2; sacc += A3; PIN(sacc); W0; W1; PIN(PW); AT_SBAR(); } while (0)
#define EX(v) __builtin_amdgcn_exp2f(v)
#define GAPB(MF, X, B) do { MF; X[B] = EX(X[B]); X[B + 1] = EX(X[B + 1]); X[B + 2] = EX(X[B + 2]); X[B + 3] = EX(X[B + 3]); PIN(X); AT_SBAR(); } while (0)
#define VRD(i) do { vlo[i] = vtr(vp_ + (((i) >> 2) * 4096 + ((i) & 3) * 1024)); vhi[i] = vtr(vp_ + (((i) >> 2) * 4096 + ((i) & 3) * 1024 + 512)); } while (0)
#define KRD(G, j) do { if (G) { kload2(kf, kp0 + KOFF(sl_next), j); AT_SBAR(); } } while (0)
#define STEP(C0, C1, P0, P1, t, GK, GV, GL) do { AT_SBAR(); \
    const lds_cptr vp_ = vp0 + sl_prev; \
    VRD(0); AT_SBAR(); float sacc = (P0[0] + P0[1]); \
    GAPA(C0 = AT_MFMA(kf[0], qr[0], negm), P0[2], P0[3], P0[4], P0[5], pw0[0] = PKW(P0, 0), pw0[1] = PKW(P0, 2), pw0); \
    VRD(4); AT_SBAR(); GAPA(C1 = AT_MFMA(kf[1], qr[0], negm), P0[6], P0[7], P0[8], P0[9], pw0[2] = PKW(P0, 4), pw0[3] = PKW(P0, 6), pw0); \
    VRD(1); AT_SBAR(); GAPA(C0 = AT_MFMA(kf[2], qr[1], C0), P0[10], P0[11], P0[12], P0[13], pw1[0] = PKW(P0, 8), pw1[1] = PKW(P0, 10), pw1); \
    VRD(5); AT_SBAR(); GAPA(C1 = AT_MFMA(kf[3], qr[1], C1), P0[14], P0[15], P1[0], P1[1], pw1[2] = PKW(P0, 12), pw1[3] = PKW(P0, 14), pw1); \
    VRD(2); AT_SBAR(); GAPA(C0 = AT_MFMA(kf[4], qr[2], C0), P1[2], P1[3], P1[4], P1[5], pw2[0] = PKW(P1, 0), pw2[1] = PKW(P1, 2), pw2); \
    VRD(6); AT_SBAR(); GAPA(C1 = AT_MFMA(kf[5], qr[2], C1), P1[6], P1[7], P1[8], P1[9], pw2[2] = PKW(P1, 4), pw2[3] = PKW(P1, 6), pw2); \
    VRD(3); AT_SBAR(); GAPA(C0 = AT_MFMA(kf[6], qr[3], C0), P1[10], P1[11], P1[12], P1[13], pw3[0] = PKW(P1, 8), pw3[1] = PKW(P1, 10), pw3); \
    VRD(7); AT_SBAR(); GAPA(C1 = AT_MFMA(kf[7], qr[3], C1), P1[14], P1[15], 0.f, 0.f, pw3[2] = PKW(P1, 12), pw3[3] = PKW(P1, 14), pw3); \
    if (NKS == 6) { C0 = AT_MFMA(kf[8 % (2 * NKS)], qr[4 % NKS], C0); AT_SBAR(); C1 = AT_MFMA(kf[9 % (2 * NKS)], qr[4 % NKS], C1); AT_SBAR(); \
                    C0 = AT_MFMA(kf[10 % (2 * NKS)], qr[5 % NKS], C0); AT_SBAR(); C1 = AT_MFMA(kf[11 % (2 * NKS)], qr[5 % NKS], C1); AT_SBAR(); } \
    l_reg += sacc; \
    if (GK) { DMA_K((t) + 3, sl_cur); } if (GV) { DMA_V((t) + 1, sl_next); } \
    { float a = MX3(C0[0], C0[1], C1[0]), b_ = MX3(C0[2], C0[3], C1[1]); a = MX3(a, C1[2], C1[3]); \
      _Pragma("unroll") for (int r = 4; r < 16; r += 4) { a = MX3(a, C0[r], C0[r + 1]); b_ = MX3(b_, C0[r + 2], C0[r + 3]); a = MX3(a, C1[r], C1[r + 1]); b_ = MX3(b_, C1[r + 2], C1[r + 3]); } \
      float rm = __builtin_fmaxf(a, b_); { auto rr = __builtin_amdgcn_permlane32_swap(__float_as_uint(rm), __float_as_uint(rm), false, false); rm = __builtin_fmaxf(__uint_as_float(rr[0]), __uint_as_float(rr[1])); } \
      resc = false; \
      if (__builtin_expect(__any(rm > THRL), 0)) { const float dl = __builtin_fmaxf(rm, 0.f); mhat += dl; \
        _Pragma("unroll") for (int r = 0; r < 16; ++r) { C0[r] -= dl; C1[r] -= dl; } \
        _Pragma("unroll") for (int r = 0; r < 16; ++r) negm[r] = -mhat; asm volatile("" : "+v"(negm)); \
        const float f = __builtin_amdgcn_exp2f(-dl); l_reg *= f; if (hi == 0) wsf[r32] = f; resc = true; } } \
    AT_SBAR(); \
    GAPB(o[0] = AT_MFMA(PAF(0), VFR(0), o[0]), C0, 0); \
    GAPB(o[1] = AT_MFMA(PAF(0), VFR(4), o[1]), C0, 4); \
    KRD(GL, 0); GAPB(o[0] = AT_MFMA(PAF(1), VFR(1), o[0]), C0, 8); \
    KRD(GL, 1); GAPB(o[1] = AT_MFMA(PAF(1), VFR(5), o[1]), C0, 12); \
    KRD(GL, 2); GAPB(o[0] = AT_MFMA(PAF(2), VFR(2), o[0]), C1, 0); \
    KRD(GL, 3); GAPB(o[1] = AT_MFMA(PAF(2), VFR(6), o[1]), C1, 4); \
    if (NKS == 6) KRD(GL, 4 % NKS); GAPB(o[0] = AT_MFMA(PAF(3), VFR(3), o[0]), C1, 8); \
    if (NKS == 6) KRD(GL, 5 % NKS); GAPB(o[1] = AT_MFMA(PAF(3), VFR(7), o[1]), C1, 12); \
    } while (0)
    int t = 1;
    for (; t + 5 < NT; t += 2) {
        STEP(pB0, pB1, pA0, pA1, t, true, true, true);     AT_WAIT_BAR(KD + 1); RESC(); ROT();
        STEP(pA0, pA1, pB0, pB1, t + 1, true, true, true); AT_WAIT_BAR(KD + 1); RESC(); ROT();
    }
#define ENDW(tt) do { if ((tt) + 3 < NT) { AT_WAIT_BAR(KD + 1); } else if ((tt) + 2 < NT) { AT_WAIT_BAR(1); } else { AT_WAIT_BAR(0); } } while (0)
    for (; t + 1 < NT; t += 2) {
        STEP(pB0, pB1, pA0, pA1, t, (t + 3 < NT), (t + 1 < NT), (t + 1 < NT));         ENDW(t);     RESC(); ROT();
        STEP(pA0, pA1, pB0, pB1, t + 1, (t + 4 < NT), (t + 2 < NT), (t + 2 < NT));     ENDW(t + 1); RESC(); ROT();
    }
    STEP(pB0, pB1, pA0, pA1, NT - 1, false, false, false); RESC();
    { float sacc = pB0[0] + pB0[1];
#pragma unroll
      for (int r = 2; r < 16; ++r) sacc += pB0[r];
#pragma unroll
      for (int r = 0; r < 16; ++r) sacc += pB1[r];
      l_reg += sacc;
      pw0 = (u32x4){PKW(pB0, 0), PKW(pB0, 2), PKW(pB0, 4), PKW(pB0, 6)}; pw1 = (u32x4){PKW(pB0, 8), PKW(pB0, 10), PKW(pB0, 12), PKW(pB0, 14)};
      pw2 = (u32x4){PKW(pB1, 0), PKW(pB1, 2), PKW(pB1, 4), PKW(pB1, 6)}; pw3 = (u32x4){PKW(pB1, 8), PKW(pB1, 10), PKW(pB1, 12), PKW(pB1, 14)};
      AT_SBAR(); pv(o, vb0 + sl_cur, PAF(0), PAF(1), PAF(2), PAF(3)); }
#undef PKW
#undef PAF
#undef VFR
#undef PIN
#undef MX3
#undef GAPA
#undef GAPB
#undef EX
#undef VRD
#undef KRD
#undef STEP
#undef ENDW
    { auto rr = __builtin_amdgcn_permlane32_swap(__float_as_uint(l_reg), __float_as_uint(l_reg), false, false); l_reg = __uint_as_float(rr[0]) + __uint_as_float(rr[1]); }
    if (hi == 0) wsf[32 + r32] = l_reg; asm volatile("s_waitcnt lgkmcnt(0)" ::: "memory");
    float rli[16];
#pragma unroll
    for (int r = 0; r < 16; ++r) rli[r] = __builtin_amdgcn_rcpf(wsf[32 + crow(r, hi)]);
    { bf16_t* stg = (bf16_t*)(shm + L_OST) + wid * 2048;
#pragma unroll
      for (int r = 0; r < 16; ++r) { const int orow = crow(r, hi);
#pragma unroll
          for (int d0 = 0; d0 < 2; ++d0) stg[orow * 64 + d0 * 32 + r32] = f2bf(o[d0][r] * rli[r]); }
      asm volatile("s_waitcnt lgkmcnt(0)" ::: "memory");
      const size_t tok0 = (size_t)(b * SEQ + q0 + wid * 32);
#pragma unroll
      for (int i = 0; i < 4; ++i) { const int row = i * 8 + (lane >> 3), ch = lane & 7; const u32x4 v = *(const u32x4*)(stg + row * 64 + ch * 8);
          const size_t off = (tok0 + row) * 1024 + ocol + ch * 8; const u32x4 g = *(const u32x4*)(Gt + off);
          u32x4 w; w.x = pk2(lo_bf(v.x) * lo_bf(g.x), hi_bf(v.x) * hi_bf(g.x)); w.y = pk2(lo_bf(v.y) * lo_bf(g.y), hi_bf(v.y) * hi_bf(g.y));
          w.z = pk2(lo_bf(v.z) * lo_bf(g.z), hi_bf(v.z) * hi_bf(g.z)); w.w = pk2(lo_bf(v.w) * lo_bf(g.w), hi_bf(v.w) * hi_bf(g.w));
          *(u32x4*)(OG + off) = w; } }
    asm volatile("s_waitcnt vmcnt(0) lgkmcnt(0)\n\ts_barrier" ::: "memory");
#undef DMA_K
#undef DMA_V
#undef KOFF
#undef RESC
#undef ROT
}
#undef AT_SBAR
#undef AT_WAIT_BAR
#undef AT_MFMA
}

DEV void phase_attn(char* lds, const Params& p) {
    const bf16_t* QA = (const bf16_t*)(p.ws + WS_QA); const bf16_t* KA = (const bf16_t*)(p.ws + WS_KA); const bf16_t* VA = (const bf16_t*)(p.ws + WS_VA);
    const bf16_t* QM = (const bf16_t*)(p.ws + WS_QM); const bf16_t* KM = (const bf16_t*)(p.ws + WS2_KM); const bf16_t* VM = (const bf16_t*)(p.ws + WS2_VM);
    const bf16_t* G = (const bf16_t*)(p.ws + WS_G); bf16_t* OG = (bf16_t*)(p.ws + WS2_OG);
    const int vblk = (gridDim.x % 8 == 0) ? (int)((blockIdx.x % 8) * (gridDim.x / 8) + blockIdx.x / 8) : (int)blockIdx.x;
    for (int u = vblk; u < 2048; u += gridDim.x) {
        const int type = u >> 10, rem = u & 1023, b = rem >> 7, h = (rem >> 4) & 7, qb = rem & 15;
        if (type == 0) at3::attn_unit3<64>(lds, QA, 512, h * 64, KA, 128, (h >> 2) * 64, VA, 128, (h >> 2) * 64, G, OG, h * 64, b, qb * 256);
        else at3::attn_unit3<96>(lds, QM, 768, h * 96, KM, 768, h * 96, VM, 512, h * 64, G, OG, 512 + h * 64, b, qb * 256);
    }
}

constexpr int CV_PADL = 192, CV_ROW = 4488, CV_RS = CV_ROW * 2;
constexpr int CV_UB = 8 * CV_RS;
constexpr int CV_FS = 16416;
DEV void conv_load_filter(char* lds, const bf16_t* gr) {
    const int tid = TID();
#pragma unroll
    for (int rnd = 0; rnd < 2; ++rnd) {
        const int ch = tid + rnd * 512;
        const u32x4 a = *(const u32x4*)(gr + ch * 8);
        u32x4 bq = {0u, 0u, 0u, 0u}; if (ch + 1 < 1024) bq = *(const u32x4*)(gr + ch * 8 + 8);
        const unsigned w[8] = {a.x, a.y, a.z, a.w, bq.x, bq.y, bq.z, bq.w};
        char* f = lds + CV_UB + ch * 16;
        *(u32x4*)(f) = a;
        u32x4 c1, c2, c3;
        c1.x = __builtin_amdgcn_alignbit(w[1], w[0], 16); c1.y = __builtin_amdgcn_alignbit(w[2], w[1], 16); c1.z = __builtin_amdgcn_alignbit(w[3], w[2], 16); c1.w = __builtin_amdgcn_alignbit(w[4], w[3], 16);
        c2 = (u32x4){w[1], w[2], w[3], w[4]};
        c3.x = __builtin_amdgcn_alignbit(w[2], w[1], 16); c3.y = __builtin_amdgcn_alignbit(w[3], w[2], 16); c3.z = __builtin_amdgcn_alignbit(w[4], w[3], 16); c3.w = __builtin_amdgcn_alignbit(w[5], w[4], 16);
        *(u32x4*)(f + CV_FS) = c1; *(u32x4*)(f + 2 * CV_FS) = c2; *(u32x4*)(f + 3 * CV_FS) = c3;
    }
}
DEV void sconv4(const bf16_t* px, int t, float w0, float w1, float w2, float bias, float* u) {
    const u32x2 mid = *(const u32x2*)(px + t);
    const float pm = (t > 0) ? bf2f(px[t - 1]) : 0.f, pp = (t + 4 < SEQ) ? bf2f(px[t + 4]) : 0.f;
    const float q0 = lo_bf(mid.x), q1 = hi_bf(mid.x), q2 = lo_bf(mid.y), q3 = hi_bf(mid.y);
    u[0] = w0 * pm + w1 * q0 + w2 * q1 + bias; u[1] = w0 * q0 + w1 * q1 + w2 * q2 + bias; u[2] = w0 * q1 + w1 * q2 + w2 * q3 + bias; u[3] = w0 * q2 + w1 * q3 + w2 * pp + bias;
}
template <bool V0, bool V1>
DEV void conv_step(const char* lds, f32x16 (&acc)[2][2], const int (&a_off)[2], const int (&b_off)[2], int d) {
    bf16x8 fa[2][4];
#pragma unroll
    for (int mt = 0; mt < 2; ++mt)
#pragma unroll
        for (int ks = 0; ks < 4; ++ks) { const char* ap = lds + a_off[mt] - 128 * d + ks * 32;
            const u32x2 lo = *(const u32x2*)ap, hh = *(const u32x2*)(ap + 8);
            fa[mt][ks] = __builtin_bit_cast(bf16x8, (u32x4){lo.x, lo.y, hh.x, hh.y}); }
#pragma unroll
    for (int n = 0; n < 2; ++n) {
        if ((n == 0 && V0) || (n == 1 && V1)) {
#pragma unroll
            for (int ks = 0; ks < 4; ++ks) { const bf16x8 fb = *(const bf16x8*)(lds + b_off[n] - 128 * d + ks * 32);
#pragma unroll
                for (int mt = 0; mt < 2; ++mt) acc[n][mt] = __builtin_amdgcn_mfma_f32_32x32x16_bf16(fa[mt][ks], fb, acc[n][mt], 0, 0, 0); }
        }
    }
}
struct ConvFrags { bf16x8 a[6], b0[4], b1[4]; };
DEV void conv_load_frags(ConvFrags& F, const char* lds, int a_off0, int a_off0h, int b_off0, int b_off1, int d) {
#pragma unroll
    for (int j = 0; j < 6; ++j) { const u32x2 lo = *(const u32x2*)(lds + a_off0 - 128 * d + (j - 2) * 32), hh = *(const u32x2*)(lds + a_off0h - 128 * d + (j - 2) * 32);
        F.a[j] = __builtin_bit_cast(bf16x8, (u32x4){lo.x, lo.y, hh.x, hh.y}); }
#pragma unroll
    for (int ks = 0; ks < 4; ++ks) { F.b0[ks] = *(const bf16x8*)(lds + b_off0 - 128 * d + ks * 32); F.b1[ks] = *(const bf16x8*)(lds + b_off1 - 128 * d + ks * 32); }
}
DEV void conv_mfma_frags(const ConvFrags& F, f32x16 (&acc)[2][2]) {
#pragma unroll
    for (int ks = 0; ks < 4; ++ks) {
        acc[0][0] = __builtin_amdgcn_mfma_f32_32x32x16_bf16(F.a[ks + 2], F.b0[ks], acc[0][0], 0, 0, 0);
        acc[0][1] = __builtin_amdgcn_mfma_f32_32x32x16_bf16(F.a[ks], F.b0[ks], acc[0][1], 0, 0, 0);
        acc[1][0] = __builtin_amdgcn_mfma_f32_32x32x16_bf16(F.a[ks + 2], F.b1[ks], acc[1][0], 0, 0, 0);
        acc[1][1] = __builtin_amdgcn_mfma_f32_32x32x16_bf16(F.a[ks], F.b1[ks], acc[1][1], 0, 0, 0);
    }
}
DEV void conv_mfma_loop(const char* lds, f32x16 (&acc)[2][2], int wid, int lane) {
    const int l31 = lane & 31, hi = lane >> 5;
#pragma unroll
    for (int a = 0; a < 2; ++a)
#pragma unroll
        for (int b = 0; b < 2; ++b)
#pragma unroll
            for (int r = 0; r < 16; ++r) acc[a][b][r] = 0.f;
    int a_off[2];
#pragma unroll
    for (int mt = 0; mt < 2; ++mt) { const int r = l31 + 32 * mt, q = (4 - (r & 3)) & 3; a_off[mt] = CV_UB + q * CV_FS + (4096 - r - q + 8 * hi) * 2; }
    int b_off[2];
#pragma unroll
    for (int n = 0; n < 2; ++n) { const int nt = 2 * wid + n; b_off[n] = (l31 & 7) * CV_RS + (CV_PADL + 64 * (4 * nt + (l31 >> 3)) + 8 * hi) * 2; }
    const int dlo = 8 * wid - 63;
#pragma unroll
    for (int j = 0; j < 4; ++j) conv_step<true, false>(lds, acc, a_off, b_off, dlo + j);
    ConvFrags F0, F1; const int d0 = dlo + 4; int a_hi = a_off[0] + 8; asm volatile("" : "+v"(a_hi));
    conv_load_frags(F0, lds, a_off[0], a_hi, b_off[0], b_off[1], d0);
#pragma unroll 1
    for (int j = 0; j < 31; ++j) { const int d = d0 + 2 * j;
        conv_load_frags(F1, lds, a_off[0], a_hi, b_off[0], b_off[1], d + 1); __builtin_amdgcn_sched_barrier(0);
        conv_mfma_frags(F0, acc); __builtin_amdgcn_sched_barrier(0);
        conv_load_frags(F0, lds, a_off[0], a_hi, b_off[0], b_off[1], d + 2); __builtin_amdgcn_sched_barrier(0);
        conv_mfma_frags(F1, acc); __builtin_amdgcn_sched_barrier(0); }
    conv_mfma_frags(F0, acc);
#pragma unroll
    for (int j = 0; j < 4; ++j) conv_step<false, true>(lds, acc, a_off, b_off, dlo + 67 + j);
}
DEV void conv_unit(char* lds, const Params& p, int c) {
    const int tid = TID(), lane = tid & 63, wid = tid >> 6, l31 = lane & 31, hi = lane >> 5;
    const bf16_t* PT = (const bf16_t*)(p.ws + WS_PT); const bf16_t* GR = (const bf16_t*)(p.ws + WS_GR); const float* ssum = (const float*)(p.ws + WS_SSUM);
    bf16_t* OG2 = (bf16_t*)(p.ws + WS_OG2);
    for (int i = tid; i < 8 * 98; i += 512) { const int b = i / 98, j = i % 98;
        const int e = (j < 48) ? j * 4 : (CV_PADL + SEQ + (j - 48) * 4); *(u32x2*)(lds + b * CV_RS + e * 2) = (u32x2){0u, 0u}; }
    { const float w0 = p.conv_w[c], w1 = p.conv_w[3072 + c], w2 = p.conv_w[6144 + c], bias = p.conv_b[c];
        for (int i = tid; i < 8 * 1024; i += 512) { const int b = i >> 10, t = (i & 1023) * 4; float u[4];
            sconv4(PT + ((size_t)(b * 4096 + c)) * 4096, t, w0, w1, w2, bias, u);
            u32x2 w; w.x = pk2(u[0], u[1]); w.y = pk2(u[2], u[3]); *(u32x2*)(lds + b * CV_RS + (CV_PADL + t) * 2) = w; } }
    conv_load_filter(lds, GR + (size_t)c * 8192);
    __syncthreads();
    f32x16 acc[2][2];
    conv_mfma_loop(lds, acc, wid, lane);
    __syncthreads();
    { const float invs = 1.0f / ssum[c], sk = p.skip[c];
        const float w0 = p.conv_w[1024 + c], w1 = p.conv_w[3072 + 1024 + c], w2 = p.conv_w[6144 + 1024 + c], bias = p.conv_b[1024 + c];
        const int b = l31 & 7;
#pragma unroll
        for (int n = 0; n < 2; ++n) { const int i = 4 * (2 * wid + n) + (l31 >> 3);
#pragma unroll
            for (int mt = 0; mt < 2; ++mt)
#pragma unroll
                for (int g = 0; g < 4; ++g) { const int t = 64 * i + 32 * mt + 8 * g + 4 * hi; float x1[4];
                    sconv4(PT + ((size_t)(b * 4096 + 1024 + c)) * 4096, t, w0, w1, w2, bias, x1);
                    char* up = lds + b * CV_RS + (CV_PADL + t) * 2; const u32x2 vw = *(const u32x2*)up;
                    const float z0 = x1[0] * (acc[n][mt][4 * g] * invs + sk * lo_bf(vw.x)), z1 = x1[1] * (acc[n][mt][4 * g + 1] * invs + sk * hi_bf(vw.x));
                    const float z2 = x1[2] * (acc[n][mt][4 * g + 2] * invs + sk * lo_bf(vw.y)), z3 = x1[3] * (acc[n][mt][4 * g + 3] * invs + sk * hi_bf(vw.y));
                    u32x2 w; w.x = pk2(z0, z1); w.y = pk2(z2, z3); *(u32x2*)up = w; } } }
    conv_load_filter(lds, GR + (size_t)(1024 + c) * 8192);
    __syncthreads();
    conv_mfma_loop(lds, acc, wid, lane);
    { const float invs = 1.0f / ssum[1024 + c], sk = p.skip[1024 + c];
        const float w0 = p.conv_w[2048 + c], w1 = p.conv_w[3072 + 2048 + c], w2 = p.conv_w[6144 + 2048 + c], bias = p.conv_b[2048 + c];
        const int b = l31 & 7;
#pragma unroll
        for (int n = 0; n < 2; ++n) { const int i = 4 * (2 * wid + n) + (l31 >> 3);
#pragma unroll
            for (int mt = 0; mt < 2; ++mt)
#pragma unroll
                for (int g = 0; g < 4; ++g) { const int t = 64 * i + 32 * mt + 8 * g + 4 * hi; float x2[4];
                    sconv4(PT + ((size_t)(b * 4096 + 2048 + c)) * 4096, t, w0, w1, w2, bias, x2);
                    const u32x2 zw = *(const u32x2*)(lds + b * CV_RS + (CV_PADL + t) * 2);
                    const u32x2 gw = *(const u32x2*)(PT + ((size_t)(b * 4096 + 3072 + c)) * 4096 + t);
                    const float y0 = x2[0] * (acc[n][mt][4 * g] * invs + sk * lo_bf(zw.x)) * silu(lo_bf(gw.x)), y1 = x2[1] * (acc[n][mt][4 * g + 1] * invs + sk * hi_bf(zw.x)) * silu(hi_bf(gw.x));
                    const float y2 = x2[2] * (acc[n][mt][4 * g + 2] * invs + sk * lo_bf(zw.y)) * silu(lo_bf(gw.y)), y3 = x2[3] * (acc[n][mt][4 * g + 3] * invs + sk * hi_bf(zw.y)) * silu(hi_bf(gw.y));
                    u32x2 w; w.x = pk2(y0, y1); w.y = pk2(y2, y3); *(u32x2*)(OG2 + ((size_t)(b * 1024 + c)) * 4096 + t) = w; } } }
    __syncthreads();
}

struct Raw3 { u32x2 mid; unsigned halo; };
DEV Raw3 ld_raw3(const bf16_t* px, int t) {
    Raw3 r; r.mid = *(const u32x2*)(px + t);
    const unsigned a = px[t - 1], b = px[t + 4];
    r.halo = (t > 0 ? a : 0u) | ((t + 4 < SEQ ? b : 0u) << 16);
    return r;
}
DEV void sconv_raw(const Raw3& r, float w0, float w1, float w2, float bias, float* u) {
    const float pm = lo_bf(r.halo), pp = hi_bf(r.halo), q0 = lo_bf(r.mid.x), q1 = hi_bf(r.mid.x), q2 = lo_bf(r.mid.y), q3 = hi_bf(r.mid.y);
    u[0] = w0 * pm + w1 * q0 + w2 * q1 + bias; u[1] = w0 * q0 + w1 * q1 + w2 * q2 + bias; u[2] = w0 * q1 + w1 * q2 + w2 * q3 + bias; u[3] = w0 * q2 + w1 * q3 + w2 * pp + bias;
}
struct FiltRegs { u32x4 a[2], b[2]; };
DEV void filt_load(FiltRegs& f, const bf16_t* gr, int tid) {
#pragma unroll
    for (int rnd = 0; rnd < 2; ++rnd) { const int ch = tid + rnd * 512; f.a[rnd] = *(const u32x4*)(gr + ch * 8);
        const int ch1 = ch + 1 < 1024 ? ch + 1 : ch; const u32x4 t = *(const u32x4*)(gr + ch1 * 8); f.b[rnd] = (ch + 1 < 1024) ? t : (u32x4){0u, 0u, 0u, 0u}; }
}
DEV void filt_store(char* lds, const FiltRegs& f, int tid) {
#pragma unroll
    for (int rnd = 0; rnd < 2; ++rnd) { const int ch = tid + rnd * 512; const u32x4 a = f.a[rnd], bq = f.b[rnd];
        const unsigned w[8] = {a.x, a.y, a.z, a.w, bq.x, bq.y, bq.z, bq.w};
        char* fp = lds + CV_UB + ch * 16;
        *(u32x4*)(fp) = a;
        u32x4 c1, c2, c3;
        c1.x = __builtin_amdgcn_alignbit(w[1], w[0], 16); c1.y = __builtin_amdgcn_alignbit(w[2], w[1], 16); c1.z = __builtin_amdgcn_alignbit(w[3], w[2], 16); c1.w = __builtin_amdgcn_alignbit(w[4], w[3], 16);
        c2 = (u32x4){w[1], w[2], w[3], w[4]};
        c3.x = __builtin_amdgcn_alignbit(w[2], w[1], 16); c3.y = __builtin_amdgcn_alignbit(w[3], w[2], 16); c3.z = __builtin_amdgcn_alignbit(w[4], w[3], 16); c3.w = __builtin_amdgcn_alignbit(w[5], w[4], 16);
        *(u32x4*)(fp + CV_FS) = c1; *(u32x4*)(fp + 2 * CV_FS) = c2; *(u32x4*)(fp + 3 * CV_FS) = c3; }
}
#define CV_T(k) (64 * (4 * (2 * wid + ((k) >> 3)) + (l31 >> 3)) + 32 * (((k) >> 2) & 1) + 8 * ((k) & 3) + 4 * hi)
#define CV_LANE_IDS() int tid = TID(); asm volatile("" : "+v"(tid));   \
    const int lane = tid & 63, wid = __builtin_amdgcn_readfirstlane(tid >> 6), l31 = lane & 31, hi = lane >> 5, eb = l31 & 7; (void)eb; (void)hi; (void)wid
DEV void conv_stage_load(char* lds, const Params& p, int c) {
    CV_LANE_IDS();
    const bf16_t* PT = (const bf16_t*)(p.ws + WS_PT); const bf16_t* GR = (const bf16_t*)(p.ws + WS_GR);
    FiltRegs f0; filt_load(f0, GR + (size_t)c * 8192, tid);
    Raw3 ru[16];
#pragma unroll
    for (int k = 0; k < 16; ++k) { const int i = tid + k * 512, b = i >> 10, t = (i & 1023) * 4; ru[k] = ld_raw3(PT + ((size_t)(b * 4096 + c)) * 4096, t); }
    for (int i = tid; i < 8 * 98; i += 512) { const int b = i / 98, j = i % 98;
        const int e = (j < 48) ? j * 4 : (CV_PADL + SEQ + (j - 48) * 4); *(u32x2*)(lds + b * CV_RS + e * 2) = (u32x2){0u, 0u}; }
    const float w0 = p.conv_w[c], w1 = p.conv_w[3072 + c], w2 = p.conv_w[6144 + c], bias = p.conv_b[c];
#pragma unroll
    for (int k = 0; k < 16; ++k) { const int i = tid + k * 512, b = i >> 10, t = (i & 1023) * 4; float u[4]; sconv_raw(ru[k], w0, w1, w2, bias, u);
        u32x2 w; w.x = pk2(u[0], u[1]); w.y = pk2(u[2], u[3]); *(u32x2*)(lds + b * CV_RS + (CV_PADL + t) * 2) = w; }
    filt_store(lds, f0, tid);
}
DEV void conv_stage_epi0(char* lds, const Params& p, int c, const f32x16 (&acc)[2][2]) {
    CV_LANE_IDS();
    const bf16_t* PT = (const bf16_t*)(p.ws + WS_PT); const bf16_t* GR = (const bf16_t*)(p.ws + WS_GR); const float* ssum = (const float*)(p.ws + WS_SSUM);
    FiltRegs f1; filt_load(f1, GR + (size_t)(1024 + c) * 8192, tid);
    const bf16_t* px1 = PT + ((size_t)(eb * 4096 + 1024 + c)) * 4096;
    Raw3 r1[16];
#pragma unroll
    for (int k = 0; k < 16; ++k) r1[k] = ld_raw3(px1, CV_T(k));
    const float a0 = p.conv_w[1024 + c], a1 = p.conv_w[3072 + 1024 + c], a2 = p.conv_w[6144 + 1024 + c], ab = p.conv_b[1024 + c];
    const float invs = 1.0f / ssum[c], sk = p.skip[c];
#pragma unroll
    for (int k = 0; k < 16; ++k) { const int n = k >> 3, mt = (k >> 2) & 1, g = k & 3; const int t = CV_T(k);
        float x1[4]; sconv_raw(r1[k], a0, a1, a2, ab, x1);
        char* up = lds + eb * CV_RS + (CV_PADL + t) * 2; const u32x2 vw = *(const u32x2*)up;
        const float z0 = x1[0] * (acc[n][mt][4 * g] * invs + sk * lo_bf(vw.x)), z1 = x1[1] * (acc[n][mt][4 * g + 1] * invs + sk * hi_bf(vw.x));
        const float z2 = x1[2] * (acc[n][mt][4 * g + 2] * invs + sk * lo_bf(vw.y)), z3 = x1[3] * (acc[n][mt][4 * g + 3] * invs + sk * hi_bf(vw.y));
        u32x2 w; w.x = pk2(z0, z1); w.y = pk2(z2, z3); *(u32x2*)up = w; }
    filt_store(lds, f1, tid);
}
DEV void conv_stage_epi1(char* lds, const Params& p, int c, const f32x16 (&acc)[2][2]) {
    CV_LANE_IDS();
    const bf16_t* PT = (const bf16_t*)(p.ws + WS_PT); const float* ssum = (const float*)(p.ws + WS_SSUM); bf16_t* OG2 = (bf16_t*)(p.ws + WS_OG2);
    const bf16_t* px2 = PT + ((size_t)(eb * 4096 + 2048 + c)) * 4096; const bf16_t* pg = PT + ((size_t)(eb * 4096 + 3072 + c)) * 4096;
    Raw3 r2[16]; u32x2 rg[16];
#pragma unroll
    for (int k = 0; k < 16; ++k) { r2[k] = ld_raw3(px2, CV_T(k)); rg[k] = *(const u32x2*)(pg + CV_T(k)); }
    const float b0 = p.conv_w[2048 + c], b1 = p.conv_w[3072 + 2048 + c], b2 = p.conv_w[6144 + 2048 + c], bb = p.conv_b[2048 + c];
    const float invs = 1.0f / ssum[1024 + c], sk = p.skip[1024 + c];
#pragma unroll
    for (int k = 0; k < 16; ++k) { const int n = k >> 3, mt = (k >> 2) & 1, g = k & 3; const int t = CV_T(k);
        float x2[4]; sconv_raw(r2[k], b0, b1, b2, bb, x2);
        const u32x2 zw = *(const u32x2*)(lds + eb * CV_RS + (CV_PADL + t) * 2);
        const float y0 = x2[0] * silu(lo_bf(rg[k].x)) * (acc[n][mt][4 * g] * invs + sk * lo_bf(zw.x)), y1 = x2[1] * silu(hi_bf(rg[k].x)) * (acc[n][mt][4 * g + 1] * invs + sk * hi_bf(zw.x));
        const float y2 = x2[2] * silu(lo_bf(rg[k].y)) * (acc[n][mt][4 * g + 2] * invs + sk * lo_bf(zw.y)), y3 = x2[3] * silu(hi_bf(rg[k].y)) * (acc[n][mt][4 * g + 3] * invs + sk * hi_bf(zw.y));
        u32x2 w; w.x = pk2(y0, y1); w.y = pk2(y2, y3); *(u32x2*)(OG2 + ((size_t)(eb * 1024 + c)) * 4096 + t) = w; }
}
DEV void conv_stage_mfma(const char* lds, f32x16 (&acc)[2][2]) { CV_LANE_IDS(); conv_mfma_loop(lds, acc, wid, lane); }
DEV void conv_unit2(char* lds, const Params& p, int c) {
    conv_stage_load(lds, p, c);
    __syncthreads();
    f32x16 acc[2][2];
    conv_stage_mfma(lds, acc);
    __syncthreads();
    conv_stage_epi0(lds, p, c, acc);
    __syncthreads();
    conv_stage_mfma(lds, acc);
    conv_stage_epi1(lds, p, c, acc);
    __syncthreads();
}
#undef CV_T
#undef CV_LANE_IDS

struct cf { float x, y; };
DEV float s_add(float a, float b) { float r; asm("v_add_f32_e32 %0, %1, %2" : "=v"(r) : "v"(a), "v"(b)); return r; }
DEV float s_sub(float a, float b) { float r; asm("v_sub_f32_e32 %0, %1, %2" : "=v"(r) : "v"(a), "v"(b)); return r; }
DEV float s_mul(float a, float b) { float r; asm("v_mul_f32_e32 %0, %1, %2" : "=v"(r) : "v"(a), "v"(b)); return r; }
DEV float s_fma(float a, float b, float c) { float r; asm("v_fma_f32 %0, %1, %2, %3" : "=v"(r) : "v"(a), "v"(b), "v"(c)); return r; }
DEV float s_fnma(float a, float b, float c) { float r; asm("v_fma_f32 %0, -%1, %2, %3" : "=v"(r) : "v"(a), "v"(b), "v"(c)); return r; }
DEV cf cadd(cf a, cf b) { return cf{s_add(a.x, b.x), s_add(a.y, b.y)}; }
DEV cf csub(cf a, cf b) { return cf{s_sub(a.x, b.x), s_sub(a.y, b.y)}; }
DEV cf cmul(cf a, cf b) { cf r;
    asm("v_mul_f32_e32 %0, %2, %4\n\tv_mul_f32_e32 %1, %2, %5\n\tv_fma_f32 %0, -%3, %5, %0\n\tv_fma_f32 %1, %3, %4, %1" : "=&v"(r.x), "=&v"(r.y) : "v"(a.x), "v"(a.y), "v"(b.x), "v"(b.y)); return r; }
template <int M> DEV cf mulw16(cf a) {
    if constexpr (M == 0) return a;
    else if constexpr (M == 4) return cf{a.y, -a.x};
    else if constexpr (M == 2) return cf{s_mul(s_add(a.x, a.y), 0.70710678118654752f), s_mul(s_sub(a.y, a.x), 0.70710678118654752f)};
    else if constexpr (M == 6) return cf{s_mul(s_sub(a.y, a.x), 0.70710678118654752f), s_mul(s_add(a.x, a.y), -0.70710678118654752f)};
    else { constexpr float c = (M == 1) ? 0.92387953251128674f : (M == 3) ? 0.38268343236508977f : (M == 5) ? -0.38268343236508977f : -0.92387953251128674f;
           constexpr float sn = (M == 1) ? -0.38268343236508977f : (M == 3) ? -0.92387953251128674f : (M == 5) ? -0.92387953251128674f : -0.38268343236508977f;
           return cf{s_fnma(a.y, sn, s_mul(a.x, c)), s_fma(a.y, c, s_mul(a.x, sn))}; }
}
DEV void bfly4(cf a, cf b, cf& s_, cf& d_) {
    asm("v_add_f32_e32 %0, %4, %6\n\tv_add_f32_e32 %1, %5, %7\n\tv_sub_f32_e32 %2, %4, %6\n\tv_sub_f32_e32 %3, %5, %7" : "=&v"(s_.x), "=&v"(s_.y), "=&v"(d_.x), "=&v"(d_.y) : "v"(a.x), "v"(a.y), "v"(b.x), "v"(b.y)); }
template <int HALF, int BLK, int J> DEV void dif_bfly(cf (&v)[16]) { const cf a = v[BLK + J], b = v[BLK + J + HALF]; cf sm, df; bfly4(a, b, sm, df); v[BLK + J] = sm; v[BLK + J + HALF] = mulw16<J * (8 / HALF)>(df); }
DEV void dft16(cf (&v)[16]) {
#define B8(j) dif_bfly<8, 0, j>(v)
    B8(0); B8(1); B8(2); B8(3); B8(4); B8(5); B8(6); B8(7);
#undef B8
#define B4(b, j) dif_bfly<4, b, j>(v)
    B4(0, 0); B4(0, 1); B4(0, 2); B4(0, 3); B4(8, 0); B4(8, 1); B4(8, 2); B4(8, 3);
#undef B4
#define B2(b, j) dif_bfly<2, b, j>(v)
    B2(0, 0); B2(0, 1); B2(4, 0); B2(4, 1); B2(8, 0); B2(8, 1); B2(12, 0); B2(12, 1);
#undef B2
#define B1(b) dif_bfly<1, b, 0>(v)
    B1(0); B1(2); B1(4); B1(6); B1(8); B1(10); B1(12); B1(14);
#undef B1
}
#define FFT_BR4(k) ((((k) & 1) << 3) | (((k) & 2) << 1) | (((k) & 4) >> 1) | (((k) & 8) >> 3))
constexpr int FF_BUF = (8192 + 512) * 8;
DEV int ffp(int idx) { return (idx + (idx >> 4)) * 8; }
struct FftTw { cf t3[16]; };
constexpr int FF_T2 = 2 * FF_BUF;
DEV void fft_twiddles(FftTw& T, char* lds, int tid) {
    if (tid < 240) { const int k = tid / 15, r = tid % 15 + 1; float sn, cs; sincospif(-(float)(k * r) * (1.0f / 128.0f), &sn, &cs); *(cf*)(lds + FF_T2 + tid * 8) = cf{cs, sn}; }
    __syncthreads();
    { const int i3 = tid & 255, h = tid >> 8; float sn, cs; sincospif(-(float)i3 * (1.0f / 4096.0f), &sn, &cs); asm volatile("s_nop 1" : "+v"(sn), "+v"(cs));
        const cf w1 = cf{cs, sn}; const cf w2 = cmul(w1, w1);
        cf t = h ? w1 : cf{1.f, 0.f};
#pragma unroll
        for (int sx = 0; sx < 16; ++sx) { T.t3[sx] = t; t = cmul(t, w2); } }
}
DEV void fft_pass23(char* A, char* B, const char* tw2, int tid, const FftTw& T) {
    asm volatile("" : "+v"(tid));
    cf v[16];
    {
        const int i = tid, k = i & 15;
        { const char* rb = A + ffp(i);
#pragma unroll
        for (int r = 0; r < 16; ++r) v[r] = *(const cf*)(rb + 4352 * r); }
#pragma unroll
        for (int r = 1; r < 16; ++r) v[r] = cmul(v[r], *(const cf*)(tw2 + k * 120 + (r - 1) * 8));
        dft16(v);
        const int j = ((i >> 4) << 8) + k;
        { char* wb = B + (j + 16 * (i >> 4)) * 8;
#pragma unroll
        for (int r = 0; r < 16; ++r) *(cf*)(wb + 136 * r) = v[FFT_BR4(r)]; }
        __syncthreads();
    }
    {
        const int i3 = tid & 255, h = tid >> 8;
        const char* rb3 = B + ffp(i3) + 2176 * h;
#pragma unroll
        for (int sx = 0; sx < 16; ++sx) v[sx] = *(const cf*)(rb3 + 4352 * sx);
#pragma unroll
        for (int sx = 0; sx < 16; ++sx) v[sx] = cmul(v[sx], T.t3[sx]);
        dft16(v);
        if (h) {
            const float c32[16] = {1.f, 0.98078528040323043f, 0.92387953251128674f, 0.83146961230254524f, 0.70710678118654752f, 0.55557023301960218f, 0.38268343236508977f, 0.19509032201612825f,
                                   0.f, -0.19509032201612825f, -0.38268343236508977f, -0.55557023301960218f, -0.70710678118654752f, -0.83146961230254524f, -0.92387953251128674f, -0.98078528040323043f};
            const float s32[16] = {0.f, -0.19509032201612825f, -0.38268343236508977f, -0.55557023301960218f, -0.70710678118654752f, -0.83146961230254524f, -0.92387953251128674f, -0.98078528040323043f,
                                   -1.f, -0.98078528040323043f, -0.92387953251128674f, -0.83146961230254524f, -0.70710678118654752f, -0.55557023301960218f, -0.38268343236508977f, -0.19509032201612825f};
#pragma unroll
            for (int m = 0; m < 16; ++m) v[FFT_BR4(m)] = cmul(v[FFT_BR4(m)], cf{c32[m], s32[m]});
        }
        { char* wb3 = A + ffp(i3) + 34816 * h;
#pragma unroll
        for (int m = 0; m < 16; ++m) *(cf*)(wb3 + 2176 * m) = v[FFT_BR4(m)]; }
        __syncthreads();
    }
}
DEV void fft_pass1_store(char* D, cf (&v)[16], int tid) {
    dft16(v);
    { char* wb = D + 136 * tid;
#pragma unroll
    for (int r = 0; r < 16; ++r) *(cf*)(wb + 8 * r) = v[FFT_BR4(r)]; }
    __syncthreads();
}
constexpr size_t WS_CVIN = WS_H1;
DEV void fftconv_unit(char* lds, const Params& p, int c, const FftTw& T) {
    int tid = TID(); asm volatile("" : "+v"(tid));
    char* D0 = lds; char* D1 = lds + FF_BUF;
    const bf16_t* PT = (const bf16_t*)(p.ws + WS_PT); const bf16_t* GR = (const bf16_t*)(p.ws + WS_GR); const float* ssum = (const float*)(p.ws + WS_SSUM);
    bf16_t* OG2 = (bf16_t*)(p.ws + WS_OG2); float* IN = (float*)(p.ws + WS_CVIN) + (size_t)blockIdx.x * (8 * 4096);
    { const float w0 = p.conv_w[c], w1 = p.conv_w[3072 + c], w2 = p.conv_w[6144 + c], bias = p.conv_b[c];
#pragma unroll 2
        for (int k = 0; k < 8; ++k) { const int i = tid + k * 512, b = i >> 9, n0 = (i & 511) * 8;
            const bf16_t* px = PT + ((size_t)(b * 4096 + c)) * 4096;
            float q[10]; { const u32x4 m = *(const u32x4*)(px + n0); unpack8(m, q + 1); q[0] = (n0 > 0) ? bf2f(px[n0 - 1]) : 0.f; q[9] = (n0 + 8 < SEQ) ? bf2f(px[n0 + 8]) : 0.f; }
            f32x4 o0, o1;
#pragma unroll
            for (int e = 0; e < 4; ++e) { o0[e] = w0 * q[e] + w1 * q[e + 1] + w2 * q[e + 2] + bias; o1[e] = w0 * q[e + 4] + w1 * q[e + 5] + w2 * q[e + 6] + bias; }
            *(f32x4*)(IN + b * 4096 + n0) = o0; *(f32x4*)(IN + b * 4096 + n0 + 4) = o1; } }
    __syncthreads();
#pragma unroll 1
    for (int o = 0; o < 2; ++o) {
        cf KS[16];
        asm volatile("" : "+v"(tid));
        { const bf16_t* g = GR + (size_t)(o * 1024 + c) * 8192; const float invs = 1.0f / ssum[o * 1024 + c];
            cf v[16];
#pragma unroll
            for (int r = 0; r < 16; ++r) { const int n = tid + 512 * r; v[r] = cf{bf2f(g[(12288 - n) & 8191]) * invs, 0.f}; }
            fft_pass1_store(D0, v, tid);
            fft_pass23(D0, D1, lds + FF_T2, tid, T);
#pragma unroll
            for (int q = 0; q < 8; ++q) { const cf a = *(const cf*)(D0 + ffp(tid) + 4352 * q), b = *(const cf*)(D0 + ffp(tid) + 4352 * q + 34816); KS[q] = cadd(a, b); KS[q + 8] = csub(a, b); }
            __syncthreads(); }
        const float sk = p.skip[o * 1024 + c];
        const int part = (o == 0) ? 1024 : 2048;
        const float w0 = p.conv_w[part + c], w1 = p.conv_w[3072 + part + c], w2 = p.conv_w[6144 + part + c], bias = p.conv_b[part + c];
        cf vin[8];
#pragma unroll
        for (int r = 0; r < 8; ++r) vin[r] = cf{IN[tid + 512 * r], IN[4096 + tid + 512 * r]};
#pragma unroll 1
        for (int pr = 0; pr < 4; ++pr) {
            asm volatile("" : "+v"(tid));
            const int n0 = 8 * tid;
            u32x4 eraw[2], egate[2]; f32x4 eu[2][2]; unsigned ehalo[2];
#pragma unroll
            for (int hb = 0; hb < 2; ++hb) { const int b = 2 * pr + hb; const bf16_t* px = PT + ((size_t)(b * 4096 + part + c)) * 4096;
                eraw[hb] = *(const u32x4*)(px + n0);
                const unsigned ha = px[n0 - 1], hz = px[n0 + 8];
                ehalo[hb] = ((n0 > 0) ? ha : 0u) | (((n0 + 8 < SEQ) ? hz : 0u) << 16);
                eu[hb][0] = *(const f32x4*)(IN + b * 4096 + n0); eu[hb][1] = *(const f32x4*)(IN + b * 4096 + n0 + 4);
                egate[hb] = (o == 1) ? *(const u32x4*)(PT + ((size_t)(b * 4096 + 3072 + c)) * 4096 + n0) : (u32x4){0u, 0u, 0u, 0u}; }
            {
                cf v[16];
#pragma unroll
                for (int r = 0; r < 8; ++r) v[r] = vin[r];
#pragma unroll
                for (int r = 8; r < 16; ++r) v[r] = cf{0.f, 0.f};
                fft_pass1_store(D0, v, tid);
                fft_pass23(D0, D1, lds + FF_T2, tid, T);
            }
            {
                const int pn = (pr < 3) ? pr + 1 : pr; const float* ina = IN + (2 * pn) * 4096;
#pragma unroll
                for (int r = 0; r < 8; ++r) vin[r] = cf{ina[tid + 512 * r], ina[4096 + tid + 512 * r]};
            }
            {
                cf v[16];
#pragma unroll
                for (int q = 0; q < 8; ++q) { const cf a = *(const cf*)(D0 + ffp(tid) + 4352 * q), b = *(const cf*)(D0 + ffp(tid) + 4352 * q + 34816);
                    const cf x0 = cmul(cadd(a, b), KS[q]), x1 = cmul(csub(a, b), KS[q + 8]);
                    v[q] = cf{x0.x, -x0.y}; v[q + 8] = cf{x1.x, -x1.y}; }
                fft_pass1_store(D1, v, tid);
                fft_pass23(D1, D0, lds + FF_T2, tid, T);
            }
            {
                float ya[8], yb[8];
#pragma unroll
                for (int e = 0; e < 8; ++e) { const cf a = *(const cf*)(D1 + 64 * tid + 8 * (tid >> 1) + 8 * e), b = *(const cf*)(D1 + 64 * tid + 8 * (tid >> 1) + 8 * e + 34816); ya[e] = (a.x + b.x) * (1.0f / 8192.0f); yb[e] = -(a.y + b.y) * (1.0f / 8192.0f); }
#pragma unroll
                for (int hb = 0; hb < 2; ++hb) { const int b = 2 * pr + hb; float* inp = IN + b * 4096 + n0; const float* yy = hb ? yb : ya;
                    float q[10]; unpack8(eraw[hb], q + 1); q[0] = lo_bf(ehalo[hb]); q[9] = hi_bf(ehalo[hb]);
                    const f32x4 u0 = eu[hb][0], u1 = eu[hb][1]; const float uu[8] = {u0.x, u0.y, u0.z, u0.w, u1.x, u1.y, u1.z, u1.w};
                    float z[8];
#pragma unroll
                    for (int e = 0; e < 8; ++e) { const float xc = w0 * q[e] + w1 * q[e + 1] + w2 * q[e + 2] + bias; z[e] = xc * (yy[e] + sk * uu[e]); }
                    if (o == 0) { *(f32x4*)inp = (f32x4){z[0], z[1], z[2], z[3]}; *(f32x4*)(inp + 4) = (f32x4){z[4], z[5], z[6], z[7]}; }
                    else { float gg[8]; unpack8(egate[hb], gg);
#pragma unroll
                        for (int e = 0; e < 8; ++e) z[e] *= silu(gg[e]);
                        *(u32x4*)(OG2 + ((size_t)(b * 1024 + c)) * 4096 + n0) = pack8(z); } }
            }
        }
        __syncthreads();
    }
}

#define XB_TMO      128
#define XB_XCNT(j)  (256  + 64 * (j))
#define XB_XSUB(j)  (1280 + 64 * (j))
#define XB_XGEN(j)  (2304 + 64 * (j))
#define XB_TOP      3328
#define XB_TOPGEN   3392
#define XCD_BAR_WORDS 3456
#define XB_SPIN_CAP (1u << 20)
DEV unsigned xb_ld(unsigned* p) { return __hip_atomic_load(p, __ATOMIC_RELAXED, __HIP_MEMORY_SCOPE_AGENT); }
DEV unsigned xb_add(unsigned* p, unsigned v) { return __hip_atomic_fetch_add(p, v, __ATOMIC_RELAXED, __HIP_MEMORY_SCOPE_AGENT); }
DEV unsigned xb_xcc_id() { return (unsigned)__builtin_amdgcn_s_getreg((3 << 11) | 20) & 0xFu; }
#define XB_SPIN(cond, bar) do { unsigned _sp = 0; while (cond) { __builtin_amdgcn_s_sleep(1); \
    if ((++_sp & 255u) == 0u) { if (xb_ld(&(bar)[XB_TMO])) break; if (_sp > XB_SPIN_CAP) { atomicAdd(&(bar)[XB_TMO], 1u); break; } } } } while (0)
struct XcdBarrier { unsigned* bar; unsigned x; volatile LAS unsigned* st; };
DEV XcdBarrier xcd_barrier_post(unsigned* bar, volatile LAS unsigned* st) {
    XcdBarrier b; b.bar = bar; b.x = xb_xcc_id(); b.st = st;
    if (TID() == 0) (void)xb_add(&bar[XB_XCNT(b.x)], 1u);
    return b;
}
DEV void xcd_barrier_complete(unsigned* bar, unsigned x, unsigned& nloc, unsigned& nx) {
    const unsigned G = gridDim.x * gridDim.y * gridDim.z;
    unsigned sum, cnt, mine, sp = 0u;
    for (;;) {
        sum = 0u; cnt = 0u; mine = 0u;
#pragma unroll
        for (unsigned j = 0; j < 16; ++j) { const unsigned c = xb_ld(&bar[XB_XCNT(j)]); sum += c; cnt += (c > 0u) ? 1u : 0u; mine = (j == x) ? c : mine; }
        if (sum == G) break;
        __builtin_amdgcn_s_sleep(1);
        if ((++sp & 255u) == 0u) { if (xb_ld(&bar[XB_TMO])) break; if (sp > XB_SPIN_CAP) { atomicAdd(&bar[XB_TMO], 1u); break; } }
    }
    nloc = mine > 0u ? mine : 1u; nx = cnt > 0u ? cnt : 1u;
}
DEV void xcd_barrier(const XcdBarrier& b) {
    asm volatile("s_waitcnt vmcnt(0)" ::: "memory");
    __syncthreads();
    if (TID() == 0) {
        unsigned* bar = b.bar;
        __builtin_amdgcn_s_waitcnt(0);
        unsigned nloc = b.st[0], nx = b.st[1];
        if (nloc == 0u) { xcd_barrier_complete(bar, b.x, nloc, nx); b.st[0] = nloc; b.st[1] = nx; }
        const unsigned old = xb_add(&bar[XB_XSUB(b.x)], 1u);
        const unsigned gen = old / nloc;
        if (old + 1u == (gen + 1u) * nloc) {
            __builtin_amdgcn_fence(__ATOMIC_RELEASE, "agent");
            asm volatile("s_waitcnt vmcnt(0)" ::: "memory");
            const unsigned og = xb_add(&bar[XB_TOP], 1u);
            const unsigned tg = og / nx;
            if (og + 1u == (tg + 1u) * nx) xb_add(&bar[XB_TOPGEN], 1u);
            else XB_SPIN(xb_ld(&bar[XB_TOPGEN]) == tg, bar);
            __builtin_amdgcn_fence(__ATOMIC_ACQUIRE, "agent");
            xb_add(&bar[XB_XGEN(b.x)], 1u);
            asm volatile("s_waitcnt vmcnt(0)" ::: "memory");
        } else {
            XB_SPIN(xb_ld(&bar[XB_XGEN(b.x)]) == gen, bar);
            __builtin_amdgcn_fence(__ATOMIC_ACQUIRE, "agent");
            asm volatile("s_waitcnt vmcnt(0)" ::: "memory");
        }
    }
    __syncthreads();
}

constexpr int NPHASE = 12;
__global__ void __launch_bounds__(512) fwd_kernel(Params p) {
    char* lds = lds_dyn;
    char* ws = p.ws;
    volatile LAS unsigned* bst = (volatile LAS unsigned*)(LAS char*)(lds + LDS_BYTES - 64);
    { const int t0 = threadIdx.x;
        if (t0 < 16) bst[t0] = 0u;
        if ((t0 & 63) == 0) *(volatile LAS int*)(LAS char*)(lds + LDS_WTAB + 4 * hw_slot()) = t0 >> 6; }
    __syncthreads();
    if (MK_LAUNCHES == 1) (void)xcd_barrier_post((unsigned*)(ws + WS_CTL), bst);
    if (MK_LAUNCHES == 1 && p.ph_hi > NPHASE) cg::this_grid().sync();
#define SEAM(k) do { if (MK_LAUNCHES == 1 && (k) + 1 < p.ph_hi) { XcdBarrier xb_; xb_.bar = (unsigned*)(p.ws + WS_CTL); xb_.x = xb_xcc_id(); xb_.st = (volatile LAS unsigned*)(LAS char*)(lds + LDS_BYTES - 64); xcd_barrier(xb_); } } while (0)
#ifndef PHASE_MASK
#define PHASE_MASK 0xFFF
#endif
#define IN(k) (((PHASE_MASK >> (k)) & 1) && p.ph_lo <= (k) && (k) < p.ph_hi)
#define REP(k) for (int rep_ = 0; rep_ < ((PROBE_REPEAT == (k)) ? 2 : 1); ++rep_)
    if (IN(0)) { REP(0) phase_prep(lds, p); SEAM(0); }
    if (IN(1)) {
        for (int rep_ = 0; rep_ < ((PROBE_REPEAT == 21) ? 2 : 1); ++rep_) {
        const bool dummy = (PROBE_REPEAT == 21 && rep_ == 0);
        EpiFilt ef{(bf16_t*)(ws + (dummy ? WS_PRAW : WS_GR)), p.f_b3};
        gemm_phase<false, EpiFilt>(lds, (const bf16_t*)(ws + WS_W3), 64, (const bf16_t*)(ws + WS_HID2), 64, 4096, 4096, 64, ef); }
        REP(1) phase_norm0(p); SEAM(1); }
    if (IN(2)) {
        REP(2) { pg8::Gemm g{(const bf16_t*)(ws + WS_H0), (const bf16_t*)(ws + WS_WIN), NALL, AINP, DM}; pg8::StaticOrder S; S.init(NALL, AINP, (int)gridDim.x, (int)blockIdx.x);
            pg8::EpiBf16 E{(bf16_t*)(ws + WS_PRAW), (size_t)AINP, 0, 0};
            pg8::gemm_phase<pg8::EpiBf16, pg8::StaticOrder, true, true>((PG8_LAS unsigned char*)lds, g, S, E); }
        SEAM(2); }
    if (IN(3)) { filt_sums(p); REP(3) phase_post(p); SEAM(3); }
    if (IN(4)) {
        const float* rp = (const float*)(ws + WS_ROPE);
        REP(4) {
        { pg8::Gemm g{(const bf16_t*)(ws + WS_CQN), (const bf16_t*)(ws + WS_WUQ), NTOK, 768, 256}; pg8::StaticOrder S; S.init(NTOK, 768, (int)gridDim.x, (int)blockIdx.x);
            pg8::EpiUqPg E{(bf16_t*)(ws + WS_QM), rp + 2048, rp + 2560, QSC_M};
            pg8::gemm_phase<pg8::EpiUqPg, pg8::StaticOrder, true, true>((PG8_LAS unsigned char*)lds, g, S, E); }
        int opq_ = 0; asm volatile("" : "+s"(opq_));
        if (opq_ == 0) { pg8::Gemm g{(const bf16_t*)(ws + WS_CKVN), (const bf16_t*)(ws + WS_WUKV), NALL, 1024, 128}; pg8::StaticOrder S; S.init(NALL, 1024, (int)gridDim.x, (int)blockIdx.x);
            pg8::EpiUkvPg E{(bf16_t*)(ws + WS2_KM), (bf16_t*)(ws + WS2_VM)};
            pg8::gemm_phase<pg8::EpiUkvPg, pg8::StaticOrder, true, true>((PG8_LAS unsigned char*)lds, g, S, E); } }
        SEAM(4); }
    if (IN(5)) { REP(5) phase_attn(lds, p); SEAM(5); }
    if (IN(6)) {
        REP(6) { pg8::Gemm g{(const bf16_t*)(ws + WS2_OG), (const bf16_t*)(ws + WS_WOUT), NTOK, DM, DM}; pg8::StaticOrder S; S.init(NTOK, DM, (int)gridDim.x, (int)blockIdx.x);
            pg8::EpiResBf16 E{p.x, (bf16_t*)p.out, (const float*)(ws + WS_MOD0), (DBG_SKIP & 1) ? 0.f : 1.f};
            pg8::gemm_phase<pg8::EpiResBf16, pg8::StaticOrder, true, true>((PG8_LAS unsigned char*)lds, g, S, E); }
        SEAM(6); }
    if (IN(7)) { REP(7) phase_norm1(p); SEAM(7); }
    if (IN(8)) {
        REP(8) { pg8::Gemm g{(const bf16_t*)(ws + WS_HWIN), (const bf16_t*)(ws + WS_H1), 4096, NTOK, DM}; pg8::StaticOrder S; S.init(4096, NTOK, (int)gridDim.x, (int)blockIdx.x);
            pg8::EpiBf16 E{(bf16_t*)(ws + WS_PT), (size_t)4096, 4096, (size_t)4096 * 4096};
            pg8::gemm_phase<pg8::EpiBf16, pg8::StaticOrder, true, true>((PG8_LAS unsigned char*)lds, g, S, E); }
        SEAM(8); }
    if (IN(9)) { FftTw T; fft_twiddles(T, lds, TID()); REP(9) for (int c = blockIdx.x; c < 1024; c += gridDim.x) fftconv_unit(lds, p, c, T); SEAM(9); }
    if (IN(10)) {
        REP(10) {
        EpiRes e{(const bf16_t*)p.out, (bf16_t*)(ws + WS_PT), (const float*)(ws + WS_MOD1), (DBG_SKIP & 2) ? 0.f : 1.f};
        const bf16_t* OG2 = (const bf16_t*)(ws + WS_OG2); const bf16_t* W = (const bf16_t*)(ws + WS_HWOUT);
        const int nt = (NTOK / 256) * (DM / 256);
        for (int t = blockIdx.x; t < nt; t += gridDim.x) { const int ti = t / 4, tj = t % 4; const int b = ti >> 4, l0 = (ti & 15) * 256;
            gemm_tile256_tr<EpiRes>(lds, OG2 + (size_t)b * 1024 * 4096 + l0, 4096, W + (size_t)tj * 256 * DM, DM, DM, e, ti * 256, tj * 256); }
        }
        SEAM(10); }
    if (IN(11)) { phase_final(p); }
#undef SEAM
#undef IN
}

extern "C" void kernel_launch(void* const* d_in, const int* in_sizes, int n_in, void* d_out, int out_size, void* d_ws, size_t ws_size, hipStream_t stream) {
    static int grid = 0;
    if (grid == 0) {
        if (n_in != 28 || out_size != NTOK * DM || ws_size < WS_END) { fprintf(stderr, "kernel_launch: unexpected shapes n_in %d out %d ws %zu\n", n_in, out_size, ws_size); grid = -1; return; }
        int dev = 0, cus = 0, per_cu = 0;
        hipGetDevice(&dev); hipDeviceGetAttribute(&cus, hipDeviceAttributeMultiprocessorCount, dev);
        if (hipFuncSetAttribute((const void*)fwd_kernel, hipFuncAttributeMaxDynamicSharedMemorySize, LDS_BYTES) != hipSuccess) { fprintf(stderr, "hipFuncSetAttribute failed\n"); grid = -1; return; }
        hipOccupancyMaxActiveBlocksPerMultiprocessor(&per_cu, (const void*)fwd_kernel, 512, LDS_BYTES);
        if (per_cu < 1) { fprintf(stderr, "occupancy query says %d\n", per_cu); per_cu = 1; }
        grid = cus * 1;
        (void)hipGetLastError();
    }
    if (grid < 0) return;
    Params p{};
    const float** pp = (const float**)&p;
    for (int i = 0; i < 28; ++i) pp[i] = (const float*)d_in[i];
    p.out = (float*)d_out; p.ws = (char*)d_ws;
#if MK_LAUNCHES == 1
    if (hipMemsetAsync((char*)d_ws + WS_CTL, 0, CTL_BYTES, stream) != hipSuccess) { fprintf(stderr, "memset failed\n"); return; }
    p.ph_lo = 0; p.ph_hi = NPHASE;
    void* args[] = {&p};
    hipError_t e = hipLaunchCooperativeKernel((const void*)fwd_kernel, dim3(grid), dim3(512), args, LDS_BYTES, stream);
    if (e != hipSuccess) fprintf(stderr, "cooperative launch failed: %s (grid %d)\n", hipGetErrorString(e), grid);
#else
    for (int k = 0; k < NPHASE; ++k) { p.ph_lo = k; p.ph_hi = k + 1; hipLaunchKernelGGL(fwd_kernel, dim3(grid), dim3(512), LDS_BYTES, stream, p); }
#endif
}
```
